# Optimizing an MI355X kernel written in HIP

```python
import math
import jax
import jax.numpy as jnp
from jax import lax
import numpy as np

D_MODEL = 1024
BATCH = 4
SEQ = 8192
DEPTH = 1
DEC_BATCH = 32
DEC_SEQ = 1
PAST_LEN = 16384
PAGE_SIZE = 128

N_HEADS = 8
KV_HEADS = 2
HEADS_PER_GROUP = N_HEADS // KV_HEADS
HEAD_DIM = 64
Q_DIM = N_HEADS * HEAD_DIM
KV_DIM = KV_HEADS * HEAD_DIM
CMP_LEN = 32
CMP_STRIDE = 16
CMP_HID = 2 * HEAD_DIM
SEL_LEN = 64
N_SEL_BLOCKS = 16
WINDOW = 512
Q_BLOCK = 128
GM_GROUPS = 4
GM_CHUNK = 128
GM_DIM = D_MODEL // 2
GM_GROUP_DIM = GM_DIM // GM_GROUPS
D_FF = -(-8 * D_MODEL // (3 * 256)) * 256
PLE_DIM = 256
N_BUCKETS = 32
MAX_DISTANCE = 128
EPS = 1e-6
NEG_INF = -1e30
FORCE_SCORE = 1e6
IN_DIM = Q_DIM + 6 * KV_DIM + 3 * N_HEADS + 2 * GM_DIM + 2 * D_MODEL

kernel_name = 'nsa_gmlp_parallel_hybrid_step'


def rms_norm(x, g):
    xf = x.astype(jnp.float32)
    y = xf * lax.rsqrt(jnp.mean(xf * xf, axis=-1, keepdims=True) + EPS)
    return (y * g.astype(jnp.float32)).astype(x.dtype)


def layer_norm(x, g, b):
    xf = x.astype(jnp.float32)
    mu = jnp.mean(xf, axis=-1, keepdims=True)
    var = jnp.mean(jnp.square(xf - mu), axis=-1, keepdims=True)
    y = (xf - mu) * lax.rsqrt(var + EPS)
    return (y * g.astype(jnp.float32) + b.astype(jnp.float32)).astype(x.dtype)


def t5_bucket(dist):
    dist = jnp.maximum(dist, 0)
    max_exact = N_BUCKETS // 2
    ratio = jnp.log(jnp.maximum(dist, 1).astype(jnp.float32) / max_exact) / math.log(MAX_DISTANCE / max_exact)
    large = jnp.minimum(max_exact + (ratio * (N_BUCKETS - max_exact)).astype(jnp.int32), N_BUCKETS - 1)
    return jnp.where(dist < max_exact, dist, large)


def rel_bias_heads(rel_bias, dist):
    b = rel_bias[t5_bucket(dist)].astype(jnp.float32)
    return b.reshape(dist.shape + (KV_HEADS, HEADS_PER_GROUP)).transpose(2, 3, 0, 1)


def masked_softmax(s, mask):
    p = jax.nn.softmax(jnp.where(mask, s, NEG_INF), axis=-1)
    return jnp.where(mask, p, 0.0)


def compress_rows(rows, pe, w1, w2):
    bsz, t = rows.shape[:2]
    n_sub = CMP_LEN // CMP_STRIDE
    nc = (t - CMP_LEN) // CMP_STRIDE + 1
    ns = nc + n_sub - 1
    sub = rows[:, :ns * CMP_STRIDE].reshape(bsz, ns, CMP_STRIDE, KV_HEADS, HEAD_DIM)
    sub = sub.transpose(0, 1, 3, 2, 4).reshape(bsz, ns, KV_HEADS, CMP_STRIDE * HEAD_DIM)
    w1s = w1.reshape(n_sub, CMP_STRIDE * HEAD_DIM, CMP_HID)
    pre = pe.reshape(-1) @ w1
    for j in range(n_sub):
        pre = pre + sub[:, j:j + nc] @ w1s[j]
    return jax.nn.silu(pre) @ w2


def compress_kv(rows, comp_w):
    pe_k, w1_k, w2_k, pe_v, w1_v, w2_v = comp_w
    kc = compress_rows(rows[:, :, 0], pe_k, w1_k, w2_k)
    vc = compress_rows(rows[:, :, 1], pe_v, w1_v, w2_v)
    cend = jnp.arange(kc.shape[1]) * CMP_STRIDE + CMP_LEN - 1
    return kc, vc, cend


def selection_blocks(rows):
    bsz, t = rows.shape[:2]
    nsel = -(-t // SEL_LEN)
    rows = jnp.pad(rows, ((0, 0), (0, nsel * SEL_LEN - t), (0, 0), (0, 0), (0, 0)))
    blk = rows.reshape(bsz, nsel, SEL_LEN, 2, KV_HEADS, HEAD_DIM).transpose(3, 0, 4, 1, 2, 5)
    return blk[0], blk[1]


def nsa_attend(q, qpos, kc, vc, cend, ks_blk, vs_blk, kw, vw, wpos, gate, rel_bias):
    bsz, nq = q.shape[:2]
    nsel = ks_blk.shape[2]
    scale = HEAD_DIM ** -0.5
    s_c = jnp.einsum('bqghd,bngd->bghqn', q, kc).astype(jnp.float32) * scale
    s_c = s_c + rel_bias_heads(rel_bias, qpos[:, None] - cend[None, :])
    p_c = masked_softmax(s_c, cend[None, :] <= qpos[:, None])
    o_c = jnp.einsum('bghqn,bngd->bqghd', p_c.astype(vc.dtype), vc)
    ci = jnp.arange(kc.shape[1])[:, None] * CMP_STRIDE
    sj = jnp.arange(nsel)[None, :] * SEL_LEN
    overlap = ((ci <= sj + SEL_LEN - 1) & (ci + CMP_LEN - 1 >= sj)).astype(jnp.float32)
    imp = jnp.einsum('bghqn,nj->bgqj', p_c, overlap)
    blk = jnp.arange(nsel)[None, :]
    qblk = (qpos // SEL_LEN)[:, None]
    forced = (blk == 0) | (blk == qblk) | (blk == qblk - 1)
    score = jnp.where(forced, FORCE_SCORE, jnp.where(blk <= qblk, imp, -FORCE_SCORE))
    _, idx = lax.top_k(score, min(N_SEL_BLOCKS, nsel))
    bi = jnp.arange(bsz)[:, None, None, None]
    gi = jnp.arange(KV_HEADS)[None, :, None, None]
    k_sel = ks_blk[bi, gi, idx]
    v_sel = vs_blk[bi, gi, idx]
    tpos = idx[..., None] * SEL_LEN + jnp.arange(SEL_LEN)
    qp = qpos[None, None, :, None, None]
    tbl = rel_bias.reshape(N_BUCKETS, KV_HEADS, HEADS_PER_GROUP)
    b_s = tbl[t5_bucket(qp - tpos), gi[..., None]].astype(jnp.float32)
    s_s = jnp.einsum('bqghd,bgqkld->bghqkl', q, k_sel).astype(jnp.float32) * scale
    s_s = s_s + b_s.transpose(0, 1, 5, 2, 3, 4)
    nk = idx.shape[-1] * SEL_LEN
    p_s = masked_softmax(s_s.reshape(bsz, KV_HEADS, HEADS_PER_GROUP, nq, nk),
                         (tpos <= qp).reshape(bsz, KV_HEADS, 1, nq, nk))
    o_s = jnp.einsum('bghqm,bgqmd->bqghd', p_s.astype(v_sel.dtype),
                     v_sel.reshape(bsz, KV_HEADS, nq, nk, HEAD_DIM))
    dw = qpos[:, None] - wpos[None, :]
    s_w = jnp.einsum('bqghd,bkgd->bghqk', q, kw).astype(jnp.float32) * scale
    s_w = s_w + rel_bias_heads(rel_bias, dw)
    p_w = masked_softmax(s_w, (dw >= 0) & (dw <= WINDOW) & (wpos[None, :] >= 0))
    o_w = jnp.einsum('bghqk,bkgd->bqghd', p_w.astype(vw.dtype), vw)
    g = jax.nn.sigmoid(gate.astype(jnp.float32))
    o = g[..., 0:1] * o_c + g[..., 1:2] * o_s + g[..., 2:3] * o_w
    return o.astype(q.dtype).reshape(bsz, nq, Q_DIM)


def nsa_prompt(q, gate, cmp, slc, win, comp_w, rel_bias):
    bsz, seq = q.shape[:2]
    kc, vc, cend = compress_kv(cmp, comp_w)
    ks_blk, vs_blk = selection_blocks(slc)
    win_pad = jnp.pad(win, ((0, 0), (WINDOW, 0), (0, 0), (0, 0), (0, 0)))
    n_qb = seq // Q_BLOCK
    q_b = q.reshape((bsz, n_qb, Q_BLOCK) + q.shape[2:]).swapaxes(0, 1)
    g_b = gate.reshape((bsz, n_qb, Q_BLOCK) + gate.shape[2:]).swapaxes(0, 1)

    def one_block(args):
        q_blk, g_blk, b = args
        start = b * Q_BLOCK
        qpos = start + jnp.arange(Q_BLOCK)
        kv_w = lax.dynamic_slice_in_dim(win_pad, start, WINDOW + Q_BLOCK, axis=1)
        wpos = start - WINDOW + jnp.arange(WINDOW + Q_BLOCK)
        return nsa_attend(q_blk, qpos, kc, vc, cend, ks_blk, vs_blk,
                          kv_w[:, :, 0], kv_w[:, :, 1], wpos, g_blk, rel_bias)

    o = lax.map(one_block, (q_b, g_b, jnp.arange(n_qb)))
    o = o.swapaxes(0, 1).reshape(bsz, seq, Q_DIM)
    return o, win[:, seq - min(WINDOW, seq):]


def nsa_sample(q, gate, cmp_new, slc_new, win_new, cache_cmp, cache_slc, win_buf, page_table, comp_w, rel_bias):
    bsz, nq = q.shape[:2]
    past_len = page_table.shape[1] * PAGE_SIZE

    def gather_past(cache):
        return cache[page_table].reshape(bsz, past_len, 2, KV_HEADS, HEAD_DIM)

    cmp_all = jnp.concatenate([gather_past(cache_cmp), cmp_new], axis=1)
    slc_all = jnp.concatenate([gather_past(cache_slc), slc_new], axis=1)
    win_all = jnp.concatenate([win_buf, win_new], axis=1)
    w_buf = win_buf.shape[1]
    qpos = past_len + jnp.arange(nq)
    wpos = past_len - w_buf + jnp.arange(w_buf + nq)
    kc, vc, cend = compress_kv(cmp_all, comp_w)
    ks_blk, vs_blk = selection_blocks(slc_all)
    o = nsa_attend(q, qpos, kc, vc, cend, ks_blk, vs_blk,
                   win_all[:, :, 0], win_all[:, :, 1], wpos, gate, rel_bias)
    return o, win_all[:, nq:]


def chunk_spatial_mix(v, w_s, b_s):
    bsz, t = v.shape[:2]
    nch = -(-t // GM_CHUNK)
    vp = jnp.pad(v, ((0, 0), (0, nch * GM_CHUNK - t), (0, 0)))
    vp = vp.reshape(bsz, nch, GM_CHUNK, GM_GROUPS, GM_GROUP_DIM)
    w = w_s * jnp.tril(jnp.ones((GM_CHUNK, GM_CHUNK), w_s.dtype))
    s = jnp.einsum('gts,bcsgd->bctgd', w, vp) + b_s.T[None, None, :, :, None]
    return s.reshape(bsz, nch * GM_CHUNK, GM_DIM)[:, :t]


def trunk_layer(x, ple, attend, ln_mix_pre, w_in, gm_ln_g, gm_ln_b, gm_ws, gm_bs,
                w_branch_nsa, w_branch_gm, w_out, ln_mix_post, ln_ffn_pre, w_ffn_gate,
                w_ffn_up, w_ffn_down, ln_ffn_post, w_ple, w_ple_gate, ln_ple_post):
    bsz, t, _ = x.shape
    h = rms_norm(x, ln_mix_pre)
    z = h @ w_in
    sizes = [Q_DIM, 2 * KV_DIM, 2 * KV_DIM, 2 * KV_DIM, 3 * N_HEADS, 2 * GM_DIM, 2 * D_MODEL]
    q, cmp, slc, win, gate, uv, mg = jnp.split(z, np.cumsum(sizes)[:-1].tolist(), axis=-1)
    q = q.reshape(bsz, t, KV_HEADS, HEADS_PER_GROUP, HEAD_DIM)
    gate = gate.reshape(bsz, t, KV_HEADS, HEADS_PER_GROUP, 3)
    cmp = cmp.reshape(bsz, t, 2, KV_HEADS, HEAD_DIM)
    slc = slc.reshape(bsz, t, 2, KV_HEADS, HEAD_DIM)
    win = win.reshape(bsz, t, 2, KV_HEADS, HEAD_DIM)
    o_nsa, win_state = attend(q, gate, cmp, slc, win)
    u, v = jnp.split(jax.nn.gelu(uv), 2, axis=-1)
    v = layer_norm(v, gm_ln_g, gm_ln_b)
    o_gm = u * chunk_spatial_mix(v, gm_ws, gm_bs)
    g_a, g_b = jnp.split(jax.nn.sigmoid(mg), 2, axis=-1)
    mixed = (g_a * (o_nsa @ w_branch_nsa) + g_b * (o_gm @ w_branch_gm)) @ w_out
    x = x + rms_norm(mixed, ln_mix_post)
    h2 = rms_norm(x, ln_ffn_pre)
    f = (jax.nn.silu(h2 @ w_ffn_gate) * (h2 @ w_ffn_up)) @ w_ffn_down
    x = x + rms_norm(f, ln_ffn_post)
    e = ple @ w_ple
    x = x + rms_norm(jax.nn.sigmoid(x @ w_ple_gate) * e, ln_ple_post)
    return x, cmp, slc, win_state, v


def setup_inputs(seed: int = 0) -> dict:
    key = jax.random.key(seed)
    keys = iter(jax.random.split(key, 48))

    def nrm(shape, scale):
        return jax.random.normal(next(keys), shape, jnp.float32) * scale

    def gain(shape):
        return 1.0 + nrm(shape, 0.05)

    n_pages = PAST_LEN // PAGE_SIZE
    n_pool = (DEC_BATCH * n_pages * 5) // 4
    w_buf = min(WINDOW, PAST_LEN)
    x_prompt = nrm((BATCH, SEQ, D_MODEL), 1.0)
    x_sample = nrm((DEC_BATCH, DEC_SEQ, D_MODEL), 1.0)
    cache_cmp_kv = nrm((DEPTH, n_pool, PAGE_SIZE, 2, KV_HEADS, HEAD_DIM), 1.0)
    cache_slc_kv = nrm((DEPTH, n_pool, PAGE_SIZE, 2, KV_HEADS, HEAD_DIM), 1.0)
    state_win_kv = nrm((DEPTH, DEC_BATCH, w_buf, 2, KV_HEADS, HEAD_DIM), 1.0)
    perm = jax.random.permutation(next(keys), n_pool)
    page_table = perm[:DEC_BATCH * n_pages].reshape(DEC_BATCH, n_pages).astype(jnp.int32)
    p_prompt = nrm((DEPTH, BATCH, SEQ, PLE_DIM), 1.0)
    p_sample = nrm((DEPTH, DEC_BATCH, DEC_SEQ, PLE_DIM), 1.0)
    return {
        'x_prompt': x_prompt,
        'x_sample': x_sample,
        'cache_cmp_kv': cache_cmp_kv,
        'cache_slc_kv': cache_slc_kv,
        'state_win_kv': state_win_kv,
        'page_table': page_table,
        'p_prompt': p_prompt,
        'p_sample': p_sample,
        'rel_bias': nrm((N_BUCKETS, N_HEADS), 0.5),
        'ln_mix_pre': gain((DEPTH, D_MODEL)),
        'w_in': nrm((DEPTH, D_MODEL, IN_DIM), D_MODEL ** -0.5),
        'cmp_pe_k': nrm((DEPTH, CMP_LEN, HEAD_DIM), 0.1),
        'cmp_w1_k': nrm((DEPTH, CMP_LEN * HEAD_DIM, CMP_HID), (CMP_LEN * HEAD_DIM) ** -0.5),
        'cmp_w2_k': nrm((DEPTH, CMP_HID, HEAD_DIM), CMP_HID ** -0.5),
        'cmp_pe_v': nrm((DEPTH, CMP_LEN, HEAD_DIM), 0.1),
        'cmp_w1_v': nrm((DEPTH, CMP_LEN * HEAD_DIM, CMP_HID), (CMP_LEN * HEAD_DIM) ** -0.5),
        'cmp_w2_v': nrm((DEPTH, CMP_HID, HEAD_DIM), CMP_HID ** -0.5),
        'gm_ln_g': gain((DEPTH, GM_DIM)),
        'gm_ln_b': nrm((DEPTH, GM_DIM), 0.02),
        'gm_ws': nrm((DEPTH, GM_GROUPS, GM_CHUNK, GM_CHUNK), GM_CHUNK ** -0.5),
        'gm_bs': gain((DEPTH, GM_GROUPS, GM_CHUNK)),
        'w_branch_nsa': nrm((DEPTH, Q_DIM, D_MODEL), Q_DIM ** -0.5),
        'w_branch_gm': nrm((DEPTH, GM_DIM, D_MODEL), GM_DIM ** -0.5),
        'w_out': nrm((DEPTH, D_MODEL, D_MODEL), D_MODEL ** -0.5),
        'ln_mix_post': gain((DEPTH, D_MODEL)),
        'ln_ffn_pre': gain((DEPTH, D_MODEL)),
        'w_ffn_gate': nrm((DEPTH, D_MODEL, D_FF), D_MODEL ** -0.5),
        'w_ffn_up': nrm((DEPTH, D_MODEL, D_FF), D_MODEL ** -0.5),
        'w_ffn_down': nrm((DEPTH, D_FF, D_MODEL), D_FF ** -0.5),
        'ln_ffn_post': gain((DEPTH, D_MODEL)),
        'w_ple': nrm((DEPTH, PLE_DIM, D_MODEL), PLE_DIM ** -0.5),
        'w_ple_gate': nrm((DEPTH, D_MODEL, D_MODEL), D_MODEL ** -0.5),
        'ln_ple_post': gain((DEPTH, D_MODEL)),
    }


def reference(x_prompt, x_sample, cache_cmp_kv, cache_slc_kv, state_win_kv, page_table,
              p_prompt, p_sample, rel_bias, ln_mix_pre, w_in, cmp_pe_k, cmp_w1_k, cmp_w2_k,
              cmp_pe_v, cmp_w1_v, cmp_w2_v, gm_ln_g, gm_ln_b, gm_ws, gm_bs, w_branch_nsa,
              w_branch_gm, w_out, ln_mix_post, ln_ffn_pre, w_ffn_gate, w_ffn_up, w_ffn_down,
              ln_ffn_post, w_ple, w_ple_gate, ln_ple_post):
    xp = x_prompt
    xs = x_sample
    pc, ps, pw, sc, ss, sw, sv = [], [], [], [], [], [], []
    for i in range(DEPTH):
        comp_w = (cmp_pe_k[i], cmp_w1_k[i], cmp_w2_k[i], cmp_pe_v[i], cmp_w1_v[i], cmp_w2_v[i])
        layer_w = (ln_mix_pre[i], w_in[i], gm_ln_g[i], gm_ln_b[i], gm_ws[i], gm_bs[i],
                   w_branch_nsa[i], w_branch_gm[i], w_out[i], ln_mix_post[i], ln_ffn_pre[i],
                   w_ffn_gate[i], w_ffn_up[i], w_ffn_down[i], ln_ffn_post[i], w_ple[i],
                   w_ple_gate[i], ln_ple_post[i])

        def attend_prompt(q, gate, cmp, slc, win, comp_w=comp_w):
            return nsa_prompt(q, gate, cmp, slc, win, comp_w, rel_bias)

        def attend_sample(q, gate, cmp, slc, win, comp_w=comp_w, i=i):
            return nsa_sample(q, gate, cmp, slc, win, cache_cmp_kv[i], cache_slc_kv[i],
                              state_win_kv[i], page_table, comp_w, rel_bias)

        xp, c_p, s_p, w_p, _ = trunk_layer(xp, p_prompt[i], attend_prompt, *layer_w)
        xs, c_s, s_s, w_s, v_s = trunk_layer(xs, p_sample[i], attend_sample, *layer_w)
        pc.append(c_p)
        ps.append(s_p)
        pw.append(w_p)
        sc.append(c_s)
        ss.append(s_s)
        sw.append(w_s)
        sv.append(v_s)
    return (xp, xs, jnp.stack(pc), jnp.stack(ps), jnp.stack(pw), jnp.stack(sc), jnp.stack(ss), jnp.stack(sw), jnp.stack(sv))
```

```cpp
#include <hip/hip_runtime.h>
#include <stdint.h>
#include <cstdio>

typedef unsigned short bf16_t;
typedef short bf16x8 __attribute__((ext_vector_type(8)));
typedef float f32x4 __attribute__((ext_vector_type(4)));
typedef float f32x2 __attribute__((ext_vector_type(2)));
typedef unsigned u32x4 __attribute__((ext_vector_type(4)));
typedef unsigned u32x2 __attribute__((ext_vector_type(2)));
#define LAS __attribute__((address_space(3)))

constexpr int DM = 1024, NB = 4, SEQ = 8192, MP = NB * SEQ, NS = 32, MALL = MP + 256, PAST = 16384, PAGE = 128, NPG = 128;
constexpr int NH = 8, NG = 2, HPG = 4, DH = 64, QD = 512, WIN = 512, GMD = 512, DFF = 2816, PLE = 256, IND = 4376, INP = 4608;
constexpr int NCP = 511, NCS = 1023;
constexpr float EPS = 1e-6f;
constexpr long O_YP = 0, O_YS = 33554432, O_CMPP = 33587200, O_SLCP = 41975808, O_WINP = 50364416, O_CMPS = 50888704,
               O_SLCS = 50896896, O_WINS = 50905088, O_GMV = 55099392;

struct Params {
    const float *x_prompt, *x_sample, *cache_cmp, *cache_slc, *state_win; const int* page_table;
    const float *p_prompt, *p_sample, *rel_bias, *ln_mix_pre, *w_in, *pe_k, *w1_k, *w2_k, *pe_v, *w1_v, *w2_v;
    const float *gm_ln_g, *gm_ln_b, *gm_ws, *gm_bs, *w_br_nsa, *w_br_gm, *w_out, *ln_mix_post, *ln_ffn_pre;
    const float *w_gate, *w_up, *w_down, *ln_ffn_post, *w_ple, *w_ple_gate, *ln_ple_post;
    float* out;
    unsigned* bar;
    bf16_t *WinT, *WnT, *WgT, *WoT, *WguT, *WdT, *WpgT, *WpT;
    bf16_t *H, *Qb, *CMPb, *SLCb, *WINb, *U, *Vg, *GA, *GB;
    float* GATE;
    float *PARTP, *PARTS, *PEB, *KCP, *VCP, *KCS, *VCS;
    bf16_t* OCAT; float* T; bf16_t* Y1; float* F; float* X1; bf16_t* H2; bf16_t* ACT; float* X2; bf16_t* X2b; bf16_t* Pb;
};

__device__ __forceinline__ unsigned cvt_pk_bf16(float lo, float hi) { unsigned r; asm volatile("v_cvt_pk_bf16_f32 %0, %1, %2" : "=v"(r) : "v"(lo), "v"(hi)); return r; }
__device__ __forceinline__ bf16_t f2bf(float f) { return (bf16_t)(cvt_pk_bf16(f, 0.f) & 0xffffu); }
__device__ __forceinline__ float bf2f(bf16_t h) { return __uint_as_float(((unsigned)h) << 16); }
__device__ __forceinline__ float bflo(unsigned w) { return __uint_as_float(w << 16); }
__device__ __forceinline__ float bfhi(unsigned w) { return __uint_as_float(w & 0xffff0000u); }
__device__ __forceinline__ float sigmoidf_(float x) { return 1.0f / (1.0f + __expf(-x)); }
__device__ __forceinline__ float siluf_(float x) { return x * sigmoidf_(x); }
__device__ __forceinline__ float geluf_(float x) {
    const float u = 0.7978845608028654f * (x + 0.044715f * x * x * x);
    const float e = __expf(2.0f * u);
    const float th = 1.0f - 2.0f / (e + 1.0f);
    return 0.5f * x * (1.0f + th);
}
__device__ __forceinline__ float wave_sum(float v) {
#pragma unroll
    for (int o = 32; o > 0; o >>= 1) v += __shfl_xor(v, o);
    return v;
}
__device__ __forceinline__ float wave_max(float v) {
#pragma unroll
    for (int o = 32; o > 0; o >>= 1) v = fmaxf(v, __shfl_xor(v, o));
    return v;
}
__device__ __forceinline__ int t5_bucket(int d) {
    if (d < 16) return d;
    if (d >= 128) return 31;
    const int b = 16 + (int)(__logf((float)d * (1.0f / 16.0f)) * (16.0f / 2.0794415416798357f));
    return b < 31 ? b : 31;
}

extern __shared__ __attribute__((aligned(16))) unsigned char smem[];

constexpr int BM = 256, BK = 64, HALF = 128, HT = HALF * BK, GEMM_LDS = 8 * HT * 2;
__device__ __forceinline__ int lds_byte(int r, int c) { const int st = (r >> 4) * 2 + (c >> 5), rr = r & 15, cc = c & 31, ob = rr * 64 + cc * 2; return st * 1024 + (ob ^ (((ob >> 9) & 1) << 5)); }
__device__ __forceinline__ void stage_rc(int b, int& R, int& C) { const int st = b / 1024, sb = b % 1024, swz = sb ^ (((sb >> 9) & 1) << 5); R = (st >> 1) * 16 + swz / 64; C = (st & 1) * 32 + (swz % 64) / 2; }

constexpr int HTB = HALF * BK * 2;
template <class F>
__device__ __forceinline__ void for_each_frag(const f32x4 (&acc)[2][2][4][2], int brow, int bcol, int wr, int wc, int fr, int fq, F&& f) {
#pragma unroll
    for (int ai = 0; ai < 2; ++ai)
#pragma unroll
        for (int m = 0; m < 4; ++m)
#pragma unroll
            for (int bj = 0; bj < 2; ++bj)
#pragma unroll
                for (int n = 0; n < 2; ++n)
                    f(brow + ai * HALF + wr * 64 + m * 16 + fr, bcol + bj * HALF + wc * 32 + n * 16 + fq * 4, acc[ai][bj][m][n]);
}

template <class Epi>
__device__ __forceinline__ void gemm_phase(const bf16_t* A, int lda, const bf16_t* Bt, int K, int nM, int nN, const Epi& E) {
    LAS unsigned char* lds = (LAS unsigned char*)smem;
    const int tid = threadIdx.x, wid = __builtin_amdgcn_readfirstlane(tid >> 6), lane = tid & 63, wr = wid >> 2, wc = wid & 3, fr = lane & 15, fq = lane >> 4;
    const int nt = K / BK, nu = nM * nN, G = gridDim.x;
    int u = blockIdx.x;
    if (u >= nu) return;
    unsigned voffA[2], voffB[2];
#pragma unroll
    for (int i = 0; i < 2; ++i) { int R, C; stage_rc(tid * 16 + i * 8192, R, C); voffA[i] = (unsigned)(R * lda + C) * 2u; voffB[i] = (unsigned)(R * K + C) * 2u; }
    const size_t kstep = (size_t)(BK * 2);
    const size_t hstepA = (size_t)HALF * lda * 2, hstepB = (size_t)HALF * K * 2, tstepA = 2 * hstepA, tstepB = 2 * hstepB;
    const unsigned ldsw = (unsigned)wid * 1024u;
    const int aoff = lds_byte(wr * 64 + fr, fq * 8), boff = lds_byte(wc * 32 + fr, fq * 8);
#define PG8_SA(b, h) (((b) * 2 + (h)) * HTB)
#define PG8_SB(b, h) ((4 + (b) * 2 + (h)) * HTB)
#define PG8_STAGE(bufoff, gbase, voff) do { _Pragma("unroll") for (int _i = 0; _i < 2; ++_i) \
        __builtin_amdgcn_global_load_lds((const unsigned*)((const char*)(gbase) + (voff)[_i]), (LAS unsigned*)(lds + (bufoff) + ldsw + _i * 8192), 16, 0, 0); } while (0)
#define PG8_LDA(dst, b, h) do { _Pragma("unroll") for (int m = 0; m < 4; ++m) _Pragma("unroll") for (int k = 0; k < 2; ++k) dst[m][k] = *(const LAS bf16x8*)(lds + PG8_SA(b, h) + aoff + m * 2048 + k * 1024); } while (0)
#define PG8_LDB(dst, b, h) do { _Pragma("unroll") for (int n = 0; n < 2; ++n) _Pragma("unroll") for (int k = 0; k < 2; ++k) dst[n][k] = *(const LAS bf16x8*)(lds + PG8_SB(b, h) + boff + n * 2048 + k * 1024); } while (0)
#define PG8_MMA(ai, bj, At, Bt_) do { __builtin_amdgcn_s_setprio(1); _Pragma("unroll") for (int m = 0; m < 4; ++m) _Pragma("unroll") for (int n = 0; n < 2; ++n) _Pragma("unroll") for (int k = 0; k < 2; ++k) \
        acc[ai][bj][m][n] = __builtin_amdgcn_mfma_f32_16x16x32_bf16(Bt_[n][k], At[m][k], acc[ai][bj][m][n], 0, 0, 0); __builtin_amdgcn_s_setprio(0); } while (0)
#define PG8_WAIT_V(n) asm volatile("s_waitcnt vmcnt(" #n ")" ::: "memory")
#define PG8_WAIT_L(n) asm volatile("s_waitcnt lgkmcnt(" #n ")" ::: "memory")
#define PG8_BAR __builtin_amdgcn_s_barrier()
#define PG8_SCHED __builtin_amdgcn_sched_barrier(0)
    f32x4 acc[2][2][4][2];
#pragma unroll
    for (int a = 0; a < 2; ++a)
#pragma unroll
        for (int b = 0; b < 2; ++b)
#pragma unroll
            for (int m = 0; m < 4; ++m)
#pragma unroll
                for (int n = 0; n < 2; ++n) acc[a][b][m][n] = (f32x4){0.f, 0.f, 0.f, 0.f};
    bf16x8 At[4][2], B0[2][2], B1[2][2];
    int pm = u / nN, pn = u - pm * nN;
    const char* cA = (const char*)A + (size_t)pm * tstepA; const char* cB = (const char*)Bt + (size_t)pn * tstepB;
    PG8_STAGE(PG8_SB(0, 0), cB, voffB); PG8_STAGE(PG8_SA(0, 0), cA, voffA); PG8_STAGE(PG8_SB(0, 1), cB + hstepB, voffB); PG8_STAGE(PG8_SA(0, 1), cA + hstepA, voffA);
    if (wr == 1) PG8_BAR;
    PG8_WAIT_V(4); PG8_BAR;
    PG8_STAGE(PG8_SB(1, 0), cB + kstep, voffB); PG8_STAGE(PG8_SA(1, 0), cA + kstep, voffA); PG8_STAGE(PG8_SB(1, 1), cB + hstepB + kstep, voffB);
    PG8_WAIT_V(6); PG8_BAR;
    for (;;) {
        const int un = u + G; const bool has_next = un < nu;
        const int npm = has_next ? un / nN : pm, npn = has_next ? un - npm * nN : pn;
        const char* nA = (const char*)A + (size_t)npm * tstepA; const char* nB = (const char*)Bt + (size_t)npn * tstepB;
        for (int t = 0; t < nt; t += 2) {
            const bool last = (t == nt - 2);
            const char* a1 = cA + (size_t)(t + 1) * kstep;
            const char* a2 = last ? nA : cA + (size_t)(t + 2) * kstep; const char* b2 = last ? nB : cB + (size_t)(t + 2) * kstep;
            const char* a3 = a2 + kstep; const char* b3 = b2 + kstep;
            PG8_LDB(B0, 0, 0); PG8_SCHED; PG8_LDA(At, 0, 0); PG8_STAGE(PG8_SA(1, 1), a1 + hstepA, voffA);
            PG8_WAIT_L(8); PG8_BAR; PG8_WAIT_L(0); PG8_MMA(0, 0, At, B0); PG8_BAR; PG8_SCHED;
            PG8_LDB(B1, 0, 1); PG8_STAGE(PG8_SB(0, 0), b2, voffB);
            PG8_BAR; PG8_WAIT_L(0); PG8_MMA(0, 1, At, B1); PG8_BAR;
            PG8_LDA(At, 0, 1); PG8_STAGE(PG8_SA(0, 0), a2, voffA);
            PG8_BAR; PG8_WAIT_L(0); PG8_MMA(1, 0, At, B0); PG8_BAR; PG8_SCHED;
            PG8_STAGE(PG8_SB(0, 1), b2 + hstepB, voffB);
            PG8_WAIT_V(6); PG8_BAR; PG8_MMA(1, 1, At, B1); PG8_BAR;
            PG8_LDB(B0, 1, 0); PG8_SCHED; PG8_LDA(At, 1, 0); PG8_STAGE(PG8_SA(0, 1), a2 + hstepA, voffA);
            PG8_WAIT_L(8); PG8_BAR; PG8_WAIT_L(0); PG8_MMA(0, 0, At, B0); PG8_BAR; PG8_SCHED;
            PG8_LDB(B1, 1, 1); PG8_STAGE(PG8_SB(1, 0), b3, voffB);
            PG8_BAR; PG8_WAIT_L(0); PG8_MMA(0, 1, At, B1); PG8_BAR;
            PG8_LDA(At, 1, 1); PG8_STAGE(PG8_SA(1, 0), a3, voffA);
            PG8_BAR; PG8_WAIT_L(0); PG8_MMA(1, 0, At, B0); PG8_BAR; PG8_SCHED;
            PG8_STAGE(PG8_SB(1, 1), b3 + hstepB, voffB);
            PG8_WAIT_V(6); PG8_BAR; PG8_MMA(1, 1, At, B1); PG8_BAR;
        }
        E(acc, pm * BM, pn * BM, wr, wc, fr, fq);
        if (!has_next) break;
#pragma unroll
        for (int a = 0; a < 2; ++a)
#pragma unroll
            for (int b = 0; b < 2; ++b)
#pragma unroll
                for (int m = 0; m < 4; ++m)
#pragma unroll
                    for (int n = 0; n < 2; ++n) acc[a][b][m][n] = (f32x4){0.f, 0.f, 0.f, 0.f};
        u = un; pm = npm; pn = npn; cA = nA; cB = nB;
    }
    PG8_WAIT_V(0);
    if (wr == 0) PG8_BAR;
    PG8_BAR;
#undef PG8_SA
#undef PG8_SB
#undef PG8_STAGE
#undef PG8_LDA
#undef PG8_LDB
#undef PG8_MMA
#undef PG8_WAIT_V
#undef PG8_WAIT_L
#undef PG8_BAR
#undef PG8_SCHED
}

__device__ __forceinline__ void st_bf16x4(bf16_t* p, f32x4 v) { u32x2 w; w.x = cvt_pk_bf16(v[0], v[1]); w.y = cvt_pk_bf16(v[2], v[3]); *(u32x2*)p = w; }

struct EpiIn {
    const Params& p;
    __device__ __forceinline__ void operator()(const f32x4 (&acc)[2][2][4][2], int brow, int bcol, int wr, int wc, int fr, int fq) const {
        const int pn = bcol >> 8;
        const Params& P = p;
        if (pn < 2) {
            for_each_frag(acc, brow, bcol, wr, wc, fr, fq, [&](int row, int col, f32x4 v) { st_bf16x4(P.Qb + (size_t)row * QD + col, v * 0.125f); });
        } else if (pn < 5) {
            bf16_t* cp = pn == 2 ? P.CMPb : pn == 3 ? P.SLCb : P.WINb;
            for_each_frag(acc, brow, bcol, wr, wc, fr, fq, [&](int row, int col, f32x4 v) {
                const int c = col & 255;
                st_bf16x4(cp + (size_t)row * 256 + c, v);
                if (pn < 4) {
                    if (row < MP) *(f32x4*)(P.out + (pn == 2 ? O_CMPP : O_SLCP) + (size_t)row * 256 + c) = v;
                    else if (row < MP + NS) *(f32x4*)(P.out + (pn == 2 ? O_CMPS : O_SLCS) + (size_t)(row - MP) * 256 + c) = v;
                } else {
                    if (row < MP) { const int t = row & (SEQ - 1), b = row >> 13; if (t >= SEQ - WIN) *(f32x4*)(P.out + O_WINP + ((size_t)b * WIN + (t - (SEQ - WIN))) * 256 + c) = v; }
                    else if (row < MP + NS) *(f32x4*)(P.out + O_WINS + ((size_t)(row - MP) * WIN + (WIN - 1)) * 256 + c) = v;
                }
            });
        } else if (pn < 9) {
            bf16_t* dst = pn < 7 ? P.U : P.Vg; const int c0 = pn < 7 ? 1280 : 1792;
            for_each_frag(acc, brow, bcol, wr, wc, fr, fq, [&](int row, int col, f32x4 v) {
                f32x4 g; g[0] = geluf_(v[0]); g[1] = geluf_(v[1]); g[2] = geluf_(v[2]); g[3] = geluf_(v[3]);
                st_bf16x4(dst + (size_t)row * GMD + (col - c0), g); });
        } else if (pn < 17) {
            bf16_t* dst = pn < 13 ? P.GA : P.GB; const int c0 = pn < 13 ? 2304 : 3328;
            for_each_frag(acc, brow, bcol, wr, wc, fr, fq, [&](int row, int col, f32x4 v) {
                f32x4 g; g[0] = sigmoidf_(v[0]); g[1] = sigmoidf_(v[1]); g[2] = sigmoidf_(v[2]); g[3] = sigmoidf_(v[3]);
                st_bf16x4(dst + (size_t)row * DM + (col - c0), g); });
        } else {
            for_each_frag(acc, brow, bcol, wr, wc, fr, fq, [&](int row, int col, f32x4 v) {
                const int c = col & 255;
                if (c < 24) { f32x4 g; g[0] = sigmoidf_(v[0]); g[1] = sigmoidf_(v[1]); g[2] = sigmoidf_(v[2]); g[3] = sigmoidf_(v[3]); *(f32x4*)(P.GATE + (size_t)row * 32 + c) = g; } });
        }
    }
};
struct EpiBrA {
    const bf16_t* GA; float* T;
    __device__ __forceinline__ void operator()(const f32x4 (&acc)[2][2][4][2], int brow, int bcol, int wr, int wc, int fr, int fq) const {
        for_each_frag(acc, brow, bcol, wr, wc, fr, fq, [&](int row, int col, f32x4 v) {
            const u32x2 g = *(const u32x2*)(GA + (size_t)row * DM + col);
            f32x4 o; o[0] = v[0] * bflo(g.x); o[1] = v[1] * bfhi(g.x); o[2] = v[2] * bflo(g.y); o[3] = v[3] * bfhi(g.y);
            *(f32x4*)(T + (size_t)row * DM + col) = o; });
    }
};
struct EpiBrB {
    const bf16_t* GB; const float* T; bf16_t* Y1;
    __device__ __forceinline__ void operator()(const f32x4 (&acc)[2][2][4][2], int brow, int bcol, int wr, int wc, int fr, int fq) const {
        for_each_frag(acc, brow, bcol, wr, wc, fr, fq, [&](int row, int col, f32x4 v) {
            const u32x2 g = *(const u32x2*)(GB + (size_t)row * DM + col);
            const f32x4 t = *(const f32x4*)(T + (size_t)row * DM + col);
            f32x4 o; o[0] = t[0] + v[0] * bflo(g.x); o[1] = t[1] + v[1] * bfhi(g.x); o[2] = t[2] + v[2] * bflo(g.y); o[3] = t[3] + v[3] * bfhi(g.y);
            st_bf16x4(Y1 + (size_t)row * DM + col, o); });
    }
};
struct EpiF32 {
    float* F; int ld;
    __device__ __forceinline__ void operator()(const f32x4 (&acc)[2][2][4][2], int brow, int bcol, int wr, int wc, int fr, int fq) const {
        for_each_frag(acc, brow, bcol, wr, wc, fr, fq, [&](int row, int col, f32x4 v) { *(f32x4*)(F + (size_t)row * ld + col) = v; });
    }
};
struct EpiSwiGLU {
    bf16_t* ACT;
    __device__ __forceinline__ void operator()(const f32x4 (&acc)[2][2][4][2], int brow, int bcol, int wr, int wc, int fr, int fq) const {
        for_each_frag(acc, brow, bcol, wr, wc, fr, fq, [&](int row, int col, f32x4 v) {
            *(unsigned*)(ACT + (size_t)row * DFF + (col >> 1)) = cvt_pk_bf16(siluf_(v[0]) * v[1], siluf_(v[2]) * v[3]); });
    }
};
struct EpiPleGate {
    const float* E; float* F;
    __device__ __forceinline__ void operator()(const f32x4 (&acc)[2][2][4][2], int brow, int bcol, int wr, int wc, int fr, int fq) const {
        for_each_frag(acc, brow, bcol, wr, wc, fr, fq, [&](int row, int col, f32x4 v) {
            const f32x4 e = *(const f32x4*)(E + (size_t)row * DM + col);
            f32x4 o; o[0] = sigmoidf_(v[0]) * e[0]; o[1] = sigmoidf_(v[1]) * e[1]; o[2] = sigmoidf_(v[2]) * e[2]; o[3] = sigmoidf_(v[3]) * e[3];
            *(f32x4*)(F + (size_t)row * DM + col) = o; });
    }
};

template <class Map>
__device__ __forceinline__ void transpose_tile(const float* W, int K, int N, bf16_t* Wt, int ldk, int kt, int ntile, Map map) {
    LAS float* tile = (LAS float*)smem;
    const int t = threadIdx.x;
    __syncthreads();
#pragma unroll
    for (int i = 0; i < 2; ++i) {
        const int k = (t >> 4) + 32 * i, n = (t & 15) * 4, gn = ntile * 64 + n;
        f32x4 v = (f32x4){0.f, 0.f, 0.f, 0.f};
        if (gn < N) v = *(const f32x4*)(W + (size_t)(kt * 64 + k) * N + gn);
        tile[k * 65 + n] = v[0]; tile[k * 65 + n + 1] = v[1]; tile[k * 65 + n + 2] = v[2]; tile[k * 65 + n + 3] = v[3];
    }
    __syncthreads();
    const int n = t >> 3, kc = (t & 7) * 8, gn = ntile * 64 + n;
    if (gn < N) {
        u32x4 w;
        w.x = cvt_pk_bf16(tile[(kc + 0) * 65 + n], tile[(kc + 1) * 65 + n]); w.y = cvt_pk_bf16(tile[(kc + 2) * 65 + n], tile[(kc + 3) * 65 + n]);
        w.z = cvt_pk_bf16(tile[(kc + 4) * 65 + n], tile[(kc + 5) * 65 + n]); w.w = cvt_pk_bf16(tile[(kc + 6) * 65 + n], tile[(kc + 7) * 65 + n]);
        *(u32x4*)(Wt + (size_t)map(gn) * ldk + kt * 64 + kc) = w;
    }
}
template <class Map>
__device__ __forceinline__ void transpose_all(const float* W, int K, int N, bf16_t* Wt, int ldk, Map map, int& base) {
    const int nkt = K / 64, nnt = (N + 63) / 64, ntl = nkt * nnt;
    for (int it = blockIdx.x; it < base + ntl; it += gridDim.x) {
        if (it < base) continue;
        const int l = it - base;
        transpose_tile(W, K, N, Wt, ldk, l / nnt, l % nnt, map);
    }
    base += ntl;
}
__device__ __forceinline__ int map_win(int n) {
    if (n < 1280) return n;
    if (n < 1304) return 4352 + (n - 1280);
    if (n < 2328) return 1280 + (n - 1304);
    return 2304 + (n - 2328);
}

__device__ __forceinline__ float row_rstd(const f32x4 (&v)[4]) {
    float s = 0.f;
#pragma unroll
    for (int k = 0; k < 4; ++k) s += v[k][0] * v[k][0] + v[k][1] * v[k][1] + v[k][2] * v[k][2] + v[k][3] * v[k][3];
    s = wave_sum(s);
    return rsqrtf(s * (1.0f / DM) + EPS);
}
__device__ __forceinline__ const float* xrow_ptr(const Params& p, int row) {
    return row < MP ? p.x_prompt + (size_t)row * DM : p.x_sample + (size_t)(row - MP) * DM;
}

__device__ void phase_prologue(const Params& p) {
    const int wid = threadIdx.x >> 6, lane = threadIdx.x & 63;
    const int gw = blockIdx.x * 8 + wid, nw = gridDim.x * 8;
    int base = 0;
    transpose_all(p.w_in, DM, IND, p.WinT, DM, [](int n) { return map_win(n); }, base);
    transpose_all(p.w_br_nsa, QD, DM, p.WnT, QD, [](int n) { return n; }, base);
    transpose_all(p.w_br_gm, GMD, DM, p.WgT, GMD, [](int n) { return n; }, base);
    transpose_all(p.w_out, DM, DM, p.WoT, DM, [](int n) { return n; }, base);
    transpose_all(p.w_gate, DM, DFF, p.WguT, DM, [](int n) { return 2 * n; }, base);
    transpose_all(p.w_up, DM, DFF, p.WguT, DM, [](int n) { return 2 * n + 1; }, base);
    transpose_all(p.w_down, DFF, DM, p.WdT, DFF, [](int n) { return n; }, base);
    transpose_all(p.w_ple_gate, DM, DM, p.WpgT, DM, [](int n) { return n; }, base);
    transpose_all(p.w_ple, PLE, DM, p.WpT, PLE, [](int n) { return n; }, base);
    __syncthreads();
    for (int i = blockIdx.x * 512 + threadIdx.x; i < (INP - IND) * DM / 8; i += gridDim.x * 512) ((u32x4*)(p.WinT + (size_t)IND * DM))[i] = (u32x4){0u, 0u, 0u, 0u};
    for (int row = gw; row < MALL; row += nw) {
        u32x2* hd = (u32x2*)(p.H + (size_t)row * DM);
        if (row < MP + NS) {
            const float* xr = xrow_ptr(p, row);
            f32x4 v[4];
#pragma unroll
            for (int k = 0; k < 4; ++k) v[k] = *(const f32x4*)(xr + lane * 4 + k * 256);
            const float r = row_rstd(v);
#pragma unroll
            for (int k = 0; k < 4; ++k) { const f32x4 g = *(const f32x4*)(p.ln_mix_pre + lane * 4 + k * 256); const f32x4 o = v[k] * r * g; u32x2 w; w.x = cvt_pk_bf16(o[0], o[1]); w.y = cvt_pk_bf16(o[2], o[3]); hd[lane + k * 64] = w; }
            const float* pr = row < MP ? p.p_prompt + (size_t)row * PLE : p.p_sample + (size_t)(row - MP) * PLE;
            const f32x4 pv = *(const f32x4*)(pr + lane * 4);
            u32x2 w; w.x = cvt_pk_bf16(pv[0], pv[1]); w.y = cvt_pk_bf16(pv[2], pv[3]);
            ((u32x2*)(p.Pb + (size_t)row * PLE))[lane] = w;
        } else {
#pragma unroll
            for (int k = 0; k < 4; ++k) hd[lane + k * 64] = (u32x2){0u, 0u};
            ((u32x2*)(p.Pb + (size_t)row * PLE))[lane] = (u32x2){0u, 0u};
        }
    }
    if (gw < 4) {
        const int kv = gw >> 1, h = (gw & 1) * 64 + lane;
        const float* pe = kv ? p.pe_v : p.pe_k; const float* w1 = kv ? p.w1_v : p.w1_k;
        float s = 0.f;
        for (int k = 0; k < 2048; ++k) s += pe[k] * w1[(size_t)k * 128 + h];
        p.PEB[kv * 128 + h] = s;
    }
    for (int i = blockIdx.x * 512 + threadIdx.x; i < NS * (WIN - 1) * 64; i += gridDim.x * 512) {
        const int b = i / ((WIN - 1) * 64), r = i % ((WIN - 1) * 64);
        ((f32x4*)(p.out + O_WINS + (size_t)b * WIN * 256))[r] = ((const f32x4*)(p.state_win + (size_t)b * WIN * 256 + 256))[r];
    }
}

__device__ void phase_cmp_parts(const Params& p) {
    const int wid = threadIdx.x >> 6, lane = threadIdx.x & 63;
    const int nitem_p = NB * 64 * 4, nitem_s = NS * 128 * 4;
    for (int it = blockIdx.x * 8 + wid; it < nitem_p + nitem_s; it += gridDim.x * 8) {
        const bool smp = it >= nitem_p; const int l = smp ? it - nitem_p : it;
        const int gk = l & 3, g = gk >> 1, kv = gk & 1, s8 = l >> 2;
        const int nsub8 = smp ? 128 : 64, seq = s8 / nsub8, s0 = (s8 % nsub8) * 8;
        const float* w1 = kv ? p.w1_v : p.w1_k;
        const float* src;
        if (smp) src = p.cache_cmp + ((size_t)p.page_table[seq * NPG + (s0 >> 3)] * PAGE) * 256 + kv * 128 + g * 64;
        else src = p.out + O_CMPP + ((size_t)seq * SEQ + s0 * 16) * 256 + kv * 128 + g * 64;
        float acc[8][4];
#pragma unroll
        for (int i = 0; i < 8; ++i) { acc[i][0] = acc[i][1] = acc[i][2] = acc[i][3] = 0.f; }
        for (int k = 0; k < 1024; ++k) {
            const int pos = k >> 6, d = k & 63;
            const f32x2 wa = *(const f32x2*)(w1 + (size_t)k * 128 + lane * 2);
            const f32x2 wb = *(const f32x2*)(w1 + (size_t)(1024 + k) * 128 + lane * 2);
#pragma unroll
            for (int i = 0; i < 8; ++i) {
                const float x = src[(size_t)(i * 16 + pos) * 256 + d];
                acc[i][0] += x * wa.x; acc[i][1] += x * wa.y; acc[i][2] += x * wb.x; acc[i][3] += x * wb.y;
            }
        }
        float* dst = (smp ? p.PARTS : p.PARTP);
        const int nsub = smp ? 1024 : 512;
#pragma unroll
        for (int i = 0; i < 8; ++i) {
            float* d0 = dst + (((size_t)seq * nsub + s0 + i) * 4 + gk) * 256;
            *(f32x2*)(d0 + lane * 2) = (f32x2){acc[i][0], acc[i][1]};
            *(f32x2*)(d0 + 128 + lane * 2) = (f32x2){acc[i][2], acc[i][3]};
        }
    }
}
__device__ void phase_cmp_final(const Params& p) {
    const int wid = threadIdx.x >> 6, lane = threadIdx.x & 63;
    LAS float* hb = (LAS float*)smem + wid * 128;
    const int nitem_p = NB * NCP * 4, nitem_s = NS * NCS * 4;
    for (int it = blockIdx.x * 8 + wid; it < nitem_p + nitem_s; it += gridDim.x * 8) {
        const bool smp = it >= nitem_p; const int l = smp ? it - nitem_p : it;
        const int gk = l & 3, g = gk >> 1, kv = gk & 1, r = l >> 2;
        const int nc = smp ? NCS : NCP, nsub = smp ? 1024 : 512, seq = r / nc, n = r % nc;
        const float* part = smp ? p.PARTS : p.PARTP;
        const float* p0 = part + (((size_t)seq * nsub + n) * 4 + gk) * 256;
        const float* p1 = part + (((size_t)seq * nsub + n + 1) * 4 + gk) * 256 + 128;
        const float* w2 = kv ? p.w2_v : p.w2_k;
#pragma unroll
        for (int i = 0; i < 2; ++i) { const int h = lane + 64 * i; hb[h] = siluf_(p0[h] + p1[h] + p.PEB[kv * 128 + h]); }
        __builtin_amdgcn_wave_barrier();
        float s = 0.f;
        for (int h = 0; h < 128; ++h) s += hb[h] * w2[h * 64 + lane];
        __builtin_amdgcn_wave_barrier();
        float* dst = smp ? (kv ? p.VCS : p.KCS) + (((size_t)seq * NG + g) * 1024 + n) * 64 : (kv ? p.VCP : p.KCP) + (((size_t)seq * NG + g) * 512 + n) * 64;
        dst[lane] = s;
    }
}

template <bool SAMPLE>
__device__ __forceinline__ void kv_row_ptr(const Params& p, int branch  , int b, int pos, int kv, int g, const bf16_t*& pb, const float*& pf) {
    const int off = kv * 128 + g * 64;
    if (!SAMPLE) { pf = nullptr; pb = (branch == 1 ? p.SLCb : p.WINb) + ((size_t)b * SEQ + pos) * 256 + off; }
    else if (pos >= PAST) { pf = nullptr; pb = (branch == 1 ? p.SLCb : p.WINb) + ((size_t)MP + b) * 256 + off; }
    else if (branch == 1) { pb = nullptr; pf = p.cache_slc + ((size_t)p.page_table[b * NPG + (pos >> 7)] * PAGE + (pos & 127)) * 256 + off; }
    else { pb = nullptr; pf = p.state_win + ((size_t)b * WIN + (pos - (PAST - WIN))) * 256 + off; }
}
__device__ __forceinline__ void dot4x64(const bf16_t* pb, const float* pf, const LAS float* qs_, float (&s)[4]) {
    s[0] = s[1] = s[2] = s[3] = 0.f;
    const LAS float* qs = qs_; asm volatile("" : "+v"(qs));
    if (pf) {
#pragma unroll 2
        for (int c = 0; c < 16; ++c) {
            const f32x4 kx = *(const f32x4*)(pf + c * 4);
#pragma unroll
            for (int h = 0; h < 4; ++h) { const f32x4 q = *(const LAS f32x4*)(qs + h * 64 + c * 4); s[h] += q[0] * kx[0] + q[1] * kx[1] + q[2] * kx[2] + q[3] * kx[3]; }
        }
    } else {
#pragma unroll 1
        for (int c = 0; c < 8; ++c) {
            const u32x4 w = *(const u32x4*)(pb + c * 8);
            const float k0 = bflo(w.x), k1 = bfhi(w.x), k2 = bflo(w.y), k3 = bfhi(w.y), k4 = bflo(w.z), k5 = bfhi(w.z), k6 = bflo(w.w), k7 = bfhi(w.w);
#pragma unroll
            for (int h = 0; h < 4; ++h) {
                const f32x4 qa = *(const LAS f32x4*)(qs + h * 64 + c * 8), qb = *(const LAS f32x4*)(qs + h * 64 + c * 8 + 4);
                s[h] += qa[0] * k0 + qa[1] * k1 + qa[2] * k2 + qa[3] * k3 + qb[0] * k4 + qb[1] * k5 + qb[2] * k6 + qb[3] * k7;
            }
        }
    }
}
template <bool SAMPLE>
__device__ __forceinline__ void attn_chunk(const Params& p, int branch, int b, int g, int t, int pos0, int lo, int hi,
                                           float (&m)[4], float (&l)[4], float (&o)[4], const LAS float* qs, LAS float* pbk, const LAS float* relb, int lane) {
    const int pos = pos0 + lane;
    const bool valid = pos >= lo && pos <= hi;
    float s[4] = {-1e30f, -1e30f, -1e30f, -1e30f};
    if (valid) {
        const bf16_t* pb; const float* pf; kv_row_ptr<SAMPLE>(p, branch, b, pos, 0, g, pb, pf);
        dot4x64(pb, pf, qs, s);
        const int bk = t5_bucket(t - pos);
#pragma unroll
        for (int h = 0; h < 4; ++h) s[h] += relb[bk * 8 + g * 4 + h];
    }
#pragma unroll
    for (int h = 0; h < 4; ++h) {
        const float mx = wave_max(s[h]);
        const float mn = fmaxf(m[h], mx);
        const float pr = valid ? __expf(s[h] - mn) : 0.f;
        const float sm = wave_sum(pr);
        const float al = __expf(m[h] - mn);
        l[h] = l[h] * al + sm; o[h] *= al; m[h] = mn;
        pbk[h * 64 + lane] = pr;
    }
    __builtin_amdgcn_wave_barrier();
    const int k0 = (lo > pos0 ? lo : pos0) - pos0, k1 = (hi < pos0 + 63 ? hi : pos0 + 63) - pos0;
#pragma unroll 1
    for (int k = k0; k <= k1; ++k) {
        const bf16_t* pb; const float* pf; kv_row_ptr<SAMPLE>(p, branch, b, pos0 + k, 1, g, pb, pf);
        const float v = pf ? pf[lane] : bf2f(pb[lane]);
#pragma unroll
        for (int h = 0; h < 4; ++h) o[h] += pbk[h * 64 + k] * v;
    }
    __builtin_amdgcn_wave_barrier();
}

constexpr int ATT_WAVE_LDS_P = 256 * 4 + 4 * 512 * 4 + (512 + 64) * 4 + 256 * 4 + 64;
constexpr int ATT_WAVE_LDS_S = 256 * 4 + 4 * 1024 * 4 + (1024 + 64) * 4 + 256 * 4 + 64;
constexpr int ATT_LDS = 1024 + (8 * ATT_WAVE_LDS_P > 4 * ATT_WAVE_LDS_S ? 8 * ATT_WAVE_LDS_P : 4 * ATT_WAVE_LDS_S);

template <bool SAMPLE>
__device__ __forceinline__ void attn_item(const Params& p, int row  , int b, int t, int g, const LAS float* relb, LAS unsigned char* wl, int lane) {
    constexpr int NCAP = SAMPLE ? 1024 : 512, NC = SAMPLE ? NCS : NCP, NSEL = SAMPLE ? 257 : 128, NJR = SAMPLE ? 5 : 2;
    LAS float* qs = (LAS float*)wl; LAS float* sl = qs + 256; LAS float* phs = sl + 4 * NCAP; LAS float* pbk = phs + NCAP + 64; LAS int* sel = (LAS int*)(pbk + 256);
    {
        const u32x2 w = *(const u32x2*)(p.Qb + (size_t)row * QD + g * 256 + lane * 4);
        qs[lane * 4 + 0] = bflo(w.x); qs[lane * 4 + 1] = bfhi(w.x); qs[lane * 4 + 2] = bflo(w.y); qs[lane * 4 + 3] = bfhi(w.y);
    }
    __builtin_amdgcn_wave_barrier();
    const int ncv = t >= 31 ? ((t - 31) >> 4) + 1 : 0;
    const int ncvc = ncv < NC ? ncv : NC;
    const float* kc = (SAMPLE ? p.KCS + ((size_t)b * NG + g) * 1024 * 64 : p.KCP + ((size_t)b * NG + g) * 512 * 64);
    const float* vc = (SAMPLE ? p.VCS + ((size_t)b * NG + g) * 1024 * 64 : p.VCP + ((size_t)b * NG + g) * 512 * 64);
    float oc[4] = {0.f, 0.f, 0.f, 0.f};
    {
        const int nrnd = (ncvc + 63) >> 6;
        float mx[4] = {-1e30f, -1e30f, -1e30f, -1e30f};
#pragma unroll 1
        for (int r = 0; r < nrnd; ++r) {
            const int n = r * 64 + lane;
            float s[4] = {-1e30f, -1e30f, -1e30f, -1e30f};
            if (n < ncvc) {
                dot4x64(nullptr, kc + (size_t)n * 64, qs, s);
                const int bk = t5_bucket(t - (16 * n + 31));
#pragma unroll
                for (int h = 0; h < 4; ++h) s[h] += relb[bk * 8 + g * 4 + h];
            }
#pragma unroll
            for (int h = 0; h < 4; ++h) { sl[h * NCAP + n] = s[h]; mx[h] = fmaxf(mx[h], s[h]); }
        }
        float sum[4] = {0.f, 0.f, 0.f, 0.f};
#pragma unroll
        for (int h = 0; h < 4; ++h) mx[h] = wave_max(mx[h]);
#pragma unroll 1
        for (int r = 0; r < nrnd; ++r) {
            const int n = r * 64 + lane;
#pragma unroll
            for (int h = 0; h < 4; ++h) { const float e = (n < ncvc) ? __expf(sl[h * NCAP + n] - mx[h]) : 0.f; sl[h * NCAP + n] = e; sum[h] += e; }
        }
#pragma unroll
        for (int h = 0; h < 4; ++h) { sum[h] = wave_sum(sum[h]); sum[h] = sum[h] > 0.f ? 1.0f / sum[h] : 0.f; }
#pragma unroll 1
        for (int r = 0; r < nrnd; ++r) {
            const int n = r * 64 + lane;
            phs[n] = (sl[n] * sum[0] + sl[NCAP + n] * sum[1]) + (sl[2 * NCAP + n] * sum[2] + sl[3 * NCAP + n] * sum[3]);
        }
#pragma unroll 1
        for (int n = nrnd * 64 + lane; n < NCAP + 64; n += 64) phs[n] = 0.f;
        __builtin_amdgcn_wave_barrier();
#pragma unroll
        for (int h = 0; h < 4; ++h) {
            float a = 0.f;
#pragma unroll 2
            for (int n = 0; n < ncvc; ++n) a += sl[h * NCAP + n] * vc[(size_t)n * 64 + lane];
            oc[h] = a * sum[h];
        }
    }
    const int qblk = t >> 6;
    int nselected;
    if (qblk <= 15) {
        nselected = qblk + 1;
        if (lane < 16) sel[lane] = lane;
    } else {
        unsigned long long key[NJR];
#pragma unroll
        for (int jr = 0; jr < NJR; ++jr) {
            const int j = jr * 64 + lane;
            key[jr] = 0ull;
            if (j >= 1 && j <= qblk - 2 && j < NSEL) {
                float im = 0.f;
#pragma unroll
                for (int n = 4 * j - 1; n <= 4 * j + 3; ++n) im += (n < NC) ? phs[n] : 0.f;
                key[jr] = ((unsigned long long)__float_as_uint(im) << 32) | (unsigned)(0xFFFF - j) | 0x10000ull;
            }
        }
        if (lane == 0) { sel[0] = 0; sel[1] = qblk - 1; sel[2] = qblk; }
#pragma unroll 1
        for (int it = 0; it < 13; ++it) {
            unsigned long long best = 0ull;
#pragma unroll
            for (int jr = 0; jr < NJR; ++jr) best = key[jr] > best ? key[jr] : best;
#pragma unroll
            for (int o = 32; o > 0; o >>= 1) { const unsigned long long ot = __shfl_xor(best, o); best = ot > best ? ot : best; }
            const int j = 0xFFFF - (int)(best & 0xFFFFull);
#pragma unroll
            for (int jr = 0; jr < NJR; ++jr) if (key[jr] == best) key[jr] = 0ull;
            if (lane == 0) sel[3 + it] = j;
        }
        nselected = 16;
    }
    __builtin_amdgcn_wave_barrier();
    float ms[4] = {-1e30f, -1e30f, -1e30f, -1e30f}, ls[4] = {0.f, 0.f, 0.f, 0.f}, os[4] = {0.f, 0.f, 0.f, 0.f};
#pragma unroll 1
    for (int i = 0; i < nselected; ++i) {
        const int j = sel[i];
        attn_chunk<SAMPLE>(p, 1, b, g, t, j * 64, 0, t, ms, ls, os, qs, pbk, relb, lane);
    }
    float mw[4] = {-1e30f, -1e30f, -1e30f, -1e30f}, lw[4] = {0.f, 0.f, 0.f, 0.f}, ow[4] = {0.f, 0.f, 0.f, 0.f};
    {
        const int lo = t - WIN > 0 ? t - WIN : 0;
#pragma unroll 1
        for (int c = 0; c < 9; ++c) {
            const int pos0 = t - 63 - 64 * c;
            if (pos0 + 63 < lo) break;
            attn_chunk<SAMPLE>(p, 2, b, g, t, pos0, lo, t, mw, lw, ow, qs, pbk, relb, lane);
        }
    }
    const float* gt = p.GATE + (size_t)row * 32 + g * 12;
#pragma unroll
    for (int h = 0; h < 4; ++h) {
        const float v = gt[h * 3 + 0] * oc[h] + gt[h * 3 + 1] * os[h] / ls[h] + gt[h * 3 + 2] * ow[h] / lw[h];
        p.OCAT[(size_t)row * DM + (g * 4 + h) * 64 + lane] = f2bf(v);
    }
    __builtin_amdgcn_wave_barrier();
}

__device__ void phase_attn(const Params& p) {
    const int wid = threadIdx.x >> 6, lane = threadIdx.x & 63;
    LAS float* relb = (LAS float*)smem;
    if (threadIdx.x < 256) relb[threadIdx.x] = p.rel_bias[threadIdx.x];
    __syncthreads();
    if (wid < 4) {
        LAS unsigned char* wl = (LAS unsigned char*)smem + 1024 + wid * ATT_WAVE_LDS_S;
#pragma unroll 1
        for (int it = blockIdx.x * 4 + wid; it < NS * NG; it += gridDim.x * 4) { const int b = it >> 1, g = it & 1; attn_item<true>(p, MP + b, b, PAST, g, relb, wl, lane); }
    }
    __syncthreads();
    LAS unsigned char* wl = (LAS unsigned char*)smem + 1024 + wid * ATT_WAVE_LDS_P;
#pragma unroll 1
    for (int it = blockIdx.x * 8 + wid; it < MP * NG; it += gridDim.x * 8) {
        const int g = it & 1, tok = it >> 1; const int b = tok & 3, t = SEQ - 1 - (tok >> 2);
        attn_item<false>(p, b * SEQ + t, b, t, g, relb, wl, lane);
    }
}

constexpr int GM_LDS = 128 * 128 * 4 + 1024;
__device__ void phase_gmlp(const Params& p) {
    const int wid = threadIdx.x >> 6, lane = threadIdx.x & 63, tid = threadIdx.x;
    LAS float* vn = (LAS float*)smem;
    LAS float* mu = (LAS float*)(smem + 128 * 128 * 4);
    for (int u = blockIdx.x; u < NB * 64; u += gridDim.x) {
        const int b = u >> 6, ch = u & 63; const size_t row0 = (size_t)b * SEQ + ch * 128;
        __syncthreads();
        for (int r = wid; r < 128; r += 8) {
            const u32x4 w = *(const u32x4*)(p.Vg + (row0 + r) * GMD + lane * 8);
            const float x[8] = {bflo(w.x), bfhi(w.x), bflo(w.y), bfhi(w.y), bflo(w.z), bfhi(w.z), bflo(w.w), bfhi(w.w)};
            float s = 0.f;
#pragma unroll
            for (int i = 0; i < 8; ++i) s += x[i];
            const float mean = wave_sum(s) * (1.0f / GMD);
            float q = 0.f;
#pragma unroll
            for (int i = 0; i < 8; ++i) q += (x[i] - mean) * (x[i] - mean);
            const float var = wave_sum(q) * (1.0f / GMD);
            if (lane == 0) { mu[r] = mean; mu[128 + r] = rsqrtf(var + EPS); }
        }
        for (int g = 0; g < 4; ++g) {
            __syncthreads();
            for (int i = tid; i < 128 * 128; i += 512) {
                const int s = i >> 7, d = i & 127, c = g * 128 + d;
                vn[i] = (bf2f(p.Vg[(row0 + s) * GMD + c]) - mu[s]) * mu[128 + s] * p.gm_ln_g[c] + p.gm_ln_b[c];
            }
            __syncthreads();
            const int d = tid & 127;
            for (int i = 0; i < 32; ++i) {
                const int t = (tid >> 7) + 4 * i;
                const float* wrow = p.gm_ws + ((size_t)g * 128 + t) * 128;
                float a = 0.f;
                for (int s = 0; s <= t; ++s) a += wrow[s] * vn[s * 128 + d];
                a += p.gm_bs[g * 128 + t];
                const float uu = bf2f(p.U[(row0 + t) * GMD + g * 128 + d]);
                p.OCAT[(row0 + t) * DM + QD + g * 128 + d] = f2bf(uu * a);
            }
        }
    }
    for (int it = blockIdx.x * 8 + wid; it < NS; it += gridDim.x * 8) {
        const size_t row = (size_t)MP + it;
        const u32x4 w = *(const u32x4*)(p.Vg + row * GMD + lane * 8);
        const float x[8] = {bflo(w.x), bfhi(w.x), bflo(w.y), bfhi(w.y), bflo(w.z), bfhi(w.z), bflo(w.w), bfhi(w.w)};
        float s = 0.f;
#pragma unroll
        for (int i = 0; i < 8; ++i) s += x[i];
        const float mean = wave_sum(s) * (1.0f / GMD);
        float q = 0.f;
#pragma unroll
        for (int i = 0; i < 8; ++i) q += (x[i] - mean) * (x[i] - mean);
        const float rs = rsqrtf(wave_sum(q) * (1.0f / GMD) + EPS);
#pragma unroll
        for (int i = 0; i < 8; ++i) {
            const int c = lane * 8 + i, g = c >> 7;
            const float v = (x[i] - mean) * rs * p.gm_ln_g[c] + p.gm_ln_b[c];
            p.out[O_GMV + (size_t)it * GMD + c] = v;
            const float a = p.gm_ws[(size_t)g * 128 * 128] * v + p.gm_bs[g * 128];
            p.OCAT[row * DM + QD + c] = f2bf(bf2f(p.U[row * GMD + c]) * a);
        }
    }
}

template <int MODE>
__device__ void phase_norm(const Params& p) {
    const int wid = threadIdx.x >> 6, lane = threadIdx.x & 63;
    const float* gpost = MODE == 0 ? p.ln_mix_post : MODE == 1 ? p.ln_ffn_post : p.ln_ple_post;
    for (int row = blockIdx.x * 8 + wid; row < MP + NS; row += gridDim.x * 8) {
        const float* fr = p.F + (size_t)row * DM;
        const float* xr = MODE == 0 ? xrow_ptr(p, row) : MODE == 1 ? p.X1 + (size_t)row * DM : p.X2 + (size_t)row * DM;
        f32x4 f[4], x[4];
#pragma unroll
        for (int k = 0; k < 4; ++k) { f[k] = *(const f32x4*)(fr + lane * 4 + k * 256); x[k] = *(const f32x4*)(xr + lane * 4 + k * 256); }
        const float r = row_rstd(f);
#pragma unroll
        for (int k = 0; k < 4; ++k) { const f32x4 g = *(const f32x4*)(gpost + lane * 4 + k * 256); x[k] = x[k] + f[k] * r * g; }
        if (MODE == 0) {
            const float r2 = row_rstd(x);
#pragma unroll
            for (int k = 0; k < 4; ++k) {
                *(f32x4*)(p.X1 + (size_t)row * DM + lane * 4 + k * 256) = x[k];
                const f32x4 g = *(const f32x4*)(p.ln_ffn_pre + lane * 4 + k * 256); const f32x4 o = x[k] * r2 * g;
                st_bf16x4(p.H2 + (size_t)row * DM + lane * 4 + k * 256, o);
            }
        } else if (MODE == 1) {
#pragma unroll
            for (int k = 0; k < 4; ++k) { *(f32x4*)(p.X2 + (size_t)row * DM + lane * 4 + k * 256) = x[k]; st_bf16x4(p.X2b + (size_t)row * DM + lane * 4 + k * 256, x[k]); }
        } else {
            float* yr = row < MP ? p.out + O_YP + (size_t)row * DM : p.out + O_YS + (size_t)(row - MP) * DM;
#pragma unroll
            for (int k = 0; k < 4; ++k) *(f32x4*)(yr + lane * 4 + k * 256) = x[k];
        }
    }
}

constexpr int NPHASE = 16;
constexpr int LDS_BYTES = GEMM_LDS;
static_assert(ATT_LDS <= LDS_BYTES && GM_LDS <= LDS_BYTES, "lds");
constexpr int NMT = MALL / BM;

template <int PH>
__device__ __forceinline__ void run_phase(const Params& p) {
    if (PH == 0) phase_prologue(p);
    if (PH == 1) { EpiIn e{p}; gemm_phase(p.H, DM, p.WinT, DM, NMT, INP / BM, e); }
    if (PH == 2) phase_cmp_parts(p);
    if (PH == 3) phase_cmp_final(p);
    if (PH == 4) phase_attn(p);
    if (PH == 5) phase_gmlp(p);
    if (PH == 6) { EpiBrA e{p.GA, p.T}; gemm_phase(p.OCAT, DM, p.WnT, QD, NMT, DM / BM, e); }
    if (PH == 7) { EpiBrB e{p.GB, p.T, p.Y1}; gemm_phase(p.OCAT + QD, DM, p.WgT, GMD, NMT, DM / BM, e); }
    if (PH == 8) { EpiF32 e{p.F, DM}; gemm_phase(p.Y1, DM, p.WoT, DM, NMT, DM / BM, e); }
    if (PH == 9) phase_norm<0>(p);
    if (PH == 10) { EpiSwiGLU e{p.ACT}; gemm_phase(p.H2, DM, p.WguT, DM, NMT, 2 * DFF / BM, e); }
    if (PH == 11) { EpiF32 e{p.F, DM}; gemm_phase(p.ACT, DFF, p.WdT, DFF, NMT, DM / BM, e); }
    if (PH == 12) phase_norm<1>(p);
    if (PH == 13) { EpiF32 e{p.T, DM}; gemm_phase(p.Pb, PLE, p.WpT, PLE, NMT, DM / BM, e); }
    if (PH == 14) { EpiPleGate e{p.T, p.F}; gemm_phase(p.X2b, DM, p.WpgT, DM, NMT, DM / BM, e); }
    if (PH == 15) phase_norm<2>(p);
}

template <int PH>
__global__ void __launch_bounds__(512, 2) k_phase(Params p) { run_phase<PH>(p); }

static inline size_t al256(size_t x) { return (x + 255) & ~(size_t)255; }
template <int PH> static void launch_phase(const Params& p, int grid, hipStream_t s) {
    static bool attr = false;
    if (!attr) { hipFuncSetAttribute((const void*)k_phase<PH>, hipFuncAttributeMaxDynamicSharedMemorySize, LDS_BYTES); attr = true; }
    k_phase<PH><<<grid, 512, LDS_BYTES, s>>>(p);
}
template <int PH> static void launch_all(const Params& p, int grid, hipStream_t s) {
    launch_phase<PH>(p, grid, s);
    if constexpr (PH + 1 < NPHASE) launch_all<PH + 1>(p, grid, s);
}

extern "C" void kernel_launch(void* const* d_in, const int* in_sizes, int n_in, void* d_out, int out_size, void* d_ws, size_t ws_size, hipStream_t stream) {
    Params p{};
    p.x_prompt = (const float*)d_in[0]; p.x_sample = (const float*)d_in[1]; p.cache_cmp = (const float*)d_in[2]; p.cache_slc = (const float*)d_in[3];
    p.state_win = (const float*)d_in[4]; p.page_table = (const int*)d_in[5]; p.p_prompt = (const float*)d_in[6]; p.p_sample = (const float*)d_in[7];
    p.rel_bias = (const float*)d_in[8]; p.ln_mix_pre = (const float*)d_in[9]; p.w_in = (const float*)d_in[10];
    p.pe_k = (const float*)d_in[11]; p.w1_k = (const float*)d_in[12]; p.w2_k = (const float*)d_in[13];
    p.pe_v = (const float*)d_in[14]; p.w1_v = (const float*)d_in[15]; p.w2_v = (const float*)d_in[16];
    p.gm_ln_g = (const float*)d_in[17]; p.gm_ln_b = (const float*)d_in[18]; p.gm_ws = (const float*)d_in[19]; p.gm_bs = (const float*)d_in[20];
    p.w_br_nsa = (const float*)d_in[21]; p.w_br_gm = (const float*)d_in[22]; p.w_out = (const float*)d_in[23];
    p.ln_mix_post = (const float*)d_in[24]; p.ln_ffn_pre = (const float*)d_in[25]; p.w_gate = (const float*)d_in[26]; p.w_up = (const float*)d_in[27];
    p.w_down = (const float*)d_in[28]; p.ln_ffn_post = (const float*)d_in[29]; p.w_ple = (const float*)d_in[30]; p.w_ple_gate = (const float*)d_in[31];
    p.ln_ple_post = (const float*)d_in[32];
    p.out = (float*)d_out;
    unsigned char* w = (unsigned char*)d_ws; size_t off = 0;
    auto take = [&](size_t bytes) { void* r = w + off; off = al256(off + bytes); return r; };
    p.bar = (unsigned*)take(16384);
    p.WinT = (bf16_t*)take((size_t)INP * DM * 2); p.WnT = (bf16_t*)take((size_t)DM * QD * 2); p.WgT = (bf16_t*)take((size_t)DM * GMD * 2);
    p.WoT = (bf16_t*)take((size_t)DM * DM * 2); p.WguT = (bf16_t*)take((size_t)2 * DFF * DM * 2); p.WdT = (bf16_t*)take((size_t)DM * DFF * 2);
    p.WpgT = (bf16_t*)take((size_t)DM * DM * 2); p.WpT = (bf16_t*)take((size_t)DM * PLE * 2);
    p.H = (bf16_t*)take((size_t)MALL * DM * 2); p.Qb = (bf16_t*)take((size_t)MALL * QD * 2);
    p.CMPb = (bf16_t*)take((size_t)MALL * 256 * 2); p.SLCb = (bf16_t*)take((size_t)MALL * 256 * 2); p.WINb = (bf16_t*)take((size_t)MALL * 256 * 2);
    p.U = (bf16_t*)take((size_t)MALL * GMD * 2); p.Vg = (bf16_t*)take((size_t)MALL * GMD * 2);
    p.GA = (bf16_t*)take((size_t)MALL * DM * 2); p.GB = (bf16_t*)take((size_t)MALL * DM * 2);
    p.GATE = (float*)take((size_t)MALL * 32 * 4);
    p.PARTP = (float*)take((size_t)NB * 512 * 4 * 256 * 4); p.PARTS = (float*)take((size_t)NS * 1024 * 4 * 256 * 4); p.PEB = (float*)take(256 * 4);
    p.KCP = (float*)take((size_t)NB * NG * 512 * 64 * 4); p.VCP = (float*)take((size_t)NB * NG * 512 * 64 * 4);
    p.KCS = (float*)take((size_t)NS * NG * 1024 * 64 * 4); p.VCS = (float*)take((size_t)NS * NG * 1024 * 64 * 4);
    p.OCAT = (bf16_t*)take((size_t)MALL * DM * 2); p.T = (float*)take((size_t)MALL * DM * 4); p.Y1 = (bf16_t*)take((size_t)MALL * DM * 2);
    p.F = (float*)take((size_t)MALL * DM * 4); p.X1 = (float*)take((size_t)MALL * DM * 4); p.H2 = (bf16_t*)take((size_t)MALL * DM * 2);
    p.ACT = (bf16_t*)take((size_t)MALL * DFF * 2); p.X2 = (float*)take((size_t)MALL * DM * 4); p.X2b = (bf16_t*)take((size_t)MALL * DM * 2);
    p.Pb = (bf16_t*)take((size_t)MALL * PLE * 2);
    if (off > ws_size) { fprintf(stderr, "workspace too small: need %zu have %zu\n", off, ws_size); return; }
    hipMemsetAsync(p.OCAT + (size_t)(MP + NS) * DM, 0, (size_t)(MALL - MP - NS) * DM * 2, stream);
    launch_all<0>(p, 256, stream);
}
```

```cpp
#include <hip/hip_runtime.h>
#include <stdint.h>
#include <cstdio>

typedef unsigned short bf16_t;
typedef short bf16x8 __attribute__((ext_vector_type(8)));
typedef float f32x4 __attribute__((ext_vector_type(4)));
typedef float f32x2 __attribute__((ext_vector_type(2)));
typedef unsigned u32x4 __attribute__((ext_vector_type(4)));
typedef unsigned u32x2 __attribute__((ext_vector_type(2)));
#define LAS __attribute__((address_space(3)))

constexpr int DM = 1024, NB = 4, SEQ = 8192, MP = NB * SEQ, NS = 32, MALL = MP + 256, PAST = 16384, PAGE = 128, NPG = 128;
constexpr int NH = 8, NG = 2, HPG = 4, DH = 64, QD = 512, WIN = 512, GMD = 512, DFF = 2816, PLE = 256, IND = 4376, INP = 4608;
constexpr int NCP = 511, NCS = 1023;
constexpr float EPS = 1e-6f;
constexpr long O_YP = 0, O_YS = 33554432, O_CMPP = 33587200, O_SLCP = 41975808, O_WINP = 50364416, O_CMPS = 50888704,
               O_SLCS = 50896896, O_WINS = 50905088, O_GMV = 55099392;

struct Params {
    const float *x_prompt, *x_sample, *cache_cmp, *cache_slc, *state_win; const int* page_table;
    const float *p_prompt, *p_sample, *rel_bias, *ln_mix_pre, *w_in, *pe_k, *w1_k, *w2_k, *pe_v, *w1_v, *w2_v;
    const float *gm_ln_g, *gm_ln_b, *gm_ws, *gm_bs, *w_br_nsa, *w_br_gm, *w_out, *ln_mix_post, *ln_ffn_pre;
    const float *w_gate, *w_up, *w_down, *ln_ffn_post, *w_ple, *w_ple_gate, *ln_ple_post;
    float* out;
    unsigned* bar;
    bf16_t *WinT, *WnT, *WgT, *WoT, *WguT, *WdT, *WpgT, *WpT;
    bf16_t *H, *Qb, *CMPb, *SLCb, *WINb, *U, *Vg, *GA, *GB;
    float* GATE;
    float *PARTP, *PARTS, *PEB, *KCP, *VCP, *KCS, *VCS;
    bf16_t* OCAT; float* T; bf16_t* Y1; float* F; float* X1; bf16_t* H2; bf16_t* ACT; float* X2; bf16_t* X2b; bf16_t* Pb;
};

__device__ __forceinline__ unsigned cvt_pk_bf16(float lo, float hi) { unsigned r; asm volatile("v_cvt_pk_bf16_f32 %0, %1, %2" : "=v"(r) : "v"(lo), "v"(hi)); return r; }
__device__ __forceinline__ bf16_t f2bf(float f) { return (bf16_t)(cvt_pk_bf16(f, 0.f) & 0xffffu); }
__device__ __forceinline__ float bf2f(bf16_t h) { return __uint_as_float(((unsigned)h) << 16); }
__device__ __forceinline__ float bflo(unsigned w) { return __uint_as_float(w << 16); }
__device__ __forceinline__ float bfhi(unsigned w) { return __uint_as_float(w & 0xffff0000u); }
__device__ __forceinline__ float sigmoidf_(float x) { return 1.0f / (1.0f + __expf(-x)); }
__device__ __forceinline__ float siluf_(float x) { return x * sigmoidf_(x); }
__device__ __forceinline__ float geluf_(float x) {
    const float u = 0.7978845608028654f * (x + 0.044715f * x * x * x);
    const float e = __expf(2.0f * u);
    const float th = 1.0f - 2.0f / (e + 1.0f);
    return 0.5f * x * (1.0f + th);
}
__device__ __forceinline__ float wave_sum(float v) {
#pragma unroll
    for (int o = 32; o > 0; o >>= 1) v += __shfl_xor(v, o);
    return v;
}
__device__ __forceinline__ float wave_max(float v) {
#pragma unroll
    for (int o = 32; o > 0; o >>= 1) v = fmaxf(v, __shfl_xor(v, o));
    return v;
}
__device__ __forceinline__ int t5_bucket(int d) {
    if (d < 16) return d;
    if (d >= 128) return 31;
    const int b = 16 + (int)(__logf((float)d * (1.0f / 16.0f)) * (16.0f / 2.0794415416798357f));
    return b < 31 ? b : 31;
}

extern __shared__ __attribute__((aligned(16))) unsigned char smem[];

constexpr int BM = 256, BK = 64, HALF = 128, HT = HALF * BK, GEMM_LDS = 8 * HT * 2;
__device__ __forceinline__ int lds_byte(int r, int c) { const int st = (r >> 4) * 2 + (c >> 5), rr = r & 15, cc = c & 31, ob = rr * 64 + cc * 2; return st * 1024 + (ob ^ (((ob >> 9) & 1) << 5)); }
__device__ __forceinline__ void stage_rc(int b, int& R, int& C) { const int st = b / 1024, sb = b % 1024, swz = sb ^ (((sb >> 9) & 1) << 5); R = (st >> 1) * 16 + swz / 64; C = (st & 1) * 32 + (swz % 64) / 2; }

constexpr int HTB = HALF * BK * 2;
template <class F>
__device__ __forceinline__ void for_each_frag(const f32x4 (&acc)[2][2][4][2], int brow, int bcol, int wr, int wc, int fr, int fq, F&& f) {
#pragma unroll
    for (int ai = 0; ai < 2; ++ai)
#pragma unroll
        for (int m = 0; m < 4; ++m)
#pragma unroll
            for (int bj = 0; bj < 2; ++bj)
#pragma unroll
                for (int n = 0; n < 2; ++n)
                    f(brow + ai * HALF + wr * 64 + m * 16 + fr, bcol + bj * HALF + wc * 32 + n * 16 + fq * 4, acc[ai][bj][m][n]);
}

template <class Epi>
__device__ __forceinline__ void gemm_phase(const bf16_t* A, int lda, const bf16_t* Bt, int K, int nM, int nN, const Epi& E) {
    LAS unsigned char* lds = (LAS unsigned char*)smem;
    const int tid = threadIdx.x, wid = __builtin_amdgcn_readfirstlane(tid >> 6), lane = tid & 63, wr = wid >> 2, wc = wid & 3, fr = lane & 15, fq = lane >> 4;
    const int nt = K / BK, nu = nM * nN, G = gridDim.x;
    int u = blockIdx.x;
    if (u >= nu) return;
    unsigned voffA[2], voffB[2];
#pragma unroll
    for (int i = 0; i < 2; ++i) { int R, C; stage_rc(tid * 16 + i * 8192, R, C); voffA[i] = (unsigned)(R * lda + C) * 2u; voffB[i] = (unsigned)(R * K + C) * 2u; }
    const size_t kstep = (size_t)(BK * 2);
    const size_t hstepA = (size_t)HALF * lda * 2, hstepB = (size_t)HALF * K * 2, tstepA = 2 * hstepA, tstepB = 2 * hstepB;
    const unsigned ldsw = (unsigned)wid * 1024u;
    const int aoff = lds_byte(wr * 64 + fr, fq * 8), boff = lds_byte(wc * 32 + fr, fq * 8);
#define PG8_SA(b, h) (((b) * 2 + (h)) * HTB)
#define PG8_SB(b, h) ((4 + (b) * 2 + (h)) * HTB)
#define PG8_STAGE(bufoff, gbase, voff) do { _Pragma("unroll") for (int _i = 0; _i < 2; ++_i) \
        __builtin_amdgcn_global_load_lds((const unsigned*)((const char*)(gbase) + (voff)[_i]), (LAS unsigned*)(lds + (bufoff) + ldsw + _i * 8192), 16, 0, 0); } while (0)
#define PG8_LDA(dst, b, h) do { _Pragma("unroll") for (int m = 0; m < 4; ++m) _Pragma("unroll") for (int k = 0; k < 2; ++k) dst[m][k] = *(const LAS bf16x8*)(lds + PG8_SA(b, h) + aoff + m * 2048 + k * 1024); } while (0)
#define PG8_LDB(dst, b, h) do { _Pragma("unroll") for (int n = 0; n < 2; ++n) _Pragma("unroll") for (int k = 0; k < 2; ++k) dst[n][k] = *(const LAS bf16x8*)(lds + PG8_SB(b, h) + boff + n * 2048 + k * 1024); } while (0)
#define PG8_MMA(ai, bj, At, Bt_) do { __builtin_amdgcn_s_setprio(1); _Pragma("unroll") for (int m = 0; m < 4; ++m) _Pragma("unroll") for (int n = 0; n < 2; ++n) _Pragma("unroll") for (int k = 0; k < 2; ++k) \
        acc[ai][bj][m][n] = __builtin_amdgcn_mfma_f32_16x16x32_bf16(Bt_[n][k], At[m][k], acc[ai][bj][m][n], 0, 0, 0); __builtin_amdgcn_s_setprio(0); } while (0)
#define PG8_WAIT_V(n) asm volatile("s_waitcnt vmcnt(" #n ")" ::: "memory")
#define PG8_WAIT_L(n) asm volatile("s_waitcnt lgkmcnt(" #n ")" ::: "memory")
#define PG8_BAR __builtin_amdgcn_s_barrier()
#define PG8_SCHED __builtin_amdgcn_sched_barrier(0)
    f32x4 acc[2][2][4][2];
#pragma unroll
    for (int a = 0; a < 2; ++a)
#pragma unroll
        for (int b = 0; b < 2; ++b)
#pragma unroll
            for (int m = 0; m < 4; ++m)
#pragma unroll
                for (int n = 0; n < 2; ++n) acc[a][b][m][n] = (f32x4){0.f, 0.f, 0.f, 0.f};
    bf16x8 At[4][2], B0[2][2], B1[2][2];
    int pm = u / nN, pn = u - pm * nN;
    const char* cA = (const char*)A + (size_t)pm * tstepA; const char* cB = (const char*)Bt + (size_t)pn * tstepB;
    PG8_STAGE(PG8_SB(0, 0), cB, voffB); PG8_STAGE(PG8_SA(0, 0), cA, voffA); PG8_STAGE(PG8_SB(0, 1), cB + hstepB, voffB); PG8_STAGE(PG8_SA(0, 1), cA + hstepA, voffA);
    if (wr == 1) PG8_BAR;
    PG8_WAIT_V(4); PG8_BAR;
    PG8_STAGE(PG8_SB(1, 0), cB + kstep, voffB); PG8_STAGE(PG8_SA(1, 0), cA + kstep, voffA); PG8_STAGE(PG8_SB(1, 1), cB + hstepB + kstep, voffB);
    PG8_WAIT_V(6); PG8_BAR;
    for (;;) {
        const int un = u + G; const bool has_next = un < nu;
        const int npm = has_next ? un / nN : pm, npn = has_next ? un - npm * nN : pn;
        const char* nA = (const char*)A + (size_t)npm * tstepA; const char* nB = (const char*)Bt + (size_t)npn * tstepB;
        for (int t = 0; t < nt; t += 2) {
            const bool last = (t == nt - 2);
            const char* a1 = cA + (size_t)(t + 1) * kstep;
            const char* a2 = last ? nA : cA + (size_t)(t + 2) * kstep; const char* b2 = last ? nB : cB + (size_t)(t + 2) * kstep;
            const char* a3 = a2 + kstep; const char* b3 = b2 + kstep;
            PG8_LDB(B0, 0, 0); PG8_SCHED; PG8_LDA(At, 0, 0); PG8_STAGE(PG8_SA(1, 1), a1 + hstepA, voffA);
            PG8_WAIT_L(8); PG8_BAR; PG8_WAIT_L(0); PG8_MMA(0, 0, At, B0); PG8_BAR; PG8_SCHED;
            PG8_LDB(B1, 0, 1); PG8_STAGE(PG8_SB(0, 0), b2, voffB);
            PG8_BAR; PG8_WAIT_L(0); PG8_MMA(0, 1, At, B1); PG8_BAR;
            PG8_LDA(At, 0, 1); PG8_STAGE(PG8_SA(0, 0), a2, voffA);
            PG8_BAR; PG8_WAIT_L(0); PG8_MMA(1, 0, At, B0); PG8_BAR; PG8_SCHED;
            PG8_STAGE(PG8_SB(0, 1), b2 + hstepB, voffB);
            PG8_WAIT_V(6); PG8_BAR; PG8_MMA(1, 1, At, B1); PG8_BAR;
            PG8_LDB(B0, 1, 0); PG8_SCHED; PG8_LDA(At, 1, 0); PG8_STAGE(PG8_SA(0, 1), a2 + hstepA, voffA);
            PG8_WAIT_L(8); PG8_BAR; PG8_WAIT_L(0); PG8_MMA(0, 0, At, B0); PG8_BAR; PG8_SCHED;
            PG8_LDB(B1, 1, 1); PG8_STAGE(PG8_SB(1, 0), b3, voffB);
            PG8_BAR; PG8_WAIT_L(0); PG8_MMA(0, 1, At, B1); PG8_BAR;
            PG8_LDA(At, 1, 1); PG8_STAGE(PG8_SA(1, 0), a3, voffA);
            PG8_BAR; PG8_WAIT_L(0); PG8_MMA(1, 0, At, B0); PG8_BAR; PG8_SCHED;
            PG8_STAGE(PG8_SB(1, 1), b3 + hstepB, voffB);
            PG8_WAIT_V(6); PG8_BAR; PG8_MMA(1, 1, At, B1); PG8_BAR;
        }
        E(acc, pm * BM, pn * BM, wr, wc, fr, fq);
        if (!has_next) break;
#pragma unroll
        for (int a = 0; a < 2; ++a)
#pragma unroll
            for (int b = 0; b < 2; ++b)
#pragma unroll
                for (int m = 0; m < 4; ++m)
#pragma unroll
                    for (int n = 0; n < 2; ++n) acc[a][b][m][n] = (f32x4){0.f, 0.f, 0.f, 0.f};
        u = un; pm = npm; pn = npn; cA = nA; cB = nB;
    }
    PG8_WAIT_V(0);
    if (wr == 0) PG8_BAR;
    PG8_BAR;
#undef PG8_SA
#undef PG8_SB
#undef PG8_STAGE
#undef PG8_LDA
#undef PG8_LDB
#undef PG8_MMA
#undef PG8_WAIT_V
#undef PG8_WAIT_L
#undef PG8_BAR
#undef PG8_SCHED
}

__device__ __forceinline__ void st_bf16x4(bf16_t* p, f32x4 v) { u32x2 w; w.x = cvt_pk_bf16(v[0], v[1]); w.y = cvt_pk_bf16(v[2], v[3]); *(u32x2*)p = w; }

struct EpiIn {
    const Params& p;
    __device__ __forceinline__ void operator()(const f32x4 (&acc)[2][2][4][2], int brow, int bcol, int wr, int wc, int fr, int fq) const {
        const int pn = bcol >> 8;
        const Params& P = p;
        if (pn < 2) {
            for_each_frag(acc, brow, bcol, wr, wc, fr, fq, [&](int row, int col, f32x4 v) { st_bf16x4(P.Qb + (size_t)row * QD + col, v * 0.125f); });
        } else if (pn < 5) {
            bf16_t* cp = pn == 2 ? P.CMPb : pn == 3 ? P.SLCb : P.WINb;
            for_each_frag(acc, brow, bcol, wr, wc, fr, fq, [&](int row, int col, f32x4 v) {
                const int c = col & 255;
                st_bf16x4(cp + (size_t)row * 256 + c, v);
                if (pn < 4) {
                    if (row < MP) *(f32x4*)(P.out + (pn == 2 ? O_CMPP : O_SLCP) + (size_t)row * 256 + c) = v;
                    else if (row < MP + NS) *(f32x4*)(P.out + (pn == 2 ? O_CMPS : O_SLCS) + (size_t)(row - MP) * 256 + c) = v;
                } else {
                    if (row < MP) { const int t = row & (SEQ - 1), b = row >> 13; if (t >= SEQ - WIN) *(f32x4*)(P.out + O_WINP + ((size_t)b * WIN + (t - (SEQ - WIN))) * 256 + c) = v; }
                    else if (row < MP + NS) *(f32x4*)(P.out + O_WINS + ((size_t)(row - MP) * WIN + (WIN - 1)) * 256 + c) = v;
                }
            });
        } else if (pn < 9) {
            bf16_t* dst = pn < 7 ? P.U : P.Vg; const int c0 = pn < 7 ? 1280 : 1792;
            for_each_frag(acc, brow, bcol, wr, wc, fr, fq, [&](int row, int col, f32x4 v) {
                f32x4 g; g[0] = geluf_(v[0]); g[1] = geluf_(v[1]); g[2] = geluf_(v[2]); g[3] = geluf_(v[3]);
                st_bf16x4(dst + (size_t)row * GMD + (col - c0), g); });
        } else if (pn < 17) {
            bf16_t* dst = pn < 13 ? P.GA : P.GB; const int c0 = pn < 13 ? 2304 : 3328;
            for_each_frag(acc, brow, bcol, wr, wc, fr, fq, [&](int row, int col, f32x4 v) {
                f32x4 g; g[0] = sigmoidf_(v[0]); g[1] = sigmoidf_(v[1]); g[2] = sigmoidf_(v[2]); g[3] = sigmoidf_(v[3]);
                st_bf16x4(dst + (size_t)row * DM + (col - c0), g); });
        } else {
            for_each_frag(acc, brow, bcol, wr, wc, fr, fq, [&](int row, int col, f32x4 v) {
                const int c = col & 255;
                if (c < 24) { f32x4 g; g[0] = sigmoidf_(v[0]); g[1] = sigmoidf_(v[1]); g[2] = sigmoidf_(v[2]); g[3] = sigmoidf_(v[3]); *(f32x4*)(P.GATE + (size_t)row * 32 + c) = g; } });
        }
    }
};
struct EpiBrA {
    const bf16_t* GA; float* T;
    __device__ __forceinline__ void operator()(const f32x4 (&acc)[2][2][4][2], int brow, int bcol, int wr, int wc, int fr, int fq) const {
        for_each_frag(acc, brow, bcol, wr, wc, fr, fq, [&](int row, int col, f32x4 v) {
            const u32x2 g = *(const u32x2*)(GA + (size_t)row * DM + col);
            f32x4 o; o[0] = v[0] * bflo(g.x); o[1] = v[1] * bfhi(g.x); o[2] = v[2] * bflo(g.y); o[3] = v[3] * bfhi(g.y);
            *(f32x4*)(T + (size_t)row * DM + col) = o; });
    }
};
struct EpiBrB {
    const bf16_t* GB; const float* T; bf16_t* Y1;
    __device__ __forceinline__ void operator()(const f32x4 (&acc)[2][2][4][2], int brow, int bcol, int wr, int wc, int fr, int fq) const {
        for_each_frag(acc, brow, bcol, wr, wc, fr, fq, [&](int row, int col, f32x4 v) {
            const u32x2 g = *(const u32x2*)(GB + (size_t)row * DM + col);
            const f32x4 t = *(const f32x4*)(T + (size_t)row * DM + col);
            f32x4 o; o[0] = t[0] + v[0] * bflo(g.x); o[1] = t[1] + v[1] * bfhi(g.x); o[2] = t[2] + v[2] * bflo(g.y); o[3] = t[3] + v[3] * bfhi(g.y);
            st_bf16x4(Y1 + (size_t)row * DM + col, o); });
    }
};
struct EpiF32 {
    float* F; int ld;
    __device__ __forceinline__ void operator()(const f32x4 (&acc)[2][2][4][2], int brow, int bcol, int wr, int wc, int fr, int fq) const {
        for_each_frag(acc, brow, bcol, wr, wc, fr, fq, [&](int row, int col, f32x4 v) { *(f32x4*)(F + (size_t)row * ld + col) = v; });
    }
};
struct EpiSwiGLU {
    bf16_t* ACT;
    __device__ __forceinline__ void operator()(const f32x4 (&acc)[2][2][4][2], int brow, int bcol, int wr, int wc, int fr, int fq) const {
        for_each_frag(acc, brow, bcol, wr, wc, fr, fq, [&](int row, int col, f32x4 v) {
            *(unsigned*)(ACT + (size_t)row * DFF + (col >> 1)) = cvt_pk_bf16(siluf_(v[0]) * v[1], siluf_(v[2]) * v[3]); });
    }
};
struct EpiPleGate {
    const float* E; float* F;
    __device__ __forceinline__ void operator()(const f32x4 (&acc)[2][2][4][2], int brow, int bcol, int wr, int wc, int fr, int fq) const {
        for_each_frag(acc, brow, bcol, wr, wc, fr, fq, [&](int row, int col, f32x4 v) {
            const f32x4 e = *(const f32x4*)(E + (size_t)row * DM + col);
            f32x4 o; o[0] = sigmoidf_(v[0]) * e[0]; o[1] = sigmoidf_(v[1]) * e[1]; o[2] = sigmoidf_(v[2]) * e[2]; o[3] = sigmoidf_(v[3]) * e[3];
            *(f32x4*)(F + (size_t)row * DM + col) = o; });
    }
};

template <class Map>
__device__ __forceinline__ void transpose_tile(const float* W, int K, int N, bf16_t* Wt, int ldk, int kt, int ntile, Map map) {
    LAS float* tile = (LAS float*)smem;
    const int t = threadIdx.x;
    __syncthreads();
#pragma unroll
    for (int i = 0; i < 2; ++i) {
        const int k = (t >> 4) + 32 * i, n = (t & 15) * 4, gn = ntile * 64 + n;
        f32x4 v = (f32x4){0.f, 0.f, 0.f, 0.f};
        if (gn < N) v = *(const f32x4*)(W + (size_t)(kt * 64 + k) * N + gn);
        tile[k * 65 + n] = v[0]; tile[k * 65 + n + 1] = v[1]; tile[k * 65 + n + 2] = v[2]; tile[k * 65 + n + 3] = v[3];
    }
    __syncthreads();
    const int n = t >> 3, kc = (t & 7) * 8, gn = ntile * 64 + n;
    if (gn < N) {
        u32x4 w;
        w.x = cvt_pk_bf16(tile[(kc + 0) * 65 + n], tile[(kc + 1) * 65 + n]); w.y = cvt_pk_bf16(tile[(kc + 2) * 65 + n], tile[(kc + 3) * 65 + n]);
        w.z = cvt_pk_bf16(tile[(kc + 4) * 65 + n], tile[(kc + 5) * 65 + n]); w.w = cvt_pk_bf16(tile[(kc + 6) * 65 + n], tile[(kc + 7) * 65 + n]);
        *(u32x4*)(Wt + (size_t)map(gn) * ldk + kt * 64 + kc) = w;
    }
}
template <class Map>
__device__ __forceinline__ void transpose_all(const float* W, int K, int N, bf16_t* Wt, int ldk, Map map, int& base) {
    const int nkt = K / 64, nnt = (N + 63) / 64, ntl = nkt * nnt;
    for (int it = blockIdx.x; it < base + ntl; it += gridDim.x) {
        if (it < base) continue;
        const int l = it - base;
        transpose_tile(W, K, N, Wt, ldk, l / nnt, l % nnt, map);
    }
    base += ntl;
}
__device__ __forceinline__ int map_win(int n) {
    if (n < 1280) return n;
    if (n < 1304) return 4352 + (n - 1280);
    if (n < 2328) return 1280 + (n - 1304);
    return 2304 + (n - 2328);
}

__device__ __forceinline__ float row_rstd(const f32x4 (&v)[4]) {
    float s = 0.f;
#pragma unroll
    for (int k = 0; k < 4; ++k) s += v[k][0] * v[k][0] + v[k][1] * v[k][1] + v[k][2] * v[k][2] + v[k][3] * v[k][3];
    s = wave_sum(s);
    return rsqrtf(s * (1.0f / DM) + EPS);
}
__device__ __forceinline__ const float* xrow_ptr(const Params& p, int row) {
    return row < MP ? p.x_prompt + (size_t)row * DM : p.x_sample + (size_t)(row - MP) * DM;
}

__device__ void phase_prologue(const Params& p) {
    const int wid = threadIdx.x >> 6, lane = threadIdx.x & 63;
    const int gw = blockIdx.x * 8 + wid, nw = gridDim.x * 8;
    int base = 0;
    transpose_all(p.w_in, DM, IND, p.WinT, DM, [](int n) { return map_win(n); }, base);
    transpose_all(p.w_br_nsa, QD, DM, p.WnT, QD, [](int n) { return n; }, base);
    transpose_all(p.w_br_gm, GMD, DM, p.WgT, GMD, [](int n) { return n; }, base);
    transpose_all(p.w_out, DM, DM, p.WoT, DM, [](int n) { return n; }, base);
    transpose_all(p.w_gate, DM, DFF, p.WguT, DM, [](int n) { return 2 * n; }, base);
    transpose_all(p.w_up, DM, DFF, p.WguT, DM, [](int n) { return 2 * n + 1; }, base);
    transpose_all(p.w_down, DFF, DM, p.WdT, DFF, [](int n) { return n; }, base);
    transpose_all(p.w_ple_gate, DM, DM, p.WpgT, DM, [](int n) { return n; }, base);
    transpose_all(p.w_ple, PLE, DM, p.WpT, PLE, [](int n) { return n; }, base);
    __syncthreads();
    for (int i = blockIdx.x * 512 + threadIdx.x; i < (INP - IND) * DM / 8; i += gridDim.x * 512) ((u32x4*)(p.WinT + (size_t)IND * DM))[i] = (u32x4){0u, 0u, 0u, 0u};
    for (int row = gw; row < MALL; row += nw) {
        u32x2* hd = (u32x2*)(p.H + (size_t)row * DM);
        if (row < MP + NS) {
            const float* xr = xrow_ptr(p, row);
            f32x4 v[4];
#pragma unroll
            for (int k = 0; k < 4; ++k) v[k] = *(const f32x4*)(xr + lane * 4 + k * 256);
            const float r = row_rstd(v);
#pragma unroll
            for (int k = 0; k < 4; ++k) { const f32x4 g = *(const f32x4*)(p.ln_mix_pre + lane * 4 + k * 256); const f32x4 o = v[k] * r * g; u32x2 w; w.x = cvt_pk_bf16(o[0], o[1]); w.y = cvt_pk_bf16(o[2], o[3]); hd[lane + k * 64] = w; }
            const float* pr = row < MP ? p.p_prompt + (size_t)row * PLE : p.p_sample + (size_t)(row - MP) * PLE;
            const f32x4 pv = *(const f32x4*)(pr + lane * 4);
            u32x2 w; w.x = cvt_pk_bf16(pv[0], pv[1]); w.y = cvt_pk_bf16(pv[2], pv[3]);
            ((u32x2*)(p.Pb + (size_t)row * PLE))[lane] = w;
        } else {
#pragma unroll
            for (int k = 0; k < 4; ++k) hd[lane + k * 64] = (u32x2){0u, 0u};
            ((u32x2*)(p.Pb + (size_t)row * PLE))[lane] = (u32x2){0u, 0u};
        }
    }
    if (gw < 4) {
        const int kv = gw >> 1, h = (gw & 1) * 64 + lane;
        const float* pe = kv ? p.pe_v : p.pe_k; const float* w1 = kv ? p.w1_v : p.w1_k;
        float s = 0.f;
        for (int k = 0; k < 2048; ++k) s += pe[k] * w1[(size_t)k * 128 + h];
        p.PEB[kv * 128 + h] = s;
    }
    for (int i = blockIdx.x * 512 + threadIdx.x; i < NS * (WIN - 1) * 64; i += gridDim.x * 512) {
        const int b = i / ((WIN - 1) * 64), r = i % ((WIN - 1) * 64);
        ((f32x4*)(p.out + O_WINS + (size_t)b * WIN * 256))[r] = ((const f32x4*)(p.state_win + (size_t)b * WIN * 256 + 256))[r];
    }
}

__device__ void phase_cmp_parts(const Params& p) {
    const int wid = threadIdx.x >> 6, lane = threadIdx.x & 63;
    const int nitem_p = NB * 64 * 4, nitem_s = NS * 128 * 4;
    for (int it = blockIdx.x * 8 + wid; it < nitem_p + nitem_s; it += gridDim.x * 8) {
        const bool smp = it >= nitem_p; const int l = smp ? it - nitem_p : it;
        const int gk = l & 3, g = gk >> 1, kv = gk & 1, s8 = l >> 2;
        const int nsub8 = smp ? 128 : 64, seq = s8 / nsub8, s0 = (s8 % nsub8) * 8;
        const float* w1 = kv ? p.w1_v : p.w1_k;
        const float* src;
        if (smp) src = p.cache_cmp + ((size_t)p.page_table[seq * NPG + (s0 >> 3)] * PAGE) * 256 + kv * 128 + g * 64;
        else src = p.out + O_CMPP + ((size_t)seq * SEQ + s0 * 16) * 256 + kv * 128 + g * 64;
        float acc[8][4];
#pragma unroll
        for (int i = 0; i < 8; ++i) { acc[i][0] = acc[i][1] = acc[i][2] = acc[i][3] = 0.f; }
        for (int k = 0; k < 1024; ++k) {
            const int pos = k >> 6, d = k & 63;
            const f32x2 wa = *(const f32x2*)(w1 + (size_t)k * 128 + lane * 2);
            const f32x2 wb = *(const f32x2*)(w1 + (size_t)(1024 + k) * 128 + lane * 2);
#pragma unroll
            for (int i = 0; i < 8; ++i) {
                const float x = src[(size_t)(i * 16 + pos) * 256 + d];
                acc[i][0] += x * wa.x; acc[i][1] += x * wa.y; acc[i][2] += x * wb.x; acc[i][3] += x * wb.y;
            }
        }
        float* dst = (smp ? p.PARTS : p.PARTP);
        const int nsub = smp ? 1024 : 512;
#pragma unroll
        for (int i = 0; i < 8; ++i) {
            float* d0 = dst + (((size_t)seq * nsub + s0 + i) * 4 + gk) * 256;
            *(f32x2*)(d0 + lane * 2) = (f32x2){acc[i][0], acc[i][1]};
            *(f32x2*)(d0 + 128 + lane * 2) = (f32x2){acc[i][2], acc[i][3]};
        }
    }
}
__device__ void phase_cmp_final(const Params& p) {
    const int wid = threadIdx.x >> 6, lane = threadIdx.x & 63;
    LAS float* hb = (LAS float*)smem + wid * 128;
    const int nitem_p = NB * NCP * 4, nitem_s = NS * NCS * 4;
    for (int it = blockIdx.x * 8 + wid; it < nitem_p + nitem_s; it += gridDim.x * 8) {
        const bool smp = it >= nitem_p; const int l = smp ? it - nitem_p : it;
        const int gk = l & 3, g = gk >> 1, kv = gk & 1, r = l >> 2;
        const int nc = smp ? NCS : NCP, nsub = smp ? 1024 : 512, seq = r / nc, n = r % nc;
        const float* part = smp ? p.PARTS : p.PARTP;
        const float* p0 = part + (((size_t)seq * nsub + n) * 4 + gk) * 256;
        const float* p1 = part + (((size_t)seq * nsub + n + 1) * 4 + gk) * 256 + 128;
        const float* w2 = kv ? p.w2_v : p.w2_k;
#pragma unroll
        for (int i = 0; i < 2; ++i) { const int h = lane + 64 * i; hb[h] = siluf_(p0[h] + p1[h] + p.PEB[kv * 128 + h]); }
        __builtin_amdgcn_wave_barrier();
        float s = 0.f;
        for (int h = 0; h < 128; ++h) s += hb[h] * w2[h * 64 + lane];
        __builtin_amdgcn_wave_barrier();
        float* dst = smp ? (kv ? p.VCS : p.KCS) + (((size_t)seq * NG + g) * 1024 + n) * 64 : (kv ? p.VCP : p.KCP) + (((size_t)seq * NG + g) * 512 + n) * 64;
        dst[lane] = s;
    }
}

template <bool SAMPLE>
__device__ __forceinline__ void kv_row_ptr(const Params& p, int branch  , int b, int pos, int kv, int g, const bf16_t*& pb, const float*& pf) {
    const int off = kv * 128 + g * 64;
    if (!SAMPLE) { pf = nullptr; pb = (branch == 1 ? p.SLCb : p.WINb) + ((size_t)b * SEQ + pos) * 256 + off; }
    else if (pos >= PAST) { pf = nullptr; pb = (branch == 1 ? p.SLCb : p.WINb) + ((size_t)MP + b) * 256 + off; }
    else if (branch == 1) { pb = nullptr; pf = p.cache_slc + ((size_t)p.page_table[b * NPG + (pos >> 7)] * PAGE + (pos & 127)) * 256 + off; }
    else { pb = nullptr; pf = p.state_win + ((size_t)b * WIN + (pos - (PAST - WIN))) * 256 + off; }
}
__device__ __forceinline__ void dot4x64(const bf16_t* pb, const float* pf, const LAS float* qs_, float (&s)[4]) {
    s[0] = s[1] = s[2] = s[3] = 0.f;
    const LAS float* qs = qs_; asm volatile("" : "+v"(qs));
    if (pf) {
#pragma unroll 2
        for (int c = 0; c < 16; ++c) {
            const f32x4 kx = *(const f32x4*)(pf + c * 4);
#pragma unroll
            for (int h = 0; h < 4; ++h) { const f32x4 q = *(const LAS f32x4*)(qs + h * 64 + c * 4); s[h] += q[0] * kx[0] + q[1] * kx[1] + q[2] * kx[2] + q[3] * kx[3]; }
        }
    } else {
#pragma unroll 1
        for (int c = 0; c < 8; ++c) {
            const u32x4 w = *(const u32x4*)(pb + c * 8);
            const float k0 = bflo(w.x), k1 = bfhi(w.x), k2 = bflo(w.y), k3 = bfhi(w.y), k4 = bflo(w.z), k5 = bfhi(w.z), k6 = bflo(w.w), k7 = bfhi(w.w);
#pragma unroll
            for (int h = 0; h < 4; ++h) {
                const f32x4 qa = *(const LAS f32x4*)(qs + h * 64 + c * 8), qb = *(const LAS f32x4*)(qs + h * 64 + c * 8 + 4);
                s[h] += qa[0] * k0 + qa[1] * k1 + qa[2] * k2 + qa[3] * k3 + qb[0] * k4 + qb[1] * k5 + qb[2] * k6 + qb[3] * k7;
            }
        }
    }
}
template <bool SAMPLE>
__device__ __forceinline__ void attn_chunk(const Params& p, int branch, int b, int g, int t, int pos0, int lo, int hi,
                                           float (&m)[4], float (&l)[4], float (&o)[4], const LAS float* qs, LAS float* pbk, const LAS float* relb, int lane) {
    const int pos = pos0 + lane;
    const bool valid = pos >= lo && pos <= hi;
    float s[4] = {-1e30f, -1e30f, -1e30f, -1e30f};
    if (valid) {
        const bf16_t* pb; const float* pf; kv_row_ptr<SAMPLE>(p, branch, b, pos, 0, g, pb, pf);
        dot4x64(pb, pf, qs, s);
        const int bk = t5_bucket(t - pos);
#pragma unroll
        for (int h = 0; h < 4; ++h) s[h] += relb[bk * 8 + g * 4 + h];
    }
#pragma unroll
    for (int h = 0; h < 4; ++h) {
        const float mx = wave_max(s[h]);
        const float mn = fmaxf(m[h], mx);
        const float pr = valid ? __expf(s[h] - mn) : 0.f;
        const float sm = wave_sum(pr);
        const float al = __expf(m[h] - mn);
        l[h] = l[h] * al + sm; o[h] *= al; m[h] = mn;
        pbk[h * 64 + lane] = pr;
    }
    __builtin_amdgcn_wave_barrier();
    const int k0 = (lo > pos0 ? lo : pos0) - pos0, k1 = (hi < pos0 + 63 ? hi : pos0 + 63) - pos0;
#pragma unroll 1
    for (int k = k0; k <= k1; ++k) {
        const bf16_t* pb; const float* pf; kv_row_ptr<SAMPLE>(p, branch, b, pos0 + k, 1, g, pb, pf);
        const float v = pf ? pf[lane] : bf2f(pb[lane]);
#pragma unroll
        for (int h = 0; h < 4; ++h) o[h] += pbk[h * 64 + k] * v;
    }
    __builtin_amdgcn_wave_barrier();
}

constexpr int ATT_WAVE_LDS_P = 256 * 4 + 4 * 512 * 4 + (512 + 64) * 4 + 256 * 4 + 64;
constexpr int ATT_WAVE_LDS_S = 256 * 4 + 4 * 1024 * 4 + (1024 + 64) * 4 + 256 * 4 + 64;
constexpr int ATT_LDS = 1024 + (8 * ATT_WAVE_LDS_P > 4 * ATT_WAVE_LDS_S ? 8 * ATT_WAVE_LDS_P : 4 * ATT_WAVE_LDS_S);

template <bool SAMPLE>
__device__ __forceinline__ void attn_item(const Params& p, int row  , int b, int t, int g, const LAS float* relb, LAS unsigned char* wl, int lane) {
    constexpr int NCAP = SAMPLE ? 1024 : 512, NC = SAMPLE ? NCS : NCP, NSEL = SAMPLE ? 257 : 128, NJR = SAMPLE ? 5 : 2;
    LAS float* qs = (LAS float*)wl; LAS float* sl = qs + 256; LAS float* phs = sl + 4 * NCAP; LAS float* pbk = phs + NCAP + 64; LAS int* sel = (LAS int*)(pbk + 256);
    {
        const u32x2 w = *(const u32x2*)(p.Qb + (size_t)row * QD + g * 256 + lane * 4);
        qs[lane * 4 + 0] = bflo(w.x); qs[lane * 4 + 1] = bfhi(w.x); qs[lane * 4 + 2] = bflo(w.y); qs[lane * 4 + 3] = bfhi(w.y);
    }
    __builtin_amdgcn_wave_barrier();
    const int ncv = t >= 31 ? ((t - 31) >> 4) + 1 : 0;
    const int ncvc = ncv < NC ? ncv : NC;
    const float* kc = (SAMPLE ? p.KCS + ((size_t)b * NG + g) * 1024 * 64 : p.KCP + ((size_t)b * NG + g) * 512 * 64);
    const float* vc = (SAMPLE ? p.VCS + ((size_t)b * NG + g) * 1024 * 64 : p.VCP + ((size_t)b * NG + g) * 512 * 64);
    float oc[4] = {0.f, 0.f, 0.f, 0.f};
    {
        const int nrnd = (ncvc + 63) >> 6;
        float mx[4] = {-1e30f, -1e30f, -1e30f, -1e30f};
#pragma unroll 1
        for (int r = 0; r < nrnd; ++r) {
            const int n = r * 64 + lane;
            float s[4] = {-1e30f, -1e30f, -1e30f, -1e30f};
            if (n < ncvc) {
                dot4x64(nullptr, kc + (size_t)n * 64, qs, s);
                const int bk = t5_bucket(t - (16 * n + 31));
#pragma unroll
                for (int h = 0; h < 4; ++h) s[h] += relb[bk * 8 + g * 4 + h];
            }
#pragma unroll
            for (int h = 0; h < 4; ++h) { sl[h * NCAP + n] = s[h]; mx[h] = fmaxf(mx[h], s[h]); }
        }
        float sum[4] = {0.f, 0.f, 0.f, 0.f};
#pragma unroll
        for (int h = 0; h < 4; ++h) mx[h] = wave_max(mx[h]);
#pragma unroll 1
        for (int r = 0; r < nrnd; ++r) {
            const int n = r * 64 + lane;
#pragma unroll
            for (int h = 0; h < 4; ++h) { const float e = (n < ncvc) ? __expf(sl[h * NCAP + n] - mx[h]) : 0.f; sl[h * NCAP + n] = e; sum[h] += e; }
        }
#pragma unroll
        for (int h = 0; h < 4; ++h) { sum[h] = wave_sum(sum[h]); sum[h] = sum[h] > 0.f ? 1.0f / sum[h] : 0.f; }
#pragma unroll 1
        for (int r = 0; r < nrnd; ++r) {
            const int n = r * 64 + lane;
            phs[n] = (sl[n] * sum[0] + sl[NCAP + n] * sum[1]) + (sl[2 * NCAP + n] * sum[2] + sl[3 * NCAP + n] * sum[3]);
        }
#pragma unroll 1
        for (int n = nrnd * 64 + lane; n < NCAP + 64; n += 64) phs[n] = 0.f;
        __builtin_amdgcn_wave_barrier();
#pragma unroll
        for (int h = 0; h < 4; ++h) {
            float a = 0.f;
#pragma unroll 2
            for (int n = 0; n < ncvc; ++n) a += sl[h * NCAP + n] * vc[(size_t)n * 64 + lane];
            oc[h] = a * sum[h];
        }
    }
    const int qblk = t >> 6;
    int nselected;
    if (qblk <= 15) {
        nselected = qblk + 1;
        if (lane < 16) sel[lane] = lane;
    } else {
        unsigned long long key[NJR];
#pragma unroll
        for (int jr = 0; jr < NJR; ++jr) {
            const int j = jr * 64 + lane;
            key[jr] = 0ull;
            if (j >= 1 && j <= qblk - 2 && j < NSEL) {
                float im = 0.f;
#pragma unroll
                for (int n = 4 * j - 1; n <= 4 * j + 3; ++n) im += (n < NC) ? phs[n] : 0.f;
                key[jr] = ((unsigned long long)__float_as_uint(im) << 32) | (unsigned)(0xFFFF - j) | 0x10000ull;
            }
        }
        if (lane == 0) { sel[0] = 0; sel[1] = qblk - 1; sel[2] = qblk; }
#pragma unroll 1
        for (int it = 0; it < 13; ++it) {
            unsigned long long best = 0ull;
#pragma unroll
            for (int jr = 0; jr < NJR; ++jr) best = key[jr] > best ? key[jr] : best;
#pragma unroll
            for (int o = 32; o > 0; o >>= 1) { const unsigned long long ot = __shfl_xor(best, o); best = ot > best ? ot : best; }
            const int j = 0xFFFF - (int)(best & 0xFFFFull);
#pragma unroll
            for (int jr = 0; jr < NJR; ++jr) if (key[jr] == best) key[jr] = 0ull;
            if (lane == 0) sel[3 + it] = j;
        }
        nselected = 16;
    }
    __builtin_amdgcn_wave_barrier();
    float ms[4] = {-1e30f, -1e30f, -1e30f, -1e30f}, ls[4] = {0.f, 0.f, 0.f, 0.f}, os[4] = {0.f, 0.f, 0.f, 0.f};
#pragma unroll 1
    for (int i = 0; i < nselected; ++i) {
        const int j = sel[i];
        attn_chunk<SAMPLE>(p, 1, b, g, t, j * 64, 0, t, ms, ls, os, qs, pbk, relb, lane);
    }
    float mw[4] = {-1e30f, -1e30f, -1e30f, -1e30f}, lw[4] = {0.f, 0.f, 0.f, 0.f}, ow[4] = {0.f, 0.f, 0.f, 0.f};
    {
        const int lo = t - WIN > 0 ? t - WIN : 0;
#pragma unroll 1
        for (int c = 0; c < 9; ++c) {
            const int pos0 = t - 63 - 64 * c;
            if (pos0 + 63 < lo) break;
            attn_chunk<SAMPLE>(p, 2, b, g, t, pos0, lo, t, mw, lw, ow, qs, pbk, relb, lane);
        }
    }
    const float* gt = p.GATE + (size_t)row * 32 + g * 12;
#pragma unroll
    for (int h = 0; h < 4; ++h) {
        const float v = gt[h * 3 + 0] * oc[h] + gt[h * 3 + 1] * os[h] / ls[h] + gt[h * 3 + 2] * ow[h] / lw[h];
        p.OCAT[(size_t)row * DM + (g * 4 + h) * 64 + lane] = f2bf(v);
    }
    __builtin_amdgcn_wave_barrier();
}

__device__ void phase_attn(const Params& p) {
    const int wid = threadIdx.x >> 6, lane = threadIdx.x & 63;
    LAS float* relb = (LAS float*)smem;
    if (threadIdx.x < 256) relb[threadIdx.x] = p.rel_bias[threadIdx.x];
    __syncthreads();
    if (wid < 4) {
        LAS unsigned char* wl = (LAS unsigned char*)smem + 1024 + wid * ATT_WAVE_LDS_S;
#pragma unroll 1
        for (int it = blockIdx.x * 4 + wid; it < NS * NG; it += gridDim.x * 4) { const int b = it >> 1, g = it & 1; attn_item<true>(p, MP + b, b, PAST, g, relb, wl, lane); }
    }
    __syncthreads();
    LAS unsigned char* wl = (LAS unsigned char*)smem + 1024 + wid * ATT_WAVE_LDS_P;
#pragma unroll 1
    for (int it = blockIdx.x * 8 + wid; it < MP * NG; it += gridDim.x * 8) {
        const int g = it & 1, tok = it >> 1; const int b = tok & 3, t = SEQ - 1 - (tok >> 2);
        attn_item<false>(p, b * SEQ + t, b, t, g, relb, wl, lane);
    }
}

constexpr int GM_LDS = 128 * 128 * 4 + 1024;
__device__ void phase_gmlp(const Params& p) {
    const int wid = threadIdx.x >> 6, lane = threadIdx.x & 63, tid = threadIdx.x;
    LAS float* vn = (LAS float*)smem;
    LAS float* mu = (LAS float*)(smem + 128 * 128 * 4);
    for (int u = blockIdx.x; u < NB * 64; u += gridDim.x) {
        const int b = u >> 6, ch = u & 63; const size_t row0 = (size_t)b * SEQ + ch * 128;
        __syncthreads();
        for (int r = wid; r < 128; r += 8) {
            const u32x4 w = *(const u32x4*)(p.Vg + (row0 + r) * GMD + lane * 8);
            const float x[8] = {bflo(w.x), bfhi(w.x), bflo(w.y), bfhi(w.y), bflo(w.z), bfhi(w.z), bflo(w.w), bfhi(w.w)};
            float s = 0.f;
#pragma unroll
            for (int i = 0; i < 8; ++i) s += x[i];
            const float mean = wave_sum(s) * (1.0f / GMD);
            float q = 0.f;
#pragma unroll
            for (int i = 0; i < 8; ++i) q += (x[i] - mean) * (x[i] - mean);
            const float var = wave_sum(q) * (1.0f / GMD);
            if (lane == 0) { mu[r] = mean; mu[128 + r] = rsqrtf(var + EPS); }
        }
        for (int g = 0; g < 4; ++g) {
            __syncthreads();
            for (int i = tid; i < 128 * 128; i += 512) {
                const int s = i >> 7, d = i & 127, c = g * 128 + d;
                vn[i] = (bf2f(p.Vg[(row0 + s) * GMD + c]) - mu[s]) * mu[128 + s] * p.gm_ln_g[c] + p.gm_ln_b[c];
            }
            __syncthreads();
            const int d = tid & 127;
            for (int i = 0; i < 32; ++i) {
                const int t = (tid >> 7) + 4 * i;
                const float* wrow = p.gm_ws + ((size_t)g * 128 + t) * 128;
                float a = 0.f;
                for (int s = 0; s <= t; ++s) a += wrow[s] * vn[s * 128 + d];
                a += p.gm_bs[g * 128 + t];
                const float uu = bf2f(p.U[(row0 + t) * GMD + g * 128 + d]);
                p.OCAT[(row0 + t) * DM + QD + g * 128 + d] = f2bf(uu * a);
            }
        }
    }
    for (int it = blockIdx.x * 8 + wid; it < NS; it += gridDim.x * 8) {
        const size_t row = (size_t)MP + it;
        const u32x4 w = *(const u32x4*)(p.Vg + row * GMD + lane * 8);
        const float x[8] = {bflo(w.x), bfhi(w.x), bflo(w.y), bfhi(w.y), bflo(w.z), bfhi(w.z), bflo(w.w), bfhi(w.w)};
        float s = 0.f;
#pragma unroll
        for (int i = 0; i < 8; ++i) s += x[i];
        const float mean = wave_sum(s) * (1.0f / GMD);
        float q = 0.f;
#pragma unroll
        for (int i = 0; i < 8; ++i) q += (x[i] - mean) * (x[i] - mean);
        const float rs = rsqrtf(wave_sum(q) * (1.0f / GMD) + EPS);
#pragma unroll
        for (int i = 0; i < 8; ++i) {
            const int c = lane * 8 + i, g = c >> 7;
            const float v = (x[i] - mean) * rs * p.gm_ln_g[c] + p.gm_ln_b[c];
            p.out[O_GMV + (size_t)it * GMD + c] = v;
            const float a = p.gm_ws[(size_t)g * 128 * 128] * v + p.gm_bs[g * 128];
            p.OCAT[row * DM + QD + c] = f2bf(bf2f(p.U[row * GMD + c]) * a);
        }
    }
}

template <int MODE>
__device__ void phase_norm(const Params& p) {
    const int wid = threadIdx.x >> 6, lane = threadIdx.x & 63;
    const float* gpost = MODE == 0 ? p.ln_mix_post : MODE == 1 ? p.ln_ffn_post : p.ln_ple_post;
    for (int row = blockIdx.x * 8 + wid; row < MP + NS; row += gridDim.x * 8) {
        const float* fr = p.F + (size_t)row * DM;
        const float* xr = MODE == 0 ? xrow_ptr(p, row) : MODE == 1 ? p.X1 + (size_t)row * DM : p.X2 + (size_t)row * DM;
        f32x4 f[4], x[4];
#pragma unroll
        for (int k = 0; k < 4; ++k) { f[k] = *(const f32x4*)(fr + lane * 4 + k * 256); x[k] = *(const f32x4*)(xr + lane * 4 + k * 256); }
        const float r = row_rstd(f);
#pragma unroll
        for (int k = 0; k < 4; ++k) { const f32x4 g = *(const f32x4*)(gpost + lane * 4 + k * 256); x[k] = x[k] + f[k] * r * g; }
        if (MODE == 0) {
            const float r2 = row_rstd(x);
#pragma unroll
            for (int k = 0; k < 4; ++k) {
                *(f32x4*)(p.X1 + (size_t)row * DM + lane * 4 + k * 256) = x[k];
                const f32x4 g = *(const f32x4*)(p.ln_ffn_pre + lane * 4 + k * 256); const f32x4 o = x[k] * r2 * g;
                st_bf16x4(p.H2 + (size_t)row * DM + lane * 4 + k * 256, o);
            }
        } else if (MODE == 1) {
#pragma unroll
            for (int k = 0; k < 4; ++k) { *(f32x4*)(p.X2 + (size_t)row * DM + lane * 4 + k * 256) = x[k]; st_bf16x4(p.X2b + (size_t)row * DM + lane * 4 + k * 256, x[k]); }
        } else {
            float* yr = row < MP ? p.out + O_YP + (size_t)row * DM : p.out + O_YS + (size_t)(row - MP) * DM;
#pragma unroll
            for (int k = 0; k < 4; ++k) *(f32x4*)(yr + lane * 4 + k * 256) = x[k];
        }
    }
}


#define XB_TMO      128
#define XB_XCNT(j)  (256  + 64 * (j))
#define XB_XSUB(j)  (1280 + 64 * (j))
#define XB_XGEN(j)  (2304 + 64 * (j))
#define XB_TOP      3328
#define XB_TOPGEN   3392
#define XCD_BAR_WORDS 3456
#define XB_SPIN_CAP (1u << 22)

__device__ __forceinline__ unsigned xb_ld(unsigned* p)              { return __hip_atomic_load(p, __ATOMIC_RELAXED, __HIP_MEMORY_SCOPE_AGENT); }
__device__ __forceinline__ unsigned xb_add(unsigned* p, unsigned v) { return __hip_atomic_fetch_add(p, v, __ATOMIC_RELAXED, __HIP_MEMORY_SCOPE_AGENT); }
__device__ __forceinline__ unsigned xb_xcc_id() { return (unsigned)__builtin_amdgcn_s_getreg((3 << 11) | 20) & 0xFu; }
#define XB_SPIN(cond, bar) do { unsigned _sp = 0; while (cond) { __builtin_amdgcn_s_sleep(1); \
    if ((++_sp & 255u) == 0u) { if (xb_ld(&(bar)[XB_TMO])) break; if (_sp > XB_SPIN_CAP) { atomicAdd(&(bar)[XB_TMO], 1u); break; } } } } while (0)

struct XcdBarrier {
    unsigned* bar; unsigned x;
    volatile LAS unsigned* st;
};

__device__ __forceinline__ XcdBarrier xcd_barrier_post(unsigned* bar, volatile LAS unsigned* st) {
    XcdBarrier b; b.bar = bar; b.x = xb_xcc_id(); b.st = st;
    if (threadIdx.x == 0) (void)xb_add(&bar[XB_XCNT(b.x)], 1u);
    return b;
}
__device__ __forceinline__ void xcd_barrier_complete(unsigned* bar, unsigned x, unsigned& nloc, unsigned& nx) {
    const unsigned G = gridDim.x * gridDim.y * gridDim.z;
    unsigned sum, cnt, mine, sp = 0u;
    for (;;) {
        sum = 0u; cnt = 0u; mine = 0u;
#pragma unroll
        for (unsigned j = 0; j < 16; ++j) { const unsigned c = xb_ld(&bar[XB_XCNT(j)]); sum += c; cnt += (c > 0u) ? 1u : 0u; mine = (j == x) ? c : mine; }
        if (sum == G) break;
        __builtin_amdgcn_s_sleep(1);
        if ((++sp & 255u) == 0u) { if (xb_ld(&bar[XB_TMO])) break; if (sp > XB_SPIN_CAP) { atomicAdd(&bar[XB_TMO], 1u); break; } }
    }
    nloc = mine > 0u ? mine : 1u; nx = cnt > 0u ? cnt : 1u;
}

__device__ __forceinline__ void xcd_barrier(const XcdBarrier& b) {
    asm volatile("s_waitcnt vmcnt(0)" ::: "memory");
    __syncthreads();
    if (threadIdx.x == 0) {
        unsigned* bar = b.bar;
        __builtin_amdgcn_s_waitcnt(0);
        unsigned nloc = b.st[0], nx = b.st[1];
        if (nloc == 0u) { xcd_barrier_complete(bar, b.x, nloc, nx); b.st[0] = nloc; b.st[1] = nx; }
        const unsigned old = xb_add(&bar[XB_XSUB(b.x)], 1u);
        const unsigned gen = old / nloc;
        if (old + 1u == (gen + 1u) * nloc) {
            __builtin_amdgcn_fence(__ATOMIC_RELEASE, "agent");
            asm volatile("s_waitcnt vmcnt(0)" ::: "memory");
            const unsigned og = xb_add(&bar[XB_TOP], 1u);
            const unsigned tg = og / nx;
            if (og + 1u == (tg + 1u) * nx) xb_add(&bar[XB_TOPGEN], 1u);
            else XB_SPIN(xb_ld(&bar[XB_TOPGEN]) == tg, bar);
            __builtin_amdgcn_fence(__ATOMIC_ACQUIRE, "agent");
            xb_add(&bar[XB_XGEN(b.x)], 1u);
            asm volatile("s_waitcnt vmcnt(0)" ::: "memory");
        } else {
            XB_SPIN(xb_ld(&bar[XB_XGEN(b.x)]) == gen, bar);
            __builtin_amdgcn_fence(__ATOMIC_ACQUIRE, "agent");
            asm volatile("s_waitcnt vmcnt(0)" ::: "memory");
        }
    }
    __syncthreads();
}

constexpr int NPHASE = 16;
constexpr int LDS_BYTES = GEMM_LDS;
static_assert(ATT_LDS <= LDS_BYTES && GM_LDS <= LDS_BYTES, "lds");
constexpr int NMT = MALL / BM;

template <int PH>
__device__ __forceinline__ void run_phase(const Params& p) {
    if (PH == 0) phase_prologue(p);
    if (PH == 1) { EpiIn e{p}; gemm_phase(p.H, DM, p.WinT, DM, NMT, INP / BM, e); }
    if (PH == 2) phase_cmp_parts(p);
    if (PH == 3) phase_cmp_final(p);
    if (PH == 4) phase_attn(p);
    if (PH == 5) phase_gmlp(p);
    if (PH == 6) { EpiBrA e{p.GA, p.T}; gemm_phase(p.OCAT, DM, p.WnT, QD, NMT, DM / BM, e); }
    if (PH == 7) { EpiBrB e{p.GB, p.T, p.Y1}; gemm_phase(p.OCAT + QD, DM, p.WgT, GMD, NMT, DM / BM, e); }
    if (PH == 8) { EpiF32 e{p.F, DM}; gemm_phase(p.Y1, DM, p.WoT, DM, NMT, DM / BM, e); }
    if (PH == 9) phase_norm<0>(p);
    if (PH == 10) { EpiSwiGLU e{p.ACT}; gemm_phase(p.H2, DM, p.WguT, DM, NMT, 2 * DFF / BM, e); }
    if (PH == 11) { EpiF32 e{p.F, DM}; gemm_phase(p.ACT, DFF, p.WdT, DFF, NMT, DM / BM, e); }
    if (PH == 12) phase_norm<1>(p);
    if (PH == 13) { EpiF32 e{p.T, DM}; gemm_phase(p.Pb, PLE, p.WpT, PLE, NMT, DM / BM, e); }
    if (PH == 14) { EpiPleGate e{p.T, p.F}; gemm_phase(p.X2b, DM, p.WpgT, DM, NMT, DM / BM, e); }
    if (PH == 15) phase_norm<2>(p);
}

#ifndef MK_MULTI
#define MK_MULTI 0
#endif
template <int PH>
__global__ void __launch_bounds__(512, 2) k_phase(Params p) { run_phase<PH>(p); }

__global__ void __launch_bounds__(512, 2) k_all(Params p) {
    volatile LAS unsigned* st = (volatile LAS unsigned*)((LAS unsigned char*)smem + LDS_BYTES);
    if (threadIdx.x < 4) st[threadIdx.x] = 0u;
    __syncthreads();
    XcdBarrier bar = xcd_barrier_post(p.bar, st);
    run_phase<0>(p);  xcd_barrier(bar);
    run_phase<1>(p);  xcd_barrier(bar);
    run_phase<2>(p);  xcd_barrier(bar);
    run_phase<3>(p);  xcd_barrier(bar);
    run_phase<4>(p);
    run_phase<5>(p);  xcd_barrier(bar);
    run_phase<6>(p);  xcd_barrier(bar);
    run_phase<7>(p);  xcd_barrier(bar);
    run_phase<8>(p);  xcd_barrier(bar);
    run_phase<9>(p);  xcd_barrier(bar);
    run_phase<10>(p); xcd_barrier(bar);
    run_phase<11>(p); xcd_barrier(bar);
    run_phase<12>(p);
    run_phase<13>(p); xcd_barrier(bar);
    run_phase<14>(p); xcd_barrier(bar);
    run_phase<15>(p);
}

static inline size_t al256(size_t x) { return (x + 255) & ~(size_t)255; }
template <int PH> static void launch_phase(const Params& p, int grid, hipStream_t s) {
    static bool attr = false;
    if (!attr) { (void)hipFuncSetAttribute((const void*)k_phase<PH>, hipFuncAttributeMaxDynamicSharedMemorySize, LDS_BYTES); attr = true; }
    k_phase<PH><<<grid, 512, LDS_BYTES, s>>>(p);
}
template <int PH> static void launch_all(const Params& p, int grid, hipStream_t s) {
    launch_phase<PH>(p, grid, s);
    if constexpr (PH + 1 < NPHASE) launch_all<PH + 1>(p, grid, s);
}

extern "C" void kernel_launch(void* const* d_in, const int* in_sizes, int n_in, void* d_out, int out_size, void* d_ws, size_t ws_size, hipStream_t stream) {
    Params p{};
    p.x_prompt = (const float*)d_in[0]; p.x_sample = (const float*)d_in[1]; p.cache_cmp = (const float*)d_in[2]; p.cache_slc = (const float*)d_in[3];
    p.state_win = (const float*)d_in[4]; p.page_table = (const int*)d_in[5]; p.p_prompt = (const float*)d_in[6]; p.p_sample = (const float*)d_in[7];
    p.rel_bias = (const float*)d_in[8]; p.ln_mix_pre = (const float*)d_in[9]; p.w_in = (const float*)d_in[10];
    p.pe_k = (const float*)d_in[11]; p.w1_k = (const float*)d_in[12]; p.w2_k = (const float*)d_in[13];
    p.pe_v = (const float*)d_in[14]; p.w1_v = (const float*)d_in[15]; p.w2_v = (const float*)d_in[16];
    p.gm_ln_g = (const float*)d_in[17]; p.gm_ln_b = (const float*)d_in[18]; p.gm_ws = (const float*)d_in[19]; p.gm_bs = (const float*)d_in[20];
    p.w_br_nsa = (const float*)d_in[21]; p.w_br_gm = (const float*)d_in[22]; p.w_out = (const float*)d_in[23];
    p.ln_mix_post = (const float*)d_in[24]; p.ln_ffn_pre = (const float*)d_in[25]; p.w_gate = (const float*)d_in[26]; p.w_up = (const float*)d_in[27];
    p.w_down = (const float*)d_in[28]; p.ln_ffn_post = (const float*)d_in[29]; p.w_ple = (const float*)d_in[30]; p.w_ple_gate = (const float*)d_in[31];
    p.ln_ple_post = (const float*)d_in[32];
    p.out = (float*)d_out;
    unsigned char* w = (unsigned char*)d_ws; size_t off = 0;
    auto take = [&](size_t bytes) { void* r = w + off; off = al256(off + bytes); return r; };
    p.bar = (unsigned*)take(16384);
    p.WinT = (bf16_t*)take((size_t)INP * DM * 2); p.WnT = (bf16_t*)take((size_t)DM * QD * 2); p.WgT = (bf16_t*)take((size_t)DM * GMD * 2);
    p.WoT = (bf16_t*)take((size_t)DM * DM * 2); p.WguT = (bf16_t*)take((size_t)2 * DFF * DM * 2); p.WdT = (bf16_t*)take((size_t)DM * DFF * 2);
    p.WpgT = (bf16_t*)take((size_t)DM * DM * 2); p.WpT = (bf16_t*)take((size_t)DM * PLE * 2);
    p.H = (bf16_t*)take((size_t)MALL * DM * 2); p.Qb = (bf16_t*)take((size_t)MALL * QD * 2);
    p.CMPb = (bf16_t*)take((size_t)MALL * 256 * 2); p.SLCb = (bf16_t*)take((size_t)MALL * 256 * 2); p.WINb = (bf16_t*)take((size_t)MALL * 256 * 2);
    p.U = (bf16_t*)take((size_t)MALL * GMD * 2); p.Vg = (bf16_t*)take((size_t)MALL * GMD * 2);
    p.GA = (bf16_t*)take((size_t)MALL * DM * 2); p.GB = (bf16_t*)take((size_t)MALL * DM * 2);
    p.GATE = (float*)take((size_t)MALL * 32 * 4);
    p.PARTP = (float*)take((size_t)NB * 512 * 4 * 256 * 4); p.PARTS = (float*)take((size_t)NS * 1024 * 4 * 256 * 4); p.PEB = (float*)take(256 * 4);
    p.KCP = (float*)take((size_t)NB * NG * 512 * 64 * 4); p.VCP = (float*)take((size_t)NB * NG * 512 * 64 * 4);
    p.KCS = (float*)take((size_t)NS * NG * 1024 * 64 * 4); p.VCS = (float*)take((size_t)NS * NG * 1024 * 64 * 4);
    p.OCAT = (bf16_t*)take((size_t)MALL * DM * 2); p.T = (float*)take((size_t)MALL * DM * 4); p.Y1 = (bf16_t*)take((size_t)MALL * DM * 2);
    p.F = (float*)take((size_t)MALL * DM * 4); p.X1 = (float*)take((size_t)MALL * DM * 4); p.H2 = (bf16_t*)take((size_t)MALL * DM * 2);
    p.ACT = (bf16_t*)take((size_t)MALL * DFF * 2); p.X2 = (float*)take((size_t)MALL * DM * 4); p.X2b = (bf16_t*)take((size_t)MALL * DM * 2);
    p.Pb = (bf16_t*)take((size_t)MALL * PLE * 2);
    if (off > ws_size) { fprintf(stderr, "workspace too small: need %zu have %zu\n", off, ws_size); return; }
    (void)hipMemsetAsync(p.OCAT + (size_t)(MP + NS) * DM, 0, (size_t)(MALL - MP - NS) * DM * 2, stream);
#if MK_MULTI
    launch_all<0>(p, 256, stream);
#else
    constexpr size_t kDynLds = LDS_BYTES + 16;
    static int grid = 0;
    if (!grid) {
        int dev = 0, cus = 0, per_cu = 0;
        (void)hipGetDevice(&dev);
        (void)hipDeviceGetAttribute(&cus, hipDeviceAttributeMultiprocessorCount, dev);
        (void)hipFuncSetAttribute((const void*)k_all, hipFuncAttributeMaxDynamicSharedMemorySize, (int)kDynLds);
        (void)hipOccupancyMaxActiveBlocksPerMultiprocessor(&per_cu, (const void*)k_all, 512, kDynLds);
        grid = cus * (per_cu < 1 ? per_cu : 1);
        if (grid <= 0) { fprintf(stderr, "k_all: occupancy query says %d blocks per CU\n", per_cu); grid = 0; return; }
    }
    (void)hipMemsetAsync(p.bar, 0, XCD_BAR_WORDS * sizeof(unsigned), stream);
    k_all<<<grid, 512, kDynLds, stream>>>(p);
#endif
}
```

```cpp
#include <hip/hip_runtime.h>
#include <stdint.h>
#include <cstdio>

typedef unsigned short bf16_t;
typedef short bf16x8 __attribute__((ext_vector_type(8)));
typedef float f32x4 __attribute__((ext_vector_type(4)));
typedef float f32x2 __attribute__((ext_vector_type(2)));
typedef unsigned u32x4 __attribute__((ext_vector_type(4)));
typedef unsigned u32x2 __attribute__((ext_vector_type(2)));
#define LAS __attribute__((address_space(3)))

constexpr int DM = 1024, NB = 4, SEQ = 8192, MP = NB * SEQ, NS = 32, MALL = MP + 256, PAST = 16384, PAGE = 128, NPG = 128;
constexpr int NH = 8, NG = 2, HPG = 4, DH = 64, QD = 512, WIN = 512, GMD = 512, DFF = 2816, PLE = 256, IND = 4376, INP = 4608;
constexpr int NCP = 511, NCS = 1023;
constexpr float EPS = 1e-6f;
constexpr long O_YP = 0, O_YS = 33554432, O_CMPP = 33587200, O_SLCP = 41975808, O_WINP = 50364416, O_CMPS = 50888704,
               O_SLCS = 50896896, O_WINS = 50905088, O_GMV = 55099392;

struct Params {
    const float *x_prompt, *x_sample, *cache_cmp, *cache_slc, *state_win; const int* page_table;
    const float *p_prompt, *p_sample, *rel_bias, *ln_mix_pre, *w_in, *pe_k, *w1_k, *w2_k, *pe_v, *w1_v, *w2_v;
    const float *gm_ln_g, *gm_ln_b, *gm_ws, *gm_bs, *w_br_nsa, *w_br_gm, *w_out, *ln_mix_post, *ln_ffn_pre;
    const float *w_gate, *w_up, *w_down, *ln_ffn_post, *w_ple, *w_ple_gate, *ln_ple_post;
    float* out;
    unsigned* bar;
    bf16_t *WinT, *WnT, *WgT, *WoT, *WguT, *WdT, *WpgT, *WpT, *W1T;
    bf16_t *H, *Qb, *CMPb, *SLCb, *WINb, *U, *Vg, *GA, *GB;
    float* GATE;
    float *PART, *PEB, *KCP, *VCP, *KCS, *VCS;
    bf16_t* OCAT; float* T; bf16_t* Y1; float* F; float* X1; bf16_t* H2; bf16_t* ACT; float* X2; bf16_t* X2b; bf16_t* Pb;
};

__device__ __forceinline__ unsigned cvt_pk_bf16(float lo, float hi) { unsigned r; asm volatile("v_cvt_pk_bf16_f32 %0, %1, %2" : "=v"(r) : "v"(lo), "v"(hi)); return r; }
__device__ __forceinline__ bf16_t f2bf(float f) { return (bf16_t)(cvt_pk_bf16(f, 0.f) & 0xffffu); }
__device__ __forceinline__ float bf2f(bf16_t h) { return __uint_as_float(((unsigned)h) << 16); }
__device__ __forceinline__ float bflo(unsigned w) { return __uint_as_float(w << 16); }
__device__ __forceinline__ float bfhi(unsigned w) { return __uint_as_float(w & 0xffff0000u); }
__device__ __forceinline__ float sigmoidf_(float x) { return 1.0f / (1.0f + __expf(-x)); }
__device__ __forceinline__ float siluf_(float x) { return x * sigmoidf_(x); }
__device__ __forceinline__ float geluf_(float x) {
    const float u = 0.7978845608028654f * (x + 0.044715f * x * x * x);
    const float e = __expf(2.0f * u);
    const float th = 1.0f - 2.0f / (e + 1.0f);
    return 0.5f * x * (1.0f + th);
}
__device__ __forceinline__ float wave_sum(float v) {
#pragma unroll
    for (int o = 32; o > 0; o >>= 1) v += __shfl_xor(v, o);
    return v;
}
__device__ __forceinline__ float wave_max(float v) {
#pragma unroll
    for (int o = 32; o > 0; o >>= 1) v = fmaxf(v, __shfl_xor(v, o));
    return v;
}
__device__ __forceinline__ int t5_bucket(int d) {
    if (d < 16) return d;
    if (d >= 128) return 31;
    const int b = 16 + (int)(__logf((float)d * (1.0f / 16.0f)) * (16.0f / 2.0794415416798357f));
    return b < 31 ? b : 31;
}

extern __shared__ __attribute__((aligned(16))) unsigned char smem[];

constexpr int BM = 256, BK = 64, HALF = 128, HT = HALF * BK, GEMM_LDS = 8 * HT * 2;
__device__ __forceinline__ int lds_byte(int r, int c) { const int st = (r >> 4) * 2 + (c >> 5), rr = r & 15, cc = c & 31, ob = rr * 64 + cc * 2; return st * 1024 + (ob ^ (((ob >> 9) & 1) << 5)); }
__device__ __forceinline__ void stage_rc(int b, int& R, int& C) { const int st = b / 1024, sb = b % 1024, swz = sb ^ (((sb >> 9) & 1) << 5); R = (st >> 1) * 16 + swz / 64; C = (st & 1) * 32 + (swz % 64) / 2; }

constexpr int HTB = HALF * BK * 2;
template <class F>
__device__ __forceinline__ void for_each_frag(const f32x4 (&acc)[2][2][4][2], int brow, int bcol, int wr, int wc, int fr, int fq, F&& f) {
#pragma unroll
    for (int ai = 0; ai < 2; ++ai)
#pragma unroll
        for (int m = 0; m < 4; ++m)
#pragma unroll
            for (int bj = 0; bj < 2; ++bj)
#pragma unroll
                for (int n = 0; n < 2; ++n)
                    f(brow + ai * HALF + wr * 64 + m * 16 + fr, bcol + bj * HALF + wc * 32 + n * 16 + fq * 4, acc[ai][bj][m][n]);
}

struct ZNone { __device__ __forceinline__ size_t a(int) const { return 0; } __device__ __forceinline__ size_t b(int) const { return 0; } };
template <class Epi, class ZMap = ZNone>
__device__ __forceinline__ void gemm_phase(const bf16_t* A, int lda, const bf16_t* Bt, int K, int nM, int nN, const Epi& E, int nZ = 1, ZMap zm = ZMap(), int kstepA_el = BK) {
    LAS unsigned char* lds = (LAS unsigned char*)smem;
    const int tid = threadIdx.x, wid = __builtin_amdgcn_readfirstlane(tid >> 6), lane = tid & 63, wr = wid >> 2, wc = wid & 3, fr = lane & 15, fq = lane >> 4;
    const int nt = K / BK, nmn = nM * nN, nu = nmn * nZ, G = gridDim.x;
    int u = blockIdx.x;
    if (u >= nu) return;
    unsigned voffA[2], voffB[2];
#pragma unroll
    for (int i = 0; i < 2; ++i) { int R, C; stage_rc(tid * 16 + i * 8192, R, C); voffA[i] = (unsigned)(R * lda + C) * 2u; voffB[i] = (unsigned)(R * K + C) * 2u; }
    const size_t kstep = (size_t)(BK * 2), kstepA = (size_t)kstepA_el * 2;
    const size_t hstepA = (size_t)HALF * lda * 2, hstepB = (size_t)HALF * K * 2, tstepA = 2 * hstepA, tstepB = 2 * hstepB;
    const unsigned ldsw = (unsigned)wid * 1024u;
    const int aoff = lds_byte(wr * 64 + fr, fq * 8), boff = lds_byte(wc * 32 + fr, fq * 8);
#define PG8_SA(b, h) (((b) * 2 + (h)) * HTB)
#define PG8_SB(b, h) ((4 + (b) * 2 + (h)) * HTB)
#define PG8_STAGE(bufoff, gbase, voff) do { _Pragma("unroll") for (int _i = 0; _i < 2; ++_i) \
        __builtin_amdgcn_global_load_lds((const unsigned*)((const char*)(gbase) + (voff)[_i]), (LAS unsigned*)(lds + (bufoff) + ldsw + _i * 8192), 16, 0, 0); } while (0)
#define PG8_LDA(dst, b, h) do { _Pragma("unroll") for (int m = 0; m < 4; ++m) _Pragma("unroll") for (int k = 0; k < 2; ++k) dst[m][k] = *(const LAS bf16x8*)(lds + PG8_SA(b, h) + aoff + m * 2048 + k * 1024); } while (0)
#define PG8_LDB(dst, b, h) do { _Pragma("unroll") for (int n = 0; n < 2; ++n) _Pragma("unroll") for (int k = 0; k < 2; ++k) dst[n][k] = *(const LAS bf16x8*)(lds + PG8_SB(b, h) + boff + n * 2048 + k * 1024); } while (0)
#define PG8_MMA(ai, bj, At, Bt_) do { __builtin_amdgcn_s_setprio(1); _Pragma("unroll") for (int m = 0; m < 4; ++m) _Pragma("unroll") for (int n = 0; n < 2; ++n) _Pragma("unroll") for (int k = 0; k < 2; ++k) \
        acc[ai][bj][m][n] = __builtin_amdgcn_mfma_f32_16x16x32_bf16(Bt_[n][k], At[m][k], acc[ai][bj][m][n], 0, 0, 0); __builtin_amdgcn_s_setprio(0); } while (0)
#define PG8_WAIT_V(n) asm volatile("s_waitcnt vmcnt(" #n ")" ::: "memory")
#define PG8_WAIT_L(n) asm volatile("s_waitcnt lgkmcnt(" #n ")" ::: "memory")
#define PG8_BAR __builtin_amdgcn_s_barrier()
#define PG8_SCHED __builtin_amdgcn_sched_barrier(0)
    f32x4 acc[2][2][4][2];
#pragma unroll
    for (int a = 0; a < 2; ++a)
#pragma unroll
        for (int b = 0; b < 2; ++b)
#pragma unroll
            for (int m = 0; m < 4; ++m)
#pragma unroll
                for (int n = 0; n < 2; ++n) acc[a][b][m][n] = (f32x4){0.f, 0.f, 0.f, 0.f};
    bf16x8 At[4][2], B0[2][2], B1[2][2];
    int z = u / nmn, pm = (u - z * nmn) / nN, pn = (u - z * nmn) - pm * nN;
    const char* cA = (const char*)(A + zm.a(z)) + (size_t)pm * tstepA; const char* cB = (const char*)(Bt + zm.b(z)) + (size_t)pn * tstepB;
    PG8_STAGE(PG8_SB(0, 0), cB, voffB); PG8_STAGE(PG8_SA(0, 0), cA, voffA); PG8_STAGE(PG8_SB(0, 1), cB + hstepB, voffB); PG8_STAGE(PG8_SA(0, 1), cA + hstepA, voffA);
    if (wr == 1) PG8_BAR;
    PG8_WAIT_V(4); PG8_BAR;
    PG8_STAGE(PG8_SB(1, 0), cB + kstep, voffB); PG8_STAGE(PG8_SA(1, 0), cA + kstepA, voffA); PG8_STAGE(PG8_SB(1, 1), cB + hstepB + kstep, voffB);
    PG8_WAIT_V(6); PG8_BAR;
    for (;;) {
        const int un = u + G; const bool has_next = un < nu;
        const int nz = has_next ? un / nmn : z, npm = has_next ? (un - nz * nmn) / nN : pm, npn = has_next ? (un - nz * nmn) - npm * nN : pn;
        const char* nA = (const char*)(A + zm.a(nz)) + (size_t)npm * tstepA; const char* nB = (const char*)(Bt + zm.b(nz)) + (size_t)npn * tstepB;
        for (int t = 0; t < nt; t += 2) {
            const bool last = (t == nt - 2);
            const char* a1 = cA + (size_t)(t + 1) * kstepA;
            const char* a2 = last ? nA : cA + (size_t)(t + 2) * kstepA; const char* b2 = last ? nB : cB + (size_t)(t + 2) * kstep;
            const char* a3 = a2 + kstepA; const char* b3 = b2 + kstep;
            PG8_LDB(B0, 0, 0); PG8_SCHED; PG8_LDA(At, 0, 0); PG8_STAGE(PG8_SA(1, 1), a1 + hstepA, voffA);
            PG8_WAIT_L(8); PG8_BAR; PG8_WAIT_L(0); PG8_MMA(0, 0, At, B0); PG8_BAR; PG8_SCHED;
            PG8_LDB(B1, 0, 1); PG8_STAGE(PG8_SB(0, 0), b2, voffB);
            PG8_BAR; PG8_WAIT_L(0); PG8_MMA(0, 1, At, B1); PG8_BAR;
            PG8_LDA(At, 0, 1); PG8_STAGE(PG8_SA(0, 0), a2, voffA);
            PG8_BAR; PG8_WAIT_L(0); PG8_MMA(1, 0, At, B0); PG8_BAR; PG8_SCHED;
            PG8_STAGE(PG8_SB(0, 1), b2 + hstepB, voffB);
            PG8_WAIT_V(6); PG8_BAR; PG8_MMA(1, 1, At, B1); PG8_BAR;
            PG8_LDB(B0, 1, 0); PG8_SCHED; PG8_LDA(At, 1, 0); PG8_STAGE(PG8_SA(0, 1), a2 + hstepA, voffA);
            PG8_WAIT_L(8); PG8_BAR; PG8_WAIT_L(0); PG8_MMA(0, 0, At, B0); PG8_BAR; PG8_SCHED;
            PG8_LDB(B1, 1, 1); PG8_STAGE(PG8_SB(1, 0), b3, voffB);
            PG8_BAR; PG8_WAIT_L(0); PG8_MMA(0, 1, At, B1); PG8_BAR;
            PG8_LDA(At, 1, 1); PG8_STAGE(PG8_SA(1, 0), a3, voffA);
            PG8_BAR; PG8_WAIT_L(0); PG8_MMA(1, 0, At, B0); PG8_BAR; PG8_SCHED;
            PG8_STAGE(PG8_SB(1, 1), b3 + hstepB, voffB);
            PG8_WAIT_V(6); PG8_BAR; PG8_MMA(1, 1, At, B1); PG8_BAR;
        }
        E(acc, pm * BM, pn * BM + (z << 20), wr, wc, fr, fq);
        if (!has_next) break;
#pragma unroll
        for (int a = 0; a < 2; ++a)
#pragma unroll
            for (int b = 0; b < 2; ++b)
#pragma unroll
                for (int m = 0; m < 4; ++m)
#pragma unroll
                    for (int n = 0; n < 2; ++n) acc[a][b][m][n] = (f32x4){0.f, 0.f, 0.f, 0.f};
        u = un; z = nz; pm = npm; pn = npn; cA = nA; cB = nB;
    }
    PG8_WAIT_V(0);
    if (wr == 0) PG8_BAR;
    PG8_BAR;
#undef PG8_SA
#undef PG8_SB
#undef PG8_STAGE
#undef PG8_LDA
#undef PG8_LDB
#undef PG8_MMA
#undef PG8_WAIT_V
#undef PG8_WAIT_L
#undef PG8_BAR
#undef PG8_SCHED
}

__device__ __forceinline__ void st_bf16x4(bf16_t* p, f32x4 v) { u32x2 w; w.x = cvt_pk_bf16(v[0], v[1]); w.y = cvt_pk_bf16(v[2], v[3]); *(u32x2*)p = w; }

struct EpiIn {
    const Params& p;
    __device__ __forceinline__ void operator()(const f32x4 (&acc)[2][2][4][2], int brow, int bcol, int wr, int wc, int fr, int fq) const {
        const int pn = bcol >> 8;
        const Params& P = p;
        if (pn < 2) {
            for_each_frag(acc, brow, bcol, wr, wc, fr, fq, [&](int row, int col, f32x4 v) { st_bf16x4(P.Qb + (size_t)row * QD + col, v * 0.125f); });
        } else if (pn < 5) {
            bf16_t* cp = pn == 2 ? P.CMPb : pn == 3 ? P.SLCb : P.WINb;
            for_each_frag(acc, brow, bcol, wr, wc, fr, fq, [&](int row, int col, f32x4 v) {
                const int c = col & 255;
                if (pn != 2 || row < MP) st_bf16x4(cp + (size_t)row * 256 + c, v);
                if (pn < 4) {
                    if (row < MP) *(f32x4*)(P.out + (pn == 2 ? O_CMPP : O_SLCP) + (size_t)row * 256 + c) = v;
                    else if (row < MP + NS) *(f32x4*)(P.out + (pn == 2 ? O_CMPS : O_SLCS) + (size_t)(row - MP) * 256 + c) = v;
                } else {
                    if (row < MP) { const int t = row & (SEQ - 1), b = row >> 13; if (t >= SEQ - WIN) *(f32x4*)(P.out + O_WINP + ((size_t)b * WIN + (t - (SEQ - WIN))) * 256 + c) = v; }
                    else if (row < MP + NS) *(f32x4*)(P.out + O_WINS + ((size_t)(row - MP) * WIN + (WIN - 1)) * 256 + c) = v;
                }
            });
        } else if (pn < 9) {
            bf16_t* dst = pn < 7 ? P.U : P.Vg; const int c0 = pn < 7 ? 1280 : 1792;
            for_each_frag(acc, brow, bcol, wr, wc, fr, fq, [&](int row, int col, f32x4 v) {
                f32x4 g; g[0] = geluf_(v[0]); g[1] = geluf_(v[1]); g[2] = geluf_(v[2]); g[3] = geluf_(v[3]);
                st_bf16x4(dst + (size_t)row * GMD + (col - c0), g); });
        } else if (pn < 17) {
            bf16_t* dst = pn < 13 ? P.GA : P.GB; const int c0 = pn < 13 ? 2304 : 3328;
            for_each_frag(acc, brow, bcol, wr, wc, fr, fq, [&](int row, int col, f32x4 v) {
                f32x4 g; g[0] = sigmoidf_(v[0]); g[1] = sigmoidf_(v[1]); g[2] = sigmoidf_(v[2]); g[3] = sigmoidf_(v[3]);
                st_bf16x4(dst + (size_t)row * DM + (col - c0), g); });
        } else {
            for_each_frag(acc, brow, bcol, wr, wc, fr, fq, [&](int row, int col, f32x4 v) {
                const int c = col & 255;
                if (c < 24) { f32x4 g; g[0] = sigmoidf_(v[0]); g[1] = sigmoidf_(v[1]); g[2] = sigmoidf_(v[2]); g[3] = sigmoidf_(v[3]); *(f32x4*)(P.GATE + (size_t)row * 32 + c) = g; } });
        }
    }
};
struct EpiBrA {
    const bf16_t* GA; float* T;
    __device__ __forceinline__ void operator()(const f32x4 (&acc)[2][2][4][2], int brow, int bcol, int wr, int wc, int fr, int fq) const {
        for_each_frag(acc, brow, bcol, wr, wc, fr, fq, [&](int row, int col, f32x4 v) {
            const u32x2 g = *(const u32x2*)(GA + (size_t)row * DM + col);
            f32x4 o; o[0] = v[0] * bflo(g.x); o[1] = v[1] * bfhi(g.x); o[2] = v[2] * bflo(g.y); o[3] = v[3] * bfhi(g.y);
            *(f32x4*)(T + (size_t)row * DM + col) = o; });
    }
};
struct EpiBrB {
    const bf16_t* GB; const float* T; bf16_t* Y1;
    __device__ __forceinline__ void operator()(const f32x4 (&acc)[2][2][4][2], int brow, int bcol, int wr, int wc, int fr, int fq) const {
        for_each_frag(acc, brow, bcol, wr, wc, fr, fq, [&](int row, int col, f32x4 v) {
            const u32x2 g = *(const u32x2*)(GB + (size_t)row * DM + col);
            const f32x4 t = *(const f32x4*)(T + (size_t)row * DM + col);
            f32x4 o; o[0] = t[0] + v[0] * bflo(g.x); o[1] = t[1] + v[1] * bfhi(g.x); o[2] = t[2] + v[2] * bflo(g.y); o[3] = t[3] + v[3] * bfhi(g.y);
            st_bf16x4(Y1 + (size_t)row * DM + col, o); });
    }
};
struct EpiF32 {
    float* F; int ld;
    __device__ __forceinline__ void operator()(const f32x4 (&acc)[2][2][4][2], int brow, int bcol, int wr, int wc, int fr, int fq) const {
        for_each_frag(acc, brow, bcol, wr, wc, fr, fq, [&](int row, int col, f32x4 v) { *(f32x4*)(F + (size_t)row * ld + col) = v; });
    }
};
struct EpiPart {
    float* PART;
    __device__ __forceinline__ void operator()(const f32x4 (&acc)[2][2][4][2], int brow, int bcol, int wr, int wc, int fr, int fq) const {
        const int z = bcol >> 20;
        for_each_frag(acc, brow, 0, wr, wc, fr, fq, [&](int row, int col, f32x4 v) { *(f32x4*)(PART + ((size_t)row * 4 + z) * 256 + col) = v; });
    }
};
struct ZCmp { __device__ __forceinline__ size_t a(int z) const { return (size_t)z * 64; } __device__ __forceinline__ size_t b(int z) const { return (size_t)(z >> 1) * 256 * 1024; } };
struct EpiSwiGLU {
    bf16_t* ACT;
    __device__ __forceinline__ void operator()(const f32x4 (&acc)[2][2][4][2], int brow, int bcol, int wr, int wc, int fr, int fq) const {
        for_each_frag(acc, brow, bcol, wr, wc, fr, fq, [&](int row, int col, f32x4 v) {
            *(unsigned*)(ACT + (size_t)row * DFF + (col >> 1)) = cvt_pk_bf16(siluf_(v[0]) * v[1], siluf_(v[2]) * v[3]); });
    }
};
struct EpiPleGate {
    const float* E; float* F;
    __device__ __forceinline__ void operator()(const f32x4 (&acc)[2][2][4][2], int brow, int bcol, int wr, int wc, int fr, int fq) const {
        for_each_frag(acc, brow, bcol, wr, wc, fr, fq, [&](int row, int col, f32x4 v) {
            const f32x4 e = *(const f32x4*)(E + (size_t)row * DM + col);
            f32x4 o; o[0] = sigmoidf_(v[0]) * e[0]; o[1] = sigmoidf_(v[1]) * e[1]; o[2] = sigmoidf_(v[2]) * e[2]; o[3] = sigmoidf_(v[3]) * e[3];
            *(f32x4*)(F + (size_t)row * DM + col) = o; });
    }
};

template <class Map>
__device__ __forceinline__ void transpose_tile(const float* W, int K, int N, bf16_t* Wt, int ldk, int kt, int ntile, Map map) {
    LAS float* tile = (LAS float*)smem;
    const int t = threadIdx.x;
    __syncthreads();
#pragma unroll
    for (int i = 0; i < 2; ++i) {
        const int k = (t >> 4) + 32 * i, n = (t & 15) * 4, gn = ntile * 64 + n;
        f32x4 v = (f32x4){0.f, 0.f, 0.f, 0.f};
        if (gn < N) v = *(const f32x4*)(W + (size_t)(kt * 64 + k) * N + gn);
        tile[k * 65 + n] = v[0]; tile[k * 65 + n + 1] = v[1]; tile[k * 65 + n + 2] = v[2]; tile[k * 65 + n + 3] = v[3];
    }
    __syncthreads();
    const int n = t >> 3, kc = (t & 7) * 8, gn = ntile * 64 + n;
    if (gn < N) {
        u32x4 w;
        w.x = cvt_pk_bf16(tile[(kc + 0) * 65 + n], tile[(kc + 1) * 65 + n]); w.y = cvt_pk_bf16(tile[(kc + 2) * 65 + n], tile[(kc + 3) * 65 + n]);
        w.z = cvt_pk_bf16(tile[(kc + 4) * 65 + n], tile[(kc + 5) * 65 + n]); w.w = cvt_pk_bf16(tile[(kc + 6) * 65 + n], tile[(kc + 7) * 65 + n]);
        *(u32x4*)(Wt + (size_t)map(gn) * ldk + kt * 64 + kc) = w;
    }
}
template <class Map>
__device__ __forceinline__ void transpose_all(const float* W, int K, int N, bf16_t* Wt, int ldk, Map map, int& base) {
    const int nkt = K / 64, nnt = (N + 63) / 64, ntl = nkt * nnt;
    for (int it = blockIdx.x; it < base + ntl; it += gridDim.x) {
        if (it < base) continue;
        const int l = it - base;
        transpose_tile(W, K, N, Wt, ldk, l / nnt, l % nnt, map);
    }
    base += ntl;
}
__device__ __forceinline__ int map_win(int n) {
    if (n < 1280) return n;
    if (n < 1304) return 4352 + (n - 1280);
    if (n < 2328) return 1280 + (n - 1304);
    return 2304 + (n - 2328);
}

__device__ __forceinline__ float row_rstd(const f32x4 (&v)[4]) {
    float s = 0.f;
#pragma unroll
    for (int k = 0; k < 4; ++k) s += v[k][0] * v[k][0] + v[k][1] * v[k][1] + v[k][2] * v[k][2] + v[k][3] * v[k][3];
    s = wave_sum(s);
    return rsqrtf(s * (1.0f / DM) + EPS);
}
__device__ __forceinline__ const float* xrow_ptr(const Params& p, int row) {
    return row < MP ? p.x_prompt + (size_t)row * DM : p.x_sample + (size_t)(row - MP) * DM;
}

__device__ void phase_prologue(const Params& p) {
    const int wid = threadIdx.x >> 6, lane = threadIdx.x & 63;
    const int gw = blockIdx.x * 8 + wid, nw = gridDim.x * 8;
    int base = 0;
    transpose_all(p.w_in, DM, IND, p.WinT, DM, [](int n) { return map_win(n); }, base);
    transpose_all(p.w_br_nsa, QD, DM, p.WnT, QD, [](int n) { return n; }, base);
    transpose_all(p.w_br_gm, GMD, DM, p.WgT, GMD, [](int n) { return n; }, base);
    transpose_all(p.w_out, DM, DM, p.WoT, DM, [](int n) { return n; }, base);
    transpose_all(p.w_gate, DM, DFF, p.WguT, DM, [](int n) { return 2 * n; }, base);
    transpose_all(p.w_up, DM, DFF, p.WguT, DM, [](int n) { return 2 * n + 1; }, base);
    transpose_all(p.w_down, DFF, DM, p.WdT, DFF, [](int n) { return n; }, base);
    transpose_all(p.w_ple_gate, DM, DM, p.WpgT, DM, [](int n) { return n; }, base);
    transpose_all(p.w_ple, PLE, DM, p.WpT, PLE, [](int n) { return n; }, base);
    for (int kv = 0; kv < 2; ++kv) for (int j = 0; j < 2; ++j)
        transpose_all((kv ? p.w1_v : p.w1_k) + (size_t)j * 1024 * 128, 1024, 128, p.W1T + ((size_t)kv * 256 + j * 128) * 1024, 1024, [](int n) { return n; }, base);
    __syncthreads();
    for (int i = blockIdx.x * 512 + threadIdx.x; i < (INP - IND) * DM / 8; i += gridDim.x * 512) ((u32x4*)(p.WinT + (size_t)IND * DM))[i] = (u32x4){0u, 0u, 0u, 0u};
    for (int row = gw; row < MALL; row += nw) {
        u32x2* hd = (u32x2*)(p.H + (size_t)row * DM);
        if (row < MP + NS) {
            const float* xr = xrow_ptr(p, row);
            f32x4 v[4];
#pragma unroll
            for (int k = 0; k < 4; ++k) v[k] = *(const f32x4*)(xr + lane * 4 + k * 256);
            const float r = row_rstd(v);
#pragma unroll
            for (int k = 0; k < 4; ++k) { const f32x4 g = *(const f32x4*)(p.ln_mix_pre + lane * 4 + k * 256); const f32x4 o = v[k] * r * g; u32x2 w; w.x = cvt_pk_bf16(o[0], o[1]); w.y = cvt_pk_bf16(o[2], o[3]); hd[lane + k * 64] = w; }
            const float* pr = row < MP ? p.p_prompt + (size_t)row * PLE : p.p_sample + (size_t)(row - MP) * PLE;
            const f32x4 pv = *(const f32x4*)(pr + lane * 4);
            u32x2 w; w.x = cvt_pk_bf16(pv[0], pv[1]); w.y = cvt_pk_bf16(pv[2], pv[3]);
            ((u32x2*)(p.Pb + (size_t)row * PLE))[lane] = w;
        } else {
#pragma unroll
            for (int k = 0; k < 4; ++k) hd[lane + k * 64] = (u32x2){0u, 0u};
            ((u32x2*)(p.Pb + (size_t)row * PLE))[lane] = (u32x2){0u, 0u};
        }
    }
    for (int r2 = gw; r2 < NS * PAST / 2; r2 += nw) {
        const int r = r2 * 2 + (lane >> 5), b = r >> 14, pos = r & (PAST - 1), l5 = lane & 31;
        const float* s = p.cache_cmp + ((size_t)p.page_table[b * NPG + (pos >> 7)] * PAGE + (pos & 127)) * 256 + l5 * 8;
        const f32x4 a = *(const f32x4*)s, c = *(const f32x4*)(s + 4);
        u32x4 w; w.x = cvt_pk_bf16(a[0], a[1]); w.y = cvt_pk_bf16(a[2], a[3]); w.z = cvt_pk_bf16(c[0], c[1]); w.w = cvt_pk_bf16(c[2], c[3]);
        *(u32x4*)(p.CMPb + ((size_t)MP + r) * 256 + l5 * 8) = w;
    }
    if (gw < 4) {
        const int kv = gw >> 1, h = (gw & 1) * 64 + lane;
        const float* pe = kv ? p.pe_v : p.pe_k; const float* w1 = kv ? p.w1_v : p.w1_k;
        float s = 0.f;
        for (int k = 0; k < 2048; ++k) s += pe[k] * w1[(size_t)k * 128 + h];
        p.PEB[kv * 128 + h] = s;
    }
    for (int i = blockIdx.x * 512 + threadIdx.x; i < NS * (WIN - 1) * 64; i += gridDim.x * 512) {
        const int b = i / ((WIN - 1) * 64), r = i % ((WIN - 1) * 64);
        ((f32x4*)(p.out + O_WINS + (size_t)b * WIN * 256))[r] = ((const f32x4*)(p.state_win + (size_t)b * WIN * 256 + 256))[r];
    }
}

__device__ void phase_cmp_final(const Params& p) {
    const int wid = threadIdx.x >> 6, lane = threadIdx.x & 63;
    LAS float* hb = (LAS float*)smem + wid * 128;
    const int nitem_p = NB * NCP * 4, nitem_s = NS * NCS * 4;
#pragma unroll 1
    for (int it = blockIdx.x * 8 + wid; it < nitem_p + nitem_s; it += gridDim.x * 8) {
        const bool smp = it >= nitem_p; const int l = smp ? it - nitem_p : it;
        const int z = l & 3, kv = z >> 1, g = z & 1, r = l >> 2;
        const int nc = smp ? NCS : NCP, seq = r / nc, n = r % nc;
        const size_t r0 = smp ? (size_t)2048 + (size_t)seq * 1024 + n : (size_t)seq * 512 + n;
        const float* p0 = p.PART + (r0 * 4 + z) * 256;
        const float* p1 = p.PART + ((r0 + 1) * 4 + z) * 256 + 128;
        const float* w2 = kv ? p.w2_v : p.w2_k;
#pragma unroll
        for (int i = 0; i < 2; ++i) { const int h = lane + 64 * i; hb[h] = siluf_(p0[h] + p1[h] + p.PEB[kv * 128 + h]); }
        __builtin_amdgcn_wave_barrier();
        float s = 0.f;
#pragma unroll 4
        for (int h = 0; h < 128; ++h) s += hb[h] * w2[h * 64 + lane];
        __builtin_amdgcn_wave_barrier();
        float* dst = smp ? (kv ? p.VCS : p.KCS) + (((size_t)seq * NG + g) * 1024 + n) * 64 : (kv ? p.VCP : p.KCP) + (((size_t)seq * NG + g) * 512 + n) * 64;
        dst[lane] = s;
    }
}

template <bool SAMPLE>
__device__ __forceinline__ void kv_row_ptr(const Params& p, int branch  , int b, int pos, int kv, int g, const bf16_t*& pb, const float*& pf) {
    const int off = kv * 128 + g * 64;
    if (!SAMPLE) { pf = nullptr; pb = (branch == 1 ? p.SLCb : p.WINb) + ((size_t)b * SEQ + pos) * 256 + off; }
    else if (pos >= PAST) { pf = nullptr; pb = (branch == 1 ? p.SLCb : p.WINb) + ((size_t)MP + b) * 256 + off; }
    else if (branch == 1) { pb = nullptr; pf = p.cache_slc + ((size_t)p.page_table[b * NPG + (pos >> 7)] * PAGE + (pos & 127)) * 256 + off; }
    else { pb = nullptr; pf = p.state_win + ((size_t)b * WIN + (pos - (PAST - WIN))) * 256 + off; }
}
__device__ __forceinline__ void dot4x64(const bf16_t* pb, const float* pf, const LAS float* qs_, float (&s)[4]) {
    s[0] = s[1] = s[2] = s[3] = 0.f;
    const LAS float* qs = qs_; asm volatile("" : "+v"(qs));
    if (pf) {
#pragma unroll 2
        for (int c = 0; c < 16; ++c) {
            const f32x4 kx = *(const f32x4*)(pf + c * 4);
#pragma unroll
            for (int h = 0; h < 4; ++h) { const f32x4 q = *(const LAS f32x4*)(qs + h * 64 + c * 4); s[h] += q[0] * kx[0] + q[1] * kx[1] + q[2] * kx[2] + q[3] * kx[3]; }
        }
    } else {
#pragma unroll 1
        for (int c = 0; c < 8; ++c) {
            const u32x4 w = *(const u32x4*)(pb + c * 8);
            const float k0 = bflo(w.x), k1 = bfhi(w.x), k2 = bflo(w.y), k3 = bfhi(w.y), k4 = bflo(w.z), k5 = bfhi(w.z), k6 = bflo(w.w), k7 = bfhi(w.w);
#pragma unroll
            for (int h = 0; h < 4; ++h) {
                const f32x4 qa = *(const LAS f32x4*)(qs + h * 64 + c * 8), qb = *(const LAS f32x4*)(qs + h * 64 + c * 8 + 4);
                s[h] += qa[0] * k0 + qa[1] * k1 + qa[2] * k2 + qa[3] * k3 + qb[0] * k4 + qb[1] * k5 + qb[2] * k6 + qb[3] * k7;
            }
        }
    }
}
template <bool SAMPLE>
__device__ __forceinline__ void attn_chunk(const Params& p, int branch, int b, int g, int t, int pos0, int lo, int hi,
                                           float (&m)[4], float (&l)[4], float (&o)[4], const LAS float* qs, LAS float* pbk, const LAS float* relb, int lane) {
    const int pos = pos0 + lane;
    const bool valid = pos >= lo && pos <= hi;
    float s[4] = {-1e30f, -1e30f, -1e30f, -1e30f};
    if (valid) {
        const bf16_t* pb; const float* pf; kv_row_ptr<SAMPLE>(p, branch, b, pos, 0, g, pb, pf);
        dot4x64(pb, pf, qs, s);
        const int bk = t5_bucket(t - pos);
#pragma unroll
        for (int h = 0; h < 4; ++h) s[h] += relb[bk * 8 + g * 4 + h];
    }
#pragma unroll
    for (int h = 0; h < 4; ++h) {
        const float mx = wave_max(s[h]);
        const float mn = fmaxf(m[h], mx);
        const float pr = valid ? __expf(s[h] - mn) : 0.f;
        const float sm = wave_sum(pr);
        const float al = __expf(m[h] - mn);
        l[h] = l[h] * al + sm; o[h] *= al; m[h] = mn;
        pbk[h * 64 + lane] = pr;
    }
    __builtin_amdgcn_wave_barrier();
    const int k0 = (lo > pos0 ? lo : pos0) - pos0, k1 = (hi < pos0 + 63 ? hi : pos0 + 63) - pos0;
#pragma unroll 1
    for (int k = k0; k <= k1; ++k) {
        const bf16_t* pb; const float* pf; kv_row_ptr<SAMPLE>(p, branch, b, pos0 + k, 1, g, pb, pf);
        const float v = pf ? pf[lane] : bf2f(pb[lane]);
#pragma unroll
        for (int h = 0; h < 4; ++h) o[h] += pbk[h * 64 + k] * v;
    }
    __builtin_amdgcn_wave_barrier();
}

constexpr int ATT_WAVE_LDS_P = 256 * 4 + 4 * 512 * 4 + (512 + 64) * 4 + 256 * 4 + 64;
constexpr int ATT_WAVE_LDS_S = 256 * 4 + 4 * 1024 * 4 + (1024 + 64) * 4 + 256 * 4 + 64;
constexpr int ATT_LDS = 1024 + (8 * ATT_WAVE_LDS_P > 4 * ATT_WAVE_LDS_S ? 8 * ATT_WAVE_LDS_P : 4 * ATT_WAVE_LDS_S);

template <bool SAMPLE>
__device__ __forceinline__ void attn_item(const Params& p, int row  , int b, int t, int g, const LAS float* relb, LAS unsigned char* wl, int lane) {
    constexpr int NCAP = SAMPLE ? 1024 : 512, NC = SAMPLE ? NCS : NCP, NSEL = SAMPLE ? 257 : 128, NJR = SAMPLE ? 5 : 2;
    LAS float* qs = (LAS float*)wl; LAS float* sl = qs + 256; LAS float* phs = sl + 4 * NCAP; LAS float* pbk = phs + NCAP + 64; LAS int* sel = (LAS int*)(pbk + 256);
    {
        const u32x2 w = *(const u32x2*)(p.Qb + (size_t)row * QD + g * 256 + lane * 4);
        qs[lane * 4 + 0] = bflo(w.x); qs[lane * 4 + 1] = bfhi(w.x); qs[lane * 4 + 2] = bflo(w.y); qs[lane * 4 + 3] = bfhi(w.y);
    }
    __builtin_amdgcn_wave_barrier();
    const int ncv = t >= 31 ? ((t - 31) >> 4) + 1 : 0;
    const int ncvc = ncv < NC ? ncv : NC;
    const float* kc = (SAMPLE ? p.KCS + ((size_t)b * NG + g) * 1024 * 64 : p.KCP + ((size_t)b * NG + g) * 512 * 64);
    const float* vc = (SAMPLE ? p.VCS + ((size_t)b * NG + g) * 1024 * 64 : p.VCP + ((size_t)b * NG + g) * 512 * 64);
    float oc[4] = {0.f, 0.f, 0.f, 0.f};
    {
        const int nrnd = (ncvc + 63) >> 6;
        float mx[4] = {-1e30f, -1e30f, -1e30f, -1e30f};
#pragma unroll 1
        for (int r = 0; r < nrnd; ++r) {
            const int n = r * 64 + lane;
            float s[4] = {-1e30f, -1e30f, -1e30f, -1e30f};
            if (n < ncvc) {
                dot4x64(nullptr, kc + (size_t)n * 64, qs, s);
                const int bk = t5_bucket(t - (16 * n + 31));
#pragma unroll
                for (int h = 0; h < 4; ++h) s[h] += relb[bk * 8 + g * 4 + h];
            }
#pragma unroll
            for (int h = 0; h < 4; ++h) { sl[h * NCAP + n] = s[h]; mx[h] = fmaxf(mx[h], s[h]); }
        }
        float sum[4] = {0.f, 0.f, 0.f, 0.f};
#pragma unroll
        for (int h = 0; h < 4; ++h) mx[h] = wave_max(mx[h]);
#pragma unroll 1
        for (int r = 0; r < nrnd; ++r) {
            const int n = r * 64 + lane;
#pragma unroll
            for (int h = 0; h < 4; ++h) { const float e = (n < ncvc) ? __expf(sl[h * NCAP + n] - mx[h]) : 0.f; sl[h * NCAP + n] = e; sum[h] += e; }
        }
#pragma unroll
        for (int h = 0; h < 4; ++h) { sum[h] = wave_sum(sum[h]); sum[h] = sum[h] > 0.f ? 1.0f / sum[h] : 0.f; }
#pragma unroll 1
        for (int r = 0; r < nrnd; ++r) {
            const int n = r * 64 + lane;
            phs[n] = (sl[n] * sum[0] + sl[NCAP + n] * sum[1]) + (sl[2 * NCAP + n] * sum[2] + sl[3 * NCAP + n] * sum[3]);
        }
#pragma unroll 1
        for (int n = nrnd * 64 + lane; n < NCAP + 64; n += 64) phs[n] = 0.f;
        __builtin_amdgcn_wave_barrier();
#pragma unroll
        for (int h = 0; h < 4; ++h) {
            float a = 0.f;
#pragma unroll 2
            for (int n = 0; n < ncvc; ++n) a += sl[h * NCAP + n] * vc[(size_t)n * 64 + lane];
            oc[h] = a * sum[h];
        }
    }
    const int qblk = t >> 6;
    int nselected;
    if (qblk <= 15) {
        nselected = qblk + 1;
        if (lane < 16) sel[lane] = lane;
    } else {
        unsigned long long key[NJR];
#pragma unroll
        for (int jr = 0; jr < NJR; ++jr) {
            const int j = jr * 64 + lane;
            key[jr] = 0ull;
            if (j >= 1 && j <= qblk - 2 && j < NSEL) {
                float im = 0.f;
#pragma unroll
                for (int n = 4 * j - 1; n <= 4 * j + 3; ++n) im += (n < NC) ? phs[n] : 0.f;
                key[jr] = ((unsigned long long)__float_as_uint(im) << 32) | (unsigned)(0xFFFF - j) | 0x10000ull;
            }
        }
        if (lane == 0) { sel[0] = 0; sel[1] = qblk - 1; sel[2] = qblk; }
#pragma unroll 1
        for (int it = 0; it < 13; ++it) {
            unsigned long long best = 0ull;
#pragma unroll
            for (int jr = 0; jr < NJR; ++jr) best = key[jr] > best ? key[jr] : best;
#pragma unroll
            for (int o = 32; o > 0; o >>= 1) { const unsigned long long ot = __shfl_xor(best, o); best = ot > best ? ot : best; }
            const int j = 0xFFFF - (int)(best & 0xFFFFull);
#pragma unroll
            for (int jr = 0; jr < NJR; ++jr) if (key[jr] == best) key[jr] = 0ull;
            if (lane == 0) sel[3 + it] = j;
        }
        nselected = 16;
    }
    __builtin_amdgcn_wave_barrier();
    float ms[4] = {-1e30f, -1e30f, -1e30f, -1e30f}, ls[4] = {0.f, 0.f, 0.f, 0.f}, os[4] = {0.f, 0.f, 0.f, 0.f};
#pragma unroll 1
    for (int i = 0; i < nselected; ++i) {
        const int j = sel[i];
        attn_chunk<SAMPLE>(p, 1, b, g, t, j * 64, 0, t, ms, ls, os, qs, pbk, relb, lane);
    }
    float mw[4] = {-1e30f, -1e30f, -1e30f, -1e30f}, lw[4] = {0.f, 0.f, 0.f, 0.f}, ow[4] = {0.f, 0.f, 0.f, 0.f};
    {
        const int lo = t - WIN > 0 ? t - WIN : 0;
#pragma unroll 1
        for (int c = 0; c < 9; ++c) {
            const int pos0 = t - 63 - 64 * c;
            if (pos0 + 63 < lo) break;
            attn_chunk<SAMPLE>(p, 2, b, g, t, pos0, lo, t, mw, lw, ow, qs, pbk, relb, lane);
        }
    }
    const float* gt = p.GATE + (size_t)row * 32 + g * 12;
#pragma unroll
    for (int h = 0; h < 4; ++h) {
        const float v = gt[h * 3 + 0] * oc[h] + gt[h * 3 + 1] * os[h] / ls[h] + gt[h * 3 + 2] * ow[h] / lw[h];
        p.OCAT[(size_t)row * DM + (g * 4 + h) * 64 + lane] = f2bf(v);
    }
    __builtin_amdgcn_wave_barrier();
}

__device__ void phase_attn(const Params& p) {
    const int wid = threadIdx.x >> 6, lane = threadIdx.x & 63;
    LAS float* relb = (LAS float*)smem;
    if (threadIdx.x < 256) relb[threadIdx.x] = p.rel_bias[threadIdx.x];
    __syncthreads();
    if (wid < 4) {
        LAS unsigned char* wl = (LAS unsigned char*)smem + 1024 + wid * ATT_WAVE_LDS_S;
#pragma unroll 1
        for (int it = blockIdx.x * 4 + wid; it < NS * NG; it += gridDim.x * 4) { const int b = it >> 1, g = it & 1; attn_item<true>(p, MP + b, b, PAST, g, relb, wl, lane); }
    }
    __syncthreads();
    LAS unsigned char* wl = (LAS unsigned char*)smem + 1024 + wid * ATT_WAVE_LDS_P;
#pragma unroll 1
    for (int it = blockIdx.x * 8 + wid; it < MP * NG; it += gridDim.x * 8) {
        const int g = it & 1, tok = it >> 1; const int b = tok & 3, t = SEQ - 1 - (tok >> 2);
        attn_item<false>(p, b * SEQ + t, b, t, g, relb, wl, lane);
    }
}

constexpr int GM_LDS = 128 * 128 * 4 + 1024;
__device__ void phase_gmlp(const Params& p) {
    const int wid = threadIdx.x >> 6, lane = threadIdx.x & 63, tid = threadIdx.x;
    LAS float* vn = (LAS float*)smem;
    LAS float* mu = (LAS float*)(smem + 128 * 128 * 4);
    for (int u = blockIdx.x; u < NB * 64; u += gridDim.x) {
        const int b = u >> 6, ch = u & 63; const size_t row0 = (size_t)b * SEQ + ch * 128;
        __syncthreads();
        for (int r = wid; r < 128; r += 8) {
            const u32x4 w = *(const u32x4*)(p.Vg + (row0 + r) * GMD + lane * 8);
            const float x[8] = {bflo(w.x), bfhi(w.x), bflo(w.y), bfhi(w.y), bflo(w.z), bfhi(w.z), bflo(w.w), bfhi(w.w)};
            float s = 0.f;
#pragma unroll
            for (int i = 0; i < 8; ++i) s += x[i];
            const float mean = wave_sum(s) * (1.0f / GMD);
            float q = 0.f;
#pragma unroll
            for (int i = 0; i < 8; ++i) q += (x[i] - mean) * (x[i] - mean);
            const float var = wave_sum(q) * (1.0f / GMD);
            if (lane == 0) { mu[r] = mean; mu[128 + r] = rsqrtf(var + EPS); }
        }
        for (int g = 0; g < 4; ++g) {
            __syncthreads();
            for (int i = tid; i < 128 * 128; i += 512) {
                const int s = i >> 7, d = i & 127, c = g * 128 + d;
                vn[i] = (bf2f(p.Vg[(row0 + s) * GMD + c]) - mu[s]) * mu[128 + s] * p.gm_ln_g[c] + p.gm_ln_b[c];
            }
            __syncthreads();
            const int d = tid & 127;
            for (int i = 0; i < 32; ++i) {
                const int t = (tid >> 7) + 4 * i;
                const float* wrow = p.gm_ws + ((size_t)g * 128 + t) * 128;
                float a = 0.f;
                for (int s = 0; s <= t; ++s) a += wrow[s] * vn[s * 128 + d];
                a += p.gm_bs[g * 128 + t];
                const float uu = bf2f(p.U[(row0 + t) * GMD + g * 128 + d]);
                p.OCAT[(row0 + t) * DM + QD + g * 128 + d] = f2bf(uu * a);
            }
        }
    }
    for (int it = blockIdx.x * 8 + wid; it < NS; it += gridDim.x * 8) {
        const size_t row = (size_t)MP + it;
        const u32x4 w = *(const u32x4*)(p.Vg + row * GMD + lane * 8);
        const float x[8] = {bflo(w.x), bfhi(w.x), bflo(w.y), bfhi(w.y), bflo(w.z), bfhi(w.z), bflo(w.w), bfhi(w.w)};
        float s = 0.f;
#pragma unroll
        for (int i = 0; i < 8; ++i) s += x[i];
        const float mean = wave_sum(s) * (1.0f / GMD);
        float q = 0.f;
#pragma unroll
        for (int i = 0; i < 8; ++i) q += (x[i] - mean) * (x[i] - mean);
        const float rs = rsqrtf(wave_sum(q) * (1.0f / GMD) + EPS);
#pragma unroll
        for (int i = 0; i < 8; ++i) {
            const int c = lane * 8 + i, g = c >> 7;
            const float v = (x[i] - mean) * rs * p.gm_ln_g[c] + p.gm_ln_b[c];
            p.out[O_GMV + (size_t)it * GMD + c] = v;
            const float a = p.gm_ws[(size_t)g * 128 * 128] * v + p.gm_bs[g * 128];
            p.OCAT[row * DM + QD + c] = f2bf(bf2f(p.U[row * GMD + c]) * a);
        }
    }
}

template <int MODE>
__device__ void phase_norm(const Params& p) {
    const int wid = threadIdx.x >> 6, lane = threadIdx.x & 63;
    const float* gpost = MODE == 0 ? p.ln_mix_post : MODE == 1 ? p.ln_ffn_post : p.ln_ple_post;
    for (int row = blockIdx.x * 8 + wid; row < MP + NS; row += gridDim.x * 8) {
        const float* fr = p.F + (size_t)row * DM;
        const float* xr = MODE == 0 ? xrow_ptr(p, row) : MODE == 1 ? p.X1 + (size_t)row * DM : p.X2 + (size_t)row * DM;
        f32x4 f[4], x[4];
#pragma unroll
        for (int k = 0; k < 4; ++k) { f[k] = *(const f32x4*)(fr + lane * 4 + k * 256); x[k] = *(const f32x4*)(xr + lane * 4 + k * 256); }
        const float r = row_rstd(f);
#pragma unroll
        for (int k = 0; k < 4; ++k) { const f32x4 g = *(const f32x4*)(gpost + lane * 4 + k * 256); x[k] = x[k] + f[k] * r * g; }
        if (MODE == 0) {
            const float r2 = row_rstd(x);
#pragma unroll
            for (int k = 0; k < 4; ++k) {
                *(f32x4*)(p.X1 + (size_t)row * DM + lane * 4 + k * 256) = x[k];
                const f32x4 g = *(const f32x4*)(p.ln_ffn_pre + lane * 4 + k * 256); const f32x4 o = x[k] * r2 * g;
                st_bf16x4(p.H2 + (size_t)row * DM + lane * 4 + k * 256, o);
            }
        } else if (MODE == 1) {
#pragma unroll
            for (int k = 0; k < 4; ++k) { *(f32x4*)(p.X2 + (size_t)row * DM + lane * 4 + k * 256) = x[k]; st_bf16x4(p.X2b + (size_t)row * DM + lane * 4 + k * 256, x[k]); }
        } else {
            float* yr = row < MP ? p.out + O_YP + (size_t)row * DM : p.out + O_YS + (size_t)(row - MP) * DM;
#pragma unroll
            for (int k = 0; k < 4; ++k) *(f32x4*)(yr + lane * 4 + k * 256) = x[k];
        }
    }
}


#define XB_TMO      128
#define XB_XCNT(j)  (256  + 64 * (j))
#define XB_XSUB(j)  (1280 + 64 * (j))
#define XB_XGEN(j)  (2304 + 64 * (j))
#define XB_TOP      3328
#define XB_TOPGEN   3392
#define XCD_BAR_WORDS 3456
#define XB_SPIN_CAP (1u << 22)

__device__ __forceinline__ unsigned xb_ld(unsigned* p)              { return __hip_atomic_load(p, __ATOMIC_RELAXED, __HIP_MEMORY_SCOPE_AGENT); }
__device__ __forceinline__ unsigned xb_add(unsigned* p, unsigned v) { return __hip_atomic_fetch_add(p, v, __ATOMIC_RELAXED, __HIP_MEMORY_SCOPE_AGENT); }
__device__ __forceinline__ unsigned xb_xcc_id() { return (unsigned)__builtin_amdgcn_s_getreg((3 << 11) | 20) & 0xFu; }
#define XB_SPIN(cond, bar) do { unsigned _sp = 0; while (cond) { __builtin_amdgcn_s_sleep(1); \
    if ((++_sp & 255u) == 0u) { if (xb_ld(&(bar)[XB_TMO])) break; if (_sp > XB_SPIN_CAP) { atomicAdd(&(bar)[XB_TMO], 1u); break; } } } } while (0)

struct XcdBarrier {
    unsigned* bar; unsigned x;
    volatile LAS unsigned* st;
};

__device__ __forceinline__ XcdBarrier xcd_barrier_post(unsigned* bar, volatile LAS unsigned* st) {
    XcdBarrier b; b.bar = bar; b.x = xb_xcc_id(); b.st = st;
    if (threadIdx.x == 0) (void)xb_add(&bar[XB_XCNT(b.x)], 1u);
    return b;
}
__device__ __forceinline__ void xcd_barrier_complete(unsigned* bar, unsigned x, unsigned& nloc, unsigned& nx) {
    const unsigned G = gridDim.x * gridDim.y * gridDim.z;
    unsigned sum, cnt, mine, sp = 0u;
    for (;;) {
        sum = 0u; cnt = 0u; mine = 0u;
#pragma unroll
        for (unsigned j = 0; j < 16; ++j) { const unsigned c = xb_ld(&bar[XB_XCNT(j)]); sum += c; cnt += (c > 0u) ? 1u : 0u; mine = (j == x) ? c : mine; }
        if (sum == G) break;
        __builtin_amdgcn_s_sleep(1);
        if ((++sp & 255u) == 0u) { if (xb_ld(&bar[XB_TMO])) break; if (sp > XB_SPIN_CAP) { atomicAdd(&bar[XB_TMO], 1u); break; } }
    }
    nloc = mine > 0u ? mine : 1u; nx = cnt > 0u ? cnt : 1u;
}

__device__ __forceinline__ void xcd_barrier(const XcdBarrier& b) {
    asm volatile("s_waitcnt vmcnt(0)" ::: "memory");
    __syncthreads();
    if (threadIdx.x == 0) {
        unsigned* bar = b.bar;
        __builtin_amdgcn_s_waitcnt(0);
        unsigned nloc = b.st[0], nx = b.st[1];
        if (nloc == 0u) { xcd_barrier_complete(bar, b.x, nloc, nx); b.st[0] = nloc; b.st[1] = nx; }
        const unsigned old = xb_add(&bar[XB_XSUB(b.x)], 1u);
        const unsigned gen = old / nloc;
        if (old + 1u == (gen + 1u) * nloc) {
            __builtin_amdgcn_fence(__ATOMIC_RELEASE, "agent");
            asm volatile("s_waitcnt vmcnt(0)" ::: "memory");
            const unsigned og = xb_add(&bar[XB_TOP], 1u);
            const unsigned tg = og / nx;
            if (og + 1u == (tg + 1u) * nx) xb_add(&bar[XB_TOPGEN], 1u);
            else XB_SPIN(xb_ld(&bar[XB_TOPGEN]) == tg, bar);
            __builtin_amdgcn_fence(__ATOMIC_ACQUIRE, "agent");
            xb_add(&bar[XB_XGEN(b.x)], 1u);
            asm volatile("s_waitcnt vmcnt(0)" ::: "memory");
        } else {
            XB_SPIN(xb_ld(&bar[XB_XGEN(b.x)]) == gen, bar);
            __builtin_amdgcn_fence(__ATOMIC_ACQUIRE, "agent");
            asm volatile("s_waitcnt vmcnt(0)" ::: "memory");
        }
    }
    __syncthreads();
}

constexpr int NPHASE = 16;
constexpr int LDS_BYTES = GEMM_LDS;
static_assert(ATT_LDS <= LDS_BYTES && GM_LDS <= LDS_BYTES, "lds");
constexpr int NMT = MALL / BM;

template <int PH>
__device__ __forceinline__ void run_phase(const Params& p) {
    if (PH == 0) phase_prologue(p);
    if (PH == 1) { EpiIn e{p}; gemm_phase(p.H, DM, p.WinT, DM, NMT, INP / BM, e); }
    if (PH == 2) { EpiPart e{p.PART}; gemm_phase(p.CMPb, 4096, p.W1T, 1024, (2048 + NS * 1024) / BM, 1, e, 4, ZCmp(), 256); }
    if (PH == 3) phase_cmp_final(p);
    if (PH == 4) phase_attn(p);
    if (PH == 5) phase_gmlp(p);
    if (PH == 6) { EpiBrA e{p.GA, p.T}; gemm_phase(p.OCAT, DM, p.WnT, QD, NMT, DM / BM, e); }
    if (PH == 7) { EpiBrB e{p.GB, p.T, p.Y1}; gemm_phase(p.OCAT + QD, DM, p.WgT, GMD, NMT, DM / BM, e); }
    if (PH == 8) { EpiF32 e{p.F, DM}; gemm_phase(p.Y1, DM, p.WoT, DM, NMT, DM / BM, e); }
    if (PH == 9) phase_norm<0>(p);
    if (PH == 10) { EpiSwiGLU e{p.ACT}; gemm_phase(p.H2, DM, p.WguT, DM, NMT, 2 * DFF / BM, e); }
    if (PH == 11) { EpiF32 e{p.F, DM}; gemm_phase(p.ACT, DFF, p.WdT, DFF, NMT, DM / BM, e); }
    if (PH == 12) phase_norm<1>(p);
    if (PH == 13) { EpiF32 e{p.T, DM}; gemm_phase(p.Pb, PLE, p.WpT, PLE, NMT, DM / BM, e); }
    if (PH == 14) { EpiPleGate e{p.T, p.F}; gemm_phase(p.X2b, DM, p.WpgT, DM, NMT, DM / BM, e); }
    if (PH == 15) phase_norm<2>(p);
}

#ifndef MK_MULTI
#define MK_MULTI 0
#endif
template <int PH>
__global__ void __launch_bounds__(512, 2) k_phase(Params p) { run_phase<PH>(p); }

__global__ void __launch_bounds__(512, 2) k_all(Params p) {
    volatile LAS unsigned* st = (volatile LAS unsigned*)((LAS unsigned char*)smem + LDS_BYTES);
    if (threadIdx.x < 4) st[threadIdx.x] = 0u;
    __syncthreads();
    XcdBarrier bar = xcd_barrier_post(p.bar, st);
    run_phase<0>(p);  xcd_barrier(bar);
    run_phase<1>(p);  xcd_barrier(bar);
    run_phase<2>(p);  xcd_barrier(bar);
    run_phase<3>(p);  xcd_barrier(bar);
    run_phase<4>(p);
    run_phase<5>(p);  xcd_barrier(bar);
    run_phase<6>(p);  xcd_barrier(bar);
    run_phase<7>(p);  xcd_barrier(bar);
    run_phase<8>(p);  xcd_barrier(bar);
    run_phase<9>(p);  xcd_barrier(bar);
    run_phase<10>(p); xcd_barrier(bar);
    run_phase<11>(p); xcd_barrier(bar);
    run_phase<12>(p);
    run_phase<13>(p); xcd_barrier(bar);
    run_phase<14>(p); xcd_barrier(bar);
    run_phase<15>(p);
}

static inline size_t al256(size_t x) { return (x + 255) & ~(size_t)255; }
template <int PH> static void launch_phase(const Params& p, int grid, hipStream_t s) {
    static bool attr = false;
    if (!attr) { (void)hipFuncSetAttribute((const void*)k_phase<PH>, hipFuncAttributeMaxDynamicSharedMemorySize, LDS_BYTES); attr = true; }
    k_phase<PH><<<grid, 512, LDS_BYTES, s>>>(p);
}
template <int PH> static void launch_all(const Params& p, int grid, hipStream_t s) {
    launch_phase<PH>(p, grid, s);
    if constexpr (PH + 1 < NPHASE) launch_all<PH + 1>(p, grid, s);
}

extern "C" void kernel_launch(void* const* d_in, const int* in_sizes, int n_in, void* d_out, int out_size, void* d_ws, size_t ws_size, hipStream_t stream) {
    Params p{};
    p.x_prompt = (const float*)d_in[0]; p.x_sample = (const float*)d_in[1]; p.cache_cmp = (const float*)d_in[2]; p.cache_slc = (const float*)d_in[3];
    p.state_win = (const float*)d_in[4]; p.page_table = (const int*)d_in[5]; p.p_prompt = (const float*)d_in[6]; p.p_sample = (const float*)d_in[7];
    p.rel_bias = (const float*)d_in[8]; p.ln_mix_pre = (const float*)d_in[9]; p.w_in = (const float*)d_in[10];
    p.pe_k = (const float*)d_in[11]; p.w1_k = (const float*)d_in[12]; p.w2_k = (const float*)d_in[13];
    p.pe_v = (const float*)d_in[14]; p.w1_v = (const float*)d_in[15]; p.w2_v = (const float*)d_in[16];
    p.gm_ln_g = (const float*)d_in[17]; p.gm_ln_b = (const float*)d_in[18]; p.gm_ws = (const float*)d_in[19]; p.gm_bs = (const float*)d_in[20];
    p.w_br_nsa = (const float*)d_in[21]; p.w_br_gm = (const float*)d_in[22]; p.w_out = (const float*)d_in[23];
    p.ln_mix_post = (const float*)d_in[24]; p.ln_ffn_pre = (const float*)d_in[25]; p.w_gate = (const float*)d_in[26]; p.w_up = (const float*)d_in[27];
    p.w_down = (const float*)d_in[28]; p.ln_ffn_post = (const float*)d_in[29]; p.w_ple = (const float*)d_in[30]; p.w_ple_gate = (const float*)d_in[31];
    p.ln_ple_post = (const float*)d_in[32];
    p.out = (float*)d_out;
    unsigned char* w = (unsigned char*)d_ws; size_t off = 0;
    auto take = [&](size_t bytes) { void* r = w + off; off = al256(off + bytes); return r; };
    p.bar = (unsigned*)take(16384);
    p.WinT = (bf16_t*)take((size_t)INP * DM * 2); p.WnT = (bf16_t*)take((size_t)DM * QD * 2); p.WgT = (bf16_t*)take((size_t)DM * GMD * 2);
    p.WoT = (bf16_t*)take((size_t)DM * DM * 2); p.WguT = (bf16_t*)take((size_t)2 * DFF * DM * 2); p.WdT = (bf16_t*)take((size_t)DM * DFF * 2);
    p.WpgT = (bf16_t*)take((size_t)DM * DM * 2); p.WpT = (bf16_t*)take((size_t)DM * PLE * 2); p.W1T = (bf16_t*)take((size_t)2 * 256 * 1024 * 2);
    p.H = (bf16_t*)take((size_t)MALL * DM * 2); p.Qb = (bf16_t*)take((size_t)MALL * QD * 2);
    p.CMPb = (bf16_t*)take(((size_t)MP + (size_t)NS * PAST) * 256 * 2); p.SLCb = (bf16_t*)take((size_t)MALL * 256 * 2); p.WINb = (bf16_t*)take((size_t)MALL * 256 * 2);
    p.U = (bf16_t*)take((size_t)MALL * GMD * 2); p.Vg = (bf16_t*)take((size_t)MALL * GMD * 2);
    p.GA = (bf16_t*)take((size_t)MALL * DM * 2); p.GB = (bf16_t*)take((size_t)MALL * DM * 2);
    p.GATE = (float*)take((size_t)MALL * 32 * 4);
    p.PART = (float*)take((size_t)(2048 + NS * 1024) * 4 * 256 * 4); p.PEB = (float*)take(256 * 4);
    p.KCP = (float*)take((size_t)NB * NG * 512 * 64 * 4); p.VCP = (float*)take((size_t)NB * NG * 512 * 64 * 4);
    p.KCS = (float*)take((size_t)NS * NG * 1024 * 64 * 4); p.VCS = (float*)take((size_t)NS * NG * 1024 * 64 * 4);
    p.OCAT = (bf16_t*)take((size_t)MALL * DM * 2); p.T = (float*)take((size_t)MALL * DM * 4); p.Y1 = (bf16_t*)take((size_t)MALL * DM * 2);
    p.F = (float*)take((size_t)MALL * DM * 4); p.X1 = (float*)take((size_t)MALL * DM * 4); p.H2 = (bf16_t*)take((size_t)MALL * DM * 2);
    p.ACT = (bf16_t*)take((size_t)MALL * DFF * 2); p.X2 = (float*)take((size_t)MALL * DM * 4); p.X2b = (bf16_t*)take((size_t)MALL * DM * 2);
    p.Pb = (bf16_t*)take((size_t)MALL * PLE * 2);
    if (off > ws_size) { fprintf(stderr, "workspace too small: need %zu have %zu\n", off, ws_size); return; }
    (void)hipMemsetAsync(p.OCAT + (size_t)(MP + NS) * DM, 0, (size_t)(MALL - MP - NS) * DM * 2, stream);
#if MK_MULTI
    launch_all<0>(p, 256, stream);
#else
    constexpr size_t kDynLds = LDS_BYTES + 16;
    static int grid = 0;
    if (!grid) {
        int dev = 0, cus = 0, per_cu = 0;
        (void)hipGetDevice(&dev);
        (void)hipDeviceGetAttribute(&cus, hipDeviceAttributeMultiprocessorCount, dev);
        (void)hipFuncSetAttribute((const void*)k_all, hipFuncAttributeMaxDynamicSharedMemorySize, (int)kDynLds);
        (void)hipOccupancyMaxActiveBlocksPerMultiprocessor(&per_cu, (const void*)k_all, 512, kDynLds);
        grid = cus * (per_cu < 1 ? per_cu : 1);
        if (grid <= 0) { fprintf(stderr, "k_all: occupancy query says %d blocks per CU\n", per_cu); grid = 0; return; }
    }
    (void)hipMemsetAsync(p.bar, 0, XCD_BAR_WORDS * sizeof(unsigned), stream);
    k_all<<<grid, 512, kDynLds, stream>>>(p);
#endif
}
```

```cpp
#include <hip/hip_runtime.h>
#include <stdint.h>
#include <cstdio>

typedef unsigned short bf16_t;
typedef short bf16x8 __attribute__((ext_vector_type(8)));
typedef float f32x4 __attribute__((ext_vector_type(4)));
typedef float f32x2 __attribute__((ext_vector_type(2)));
typedef unsigned u32x4 __attribute__((ext_vector_type(4)));
typedef unsigned u32x2 __attribute__((ext_vector_type(2)));
#define LAS __attribute__((address_space(3)))

constexpr int DM = 1024, NB = 4, SEQ = 8192, MP = NB * SEQ, NS = 32, MALL = MP + 256, PAST = 16384, PAGE = 128, NPG = 128;
constexpr int NH = 8, NG = 2, HPG = 4, DH = 64, QD = 512, WIN = 512, GMD = 512, DFF = 2816, PLE = 256, IND = 4376, INP = 4608;
constexpr int NCP = 511, NCS = 1023;
constexpr float EPS = 1e-6f;
constexpr float LOG2E = 1.4426950408889634f, QSCALE = 0.125f * LOG2E;
constexpr long O_YP = 0, O_YS = 33554432, O_CMPP = 33587200, O_SLCP = 41975808, O_WINP = 50364416, O_CMPS = 50888704,
               O_SLCS = 50896896, O_WINS = 50905088, O_GMV = 55099392;

struct Params {
    const float *x_prompt, *x_sample, *cache_cmp, *cache_slc, *state_win; const int* page_table;
    const float *p_prompt, *p_sample, *rel_bias, *ln_mix_pre, *w_in, *pe_k, *w1_k, *w2_k, *pe_v, *w1_v, *w2_v;
    const float *gm_ln_g, *gm_ln_b, *gm_ws, *gm_bs, *w_br_nsa, *w_br_gm, *w_out, *ln_mix_post, *ln_ffn_pre;
    const float *w_gate, *w_up, *w_down, *ln_ffn_post, *w_ple, *w_ple_gate, *ln_ple_post;
    float* out;
    unsigned* bar;
    bf16_t *WinT, *WnT, *WgT, *WoT, *WguT, *WdT, *WpgT, *WpT, *W1T;
    bf16_t *H, *Qb, *CMPb, *SLCb, *WINb, *U, *Vg, *GA, *GB;
    float* GATE;
    float *PART, *PEB, *KCP, *VCP, *KCS, *VCS, *KN;
    bf16_t *KCb, *VCT, *SLCvT, *WINvT;
    bf16_t* OCAT; float* T; bf16_t* Y1; float* F; float* X1; bf16_t* H2; bf16_t* ACT; float* X2; bf16_t* X2b; bf16_t* Pb;
};

__device__ __forceinline__ unsigned cvt_pk_bf16(float lo, float hi) { unsigned r; asm volatile("v_cvt_pk_bf16_f32 %0, %1, %2" : "=v"(r) : "v"(lo), "v"(hi)); return r; }
__device__ __forceinline__ bf16_t f2bf(float f) { return (bf16_t)(cvt_pk_bf16(f, 0.f) & 0xffffu); }
__device__ __forceinline__ float bf2f(bf16_t h) { return __uint_as_float(((unsigned)h) << 16); }
__device__ __forceinline__ float bflo(unsigned w) { return __uint_as_float(w << 16); }
__device__ __forceinline__ float bfhi(unsigned w) { return __uint_as_float(w & 0xffff0000u); }
__device__ __forceinline__ float ex2(float x) { return __builtin_amdgcn_exp2f(x); }
__device__ __forceinline__ float sigmoidf_(float x) { return 1.0f / (1.0f + __expf(-x)); }
__device__ __forceinline__ float siluf_(float x) { return x * sigmoidf_(x); }
__device__ __forceinline__ float geluf_(float x) {
    const float u = 0.7978845608028654f * (x + 0.044715f * x * x * x);
    const float e = __expf(2.0f * u);
    const float th = 1.0f - 2.0f / (e + 1.0f);
    return 0.5f * x * (1.0f + th);
}
__device__ __forceinline__ float wave_sum(float v) {
#pragma unroll
    for (int o = 32; o > 0; o >>= 1) v += __shfl_xor(v, o);
    return v;
}
__device__ __forceinline__ float wave_max(float v) {
#pragma unroll
    for (int o = 32; o > 0; o >>= 1) v = fmaxf(v, __shfl_xor(v, o));
    return v;
}
__device__ __forceinline__ int t5_bucket(int d) {
    if (d < 16) return d;
    if (d >= 128) return 31;
    const int b = 16 + (int)(__logf((float)d * (1.0f / 16.0f)) * (16.0f / 2.0794415416798357f));
    return b < 31 ? b : 31;
}

extern __shared__ __attribute__((aligned(16))) unsigned char smem[];

constexpr int BM = 256, BK = 64, HALF = 128, HT = HALF * BK, GEMM_LDS = 8 * HT * 2;
__device__ __forceinline__ int lds_byte(int r, int c) { const int st = (r >> 4) * 2 + (c >> 5), rr = r & 15, cc = c & 31, ob = rr * 64 + cc * 2; return st * 1024 + (ob ^ (((ob >> 9) & 1) << 5)); }
__device__ __forceinline__ void stage_rc(int b, int& R, int& C) { const int st = b / 1024, sb = b % 1024, swz = sb ^ (((sb >> 9) & 1) << 5); R = (st >> 1) * 16 + swz / 64; C = (st & 1) * 32 + (swz % 64) / 2; }

constexpr int HTB = HALF * BK * 2;
template <class F>
__device__ __forceinline__ void for_each_frag(const f32x4 (&acc)[2][2][4][2], int brow, int bcol, int wr, int wc, int fr, int fq, F&& f) {
#pragma unroll
    for (int ai = 0; ai < 2; ++ai)
#pragma unroll
        for (int m = 0; m < 4; ++m)
#pragma unroll
            for (int bj = 0; bj < 2; ++bj)
#pragma unroll
                for (int n = 0; n < 2; ++n)
                    f(brow + ai * HALF + wr * 64 + m * 16 + fr, bcol + bj * HALF + wc * 32 + n * 16 + fq * 4, acc[ai][bj][m][n]);
}

struct ZNone { __device__ __forceinline__ size_t a(int) const { return 0; } __device__ __forceinline__ size_t b(int) const { return 0; } };
template <class Epi, class ZMap = ZNone>
__device__ __forceinline__ void gemm_phase(const bf16_t* A, int lda, const bf16_t* Bt, int K, int nM, int nN, const Epi& E, int nZ = 1, ZMap zm = ZMap(), int kstepA_el = BK) {
    LAS unsigned char* lds = (LAS unsigned char*)smem;
    const int tid = threadIdx.x, wid = __builtin_amdgcn_readfirstlane(tid >> 6), lane = tid & 63, wr = wid >> 2, wc = wid & 3, fr = lane & 15, fq = lane >> 4;
    const int nt = K / BK, nmn = nM * nN, nu = nmn * nZ, G = gridDim.x;
    int u = blockIdx.x;
    if (u >= nu) return;
    unsigned voffA[2], voffB[2];
#pragma unroll
    for (int i = 0; i < 2; ++i) { int R, C; stage_rc(tid * 16 + i * 8192, R, C); voffA[i] = (unsigned)(R * lda + C) * 2u; voffB[i] = (unsigned)(R * K + C) * 2u; }
    const size_t kstep = (size_t)(BK * 2), kstepA = (size_t)kstepA_el * 2;
    const size_t hstepA = (size_t)HALF * lda * 2, hstepB = (size_t)HALF * K * 2, tstepA = 2 * hstepA, tstepB = 2 * hstepB;
    const unsigned ldsw = (unsigned)wid * 1024u;
    const int aoff = lds_byte(wr * 64 + fr, fq * 8), boff = lds_byte(wc * 32 + fr, fq * 8);
#define PG8_SA(b, h) (((b) * 2 + (h)) * HTB)
#define PG8_SB(b, h) ((4 + (b) * 2 + (h)) * HTB)
#define PG8_STAGE(bufoff, gbase, voff) do { _Pragma("unroll") for (int _i = 0; _i < 2; ++_i) \
        __builtin_amdgcn_global_load_lds((const unsigned*)((const char*)(gbase) + (voff)[_i]), (LAS unsigned*)(lds + (bufoff) + ldsw + _i * 8192), 16, 0, 0); } while (0)
#define PG8_LDA(dst, b, h) do { _Pragma("unroll") for (int m = 0; m < 4; ++m) _Pragma("unroll") for (int k = 0; k < 2; ++k) dst[m][k] = *(const LAS bf16x8*)(lds + PG8_SA(b, h) + aoff + m * 2048 + k * 1024); } while (0)
#define PG8_LDB(dst, b, h) do { _Pragma("unroll") for (int n = 0; n < 2; ++n) _Pragma("unroll") for (int k = 0; k < 2; ++k) dst[n][k] = *(const LAS bf16x8*)(lds + PG8_SB(b, h) + boff + n * 2048 + k * 1024); } while (0)
#define PG8_MMA(ai, bj, At, Bt_) do { __builtin_amdgcn_s_setprio(1); _Pragma("unroll") for (int m = 0; m < 4; ++m) _Pragma("unroll") for (int n = 0; n < 2; ++n) _Pragma("unroll") for (int k = 0; k < 2; ++k) \
        acc[ai][bj][m][n] = __builtin_amdgcn_mfma_f32_16x16x32_bf16(Bt_[n][k], At[m][k], acc[ai][bj][m][n], 0, 0, 0); __builtin_amdgcn_s_setprio(0); } while (0)
#define PG8_WAIT_V(n) asm volatile("s_waitcnt vmcnt(" #n ")" ::: "memory")
#define PG8_WAIT_L(n) asm volatile("s_waitcnt lgkmcnt(" #n ")" ::: "memory")
#define PG8_BAR __builtin_amdgcn_s_barrier()
#define PG8_SCHED __builtin_amdgcn_sched_barrier(0)
    f32x4 acc[2][2][4][2];
#pragma unroll
    for (int a = 0; a < 2; ++a)
#pragma unroll
        for (int b = 0; b < 2; ++b)
#pragma unroll
            for (int m = 0; m < 4; ++m)
#pragma unroll
                for (int n = 0; n < 2; ++n) acc[a][b][m][n] = (f32x4){0.f, 0.f, 0.f, 0.f};
    bf16x8 At[4][2], B0[2][2], B1[2][2];
    int z = u / nmn, pm = (u - z * nmn) / nN, pn = (u - z * nmn) - pm * nN;
    const char* cA = (const char*)(A + zm.a(z)) + (size_t)pm * tstepA; const char* cB = (const char*)(Bt + zm.b(z)) + (size_t)pn * tstepB;
    PG8_STAGE(PG8_SB(0, 0), cB, voffB); PG8_STAGE(PG8_SA(0, 0), cA, voffA); PG8_STAGE(PG8_SB(0, 1), cB + hstepB, voffB); PG8_STAGE(PG8_SA(0, 1), cA + hstepA, voffA);
    if (wr == 1) PG8_BAR;
    PG8_WAIT_V(4); PG8_BAR;
    PG8_STAGE(PG8_SB(1, 0), cB + kstep, voffB); PG8_STAGE(PG8_SA(1, 0), cA + kstepA, voffA); PG8_STAGE(PG8_SB(1, 1), cB + hstepB + kstep, voffB);
    PG8_WAIT_V(6); PG8_BAR;
    for (;;) {
        const int un = u + G; const bool has_next = un < nu;
        const int nz = has_next ? un / nmn : z, npm = has_next ? (un - nz * nmn) / nN : pm, npn = has_next ? (un - nz * nmn) - npm * nN : pn;
        const char* nA = (const char*)(A + zm.a(nz)) + (size_t)npm * tstepA; const char* nB = (const char*)(Bt + zm.b(nz)) + (size_t)npn * tstepB;
        for (int t = 0; t < nt; t += 2) {
            const bool last = (t == nt - 2);
            const char* a1 = cA + (size_t)(t + 1) * kstepA;
            const char* a2 = last ? nA : cA + (size_t)(t + 2) * kstepA; const char* b2 = last ? nB : cB + (size_t)(t + 2) * kstep;
            const char* a3 = a2 + kstepA; const char* b3 = b2 + kstep;
            PG8_LDB(B0, 0, 0); PG8_SCHED; PG8_LDA(At, 0, 0); PG8_STAGE(PG8_SA(1, 1), a1 + hstepA, voffA);
            PG8_WAIT_L(8); PG8_BAR; PG8_WAIT_L(0); PG8_MMA(0, 0, At, B0); PG8_BAR; PG8_SCHED;
            PG8_LDB(B1, 0, 1); PG8_STAGE(PG8_SB(0, 0), b2, voffB);
            PG8_BAR; PG8_WAIT_L(0); PG8_MMA(0, 1, At, B1); PG8_BAR;
            PG8_LDA(At, 0, 1); PG8_STAGE(PG8_SA(0, 0), a2, voffA);
            PG8_BAR; PG8_WAIT_L(0); PG8_MMA(1, 0, At, B0); PG8_BAR; PG8_SCHED;
            PG8_STAGE(PG8_SB(0, 1), b2 + hstepB, voffB);
            PG8_WAIT_V(6); PG8_BAR; PG8_MMA(1, 1, At, B1); PG8_BAR;
            PG8_LDB(B0, 1, 0); PG8_SCHED; PG8_LDA(At, 1, 0); PG8_STAGE(PG8_SA(0, 1), a2 + hstepA, voffA);
            PG8_WAIT_L(8); PG8_BAR; PG8_WAIT_L(0); PG8_MMA(0, 0, At, B0); PG8_BAR; PG8_SCHED;
            PG8_LDB(B1, 1, 1); PG8_STAGE(PG8_SB(1, 0), b3, voffB);
            PG8_BAR; PG8_WAIT_L(0); PG8_MMA(0, 1, At, B1); PG8_BAR;
            PG8_LDA(At, 1, 1); PG8_STAGE(PG8_SA(1, 0), a3, voffA);
            PG8_BAR; PG8_WAIT_L(0); PG8_MMA(1, 0, At, B0); PG8_BAR; PG8_SCHED;
            PG8_STAGE(PG8_SB(1, 1), b3 + hstepB, voffB);
            PG8_WAIT_V(6); PG8_BAR; PG8_MMA(1, 1, At, B1); PG8_BAR;
        }
        E(acc, pm * BM, pn * BM + (z << 20), wr, wc, fr, fq);
        if (!has_next) break;
#pragma unroll
        for (int a = 0; a < 2; ++a)
#pragma unroll
            for (int b = 0; b < 2; ++b)
#pragma unroll
                for (int m = 0; m < 4; ++m)
#pragma unroll
                    for (int n = 0; n < 2; ++n) acc[a][b][m][n] = (f32x4){0.f, 0.f, 0.f, 0.f};
        u = un; z = nz; pm = npm; pn = npn; cA = nA; cB = nB;
    }
    PG8_WAIT_V(0);
    if (wr == 0) PG8_BAR;
    PG8_BAR;
#undef PG8_SA
#undef PG8_SB
#undef PG8_STAGE
#undef PG8_LDA
#undef PG8_LDB
#undef PG8_MMA
#undef PG8_WAIT_V
#undef PG8_WAIT_L
#undef PG8_BAR
#undef PG8_SCHED
}

__device__ __forceinline__ void st_bf16x4(bf16_t* p, f32x4 v) { u32x2 w; w.x = cvt_pk_bf16(v[0], v[1]); w.y = cvt_pk_bf16(v[2], v[3]); *(u32x2*)p = w; }

struct EpiIn {
    const Params& p;
    __device__ __forceinline__ void operator()(const f32x4 (&acc)[2][2][4][2], int brow, int bcol, int wr, int wc, int fr, int fq) const {
        const int pn = bcol >> 8;
        const Params& P = p;
        if (pn < 2) {
            for_each_frag(acc, brow, bcol, wr, wc, fr, fq, [&](int row, int col, f32x4 v) { st_bf16x4(P.Qb + (size_t)row * QD + col, v * QSCALE); });
        } else if (pn < 5) {
            bf16_t* cp = pn == 2 ? P.CMPb : pn == 3 ? P.SLCb : P.WINb;
            for_each_frag(acc, brow, bcol, wr, wc, fr, fq, [&](int row, int col, f32x4 v) {
                const int c = col & 255;
                if (pn != 2 || row < MP) st_bf16x4(cp + (size_t)row * 256 + c, v);
                if (pn >= 3 && c >= 128 && row < MP) {
                    bf16_t* vt = (pn == 3 ? P.SLCvT : P.WINvT) + ((size_t)(row >> 13) * 128 + (c - 128)) * SEQ + (row & (SEQ - 1));
                    vt[0] = f2bf(v[0]); vt[SEQ] = f2bf(v[1]); vt[2 * SEQ] = f2bf(v[2]); vt[3 * SEQ] = f2bf(v[3]);
                }
                if (pn < 4) {
                    if (row < MP) *(f32x4*)(P.out + (pn == 2 ? O_CMPP : O_SLCP) + (size_t)row * 256 + c) = v;
                    else if (row < MP + NS) *(f32x4*)(P.out + (pn == 2 ? O_CMPS : O_SLCS) + (size_t)(row - MP) * 256 + c) = v;
                } else {
                    if (row < MP) { const int t = row & (SEQ - 1), b = row >> 13; if (t >= SEQ - WIN) *(f32x4*)(P.out + O_WINP + ((size_t)b * WIN + (t - (SEQ - WIN))) * 256 + c) = v; }
                    else if (row < MP + NS) *(f32x4*)(P.out + O_WINS + ((size_t)(row - MP) * WIN + (WIN - 1)) * 256 + c) = v;
                }
            });
        } else if (pn < 9) {
            bf16_t* dst = pn < 7 ? P.U : P.Vg; const int c0 = pn < 7 ? 1280 : 1792;
            for_each_frag(acc, brow, bcol, wr, wc, fr, fq, [&](int row, int col, f32x4 v) {
                f32x4 g; g[0] = geluf_(v[0]); g[1] = geluf_(v[1]); g[2] = geluf_(v[2]); g[3] = geluf_(v[3]);
                st_bf16x4(dst + (size_t)row * GMD + (col - c0), g); });
        } else if (pn < 17) {
            bf16_t* dst = pn < 13 ? P.GA : P.GB; const int c0 = pn < 13 ? 2304 : 3328;
            for_each_frag(acc, brow, bcol, wr, wc, fr, fq, [&](int row, int col, f32x4 v) {
                f32x4 g; g[0] = sigmoidf_(v[0]); g[1] = sigmoidf_(v[1]); g[2] = sigmoidf_(v[2]); g[3] = sigmoidf_(v[3]);
                st_bf16x4(dst + (size_t)row * DM + (col - c0), g); });
        } else {
            for_each_frag(acc, brow, bcol, wr, wc, fr, fq, [&](int row, int col, f32x4 v) {
                const int c = col & 255;
                if (c < 24) { f32x4 g; g[0] = sigmoidf_(v[0]); g[1] = sigmoidf_(v[1]); g[2] = sigmoidf_(v[2]); g[3] = sigmoidf_(v[3]); *(f32x4*)(P.GATE + (size_t)row * 32 + c) = g; } });
        }
    }
};
struct EpiBrA {
    const bf16_t* GA; float* T;
    __device__ __forceinline__ void operator()(const f32x4 (&acc)[2][2][4][2], int brow, int bcol, int wr, int wc, int fr, int fq) const {
        for_each_frag(acc, brow, bcol, wr, wc, fr, fq, [&](int row, int col, f32x4 v) {
            const u32x2 g = *(const u32x2*)(GA + (size_t)row * DM + col);
            f32x4 o; o[0] = v[0] * bflo(g.x); o[1] = v[1] * bfhi(g.x); o[2] = v[2] * bflo(g.y); o[3] = v[3] * bfhi(g.y);
            *(f32x4*)(T + (size_t)row * DM + col) = o; });
    }
};
struct EpiBrB {
    const bf16_t* GB; const float* T; bf16_t* Y1;
    __device__ __forceinline__ void operator()(const f32x4 (&acc)[2][2][4][2], int brow, int bcol, int wr, int wc, int fr, int fq) const {
        for_each_frag(acc, brow, bcol, wr, wc, fr, fq, [&](int row, int col, f32x4 v) {
            const u32x2 g = *(const u32x2*)(GB + (size_t)row * DM + col);
            const f32x4 t = *(const f32x4*)(T + (size_t)row * DM + col);
            f32x4 o; o[0] = t[0] + v[0] * bflo(g.x); o[1] = t[1] + v[1] * bfhi(g.x); o[2] = t[2] + v[2] * bflo(g.y); o[3] = t[3] + v[3] * bfhi(g.y);
            st_bf16x4(Y1 + (size_t)row * DM + col, o); });
    }
};
struct EpiF32 {
    float* F; int ld;
    __device__ __forceinline__ void operator()(const f32x4 (&acc)[2][2][4][2], int brow, int bcol, int wr, int wc, int fr, int fq) const {
        for_each_frag(acc, brow, bcol, wr, wc, fr, fq, [&](int row, int col, f32x4 v) { *(f32x4*)(F + (size_t)row * ld + col) = v; });
    }
};
struct EpiPart {
    float* PART;
    __device__ __forceinline__ void operator()(const f32x4 (&acc)[2][2][4][2], int brow, int bcol, int wr, int wc, int fr, int fq) const {
        const int z = bcol >> 20;
        for_each_frag(acc, brow, 0, wr, wc, fr, fq, [&](int row, int col, f32x4 v) { *(f32x4*)(PART + ((size_t)row * 4 + z) * 256 + col) = v; });
    }
};
struct ZCmp { __device__ __forceinline__ size_t a(int z) const { return (size_t)z * 64; } __device__ __forceinline__ size_t b(int z) const { return (size_t)(z >> 1) * 256 * 1024; } };
struct EpiSwiGLU {
    bf16_t* ACT;
    __device__ __forceinline__ void operator()(const f32x4 (&acc)[2][2][4][2], int brow, int bcol, int wr, int wc, int fr, int fq) const {
        for_each_frag(acc, brow, bcol, wr, wc, fr, fq, [&](int row, int col, f32x4 v) {
            *(unsigned*)(ACT + (size_t)row * DFF + (col >> 1)) = cvt_pk_bf16(siluf_(v[0]) * v[1], siluf_(v[2]) * v[3]); });
    }
};
struct EpiPleGate {
    const float* E; float* F;
    __device__ __forceinline__ void operator()(const f32x4 (&acc)[2][2][4][2], int brow, int bcol, int wr, int wc, int fr, int fq) const {
        for_each_frag(acc, brow, bcol, wr, wc, fr, fq, [&](int row, int col, f32x4 v) {
            const f32x4 e = *(const f32x4*)(E + (size_t)row * DM + col);
            f32x4 o; o[0] = sigmoidf_(v[0]) * e[0]; o[1] = sigmoidf_(v[1]) * e[1]; o[2] = sigmoidf_(v[2]) * e[2]; o[3] = sigmoidf_(v[3]) * e[3];
            *(f32x4*)(F + (size_t)row * DM + col) = o; });
    }
};

template <class Map>
__device__ __forceinline__ void transpose_tile(const float* W, int K, int N, bf16_t* Wt, int ldk, int kt, int ntile, Map map) {
    LAS float* tile = (LAS float*)smem;
    const int t = threadIdx.x;
    __syncthreads();
#pragma unroll
    for (int i = 0; i < 2; ++i) {
        const int k = (t >> 4) + 32 * i, n = (t & 15) * 4, gn = ntile * 64 + n;
        f32x4 v = (f32x4){0.f, 0.f, 0.f, 0.f};
        if (gn < N) v = *(const f32x4*)(W + (size_t)(kt * 64 + k) * N + gn);
        tile[k * 65 + n] = v[0]; tile[k * 65 + n + 1] = v[1]; tile[k * 65 + n + 2] = v[2]; tile[k * 65 + n + 3] = v[3];
    }
    __syncthreads();
    const int n = t >> 3, kc = (t & 7) * 8, gn = ntile * 64 + n;
    if (gn < N) {
        u32x4 w;
        w.x = cvt_pk_bf16(tile[(kc + 0) * 65 + n], tile[(kc + 1) * 65 + n]); w.y = cvt_pk_bf16(tile[(kc + 2) * 65 + n], tile[(kc + 3) * 65 + n]);
        w.z = cvt_pk_bf16(tile[(kc + 4) * 65 + n], tile[(kc + 5) * 65 + n]); w.w = cvt_pk_bf16(tile[(kc + 6) * 65 + n], tile[(kc + 7) * 65 + n]);
        *(u32x4*)(Wt + (size_t)map(gn) * ldk + kt * 64 + kc) = w;
    }
}
template <class Map>
__device__ __forceinline__ void transpose_all(const float* W, int K, int N, bf16_t* Wt, int ldk, Map map, int& base) {
    const int nkt = K / 64, nnt = (N + 63) / 64, ntl = nkt * nnt;
    for (int it = blockIdx.x; it < base + ntl; it += gridDim.x) {
        if (it < base) continue;
        const int l = it - base;
        transpose_tile(W, K, N, Wt, ldk, l / nnt, l % nnt, map);
    }
    base += ntl;
}
__device__ __forceinline__ int map_win(int n) {
    if (n < 1280) return n;
    if (n < 1304) return 4352 + (n - 1280);
    if (n < 2328) return 1280 + (n - 1304);
    return 2304 + (n - 2328);
}

__device__ __forceinline__ float row_rstd(const f32x4 (&v)[4]) {
    float s = 0.f;
#pragma unroll
    for (int k = 0; k < 4; ++k) s += v[k][0] * v[k][0] + v[k][1] * v[k][1] + v[k][2] * v[k][2] + v[k][3] * v[k][3];
    s = wave_sum(s);
    return rsqrtf(s * (1.0f / DM) + EPS);
}
__device__ __forceinline__ const float* xrow_ptr(const Params& p, int row) {
    return row < MP ? p.x_prompt + (size_t)row * DM : p.x_sample + (size_t)(row - MP) * DM;
}

__device__ void phase_prologue(const Params& p) {
    const int wid = threadIdx.x >> 6, lane = threadIdx.x & 63;
    const int gw = blockIdx.x * 8 + wid, nw = gridDim.x * 8;
    int base = 0;
    transpose_all(p.w_in, DM, IND, p.WinT, DM, [](int n) { return map_win(n); }, base);
    transpose_all(p.w_br_nsa, QD, DM, p.WnT, QD, [](int n) { return n; }, base);
    transpose_all(p.w_br_gm, GMD, DM, p.WgT, GMD, [](int n) { return n; }, base);
    transpose_all(p.w_out, DM, DM, p.WoT, DM, [](int n) { return n; }, base);
    transpose_all(p.w_gate, DM, DFF, p.WguT, DM, [](int n) { return 2 * n; }, base);
    transpose_all(p.w_up, DM, DFF, p.WguT, DM, [](int n) { return 2 * n + 1; }, base);
    transpose_all(p.w_down, DFF, DM, p.WdT, DFF, [](int n) { return n; }, base);
    transpose_all(p.w_ple_gate, DM, DM, p.WpgT, DM, [](int n) { return n; }, base);
    transpose_all(p.w_ple, PLE, DM, p.WpT, PLE, [](int n) { return n; }, base);
    for (int kv = 0; kv < 2; ++kv) for (int j = 0; j < 2; ++j)
        transpose_all((kv ? p.w1_v : p.w1_k) + (size_t)j * 1024 * 128, 1024, 128, p.W1T + ((size_t)kv * 256 + j * 128) * 1024, 1024, [](int n) { return n; }, base);
    __syncthreads();
    for (int i = blockIdx.x * 512 + threadIdx.x; i < (INP - IND) * DM / 8; i += gridDim.x * 512) ((u32x4*)(p.WinT + (size_t)IND * DM))[i] = (u32x4){0u, 0u, 0u, 0u};
    for (int row = gw; row < MALL; row += nw) {
        u32x2* hd = (u32x2*)(p.H + (size_t)row * DM);
        if (row < MP + NS) {
            const float* xr = xrow_ptr(p, row);
            f32x4 v[4];
#pragma unroll
            for (int k = 0; k < 4; ++k) v[k] = *(const f32x4*)(xr + lane * 4 + k * 256);
            const float r = row_rstd(v);
#pragma unroll
            for (int k = 0; k < 4; ++k) { const f32x4 g = *(const f32x4*)(p.ln_mix_pre + lane * 4 + k * 256); const f32x4 o = v[k] * r * g; u32x2 w; w.x = cvt_pk_bf16(o[0], o[1]); w.y = cvt_pk_bf16(o[2], o[3]); hd[lane + k * 64] = w; }
            const float* pr = row < MP ? p.p_prompt + (size_t)row * PLE : p.p_sample + (size_t)(row - MP) * PLE;
            const f32x4 pv = *(const f32x4*)(pr + lane * 4);
            u32x2 w; w.x = cvt_pk_bf16(pv[0], pv[1]); w.y = cvt_pk_bf16(pv[2], pv[3]);
            ((u32x2*)(p.Pb + (size_t)row * PLE))[lane] = w;
        } else {
#pragma unroll
            for (int k = 0; k < 4; ++k) hd[lane + k * 64] = (u32x2){0u, 0u};
            ((u32x2*)(p.Pb + (size_t)row * PLE))[lane] = (u32x2){0u, 0u};
        }
    }
    for (int r2 = gw; r2 < NS * PAST / 2; r2 += nw) {
        const int r = r2 * 2 + (lane >> 5), b = r >> 14, pos = r & (PAST - 1), l5 = lane & 31;
        const float* s = p.cache_cmp + ((size_t)p.page_table[b * NPG + (pos >> 7)] * PAGE + (pos & 127)) * 256 + l5 * 8;
        const f32x4 a = *(const f32x4*)s, c = *(const f32x4*)(s + 4);
        u32x4 w; w.x = cvt_pk_bf16(a[0], a[1]); w.y = cvt_pk_bf16(a[2], a[3]); w.z = cvt_pk_bf16(c[0], c[1]); w.w = cvt_pk_bf16(c[2], c[3]);
        *(u32x4*)(p.CMPb + ((size_t)MP + r) * 256 + l5 * 8) = w;
    }
    if (gw < 4) {
        const int kv = gw >> 1, h = (gw & 1) * 64 + lane;
        const float* pe = kv ? p.pe_v : p.pe_k; const float* w1 = kv ? p.w1_v : p.w1_k;
        float s = 0.f;
        for (int k = 0; k < 2048; ++k) s += pe[k] * w1[(size_t)k * 128 + h];
        p.PEB[kv * 128 + h] = s;
    }
    for (int i = blockIdx.x * 512 + threadIdx.x; i < NS * (WIN - 1) * 64; i += gridDim.x * 512) {
        const int b = i / ((WIN - 1) * 64), r = i % ((WIN - 1) * 64);
        ((f32x4*)(p.out + O_WINS + (size_t)b * WIN * 256))[r] = ((const f32x4*)(p.state_win + (size_t)b * WIN * 256 + 256))[r];
    }
}

__device__ void phase_cmp_final(const Params& p) {
    const int wid = threadIdx.x >> 6, lane = threadIdx.x & 63;
    LAS float* hb = (LAS float*)smem + wid * 128;
    const int nitem_p = NB * NCP * 4, nitem_s = NS * NCS * 4;
#pragma unroll 1
    for (int it = blockIdx.x * 8 + wid; it < nitem_p + nitem_s; it += gridDim.x * 8) {
        const bool smp = it >= nitem_p; const int l = smp ? it - nitem_p : it;
        const int z = l & 3, kv = z >> 1, g = z & 1, r = l >> 2;
        const int nc = smp ? NCS : NCP, seq = r / nc, n = r % nc;
        const size_t r0 = smp ? (size_t)2048 + (size_t)seq * 1024 + n : (size_t)seq * 512 + n;
        const float* p0 = p.PART + (r0 * 4 + z) * 256;
        const float* p1 = p.PART + ((r0 + 1) * 4 + z) * 256 + 128;
        const float* w2 = kv ? p.w2_v : p.w2_k;
#pragma unroll
        for (int i = 0; i < 2; ++i) { const int h = lane + 64 * i; hb[h] = siluf_(p0[h] + p1[h] + p.PEB[kv * 128 + h]); }
        __builtin_amdgcn_wave_barrier();
        float s = 0.f;
#pragma unroll 4
        for (int h = 0; h < 128; ++h) s += hb[h] * w2[h * 64 + lane];
        __builtin_amdgcn_wave_barrier();
        float* dst = smp ? (kv ? p.VCS : p.KCS) + (((size_t)seq * NG + g) * 1024 + n) * 64 : (kv ? p.VCP : p.KCP) + (((size_t)seq * NG + g) * 512 + n) * 64;
        dst[lane] = s;
        if (!smp) {
            if (kv == 0) p.KCb[(((size_t)seq * NG + g) * 512 + n) * 64 + lane] = f2bf(s);
            else { bf16_t* vt = p.VCT + (((size_t)seq * NG + g) * 64 + lane) * 512; vt[n] = f2bf(s); if (n == NCP - 1) vt[NCP] = 0; }
        }
    }
#pragma unroll 1
    for (int it = blockIdx.x * 8 + wid; it < NB * NG * 128; it += gridDim.x * 8) {
        const int j = it & 127, g = (it >> 7) & 1, b = it >> 8;
        const bf16_t* kr = p.SLCb + ((size_t)b * SEQ + j * 64 + lane) * 256 + g * 64;
        float q = 0.f;
#pragma unroll
        for (int c = 0; c < 8; ++c) { const u32x4 w = *(const u32x4*)(kr + c * 8);
            q += bflo(w.x) * bflo(w.x) + bfhi(w.x) * bfhi(w.x) + bflo(w.y) * bflo(w.y) + bfhi(w.y) * bfhi(w.y) + bflo(w.z) * bflo(w.z) + bfhi(w.z) * bfhi(w.z) + bflo(w.w) * bflo(w.w) + bfhi(w.w) * bfhi(w.w); }
        q = wave_max(q);
        if (lane == 0) p.KN[it] = q;
    }
}

template <bool SAMPLE>
__device__ __forceinline__ void kv_row_ptr(const Params& p, int branch  , int b, int pos, int kv, int g, const bf16_t*& pb, const float*& pf) {
    const int off = kv * 128 + g * 64;
    if (!SAMPLE) { pf = nullptr; pb = (branch == 1 ? p.SLCb : p.WINb) + ((size_t)b * SEQ + pos) * 256 + off; }
    else if (pos >= PAST) { pf = nullptr; pb = (branch == 1 ? p.SLCb : p.WINb) + ((size_t)MP + b) * 256 + off; }
    else if (branch == 1) { pb = nullptr; pf = p.cache_slc + ((size_t)p.page_table[b * NPG + (pos >> 7)] * PAGE + (pos & 127)) * 256 + off; }
    else { pb = nullptr; pf = p.state_win + ((size_t)b * WIN + (pos - (PAST - WIN))) * 256 + off; }
}
__device__ __forceinline__ void dot4x64(const bf16_t* pb, const float* pf, const LAS float* qs_, float (&s)[4]) {
    s[0] = s[1] = s[2] = s[3] = 0.f;
    const LAS float* qs = qs_; asm volatile("" : "+v"(qs));
    if (pf) {
#pragma unroll 2
        for (int c = 0; c < 16; ++c) {
            const f32x4 kx = *(const f32x4*)(pf + c * 4);
#pragma unroll
            for (int h = 0; h < 4; ++h) { const f32x4 q = *(const LAS f32x4*)(qs + h * 64 + c * 4); s[h] += q[0] * kx[0] + q[1] * kx[1] + q[2] * kx[2] + q[3] * kx[3]; }
        }
    } else {
#pragma unroll 1
        for (int c = 0; c < 8; ++c) {
            const u32x4 w = *(const u32x4*)(pb + c * 8);
            const float k0 = bflo(w.x), k1 = bfhi(w.x), k2 = bflo(w.y), k3 = bfhi(w.y), k4 = bflo(w.z), k5 = bfhi(w.z), k6 = bflo(w.w), k7 = bfhi(w.w);
#pragma unroll
            for (int h = 0; h < 4; ++h) {
                const f32x4 qa = *(const LAS f32x4*)(qs + h * 64 + c * 8), qb = *(const LAS f32x4*)(qs + h * 64 + c * 8 + 4);
                s[h] += qa[0] * k0 + qa[1] * k1 + qa[2] * k2 + qa[3] * k3 + qb[0] * k4 + qb[1] * k5 + qb[2] * k6 + qb[3] * k7;
            }
        }
    }
}
template <bool SAMPLE>
__device__ __forceinline__ void attn_chunk(const Params& p, int branch, int b, int g, int t, int pos0, int lo, int hi,
                                           float (&m)[4], float (&l)[4], float (&o)[4], const LAS float* qs, LAS float* pbk, const LAS float* relb, int lane) {
    const int pos = pos0 + lane;
    const bool valid = pos >= lo && pos <= hi;
    float s[4] = {-1e30f, -1e30f, -1e30f, -1e30f};
    if (valid) {
        const bf16_t* pb; const float* pf; kv_row_ptr<SAMPLE>(p, branch, b, pos, 0, g, pb, pf);
        dot4x64(pb, pf, qs, s);
        const int bk = t5_bucket(t - pos);
#pragma unroll
        for (int h = 0; h < 4; ++h) s[h] += relb[bk * 8 + g * 4 + h];
    }
#pragma unroll
    for (int h = 0; h < 4; ++h) {
        const float mx = wave_max(s[h]);
        const float mn = fmaxf(m[h], mx);
        const float pr = valid ? ex2(s[h] - mn) : 0.f;
        const float sm = wave_sum(pr);
        const float al = ex2(m[h] - mn);
        l[h] = l[h] * al + sm; o[h] *= al; m[h] = mn;
        pbk[h * 64 + lane] = pr;
    }
    __builtin_amdgcn_wave_barrier();
    const int k0 = (lo > pos0 ? lo : pos0) - pos0, k1 = (hi < pos0 + 63 ? hi : pos0 + 63) - pos0;
#pragma unroll 1
    for (int k = k0; k <= k1; ++k) {
        const bf16_t* pb; const float* pf; kv_row_ptr<SAMPLE>(p, branch, b, pos0 + k, 1, g, pb, pf);
        const float v = pf ? pf[lane] : bf2f(pb[lane]);
#pragma unroll
        for (int h = 0; h < 4; ++h) o[h] += pbk[h * 64 + k] * v;
    }
    __builtin_amdgcn_wave_barrier();
}

constexpr int ATT_WAVE_LDS_P = 256 * 4 + 4 * 512 * 4 + (512 + 64) * 4 + 256 * 4 + 64;
constexpr int ATT_WAVE_LDS_S = 256 * 4 + 4 * 1024 * 4 + (1024 + 64) * 4 + 256 * 4 + 64;
constexpr int ATT_LDS = 1024 + (8 * ATT_WAVE_LDS_P > 4 * ATT_WAVE_LDS_S ? 8 * ATT_WAVE_LDS_P : 4 * ATT_WAVE_LDS_S);

template <bool SAMPLE>
__device__ __forceinline__ void attn_item(const Params& p, int row  , int b, int t, int g, const LAS float* relb, LAS unsigned char* wl, int lane) {
    constexpr int NCAP = SAMPLE ? 1024 : 512, NC = SAMPLE ? NCS : NCP, NSEL = SAMPLE ? 257 : 128, NJR = SAMPLE ? 5 : 2;
    LAS float* qs = (LAS float*)wl; LAS float* sl = qs + 256; LAS float* phs = sl + 4 * NCAP; LAS float* pbk = phs + NCAP + 64; LAS int* sel = (LAS int*)(pbk + 256);
    {
        const u32x2 w = *(const u32x2*)(p.Qb + (size_t)row * QD + g * 256 + lane * 4);
        qs[lane * 4 + 0] = bflo(w.x); qs[lane * 4 + 1] = bfhi(w.x); qs[lane * 4 + 2] = bflo(w.y); qs[lane * 4 + 3] = bfhi(w.y);
    }
    __builtin_amdgcn_wave_barrier();
    const int ncv = t >= 31 ? ((t - 31) >> 4) + 1 : 0;
    const int ncvc = ncv < NC ? ncv : NC;
    const float* kc = (SAMPLE ? p.KCS + ((size_t)b * NG + g) * 1024 * 64 : p.KCP + ((size_t)b * NG + g) * 512 * 64);
    const float* vc = (SAMPLE ? p.VCS + ((size_t)b * NG + g) * 1024 * 64 : p.VCP + ((size_t)b * NG + g) * 512 * 64);
    float oc[4] = {0.f, 0.f, 0.f, 0.f};
    {
        const int nrnd = (ncvc + 63) >> 6;
        float mx[4] = {-1e30f, -1e30f, -1e30f, -1e30f};
#pragma unroll 1
        for (int r = 0; r < nrnd; ++r) {
            const int n = r * 64 + lane;
            float s[4] = {-1e30f, -1e30f, -1e30f, -1e30f};
            if (n < ncvc) {
                dot4x64(nullptr, kc + (size_t)n * 64, qs, s);
                const int bk = t5_bucket(t - (16 * n + 31));
#pragma unroll
                for (int h = 0; h < 4; ++h) s[h] += relb[bk * 8 + g * 4 + h];
            }
#pragma unroll
            for (int h = 0; h < 4; ++h) { sl[h * NCAP + n] = s[h]; mx[h] = fmaxf(mx[h], s[h]); }
        }
        float sum[4] = {0.f, 0.f, 0.f, 0.f};
#pragma unroll
        for (int h = 0; h < 4; ++h) mx[h] = wave_max(mx[h]);
#pragma unroll 1
        for (int r = 0; r < nrnd; ++r) {
            const int n = r * 64 + lane;
#pragma unroll
            for (int h = 0; h < 4; ++h) { const float e = (n < ncvc) ? ex2(sl[h * NCAP + n] - mx[h]) : 0.f; sl[h * NCAP + n] = e; sum[h] += e; }
        }
#pragma unroll
        for (int h = 0; h < 4; ++h) { sum[h] = wave_sum(sum[h]); sum[h] = sum[h] > 0.f ? 1.0f / sum[h] : 0.f; }
#pragma unroll 1
        for (int r = 0; r < nrnd; ++r) {
            const int n = r * 64 + lane;
            phs[n] = (sl[n] * sum[0] + sl[NCAP + n] * sum[1]) + (sl[2 * NCAP + n] * sum[2] + sl[3 * NCAP + n] * sum[3]);
        }
#pragma unroll 1
        for (int n = nrnd * 64 + lane; n < NCAP + 64; n += 64) phs[n] = 0.f;
        __builtin_amdgcn_wave_barrier();
#pragma unroll
        for (int h = 0; h < 4; ++h) {
            float a = 0.f;
#pragma unroll 2
            for (int n = 0; n < ncvc; ++n) a += sl[h * NCAP + n] * vc[(size_t)n * 64 + lane];
            oc[h] = a * sum[h];
        }
    }
    const int qblk = t >> 6;
    int nselected;
    if (qblk <= 15) {
        nselected = qblk + 1;
        if (lane < 16) sel[lane] = lane;
    } else {
        unsigned long long key[NJR];
#pragma unroll
        for (int jr = 0; jr < NJR; ++jr) {
            const int j = jr * 64 + lane;
            key[jr] = 0ull;
            if (j >= 1 && j <= qblk - 2 && j < NSEL) {
                float im = 0.f;
#pragma unroll
                for (int n = 4 * j - 1; n <= 4 * j + 3; ++n) im += (n < NC) ? phs[n] : 0.f;
                key[jr] = ((unsigned long long)__float_as_uint(im) << 32) | (unsigned)(0xFFFF - j) | 0x10000ull;
            }
        }
        if (lane == 0) { sel[0] = 0; sel[1] = qblk - 1; sel[2] = qblk; }
#pragma unroll 1
        for (int it = 0; it < 13; ++it) {
            unsigned long long best = 0ull;
#pragma unroll
            for (int jr = 0; jr < NJR; ++jr) best = key[jr] > best ? key[jr] : best;
#pragma unroll
            for (int o = 32; o > 0; o >>= 1) { const unsigned long long ot = __shfl_xor(best, o); best = ot > best ? ot : best; }
            const int j = 0xFFFF - (int)(best & 0xFFFFull);
#pragma unroll
            for (int jr = 0; jr < NJR; ++jr) if (key[jr] == best) key[jr] = 0ull;
            if (lane == 0) sel[3 + it] = j;
        }
        nselected = 16;
    }
    __builtin_amdgcn_wave_barrier();
    float ms[4] = {-1e30f, -1e30f, -1e30f, -1e30f}, ls[4] = {0.f, 0.f, 0.f, 0.f}, os[4] = {0.f, 0.f, 0.f, 0.f};
#pragma unroll 1
    for (int i = 0; i < nselected; ++i) {
        const int j = sel[i];
        attn_chunk<SAMPLE>(p, 1, b, g, t, j * 64, 0, t, ms, ls, os, qs, pbk, relb, lane);
    }
    float mw[4] = {-1e30f, -1e30f, -1e30f, -1e30f}, lw[4] = {0.f, 0.f, 0.f, 0.f}, ow[4] = {0.f, 0.f, 0.f, 0.f};
    {
        const int lo = t - WIN > 0 ? t - WIN : 0;
#pragma unroll 1
        for (int c = 0; c < 9; ++c) {
            const int pos0 = t - 63 - 64 * c;
            if (pos0 + 63 < lo) break;
            attn_chunk<SAMPLE>(p, 2, b, g, t, pos0, lo, t, mw, lw, ow, qs, pbk, relb, lane);
        }
    }
    const float* gt = p.GATE + (size_t)row * 32 + g * 12;
#pragma unroll
    for (int h = 0; h < 4; ++h) {
        const float v = gt[h * 3 + 0] * oc[h] + gt[h * 3 + 1] * os[h] / ls[h] + gt[h * 3 + 2] * ow[h] / lw[h];
        p.OCAT[(size_t)row * DM + (g * 4 + h) * 64 + lane] = f2bf(v);
    }
    __builtin_amdgcn_wave_barrier();
}

constexpr int A_OST = 0, OST_LD = 68, A_LST = A_OST + 256 * OST_LD * 4, A_M0 = A_LST + 1024, A_MB = A_M0 + 1024, MB_LD = 132, A_MKN = A_MB + 64 * MB_LD,
              A_LIST = A_MKN + 256, A_CNT = A_LIST + 132 * 64, A_PK = A_CNT + 544, A_KN = A_PK + 400 * 4, A_T2 = A_KN + 512, A_NP = A_T2 + 132 * 8 * 4, ATT2_LDS = A_NP + 16;
static_assert(ATT2_LDS <= GEMM_LDS, "attention LDS");

__device__ __forceinline__ f32x4 mfma16(bf16x8 a, bf16x8 b, f32x4 c) { return __builtin_amdgcn_mfma_f32_16x16x32_bf16(a, b, c, 0, 0, 0); }
__device__ __forceinline__ bf16x8 pack_p(const f32x4& a, const f32x4& b) {
    u32x4 w; w.x = cvt_pk_bf16(a[0], a[1]); w.y = cvt_pk_bf16(a[2], a[3]); w.z = cvt_pk_bf16(b[0], b[1]); w.w = cvt_pk_bf16(b[2], b[3]);
    return __builtin_bit_cast(bf16x8, w);
}
__device__ __forceinline__ void qk64(const bf16_t* kb, int c, int G, const bf16x8 (&qB)[2], f32x4 (&s)[4]) {
#pragma unroll
    for (int kt = 0; kt < 4; ++kt) {
        const bf16_t* r = kb + (size_t)(16 * kt + c) * 256 + G * 8;
        const bf16x8 a0 = *(const bf16x8*)r, a1 = *(const bf16x8*)(r + 32);
        s[kt] = mfma16(a0, qB[0], (f32x4){0.f, 0.f, 0.f, 0.f}); s[kt] = mfma16(a1, qB[1], s[kt]);
    }
}
__device__ __forceinline__ void pv64(const bf16_t* vt, int ldv, int c, int G, const f32x4 (&pr)[4], f32x4 (&o)[4]) {
#pragma unroll
    for (int ks = 0; ks < 2; ++ks) {
        const bf16x8 pB = pack_p(pr[2 * ks], pr[2 * ks + 1]);
#pragma unroll
        for (int dt = 0; dt < 4; ++dt) {
            const bf16_t* r = vt + (size_t)(dt * 16 + c) * ldv + 32 * ks + 4 * G;
            u32x4 w; const u32x2 v0 = *(const u32x2*)r, v1 = *(const u32x2*)(r + 16); w.x = v0.x; w.y = v0.y; w.z = v1.x; w.w = v1.y;
            o[dt] = mfma16(__builtin_bit_cast(bf16x8, w), pB, o[dt]);
        }
    }
}
__device__ __forceinline__ float grp_max(float v) { v = fmaxf(v, __shfl_xor(v, 16)); return fmaxf(v, __shfl_xor(v, 32)); }
__device__ __forceinline__ float grp_sum(float v) { v += __shfl_xor(v, 16); return v + __shfl_xor(v, 32); }

__device__ __forceinline__ void cmp_win_pack(const Params& p, int b, int g, int qb, int pk, int lane_, LAS unsigned char* L) {
    f32x4 oacc[4];
    int lane = lane_; asm volatile("" : "+v"(lane));
    const int c = lane & 15, G = lane >> 4, qs = c >> 2, hh = c & 3;
    const int t0 = qb * 64 + pk * 4, tc = t0 + qs, qi = pk * 4 + qs;
    const size_t qrow = (size_t)b * SEQ + tc;
    const LAS float* T2 = (const LAS float*)(L + A_T2);
    const float b31 = T2[128 * 8 + g * 4 + hh];
    bf16x8 qB[2];
    qB[0] = *(const bf16x8*)(p.Qb + qrow * QD + (g * 4 + hh) * 64 + G * 8); qB[1] = *(const bf16x8*)(p.Qb + qrow * QD + (g * 4 + hh) * 64 + 32 + G * 8);
    const float* gate = p.GATE + qrow * 32 + (g * 4 + hh) * 3;
    {
        const int ncv_c = tc >= 31 ? ((tc - 31) >> 4) + 1 : 0;
        const int ncv_m = t0 + 3 >= 31 ? ((t0 + 3 - 31) >> 4) + 1 : 0;
        const int NT = (ncv_m + 15) >> 4;
        const int mt_far = t0 >= 399 ? (t0 - 399) / 256 + 1 : 0;
        const bf16_t* kcb = p.KCb + (size_t)(b * NG + g) * 512 * 64;
        f32x4 sc[32];
        float mx = -1e30f;
#pragma unroll
        for (int mt = 0; mt < 32; ++mt) {
            sc[mt] = (f32x4){0.f, 0.f, 0.f, 0.f};
            if (mt < NT) {
                const bf16_t* r = kcb + (size_t)(16 * mt + c) * 64 + G * 8;
                const bf16x8 a0 = *(const bf16x8*)r, a1 = *(const bf16x8*)(r + 32);
                f32x4 s = mfma16(a0, qB[0], (f32x4){0.f, 0.f, 0.f, 0.f}); s = mfma16(a1, qB[1], s);
                if (mt < mt_far) { s = s + b31; }
                else {
#pragma unroll
                    for (int i = 0; i < 4; ++i) { const int n = 16 * mt + 4 * G + i; int dist = tc - (16 * n + 31); const bool ok = n < ncv_c; dist = dist < 0 ? 0 : (dist > 128 ? 128 : dist);
                        s[i] = ok ? s[i] + T2[dist * 8 + g * 4 + hh] : -1e30f; }
                }
                mx = fmaxf(mx, fmaxf(fmaxf(s[0], s[1]), fmaxf(s[2], s[3])));
                sc[mt] = s;
            }
            if ((mt & 3) == 3) __builtin_amdgcn_sched_barrier(0);
        }
        mx = grp_max(mx);
        float sum = 0.f;
#pragma unroll
        for (int mt = 0; mt < 32; ++mt) if (mt < NT) {
#pragma unroll
            for (int i = 0; i < 4; ++i) { const float e = sc[mt][i] > -1e29f ? ex2(sc[mt][i] - mx) : 0.f; sc[mt][i] = e; sum += e; }
        }
        sum = grp_sum(sum);
        const float inv = sum > 0.f ? 1.0f / sum : 0.f;
#pragma unroll
        for (int mt = 0; mt < 32; ++mt) if (mt < NT) sc[mt] = sc[mt] * inv;
        LAS unsigned char* Mb = (LAS unsigned char*)(L + A_MB) + qi * MB_LD;
        const LAS float* KNs = (const LAS float*)(L + A_KN);
        if (qb <= 15) {
            if (hh == 0) { for (int j = G; j <= qb; j += 4) Mb[j] = 1; }
            float mk = 0.f; for (int j = 0; j <= qb; ++j) mk = fmaxf(mk, KNs[j]);
            if (hh == 0 && G == 0) ((LAS float*)(L + A_MKN))[qi] = mk;
        } else {
            float cand[8];
#pragma unroll
            for (int k = 0; k < 8; ++k) cand[k] = -1.f;
            float prevB = 0.f;
#pragma unroll
            for (int mt = 0; mt < 32; ++mt) if (mt < NT) {
                const float r1 = __shfl(sc[mt][3], (lane - 16) & 63);
                float v = (sc[mt][0] + sc[mt][1]) + (sc[mt][2] + sc[mt][3]) + (G == 0 ? prevB : r1);
                prevB = r1;
                v += __shfl_xor(v, 1); v += __shfl_xor(v, 2);
                const int j = 4 * mt + G;
                if ((mt & 3) == hh) cand[mt >> 2] = (j >= 1 && j <= qb - 2) ? v : -1.f;
            }
            float mk = fmaxf(KNs[0], fmaxf(KNs[qb], KNs[qb - 1]));
#pragma unroll 1
            for (int it = 0; it < 13; ++it) {
                float bv = cand[0];
#pragma unroll
                for (int k = 1; k < 8; ++k) bv = fmaxf(bv, cand[k]);
                bv = fmaxf(bv, __shfl_xor(bv, 1)); bv = fmaxf(bv, __shfl_xor(bv, 2)); bv = grp_max(bv);
                int bj = 9999;
#pragma unroll
                for (int k = 0; k < 8; ++k) { const int j = 16 * k + 4 * hh + G; bj = (cand[k] == bv && j < bj) ? j : bj; }
                { int o = __shfl_xor(bj, 1); bj = o < bj ? o : bj; o = __shfl_xor(bj, 2); bj = o < bj ? o : bj; o = __shfl_xor(bj, 16); bj = o < bj ? o : bj; o = __shfl_xor(bj, 32); bj = o < bj ? o : bj; }
#pragma unroll
                for (int k = 0; k < 8; ++k) { const int j = 16 * k + 4 * hh + G; if (j == bj) cand[k] = -1.f; }
                mk = fmaxf(mk, KNs[bj & 127]);
                if (hh == 0 && G == 0) Mb[bj & 127] = 1;
            }
            if (hh == 0 && G == 0) { Mb[0] = 1; Mb[qb] = 1; Mb[qb - 1] = 1; ((LAS float*)(L + A_MKN))[qi] = mk; }
        }
        const bf16_t* vct = p.VCT + (size_t)(b * NG + g) * 64 * 512;
        f32x4 oc[4] = {{0.f, 0.f, 0.f, 0.f}, {0.f, 0.f, 0.f, 0.f}, {0.f, 0.f, 0.f, 0.f}, {0.f, 0.f, 0.f, 0.f}};
#pragma unroll
        for (int k2 = 0; k2 < 16; ++k2) if (2 * k2 < NT) {
            const bf16x8 pB = pack_p(sc[2 * k2], sc[2 * k2 + 1]);
#pragma unroll
            for (int dt = 0; dt < 4; ++dt) {
                const bf16_t* r = vct + (size_t)(dt * 16 + c) * 512 + 32 * k2 + 4 * G;
                u32x4 w; const u32x2 v0 = *(const u32x2*)r, v1 = *(const u32x2*)(r + 16); w.x = v0.x; w.y = v0.y; w.z = v1.x; w.w = v1.y;
                oc[dt] = mfma16(__builtin_bit_cast(bf16x8, w), pB, oc[dt]);
            }
            if (k2 & 1) __builtin_amdgcn_sched_barrier(0);
        }
        const float g0 = gate[0];
#pragma unroll
        for (int dt = 0; dt < 4; ++dt) oacc[dt] = oc[dt] * g0;
    }
    {
        f32x4 ow[4] = {{0.f, 0.f, 0.f, 0.f}, {0.f, 0.f, 0.f, 0.f}, {0.f, 0.f, 0.f, 0.f}, {0.f, 0.f, 0.f, 0.f}};
        float m = -1e30f, l = 0.f;
        const int lo = t0 - WIN > 0 ? t0 - WIN : 0, hi = t0 + 3;
        const bf16_t* kbase = p.WINb + (size_t)b * SEQ * 256 + g * 64;
        const bf16_t* vbase = p.WINvT + (size_t)(b * NG + g) * 64 * SEQ;
#pragma unroll 1
        for (int cb = lo & ~63; cb <= hi; cb += 64) {
            f32x4 s[4];
            qk64(kbase + (size_t)cb * 256, c, G, qB, s);
            const bool far = (cb + 63 <= t0 - 128) && (cb >= t0 + 3 - WIN);
            if (far) {
#pragma unroll
                for (int kt = 0; kt < 4; ++kt) s[kt] = s[kt] + b31;
            } else {
#pragma unroll
                for (int kt = 0; kt < 4; ++kt)
#pragma unroll
                    for (int i = 0; i < 4; ++i) { const int dist = tc - (cb + 16 * kt + 4 * G + i); const bool ok = dist >= 0 && dist <= WIN; const int dd = dist < 0 ? 0 : (dist > 128 ? 128 : dist);
                        s[kt][i] = ok ? s[kt][i] + T2[dd * 8 + g * 4 + hh] : -1e30f; }
            }
            float cm = fmaxf(fmaxf(fmaxf(s[0][0], s[0][1]), fmaxf(s[0][2], s[0][3])), fmaxf(fmaxf(s[1][0], s[1][1]), fmaxf(s[1][2], s[1][3])));
            cm = fmaxf(cm, fmaxf(fmaxf(fmaxf(s[2][0], s[2][1]), fmaxf(s[2][2], s[2][3])), fmaxf(fmaxf(s[3][0], s[3][1]), fmaxf(s[3][2], s[3][3]))));
            cm = grp_max(cm);
            const float mn = fmaxf(m, cm), al = ex2(m - mn);
            float ps = 0.f;
#pragma unroll
            for (int kt = 0; kt < 4; ++kt)
#pragma unroll
                for (int i = 0; i < 4; ++i) { const float e = s[kt][i] > -1e29f ? ex2(s[kt][i] - mn) : 0.f; s[kt][i] = e; ps += e; }
            l = l * al + grp_sum(ps); m = mn;
#pragma unroll
            for (int dt = 0; dt < 4; ++dt) ow[dt] = ow[dt] * al;
            pv64(vbase + cb, SEQ, c, G, s, ow);
        }
        const float gw = gate[2] / l;
#pragma unroll
        for (int dt = 0; dt < 4; ++dt) st_bf16x4(p.OCAT + qrow * DM + (g * 4 + hh) * 64 + dt * 16 + 4 * G, oacc[dt] + ow[dt] * gw);
    }
}

__device__ __forceinline__ void sel_pack(const Params& p, int b, int g, int qb, int j, int s0, int lane_, LAS unsigned char* L) {
    int lane = lane_; asm volatile("" : "+v"(lane));
    const int c = lane & 15, G = lane >> 4, qs = c >> 2, hh = c & 3;
    const LAS unsigned char* list = (const LAS unsigned char*)(L + A_LIST) + j * 64;
    const int cnt = ((const LAS int*)(L + A_CNT))[j];
    const bool cval = s0 + qs < cnt;
    const int qi = list[cval ? s0 + qs : s0];
    const int tc = qb * 64 + qi;
    const size_t qrow = (size_t)b * SEQ + tc;
    const LAS float* T2 = (const LAS float*)(L + A_T2);
    bf16x8 qB[2];
    qB[0] = *(const bf16x8*)(p.Qb + qrow * QD + (g * 4 + hh) * 64 + G * 8); qB[1] = *(const bf16x8*)(p.Qb + qrow * QD + (g * 4 + hh) * 64 + 32 + G * 8);
    f32x4 s[4];
    qk64(p.SLCb + ((size_t)b * SEQ + j * 64) * 256 + g * 64, c, G, qB, s);
    const float m0 = ((const LAS float*)(L + A_M0))[qi * 4 + hh];
    float ps = 0.f;
    if (j <= qb - 3) {
        const float b31 = T2[128 * 8 + g * 4 + hh] - m0;
#pragma unroll
        for (int kt = 0; kt < 4; ++kt)
#pragma unroll
            for (int i = 0; i < 4; ++i) { const float e = ex2(s[kt][i] + b31); s[kt][i] = e; ps += e; }
    } else {
#pragma unroll
        for (int kt = 0; kt < 4; ++kt)
#pragma unroll
            for (int i = 0; i < 4; ++i) { const int dist = tc - (j * 64 + 16 * kt + 4 * G + i); const int dd = dist < 0 ? 0 : (dist > 128 ? 128 : dist);
                const float e = dist >= 0 ? ex2(s[kt][i] + T2[dd * 8 + g * 4 + hh] - m0) : 0.f; s[kt][i] = e; ps += e; }
    }
    if (!cval) {
        ps = 0.f;
#pragma unroll
        for (int kt = 0; kt < 4; ++kt) s[kt] = (f32x4){0.f, 0.f, 0.f, 0.f};
    }
    ps = grp_sum(ps);
    f32x4 o[4] = {{0.f, 0.f, 0.f, 0.f}, {0.f, 0.f, 0.f, 0.f}, {0.f, 0.f, 0.f, 0.f}, {0.f, 0.f, 0.f, 0.f}};
    pv64(p.SLCvT + (size_t)(b * NG + g) * 64 * SEQ + j * 64, SEQ, c, G, s, o);
    if (cval) {
        LAS float* ost = (LAS float*)(L + A_OST) + (qi * 4 + hh) * OST_LD + 4 * G;
#pragma unroll
        for (int dt = 0; dt < 4; ++dt)
#pragma unroll
            for (int i = 0; i < 4; ++i) (void)__hip_atomic_fetch_add(ost + dt * 16 + i, o[dt][i], __ATOMIC_RELAXED, __HIP_MEMORY_SCOPE_WORKGROUP);
        if (G == 0) (void)__hip_atomic_fetch_add((LAS float*)(L + A_LST) + qi * 4 + hh, ps, __ATOMIC_RELAXED, __HIP_MEMORY_SCOPE_WORKGROUP);
    }
}

__device__ void attn_tile(const Params& p, int b, int g, int qb, LAS unsigned char* L) {
    int tid = threadIdx.x; asm volatile("" : "+v"(tid));
    const int wid = __builtin_amdgcn_readfirstlane(tid >> 6), lane = tid & 63;
    __syncthreads();
    for (int i = tid; i < (A_MKN + 256) / 4; i += 512) ((LAS unsigned*)L)[i] = 0u;
    if (tid < 128) ((LAS float*)(L + A_KN))[tid] = p.KN[(b * NG + g) * 128 + tid];
    __syncthreads();
#pragma unroll 1
    for (int k = 0; k < 2; ++k) cmp_win_pack(p, b, g, qb, 2 * wid + k, lane, L);
    __syncthreads();
    LAS int* cnt = (LAS int*)(L + A_CNT);
    if (tid < 132) {
        int n = 0;
        if (tid <= qb) { LAS unsigned char* list = (LAS unsigned char*)(L + A_LIST) + tid * 64; const LAS unsigned char* Mb = (const LAS unsigned char*)(L + A_MB) + tid;
            for (int q = 0; q < 64; ++q) if (Mb[q * MB_LD]) list[n++] = (unsigned char)q; }
        cnt[tid] = n;
    } else if (tid >= 256) {
        const int e = tid - 256, qi = e >> 2, h = e & 3;
        const bf16_t* qr = p.Qb + ((size_t)b * SEQ + qb * 64 + qi) * QD + (g * 4 + h) * 64;
        float q2 = 0.f;
#pragma unroll
        for (int cc = 0; cc < 8; ++cc) { const u32x4 w = *(const u32x4*)(qr + cc * 8);
            q2 += bflo(w.x) * bflo(w.x) + bfhi(w.x) * bfhi(w.x) + bflo(w.y) * bflo(w.y) + bfhi(w.y) * bfhi(w.y) + bflo(w.z) * bflo(w.z) + bfhi(w.z) * bfhi(w.z) + bflo(w.w) * bflo(w.w) + bfhi(w.w) * bfhi(w.w); }
        const LAS float* T2 = (const LAS float*)(L + A_T2);
        float bm = T2[g * 4 + h];
        for (int d = 1; d <= 128; ++d) bm = fmaxf(bm, T2[d * 8 + g * 4 + h]);
        ((LAS float*)(L + A_M0))[e] = sqrtf(q2 * ((const LAS float*)(L + A_MKN))[qi]) * 1.0001f + bm + 1e-3f;
    }
    __syncthreads();
    if (wid == 0) {
        int a[3], run = 0;
        LAS int* PK = (LAS int*)(L + A_PK);
#pragma unroll
        for (int r = 0; r < 3; ++r) {
            const int j = r * 64 + lane; const int np = j < 132 ? (cnt[j] + 3) >> 2 : 0;
            int inc = np;
#pragma unroll
            for (int o = 1; o < 64; o <<= 1) { const int t = __shfl_up(inc, o); if (lane >= o) inc += t; }
            a[r] = run + inc - np;
            for (int k = 0; k < np; ++k) PK[a[r] + k] = (j << 8) | (k * 4);
            run += __shfl(inc, 63);
        }
        if (lane == 0) ((LAS int*)(L + A_NP))[0] = run;
    }
    __syncthreads();
    {
        const int np = ((const LAS int*)(L + A_NP))[0];
        const LAS int* PK = (const LAS int*)(L + A_PK);
#pragma unroll 1
        for (int k = wid; k < np; k += 8) { const int e = PK[k]; sel_pack(p, b, g, qb, e >> 8, e & 255, lane, L); }
    }
    __syncthreads();
    {
        const int c = lane & 15, G = lane >> 4, qs = c >> 2, hh = c & 3;
#pragma unroll 1
        for (int k = 0; k < 2; ++k) {
            const int qi = (2 * wid + k) * 4 + qs;
            const size_t qrow = (size_t)b * SEQ + qb * 64 + qi;
            const float gs = p.GATE[qrow * 32 + (g * 4 + hh) * 3 + 1] / ((const LAS float*)(L + A_LST))[qi * 4 + hh];
            const LAS float* ost = (const LAS float*)(L + A_OST) + (qi * 4 + hh) * OST_LD + 4 * G;
#pragma unroll
            for (int dt = 0; dt < 4; ++dt) {
                const f32x4 os = *(const LAS f32x4*)(ost + dt * 16);
                bf16_t* op = p.OCAT + qrow * DM + (g * 4 + hh) * 64 + dt * 16 + 4 * G;
                const u32x2 w = *(const u32x2*)op;
                f32x4 pa; pa[0] = bflo(w.x); pa[1] = bfhi(w.x); pa[2] = bflo(w.y); pa[3] = bfhi(w.y);
                st_bf16x4(op, pa + os * gs);
            }
        }
    }
}

__device__ void phase_attn(const Params& p) {
    const int wid = threadIdx.x >> 6, lane = threadIdx.x & 63;
    {
        LAS float* relb = (LAS float*)smem;
        if (threadIdx.x < 256) relb[threadIdx.x] = p.rel_bias[threadIdx.x] * LOG2E;
        __syncthreads();
        if (wid < 4) {
            LAS unsigned char* wl = (LAS unsigned char*)smem + 1024 + wid * ATT_WAVE_LDS_S;
#pragma unroll 1
            for (int it = blockIdx.x * 4 + wid; it < NS * NG; it += gridDim.x * 4) { const int b = it >> 1, g = it & 1; attn_item<true>(p, MP + b, b, PAST, g, relb, wl, lane); }
        }
        __syncthreads();
    }
    LAS unsigned char* L = (LAS unsigned char*)smem;
    for (int i = threadIdx.x; i < 129 * 8; i += 512) ((LAS float*)(L + A_T2))[i] = p.rel_bias[t5_bucket(i >> 3) * 8 + (i & 7)] * LOG2E;
    __syncthreads();
#pragma unroll 1
    for (int u = blockIdx.x; u < NB * NG * (SEQ / 64); u += gridDim.x) {
        const int qb = (SEQ / 64 - 1) - (u >> 3), bg = u & 7;
        attn_tile(p, bg >> 1, bg & 1, qb, L);
    }
    __syncthreads();
}

constexpr int GM_LDS = 128 * 128 * 4 + 1024;
__device__ void phase_gmlp(const Params& p) {
    const int wid = threadIdx.x >> 6, lane = threadIdx.x & 63, tid = threadIdx.x;
    LAS float* vn = (LAS float*)smem;
    LAS float* mu = (LAS float*)(smem + 128 * 128 * 4);
    for (int u = blockIdx.x; u < NB * 64; u += gridDim.x) {
        const int b = u >> 6, ch = u & 63; const size_t row0 = (size_t)b * SEQ + ch * 128;
        __syncthreads();
        for (int r = wid; r < 128; r += 8) {
            const u32x4 w = *(const u32x4*)(p.Vg + (row0 + r) * GMD + lane * 8);
            const float x[8] = {bflo(w.x), bfhi(w.x), bflo(w.y), bfhi(w.y), bflo(w.z), bfhi(w.z), bflo(w.w), bfhi(w.w)};
            float s = 0.f;
#pragma unroll
            for (int i = 0; i < 8; ++i) s += x[i];
            const float mean = wave_sum(s) * (1.0f / GMD);
            float q = 0.f;
#pragma unroll
            for (int i = 0; i < 8; ++i) q += (x[i] - mean) * (x[i] - mean);
            const float var = wave_sum(q) * (1.0f / GMD);
            if (lane == 0) { mu[r] = mean; mu[128 + r] = rsqrtf(var + EPS); }
        }
        for (int g = 0; g < 4; ++g) {
            __syncthreads();
            for (int i = tid; i < 128 * 128; i += 512) {
                const int s = i >> 7, d = i & 127, c = g * 128 + d;
                vn[i] = (bf2f(p.Vg[(row0 + s) * GMD + c]) - mu[s]) * mu[128 + s] * p.gm_ln_g[c] + p.gm_ln_b[c];
            }
            __syncthreads();
            const int d = tid & 127;
            for (int i = 0; i < 32; ++i) {
                const int t = (tid >> 7) + 4 * i;
                const float* wrow = p.gm_ws + ((size_t)g * 128 + t) * 128;
                float a = 0.f;
                for (int s = 0; s <= t; ++s) a += wrow[s] * vn[s * 128 + d];
                a += p.gm_bs[g * 128 + t];
                const float uu = bf2f(p.U[(row0 + t) * GMD + g * 128 + d]);
                p.OCAT[(row0 + t) * DM + QD + g * 128 + d] = f2bf(uu * a);
            }
        }
    }
    for (int it = blockIdx.x * 8 + wid; it < NS; it += gridDim.x * 8) {
        const size_t row = (size_t)MP + it;
        const u32x4 w = *(const u32x4*)(p.Vg + row * GMD + lane * 8);
        const float x[8] = {bflo(w.x), bfhi(w.x), bflo(w.y), bfhi(w.y), bflo(w.z), bfhi(w.z), bflo(w.w), bfhi(w.w)};
        float s = 0.f;
#pragma unroll
        for (int i = 0; i < 8; ++i) s += x[i];
        const float mean = wave_sum(s) * (1.0f / GMD);
        float q = 0.f;
#pragma unroll
        for (int i = 0; i < 8; ++i) q += (x[i] - mean) * (x[i] - mean);
        const float rs = rsqrtf(wave_sum(q) * (1.0f / GMD) + EPS);
#pragma unroll
        for (int i = 0; i < 8; ++i) {
            const int c = lane * 8 + i, g = c >> 7;
            const float v = (x[i] - mean) * rs * p.gm_ln_g[c] + p.gm_ln_b[c];
            p.out[O_GMV + (size_t)it * GMD + c] = v;
            const float a = p.gm_ws[(size_t)g * 128 * 128] * v + p.gm_bs[g * 128];
            p.OCAT[row * DM + QD + c] = f2bf(bf2f(p.U[row * GMD + c]) * a);
        }
    }
}

template <int MODE>
__device__ void phase_norm(const Params& p) {
    const int wid = threadIdx.x >> 6, lane = threadIdx.x & 63;
    const float* gpost = MODE == 0 ? p.ln_mix_post : MODE == 1 ? p.ln_ffn_post : p.ln_ple_post;
    for (int row = blockIdx.x * 8 + wid; row < MP + NS; row += gridDim.x * 8) {
        const float* fr = p.F + (size_t)row * DM;
        const float* xr = MODE == 0 ? xrow_ptr(p, row) : MODE == 1 ? p.X1 + (size_t)row * DM : p.X2 + (size_t)row * DM;
        f32x4 f[4], x[4];
#pragma unroll
        for (int k = 0; k < 4; ++k) { f[k] = *(const f32x4*)(fr + lane * 4 + k * 256); x[k] = *(const f32x4*)(xr + lane * 4 + k * 256); }
        const float r = row_rstd(f);
#pragma unroll
        for (int k = 0; k < 4; ++k) { const f32x4 g = *(const f32x4*)(gpost + lane * 4 + k * 256); x[k] = x[k] + f[k] * r * g; }
        if (MODE == 0) {
            const float r2 = row_rstd(x);
#pragma unroll
            for (int k = 0; k < 4; ++k) {
                *(f32x4*)(p.X1 + (size_t)row * DM + lane * 4 + k * 256) = x[k];
                const f32x4 g = *(const f32x4*)(p.ln_ffn_pre + lane * 4 + k * 256); const f32x4 o = x[k] * r2 * g;
                st_bf16x4(p.H2 + (size_t)row * DM + lane * 4 + k * 256, o);
            }
        } else if (MODE == 1) {
#pragma unroll
            for (int k = 0; k < 4; ++k) { *(f32x4*)(p.X2 + (size_t)row * DM + lane * 4 + k * 256) = x[k]; st_bf16x4(p.X2b + (size_t)row * DM + lane * 4 + k * 256, x[k]); }
        } else {
            float* yr = row < MP ? p.out + O_YP + (size_t)row * DM : p.out + O_YS + (size_t)(row - MP) * DM;
#pragma unroll
            for (int k = 0; k < 4; ++k) *(f32x4*)(yr + lane * 4 + k * 256) = x[k];
        }
    }
}


#define XB_TMO      128
#define XB_XCNT(j)  (256  + 64 * (j))
#define XB_XSUB(j)  (1280 + 64 * (j))
#define XB_XGEN(j)  (2304 + 64 * (j))
#define XB_TOP      3328
#define XB_TOPGEN   3392
#define XCD_BAR_WORDS 3456
#define XB_SPIN_CAP (1u << 22)

__device__ __forceinline__ unsigned xb_ld(unsigned* p)              { return __hip_atomic_load(p, __ATOMIC_RELAXED, __HIP_MEMORY_SCOPE_AGENT); }
__device__ __forceinline__ unsigned xb_add(unsigned* p, unsigned v) { return __hip_atomic_fetch_add(p, v, __ATOMIC_RELAXED, __HIP_MEMORY_SCOPE_AGENT); }
__device__ __forceinline__ unsigned xb_xcc_id() { return (unsigned)__builtin_amdgcn_s_getreg((3 << 11) | 20) & 0xFu; }
#define XB_SPIN(cond, bar) do { unsigned _sp = 0; while (cond) { __builtin_amdgcn_s_sleep(1); \
    if ((++_sp & 255u) == 0u) { if (xb_ld(&(bar)[XB_TMO])) break; if (_sp > XB_SPIN_CAP) { atomicAdd(&(bar)[XB_TMO], 1u); break; } } } } while (0)

struct XcdBarrier {
    unsigned* bar; unsigned x;
    volatile LAS unsigned* st;
};

__device__ __forceinline__ XcdBarrier xcd_barrier_post(unsigned* bar, volatile LAS unsigned* st) {
    XcdBarrier b; b.bar = bar; b.x = xb_xcc_id(); b.st = st;
    if (threadIdx.x == 0) (void)xb_add(&bar[XB_XCNT(b.x)], 1u);
    return b;
}
__device__ __forceinline__ void xcd_barrier_complete(unsigned* bar, unsigned x, unsigned& nloc, unsigned& nx) {
    const unsigned G = gridDim.x * gridDim.y * gridDim.z;
    unsigned sum, cnt, mine, sp = 0u;
    for (;;) {
        sum = 0u; cnt = 0u; mine = 0u;
#pragma unroll
        for (unsigned j = 0; j < 16; ++j) { const unsigned c = xb_ld(&bar[XB_XCNT(j)]); sum += c; cnt += (c > 0u) ? 1u : 0u; mine = (j == x) ? c : mine; }
        if (sum == G) break;
        __builtin_amdgcn_s_sleep(1);
        if ((++sp & 255u) == 0u) { if (xb_ld(&bar[XB_TMO])) break; if (sp > XB_SPIN_CAP) { atomicAdd(&bar[XB_TMO], 1u); break; } }
    }
    nloc = mine > 0u ? mine : 1u; nx = cnt > 0u ? cnt : 1u;
}

__device__ __forceinline__ void xcd_barrier(const XcdBarrier& b) {
    asm volatile("s_waitcnt vmcnt(0)" ::: "memory");
    __syncthreads();
    if (threadIdx.x == 0) {
        unsigned* bar = b.bar;
        __builtin_amdgcn_s_waitcnt(0);
        unsigned nloc = b.st[0], nx = b.st[1];
        if (nloc == 0u) { xcd_barrier_complete(bar, b.x, nloc, nx); b.st[0] = nloc; b.st[1] = nx; }
        const unsigned old = xb_add(&bar[XB_XSUB(b.x)], 1u);
        const unsigned gen = old / nloc;
        if (old + 1u == (gen + 1u) * nloc) {
            __builtin_amdgcn_fence(__ATOMIC_RELEASE, "agent");
            asm volatile("s_waitcnt vmcnt(0)" ::: "memory");
            const unsigned og = xb_add(&bar[XB_TOP], 1u);
            const unsigned tg = og / nx;
            if (og + 1u == (tg + 1u) * nx) xb_add(&bar[XB_TOPGEN], 1u);
            else XB_SPIN(xb_ld(&bar[XB_TOPGEN]) == tg, bar);
            __builtin_amdgcn_fence(__ATOMIC_ACQUIRE, "agent");
            xb_add(&bar[XB_XGEN(b.x)], 1u);
            asm volatile("s_waitcnt vmcnt(0)" ::: "memory");
        } else {
            XB_SPIN(xb_ld(&bar[XB_XGEN(b.x)]) == gen, bar);
            __builtin_amdgcn_fence(__ATOMIC_ACQUIRE, "agent");
            asm volatile("s_waitcnt vmcnt(0)" ::: "memory");
        }
    }
    __syncthreads();
}

constexpr int NPHASE = 16;
constexpr int LDS_BYTES = GEMM_LDS;
static_assert(ATT_LDS <= LDS_BYTES && GM_LDS <= LDS_BYTES, "lds");
constexpr int NMT = MALL / BM;

template <int PH>
__device__ __forceinline__ void run_phase(const Params& p) {
    if (PH == 0) phase_prologue(p);
    if (PH == 1) { EpiIn e{p}; gemm_phase(p.H, DM, p.WinT, DM, NMT, INP / BM, e); }
    if (PH == 2) { EpiPart e{p.PART}; gemm_phase(p.CMPb, 4096, p.W1T, 1024, (2048 + NS * 1024) / BM, 1, e, 4, ZCmp(), 256); }
    if (PH == 3) phase_cmp_final(p);
    if (PH == 4) phase_attn(p);
    if (PH == 5) phase_gmlp(p);
    if (PH == 6) { EpiBrA e{p.GA, p.T}; gemm_phase(p.OCAT, DM, p.WnT, QD, NMT, DM / BM, e); }
    if (PH == 7) { EpiBrB e{p.GB, p.T, p.Y1}; gemm_phase(p.OCAT + QD, DM, p.WgT, GMD, NMT, DM / BM, e); }
    if (PH == 8) { EpiF32 e{p.F, DM}; gemm_phase(p.Y1, DM, p.WoT, DM, NMT, DM / BM, e); }
    if (PH == 9) phase_norm<0>(p);
    if (PH == 10) { EpiSwiGLU e{p.ACT}; gemm_phase(p.H2, DM, p.WguT, DM, NMT, 2 * DFF / BM, e); }
    if (PH == 11) { EpiF32 e{p.F, DM}; gemm_phase(p.ACT, DFF, p.WdT, DFF, NMT, DM / BM, e); }
    if (PH == 12) phase_norm<1>(p);
    if (PH == 13) { EpiF32 e{p.T, DM}; gemm_phase(p.Pb, PLE, p.WpT, PLE, NMT, DM / BM, e); }
    if (PH == 14) { EpiPleGate e{p.T, p.F}; gemm_phase(p.X2b, DM, p.WpgT, DM, NMT, DM / BM, e); }
    if (PH == 15) phase_norm<2>(p);
}

#ifndef MK_MULTI
#define MK_MULTI 0
#endif
template <int PH>
__global__ void __launch_bounds__(512, 2) k_phase(Params p) { run_phase<PH>(p); }

__global__ void __launch_bounds__(512, 2) k_all(Params p) {
    volatile LAS unsigned* st = (volatile LAS unsigned*)((LAS unsigned char*)smem + LDS_BYTES);
    if (threadIdx.x < 4) st[threadIdx.x] = 0u;
    __syncthreads();
    XcdBarrier bar = xcd_barrier_post(p.bar, st);
    run_phase<0>(p);  xcd_barrier(bar);
    run_phase<1>(p);  xcd_barrier(bar);
    run_phase<2>(p);  xcd_barrier(bar);
    run_phase<3>(p);  xcd_barrier(bar);
    run_phase<4>(p);
    run_phase<5>(p);  xcd_barrier(bar);
    run_phase<6>(p);  xcd_barrier(bar);
    run_phase<7>(p);  xcd_barrier(bar);
    run_phase<8>(p);  xcd_barrier(bar);
    run_phase<9>(p);  xcd_barrier(bar);
    run_phase<10>(p); xcd_barrier(bar);
    run_phase<11>(p); xcd_barrier(bar);
    run_phase<12>(p);
    run_phase<13>(p); xcd_barrier(bar);
    run_phase<14>(p); xcd_barrier(bar);
    run_phase<15>(p);
}

static inline size_t al256(size_t x) { return (x + 255) & ~(size_t)255; }
template <int PH> static void launch_phase(const Params& p, int grid, hipStream_t s) {
    static bool attr = false;
    if (!attr) { (void)hipFuncSetAttribute((const void*)k_phase<PH>, hipFuncAttributeMaxDynamicSharedMemorySize, LDS_BYTES); attr = true; }
    k_phase<PH><<<grid, 512, LDS_BYTES, s>>>(p);
}
template <int PH> static void launch_all(const Params& p, int grid, hipStream_t s) {
    launch_phase<PH>(p, grid, s);
    if constexpr (PH + 1 < NPHASE) launch_all<PH + 1>(p, grid, s);
}

extern "C" void kernel_launch(void* const* d_in, const int* in_sizes, int n_in, void* d_out, int out_size, void* d_ws, size_t ws_size, hipStream_t stream) {
    Params p{};
    p.x_prompt = (const float*)d_in[0]; p.x_sample = (const float*)d_in[1]; p.cache_cmp = (const float*)d_in[2]; p.cache_slc = (const float*)d_in[3];
    p.state_win = (const float*)d_in[4]; p.page_table = (const int*)d_in[5]; p.p_prompt = (const float*)d_in[6]; p.p_sample = (const float*)d_in[7];
    p.rel_bias = (const float*)d_in[8]; p.ln_mix_pre = (const float*)d_in[9]; p.w_in = (const float*)d_in[10];
    p.pe_k = (const float*)d_in[11]; p.w1_k = (const float*)d_in[12]; p.w2_k = (const float*)d_in[13];
    p.pe_v = (const float*)d_in[14]; p.w1_v = (const float*)d_in[15]; p.w2_v = (const float*)d_in[16];
    p.gm_ln_g = (const float*)d_in[17]; p.gm_ln_b = (const float*)d_in[18]; p.gm_ws = (const float*)d_in[19]; p.gm_bs = (const float*)d_in[20];
    p.w_br_nsa = (const float*)d_in[21]; p.w_br_gm = (const float*)d_in[22]; p.w_out = (const float*)d_in[23];
    p.ln_mix_post = (const float*)d_in[24]; p.ln_ffn_pre = (const float*)d_in[25]; p.w_gate = (const float*)d_in[26]; p.w_up = (const float*)d_in[27];
    p.w_down = (const float*)d_in[28]; p.ln_ffn_post = (const float*)d_in[29]; p.w_ple = (const float*)d_in[30]; p.w_ple_gate = (const float*)d_in[31];
    p.ln_ple_post = (const float*)d_in[32];
    p.out = (float*)d_out;
    unsigned char* w = (unsigned char*)d_ws; size_t off = 0;
    auto take = [&](size_t bytes) { void* r = w + off; off = al256(off + bytes); return r; };
    p.bar = (unsigned*)take(16384);
    p.WinT = (bf16_t*)take((size_t)INP * DM * 2); p.WnT = (bf16_t*)take((size_t)DM * QD * 2); p.WgT = (bf16_t*)take((size_t)DM * GMD * 2);
    p.WoT = (bf16_t*)take((size_t)DM * DM * 2); p.WguT = (bf16_t*)take((size_t)2 * DFF * DM * 2); p.WdT = (bf16_t*)take((size_t)DM * DFF * 2);
    p.WpgT = (bf16_t*)take((size_t)DM * DM * 2); p.WpT = (bf16_t*)take((size_t)DM * PLE * 2); p.W1T = (bf16_t*)take((size_t)2 * 256 * 1024 * 2);
    p.H = (bf16_t*)take((size_t)MALL * DM * 2); p.Qb = (bf16_t*)take((size_t)MALL * QD * 2);
    p.CMPb = (bf16_t*)take(((size_t)MP + (size_t)NS * PAST) * 256 * 2); p.SLCb = (bf16_t*)take((size_t)MALL * 256 * 2); p.WINb = (bf16_t*)take((size_t)MALL * 256 * 2);
    p.U = (bf16_t*)take((size_t)MALL * GMD * 2); p.Vg = (bf16_t*)take((size_t)MALL * GMD * 2);
    p.GA = (bf16_t*)take((size_t)MALL * DM * 2); p.GB = (bf16_t*)take((size_t)MALL * DM * 2);
    p.GATE = (float*)take((size_t)MALL * 32 * 4);
    p.PART = (float*)take((size_t)(2048 + NS * 1024) * 4 * 256 * 4); p.PEB = (float*)take(256 * 4);
    p.KCP = (float*)take((size_t)NB * NG * 512 * 64 * 4); p.VCP = (float*)take((size_t)NB * NG * 512 * 64 * 4);
    p.KCS = (float*)take((size_t)NS * NG * 1024 * 64 * 4); p.VCS = (float*)take((size_t)NS * NG * 1024 * 64 * 4); p.KN = (float*)take(NB * NG * 128 * 4);
    p.KCb = (bf16_t*)take((size_t)NB * NG * 512 * 64 * 2); p.VCT = (bf16_t*)take((size_t)NB * NG * 64 * 512 * 2);
    p.SLCvT = (bf16_t*)take((size_t)NB * NG * 64 * SEQ * 2); p.WINvT = (bf16_t*)take((size_t)NB * NG * 64 * SEQ * 2);
    p.OCAT = (bf16_t*)take((size_t)MALL * DM * 2); p.T = (float*)take((size_t)MALL * DM * 4); p.Y1 = (bf16_t*)take((size_t)MALL * DM * 2);
    p.F = (float*)take((size_t)MALL * DM * 4); p.X1 = (float*)take((size_t)MALL * DM * 4); p.H2 = (bf16_t*)take((size_t)MALL * DM * 2);
    p.ACT = (bf16_t*)take((size_t)MALL * DFF * 2); p.X2 = (float*)take((size_t)MALL * DM * 4); p.X2b = (bf16_t*)take((size_t)MALL * DM * 2);
    p.Pb = (bf16_t*)take((size_t)MALL * PLE * 2);
    if (off > ws_size) { fprintf(stderr, "workspace too small: need %zu have %zu\n", off, ws_size); return; }
    (void)hipMemsetAsync(p.OCAT + (size_t)(MP + NS) * DM, 0, (size_t)(MALL - MP - NS) * DM * 2, stream);
#if MK_MULTI
    launch_all<0>(p, 256, stream);
#else
    constexpr size_t kDynLds = LDS_BYTES + 16;
    static int grid = 0;
    if (!grid) {
        int dev = 0, cus = 0, per_cu = 0;
        (void)hipGetDevice(&dev);
        (void)hipDeviceGetAttribute(&cus, hipDeviceAttributeMultiprocessorCount, dev);
        (void)hipFuncSetAttribute((const void*)k_all, hipFuncAttributeMaxDynamicSharedMemorySize, (int)kDynLds);
        (void)hipOccupancyMaxActiveBlocksPerMultiprocessor(&per_cu, (const void*)k_all, 512, kDynLds);
        grid = cus * (per_cu < 1 ? per_cu : 1);
        if (grid <= 0) { fprintf(stderr, "k_all: occupancy query says %d blocks per CU\n", per_cu); grid = 0; return; }
    }
    (void)hipMemsetAsync(p.bar, 0, XCD_BAR_WORDS * sizeof(unsigned), stream);
    k_all<<<grid, 512, kDynLds, stream>>>(p);
#endif
}
```

```cpp
#include <hip/hip_runtime.h>
#include <stdint.h>
#include <cstdio>

typedef unsigned short bf16_t;
typedef short bf16x8 __attribute__((ext_vector_type(8)));
typedef float f32x4 __attribute__((ext_vector_type(4)));
typedef float f32x2 __attribute__((ext_vector_type(2)));
typedef unsigned u32x4 __attribute__((ext_vector_type(4)));
typedef unsigned u32x2 __attribute__((ext_vector_type(2)));
#define LAS __attribute__((address_space(3)))

constexpr int DM = 1024, NB = 4, SEQ = 8192, MP = NB * SEQ, NS = 32, MALL = MP + 256, PAST = 16384, PAGE = 128, NPG = 128;
constexpr int NH = 8, NG = 2, HPG = 4, DH = 64, QD = 512, WIN = 512, GMD = 512, DFF = 2816, PLE = 256, IND = 4376, INP = 4608;
constexpr int NCP = 511, NCS = 1023;
constexpr float EPS = 1e-6f;
constexpr float LOG2E = 1.4426950408889634f, QSCALE = 0.125f * LOG2E;
constexpr long O_YP = 0, O_YS = 33554432, O_CMPP = 33587200, O_SLCP = 41975808, O_WINP = 50364416, O_CMPS = 50888704,
               O_SLCS = 50896896, O_WINS = 50905088, O_GMV = 55099392;

struct Params {
    const float *x_prompt, *x_sample, *cache_cmp, *cache_slc, *state_win; const int* page_table;
    const float *p_prompt, *p_sample, *rel_bias, *ln_mix_pre, *w_in, *pe_k, *w1_k, *w2_k, *pe_v, *w1_v, *w2_v;
    const float *gm_ln_g, *gm_ln_b, *gm_ws, *gm_bs, *w_br_nsa, *w_br_gm, *w_out, *ln_mix_post, *ln_ffn_pre;
    const float *w_gate, *w_up, *w_down, *ln_ffn_post, *w_ple, *w_ple_gate, *ln_ple_post;
    float* out;
    unsigned* bar;
    bf16_t *WinT, *WnT, *WgT, *WoT, *WguT, *WdT, *WpgT, *WpT, *W1T;
    bf16_t *H, *Qb, *CMPb, *SLCb, *WINb, *U, *Vg, *GA, *GB;
    float* GATE;
    float *PART, *PEB, *KCP, *VCP, *KCS, *VCS, *KN;
    bf16_t *KCb, *VCT, *SLCvT, *WINvT;
    bf16_t* OCAT; float* T; bf16_t* Y1; float* F; float* X1; bf16_t* H2; bf16_t* ACT; float* X2; bf16_t* X2b; bf16_t* Pb;
};

__device__ __forceinline__ unsigned cvt_pk_bf16(float lo, float hi) { unsigned r; asm volatile("v_cvt_pk_bf16_f32 %0, %1, %2" : "=v"(r) : "v"(lo), "v"(hi)); return r; }
__device__ __forceinline__ bf16_t f2bf(float f) { return (bf16_t)(cvt_pk_bf16(f, 0.f) & 0xffffu); }
__device__ __forceinline__ float bf2f(bf16_t h) { return __uint_as_float(((unsigned)h) << 16); }
__device__ __forceinline__ float bflo(unsigned w) { return __uint_as_float(w << 16); }
__device__ __forceinline__ float bfhi(unsigned w) { return __uint_as_float(w & 0xffff0000u); }
__device__ __forceinline__ float ex2(float x) { return __builtin_amdgcn_exp2f(x); }
__device__ __forceinline__ float sigmoidf_(float x) { return 1.0f / (1.0f + __expf(-x)); }
__device__ __forceinline__ float siluf_(float x) { return x * sigmoidf_(x); }
__device__ __forceinline__ float geluf_(float x) {
    const float u = 0.7978845608028654f * (x + 0.044715f * x * x * x);
    const float e = __expf(2.0f * u);
    const float th = 1.0f - 2.0f / (e + 1.0f);
    return 0.5f * x * (1.0f + th);
}
__device__ __forceinline__ float wave_sum(float v) {
#pragma unroll
    for (int o = 32; o > 0; o >>= 1) v += __shfl_xor(v, o);
    return v;
}
__device__ __forceinline__ float wave_max(float v) {
#pragma unroll
    for (int o = 32; o > 0; o >>= 1) v = fmaxf(v, __shfl_xor(v, o));
    return v;
}
__device__ __forceinline__ int t5_bucket(int d) {
    if (d < 16) return d;
    if (d >= 128) return 31;
    const int b = 16 + (int)(__logf((float)d * (1.0f / 16.0f)) * (16.0f / 2.0794415416798357f));
    return b < 31 ? b : 31;
}

extern __shared__ __attribute__((aligned(16))) unsigned char smem[];

constexpr int BM = 256, BK = 64, HALF = 128, HT = HALF * BK, GEMM_LDS = 8 * HT * 2;
__device__ __forceinline__ int lds_byte(int r, int c) { const int st = (r >> 4) * 2 + (c >> 5), rr = r & 15, cc = c & 31, ob = rr * 64 + cc * 2; return st * 1024 + (ob ^ (((ob >> 9) & 1) << 5)); }
__device__ __forceinline__ void stage_rc(int b, int& R, int& C) { const int st = b / 1024, sb = b % 1024, swz = sb ^ (((sb >> 9) & 1) << 5); R = (st >> 1) * 16 + swz / 64; C = (st & 1) * 32 + (swz % 64) / 2; }

constexpr int HTB = HALF * BK * 2;
template <class F>
__device__ __forceinline__ void for_each_frag(const f32x4 (&acc)[2][2][4][2], int brow, int bcol, int wr, int wc, int fr, int fq, F&& f) {
#pragma unroll
    for (int ai = 0; ai < 2; ++ai)
#pragma unroll
        for (int m = 0; m < 4; ++m)
#pragma unroll
            for (int bj = 0; bj < 2; ++bj)
#pragma unroll
                for (int n = 0; n < 2; ++n)
                    f(brow + ai * HALF + wr * 64 + m * 16 + fr, bcol + bj * HALF + wc * 32 + n * 16 + fq * 4, acc[ai][bj][m][n]);
}

struct ZNone { __device__ __forceinline__ size_t a(int) const { return 0; } __device__ __forceinline__ size_t b(int) const { return 0; } };
template <class Epi, class ZMap = ZNone>
__device__ __forceinline__ void gemm_phase(const bf16_t* A, int lda, const bf16_t* Bt, int K, int nM, int nN, const Epi& E, int nZ = 1, ZMap zm = ZMap(), int kstepA_el = BK) {
    LAS unsigned char* lds = (LAS unsigned char*)smem;
    const int tid = threadIdx.x, wid = __builtin_amdgcn_readfirstlane(tid >> 6), lane = tid & 63, wr = wid >> 2, wc = wid & 3, fr = lane & 15, fq = lane >> 4;
    const int nt = K / BK, nmn = nM * nN, nu = nmn * nZ, G = gridDim.x;
    int u = blockIdx.x;
    if (u >= nu) return;
    unsigned voffA[2], voffB[2];
#pragma unroll
    for (int i = 0; i < 2; ++i) { int R, C; stage_rc(tid * 16 + i * 8192, R, C); voffA[i] = (unsigned)(R * lda + C) * 2u; voffB[i] = (unsigned)(R * K + C) * 2u; }
    const size_t kstep = (size_t)(BK * 2), kstepA = (size_t)kstepA_el * 2;
    const size_t hstepA = (size_t)HALF * lda * 2, hstepB = (size_t)HALF * K * 2, tstepA = 2 * hstepA, tstepB = 2 * hstepB;
    const unsigned ldsw = (unsigned)wid * 1024u;
    const int aoff = lds_byte(wr * 64 + fr, fq * 8), boff = lds_byte(wc * 32 + fr, fq * 8);
#define PG8_SA(b, h) (((b) * 2 + (h)) * HTB)
#define PG8_SB(b, h) ((4 + (b) * 2 + (h)) * HTB)
#define PG8_STAGE(bufoff, gbase, voff) do { _Pragma("unroll") for (int _i = 0; _i < 2; ++_i) \
        __builtin_amdgcn_global_load_lds((const unsigned*)((const char*)(gbase) + (voff)[_i]), (LAS unsigned*)(lds + (bufoff) + ldsw + _i * 8192), 16, 0, 0); } while (0)
#define PG8_LDA(dst, b, h) do { _Pragma("unroll") for (int m = 0; m < 4; ++m) _Pragma("unroll") for (int k = 0; k < 2; ++k) dst[m][k] = *(const LAS bf16x8*)(lds + PG8_SA(b, h) + aoff + m * 2048 + k * 1024); } while (0)
#define PG8_LDB(dst, b, h) do { _Pragma("unroll") for (int n = 0; n < 2; ++n) _Pragma("unroll") for (int k = 0; k < 2; ++k) dst[n][k] = *(const LAS bf16x8*)(lds + PG8_SB(b, h) + boff + n * 2048 + k * 1024); } while (0)
#define PG8_MMA(ai, bj, At, Bt_) do { __builtin_amdgcn_s_setprio(1); _Pragma("unroll") for (int m = 0; m < 4; ++m) _Pragma("unroll") for (int n = 0; n < 2; ++n) _Pragma("unroll") for (int k = 0; k < 2; ++k) \
        acc[ai][bj][m][n] = __builtin_amdgcn_mfma_f32_16x16x32_bf16(Bt_[n][k], At[m][k], acc[ai][bj][m][n], 0, 0, 0); __builtin_amdgcn_s_setprio(0); } while (0)
#define PG8_WAIT_V(n) asm volatile("s_waitcnt vmcnt(" #n ")" ::: "memory")
#define PG8_WAIT_L(n) asm volatile("s_waitcnt lgkmcnt(" #n ")" ::: "memory")
#define PG8_BAR __builtin_amdgcn_s_barrier()
#define PG8_SCHED __builtin_amdgcn_sched_barrier(0)
    f32x4 acc[2][2][4][2];
#pragma unroll
    for (int a = 0; a < 2; ++a)
#pragma unroll
        for (int b = 0; b < 2; ++b)
#pragma unroll
            for (int m = 0; m < 4; ++m)
#pragma unroll
                for (int n = 0; n < 2; ++n) acc[a][b][m][n] = (f32x4){0.f, 0.f, 0.f, 0.f};
    bf16x8 At[4][2], B0[2][2], B1[2][2];
    int z = u / nmn, pm = (u - z * nmn) / nN, pn = (u - z * nmn) - pm * nN;
    const char* cA = (const char*)(A + zm.a(z)) + (size_t)pm * tstepA; const char* cB = (const char*)(Bt + zm.b(z)) + (size_t)pn * tstepB;
    PG8_STAGE(PG8_SB(0, 0), cB, voffB); PG8_STAGE(PG8_SA(0, 0), cA, voffA); PG8_STAGE(PG8_SB(0, 1), cB + hstepB, voffB); PG8_STAGE(PG8_SA(0, 1), cA + hstepA, voffA);
    if (wr == 1) PG8_BAR;
    PG8_WAIT_V(4); PG8_BAR;
    PG8_STAGE(PG8_SB(1, 0), cB + kstep, voffB); PG8_STAGE(PG8_SA(1, 0), cA + kstepA, voffA); PG8_STAGE(PG8_SB(1, 1), cB + hstepB + kstep, voffB);
    PG8_WAIT_V(6); PG8_BAR;
    for (;;) {
        const int un = u + G; const bool has_next = un < nu;
        const int nz = has_next ? un / nmn : z, npm = has_next ? (un - nz * nmn) / nN : pm, npn = has_next ? (un - nz * nmn) - npm * nN : pn;
        const char* nA = (const char*)(A + zm.a(nz)) + (size_t)npm * tstepA; const char* nB = (const char*)(Bt + zm.b(nz)) + (size_t)npn * tstepB;
        for (int t = 0; t < nt; t += 2) {
            const bool last = (t == nt - 2);
            const char* a1 = cA + (size_t)(t + 1) * kstepA;
            const char* a2 = last ? nA : cA + (size_t)(t + 2) * kstepA; const char* b2 = last ? nB : cB + (size_t)(t + 2) * kstep;
            const char* a3 = a2 + kstepA; const char* b3 = b2 + kstep;
            PG8_LDB(B0, 0, 0); PG8_SCHED; PG8_LDA(At, 0, 0); PG8_STAGE(PG8_SA(1, 1), a1 + hstepA, voffA);
            PG8_WAIT_L(8); PG8_BAR; PG8_WAIT_L(0); PG8_MMA(0, 0, At, B0); PG8_BAR; PG8_SCHED;
            PG8_LDB(B1, 0, 1); PG8_STAGE(PG8_SB(0, 0), b2, voffB);
            PG8_BAR; PG8_WAIT_L(0); PG8_MMA(0, 1, At, B1); PG8_BAR;
            PG8_LDA(At, 0, 1); PG8_STAGE(PG8_SA(0, 0), a2, voffA);
            PG8_BAR; PG8_WAIT_L(0); PG8_MMA(1, 0, At, B0); PG8_BAR; PG8_SCHED;
            PG8_STAGE(PG8_SB(0, 1), b2 + hstepB, voffB);
            PG8_WAIT_V(6); PG8_BAR; PG8_MMA(1, 1, At, B1); PG8_BAR;
            PG8_LDB(B0, 1, 0); PG8_SCHED; PG8_LDA(At, 1, 0); PG8_STAGE(PG8_SA(0, 1), a2 + hstepA, voffA);
            PG8_WAIT_L(8); PG8_BAR; PG8_WAIT_L(0); PG8_MMA(0, 0, At, B0); PG8_BAR; PG8_SCHED;
            PG8_LDB(B1, 1, 1); PG8_STAGE(PG8_SB(1, 0), b3, voffB);
            PG8_BAR; PG8_WAIT_L(0); PG8_MMA(0, 1, At, B1); PG8_BAR;
            PG8_LDA(At, 1, 1); PG8_STAGE(PG8_SA(1, 0), a3, voffA);
            PG8_BAR; PG8_WAIT_L(0); PG8_MMA(1, 0, At, B0); PG8_BAR; PG8_SCHED;
            PG8_STAGE(PG8_SB(1, 1), b3 + hstepB, voffB);
            PG8_WAIT_V(6); PG8_BAR; PG8_MMA(1, 1, At, B1); PG8_BAR;
        }
        E(acc, pm * BM, pn * BM + (z << 20), wr, wc, fr, fq);
        if (!has_next) break;
#pragma unroll
        for (int a = 0; a < 2; ++a)
#pragma unroll
            for (int b = 0; b < 2; ++b)
#pragma unroll
                for (int m = 0; m < 4; ++m)
#pragma unroll
                    for (int n = 0; n < 2; ++n) acc[a][b][m][n] = (f32x4){0.f, 0.f, 0.f, 0.f};
        u = un; z = nz; pm = npm; pn = npn; cA = nA; cB = nB;
    }
    PG8_WAIT_V(0);
    if (wr == 0) PG8_BAR;
    PG8_BAR;
#undef PG8_SA
#undef PG8_SB
#undef PG8_STAGE
#undef PG8_LDA
#undef PG8_LDB
#undef PG8_MMA
#undef PG8_WAIT_V
#undef PG8_WAIT_L
#undef PG8_BAR
#undef PG8_SCHED
}

__device__ __forceinline__ void st_bf16x4(bf16_t* p, f32x4 v) { u32x2 w; w.x = cvt_pk_bf16(v[0], v[1]); w.y = cvt_pk_bf16(v[2], v[3]); *(u32x2*)p = w; }

struct EpiIn {
    const Params& p;
    __device__ __forceinline__ void operator()(const f32x4 (&acc)[2][2][4][2], int brow, int bcol, int wr, int wc, int fr, int fq) const {
        const int pn = bcol >> 8;
        const Params& P = p;
        if (pn < 2) {
            for_each_frag(acc, brow, bcol, wr, wc, fr, fq, [&](int row, int col, f32x4 v) { st_bf16x4(P.Qb + (size_t)row * QD + col, v * QSCALE); });
        } else if (pn < 5) {
            bf16_t* cp = pn == 2 ? P.CMPb : pn == 3 ? P.SLCb : P.WINb;
            for_each_frag(acc, brow, bcol, wr, wc, fr, fq, [&](int row, int col, f32x4 v) {
                const int c = col & 255;
                if (pn != 2 || row < MP) st_bf16x4(cp + (size_t)row * 256 + c, v);
                if (pn >= 3 && c >= 128 && row < MP) {
                    bf16_t* vt = (pn == 3 ? P.SLCvT : P.WINvT) + ((size_t)(row >> 13) * 128 + (c - 128)) * SEQ + (row & (SEQ - 1));
                    vt[0] = f2bf(v[0]); vt[SEQ] = f2bf(v[1]); vt[2 * SEQ] = f2bf(v[2]); vt[3 * SEQ] = f2bf(v[3]);
                }
                if (pn < 4) {
                    if (row < MP) *(f32x4*)(P.out + (pn == 2 ? O_CMPP : O_SLCP) + (size_t)row * 256 + c) = v;
                    else if (row < MP + NS) *(f32x4*)(P.out + (pn == 2 ? O_CMPS : O_SLCS) + (size_t)(row - MP) * 256 + c) = v;
                } else {
                    if (row < MP) { const int t = row & (SEQ - 1), b = row >> 13; if (t >= SEQ - WIN) *(f32x4*)(P.out + O_WINP + ((size_t)b * WIN + (t - (SEQ - WIN))) * 256 + c) = v; }
                    else if (row < MP + NS) *(f32x4*)(P.out + O_WINS + ((size_t)(row - MP) * WIN + (WIN - 1)) * 256 + c) = v;
                }
            });
        } else if (pn < 9) {
            bf16_t* dst = pn < 7 ? P.U : P.Vg; const int c0 = pn < 7 ? 1280 : 1792;
            for_each_frag(acc, brow, bcol, wr, wc, fr, fq, [&](int row, int col, f32x4 v) {
                f32x4 g; g[0] = geluf_(v[0]); g[1] = geluf_(v[1]); g[2] = geluf_(v[2]); g[3] = geluf_(v[3]);
                st_bf16x4(dst + (size_t)row * GMD + (col - c0), g); });
        } else if (pn < 17) {
            bf16_t* dst = pn < 13 ? P.GA : P.GB; const int c0 = pn < 13 ? 2304 : 3328;
            for_each_frag(acc, brow, bcol, wr, wc, fr, fq, [&](int row, int col, f32x4 v) {
                f32x4 g; g[0] = sigmoidf_(v[0]); g[1] = sigmoidf_(v[1]); g[2] = sigmoidf_(v[2]); g[3] = sigmoidf_(v[3]);
                st_bf16x4(dst + (size_t)row * DM + (col - c0), g); });
        } else {
            for_each_frag(acc, brow, bcol, wr, wc, fr, fq, [&](int row, int col, f32x4 v) {
                const int c = col & 255;
                if (c < 24) { f32x4 g; g[0] = sigmoidf_(v[0]); g[1] = sigmoidf_(v[1]); g[2] = sigmoidf_(v[2]); g[3] = sigmoidf_(v[3]); *(f32x4*)(P.GATE + (size_t)row * 32 + c) = g; } });
        }
    }
};
struct EpiBrA {
    const bf16_t* GA; float* T;
    __device__ __forceinline__ void operator()(const f32x4 (&acc)[2][2][4][2], int brow, int bcol, int wr, int wc, int fr, int fq) const {
        for_each_frag(acc, brow, bcol, wr, wc, fr, fq, [&](int row, int col, f32x4 v) {
            const u32x2 g = *(const u32x2*)(GA + (size_t)row * DM + col);
            f32x4 o; o[0] = v[0] * bflo(g.x); o[1] = v[1] * bfhi(g.x); o[2] = v[2] * bflo(g.y); o[3] = v[3] * bfhi(g.y);
            *(f32x4*)(T + (size_t)row * DM + col) = o; });
    }
};
struct EpiBrB {
    const bf16_t* GB; const float* T; bf16_t* Y1;
    __device__ __forceinline__ void operator()(const f32x4 (&acc)[2][2][4][2], int brow, int bcol, int wr, int wc, int fr, int fq) const {
        for_each_frag(acc, brow, bcol, wr, wc, fr, fq, [&](int row, int col, f32x4 v) {
            const u32x2 g = *(const u32x2*)(GB + (size_t)row * DM + col);
            const f32x4 t = *(const f32x4*)(T + (size_t)row * DM + col);
            f32x4 o; o[0] = t[0] + v[0] * bflo(g.x); o[1] = t[1] + v[1] * bfhi(g.x); o[2] = t[2] + v[2] * bflo(g.y); o[3] = t[3] + v[3] * bfhi(g.y);
            st_bf16x4(Y1 + (size_t)row * DM + col, o); });
    }
};
struct EpiF32 {
    float* F; int ld;
    __device__ __forceinline__ void operator()(const f32x4 (&acc)[2][2][4][2], int brow, int bcol, int wr, int wc, int fr, int fq) const {
        for_each_frag(acc, brow, bcol, wr, wc, fr, fq, [&](int row, int col, f32x4 v) { *(f32x4*)(F + (size_t)row * ld + col) = v; });
    }
};
struct EpiPart {
    float* PART;
    __device__ __forceinline__ void operator()(const f32x4 (&acc)[2][2][4][2], int brow, int bcol, int wr, int wc, int fr, int fq) const {
        const int z = bcol >> 20;
        for_each_frag(acc, brow, 0, wr, wc, fr, fq, [&](int row, int col, f32x4 v) { *(f32x4*)(PART + ((size_t)row * 4 + z) * 256 + col) = v; });
    }
};
struct ZCmp { __device__ __forceinline__ size_t a(int z) const { return (size_t)z * 64; } __device__ __forceinline__ size_t b(int z) const { return (size_t)(z >> 1) * 256 * 1024; } };
struct EpiSwiGLU {
    bf16_t* ACT;
    __device__ __forceinline__ void operator()(const f32x4 (&acc)[2][2][4][2], int brow, int bcol, int wr, int wc, int fr, int fq) const {
        for_each_frag(acc, brow, bcol, wr, wc, fr, fq, [&](int row, int col, f32x4 v) {
            *(unsigned*)(ACT + (size_t)row * DFF + (col >> 1)) = cvt_pk_bf16(siluf_(v[0]) * v[1], siluf_(v[2]) * v[3]); });
    }
};
struct EpiPleGate {
    const float* E; float* F;
    __device__ __forceinline__ void operator()(const f32x4 (&acc)[2][2][4][2], int brow, int bcol, int wr, int wc, int fr, int fq) const {
        for_each_frag(acc, brow, bcol, wr, wc, fr, fq, [&](int row, int col, f32x4 v) {
            const f32x4 e = *(const f32x4*)(E + (size_t)row * DM + col);
            f32x4 o; o[0] = sigmoidf_(v[0]) * e[0]; o[1] = sigmoidf_(v[1]) * e[1]; o[2] = sigmoidf_(v[2]) * e[2]; o[3] = sigmoidf_(v[3]) * e[3];
            *(f32x4*)(F + (size_t)row * DM + col) = o; });
    }
};

template <class Map>
__device__ __forceinline__ void transpose_tile(const float* W, int K, int N, bf16_t* Wt, int ldk, int kt, int ntile, Map map) {
    LAS float* tile = (LAS float*)smem;
    const int t = threadIdx.x;
    __syncthreads();
#pragma unroll
    for (int i = 0; i < 2; ++i) {
        const int k = (t >> 4) + 32 * i, n = (t & 15) * 4, gn = ntile * 64 + n;
        f32x4 v = (f32x4){0.f, 0.f, 0.f, 0.f};
        if (gn < N) v = *(const f32x4*)(W + (size_t)(kt * 64 + k) * N + gn);
        tile[k * 65 + n] = v[0]; tile[k * 65 + n + 1] = v[1]; tile[k * 65 + n + 2] = v[2]; tile[k * 65 + n + 3] = v[3];
    }
    __syncthreads();
    const int n = t >> 3, kc = (t & 7) * 8, gn = ntile * 64 + n;
    if (gn < N) {
        u32x4 w;
        w.x = cvt_pk_bf16(tile[(kc + 0) * 65 + n], tile[(kc + 1) * 65 + n]); w.y = cvt_pk_bf16(tile[(kc + 2) * 65 + n], tile[(kc + 3) * 65 + n]);
        w.z = cvt_pk_bf16(tile[(kc + 4) * 65 + n], tile[(kc + 5) * 65 + n]); w.w = cvt_pk_bf16(tile[(kc + 6) * 65 + n], tile[(kc + 7) * 65 + n]);
        *(u32x4*)(Wt + (size_t)map(gn) * ldk + kt * 64 + kc) = w;
    }
}
template <class Map>
__device__ __forceinline__ void transpose_all(const float* W, int K, int N, bf16_t* Wt, int ldk, Map map, int& base) {
    const int nkt = K / 64, nnt = (N + 63) / 64, ntl = nkt * nnt;
    for (int it = blockIdx.x; it < base + ntl; it += gridDim.x) {
        if (it < base) continue;
        const int l = it - base;
        transpose_tile(W, K, N, Wt, ldk, l / nnt, l % nnt, map);
    }
    base += ntl;
}
__device__ __forceinline__ int map_win(int n) {
    if (n < 1280) return n;
    if (n < 1304) return 4352 + (n - 1280);
    if (n < 2328) return 1280 + (n - 1304);
    return 2304 + (n - 2328);
}

__device__ __forceinline__ float row_rstd(const f32x4 (&v)[4]) {
    float s = 0.f;
#pragma unroll
    for (int k = 0; k < 4; ++k) s += v[k][0] * v[k][0] + v[k][1] * v[k][1] + v[k][2] * v[k][2] + v[k][3] * v[k][3];
    s = wave_sum(s);
    return rsqrtf(s * (1.0f / DM) + EPS);
}
__device__ __forceinline__ const float* xrow_ptr(const Params& p, int row) {
    return row < MP ? p.x_prompt + (size_t)row * DM : p.x_sample + (size_t)(row - MP) * DM;
}

__device__ void phase_prologue(const Params& p) {
    const int wid = threadIdx.x >> 6, lane = threadIdx.x & 63;
    const int gw = blockIdx.x * 8 + wid, nw = gridDim.x * 8;
    int base = 0;
    transpose_all(p.w_in, DM, IND, p.WinT, DM, [](int n) { return map_win(n); }, base);
    transpose_all(p.w_br_nsa, QD, DM, p.WnT, QD, [](int n) { return n; }, base);
    transpose_all(p.w_br_gm, GMD, DM, p.WgT, GMD, [](int n) { return n; }, base);
    transpose_all(p.w_out, DM, DM, p.WoT, DM, [](int n) { return n; }, base);
    transpose_all(p.w_gate, DM, DFF, p.WguT, DM, [](int n) { return 2 * n; }, base);
    transpose_all(p.w_up, DM, DFF, p.WguT, DM, [](int n) { return 2 * n + 1; }, base);
    transpose_all(p.w_down, DFF, DM, p.WdT, DFF, [](int n) { return n; }, base);
    transpose_all(p.w_ple_gate, DM, DM, p.WpgT, DM, [](int n) { return n; }, base);
    transpose_all(p.w_ple, PLE, DM, p.WpT, PLE, [](int n) { return n; }, base);
    for (int kv = 0; kv < 2; ++kv) for (int j = 0; j < 2; ++j)
        transpose_all((kv ? p.w1_v : p.w1_k) + (size_t)j * 1024 * 128, 1024, 128, p.W1T + ((size_t)kv * 256 + j * 128) * 1024, 1024, [](int n) { return n; }, base);
    __syncthreads();
    for (int i = blockIdx.x * 512 + threadIdx.x; i < (INP - IND) * DM / 8; i += gridDim.x * 512) ((u32x4*)(p.WinT + (size_t)IND * DM))[i] = (u32x4){0u, 0u, 0u, 0u};
    for (int row = gw; row < MALL; row += nw) {
        u32x2* hd = (u32x2*)(p.H + (size_t)row * DM);
        if (row < MP + NS) {
            const float* xr = xrow_ptr(p, row);
            f32x4 v[4];
#pragma unroll
            for (int k = 0; k < 4; ++k) v[k] = *(const f32x4*)(xr + lane * 4 + k * 256);
            const float r = row_rstd(v);
#pragma unroll
            for (int k = 0; k < 4; ++k) { const f32x4 g = *(const f32x4*)(p.ln_mix_pre + lane * 4 + k * 256); const f32x4 o = v[k] * r * g; u32x2 w; w.x = cvt_pk_bf16(o[0], o[1]); w.y = cvt_pk_bf16(o[2], o[3]); hd[lane + k * 64] = w; }
            const float* pr = row < MP ? p.p_prompt + (size_t)row * PLE : p.p_sample + (size_t)(row - MP) * PLE;
            const f32x4 pv = *(const f32x4*)(pr + lane * 4);
            u32x2 w; w.x = cvt_pk_bf16(pv[0], pv[1]); w.y = cvt_pk_bf16(pv[2], pv[3]);
            ((u32x2*)(p.Pb + (size_t)row * PLE))[lane] = w;
        } else {
#pragma unroll
            for (int k = 0; k < 4; ++k) hd[lane + k * 64] = (u32x2){0u, 0u};
            ((u32x2*)(p.Pb + (size_t)row * PLE))[lane] = (u32x2){0u, 0u};
        }
    }
    for (int r2 = gw; r2 < NS * PAST / 2; r2 += nw) {
        const int r = r2 * 2 + (lane >> 5), b = r >> 14, pos = r & (PAST - 1), l5 = lane & 31;
        const float* s = p.cache_cmp + ((size_t)p.page_table[b * NPG + (pos >> 7)] * PAGE + (pos & 127)) * 256 + l5 * 8;
        const f32x4 a = *(const f32x4*)s, c = *(const f32x4*)(s + 4);
        u32x4 w; w.x = cvt_pk_bf16(a[0], a[1]); w.y = cvt_pk_bf16(a[2], a[3]); w.z = cvt_pk_bf16(c[0], c[1]); w.w = cvt_pk_bf16(c[2], c[3]);
        *(u32x4*)(p.CMPb + ((size_t)MP + r) * 256 + l5 * 8) = w;
    }
    if (gw < 4) {
        const int kv = gw >> 1, h = (gw & 1) * 64 + lane;
        const float* pe = kv ? p.pe_v : p.pe_k; const float* w1 = kv ? p.w1_v : p.w1_k;
        float s = 0.f;
        for (int k = 0; k < 2048; ++k) s += pe[k] * w1[(size_t)k * 128 + h];
        p.PEB[kv * 128 + h] = s;
    }
    for (int i = blockIdx.x * 512 + threadIdx.x; i < NS * (WIN - 1) * 64; i += gridDim.x * 512) {
        const int b = i / ((WIN - 1) * 64), r = i % ((WIN - 1) * 64);
        ((f32x4*)(p.out + O_WINS + (size_t)b * WIN * 256))[r] = ((const f32x4*)(p.state_win + (size_t)b * WIN * 256 + 256))[r];
    }
}

__device__ void phase_cmp_final(const Params& p) {
    const int wid = threadIdx.x >> 6, lane = threadIdx.x & 63;
    LAS float* hb = (LAS float*)smem + wid * 128;
    const int nitem_p = NB * NCP * 4, nitem_s = NS * NCS * 4;
#pragma unroll 1
    for (int it = blockIdx.x * 8 + wid; it < nitem_p + nitem_s; it += gridDim.x * 8) {
        const bool smp = it >= nitem_p; const int l = smp ? it - nitem_p : it;
        const int z = l & 3, kv = z >> 1, g = z & 1, r = l >> 2;
        const int nc = smp ? NCS : NCP, seq = r / nc, n = r % nc;
        const size_t r0 = smp ? (size_t)2048 + (size_t)seq * 1024 + n : (size_t)seq * 512 + n;
        const float* p0 = p.PART + (r0 * 4 + z) * 256;
        const float* p1 = p.PART + ((r0 + 1) * 4 + z) * 256 + 128;
        const float* w2 = kv ? p.w2_v : p.w2_k;
#pragma unroll
        for (int i = 0; i < 2; ++i) { const int h = lane + 64 * i; hb[h] = siluf_(p0[h] + p1[h] + p.PEB[kv * 128 + h]); }
        __builtin_amdgcn_wave_barrier();
        float s = 0.f;
#pragma unroll 4
        for (int h = 0; h < 128; ++h) s += hb[h] * w2[h * 64 + lane];
        __builtin_amdgcn_wave_barrier();
        float* dst = smp ? (kv ? p.VCS : p.KCS) + (((size_t)seq * NG + g) * 1024 + n) * 64 : (kv ? p.VCP : p.KCP) + (((size_t)seq * NG + g) * 512 + n) * 64;
        dst[lane] = s;
        if (!smp) {
            if (kv == 0) p.KCb[(((size_t)seq * NG + g) * 512 + n) * 64 + lane] = f2bf(s);
            else { bf16_t* vt = p.VCT + (((size_t)seq * NG + g) * 64 + lane) * 512; vt[n] = f2bf(s); if (n == NCP - 1) vt[NCP] = 0; }
        }
    }
#pragma unroll 1
    for (int it = blockIdx.x * 8 + wid; it < NB * NG * 128; it += gridDim.x * 8) {
        const int j = it & 127, g = (it >> 7) & 1, b = it >> 8;
        const bf16_t* kr = p.SLCb + ((size_t)b * SEQ + j * 64 + lane) * 256 + g * 64;
        float q = 0.f;
#pragma unroll
        for (int c = 0; c < 8; ++c) { const u32x4 w = *(const u32x4*)(kr + c * 8);
            q += bflo(w.x) * bflo(w.x) + bfhi(w.x) * bfhi(w.x) + bflo(w.y) * bflo(w.y) + bfhi(w.y) * bfhi(w.y) + bflo(w.z) * bflo(w.z) + bfhi(w.z) * bfhi(w.z) + bflo(w.w) * bflo(w.w) + bfhi(w.w) * bfhi(w.w); }
        q = wave_max(q);
        if (lane == 0) p.KN[it] = q;
    }
}

template <bool SAMPLE>
__device__ __forceinline__ void kv_row_ptr(const Params& p, int branch  , int b, int pos, int kv, int g, const bf16_t*& pb, const float*& pf) {
    const int off = kv * 128 + g * 64;
    if (!SAMPLE) { pf = nullptr; pb = (branch == 1 ? p.SLCb : p.WINb) + ((size_t)b * SEQ + pos) * 256 + off; }
    else if (pos >= PAST) { pf = nullptr; pb = (branch == 1 ? p.SLCb : p.WINb) + ((size_t)MP + b) * 256 + off; }
    else if (branch == 1) { pb = nullptr; pf = p.cache_slc + ((size_t)p.page_table[b * NPG + (pos >> 7)] * PAGE + (pos & 127)) * 256 + off; }
    else { pb = nullptr; pf = p.state_win + ((size_t)b * WIN + (pos - (PAST - WIN))) * 256 + off; }
}
__device__ __forceinline__ void dot4x64(const bf16_t* pb, const float* pf, const LAS float* qs_, float (&s)[4]) {
    s[0] = s[1] = s[2] = s[3] = 0.f;
    const LAS float* qs = qs_; asm volatile("" : "+v"(qs));
    if (pf) {
#pragma unroll 2
        for (int c = 0; c < 16; ++c) {
            const f32x4 kx = *(const f32x4*)(pf + c * 4);
#pragma unroll
            for (int h = 0; h < 4; ++h) { const f32x4 q = *(const LAS f32x4*)(qs + h * 64 + c * 4); s[h] += q[0] * kx[0] + q[1] * kx[1] + q[2] * kx[2] + q[3] * kx[3]; }
        }
    } else {
#pragma unroll 1
        for (int c = 0; c < 8; ++c) {
            const u32x4 w = *(const u32x4*)(pb + c * 8);
            const float k0 = bflo(w.x), k1 = bfhi(w.x), k2 = bflo(w.y), k3 = bfhi(w.y), k4 = bflo(w.z), k5 = bfhi(w.z), k6 = bflo(w.w), k7 = bfhi(w.w);
#pragma unroll
            for (int h = 0; h < 4; ++h) {
                const f32x4 qa = *(const LAS f32x4*)(qs + h * 64 + c * 8), qb = *(const LAS f32x4*)(qs + h * 64 + c * 8 + 4);
                s[h] += qa[0] * k0 + qa[1] * k1 + qa[2] * k2 + qa[3] * k3 + qb[0] * k4 + qb[1] * k5 + qb[2] * k6 + qb[3] * k7;
            }
        }
    }
}
template <bool SAMPLE>
__device__ __forceinline__ void attn_chunk(const Params& p, int branch, int b, int g, int t, int pos0, int lo, int hi,
                                           float (&m)[4], float (&l)[4], float (&o)[4], const LAS float* qs, LAS float* pbk, const LAS float* relb, int lane) {
    const int pos = pos0 + lane;
    const bool valid = pos >= lo && pos <= hi;
    float s[4] = {-1e30f, -1e30f, -1e30f, -1e30f};
    if (valid) {
        const bf16_t* pb; const float* pf; kv_row_ptr<SAMPLE>(p, branch, b, pos, 0, g, pb, pf);
        dot4x64(pb, pf, qs, s);
        const int bk = t5_bucket(t - pos);
#pragma unroll
        for (int h = 0; h < 4; ++h) s[h] += relb[bk * 8 + g * 4 + h];
    }
#pragma unroll
    for (int h = 0; h < 4; ++h) {
        const float mx = wave_max(s[h]);
        const float mn = fmaxf(m[h], mx);
        const float pr = valid ? ex2(s[h] - mn) : 0.f;
        const float sm = wave_sum(pr);
        const float al = ex2(m[h] - mn);
        l[h] = l[h] * al + sm; o[h] *= al; m[h] = mn;
        pbk[h * 64 + lane] = pr;
    }
    __builtin_amdgcn_wave_barrier();
    const int k0 = (lo > pos0 ? lo : pos0) - pos0, k1 = (hi < pos0 + 63 ? hi : pos0 + 63) - pos0;
#pragma unroll 1
    for (int k = k0; k <= k1; ++k) {
        const bf16_t* pb; const float* pf; kv_row_ptr<SAMPLE>(p, branch, b, pos0 + k, 1, g, pb, pf);
        const float v = pf ? pf[lane] : bf2f(pb[lane]);
#pragma unroll
        for (int h = 0; h < 4; ++h) o[h] += pbk[h * 64 + k] * v;
    }
    __builtin_amdgcn_wave_barrier();
}

constexpr int S_QS = 0, S_SC = 1024, S_PHS = S_SC + 4 * 1024 * 4, S_PBK = S_PHS + 1088 * 4, S_PART = S_PBK + 8 * 1024, S_RED = S_PART + 2 * 8 * 272 * 4, S_OCP = S_RED + 512,
              S_SEL = S_OCP + 2048, S_RELB = S_SEL + 64, ATTS_LDS = S_RELB + 1024;
__device__ void attn_sample_item(const Params& p, int b, int g) {
    const int tid = threadIdx.x, wid = tid >> 6, lane = tid & 63;
    constexpr int t = PAST, NC = NCS, NSEL = 257, NJR = 5, qblk = PAST >> 6;
    const int row = MP + b;
    LAS unsigned char* L = (LAS unsigned char*)smem;
    LAS float* qs = (LAS float*)(L + S_QS); LAS float* sc = (LAS float*)(L + S_SC); LAS float* phs = (LAS float*)(L + S_PHS); LAS float* pbk = (LAS float*)(L + S_PBK) + wid * 256;
    LAS float* part = (LAS float*)(L + S_PART); LAS float* red = (LAS float*)(L + S_RED); LAS float* ocp = (LAS float*)(L + S_OCP); LAS int* sel = (LAS int*)(L + S_SEL);
    LAS float* relb = (LAS float*)(L + S_RELB);
    __syncthreads();
    if (tid < 256) { relb[tid] = p.rel_bias[tid] * LOG2E; qs[tid] = bf2f(p.Qb[(size_t)row * QD + g * 256 + tid]); }
    __syncthreads();
    const float* kc = p.KCS + ((size_t)b * NG + g) * 1024 * 64;
    const float* vc = p.VCS + ((size_t)b * NG + g) * 1024 * 64;
    {
        float mx[4] = {-1e30f, -1e30f, -1e30f, -1e30f};
#pragma unroll 1
        for (int r = wid; r < 16; r += 8) {
            const int n = r * 64 + lane;
            float s[4] = {-1e30f, -1e30f, -1e30f, -1e30f};
            if (n < NC) {
                dot4x64(nullptr, kc + (size_t)n * 64, qs, s);
                const int bk = t5_bucket(t - (16 * n + 31));
#pragma unroll
                for (int h = 0; h < 4; ++h) s[h] += relb[bk * 8 + g * 4 + h];
            }
#pragma unroll
            for (int h = 0; h < 4; ++h) { sc[h * 1024 + n] = s[h]; mx[h] = fmaxf(mx[h], s[h]); }
        }
#pragma unroll
        for (int h = 0; h < 4; ++h) { const float m = wave_max(mx[h]); if (lane == 0) red[wid * 4 + h] = m; }
    }
    __syncthreads();
    float gmx[4], inv[4];
#pragma unroll
    for (int h = 0; h < 4; ++h) { float m = red[h]; for (int w = 1; w < 8; ++w) m = fmaxf(m, red[w * 4 + h]); gmx[h] = m; }
    {
        float sum[4] = {0.f, 0.f, 0.f, 0.f};
#pragma unroll
        for (int k = 0; k < 2; ++k) { const int n = tid + 512 * k;
#pragma unroll
            for (int h = 0; h < 4; ++h) { const float e = n < NC ? ex2(sc[h * 1024 + n] - gmx[h]) : 0.f; sc[h * 1024 + n] = e; sum[h] += e; } }
#pragma unroll
        for (int h = 0; h < 4; ++h) { const float s = wave_sum(sum[h]); if (lane == 0) red[32 + wid * 4 + h] = s; }
    }
    __syncthreads();
#pragma unroll
    for (int h = 0; h < 4; ++h) { float s = 0.f; for (int w = 0; w < 8; ++w) s += red[32 + w * 4 + h]; inv[h] = s > 0.f ? 1.0f / s : 0.f; }
    for (int n = tid; n < 1088; n += 512) phs[n] = n < NC ? (sc[n] * inv[0] + sc[1024 + n] * inv[1]) + (sc[2048 + n] * inv[2] + sc[3072 + n] * inv[3]) : 0.f;
    {
        const int hd = tid & 255, half = tid >> 8, h = hd >> 6, d = hd & 63;
        float a = 0.f;
#pragma unroll 4
        for (int n = half * 512; n < (half ? NC : 512); ++n) a += sc[h * 1024 + n] * vc[(size_t)n * 64 + d];
        ocp[tid] = a * inv[h];
    }
    __syncthreads();
    if (wid == 0) {
        unsigned long long key[NJR];
#pragma unroll
        for (int jr = 0; jr < NJR; ++jr) {
            const int j = jr * 64 + lane;
            key[jr] = 0ull;
            if (j >= 1 && j <= qblk - 2 && j < NSEL) {
                float im = 0.f;
#pragma unroll
                for (int n = 4 * j - 1; n <= 4 * j + 3; ++n) im += (n < NC) ? phs[n] : 0.f;
                key[jr] = ((unsigned long long)__float_as_uint(im) << 32) | (unsigned)(0xFFFF - j) | 0x10000ull;
            }
        }
        if (lane == 0) { sel[0] = 0; sel[1] = qblk - 1; sel[2] = qblk; }
#pragma unroll 1
        for (int it = 0; it < 13; ++it) {
            unsigned long long best = 0ull;
#pragma unroll
            for (int jr = 0; jr < NJR; ++jr) best = key[jr] > best ? key[jr] : best;
#pragma unroll
            for (int o = 32; o > 0; o >>= 1) { const unsigned long long ot = __shfl_xor(best, o); best = ot > best ? ot : best; }
            const int j = 0xFFFF - (int)(best & 0xFFFFull);
#pragma unroll
            for (int jr = 0; jr < NJR; ++jr) if (key[jr] == best) key[jr] = 0ull;
            if (lane == 0) sel[3 + it] = j;
        }
    }
    __syncthreads();
    {
        float ms[4] = {-1e30f, -1e30f, -1e30f, -1e30f}, ls[4] = {0.f, 0.f, 0.f, 0.f}, os[4] = {0.f, 0.f, 0.f, 0.f};
#pragma unroll 1
        for (int i = wid; i < 16; i += 8) attn_chunk<true>(p, 1, b, g, t, sel[i] * 64, 0, t, ms, ls, os, qs, pbk, relb, lane);
        float mw[4] = {-1e30f, -1e30f, -1e30f, -1e30f}, lw[4] = {0.f, 0.f, 0.f, 0.f}, ow[4] = {0.f, 0.f, 0.f, 0.f};
#pragma unroll 1
        for (int c = wid; c < 9; c += 8) attn_chunk<true>(p, 2, b, g, t, t - 63 - 64 * c, t - WIN, t, mw, lw, ow, qs, pbk, relb, lane);
#pragma unroll
        for (int h = 0; h < 4; ++h) {
            LAS float* ps = part + (wid * 4 + h) * 68; LAS float* pw = part + 8 * 272 + (wid * 4 + h) * 68;
            ps[lane] = os[h]; pw[lane] = ow[h];
            if (lane == 0) { ps[64] = ms[h]; ps[65] = ls[h]; pw[64] = mw[h]; pw[65] = lw[h]; }
        }
    }
    __syncthreads();
    if (tid < 256) {
        const int h = tid >> 6, d = tid & 63;
        float res[2];
#pragma unroll
        for (int br = 0; br < 2; ++br) {
            const LAS float* pp = part + br * 8 * 272 + h * 68;
            float m = -1e30f;
            for (int w = 0; w < 8; ++w) m = fmaxf(m, pp[w * 272 + 64]);
            float l = 0.f, o = 0.f;
            for (int w = 0; w < 8; ++w) { const float sc_ = ex2(pp[w * 272 + 64] - m); l += pp[w * 272 + 65] * sc_; o += pp[w * 272 + d] * sc_; }
            res[br] = o / l;
        }
        const float* gt = p.GATE + (size_t)row * 32 + (g * 4 + h) * 3;
        const float v = gt[0] * (ocp[tid] + ocp[256 + tid]) + gt[1] * res[0] + gt[2] * res[1];
        p.OCAT[(size_t)row * DM + (g * 4 + h) * 64 + d] = f2bf(v);
    }
    __syncthreads();
}

constexpr int A_OST = 0, OST_LD = 68, A_LST = A_OST + 256 * OST_LD * 4, A_M0 = A_LST + 1024, A_MB = A_M0 + 1024, MB_LD = 132, A_MKN = A_MB + 64 * MB_LD,
              A_LIST = A_MKN + 256, A_CNT = A_LIST + 132 * 64, A_PK = A_CNT + 544, A_KN = A_PK + 400 * 4, A_T2 = A_KN + 512, A_NP = A_T2 + 132 * 8 * 4, ATT2_LDS = A_NP + 16;
static_assert(ATT2_LDS <= GEMM_LDS && ATTS_LDS <= GEMM_LDS, "attention LDS");

__device__ __forceinline__ f32x4 mfma16(bf16x8 a, bf16x8 b, f32x4 c) { return __builtin_amdgcn_mfma_f32_16x16x32_bf16(a, b, c, 0, 0, 0); }
__device__ __forceinline__ bf16x8 pack_p(const f32x4& a, const f32x4& b) {
    u32x4 w; w.x = cvt_pk_bf16(a[0], a[1]); w.y = cvt_pk_bf16(a[2], a[3]); w.z = cvt_pk_bf16(b[0], b[1]); w.w = cvt_pk_bf16(b[2], b[3]);
    return __builtin_bit_cast(bf16x8, w);
}
__device__ __forceinline__ void qk64(const bf16_t* kb, int c, int G, const bf16x8 (&qB)[2], f32x4 (&s)[4]) {
#pragma unroll
    for (int kt = 0; kt < 4; ++kt) {
        const bf16_t* r = kb + (size_t)(16 * kt + c) * 256 + G * 8;
        const bf16x8 a0 = *(const bf16x8*)r, a1 = *(const bf16x8*)(r + 32);
        s[kt] = mfma16(a0, qB[0], (f32x4){0.f, 0.f, 0.f, 0.f}); s[kt] = mfma16(a1, qB[1], s[kt]);
    }
}
__device__ __forceinline__ void pv64(const bf16_t* vt, int ldv, int c, int G, const f32x4 (&pr)[4], f32x4 (&o)[4]) {
#pragma unroll
    for (int ks = 0; ks < 2; ++ks) {
        const bf16x8 pB = pack_p(pr[2 * ks], pr[2 * ks + 1]);
#pragma unroll
        for (int dt = 0; dt < 4; ++dt) {
            const bf16_t* r = vt + (size_t)(dt * 16 + c) * ldv + 32 * ks + 4 * G;
            u32x4 w; const u32x2 v0 = *(const u32x2*)r, v1 = *(const u32x2*)(r + 16); w.x = v0.x; w.y = v0.y; w.z = v1.x; w.w = v1.y;
            o[dt] = mfma16(__builtin_bit_cast(bf16x8, w), pB, o[dt]);
        }
    }
}
__device__ __forceinline__ float grp_max(float v) { v = fmaxf(v, __shfl_xor(v, 16)); return fmaxf(v, __shfl_xor(v, 32)); }
__device__ __forceinline__ float grp_sum(float v) { v += __shfl_xor(v, 16); return v + __shfl_xor(v, 32); }

__device__ __forceinline__ void cmp_win_pack(const Params& p, int b, int g, int qb, int pk, int lane_, LAS unsigned char* L) {
    f32x4 oacc[4];
    int lane = lane_; asm volatile("" : "+v"(lane));
    const int c = lane & 15, G = lane >> 4, qs = c >> 2, hh = c & 3;
    const int t0 = qb * 64 + pk * 4, tc = t0 + qs, qi = pk * 4 + qs;
    const size_t qrow = (size_t)b * SEQ + tc;
    const LAS float* T2 = (const LAS float*)(L + A_T2);
    const float b31 = T2[128 * 8 + g * 4 + hh];
    bf16x8 qB[2];
    qB[0] = *(const bf16x8*)(p.Qb + qrow * QD + (g * 4 + hh) * 64 + G * 8); qB[1] = *(const bf16x8*)(p.Qb + qrow * QD + (g * 4 + hh) * 64 + 32 + G * 8);
    const float* gate = p.GATE + qrow * 32 + (g * 4 + hh) * 3;
    {
        const int ncv_c = tc >= 31 ? ((tc - 31) >> 4) + 1 : 0;
        const int ncv_m = t0 + 3 >= 31 ? ((t0 + 3 - 31) >> 4) + 1 : 0;
        const int NT = (ncv_m + 15) >> 4;
        const int mt_far = t0 >= 399 ? (t0 - 399) / 256 + 1 : 0;
        const bf16_t* kcb = p.KCb + (size_t)(b * NG + g) * 512 * 64;
        f32x4 sc[32];
        float mx = -1e30f;
#pragma unroll
        for (int mt = 0; mt < 32; ++mt) {
            sc[mt] = (f32x4){0.f, 0.f, 0.f, 0.f};
            if (mt < NT) {
                const bf16_t* r = kcb + (size_t)(16 * mt + c) * 64 + G * 8;
                const bf16x8 a0 = *(const bf16x8*)r, a1 = *(const bf16x8*)(r + 32);
                f32x4 s = mfma16(a0, qB[0], (f32x4){0.f, 0.f, 0.f, 0.f}); s = mfma16(a1, qB[1], s);
                if (mt < mt_far) { s = s + b31; }
                else {
#pragma unroll
                    for (int i = 0; i < 4; ++i) { const int n = 16 * mt + 4 * G + i; int dist = tc - (16 * n + 31); const bool ok = n < ncv_c; dist = dist < 0 ? 0 : (dist > 128 ? 128 : dist);
                        s[i] = ok ? s[i] + T2[dist * 8 + g * 4 + hh] : -1e30f; }
                }
                mx = fmaxf(mx, fmaxf(fmaxf(s[0], s[1]), fmaxf(s[2], s[3])));
                sc[mt] = s;
            }
            if ((mt & 3) == 3) __builtin_amdgcn_sched_barrier(0);
        }
        mx = grp_max(mx);
        float sum = 0.f;
#pragma unroll
        for (int mt = 0; mt < 32; ++mt) if (mt < NT) {
#pragma unroll
            for (int i = 0; i < 4; ++i) { const float e = sc[mt][i] > -1e29f ? ex2(sc[mt][i] - mx) : 0.f; sc[mt][i] = e; sum += e; }
        }
        sum = grp_sum(sum);
        const float inv = sum > 0.f ? 1.0f / sum : 0.f;
#pragma unroll
        for (int mt = 0; mt < 32; ++mt) if (mt < NT) sc[mt] = sc[mt] * inv;
        LAS unsigned char* Mb = (LAS unsigned char*)(L + A_MB) + qi * MB_LD;
        const LAS float* KNs = (const LAS float*)(L + A_KN);
        if (qb <= 15) {
            if (hh == 0) { for (int j = G; j <= qb; j += 4) Mb[j] = 1; }
            float mk = 0.f; for (int j = 0; j <= qb; ++j) mk = fmaxf(mk, KNs[j]);
            if (hh == 0 && G == 0) ((LAS float*)(L + A_MKN))[qi] = mk;
        } else {
            float cand[8];
#pragma unroll
            for (int k = 0; k < 8; ++k) cand[k] = -1.f;
            float prevB = 0.f;
#pragma unroll
            for (int mt = 0; mt < 32; ++mt) if (mt < NT) {
                const float r1 = __shfl(sc[mt][3], (lane - 16) & 63);
                float v = (sc[mt][0] + sc[mt][1]) + (sc[mt][2] + sc[mt][3]) + (G == 0 ? prevB : r1);
                prevB = r1;
                v += __shfl_xor(v, 1); v += __shfl_xor(v, 2);
                const int j = 4 * mt + G;
                if ((mt & 3) == hh) cand[mt >> 2] = (j >= 1 && j <= qb - 2) ? v : -1.f;
            }
            float mk = fmaxf(KNs[0], fmaxf(KNs[qb], KNs[qb - 1]));
#pragma unroll 1
            for (int it = 0; it < 13; ++it) {
                float bv = cand[0];
#pragma unroll
                for (int k = 1; k < 8; ++k) bv = fmaxf(bv, cand[k]);
                bv = fmaxf(bv, __shfl_xor(bv, 1)); bv = fmaxf(bv, __shfl_xor(bv, 2)); bv = grp_max(bv);
                int bj = 9999;
#pragma unroll
                for (int k = 0; k < 8; ++k) { const int j = 16 * k + 4 * hh + G; bj = (cand[k] == bv && j < bj) ? j : bj; }
                { int o = __shfl_xor(bj, 1); bj = o < bj ? o : bj; o = __shfl_xor(bj, 2); bj = o < bj ? o : bj; o = __shfl_xor(bj, 16); bj = o < bj ? o : bj; o = __shfl_xor(bj, 32); bj = o < bj ? o : bj; }
#pragma unroll
                for (int k = 0; k < 8; ++k) { const int j = 16 * k + 4 * hh + G; if (j == bj) cand[k] = -1.f; }
                mk = fmaxf(mk, KNs[bj & 127]);
                if (hh == 0 && G == 0) Mb[bj & 127] = 1;
            }
            if (hh == 0 && G == 0) { Mb[0] = 1; Mb[qb] = 1; Mb[qb - 1] = 1; ((LAS float*)(L + A_MKN))[qi] = mk; }
        }
        const bf16_t* vct = p.VCT + (size_t)(b * NG + g) * 64 * 512;
        f32x4 oc[4] = {{0.f, 0.f, 0.f, 0.f}, {0.f, 0.f, 0.f, 0.f}, {0.f, 0.f, 0.f, 0.f}, {0.f, 0.f, 0.f, 0.f}};
#pragma unroll
        for (int k2 = 0; k2 < 16; ++k2) if (2 * k2 < NT) {
            const bf16x8 pB = pack_p(sc[2 * k2], sc[2 * k2 + 1]);
#pragma unroll
            for (int dt = 0; dt < 4; ++dt) {
                const bf16_t* r = vct + (size_t)(dt * 16 + c) * 512 + 32 * k2 + 4 * G;
                u32x4 w; const u32x2 v0 = *(const u32x2*)r, v1 = *(const u32x2*)(r + 16); w.x = v0.x; w.y = v0.y; w.z = v1.x; w.w = v1.y;
                oc[dt] = mfma16(__builtin_bit_cast(bf16x8, w), pB, oc[dt]);
            }
            if (k2 & 1) __builtin_amdgcn_sched_barrier(0);
        }
        const float g0 = gate[0];
#pragma unroll
        for (int dt = 0; dt < 4; ++dt) oacc[dt] = oc[dt] * g0;
    }
    {
        f32x4 ow[4] = {{0.f, 0.f, 0.f, 0.f}, {0.f, 0.f, 0.f, 0.f}, {0.f, 0.f, 0.f, 0.f}, {0.f, 0.f, 0.f, 0.f}};
        float m = -1e30f, l = 0.f;
        const int lo = t0 - WIN > 0 ? t0 - WIN : 0, hi = t0 + 3;
        const bf16_t* kbase = p.WINb + (size_t)b * SEQ * 256 + g * 64;
        const bf16_t* vbase = p.WINvT + (size_t)(b * NG + g) * 64 * SEQ;
#pragma unroll 1
        for (int cb = lo & ~63; cb <= hi; cb += 64) {
            f32x4 s[4];
            qk64(kbase + (size_t)cb * 256, c, G, qB, s);
            const bool far = (cb + 63 <= t0 - 128) && (cb >= t0 + 3 - WIN);
            if (far) {
#pragma unroll
                for (int kt = 0; kt < 4; ++kt) s[kt] = s[kt] + b31;
            } else {
#pragma unroll
                for (int kt = 0; kt < 4; ++kt)
#pragma unroll
                    for (int i = 0; i < 4; ++i) { const int dist = tc - (cb + 16 * kt + 4 * G + i); const bool ok = dist >= 0 && dist <= WIN; const int dd = dist < 0 ? 0 : (dist > 128 ? 128 : dist);
                        s[kt][i] = ok ? s[kt][i] + T2[dd * 8 + g * 4 + hh] : -1e30f; }
            }
            float cm = fmaxf(fmaxf(fmaxf(s[0][0], s[0][1]), fmaxf(s[0][2], s[0][3])), fmaxf(fmaxf(s[1][0], s[1][1]), fmaxf(s[1][2], s[1][3])));
            cm = fmaxf(cm, fmaxf(fmaxf(fmaxf(s[2][0], s[2][1]), fmaxf(s[2][2], s[2][3])), fmaxf(fmaxf(s[3][0], s[3][1]), fmaxf(s[3][2], s[3][3]))));
            cm = grp_max(cm);
            const float mn = fmaxf(m, cm), al = ex2(m - mn);
            float ps = 0.f;
#pragma unroll
            for (int kt = 0; kt < 4; ++kt)
#pragma unroll
                for (int i = 0; i < 4; ++i) { const float e = s[kt][i] > -1e29f ? ex2(s[kt][i] - mn) : 0.f; s[kt][i] = e; ps += e; }
            l = l * al + grp_sum(ps); m = mn;
#pragma unroll
            for (int dt = 0; dt < 4; ++dt) ow[dt] = ow[dt] * al;
            pv64(vbase + cb, SEQ, c, G, s, ow);
        }
        const float gw = gate[2] / l;
#pragma unroll
        for (int dt = 0; dt < 4; ++dt) st_bf16x4(p.OCAT + qrow * DM + (g * 4 + hh) * 64 + dt * 16 + 4 * G, oacc[dt] + ow[dt] * gw);
    }
}

__device__ __forceinline__ void sel_pack(const Params& p, int b, int g, int qb, int j, int s0, int lane_, LAS unsigned char* L) {
    int lane = lane_; asm volatile("" : "+v"(lane));
    const int c = lane & 15, G = lane >> 4, qs = c >> 2, hh = c & 3;
    const LAS unsigned char* list = (const LAS unsigned char*)(L + A_LIST) + j * 64;
    const int cnt = ((const LAS int*)(L + A_CNT))[j];
    const bool cval = s0 + qs < cnt;
    const int qi = list[cval ? s0 + qs : s0];
    const int tc = qb * 64 + qi;
    const size_t qrow = (size_t)b * SEQ + tc;
    const LAS float* T2 = (const LAS float*)(L + A_T2);
    bf16x8 qB[2];
    qB[0] = *(const bf16x8*)(p.Qb + qrow * QD + (g * 4 + hh) * 64 + G * 8); qB[1] = *(const bf16x8*)(p.Qb + qrow * QD + (g * 4 + hh) * 64 + 32 + G * 8);
    f32x4 s[4];
    qk64(p.SLCb + ((size_t)b * SEQ + j * 64) * 256 + g * 64, c, G, qB, s);
    const float m0 = ((const LAS float*)(L + A_M0))[qi * 4 + hh];
    float ps = 0.f;
    if (j <= qb - 3) {
        const float b31 = T2[128 * 8 + g * 4 + hh] - m0;
#pragma unroll
        for (int kt = 0; kt < 4; ++kt)
#pragma unroll
            for (int i = 0; i < 4; ++i) { const float e = ex2(s[kt][i] + b31); s[kt][i] = e; ps += e; }
    } else {
#pragma unroll
        for (int kt = 0; kt < 4; ++kt)
#pragma unroll
            for (int i = 0; i < 4; ++i) { const int dist = tc - (j * 64 + 16 * kt + 4 * G + i); const int dd = dist < 0 ? 0 : (dist > 128 ? 128 : dist);
                const float e = dist >= 0 ? ex2(s[kt][i] + T2[dd * 8 + g * 4 + hh] - m0) : 0.f; s[kt][i] = e; ps += e; }
    }
    if (!cval) {
        ps = 0.f;
#pragma unroll
        for (int kt = 0; kt < 4; ++kt) s[kt] = (f32x4){0.f, 0.f, 0.f, 0.f};
    }
    ps = grp_sum(ps);
    f32x4 o[4] = {{0.f, 0.f, 0.f, 0.f}, {0.f, 0.f, 0.f, 0.f}, {0.f, 0.f, 0.f, 0.f}, {0.f, 0.f, 0.f, 0.f}};
    pv64(p.SLCvT + (size_t)(b * NG + g) * 64 * SEQ + j * 64, SEQ, c, G, s, o);
    if (cval) {
        LAS float* ost = (LAS float*)(L + A_OST) + (qi * 4 + hh) * OST_LD + 4 * G;
#pragma unroll
        for (int dt = 0; dt < 4; ++dt)
#pragma unroll
            for (int i = 0; i < 4; ++i) (void)__hip_atomic_fetch_add(ost + dt * 16 + i, o[dt][i], __ATOMIC_RELAXED, __HIP_MEMORY_SCOPE_WORKGROUP);
        if (G == 0) (void)__hip_atomic_fetch_add((LAS float*)(L + A_LST) + qi * 4 + hh, ps, __ATOMIC_RELAXED, __HIP_MEMORY_SCOPE_WORKGROUP);
    }
}

__device__ void attn_tile(const Params& p, int b, int g, int qb, LAS unsigned char* L) {
    int tid = threadIdx.x; asm volatile("" : "+v"(tid));
    const int wid = __builtin_amdgcn_readfirstlane(tid >> 6), lane = tid & 63;
    __syncthreads();
    for (int i = tid; i < (A_MKN + 256) / 4; i += 512) ((LAS unsigned*)L)[i] = 0u;
    if (tid < 128) ((LAS float*)(L + A_KN))[tid] = p.KN[(b * NG + g) * 128 + tid];
    __syncthreads();
#pragma unroll 1
    for (int k = 0; k < 2; ++k) cmp_win_pack(p, b, g, qb, 2 * wid + k, lane, L);
    __syncthreads();
    LAS int* cnt = (LAS int*)(L + A_CNT);
    if (tid < 132) {
        int n = 0;
        if (tid <= qb) { LAS unsigned char* list = (LAS unsigned char*)(L + A_LIST) + tid * 64; const LAS unsigned char* Mb = (const LAS unsigned char*)(L + A_MB) + tid;
            for (int q = 0; q < 64; ++q) if (Mb[q * MB_LD]) list[n++] = (unsigned char)q; }
        cnt[tid] = n;
    } else if (tid >= 256) {
        const int e = tid - 256, qi = e >> 2, h = e & 3;
        const bf16_t* qr = p.Qb + ((size_t)b * SEQ + qb * 64 + qi) * QD + (g * 4 + h) * 64;
        float q2 = 0.f;
#pragma unroll
        for (int cc = 0; cc < 8; ++cc) { const u32x4 w = *(const u32x4*)(qr + cc * 8);
            q2 += bflo(w.x) * bflo(w.x) + bfhi(w.x) * bfhi(w.x) + bflo(w.y) * bflo(w.y) + bfhi(w.y) * bfhi(w.y) + bflo(w.z) * bflo(w.z) + bfhi(w.z) * bfhi(w.z) + bflo(w.w) * bflo(w.w) + bfhi(w.w) * bfhi(w.w); }
        const LAS float* T2 = (const LAS float*)(L + A_T2);
        float bm = T2[g * 4 + h];
        for (int d = 1; d <= 128; ++d) bm = fmaxf(bm, T2[d * 8 + g * 4 + h]);
        ((LAS float*)(L + A_M0))[e] = sqrtf(q2 * ((const LAS float*)(L + A_MKN))[qi]) * 1.0001f + bm + 1e-3f;
    }
    __syncthreads();
    if (wid == 0) {
        int a[3], run = 0;
        LAS int* PK = (LAS int*)(L + A_PK);
#pragma unroll
        for (int r = 0; r < 3; ++r) {
            const int j = r * 64 + lane; const int np = j < 132 ? (cnt[j] + 3) >> 2 : 0;
            int inc = np;
#pragma unroll
            for (int o = 1; o < 64; o <<= 1) { const int t = __shfl_up(inc, o); if (lane >= o) inc += t; }
            a[r] = run + inc - np;
            for (int k = 0; k < np; ++k) PK[a[r] + k] = (j << 8) | (k * 4);
            run += __shfl(inc, 63);
        }
        if (lane == 0) ((LAS int*)(L + A_NP))[0] = run;
    }
    __syncthreads();
    {
        const int np = ((const LAS int*)(L + A_NP))[0];
        const LAS int* PK = (const LAS int*)(L + A_PK);
#pragma unroll 1
        for (int k = wid; k < np; k += 8) { const int e = PK[k]; sel_pack(p, b, g, qb, e >> 8, e & 255, lane, L); }
    }
    __syncthreads();
    {
        const int c = lane & 15, G = lane >> 4, qs = c >> 2, hh = c & 3;
#pragma unroll 1
        for (int k = 0; k < 2; ++k) {
            const int qi = (2 * wid + k) * 4 + qs;
            const size_t qrow = (size_t)b * SEQ + qb * 64 + qi;
            const float gs = p.GATE[qrow * 32 + (g * 4 + hh) * 3 + 1] / ((const LAS float*)(L + A_LST))[qi * 4 + hh];
            const LAS float* ost = (const LAS float*)(L + A_OST) + (qi * 4 + hh) * OST_LD + 4 * G;
#pragma unroll
            for (int dt = 0; dt < 4; ++dt) {
                const f32x4 os = *(const LAS f32x4*)(ost + dt * 16);
                bf16_t* op = p.OCAT + qrow * DM + (g * 4 + hh) * 64 + dt * 16 + 4 * G;
                const u32x2 w = *(const u32x2*)op;
                f32x4 pa; pa[0] = bflo(w.x); pa[1] = bfhi(w.x); pa[2] = bflo(w.y); pa[3] = bfhi(w.y);
                st_bf16x4(op, pa + os * gs);
            }
        }
    }
}

#ifndef PROBE_DUP
#define PROBE_DUP 0
#endif
__device__ void phase_attn(const Params& p) {
    const int wid = threadIdx.x >> 6, lane = threadIdx.x & 63;
    if (blockIdx.x < NS * NG) attn_sample_item(p, blockIdx.x >> 1, blockIdx.x & 1);
    LAS unsigned char* L = (LAS unsigned char*)smem;
    for (int i = threadIdx.x; i < 129 * 8; i += 512) ((LAS float*)(L + A_T2))[i] = p.rel_bias[t5_bucket(i >> 3) * 8 + (i & 7)] * LOG2E;
    __syncthreads();
#pragma unroll 1
    for (int rep_ = 0; rep_ < (PROBE_DUP == 41 ? 2 : 1); ++rep_)
#pragma unroll 1
    for (int u = blockIdx.x; u < NB * NG * (SEQ / 64); u += gridDim.x) {
        const int qb = (SEQ / 64 - 1) - (u >> 3), bg = u & 7;
        attn_tile(p, bg >> 1, bg & 1, qb, L);
    }
    __syncthreads();
}

constexpr int GM_LDS = 128 * 128 * 4 + 1024;
__device__ void phase_gmlp(const Params& p) {
    const int wid = threadIdx.x >> 6, lane = threadIdx.x & 63, tid = threadIdx.x;
    LAS float* vn = (LAS float*)smem;
    LAS float* mu = (LAS float*)(smem + 128 * 128 * 4);
    for (int u = blockIdx.x; u < NB * 64; u += gridDim.x) {
        const int b = u >> 6, ch = u & 63; const size_t row0 = (size_t)b * SEQ + ch * 128;
        __syncthreads();
        for (int r = wid; r < 128; r += 8) {
            const u32x4 w = *(const u32x4*)(p.Vg + (row0 + r) * GMD + lane * 8);
            const float x[8] = {bflo(w.x), bfhi(w.x), bflo(w.y), bfhi(w.y), bflo(w.z), bfhi(w.z), bflo(w.w), bfhi(w.w)};
            float s = 0.f;
#pragma unroll
            for (int i = 0; i < 8; ++i) s += x[i];
            const float mean = wave_sum(s) * (1.0f / GMD);
            float q = 0.f;
#pragma unroll
            for (int i = 0; i < 8; ++i) q += (x[i] - mean) * (x[i] - mean);
            const float var = wave_sum(q) * (1.0f / GMD);
            if (lane == 0) { mu[r] = mean; mu[128 + r] = rsqrtf(var + EPS); }
        }
        for (int g = 0; g < 4; ++g) {
            __syncthreads();
            for (int i = tid; i < 128 * 128; i += 512) {
                const int s = i >> 7, d = i & 127, c = g * 128 + d;
                vn[i] = (bf2f(p.Vg[(row0 + s) * GMD + c]) - mu[s]) * mu[128 + s] * p.gm_ln_g[c] + p.gm_ln_b[c];
            }
            __syncthreads();
            const int d = tid & 127;
            for (int i = 0; i < 32; ++i) {
                const int t = (tid >> 7) + 4 * i;
                const float* wrow = p.gm_ws + ((size_t)g * 128 + t) * 128;
                float a = 0.f;
                for (int s = 0; s <= t; ++s) a += wrow[s] * vn[s * 128 + d];
                a += p.gm_bs[g * 128 + t];
                const float uu = bf2f(p.U[(row0 + t) * GMD + g * 128 + d]);
                p.OCAT[(row0 + t) * DM + QD + g * 128 + d] = f2bf(uu * a);
            }
        }
    }
    for (int it = blockIdx.x * 8 + wid; it < NS; it += gridDim.x * 8) {
        const size_t row = (size_t)MP + it;
        const u32x4 w = *(const u32x4*)(p.Vg + row * GMD + lane * 8);
        const float x[8] = {bflo(w.x), bfhi(w.x), bflo(w.y), bfhi(w.y), bflo(w.z), bfhi(w.z), bflo(w.w), bfhi(w.w)};
        float s = 0.f;
#pragma unroll
        for (int i = 0; i < 8; ++i) s += x[i];
        const float mean = wave_sum(s) * (1.0f / GMD);
        float q = 0.f;
#pragma unroll
        for (int i = 0; i < 8; ++i) q += (x[i] - mean) * (x[i] - mean);
        const float rs = rsqrtf(wave_sum(q) * (1.0f / GMD) + EPS);
#pragma unroll
        for (int i = 0; i < 8; ++i) {
            const int c = lane * 8 + i, g = c >> 7;
            const float v = (x[i] - mean) * rs * p.gm_ln_g[c] + p.gm_ln_b[c];
            p.out[O_GMV + (size_t)it * GMD + c] = v;
            const float a = p.gm_ws[(size_t)g * 128 * 128] * v + p.gm_bs[g * 128];
            p.OCAT[row * DM + QD + c] = f2bf(bf2f(p.U[row * GMD + c]) * a);
        }
    }
}

template <int MODE>
__device__ void phase_norm(const Params& p) {
    const int wid = threadIdx.x >> 6, lane = threadIdx.x & 63;
    const float* gpost = MODE == 0 ? p.ln_mix_post : MODE == 1 ? p.ln_ffn_post : p.ln_ple_post;
    for (int row = blockIdx.x * 8 + wid; row < MP + NS; row += gridDim.x * 8) {
        const float* fr = p.F + (size_t)row * DM;
        const float* xr = MODE == 0 ? xrow_ptr(p, row) : MODE == 1 ? p.X1 + (size_t)row * DM : p.X2 + (size_t)row * DM;
        f32x4 f[4], x[4];
#pragma unroll
        for (int k = 0; k < 4; ++k) { f[k] = *(const f32x4*)(fr + lane * 4 + k * 256); x[k] = *(const f32x4*)(xr + lane * 4 + k * 256); }
        const float r = row_rstd(f);
#pragma unroll
        for (int k = 0; k < 4; ++k) { const f32x4 g = *(const f32x4*)(gpost + lane * 4 + k * 256); x[k] = x[k] + f[k] * r * g; }
        if (MODE == 0) {
            const float r2 = row_rstd(x);
#pragma unroll
            for (int k = 0; k < 4; ++k) {
                *(f32x4*)(p.X1 + (size_t)row * DM + lane * 4 + k * 256) = x[k];
                const f32x4 g = *(const f32x4*)(p.ln_ffn_pre + lane * 4 + k * 256); const f32x4 o = x[k] * r2 * g;
                st_bf16x4(p.H2 + (size_t)row * DM + lane * 4 + k * 256, o);
            }
        } else if (MODE == 1) {
#pragma unroll
            for (int k = 0; k < 4; ++k) { *(f32x4*)(p.X2 + (size_t)row * DM + lane * 4 + k * 256) = x[k]; st_bf16x4(p.X2b + (size_t)row * DM + lane * 4 + k * 256, x[k]); }
        } else {
            float* yr = row < MP ? p.out + O_YP + (size_t)row * DM : p.out + O_YS + (size_t)(row - MP) * DM;
#pragma unroll
            for (int k = 0; k < 4; ++k) *(f32x4*)(yr + lane * 4 + k * 256) = x[k];
        }
    }
}


#define XB_TMO      128
#define XB_XCNT(j)  (256  + 64 * (j))
#define XB_XSUB(j)  (1280 + 64 * (j))
#define XB_XGEN(j)  (2304 + 64 * (j))
#define XB_TOP      3328
#define XB_TOPGEN   3392
#define XCD_BAR_WORDS 3456
#define XB_SPIN_CAP (1u << 22)

__device__ __forceinline__ unsigned xb_ld(unsigned* p)              { return __hip_atomic_load(p, __ATOMIC_RELAXED, __HIP_MEMORY_SCOPE_AGENT); }
__device__ __forceinline__ unsigned xb_add(unsigned* p, unsigned v) { return __hip_atomic_fetch_add(p, v, __ATOMIC_RELAXED, __HIP_MEMORY_SCOPE_AGENT); }
__device__ __forceinline__ unsigned xb_xcc_id() { return (unsigned)__builtin_amdgcn_s_getreg((3 << 11) | 20) & 0xFu; }
#define XB_SPIN(cond, bar) do { unsigned _sp = 0; while (cond) { __builtin_amdgcn_s_sleep(1); \
    if ((++_sp & 255u) == 0u) { if (xb_ld(&(bar)[XB_TMO])) break; if (_sp > XB_SPIN_CAP) { atomicAdd(&(bar)[XB_TMO], 1u); break; } } } } while (0)

struct XcdBarrier {
    unsigned* bar; unsigned x;
    volatile LAS unsigned* st;
};

__device__ __forceinline__ XcdBarrier xcd_barrier_post(unsigned* bar, volatile LAS unsigned* st) {
    XcdBarrier b; b.bar = bar; b.x = xb_xcc_id(); b.st = st;
    if (threadIdx.x == 0) (void)xb_add(&bar[XB_XCNT(b.x)], 1u);
    return b;
}
__device__ __forceinline__ void xcd_barrier_complete(unsigned* bar, unsigned x, unsigned& nloc, unsigned& nx) {
    const unsigned G = gridDim.x * gridDim.y * gridDim.z;
    unsigned sum, cnt, mine, sp = 0u;
    for (;;) {
        sum = 0u; cnt = 0u; mine = 0u;
#pragma unroll
        for (unsigned j = 0; j < 16; ++j) { const unsigned c = xb_ld(&bar[XB_XCNT(j)]); sum += c; cnt += (c > 0u) ? 1u : 0u; mine = (j == x) ? c : mine; }
        if (sum == G) break;
        __builtin_amdgcn_s_sleep(1);
        if ((++sp & 255u) == 0u) { if (xb_ld(&bar[XB_TMO])) break; if (sp > XB_SPIN_CAP) { atomicAdd(&bar[XB_TMO], 1u); break; } }
    }
    nloc = mine > 0u ? mine : 1u; nx = cnt > 0u ? cnt : 1u;
}

__device__ __forceinline__ void xcd_barrier(const XcdBarrier& b) {
    asm volatile("s_waitcnt vmcnt(0)" ::: "memory");
    __syncthreads();
    if (threadIdx.x == 0) {
        unsigned* bar = b.bar;
        __builtin_amdgcn_s_waitcnt(0);
        unsigned nloc = b.st[0], nx = b.st[1];
        if (nloc == 0u) { xcd_barrier_complete(bar, b.x, nloc, nx); b.st[0] = nloc; b.st[1] = nx; }
        const unsigned old = xb_add(&bar[XB_XSUB(b.x)], 1u);
        const unsigned gen = old / nloc;
        if (old + 1u == (gen + 1u) * nloc) {
            __builtin_amdgcn_fence(__ATOMIC_RELEASE, "agent");
            asm volatile("s_waitcnt vmcnt(0)" ::: "memory");
            const unsigned og = xb_add(&bar[XB_TOP], 1u);
            const unsigned tg = og / nx;
            if (og + 1u == (tg + 1u) * nx) xb_add(&bar[XB_TOPGEN], 1u);
            else XB_SPIN(xb_ld(&bar[XB_TOPGEN]) == tg, bar);
            __builtin_amdgcn_fence(__ATOMIC_ACQUIRE, "agent");
            xb_add(&bar[XB_XGEN(b.x)], 1u);
            asm volatile("s_waitcnt vmcnt(0)" ::: "memory");
        } else {
            XB_SPIN(xb_ld(&bar[XB_XGEN(b.x)]) == gen, bar);
            __builtin_amdgcn_fence(__ATOMIC_ACQUIRE, "agent");
            asm volatile("s_waitcnt vmcnt(0)" ::: "memory");
        }
    }
    __syncthreads();
}

constexpr int NPHASE = 16;
constexpr int LDS_BYTES = GEMM_LDS;
static_assert(GM_LDS <= LDS_BYTES, "lds");
constexpr int NMT = MALL / BM;

template <int PH>
__device__ __forceinline__ void run_phase(const Params& p) {
    if (PH == 0) phase_prologue(p);
    if (PH == 1) { EpiIn e{p}; gemm_phase(p.H, DM, p.WinT, DM, NMT, INP / BM, e); }
    if (PH == 2) { EpiPart e{p.PART}; gemm_phase(p.CMPb, 4096, p.W1T, 1024, (2048 + NS * 1024) / BM, 1, e, 4, ZCmp(), 256); }
    if (PH == 3) phase_cmp_final(p);
    if (PH == 4) phase_attn(p);
    if (PH == 5) phase_gmlp(p);
    if (PH == 6) { EpiBrA e{p.GA, p.T}; gemm_phase(p.OCAT, DM, p.WnT, QD, NMT, DM / BM, e); }
    if (PH == 7) { EpiBrB e{p.GB, p.T, p.Y1}; gemm_phase(p.OCAT + QD, DM, p.WgT, GMD, NMT, DM / BM, e); }
    if (PH == 8) { EpiF32 e{p.F, DM}; gemm_phase(p.Y1, DM, p.WoT, DM, NMT, DM / BM, e); }
    if (PH == 9) phase_norm<0>(p);
    if (PH == 10) { EpiSwiGLU e{p.ACT}; gemm_phase(p.H2, DM, p.WguT, DM, NMT, 2 * DFF / BM, e); }
    if (PH == 11) { EpiF32 e{p.F, DM}; gemm_phase(p.ACT, DFF, p.WdT, DFF, NMT, DM / BM, e); }
    if (PH == 12) phase_norm<1>(p);
    if (PH == 13) { EpiF32 e{p.T, DM}; gemm_phase(p.Pb, PLE, p.WpT, PLE, NMT, DM / BM, e); }
    if (PH == 14) { EpiPleGate e{p.T, p.F}; gemm_phase(p.X2b, DM, p.WpgT, DM, NMT, DM / BM, e); }
    if (PH == 15) phase_norm<2>(p);
}

#ifndef MK_MULTI
#define MK_MULTI 0
#endif
template <int PH>
__global__ void __launch_bounds__(512, 2) k_phase(Params p) { run_phase<PH>(p); }

__global__ void __launch_bounds__(512, 2) k_all(Params p) {
    volatile LAS unsigned* st = (volatile LAS unsigned*)((LAS unsigned char*)smem + LDS_BYTES);
    if (threadIdx.x < 4) st[threadIdx.x] = 0u;
    __syncthreads();
    XcdBarrier bar = xcd_barrier_post(p.bar, st);
#if PROBE_DUP == 100
    run_phase<0>(p);  xcd_barrier(bar);
#endif
    run_phase<0>(p);  xcd_barrier(bar);
    run_phase<1>(p);  xcd_barrier(bar);
    run_phase<2>(p);  xcd_barrier(bar);
#if PROBE_DUP == 100
    run_phase<3>(p);  xcd_barrier(bar);
#endif
    run_phase<3>(p);  xcd_barrier(bar);
#if PROBE_DUP == 104
    run_phase<4>(p);  xcd_barrier(bar);
#endif
    run_phase<4>(p);
#if PROBE_DUP == 100
    run_phase<5>(p);  xcd_barrier(bar);
#endif
    run_phase<5>(p);  xcd_barrier(bar);
    run_phase<6>(p);  xcd_barrier(bar);
    run_phase<7>(p);  xcd_barrier(bar);
    run_phase<8>(p);  xcd_barrier(bar);
    run_phase<9>(p);  xcd_barrier(bar);
    run_phase<10>(p); xcd_barrier(bar);
    run_phase<11>(p); xcd_barrier(bar);
    run_phase<12>(p);
    run_phase<13>(p); xcd_barrier(bar);
    run_phase<14>(p); xcd_barrier(bar);
    run_phase<15>(p);
}

static inline size_t al256(size_t x) { return (x + 255) & ~(size_t)255; }
template <int PH> static void launch_phase(const Params& p, int grid, hipStream_t s) {
    static bool attr = false;
    if (!attr) { (void)hipFuncSetAttribute((const void*)k_phase<PH>, hipFuncAttributeMaxDynamicSharedMemorySize, LDS_BYTES); attr = true; }
    k_phase<PH><<<grid, 512, LDS_BYTES, s>>>(p);
}
template <int PH> static void launch_all(const Params& p, int grid, hipStream_t s) {
    launch_phase<PH>(p, grid, s);
    if constexpr (PH + 1 < NPHASE) launch_all<PH + 1>(p, grid, s);
}

extern "C" void kernel_launch(void* const* d_in, const int* in_sizes, int n_in, void* d_out, int out_size, void* d_ws, size_t ws_size, hipStream_t stream) {
    Params p{};
    p.x_prompt = (const float*)d_in[0]; p.x_sample = (const float*)d_in[1]; p.cache_cmp = (const float*)d_in[2]; p.cache_slc = (const float*)d_in[3];
    p.state_win = (const float*)d_in[4]; p.page_table = (const int*)d_in[5]; p.p_prompt = (const float*)d_in[6]; p.p_sample = (const float*)d_in[7];
    p.rel_bias = (const float*)d_in[8]; p.ln_mix_pre = (const float*)d_in[9]; p.w_in = (const float*)d_in[10];
    p.pe_k = (const float*)d_in[11]; p.w1_k = (const float*)d_in[12]; p.w2_k = (const float*)d_in[13];
    p.pe_v = (const float*)d_in[14]; p.w1_v = (const float*)d_in[15]; p.w2_v = (const float*)d_in[16];
    p.gm_ln_g = (const float*)d_in[17]; p.gm_ln_b = (const float*)d_in[18]; p.gm_ws = (const float*)d_in[19]; p.gm_bs = (const float*)d_in[20];
    p.w_br_nsa = (const float*)d_in[21]; p.w_br_gm = (const float*)d_in[22]; p.w_out = (const float*)d_in[23];
    p.ln_mix_post = (const float*)d_in[24]; p.ln_ffn_pre = (const float*)d_in[25]; p.w_gate = (const float*)d_in[26]; p.w_up = (const float*)d_in[27];
    p.w_down = (const float*)d_in[28]; p.ln_ffn_post = (const float*)d_in[29]; p.w_ple = (const float*)d_in[30]; p.w_ple_gate = (const float*)d_in[31];
    p.ln_ple_post = (const float*)d_in[32];
    p.out = (float*)d_out;
    unsigned char* w = (unsigned char*)d_ws; size_t off = 0;
    auto take = [&](size_t bytes) { void* r = w + off; off = al256(off + bytes); return r; };
    p.bar = (unsigned*)take(16384);
    p.WinT = (bf16_t*)take((size_t)INP * DM * 2); p.WnT = (bf16_t*)take((size_t)DM * QD * 2); p.WgT = (bf16_t*)take((size_t)DM * GMD * 2);
    p.WoT = (bf16_t*)take((size_t)DM * DM * 2); p.WguT = (bf16_t*)take((size_t)2 * DFF * DM * 2); p.WdT = (bf16_t*)take((size_t)DM * DFF * 2);
    p.WpgT = (bf16_t*)take((size_t)DM * DM * 2); p.WpT = (bf16_t*)take((size_t)DM * PLE * 2); p.W1T = (bf16_t*)take((size_t)2 * 256 * 1024 * 2);
    p.H = (bf16_t*)take((size_t)MALL * DM * 2); p.Qb = (bf16_t*)take((size_t)MALL * QD * 2);
    p.CMPb = (bf16_t*)take(((size_t)MP + (size_t)NS * PAST) * 256 * 2); p.SLCb = (bf16_t*)take((size_t)MALL * 256 * 2); p.WINb = (bf16_t*)take((size_t)MALL * 256 * 2);
    p.U = (bf16_t*)take((size_t)MALL * GMD * 2); p.Vg = (bf16_t*)take((size_t)MALL * GMD * 2);
    p.GA = (bf16_t*)take((size_t)MALL * DM * 2); p.GB = (bf16_t*)take((size_t)MALL * DM * 2);
    p.GATE = (float*)take((size_t)MALL * 32 * 4);
    p.PART = (float*)take((size_t)(2048 + NS * 1024) * 4 * 256 * 4); p.PEB = (float*)take(256 * 4);
    p.KCP = (float*)take((size_t)NB * NG * 512 * 64 * 4); p.VCP = (float*)take((size_t)NB * NG * 512 * 64 * 4);
    p.KCS = (float*)take((size_t)NS * NG * 1024 * 64 * 4); p.VCS = (float*)take((size_t)NS * NG * 1024 * 64 * 4); p.KN = (float*)take(NB * NG * 128 * 4);
    p.KCb = (bf16_t*)take((size_t)NB * NG * 512 * 64 * 2); p.VCT = (bf16_t*)take((size_t)NB * NG * 64 * 512 * 2);
    p.SLCvT = (bf16_t*)take((size_t)NB * NG * 64 * SEQ * 2); p.WINvT = (bf16_t*)take((size_t)NB * NG * 64 * SEQ * 2);
    p.OCAT = (bf16_t*)take((size_t)MALL * DM * 2); p.T = (float*)take((size_t)MALL * DM * 4); p.Y1 = (bf16_t*)take((size_t)MALL * DM * 2);
    p.F = (float*)take((size_t)MALL * DM * 4); p.X1 = (float*)take((size_t)MALL * DM * 4); p.H2 = (bf16_t*)take((size_t)MALL * DM * 2);
    p.ACT = (bf16_t*)take((size_t)MALL * DFF * 2); p.X2 = (float*)take((size_t)MALL * DM * 4); p.X2b = (bf16_t*)take((size_t)MALL * DM * 2);
    p.Pb = (bf16_t*)take((size_t)MALL * PLE * 2);
    if (off > ws_size) { fprintf(stderr, "workspace too small: need %zu have %zu\n", off, ws_size); return; }
    (void)hipMemsetAsync(p.OCAT + (size_t)(MP + NS) * DM, 0, (size_t)(MALL - MP - NS) * DM * 2, stream);
#if MK_MULTI
    launch_all<0>(p, 256, stream);
#else
    constexpr size_t kDynLds = LDS_BYTES + 16;
    static int grid = 0;
    if (!grid) {
        int dev = 0, cus = 0, per_cu = 0;
        (void)hipGetDevice(&dev);
        (void)hipDeviceGetAttribute(&cus, hipDeviceAttributeMultiprocessorCount, dev);
        (void)hipFuncSetAttribute((const void*)k_all, hipFuncAttributeMaxDynamicSharedMemorySize, (int)kDynLds);
        (void)hipOccupancyMaxActiveBlocksPerMultiprocessor(&per_cu, (const void*)k_all, 512, kDynLds);
        grid = cus * (per_cu < 1 ? per_cu : 1);
        if (grid <= 0) { fprintf(stderr, "k_all: occupancy query says %d blocks per CU\n", per_cu); grid = 0; return; }
    }
    (void)hipMemsetAsync(p.bar, 0, XCD_BAR_WORDS * sizeof(unsigned), stream);
    k_all<<<grid, 512, kDynLds, stream>>>(p);
#endif
}
```

```cpp
#include <hip/hip_runtime.h>
#include <stdint.h>
#include <cstdio>

typedef unsigned short bf16_t;
typedef short bf16x8 __attribute__((ext_vector_type(8)));
typedef float f32x4 __attribute__((ext_vector_type(4)));
typedef float f32x2 __attribute__((ext_vector_type(2)));
typedef unsigned u32x4 __attribute__((ext_vector_type(4)));
typedef unsigned u32x2 __attribute__((ext_vector_type(2)));
#define LAS __attribute__((address_space(3)))

constexpr int DM = 1024, NB = 4, SEQ = 8192, MP = NB * SEQ, NS = 32, MALL = MP + 256, PAST = 16384, PAGE = 128, NPG = 128;
constexpr int NH = 8, NG = 2, HPG = 4, DH = 64, QD = 512, WIN = 512, GMD = 512, DFF = 2816, PLE = 256, IND = 4376, INP = 4608;
constexpr int NCP = 511, NCS = 1023;
constexpr float EPS = 1e-6f;
constexpr float LOG2E = 1.4426950408889634f, QSCALE = 0.125f * LOG2E;
constexpr long O_YP = 0, O_YS = 33554432, O_CMPP = 33587200, O_SLCP = 41975808, O_WINP = 50364416, O_CMPS = 50888704,
               O_SLCS = 50896896, O_WINS = 50905088, O_GMV = 55099392;

struct Params {
    const float *x_prompt, *x_sample, *cache_cmp, *cache_slc, *state_win; const int* page_table;
    const float *p_prompt, *p_sample, *rel_bias, *ln_mix_pre, *w_in, *pe_k, *w1_k, *w2_k, *pe_v, *w1_v, *w2_v;
    const float *gm_ln_g, *gm_ln_b, *gm_ws, *gm_bs, *w_br_nsa, *w_br_gm, *w_out, *ln_mix_post, *ln_ffn_pre;
    const float *w_gate, *w_up, *w_down, *ln_ffn_post, *w_ple, *w_ple_gate, *ln_ple_post;
    float* out;
    unsigned* bar;
    bf16_t *WinT, *WnT, *WgT, *WoT, *WguT, *WdT, *WpgT, *WpT, *W1T;
    bf16_t *H, *Qb, *CMPb, *SLCb, *WINb, *U, *Vg, *GA, *GB;
    float* GATE;
    float *PART, *PEB, *KCP, *VCP, *KCS, *VCS, *KN;
    bf16_t *KCb, *VCT, *SLCvT, *WINvT, *GWb, *W2T;
    bf16_t* OCAT; float* T; bf16_t* Y1; float* F; float* X1; bf16_t* H2; bf16_t* ACT; float* X2; bf16_t* X2b; bf16_t* Pb;
};

__device__ __forceinline__ unsigned cvt_pk_bf16(float lo, float hi) { unsigned r; asm volatile("v_cvt_pk_bf16_f32 %0, %1, %2" : "=v"(r) : "v"(lo), "v"(hi)); return r; }
__device__ __forceinline__ bf16_t f2bf(float f) { return (bf16_t)(cvt_pk_bf16(f, 0.f) & 0xffffu); }
__device__ __forceinline__ float bf2f(bf16_t h) { return __uint_as_float(((unsigned)h) << 16); }
__device__ __forceinline__ float bflo(unsigned w) { return __uint_as_float(w << 16); }
__device__ __forceinline__ float bfhi(unsigned w) { return __uint_as_float(w & 0xffff0000u); }
__device__ __forceinline__ float ex2(float x) { return __builtin_amdgcn_exp2f(x); }
__device__ __forceinline__ float sigmoidf_(float x) { return 1.0f / (1.0f + __expf(-x)); }
__device__ __forceinline__ float siluf_(float x) { return x * sigmoidf_(x); }
__device__ __forceinline__ float geluf_(float x) {
    const float u = 0.7978845608028654f * (x + 0.044715f * x * x * x);
    const float e = __expf(2.0f * u);
    const float th = 1.0f - 2.0f / (e + 1.0f);
    return 0.5f * x * (1.0f + th);
}
__device__ __forceinline__ float wave_sum(float v) {
#pragma unroll
    for (int o = 32; o > 0; o >>= 1) v += __shfl_xor(v, o);
    return v;
}
__device__ __forceinline__ float wave_max(float v) {
#pragma unroll
    for (int o = 32; o > 0; o >>= 1) v = fmaxf(v, __shfl_xor(v, o));
    return v;
}
__device__ __forceinline__ int t5_bucket(int d) {
    if (d < 16) return d;
    if (d >= 128) return 31;
    const int b = 16 + (int)(__logf((float)d * (1.0f / 16.0f)) * (16.0f / 2.0794415416798357f));
    return b < 31 ? b : 31;
}

extern __shared__ __attribute__((aligned(16))) unsigned char smem[];
#ifndef PROBE_DUP
#define PROBE_DUP 0
#endif
#define PROBE_LDS_OFF 131072
#ifndef PROBE_SPIN
#define PROBE_SPIN 0
#endif
#ifndef PROBE_SEG
#define PROBE_SEG 5
#endif
__device__ __forceinline__ unsigned long long probe_now() { unsigned long long t; asm volatile("s_memrealtime %0\n\ts_waitcnt lgkmcnt(0)" : "=s"(t) :: "memory"); return t; }
#define PROBE_TS ((volatile LAS unsigned long long*)((LAS unsigned char*)smem + PROBE_LDS_OFF + 16))
#if PROBE_SPIN
#define PROBE_BEGIN(seg) unsigned long long pb_##seg = 0; if (PROBE_SEG == seg && threadIdx.x == 0) pb_##seg = probe_now();
#define PROBE_END(seg) if (PROBE_SEG == seg && threadIdx.x == 0) { PROBE_TS[2] = PROBE_TS[2] + (probe_now() - pb_##seg); }
#else
#define PROBE_BEGIN(seg)
#define PROBE_END(seg)
#endif

constexpr int BM = 256, BK = 64, HALF = 128, HT = HALF * BK, GEMM_LDS = 8 * HT * 2;
__device__ __forceinline__ int lds_byte(int r, int c) { const int st = (r >> 4) * 2 + (c >> 5), rr = r & 15, cc = c & 31, ob = rr * 64 + cc * 2; return st * 1024 + (ob ^ (((ob >> 9) & 1) << 5)); }
__device__ __forceinline__ void stage_rc(int b, int& R, int& C) { const int st = b / 1024, sb = b % 1024, swz = sb ^ (((sb >> 9) & 1) << 5); R = (st >> 1) * 16 + swz / 64; C = (st & 1) * 32 + (swz % 64) / 2; }

constexpr int HTB = HALF * BK * 2;
template <class F>
__device__ __forceinline__ void for_each_frag(const f32x4 (&acc)[2][2][4][2], int brow, int bcol, int wr, int wc, int fr, int fq, F&& f) {
#pragma unroll
    for (int ai = 0; ai < 2; ++ai)
#pragma unroll
        for (int m = 0; m < 4; ++m)
#pragma unroll
            for (int bj = 0; bj < 2; ++bj)
#pragma unroll
                for (int n = 0; n < 2; ++n)
                    f(brow + ai * HALF + wr * 64 + m * 16 + fr, bcol + bj * HALF + wc * 32 + n * 16 + fq * 4, acc[ai][bj][m][n]);
}

struct ZNone { __device__ __forceinline__ size_t a(int) const { return 0; } __device__ __forceinline__ size_t b(int) const { return 0; } };
template <class Epi, class ZMap = ZNone>
__device__ __forceinline__ void gemm_phase(const bf16_t* A, int lda, const bf16_t* Bt, int K, int nM, int nN, const Epi& E, int nZ = 1, ZMap zm = ZMap(), int kstepA_el = BK) {
    LAS unsigned char* lds = (LAS unsigned char*)smem;
    const int tid = threadIdx.x, wid = __builtin_amdgcn_readfirstlane(tid >> 6), lane = tid & 63, wr = wid >> 2, wc = wid & 3, fr = lane & 15, fq = lane >> 4;
    const int nt = K / BK, nmn = nM * nN, nu = nmn * nZ, G = gridDim.x;
    int u = blockIdx.x;
    if (u >= nu) return;
    unsigned voffA[2], voffB[2];
#pragma unroll
    for (int i = 0; i < 2; ++i) { int R, C; stage_rc(tid * 16 + i * 8192, R, C); voffA[i] = (unsigned)(R * lda + C) * 2u; voffB[i] = (unsigned)(R * K + C) * 2u; }
    const size_t kstep = (size_t)(BK * 2), kstepA = (size_t)kstepA_el * 2;
    const size_t hstepA = (size_t)HALF * lda * 2, hstepB = (size_t)HALF * K * 2, tstepA = 2 * hstepA, tstepB = 2 * hstepB;
    const unsigned ldsw = (unsigned)wid * 1024u;
    const int aoff = lds_byte(wr * 64 + fr, fq * 8), boff = lds_byte(wc * 32 + fr, fq * 8);
#define PG8_SA(b, h) (((b) * 2 + (h)) * HTB)
#define PG8_SB(b, h) ((4 + (b) * 2 + (h)) * HTB)
#define PG8_STAGE(bufoff, gbase, voff) do { _Pragma("unroll") for (int _i = 0; _i < 2; ++_i) \
        __builtin_amdgcn_global_load_lds((const unsigned*)((const char*)(gbase) + (voff)[_i]), (LAS unsigned*)(lds + (bufoff) + ldsw + _i * 8192), 16, 0, 0); } while (0)
#define PG8_LDA(dst, b, h) do { _Pragma("unroll") for (int m = 0; m < 4; ++m) _Pragma("unroll") for (int k = 0; k < 2; ++k) dst[m][k] = *(const LAS bf16x8*)(lds + PG8_SA(b, h) + aoff + m * 2048 + k * 1024); } while (0)
#define PG8_LDB(dst, b, h) do { _Pragma("unroll") for (int n = 0; n < 2; ++n) _Pragma("unroll") for (int k = 0; k < 2; ++k) dst[n][k] = *(const LAS bf16x8*)(lds + PG8_SB(b, h) + boff + n * 2048 + k * 1024); } while (0)
#define PG8_MMA(ai, bj, At, Bt_) do { __builtin_amdgcn_s_setprio(1); _Pragma("unroll") for (int m = 0; m < 4; ++m) _Pragma("unroll") for (int n = 0; n < 2; ++n) _Pragma("unroll") for (int k = 0; k < 2; ++k) \
        acc[ai][bj][m][n] = __builtin_amdgcn_mfma_f32_16x16x32_bf16(Bt_[n][k], At[m][k], acc[ai][bj][m][n], 0, 0, 0); __builtin_amdgcn_s_setprio(0); } while (0)
#define PG8_WAIT_V(n) asm volatile("s_waitcnt vmcnt(" #n ")" ::: "memory")
#define PG8_WAIT_L(n) asm volatile("s_waitcnt lgkmcnt(" #n ")" ::: "memory")
#define PG8_BAR __builtin_amdgcn_s_barrier()
#define PG8_SCHED __builtin_amdgcn_sched_barrier(0)
    f32x4 acc[2][2][4][2];
#pragma unroll
    for (int a = 0; a < 2; ++a)
#pragma unroll
        for (int b = 0; b < 2; ++b)
#pragma unroll
            for (int m = 0; m < 4; ++m)
#pragma unroll
                for (int n = 0; n < 2; ++n) acc[a][b][m][n] = (f32x4){0.f, 0.f, 0.f, 0.f};
    bf16x8 At[4][2], B0[2][2], B1[2][2];
    int z = u / nmn, pm = (u - z * nmn) / nN, pn = (u - z * nmn) - pm * nN;
    const char* cA = (const char*)(A + zm.a(z)) + (size_t)pm * tstepA; const char* cB = (const char*)(Bt + zm.b(z)) + (size_t)pn * tstepB;
    PG8_STAGE(PG8_SB(0, 0), cB, voffB); PG8_STAGE(PG8_SA(0, 0), cA, voffA); PG8_STAGE(PG8_SB(0, 1), cB + hstepB, voffB); PG8_STAGE(PG8_SA(0, 1), cA + hstepA, voffA);
    if (wr == 1) PG8_BAR;
    PG8_WAIT_V(4); PG8_BAR;
    PG8_STAGE(PG8_SB(1, 0), cB + kstep, voffB); PG8_STAGE(PG8_SA(1, 0), cA + kstepA, voffA); PG8_STAGE(PG8_SB(1, 1), cB + hstepB + kstep, voffB);
    PG8_WAIT_V(6); PG8_BAR;
    for (;;) {
        const int un = u + G; const bool has_next = un < nu;
        const int nz = has_next ? un / nmn : z, npm = has_next ? (un - nz * nmn) / nN : pm, npn = has_next ? (un - nz * nmn) - npm * nN : pn;
        const char* nA = (const char*)(A + zm.a(nz)) + (size_t)npm * tstepA; const char* nB = (const char*)(Bt + zm.b(nz)) + (size_t)npn * tstepB;
        for (int t = 0; t < nt; t += 2) {
            const bool last = (t == nt - 2);
            const char* a1 = cA + (size_t)(t + 1) * kstepA;
            const char* a2 = last ? nA : cA + (size_t)(t + 2) * kstepA; const char* b2 = last ? nB : cB + (size_t)(t + 2) * kstep;
            const char* a3 = a2 + kstepA; const char* b3 = b2 + kstep;
            PG8_LDB(B0, 0, 0); PG8_SCHED; PG8_LDA(At, 0, 0); PG8_STAGE(PG8_SA(1, 1), a1 + hstepA, voffA);
            PG8_WAIT_L(8); PG8_BAR; PG8_WAIT_L(0); PG8_MMA(0, 0, At, B0); PG8_BAR; PG8_SCHED;
            PG8_LDB(B1, 0, 1); PG8_STAGE(PG8_SB(0, 0), b2, voffB);
            PG8_BAR; PG8_WAIT_L(0); PG8_MMA(0, 1, At, B1); PG8_BAR;
            PG8_LDA(At, 0, 1); PG8_STAGE(PG8_SA(0, 0), a2, voffA);
            PG8_BAR; PG8_WAIT_L(0); PG8_MMA(1, 0, At, B0); PG8_BAR; PG8_SCHED;
            PG8_STAGE(PG8_SB(0, 1), b2 + hstepB, voffB);
            PG8_WAIT_V(6); PG8_BAR; PG8_MMA(1, 1, At, B1); PG8_BAR;
            PG8_LDB(B0, 1, 0); PG8_SCHED; PG8_LDA(At, 1, 0); PG8_STAGE(PG8_SA(0, 1), a2 + hstepA, voffA);
            PG8_WAIT_L(8); PG8_BAR; PG8_WAIT_L(0); PG8_MMA(0, 0, At, B0); PG8_BAR; PG8_SCHED;
            PG8_LDB(B1, 1, 1); PG8_STAGE(PG8_SB(1, 0), b3, voffB);
            PG8_BAR; PG8_WAIT_L(0); PG8_MMA(0, 1, At, B1); PG8_BAR;
            PG8_LDA(At, 1, 1); PG8_STAGE(PG8_SA(1, 0), a3, voffA);
            PG8_BAR; PG8_WAIT_L(0); PG8_MMA(1, 0, At, B0); PG8_BAR; PG8_SCHED;
            PG8_STAGE(PG8_SB(1, 1), b3 + hstepB, voffB);
            PG8_WAIT_V(6); PG8_BAR; PG8_MMA(1, 1, At, B1); PG8_BAR;
        }
        E(acc, pm * BM, pn * BM + (z << 20), wr, wc, fr, fq);
        if (!has_next) break;
#pragma unroll
        for (int a = 0; a < 2; ++a)
#pragma unroll
            for (int b = 0; b < 2; ++b)
#pragma unroll
                for (int m = 0; m < 4; ++m)
#pragma unroll
                    for (int n = 0; n < 2; ++n) acc[a][b][m][n] = (f32x4){0.f, 0.f, 0.f, 0.f};
        u = un; z = nz; pm = npm; pn = npn; cA = nA; cB = nB;
    }
    PG8_WAIT_V(0);
    if (wr == 0) PG8_BAR;
    PG8_BAR;
#undef PG8_SA
#undef PG8_SB
#undef PG8_STAGE
#undef PG8_LDA
#undef PG8_LDB
#undef PG8_MMA
#undef PG8_WAIT_V
#undef PG8_WAIT_L
#undef PG8_BAR
#undef PG8_SCHED
}

__device__ __forceinline__ size_t vfrag_off(int key, int d) {
    return ((size_t)((key >> 5) * 4 + (d >> 4)) * 64 + ((key >> 2) & 3) * 16 + (d & 15)) * 8 + ((key >> 4) & 1) * 4 + (key & 3);
}
__device__ __forceinline__ void st_bf16x4(bf16_t* p, f32x4 v) { u32x2 w; w.x = cvt_pk_bf16(v[0], v[1]); w.y = cvt_pk_bf16(v[2], v[3]); *(u32x2*)p = w; }

struct EpiIn {
    const Params& p;
    __device__ __forceinline__ void operator()(const f32x4 (&acc)[2][2][4][2], int brow, int bcol, int wr, int wc, int fr, int fq) const {
        const int pn = bcol >> 8;
        const Params& P = p;
        if (pn < 2) {
            for_each_frag(acc, brow, bcol, wr, wc, fr, fq, [&](int row, int col, f32x4 v) { st_bf16x4(P.Qb + (size_t)row * QD + col, v * QSCALE); });
        } else if (pn < 5) {
            bf16_t* cp = pn == 2 ? P.CMPb : pn == 3 ? P.SLCb : P.WINb;
            for_each_frag(acc, brow, bcol, wr, wc, fr, fq, [&](int row, int col, f32x4 v) {
                const int c = col & 255;
                if (pn != 2 || row < MP) st_bf16x4(cp + (size_t)row * 256 + c, v);
                if (pn >= 3 && c >= 128 && row < MP) {
                    const int t = row & (SEQ - 1), dc = c - 128;
                    bf16_t* vt = (pn == 3 ? P.SLCvT : P.WINvT) + ((size_t)(row >> 13) * NG + (dc >> 6)) * SEQ * 64 + vfrag_off(t, dc & 63);
                    vt[0] = f2bf(v[0]); vt[8] = f2bf(v[1]); vt[16] = f2bf(v[2]); vt[24] = f2bf(v[3]);
                }
                if (pn < 4) {
                    if (row < MP) *(f32x4*)(P.out + (pn == 2 ? O_CMPP : O_SLCP) + (size_t)row * 256 + c) = v;
                    else if (row < MP + NS) *(f32x4*)(P.out + (pn == 2 ? O_CMPS : O_SLCS) + (size_t)(row - MP) * 256 + c) = v;
                } else {
                    if (row < MP) { const int t = row & (SEQ - 1), b = row >> 13; if (t >= SEQ - WIN) *(f32x4*)(P.out + O_WINP + ((size_t)b * WIN + (t - (SEQ - WIN))) * 256 + c) = v; }
                    else if (row < MP + NS) *(f32x4*)(P.out + O_WINS + ((size_t)(row - MP) * WIN + (WIN - 1)) * 256 + c) = v;
                }
            });
        } else if (pn < 9) {
            bf16_t* dst = pn < 7 ? P.U : P.Vg; const int c0 = pn < 7 ? 1280 : 1792;
            for_each_frag(acc, brow, bcol, wr, wc, fr, fq, [&](int row, int col, f32x4 v) {
                f32x4 g; g[0] = geluf_(v[0]); g[1] = geluf_(v[1]); g[2] = geluf_(v[2]); g[3] = geluf_(v[3]);
                st_bf16x4(dst + (size_t)row * GMD + (col - c0), g); });
        } else if (pn < 17) {
            bf16_t* dst = pn < 13 ? P.GA : P.GB; const int c0 = pn < 13 ? 2304 : 3328;
            for_each_frag(acc, brow, bcol, wr, wc, fr, fq, [&](int row, int col, f32x4 v) {
                f32x4 g; g[0] = sigmoidf_(v[0]); g[1] = sigmoidf_(v[1]); g[2] = sigmoidf_(v[2]); g[3] = sigmoidf_(v[3]);
                st_bf16x4(dst + (size_t)row * DM + (col - c0), g); });
        } else {
            for_each_frag(acc, brow, bcol, wr, wc, fr, fq, [&](int row, int col, f32x4 v) {
                const int c = col & 255;
                if (c < 24) { f32x4 g; g[0] = sigmoidf_(v[0]); g[1] = sigmoidf_(v[1]); g[2] = sigmoidf_(v[2]); g[3] = sigmoidf_(v[3]); *(f32x4*)(P.GATE + (size_t)row * 32 + c) = g; } });
        }
    }
};
struct EpiBrA {
    const bf16_t* GA; float* T;
    __device__ __forceinline__ void operator()(const f32x4 (&acc)[2][2][4][2], int brow, int bcol, int wr, int wc, int fr, int fq) const {
        for_each_frag(acc, brow, bcol, wr, wc, fr, fq, [&](int row, int col, f32x4 v) {
            const u32x2 g = *(const u32x2*)(GA + (size_t)row * DM + col);
            f32x4 o; o[0] = v[0] * bflo(g.x); o[1] = v[1] * bfhi(g.x); o[2] = v[2] * bflo(g.y); o[3] = v[3] * bfhi(g.y);
            *(f32x4*)(T + (size_t)row * DM + col) = o; });
    }
};
struct EpiBrB {
    const bf16_t* GB; const float* T; bf16_t* Y1;
    __device__ __forceinline__ void operator()(const f32x4 (&acc)[2][2][4][2], int brow, int bcol, int wr, int wc, int fr, int fq) const {
        for_each_frag(acc, brow, bcol, wr, wc, fr, fq, [&](int row, int col, f32x4 v) {
            const u32x2 g = *(const u32x2*)(GB + (size_t)row * DM + col);
            const f32x4 t = *(const f32x4*)(T + (size_t)row * DM + col);
            f32x4 o; o[0] = t[0] + v[0] * bflo(g.x); o[1] = t[1] + v[1] * bfhi(g.x); o[2] = t[2] + v[2] * bflo(g.y); o[3] = t[3] + v[3] * bfhi(g.y);
            st_bf16x4(Y1 + (size_t)row * DM + col, o); });
    }
};
struct EpiF32 {
    float* F; int ld;
    __device__ __forceinline__ void operator()(const f32x4 (&acc)[2][2][4][2], int brow, int bcol, int wr, int wc, int fr, int fq) const {
        for_each_frag(acc, brow, bcol, wr, wc, fr, fq, [&](int row, int col, f32x4 v) { *(f32x4*)(F + (size_t)row * ld + col) = v; });
    }
};
struct EpiPart {
    float* PART;
    __device__ __forceinline__ void operator()(const f32x4 (&acc)[2][2][4][2], int brow, int bcol, int wr, int wc, int fr, int fq) const {
        const int z = bcol >> 20;
        for_each_frag(acc, brow, 0, wr, wc, fr, fq, [&](int row, int col, f32x4 v) { *(f32x4*)(PART + ((size_t)row * 4 + z) * 256 + col) = v; });
    }
};
struct ZCmp { __device__ __forceinline__ size_t a(int z) const { return (size_t)z * 64; } __device__ __forceinline__ size_t b(int z) const { return (size_t)(z >> 1) * 256 * 1024; } };
struct EpiSwiGLU {
    bf16_t* ACT;
    __device__ __forceinline__ void operator()(const f32x4 (&acc)[2][2][4][2], int brow, int bcol, int wr, int wc, int fr, int fq) const {
        for_each_frag(acc, brow, bcol, wr, wc, fr, fq, [&](int row, int col, f32x4 v) {
            *(unsigned*)(ACT + (size_t)row * DFF + (col >> 1)) = cvt_pk_bf16(siluf_(v[0]) * v[1], siluf_(v[2]) * v[3]); });
    }
};
struct EpiPleGate {
    const float* E; float* F;
    __device__ __forceinline__ void operator()(const f32x4 (&acc)[2][2][4][2], int brow, int bcol, int wr, int wc, int fr, int fq) const {
        for_each_frag(acc, brow, bcol, wr, wc, fr, fq, [&](int row, int col, f32x4 v) {
            const f32x4 e = *(const f32x4*)(E + (size_t)row * DM + col);
            f32x4 o; o[0] = sigmoidf_(v[0]) * e[0]; o[1] = sigmoidf_(v[1]) * e[1]; o[2] = sigmoidf_(v[2]) * e[2]; o[3] = sigmoidf_(v[3]) * e[3];
            *(f32x4*)(F + (size_t)row * DM + col) = o; });
    }
};

template <class Map>
__device__ __forceinline__ void transpose_tile(const float* W, int K, int N, bf16_t* Wt, int ldk, int kt, int ntile, Map map) {
    LAS float* tile = (LAS float*)smem;
    const int t = threadIdx.x;
    __syncthreads();
#pragma unroll
    for (int i = 0; i < 2; ++i) {
        const int k = (t >> 4) + 32 * i, n = (t & 15) * 4, gn = ntile * 64 + n;
        f32x4 v = (f32x4){0.f, 0.f, 0.f, 0.f};
        if (gn < N) v = *(const f32x4*)(W + (size_t)(kt * 64 + k) * N + gn);
        tile[k * 65 + n] = v[0]; tile[k * 65 + n + 1] = v[1]; tile[k * 65 + n + 2] = v[2]; tile[k * 65 + n + 3] = v[3];
    }
    __syncthreads();
    const int n = t >> 3, kc = (t & 7) * 8, gn = ntile * 64 + n;
    if (gn < N) {
        u32x4 w;
        w.x = cvt_pk_bf16(tile[(kc + 0) * 65 + n], tile[(kc + 1) * 65 + n]); w.y = cvt_pk_bf16(tile[(kc + 2) * 65 + n], tile[(kc + 3) * 65 + n]);
        w.z = cvt_pk_bf16(tile[(kc + 4) * 65 + n], tile[(kc + 5) * 65 + n]); w.w = cvt_pk_bf16(tile[(kc + 6) * 65 + n], tile[(kc + 7) * 65 + n]);
        *(u32x4*)(Wt + (size_t)map(gn) * ldk + kt * 64 + kc) = w;
    }
}
template <class Map>
__device__ __forceinline__ void transpose_all(const float* W, int K, int N, bf16_t* Wt, int ldk, Map map, int& base) {
    const int nkt = K / 64, nnt = (N + 63) / 64, ntl = nkt * nnt;
    for (int it = blockIdx.x; it < base + ntl; it += gridDim.x) {
        if (it < base) continue;
        const int l = it - base;
        transpose_tile(W, K, N, Wt, ldk, l / nnt, l % nnt, map);
    }
    base += ntl;
}
__device__ __forceinline__ int map_win(int n) {
    if (n < 1280) return n;
    if (n < 1304) return 4352 + (n - 1280);
    if (n < 2328) return 1280 + (n - 1304);
    return 2304 + (n - 2328);
}

__device__ __forceinline__ float row_rstd(const f32x4 (&v)[4]) {
    float s = 0.f;
#pragma unroll
    for (int k = 0; k < 4; ++k) s += v[k][0] * v[k][0] + v[k][1] * v[k][1] + v[k][2] * v[k][2] + v[k][3] * v[k][3];
    s = wave_sum(s);
    return rsqrtf(s * (1.0f / DM) + EPS);
}
__device__ __forceinline__ const float* xrow_ptr(const Params& p, int row) {
    return row < MP ? p.x_prompt + (size_t)row * DM : p.x_sample + (size_t)(row - MP) * DM;
}

__device__ void phase_prologue(const Params& p) {
    const int wid = threadIdx.x >> 6, lane = threadIdx.x & 63;
    const int gw = blockIdx.x * 8 + wid, nw = gridDim.x * 8;
    int base = 0;
    transpose_all(p.w_in, DM, IND, p.WinT, DM, [](int n) { return map_win(n); }, base);
    transpose_all(p.w_br_nsa, QD, DM, p.WnT, QD, [](int n) { return n; }, base);
    transpose_all(p.w_br_gm, GMD, DM, p.WgT, GMD, [](int n) { return n; }, base);
    transpose_all(p.w_out, DM, DM, p.WoT, DM, [](int n) { return n; }, base);
    transpose_all(p.w_gate, DM, DFF, p.WguT, DM, [](int n) { return 2 * n; }, base);
    transpose_all(p.w_up, DM, DFF, p.WguT, DM, [](int n) { return 2 * n + 1; }, base);
    transpose_all(p.w_down, DFF, DM, p.WdT, DFF, [](int n) { return n; }, base);
    transpose_all(p.w_ple_gate, DM, DM, p.WpgT, DM, [](int n) { return n; }, base);
    transpose_all(p.w_ple, PLE, DM, p.WpT, PLE, [](int n) { return n; }, base);
    for (int kv = 0; kv < 2; ++kv) for (int j = 0; j < 2; ++j)
        transpose_all((kv ? p.w1_v : p.w1_k) + (size_t)j * 1024 * 128, 1024, 128, p.W1T + ((size_t)kv * 256 + j * 128) * 1024, 1024, [](int n) { return n; }, base);
    __syncthreads();
    for (int i = blockIdx.x * 512 + threadIdx.x; i < (INP - IND) * DM / 8; i += gridDim.x * 512) ((u32x4*)(p.WinT + (size_t)IND * DM))[i] = (u32x4){0u, 0u, 0u, 0u};
    for (int row = gw; row < MALL; row += nw) {
        u32x2* hd = (u32x2*)(p.H + (size_t)row * DM);
        if (row < MP + NS) {
            const float* xr = xrow_ptr(p, row);
            f32x4 v[4];
#pragma unroll
            for (int k = 0; k < 4; ++k) v[k] = *(const f32x4*)(xr + lane * 4 + k * 256);
            const float r = row_rstd(v);
#pragma unroll
            for (int k = 0; k < 4; ++k) { const f32x4 g = *(const f32x4*)(p.ln_mix_pre + lane * 4 + k * 256); const f32x4 o = v[k] * r * g; u32x2 w; w.x = cvt_pk_bf16(o[0], o[1]); w.y = cvt_pk_bf16(o[2], o[3]); hd[lane + k * 64] = w; }
            const float* pr = row < MP ? p.p_prompt + (size_t)row * PLE : p.p_sample + (size_t)(row - MP) * PLE;
            const f32x4 pv = *(const f32x4*)(pr + lane * 4);
            u32x2 w; w.x = cvt_pk_bf16(pv[0], pv[1]); w.y = cvt_pk_bf16(pv[2], pv[3]);
            ((u32x2*)(p.Pb + (size_t)row * PLE))[lane] = w;
        } else {
#pragma unroll
            for (int k = 0; k < 4; ++k) hd[lane + k * 64] = (u32x2){0u, 0u};
            ((u32x2*)(p.Pb + (size_t)row * PLE))[lane] = (u32x2){0u, 0u};
        }
    }
    for (int r2 = gw; r2 < NS * PAST / 2; r2 += nw) {
        const int r = r2 * 2 + (lane >> 5), b = r >> 14, pos = r & (PAST - 1), l5 = lane & 31;
        const float* s = p.cache_cmp + ((size_t)p.page_table[b * NPG + (pos >> 7)] * PAGE + (pos & 127)) * 256 + l5 * 8;
        const f32x4 a = *(const f32x4*)s, c = *(const f32x4*)(s + 4);
        u32x4 w; w.x = cvt_pk_bf16(a[0], a[1]); w.y = cvt_pk_bf16(a[2], a[3]); w.z = cvt_pk_bf16(c[0], c[1]); w.w = cvt_pk_bf16(c[2], c[3]);
        *(u32x4*)(p.CMPb + ((size_t)MP + r) * 256 + l5 * 8) = w;
    }
    for (int i = blockIdx.x * 512 + threadIdx.x; i < 4 * 128 * 128; i += gridDim.x * 512) { const int t = (i >> 7) & 127, s = i & 127; p.GWb[i] = f2bf(s <= t ? p.gm_ws[i] : 0.f); }
    for (int i = blockIdx.x * 512 + threadIdx.x; i < 2 * 64 * 128; i += gridDim.x * 512) { const int kv = i >> 13, d = (i >> 7) & 63, h = i & 127; p.W2T[i] = f2bf((kv ? p.w2_v : p.w2_k)[h * 64 + d]); }
    if (gw < 4) {
        const int kv = gw >> 1, h = (gw & 1) * 64 + lane;
        const float* pe = kv ? p.pe_v : p.pe_k; const float* w1 = kv ? p.w1_v : p.w1_k;
        float s = 0.f;
        for (int k = 0; k < 2048; ++k) s += pe[k] * w1[(size_t)k * 128 + h];
        p.PEB[kv * 128 + h] = s;
    }
    for (int i = blockIdx.x * 512 + threadIdx.x; i < NS * (WIN - 1) * 64; i += gridDim.x * 512) {
        const int b = i / ((WIN - 1) * 64), r = i % ((WIN - 1) * 64);
        ((f32x4*)(p.out + O_WINS + (size_t)b * WIN * 256))[r] = ((const f32x4*)(p.state_win + (size_t)b * WIN * 256 + 256))[r];
    }
}

__device__ __forceinline__ f32x4 mfma16(bf16x8 a, bf16x8 b, f32x4 c) { return __builtin_amdgcn_mfma_f32_16x16x32_bf16(a, b, c, 0, 0, 0); }
__device__ __forceinline__ bf16x8 pack_p(const f32x4& a, const f32x4& b) {
    u32x4 w; w.x = cvt_pk_bf16(a[0], a[1]); w.y = cvt_pk_bf16(a[2], a[3]); w.z = cvt_pk_bf16(b[0], b[1]); w.w = cvt_pk_bf16(b[2], b[3]);
    return __builtin_bit_cast(bf16x8, w);
}
__device__ void phase_cmp_final(const Params& p) {
    const int wid = threadIdx.x >> 6, lane = threadIdx.x & 63;
    {
        const int c = lane & 15, G = lane >> 4;
        const int ngrp_p = NB * 4 * 32, ngrp_s = NS * 4 * 64;
#pragma unroll 1
        for (int it = blockIdx.x * 8 + wid; it < ngrp_p + ngrp_s; it += gridDim.x * 8) {
            const bool smp = it >= ngrp_p; const int l = smp ? it - ngrp_p : it;
            const int nch = smp ? 64 : 32, nc = smp ? NCS : NCP;
            const int ch = l % nch, z = (l / nch) & 3, seq = l / (nch * 4), kv = z >> 1, g = z & 1, n0 = ch * 16;
            const size_t r0 = smp ? (size_t)2048 + (size_t)seq * 1024 : (size_t)seq * 512;
            const int nr = n0 + c < nc ? n0 + c : nc - 1;
            const float* p0 = p.PART + ((r0 + nr) * 4 + z) * 256;
            const float* p1 = p.PART + ((r0 + nr + 1) * 4 + z) * 256 + 128;
            const float* pb = p.PEB + kv * 128;
            f32x4 acc[4] = {{0.f, 0.f, 0.f, 0.f}, {0.f, 0.f, 0.f, 0.f}, {0.f, 0.f, 0.f, 0.f}, {0.f, 0.f, 0.f, 0.f}};
#pragma unroll
            for (int ks = 0; ks < 4; ++ks) {
                const int h0 = 32 * ks + 8 * G;
                const f32x4 a0 = *(const f32x4*)(p0 + h0), a1 = *(const f32x4*)(p0 + h0 + 4), b0 = *(const f32x4*)(p1 + h0), b1 = *(const f32x4*)(p1 + h0 + 4);
                const f32x4 e0 = *(const f32x4*)(pb + h0), e1 = *(const f32x4*)(pb + h0 + 4);
                f32x4 x0 = a0 + b0 + e0, x1 = a1 + b1 + e1;
#pragma unroll
                for (int i = 0; i < 4; ++i) { x0[i] = siluf_(x0[i]); x1[i] = siluf_(x1[i]); }
                const bf16x8 A = pack_p(x0, x1);
#pragma unroll
                for (int nt = 0; nt < 4; ++nt) {
                    const bf16x8 B = *(const bf16x8*)(p.W2T + ((size_t)kv * 64 + nt * 16 + c) * 128 + h0);
                    acc[nt] = mfma16(A, B, acc[nt]);
                }
            }
#pragma unroll
            for (int nt = 0; nt < 4; ++nt) {
                const int d = nt * 16 + c;
#pragma unroll
                for (int i = 0; i < 4; ++i) {
                    const int n = n0 + 4 * G + i;
                    if (n < nc) {
                        if (smp) ((kv ? p.VCS : p.KCS) + (((size_t)seq * NG + g) * 1024 + n) * 64)[d] = acc[nt][i];
                        else if (kv == 0) p.KCb[(((size_t)seq * NG + g) * 512 + n) * 64 + d] = f2bf(acc[nt][i]);
                    }
                }
                if (!smp && kv == 1) {
                    f32x4 v = acc[nt];
#pragma unroll
                    for (int i = 0; i < 4; ++i) if (n0 + 4 * G + i >= nc) v[i] = 0.f;
                    st_bf16x4(p.VCT + ((size_t)seq * NG + g) * 512 * 64 + vfrag_off(n0 + 4 * G, d), v);
                }
            }
        }
    }
#pragma unroll 1
    for (int it = blockIdx.x * 8 + wid; it < NB * NG * 128; it += gridDim.x * 8) {
        const int j = it & 127, g = (it >> 7) & 1, b = it >> 8;
        const bf16_t* kr = p.SLCb + ((size_t)b * SEQ + j * 64 + lane) * 256 + g * 64;
        float q = 0.f;
#pragma unroll
        for (int c = 0; c < 8; ++c) { const u32x4 w = *(const u32x4*)(kr + c * 8);
            q += bflo(w.x) * bflo(w.x) + bfhi(w.x) * bfhi(w.x) + bflo(w.y) * bflo(w.y) + bfhi(w.y) * bfhi(w.y) + bflo(w.z) * bflo(w.z) + bfhi(w.z) * bfhi(w.z) + bflo(w.w) * bflo(w.w) + bfhi(w.w) * bfhi(w.w); }
        q = wave_max(q);
        if (lane == 0) p.KN[it] = q;
    }
}

template <bool SAMPLE>
__device__ __forceinline__ void kv_row_ptr(const Params& p, int branch  , int b, int pos, int kv, int g, const bf16_t*& pb, const float*& pf) {
    const int off = kv * 128 + g * 64;
    if (!SAMPLE) { pf = nullptr; pb = (branch == 1 ? p.SLCb : p.WINb) + ((size_t)b * SEQ + pos) * 256 + off; }
    else if (pos >= PAST) { pf = nullptr; pb = (branch == 1 ? p.SLCb : p.WINb) + ((size_t)MP + b) * 256 + off; }
    else if (branch == 1) { pb = nullptr; pf = p.cache_slc + ((size_t)p.page_table[b * NPG + (pos >> 7)] * PAGE + (pos & 127)) * 256 + off; }
    else { pb = nullptr; pf = p.state_win + ((size_t)b * WIN + (pos - (PAST - WIN))) * 256 + off; }
}
__device__ __forceinline__ void dot4x64(const bf16_t* pb, const float* pf, const LAS float* qs_, float (&s)[4]) {
    s[0] = s[1] = s[2] = s[3] = 0.f;
    const LAS float* qs = qs_; asm volatile("" : "+v"(qs));
    if (pf) {
#pragma unroll 4
        for (int c = 0; c < 16; ++c) {
            const f32x4 kx = *(const f32x4*)(pf + c * 4);
#pragma unroll
            for (int h = 0; h < 4; ++h) { const f32x4 q = *(const LAS f32x4*)(qs + h * 64 + c * 4); s[h] += q[0] * kx[0] + q[1] * kx[1] + q[2] * kx[2] + q[3] * kx[3]; }
        }
    } else {
#pragma unroll 2
        for (int c = 0; c < 8; ++c) {
            const u32x4 w = *(const u32x4*)(pb + c * 8);
            const float k0 = bflo(w.x), k1 = bfhi(w.x), k2 = bflo(w.y), k3 = bfhi(w.y), k4 = bflo(w.z), k5 = bfhi(w.z), k6 = bflo(w.w), k7 = bfhi(w.w);
#pragma unroll
            for (int h = 0; h < 4; ++h) {
                const f32x4 qa = *(const LAS f32x4*)(qs + h * 64 + c * 8), qb = *(const LAS f32x4*)(qs + h * 64 + c * 8 + 4);
                s[h] += qa[0] * k0 + qa[1] * k1 + qa[2] * k2 + qa[3] * k3 + qb[0] * k4 + qb[1] * k5 + qb[2] * k6 + qb[3] * k7;
            }
        }
    }
}
template <bool SAMPLE>
__device__ __forceinline__ void attn_chunk(const Params& p, int branch, int b, int g, int t, int pos0, int lo, int hi,
                                           float (&m)[4], float (&l)[4], float (&o)[4], const LAS float* qs, LAS float* pbk, const LAS float* relb, int lane) {
    const int pos = pos0 + lane;
    const bool valid = pos >= lo && pos <= hi;
    float s[4] = {-1e30f, -1e30f, -1e30f, -1e30f};
    if (valid) {
        const bf16_t* pb; const float* pf; kv_row_ptr<SAMPLE>(p, branch, b, pos, 0, g, pb, pf);
        dot4x64(pb, pf, qs, s);
        const int bk = t5_bucket(t - pos);
#pragma unroll
        for (int h = 0; h < 4; ++h) s[h] += relb[bk * 8 + g * 4 + h];
    }
#pragma unroll
    for (int h = 0; h < 4; ++h) {
        const float mx = wave_max(s[h]);
        const float mn = fmaxf(m[h], mx);
        const float pr = valid ? ex2(s[h] - mn) : 0.f;
        const float sm = wave_sum(pr);
        const float al = ex2(m[h] - mn);
        l[h] = l[h] * al + sm; o[h] *= al; m[h] = mn;
        pbk[h * 64 + lane] = pr;
    }
    __builtin_amdgcn_wave_barrier();
    const int k0 = (lo > pos0 ? lo : pos0) - pos0, k1 = (hi < pos0 + 63 ? hi : pos0 + 63) - pos0;
    if (SAMPLE) {
        const int kend = (PAST - 1 - pos0) < k1 ? (PAST - 1 - pos0) : k1;
        if (kend >= k0) {
            const bf16_t* pb; const float* pf; kv_row_ptr<SAMPLE>(p, branch, b, pos0 + k0, 1, g, pb, pf);
            pf += lane;
#pragma unroll 8
            for (int k = k0; k <= kend; ++k) {
                const float v = pf[(size_t)(k - k0) * 256];
#pragma unroll
                for (int h = 0; h < 4; ++h) o[h] += pbk[h * 64 + k] * v;
            }
        }
        if (k1 > kend) {
            const bf16_t* pb; const float* pf; kv_row_ptr<SAMPLE>(p, branch, b, pos0 + k1, 1, g, pb, pf);
            const float v = bf2f(pb[lane]);
#pragma unroll
            for (int h = 0; h < 4; ++h) o[h] += pbk[h * 64 + k1] * v;
        }
    } else {
#pragma unroll 1
    for (int k = k0; k <= k1; ++k) {
        const bf16_t* pb; const float* pf; kv_row_ptr<SAMPLE>(p, branch, b, pos0 + k, 1, g, pb, pf);
        const float v = pf ? pf[lane] : bf2f(pb[lane]);
#pragma unroll
        for (int h = 0; h < 4; ++h) o[h] += pbk[h * 64 + k] * v;
    }
    }
    __builtin_amdgcn_wave_barrier();
}

constexpr int S_QS = 0, S_SC = 1024, S_PHS = S_SC + 4 * 1024 * 4, S_PBK = S_PHS + 1088 * 4, S_PART = S_PBK + 8 * 1024, S_RED = S_PART + 2 * 8 * 272 * 4, S_OCP = S_RED + 512,
              S_SEL = S_OCP + 2048, S_RELB = S_SEL + 64, ATTS_LDS = S_RELB + 1024;
__device__ void attn_sample_item(const Params& p, int b, int g) {
    const int tid = threadIdx.x, wid = tid >> 6, lane = tid & 63;
    constexpr int t = PAST, NC = NCS, NSEL = 257, NJR = 5, qblk = PAST >> 6;
    const int row = MP + b;
    LAS unsigned char* L = (LAS unsigned char*)smem;
    LAS float* qs = (LAS float*)(L + S_QS); LAS float* sc = (LAS float*)(L + S_SC); LAS float* phs = (LAS float*)(L + S_PHS); LAS float* pbk = (LAS float*)(L + S_PBK) + wid * 256;
    LAS float* part = (LAS float*)(L + S_PART); LAS float* red = (LAS float*)(L + S_RED); LAS float* ocp = (LAS float*)(L + S_OCP); LAS int* sel = (LAS int*)(L + S_SEL);
    LAS float* relb = (LAS float*)(L + S_RELB);
    __syncthreads();
    if (tid < 256) { relb[tid] = p.rel_bias[tid] * LOG2E; qs[tid] = bf2f(p.Qb[(size_t)row * QD + g * 256 + tid]); }
    __syncthreads();
    const float* kc = p.KCS + ((size_t)b * NG + g) * 1024 * 64;
    const float* vc = p.VCS + ((size_t)b * NG + g) * 1024 * 64;
    {
        float mx[4] = {-1e30f, -1e30f, -1e30f, -1e30f};
#pragma unroll 1
        for (int r = wid; r < 16; r += 8) {
            const int n = r * 64 + lane;
            float s[4] = {-1e30f, -1e30f, -1e30f, -1e30f};
            if (n < NC) {
                dot4x64(nullptr, kc + (size_t)n * 64, qs, s);
                const int bk = t5_bucket(t - (16 * n + 31));
#pragma unroll
                for (int h = 0; h < 4; ++h) s[h] += relb[bk * 8 + g * 4 + h];
            }
#pragma unroll
            for (int h = 0; h < 4; ++h) { sc[h * 1024 + n] = s[h]; mx[h] = fmaxf(mx[h], s[h]); }
        }
#pragma unroll
        for (int h = 0; h < 4; ++h) { const float m = wave_max(mx[h]); if (lane == 0) red[wid * 4 + h] = m; }
    }
    __syncthreads();
    float gmx[4], inv[4];
#pragma unroll
    for (int h = 0; h < 4; ++h) { float m = red[h]; for (int w = 1; w < 8; ++w) m = fmaxf(m, red[w * 4 + h]); gmx[h] = m; }
    {
        float sum[4] = {0.f, 0.f, 0.f, 0.f};
#pragma unroll
        for (int k = 0; k < 2; ++k) { const int n = tid + 512 * k;
#pragma unroll
            for (int h = 0; h < 4; ++h) { const float e = n < NC ? ex2(sc[h * 1024 + n] - gmx[h]) : 0.f; sc[h * 1024 + n] = e; sum[h] += e; } }
#pragma unroll
        for (int h = 0; h < 4; ++h) { const float s = wave_sum(sum[h]); if (lane == 0) red[32 + wid * 4 + h] = s; }
    }
    __syncthreads();
#pragma unroll
    for (int h = 0; h < 4; ++h) { float s = 0.f; for (int w = 0; w < 8; ++w) s += red[32 + w * 4 + h]; inv[h] = s > 0.f ? 1.0f / s : 0.f; }
    for (int n = tid; n < 1088; n += 512) phs[n] = n < NC ? (sc[n] * inv[0] + sc[1024 + n] * inv[1]) + (sc[2048 + n] * inv[2] + sc[3072 + n] * inv[3]) : 0.f;
    {
        float a[4] = {0.f, 0.f, 0.f, 0.f};
#pragma unroll 8
        for (int n = wid; n < NC; n += 8) {
            const float v = vc[(size_t)n * 64 + lane];
#pragma unroll
            for (int h = 0; h < 4; ++h) a[h] += sc[h * 1024 + n] * v;
        }
#pragma unroll
        for (int h = 0; h < 4; ++h) part[(wid * 4 + h) * 68 + lane] = a[h] * inv[h];
    }
    __syncthreads();
    if (tid < 256) { float a = 0.f; for (int w = 0; w < 8; ++w) a += part[(w * 4 + (tid >> 6)) * 68 + (tid & 63)]; ocp[tid] = a; }
    __syncthreads();
    if (wid == 0) {
        unsigned long long key[NJR];
#pragma unroll
        for (int jr = 0; jr < NJR; ++jr) {
            const int j = jr * 64 + lane;
            key[jr] = 0ull;
            if (j >= 1 && j <= qblk - 2 && j < NSEL) {
                float im = 0.f;
#pragma unroll
                for (int n = 4 * j - 1; n <= 4 * j + 3; ++n) im += (n < NC) ? phs[n] : 0.f;
                key[jr] = ((unsigned long long)__float_as_uint(im) << 32) | (unsigned)(0xFFFF - j) | 0x10000ull;
            }
        }
        if (lane == 0) { sel[0] = 0; sel[1] = qblk - 1; sel[2] = qblk; }
#pragma unroll 1
        for (int it = 0; it < 13; ++it) {
            unsigned long long best = 0ull;
#pragma unroll
            for (int jr = 0; jr < NJR; ++jr) best = key[jr] > best ? key[jr] : best;
#pragma unroll
            for (int o = 32; o > 0; o >>= 1) { const unsigned long long ot = __shfl_xor(best, o); best = ot > best ? ot : best; }
            const int j = 0xFFFF - (int)(best & 0xFFFFull);
#pragma unroll
            for (int jr = 0; jr < NJR; ++jr) if (key[jr] == best) key[jr] = 0ull;
            if (lane == 0) sel[3 + it] = j;
        }
    }
    __syncthreads();
    {
        float ms[4] = {-1e30f, -1e30f, -1e30f, -1e30f}, ls[4] = {0.f, 0.f, 0.f, 0.f}, os[4] = {0.f, 0.f, 0.f, 0.f};
#pragma unroll 1
        for (int i = wid; i < 16; i += 8) attn_chunk<true>(p, 1, b, g, t, sel[i] * 64, 0, t, ms, ls, os, qs, pbk, relb, lane);
        float mw[4] = {-1e30f, -1e30f, -1e30f, -1e30f}, lw[4] = {0.f, 0.f, 0.f, 0.f}, ow[4] = {0.f, 0.f, 0.f, 0.f};
#pragma unroll 1
        for (int c = wid; c < 9; c += 8) attn_chunk<true>(p, 2, b, g, t, t - 63 - 64 * c, t - WIN, t, mw, lw, ow, qs, pbk, relb, lane);
#pragma unroll
        for (int h = 0; h < 4; ++h) {
            LAS float* ps = part + (wid * 4 + h) * 68; LAS float* pw = part + 8 * 272 + (wid * 4 + h) * 68;
            ps[lane] = os[h]; pw[lane] = ow[h];
            if (lane == 0) { ps[64] = ms[h]; ps[65] = ls[h]; pw[64] = mw[h]; pw[65] = lw[h]; }
        }
    }
    __syncthreads();
    if (tid < 256) {
        const int h = tid >> 6, d = tid & 63;
        float res[2];
#pragma unroll
        for (int br = 0; br < 2; ++br) {
            const LAS float* pp = part + br * 8 * 272 + h * 68;
            float m = -1e30f;
            for (int w = 0; w < 8; ++w) m = fmaxf(m, pp[w * 272 + 64]);
            float l = 0.f, o = 0.f;
            for (int w = 0; w < 8; ++w) { const float sc_ = ex2(pp[w * 272 + 64] - m); l += pp[w * 272 + 65] * sc_; o += pp[w * 272 + d] * sc_; }
            res[br] = o / l;
        }
        const float* gt = p.GATE + (size_t)row * 32 + (g * 4 + h) * 3;
        const float v = gt[0] * ocp[tid] + gt[1] * res[0] + gt[2] * res[1];
        p.OCAT[(size_t)row * DM + (g * 4 + h) * 64 + d] = f2bf(v);
    }
    __syncthreads();
}

constexpr int A_OST = 0, OST_LD = 68, A_LST = A_OST + 256 * OST_LD * 4, A_M0 = A_LST + 1024, A_MB = A_M0 + 1024, MB_LD = 132, A_MKN = A_MB + 64 * MB_LD,
              A_LIST = A_MKN + 256, A_CNT = A_LIST + 132 * 64, A_PK = A_CNT + 544, A_KN = A_PK + 400 * 4, A_T2 = A_KN + 512, A_NP = A_T2 + 132 * 8 * 4, A_QT = A_NP + 16, ATT2_LDS = A_QT + 64 * 512;
static_assert(ATT2_LDS <= GEMM_LDS && ATTS_LDS <= GEMM_LDS, "attention LDS");

__device__ __forceinline__ void qk64(const bf16_t* kb, int c, int G, const bf16x8 (&qB)[2], f32x4 (&s)[4]) {
#pragma unroll
    for (int kt = 0; kt < 4; ++kt) {
        const bf16_t* r = kb + (size_t)(16 * kt + c) * 256 + G * 8;
        const bf16x8 a0 = *(const bf16x8*)r, a1 = *(const bf16x8*)(r + 32);
        s[kt] = mfma16(a0, qB[0], (f32x4){0.f, 0.f, 0.f, 0.f}); s[kt] = mfma16(a1, qB[1], s[kt]);
    }
}
__device__ __forceinline__ void pv64(const bf16_t* vf, int key0, int lane, const f32x4 (&pr)[4], f32x4 (&o)[4]) {
#pragma unroll
    for (int ks = 0; ks < 2; ++ks) {
        const bf16x8 pB = pack_p(pr[2 * ks], pr[2 * ks + 1]);
#pragma unroll
        for (int dt = 0; dt < 4; ++dt) {
            const bf16x8 vA = *(const bf16x8*)(vf + ((size_t)(((key0 >> 5) + ks) * 4 + dt) * 64 + lane) * 8);
            o[dt] = mfma16(vA, pB, o[dt]);
        }
    }
}
__device__ __forceinline__ int qt_off(int qi, int hh, int k) { return (qi * 4 + hh) * 128 + ((k ^ (((qi & 3) << 1) | (hh >> 1))) << 4); }
__device__ __forceinline__ float grp_max(float v) { v = fmaxf(v, __shfl_xor(v, 16)); return fmaxf(v, __shfl_xor(v, 32)); }
__device__ __forceinline__ float grp_sum(float v) { v += __shfl_xor(v, 16); return v + __shfl_xor(v, 32); }

__device__ __forceinline__ void attn_pack(const Params& p, int b, int g, int t0, int lane_, LAS unsigned char* L) {
    f32x4 oacc[4];
    int lane = lane_; asm volatile("" : "+v"(lane));
    const int c = lane & 15, G = lane >> 4, qs = c >> 2, hh = c & 3;
    const int qb = t0 >> 6, tc = t0 + qs;
    const size_t qrow = (size_t)b * SEQ + tc;
    const LAS float* T2 = (const LAS float*)(L + A_T2);
    const float b31 = T2[128 * 8 + g * 4 + hh];
    bf16x8 qB[2];
    qB[0] = *(const bf16x8*)(p.Qb + qrow * QD + (g * 4 + hh) * 64 + G * 8); qB[1] = *(const bf16x8*)(p.Qb + qrow * QD + (g * 4 + hh) * 64 + 32 + G * 8);
    const float* gate = p.GATE + qrow * 32 + (g * 4 + hh) * 3;
    unsigned msk[4] = {0u, 0u, 0u, 0u};
    {
        const int ncv_c = tc >= 31 ? ((tc - 31) >> 4) + 1 : 0;
        const int ncv_m = t0 + 3 >= 31 ? ((t0 + 3 - 31) >> 4) + 1 : 0;
        const int NT = (ncv_m + 15) >> 4;
        const int mt_far = t0 >= 399 ? (t0 - 399) / 256 + 1 : 0;
        const bf16_t* kcb = p.KCb + (size_t)(b * NG + g) * 512 * 64;
        f32x4 sc[32];
        float mx = -1e30f;
#pragma unroll
        for (int mt = 0; mt < 32; ++mt) {
            sc[mt] = (f32x4){0.f, 0.f, 0.f, 0.f};
            if (mt < NT) {
                const bf16_t* r = kcb + (size_t)(16 * mt + c) * 64 + G * 8;
                const bf16x8 a0 = *(const bf16x8*)r, a1 = *(const bf16x8*)(r + 32);
                f32x4 s = mfma16(a0, qB[0], (f32x4){0.f, 0.f, 0.f, 0.f}); s = mfma16(a1, qB[1], s);
                if (mt < mt_far) { s = s + b31; }
                else {
#pragma unroll
                    for (int i = 0; i < 4; ++i) { const int n = 16 * mt + 4 * G + i; int dist = tc - (16 * n + 31); const bool ok = n < ncv_c; dist = dist < 0 ? 0 : (dist > 128 ? 128 : dist);
                        s[i] = ok ? s[i] + T2[dist * 8 + g * 4 + hh] : -1e30f; }
                }
                mx = fmaxf(mx, fmaxf(fmaxf(s[0], s[1]), fmaxf(s[2], s[3])));
                sc[mt] = s;
            }
            if ((mt & 3) == 3) __builtin_amdgcn_sched_barrier(0);
        }
        mx = grp_max(mx);
        float sum = 0.f;
#pragma unroll
        for (int mt = 0; mt < 32; ++mt) if (mt < NT) {
#pragma unroll
            for (int i = 0; i < 4; ++i) { const float e = sc[mt][i] > -1e29f ? ex2(sc[mt][i] - mx) : 0.f; sc[mt][i] = e; sum += e; }
        }
        sum = grp_sum(sum);
        const float inv = sum > 0.f ? 1.0f / sum : 0.f;
#pragma unroll
        for (int mt = 0; mt < 32; ++mt) if (mt < NT) sc[mt] = sc[mt] * inv;
        if (qb <= 15) {
            msk[0] = (qb >= 31) ? 0xffffffffu : ((2u << qb) - 1u);
        } else {
            float cand[8];
#pragma unroll
            for (int k = 0; k < 8; ++k) cand[k] = -1.f;
            float prevB = 0.f;
#pragma unroll
            for (int mt = 0; mt < 32; ++mt) if (mt < NT) {
                const float r1 = __shfl(sc[mt][3], (lane - 16) & 63);
                float v = (sc[mt][0] + sc[mt][1]) + (sc[mt][2] + sc[mt][3]) + (G == 0 ? prevB : r1);
                prevB = r1;
                v += __shfl_xor(v, 1); v += __shfl_xor(v, 2);
                const int j = 4 * mt + G;
                if ((mt & 3) == hh) cand[mt >> 2] = (j >= 1 && j <= qb - 2) ? v : -1.f;
            }
            auto setbit = [&](int j) { const unsigned bit = 1u << (j & 31); const int w = j >> 5; msk[0] |= w == 0 ? bit : 0u; msk[1] |= w == 1 ? bit : 0u; msk[2] |= w == 2 ? bit : 0u; msk[3] |= w == 3 ? bit : 0u; };
            setbit(0); setbit(qb); setbit(qb - 1);
#pragma unroll 1
            for (int it = 0; it < 13; ++it) {
                float bv = cand[0];
#pragma unroll
                for (int k = 1; k < 8; ++k) bv = fmaxf(bv, cand[k]);
                bv = fmaxf(bv, __shfl_xor(bv, 1)); bv = fmaxf(bv, __shfl_xor(bv, 2)); bv = grp_max(bv);
                int bj = 9999;
#pragma unroll
                for (int k = 0; k < 8; ++k) { const int j = 16 * k + 4 * hh + G; bj = (cand[k] == bv && j < bj) ? j : bj; }
                { int o = __shfl_xor(bj, 1); bj = o < bj ? o : bj; o = __shfl_xor(bj, 2); bj = o < bj ? o : bj; o = __shfl_xor(bj, 16); bj = o < bj ? o : bj; o = __shfl_xor(bj, 32); bj = o < bj ? o : bj; }
#pragma unroll
                for (int k = 0; k < 8; ++k) { const int j = 16 * k + 4 * hh + G; if (j == bj) cand[k] = -1.f; }
                setbit(bj & 127);
            }
        }
        const bf16_t* vct = p.VCT + (size_t)(b * NG + g) * 64 * 512;
        f32x4 oc[4] = {{0.f, 0.f, 0.f, 0.f}, {0.f, 0.f, 0.f, 0.f}, {0.f, 0.f, 0.f, 0.f}, {0.f, 0.f, 0.f, 0.f}};
#pragma unroll
        for (int k2 = 0; k2 < 16; ++k2) if (2 * k2 < NT) {
            const bf16x8 pB = pack_p(sc[2 * k2], sc[2 * k2 + 1]);
#pragma unroll
            for (int dt = 0; dt < 4; ++dt) {
                const bf16x8 vA = *(const bf16x8*)(vct + ((size_t)(k2 * 4 + dt) * 64 + lane) * 8);
                oc[dt] = mfma16(vA, pB, oc[dt]);
            }
            if (k2 & 1) __builtin_amdgcn_sched_barrier(0);
        }
        const float g0 = gate[0];
#pragma unroll
        for (int dt = 0; dt < 4; ++dt) oacc[dt] = oc[dt] * g0;
    }
    {
        unsigned um[4];
#pragma unroll
        for (int w = 0; w < 4; ++w) { unsigned u = msk[w]; u |= __shfl_xor(u, 4); u |= __shfl_xor(u, 8); um[w] = __builtin_amdgcn_readfirstlane(u); }
        f32x4 os[4] = {{0.f, 0.f, 0.f, 0.f}, {0.f, 0.f, 0.f, 0.f}, {0.f, 0.f, 0.f, 0.f}, {0.f, 0.f, 0.f, 0.f}};
        float m = -1e30f, l = 0.f;
        const bf16_t* kbase = p.SLCb + (size_t)b * SEQ * 256 + g * 64;
        const bf16_t* vbase = p.SLCvT + (size_t)(b * NG + g) * SEQ * 64;
        auto ldfr = [&](int j_, bf16x8 (&kf_)[4][2], bf16x8 (&vf_)[2][4]) {
#pragma unroll
            for (int kt = 0; kt < 4; ++kt) { const bf16_t* r = kbase + (size_t)(j_ * 64 + 16 * kt + c) * 256 + G * 8; kf_[kt][0] = *(const bf16x8*)r; kf_[kt][1] = *(const bf16x8*)(r + 32); }
#pragma unroll
            for (int ks = 0; ks < 2; ++ks)
#pragma unroll
                for (int dt = 0; dt < 4; ++dt) vf_[ks][dt] = *(const bf16x8*)(vbase + ((size_t)((2 * j_ + ks) * 4 + dt) * 64 + lane) * 8);
        };
        auto nextj = [&](int& j_) {
            int w = um[0] ? 0 : um[1] ? 1 : um[2] ? 2 : um[3] ? 3 : -1;
            if (w < 0) return false;
            const unsigned u = w == 0 ? um[0] : w == 1 ? um[1] : w == 2 ? um[2] : um[3];
            const int bpos = __builtin_ctz(u);
            j_ = w * 32 + bpos;
            const unsigned cl = ~(1u << bpos);
            if (w == 0) um[0] &= cl; else if (w == 1) um[1] &= cl; else if (w == 2) um[2] &= cl; else um[3] &= cl;
            return true;
        };
        bf16x8 kf[4][2], vf[2][4];
        int j = 0; bool have = nextj(j);
        ldfr(j, kf, vf);
#pragma unroll 1
        while (have) {
            int jn = j; const bool haven = nextj(jn);
            bf16x8 kn[4][2], vn[2][4];
            ldfr(jn, kn, vn);
            __builtin_amdgcn_sched_barrier(0);
            f32x4 s[4];
#pragma unroll
            for (int kt = 0; kt < 4; ++kt) { s[kt] = mfma16(kf[kt][0], qB[0], (f32x4){0.f, 0.f, 0.f, 0.f}); s[kt] = mfma16(kf[kt][1], qB[1], s[kt]); }
            const unsigned mw = (j >> 5) == 0 ? msk[0] : (j >> 5) == 1 ? msk[1] : (j >> 5) == 2 ? msk[2] : msk[3];
            const bool mine = (mw >> (j & 31)) & 1u;
            if (j <= qb - 3) {
#pragma unroll
                for (int kt = 0; kt < 4; ++kt)
#pragma unroll
                    for (int i = 0; i < 4; ++i) s[kt][i] = mine ? s[kt][i] + b31 : -1e30f;
            } else {
#pragma unroll
                for (int kt = 0; kt < 4; ++kt)
#pragma unroll
                    for (int i = 0; i < 4; ++i) { const int dist = tc - (j * 64 + 16 * kt + 4 * G + i); const int dd = dist < 0 ? 0 : (dist > 128 ? 128 : dist);
                        s[kt][i] = (mine && dist >= 0) ? s[kt][i] + T2[dd * 8 + g * 4 + hh] : -1e30f; }
            }
            float cm = fmaxf(fmaxf(fmaxf(s[0][0], s[0][1]), fmaxf(s[0][2], s[0][3])), fmaxf(fmaxf(s[1][0], s[1][1]), fmaxf(s[1][2], s[1][3])));
            cm = fmaxf(cm, fmaxf(fmaxf(fmaxf(s[2][0], s[2][1]), fmaxf(s[2][2], s[2][3])), fmaxf(fmaxf(s[3][0], s[3][1]), fmaxf(s[3][2], s[3][3]))));
            cm = grp_max(cm);
            const float mn = fmaxf(m, cm), al = ex2(m - mn);
            float ps = 0.f;
#pragma unroll
            for (int kt = 0; kt < 4; ++kt)
#pragma unroll
                for (int i = 0; i < 4; ++i) { const float e = s[kt][i] > -1e29f ? ex2(s[kt][i] - mn) : 0.f; s[kt][i] = e; ps += e; }
            l = l * al + grp_sum(ps); m = mn;
#pragma unroll
            for (int dt = 0; dt < 4; ++dt) os[dt] = os[dt] * al;
#pragma unroll
            for (int ks = 0; ks < 2; ++ks) { const bf16x8 pB = pack_p(s[2 * ks], s[2 * ks + 1]);
#pragma unroll
                for (int dt = 0; dt < 4; ++dt) os[dt] = mfma16(vf[ks][dt], pB, os[dt]); }
#pragma unroll
            for (int kt = 0; kt < 4; ++kt) { kf[kt][0] = kn[kt][0]; kf[kt][1] = kn[kt][1]; }
#pragma unroll
            for (int ks = 0; ks < 2; ++ks)
#pragma unroll
                for (int dt = 0; dt < 4; ++dt) vf[ks][dt] = vn[ks][dt];
            j = jn; have = haven;
        }
        const float gs = gate[1] / l;
#pragma unroll
        for (int dt = 0; dt < 4; ++dt) oacc[dt] = oacc[dt] + os[dt] * gs;
    }
    {
        f32x4 ow[4] = {{0.f, 0.f, 0.f, 0.f}, {0.f, 0.f, 0.f, 0.f}, {0.f, 0.f, 0.f, 0.f}, {0.f, 0.f, 0.f, 0.f}};
        float m = -1e30f, l = 0.f;
        const int lo = t0 - WIN > 0 ? t0 - WIN : 0, hi = t0 + 3;
        const bf16_t* kbase = p.WINb + (size_t)b * SEQ * 256 + g * 64;
        const bf16_t* vbase = p.WINvT + (size_t)(b * NG + g) * 64 * SEQ;
        bf16x8 kf[4][2], vf[2][4];
        auto ldfr = [&](int cb_, bf16x8 (&kf_)[4][2], bf16x8 (&vf_)[2][4]) {
#pragma unroll
            for (int kt = 0; kt < 4; ++kt) { const bf16_t* r = kbase + (size_t)(cb_ + 16 * kt + c) * 256 + G * 8; kf_[kt][0] = *(const bf16x8*)r; kf_[kt][1] = *(const bf16x8*)(r + 32); }
#pragma unroll
            for (int ks = 0; ks < 2; ++ks)
#pragma unroll
                for (int dt = 0; dt < 4; ++dt) vf_[ks][dt] = *(const bf16x8*)(vbase + ((size_t)(((cb_ >> 5) + ks) * 4 + dt) * 64 + lane) * 8);
        };
        ldfr(lo & ~63, kf, vf);
#pragma unroll 1
        for (int cb = lo & ~63; cb <= hi; cb += 64) {
            bf16x8 kn[4][2], vn[2][4];
            ldfr(cb + 64 <= hi ? cb + 64 : cb, kn, vn);
            __builtin_amdgcn_sched_barrier(0);
            f32x4 s[4];
#pragma unroll
            for (int kt = 0; kt < 4; ++kt) { s[kt] = mfma16(kf[kt][0], qB[0], (f32x4){0.f, 0.f, 0.f, 0.f}); s[kt] = mfma16(kf[kt][1], qB[1], s[kt]); }
            const bool far = (cb + 63 <= t0 - 128) && (cb >= t0 + 3 - WIN);
            if (far) {
#pragma unroll
                for (int kt = 0; kt < 4; ++kt) s[kt] = s[kt] + b31;
            } else {
#pragma unroll
                for (int kt = 0; kt < 4; ++kt)
#pragma unroll
                    for (int i = 0; i < 4; ++i) { const int dist = tc - (cb + 16 * kt + 4 * G + i); const bool ok = dist >= 0 && dist <= WIN; const int dd = dist < 0 ? 0 : (dist > 128 ? 128 : dist);
                        s[kt][i] = ok ? s[kt][i] + T2[dd * 8 + g * 4 + hh] : -1e30f; }
            }
            float cm = fmaxf(fmaxf(fmaxf(s[0][0], s[0][1]), fmaxf(s[0][2], s[0][3])), fmaxf(fmaxf(s[1][0], s[1][1]), fmaxf(s[1][2], s[1][3])));
            cm = fmaxf(cm, fmaxf(fmaxf(fmaxf(s[2][0], s[2][1]), fmaxf(s[2][2], s[2][3])), fmaxf(fmaxf(s[3][0], s[3][1]), fmaxf(s[3][2], s[3][3]))));
            cm = grp_max(cm);
            const float mn = fmaxf(m, cm), al = ex2(m - mn);
            float ps = 0.f;
#pragma unroll
            for (int kt = 0; kt < 4; ++kt)
#pragma unroll
                for (int i = 0; i < 4; ++i) { const float e = s[kt][i] > -1e29f ? ex2(s[kt][i] - mn) : 0.f; s[kt][i] = e; ps += e; }
            l = l * al + grp_sum(ps); m = mn;
#pragma unroll
            for (int dt = 0; dt < 4; ++dt) ow[dt] = ow[dt] * al;
#pragma unroll
            for (int ks = 0; ks < 2; ++ks) { const bf16x8 pB = pack_p(s[2 * ks], s[2 * ks + 1]);
#pragma unroll
                for (int dt = 0; dt < 4; ++dt) ow[dt] = mfma16(vf[ks][dt], pB, ow[dt]); }
#pragma unroll
            for (int kt = 0; kt < 4; ++kt) { kf[kt][0] = kn[kt][0]; kf[kt][1] = kn[kt][1]; }
#pragma unroll
            for (int ks = 0; ks < 2; ++ks)
#pragma unroll
                for (int dt = 0; dt < 4; ++dt) vf[ks][dt] = vn[ks][dt];
        }
        const float gw = gate[2] / l;
#pragma unroll
        for (int dt = 0; dt < 4; ++dt) st_bf16x4(p.OCAT + qrow * DM + (g * 4 + hh) * 64 + dt * 16 + 4 * G, oacc[dt] + ow[dt] * gw);
    }
}

__device__ void phase_attn(const Params& p) {
    const int wid = threadIdx.x >> 6, lane = threadIdx.x & 63;
    { PROBE_BEGIN(3)
    if (blockIdx.x < NS * NG) attn_sample_item(p, blockIdx.x >> 1, blockIdx.x & 1);
    PROBE_END(3) }
    LAS unsigned char* L = (LAS unsigned char*)smem;
    for (int i = threadIdx.x; i < 129 * 8; i += 512) ((LAS float*)(L + A_T2))[i] = p.rel_bias[t5_bucket(i >> 3) * 8 + (i & 7)] * LOG2E;
    __syncthreads();
    {
        const int wid2 = __builtin_amdgcn_readfirstlane(threadIdx.x >> 6);
#pragma unroll 1
        for (int T = blockIdx.x; T < NB * NG * (SEQ / 32); T += gridDim.x) {
            const int bg = T & 7, h32 = (SEQ / 32 - 1) - (T >> 3);
            attn_pack(p, bg >> 1, bg & 1, h32 * 32 + wid2 * 4, lane, L);
        }
    }
    __syncthreads();
}

constexpr int GM_LD = 136, GM_LDS = 128 * GM_LD * 2 + 1024;
__device__ void phase_gmlp(const Params& p) {
    const int tid = threadIdx.x, wid = __builtin_amdgcn_readfirstlane(tid >> 6), lane = tid & 63;
    LAS bf16_t* vnT = (LAS bf16_t*)smem;
    LAS float* mu = (LAS float*)(smem + 128 * GM_LD * 2);
    const int c = lane & 15, G = lane >> 4;
#pragma unroll 1
    for (int u = blockIdx.x; u < NB * 64; u += gridDim.x) {
        const int b = u >> 6, ch = u & 63; const size_t row0 = (size_t)b * SEQ + ch * 128;
        __syncthreads();
        for (int r = wid; r < 128; r += 8) {
            const u32x4 w = *(const u32x4*)(p.Vg + (row0 + r) * GMD + lane * 8);
            const float x[8] = {bflo(w.x), bfhi(w.x), bflo(w.y), bfhi(w.y), bflo(w.z), bfhi(w.z), bflo(w.w), bfhi(w.w)};
            float s = 0.f;
#pragma unroll
            for (int i = 0; i < 8; ++i) s += x[i];
            const float mean = wave_sum(s) * (1.0f / GMD);
            float q = 0.f;
#pragma unroll
            for (int i = 0; i < 8; ++i) q += (x[i] - mean) * (x[i] - mean);
            const float var = wave_sum(q) * (1.0f / GMD);
            if (lane == 0) { mu[r] = mean; mu[128 + r] = rsqrtf(var + EPS); }
        }
#pragma unroll 1
        for (int g = 0; g < 4; ++g) {
            __syncthreads();
#pragma unroll
            for (int k = 0; k < 4; ++k) {
                const int e = tid + 512 * k, s = e & 127, d0 = (e >> 7) * 8;
                const u32x4 w = *(const u32x4*)(p.Vg + (row0 + s) * GMD + g * 128 + d0);
                const float x[8] = {bflo(w.x), bfhi(w.x), bflo(w.y), bfhi(w.y), bflo(w.z), bfhi(w.z), bflo(w.w), bfhi(w.w)};
                const float m = mu[s], rs = mu[128 + s];
#pragma unroll
                for (int i = 0; i < 8; ++i) { const int cc = g * 128 + d0 + i; vnT[(d0 + i) * GM_LD + s] = f2bf((x[i] - m) * rs * p.gm_ln_g[cc] + p.gm_ln_b[cc]); }
            }
            __syncthreads();
            f32x4 acc[8];
#pragma unroll
            for (int dt = 0; dt < 8; ++dt) acc[dt] = (f32x4){0.f, 0.f, 0.f, 0.f};
            const bf16_t* wrow = p.GWb + ((size_t)g * 128 + 16 * wid + c) * 128 + 8 * G;
#pragma unroll 1
            for (int ks = 0; ks <= (wid >> 1); ++ks) {
                const bf16x8 B = *(const bf16x8*)(wrow + 32 * ks);
#pragma unroll
                for (int dt = 0; dt < 8; ++dt) {
                    const bf16x8 A = *(const LAS bf16x8*)(vnT + (dt * 16 + c) * GM_LD + 32 * ks + 8 * G);
                    acc[dt] = mfma16(A, B, acc[dt]);
                }
            }
            const int t = 16 * wid + c;
            const float bs = p.gm_bs[g * 128 + t];
#pragma unroll
            for (int dt = 0; dt < 8; ++dt) {
                const int d = dt * 16 + 4 * G;
                const u32x2 uw = *(const u32x2*)(p.U + (row0 + t) * GMD + g * 128 + d);
                f32x4 o; o[0] = bflo(uw.x) * (acc[dt][0] + bs); o[1] = bfhi(uw.x) * (acc[dt][1] + bs); o[2] = bflo(uw.y) * (acc[dt][2] + bs); o[3] = bfhi(uw.y) * (acc[dt][3] + bs);
                st_bf16x4(p.OCAT + (row0 + t) * DM + QD + g * 128 + d, o);
            }
        }
    }
    for (int it = blockIdx.x * 8 + wid; it < NS; it += gridDim.x * 8) {
        const size_t row = (size_t)MP + it;
        const u32x4 w = *(const u32x4*)(p.Vg + row * GMD + lane * 8);
        const float x[8] = {bflo(w.x), bfhi(w.x), bflo(w.y), bfhi(w.y), bflo(w.z), bfhi(w.z), bflo(w.w), bfhi(w.w)};
        float s = 0.f;
#pragma unroll
        for (int i = 0; i < 8; ++i) s += x[i];
        const float mean = wave_sum(s) * (1.0f / GMD);
        float q = 0.f;
#pragma unroll
        for (int i = 0; i < 8; ++i) q += (x[i] - mean) * (x[i] - mean);
        const float rs = rsqrtf(wave_sum(q) * (1.0f / GMD) + EPS);
#pragma unroll
        for (int i = 0; i < 8; ++i) {
            const int c = lane * 8 + i, g = c >> 7;
            const float v = (x[i] - mean) * rs * p.gm_ln_g[c] + p.gm_ln_b[c];
            p.out[O_GMV + (size_t)it * GMD + c] = v;
            const float a = p.gm_ws[(size_t)g * 128 * 128] * v + p.gm_bs[g * 128];
            p.OCAT[row * DM + QD + c] = f2bf(bf2f(p.U[row * GMD + c]) * a);
        }
    }
}

template <int MODE>
__device__ void phase_norm(const Params& p) {
    const int wid = threadIdx.x >> 6, lane = threadIdx.x & 63;
    const float* gpost = MODE == 0 ? p.ln_mix_post : MODE == 1 ? p.ln_ffn_post : p.ln_ple_post;
    for (int row = blockIdx.x * 8 + wid; row < MP + NS; row += gridDim.x * 8) {
        const float* fr = p.F + (size_t)row * DM;
        const float* xr = MODE == 0 ? xrow_ptr(p, row) : MODE == 1 ? p.X1 + (size_t)row * DM : p.X2 + (size_t)row * DM;
        f32x4 f[4], x[4];
#pragma unroll
        for (int k = 0; k < 4; ++k) { f[k] = *(const f32x4*)(fr + lane * 4 + k * 256); x[k] = *(const f32x4*)(xr + lane * 4 + k * 256); }
        const float r = row_rstd(f);
#pragma unroll
        for (int k = 0; k < 4; ++k) { const f32x4 g = *(const f32x4*)(gpost + lane * 4 + k * 256); x[k] = x[k] + f[k] * r * g; }
        if (MODE == 0) {
            const float r2 = row_rstd(x);
#pragma unroll
            for (int k = 0; k < 4; ++k) {
                *(f32x4*)(p.X1 + (size_t)row * DM + lane * 4 + k * 256) = x[k];
                const f32x4 g = *(const f32x4*)(p.ln_ffn_pre + lane * 4 + k * 256); const f32x4 o = x[k] * r2 * g;
                st_bf16x4(p.H2 + (size_t)row * DM + lane * 4 + k * 256, o);
            }
        } else if (MODE == 1) {
#pragma unroll
            for (int k = 0; k < 4; ++k) { *(f32x4*)(p.X2 + (size_t)row * DM + lane * 4 + k * 256) = x[k]; st_bf16x4(p.X2b + (size_t)row * DM + lane * 4 + k * 256, x[k]); }
        } else {
            float* yr = row < MP ? p.out + O_YP + (size_t)row * DM : p.out + O_YS + (size_t)(row - MP) * DM;
#pragma unroll
            for (int k = 0; k < 4; ++k) *(f32x4*)(yr + lane * 4 + k * 256) = x[k];
        }
    }
}


#define XB_TMO      128
#define XB_XCNT(j)  (256  + 64 * (j))
#define XB_XSUB(j)  (1280 + 64 * (j))
#define XB_XGEN(j)  (2304 + 64 * (j))
#define XB_TOP      3328
#define XB_TOPGEN   3392
#define XCD_BAR_WORDS 3456
#define XB_SPIN_CAP (1u << 22)

__device__ __forceinline__ unsigned xb_ld(unsigned* p)              { return __hip_atomic_load(p, __ATOMIC_RELAXED, __HIP_MEMORY_SCOPE_AGENT); }
__device__ __forceinline__ unsigned xb_add(unsigned* p, unsigned v) { return __hip_atomic_fetch_add(p, v, __ATOMIC_RELAXED, __HIP_MEMORY_SCOPE_AGENT); }
__device__ __forceinline__ unsigned xb_xcc_id() { return (unsigned)__builtin_amdgcn_s_getreg((3 << 11) | 20) & 0xFu; }
#define XB_SPIN(cond, bar) do { unsigned _sp = 0; while (cond) { __builtin_amdgcn_s_sleep(1); \
    if ((++_sp & 255u) == 0u) { if (xb_ld(&(bar)[XB_TMO])) break; if (_sp > XB_SPIN_CAP) { atomicAdd(&(bar)[XB_TMO], 1u); break; } } } } while (0)

struct XcdBarrier {
    unsigned* bar; unsigned x;
    volatile LAS unsigned* st;
};

__device__ __forceinline__ XcdBarrier xcd_barrier_post(unsigned* bar, volatile LAS unsigned* st) {
    XcdBarrier b; b.bar = bar; b.x = xb_xcc_id(); b.st = st;
    if (threadIdx.x == 0) (void)xb_add(&bar[XB_XCNT(b.x)], 1u);
    return b;
}
__device__ __forceinline__ void xcd_barrier_complete(unsigned* bar, unsigned x, unsigned& nloc, unsigned& nx) {
    const unsigned G = gridDim.x * gridDim.y * gridDim.z;
    unsigned sum, cnt, mine, sp = 0u;
    for (;;) {
        sum = 0u; cnt = 0u; mine = 0u;
#pragma unroll
        for (unsigned j = 0; j < 16; ++j) { const unsigned c = xb_ld(&bar[XB_XCNT(j)]); sum += c; cnt += (c > 0u) ? 1u : 0u; mine = (j == x) ? c : mine; }
        if (sum == G) break;
        __builtin_amdgcn_s_sleep(1);
        if ((++sp & 255u) == 0u) { if (xb_ld(&bar[XB_TMO])) break; if (sp > XB_SPIN_CAP) { atomicAdd(&bar[XB_TMO], 1u); break; } }
    }
    nloc = mine > 0u ? mine : 1u; nx = cnt > 0u ? cnt : 1u;
}

__device__ __forceinline__ void xcd_barrier(const XcdBarrier& b) {
    asm volatile("s_waitcnt vmcnt(0)" ::: "memory");
    __syncthreads();
    if (threadIdx.x == 0) {
        unsigned* bar = b.bar;
        __builtin_amdgcn_s_waitcnt(0);
        unsigned nloc = b.st[0], nx = b.st[1];
        if (nloc == 0u) { xcd_barrier_complete(bar, b.x, nloc, nx); b.st[0] = nloc; b.st[1] = nx; }
        const unsigned old = xb_add(&bar[XB_XSUB(b.x)], 1u);
        const unsigned gen = old / nloc;
        if (old + 1u == (gen + 1u) * nloc) {
            __builtin_amdgcn_fence(__ATOMIC_RELEASE, "agent");
            asm volatile("s_waitcnt vmcnt(0)" ::: "memory");
            const unsigned og = xb_add(&bar[XB_TOP], 1u);
            const unsigned tg = og / nx;
            if (og + 1u == (tg + 1u) * nx) xb_add(&bar[XB_TOPGEN], 1u);
            else XB_SPIN(xb_ld(&bar[XB_TOPGEN]) == tg, bar);
            __builtin_amdgcn_fence(__ATOMIC_ACQUIRE, "agent");
            xb_add(&bar[XB_XGEN(b.x)], 1u);
            asm volatile("s_waitcnt vmcnt(0)" ::: "memory");
        } else {
            XB_SPIN(xb_ld(&bar[XB_XGEN(b.x)]) == gen, bar);
            __builtin_amdgcn_fence(__ATOMIC_ACQUIRE, "agent");
            asm volatile("s_waitcnt vmcnt(0)" ::: "memory");
        }
    }
    __syncthreads();
}

constexpr int NPHASE = 16;
constexpr int LDS_BYTES = GEMM_LDS;
static_assert(GM_LDS <= LDS_BYTES, "lds");
constexpr int NMT = MALL / BM;

template <int PH>
__device__ __forceinline__ void run_phase(const Params& p) {
    if (PH == 0) phase_prologue(p);
    if (PH == 1) { EpiIn e{p}; gemm_phase(p.H, DM, p.WinT, DM, NMT, INP / BM, e); }
    if (PH == 2) { EpiPart e{p.PART}; gemm_phase(p.CMPb, 4096, p.W1T, 1024, (2048 + NS * 1024) / BM, 1, e, 4, ZCmp(), 256); }
    if (PH == 3) phase_cmp_final(p);
    if (PH == 4) phase_attn(p);
    if (PH == 5) phase_gmlp(p);
    if (PH == 6) { EpiBrA e{p.GA, p.T}; gemm_phase(p.OCAT, DM, p.WnT, QD, NMT, DM / BM, e); }
    if (PH == 7) { EpiBrB e{p.GB, p.T, p.Y1}; gemm_phase(p.OCAT + QD, DM, p.WgT, GMD, NMT, DM / BM, e); }
    if (PH == 8) { EpiF32 e{p.F, DM}; gemm_phase(p.Y1, DM, p.WoT, DM, NMT, DM / BM, e); }
    if (PH == 9) phase_norm<0>(p);
    if (PH == 10) { EpiSwiGLU e{p.ACT}; gemm_phase(p.H2, DM, p.WguT, DM, NMT, 2 * DFF / BM, e); }
    if (PH == 11) { EpiF32 e{p.F, DM}; gemm_phase(p.ACT, DFF, p.WdT, DFF, NMT, DM / BM, e); }
    if (PH == 12) phase_norm<1>(p);
    if (PH == 13) { EpiF32 e{p.T, DM}; gemm_phase(p.Pb, PLE, p.WpT, PLE, NMT, DM / BM, e); }
    if (PH == 14) { EpiPleGate e{p.T, p.F}; gemm_phase(p.X2b, DM, p.WpgT, DM, NMT, DM / BM, e); }
    if (PH == 15) phase_norm<2>(p);
}

#ifndef MK_MULTI
#define MK_MULTI 0
#endif
template <int PH>
__global__ void __launch_bounds__(512, 2) k_phase(Params p) { run_phase<PH>(p); }

__global__ void __launch_bounds__(512, 2) k_all(Params p) {
    volatile LAS unsigned* st = (volatile LAS unsigned*)((LAS unsigned char*)smem + LDS_BYTES);
    if (threadIdx.x < 12) st[threadIdx.x] = 0u;
    __syncthreads();
    XcdBarrier bar = xcd_barrier_post(p.bar, st);
#if PROBE_DUP == 100
    run_phase<0>(p);  xcd_barrier(bar);
#endif
    run_phase<0>(p);  xcd_barrier(bar);
    run_phase<1>(p);  xcd_barrier(bar);
    run_phase<2>(p);  xcd_barrier(bar);
#if PROBE_DUP == 100
    run_phase<3>(p);  xcd_barrier(bar);
#endif
    run_phase<3>(p);  xcd_barrier(bar);
#if PROBE_DUP == 104
    run_phase<4>(p);  xcd_barrier(bar);
#endif
    run_phase<4>(p);
#if PROBE_DUP == 100
    run_phase<5>(p);  xcd_barrier(bar);
#endif
    run_phase<5>(p);  xcd_barrier(bar);
    run_phase<6>(p);  xcd_barrier(bar);
    run_phase<7>(p);  xcd_barrier(bar);
    run_phase<8>(p);  xcd_barrier(bar);
    run_phase<9>(p);  xcd_barrier(bar);
    run_phase<10>(p); xcd_barrier(bar);
    run_phase<11>(p); xcd_barrier(bar);
    run_phase<12>(p);
    run_phase<13>(p); xcd_barrier(bar);
    run_phase<14>(p); xcd_barrier(bar);
    run_phase<15>(p);
#if PROBE_SPIN
    if (blockIdx.x == 0 && threadIdx.x == 0) {
        const unsigned long long d = PROBE_TS[2] * PROBE_SPIN, t0 = probe_now();
        while (probe_now() - t0 < d) __builtin_amdgcn_s_sleep(8);
    }
#endif
}

static inline size_t al256(size_t x) { return (x + 255) & ~(size_t)255; }
template <int PH> static void launch_phase(const Params& p, int grid, hipStream_t s) {
    static bool attr = false;
    if (!attr) { (void)hipFuncSetAttribute((const void*)k_phase<PH>, hipFuncAttributeMaxDynamicSharedMemorySize, LDS_BYTES); attr = true; }
    k_phase<PH><<<grid, 512, LDS_BYTES, s>>>(p);
}
template <int PH> static void launch_all(const Params& p, int grid, hipStream_t s) {
    launch_phase<PH>(p, grid, s);
    if constexpr (PH + 1 < NPHASE) launch_all<PH + 1>(p, grid, s);
}

extern "C" void kernel_launch(void* const* d_in, const int* in_sizes, int n_in, void* d_out, int out_size, void* d_ws, size_t ws_size, hipStream_t stream) {
    Params p{};
    p.x_prompt = (const float*)d_in[0]; p.x_sample = (const float*)d_in[1]; p.cache_cmp = (const float*)d_in[2]; p.cache_slc = (const float*)d_in[3];
    p.state_win = (const float*)d_in[4]; p.page_table = (const int*)d_in[5]; p.p_prompt = (const float*)d_in[6]; p.p_sample = (const float*)d_in[7];
    p.rel_bias = (const float*)d_in[8]; p.ln_mix_pre = (const float*)d_in[9]; p.w_in = (const float*)d_in[10];
    p.pe_k = (const float*)d_in[11]; p.w1_k = (const float*)d_in[12]; p.w2_k = (const float*)d_in[13];
    p.pe_v = (const float*)d_in[14]; p.w1_v = (const float*)d_in[15]; p.w2_v = (const float*)d_in[16];
    p.gm_ln_g = (const float*)d_in[17]; p.gm_ln_b = (const float*)d_in[18]; p.gm_ws = (const float*)d_in[19]; p.gm_bs = (const float*)d_in[20];
    p.w_br_nsa = (const float*)d_in[21]; p.w_br_gm = (const float*)d_in[22]; p.w_out = (const float*)d_in[23];
    p.ln_mix_post = (const float*)d_in[24]; p.ln_ffn_pre = (const float*)d_in[25]; p.w_gate = (const float*)d_in[26]; p.w_up = (const float*)d_in[27];
    p.w_down = (const float*)d_in[28]; p.ln_ffn_post = (const float*)d_in[29]; p.w_ple = (const float*)d_in[30]; p.w_ple_gate = (const float*)d_in[31];
    p.ln_ple_post = (const float*)d_in[32];
    p.out = (float*)d_out;
    unsigned char* w = (unsigned char*)d_ws; size_t off = 0;
    auto take = [&](size_t bytes) { void* r = w + off; off = al256(off + bytes); return r; };
    p.bar = (unsigned*)take(16384);
    p.WinT = (bf16_t*)take((size_t)INP * DM * 2); p.WnT = (bf16_t*)take((size_t)DM * QD * 2); p.WgT = (bf16_t*)take((size_t)DM * GMD * 2);
    p.WoT = (bf16_t*)take((size_t)DM * DM * 2); p.WguT = (bf16_t*)take((size_t)2 * DFF * DM * 2); p.WdT = (bf16_t*)take((size_t)DM * DFF * 2);
    p.WpgT = (bf16_t*)take((size_t)DM * DM * 2); p.WpT = (bf16_t*)take((size_t)DM * PLE * 2); p.W1T = (bf16_t*)take((size_t)2 * 256 * 1024 * 2);
    p.H = (bf16_t*)take((size_t)MALL * DM * 2); p.Qb = (bf16_t*)take((size_t)MALL * QD * 2);
    p.CMPb = (bf16_t*)take(((size_t)MP + (size_t)NS * PAST) * 256 * 2); p.SLCb = (bf16_t*)take((size_t)MALL * 256 * 2); p.WINb = (bf16_t*)take((size_t)MALL * 256 * 2);
    p.U = (bf16_t*)take((size_t)MALL * GMD * 2); p.Vg = (bf16_t*)take((size_t)MALL * GMD * 2);
    p.GA = (bf16_t*)take((size_t)MALL * DM * 2); p.GB = (bf16_t*)take((size_t)MALL * DM * 2);
    p.GATE = (float*)take((size_t)MALL * 32 * 4);
    p.PART = (float*)take((size_t)(2048 + NS * 1024) * 4 * 256 * 4); p.PEB = (float*)take(256 * 4);
    p.KCP = (float*)take((size_t)NB * NG * 512 * 64 * 4); p.VCP = (float*)take((size_t)NB * NG * 512 * 64 * 4);
    p.KCS = (float*)take((size_t)NS * NG * 1024 * 64 * 4); p.VCS = (float*)take((size_t)NS * NG * 1024 * 64 * 4); p.KN = (float*)take(NB * NG * 128 * 4);
    p.KCb = (bf16_t*)take((size_t)NB * NG * 512 * 64 * 2); p.VCT = (bf16_t*)take((size_t)NB * NG * 64 * 512 * 2);
    p.SLCvT = (bf16_t*)take((size_t)NB * NG * 64 * SEQ * 2); p.WINvT = (bf16_t*)take((size_t)NB * NG * 64 * SEQ * 2);
    p.GWb = (bf16_t*)take(4 * 128 * 128 * 2); p.W2T = (bf16_t*)take(2 * 64 * 128 * 2);
    p.OCAT = (bf16_t*)take((size_t)MALL * DM * 2); p.T = (float*)take((size_t)MALL * DM * 4); p.Y1 = (bf16_t*)take((size_t)MALL * DM * 2);
    p.F = (float*)take((size_t)MALL * DM * 4); p.X1 = (float*)take((size_t)MALL * DM * 4); p.H2 = (bf16_t*)take((size_t)MALL * DM * 2);
    p.ACT = (bf16_t*)take((size_t)MALL * DFF * 2); p.X2 = (float*)take((size_t)MALL * DM * 4); p.X2b = (bf16_t*)take((size_t)MALL * DM * 2);
    p.Pb = (bf16_t*)take((size_t)MALL * PLE * 2);
    if (off > ws_size) { fprintf(stderr, "workspace too small: need %zu have %zu\n", off, ws_size); return; }
    (void)hipMemsetAsync(p.OCAT + (size_t)(MP + NS) * DM, 0, (size_t)(MALL - MP - NS) * DM * 2, stream);
#if MK_MULTI
    launch_all<0>(p, 256, stream);
#else
    constexpr size_t kDynLds = LDS_BYTES + 48;
    static int grid = 0;
    if (!grid) {
        int dev = 0, cus = 0, per_cu = 0;
        (void)hipGetDevice(&dev);
        (void)hipDeviceGetAttribute(&cus, hipDeviceAttributeMultiprocessorCount, dev);
        (void)hipFuncSetAttribute((const void*)k_all, hipFuncAttributeMaxDynamicSharedMemorySize, (int)kDynLds);
        (void)hipOccupancyMaxActiveBlocksPerMultiprocessor(&per_cu, (const void*)k_all, 512, kDynLds);
        grid = cus * (per_cu < 1 ? per_cu : 1);
        if (grid <= 0) { fprintf(stderr, "k_all: occupancy query says %d blocks per CU\n", per_cu); grid = 0; return; }
    }
    (void)hipMemsetAsync(p.bar, 0, XCD_BAR_WORDS * sizeof(unsigned), stream);
    k_all<<<grid, 512, kDynLds, stream>>>(p);
#endif
}
```

```cpp
#include <hip/hip_runtime.h>
#include <stdint.h>
#include <cstdio>

typedef unsigned short bf16_t;
typedef short bf16x8 __attribute__((ext_vector_type(8)));
typedef float f32x4 __attribute__((ext_vector_type(4)));
typedef float f32x2 __attribute__((ext_vector_type(2)));
typedef unsigned u32x4 __attribute__((ext_vector_type(4)));
typedef unsigned u32x2 __attribute__((ext_vector_type(2)));
#define LAS __attribute__((address_space(3)))

constexpr int DM = 1024, NB = 4, SEQ = 8192, MP = NB * SEQ, NS = 32, MALL = MP + 256, PAST = 16384, PAGE = 128, NPG = 128;
constexpr int NH = 8, NG = 2, HPG = 4, DH = 64, QD = 512, WIN = 512, GMD = 512, DFF = 2816, PLE = 256, IND = 4376, INP = 4608;
constexpr int NCP = 511, NCS = 1023;
constexpr float EPS = 1e-6f;
constexpr float LOG2E = 1.4426950408889634f, QSCALE = 0.125f * LOG2E;
constexpr long O_YP = 0, O_YS = 33554432, O_CMPP = 33587200, O_SLCP = 41975808, O_WINP = 50364416, O_CMPS = 50888704,
               O_SLCS = 50896896, O_WINS = 50905088, O_GMV = 55099392;

struct Params {
    const float *x_prompt, *x_sample, *cache_cmp, *cache_slc, *state_win; const int* page_table;
    const float *p_prompt, *p_sample, *rel_bias, *ln_mix_pre, *w_in, *pe_k, *w1_k, *w2_k, *pe_v, *w1_v, *w2_v;
    const float *gm_ln_g, *gm_ln_b, *gm_ws, *gm_bs, *w_br_nsa, *w_br_gm, *w_out, *ln_mix_post, *ln_ffn_pre;
    const float *w_gate, *w_up, *w_down, *ln_ffn_post, *w_ple, *w_ple_gate, *ln_ple_post;
    float* out;
    unsigned* bar;
    bf16_t *WinT, *WnT, *WgT, *WoT, *WguT, *WdT, *WpgT, *WpT, *W1T;
    bf16_t *H, *Qb, *CMPb, *SLCb, *WINb, *U, *Vg, *GA, *GB;
    float* GATE;
    float *PART, *PEB, *KCP, *VCP, *KCS, *VCS, *KN;
    bf16_t *KCb, *VCT, *SLCvT, *WINvT, *SLCkF, *WINkF, *GWb, *W2T;
    bf16_t* OCAT; float* T; bf16_t* Y1; float* F; float* X1; bf16_t* H2; bf16_t* ACT; float* X2; bf16_t* X2b; bf16_t* Pb;
};

__device__ __forceinline__ unsigned cvt_pk_bf16(float lo, float hi) { unsigned r; asm volatile("v_cvt_pk_bf16_f32 %0, %1, %2" : "=v"(r) : "v"(lo), "v"(hi)); return r; }
__device__ __forceinline__ bf16_t f2bf(float f) { return (bf16_t)(cvt_pk_bf16(f, 0.f) & 0xffffu); }
__device__ __forceinline__ float bf2f(bf16_t h) { return __uint_as_float(((unsigned)h) << 16); }
__device__ __forceinline__ float bflo(unsigned w) { return __uint_as_float(w << 16); }
__device__ __forceinline__ float bfhi(unsigned w) { return __uint_as_float(w & 0xffff0000u); }
__device__ __forceinline__ float ex2(float x) { return __builtin_amdgcn_exp2f(x); }
__device__ __forceinline__ float sigmoidf_(float x) { return 1.0f / (1.0f + __expf(-x)); }
__device__ __forceinline__ float siluf_(float x) { return x * sigmoidf_(x); }
__device__ __forceinline__ float geluf_(float x) {
    const float u = 0.7978845608028654f * (x + 0.044715f * x * x * x);
    const float e = __expf(2.0f * u);
    const float th = 1.0f - 2.0f / (e + 1.0f);
    return 0.5f * x * (1.0f + th);
}
__device__ __forceinline__ float wave_sum(float v) {
#pragma unroll
    for (int o = 32; o > 0; o >>= 1) v += __shfl_xor(v, o);
    return v;
}
__device__ __forceinline__ float wave_max(float v) {
#pragma unroll
    for (int o = 32; o > 0; o >>= 1) v = fmaxf(v, __shfl_xor(v, o));
    return v;
}
__device__ __forceinline__ int t5_bucket(int d) {
    if (d < 16) return d;
    if (d >= 128) return 31;
    const int b = 16 + (int)(__logf((float)d * (1.0f / 16.0f)) * (16.0f / 2.0794415416798357f));
    return b < 31 ? b : 31;
}

extern __shared__ __attribute__((aligned(16))) unsigned char smem[];
#ifndef PROBE_DUP
#define PROBE_DUP 0
#endif
#define PROBE_LDS_OFF 131072
#ifndef PROBE_SPIN
#define PROBE_SPIN 0
#endif
#ifndef PROBE_SEG
#define PROBE_SEG 5
#endif
__device__ __forceinline__ unsigned long long probe_now() { unsigned long long t; asm volatile("s_memrealtime %0\n\ts_waitcnt lgkmcnt(0)" : "=s"(t) :: "memory"); return t; }
#define PROBE_TS ((volatile LAS unsigned long long*)((LAS unsigned char*)smem + PROBE_LDS_OFF + 16))
#if PROBE_SPIN
#define PROBE_BEGIN(seg) unsigned long long pb_##seg = 0; if (PROBE_SEG == seg && threadIdx.x == 0) pb_##seg = probe_now();
#define PROBE_END(seg) if (PROBE_SEG == seg && threadIdx.x == 0) { PROBE_TS[2] = PROBE_TS[2] + (probe_now() - pb_##seg); }
#else
#define PROBE_BEGIN(seg)
#define PROBE_END(seg)
#endif

constexpr int BM = 256, BK = 64, HALF = 128, HT = HALF * BK, GEMM_LDS = 8 * HT * 2;
__device__ __forceinline__ int lds_byte(int r, int c) { const int st = (r >> 4) * 2 + (c >> 5), rr = r & 15, cc = c & 31, ob = rr * 64 + cc * 2; return st * 1024 + (ob ^ (((ob >> 9) & 1) << 5)); }
__device__ __forceinline__ void stage_rc(int b, int& R, int& C) { const int st = b / 1024, sb = b % 1024, swz = sb ^ (((sb >> 9) & 1) << 5); R = (st >> 1) * 16 + swz / 64; C = (st & 1) * 32 + (swz % 64) / 2; }

constexpr int HTB = HALF * BK * 2;
template <class F>
__device__ __forceinline__ void for_each_frag(const f32x4 (&acc)[2][2][4][2], int brow, int bcol, int wr, int wc, int fr, int fq, F&& f) {
#pragma unroll
    for (int ai = 0; ai < 2; ++ai)
#pragma unroll
        for (int m = 0; m < 4; ++m)
#pragma unroll
            for (int bj = 0; bj < 2; ++bj)
#pragma unroll
                for (int n = 0; n < 2; ++n)
                    f(brow + ai * HALF + wr * 64 + m * 16 + fr, bcol + bj * HALF + wc * 32 + n * 16 + fq * 4, acc[ai][bj][m][n]);
}

struct ZNone { __device__ __forceinline__ size_t a(int) const { return 0; } __device__ __forceinline__ size_t b(int) const { return 0; } };
template <class Epi, class ZMap = ZNone>
__device__ __forceinline__ void gemm_phase(const bf16_t* A, int lda, const bf16_t* Bt, int K, int nM, int nN, const Epi& E, int nZ = 1, ZMap zm = ZMap(), int kstepA_el = BK) {
    LAS unsigned char* lds = (LAS unsigned char*)smem;
    const int tid = threadIdx.x, wid = __builtin_amdgcn_readfirstlane(tid >> 6), lane = tid & 63, wr = wid >> 2, wc = wid & 3, fr = lane & 15, fq = lane >> 4;
    const int nt = K / BK, nmn = nM * nN, nu = nmn * nZ, G = gridDim.x;
    int u = blockIdx.x;
    if (u >= nu) return;
    unsigned voffA[2], voffB[2];
#pragma unroll
    for (int i = 0; i < 2; ++i) { int R, C; stage_rc(tid * 16 + i * 8192, R, C); voffA[i] = (unsigned)(R * lda + C) * 2u; voffB[i] = (unsigned)(R * K + C) * 2u; }
    const size_t kstep = (size_t)(BK * 2), kstepA = (size_t)kstepA_el * 2;
    const size_t hstepA = (size_t)HALF * lda * 2, hstepB = (size_t)HALF * K * 2, tstepA = 2 * hstepA, tstepB = 2 * hstepB;
    const unsigned ldsw = (unsigned)wid * 1024u;
    const int aoff = lds_byte(wr * 64 + fr, fq * 8), boff = lds_byte(wc * 32 + fr, fq * 8);
#define PG8_SA(b, h) (((b) * 2 + (h)) * HTB)
#define PG8_SB(b, h) ((4 + (b) * 2 + (h)) * HTB)
#define PG8_STAGE(bufoff, gbase, voff) do { _Pragma("unroll") for (int _i = 0; _i < 2; ++_i) \
        __builtin_amdgcn_global_load_lds((const unsigned*)((const char*)(gbase) + (voff)[_i]), (LAS unsigned*)(lds + (bufoff) + ldsw + _i * 8192), 16, 0, 0); } while (0)
#define PG8_LDA(dst, b, h) do { _Pragma("unroll") for (int m = 0; m < 4; ++m) _Pragma("unroll") for (int k = 0; k < 2; ++k) dst[m][k] = *(const LAS bf16x8*)(lds + PG8_SA(b, h) + aoff + m * 2048 + k * 1024); } while (0)
#define PG8_LDB(dst, b, h) do { _Pragma("unroll") for (int n = 0; n < 2; ++n) _Pragma("unroll") for (int k = 0; k < 2; ++k) dst[n][k] = *(const LAS bf16x8*)(lds + PG8_SB(b, h) + boff + n * 2048 + k * 1024); } while (0)
#define PG8_MMA(ai, bj, At, Bt_) do { __builtin_amdgcn_s_setprio(1); _Pragma("unroll") for (int m = 0; m < 4; ++m) _Pragma("unroll") for (int n = 0; n < 2; ++n) _Pragma("unroll") for (int k = 0; k < 2; ++k) \
        acc[ai][bj][m][n] = __builtin_amdgcn_mfma_f32_16x16x32_bf16(Bt_[n][k], At[m][k], acc[ai][bj][m][n], 0, 0, 0); __builtin_amdgcn_s_setprio(0); } while (0)
#define PG8_WAIT_V(n) asm volatile("s_waitcnt vmcnt(" #n ")" ::: "memory")
#define PG8_WAIT_L(n) asm volatile("s_waitcnt lgkmcnt(" #n ")" ::: "memory")
#define PG8_BAR __builtin_amdgcn_s_barrier()
#define PG8_SCHED __builtin_amdgcn_sched_barrier(0)
    f32x4 acc[2][2][4][2];
#pragma unroll
    for (int a = 0; a < 2; ++a)
#pragma unroll
        for (int b = 0; b < 2; ++b)
#pragma unroll
            for (int m = 0; m < 4; ++m)
#pragma unroll
                for (int n = 0; n < 2; ++n) acc[a][b][m][n] = (f32x4){0.f, 0.f, 0.f, 0.f};
    bf16x8 At[4][2], B0[2][2], B1[2][2];
    auto unit_of = [&](int uu, int& z_, int& pm_, int& pn_) {
        if (nZ == 1) {
            int wg = uu; { const int q = nu / 8, r = nu % 8, xcd = wg % 8, off = wg / 8; wg = (xcd < r ? xcd * (q + 1) : r * (q + 1) + (xcd - r) * q) + off; }
            const int nig = 8 * nN, gid = wg / nig, fm = gid * 8, gsz = (nM - fm) < 8 ? (nM - fm) : 8;
            z_ = 0; pm_ = fm + ((wg % nig) % gsz); pn_ = (wg % nig) / gsz;
        } else { z_ = uu / nmn; pm_ = (uu - z_ * nmn) / nN; pn_ = (uu - z_ * nmn) - pm_ * nN; }
    };
    int z, pm, pn; unit_of(u, z, pm, pn);
    const char* cA = (const char*)(A + zm.a(z)) + (size_t)pm * tstepA; const char* cB = (const char*)(Bt + zm.b(z)) + (size_t)pn * tstepB;
    PG8_STAGE(PG8_SB(0, 0), cB, voffB); PG8_STAGE(PG8_SA(0, 0), cA, voffA); PG8_STAGE(PG8_SB(0, 1), cB + hstepB, voffB); PG8_STAGE(PG8_SA(0, 1), cA + hstepA, voffA);
    if (wr == 1) PG8_BAR;
    PG8_WAIT_V(4); PG8_BAR;
    PG8_STAGE(PG8_SB(1, 0), cB + kstep, voffB); PG8_STAGE(PG8_SA(1, 0), cA + kstepA, voffA); PG8_STAGE(PG8_SB(1, 1), cB + hstepB + kstep, voffB);
    PG8_WAIT_V(6); PG8_BAR;
    for (;;) {
        const int un = u + G; const bool has_next = un < nu;
        int nz = z, npm = pm, npn = pn; if (has_next) unit_of(un, nz, npm, npn);
        const char* nA = (const char*)(A + zm.a(nz)) + (size_t)npm * tstepA; const char* nB = (const char*)(Bt + zm.b(nz)) + (size_t)npn * tstepB;
        for (int t = 0; t < nt; t += 2) {
            const bool last = (t == nt - 2);
            const char* a1 = cA + (size_t)(t + 1) * kstepA;
            const char* a2 = last ? nA : cA + (size_t)(t + 2) * kstepA; const char* b2 = last ? nB : cB + (size_t)(t + 2) * kstep;
            const char* a3 = a2 + kstepA; const char* b3 = b2 + kstep;
            PG8_LDB(B0, 0, 0); PG8_SCHED; PG8_LDA(At, 0, 0); PG8_STAGE(PG8_SA(1, 1), a1 + hstepA, voffA);
            PG8_WAIT_L(8); PG8_BAR; PG8_WAIT_L(0); PG8_MMA(0, 0, At, B0); PG8_BAR; PG8_SCHED;
            PG8_LDB(B1, 0, 1); PG8_STAGE(PG8_SB(0, 0), b2, voffB);
            PG8_BAR; PG8_WAIT_L(0); PG8_MMA(0, 1, At, B1); PG8_BAR;
            PG8_LDA(At, 0, 1); PG8_STAGE(PG8_SA(0, 0), a2, voffA);
            PG8_BAR; PG8_WAIT_L(0); PG8_MMA(1, 0, At, B0); PG8_BAR; PG8_SCHED;
            PG8_STAGE(PG8_SB(0, 1), b2 + hstepB, voffB);
            PG8_WAIT_V(6); PG8_BAR; PG8_MMA(1, 1, At, B1); PG8_BAR;
            PG8_LDB(B0, 1, 0); PG8_SCHED; PG8_LDA(At, 1, 0); PG8_STAGE(PG8_SA(0, 1), a2 + hstepA, voffA);
            PG8_WAIT_L(8); PG8_BAR; PG8_WAIT_L(0); PG8_MMA(0, 0, At, B0); PG8_BAR; PG8_SCHED;
            PG8_LDB(B1, 1, 1); PG8_STAGE(PG8_SB(1, 0), b3, voffB);
            PG8_BAR; PG8_WAIT_L(0); PG8_MMA(0, 1, At, B1); PG8_BAR;
            PG8_LDA(At, 1, 1); PG8_STAGE(PG8_SA(1, 0), a3, voffA);
            PG8_BAR; PG8_WAIT_L(0); PG8_MMA(1, 0, At, B0); PG8_BAR; PG8_SCHED;
            PG8_STAGE(PG8_SB(1, 1), b3 + hstepB, voffB);
            PG8_WAIT_V(6); PG8_BAR; PG8_MMA(1, 1, At, B1); PG8_BAR;
        }
        E(acc, pm * BM, pn * BM + (z << 20), wr, wc, fr, fq);
        if (!has_next) break;
#pragma unroll
        for (int a = 0; a < 2; ++a)
#pragma unroll
            for (int b = 0; b < 2; ++b)
#pragma unroll
                for (int m = 0; m < 4; ++m)
#pragma unroll
                    for (int n = 0; n < 2; ++n) acc[a][b][m][n] = (f32x4){0.f, 0.f, 0.f, 0.f};
        u = un; z = nz; pm = npm; pn = npn; cA = nA; cB = nB;
    }
    PG8_WAIT_V(0);
    if (wr == 0) PG8_BAR;
    PG8_BAR;
#undef PG8_SA
#undef PG8_SB
#undef PG8_STAGE
#undef PG8_LDA
#undef PG8_LDB
#undef PG8_MMA
#undef PG8_WAIT_V
#undef PG8_WAIT_L
#undef PG8_BAR
#undef PG8_SCHED
}

__device__ __forceinline__ f32x4 mfma16(bf16x8 a, bf16x8 b, f32x4 c) { return __builtin_amdgcn_mfma_f32_16x16x32_bf16(a, b, c, 0, 0, 0); }
__device__ __forceinline__ bf16x8 pack_p(const f32x4& a, const f32x4& b) {
    u32x4 w; w.x = cvt_pk_bf16(a[0], a[1]); w.y = cvt_pk_bf16(a[2], a[3]); w.z = cvt_pk_bf16(b[0], b[1]); w.w = cvt_pk_bf16(b[2], b[3]);
    return __builtin_bit_cast(bf16x8, w);
}
__device__ __forceinline__ size_t kfrag_off(int key, int d) { return ((size_t)((key >> 4) * 2 + (d >> 5)) * 64 + ((d >> 3) & 3) * 16 + (key & 15)) * 8 + (d & 7); }
__device__ __forceinline__ size_t vfrag_off(int key, int d) {
    return ((size_t)((key >> 5) * 4 + (d >> 4)) * 64 + ((key >> 2) & 3) * 16 + (d & 15)) * 8 + ((key >> 4) & 1) * 4 + (key & 3);
}
__device__ __forceinline__ void st_bf16x4(bf16_t* p, f32x4 v) { u32x2 w; w.x = cvt_pk_bf16(v[0], v[1]); w.y = cvt_pk_bf16(v[2], v[3]); *(u32x2*)p = w; }

struct EpiIn {
    const Params& p;
    __device__ __forceinline__ void apply(int row, int col, f32x4 v) const {
        const Params& P = p; const int pn = col >> 8, c = col & 255;
        if (pn < 2) st_bf16x4(P.Qb + (size_t)row * QD + col, v * QSCALE);
        else if (pn < 5) {
            if (pn != 2) st_bf16x4((pn == 3 ? P.SLCb : P.WINb) + (size_t)row * 256 + c, v);
            if (pn < 4) *(f32x4*)(P.out + (pn == 2 ? O_CMPS : O_SLCS) + (size_t)(row - MP) * 256 + c) = v;
            else *(f32x4*)(P.out + O_WINS + ((size_t)(row - MP) * WIN + (WIN - 1)) * 256 + c) = v;
        } else if (pn < 9) {
            f32x4 g; g[0] = geluf_(v[0]); g[1] = geluf_(v[1]); g[2] = geluf_(v[2]); g[3] = geluf_(v[3]);
            st_bf16x4((pn < 7 ? P.U : P.Vg) + (size_t)row * GMD + (col - (pn < 7 ? 1280 : 1792)), g);
        } else if (pn < 17) {
            f32x4 g; g[0] = sigmoidf_(v[0]); g[1] = sigmoidf_(v[1]); g[2] = sigmoidf_(v[2]); g[3] = sigmoidf_(v[3]);
            st_bf16x4((pn < 13 ? P.GA : P.GB) + (size_t)row * DM + (col - (pn < 13 ? 2304 : 3328)), g);
        } else if (c < 24) { f32x4 g; g[0] = sigmoidf_(v[0]); g[1] = sigmoidf_(v[1]); g[2] = sigmoidf_(v[2]); g[3] = sigmoidf_(v[3]); *(f32x4*)(P.GATE + (size_t)row * 32 + c) = g; }
    }
    __device__ __forceinline__ void operator()(const f32x4 (&acc)[2][2][4][2], int brow, int bcol, int wr, int wc, int fr, int fq) const {
        const int pn = bcol >> 8;
        const Params& P = p;
        if (pn < 2) {
            for_each_frag(acc, brow, bcol, wr, wc, fr, fq, [&](int row, int col, f32x4 v) { st_bf16x4(P.Qb + (size_t)row * QD + col, v * QSCALE); });
        } else if (pn < 5) {
            bf16_t* cp = pn == 2 ? P.CMPb : pn == 3 ? P.SLCb : P.WINb;
            for_each_frag(acc, brow, bcol, wr, wc, fr, fq, [&](int row, int col, f32x4 v) {
                const int c = col & 255;
                if (pn == 2) st_bf16x4(cp + (size_t)row * 256 + c, v);
                if (pn >= 3 && c < 128 && row < MP) {
                    st_bf16x4((pn == 3 ? P.SLCkF : P.WINkF) + ((size_t)(row >> 13) * NG + (c >> 6)) * SEQ * 64 + kfrag_off(row & (SEQ - 1), c & 63), v);
                }
                if (pn >= 3 && c >= 128 && row < MP) {
                    const int t = row & (SEQ - 1), dc = c - 128;
                    bf16_t* vt = (pn == 3 ? P.SLCvT : P.WINvT) + ((size_t)(row >> 13) * NG + (dc >> 6)) * SEQ * 64 + vfrag_off(t, dc & 63);
                    vt[0] = f2bf(v[0]); vt[8] = f2bf(v[1]); vt[16] = f2bf(v[2]); vt[24] = f2bf(v[3]);
                }
                if (pn < 4) {
                    if (row < MP) *(f32x4*)(P.out + (pn == 2 ? O_CMPP : O_SLCP) + (size_t)row * 256 + c) = v;
                    else if (row < MP + NS) *(f32x4*)(P.out + (pn == 2 ? O_CMPS : O_SLCS) + (size_t)(row - MP) * 256 + c) = v;
                } else {
                    if (row < MP) { const int t = row & (SEQ - 1), b = row >> 13; if (t >= SEQ - WIN) *(f32x4*)(P.out + O_WINP + ((size_t)b * WIN + (t - (SEQ - WIN))) * 256 + c) = v; }
                    else if (row < MP + NS) *(f32x4*)(P.out + O_WINS + ((size_t)(row - MP) * WIN + (WIN - 1)) * 256 + c) = v;
                }
            });
        } else if (pn < 9) {
            bf16_t* dst = pn < 7 ? P.U : P.Vg; const int c0 = pn < 7 ? 1280 : 1792;
            for_each_frag(acc, brow, bcol, wr, wc, fr, fq, [&](int row, int col, f32x4 v) {
                f32x4 g; g[0] = geluf_(v[0]); g[1] = geluf_(v[1]); g[2] = geluf_(v[2]); g[3] = geluf_(v[3]);
                st_bf16x4(dst + (size_t)row * GMD + (col - c0), g); });
        } else if (pn < 17) {
            bf16_t* dst = pn < 13 ? P.GA : P.GB; const int c0 = pn < 13 ? 2304 : 3328;
            for_each_frag(acc, brow, bcol, wr, wc, fr, fq, [&](int row, int col, f32x4 v) {
                f32x4 g; g[0] = sigmoidf_(v[0]); g[1] = sigmoidf_(v[1]); g[2] = sigmoidf_(v[2]); g[3] = sigmoidf_(v[3]);
                st_bf16x4(dst + (size_t)row * DM + (col - c0), g); });
        } else {
            for_each_frag(acc, brow, bcol, wr, wc, fr, fq, [&](int row, int col, f32x4 v) {
                const int c = col & 255;
                if (c < 24) { f32x4 g; g[0] = sigmoidf_(v[0]); g[1] = sigmoidf_(v[1]); g[2] = sigmoidf_(v[2]); g[3] = sigmoidf_(v[3]); *(f32x4*)(P.GATE + (size_t)row * 32 + c) = g; } });
        }
    }
};
struct EpiBrA {
    const bf16_t* GA; float* T;
    __device__ __forceinline__ void apply(int row, int col, f32x4 v) const {
        const u32x2 g = *(const u32x2*)(GA + (size_t)row * DM + col);
        f32x4 o; o[0] = v[0] * bflo(g.x); o[1] = v[1] * bfhi(g.x); o[2] = v[2] * bflo(g.y); o[3] = v[3] * bfhi(g.y);
        *(f32x4*)(T + (size_t)row * DM + col) = o; }
    __device__ __forceinline__ void operator()(const f32x4 (&acc)[2][2][4][2], int brow, int bcol, int wr, int wc, int fr, int fq) const {
        for_each_frag(acc, brow, bcol, wr, wc, fr, fq, [&](int row, int col, f32x4 v) {
            const u32x2 g = *(const u32x2*)(GA + (size_t)row * DM + col);
            f32x4 o; o[0] = v[0] * bflo(g.x); o[1] = v[1] * bfhi(g.x); o[2] = v[2] * bflo(g.y); o[3] = v[3] * bfhi(g.y);
            *(f32x4*)(T + (size_t)row * DM + col) = o; });
    }
};
struct EpiBrB {
    const bf16_t* GB; const float* T; bf16_t* Y1;
    __device__ __forceinline__ void apply(int row, int col, f32x4 v) const {
        const u32x2 g = *(const u32x2*)(GB + (size_t)row * DM + col);
        const f32x4 t = *(const f32x4*)(T + (size_t)row * DM + col);
        f32x4 o; o[0] = t[0] + v[0] * bflo(g.x); o[1] = t[1] + v[1] * bfhi(g.x); o[2] = t[2] + v[2] * bflo(g.y); o[3] = t[3] + v[3] * bfhi(g.y);
        st_bf16x4(Y1 + (size_t)row * DM + col, o); }
    __device__ __forceinline__ void operator()(const f32x4 (&acc)[2][2][4][2], int brow, int bcol, int wr, int wc, int fr, int fq) const {
        for_each_frag(acc, brow, bcol, wr, wc, fr, fq, [&](int row, int col, f32x4 v) {
            const u32x2 g = *(const u32x2*)(GB + (size_t)row * DM + col);
            const f32x4 t = *(const f32x4*)(T + (size_t)row * DM + col);
            f32x4 o; o[0] = t[0] + v[0] * bflo(g.x); o[1] = t[1] + v[1] * bfhi(g.x); o[2] = t[2] + v[2] * bflo(g.y); o[3] = t[3] + v[3] * bfhi(g.y);
            st_bf16x4(Y1 + (size_t)row * DM + col, o); });
    }
};
struct EpiF32 {
    float* F; int ld;
    __device__ __forceinline__ void apply(int row, int col, f32x4 v) const { *(f32x4*)(F + (size_t)row * ld + col) = v; }
    __device__ __forceinline__ void operator()(const f32x4 (&acc)[2][2][4][2], int brow, int bcol, int wr, int wc, int fr, int fq) const {
        for_each_frag(acc, brow, bcol, wr, wc, fr, fq, [&](int row, int col, f32x4 v) { *(f32x4*)(F + (size_t)row * ld + col) = v; });
    }
};
struct EpiPart {
    float* PART;
    __device__ __forceinline__ void operator()(const f32x4 (&acc)[2][2][4][2], int brow, int bcol, int wr, int wc, int fr, int fq) const {
        const int z = bcol >> 20;
        for_each_frag(acc, brow, 0, wr, wc, fr, fq, [&](int row, int col, f32x4 v) { *(f32x4*)(PART + ((size_t)row * 4 + z) * 256 + col) = v; });
    }
};
struct ZCmp { __device__ __forceinline__ size_t a(int z) const { return (size_t)z * 64; } __device__ __forceinline__ size_t b(int z) const { return (size_t)(z >> 1) * 256 * 1024; } };
struct EpiSwiGLU {
    bf16_t* ACT;
    __device__ __forceinline__ void apply(int row, int col, f32x4 v) const { *(unsigned*)(ACT + (size_t)row * DFF + (col >> 1)) = cvt_pk_bf16(siluf_(v[0]) * v[1], siluf_(v[2]) * v[3]); }
    __device__ __forceinline__ void operator()(const f32x4 (&acc)[2][2][4][2], int brow, int bcol, int wr, int wc, int fr, int fq) const {
        for_each_frag(acc, brow, bcol, wr, wc, fr, fq, [&](int row, int col, f32x4 v) {
            *(unsigned*)(ACT + (size_t)row * DFF + (col >> 1)) = cvt_pk_bf16(siluf_(v[0]) * v[1], siluf_(v[2]) * v[3]); });
    }
};
struct EpiPleGate {
    const float* E; float* F;
    __device__ __forceinline__ void apply(int row, int col, f32x4 v) const {
        const f32x4 e = *(const f32x4*)(E + (size_t)row * DM + col);
        f32x4 o; o[0] = sigmoidf_(v[0]) * e[0]; o[1] = sigmoidf_(v[1]) * e[1]; o[2] = sigmoidf_(v[2]) * e[2]; o[3] = sigmoidf_(v[3]) * e[3];
        *(f32x4*)(F + (size_t)row * DM + col) = o; }
    __device__ __forceinline__ void operator()(const f32x4 (&acc)[2][2][4][2], int brow, int bcol, int wr, int wc, int fr, int fq) const {
        for_each_frag(acc, brow, bcol, wr, wc, fr, fq, [&](int row, int col, f32x4 v) {
            const f32x4 e = *(const f32x4*)(E + (size_t)row * DM + col);
            f32x4 o; o[0] = sigmoidf_(v[0]) * e[0]; o[1] = sigmoidf_(v[1]) * e[1]; o[2] = sigmoidf_(v[2]) * e[2]; o[3] = sigmoidf_(v[3]) * e[3];
            *(f32x4*)(F + (size_t)row * DM + col) = o; });
    }
};

template <class Epi>
__device__ __forceinline__ void gemm_skinny(const bf16_t* A  , int lda, const bf16_t* Bt, int K, int N, const Epi& E) {
    const int tid = threadIdx.x, wid = __builtin_amdgcn_readfirstlane(tid >> 6), lane = tid & 63, c = lane & 15, G = lane >> 4;
    LAS f32x4* red = (LAS f32x4*)smem;
    const int nsteps = K / 32;
#pragma unroll 1
    for (int ct = blockIdx.x; ct < N / 16; ct += gridDim.x) {
        f32x4 acc0 = {0.f, 0.f, 0.f, 0.f}, acc1 = {0.f, 0.f, 0.f, 0.f};
        const bf16_t* bp = Bt + (size_t)(ct * 16 + c) * K + G * 8;
        const bf16_t* a0 = A + (size_t)c * lda + G * 8; const bf16_t* a1 = A + (size_t)(16 + c) * lda + G * 8;
#pragma unroll 4
        for (int kk = wid; kk < nsteps; kk += 8) {
            const bf16x8 bf = *(const bf16x8*)(bp + kk * 32), x0 = *(const bf16x8*)(a0 + kk * 32), x1 = *(const bf16x8*)(a1 + kk * 32);
            acc0 = mfma16(bf, x0, acc0); acc1 = mfma16(bf, x1, acc1);
        }
        __syncthreads();
        red[(wid * 2 + 0) * 64 + lane] = acc0; red[(wid * 2 + 1) * 64 + lane] = acc1;
        __syncthreads();
        if (tid < 128) {
            const int rt = tid >> 6;
            f32x4 v = red[rt * 64 + lane];
#pragma unroll
            for (int w = 1; w < 8; ++w) v = v + red[(w * 2 + rt) * 64 + lane];
            E.apply(MP + rt * 16 + c, ct * 16 + 4 * G, v);
        }
    }
    __syncthreads();
}

template <class Map>
__device__ __forceinline__ void transpose_tile(const float* W, int K, int N, bf16_t* Wt, int ldk, int kt, int ntile, Map map) {
    LAS float* tile = (LAS float*)smem;
    const int t = threadIdx.x;
    __syncthreads();
#pragma unroll
    for (int i = 0; i < 2; ++i) {
        const int k = (t >> 4) + 32 * i, n = (t & 15) * 4, gn = ntile * 64 + n;
        f32x4 v = (f32x4){0.f, 0.f, 0.f, 0.f};
        if (gn < N) v = *(const f32x4*)(W + (size_t)(kt * 64 + k) * N + gn);
        tile[k * 65 + n] = v[0]; tile[k * 65 + n + 1] = v[1]; tile[k * 65 + n + 2] = v[2]; tile[k * 65 + n + 3] = v[3];
    }
    __syncthreads();
    const int n = t >> 3, kc = (t & 7) * 8, gn = ntile * 64 + n;
    if (gn < N) {
        u32x4 w;
        w.x = cvt_pk_bf16(tile[(kc + 0) * 65 + n], tile[(kc + 1) * 65 + n]); w.y = cvt_pk_bf16(tile[(kc + 2) * 65 + n], tile[(kc + 3) * 65 + n]);
        w.z = cvt_pk_bf16(tile[(kc + 4) * 65 + n], tile[(kc + 5) * 65 + n]); w.w = cvt_pk_bf16(tile[(kc + 6) * 65 + n], tile[(kc + 7) * 65 + n]);
        *(u32x4*)(Wt + (size_t)map(gn) * ldk + kt * 64 + kc) = w;
    }
}
template <class Map>
__device__ __forceinline__ void transpose_all(const float* W, int K, int N, bf16_t* Wt, int ldk, Map map, int& base) {
    const int nkt = K / 64, nnt = (N + 63) / 64, ntl = nkt * nnt;
    for (int it = blockIdx.x; it < base + ntl; it += gridDim.x) {
        if (it < base) continue;
        const int l = it - base;
        transpose_tile(W, K, N, Wt, ldk, l / nnt, l % nnt, map);
    }
    base += ntl;
}
__device__ __forceinline__ int map_win(int n) {
    if (n < 1280) return n;
    if (n < 1304) return 4352 + (n - 1280);
    if (n < 2328) return 1280 + (n - 1304);
    return 2304 + (n - 2328);
}

__device__ __forceinline__ float row_rstd(const f32x4 (&v)[4]) {
    float s = 0.f;
#pragma unroll
    for (int k = 0; k < 4; ++k) s += v[k][0] * v[k][0] + v[k][1] * v[k][1] + v[k][2] * v[k][2] + v[k][3] * v[k][3];
    s = wave_sum(s);
    return rsqrtf(s * (1.0f / DM) + EPS);
}
__device__ __forceinline__ const float* xrow_ptr(const Params& p, int row) {
    return row < MP ? p.x_prompt + (size_t)row * DM : p.x_sample + (size_t)(row - MP) * DM;
}

__device__ void phase_prologue(const Params& p) {
    const int wid = threadIdx.x >> 6, lane = threadIdx.x & 63;
    const int gw = blockIdx.x * 8 + wid, nw = gridDim.x * 8;
    int base = 0;
    transpose_all(p.w_in, DM, IND, p.WinT, DM, [](int n) { return map_win(n); }, base);
    transpose_all(p.w_br_nsa, QD, DM, p.WnT, QD, [](int n) { return n; }, base);
    transpose_all(p.w_br_gm, GMD, DM, p.WgT, GMD, [](int n) { return n; }, base);
    transpose_all(p.w_out, DM, DM, p.WoT, DM, [](int n) { return n; }, base);
    transpose_all(p.w_gate, DM, DFF, p.WguT, DM, [](int n) { return 2 * n; }, base);
    transpose_all(p.w_up, DM, DFF, p.WguT, DM, [](int n) { return 2 * n + 1; }, base);
    transpose_all(p.w_down, DFF, DM, p.WdT, DFF, [](int n) { return n; }, base);
    transpose_all(p.w_ple_gate, DM, DM, p.WpgT, DM, [](int n) { return n; }, base);
    transpose_all(p.w_ple, PLE, DM, p.WpT, PLE, [](int n) { return n; }, base);
    for (int kv = 0; kv < 2; ++kv) for (int j = 0; j < 2; ++j)
        transpose_all((kv ? p.w1_v : p.w1_k) + (size_t)j * 1024 * 128, 1024, 128, p.W1T + ((size_t)kv * 256 + j * 128) * 1024, 1024, [](int n) { return n; }, base);
    __syncthreads();
    for (int i = blockIdx.x * 512 + threadIdx.x; i < (INP - IND) * DM / 8; i += gridDim.x * 512) ((u32x4*)(p.WinT + (size_t)IND * DM))[i] = (u32x4){0u, 0u, 0u, 0u};
    for (int row = gw; row < MALL; row += nw) {
        u32x2* hd = (u32x2*)(p.H + (size_t)row * DM);
        if (row < MP + NS) {
            const float* xr = xrow_ptr(p, row);
            f32x4 v[4];
#pragma unroll
            for (int k = 0; k < 4; ++k) v[k] = *(const f32x4*)(xr + lane * 4 + k * 256);
            const float r = row_rstd(v);
#pragma unroll
            for (int k = 0; k < 4; ++k) { const f32x4 g = *(const f32x4*)(p.ln_mix_pre + lane * 4 + k * 256); const f32x4 o = v[k] * r * g; u32x2 w; w.x = cvt_pk_bf16(o[0], o[1]); w.y = cvt_pk_bf16(o[2], o[3]); hd[lane + k * 64] = w; }
            const float* pr = row < MP ? p.p_prompt + (size_t)row * PLE : p.p_sample + (size_t)(row - MP) * PLE;
            const f32x4 pv = *(const f32x4*)(pr + lane * 4);
            u32x2 w; w.x = cvt_pk_bf16(pv[0], pv[1]); w.y = cvt_pk_bf16(pv[2], pv[3]);
            ((u32x2*)(p.Pb + (size_t)row * PLE))[lane] = w;
        } else {
#pragma unroll
            for (int k = 0; k < 4; ++k) hd[lane + k * 64] = (u32x2){0u, 0u};
            ((u32x2*)(p.Pb + (size_t)row * PLE))[lane] = (u32x2){0u, 0u};
        }
    }
#pragma unroll 1
    for (int r8 = gw; r8 < NS * PAST / 8; r8 += nw) {
        const int r = r8 * 8, b = r >> 14, pos = r & (PAST - 1), l5 = lane & 31, hrow = lane >> 5;
        const float* s = p.cache_cmp + ((size_t)p.page_table[b * NPG + (pos >> 7)] * PAGE + (pos & 127) + hrow) * 256 + l5 * 8;
        f32x4 a[4], cc[4];
#pragma unroll
        for (int k = 0; k < 4; ++k) { a[k] = *(const f32x4*)(s + (size_t)k * 512); cc[k] = *(const f32x4*)(s + (size_t)k * 512 + 4); }
#pragma unroll
        for (int k = 0; k < 4; ++k) {
            u32x4 w; w.x = cvt_pk_bf16(a[k][0], a[k][1]); w.y = cvt_pk_bf16(a[k][2], a[k][3]); w.z = cvt_pk_bf16(cc[k][0], cc[k][1]); w.w = cvt_pk_bf16(cc[k][2], cc[k][3]);
            *(u32x4*)(p.CMPb + ((size_t)MP + r + 2 * k + hrow) * 256 + l5 * 8) = w;
        }
    }
    for (int i = blockIdx.x * 512 + threadIdx.x; i < 4 * 128 * 128; i += gridDim.x * 512) { const int t = (i >> 7) & 127, s = i & 127; p.GWb[i] = f2bf(s <= t ? p.gm_ws[i] : 0.f); }
    for (int i = blockIdx.x * 512 + threadIdx.x; i < 2 * 64 * 128; i += gridDim.x * 512) { const int kv = i >> 13, d = (i >> 7) & 63, h = i & 127; p.W2T[i] = f2bf((kv ? p.w2_v : p.w2_k)[h * 64 + d]); }
    if (gw < 4) {
        const int kv = gw >> 1, h = (gw & 1) * 64 + lane;
        const float* pe = kv ? p.pe_v : p.pe_k; const float* w1 = kv ? p.w1_v : p.w1_k;
        float s = 0.f;
        for (int k = 0; k < 2048; ++k) s += pe[k] * w1[(size_t)k * 128 + h];
        p.PEB[kv * 128 + h] = s;
    }
    for (int i = blockIdx.x * 512 + threadIdx.x; i < NS * (WIN - 1) * 64; i += gridDim.x * 512) {
        const int b = i / ((WIN - 1) * 64), r = i % ((WIN - 1) * 64);
        ((f32x4*)(p.out + O_WINS + (size_t)b * WIN * 256))[r] = ((const f32x4*)(p.state_win + (size_t)b * WIN * 256 + 256))[r];
    }
}

__device__ void phase_cmp_final(const Params& p) {
    const int wid = threadIdx.x >> 6, lane = threadIdx.x & 63;
    {
        const int c = lane & 15, G = lane >> 4;
        const int ngrp_p = NB * 4 * 32, ngrp_s = NS * 4 * 64;
#pragma unroll 1
        for (int it = blockIdx.x * 8 + wid; it < ngrp_p + ngrp_s; it += gridDim.x * 8) {
            const bool smp = it >= ngrp_p; const int l = smp ? it - ngrp_p : it;
            const int nch = smp ? 64 : 32, nc = smp ? NCS : NCP;
            const int ch = l % nch, z = (l / nch) & 3, seq = l / (nch * 4), kv = z >> 1, g = z & 1, n0 = ch * 16;
            const size_t r0 = smp ? (size_t)2048 + (size_t)seq * 1024 : (size_t)seq * 512;
            const int nr = n0 + c < nc ? n0 + c : nc - 1;
            const float* p0 = p.PART + ((r0 + nr) * 4 + z) * 256;
            const float* p1 = p.PART + ((r0 + nr + 1) * 4 + z) * 256 + 128;
            const float* pb = p.PEB + kv * 128;
            f32x4 acc[4] = {{0.f, 0.f, 0.f, 0.f}, {0.f, 0.f, 0.f, 0.f}, {0.f, 0.f, 0.f, 0.f}, {0.f, 0.f, 0.f, 0.f}};
#pragma unroll
            for (int ks = 0; ks < 4; ++ks) {
                const int h0 = 32 * ks + 8 * G;
                const f32x4 a0 = *(const f32x4*)(p0 + h0), a1 = *(const f32x4*)(p0 + h0 + 4), b0 = *(const f32x4*)(p1 + h0), b1 = *(const f32x4*)(p1 + h0 + 4);
                const f32x4 e0 = *(const f32x4*)(pb + h0), e1 = *(const f32x4*)(pb + h0 + 4);
                f32x4 x0 = a0 + b0 + e0, x1 = a1 + b1 + e1;
#pragma unroll
                for (int i = 0; i < 4; ++i) { x0[i] = siluf_(x0[i]); x1[i] = siluf_(x1[i]); }
                const bf16x8 A = pack_p(x0, x1);
#pragma unroll
                for (int nt = 0; nt < 4; ++nt) {
                    const bf16x8 B = *(const bf16x8*)(p.W2T + ((size_t)kv * 64 + nt * 16 + c) * 128 + h0);
                    acc[nt] = mfma16(A, B, acc[nt]);
                }
            }
#pragma unroll
            for (int nt = 0; nt < 4; ++nt) {
                const int d = nt * 16 + c;
#pragma unroll
                for (int i = 0; i < 4; ++i) {
                    const int n = n0 + 4 * G + i;
                    if (n < nc) {
                        if (smp) ((kv ? p.VCS : p.KCS) + (((size_t)seq * NG + g) * 1024 + n) * 64)[d] = acc[nt][i];
                        else if (kv == 0) p.KCb[((size_t)seq * NG + g) * 512 * 64 + kfrag_off(n, d)] = f2bf(acc[nt][i]);
                    }
                }
                if (!smp && kv == 1) {
                    f32x4 v = acc[nt];
#pragma unroll
                    for (int i = 0; i < 4; ++i) if (n0 + 4 * G + i >= nc) v[i] = 0.f;
                    st_bf16x4(p.VCT + ((size_t)seq * NG + g) * 512 * 64 + vfrag_off(n0 + 4 * G, d), v);
                }
            }
        }
    }
}

template <bool SAMPLE>
__device__ __forceinline__ void kv_row_ptr(const Params& p, int branch  , int b, int pos, int kv, int g, const bf16_t*& pb, const float*& pf) {
    const int off = kv * 128 + g * 64;
    if (!SAMPLE) { pf = nullptr; pb = (branch == 1 ? p.SLCb : p.WINb) + ((size_t)b * SEQ + pos) * 256 + off; }
    else if (pos >= PAST) { pf = nullptr; pb = (branch == 1 ? p.SLCb : p.WINb) + ((size_t)MP + b) * 256 + off; }
    else if (branch == 1) { pb = nullptr; pf = p.cache_slc + ((size_t)p.page_table[b * NPG + (pos >> 7)] * PAGE + (pos & 127)) * 256 + off; }
    else { pb = nullptr; pf = p.state_win + ((size_t)b * WIN + (pos - (PAST - WIN))) * 256 + off; }
}
__device__ __forceinline__ void dot4x64(const bf16_t* pb, const float* pf, const LAS float* qs_, float (&s)[4]) {
    s[0] = s[1] = s[2] = s[3] = 0.f;
    const LAS float* qs = qs_; asm volatile("" : "+v"(qs));
    if (pf) {
#pragma unroll 4
        for (int c = 0; c < 16; ++c) {
            const f32x4 kx = *(const f32x4*)(pf + c * 4);
#pragma unroll
            for (int h = 0; h < 4; ++h) { const f32x4 q = *(const LAS f32x4*)(qs + h * 64 + c * 4); s[h] += q[0] * kx[0] + q[1] * kx[1] + q[2] * kx[2] + q[3] * kx[3]; }
        }
    } else {
#pragma unroll 2
        for (int c = 0; c < 8; ++c) {
            const u32x4 w = *(const u32x4*)(pb + c * 8);
            const float k0 = bflo(w.x), k1 = bfhi(w.x), k2 = bflo(w.y), k3 = bfhi(w.y), k4 = bflo(w.z), k5 = bfhi(w.z), k6 = bflo(w.w), k7 = bfhi(w.w);
#pragma unroll
            for (int h = 0; h < 4; ++h) {
                const f32x4 qa = *(const LAS f32x4*)(qs + h * 64 + c * 8), qb = *(const LAS f32x4*)(qs + h * 64 + c * 8 + 4);
                s[h] += qa[0] * k0 + qa[1] * k1 + qa[2] * k2 + qa[3] * k3 + qb[0] * k4 + qb[1] * k5 + qb[2] * k6 + qb[3] * k7;
            }
        }
    }
}
template <bool SAMPLE>
__device__ __forceinline__ void attn_chunk(const Params& p, int branch, int b, int g, int t, int pos0, int lo, int hi,
                                           float (&m)[4], float (&l)[4], float (&o)[4], const LAS float* qs, LAS float* pbk, const LAS float* relb, int lane) {
    const int pos = pos0 + lane;
    const bool valid = pos >= lo && pos <= hi;
    float s[4] = {-1e30f, -1e30f, -1e30f, -1e30f};
    if (valid) {
        const bf16_t* pb; const float* pf; kv_row_ptr<SAMPLE>(p, branch, b, pos, 0, g, pb, pf);
        dot4x64(pb, pf, qs, s);
        const int bk = t5_bucket(t - pos);
#pragma unroll
        for (int h = 0; h < 4; ++h) s[h] += relb[bk * 8 + g * 4 + h];
    }
#pragma unroll
    for (int h = 0; h < 4; ++h) {
        const float mx = wave_max(s[h]);
        const float mn = fmaxf(m[h], mx);
        const float pr = valid ? ex2(s[h] - mn) : 0.f;
        const float sm = wave_sum(pr);
        const float al = ex2(m[h] - mn);
        l[h] = l[h] * al + sm; o[h] *= al; m[h] = mn;
        pbk[h * 64 + lane] = pr;
    }
    __builtin_amdgcn_wave_barrier();
    const int k0 = (lo > pos0 ? lo : pos0) - pos0, k1 = (hi < pos0 + 63 ? hi : pos0 + 63) - pos0;
    if (SAMPLE) {
        const int kend = (PAST - 1 - pos0) < k1 ? (PAST - 1 - pos0) : k1;
        if (kend >= k0) {
            const bf16_t* pb; const float* pf; kv_row_ptr<SAMPLE>(p, branch, b, pos0 + k0, 1, g, pb, pf);
            pf += lane;
#pragma unroll 8
            for (int k = k0; k <= kend; ++k) {
                const float v = pf[(size_t)(k - k0) * 256];
#pragma unroll
                for (int h = 0; h < 4; ++h) o[h] += pbk[h * 64 + k] * v;
            }
        }
        if (k1 > kend) {
            const bf16_t* pb; const float* pf; kv_row_ptr<SAMPLE>(p, branch, b, pos0 + k1, 1, g, pb, pf);
            const float v = bf2f(pb[lane]);
#pragma unroll
            for (int h = 0; h < 4; ++h) o[h] += pbk[h * 64 + k1] * v;
        }
    } else {
#pragma unroll 1
    for (int k = k0; k <= k1; ++k) {
        const bf16_t* pb; const float* pf; kv_row_ptr<SAMPLE>(p, branch, b, pos0 + k, 1, g, pb, pf);
        const float v = pf ? pf[lane] : bf2f(pb[lane]);
#pragma unroll
        for (int h = 0; h < 4; ++h) o[h] += pbk[h * 64 + k] * v;
    }
    }
    __builtin_amdgcn_wave_barrier();
}

constexpr int S_QS = 0, S_SC = 1024, S_PHS = S_SC + 4 * 1024 * 4, S_PBK = S_PHS + 1088 * 4, S_PART = S_PBK + 8 * 1024, S_RED = S_PART + 2 * 8 * 272 * 4, S_OCP = S_RED + 512,
              S_SEL = S_OCP + 2048, S_RELB = S_SEL + 64, ATTS_LDS = S_RELB + 1024;
__device__ void attn_sample_item(const Params& p, int b, int g) {
    const int tid = threadIdx.x, wid = tid >> 6, lane = tid & 63;
    constexpr int t = PAST, NC = NCS, NSEL = 257, NJR = 5, qblk = PAST >> 6;
    const int row = MP + b;
    LAS unsigned char* L = (LAS unsigned char*)smem;
    LAS float* qs = (LAS float*)(L + S_QS); LAS float* sc = (LAS float*)(L + S_SC); LAS float* phs = (LAS float*)(L + S_PHS); LAS float* pbk = (LAS float*)(L + S_PBK) + wid * 256;
    LAS float* part = (LAS float*)(L + S_PART); LAS float* red = (LAS float*)(L + S_RED); LAS float* ocp = (LAS float*)(L + S_OCP); LAS int* sel = (LAS int*)(L + S_SEL);
    LAS float* relb = (LAS float*)(L + S_RELB);
    __syncthreads();
    if (tid < 256) { relb[tid] = p.rel_bias[tid] * LOG2E; qs[tid] = bf2f(p.Qb[(size_t)row * QD + g * 256 + tid]); }
    __syncthreads();
    const float* kc = p.KCS + ((size_t)b * NG + g) * 1024 * 64;
    const float* vc = p.VCS + ((size_t)b * NG + g) * 1024 * 64;
    {
        float mx[4] = {-1e30f, -1e30f, -1e30f, -1e30f};
#pragma unroll 1
        for (int r = wid; r < 16; r += 8) {
            const int n = r * 64 + lane;
            float s[4] = {-1e30f, -1e30f, -1e30f, -1e30f};
            if (n < NC) {
                dot4x64(nullptr, kc + (size_t)n * 64, qs, s);
                const int bk = t5_bucket(t - (16 * n + 31));
#pragma unroll
                for (int h = 0; h < 4; ++h) s[h] += relb[bk * 8 + g * 4 + h];
            }
#pragma unroll
            for (int h = 0; h < 4; ++h) { sc[h * 1024 + n] = s[h]; mx[h] = fmaxf(mx[h], s[h]); }
        }
#pragma unroll
        for (int h = 0; h < 4; ++h) { const float m = wave_max(mx[h]); if (lane == 0) red[wid * 4 + h] = m; }
    }
    __syncthreads();
    float gmx[4], inv[4];
#pragma unroll
    for (int h = 0; h < 4; ++h) { float m = red[h]; for (int w = 1; w < 8; ++w) m = fmaxf(m, red[w * 4 + h]); gmx[h] = m; }
    {
        float sum[4] = {0.f, 0.f, 0.f, 0.f};
#pragma unroll
        for (int k = 0; k < 2; ++k) { const int n = tid + 512 * k;
#pragma unroll
            for (int h = 0; h < 4; ++h) { const float e = n < NC ? ex2(sc[h * 1024 + n] - gmx[h]) : 0.f; sc[h * 1024 + n] = e; sum[h] += e; } }
#pragma unroll
        for (int h = 0; h < 4; ++h) { const float s = wave_sum(sum[h]); if (lane == 0) red[32 + wid * 4 + h] = s; }
    }
    __syncthreads();
#pragma unroll
    for (int h = 0; h < 4; ++h) { float s = 0.f; for (int w = 0; w < 8; ++w) s += red[32 + w * 4 + h]; inv[h] = s > 0.f ? 1.0f / s : 0.f; }
    for (int n = tid; n < 1088; n += 512) phs[n] = n < NC ? (sc[n] * inv[0] + sc[1024 + n] * inv[1]) + (sc[2048 + n] * inv[2] + sc[3072 + n] * inv[3]) : 0.f;
    {
        float a[4] = {0.f, 0.f, 0.f, 0.f};
#pragma unroll 8
        for (int n = wid; n < NC; n += 8) {
            const float v = vc[(size_t)n * 64 + lane];
#pragma unroll
            for (int h = 0; h < 4; ++h) a[h] += sc[h * 1024 + n] * v;
        }
#pragma unroll
        for (int h = 0; h < 4; ++h) part[(wid * 4 + h) * 68 + lane] = a[h] * inv[h];
    }
    __syncthreads();
    if (tid < 256) { float a = 0.f; for (int w = 0; w < 8; ++w) a += part[(w * 4 + (tid >> 6)) * 68 + (tid & 63)]; ocp[tid] = a; }
    __syncthreads();
    if (wid == 0) {
        unsigned long long key[NJR];
#pragma unroll
        for (int jr = 0; jr < NJR; ++jr) {
            const int j = jr * 64 + lane;
            key[jr] = 0ull;
            if (j >= 1 && j <= qblk - 2 && j < NSEL) {
                float im = 0.f;
#pragma unroll
                for (int n = 4 * j - 1; n <= 4 * j + 3; ++n) im += (n < NC) ? phs[n] : 0.f;
                key[jr] = ((unsigned long long)__float_as_uint(im) << 32) | (unsigned)(0xFFFF - j) | 0x10000ull;
            }
        }
        if (lane == 0) { sel[0] = 0; sel[1] = qblk - 1; sel[2] = qblk; }
#pragma unroll 1
        for (int it = 0; it < 13; ++it) {
            unsigned long long best = 0ull;
#pragma unroll
            for (int jr = 0; jr < NJR; ++jr) best = key[jr] > best ? key[jr] : best;
#pragma unroll
            for (int o = 32; o > 0; o >>= 1) { const unsigned long long ot = __shfl_xor(best, o); best = ot > best ? ot : best; }
            const int j = 0xFFFF - (int)(best & 0xFFFFull);
#pragma unroll
            for (int jr = 0; jr < NJR; ++jr) if (key[jr] == best) key[jr] = 0ull;
            if (lane == 0) sel[3 + it] = j;
        }
    }
    __syncthreads();
    {
        float ms[4] = {-1e30f, -1e30f, -1e30f, -1e30f}, ls[4] = {0.f, 0.f, 0.f, 0.f}, os[4] = {0.f, 0.f, 0.f, 0.f};
#pragma unroll 1
        for (int i = wid; i < 16; i += 8) attn_chunk<true>(p, 1, b, g, t, sel[i] * 64, 0, t, ms, ls, os, qs, pbk, relb, lane);
        float mw[4] = {-1e30f, -1e30f, -1e30f, -1e30f}, lw[4] = {0.f, 0.f, 0.f, 0.f}, ow[4] = {0.f, 0.f, 0.f, 0.f};
#pragma unroll 1
        for (int c = wid; c < 9; c += 8) attn_chunk<true>(p, 2, b, g, t, t - 63 - 64 * c, t - WIN, t, mw, lw, ow, qs, pbk, relb, lane);
#pragma unroll
        for (int h = 0; h < 4; ++h) {
            LAS float* ps = part + (wid * 4 + h) * 68; LAS float* pw = part + 8 * 272 + (wid * 4 + h) * 68;
            ps[lane] = os[h]; pw[lane] = ow[h];
            if (lane == 0) { ps[64] = ms[h]; ps[65] = ls[h]; pw[64] = mw[h]; pw[65] = lw[h]; }
        }
    }
    __syncthreads();
    if (tid < 256) {
        const int h = tid >> 6, d = tid & 63;
        float res[2];
#pragma unroll
        for (int br = 0; br < 2; ++br) {
            const LAS float* pp = part + br * 8 * 272 + h * 68;
            float m = -1e30f;
            for (int w = 0; w < 8; ++w) m = fmaxf(m, pp[w * 272 + 64]);
            float l = 0.f, o = 0.f;
            for (int w = 0; w < 8; ++w) { const float sc_ = ex2(pp[w * 272 + 64] - m); l += pp[w * 272 + 65] * sc_; o += pp[w * 272 + d] * sc_; }
            res[br] = o / l;
        }
        const float* gt = p.GATE + (size_t)row * 32 + (g * 4 + h) * 3;
        const float v = gt[0] * ocp[tid] + gt[1] * res[0] + gt[2] * res[1];
        p.OCAT[(size_t)row * DM + (g * 4 + h) * 64 + d] = f2bf(v);
    }
    __syncthreads();
}

constexpr int A_OST = 0, OST_LD = 68, A_LST = A_OST + 256 * OST_LD * 4, A_M0 = A_LST + 1024, A_MB = A_M0 + 1024, MB_LD = 132, A_MKN = A_MB + 64 * MB_LD,
              A_LIST = A_MKN + 256, A_CNT = A_LIST + 132 * 64, A_PK = A_CNT + 544, A_KN = A_PK + 400 * 4, A_T2 = A_KN + 512, A_NP = A_T2 + 132 * 8 * 4, A_QT = A_NP + 16, ATT2_LDS = A_QT + 64 * 512;
static_assert(ATT2_LDS <= GEMM_LDS && ATTS_LDS <= GEMM_LDS, "attention LDS");

__device__ __forceinline__ void qk64(const bf16_t* kb, int c, int G, const bf16x8 (&qB)[2], f32x4 (&s)[4]) {
#pragma unroll
    for (int kt = 0; kt < 4; ++kt) {
        const bf16_t* r = kb + (size_t)(16 * kt + c) * 256 + G * 8;
        const bf16x8 a0 = *(const bf16x8*)r, a1 = *(const bf16x8*)(r + 32);
        s[kt] = mfma16(a0, qB[0], (f32x4){0.f, 0.f, 0.f, 0.f}); s[kt] = mfma16(a1, qB[1], s[kt]);
    }
}
__device__ __forceinline__ void pv64(const bf16_t* vf, int key0, int lane, const f32x4 (&pr)[4], f32x4 (&o)[4]) {
#pragma unroll
    for (int ks = 0; ks < 2; ++ks) {
        const bf16x8 pB = pack_p(pr[2 * ks], pr[2 * ks + 1]);
#pragma unroll
        for (int dt = 0; dt < 4; ++dt) {
            const bf16x8 vA = *(const bf16x8*)(vf + ((size_t)(((key0 >> 5) + ks) * 4 + dt) * 64 + lane) * 8);
            o[dt] = mfma16(vA, pB, o[dt]);
        }
    }
}
__device__ __forceinline__ int qt_off(int qi, int hh, int k) { return (qi * 4 + hh) * 128 + ((k ^ (((qi & 3) << 1) | (hh >> 1))) << 4); }
__device__ __forceinline__ float grp_max(float v) { v = fmaxf(v, __shfl_xor(v, 16)); return fmaxf(v, __shfl_xor(v, 32)); }
__device__ __forceinline__ float grp_sum(float v) { v += __shfl_xor(v, 16); return v + __shfl_xor(v, 32); }

__device__ __forceinline__ void attn_pack(const Params& p, int b, int g, int t0, int lane_, LAS unsigned char* L) {
    f32x4 oacc[4];
    int lane = lane_; asm volatile("" : "+v"(lane));
    const int c = lane & 15, G = lane >> 4, qs = c >> 2, hh = c & 3;
    const int qb = t0 >> 6, tc = t0 + qs;
    const size_t qrow = (size_t)b * SEQ + tc;
    const LAS float* T2 = (const LAS float*)(L + A_T2);
    const float b31 = T2[128 * 8 + g * 4 + hh];
    bf16x8 qB[2];
    qB[0] = *(const bf16x8*)(p.Qb + qrow * QD + (g * 4 + hh) * 64 + G * 8); qB[1] = *(const bf16x8*)(p.Qb + qrow * QD + (g * 4 + hh) * 64 + 32 + G * 8);
    const float* gate = p.GATE + qrow * 32 + (g * 4 + hh) * 3;
    unsigned msk[4] = {0u, 0u, 0u, 0u};
    {
        const int ncv_c = tc >= 31 ? ((tc - 31) >> 4) + 1 : 0;
        const int ncv_m = t0 + 3 >= 31 ? ((t0 + 3 - 31) >> 4) + 1 : 0;
        const int NT = (ncv_m + 15) >> 4;
        const int mt_far = t0 >= 399 ? (t0 - 399) / 256 + 1 : 0;
        const bf16_t* kcb = p.KCb + (size_t)(b * NG + g) * 512 * 64;
        f32x4 sc[32];
        float mx = -1e30f;
#pragma unroll
        for (int mt = 0; mt < 32; ++mt) {
            sc[mt] = (f32x4){0.f, 0.f, 0.f, 0.f};
            if (mt < NT) {
                const bf16x8 a0 = *(const bf16x8*)(kcb + ((size_t)(mt * 2) * 64 + lane) * 8), a1 = *(const bf16x8*)(kcb + ((size_t)(mt * 2 + 1) * 64 + lane) * 8);
                f32x4 s = mfma16(a0, qB[0], (f32x4){0.f, 0.f, 0.f, 0.f}); s = mfma16(a1, qB[1], s);
                if (mt < mt_far) { s = s + b31; }
                else {
#pragma unroll
                    for (int i = 0; i < 4; ++i) { const int n = 16 * mt + 4 * G + i; int dist = tc - (16 * n + 31); const bool ok = n < ncv_c; dist = dist < 0 ? 0 : (dist > 128 ? 128 : dist);
                        s[i] = ok ? s[i] + T2[dist * 8 + g * 4 + hh] : -1e30f; }
                }
                mx = fmaxf(mx, fmaxf(fmaxf(s[0], s[1]), fmaxf(s[2], s[3])));
                sc[mt] = s;
            }
            if ((mt & 3) == 3) __builtin_amdgcn_sched_barrier(0);
        }
        mx = grp_max(mx);
        float sum = 0.f;
#pragma unroll
        for (int mt = 0; mt < 32; ++mt) if (mt < NT) {
#pragma unroll
            for (int i = 0; i < 4; ++i) { const float e = ex2(sc[mt][i] - mx); sc[mt][i] = e; sum += e; }
        }
        sum = grp_sum(sum);
        const float inv = ncv_c > 0 ? 1.0f / sum : 0.f;
#pragma unroll
        for (int mt = 0; mt < 32; ++mt) if (mt < NT) sc[mt] = sc[mt] * inv;
        if (qb <= 15) {
            msk[0] = (qb >= 31) ? 0xffffffffu : ((2u << qb) - 1u);
        } else {
            float cand[8];
#pragma unroll
            for (int k = 0; k < 8; ++k) cand[k] = -1.f;
            float prevB = 0.f;
#pragma unroll
            for (int mt = 0; mt < 32; ++mt) if (mt < NT) {
                const float r1 = __shfl(sc[mt][3], (lane - 16) & 63);
                float v = (sc[mt][0] + sc[mt][1]) + (sc[mt][2] + sc[mt][3]) + (G == 0 ? prevB : r1);
                prevB = r1;
                v += __shfl_xor(v, 1); v += __shfl_xor(v, 2);
                const int j = 4 * mt + G;
                if ((mt & 3) == hh) cand[mt >> 2] = (j >= 1 && j <= qb - 2) ? v : -1.f;
            }
            auto setbit = [&](int j) { const unsigned bit = 1u << (j & 31); const int w = j >> 5; msk[0] |= w == 0 ? bit : 0u; msk[1] |= w == 1 ? bit : 0u; msk[2] |= w == 2 ? bit : 0u; msk[3] |= w == 3 ? bit : 0u; };
            setbit(0); setbit(qb); setbit(qb - 1);
#pragma unroll 1
            for (int it = 0; it < 13; ++it) {
                float bv = cand[0];
#pragma unroll
                for (int k = 1; k < 8; ++k) bv = fmaxf(bv, cand[k]);
                bv = fmaxf(bv, __shfl_xor(bv, 1)); bv = fmaxf(bv, __shfl_xor(bv, 2)); bv = grp_max(bv);
                int bj = 9999;
#pragma unroll
                for (int k = 0; k < 8; ++k) { const int j = 16 * k + 4 * hh + G; bj = (cand[k] == bv && j < bj) ? j : bj; }
                { int o = __shfl_xor(bj, 1); bj = o < bj ? o : bj; o = __shfl_xor(bj, 2); bj = o < bj ? o : bj; o = __shfl_xor(bj, 16); bj = o < bj ? o : bj; o = __shfl_xor(bj, 32); bj = o < bj ? o : bj; }
#pragma unroll
                for (int k = 0; k < 8; ++k) { const int j = 16 * k + 4 * hh + G; if (j == bj) cand[k] = -1.f; }
                setbit(bj & 127);
            }
        }
        const bf16_t* vct = p.VCT + (size_t)(b * NG + g) * 64 * 512;
        f32x4 oc[4] = {{0.f, 0.f, 0.f, 0.f}, {0.f, 0.f, 0.f, 0.f}, {0.f, 0.f, 0.f, 0.f}, {0.f, 0.f, 0.f, 0.f}};
#pragma unroll
        for (int k2 = 0; k2 < 16; ++k2) if (2 * k2 < NT) {
            const bf16x8 pB = pack_p(sc[2 * k2], sc[2 * k2 + 1]);
#pragma unroll
            for (int dt = 0; dt < 4; ++dt) {
                const bf16x8 vA = *(const bf16x8*)(vct + ((size_t)(k2 * 4 + dt) * 64 + lane) * 8);
                oc[dt] = mfma16(vA, pB, oc[dt]);
            }
            if (k2 & 1) __builtin_amdgcn_sched_barrier(0);
        }
        const float g0 = gate[0];
#pragma unroll
        for (int dt = 0; dt < 4; ++dt) oacc[dt] = oc[dt] * g0;
    }
    bf16_t* orow = p.OCAT + qrow * DM + (g * 4 + hh) * 64 + 4 * G;
#pragma unroll
    for (int dt = 0; dt < 4; ++dt) st_bf16x4(orow + dt * 16, oacc[dt]);
    {
        unsigned um[4];
#pragma unroll
        for (int w = 0; w < 4; ++w) { unsigned u = msk[w]; u |= __shfl_xor(u, 4); u |= __shfl_xor(u, 8); um[w] = __builtin_amdgcn_readfirstlane(u); }
        f32x4 os[4] = {{0.f, 0.f, 0.f, 0.f}, {0.f, 0.f, 0.f, 0.f}, {0.f, 0.f, 0.f, 0.f}, {0.f, 0.f, 0.f, 0.f}};
        float m = -1e30f, l = 0.f;
        const bf16_t* kbase = p.SLCkF + (size_t)(b * NG + g) * SEQ * 64;
        const bf16_t* vbase = p.SLCvT + (size_t)(b * NG + g) * SEQ * 64;
        auto ldfr = [&](int j_, bf16x8 (&kf_)[4][2], bf16x8 (&vf_)[2][4]) {
#pragma unroll
            for (int kt = 0; kt < 4; ++kt) { const bf16_t* r = kbase + ((size_t)((j_ * 4 + kt) * 2) * 64 + lane) * 8; kf_[kt][0] = *(const bf16x8*)r; kf_[kt][1] = *(const bf16x8*)(r + 512); }
#pragma unroll
            for (int ks = 0; ks < 2; ++ks)
#pragma unroll
                for (int dt = 0; dt < 4; ++dt) vf_[ks][dt] = *(const bf16x8*)(vbase + ((size_t)((2 * j_ + ks) * 4 + dt) * 64 + lane) * 8);
        };
        auto nextj = [&](int& j_) {
            int w = um[0] ? 0 : um[1] ? 1 : um[2] ? 2 : um[3] ? 3 : -1;
            if (w < 0) return false;
            const unsigned u = w == 0 ? um[0] : w == 1 ? um[1] : w == 2 ? um[2] : um[3];
            const int bpos = __builtin_ctz(u);
            j_ = w * 32 + bpos;
            const unsigned cl = ~(1u << bpos);
            if (w == 0) um[0] &= cl; else if (w == 1) um[1] &= cl; else if (w == 2) um[2] &= cl; else um[3] &= cl;
            return true;
        };
        auto blockstep = [&](int j, const bf16x8 (&kf)[4][2], const bf16x8 (&vf)[2][4]) {
            const unsigned mw = (j >> 5) == 0 ? msk[0] : (j >> 5) == 1 ? msk[1] : (j >> 5) == 2 ? msk[2] : msk[3];
            const bool mine = (mw >> (j & 31)) & 1u;
            const bool farb = j <= qb - 3;
            const float ini = farb ? b31 : 0.f;
            f32x4 s[4];
#pragma unroll
            for (int kt = 0; kt < 4; ++kt) { s[kt] = mfma16(kf[kt][0], qB[0], (f32x4){ini, ini, ini, ini}); s[kt] = mfma16(kf[kt][1], qB[1], s[kt]); }
            if (!farb) {
#pragma unroll
                for (int kt = 0; kt < 4; ++kt)
#pragma unroll
                    for (int i = 0; i < 4; ++i) { const int dist = tc - (j * 64 + 16 * kt + 4 * G + i); const int dd = dist < 0 ? 0 : (dist > 128 ? 128 : dist);
                        s[kt][i] = dist >= 0 ? s[kt][i] + T2[dd * 8 + g * 4 + hh] : -1e30f; }
            }
            float cm = fmaxf(fmaxf(fmaxf(s[0][0], s[0][1]), fmaxf(s[0][2], s[0][3])), fmaxf(fmaxf(s[1][0], s[1][1]), fmaxf(s[1][2], s[1][3])));
            cm = fmaxf(cm, fmaxf(fmaxf(fmaxf(s[2][0], s[2][1]), fmaxf(s[2][2], s[2][3])), fmaxf(fmaxf(s[3][0], s[3][1]), fmaxf(s[3][2], s[3][3]))));
            cm = grp_max(mine ? cm : -1e30f);
            const float mn = fmaxf(m, cm), al = ex2(m - mn);
            const float sh = mine ? mn : 1e30f;
            float ps = 0.f;
#pragma unroll
            for (int kt = 0; kt < 4; ++kt)
#pragma unroll
                for (int i = 0; i < 4; ++i) { const float e = ex2(s[kt][i] - sh); s[kt][i] = e; ps += e; }
            l = l * al + grp_sum(ps); m = mn;
#pragma unroll
            for (int dt = 0; dt < 4; ++dt) os[dt] = os[dt] * al;
#pragma unroll
            for (int ks = 0; ks < 2; ++ks) { const bf16x8 pB = pack_p(s[2 * ks], s[2 * ks + 1]);
#pragma unroll
                for (int dt = 0; dt < 4; ++dt) os[dt] = mfma16(vf[ks][dt], pB, os[dt]); }
        };
        bf16x8 kfA[4][2], vfA[2][4], kfB[4][2], vfB[2][4];
        int j = 0; bool have = nextj(j);
        ldfr(j, kfA, vfA);
#pragma unroll 1
        while (have) {
            int jn = j; bool haven = nextj(jn);
            ldfr(jn, kfB, vfB);
            __builtin_amdgcn_sched_barrier(0);
            blockstep(j, kfA, vfA);
            if (!haven) break;
            j = jn; have = nextj(jn);
            ldfr(jn, kfA, vfA);
            __builtin_amdgcn_sched_barrier(0);
            blockstep(j, kfB, vfB);
            j = jn;
        }
        const float gs = gate[1] / l;
#pragma unroll
        for (int dt = 0; dt < 4; ++dt) { const u32x2 w = *(const u32x2*)(orow + dt * 16); f32x4 pa; pa[0] = bflo(w.x); pa[1] = bfhi(w.x); pa[2] = bflo(w.y); pa[3] = bfhi(w.y);
            st_bf16x4(orow + dt * 16, pa + os[dt] * gs); }
    }
    {
        f32x4 ow[4] = {{0.f, 0.f, 0.f, 0.f}, {0.f, 0.f, 0.f, 0.f}, {0.f, 0.f, 0.f, 0.f}, {0.f, 0.f, 0.f, 0.f}};
        float m = -1e30f, l = 0.f;
        const int lo = t0 - WIN > 0 ? t0 - WIN : 0, hi = t0 + 3;
        const bf16_t* kbase = p.WINkF + (size_t)(b * NG + g) * SEQ * 64;
        const bf16_t* vbase = p.WINvT + (size_t)(b * NG + g) * 64 * SEQ;
        auto ldfr = [&](int cb_, bf16x8 (&kf_)[4][2], bf16x8 (&vf_)[2][4]) {
#pragma unroll
            for (int kt = 0; kt < 4; ++kt) { const bf16_t* r = kbase + ((size_t)(((cb_ >> 4) + kt) * 2) * 64 + lane) * 8; kf_[kt][0] = *(const bf16x8*)r; kf_[kt][1] = *(const bf16x8*)(r + 512); }
#pragma unroll
            for (int ks = 0; ks < 2; ++ks)
#pragma unroll
                for (int dt = 0; dt < 4; ++dt) vf_[ks][dt] = *(const bf16x8*)(vbase + ((size_t)(((cb_ >> 5) + ks) * 4 + dt) * 64 + lane) * 8);
        };
        auto chunkstep = [&](int cb, const bf16x8 (&kf)[4][2], const bf16x8 (&vf)[2][4]) {
            const bool far = (cb + 63 <= t0 - 128) && (cb >= t0 + 3 - WIN);
            const float ini = far ? b31 : 0.f;
            f32x4 s[4];
#pragma unroll
            for (int kt = 0; kt < 4; ++kt) { s[kt] = mfma16(kf[kt][0], qB[0], (f32x4){ini, ini, ini, ini}); s[kt] = mfma16(kf[kt][1], qB[1], s[kt]); }
            if (!far) {
#pragma unroll
                for (int kt = 0; kt < 4; ++kt)
#pragma unroll
                    for (int i = 0; i < 4; ++i) { const int dist = tc - (cb + 16 * kt + 4 * G + i); const bool ok = dist >= 0 && dist <= WIN; const int dd = dist < 0 ? 0 : (dist > 128 ? 128 : dist);
                        s[kt][i] = ok ? s[kt][i] + T2[dd * 8 + g * 4 + hh] : -1e30f; }
            }
            float cm = fmaxf(fmaxf(fmaxf(s[0][0], s[0][1]), fmaxf(s[0][2], s[0][3])), fmaxf(fmaxf(s[1][0], s[1][1]), fmaxf(s[1][2], s[1][3])));
            cm = fmaxf(cm, fmaxf(fmaxf(fmaxf(s[2][0], s[2][1]), fmaxf(s[2][2], s[2][3])), fmaxf(fmaxf(s[3][0], s[3][1]), fmaxf(s[3][2], s[3][3]))));
            cm = grp_max(cm);
            const float mn = fmaxf(m, cm), al = ex2(m - mn);
            float ps = 0.f;
#pragma unroll
            for (int kt = 0; kt < 4; ++kt)
#pragma unroll
                for (int i = 0; i < 4; ++i) { const float e = ex2(s[kt][i] - mn); s[kt][i] = e; ps += e; }
            l = l * al + grp_sum(ps); m = mn;
#pragma unroll
            for (int dt = 0; dt < 4; ++dt) ow[dt] = ow[dt] * al;
#pragma unroll
            for (int ks = 0; ks < 2; ++ks) { const bf16x8 pB = pack_p(s[2 * ks], s[2 * ks + 1]);
#pragma unroll
                for (int dt = 0; dt < 4; ++dt) ow[dt] = mfma16(vf[ks][dt], pB, ow[dt]); }
        };
        bf16x8 kfA[4][2], vfA[2][4], kfB[4][2], vfB[2][4];
        int cb = lo & ~63;
        ldfr(cb, kfA, vfA);
#pragma unroll 1
        for (;;) {
            ldfr(cb + 64 <= hi ? cb + 64 : cb, kfB, vfB);
            __builtin_amdgcn_sched_barrier(0);
            chunkstep(cb, kfA, vfA);
            cb += 64; if (cb > hi) break;
            ldfr(cb + 64 <= hi ? cb + 64 : cb, kfA, vfA);
            __builtin_amdgcn_sched_barrier(0);
            chunkstep(cb, kfB, vfB);
            cb += 64; if (cb > hi) break;
        }
        const float gw = gate[2] / l;
#pragma unroll
        for (int dt = 0; dt < 4; ++dt) { const u32x2 w = *(const u32x2*)(orow + dt * 16); f32x4 pa; pa[0] = bflo(w.x); pa[1] = bfhi(w.x); pa[2] = bflo(w.y); pa[3] = bfhi(w.y);
            st_bf16x4(orow + dt * 16, pa + ow[dt] * gw); }
    }
}

__device__ void phase_attn(const Params& p) {
    const int wid = threadIdx.x >> 6, lane = threadIdx.x & 63;
    { PROBE_BEGIN(3)
    if (blockIdx.x < NS * NG) attn_sample_item(p, blockIdx.x >> 1, blockIdx.x & 1);
    PROBE_END(3) }
    LAS unsigned char* L = (LAS unsigned char*)smem;
    for (int i = threadIdx.x; i < 129 * 8; i += 512) ((LAS float*)(L + A_T2))[i] = p.rel_bias[t5_bucket(i >> 3) * 8 + (i & 7)] * LOG2E;
    __syncthreads();
    {
        const int wid2 = __builtin_amdgcn_readfirstlane(threadIdx.x >> 6);
#pragma unroll 1
        for (int T = blockIdx.x; T < NB * NG * (SEQ / 32); T += gridDim.x) {
            const int bg = T & 7, h32 = (SEQ / 32 - 1) - (T >> 3);
            attn_pack(p, bg >> 1, bg & 1, h32 * 32 + wid2 * 4, lane, L);
        }
    }
    __syncthreads();
}

constexpr int GM_LD = 136, GM_LDS = 128 * GM_LD * 2 + 1024;
__device__ void phase_gmlp(const Params& p) {
    const int tid = threadIdx.x, wid = __builtin_amdgcn_readfirstlane(tid >> 6), lane = tid & 63;
    LAS bf16_t* vnT = (LAS bf16_t*)smem;
    LAS float* mu = (LAS float*)(smem + 128 * GM_LD * 2);
    const int c = lane & 15, G = lane >> 4;
#pragma unroll 1
    for (int u = blockIdx.x; u < NB * 64; u += gridDim.x) {
        const int b = u >> 6, ch = u & 63; const size_t row0 = (size_t)b * SEQ + ch * 128;
        __syncthreads();
        for (int r = wid; r < 128; r += 8) {
            const u32x4 w = *(const u32x4*)(p.Vg + (row0 + r) * GMD + lane * 8);
            const float x[8] = {bflo(w.x), bfhi(w.x), bflo(w.y), bfhi(w.y), bflo(w.z), bfhi(w.z), bflo(w.w), bfhi(w.w)};
            float s = 0.f;
#pragma unroll
            for (int i = 0; i < 8; ++i) s += x[i];
            const float mean = wave_sum(s) * (1.0f / GMD);
            float q = 0.f;
#pragma unroll
            for (int i = 0; i < 8; ++i) q += (x[i] - mean) * (x[i] - mean);
            const float var = wave_sum(q) * (1.0f / GMD);
            if (lane == 0) { mu[r] = mean; mu[128 + r] = rsqrtf(var + EPS); }
        }
#pragma unroll 1
        for (int g = 0; g < 4; ++g) {
            __syncthreads();
#pragma unroll
            for (int k = 0; k < 4; ++k) {
                const int e = tid + 512 * k, s = e & 127, d0 = (e >> 7) * 8;
                const u32x4 w = *(const u32x4*)(p.Vg + (row0 + s) * GMD + g * 128 + d0);
                const float x[8] = {bflo(w.x), bfhi(w.x), bflo(w.y), bfhi(w.y), bflo(w.z), bfhi(w.z), bflo(w.w), bfhi(w.w)};
                const float m = mu[s], rs = mu[128 + s];
#pragma unroll
                for (int i = 0; i < 8; ++i) { const int cc = g * 128 + d0 + i; vnT[(d0 + i) * GM_LD + s] = f2bf((x[i] - m) * rs * p.gm_ln_g[cc] + p.gm_ln_b[cc]); }
            }
            __syncthreads();
            f32x4 acc[8];
#pragma unroll
            for (int dt = 0; dt < 8; ++dt) acc[dt] = (f32x4){0.f, 0.f, 0.f, 0.f};
            const bf16_t* wrow = p.GWb + ((size_t)g * 128 + 16 * wid + c) * 128 + 8 * G;
#pragma unroll 1
            for (int ks = 0; ks <= (wid >> 1); ++ks) {
                const bf16x8 B = *(const bf16x8*)(wrow + 32 * ks);
#pragma unroll
                for (int dt = 0; dt < 8; ++dt) {
                    const bf16x8 A = *(const LAS bf16x8*)(vnT + (dt * 16 + c) * GM_LD + 32 * ks + 8 * G);
                    acc[dt] = mfma16(A, B, acc[dt]);
                }
            }
            const int t = 16 * wid + c;
            const float bs = p.gm_bs[g * 128 + t];
#pragma unroll
            for (int dt = 0; dt < 8; ++dt) {
                const int d = dt * 16 + 4 * G;
                const u32x2 uw = *(const u32x2*)(p.U + (row0 + t) * GMD + g * 128 + d);
                f32x4 o; o[0] = bflo(uw.x) * (acc[dt][0] + bs); o[1] = bfhi(uw.x) * (acc[dt][1] + bs); o[2] = bflo(uw.y) * (acc[dt][2] + bs); o[3] = bfhi(uw.y) * (acc[dt][3] + bs);
                st_bf16x4(p.OCAT + (row0 + t) * DM + QD + g * 128 + d, o);
            }
        }
    }
    for (int it = blockIdx.x * 8 + wid; it < NS; it += gridDim.x * 8) {
        const size_t row = (size_t)MP + it;
        const u32x4 w = *(const u32x4*)(p.Vg + row * GMD + lane * 8);
        const float x[8] = {bflo(w.x), bfhi(w.x), bflo(w.y), bfhi(w.y), bflo(w.z), bfhi(w.z), bflo(w.w), bfhi(w.w)};
        float s = 0.f;
#pragma unroll
        for (int i = 0; i < 8; ++i) s += x[i];
        const float mean = wave_sum(s) * (1.0f / GMD);
        float q = 0.f;
#pragma unroll
        for (int i = 0; i < 8; ++i) q += (x[i] - mean) * (x[i] - mean);
        const float rs = rsqrtf(wave_sum(q) * (1.0f / GMD) + EPS);
#pragma unroll
        for (int i = 0; i < 8; ++i) {
            const int c = lane * 8 + i, g = c >> 7;
            const float v = (x[i] - mean) * rs * p.gm_ln_g[c] + p.gm_ln_b[c];
            p.out[O_GMV + (size_t)it * GMD + c] = v;
            const float a = p.gm_ws[(size_t)g * 128 * 128] * v + p.gm_bs[g * 128];
            p.OCAT[row * DM + QD + c] = f2bf(bf2f(p.U[row * GMD + c]) * a);
        }
    }
}

template <int MODE>
__device__ void phase_norm(const Params& p) {
    const int wid = threadIdx.x >> 6, lane = threadIdx.x & 63;
    const float* gpost = MODE == 0 ? p.ln_mix_post : MODE == 1 ? p.ln_ffn_post : p.ln_ple_post;
    for (int row = blockIdx.x * 8 + wid; row < MP + NS; row += gridDim.x * 8) {
        const float* fr = p.F + (size_t)row * DM;
        const float* xr = MODE == 0 ? xrow_ptr(p, row) : MODE == 1 ? p.X1 + (size_t)row * DM : p.X2 + (size_t)row * DM;
        f32x4 f[4], x[4];
#pragma unroll
        for (int k = 0; k < 4; ++k) { f[k] = *(const f32x4*)(fr + lane * 4 + k * 256); x[k] = *(const f32x4*)(xr + lane * 4 + k * 256); }
        const float r = row_rstd(f);
#pragma unroll
        for (int k = 0; k < 4; ++k) { const f32x4 g = *(const f32x4*)(gpost + lane * 4 + k * 256); x[k] = x[k] + f[k] * r * g; }
        if (MODE == 0) {
            const float r2 = row_rstd(x);
#pragma unroll
            for (int k = 0; k < 4; ++k) {
                *(f32x4*)(p.X1 + (size_t)row * DM + lane * 4 + k * 256) = x[k];
                const f32x4 g = *(const f32x4*)(p.ln_ffn_pre + lane * 4 + k * 256); const f32x4 o = x[k] * r2 * g;
                st_bf16x4(p.H2 + (size_t)row * DM + lane * 4 + k * 256, o);
            }
        } else if (MODE == 1) {
#pragma unroll
            for (int k = 0; k < 4; ++k) { *(f32x4*)(p.X2 + (size_t)row * DM + lane * 4 + k * 256) = x[k]; st_bf16x4(p.X2b + (size_t)row * DM + lane * 4 + k * 256, x[k]); }
        } else {
            float* yr = row < MP ? p.out + O_YP + (size_t)row * DM : p.out + O_YS + (size_t)(row - MP) * DM;
#pragma unroll
            for (int k = 0; k < 4; ++k) *(f32x4*)(yr + lane * 4 + k * 256) = x[k];
        }
    }
}


#define XB_TMO      128
#define XB_XCNT(j)  (256  + 64 * (j))
#define XB_XSUB(j)  (1280 + 64 * (j))
#define XB_XGEN(j)  (2304 + 64 * (j))
#define XB_TOP      3328
#define XB_TOPGEN   3392
#define XCD_BAR_WORDS 3456
#define XB_SPIN_CAP (1u << 22)

__device__ __forceinline__ unsigned xb_ld(unsigned* p)              { return __hip_atomic_load(p, __ATOMIC_RELAXED, __HIP_MEMORY_SCOPE_AGENT); }
__device__ __forceinline__ unsigned xb_add(unsigned* p, unsigned v) { return __hip_atomic_fetch_add(p, v, __ATOMIC_RELAXED, __HIP_MEMORY_SCOPE_AGENT); }
__device__ __forceinline__ unsigned xb_xcc_id() { return (unsigned)__builtin_amdgcn_s_getreg((3 << 11) | 20) & 0xFu; }
#define XB_SPIN(cond, bar) do { unsigned _sp = 0; while (cond) { __builtin_amdgcn_s_sleep(1); \
    if ((++_sp & 255u) == 0u) { if (xb_ld(&(bar)[XB_TMO])) break; if (_sp > XB_SPIN_CAP) { atomicAdd(&(bar)[XB_TMO], 1u); break; } } } } while (0)

struct XcdBarrier {
    unsigned* bar; unsigned x;
    volatile LAS unsigned* st;
};

__device__ __forceinline__ XcdBarrier xcd_barrier_post(unsigned* bar, volatile LAS unsigned* st) {
    XcdBarrier b; b.bar = bar; b.x = xb_xcc_id(); b.st = st;
    if (threadIdx.x == 0) (void)xb_add(&bar[XB_XCNT(b.x)], 1u);
    return b;
}
__device__ __forceinline__ void xcd_barrier_complete(unsigned* bar, unsigned x, unsigned& nloc, unsigned& nx) {
    const unsigned G = gridDim.x * gridDim.y * gridDim.z;
    unsigned sum, cnt, mine, sp = 0u;
    for (;;) {
        sum = 0u; cnt = 0u; mine = 0u;
#pragma unroll
        for (unsigned j = 0; j < 16; ++j) { const unsigned c = xb_ld(&bar[XB_XCNT(j)]); sum += c; cnt += (c > 0u) ? 1u : 0u; mine = (j == x) ? c : mine; }
        if (sum == G) break;
        __builtin_amdgcn_s_sleep(1);
        if ((++sp & 255u) == 0u) { if (xb_ld(&bar[XB_TMO])) break; if (sp > XB_SPIN_CAP) { atomicAdd(&bar[XB_TMO], 1u); break; } }
    }
    nloc = mine > 0u ? mine : 1u; nx = cnt > 0u ? cnt : 1u;
}

__device__ __forceinline__ void xcd_barrier(const XcdBarrier& b) {
    asm volatile("s_waitcnt vmcnt(0)" ::: "memory");
    __syncthreads();
    if (threadIdx.x == 0) {
        unsigned* bar = b.bar;
        __builtin_amdgcn_s_waitcnt(0);
        unsigned nloc = b.st[0], nx = b.st[1];
        if (nloc == 0u) { xcd_barrier_complete(bar, b.x, nloc, nx); b.st[0] = nloc; b.st[1] = nx; }
        const unsigned old = xb_add(&bar[XB_XSUB(b.x)], 1u);
        const unsigned gen = old / nloc;
        if (old + 1u == (gen + 1u) * nloc) {
            __builtin_amdgcn_fence(__ATOMIC_RELEASE, "agent");
            asm volatile("s_waitcnt vmcnt(0)" ::: "memory");
            const unsigned og = xb_add(&bar[XB_TOP], 1u);
            const unsigned tg = og / nx;
            if (og + 1u == (tg + 1u) * nx) xb_add(&bar[XB_TOPGEN], 1u);
            else XB_SPIN(xb_ld(&bar[XB_TOPGEN]) == tg, bar);
            __builtin_amdgcn_fence(__ATOMIC_ACQUIRE, "agent");
            xb_add(&bar[XB_XGEN(b.x)], 1u);
            asm volatile("s_waitcnt vmcnt(0)" ::: "memory");
        } else {
            XB_SPIN(xb_ld(&bar[XB_XGEN(b.x)]) == gen, bar);
            __builtin_amdgcn_fence(__ATOMIC_ACQUIRE, "agent");
            asm volatile("s_waitcnt vmcnt(0)" ::: "memory");
        }
    }
    __syncthreads();
}

constexpr int NPHASE = 16;
constexpr int LDS_BYTES = GEMM_LDS;
static_assert(GM_LDS <= LDS_BYTES, "lds");
constexpr int NMT = MALL / BM;

constexpr int NMP = MP / BM;
template <int PH>
__device__ __forceinline__ void run_phase(const Params& p) {
    if (PH == 0) phase_prologue(p);
    if (PH == 1) { EpiIn e{p}; gemm_phase(p.H, DM, p.WinT, DM, NMP, INP / BM, e); gemm_skinny(p.H + (size_t)MP * DM, DM, p.WinT, DM, INP, e); }
    if (PH == 2) { EpiPart e{p.PART}; gemm_phase(p.CMPb, 4096, p.W1T, 1024, (2048 + NS * 1024) / BM, 1, e, 4, ZCmp(), 256); }
    if (PH == 3) phase_cmp_final(p);
    if (PH == 4) phase_attn(p);
    if (PH == 5) phase_gmlp(p);
    if (PH == 6) { EpiBrA e{p.GA, p.T}; gemm_phase(p.OCAT, DM, p.WnT, QD, NMP, DM / BM, e); gemm_skinny(p.OCAT + (size_t)MP * DM, DM, p.WnT, QD, DM, e); }
    if (PH == 7) { EpiBrB e{p.GB, p.T, p.Y1}; gemm_phase(p.OCAT + QD, DM, p.WgT, GMD, NMP, DM / BM, e); gemm_skinny(p.OCAT + (size_t)MP * DM + QD, DM, p.WgT, GMD, DM, e); }
    if (PH == 8) { EpiF32 e{p.F, DM}; gemm_phase(p.Y1, DM, p.WoT, DM, NMP, DM / BM, e); gemm_skinny(p.Y1 + (size_t)MP * DM, DM, p.WoT, DM, DM, e); }
    if (PH == 9) phase_norm<0>(p);
    if (PH == 10) { EpiSwiGLU e{p.ACT}; gemm_phase(p.H2, DM, p.WguT, DM, NMP, 2 * DFF / BM, e); gemm_skinny(p.H2 + (size_t)MP * DM, DM, p.WguT, DM, 2 * DFF, e); }
    if (PH == 11) { EpiF32 e{p.F, DM}; gemm_phase(p.ACT, DFF, p.WdT, DFF, NMP, DM / BM, e); gemm_skinny(p.ACT + (size_t)MP * DFF, DFF, p.WdT, DFF, DM, e); }
    if (PH == 12) phase_norm<1>(p);
    if (PH == 13) { EpiF32 e{p.T, DM}; gemm_phase(p.Pb, PLE, p.WpT, PLE, NMP, DM / BM, e); gemm_skinny(p.Pb + (size_t)MP * PLE, PLE, p.WpT, PLE, DM, e); }
    if (PH == 14) { EpiPleGate e{p.T, p.F}; gemm_phase(p.X2b, DM, p.WpgT, DM, NMP, DM / BM, e); gemm_skinny(p.X2b + (size_t)MP * DM, DM, p.WpgT, DM, DM, e); }
    if (PH == 15) phase_norm<2>(p);
}

#ifndef MK_MULTI
#define MK_MULTI 0
#endif
template <int PH>
__global__ void __launch_bounds__(512, 2) k_phase(Params p) { run_phase<PH>(p); }

__global__ void __launch_bounds__(512, 2) k_all(Params p) {
    volatile LAS unsigned* st = (volatile LAS unsigned*)((LAS unsigned char*)smem + LDS_BYTES);
    if (threadIdx.x < 12) st[threadIdx.x] = 0u;
    __syncthreads();
    XcdBarrier bar = xcd_barrier_post(p.bar, st);
#if PROBE_DUP == 100
    run_phase<0>(p);  xcd_barrier(bar);
#endif
    run_phase<0>(p);  xcd_barrier(bar);
    run_phase<1>(p);  xcd_barrier(bar);
    run_phase<2>(p);  xcd_barrier(bar);
#if PROBE_DUP == 100
    run_phase<3>(p);  xcd_barrier(bar);
#endif
    run_phase<3>(p);  xcd_barrier(bar);
#if PROBE_DUP == 104
    run_phase<4>(p);  xcd_barrier(bar);
#endif
    run_phase<4>(p);
#if PROBE_DUP == 100
    run_phase<5>(p);  xcd_barrier(bar);
#endif
    run_phase<5>(p);  xcd_barrier(bar);
    run_phase<6>(p);  xcd_barrier(bar);
    run_phase<7>(p);  xcd_barrier(bar);
    run_phase<8>(p);  xcd_barrier(bar);
    run_phase<9>(p);  xcd_barrier(bar);
    run_phase<10>(p); xcd_barrier(bar);
    run_phase<11>(p); xcd_barrier(bar);
    run_phase<12>(p);
    run_phase<13>(p); xcd_barrier(bar);
    run_phase<14>(p); xcd_barrier(bar);
    run_phase<15>(p);
#if PROBE_SPIN
    if (blockIdx.x == 0 && threadIdx.x == 0) {
        const unsigned long long d = PROBE_TS[2] * PROBE_SPIN, t0 = probe_now();
        while (probe_now() - t0 < d) __builtin_amdgcn_s_sleep(8);
    }
#endif
}

static inline size_t al256(size_t x) { return (x + 255) & ~(size_t)255; }
template <int PH> static void launch_phase(const Params& p, int grid, hipStream_t s) {
    static bool attr = false;
    if (!attr) { (void)hipFuncSetAttribute((const void*)k_phase<PH>, hipFuncAttributeMaxDynamicSharedMemorySize, LDS_BYTES); attr = true; }
    k_phase<PH><<<grid, 512, LDS_BYTES, s>>>(p);
}
template <int PH> static void launch_all(const Params& p, int grid, hipStream_t s) {
    launch_phase<PH>(p, grid, s);
    if constexpr (PH + 1 < NPHASE) launch_all<PH + 1>(p, grid, s);
}

extern "C" void kernel_launch(void* const* d_in, const int* in_sizes, int n_in, void* d_out, int out_size, void* d_ws, size_t ws_size, hipStream_t stream) {
    Params p{};
    p.x_prompt = (const float*)d_in[0]; p.x_sample = (const float*)d_in[1]; p.cache_cmp = (const float*)d_in[2]; p.cache_slc = (const float*)d_in[3];
    p.state_win = (const float*)d_in[4]; p.page_table = (const int*)d_in[5]; p.p_prompt = (const float*)d_in[6]; p.p_sample = (const float*)d_in[7];
    p.rel_bias = (const float*)d_in[8]; p.ln_mix_pre = (const float*)d_in[9]; p.w_in = (const float*)d_in[10];
    p.pe_k = (const float*)d_in[11]; p.w1_k = (const float*)d_in[12]; p.w2_k = (const float*)d_in[13];
    p.pe_v = (const float*)d_in[14]; p.w1_v = (const float*)d_in[15]; p.w2_v = (const float*)d_in[16];
    p.gm_ln_g = (const float*)d_in[17]; p.gm_ln_b = (const float*)d_in[18]; p.gm_ws = (const float*)d_in[19]; p.gm_bs = (const float*)d_in[20];
    p.w_br_nsa = (const float*)d_in[21]; p.w_br_gm = (const float*)d_in[22]; p.w_out = (const float*)d_in[23];
    p.ln_mix_post = (const float*)d_in[24]; p.ln_ffn_pre = (const float*)d_in[25]; p.w_gate = (const float*)d_in[26]; p.w_up = (const float*)d_in[27];
    p.w_down = (const float*)d_in[28]; p.ln_ffn_post = (const float*)d_in[29]; p.w_ple = (const float*)d_in[30]; p.w_ple_gate = (const float*)d_in[31];
    p.ln_ple_post = (const float*)d_in[32];
    p.out = (float*)d_out;
    unsigned char* w = (unsigned char*)d_ws; size_t off = 0;
    auto take = [&](size_t bytes) { void* r = w + off; off = al256(off + bytes); return r; };
    p.bar = (unsigned*)take(16384);
    p.WinT = (bf16_t*)take((size_t)INP * DM * 2); p.WnT = (bf16_t*)take((size_t)DM * QD * 2); p.WgT = (bf16_t*)take((size_t)DM * GMD * 2);
    p.WoT = (bf16_t*)take((size_t)DM * DM * 2); p.WguT = (bf16_t*)take((size_t)2 * DFF * DM * 2); p.WdT = (bf16_t*)take((size_t)DM * DFF * 2);
    p.WpgT = (bf16_t*)take((size_t)DM * DM * 2); p.WpT = (bf16_t*)take((size_t)DM * PLE * 2); p.W1T = (bf16_t*)take((size_t)2 * 256 * 1024 * 2);
    p.H = (bf16_t*)take((size_t)MALL * DM * 2); p.Qb = (bf16_t*)take((size_t)MALL * QD * 2);
    p.CMPb = (bf16_t*)take(((size_t)MP + (size_t)NS * PAST) * 256 * 2); p.SLCb = (bf16_t*)take((size_t)MALL * 256 * 2); p.WINb = (bf16_t*)take((size_t)MALL * 256 * 2);
    p.U = (bf16_t*)take((size_t)MALL * GMD * 2); p.Vg = (bf16_t*)take((size_t)MALL * GMD * 2);
    p.GA = (bf16_t*)take((size_t)MALL * DM * 2); p.GB = (bf16_t*)take((size_t)MALL * DM * 2);
    p.GATE = (float*)take((size_t)MALL * 32 * 4);
    p.PART = (float*)take((size_t)(2048 + NS * 1024) * 4 * 256 * 4); p.PEB = (float*)take(256 * 4);
    p.KCP = (float*)take((size_t)NB * NG * 512 * 64 * 4); p.VCP = (float*)take((size_t)NB * NG * 512 * 64 * 4);
    p.KCS = (float*)take((size_t)NS * NG * 1024 * 64 * 4); p.VCS = (float*)take((size_t)NS * NG * 1024 * 64 * 4); p.KN = (float*)take(NB * NG * 128 * 4);
    p.KCb = (bf16_t*)take((size_t)NB * NG * 512 * 64 * 2); p.VCT = (bf16_t*)take((size_t)NB * NG * 64 * 512 * 2);
    p.SLCvT = (bf16_t*)take((size_t)NB * NG * 64 * SEQ * 2); p.WINvT = (bf16_t*)take((size_t)NB * NG * 64 * SEQ * 2);
    p.GWb = (bf16_t*)take(4 * 128 * 128 * 2); p.W2T = (bf16_t*)take(2 * 64 * 128 * 2);
    p.SLCkF = (bf16_t*)take((size_t)NB * NG * 64 * SEQ * 2); p.WINkF = (bf16_t*)take((size_t)NB * NG * 64 * SEQ * 2);
    p.OCAT = (bf16_t*)take((size_t)MALL * DM * 2); p.T = (float*)take((size_t)MALL * DM * 4); p.Y1 = (bf16_t*)take((size_t)MALL * DM * 2);
    p.F = (float*)take((size_t)MALL * DM * 4); p.X1 = (float*)take((size_t)MALL * DM * 4); p.H2 = (bf16_t*)take((size_t)MALL * DM * 2);
    p.ACT = (bf16_t*)take((size_t)MALL * DFF * 2); p.X2 = (float*)take((size_t)MALL * DM * 4); p.X2b = (bf16_t*)take((size_t)MALL * DM * 2);
    p.Pb = (bf16_t*)take((size_t)MALL * PLE * 2);
    if (off > ws_size) { fprintf(stderr, "workspace too small: need %zu have %zu\n", off, ws_size); return; }
    (void)hipMemsetAsync(p.OCAT + (size_t)(MP + NS) * DM, 0, (size_t)(MALL - MP - NS) * DM * 2, stream);
#if MK_MULTI
    launch_all<0>(p, 256, stream);
#else
    constexpr size_t kDynLds = LDS_BYTES + 48;
    static int grid = 0;
    if (!grid) {
        int dev = 0, cus = 0, per_cu = 0;
        (void)hipGetDevice(&dev);
        (void)hipDeviceGetAttribute(&cus, hipDeviceAttributeMultiprocessorCount, dev);
        (void)hipFuncSetAttribute((const void*)k_all, hipFuncAttributeMaxDynamicSharedMemorySize, (int)kDynLds);
        (void)hipOccupancyMaxActiveBlocksPerMultiprocessor(&per_cu, (const void*)k_all, 512, kDynLds);
        grid = cus * (per_cu < 1 ? per_cu : 1);
        if (grid <= 0) { fprintf(stderr, "k_all: occupancy query says %d blocks per CU\n", per_cu); grid = 0; return; }
    }
    (void)hipMemsetAsync(p.bar, 0, XCD_BAR_WORDS * sizeof(unsigned), stream);
    k_all<<<grid, 512, kDynLds, stream>>>(p);
#endif
}
```

```cpp
#include <hip/hip_runtime.h>
#include <stdint.h>
#include <cstdio>

typedef unsigned short bf16_t;
typedef short bf16x8 __attribute__((ext_vector_type(8)));
typedef float f32x4 __attribute__((ext_vector_type(4)));
typedef float f32x2 __attribute__((ext_vector_type(2)));
typedef unsigned u32x4 __attribute__((ext_vector_type(4)));
typedef unsigned u32x2 __attribute__((ext_vector_type(2)));
#define LAS __attribute__((address_space(3)))

constexpr int DM = 1024, NB = 4, SEQ = 8192, MP = NB * SEQ, NS = 32, MALL = MP + 256, PAST = 16384, PAGE = 128, NPG = 128;
constexpr int NH = 8, NG = 2, HPG = 4, DH = 64, QD = 512, WIN = 512, GMD = 512, DFF = 2816, PLE = 256, IND = 4376, INP = 4608;
constexpr int NCP = 511, NCS = 1023;
constexpr float EPS = 1e-6f;
constexpr float LOG2E = 1.4426950408889634f, QSCALE = 0.125f * LOG2E;
constexpr long O_YP = 0, O_YS = 33554432, O_CMPP = 33587200, O_SLCP = 41975808, O_WINP = 50364416, O_CMPS = 50888704,
               O_SLCS = 50896896, O_WINS = 50905088, O_GMV = 55099392;

struct Params {
    const float *x_prompt, *x_sample, *cache_cmp, *cache_slc, *state_win; const int* page_table;
    const float *p_prompt, *p_sample, *rel_bias, *ln_mix_pre, *w_in, *pe_k, *w1_k, *w2_k, *pe_v, *w1_v, *w2_v;
    const float *gm_ln_g, *gm_ln_b, *gm_ws, *gm_bs, *w_br_nsa, *w_br_gm, *w_out, *ln_mix_post, *ln_ffn_pre;
    const float *w_gate, *w_up, *w_down, *ln_ffn_post, *w_ple, *w_ple_gate, *ln_ple_post;
    float* out;
    unsigned* bar;
    bf16_t *WinT, *WnT, *WgT, *WoT, *WguT, *WdT, *WpgT, *WpT, *W1T;
    bf16_t *H, *Qb, *CMPb, *SLCb, *WINb, *U, *Vg, *GA, *GB;
    float* GATE;
    float *PART, *PEB, *KCP, *VCP, *KCS, *VCS, *KN;
    bf16_t *KCb, *VCT, *SLCvT, *WINvT, *SLCkF, *WINkF, *GWb, *W2T;
    bf16_t* OCAT; float* T; bf16_t* Y1; float* F; float* X1; bf16_t* H2; bf16_t* ACT; float* X2; bf16_t* X2b; bf16_t* Pb;
};

__device__ __forceinline__ unsigned cvt_pk_bf16(float lo, float hi) { unsigned r; asm volatile("v_cvt_pk_bf16_f32 %0, %1, %2" : "=v"(r) : "v"(lo), "v"(hi)); return r; }
__device__ __forceinline__ bf16_t f2bf(float f) { return (bf16_t)(cvt_pk_bf16(f, 0.f) & 0xffffu); }
__device__ __forceinline__ float bf2f(bf16_t h) { return __uint_as_float(((unsigned)h) << 16); }
__device__ __forceinline__ float bflo(unsigned w) { return __uint_as_float(w << 16); }
__device__ __forceinline__ float bfhi(unsigned w) { return __uint_as_float(w & 0xffff0000u); }
__device__ __forceinline__ float ex2(float x) { return __builtin_amdgcn_exp2f(x); }
__device__ __forceinline__ float sigmoidf_(float x) { return 1.0f / (1.0f + __expf(-x)); }
__device__ __forceinline__ float siluf_(float x) { return x * sigmoidf_(x); }
__device__ __forceinline__ float geluf_(float x) {
    const float u = 0.7978845608028654f * (x + 0.044715f * x * x * x);
    const float e = __expf(2.0f * u);
    const float th = 1.0f - 2.0f / (e + 1.0f);
    return 0.5f * x * (1.0f + th);
}
__device__ __forceinline__ float wave_sum(float v) {
#pragma unroll
    for (int o = 32; o > 0; o >>= 1) v += __shfl_xor(v, o);
    return v;
}
__device__ __forceinline__ float wave_max(float v) {
#pragma unroll
    for (int o = 32; o > 0; o >>= 1) v = fmaxf(v, __shfl_xor(v, o));
    return v;
}
__device__ __forceinline__ int t5_bucket(int d) {
    if (d < 16) return d;
    if (d >= 128) return 31;
    const int b = 16 + (int)(__logf((float)d * (1.0f / 16.0f)) * (16.0f / 2.0794415416798357f));
    return b < 31 ? b : 31;
}

extern __shared__ __attribute__((aligned(16))) unsigned char smem[];
#ifndef PROBE_DUP
#define PROBE_DUP 0
#endif
#define PROBE_LDS_OFF 131072
#ifndef PROBE_SPIN
#define PROBE_SPIN 0
#endif
#ifndef PROBE_SEG
#define PROBE_SEG 5
#endif
__device__ __forceinline__ unsigned long long probe_now() { unsigned long long t; asm volatile("s_memrealtime %0\n\ts_waitcnt lgkmcnt(0)" : "=s"(t) :: "memory"); return t; }
#define PROBE_TS ((volatile LAS unsigned long long*)((LAS unsigned char*)smem + PROBE_LDS_OFF + 16))
#if PROBE_SPIN
#define PROBE_BEGIN(seg) unsigned long long pb_##seg = 0; if (PROBE_SEG == seg && threadIdx.x == 0) pb_##seg = probe_now();
#define PROBE_END(seg) if (PROBE_SEG == seg && threadIdx.x == 0) { PROBE_TS[2] = PROBE_TS[2] + (probe_now() - pb_##seg); }
#else
#define PROBE_BEGIN(seg)
#define PROBE_END(seg)
#endif

constexpr int BM = 256, BK = 64, HALF = 128, HT = HALF * BK, GEMM_LDS = 8 * HT * 2;
__device__ __forceinline__ int lds_byte(int r, int c) { const int st = (r >> 4) * 2 + (c >> 5), rr = r & 15, cc = c & 31, ob = rr * 64 + cc * 2; return st * 1024 + (ob ^ (((ob >> 9) & 1) << 5)); }
__device__ __forceinline__ void stage_rc(int b, int& R, int& C) { const int st = b / 1024, sb = b % 1024, swz = sb ^ (((sb >> 9) & 1) << 5); R = (st >> 1) * 16 + swz / 64; C = (st & 1) * 32 + (swz % 64) / 2; }

constexpr int HTB = HALF * BK * 2;
template <class F>
__device__ __forceinline__ void for_each_frag(const f32x4 (&acc)[2][2][4][2], int brow, int bcol, int wr, int wc, int fr, int fq, F&& f) {
#pragma unroll
    for (int ai = 0; ai < 2; ++ai)
#pragma unroll
        for (int m = 0; m < 4; ++m)
#pragma unroll
            for (int bj = 0; bj < 2; ++bj)
#pragma unroll
                for (int n = 0; n < 2; ++n)
                    f(brow + ai * HALF + wr * 64 + m * 16 + fr, bcol + bj * HALF + wc * 32 + n * 16 + fq * 4, acc[ai][bj][m][n]);
}

struct ZNone { __device__ __forceinline__ size_t a(int) const { return 0; } __device__ __forceinline__ size_t b(int) const { return 0; } };
template <class Epi, class ZMap = ZNone, bool HAS_MID = false>
__device__ __forceinline__ void gemm_phase(const bf16_t* A, int lda, const bf16_t* Bt, int K, int nM, int nN, const Epi& E, int nZ = 1, ZMap zm = ZMap(), int kstepA_el = BK) {
    LAS unsigned char* lds = (LAS unsigned char*)smem;
    int tid = threadIdx.x; asm volatile("" : "+v"(tid));
    const int wid = __builtin_amdgcn_readfirstlane(tid >> 6), lane = tid & 63, wr = wid >> 2, wc = wid & 3, fr = lane & 15, fq = lane >> 4;
    const int nt = K / BK, nmn = nM * nN, nu = nmn * nZ, G = gridDim.x;
    int u = blockIdx.x;
    if (u >= nu) return;
    unsigned voffA[2], voffB[2];
#pragma unroll
    for (int i = 0; i < 2; ++i) { int R, C; stage_rc(tid * 16 + i * 8192, R, C); voffA[i] = (unsigned)(R * lda + C) * 2u; voffB[i] = (unsigned)(R * K + C) * 2u; }
    const size_t kstep = (size_t)(BK * 2), kstepA = (size_t)kstepA_el * 2;
    const size_t hstepA = (size_t)HALF * lda * 2, hstepB = (size_t)HALF * K * 2, tstepA = 2 * hstepA, tstepB = 2 * hstepB;
    const unsigned ldsw = (unsigned)wid * 1024u;
    const int aoff = lds_byte(wr * 64 + fr, fq * 8), boff = lds_byte(wc * 32 + fr, fq * 8);
#define PG8_SA(b, h) (((b) * 2 + (h)) * HTB)
#define PG8_SB(b, h) ((4 + (b) * 2 + (h)) * HTB)
#define PG8_STAGE(bufoff, gbase, voff) do { _Pragma("unroll") for (int _i = 0; _i < 2; ++_i) \
        __builtin_amdgcn_global_load_lds((const unsigned*)((const char*)(gbase) + (voff)[_i]), (LAS unsigned*)(lds + (bufoff) + ldsw + _i * 8192), 16, 0, 0); } while (0)
#define PG8_LDA(dst, b, h) do { _Pragma("unroll") for (int m = 0; m < 4; ++m) _Pragma("unroll") for (int k = 0; k < 2; ++k) dst[m][k] = *(const LAS bf16x8*)(lds + PG8_SA(b, h) + aoff + m * 2048 + k * 1024); } while (0)
#define PG8_LDB(dst, b, h) do { _Pragma("unroll") for (int n = 0; n < 2; ++n) _Pragma("unroll") for (int k = 0; k < 2; ++k) dst[n][k] = *(const LAS bf16x8*)(lds + PG8_SB(b, h) + boff + n * 2048 + k * 1024); } while (0)
#define PG8_MMA(ai, bj, At, Bt_) do { __builtin_amdgcn_s_setprio(1); _Pragma("unroll") for (int m = 0; m < 4; ++m) _Pragma("unroll") for (int n = 0; n < 2; ++n) _Pragma("unroll") for (int k = 0; k < 2; ++k) \
        acc[ai][bj][m][n] = __builtin_amdgcn_mfma_f32_16x16x32_bf16(Bt_[n][k], At[m][k], acc[ai][bj][m][n], 0, 0, 0); __builtin_amdgcn_s_setprio(0); } while (0)
#define PG8_WAIT_V(n) asm volatile("s_waitcnt vmcnt(" #n ")" ::: "memory")
#define PG8_WAIT_L(n) asm volatile("s_waitcnt lgkmcnt(" #n ")" ::: "memory")
#define PG8_BAR __builtin_amdgcn_s_barrier()
#define PG8_SCHED __builtin_amdgcn_sched_barrier(0)
    f32x4 acc[2][2][4][2];
#pragma unroll
    for (int a = 0; a < 2; ++a)
#pragma unroll
        for (int b = 0; b < 2; ++b)
#pragma unroll
            for (int m = 0; m < 4; ++m)
#pragma unroll
                for (int n = 0; n < 2; ++n) acc[a][b][m][n] = (f32x4){0.f, 0.f, 0.f, 0.f};
    bf16x8 At[4][2], B0[2][2], B1[2][2];
    auto unit_of = [&](int uu, int& z_, int& pm_, int& pn_) {
        if (nZ == 1) {
            int wg = uu; { const int q = nu / 8, r = nu % 8, xcd = wg % 8, off = wg / 8; wg = (xcd < r ? xcd * (q + 1) : r * (q + 1) + (xcd - r) * q) + off; }
            const int nig = 8 * nN, gid = wg / nig, fm = gid * 8, gsz = (nM - fm) < 8 ? (nM - fm) : 8;
            z_ = 0; pm_ = fm + ((wg % nig) % gsz); pn_ = (wg % nig) / gsz;
        } else { z_ = uu / nmn; pm_ = (uu - z_ * nmn) / nN; pn_ = (uu - z_ * nmn) - pm_ * nN; }
    };
    int z, pm, pn; unit_of(u, z, pm, pn);
    const char* cA = (const char*)(A + zm.a(z)) + (size_t)pm * tstepA; const char* cB = (const char*)(Bt + zm.b(z)) + (size_t)pn * tstepB;
    PG8_STAGE(PG8_SB(0, 0), cB, voffB); PG8_STAGE(PG8_SA(0, 0), cA, voffA); PG8_STAGE(PG8_SB(0, 1), cB + hstepB, voffB); PG8_STAGE(PG8_SA(0, 1), cA + hstepA, voffA);
    if (wr == 1) PG8_BAR;
    PG8_WAIT_V(4); PG8_BAR;
    PG8_STAGE(PG8_SB(1, 0), cB + kstep, voffB); PG8_STAGE(PG8_SA(1, 0), cA + kstepA, voffA); PG8_STAGE(PG8_SB(1, 1), cB + hstepB + kstep, voffB);
    PG8_WAIT_V(6); PG8_BAR;
    for (;;) {
        const int un = u + G; const bool has_next = un < nu;
        int nz = z, npm = pm, npn = pn; if (has_next) unit_of(un, nz, npm, npn);
        const char* nA = (const char*)(A + zm.a(nz)) + (size_t)npm * tstepA; const char* nB = (const char*)(Bt + zm.b(nz)) + (size_t)npn * tstepB;
        auto kiter = [&](int t) {
            const bool last = (t == nt - 2);
            const char* a1 = cA + (size_t)(t + 1) * kstepA;
            const char* a2 = last ? nA : cA + (size_t)(t + 2) * kstepA; const char* b2 = last ? nB : cB + (size_t)(t + 2) * kstep;
            const char* a3 = a2 + kstepA; const char* b3 = b2 + kstep;
            PG8_LDB(B0, 0, 0); PG8_SCHED; PG8_LDA(At, 0, 0); PG8_STAGE(PG8_SA(1, 1), a1 + hstepA, voffA);
            PG8_WAIT_L(8); PG8_BAR; PG8_WAIT_L(0); PG8_MMA(0, 0, At, B0); PG8_BAR; PG8_SCHED;
            PG8_LDB(B1, 0, 1); PG8_STAGE(PG8_SB(0, 0), b2, voffB);
            PG8_BAR; PG8_WAIT_L(0); PG8_MMA(0, 1, At, B1); PG8_BAR;
            PG8_LDA(At, 0, 1); PG8_STAGE(PG8_SA(0, 0), a2, voffA);
            PG8_BAR; PG8_WAIT_L(0); PG8_MMA(1, 0, At, B0); PG8_BAR; PG8_SCHED;
            PG8_STAGE(PG8_SB(0, 1), b2 + hstepB, voffB);
            PG8_WAIT_V(6); PG8_BAR; PG8_MMA(1, 1, At, B1); PG8_BAR;
            PG8_LDB(B0, 1, 0); PG8_SCHED; PG8_LDA(At, 1, 0); PG8_STAGE(PG8_SA(0, 1), a2 + hstepA, voffA);
            PG8_WAIT_L(8); PG8_BAR; PG8_WAIT_L(0); PG8_MMA(0, 0, At, B0); PG8_BAR; PG8_SCHED;
            PG8_LDB(B1, 1, 1); PG8_STAGE(PG8_SB(1, 0), b3, voffB);
            PG8_BAR; PG8_WAIT_L(0); PG8_MMA(0, 1, At, B1); PG8_BAR;
            PG8_LDA(At, 1, 1); PG8_STAGE(PG8_SA(1, 0), a3, voffA);
            PG8_BAR; PG8_WAIT_L(0); PG8_MMA(1, 0, At, B0); PG8_BAR; PG8_SCHED;
            PG8_STAGE(PG8_SB(1, 1), b3 + hstepB, voffB);
            PG8_WAIT_V(6); PG8_BAR; PG8_MMA(1, 1, At, B1); PG8_BAR;
        };
        if constexpr (HAS_MID) {
            for (int t = 0; t < (nt >> 1); t += 2) kiter(t);
            E.mid(acc, pm * BM, pn * BM, wr, wc, fr, fq);
            for (int t = nt >> 1; t < nt; t += 2) kiter(t);
        } else {
            for (int t = 0; t < nt; t += 2) kiter(t);
        }
        E(acc, pm * BM, pn * BM + (z << 20), wr, wc, fr, fq);
        if (!has_next) break;
#pragma unroll
        for (int a = 0; a < 2; ++a)
#pragma unroll
            for (int b = 0; b < 2; ++b)
#pragma unroll
                for (int m = 0; m < 4; ++m)
#pragma unroll
                    for (int n = 0; n < 2; ++n) acc[a][b][m][n] = (f32x4){0.f, 0.f, 0.f, 0.f};
        u = un; z = nz; pm = npm; pn = npn; cA = nA; cB = nB;
    }
    PG8_WAIT_V(0);
    if (wr == 0) PG8_BAR;
    PG8_BAR;
#undef PG8_SA
#undef PG8_SB
#undef PG8_STAGE
#undef PG8_LDA
#undef PG8_LDB
#undef PG8_MMA
#undef PG8_WAIT_V
#undef PG8_WAIT_L
#undef PG8_BAR
#undef PG8_SCHED
}

__device__ __forceinline__ f32x4 mfma16(bf16x8 a, bf16x8 b, f32x4 c) { return __builtin_amdgcn_mfma_f32_16x16x32_bf16(a, b, c, 0, 0, 0); }
__device__ __forceinline__ bf16x8 pack_p(const f32x4& a, const f32x4& b) {
    u32x4 w; w.x = cvt_pk_bf16(a[0], a[1]); w.y = cvt_pk_bf16(a[2], a[3]); w.z = cvt_pk_bf16(b[0], b[1]); w.w = cvt_pk_bf16(b[2], b[3]);
    return __builtin_bit_cast(bf16x8, w);
}
__device__ __forceinline__ size_t kfrag_off(int key, int d) { return ((size_t)((key >> 4) * 2 + (d >> 5)) * 64 + ((d >> 3) & 3) * 16 + (key & 15)) * 8 + (d & 7); }
__device__ __forceinline__ size_t vfrag_off(int key, int d) {
    return ((size_t)((key >> 5) * 4 + (d >> 4)) * 64 + ((key >> 2) & 3) * 16 + (d & 15)) * 8 + ((key >> 4) & 1) * 4 + (key & 3);
}
__device__ __forceinline__ void st_bf16x4(bf16_t* p, f32x4 v) { u32x2 w; w.x = cvt_pk_bf16(v[0], v[1]); w.y = cvt_pk_bf16(v[2], v[3]); *(u32x2*)p = w; }

struct EpiIn {
    const Params& p;
    __device__ __forceinline__ void apply(int row, int col, f32x4 v) const {
        const Params& P = p; const int pn = col >> 8, c = col & 255;
        if (pn < 2) st_bf16x4(P.Qb + (size_t)row * QD + col, v * QSCALE);
        else if (pn < 5) {
            if (pn != 2) st_bf16x4((pn == 3 ? P.SLCb : P.WINb) + (size_t)row * 256 + c, v);
            if (pn < 4) *(f32x4*)(P.out + (pn == 2 ? O_CMPS : O_SLCS) + (size_t)(row - MP) * 256 + c) = v;
            else *(f32x4*)(P.out + O_WINS + ((size_t)(row - MP) * WIN + (WIN - 1)) * 256 + c) = v;
        } else if (pn < 9) {
            f32x4 g; g[0] = geluf_(v[0]); g[1] = geluf_(v[1]); g[2] = geluf_(v[2]); g[3] = geluf_(v[3]);
            st_bf16x4((pn < 7 ? P.U : P.Vg) + (size_t)row * GMD + (col - (pn < 7 ? 1280 : 1792)), g);
        } else if (pn < 17) {
            f32x4 g; g[0] = sigmoidf_(v[0]); g[1] = sigmoidf_(v[1]); g[2] = sigmoidf_(v[2]); g[3] = sigmoidf_(v[3]);
            st_bf16x4((pn < 13 ? P.GA : P.GB) + (size_t)row * DM + (col - (pn < 13 ? 2304 : 3328)), g);
        } else if (c < 24) { f32x4 g; g[0] = sigmoidf_(v[0]); g[1] = sigmoidf_(v[1]); g[2] = sigmoidf_(v[2]); g[3] = sigmoidf_(v[3]); *(f32x4*)(P.GATE + (size_t)row * 32 + c) = g; }
    }
    __device__ __forceinline__ void operator()(const f32x4 (&acc)[2][2][4][2], int brow, int bcol, int wr, int wc, int fr, int fq) const {
        const int pn = bcol >> 8;
        const Params& P = p;
        if (pn < 2) {
            for_each_frag(acc, brow, bcol, wr, wc, fr, fq, [&](int row, int col, f32x4 v) { st_bf16x4(P.Qb + (size_t)row * QD + col, v * QSCALE); });
        } else if (pn < 5) {
            bf16_t* cp = pn == 2 ? P.CMPb : pn == 3 ? P.SLCb : P.WINb;
            for_each_frag(acc, brow, bcol, wr, wc, fr, fq, [&](int row, int col, f32x4 v) {
                const int c = col & 255;
                if (pn == 2) st_bf16x4(cp + (size_t)row * 256 + c, v);
                if (pn >= 3 && c < 128 && row < MP) {
                    st_bf16x4((pn == 3 ? P.SLCkF : P.WINkF) + ((size_t)(row >> 13) * NG + (c >> 6)) * SEQ * 64 + kfrag_off(row & (SEQ - 1), c & 63), v);
                }
                if (pn >= 3 && c >= 128 && row < MP) {
                    const int t = row & (SEQ - 1), dc = c - 128;
                    bf16_t* vt = (pn == 3 ? P.SLCvT : P.WINvT) + ((size_t)(row >> 13) * NG + (dc >> 6)) * SEQ * 64 + vfrag_off(t, dc & 63);
                    vt[0] = f2bf(v[0]); vt[8] = f2bf(v[1]); vt[16] = f2bf(v[2]); vt[24] = f2bf(v[3]);
                }
                if (pn < 4) {
                    if (row < MP) *(f32x4*)(P.out + (pn == 2 ? O_CMPP : O_SLCP) + (size_t)row * 256 + c) = v;
                    else if (row < MP + NS) *(f32x4*)(P.out + (pn == 2 ? O_CMPS : O_SLCS) + (size_t)(row - MP) * 256 + c) = v;
                } else {
                    if (row < MP) { const int t = row & (SEQ - 1), b = row >> 13; if (t >= SEQ - WIN) *(f32x4*)(P.out + O_WINP + ((size_t)b * WIN + (t - (SEQ - WIN))) * 256 + c) = v; }
                    else if (row < MP + NS) *(f32x4*)(P.out + O_WINS + ((size_t)(row - MP) * WIN + (WIN - 1)) * 256 + c) = v;
                }
            });
        } else if (pn < 9) {
            bf16_t* dst = pn < 7 ? P.U : P.Vg; const int c0 = pn < 7 ? 1280 : 1792;
            for_each_frag(acc, brow, bcol, wr, wc, fr, fq, [&](int row, int col, f32x4 v) {
                f32x4 g; g[0] = geluf_(v[0]); g[1] = geluf_(v[1]); g[2] = geluf_(v[2]); g[3] = geluf_(v[3]);
                st_bf16x4(dst + (size_t)row * GMD + (col - c0), g); });
        } else if (pn < 17) {
            bf16_t* dst = pn < 13 ? P.GA : P.GB; const int c0 = pn < 13 ? 2304 : 3328;
            for_each_frag(acc, brow, bcol, wr, wc, fr, fq, [&](int row, int col, f32x4 v) {
                f32x4 g; g[0] = sigmoidf_(v[0]); g[1] = sigmoidf_(v[1]); g[2] = sigmoidf_(v[2]); g[3] = sigmoidf_(v[3]);
                st_bf16x4(dst + (size_t)row * DM + (col - c0), g); });
        } else {
            for_each_frag(acc, brow, bcol, wr, wc, fr, fq, [&](int row, int col, f32x4 v) {
                const int c = col & 255;
                if (c < 24) { f32x4 g; g[0] = sigmoidf_(v[0]); g[1] = sigmoidf_(v[1]); g[2] = sigmoidf_(v[2]); g[3] = sigmoidf_(v[3]); *(f32x4*)(P.GATE + (size_t)row * 32 + c) = g; } });
        }
    }
};
struct EpiBranch {
    const bf16_t* GA; const bf16_t* GB; bf16_t* Y1;
    __device__ __forceinline__ void mid(f32x4 (&acc)[2][2][4][2], int brow, int bcol, int wr, int wc, int fr, int fq) const {
#pragma unroll
        for (int ai = 0; ai < 2; ++ai)
#pragma unroll
            for (int m = 0; m < 4; ++m)
#pragma unroll
                for (int bj = 0; bj < 2; ++bj)
#pragma unroll
                    for (int n = 0; n < 2; ++n) {
                        const size_t o = (size_t)(brow + ai * HALF + wr * 64 + m * 16 + fr) * DM + bcol + bj * HALF + wc * 32 + n * 16 + fq * 4;
                        const u32x2 a = *(const u32x2*)(GA + o), b = *(const u32x2*)(GB + o);
                        f32x4& v = acc[ai][bj][m][n];
                        v[0] *= bflo(a.x) / fmaxf(bflo(b.x), 1e-30f); v[1] *= bfhi(a.x) / fmaxf(bfhi(b.x), 1e-30f);
                        v[2] *= bflo(a.y) / fmaxf(bflo(b.y), 1e-30f); v[3] *= bfhi(a.y) / fmaxf(bfhi(b.y), 1e-30f);
                        if (bj == 1 && n == 1) __builtin_amdgcn_sched_barrier(0);
                    }
    }
    __device__ __forceinline__ void operator()(const f32x4 (&acc)[2][2][4][2], int brow, int bcol, int wr, int wc, int fr, int fq) const {
        for_each_frag(acc, brow, bcol, wr, wc, fr, fq, [&](int row, int col, f32x4 v) {
            const u32x2 b = *(const u32x2*)(GB + (size_t)row * DM + col);
            f32x4 o; o[0] = v[0] * fmaxf(bflo(b.x), 1e-30f); o[1] = v[1] * fmaxf(bfhi(b.x), 1e-30f); o[2] = v[2] * fmaxf(bflo(b.y), 1e-30f); o[3] = v[3] * fmaxf(bfhi(b.y), 1e-30f);
            st_bf16x4(Y1 + (size_t)row * DM + col, o); });
    }
    __device__ __forceinline__ void apply2(int row, int col, f32x4 v1, f32x4 v2) const {
        const u32x2 a = *(const u32x2*)(GA + (size_t)row * DM + col), b = *(const u32x2*)(GB + (size_t)row * DM + col);
        f32x4 o; o[0] = v1[0] * bflo(a.x) + v2[0] * bflo(b.x); o[1] = v1[1] * bfhi(a.x) + v2[1] * bfhi(b.x); o[2] = v1[2] * bflo(a.y) + v2[2] * bflo(b.y); o[3] = v1[3] * bfhi(a.y) + v2[3] * bfhi(b.y);
        st_bf16x4(Y1 + (size_t)row * DM + col, o);
    }
};
struct EpiF32 {
    float* F; int ld;
    __device__ __forceinline__ void apply(int row, int col, f32x4 v) const { *(f32x4*)(F + (size_t)row * ld + col) = v; }
    __device__ __forceinline__ void operator()(const f32x4 (&acc)[2][2][4][2], int brow, int bcol, int wr, int wc, int fr, int fq) const {
        for_each_frag(acc, brow, bcol, wr, wc, fr, fq, [&](int row, int col, f32x4 v) { *(f32x4*)(F + (size_t)row * ld + col) = v; });
    }
};
struct EpiBf16 {
    bf16_t* O; int ld;
    __device__ __forceinline__ void apply(int row, int col, f32x4 v) const { st_bf16x4(O + (size_t)row * ld + col, v); }
    __device__ __forceinline__ void operator()(const f32x4 (&acc)[2][2][4][2], int brow, int bcol, int wr, int wc, int fr, int fq) const {
        for_each_frag(acc, brow, bcol, wr, wc, fr, fq, [&](int row, int col, f32x4 v) { apply(row, col, v); });
    }
};
struct EpiPart {
    float* PART;
    __device__ __forceinline__ void operator()(const f32x4 (&acc)[2][2][4][2], int brow, int bcol, int wr, int wc, int fr, int fq) const {
        const int z = bcol >> 20;
        for_each_frag(acc, brow, 0, wr, wc, fr, fq, [&](int row, int col, f32x4 v) { *(f32x4*)(PART + ((size_t)row * 4 + z) * 256 + col) = v; });
    }
};
struct ZCmp { __device__ __forceinline__ size_t a(int z) const { return (size_t)z * 64; } __device__ __forceinline__ size_t b(int z) const { return (size_t)(z >> 1) * 256 * 1024; } };
struct EpiSwiGLU {
    bf16_t* ACT;
    __device__ __forceinline__ void apply(int row, int col, f32x4 v) const { *(unsigned*)(ACT + (size_t)row * DFF + (col >> 1)) = cvt_pk_bf16(siluf_(v[0]) * v[1], siluf_(v[2]) * v[3]); }
    __device__ __forceinline__ void operator()(const f32x4 (&acc)[2][2][4][2], int brow, int bcol, int wr, int wc, int fr, int fq) const {
        for_each_frag(acc, brow, bcol, wr, wc, fr, fq, [&](int row, int col, f32x4 v) {
            *(unsigned*)(ACT + (size_t)row * DFF + (col >> 1)) = cvt_pk_bf16(siluf_(v[0]) * v[1], siluf_(v[2]) * v[3]); });
    }
};
struct EpiPleGate {
    const bf16_t* E; bf16_t* F;
    __device__ __forceinline__ void apply(int row, int col, f32x4 v) const {
        const u32x2 w = *(const u32x2*)(E + (size_t)row * DM + col);
        f32x4 o; o[0] = sigmoidf_(v[0]) * bflo(w.x); o[1] = sigmoidf_(v[1]) * bfhi(w.x); o[2] = sigmoidf_(v[2]) * bflo(w.y); o[3] = sigmoidf_(v[3]) * bfhi(w.y);
        st_bf16x4(F + (size_t)row * DM + col, o); }
    __device__ __forceinline__ void operator()(const f32x4 (&acc)[2][2][4][2], int brow, int bcol, int wr, int wc, int fr, int fq) const {
        for_each_frag(acc, brow, bcol, wr, wc, fr, fq, [&](int row, int col, f32x4 v) { apply(row, col, v); });
    }
};

template <class Epi>
__device__ __forceinline__ void gemm_skinny(const bf16_t* A  , int lda, const bf16_t* Bt, int K, int N, const Epi& E) {
    int tid = threadIdx.x; asm volatile("" : "+v"(tid));
    const int wid = __builtin_amdgcn_readfirstlane(tid >> 6), lane = tid & 63, c = lane & 15, G = lane >> 4;
    LAS f32x4* red = (LAS f32x4*)smem;
    const int nsteps = K / 32;
#pragma unroll 1
    for (int ct = blockIdx.x; ct < N / 16; ct += gridDim.x) {
        f32x4 acc0 = {0.f, 0.f, 0.f, 0.f}, acc1 = {0.f, 0.f, 0.f, 0.f};
        const bf16_t* bp = Bt + (size_t)(ct * 16 + c) * K + G * 8;
        const bf16_t* a0 = A + (size_t)c * lda + G * 8; const bf16_t* a1 = A + (size_t)(16 + c) * lda + G * 8;
#pragma unroll 4
        for (int kk = wid; kk < nsteps; kk += 8) {
            const bf16x8 bf = *(const bf16x8*)(bp + kk * 32), x0 = *(const bf16x8*)(a0 + kk * 32), x1 = *(const bf16x8*)(a1 + kk * 32);
            acc0 = mfma16(bf, x0, acc0); acc1 = mfma16(bf, x1, acc1);
        }
        __syncthreads();
        red[(wid * 2 + 0) * 64 + lane] = acc0; red[(wid * 2 + 1) * 64 + lane] = acc1;
        __syncthreads();
        if (tid < 128) {
            const int rt = tid >> 6;
            f32x4 v = red[rt * 64 + lane];
#pragma unroll
            for (int w = 1; w < 8; ++w) v = v + red[(w * 2 + rt) * 64 + lane];
            E.apply(MP + rt * 16 + c, ct * 16 + 4 * G, v);
        }
    }
    __syncthreads();
}

template <class Epi>
__device__ __forceinline__ void gemm_skinny2(const bf16_t* A  , int lda, const bf16_t* Bt, int K, int N, const Epi& E) {
    int tid = threadIdx.x; asm volatile("" : "+v"(tid));
    const int wid = __builtin_amdgcn_readfirstlane(tid >> 6), lane = tid & 63, c = lane & 15, G = lane >> 4;
    LAS f32x4* red = (LAS f32x4*)smem;
    const int hsteps = K / 64;
#pragma unroll 1
    for (int ct = blockIdx.x; ct < N / 16; ct += gridDim.x) {
        f32x4 acc[4] = {{0.f, 0.f, 0.f, 0.f}, {0.f, 0.f, 0.f, 0.f}, {0.f, 0.f, 0.f, 0.f}, {0.f, 0.f, 0.f, 0.f}};
        const bf16_t* bp = Bt + (size_t)(ct * 16 + c) * K + G * 8;
        const bf16_t* a0 = A + (size_t)c * lda + G * 8; const bf16_t* a1 = A + (size_t)(16 + c) * lda + G * 8;
#pragma unroll
        for (int h = 0; h < 2; ++h) {
#pragma unroll 2
            for (int kk = h * hsteps + wid; kk < (h + 1) * hsteps; kk += 8) {
                const bf16x8 bf = *(const bf16x8*)(bp + kk * 32), x0 = *(const bf16x8*)(a0 + kk * 32), x1 = *(const bf16x8*)(a1 + kk * 32);
                acc[h * 2] = mfma16(bf, x0, acc[h * 2]); acc[h * 2 + 1] = mfma16(bf, x1, acc[h * 2 + 1]);
            }
        }
        __syncthreads();
#pragma unroll
        for (int q = 0; q < 4; ++q) red[(wid * 4 + q) * 64 + lane] = acc[q];
        __syncthreads();
        if (tid < 128) {
            const int rt = tid >> 6;
            f32x4 v1 = red[rt * 64 + lane], v2 = red[(2 + rt) * 64 + lane];
#pragma unroll
            for (int w = 1; w < 8; ++w) { v1 = v1 + red[(w * 4 + rt) * 64 + lane]; v2 = v2 + red[(w * 4 + 2 + rt) * 64 + lane]; }
            E.apply2(MP + rt * 16 + c, ct * 16 + 4 * G, v1, v2);
        }
    }
    __syncthreads();
}

template <class Map>
__device__ __forceinline__ void transpose_tile(const float* W, int K, int N, bf16_t* Wt, int ldk, int kt, int ntile, Map map) {
    LAS float* tile = (LAS float*)smem;
    const int t = threadIdx.x;
    __syncthreads();
#pragma unroll
    for (int i = 0; i < 2; ++i) {
        const int k = (t >> 4) + 32 * i, n = (t & 15) * 4, gn = ntile * 64 + n;
        f32x4 v = (f32x4){0.f, 0.f, 0.f, 0.f};
        if (gn < N) v = *(const f32x4*)(W + (size_t)(kt * 64 + k) * N + gn);
        tile[k * 65 + n] = v[0]; tile[k * 65 + n + 1] = v[1]; tile[k * 65 + n + 2] = v[2]; tile[k * 65 + n + 3] = v[3];
    }
    __syncthreads();
    const int n = t >> 3, kc = (t & 7) * 8, gn = ntile * 64 + n;
    if (gn < N) {
        u32x4 w;
        w.x = cvt_pk_bf16(tile[(kc + 0) * 65 + n], tile[(kc + 1) * 65 + n]); w.y = cvt_pk_bf16(tile[(kc + 2) * 65 + n], tile[(kc + 3) * 65 + n]);
        w.z = cvt_pk_bf16(tile[(kc + 4) * 65 + n], tile[(kc + 5) * 65 + n]); w.w = cvt_pk_bf16(tile[(kc + 6) * 65 + n], tile[(kc + 7) * 65 + n]);
        *(u32x4*)(Wt + (size_t)map(gn) * ldk + kt * 64 + kc) = w;
    }
}
template <class Map>
__device__ __forceinline__ void transpose_all(const float* W, int K, int N, bf16_t* Wt, int ldk, Map map, int& base) {
    const int nkt = K / 64, nnt = (N + 63) / 64, ntl = nkt * nnt;
    for (int it = blockIdx.x; it < base + ntl; it += gridDim.x) {
        if (it < base) continue;
        const int l = it - base;
        transpose_tile(W, K, N, Wt, ldk, l / nnt, l % nnt, map);
    }
    base += ntl;
}
__device__ __forceinline__ int map_win(int n) {
    if (n < 1280) return n;
    if (n < 1304) return 4352 + (n - 1280);
    if (n < 2328) return 1280 + (n - 1304);
    return 2304 + (n - 2328);
}

__device__ __forceinline__ float row_rstd(const f32x4 (&v)[4]) {
    float s = 0.f;
#pragma unroll
    for (int k = 0; k < 4; ++k) s += v[k][0] * v[k][0] + v[k][1] * v[k][1] + v[k][2] * v[k][2] + v[k][3] * v[k][3];
    s = wave_sum(s);
    return rsqrtf(s * (1.0f / DM) + EPS);
}
__device__ __forceinline__ const float* xrow_ptr(const Params& p, int row) {
    return row < MP ? p.x_prompt + (size_t)row * DM : p.x_sample + (size_t)(row - MP) * DM;
}

__device__ void phase_prologue(const Params& p) {
    const int wid = threadIdx.x >> 6, lane = threadIdx.x & 63;
    const int gw = blockIdx.x * 8 + wid, nw = gridDim.x * 8;
    auto do_transposes = [&]() {
    int base = 0;
    transpose_all(p.w_in, DM, IND, p.WinT, DM, [](int n) { return map_win(n); }, base);
    transpose_all(p.w_br_nsa, QD, DM, p.WnT, DM, [](int n) { return n; }, base);
    transpose_all(p.w_br_gm, GMD, DM, p.WnT + QD, DM, [](int n) { return n; }, base);
    transpose_all(p.w_out, DM, DM, p.WoT, DM, [](int n) { return n; }, base);
    transpose_all(p.w_gate, DM, DFF, p.WguT, DM, [](int n) { return 2 * n; }, base);
    transpose_all(p.w_up, DM, DFF, p.WguT, DM, [](int n) { return 2 * n + 1; }, base);
    transpose_all(p.w_down, DFF, DM, p.WdT, DFF, [](int n) { return n; }, base);
    transpose_all(p.w_ple_gate, DM, DM, p.WpgT, DM, [](int n) { return n; }, base);
    transpose_all(p.w_ple, PLE, DM, p.WpT, PLE, [](int n) { return n; }, base);
    for (int kv = 0; kv < 2; ++kv) for (int j = 0; j < 2; ++j)
        transpose_all((kv ? p.w1_v : p.w1_k) + (size_t)j * 1024 * 128, 1024, 128, p.W1T + ((size_t)kv * 256 + j * 128) * 1024, 1024, [](int n) { return n; }, base);
    };
    auto do_gather = [&]() {
#pragma unroll 1
    for (int r8 = gw; r8 < NS * PAST / 8; r8 += nw) {
        const int r = r8 * 8, b = r >> 14, pos = r & (PAST - 1), l5 = lane & 31, hrow = lane >> 5;
        const float* s = p.cache_cmp + ((size_t)p.page_table[b * NPG + (pos >> 7)] * PAGE + (pos & 127) + hrow) * 256 + l5 * 8;
        f32x4 a[4], cc[4];
#pragma unroll
        for (int k = 0; k < 4; ++k) { a[k] = *(const f32x4*)(s + (size_t)k * 512); cc[k] = *(const f32x4*)(s + (size_t)k * 512 + 4); }
#pragma unroll
        for (int k = 0; k < 4; ++k) {
            u32x4 w; w.x = cvt_pk_bf16(a[k][0], a[k][1]); w.y = cvt_pk_bf16(a[k][2], a[k][3]); w.z = cvt_pk_bf16(cc[k][0], cc[k][1]); w.w = cvt_pk_bf16(cc[k][2], cc[k][3]);
            *(u32x4*)(p.CMPb + ((size_t)MP + r + 2 * k + hrow) * 256 + l5 * 8) = w;
        }
    }
    };
    if (blockIdx.x & 1) { do_gather(); do_transposes(); } else { do_transposes(); do_gather(); }
    __syncthreads();
    for (int i = blockIdx.x * 512 + threadIdx.x; i < (INP - IND) * DM / 8; i += gridDim.x * 512) ((u32x4*)(p.WinT + (size_t)IND * DM))[i] = (u32x4){0u, 0u, 0u, 0u};
    for (int row = gw; row < MALL; row += nw) {
        u32x2* hd = (u32x2*)(p.H + (size_t)row * DM);
        if (row < MP + NS) {
            const float* xr = xrow_ptr(p, row);
            f32x4 v[4];
#pragma unroll
            for (int k = 0; k < 4; ++k) v[k] = *(const f32x4*)(xr + lane * 4 + k * 256);
            const float r = row_rstd(v);
#pragma unroll
            for (int k = 0; k < 4; ++k) { const f32x4 g = *(const f32x4*)(p.ln_mix_pre + lane * 4 + k * 256); const f32x4 o = v[k] * r * g; u32x2 w; w.x = cvt_pk_bf16(o[0], o[1]); w.y = cvt_pk_bf16(o[2], o[3]); hd[lane + k * 64] = w; }
            const float* pr = row < MP ? p.p_prompt + (size_t)row * PLE : p.p_sample + (size_t)(row - MP) * PLE;
            const f32x4 pv = *(const f32x4*)(pr + lane * 4);
            u32x2 w; w.x = cvt_pk_bf16(pv[0], pv[1]); w.y = cvt_pk_bf16(pv[2], pv[3]);
            ((u32x2*)(p.Pb + (size_t)row * PLE))[lane] = w;
        } else {
#pragma unroll
            for (int k = 0; k < 4; ++k) hd[lane + k * 64] = (u32x2){0u, 0u};
            ((u32x2*)(p.Pb + (size_t)row * PLE))[lane] = (u32x2){0u, 0u};
        }
    }
    for (int i = blockIdx.x * 512 + threadIdx.x; i < 4 * 128 * 128; i += gridDim.x * 512) { const int t = (i >> 7) & 127, s = i & 127; p.GWb[i] = f2bf(s <= t ? p.gm_ws[i] : 0.f); }
    for (int i = blockIdx.x * 512 + threadIdx.x; i < 2 * 64 * 128; i += gridDim.x * 512) { const int kv = i >> 13, d = (i >> 7) & 63, h = i & 127; p.W2T[i] = f2bf((kv ? p.w2_v : p.w2_k)[h * 64 + d]); }
    if (gw < 4) {
        const int kv = gw >> 1, h = (gw & 1) * 64 + lane;
        const float* pe = kv ? p.pe_v : p.pe_k; const float* w1 = kv ? p.w1_v : p.w1_k;
        float s = 0.f;
        for (int k = 0; k < 2048; ++k) s += pe[k] * w1[(size_t)k * 128 + h];
        p.PEB[kv * 128 + h] = s;
    }
    for (int i = blockIdx.x * 512 + threadIdx.x; i < NS * (WIN - 1) * 64; i += gridDim.x * 512) {
        const int b = i / ((WIN - 1) * 64), r = i % ((WIN - 1) * 64);
        ((f32x4*)(p.out + O_WINS + (size_t)b * WIN * 256))[r] = ((const f32x4*)(p.state_win + (size_t)b * WIN * 256 + 256))[r];
    }
}

__device__ void phase_cmp_final(const Params& p) {
    const int wid = threadIdx.x >> 6, lane = threadIdx.x & 63;
    {
        const int c = lane & 15, G = lane >> 4;
        const int ngrp_p = NB * 4 * 32, ngrp_s = NS * 4 * 64;
#pragma unroll 1
        for (int it = blockIdx.x * 8 + wid; it < ngrp_p + ngrp_s; it += gridDim.x * 8) {
            const bool smp = it >= ngrp_p; const int l = smp ? it - ngrp_p : it;
            const int nch = smp ? 64 : 32, nc = smp ? NCS : NCP;
            const int ch = l % nch, z = (l / nch) & 3, seq = l / (nch * 4), kv = z >> 1, g = z & 1, n0 = ch * 16;
            const size_t r0 = smp ? (size_t)2048 + (size_t)seq * 1024 : (size_t)seq * 512;
            const int nr = n0 + c < nc ? n0 + c : nc - 1;
            const float* p0 = p.PART + ((r0 + nr) * 4 + z) * 256;
            const float* p1 = p.PART + ((r0 + nr + 1) * 4 + z) * 256 + 128;
            const float* pb = p.PEB + kv * 128;
            f32x4 acc[4] = {{0.f, 0.f, 0.f, 0.f}, {0.f, 0.f, 0.f, 0.f}, {0.f, 0.f, 0.f, 0.f}, {0.f, 0.f, 0.f, 0.f}};
#pragma unroll
            for (int ks = 0; ks < 4; ++ks) {
                const int h0 = 32 * ks + 8 * G;
                const f32x4 a0 = *(const f32x4*)(p0 + h0), a1 = *(const f32x4*)(p0 + h0 + 4), b0 = *(const f32x4*)(p1 + h0), b1 = *(const f32x4*)(p1 + h0 + 4);
                const f32x4 e0 = *(const f32x4*)(pb + h0), e1 = *(const f32x4*)(pb + h0 + 4);
                f32x4 x0 = a0 + b0 + e0, x1 = a1 + b1 + e1;
#pragma unroll
                for (int i = 0; i < 4; ++i) { x0[i] = siluf_(x0[i]); x1[i] = siluf_(x1[i]); }
                const bf16x8 A = pack_p(x0, x1);
#pragma unroll
                for (int nt = 0; nt < 4; ++nt) {
                    const bf16x8 B = *(const bf16x8*)(p.W2T + ((size_t)kv * 64 + nt * 16 + c) * 128 + h0);
                    acc[nt] = mfma16(A, B, acc[nt]);
                }
            }
#pragma unroll
            for (int nt = 0; nt < 4; ++nt) {
                const int d = nt * 16 + c;
#pragma unroll
                for (int i = 0; i < 4; ++i) {
                    const int n = n0 + 4 * G + i;
                    if (n < nc) {
                        if (smp) ((kv ? p.VCS : p.KCS) + (((size_t)seq * NG + g) * 1024 + n) * 64)[d] = acc[nt][i];
                        else if (kv == 0) p.KCb[((size_t)seq * NG + g) * 512 * 64 + kfrag_off(n, d)] = f2bf(acc[nt][i]);
                    }
                }
                if (!smp && kv == 1) {
                    f32x4 v = acc[nt];
#pragma unroll
                    for (int i = 0; i < 4; ++i) if (n0 + 4 * G + i >= nc) v[i] = 0.f;
                    st_bf16x4(p.VCT + ((size_t)seq * NG + g) * 512 * 64 + vfrag_off(n0 + 4 * G, d), v);
                }
            }
        }
    }
}

template <bool SAMPLE>
__device__ __forceinline__ void kv_row_ptr(const Params& p, int branch  , int b, int pos, int kv, int g, const bf16_t*& pb, const float*& pf) {
    const int off = kv * 128 + g * 64;
    if (!SAMPLE) { pf = nullptr; pb = (branch == 1 ? p.SLCb : p.WINb) + ((size_t)b * SEQ + pos) * 256 + off; }
    else if (pos >= PAST) { pf = nullptr; pb = (branch == 1 ? p.SLCb : p.WINb) + ((size_t)MP + b) * 256 + off; }
    else if (branch == 1) { pb = nullptr; pf = p.cache_slc + ((size_t)p.page_table[b * NPG + (pos >> 7)] * PAGE + (pos & 127)) * 256 + off; }
    else { pb = nullptr; pf = p.state_win + ((size_t)b * WIN + (pos - (PAST - WIN))) * 256 + off; }
}
__device__ __forceinline__ void dot4x64(const bf16_t* pb, const float* pf, const LAS float* qs_, float (&s)[4]) {
    s[0] = s[1] = s[2] = s[3] = 0.f;
    const LAS float* qs = qs_; asm volatile("" : "+v"(qs));
    if (pf) {
#pragma unroll 4
        for (int c = 0; c < 16; ++c) {
            const f32x4 kx = *(const f32x4*)(pf + c * 4);
#pragma unroll
            for (int h = 0; h < 4; ++h) { const f32x4 q = *(const LAS f32x4*)(qs + h * 64 + c * 4); s[h] += q[0] * kx[0] + q[1] * kx[1] + q[2] * kx[2] + q[3] * kx[3]; }
        }
    } else {
#pragma unroll 2
        for (int c = 0; c < 8; ++c) {
            const u32x4 w = *(const u32x4*)(pb + c * 8);
            const float k0 = bflo(w.x), k1 = bfhi(w.x), k2 = bflo(w.y), k3 = bfhi(w.y), k4 = bflo(w.z), k5 = bfhi(w.z), k6 = bflo(w.w), k7 = bfhi(w.w);
#pragma unroll
            for (int h = 0; h < 4; ++h) {
                const f32x4 qa = *(const LAS f32x4*)(qs + h * 64 + c * 8), qb = *(const LAS f32x4*)(qs + h * 64 + c * 8 + 4);
                s[h] += qa[0] * k0 + qa[1] * k1 + qa[2] * k2 + qa[3] * k3 + qb[0] * k4 + qb[1] * k5 + qb[2] * k6 + qb[3] * k7;
            }
        }
    }
}
template <bool SAMPLE>
__device__ __forceinline__ void attn_chunk(const Params& p, int branch, int b, int g, int t, int pos0, int lo, int hi,
                                           float (&m)[4], float (&l)[4], float (&o)[4], const LAS float* qs, LAS float* pbk, const LAS float* relb, int lane) {
    const int pos = pos0 + lane;
    const bool valid = pos >= lo && pos <= hi;
    float s[4] = {-1e30f, -1e30f, -1e30f, -1e30f};
    if (valid) {
        const bf16_t* pb; const float* pf; kv_row_ptr<SAMPLE>(p, branch, b, pos, 0, g, pb, pf);
        dot4x64(pb, pf, qs, s);
        const int bk = t5_bucket(t - pos);
#pragma unroll
        for (int h = 0; h < 4; ++h) s[h] += relb[bk * 8 + g * 4 + h];
    }
#pragma unroll
    for (int h = 0; h < 4; ++h) {
        const float mx = wave_max(s[h]);
        const float mn = fmaxf(m[h], mx);
        const float pr = valid ? ex2(s[h] - mn) : 0.f;
        const float sm = wave_sum(pr);
        const float al = ex2(m[h] - mn);
        l[h] = l[h] * al + sm; o[h] *= al; m[h] = mn;
        pbk[h * 64 + lane] = pr;
    }
    __builtin_amdgcn_wave_barrier();
    const int k0 = (lo > pos0 ? lo : pos0) - pos0, k1 = (hi < pos0 + 63 ? hi : pos0 + 63) - pos0;
    if (SAMPLE) {
        const int kend = (PAST - 1 - pos0) < k1 ? (PAST - 1 - pos0) : k1;
        if (kend >= k0) {
            const bf16_t* pb; const float* pf; kv_row_ptr<SAMPLE>(p, branch, b, pos0 + k0, 1, g, pb, pf);
            pf += lane;
#pragma unroll 8
            for (int k = k0; k <= kend; ++k) {
                const float v = pf[(size_t)(k - k0) * 256];
#pragma unroll
                for (int h = 0; h < 4; ++h) o[h] += pbk[h * 64 + k] * v;
            }
        }
        if (k1 > kend) {
            const bf16_t* pb; const float* pf; kv_row_ptr<SAMPLE>(p, branch, b, pos0 + k1, 1, g, pb, pf);
            const float v = bf2f(pb[lane]);
#pragma unroll
            for (int h = 0; h < 4; ++h) o[h] += pbk[h * 64 + k1] * v;
        }
    } else {
#pragma unroll 1
    for (int k = k0; k <= k1; ++k) {
        const bf16_t* pb; const float* pf; kv_row_ptr<SAMPLE>(p, branch, b, pos0 + k, 1, g, pb, pf);
        const float v = pf ? pf[lane] : bf2f(pb[lane]);
#pragma unroll
        for (int h = 0; h < 4; ++h) o[h] += pbk[h * 64 + k] * v;
    }
    }
    __builtin_amdgcn_wave_barrier();
}

constexpr int S_QS = 0, S_SC = 1024, S_PHS = S_SC + 4 * 1024 * 4, S_PBK = S_PHS + 1088 * 4, S_PART = S_PBK + 8 * 1024, S_RED = S_PART + 2 * 8 * 272 * 4, S_OCP = S_RED + 512,
              S_SEL = S_OCP + 2048, S_RELB = S_SEL + 64, ATTS_LDS = S_RELB + 1024;
__device__ void attn_sample_item(const Params& p, int b, int g) {
    const int tid = threadIdx.x, wid = tid >> 6, lane = tid & 63;
    constexpr int t = PAST, NC = NCS, NSEL = 257, NJR = 5, qblk = PAST >> 6;
    const int row = MP + b;
    LAS unsigned char* L = (LAS unsigned char*)smem;
    LAS float* qs = (LAS float*)(L + S_QS); LAS float* sc = (LAS float*)(L + S_SC); LAS float* phs = (LAS float*)(L + S_PHS); LAS float* pbk = (LAS float*)(L + S_PBK) + wid * 256;
    LAS float* part = (LAS float*)(L + S_PART); LAS float* red = (LAS float*)(L + S_RED); LAS float* ocp = (LAS float*)(L + S_OCP); LAS int* sel = (LAS int*)(L + S_SEL);
    LAS float* relb = (LAS float*)(L + S_RELB);
    __syncthreads();
    if (tid < 256) { relb[tid] = p.rel_bias[tid] * LOG2E; qs[tid] = bf2f(p.Qb[(size_t)row * QD + g * 256 + tid]); }
    __syncthreads();
    const float* kc = p.KCS + ((size_t)b * NG + g) * 1024 * 64;
    const float* vc = p.VCS + ((size_t)b * NG + g) * 1024 * 64;
    {
        float mx[4] = {-1e30f, -1e30f, -1e30f, -1e30f};
#pragma unroll 1
        for (int r = wid; r < 16; r += 8) {
            const int n = r * 64 + lane;
            float s[4] = {-1e30f, -1e30f, -1e30f, -1e30f};
            if (n < NC) {
                dot4x64(nullptr, kc + (size_t)n * 64, qs, s);
                const int bk = t5_bucket(t - (16 * n + 31));
#pragma unroll
                for (int h = 0; h < 4; ++h) s[h] += relb[bk * 8 + g * 4 + h];
            }
#pragma unroll
            for (int h = 0; h < 4; ++h) { sc[h * 1024 + n] = s[h]; mx[h] = fmaxf(mx[h], s[h]); }
        }
#pragma unroll
        for (int h = 0; h < 4; ++h) { const float m = wave_max(mx[h]); if (lane == 0) red[wid * 4 + h] = m; }
    }
    __syncthreads();
    float gmx[4], inv[4];
#pragma unroll
    for (int h = 0; h < 4; ++h) { float m = red[h]; for (int w = 1; w < 8; ++w) m = fmaxf(m, red[w * 4 + h]); gmx[h] = m; }
    {
        float sum[4] = {0.f, 0.f, 0.f, 0.f};
#pragma unroll
        for (int k = 0; k < 2; ++k) { const int n = tid + 512 * k;
#pragma unroll
            for (int h = 0; h < 4; ++h) { const float e = n < NC ? ex2(sc[h * 1024 + n] - gmx[h]) : 0.f; sc[h * 1024 + n] = e; sum[h] += e; } }
#pragma unroll
        for (int h = 0; h < 4; ++h) { const float s = wave_sum(sum[h]); if (lane == 0) red[32 + wid * 4 + h] = s; }
    }
    __syncthreads();
#pragma unroll
    for (int h = 0; h < 4; ++h) { float s = 0.f; for (int w = 0; w < 8; ++w) s += red[32 + w * 4 + h]; inv[h] = s > 0.f ? 1.0f / s : 0.f; }
    for (int n = tid; n < 1088; n += 512) phs[n] = n < NC ? (sc[n] * inv[0] + sc[1024 + n] * inv[1]) + (sc[2048 + n] * inv[2] + sc[3072 + n] * inv[3]) : 0.f;
    {
        float a[4] = {0.f, 0.f, 0.f, 0.f};
#pragma unroll 8
        for (int n = wid; n < NC; n += 8) {
            const float v = vc[(size_t)n * 64 + lane];
#pragma unroll
            for (int h = 0; h < 4; ++h) a[h] += sc[h * 1024 + n] * v;
        }
#pragma unroll
        for (int h = 0; h < 4; ++h) part[(wid * 4 + h) * 68 + lane] = a[h] * inv[h];
    }
    __syncthreads();
    if (tid < 256) { float a = 0.f; for (int w = 0; w < 8; ++w) a += part[(w * 4 + (tid >> 6)) * 68 + (tid & 63)]; ocp[tid] = a; }
    __syncthreads();
    if (wid == 0) {
        unsigned long long key[NJR];
#pragma unroll
        for (int jr = 0; jr < NJR; ++jr) {
            const int j = jr * 64 + lane;
            key[jr] = 0ull;
            if (j >= 1 && j <= qblk - 2 && j < NSEL) {
                float im = 0.f;
#pragma unroll
                for (int n = 4 * j - 1; n <= 4 * j + 3; ++n) im += (n < NC) ? phs[n] : 0.f;
                key[jr] = ((unsigned long long)__float_as_uint(im) << 32) | (unsigned)(0xFFFF - j) | 0x10000ull;
            }
        }
        if (lane == 0) { sel[0] = 0; sel[1] = qblk - 1; sel[2] = qblk; }
#pragma unroll 1
        for (int it = 0; it < 13; ++it) {
            unsigned long long best = 0ull;
#pragma unroll
            for (int jr = 0; jr < NJR; ++jr) best = key[jr] > best ? key[jr] : best;
#pragma unroll
            for (int o = 32; o > 0; o >>= 1) { const unsigned long long ot = __shfl_xor(best, o); best = ot > best ? ot : best; }
            const int j = 0xFFFF - (int)(best & 0xFFFFull);
#pragma unroll
            for (int jr = 0; jr < NJR; ++jr) if (key[jr] == best) key[jr] = 0ull;
            if (lane == 0) sel[3 + it] = j;
        }
    }
    __syncthreads();
    {
        float ms[4] = {-1e30f, -1e30f, -1e30f, -1e30f}, ls[4] = {0.f, 0.f, 0.f, 0.f}, os[4] = {0.f, 0.f, 0.f, 0.f};
#pragma unroll 1
        for (int i = wid; i < 16; i += 8) attn_chunk<true>(p, 1, b, g, t, sel[i] * 64, 0, t, ms, ls, os, qs, pbk, relb, lane);
        float mw[4] = {-1e30f, -1e30f, -1e30f, -1e30f}, lw[4] = {0.f, 0.f, 0.f, 0.f}, ow[4] = {0.f, 0.f, 0.f, 0.f};
#pragma unroll 1
        for (int c = wid; c < 9; c += 8) attn_chunk<true>(p, 2, b, g, t, t - 63 - 64 * c, t - WIN, t, mw, lw, ow, qs, pbk, relb, lane);
#pragma unroll
        for (int h = 0; h < 4; ++h) {
            LAS float* ps = part + (wid * 4 + h) * 68; LAS float* pw = part + 8 * 272 + (wid * 4 + h) * 68;
            ps[lane] = os[h]; pw[lane] = ow[h];
            if (lane == 0) { ps[64] = ms[h]; ps[65] = ls[h]; pw[64] = mw[h]; pw[65] = lw[h]; }
        }
    }
    __syncthreads();
    if (tid < 256) {
        const int h = tid >> 6, d = tid & 63;
        float res[2];
#pragma unroll
        for (int br = 0; br < 2; ++br) {
            const LAS float* pp = part + br * 8 * 272 + h * 68;
            float m = -1e30f;
            for (int w = 0; w < 8; ++w) m = fmaxf(m, pp[w * 272 + 64]);
            float l = 0.f, o = 0.f;
            for (int w = 0; w < 8; ++w) { const float sc_ = ex2(pp[w * 272 + 64] - m); l += pp[w * 272 + 65] * sc_; o += pp[w * 272 + d] * sc_; }
            res[br] = o / l;
        }
        const float* gt = p.GATE + (size_t)row * 32 + (g * 4 + h) * 3;
        const float v = gt[0] * ocp[tid] + gt[1] * res[0] + gt[2] * res[1];
        p.OCAT[(size_t)row * DM + (g * 4 + h) * 64 + d] = f2bf(v);
    }
    __syncthreads();
}

constexpr int A_OST = 0, OST_LD = 68, A_LST = A_OST + 256 * OST_LD * 4, A_M0 = A_LST + 1024, A_MB = A_M0 + 1024, MB_LD = 132, A_MKN = A_MB + 64 * MB_LD,
              A_LIST = A_MKN + 256, A_CNT = A_LIST + 132 * 64, A_PK = A_CNT + 544, A_KN = A_PK + 400 * 4, A_T2 = A_KN + 512, A_NP = A_T2 + 132 * 8 * 4, A_QT = A_NP + 16, ATT2_LDS = A_QT + 64 * 512;
static_assert(ATT2_LDS <= GEMM_LDS && ATTS_LDS <= GEMM_LDS, "attention LDS");

__device__ __forceinline__ void qk64(const bf16_t* kb, int c, int G, const bf16x8 (&qB)[2], f32x4 (&s)[4]) {
#pragma unroll
    for (int kt = 0; kt < 4; ++kt) {
        const bf16_t* r = kb + (size_t)(16 * kt + c) * 256 + G * 8;
        const bf16x8 a0 = *(const bf16x8*)r, a1 = *(const bf16x8*)(r + 32);
        s[kt] = mfma16(a0, qB[0], (f32x4){0.f, 0.f, 0.f, 0.f}); s[kt] = mfma16(a1, qB[1], s[kt]);
    }
}
__device__ __forceinline__ void pv64(const bf16_t* vf, int key0, int lane, const f32x4 (&pr)[4], f32x4 (&o)[4]) {
#pragma unroll
    for (int ks = 0; ks < 2; ++ks) {
        const bf16x8 pB = pack_p(pr[2 * ks], pr[2 * ks + 1]);
#pragma unroll
        for (int dt = 0; dt < 4; ++dt) {
            const bf16x8 vA = *(const bf16x8*)(vf + ((size_t)(((key0 >> 5) + ks) * 4 + dt) * 64 + lane) * 8);
            o[dt] = mfma16(vA, pB, o[dt]);
        }
    }
}
__device__ __forceinline__ int qt_off(int qi, int hh, int k) { return (qi * 4 + hh) * 128 + ((k ^ (((qi & 3) << 1) | (hh >> 1))) << 4); }
__device__ __forceinline__ float grp_max(float v) { v = fmaxf(v, __shfl_xor(v, 16)); return fmaxf(v, __shfl_xor(v, 32)); }
__device__ __forceinline__ float grp_sum(float v) { v += __shfl_xor(v, 16); return v + __shfl_xor(v, 32); }

__device__ __forceinline__ void attn_pack(const Params& p, int b, int g, int t0, int lane_, LAS unsigned char* L) {
    f32x4 oacc[4];
    int lane = lane_; asm volatile("" : "+v"(lane));
    const int c = lane & 15, G = lane >> 4, qs = c >> 2, hh = c & 3;
    const int qb = t0 >> 6, tc = t0 + qs;
    const size_t qrow = (size_t)b * SEQ + tc;
    const LAS float* T2 = (const LAS float*)(L + A_T2);
    const float b31 = T2[128 * 8 + g * 4 + hh];
    bf16x8 qB[2];
    qB[0] = *(const bf16x8*)(p.Qb + qrow * QD + (g * 4 + hh) * 64 + G * 8); qB[1] = *(const bf16x8*)(p.Qb + qrow * QD + (g * 4 + hh) * 64 + 32 + G * 8);
    const float* gate = p.GATE + qrow * 32 + (g * 4 + hh) * 3;
    unsigned msk[4] = {0u, 0u, 0u, 0u};
    {
        const int ncv_c = tc >= 31 ? ((tc - 31) >> 4) + 1 : 0;
        const int ncv_m = t0 + 3 >= 31 ? ((t0 + 3 - 31) >> 4) + 1 : 0;
        const int NT = (ncv_m + 15) >> 4;
        const int mt_far = t0 >= 399 ? (t0 - 399) / 256 + 1 : 0;
        const bf16_t* kcb = p.KCb + (size_t)(b * NG + g) * 512 * 64;
        f32x4 sc[32];
        float mx = -1e30f;
#pragma unroll
        for (int mt = 0; mt < 32; ++mt) {
            sc[mt] = (f32x4){0.f, 0.f, 0.f, 0.f};
            if (mt < NT) {
                const bf16x8 a0 = *(const bf16x8*)(kcb + ((size_t)(mt * 2) * 64 + lane) * 8), a1 = *(const bf16x8*)(kcb + ((size_t)(mt * 2 + 1) * 64 + lane) * 8);
                f32x4 s = mfma16(a0, qB[0], (f32x4){0.f, 0.f, 0.f, 0.f}); s = mfma16(a1, qB[1], s);
                if (mt < mt_far) { s = s + b31; }
                else {
#pragma unroll
                    for (int i = 0; i < 4; ++i) { const int n = 16 * mt + 4 * G + i; int dist = tc - (16 * n + 31); const bool ok = n < ncv_c; dist = dist < 0 ? 0 : (dist > 128 ? 128 : dist);
                        s[i] = ok ? s[i] + T2[dist * 8 + g * 4 + hh] : -1e30f; }
                }
                mx = fmaxf(mx, fmaxf(fmaxf(s[0], s[1]), fmaxf(s[2], s[3])));
                sc[mt] = s;
            }
            if ((mt & 3) == 3) __builtin_amdgcn_sched_barrier(0);
        }
        mx = grp_max(mx);
        float sum = 0.f;
#pragma unroll
        for (int mt = 0; mt < 32; ++mt) if (mt < NT) {
#pragma unroll
            for (int i = 0; i < 4; ++i) { const float e = ex2(sc[mt][i] - mx); sc[mt][i] = e; sum += e; }
        }
        sum = grp_sum(sum);
        const float inv = ncv_c > 0 ? 1.0f / sum : 0.f;
#pragma unroll
        for (int mt = 0; mt < 32; ++mt) if (mt < NT) sc[mt] = sc[mt] * inv;
        if (qb <= 15) {
            msk[0] = (qb >= 31) ? 0xffffffffu : ((2u << qb) - 1u);
        } else {
            float cand[8];
#pragma unroll
            for (int k = 0; k < 8; ++k) cand[k] = -1.f;
            float prevB = 0.f;
#pragma unroll
            for (int mt = 0; mt < 32; ++mt) if (mt < NT) {
                const float r1 = __shfl(sc[mt][3], (lane - 16) & 63);
                float v = (sc[mt][0] + sc[mt][1]) + (sc[mt][2] + sc[mt][3]) + (G == 0 ? prevB : r1);
                prevB = r1;
                v += __shfl_xor(v, 1); v += __shfl_xor(v, 2);
                const int j = 4 * mt + G;
                if ((mt & 3) == hh) cand[mt >> 2] = (j >= 1 && j <= qb - 2) ? v : -1.f;
            }
            auto setbit = [&](int j) { const unsigned bit = 1u << (j & 31); const int w = j >> 5; msk[0] |= w == 0 ? bit : 0u; msk[1] |= w == 1 ? bit : 0u; msk[2] |= w == 2 ? bit : 0u; msk[3] |= w == 3 ? bit : 0u; };
            setbit(0); setbit(qb); setbit(qb - 1);
#pragma unroll 1
            for (int it = 0; it < 13; ++it) {
                float bv = cand[0];
#pragma unroll
                for (int k = 1; k < 8; ++k) bv = fmaxf(bv, cand[k]);
                bv = fmaxf(bv, __shfl_xor(bv, 1)); bv = fmaxf(bv, __shfl_xor(bv, 2)); bv = grp_max(bv);
                int bj = 9999;
#pragma unroll
                for (int k = 0; k < 8; ++k) { const int j = 16 * k + 4 * hh + G; bj = (cand[k] == bv && j < bj) ? j : bj; }
                { int o = __shfl_xor(bj, 1); bj = o < bj ? o : bj; o = __shfl_xor(bj, 2); bj = o < bj ? o : bj; o = __shfl_xor(bj, 16); bj = o < bj ? o : bj; o = __shfl_xor(bj, 32); bj = o < bj ? o : bj; }
#pragma unroll
                for (int k = 0; k < 8; ++k) { const int j = 16 * k + 4 * hh + G; if (j == bj) cand[k] = -1.f; }
                setbit(bj & 127);
            }
        }
        const bf16_t* vct = p.VCT + (size_t)(b * NG + g) * 64 * 512;
        f32x4 oc[4] = {{0.f, 0.f, 0.f, 0.f}, {0.f, 0.f, 0.f, 0.f}, {0.f, 0.f, 0.f, 0.f}, {0.f, 0.f, 0.f, 0.f}};
#pragma unroll
        for (int k2 = 0; k2 < 16; ++k2) if (2 * k2 < NT) {
            const bf16x8 pB = pack_p(sc[2 * k2], sc[2 * k2 + 1]);
#pragma unroll
            for (int dt = 0; dt < 4; ++dt) {
                const bf16x8 vA = *(const bf16x8*)(vct + ((size_t)(k2 * 4 + dt) * 64 + lane) * 8);
                oc[dt] = mfma16(vA, pB, oc[dt]);
            }
            if (k2 & 1) __builtin_amdgcn_sched_barrier(0);
        }
        const float g0 = gate[0];
#pragma unroll
        for (int dt = 0; dt < 4; ++dt) oacc[dt] = oc[dt] * g0;
    }
    bf16_t* orow = p.OCAT + qrow * DM + (g * 4 + hh) * 64 + 4 * G;
#pragma unroll
    for (int dt = 0; dt < 4; ++dt) st_bf16x4(orow + dt * 16, oacc[dt]);
    {
        unsigned um[4];
#pragma unroll
        for (int w = 0; w < 4; ++w) { unsigned u = msk[w]; u |= __shfl_xor(u, 4); u |= __shfl_xor(u, 8); um[w] = __builtin_amdgcn_readfirstlane(u); }
        f32x4 os[4] = {{0.f, 0.f, 0.f, 0.f}, {0.f, 0.f, 0.f, 0.f}, {0.f, 0.f, 0.f, 0.f}, {0.f, 0.f, 0.f, 0.f}};
        float m = -1e30f, l = 0.f;
        const bf16_t* kbase = p.SLCkF + (size_t)(b * NG + g) * SEQ * 64;
        const bf16_t* vbase = p.SLCvT + (size_t)(b * NG + g) * SEQ * 64;
        const bf16_t* klane = kbase + lane * 8; const bf16_t* vlane = vbase + lane * 8;
        auto ldfr = [&](int j_, bf16x8 (&kf_)[4][2], bf16x8 (&vf_)[2][4]) {
            const bf16_t* kr = klane + (size_t)j_ * 4096; const bf16_t* vr = vlane + (size_t)j_ * 4096;
#pragma unroll
            for (int kt = 0; kt < 4; ++kt) { kf_[kt][0] = *(const bf16x8*)(kr + (kt * 2) * 512); kf_[kt][1] = *(const bf16x8*)(kr + (kt * 2 + 1) * 512); }
#pragma unroll
            for (int ks = 0; ks < 2; ++ks)
#pragma unroll
                for (int dt = 0; dt < 4; ++dt) vf_[ks][dt] = *(const bf16x8*)(vr + (ks * 4 + dt) * 512);
        };
        auto nextj = [&](int& j_) {
            int w = um[0] ? 0 : um[1] ? 1 : um[2] ? 2 : um[3] ? 3 : -1;
            if (w < 0) return false;
            const unsigned u = w == 0 ? um[0] : w == 1 ? um[1] : w == 2 ? um[2] : um[3];
            const int bpos = __builtin_ctz(u);
            j_ = w * 32 + bpos;
            const unsigned cl = ~(1u << bpos);
            if (w == 0) um[0] &= cl; else if (w == 1) um[1] &= cl; else if (w == 2) um[2] &= cl; else um[3] &= cl;
            return true;
        };
        auto blockstep = [&](int j, const bf16x8 (&kf)[4][2], const bf16x8 (&vf)[2][4]) {
            const unsigned mw = (j >> 5) == 0 ? msk[0] : (j >> 5) == 1 ? msk[1] : (j >> 5) == 2 ? msk[2] : msk[3];
            const bool mine = (mw >> (j & 31)) & 1u;
            const bool farb = j <= qb - 3;
            const float ini = farb ? b31 : 0.f;
            f32x4 s[4];
#pragma unroll
            for (int kt = 0; kt < 4; ++kt) { s[kt] = mfma16(kf[kt][0], qB[0], (f32x4){ini, ini, ini, ini}); s[kt] = mfma16(kf[kt][1], qB[1], s[kt]); }
            if (!farb) {
#pragma unroll
                for (int kt = 0; kt < 4; ++kt)
#pragma unroll
                    for (int i = 0; i < 4; ++i) { const int dist = tc - (j * 64 + 16 * kt + 4 * G + i); const int dd = dist < 0 ? 0 : (dist > 128 ? 128 : dist);
                        s[kt][i] = dist >= 0 ? s[kt][i] + T2[dd * 8 + g * 4 + hh] : -1e30f; }
            }
            float cm = fmaxf(fmaxf(fmaxf(s[0][0], s[0][1]), fmaxf(s[0][2], s[0][3])), fmaxf(fmaxf(s[1][0], s[1][1]), fmaxf(s[1][2], s[1][3])));
            cm = fmaxf(cm, fmaxf(fmaxf(fmaxf(s[2][0], s[2][1]), fmaxf(s[2][2], s[2][3])), fmaxf(fmaxf(s[3][0], s[3][1]), fmaxf(s[3][2], s[3][3]))));
            cm = grp_max(mine ? cm : -1e30f);
            const float mn = fmaxf(m, cm), al = ex2(m - mn);
            const float sh = mine ? mn : 1e30f;
            float ps = 0.f;
#pragma unroll
            for (int kt = 0; kt < 4; ++kt)
#pragma unroll
                for (int i = 0; i < 4; ++i) { const float e = ex2(s[kt][i] - sh); s[kt][i] = e; ps += e; }
            l = l * al + grp_sum(ps); m = mn;
#pragma unroll
            for (int dt = 0; dt < 4; ++dt) os[dt] = os[dt] * al;
#pragma unroll
            for (int ks = 0; ks < 2; ++ks) { const bf16x8 pB = pack_p(s[2 * ks], s[2 * ks + 1]);
#pragma unroll
                for (int dt = 0; dt < 4; ++dt) os[dt] = mfma16(vf[ks][dt], pB, os[dt]); }
        };
        bf16x8 kfA[4][2], vfA[2][4], kfB[4][2], vfB[2][4];
        int j = 0; bool have = nextj(j);
        ldfr(j, kfA, vfA);
#pragma unroll 1
        while (have) {
            int jn = j; bool haven = nextj(jn);
            ldfr(jn, kfB, vfB);
            __builtin_amdgcn_sched_barrier(0);
            blockstep(j, kfA, vfA);
            if (!haven) break;
            j = jn; have = nextj(jn);
            ldfr(jn, kfA, vfA);
            __builtin_amdgcn_sched_barrier(0);
            blockstep(j, kfB, vfB);
            j = jn;
        }
        const float gs = gate[1] / l;
#pragma unroll
        for (int dt = 0; dt < 4; ++dt) { const u32x2 w = *(const u32x2*)(orow + dt * 16); f32x4 pa; pa[0] = bflo(w.x); pa[1] = bfhi(w.x); pa[2] = bflo(w.y); pa[3] = bfhi(w.y);
            st_bf16x4(orow + dt * 16, pa + os[dt] * gs); }
    }
    {
        f32x4 ow[4] = {{0.f, 0.f, 0.f, 0.f}, {0.f, 0.f, 0.f, 0.f}, {0.f, 0.f, 0.f, 0.f}, {0.f, 0.f, 0.f, 0.f}};
        float m = -1e30f, l = 0.f;
        const int lo = t0 - WIN > 0 ? t0 - WIN : 0, hi = t0 + 3;
        const bf16_t* kbase = p.WINkF + (size_t)(b * NG + g) * SEQ * 64;
        const bf16_t* vbase = p.WINvT + (size_t)(b * NG + g) * 64 * SEQ;
        const bf16_t* klane = kbase + lane * 8; const bf16_t* vlane = vbase + lane * 8;
        auto ldfr = [&](int cb_, bf16x8 (&kf_)[4][2], bf16x8 (&vf_)[2][4]) {
            const bf16_t* kr = klane + (size_t)cb_ * 64; const bf16_t* vr = vlane + (size_t)cb_ * 64;
#pragma unroll
            for (int kt = 0; kt < 4; ++kt) { kf_[kt][0] = *(const bf16x8*)(kr + (kt * 2) * 512); kf_[kt][1] = *(const bf16x8*)(kr + (kt * 2 + 1) * 512); }
#pragma unroll
            for (int ks = 0; ks < 2; ++ks)
#pragma unroll
                for (int dt = 0; dt < 4; ++dt) vf_[ks][dt] = *(const bf16x8*)(vr + (ks * 4 + dt) * 512);
        };
        auto chunkstep = [&](int cb, const bf16x8 (&kf)[4][2], const bf16x8 (&vf)[2][4]) {
            const bool far = (cb + 63 <= t0 - 128) && (cb >= t0 + 3 - WIN);
            const float ini = far ? b31 : 0.f;
            f32x4 s[4];
#pragma unroll
            for (int kt = 0; kt < 4; ++kt) { s[kt] = mfma16(kf[kt][0], qB[0], (f32x4){ini, ini, ini, ini}); s[kt] = mfma16(kf[kt][1], qB[1], s[kt]); }
            if (!far) {
#pragma unroll
                for (int kt = 0; kt < 4; ++kt)
#pragma unroll
                    for (int i = 0; i < 4; ++i) { const int dist = tc - (cb + 16 * kt + 4 * G + i); const bool ok = dist >= 0 && dist <= WIN; const int dd = dist < 0 ? 0 : (dist > 128 ? 128 : dist);
                        s[kt][i] = ok ? s[kt][i] + T2[dd * 8 + g * 4 + hh] : -1e30f; }
            }
            float cm = fmaxf(fmaxf(fmaxf(s[0][0], s[0][1]), fmaxf(s[0][2], s[0][3])), fmaxf(fmaxf(s[1][0], s[1][1]), fmaxf(s[1][2], s[1][3])));
            cm = fmaxf(cm, fmaxf(fmaxf(fmaxf(s[2][0], s[2][1]), fmaxf(s[2][2], s[2][3])), fmaxf(fmaxf(s[3][0], s[3][1]), fmaxf(s[3][2], s[3][3]))));
            cm = grp_max(cm);
            const float mn = fmaxf(m, cm), al = ex2(m - mn);
            float ps = 0.f;
#pragma unroll
            for (int kt = 0; kt < 4; ++kt)
#pragma unroll
                for (int i = 0; i < 4; ++i) { const float e = ex2(s[kt][i] - mn); s[kt][i] = e; ps += e; }
            l = l * al + grp_sum(ps); m = mn;
#pragma unroll
            for (int dt = 0; dt < 4; ++dt) ow[dt] = ow[dt] * al;
#pragma unroll
            for (int ks = 0; ks < 2; ++ks) { const bf16x8 pB = pack_p(s[2 * ks], s[2 * ks + 1]);
#pragma unroll
                for (int dt = 0; dt < 4; ++dt) ow[dt] = mfma16(vf[ks][dt], pB, ow[dt]); }
        };
        bf16x8 kfA[4][2], vfA[2][4], kfB[4][2], vfB[2][4];
        int cb = lo & ~63;
        ldfr(cb, kfA, vfA);
#pragma unroll 1
        for (;;) {
            ldfr(cb + 64 <= hi ? cb + 64 : cb, kfB, vfB);
            __builtin_amdgcn_sched_barrier(0);
            chunkstep(cb, kfA, vfA);
            cb += 64; if (cb > hi) break;
            ldfr(cb + 64 <= hi ? cb + 64 : cb, kfA, vfA);
            __builtin_amdgcn_sched_barrier(0);
            chunkstep(cb, kfB, vfB);
            cb += 64; if (cb > hi) break;
        }
        const float gw = gate[2] / l;
#pragma unroll
        for (int dt = 0; dt < 4; ++dt) { const u32x2 w = *(const u32x2*)(orow + dt * 16); f32x4 pa; pa[0] = bflo(w.x); pa[1] = bfhi(w.x); pa[2] = bflo(w.y); pa[3] = bfhi(w.y);
            st_bf16x4(orow + dt * 16, pa + ow[dt] * gw); }
    }
}

__device__ void phase_attn(const Params& p) {
    const int wid = threadIdx.x >> 6, lane = threadIdx.x & 63;
    { PROBE_BEGIN(3)
    if (blockIdx.x < NS * NG) attn_sample_item(p, blockIdx.x >> 1, blockIdx.x & 1);
    PROBE_END(3) }
    LAS unsigned char* L = (LAS unsigned char*)smem;
    for (int i = threadIdx.x; i < 129 * 8; i += 512) ((LAS float*)(L + A_T2))[i] = p.rel_bias[t5_bucket(i >> 3) * 8 + (i & 7)] * LOG2E;
    __syncthreads();
    {
        const int wid2 = __builtin_amdgcn_readfirstlane(threadIdx.x >> 6);
#pragma unroll 1
        for (int T = blockIdx.x; T < NB * NG * (SEQ / 32); T += gridDim.x) {
            const int bg = T & 7, h32 = (SEQ / 32 - 1) - (T >> 3);
            attn_pack(p, bg >> 1, bg & 1, h32 * 32 + wid2 * 4, lane, L);
        }
    }
    __syncthreads();
}

constexpr int GM_LD = 136, GM_LDS = 128 * GM_LD * 2 + 1024;
__device__ void phase_gmlp(const Params& p) {
    int tid = threadIdx.x; asm volatile("" : "+v"(tid));
    const int wid = __builtin_amdgcn_readfirstlane(tid >> 6), lane = tid & 63;
    LAS bf16_t* vnT = (LAS bf16_t*)smem;
    LAS float* mu = (LAS float*)(smem + 128 * GM_LD * 2);
    const int c = lane & 15, G = lane >> 4;
#pragma unroll 1
    for (int u = blockIdx.x; u < NB * 64; u += gridDim.x) {
        const int b = u >> 6, ch = u & 63; const size_t row0 = (size_t)b * SEQ + ch * 128;
        __syncthreads();
        for (int r = wid; r < 128; r += 8) {
            const u32x4 w = *(const u32x4*)(p.Vg + (row0 + r) * GMD + lane * 8);
            const float x[8] = {bflo(w.x), bfhi(w.x), bflo(w.y), bfhi(w.y), bflo(w.z), bfhi(w.z), bflo(w.w), bfhi(w.w)};
            float s = 0.f;
#pragma unroll
            for (int i = 0; i < 8; ++i) s += x[i];
            const float mean = wave_sum(s) * (1.0f / GMD);
            float q = 0.f;
#pragma unroll
            for (int i = 0; i < 8; ++i) q += (x[i] - mean) * (x[i] - mean);
            const float var = wave_sum(q) * (1.0f / GMD);
            if (lane == 0) { mu[r] = mean; mu[128 + r] = rsqrtf(var + EPS); }
        }
#pragma unroll 1
        for (int g = 0; g < 4; ++g) {
            __syncthreads();
#pragma unroll
            for (int k = 0; k < 4; ++k) {
                const int e = tid + 512 * k, s = e & 127, d0 = (e >> 7) * 8;
                const u32x4 w = *(const u32x4*)(p.Vg + (row0 + s) * GMD + g * 128 + d0);
                const float x[8] = {bflo(w.x), bfhi(w.x), bflo(w.y), bfhi(w.y), bflo(w.z), bfhi(w.z), bflo(w.w), bfhi(w.w)};
                const float m = mu[s], rs = mu[128 + s];
#pragma unroll
                for (int i = 0; i < 8; ++i) { const int cc = g * 128 + d0 + i; vnT[(d0 + i) * GM_LD + s] = f2bf((x[i] - m) * rs * p.gm_ln_g[cc] + p.gm_ln_b[cc]); }
            }
            __syncthreads();
            f32x4 acc[8];
#pragma unroll
            for (int dt = 0; dt < 8; ++dt) acc[dt] = (f32x4){0.f, 0.f, 0.f, 0.f};
            const bf16_t* wrow = p.GWb + ((size_t)g * 128 + 16 * wid + c) * 128 + 8 * G;
#pragma unroll 1
            for (int ks = 0; ks <= (wid >> 1); ++ks) {
                const bf16x8 B = *(const bf16x8*)(wrow + 32 * ks);
#pragma unroll
                for (int dt = 0; dt < 8; ++dt) {
                    const bf16x8 A = *(const LAS bf16x8*)(vnT + (dt * 16 + c) * GM_LD + 32 * ks + 8 * G);
                    acc[dt] = mfma16(A, B, acc[dt]);
                }
            }
            const int t = 16 * wid + c;
            const float bs = p.gm_bs[g * 128 + t];
#pragma unroll
            for (int dt = 0; dt < 8; ++dt) {
                const int d = dt * 16 + 4 * G;
                const u32x2 uw = *(const u32x2*)(p.U + (row0 + t) * GMD + g * 128 + d);
                f32x4 o; o[0] = bflo(uw.x) * (acc[dt][0] + bs); o[1] = bfhi(uw.x) * (acc[dt][1] + bs); o[2] = bflo(uw.y) * (acc[dt][2] + bs); o[3] = bfhi(uw.y) * (acc[dt][3] + bs);
                st_bf16x4(p.OCAT + (row0 + t) * DM + QD + g * 128 + d, o);
            }
        }
    }
    for (int it = blockIdx.x * 8 + wid; it < NS; it += gridDim.x * 8) {
        const size_t row = (size_t)MP + it;
        const u32x4 w = *(const u32x4*)(p.Vg + row * GMD + lane * 8);
        const float x[8] = {bflo(w.x), bfhi(w.x), bflo(w.y), bfhi(w.y), bflo(w.z), bfhi(w.z), bflo(w.w), bfhi(w.w)};
        float s = 0.f;
#pragma unroll
        for (int i = 0; i < 8; ++i) s += x[i];
        const float mean = wave_sum(s) * (1.0f / GMD);
        float q = 0.f;
#pragma unroll
        for (int i = 0; i < 8; ++i) q += (x[i] - mean) * (x[i] - mean);
        const float rs = rsqrtf(wave_sum(q) * (1.0f / GMD) + EPS);
#pragma unroll
        for (int i = 0; i < 8; ++i) {
            const int c = lane * 8 + i, g = c >> 7;
            const float v = (x[i] - mean) * rs * p.gm_ln_g[c] + p.gm_ln_b[c];
            p.out[O_GMV + (size_t)it * GMD + c] = v;
            const float a = p.gm_ws[(size_t)g * 128 * 128] * v + p.gm_bs[g * 128];
            p.OCAT[row * DM + QD + c] = f2bf(bf2f(p.U[row * GMD + c]) * a);
        }
    }
}

template <int MODE>
__device__ void phase_norm(const Params& p) {
    const int wid = threadIdx.x >> 6, lane = threadIdx.x & 63;
    const float* gpost = MODE == 0 ? p.ln_mix_post : MODE == 1 ? p.ln_ffn_post : p.ln_ple_post;
    for (int row = blockIdx.x * 8 + wid; row < MP + NS; row += gridDim.x * 8) {
        const bf16_t* fr = (const bf16_t*)p.F + (size_t)row * DM;
        const float* xr = MODE == 0 ? xrow_ptr(p, row) : MODE == 1 ? p.X1 + (size_t)row * DM : p.X2 + (size_t)row * DM;
        f32x4 f[4], x[4];
#pragma unroll
        for (int k = 0; k < 4; ++k) { const u32x2 w = *(const u32x2*)(fr + lane * 4 + k * 256); f[k][0] = bflo(w.x); f[k][1] = bfhi(w.x); f[k][2] = bflo(w.y); f[k][3] = bfhi(w.y);
            x[k] = *(const f32x4*)(xr + lane * 4 + k * 256); }
        const float r = row_rstd(f);
#pragma unroll
        for (int k = 0; k < 4; ++k) { const f32x4 g = *(const f32x4*)(gpost + lane * 4 + k * 256); x[k] = x[k] + f[k] * r * g; }
        if (MODE == 0) {
            const float r2 = row_rstd(x);
#pragma unroll
            for (int k = 0; k < 4; ++k) {
                *(f32x4*)(p.X1 + (size_t)row * DM + lane * 4 + k * 256) = x[k];
                const f32x4 g = *(const f32x4*)(p.ln_ffn_pre + lane * 4 + k * 256); const f32x4 o = x[k] * r2 * g;
                st_bf16x4(p.H2 + (size_t)row * DM + lane * 4 + k * 256, o);
            }
        } else if (MODE == 1) {
#pragma unroll
            for (int k = 0; k < 4; ++k) { *(f32x4*)(p.X2 + (size_t)row * DM + lane * 4 + k * 256) = x[k]; st_bf16x4(p.X2b + (size_t)row * DM + lane * 4 + k * 256, x[k]); }
        } else {
            float* yr = row < MP ? p.out + O_YP + (size_t)row * DM : p.out + O_YS + (size_t)(row - MP) * DM;
#pragma unroll
            for (int k = 0; k < 4; ++k) *(f32x4*)(yr + lane * 4 + k * 256) = x[k];
        }
    }
}


#define XB_TMO      128
#define XB_XCNT(j)  (256  + 64 * (j))
#define XB_XSUB(j)  (1280 + 64 * (j))
#define XB_XGEN(j)  (2304 + 64 * (j))
#define XB_TOP      3328
#define XB_TOPGEN   3392
#define XCD_BAR_WORDS 3456
#define XB_SPIN_CAP (1u << 22)

__device__ __forceinline__ unsigned xb_ld(unsigned* p)              { return __hip_atomic_load(p, __ATOMIC_RELAXED, __HIP_MEMORY_SCOPE_AGENT); }
__device__ __forceinline__ unsigned xb_add(unsigned* p, unsigned v) { return __hip_atomic_fetch_add(p, v, __ATOMIC_RELAXED, __HIP_MEMORY_SCOPE_AGENT); }
__device__ __forceinline__ unsigned xb_xcc_id() { return (unsigned)__builtin_amdgcn_s_getreg((3 << 11) | 20) & 0xFu; }
#define XB_SPIN(cond, bar) do { unsigned _sp = 0; while (cond) { __builtin_amdgcn_s_sleep(1); \
    if ((++_sp & 255u) == 0u) { if (xb_ld(&(bar)[XB_TMO])) break; if (_sp > XB_SPIN_CAP) { atomicAdd(&(bar)[XB_TMO], 1u); break; } } } } while (0)

struct XcdBarrier {
    unsigned* bar; unsigned x;
    volatile LAS unsigned* st;
};

__device__ __forceinline__ XcdBarrier xcd_barrier_post(unsigned* bar, volatile LAS unsigned* st) {
    XcdBarrier b; b.bar = bar; b.x = xb_xcc_id(); b.st = st;
    if (threadIdx.x == 0) (void)xb_add(&bar[XB_XCNT(b.x)], 1u);
    return b;
}
__device__ __forceinline__ void xcd_barrier_complete(unsigned* bar, unsigned x, unsigned& nloc, unsigned& nx) {
    const unsigned G = gridDim.x * gridDim.y * gridDim.z;
    unsigned sum, cnt, mine, sp = 0u;
    for (;;) {
        sum = 0u; cnt = 0u; mine = 0u;
#pragma unroll
        for (unsigned j = 0; j < 16; ++j) { const unsigned c = xb_ld(&bar[XB_XCNT(j)]); sum += c; cnt += (c > 0u) ? 1u : 0u; mine = (j == x) ? c : mine; }
        if (sum == G) break;
        __builtin_amdgcn_s_sleep(1);
        if ((++sp & 255u) == 0u) { if (xb_ld(&bar[XB_TMO])) break; if (sp > XB_SPIN_CAP) { atomicAdd(&bar[XB_TMO], 1u); break; } }
    }
    nloc = mine > 0u ? mine : 1u; nx = cnt > 0u ? cnt : 1u;
}

__device__ __forceinline__ void xcd_barrier(const XcdBarrier& b) {
    asm volatile("s_waitcnt vmcnt(0)" ::: "memory");
    __syncthreads();
    if (threadIdx.x == 0) {
        unsigned* bar = b.bar;
        __builtin_amdgcn_s_waitcnt(0);
        unsigned nloc = b.st[0], nx = b.st[1];
        if (nloc == 0u) { xcd_barrier_complete(bar, b.x, nloc, nx); b.st[0] = nloc; b.st[1] = nx; }
        const unsigned old = xb_add(&bar[XB_XSUB(b.x)], 1u);
        const unsigned gen = old / nloc;
        if (old + 1u == (gen + 1u) * nloc) {
            __builtin_amdgcn_fence(__ATOMIC_RELEASE, "agent");
            asm volatile("s_waitcnt vmcnt(0)" ::: "memory");
            const unsigned og = xb_add(&bar[XB_TOP], 1u);
            const unsigned tg = og / nx;
            if (og + 1u == (tg + 1u) * nx) xb_add(&bar[XB_TOPGEN], 1u);
            else XB_SPIN(xb_ld(&bar[XB_TOPGEN]) == tg, bar);
            __builtin_amdgcn_fence(__ATOMIC_ACQUIRE, "agent");
            xb_add(&bar[XB_XGEN(b.x)], 1u);
            asm volatile("s_waitcnt vmcnt(0)" ::: "memory");
        } else {
            XB_SPIN(xb_ld(&bar[XB_XGEN(b.x)]) == gen, bar);
            __builtin_amdgcn_fence(__ATOMIC_ACQUIRE, "agent");
            asm volatile("s_waitcnt vmcnt(0)" ::: "memory");
        }
    }
    __syncthreads();
}

constexpr int NPHASE = 16;
constexpr int LDS_BYTES = GEMM_LDS;
static_assert(GM_LDS <= LDS_BYTES, "lds");
constexpr int NMT = MALL / BM;

constexpr int NMP = MP / BM;
template <int PH>
__device__ __forceinline__ void run_phase(const Params& p) {
    if (PH == 0) phase_prologue(p);
    if (PH == 1) { EpiIn e{p}; gemm_phase(p.H, DM, p.WinT, DM, NMP, INP / BM, e); gemm_skinny(p.H + (size_t)MP * DM, DM, p.WinT, DM, INP, e); }
    if (PH == 2) { EpiPart e{p.PART}; gemm_phase(p.CMPb, 4096, p.W1T, 1024, (2048 + NS * 1024) / BM, 1, e, 4, ZCmp(), 256); }
    if (PH == 3) phase_cmp_final(p);
    if (PH == 4) phase_attn(p);
    if (PH == 5) phase_gmlp(p);
    if (PH == 6) { EpiBranch e{p.GA, p.GB, p.Y1}; gemm_phase<EpiBranch, ZNone, true>(p.OCAT, DM, p.WnT, DM, NMP, DM / BM, e); gemm_skinny2(p.OCAT + (size_t)MP * DM, DM, p.WnT, DM, DM, e); }
    if (PH == 8) { EpiBf16 e{(bf16_t*)p.F, DM}; gemm_phase(p.Y1, DM, p.WoT, DM, NMP, DM / BM, e); gemm_skinny(p.Y1 + (size_t)MP * DM, DM, p.WoT, DM, DM, e); }
    if (PH == 9) phase_norm<0>(p);
    if (PH == 10) { EpiSwiGLU e{p.ACT}; gemm_phase(p.H2, DM, p.WguT, DM, NMP, 2 * DFF / BM, e); gemm_skinny(p.H2 + (size_t)MP * DM, DM, p.WguT, DM, 2 * DFF, e); }
    if (PH == 11) { EpiBf16 e{(bf16_t*)p.F, DM}; gemm_phase(p.ACT, DFF, p.WdT, DFF, NMP, DM / BM, e); gemm_skinny(p.ACT + (size_t)MP * DFF, DFF, p.WdT, DFF, DM, e); }
    if (PH == 12) phase_norm<1>(p);
    if (PH == 13) { EpiBf16 e{(bf16_t*)p.T, DM}; gemm_phase(p.Pb, PLE, p.WpT, PLE, NMP, DM / BM, e); gemm_skinny(p.Pb + (size_t)MP * PLE, PLE, p.WpT, PLE, DM, e); }
    if (PH == 14) { EpiPleGate e{(const bf16_t*)p.T, (bf16_t*)p.F}; gemm_phase(p.X2b, DM, p.WpgT, DM, NMP, DM / BM, e); gemm_skinny(p.X2b + (size_t)MP * DM, DM, p.WpgT, DM, DM, e); }
    if (PH == 15) phase_norm<2>(p);
}

#ifndef MK_MULTI
#define MK_MULTI 0
#endif
template <int PH>
__global__ void __launch_bounds__(512, 2) k_phase(Params p) { run_phase<PH>(p); }

__global__ void __launch_bounds__(512, 2) k_all(Params p) {
    volatile LAS unsigned* st = (volatile LAS unsigned*)((LAS unsigned char*)smem + LDS_BYTES);
    if (threadIdx.x < 12) st[threadIdx.x] = 0u;
    __syncthreads();
    XcdBarrier bar = xcd_barrier_post(p.bar, st);
#if PROBE_DUP == 100
    run_phase<0>(p);  xcd_barrier(bar);
#endif
    run_phase<0>(p);  xcd_barrier(bar);
    run_phase<1>(p);  xcd_barrier(bar);
    run_phase<2>(p);  xcd_barrier(bar);
#if PROBE_DUP == 100
    run_phase<3>(p);  xcd_barrier(bar);
#endif
    run_phase<3>(p);  xcd_barrier(bar);
#if PROBE_DUP == 104
    run_phase<4>(p);  xcd_barrier(bar);
#endif
    run_phase<4>(p);
#if PROBE_DUP == 100
    run_phase<5>(p);  xcd_barrier(bar);
#endif
    run_phase<5>(p);  xcd_barrier(bar);
    run_phase<6>(p);  xcd_barrier(bar);
    run_phase<8>(p);  xcd_barrier(bar);
    run_phase<9>(p);  xcd_barrier(bar);
    run_phase<10>(p); xcd_barrier(bar);
    run_phase<11>(p); xcd_barrier(bar);
    run_phase<12>(p);
    run_phase<13>(p); xcd_barrier(bar);
    run_phase<14>(p); xcd_barrier(bar);
    run_phase<15>(p);
#if PROBE_SPIN
    if (blockIdx.x == 0 && threadIdx.x == 0) {
        const unsigned long long d = PROBE_TS[2] * PROBE_SPIN, t0 = probe_now();
        while (probe_now() - t0 < d) __builtin_amdgcn_s_sleep(8);
    }
#endif
}

static inline size_t al256(size_t x) { return (x + 255) & ~(size_t)255; }
template <int PH> static void launch_phase(const Params& p, int grid, hipStream_t s) {
    static bool attr = false;
    if (!attr) { (void)hipFuncSetAttribute((const void*)k_phase<PH>, hipFuncAttributeMaxDynamicSharedMemorySize, LDS_BYTES); attr = true; }
    k_phase<PH><<<grid, 512, LDS_BYTES, s>>>(p);
}
template <int PH> static void launch_all(const Params& p, int grid, hipStream_t s) {
    launch_phase<PH>(p, grid, s);
    if constexpr (PH + 1 < NPHASE) launch_all<PH + 1>(p, grid, s);
}

extern "C" void kernel_launch(void* const* d_in, const int* in_sizes, int n_in, void* d_out, int out_size, void* d_ws, size_t ws_size, hipStream_t stream) {
    Params p{};
    p.x_prompt = (const float*)d_in[0]; p.x_sample = (const float*)d_in[1]; p.cache_cmp = (const float*)d_in[2]; p.cache_slc = (const float*)d_in[3];
    p.state_win = (const float*)d_in[4]; p.page_table = (const int*)d_in[5]; p.p_prompt = (const float*)d_in[6]; p.p_sample = (const float*)d_in[7];
    p.rel_bias = (const float*)d_in[8]; p.ln_mix_pre = (const float*)d_in[9]; p.w_in = (const float*)d_in[10];
    p.pe_k = (const float*)d_in[11]; p.w1_k = (const float*)d_in[12]; p.w2_k = (const float*)d_in[13];
    p.pe_v = (const float*)d_in[14]; p.w1_v = (const float*)d_in[15]; p.w2_v = (const float*)d_in[16];
    p.gm_ln_g = (const float*)d_in[17]; p.gm_ln_b = (const float*)d_in[18]; p.gm_ws = (const float*)d_in[19]; p.gm_bs = (const float*)d_in[20];
    p.w_br_nsa = (const float*)d_in[21]; p.w_br_gm = (const float*)d_in[22]; p.w_out = (const float*)d_in[23];
    p.ln_mix_post = (const float*)d_in[24]; p.ln_ffn_pre = (const float*)d_in[25]; p.w_gate = (const float*)d_in[26]; p.w_up = (const float*)d_in[27];
    p.w_down = (const float*)d_in[28]; p.ln_ffn_post = (const float*)d_in[29]; p.w_ple = (const float*)d_in[30]; p.w_ple_gate = (const float*)d_in[31];
    p.ln_ple_post = (const float*)d_in[32];
    p.out = (float*)d_out;
    unsigned char* w = (unsigned char*)d_ws; size_t off = 0;
    auto take = [&](size_t bytes) { void* r = w + off; off = al256(off + bytes); return r; };
    p.bar = (unsigned*)take(16384);
    p.WinT = (bf16_t*)take((size_t)INP * DM * 2); p.WnT = (bf16_t*)take((size_t)DM * DM * 2); p.WgT = nullptr;
    p.WoT = (bf16_t*)take((size_t)DM * DM * 2); p.WguT = (bf16_t*)take((size_t)2 * DFF * DM * 2); p.WdT = (bf16_t*)take((size_t)DM * DFF * 2);
    p.WpgT = (bf16_t*)take((size_t)DM * DM * 2); p.WpT = (bf16_t*)take((size_t)DM * PLE * 2); p.W1T = (bf16_t*)take((size_t)2 * 256 * 1024 * 2);
    p.H = (bf16_t*)take((size_t)MALL * DM * 2); p.Qb = (bf16_t*)take((size_t)MALL * QD * 2);
    p.CMPb = (bf16_t*)take(((size_t)MP + (size_t)NS * PAST) * 256 * 2); p.SLCb = (bf16_t*)take((size_t)MALL * 256 * 2); p.WINb = (bf16_t*)take((size_t)MALL * 256 * 2);
    p.U = (bf16_t*)take((size_t)MALL * GMD * 2); p.Vg = (bf16_t*)take((size_t)MALL * GMD * 2);
    p.GA = (bf16_t*)take((size_t)MALL * DM * 2); p.GB = (bf16_t*)take((size_t)MALL * DM * 2);
    p.GATE = (float*)take((size_t)MALL * 32 * 4);
    p.PART = (float*)take((size_t)(2048 + NS * 1024) * 4 * 256 * 4); p.PEB = (float*)take(256 * 4);
    p.KCP = (float*)take((size_t)NB * NG * 512 * 64 * 4); p.VCP = (float*)take((size_t)NB * NG * 512 * 64 * 4);
    p.KCS = (float*)take((size_t)NS * NG * 1024 * 64 * 4); p.VCS = (float*)take((size_t)NS * NG * 1024 * 64 * 4); p.KN = (float*)take(NB * NG * 128 * 4);
    p.KCb = (bf16_t*)take((size_t)NB * NG * 512 * 64 * 2); p.VCT = (bf16_t*)take((size_t)NB * NG * 64 * 512 * 2);
    p.SLCvT = (bf16_t*)take((size_t)NB * NG * 64 * SEQ * 2); p.WINvT = (bf16_t*)take((size_t)NB * NG * 64 * SEQ * 2);
    p.GWb = (bf16_t*)take(4 * 128 * 128 * 2); p.W2T = (bf16_t*)take(2 * 64 * 128 * 2);
    p.SLCkF = (bf16_t*)take((size_t)NB * NG * 64 * SEQ * 2); p.WINkF = (bf16_t*)take((size_t)NB * NG * 64 * SEQ * 2);
    p.OCAT = (bf16_t*)take((size_t)MALL * DM * 2); p.T = (float*)take((size_t)MALL * DM * 4); p.Y1 = (bf16_t*)take((size_t)MALL * DM * 2);
    p.F = (float*)take((size_t)MALL * DM * 4); p.X1 = (float*)take((size_t)MALL * DM * 4); p.H2 = (bf16_t*)take((size_t)MALL * DM * 2);
    p.ACT = (bf16_t*)take((size_t)MALL * DFF * 2); p.X2 = (float*)take((size_t)MALL * DM * 4); p.X2b = (bf16_t*)take((size_t)MALL * DM * 2);
    p.Pb = (bf16_t*)take((size_t)MALL * PLE * 2);
    if (off > ws_size) { fprintf(stderr, "workspace too small: need %zu have %zu\n", off, ws_size); return; }
    (void)hipMemsetAsync(p.OCAT + (size_t)(MP + NS) * DM, 0, (size_t)(MALL - MP - NS) * DM * 2, stream);
#if MK_MULTI
    launch_all<0>(p, 256, stream);
#else
    constexpr size_t kDynLds = LDS_BYTES + 48;
    static int grid = 0;
    if (!grid) {
        int dev = 0, cus = 0, per_cu = 0;
        (void)hipGetDevice(&dev);
        (void)hipDeviceGetAttribute(&cus, hipDeviceAttributeMultiprocessorCount, dev);
        (void)hipFuncSetAttribute((const void*)k_all, hipFuncAttributeMaxDynamicSharedMemorySize, (int)kDynLds);
        (void)hipOccupancyMaxActiveBlocksPerMultiprocessor(&per_cu, (const void*)k_all, 512, kDynLds);
        grid = cus * (per_cu < 1 ? per_cu : 1);
        if (grid <= 0) { fprintf(stderr, "k_all: occupancy query says %d blocks per CU\n", per_cu); grid = 0; return; }
    }
    (void)hipMemsetAsync(p.bar, 0, XCD_BAR_WORDS * sizeof(unsigned), stream);
    k_all<<<grid, 512, kDynLds, stream>>>(p);
#endif
}
```

```cpp
#include <hip/hip_runtime.h>
#include <stdint.h>
#include <cstdio>

typedef unsigned short bf16_t;
typedef short bf16x8 __attribute__((ext_vector_type(8)));
typedef float f32x4 __attribute__((ext_vector_type(4)));
typedef float f32x2 __attribute__((ext_vector_type(2)));
typedef unsigned u32x4 __attribute__((ext_vector_type(4)));
typedef unsigned u32x2 __attribute__((ext_vector_type(2)));
#define LAS __attribute__((address_space(3)))

constexpr int DM = 1024, NB = 4, SEQ = 8192, MP = NB * SEQ, NS = 32, MALL = MP + 256, PAST = 16384, PAGE = 128, NPG = 128;
constexpr int NH = 8, NG = 2, HPG = 4, DH = 64, QD = 512, WIN = 512, GMD = 512, DFF = 2816, PLE = 256, IND = 4376, INP = 4608;
constexpr int NCP = 511, NCS = 1023;
constexpr float EPS = 1e-6f;
constexpr float LOG2E = 1.4426950408889634f, QSCALE = 0.125f * LOG2E;
constexpr long O_YP = 0, O_YS = 33554432, O_CMPP = 33587200, O_SLCP = 41975808, O_WINP = 50364416, O_CMPS = 50888704,
               O_SLCS = 50896896, O_WINS = 50905088, O_GMV = 55099392;

struct Params {
    const float *x_prompt, *x_sample, *cache_cmp, *cache_slc, *state_win; const int* page_table;
    const float *p_prompt, *p_sample, *rel_bias, *ln_mix_pre, *w_in, *pe_k, *w1_k, *w2_k, *pe_v, *w1_v, *w2_v;
    const float *gm_ln_g, *gm_ln_b, *gm_ws, *gm_bs, *w_br_nsa, *w_br_gm, *w_out, *ln_mix_post, *ln_ffn_pre;
    const float *w_gate, *w_up, *w_down, *ln_ffn_post, *w_ple, *w_ple_gate, *ln_ple_post;
    float* out;
    unsigned* bar;
    bf16_t *WinT, *WnT, *WgT, *WoT, *WguT, *WdT, *WpgT, *WpT, *W1T;
    bf16_t *H, *Qb, *CMPb, *SLCb, *WINb, *U, *Vg, *GA, *GB;
    float* GATE;
    float *PART, *PEB, *KCP, *VCP, *KCS, *VCS, *KN;
    bf16_t *KCb, *VCT, *SLCvT, *WINvT, *SLCkF, *WINkF, *GWb, *W2T;
    bf16_t* OCAT; float* T; bf16_t* Y1; float* F; float* X1; bf16_t* H2; bf16_t* ACT; float* X2; bf16_t* X2b; bf16_t* Pb;
};

__device__ __forceinline__ unsigned cvt_pk_bf16(float lo, float hi) { unsigned r; asm volatile("v_cvt_pk_bf16_f32 %0, %1, %2" : "=v"(r) : "v"(lo), "v"(hi)); return r; }
__device__ __forceinline__ bf16_t f2bf(float f) { return (bf16_t)(cvt_pk_bf16(f, 0.f) & 0xffffu); }
__device__ __forceinline__ float bf2f(bf16_t h) { return __uint_as_float(((unsigned)h) << 16); }
__device__ __forceinline__ float bflo(unsigned w) { return __uint_as_float(w << 16); }
__device__ __forceinline__ float bfhi(unsigned w) { return __uint_as_float(w & 0xffff0000u); }
__device__ __forceinline__ float ex2(float x) { return __builtin_amdgcn_exp2f(x); }
__device__ __forceinline__ float sigmoidf_(float x) { return 1.0f / (1.0f + __expf(-x)); }
__device__ __forceinline__ float siluf_(float x) { return x * sigmoidf_(x); }
__device__ __forceinline__ float geluf_(float x) {
    const float u = 0.7978845608028654f * (x + 0.044715f * x * x * x);
    const float e = __expf(2.0f * u);
    const float th = 1.0f - 2.0f / (e + 1.0f);
    return 0.5f * x * (1.0f + th);
}
__device__ __forceinline__ float wave_sum(float v) {
#pragma unroll
    for (int o = 32; o > 0; o >>= 1) v += __shfl_xor(v, o);
    return v;
}
__device__ __forceinline__ float wave_max(float v) {
#pragma unroll
    for (int o = 32; o > 0; o >>= 1) v = fmaxf(v, __shfl_xor(v, o));
    return v;
}
__device__ __forceinline__ int t5_bucket(int d) {
    if (d < 16) return d;
    if (d >= 128) return 31;
    const int b = 16 + (int)(__logf((float)d * (1.0f / 16.0f)) * (16.0f / 2.0794415416798357f));
    return b < 31 ? b : 31;
}

extern __shared__ __attribute__((aligned(16))) unsigned char smem[];
#ifndef PROBE_DUP
#define PROBE_DUP 0
#endif
#define PROBE_LDS_OFF 131072
#ifndef PROBE_SPIN
#define PROBE_SPIN 0
#endif
#ifndef PROBE_SEG
#define PROBE_SEG 5
#endif
__device__ __forceinline__ unsigned long long probe_now() { unsigned long long t; asm volatile("s_memrealtime %0\n\ts_waitcnt lgkmcnt(0)" : "=s"(t) :: "memory"); return t; }
#define PROBE_TS ((volatile LAS unsigned long long*)((LAS unsigned char*)smem + PROBE_LDS_OFF + 16))
#if PROBE_SPIN
#define PROBE_BEGIN(seg) unsigned long long pb_##seg = 0; if (PROBE_SEG == seg && threadIdx.x == 0) pb_##seg = probe_now();
#define PROBE_END(seg) if (PROBE_SEG == seg && threadIdx.x == 0) { PROBE_TS[2] = PROBE_TS[2] + (probe_now() - pb_##seg); }
#else
#define PROBE_BEGIN(seg)
#define PROBE_END(seg)
#endif

constexpr int BM = 256, BK = 64, HALF = 128, HT = HALF * BK, GEMM_LDS = 8 * HT * 2;
__device__ __forceinline__ int lds_byte(int r, int c) { const int st = (r >> 4) * 2 + (c >> 5), rr = r & 15, cc = c & 31, ob = rr * 64 + cc * 2; return st * 1024 + (ob ^ (((ob >> 9) & 1) << 5)); }
__device__ __forceinline__ void stage_rc(int b, int& R, int& C) { const int st = b / 1024, sb = b % 1024, swz = sb ^ (((sb >> 9) & 1) << 5); R = (st >> 1) * 16 + swz / 64; C = (st & 1) * 32 + (swz % 64) / 2; }

constexpr int HTB = HALF * BK * 2;
template <class F>
__device__ __forceinline__ void for_each_frag(const f32x4 (&acc)[2][2][4][2], int brow, int bcol, int wr, int wc, int fr, int fq, F&& f) {
#pragma unroll
    for (int ai = 0; ai < 2; ++ai)
#pragma unroll
        for (int m = 0; m < 4; ++m)
#pragma unroll
            for (int bj = 0; bj < 2; ++bj)
#pragma unroll
                for (int n = 0; n < 2; ++n)
                    f(brow + ai * HALF + wr * 64 + m * 16 + fr, bcol + bj * HALF + wc * 32 + n * 16 + fq * 4, acc[ai][bj][m][n]);
}

struct ZNone { __device__ __forceinline__ size_t a(int) const { return 0; } __device__ __forceinline__ size_t b(int) const { return 0; } };
template <class Epi, class ZMap = ZNone, bool HAS_MID = false>
__device__ __forceinline__ void gemm_phase(const bf16_t* A, int lda, const bf16_t* Bt, int K, int nM, int nN, const Epi& E, int nZ = 1, ZMap zm = ZMap(), int kstepA_el = BK) {
    LAS unsigned char* lds = (LAS unsigned char*)smem;
    int tid = threadIdx.x; asm volatile("" : "+v"(tid));
    const int wid = __builtin_amdgcn_readfirstlane(tid >> 6), lane = tid & 63, wr = wid >> 2, wc = wid & 3, fr = lane & 15, fq = lane >> 4;
    const int nt = K / BK, nmn = nM * nN, nu = nmn * nZ, G = gridDim.x;
    int u = blockIdx.x;
    if (u >= nu) return;
    unsigned voffA[2], voffB[2];
#pragma unroll
    for (int i = 0; i < 2; ++i) { int R, C; stage_rc(tid * 16 + i * 8192, R, C); voffA[i] = (unsigned)(R * lda + C) * 2u; voffB[i] = (unsigned)(R * K + C) * 2u; }
    const size_t kstep = (size_t)(BK * 2), kstepA = (size_t)kstepA_el * 2;
    const size_t hstepA = (size_t)HALF * lda * 2, hstepB = (size_t)HALF * K * 2, tstepA = 2 * hstepA, tstepB = 2 * hstepB;
    const unsigned ldsw = (unsigned)wid * 1024u;
    const int aoff = lds_byte(wr * 64 + fr, fq * 8), boff = lds_byte(wc * 32 + fr, fq * 8);
#define PG8_SA(b, h) (((b) * 2 + (h)) * HTB)
#define PG8_SB(b, h) ((4 + (b) * 2 + (h)) * HTB)
#define PG8_STAGE(bufoff, gbase, voff) do { _Pragma("unroll") for (int _i = 0; _i < 2; ++_i) \
        __builtin_amdgcn_global_load_lds((const unsigned*)((const char*)(gbase) + (voff)[_i]), (LAS unsigned*)(lds + (bufoff) + ldsw + _i * 8192), 16, 0, 0); } while (0)
#define PG8_LDA(dst, b, h) do { _Pragma("unroll") for (int m = 0; m < 4; ++m) _Pragma("unroll") for (int k = 0; k < 2; ++k) dst[m][k] = *(const LAS bf16x8*)(lds + PG8_SA(b, h) + aoff + m * 2048 + k * 1024); } while (0)
#define PG8_LDB(dst, b, h) do { _Pragma("unroll") for (int n = 0; n < 2; ++n) _Pragma("unroll") for (int k = 0; k < 2; ++k) dst[n][k] = *(const LAS bf16x8*)(lds + PG8_SB(b, h) + boff + n * 2048 + k * 1024); } while (0)
#define PG8_MMA(ai, bj, At, Bt_) do { __builtin_amdgcn_s_setprio(1); _Pragma("unroll") for (int m = 0; m < 4; ++m) _Pragma("unroll") for (int n = 0; n < 2; ++n) _Pragma("unroll") for (int k = 0; k < 2; ++k) \
        acc[ai][bj][m][n] = __builtin_amdgcn_mfma_f32_16x16x32_bf16(Bt_[n][k], At[m][k], acc[ai][bj][m][n], 0, 0, 0); __builtin_amdgcn_s_setprio(0); } while (0)
#define PG8_WAIT_V(n) asm volatile("s_waitcnt vmcnt(" #n ")" ::: "memory")
#define PG8_WAIT_L(n) asm volatile("s_waitcnt lgkmcnt(" #n ")" ::: "memory")
#define PG8_BAR __builtin_amdgcn_s_barrier()
#define PG8_SCHED __builtin_amdgcn_sched_barrier(0)
    f32x4 acc[2][2][4][2];
#pragma unroll
    for (int a = 0; a < 2; ++a)
#pragma unroll
        for (int b = 0; b < 2; ++b)
#pragma unroll
            for (int m = 0; m < 4; ++m)
#pragma unroll
                for (int n = 0; n < 2; ++n) acc[a][b][m][n] = (f32x4){0.f, 0.f, 0.f, 0.f};
    bf16x8 At[4][2], B0[2][2], B1[2][2];
    auto unit_of = [&](int uu, int& z_, int& pm_, int& pn_) {
        if (nZ == 1) {
            int wg = uu; { const int q = nu / 8, r = nu % 8, xcd = wg % 8, off = wg / 8; wg = (xcd < r ? xcd * (q + 1) : r * (q + 1) + (xcd - r) * q) + off; }
            const int nig = 8 * nN, gid = wg / nig, fm = gid * 8, gsz = (nM - fm) < 8 ? (nM - fm) : 8;
            z_ = 0; pm_ = fm + ((wg % nig) % gsz); pn_ = (wg % nig) / gsz;
        } else { z_ = uu / nmn; pm_ = (uu - z_ * nmn) / nN; pn_ = (uu - z_ * nmn) - pm_ * nN; }
    };
    int z, pm, pn; unit_of(u, z, pm, pn);
    const char* cA = (const char*)(A + zm.a(z)) + (size_t)pm * tstepA; const char* cB = (const char*)(Bt + zm.b(z)) + (size_t)pn * tstepB;
    PG8_STAGE(PG8_SB(0, 0), cB, voffB); PG8_STAGE(PG8_SA(0, 0), cA, voffA); PG8_STAGE(PG8_SB(0, 1), cB + hstepB, voffB); PG8_STAGE(PG8_SA(0, 1), cA + hstepA, voffA);
    if (wr == 1) PG8_BAR;
    PG8_WAIT_V(4); PG8_BAR;
    PG8_STAGE(PG8_SB(1, 0), cB + kstep, voffB); PG8_STAGE(PG8_SA(1, 0), cA + kstepA, voffA); PG8_STAGE(PG8_SB(1, 1), cB + hstepB + kstep, voffB);
    PG8_WAIT_V(6); PG8_BAR;
    for (;;) {
        const int un = u + G; const bool has_next = un < nu;
        int nz = z, npm = pm, npn = pn; if (has_next) unit_of(un, nz, npm, npn);
        const char* nA = (const char*)(A + zm.a(nz)) + (size_t)npm * tstepA; const char* nB = (const char*)(Bt + zm.b(nz)) + (size_t)npn * tstepB;
        auto kiter = [&](int t) {
            const bool last = (t == nt - 2);
            const char* a1 = cA + (size_t)(t + 1) * kstepA;
            const char* a2 = last ? nA : cA + (size_t)(t + 2) * kstepA; const char* b2 = last ? nB : cB + (size_t)(t + 2) * kstep;
            const char* a3 = a2 + kstepA; const char* b3 = b2 + kstep;
            PG8_LDB(B0, 0, 0); PG8_SCHED; PG8_LDA(At, 0, 0); PG8_STAGE(PG8_SA(1, 1), a1 + hstepA, voffA);
            PG8_WAIT_L(8); PG8_BAR; PG8_WAIT_L(0); PG8_MMA(0, 0, At, B0); PG8_BAR; PG8_SCHED;
            PG8_LDB(B1, 0, 1); PG8_STAGE(PG8_SB(0, 0), b2, voffB);
            PG8_BAR; PG8_WAIT_L(0); PG8_MMA(0, 1, At, B1); PG8_BAR;
            PG8_LDA(At, 0, 1); PG8_STAGE(PG8_SA(0, 0), a2, voffA);
            PG8_BAR; PG8_WAIT_L(0); PG8_MMA(1, 0, At, B0); PG8_BAR; PG8_SCHED;
            PG8_STAGE(PG8_SB(0, 1), b2 + hstepB, voffB);
            PG8_WAIT_V(6); PG8_BAR; PG8_MMA(1, 1, At, B1); PG8_BAR;
            PG8_LDB(B0, 1, 0); PG8_SCHED; PG8_LDA(At, 1, 0); PG8_STAGE(PG8_SA(0, 1), a2 + hstepA, voffA);
            PG8_WAIT_L(8); PG8_BAR; PG8_WAIT_L(0); PG8_MMA(0, 0, At, B0); PG8_BAR; PG8_SCHED;
            PG8_LDB(B1, 1, 1); PG8_STAGE(PG8_SB(1, 0), b3, voffB);
            PG8_BAR; PG8_WAIT_L(0); PG8_MMA(0, 1, At, B1); PG8_BAR;
            PG8_LDA(At, 1, 1); PG8_STAGE(PG8_SA(1, 0), a3, voffA);
            PG8_BAR; PG8_WAIT_L(0); PG8_MMA(1, 0, At, B0); PG8_BAR; PG8_SCHED;
            PG8_STAGE(PG8_SB(1, 1), b3 + hstepB, voffB);
            PG8_WAIT_V(6); PG8_BAR; PG8_MMA(1, 1, At, B1); PG8_BAR;
        };
        if constexpr (HAS_MID) {
            for (int t = 0; t < (nt >> 1); t += 2) kiter(t);
            E.mid(acc, pm * BM, pn * BM, wr, wc, fr, fq);
            for (int t = nt >> 1; t < nt; t += 2) kiter(t);
        } else {
            for (int t = 0; t < nt; t += 2) kiter(t);
        }
        E(acc, pm * BM, pn * BM + (z << 20), wr, wc, fr, fq);
        if (!has_next) break;
#pragma unroll
        for (int a = 0; a < 2; ++a)
#pragma unroll
            for (int b = 0; b < 2; ++b)
#pragma unroll
                for (int m = 0; m < 4; ++m)
#pragma unroll
                    for (int n = 0; n < 2; ++n) acc[a][b][m][n] = (f32x4){0.f, 0.f, 0.f, 0.f};
        u = un; z = nz; pm = npm; pn = npn; cA = nA; cB = nB;
    }
    PG8_WAIT_V(0);
    if (wr == 0) PG8_BAR;
    PG8_BAR;
#undef PG8_SA
#undef PG8_SB
#undef PG8_STAGE
#undef PG8_LDA
#undef PG8_LDB
#undef PG8_MMA
#undef PG8_WAIT_V
#undef PG8_WAIT_L
#undef PG8_BAR
#undef PG8_SCHED
}

__device__ __forceinline__ f32x4 mfma16(bf16x8 a, bf16x8 b, f32x4 c) { return __builtin_amdgcn_mfma_f32_16x16x32_bf16(a, b, c, 0, 0, 0); }
__device__ __forceinline__ bf16x8 pack_p(const f32x4& a, const f32x4& b) {
    u32x4 w; w.x = cvt_pk_bf16(a[0], a[1]); w.y = cvt_pk_bf16(a[2], a[3]); w.z = cvt_pk_bf16(b[0], b[1]); w.w = cvt_pk_bf16(b[2], b[3]);
    return __builtin_bit_cast(bf16x8, w);
}
__device__ __forceinline__ size_t kfrag_off(int key, int d) { return ((size_t)((key >> 4) * 2 + (d >> 5)) * 64 + ((d >> 3) & 3) * 16 + (key & 15)) * 8 + (d & 7); }
__device__ __forceinline__ size_t vfrag_off(int key, int d) {
    return ((size_t)((key >> 5) * 4 + (d >> 4)) * 64 + ((key >> 2) & 3) * 16 + (d & 15)) * 8 + ((key >> 4) & 1) * 4 + (key & 3);
}
__device__ __forceinline__ void st_bf16x4(bf16_t* p, f32x4 v) { u32x2 w; w.x = cvt_pk_bf16(v[0], v[1]); w.y = cvt_pk_bf16(v[2], v[3]); *(u32x2*)p = w; }

struct EpiIn {
    const Params& p;
    __device__ __forceinline__ void apply(int row, int col, f32x4 v) const {
        const Params& P = p; const int pn = col >> 8, c = col & 255;
        if (pn < 2) st_bf16x4(P.Qb + (size_t)row * QD + col, v * QSCALE);
        else if (pn < 5) {
            if (pn != 2) st_bf16x4((pn == 3 ? P.SLCb : P.WINb) + (size_t)row * 256 + c, v);
            if (pn < 4) *(f32x4*)(P.out + (pn == 2 ? O_CMPS : O_SLCS) + (size_t)(row - MP) * 256 + c) = v;
            else *(f32x4*)(P.out + O_WINS + ((size_t)(row - MP) * WIN + (WIN - 1)) * 256 + c) = v;
        } else if (pn < 9) {
            f32x4 g; g[0] = geluf_(v[0]); g[1] = geluf_(v[1]); g[2] = geluf_(v[2]); g[3] = geluf_(v[3]);
            st_bf16x4((pn < 7 ? P.U : P.Vg) + (size_t)row * GMD + (col - (pn < 7 ? 1280 : 1792)), g);
        } else if (pn < 17) {
            f32x4 g; g[0] = sigmoidf_(v[0]); g[1] = sigmoidf_(v[1]); g[2] = sigmoidf_(v[2]); g[3] = sigmoidf_(v[3]);
            st_bf16x4((pn < 13 ? P.GA : P.GB) + (size_t)row * DM + (col - (pn < 13 ? 2304 : 3328)), g);
        } else if (c < 24) { f32x4 g; g[0] = sigmoidf_(v[0]); g[1] = sigmoidf_(v[1]); g[2] = sigmoidf_(v[2]); g[3] = sigmoidf_(v[3]); *(f32x4*)(P.GATE + (size_t)row * 32 + c) = g; }
    }
    __device__ __forceinline__ void operator()(const f32x4 (&acc)[2][2][4][2], int brow, int bcol, int wr, int wc, int fr, int fq) const {
        const int pn = bcol >> 8;
        const Params& P = p;
        if (pn < 2) {
            for_each_frag(acc, brow, bcol, wr, wc, fr, fq, [&](int row, int col, f32x4 v) { st_bf16x4(P.Qb + (size_t)row * QD + col, v * QSCALE); });
        } else if (pn < 5) {
            bf16_t* cp = pn == 2 ? P.CMPb : pn == 3 ? P.SLCb : P.WINb;
            for_each_frag(acc, brow, bcol, wr, wc, fr, fq, [&](int row, int col, f32x4 v) {
                const int c = col & 255;
                if (pn == 2) st_bf16x4(cp + (size_t)row * 256 + c, v);
                if (pn >= 3 && c < 128 && row < MP) {
                    st_bf16x4((pn == 3 ? P.SLCkF : P.WINkF) + ((size_t)(row >> 13) * NG + (c >> 6)) * SEQ * 64 + kfrag_off(row & (SEQ - 1), c & 63), v);
                }
                if (pn >= 3 && c >= 128 && row < MP) {
                    const int t = row & (SEQ - 1), dc = c - 128;
                    bf16_t* vt = (pn == 3 ? P.SLCvT : P.WINvT) + ((size_t)(row >> 13) * NG + (dc >> 6)) * SEQ * 64 + vfrag_off(t, dc & 63);
                    vt[0] = f2bf(v[0]); vt[8] = f2bf(v[1]); vt[16] = f2bf(v[2]); vt[24] = f2bf(v[3]);
                }
                if (pn < 4) {
                    if (row < MP) *(f32x4*)(P.out + (pn == 2 ? O_CMPP : O_SLCP) + (size_t)row * 256 + c) = v;
                    else if (row < MP + NS) *(f32x4*)(P.out + (pn == 2 ? O_CMPS : O_SLCS) + (size_t)(row - MP) * 256 + c) = v;
                } else {
                    if (row < MP) { const int t = row & (SEQ - 1), b = row >> 13; if (t >= SEQ - WIN) *(f32x4*)(P.out + O_WINP + ((size_t)b * WIN + (t - (SEQ - WIN))) * 256 + c) = v; }
                    else if (row < MP + NS) *(f32x4*)(P.out + O_WINS + ((size_t)(row - MP) * WIN + (WIN - 1)) * 256 + c) = v;
                }
            });
        } else if (pn < 9) {
            bf16_t* dst = pn < 7 ? P.U : P.Vg; const int c0 = pn < 7 ? 1280 : 1792;
            for_each_frag(acc, brow, bcol, wr, wc, fr, fq, [&](int row, int col, f32x4 v) {
                f32x4 g; g[0] = geluf_(v[0]); g[1] = geluf_(v[1]); g[2] = geluf_(v[2]); g[3] = geluf_(v[3]);
                st_bf16x4(dst + (size_t)row * GMD + (col - c0), g); });
        } else if (pn < 17) {
            bf16_t* dst = pn < 13 ? P.GA : P.GB; const int c0 = pn < 13 ? 2304 : 3328;
            for_each_frag(acc, brow, bcol, wr, wc, fr, fq, [&](int row, int col, f32x4 v) {
                f32x4 g; g[0] = sigmoidf_(v[0]); g[1] = sigmoidf_(v[1]); g[2] = sigmoidf_(v[2]); g[3] = sigmoidf_(v[3]);
                st_bf16x4(dst + (size_t)row * DM + (col - c0), g); });
        } else {
            for_each_frag(acc, brow, bcol, wr, wc, fr, fq, [&](int row, int col, f32x4 v) {
                const int c = col & 255;
                if (c < 24) { f32x4 g; g[0] = sigmoidf_(v[0]); g[1] = sigmoidf_(v[1]); g[2] = sigmoidf_(v[2]); g[3] = sigmoidf_(v[3]); *(f32x4*)(P.GATE + (size_t)row * 32 + c) = g; } });
        }
    }
};
struct EpiBranch {
    const bf16_t* GA; const bf16_t* GB; bf16_t* Y1;
    __device__ __forceinline__ void mid(f32x4 (&acc)[2][2][4][2], int brow, int bcol, int wr, int wc, int fr, int fq) const {
#pragma unroll
        for (int ai = 0; ai < 2; ++ai)
#pragma unroll
            for (int m = 0; m < 4; ++m)
#pragma unroll
                for (int bj = 0; bj < 2; ++bj)
#pragma unroll
                    for (int n = 0; n < 2; ++n) {
                        const size_t o = (size_t)(brow + ai * HALF + wr * 64 + m * 16 + fr) * DM + bcol + bj * HALF + wc * 32 + n * 16 + fq * 4;
                        const u32x2 a = *(const u32x2*)(GA + o), b = *(const u32x2*)(GB + o);
                        f32x4& v = acc[ai][bj][m][n];
                        v[0] *= bflo(a.x) / fmaxf(bflo(b.x), 1e-30f); v[1] *= bfhi(a.x) / fmaxf(bfhi(b.x), 1e-30f);
                        v[2] *= bflo(a.y) / fmaxf(bflo(b.y), 1e-30f); v[3] *= bfhi(a.y) / fmaxf(bfhi(b.y), 1e-30f);
                        if (bj == 1 && n == 1) __builtin_amdgcn_sched_barrier(0);
                    }
    }
    __device__ __forceinline__ void operator()(const f32x4 (&acc)[2][2][4][2], int brow, int bcol, int wr, int wc, int fr, int fq) const {
        for_each_frag(acc, brow, bcol, wr, wc, fr, fq, [&](int row, int col, f32x4 v) {
            const u32x2 b = *(const u32x2*)(GB + (size_t)row * DM + col);
            f32x4 o; o[0] = v[0] * fmaxf(bflo(b.x), 1e-30f); o[1] = v[1] * fmaxf(bfhi(b.x), 1e-30f); o[2] = v[2] * fmaxf(bflo(b.y), 1e-30f); o[3] = v[3] * fmaxf(bfhi(b.y), 1e-30f);
            st_bf16x4(Y1 + (size_t)row * DM + col, o); });
    }
    __device__ __forceinline__ void apply2(int row, int col, f32x4 v1, f32x4 v2) const {
        const u32x2 a = *(const u32x2*)(GA + (size_t)row * DM + col), b = *(const u32x2*)(GB + (size_t)row * DM + col);
        f32x4 o; o[0] = v1[0] * bflo(a.x) + v2[0] * bflo(b.x); o[1] = v1[1] * bfhi(a.x) + v2[1] * bfhi(b.x); o[2] = v1[2] * bflo(a.y) + v2[2] * bflo(b.y); o[3] = v1[3] * bfhi(a.y) + v2[3] * bfhi(b.y);
        st_bf16x4(Y1 + (size_t)row * DM + col, o);
    }
};
struct EpiF32 {
    float* F; int ld;
    __device__ __forceinline__ void apply(int row, int col, f32x4 v) const { *(f32x4*)(F + (size_t)row * ld + col) = v; }
    __device__ __forceinline__ void operator()(const f32x4 (&acc)[2][2][4][2], int brow, int bcol, int wr, int wc, int fr, int fq) const {
        for_each_frag(acc, brow, bcol, wr, wc, fr, fq, [&](int row, int col, f32x4 v) { *(f32x4*)(F + (size_t)row * ld + col) = v; });
    }
};
struct EpiBf16 {
    bf16_t* O; int ld;
    __device__ __forceinline__ void apply(int row, int col, f32x4 v) const { st_bf16x4(O + (size_t)row * ld + col, v); }
    __device__ __forceinline__ void operator()(const f32x4 (&acc)[2][2][4][2], int brow, int bcol, int wr, int wc, int fr, int fq) const {
        for_each_frag(acc, brow, bcol, wr, wc, fr, fq, [&](int row, int col, f32x4 v) { apply(row, col, v); });
    }
};
struct EpiPart {
    bf16_t* PART;
    __device__ __forceinline__ void operator()(const f32x4 (&acc)[2][2][4][2], int brow, int bcol, int wr, int wc, int fr, int fq) const {
        const int z = bcol >> 20;
        for_each_frag(acc, brow, 0, wr, wc, fr, fq, [&](int row, int col, f32x4 v) { st_bf16x4(PART + ((size_t)row * 4 + z) * 256 + col, v); });
    }
};
struct ZCmp { __device__ __forceinline__ size_t a(int z) const { return (size_t)z * 64; } __device__ __forceinline__ size_t b(int z) const { return (size_t)(z >> 1) * 256 * 1024; } };
struct EpiSwiGLU {
    bf16_t* ACT;
    __device__ __forceinline__ void apply(int row, int col, f32x4 v) const { *(unsigned*)(ACT + (size_t)row * DFF + (col >> 1)) = cvt_pk_bf16(siluf_(v[0]) * v[1], siluf_(v[2]) * v[3]); }
    __device__ __forceinline__ void operator()(const f32x4 (&acc)[2][2][4][2], int brow, int bcol, int wr, int wc, int fr, int fq) const {
        for_each_frag(acc, brow, bcol, wr, wc, fr, fq, [&](int row, int col, f32x4 v) {
            *(unsigned*)(ACT + (size_t)row * DFF + (col >> 1)) = cvt_pk_bf16(siluf_(v[0]) * v[1], siluf_(v[2]) * v[3]); });
    }
};
struct EpiPleGate {
    const bf16_t* E; bf16_t* F;
    __device__ __forceinline__ void apply(int row, int col, f32x4 v) const {
        const u32x2 w = *(const u32x2*)(E + (size_t)row * DM + col);
        f32x4 o; o[0] = sigmoidf_(v[0]) * bflo(w.x); o[1] = sigmoidf_(v[1]) * bfhi(w.x); o[2] = sigmoidf_(v[2]) * bflo(w.y); o[3] = sigmoidf_(v[3]) * bfhi(w.y);
        st_bf16x4(F + (size_t)row * DM + col, o); }
    __device__ __forceinline__ void operator()(const f32x4 (&acc)[2][2][4][2], int brow, int bcol, int wr, int wc, int fr, int fq) const {
        for_each_frag(acc, brow, bcol, wr, wc, fr, fq, [&](int row, int col, f32x4 v) { apply(row, col, v); });
    }
};

template <class Epi>
__device__ __forceinline__ void gemm_skinny(const bf16_t* A  , int lda, const bf16_t* Bt, int K, int N, const Epi& E) {
    int tid = threadIdx.x; asm volatile("" : "+v"(tid));
    const int wid = __builtin_amdgcn_readfirstlane(tid >> 6), lane = tid & 63, c = lane & 15, G = lane >> 4;
    LAS f32x4* red = (LAS f32x4*)smem;
    const int nsteps = K / 32;
#pragma unroll 1
    for (int ct = blockIdx.x; ct < N / 16; ct += gridDim.x) {
        f32x4 acc0 = {0.f, 0.f, 0.f, 0.f}, acc1 = {0.f, 0.f, 0.f, 0.f};
        const bf16_t* bp = Bt + (size_t)(ct * 16 + c) * K + G * 8;
        const bf16_t* a0 = A + (size_t)c * lda + G * 8; const bf16_t* a1 = A + (size_t)(16 + c) * lda + G * 8;
#pragma unroll 4
        for (int kk = wid; kk < nsteps; kk += 8) {
            const bf16x8 bf = *(const bf16x8*)(bp + kk * 32), x0 = *(const bf16x8*)(a0 + kk * 32), x1 = *(const bf16x8*)(a1 + kk * 32);
            acc0 = mfma16(bf, x0, acc0); acc1 = mfma16(bf, x1, acc1);
        }
        __syncthreads();
        red[(wid * 2 + 0) * 64 + lane] = acc0; red[(wid * 2 + 1) * 64 + lane] = acc1;
        __syncthreads();
        if (tid < 128) {
            const int rt = tid >> 6;
            f32x4 v = red[rt * 64 + lane];
#pragma unroll
            for (int w = 1; w < 8; ++w) v = v + red[(w * 2 + rt) * 64 + lane];
            E.apply(MP + rt * 16 + c, ct * 16 + 4 * G, v);
        }
    }
    __syncthreads();
}

template <class Epi>
__device__ __forceinline__ void gemm_skinny2(const bf16_t* A  , int lda, const bf16_t* Bt, int K, int N, const Epi& E) {
    int tid = threadIdx.x; asm volatile("" : "+v"(tid));
    const int wid = __builtin_amdgcn_readfirstlane(tid >> 6), lane = tid & 63, c = lane & 15, G = lane >> 4;
    LAS f32x4* red = (LAS f32x4*)smem;
    const int hsteps = K / 64;
#pragma unroll 1
    for (int ct = blockIdx.x; ct < N / 16; ct += gridDim.x) {
        f32x4 acc[4] = {{0.f, 0.f, 0.f, 0.f}, {0.f, 0.f, 0.f, 0.f}, {0.f, 0.f, 0.f, 0.f}, {0.f, 0.f, 0.f, 0.f}};
        const bf16_t* bp = Bt + (size_t)(ct * 16 + c) * K + G * 8;
        const bf16_t* a0 = A + (size_t)c * lda + G * 8; const bf16_t* a1 = A + (size_t)(16 + c) * lda + G * 8;
#pragma unroll
        for (int h = 0; h < 2; ++h) {
#pragma unroll 2
            for (int kk = h * hsteps + wid; kk < (h + 1) * hsteps; kk += 8) {
                const bf16x8 bf = *(const bf16x8*)(bp + kk * 32), x0 = *(const bf16x8*)(a0 + kk * 32), x1 = *(const bf16x8*)(a1 + kk * 32);
                acc[h * 2] = mfma16(bf, x0, acc[h * 2]); acc[h * 2 + 1] = mfma16(bf, x1, acc[h * 2 + 1]);
            }
        }
        __syncthreads();
#pragma unroll
        for (int q = 0; q < 4; ++q) red[(wid * 4 + q) * 64 + lane] = acc[q];
        __syncthreads();
        if (tid < 128) {
            const int rt = tid >> 6;
            f32x4 v1 = red[rt * 64 + lane], v2 = red[(2 + rt) * 64 + lane];
#pragma unroll
            for (int w = 1; w < 8; ++w) { v1 = v1 + red[(w * 4 + rt) * 64 + lane]; v2 = v2 + red[(w * 4 + 2 + rt) * 64 + lane]; }
            E.apply2(MP + rt * 16 + c, ct * 16 + 4 * G, v1, v2);
        }
    }
    __syncthreads();
}

template <class Map>
__device__ __forceinline__ void transpose_tile(const float* W, int K, int N, bf16_t* Wt, int ldk, int kt, int ntile, Map map) {
    LAS float* tile = (LAS float*)smem;
    const int t = threadIdx.x;
    __syncthreads();
#pragma unroll
    for (int i = 0; i < 2; ++i) {
        const int k = (t >> 4) + 32 * i, n = (t & 15) * 4, gn = ntile * 64 + n;
        f32x4 v = (f32x4){0.f, 0.f, 0.f, 0.f};
        if (gn < N) v = *(const f32x4*)(W + (size_t)(kt * 64 + k) * N + gn);
        tile[k * 65 + n] = v[0]; tile[k * 65 + n + 1] = v[1]; tile[k * 65 + n + 2] = v[2]; tile[k * 65 + n + 3] = v[3];
    }
    __syncthreads();
    const int n = t >> 3, kc = (t & 7) * 8, gn = ntile * 64 + n;
    if (gn < N) {
        u32x4 w;
        w.x = cvt_pk_bf16(tile[(kc + 0) * 65 + n], tile[(kc + 1) * 65 + n]); w.y = cvt_pk_bf16(tile[(kc + 2) * 65 + n], tile[(kc + 3) * 65 + n]);
        w.z = cvt_pk_bf16(tile[(kc + 4) * 65 + n], tile[(kc + 5) * 65 + n]); w.w = cvt_pk_bf16(tile[(kc + 6) * 65 + n], tile[(kc + 7) * 65 + n]);
        *(u32x4*)(Wt + (size_t)map(gn) * ldk + kt * 64 + kc) = w;
    }
}
template <class Map>
__device__ __forceinline__ void transpose_all(const float* W, int K, int N, bf16_t* Wt, int ldk, Map map, int& base) {
    const int nkt = K / 64, nnt = (N + 63) / 64, ntl = nkt * nnt;
    for (int it = blockIdx.x; it < base + ntl; it += gridDim.x) {
        if (it < base) continue;
        const int l = it - base;
        transpose_tile(W, K, N, Wt, ldk, l / nnt, l % nnt, map);
    }
    base += ntl;
}
template <class Map>
__device__ __forceinline__ void transpose_all_sub(const float* W, int K, int N, bf16_t* Wt, int ldk, Map map, int& base) {
    const int nkt = K / 64, nnt = (N + 63) / 64, ntl = nkt * nnt, nb = gridDim.x - 32, me = blockIdx.x - 32;
    int first = base - (base % nb) + me; if (first < base) first += nb;
    for (int it = first; it < base + ntl; it += nb) { const int l = it - base; transpose_tile(W, K, N, Wt, ldk, l / nnt, l % nnt, map); }
    base += ntl;
}
__device__ __forceinline__ int map_win(int n) {
    if (n < 1280) return n;
    if (n < 1304) return 4352 + (n - 1280);
    if (n < 2328) return 1280 + (n - 1304);
    return 2304 + (n - 2328);
}

__device__ __forceinline__ float row_rstd(const f32x4 (&v)[4]) {
    float s = 0.f;
#pragma unroll
    for (int k = 0; k < 4; ++k) s += v[k][0] * v[k][0] + v[k][1] * v[k][1] + v[k][2] * v[k][2] + v[k][3] * v[k][3];
    s = wave_sum(s);
    return rsqrtf(s * (1.0f / DM) + EPS);
}
__device__ __forceinline__ const float* xrow_ptr(const Params& p, int row) {
    return row < MP ? p.x_prompt + (size_t)row * DM : p.x_sample + (size_t)(row - MP) * DM;
}

__device__ __forceinline__ void phase_prologue(const Params& p) {
    const int wid = threadIdx.x >> 6, lane = threadIdx.x & 63;
    const int gw = blockIdx.x * 8 + wid, nw = gridDim.x * 8;
    auto do_transposes = [&]() {
    int base = 0;
    transpose_all(p.w_in, DM, IND, p.WinT, DM, [](int n) { return map_win(n); }, base);
    for (int kv = 0; kv < 2; ++kv) for (int j = 0; j < 2; ++j)
        transpose_all((kv ? p.w1_v : p.w1_k) + (size_t)j * 1024 * 128, 1024, 128, p.W1T + ((size_t)kv * 256 + j * 128) * 1024, 1024, [](int n) { return n; }, base);
    };
    auto do_gather = [&]() {
#pragma unroll 1
    for (int r8 = gw; r8 < NS * PAST / 8; r8 += nw) {
        const int r = r8 * 8, b = r >> 14, pos = r & (PAST - 1), l5 = lane & 31, hrow = lane >> 5;
        const float* s = p.cache_cmp + ((size_t)p.page_table[b * NPG + (pos >> 7)] * PAGE + (pos & 127) + hrow) * 256 + l5 * 8;
        f32x4 a[4], cc[4];
#pragma unroll
        for (int k = 0; k < 4; ++k) { a[k] = *(const f32x4*)(s + (size_t)k * 512); cc[k] = *(const f32x4*)(s + (size_t)k * 512 + 4); }
#pragma unroll
        for (int k = 0; k < 4; ++k) {
            u32x4 w; w.x = cvt_pk_bf16(a[k][0], a[k][1]); w.y = cvt_pk_bf16(a[k][2], a[k][3]); w.z = cvt_pk_bf16(cc[k][0], cc[k][1]); w.w = cvt_pk_bf16(cc[k][2], cc[k][3]);
            *(u32x4*)(p.CMPb + ((size_t)MP + r + 2 * k + hrow) * 256 + l5 * 8) = w;
        }
    }
    };
    if (blockIdx.x & 1) { do_gather(); do_transposes(); } else { do_transposes(); do_gather(); }
    __syncthreads();
    for (int i = blockIdx.x * 512 + threadIdx.x; i < (INP - IND) * DM / 8; i += gridDim.x * 512) ((u32x4*)(p.WinT + (size_t)IND * DM))[i] = (u32x4){0u, 0u, 0u, 0u};
    for (int row = gw; row < MALL; row += nw) {
        u32x2* hd = (u32x2*)(p.H + (size_t)row * DM);
        if (row < MP + NS) {
            const float* xr = xrow_ptr(p, row);
            f32x4 v[4];
#pragma unroll
            for (int k = 0; k < 4; ++k) v[k] = *(const f32x4*)(xr + lane * 4 + k * 256);
            const float r = row_rstd(v);
#pragma unroll
            for (int k = 0; k < 4; ++k) { const f32x4 g = *(const f32x4*)(p.ln_mix_pre + lane * 4 + k * 256); const f32x4 o = v[k] * r * g; u32x2 w; w.x = cvt_pk_bf16(o[0], o[1]); w.y = cvt_pk_bf16(o[2], o[3]); hd[lane + k * 64] = w; }
            const float* pr = row < MP ? p.p_prompt + (size_t)row * PLE : p.p_sample + (size_t)(row - MP) * PLE;
            const f32x4 pv = *(const f32x4*)(pr + lane * 4);
            u32x2 w; w.x = cvt_pk_bf16(pv[0], pv[1]); w.y = cvt_pk_bf16(pv[2], pv[3]);
            ((u32x2*)(p.Pb + (size_t)row * PLE))[lane] = w;
        } else {
#pragma unroll
            for (int k = 0; k < 4; ++k) hd[lane + k * 64] = (u32x2){0u, 0u};
            ((u32x2*)(p.Pb + (size_t)row * PLE))[lane] = (u32x2){0u, 0u};
        }
    }
    for (int i = blockIdx.x * 512 + threadIdx.x; i < 4 * 128 * 128; i += gridDim.x * 512) { const int t = (i >> 7) & 127, s = i & 127; p.GWb[i] = f2bf(s <= t ? p.gm_ws[i] : 0.f); }
    for (int i = blockIdx.x * 512 + threadIdx.x; i < 2 * 64 * 128; i += gridDim.x * 512) { const int kv = i >> 13, d = (i >> 7) & 63, h = i & 127; p.W2T[i] = f2bf((kv ? p.w2_v : p.w2_k)[h * 64 + d]); }
    if (gw < 4) {
        const int kv = gw >> 1, h = (gw & 1) * 64 + lane;
        const float* pe = kv ? p.pe_v : p.pe_k; const float* w1 = kv ? p.w1_v : p.w1_k;
        float s = 0.f;
        for (int k = 0; k < 2048; ++k) s += pe[k] * w1[(size_t)k * 128 + h];
        p.PEB[kv * 128 + h] = s;
    }
    for (int i = blockIdx.x * 512 + threadIdx.x; i < NS * (WIN - 1) * 64; i += gridDim.x * 512) {
        const int b = i / ((WIN - 1) * 64), r = i % ((WIN - 1) * 64);
        ((f32x4*)(p.out + O_WINS + (size_t)b * WIN * 256))[r] = ((const f32x4*)(p.state_win + (size_t)b * WIN * 256 + 256))[r];
    }
}

__device__ __forceinline__ void phase_deferred_transposes(const Params& p) {
    if (blockIdx.x < 32) return;
    int base = 0;
    transpose_all_sub(p.w_br_nsa, QD, DM, p.WnT, DM, [](int n) { return n; }, base);
    transpose_all_sub(p.w_br_gm, GMD, DM, p.WnT + QD, DM, [](int n) { return n; }, base);
    transpose_all_sub(p.w_out, DM, DM, p.WoT, DM, [](int n) { return n; }, base);
    transpose_all_sub(p.w_gate, DM, DFF, p.WguT, DM, [](int n) { return 2 * n; }, base);
    transpose_all_sub(p.w_up, DM, DFF, p.WguT, DM, [](int n) { return 2 * n + 1; }, base);
    transpose_all_sub(p.w_down, DFF, DM, p.WdT, DFF, [](int n) { return n; }, base);
    transpose_all_sub(p.w_ple_gate, DM, DM, p.WpgT, DM, [](int n) { return n; }, base);
    transpose_all_sub(p.w_ple, PLE, DM, p.WpT, PLE, [](int n) { return n; }, base);
    __syncthreads();
}
__device__ __forceinline__ void phase_cmp_final(const Params& p) {
    const int wid = threadIdx.x >> 6, lane = threadIdx.x & 63;
    {
        const int c = lane & 15, G = lane >> 4;
        const int ngrp_p = NB * 4 * 32, ngrp_s = NS * 4 * 64;
#pragma unroll 1
        for (int it = blockIdx.x * 8 + wid; it < ngrp_p + ngrp_s; it += gridDim.x * 8) {
            const bool smp = it >= ngrp_p; const int l = smp ? it - ngrp_p : it;
            const int nch = smp ? 64 : 32, nc = smp ? NCS : NCP;
            const int ch = l % nch, z = (l / nch) & 3, seq = l / (nch * 4), kv = z >> 1, g = z & 1, n0 = ch * 16;
            const size_t r0 = smp ? (size_t)2048 + (size_t)seq * 1024 : (size_t)seq * 512;
            const int nr = n0 + c < nc ? n0 + c : nc - 1;
            const bf16_t* p0 = (const bf16_t*)p.PART + ((r0 + nr) * 4 + z) * 256;
            const bf16_t* p1 = (const bf16_t*)p.PART + ((r0 + nr + 1) * 4 + z) * 256 + 128;
            const float* pb = p.PEB + kv * 128;
            f32x4 acc[4] = {{0.f, 0.f, 0.f, 0.f}, {0.f, 0.f, 0.f, 0.f}, {0.f, 0.f, 0.f, 0.f}, {0.f, 0.f, 0.f, 0.f}};
#pragma unroll
            for (int ks = 0; ks < 4; ++ks) {
                const int h0 = 32 * ks + 8 * G;
                const u32x4 wa = *(const u32x4*)(p0 + h0), wb = *(const u32x4*)(p1 + h0);
                const f32x4 a0 = {bflo(wa.x), bfhi(wa.x), bflo(wa.y), bfhi(wa.y)}, a1 = {bflo(wa.z), bfhi(wa.z), bflo(wa.w), bfhi(wa.w)};
                const f32x4 b0 = {bflo(wb.x), bfhi(wb.x), bflo(wb.y), bfhi(wb.y)}, b1 = {bflo(wb.z), bfhi(wb.z), bflo(wb.w), bfhi(wb.w)};
                const f32x4 e0 = *(const f32x4*)(pb + h0), e1 = *(const f32x4*)(pb + h0 + 4);
                f32x4 x0 = a0 + b0 + e0, x1 = a1 + b1 + e1;
#pragma unroll
                for (int i = 0; i < 4; ++i) { x0[i] = siluf_(x0[i]); x1[i] = siluf_(x1[i]); }
                const bf16x8 A = pack_p(x0, x1);
#pragma unroll
                for (int nt = 0; nt < 4; ++nt) {
                    const bf16x8 B = *(const bf16x8*)(p.W2T + ((size_t)kv * 64 + nt * 16 + c) * 128 + h0);
                    acc[nt] = mfma16(A, B, acc[nt]);
                }
            }
#pragma unroll
            for (int nt = 0; nt < 4; ++nt) {
                const int d = nt * 16 + c;
#pragma unroll
                for (int i = 0; i < 4; ++i) {
                    const int n = n0 + 4 * G + i;
                    if (n < nc) {
                        if (smp) ((kv ? p.VCS : p.KCS) + (((size_t)seq * NG + g) * 1024 + n) * 64)[d] = acc[nt][i];
                        else if (kv == 0) p.KCb[((size_t)seq * NG + g) * 512 * 64 + kfrag_off(n, d)] = f2bf(acc[nt][i]);
                    }
                }
                if (!smp && kv == 1) {
                    f32x4 v = acc[nt];
#pragma unroll
                    for (int i = 0; i < 4; ++i) if (n0 + 4 * G + i >= nc) v[i] = 0.f;
                    st_bf16x4(p.VCT + ((size_t)seq * NG + g) * 512 * 64 + vfrag_off(n0 + 4 * G, d), v);
                }
            }
        }
    }
}

template <bool SAMPLE>
__device__ __forceinline__ void kv_row_ptr(const Params& p, int branch  , int b, int pos, int kv, int g, const bf16_t*& pb, const float*& pf) {
    const int off = kv * 128 + g * 64;
    if (!SAMPLE) { pf = nullptr; pb = (branch == 1 ? p.SLCb : p.WINb) + ((size_t)b * SEQ + pos) * 256 + off; }
    else if (pos >= PAST) { pf = nullptr; pb = (branch == 1 ? p.SLCb : p.WINb) + ((size_t)MP + b) * 256 + off; }
    else if (branch == 1) { pb = nullptr; pf = p.cache_slc + ((size_t)p.page_table[b * NPG + (pos >> 7)] * PAGE + (pos & 127)) * 256 + off; }
    else { pb = nullptr; pf = p.state_win + ((size_t)b * WIN + (pos - (PAST - WIN))) * 256 + off; }
}
__device__ __forceinline__ void dot4x64(const bf16_t* pb, const float* pf, const LAS float* qs_, float (&s)[4]) {
    s[0] = s[1] = s[2] = s[3] = 0.f;
    const LAS float* qs = qs_; asm volatile("" : "+v"(qs));
    if (pf) {
#pragma unroll 4
        for (int c = 0; c < 16; ++c) {
            const f32x4 kx = *(const f32x4*)(pf + c * 4);
#pragma unroll
            for (int h = 0; h < 4; ++h) { const f32x4 q = *(const LAS f32x4*)(qs + h * 64 + c * 4); s[h] += q[0] * kx[0] + q[1] * kx[1] + q[2] * kx[2] + q[3] * kx[3]; }
        }
    } else {
#pragma unroll 2
        for (int c = 0; c < 8; ++c) {
            const u32x4 w = *(const u32x4*)(pb + c * 8);
            const float k0 = bflo(w.x), k1 = bfhi(w.x), k2 = bflo(w.y), k3 = bfhi(w.y), k4 = bflo(w.z), k5 = bfhi(w.z), k6 = bflo(w.w), k7 = bfhi(w.w);
#pragma unroll
            for (int h = 0; h < 4; ++h) {
                const f32x4 qa = *(const LAS f32x4*)(qs + h * 64 + c * 8), qb = *(const LAS f32x4*)(qs + h * 64 + c * 8 + 4);
                s[h] += qa[0] * k0 + qa[1] * k1 + qa[2] * k2 + qa[3] * k3 + qb[0] * k4 + qb[1] * k5 + qb[2] * k6 + qb[3] * k7;
            }
        }
    }
}
template <bool SAMPLE>
__device__ __forceinline__ void attn_chunk(const Params& p, int branch, int b, int g, int t, int pos0, int lo, int hi,
                                           float (&m)[4], float (&l)[4], float (&o)[4], const LAS float* qs, LAS float* pbk, const LAS float* relb, int lane) {
    const int pos = pos0 + lane;
    const bool valid = pos >= lo && pos <= hi;
    float s[4] = {-1e30f, -1e30f, -1e30f, -1e30f};
    if (valid) {
        const bf16_t* pb; const float* pf; kv_row_ptr<SAMPLE>(p, branch, b, pos, 0, g, pb, pf);
        dot4x64(pb, pf, qs, s);
        const int bk = t5_bucket(t - pos);
#pragma unroll
        for (int h = 0; h < 4; ++h) s[h] += relb[bk * 8 + g * 4 + h];
    }
#pragma unroll
    for (int h = 0; h < 4; ++h) {
        const float mx = wave_max(s[h]);
        const float mn = fmaxf(m[h], mx);
        const float pr = valid ? ex2(s[h] - mn) : 0.f;
        const float sm = wave_sum(pr);
        const float al = ex2(m[h] - mn);
        l[h] = l[h] * al + sm; o[h] *= al; m[h] = mn;
        pbk[h * 64 + lane] = pr;
    }
    __builtin_amdgcn_wave_barrier();
    const int k0 = (lo > pos0 ? lo : pos0) - pos0, k1 = (hi < pos0 + 63 ? hi : pos0 + 63) - pos0;
    if (SAMPLE) {
        const int kend = (PAST - 1 - pos0) < k1 ? (PAST - 1 - pos0) : k1;
        if (kend >= k0) {
            const bf16_t* pb; const float* pf; kv_row_ptr<SAMPLE>(p, branch, b, pos0 + k0, 1, g, pb, pf);
            pf += lane;
#pragma unroll 8
            for (int k = k0; k <= kend; ++k) {
                const float v = pf[(size_t)(k - k0) * 256];
#pragma unroll
                for (int h = 0; h < 4; ++h) o[h] += pbk[h * 64 + k] * v;
            }
        }
        if (k1 > kend) {
            const bf16_t* pb; const float* pf; kv_row_ptr<SAMPLE>(p, branch, b, pos0 + k1, 1, g, pb, pf);
            const float v = bf2f(pb[lane]);
#pragma unroll
            for (int h = 0; h < 4; ++h) o[h] += pbk[h * 64 + k1] * v;
        }
    } else {
#pragma unroll 1
    for (int k = k0; k <= k1; ++k) {
        const bf16_t* pb; const float* pf; kv_row_ptr<SAMPLE>(p, branch, b, pos0 + k, 1, g, pb, pf);
        const float v = pf ? pf[lane] : bf2f(pb[lane]);
#pragma unroll
        for (int h = 0; h < 4; ++h) o[h] += pbk[h * 64 + k] * v;
    }
    }
    __builtin_amdgcn_wave_barrier();
}

constexpr int S_QS = 0, S_SC = 1024, S_PHS = S_SC + 4 * 1024 * 4, S_PBK = S_PHS + 1088 * 4, S_PART = S_PBK + 8 * 1024, S_RED = S_PART + 2 * 8 * 272 * 4, S_OCP = S_RED + 512,
              S_SEL = S_OCP + 2048, S_RELB = S_SEL + 64, ATTS_LDS = S_RELB + 1024;
__device__ __forceinline__ void attn_sample_item(const Params& p, int b, int g) {
    const int tid = threadIdx.x, wid = tid >> 6, lane = tid & 63;
    constexpr int t = PAST, NC = NCS, NSEL = 257, NJR = 5, qblk = PAST >> 6;
    const int row = MP + b;
    LAS unsigned char* L = (LAS unsigned char*)smem;
    LAS float* qs = (LAS float*)(L + S_QS); LAS float* sc = (LAS float*)(L + S_SC); LAS float* phs = (LAS float*)(L + S_PHS); LAS float* pbk = (LAS float*)(L + S_PBK) + wid * 256;
    LAS float* part = (LAS float*)(L + S_PART); LAS float* red = (LAS float*)(L + S_RED); LAS float* ocp = (LAS float*)(L + S_OCP); LAS int* sel = (LAS int*)(L + S_SEL);
    LAS float* relb = (LAS float*)(L + S_RELB);
    __syncthreads();
    if (tid < 256) { relb[tid] = p.rel_bias[tid] * LOG2E; qs[tid] = bf2f(p.Qb[(size_t)row * QD + g * 256 + tid]); }
    __syncthreads();
    const float* kc = p.KCS + ((size_t)b * NG + g) * 1024 * 64;
    const float* vc = p.VCS + ((size_t)b * NG + g) * 1024 * 64;
    {
        float mx[4] = {-1e30f, -1e30f, -1e30f, -1e30f};
#pragma unroll 1
        for (int r = wid; r < 16; r += 8) {
            const int n = r * 64 + lane;
            float s[4] = {-1e30f, -1e30f, -1e30f, -1e30f};
            if (n < NC) {
                dot4x64(nullptr, kc + (size_t)n * 64, qs, s);
                const int bk = t5_bucket(t - (16 * n + 31));
#pragma unroll
                for (int h = 0; h < 4; ++h) s[h] += relb[bk * 8 + g * 4 + h];
            }
#pragma unroll
            for (int h = 0; h < 4; ++h) { sc[h * 1024 + n] = s[h]; mx[h] = fmaxf(mx[h], s[h]); }
        }
#pragma unroll
        for (int h = 0; h < 4; ++h) { const float m = wave_max(mx[h]); if (lane == 0) red[wid * 4 + h] = m; }
    }
    __syncthreads();
    float gmx[4], inv[4];
#pragma unroll
    for (int h = 0; h < 4; ++h) { float m = red[h]; for (int w = 1; w < 8; ++w) m = fmaxf(m, red[w * 4 + h]); gmx[h] = m; }
    {
        float sum[4] = {0.f, 0.f, 0.f, 0.f};
#pragma unroll
        for (int k = 0; k < 2; ++k) { const int n = tid + 512 * k;
#pragma unroll
            for (int h = 0; h < 4; ++h) { const float e = n < NC ? ex2(sc[h * 1024 + n] - gmx[h]) : 0.f; sc[h * 1024 + n] = e; sum[h] += e; } }
#pragma unroll
        for (int h = 0; h < 4; ++h) { const float s = wave_sum(sum[h]); if (lane == 0) red[32 + wid * 4 + h] = s; }
    }
    __syncthreads();
#pragma unroll
    for (int h = 0; h < 4; ++h) { float s = 0.f; for (int w = 0; w < 8; ++w) s += red[32 + w * 4 + h]; inv[h] = s > 0.f ? 1.0f / s : 0.f; }
    for (int n = tid; n < 1088; n += 512) phs[n] = n < NC ? (sc[n] * inv[0] + sc[1024 + n] * inv[1]) + (sc[2048 + n] * inv[2] + sc[3072 + n] * inv[3]) : 0.f;
    {
        float a[4] = {0.f, 0.f, 0.f, 0.f};
#pragma unroll 8
        for (int n = wid; n < NC; n += 8) {
            const float v = vc[(size_t)n * 64 + lane];
#pragma unroll
            for (int h = 0; h < 4; ++h) a[h] += sc[h * 1024 + n] * v;
        }
#pragma unroll
        for (int h = 0; h < 4; ++h) part[(wid * 4 + h) * 68 + lane] = a[h] * inv[h];
    }
    __syncthreads();
    if (tid < 256) { float a = 0.f; for (int w = 0; w < 8; ++w) a += part[(w * 4 + (tid >> 6)) * 68 + (tid & 63)]; ocp[tid] = a; }
    __syncthreads();
    if (wid == 0) {
        unsigned long long key[NJR];
#pragma unroll
        for (int jr = 0; jr < NJR; ++jr) {
            const int j = jr * 64 + lane;
            key[jr] = 0ull;
            if (j >= 1 && j <= qblk - 2 && j < NSEL) {
                float im = 0.f;
#pragma unroll
                for (int n = 4 * j - 1; n <= 4 * j + 3; ++n) im += (n < NC) ? phs[n] : 0.f;
                key[jr] = ((unsigned long long)__float_as_uint(im) << 32) | (unsigned)(0xFFFF - j) | 0x10000ull;
            }
        }
        if (lane == 0) { sel[0] = 0; sel[1] = qblk - 1; sel[2] = qblk; }
#pragma unroll 1
        for (int it = 0; it < 13; ++it) {
            unsigned long long best = 0ull;
#pragma unroll
            for (int jr = 0; jr < NJR; ++jr) best = key[jr] > best ? key[jr] : best;
#pragma unroll
            for (int o = 32; o > 0; o >>= 1) { const unsigned long long ot = __shfl_xor(best, o); best = ot > best ? ot : best; }
            const int j = 0xFFFF - (int)(best & 0xFFFFull);
#pragma unroll
            for (int jr = 0; jr < NJR; ++jr) if (key[jr] == best) key[jr] = 0ull;
            if (lane == 0) sel[3 + it] = j;
        }
    }
    __syncthreads();
    {
        float ms[4] = {-1e30f, -1e30f, -1e30f, -1e30f}, ls[4] = {0.f, 0.f, 0.f, 0.f}, os[4] = {0.f, 0.f, 0.f, 0.f};
#pragma unroll 1
        for (int i = wid; i < 16; i += 8) attn_chunk<true>(p, 1, b, g, t, sel[i] * 64, 0, t, ms, ls, os, qs, pbk, relb, lane);
        float mw[4] = {-1e30f, -1e30f, -1e30f, -1e30f}, lw[4] = {0.f, 0.f, 0.f, 0.f}, ow[4] = {0.f, 0.f, 0.f, 0.f};
#pragma unroll 1
        for (int c = wid; c < 9; c += 8) attn_chunk<true>(p, 2, b, g, t, t - 63 - 64 * c, t - WIN, t, mw, lw, ow, qs, pbk, relb, lane);
#pragma unroll
        for (int h = 0; h < 4; ++h) {
            LAS float* ps = part + (wid * 4 + h) * 68; LAS float* pw = part + 8 * 272 + (wid * 4 + h) * 68;
            ps[lane] = os[h]; pw[lane] = ow[h];
            if (lane == 0) { ps[64] = ms[h]; ps[65] = ls[h]; pw[64] = mw[h]; pw[65] = lw[h]; }
        }
    }
    __syncthreads();
    if (tid < 256) {
        const int h = tid >> 6, d = tid & 63;
        float res[2];
#pragma unroll
        for (int br = 0; br < 2; ++br) {
            const LAS float* pp = part + br * 8 * 272 + h * 68;
            float m = -1e30f;
            for (int w = 0; w < 8; ++w) m = fmaxf(m, pp[w * 272 + 64]);
            float l = 0.f, o = 0.f;
            for (int w = 0; w < 8; ++w) { const float sc_ = ex2(pp[w * 272 + 64] - m); l += pp[w * 272 + 65] * sc_; o += pp[w * 272 + d] * sc_; }
            res[br] = o / l;
        }
        const float* gt = p.GATE + (size_t)row * 32 + (g * 4 + h) * 3;
        const float v = gt[0] * ocp[tid] + gt[1] * res[0] + gt[2] * res[1];
        p.OCAT[(size_t)row * DM + (g * 4 + h) * 64 + d] = f2bf(v);
    }
    __syncthreads();
}

constexpr int A_OST = 0, OST_LD = 68, A_LST = A_OST + 256 * OST_LD * 4, A_M0 = A_LST + 1024, A_MB = A_M0 + 1024, MB_LD = 132, A_MKN = A_MB + 64 * MB_LD,
              A_LIST = A_MKN + 256, A_CNT = A_LIST + 132 * 64, A_PK = A_CNT + 544, A_KN = A_PK + 400 * 4, A_T2 = A_KN + 512, A_NP = A_T2 + 132 * 8 * 4, A_QT = A_NP + 16, ATT2_LDS = A_QT + 64 * 512;
static_assert(ATT2_LDS <= GEMM_LDS && ATTS_LDS <= GEMM_LDS, "attention LDS");

__device__ __forceinline__ void qk64(const bf16_t* kb, int c, int G, const bf16x8 (&qB)[2], f32x4 (&s)[4]) {
#pragma unroll
    for (int kt = 0; kt < 4; ++kt) {
        const bf16_t* r = kb + (size_t)(16 * kt + c) * 256 + G * 8;
        const bf16x8 a0 = *(const bf16x8*)r, a1 = *(const bf16x8*)(r + 32);
        s[kt] = mfma16(a0, qB[0], (f32x4){0.f, 0.f, 0.f, 0.f}); s[kt] = mfma16(a1, qB[1], s[kt]);
    }
}
__device__ __forceinline__ void pv64(const bf16_t* vf, int key0, int lane, const f32x4 (&pr)[4], f32x4 (&o)[4]) {
#pragma unroll
    for (int ks = 0; ks < 2; ++ks) {
        const bf16x8 pB = pack_p(pr[2 * ks], pr[2 * ks + 1]);
#pragma unroll
        for (int dt = 0; dt < 4; ++dt) {
            const bf16x8 vA = *(const bf16x8*)(vf + ((size_t)(((key0 >> 5) + ks) * 4 + dt) * 64 + lane) * 8);
            o[dt] = mfma16(vA, pB, o[dt]);
        }
    }
}
__device__ __forceinline__ int qt_off(int qi, int hh, int k) { return (qi * 4 + hh) * 128 + ((k ^ (((qi & 3) << 1) | (hh >> 1))) << 4); }
__device__ __forceinline__ float grp_max(float v) {
    auto r = __builtin_amdgcn_permlane16_swap(__float_as_uint(v), __float_as_uint(v), false, false); v = fmaxf(__uint_as_float(r[0]), __uint_as_float(r[1]));
    r = __builtin_amdgcn_permlane32_swap(__float_as_uint(v), __float_as_uint(v), false, false); return fmaxf(__uint_as_float(r[0]), __uint_as_float(r[1]));
}
__device__ __forceinline__ float grp_sum(float v) {
    auto r = __builtin_amdgcn_permlane16_swap(__float_as_uint(v), __float_as_uint(v), false, false); v = __uint_as_float(r[0]) + __uint_as_float(r[1]);
    r = __builtin_amdgcn_permlane32_swap(__float_as_uint(v), __float_as_uint(v), false, false); return __uint_as_float(r[0]) + __uint_as_float(r[1]);
}
__device__ __forceinline__ int grp_min_i(int v) {
    auto r = __builtin_amdgcn_permlane16_swap((unsigned)v, (unsigned)v, false, false); v = (int)r[0] < (int)r[1] ? (int)r[0] : (int)r[1];
    r = __builtin_amdgcn_permlane32_swap((unsigned)v, (unsigned)v, false, false); return (int)r[0] < (int)r[1] ? (int)r[0] : (int)r[1];
}
__device__ __forceinline__ float dpp_x1(float v) { return __uint_as_float(__builtin_amdgcn_mov_dpp(__float_as_uint(v), 0xB1, 0xF, 0xF, true)); }
__device__ __forceinline__ float dpp_x2(float v) { return __uint_as_float(__builtin_amdgcn_mov_dpp(__float_as_uint(v), 0x4E, 0xF, 0xF, true)); }
__device__ __forceinline__ int dpp_x1i(int v) { return (int)__builtin_amdgcn_mov_dpp((unsigned)v, 0xB1, 0xF, 0xF, true); }
__device__ __forceinline__ int dpp_x2i(int v) { return (int)__builtin_amdgcn_mov_dpp((unsigned)v, 0x4E, 0xF, 0xF, true); }
__device__ __forceinline__ unsigned row_or_q(unsigned u) {
    u |= __builtin_amdgcn_mov_dpp(u, 0x124, 0xF, 0xF, true); u |= __builtin_amdgcn_mov_dpp(u, 0x128, 0xF, 0xF, true); return u;
}

__device__ __forceinline__ void attn_cmp(const Params& p, int b, int g, int t0, int lane_, LAS unsigned char* L, unsigned (&msk)[4]) {
    f32x4 oacc[4];
    int lane = lane_; asm volatile("" : "+v"(lane));
    const int c = lane & 15, G = lane >> 4, qs = c >> 2, hh = c & 3;
    const int qb = t0 >> 6, tc = t0 + qs;
    const size_t qrow = (size_t)b * SEQ + tc;
    const LAS float* T2 = (const LAS float*)(L + A_T2);
    const float b31 = T2[128 * 8 + g * 4 + hh];
    bf16x8 qB[2];
    qB[0] = *(const bf16x8*)(p.Qb + qrow * QD + (g * 4 + hh) * 64 + G * 8); qB[1] = *(const bf16x8*)(p.Qb + qrow * QD + (g * 4 + hh) * 64 + 32 + G * 8);
    const float* gate = p.GATE + qrow * 32 + (g * 4 + hh) * 3;
    msk[0] = msk[1] = msk[2] = msk[3] = 0u;
    {
        const int ncv_c = tc >= 31 ? ((tc - 31) >> 4) + 1 : 0;
        const int ncv_m = t0 + 3 >= 31 ? ((t0 + 3 - 31) >> 4) + 1 : 0;
        const int NT = (ncv_m + 15) >> 4;
        const int mt_far = t0 >= 399 ? (t0 - 399) / 256 + 1 : 0;
        const bf16_t* kcb = p.KCb + (size_t)(b * NG + g) * 512 * 64;
        f32x4 sc[32];
        float mx = -1e30f;
#pragma unroll
        for (int mt = 0; mt < 32; ++mt) {
            sc[mt] = (f32x4){0.f, 0.f, 0.f, 0.f};
            if (mt < NT) {
                const bf16x8 a0 = *(const bf16x8*)(kcb + ((size_t)(mt * 2) * 64 + lane) * 8), a1 = *(const bf16x8*)(kcb + ((size_t)(mt * 2 + 1) * 64 + lane) * 8);
                f32x4 s = mfma16(a0, qB[0], (f32x4){0.f, 0.f, 0.f, 0.f}); s = mfma16(a1, qB[1], s);
                if (mt < mt_far) { s = s + b31; }
                else {
#pragma unroll
                    for (int i = 0; i < 4; ++i) { const int n = 16 * mt + 4 * G + i; int dist = tc - (16 * n + 31); const bool ok = n < ncv_c; dist = dist < 0 ? 0 : (dist > 128 ? 128 : dist);
                        s[i] = ok ? s[i] + T2[dist * 8 + g * 4 + hh] : -1e30f; }
                }
                mx = fmaxf(mx, fmaxf(fmaxf(s[0], s[1]), fmaxf(s[2], s[3])));
                sc[mt] = s;
            }
            if ((mt & 3) == 3) __builtin_amdgcn_sched_barrier(0);
        }
        mx = grp_max(mx);
        float sum = 0.f;
#pragma unroll
        for (int mt = 0; mt < 32; ++mt) if (mt < NT) {
#pragma unroll
            for (int i = 0; i < 4; ++i) { const float e = ex2(sc[mt][i] - mx); sc[mt][i] = e; sum += e; }
        }
        sum = grp_sum(sum);
        const float inv = ncv_c > 0 ? 1.0f / sum : 0.f;
#pragma unroll
        for (int mt = 0; mt < 32; ++mt) if (mt < NT) sc[mt] = sc[mt] * inv;
        if (qb <= 15) {
            msk[0] = (qb >= 31) ? 0xffffffffu : ((2u << qb) - 1u);
        } else {
            float cand[8];
#pragma unroll
            for (int k = 0; k < 8; ++k) cand[k] = -1.f;
            float prevB = 0.f;
#pragma unroll
            for (int mt = 0; mt < 32; ++mt) if (mt < NT) {
                const unsigned x3 = __float_as_uint(sc[mt][3]);
                const auto p16 = __builtin_amdgcn_permlane16_swap(x3, x3, false, false);
                const auto p32 = __builtin_amdgcn_permlane32_swap(p16[1], p16[1], false, false);
                const float r1 = G == 2 ? __uint_as_float(p32[0]) : __uint_as_float(p16[0]);
                float v = (sc[mt][0] + sc[mt][1]) + (sc[mt][2] + sc[mt][3]) + (G == 0 ? prevB : r1);
                prevB = __uint_as_float(p32[1]);
                v += dpp_x1(v); v += dpp_x2(v);
                const int j = 4 * mt + G;
                if ((mt & 3) == hh) cand[mt >> 2] = (j >= 1 && j <= qb - 2) ? v : -1.f;
            }
            auto setbit = [&](int j) { const unsigned bit = 1u << (j & 31); const int w = j >> 5; msk[0] |= w == 0 ? bit : 0u; msk[1] |= w == 1 ? bit : 0u; msk[2] |= w == 2 ? bit : 0u; msk[3] |= w == 3 ? bit : 0u; };
            setbit(0); setbit(qb); setbit(qb - 1);
#pragma unroll 1
            for (int it = 0; it < 13; ++it) {
                float bv = cand[0];
#pragma unroll
                for (int k = 1; k < 8; ++k) bv = fmaxf(bv, cand[k]);
                bv = fmaxf(bv, dpp_x1(bv)); bv = fmaxf(bv, dpp_x2(bv)); bv = grp_max(bv);
                int bj = 9999;
#pragma unroll
                for (int k = 0; k < 8; ++k) { const int j = 16 * k + 4 * hh + G; bj = (cand[k] == bv && j < bj) ? j : bj; }
                { int o = dpp_x1i(bj); bj = o < bj ? o : bj; o = dpp_x2i(bj); bj = o < bj ? o : bj; bj = grp_min_i(bj); }
#pragma unroll
                for (int k = 0; k < 8; ++k) { const int j = 16 * k + 4 * hh + G; if (j == bj) cand[k] = -1.f; }
                setbit(bj & 127);
            }
        }
        const bf16_t* vct = p.VCT + (size_t)(b * NG + g) * 64 * 512;
        f32x4 oc[4] = {{0.f, 0.f, 0.f, 0.f}, {0.f, 0.f, 0.f, 0.f}, {0.f, 0.f, 0.f, 0.f}, {0.f, 0.f, 0.f, 0.f}};
#pragma unroll
        for (int k2 = 0; k2 < 16; ++k2) if (2 * k2 < NT) {
            const bf16x8 pB = pack_p(sc[2 * k2], sc[2 * k2 + 1]);
#pragma unroll
            for (int dt = 0; dt < 4; ++dt) {
                const bf16x8 vA = *(const bf16x8*)(vct + ((size_t)(k2 * 4 + dt) * 64 + lane) * 8);
                oc[dt] = mfma16(vA, pB, oc[dt]);
            }
            if (k2 & 1) __builtin_amdgcn_sched_barrier(0);
        }
        const float g0 = gate[0];
#pragma unroll
        for (int dt = 0; dt < 4; ++dt) oacc[dt] = oc[dt] * g0;
    }
    bf16_t* orow = p.OCAT + qrow * DM + (g * 4 + hh) * 64 + 4 * G;
#pragma unroll
    for (int dt = 0; dt < 4; ++dt) st_bf16x4(orow + dt * 16, oacc[dt]);
}

struct PackSt { bf16x8 q0, q1; float m; f32x4 l4; f32x4 o[4]; };
__device__ __forceinline__ void attn_selwin_pair(const Params& p, int b, int g, int t0, int lane_, LAS unsigned char* L, const unsigned (&mskA)[4], const unsigned (&mskB)[4]) {
    int lane = lane_; asm volatile("" : "+v"(lane));
    const int c = lane & 15, G = lane >> 4, qs = c >> 2, hh = c & 3;
    const int qb = t0 >> 6;
    const LAS float* T2 = (const LAS float*)(L + A_T2);
    const float b31 = T2[128 * 8 + g * 4 + hh];
    const int tcA = t0 + qs, tcB = t0 + 4 + qs;
    const size_t qrowA = (size_t)b * SEQ + tcA;
    PackSt A, B;
    {
        const bf16_t* qa = p.Qb + qrowA * QD + (g * 4 + hh) * 64 + G * 8;
        A.q0 = *(const bf16x8*)qa; A.q1 = *(const bf16x8*)(qa + 32); B.q0 = *(const bf16x8*)(qa + 4 * QD); B.q1 = *(const bf16x8*)(qa + 4 * QD + 32);
    }
    auto reset = [&](PackSt& S) __attribute__((always_inline)) { S.m = -1e30f; S.l4 = (f32x4){0.f, 0.f, 0.f, 0.f};
#pragma unroll
        for (int dt = 0; dt < 4; ++dt) S.o[dt] = (f32x4){0.f, 0.f, 0.f, 0.f}; };
    const bf16x8 ones = __builtin_bit_cast(bf16x8, (u32x4){0x3F803F80u, 0x3F803F80u, 0x3F803F80u, 0x3F803F80u});
    auto finish = [&](PackSt& S, f32x4 (&s)[4], float cb, bool mine, const bf16x8 (&vf)[2][4]) __attribute__((always_inline)) {
        float cm = fmaxf(fmaxf(fmaxf(s[0][0], s[0][1]), fmaxf(s[0][2], s[0][3])), fmaxf(fmaxf(s[1][0], s[1][1]), fmaxf(s[1][2], s[1][3])));
        cm = fmaxf(cm, fmaxf(fmaxf(fmaxf(s[2][0], s[2][1]), fmaxf(s[2][2], s[2][3])), fmaxf(fmaxf(s[3][0], s[3][1]), fmaxf(s[3][2], s[3][3]))));
        cm = grp_max(mine ? cm + cb : -1e30f);
        const float mn = fmaxf(S.m, cm), al = ex2(S.m - mn);
        const float sh = (mine ? mn : 1e30f) - cb;
        float ps = 0.f;
#pragma unroll
        for (int kt = 0; kt < 4; ++kt)
#pragma unroll
            for (int i = 0; i < 4; ++i) { const float e = ex2(s[kt][i] - sh); s[kt][i] = e; ps += e; }
        S.m = mn;
        S.l4[0] = S.l4[0] * al + grp_sum(ps);
#pragma unroll
        for (int dt = 0; dt < 4; ++dt) S.o[dt] = S.o[dt] * al;
#pragma unroll
        for (int ks = 0; ks < 2; ++ks) { const bf16x8 pB = pack_p(s[2 * ks], s[2 * ks + 1]);
#pragma unroll
            for (int dt = 0; dt < 4; ++dt) S.o[dt] = mfma16(vf[ks][dt], pB, S.o[dt]); }
    };
    auto addout = [&](PackSt& S, size_t qrow, int br) __attribute__((always_inline)) {
        const float gs = p.GATE[qrow * 32 + (g * 4 + hh) * 3 + br] / S.l4[0];
        bf16_t* orow = p.OCAT + qrow * DM + (g * 4 + hh) * 64 + 4 * G;
#pragma unroll
        for (int dt = 0; dt < 4; ++dt) { const u32x2 w = *(const u32x2*)(orow + dt * 16); f32x4 pa; pa[0] = bflo(w.x); pa[1] = bfhi(w.x); pa[2] = bflo(w.y); pa[3] = bfhi(w.y);
            st_bf16x4(orow + dt * 16, pa + S.o[dt] * gs); }
    };
    {
        unsigned umA[4], umB[4], um[4];
#pragma unroll
        for (int w = 0; w < 4; ++w) {
            umA[w] = __builtin_amdgcn_readfirstlane(row_or_q(mskA[w]));
            umB[w] = __builtin_amdgcn_readfirstlane(row_or_q(mskB[w]));
            um[w] = umA[w] | umB[w];
        }
        reset(A); reset(B);
        const bf16_t* klane = p.SLCkF + (size_t)(b * NG + g) * SEQ * 64 + lane * 8;
        const bf16_t* vlane = p.SLCvT + (size_t)(b * NG + g) * SEQ * 64 + lane * 8;
        auto ldfr = [&](int j_, bf16x8 (&kf_)[4][2], bf16x8 (&vf_)[2][4]) __attribute__((always_inline)) {
            const bf16_t* kr = klane + (size_t)j_ * 4096; const bf16_t* vr = vlane + (size_t)j_ * 4096;
#pragma unroll
            for (int kt = 0; kt < 4; ++kt) { kf_[kt][0] = *(const bf16x8*)(kr + (kt * 2) * 512); kf_[kt][1] = *(const bf16x8*)(kr + (kt * 2 + 1) * 512); }
#pragma unroll
            for (int ks = 0; ks < 2; ++ks)
#pragma unroll
                for (int dt = 0; dt < 4; ++dt) vf_[ks][dt] = *(const bf16x8*)(vr + (ks * 4 + dt) * 512);
        };
        auto nextj = [&](int& j_) __attribute__((always_inline)) {
            int w = um[0] ? 0 : um[1] ? 1 : um[2] ? 2 : um[3] ? 3 : -1;
            if (w < 0) return false;
            const unsigned u = w == 0 ? um[0] : w == 1 ? um[1] : w == 2 ? um[2] : um[3];
            const int bpos = __builtin_ctz(u);
            j_ = w * 32 + bpos;
            const unsigned cl = ~(1u << bpos);
            if (w == 0) um[0] &= cl; else if (w == 1) um[1] &= cl; else if (w == 2) um[2] &= cl; else um[3] &= cl;
            return true;
        };
        auto packstep = [&](PackSt& S, const unsigned (&msk)[4], int tc, int j, const bf16x8 (&kf)[4][2], const bf16x8 (&vf)[2][4]) __attribute__((always_inline)) {
            const unsigned mw = (j >> 5) == 0 ? msk[0] : (j >> 5) == 1 ? msk[1] : (j >> 5) == 2 ? msk[2] : msk[3];
            const bool mine = (mw >> (j & 31)) & 1u;
            const bool farb = j <= qb - 3;
            f32x4 s[4];
#pragma unroll
            for (int kt = 0; kt < 4; ++kt) { s[kt] = mfma16(kf[kt][0], S.q0, (f32x4){0.f, 0.f, 0.f, 0.f}); s[kt] = mfma16(kf[kt][1], S.q1, s[kt]); }
            if (!farb) {
#pragma unroll
                for (int kt = 0; kt < 4; ++kt)
#pragma unroll
                    for (int i = 0; i < 4; ++i) { const int dist = tc - (j * 64 + 16 * kt + 4 * G + i); const int dd = dist < 0 ? 0 : (dist > 128 ? 128 : dist);
                        s[kt][i] = dist >= 0 ? s[kt][i] + T2[dd * 8 + g * 4 + hh] : -1e30f; }
            }
            finish(S, s, farb ? b31 : 0.f, mine, vf);
        };
        auto blockstep = [&](int j, const bf16x8 (&kf)[4][2], const bf16x8 (&vf)[2][4]) __attribute__((always_inline)) {
            const int w = j >> 5; const unsigned bit = 1u << (j & 31);
            const unsigned ua = w == 0 ? umA[0] : w == 1 ? umA[1] : w == 2 ? umA[2] : umA[3];
            const unsigned ub = w == 0 ? umB[0] : w == 1 ? umB[1] : w == 2 ? umB[2] : umB[3];
            if (ua & bit) packstep(A, mskA, tcA, j, kf, vf);
            if (ub & bit) packstep(B, mskB, tcB, j, kf, vf);
        };
        auto ldk = [&](int j_, bf16x8 (&kf_)[4][2]) __attribute__((always_inline)) {
            const bf16_t* kr = klane + (size_t)j_ * 4096;
#pragma unroll
            for (int kt = 0; kt < 4; ++kt) { kf_[kt][0] = *(const bf16x8*)(kr + (kt * 2) * 512); kf_[kt][1] = *(const bf16x8*)(kr + (kt * 2 + 1) * 512); }
        };
        auto ldv = [&](int j_, bf16x8 (&vf_)[2][4]) __attribute__((always_inline)) {
            const bf16_t* vr = vlane + (size_t)j_ * 4096;
#pragma unroll
            for (int ks = 0; ks < 2; ++ks)
#pragma unroll
                for (int dt = 0; dt < 4; ++dt) vf_[ks][dt] = *(const bf16x8*)(vr + (ks * 4 + dt) * 512);
        };
        bf16x8 kfA[4][2], kfB[4][2], vf[2][4];
        int j = 0; bool have = nextj(j);
        ldk(j, kfA);
#pragma unroll 1
        while (have) {
            int jn = j; bool haven = nextj(jn);
            ldv(j, vf); ldk(jn, kfB);
            __builtin_amdgcn_sched_barrier(0);
            blockstep(j, kfA, vf);
            if (!haven) break;
            j = jn; have = nextj(jn);
            ldv(j, vf); ldk(jn, kfA);
            __builtin_amdgcn_sched_barrier(0);
            blockstep(j, kfB, vf);
            j = jn;
        }
        addout(A, qrowA, 1); addout(B, qrowA + 4, 1);
    }
    {
        reset(A); reset(B);
        const int loA = t0 - WIN > 0 ? t0 - WIN : 0, hiA = t0 + 3, loB = t0 + 4 - WIN > 0 ? t0 + 4 - WIN : 0, hiB = t0 + 7;
        const bf16_t* klane = p.WINkF + (size_t)(b * NG + g) * SEQ * 64 + lane * 8;
        const bf16_t* vlane = p.WINvT + (size_t)(b * NG + g) * SEQ * 64 + lane * 8;
        auto ldfr = [&](int cb_, bf16x8 (&kf_)[4][2], bf16x8 (&vf_)[2][4]) __attribute__((always_inline)) {
            const bf16_t* kr = klane + (size_t)cb_ * 64; const bf16_t* vr = vlane + (size_t)cb_ * 64;
#pragma unroll
            for (int kt = 0; kt < 4; ++kt) { kf_[kt][0] = *(const bf16x8*)(kr + (kt * 2) * 512); kf_[kt][1] = *(const bf16x8*)(kr + (kt * 2 + 1) * 512); }
#pragma unroll
            for (int ks = 0; ks < 2; ++ks)
#pragma unroll
                for (int dt = 0; dt < 4; ++dt) vf_[ks][dt] = *(const bf16x8*)(vr + (ks * 4 + dt) * 512);
        };
        auto packstep = [&](PackSt& S, int tq0, int tc, int cb, const bf16x8 (&kf)[4][2], const bf16x8 (&vf)[2][4]) __attribute__((always_inline)) {
            const bool far = (cb + 63 <= tq0 - 128) && (cb >= tq0 + 3 - WIN);
            f32x4 s[4];
#pragma unroll
            for (int kt = 0; kt < 4; ++kt) { s[kt] = mfma16(kf[kt][0], S.q0, (f32x4){0.f, 0.f, 0.f, 0.f}); s[kt] = mfma16(kf[kt][1], S.q1, s[kt]); }
            if (!far) {
#pragma unroll
                for (int kt = 0; kt < 4; ++kt)
#pragma unroll
                    for (int i = 0; i < 4; ++i) { const int dist = tc - (cb + 16 * kt + 4 * G + i); const bool ok = dist >= 0 && dist <= WIN; const int dd = dist < 0 ? 0 : (dist > 128 ? 128 : dist);
                        s[kt][i] = ok ? s[kt][i] + T2[dd * 8 + g * 4 + hh] : -1e30f; }
            }
            finish(S, s, far ? b31 : 0.f, true, vf);
        };
        auto chunkstep = [&](int cb, const bf16x8 (&kf)[4][2], const bf16x8 (&vf)[2][4]) __attribute__((always_inline)) {
            if (cb <= hiA) packstep(A, t0, tcA, cb, kf, vf);
            if (cb + 63 >= loB) packstep(B, t0 + 4, tcB, cb, kf, vf);
        };
        auto ldk = [&](int cb_, bf16x8 (&kf_)[4][2]) __attribute__((always_inline)) {
            const bf16_t* kr = klane + (size_t)cb_ * 64;
#pragma unroll
            for (int kt = 0; kt < 4; ++kt) { kf_[kt][0] = *(const bf16x8*)(kr + (kt * 2) * 512); kf_[kt][1] = *(const bf16x8*)(kr + (kt * 2 + 1) * 512); }
        };
        auto ldv = [&](int cb_, bf16x8 (&vf_)[2][4]) __attribute__((always_inline)) {
            const bf16_t* vr = vlane + (size_t)cb_ * 64;
#pragma unroll
            for (int ks = 0; ks < 2; ++ks)
#pragma unroll
                for (int dt = 0; dt < 4; ++dt) vf_[ks][dt] = *(const bf16x8*)(vr + (ks * 4 + dt) * 512);
        };
        bf16x8 kfA[4][2], kfB[4][2], vf[2][4];
        int cb = loA & ~63;
        ldk(cb, kfA);
#pragma unroll 1
        for (;;) {
            ldv(cb, vf); ldk(cb + 64 <= hiB ? cb + 64 : cb, kfB);
            __builtin_amdgcn_sched_barrier(0);
            chunkstep(cb, kfA, vf);
            cb += 64; if (cb > hiB) break;
            ldv(cb, vf); ldk(cb + 64 <= hiB ? cb + 64 : cb, kfA);
            __builtin_amdgcn_sched_barrier(0);
            chunkstep(cb, kfB, vf);
            cb += 64; if (cb > hiB) break;
        }
        addout(A, qrowA, 2); addout(B, qrowA + 4, 2);
    }
}

__device__ __forceinline__ void phase_attn(const Params& p) {
    const int wid = threadIdx.x >> 6, lane = threadIdx.x & 63;
    { PROBE_BEGIN(3)
    if (blockIdx.x < NS * NG) attn_sample_item(p, blockIdx.x >> 1, blockIdx.x & 1);
    PROBE_END(3) }
    LAS unsigned char* L = (LAS unsigned char*)smem;
    for (int i = threadIdx.x; i < 129 * 8; i += 512) ((LAS float*)(L + A_T2))[i] = p.rel_bias[t5_bucket(i >> 3) * 8 + (i & 7)] * LOG2E;
    __syncthreads();
    {
        const int wid2 = __builtin_amdgcn_readfirstlane(threadIdx.x >> 6);
#pragma unroll 1
        for (int T = blockIdx.x; T < NB * NG * (SEQ / 64); T += gridDim.x) {
            const int bg = T & 7, qb = (SEQ / 64 - 1) - (T >> 3), t0 = qb * 64 + wid2 * 8;
            unsigned mA[4], mB[4];
            attn_cmp(p, bg >> 1, bg & 1, t0, lane, L, mA);
            attn_cmp(p, bg >> 1, bg & 1, t0 + 4, lane, L, mB);
            attn_selwin_pair(p, bg >> 1, bg & 1, t0, lane, L, mA, mB);
        }
    }
    __syncthreads();
}

constexpr int GM_LD = 136, GM_LDS = 128 * GM_LD * 2 + 1024;
__device__ __forceinline__ void phase_gmlp(const Params& p) {
    int tid = threadIdx.x; asm volatile("" : "+v"(tid));
    const int wid = __builtin_amdgcn_readfirstlane(tid >> 6), lane = tid & 63;
    LAS bf16_t* vnT = (LAS bf16_t*)smem;
    LAS float* mu = (LAS float*)(smem + 128 * GM_LD * 2);
    const int c = lane & 15, G = lane >> 4;
#pragma unroll 1
    for (int u = blockIdx.x; u < NB * 64; u += gridDim.x) {
        const int b = u >> 6, ch = u & 63; const size_t row0 = (size_t)b * SEQ + ch * 128;
        __syncthreads();
        for (int r = wid; r < 128; r += 8) {
            const u32x4 w = *(const u32x4*)(p.Vg + (row0 + r) * GMD + lane * 8);
            const float x[8] = {bflo(w.x), bfhi(w.x), bflo(w.y), bfhi(w.y), bflo(w.z), bfhi(w.z), bflo(w.w), bfhi(w.w)};
            float s = 0.f;
#pragma unroll
            for (int i = 0; i < 8; ++i) s += x[i];
            const float mean = wave_sum(s) * (1.0f / GMD);
            float q = 0.f;
#pragma unroll
            for (int i = 0; i < 8; ++i) q += (x[i] - mean) * (x[i] - mean);
            const float var = wave_sum(q) * (1.0f / GMD);
            if (lane == 0) { mu[r] = mean; mu[128 + r] = rsqrtf(var + EPS); }
        }
#pragma unroll 1
        for (int g = 0; g < 4; ++g) {
            __syncthreads();
#pragma unroll
            for (int k = 0; k < 4; ++k) {
                const int e = tid + 512 * k, s = e & 127, d0 = (e >> 7) * 8;
                const u32x4 w = *(const u32x4*)(p.Vg + (row0 + s) * GMD + g * 128 + d0);
                const float x[8] = {bflo(w.x), bfhi(w.x), bflo(w.y), bfhi(w.y), bflo(w.z), bfhi(w.z), bflo(w.w), bfhi(w.w)};
                const float m = mu[s], rs = mu[128 + s];
#pragma unroll
                for (int i = 0; i < 8; ++i) { const int cc = g * 128 + d0 + i; vnT[(d0 + i) * GM_LD + s] = f2bf((x[i] - m) * rs * p.gm_ln_g[cc] + p.gm_ln_b[cc]); }
            }
            __syncthreads();
            f32x4 acc[8];
#pragma unroll
            for (int dt = 0; dt < 8; ++dt) acc[dt] = (f32x4){0.f, 0.f, 0.f, 0.f};
            const bf16_t* wrow = p.GWb + ((size_t)g * 128 + 16 * wid + c) * 128 + 8 * G;
#pragma unroll 1
            for (int ks = 0; ks <= (wid >> 1); ++ks) {
                const bf16x8 B = *(const bf16x8*)(wrow + 32 * ks);
#pragma unroll
                for (int dt = 0; dt < 8; ++dt) {
                    const bf16x8 A = *(const LAS bf16x8*)(vnT + (dt * 16 + c) * GM_LD + 32 * ks + 8 * G);
                    acc[dt] = mfma16(A, B, acc[dt]);
                }
            }
            const int t = 16 * wid + c;
            const float bs = p.gm_bs[g * 128 + t];
#pragma unroll
            for (int dt = 0; dt < 8; ++dt) {
                const int d = dt * 16 + 4 * G;
                const u32x2 uw = *(const u32x2*)(p.U + (row0 + t) * GMD + g * 128 + d);
                f32x4 o; o[0] = bflo(uw.x) * (acc[dt][0] + bs); o[1] = bfhi(uw.x) * (acc[dt][1] + bs); o[2] = bflo(uw.y) * (acc[dt][2] + bs); o[3] = bfhi(uw.y) * (acc[dt][3] + bs);
                st_bf16x4(p.OCAT + (row0 + t) * DM + QD + g * 128 + d, o);
            }
        }
    }
    for (int it = blockIdx.x * 8 + wid; it < NS; it += gridDim.x * 8) {
        const size_t row = (size_t)MP + it;
        const u32x4 w = *(const u32x4*)(p.Vg + row * GMD + lane * 8);
        const float x[8] = {bflo(w.x), bfhi(w.x), bflo(w.y), bfhi(w.y), bflo(w.z), bfhi(w.z), bflo(w.w), bfhi(w.w)};
        float s = 0.f;
#pragma unroll
        for (int i = 0; i < 8; ++i) s += x[i];
        const float mean = wave_sum(s) * (1.0f / GMD);
        float q = 0.f;
#pragma unroll
        for (int i = 0; i < 8; ++i) q += (x[i] - mean) * (x[i] - mean);
        const float rs = rsqrtf(wave_sum(q) * (1.0f / GMD) + EPS);
#pragma unroll
        for (int i = 0; i < 8; ++i) {
            const int c = lane * 8 + i, g = c >> 7;
            const float v = (x[i] - mean) * rs * p.gm_ln_g[c] + p.gm_ln_b[c];
            p.out[O_GMV + (size_t)it * GMD + c] = v;
            const float a = p.gm_ws[(size_t)g * 128 * 128] * v + p.gm_bs[g * 128];
            p.OCAT[row * DM + QD + c] = f2bf(bf2f(p.U[row * GMD + c]) * a);
        }
    }
}

template <int MODE>
__device__ __forceinline__ void phase_norm(const Params& p) {
    const int wid = threadIdx.x >> 6, lane = threadIdx.x & 63;
    const float* gpost = MODE == 0 ? p.ln_mix_post : MODE == 1 ? p.ln_ffn_post : p.ln_ple_post;
    for (int row = blockIdx.x * 8 + wid; row < MP + NS; row += gridDim.x * 8) {
        const bf16_t* fr = (const bf16_t*)p.F + (size_t)row * DM;
        const bf16_t* xb = MODE == 1 ? (const bf16_t*)p.X1 + (size_t)row * DM : p.X2b + (size_t)row * DM;
        f32x4 f[4], x[4];
#pragma unroll
        for (int k = 0; k < 4; ++k) { const u32x2 w = *(const u32x2*)(fr + lane * 4 + k * 256); f[k][0] = bflo(w.x); f[k][1] = bfhi(w.x); f[k][2] = bflo(w.y); f[k][3] = bfhi(w.y);
            if (MODE == 0) x[k] = *(const f32x4*)(xrow_ptr(p, row) + lane * 4 + k * 256);
            else { const u32x2 v = *(const u32x2*)(xb + lane * 4 + k * 256); x[k][0] = bflo(v.x); x[k][1] = bfhi(v.x); x[k][2] = bflo(v.y); x[k][3] = bfhi(v.y); } }
        const float r = row_rstd(f);
#pragma unroll
        for (int k = 0; k < 4; ++k) { const f32x4 g = *(const f32x4*)(gpost + lane * 4 + k * 256); x[k] = x[k] + f[k] * r * g; }
        if (MODE == 0) {
            const float r2 = row_rstd(x);
#pragma unroll
            for (int k = 0; k < 4; ++k) {
                st_bf16x4((bf16_t*)p.X1 + (size_t)row * DM + lane * 4 + k * 256, x[k]);
                const f32x4 g = *(const f32x4*)(p.ln_ffn_pre + lane * 4 + k * 256); const f32x4 o = x[k] * r2 * g;
                st_bf16x4(p.H2 + (size_t)row * DM + lane * 4 + k * 256, o);
            }
        } else if (MODE == 1) {
#pragma unroll
            for (int k = 0; k < 4; ++k) st_bf16x4(p.X2b + (size_t)row * DM + lane * 4 + k * 256, x[k]);
        } else {
            float* yr = row < MP ? p.out + O_YP + (size_t)row * DM : p.out + O_YS + (size_t)(row - MP) * DM;
#pragma unroll
            for (int k = 0; k < 4; ++k) *(f32x4*)(yr + lane * 4 + k * 256) = x[k];
        }
    }
}


#define XB_TMO      128
#define XB_XCNT(j)  (256  + 64 * (j))
#define XB_XSUB(j)  (1280 + 64 * (j))
#define XB_XGEN(j)  (2304 + 64 * (j))
#define XB_TOP      3328
#define XB_TOPGEN   3392
#define XCD_BAR_WORDS 3456
#define XB_SPIN_CAP (1u << 22)

__device__ __forceinline__ unsigned xb_ld(unsigned* p)              { return __hip_atomic_load(p, __ATOMIC_RELAXED, __HIP_MEMORY_SCOPE_AGENT); }
__device__ __forceinline__ unsigned xb_add(unsigned* p, unsigned v) { return __hip_atomic_fetch_add(p, v, __ATOMIC_RELAXED, __HIP_MEMORY_SCOPE_AGENT); }
__device__ __forceinline__ unsigned xb_xcc_id() { return (unsigned)__builtin_amdgcn_s_getreg((3 << 11) | 20) & 0xFu; }
#define XB_SPIN(cond, bar) do { unsigned _sp = 0; while (cond) { __builtin_amdgcn_s_sleep(1); \
    if ((++_sp & 255u) == 0u) { if (xb_ld(&(bar)[XB_TMO])) break; if (_sp > XB_SPIN_CAP) { atomicAdd(&(bar)[XB_TMO], 1u); break; } } } } while (0)

struct XcdBarrier {
    unsigned* bar; unsigned x;
    volatile LAS unsigned* st;
};

__device__ __forceinline__ XcdBarrier xcd_barrier_post(unsigned* bar, volatile LAS unsigned* st) {
    XcdBarrier b; b.bar = bar; b.x = xb_xcc_id(); b.st = st;
    if (threadIdx.x == 0) (void)xb_add(&bar[XB_XCNT(b.x)], 1u);
    return b;
}
__device__ __forceinline__ void xcd_barrier_complete(unsigned* bar, unsigned x, unsigned& nloc, unsigned& nx) {
    const unsigned G = gridDim.x * gridDim.y * gridDim.z;
    unsigned sum, cnt, mine, sp = 0u;
    for (;;) {
        sum = 0u; cnt = 0u; mine = 0u;
#pragma unroll
        for (unsigned j = 0; j < 16; ++j) { const unsigned c = xb_ld(&bar[XB_XCNT(j)]); sum += c; cnt += (c > 0u) ? 1u : 0u; mine = (j == x) ? c : mine; }
        if (sum == G) break;
        __builtin_amdgcn_s_sleep(1);
        if ((++sp & 255u) == 0u) { if (xb_ld(&bar[XB_TMO])) break; if (sp > XB_SPIN_CAP) { atomicAdd(&bar[XB_TMO], 1u); break; } }
    }
    nloc = mine > 0u ? mine : 1u; nx = cnt > 0u ? cnt : 1u;
}

__device__ __forceinline__ void xcd_barrier(const XcdBarrier& b) {
    asm volatile("s_waitcnt vmcnt(0)" ::: "memory");
    __syncthreads();
    if (threadIdx.x == 0) {
        unsigned* bar = b.bar;
        __builtin_amdgcn_s_waitcnt(0);
        unsigned nloc = b.st[0], nx = b.st[1];
        if (nloc == 0u) { xcd_barrier_complete(bar, b.x, nloc, nx); b.st[0] = nloc; b.st[1] = nx; }
        const unsigned old = xb_add(&bar[XB_XSUB(b.x)], 1u);
        const unsigned gen = old / nloc;
        if (old + 1u == (gen + 1u) * nloc) {
            __builtin_amdgcn_fence(__ATOMIC_RELEASE, "agent");
            asm volatile("s_waitcnt vmcnt(0)" ::: "memory");
            const unsigned og = xb_add(&bar[XB_TOP], 1u);
            const unsigned tg = og / nx;
            if (og + 1u == (tg + 1u) * nx) xb_add(&bar[XB_TOPGEN], 1u);
            else XB_SPIN(xb_ld(&bar[XB_TOPGEN]) == tg, bar);
            __builtin_amdgcn_fence(__ATOMIC_ACQUIRE, "agent");
            xb_add(&bar[XB_XGEN(b.x)], 1u);
            asm volatile("s_waitcnt vmcnt(0)" ::: "memory");
        } else {
            XB_SPIN(xb_ld(&bar[XB_XGEN(b.x)]) == gen, bar);
            __builtin_amdgcn_fence(__ATOMIC_ACQUIRE, "agent");
            asm volatile("s_waitcnt vmcnt(0)" ::: "memory");
        }
    }
    __syncthreads();
}

constexpr int NPHASE = 16;
constexpr int LDS_BYTES = GEMM_LDS;
static_assert(GM_LDS <= LDS_BYTES, "lds");
constexpr int NMT = MALL / BM;

constexpr int NMP = MP / BM;
template <int PH>
__device__ __forceinline__ void run_phase(const Params& p) {
    if (PH == 0) phase_prologue(p);
    if (PH == 1) { EpiIn e{p}; gemm_phase(p.H, DM, p.WinT, DM, NMP, INP / BM, e); gemm_skinny(p.H + (size_t)MP * DM, DM, p.WinT, DM, INP, e); }
    if (PH == 2) { EpiPart e{(bf16_t*)p.PART}; gemm_phase(p.CMPb, 4096, p.W1T, 1024, (2048 + NS * 1024) / BM, 1, e, 4, ZCmp(), 256); phase_deferred_transposes(p); }
    if (PH == 3) phase_cmp_final(p);
    if (PH == 4) phase_attn(p);
    if (PH == 5) phase_gmlp(p);
    if (PH == 6) { EpiBranch e{p.GA, p.GB, p.Y1}; gemm_phase<EpiBranch, ZNone, true>(p.OCAT, DM, p.WnT, DM, NMP, DM / BM, e); gemm_skinny2(p.OCAT + (size_t)MP * DM, DM, p.WnT, DM, DM, e); }
    if (PH == 8) { EpiBf16 e{(bf16_t*)p.F, DM}; gemm_phase(p.Y1, DM, p.WoT, DM, NMP, DM / BM, e); gemm_skinny(p.Y1 + (size_t)MP * DM, DM, p.WoT, DM, DM, e); }
    if (PH == 9) phase_norm<0>(p);
    if (PH == 10) { EpiSwiGLU e{p.ACT}; gemm_phase(p.H2, DM, p.WguT, DM, NMP, 2 * DFF / BM, e); gemm_skinny(p.H2 + (size_t)MP * DM, DM, p.WguT, DM, 2 * DFF, e); }
    if (PH == 11) { EpiBf16 e{(bf16_t*)p.F, DM}; gemm_phase(p.ACT, DFF, p.WdT, DFF, NMP, DM / BM, e); gemm_skinny(p.ACT + (size_t)MP * DFF, DFF, p.WdT, DFF, DM, e); }
    if (PH == 12) phase_norm<1>(p);
    if (PH == 13) { EpiBf16 e{(bf16_t*)p.T, DM}; gemm_phase(p.Pb, PLE, p.WpT, PLE, NMP, DM / BM, e); gemm_skinny(p.Pb + (size_t)MP * PLE, PLE, p.WpT, PLE, DM, e); }
    if (PH == 14) { EpiPleGate e{(const bf16_t*)p.T, (bf16_t*)p.F}; gemm_phase(p.X2b, DM, p.WpgT, DM, NMP, DM / BM, e); gemm_skinny(p.X2b + (size_t)MP * DM, DM, p.WpgT, DM, DM, e); }
    if (PH == 15) phase_norm<2>(p);
}

#ifndef MK_MULTI
#define MK_MULTI 0
#endif
template <int PH>
__global__ void __launch_bounds__(512, 2) k_phase(Params p) { run_phase<PH>(p); }

__global__ void __launch_bounds__(512, 2) k_all(Params p) {
    volatile LAS unsigned* st = (volatile LAS unsigned*)((LAS unsigned char*)smem + LDS_BYTES);
    if (threadIdx.x < 12) st[threadIdx.x] = 0u;
    __syncthreads();
    XcdBarrier bar = xcd_barrier_post(p.bar, st);
#if PROBE_DUP == 100
    run_phase<0>(p);  xcd_barrier(bar);
#endif
    run_phase<0>(p);  xcd_barrier(bar);
    run_phase<1>(p);  xcd_barrier(bar);
    run_phase<2>(p);  xcd_barrier(bar);
#if PROBE_DUP == 100
    run_phase<3>(p);  xcd_barrier(bar);
#endif
    run_phase<3>(p);  xcd_barrier(bar);
#if PROBE_DUP == 104
    run_phase<4>(p);  xcd_barrier(bar);
#endif
    run_phase<4>(p);
#if PROBE_DUP == 100
    run_phase<5>(p);  xcd_barrier(bar);
#endif
    run_phase<5>(p);  xcd_barrier(bar);
    run_phase<6>(p);  xcd_barrier(bar);
    run_phase<8>(p);  xcd_barrier(bar);
    run_phase<9>(p);  xcd_barrier(bar);
    run_phase<10>(p); xcd_barrier(bar);
    run_phase<11>(p); xcd_barrier(bar);
    run_phase<12>(p);
    run_phase<13>(p); xcd_barrier(bar);
    run_phase<14>(p); xcd_barrier(bar);
    run_phase<15>(p);
#if PROBE_SPIN
    if (blockIdx.x == 0 && threadIdx.x == 0) {
        const unsigned long long d = PROBE_TS[2] * PROBE_SPIN, t0 = probe_now();
        while (probe_now() - t0 < d) __builtin_amdgcn_s_sleep(8);
    }
#endif
}

static inline size_t al256(size_t x) { return (x + 255) & ~(size_t)255; }
template <int PH> static void launch_phase(const Params& p, int grid, hipStream_t s) {
    static bool attr = false;
    if (!attr) { (void)hipFuncSetAttribute((const void*)k_phase<PH>, hipFuncAttributeMaxDynamicSharedMemorySize, LDS_BYTES); attr = true; }
    k_phase<PH><<<grid, 512, LDS_BYTES, s>>>(p);
}
template <int PH> static void launch_all(const Params& p, int grid, hipStream_t s) {
    launch_phase<PH>(p, grid, s);
    if constexpr (PH + 1 < NPHASE) launch_all<PH + 1>(p, grid, s);
}

extern "C" void kernel_launch(void* const* d_in, const int* in_sizes, int n_in, void* d_out, int out_size, void* d_ws, size_t ws_size, hipStream_t stream) {
    Params p{};
    p.x_prompt = (const float*)d_in[0]; p.x_sample = (const float*)d_in[1]; p.cache_cmp = (const float*)d_in[2]; p.cache_slc = (const float*)d_in[3];
    p.state_win = (const float*)d_in[4]; p.page_table = (const int*)d_in[5]; p.p_prompt = (const float*)d_in[6]; p.p_sample = (const float*)d_in[7];
    p.rel_bias = (const float*)d_in[8]; p.ln_mix_pre = (const float*)d_in[9]; p.w_in = (const float*)d_in[10];
    p.pe_k = (const float*)d_in[11]; p.w1_k = (const float*)d_in[12]; p.w2_k = (const float*)d_in[13];
    p.pe_v = (const float*)d_in[14]; p.w1_v = (const float*)d_in[15]; p.w2_v = (const float*)d_in[16];
    p.gm_ln_g = (const float*)d_in[17]; p.gm_ln_b = (const float*)d_in[18]; p.gm_ws = (const float*)d_in[19]; p.gm_bs = (const float*)d_in[20];
    p.w_br_nsa = (const float*)d_in[21]; p.w_br_gm = (const float*)d_in[22]; p.w_out = (const float*)d_in[23];
    p.ln_mix_post = (const float*)d_in[24]; p.ln_ffn_pre = (const float*)d_in[25]; p.w_gate = (const float*)d_in[26]; p.w_up = (const float*)d_in[27];
    p.w_down = (const float*)d_in[28]; p.ln_ffn_post = (const float*)d_in[29]; p.w_ple = (const float*)d_in[30]; p.w_ple_gate = (const float*)d_in[31];
    p.ln_ple_post = (const float*)d_in[32];
    p.out = (float*)d_out;
    unsigned char* w = (unsigned char*)d_ws; size_t off = 0;
    auto take = [&](size_t bytes) { void* r = w + off; off = al256(off + bytes); return r; };
    p.bar = (unsigned*)take(16384);
    p.WinT = (bf16_t*)take((size_t)INP * DM * 2); p.WnT = (bf16_t*)take((size_t)DM * DM * 2); p.WgT = nullptr;
    p.WoT = (bf16_t*)take((size_t)DM * DM * 2); p.WguT = (bf16_t*)take((size_t)2 * DFF * DM * 2); p.WdT = (bf16_t*)take((size_t)DM * DFF * 2);
    p.WpgT = (bf16_t*)take((size_t)DM * DM * 2); p.WpT = (bf16_t*)take((size_t)DM * PLE * 2); p.W1T = (bf16_t*)take((size_t)2 * 256 * 1024 * 2);
    p.H = (bf16_t*)take((size_t)MALL * DM * 2); p.Qb = (bf16_t*)take((size_t)MALL * QD * 2);
    p.CMPb = (bf16_t*)take(((size_t)MP + (size_t)NS * PAST) * 256 * 2); p.SLCb = (bf16_t*)take((size_t)MALL * 256 * 2); p.WINb = (bf16_t*)take((size_t)MALL * 256 * 2);
    p.U = (bf16_t*)take((size_t)MALL * GMD * 2); p.Vg = (bf16_t*)take((size_t)MALL * GMD * 2);
    p.GA = (bf16_t*)take((size_t)MALL * DM * 2); p.GB = (bf16_t*)take((size_t)MALL * DM * 2);
    p.GATE = (float*)take((size_t)MALL * 32 * 4);
    p.PART = (float*)take((size_t)(2048 + NS * 1024) * 4 * 256 * 4); p.PEB = (float*)take(256 * 4);
    p.KCP = (float*)take((size_t)NB * NG * 512 * 64 * 4); p.VCP = (float*)take((size_t)NB * NG * 512 * 64 * 4);
    p.KCS = (float*)take((size_t)NS * NG * 1024 * 64 * 4); p.VCS = (float*)take((size_t)NS * NG * 1024 * 64 * 4); p.KN = (float*)take(NB * NG * 128 * 4);
    p.KCb = (bf16_t*)take((size_t)NB * NG * 512 * 64 * 2); p.VCT = (bf16_t*)take((size_t)NB * NG * 64 * 512 * 2);
    p.SLCvT = (bf16_t*)take((size_t)NB * NG * 64 * SEQ * 2); p.WINvT = (bf16_t*)take((size_t)NB * NG * 64 * SEQ * 2);
    p.GWb = (bf16_t*)take(4 * 128 * 128 * 2); p.W2T = (bf16_t*)take(2 * 64 * 128 * 2);
    p.SLCkF = (bf16_t*)take((size_t)NB * NG * 64 * SEQ * 2); p.WINkF = (bf16_t*)take((size_t)NB * NG * 64 * SEQ * 2);
    p.OCAT = (bf16_t*)take((size_t)MALL * DM * 2); p.T = (float*)take((size_t)MALL * DM * 4); p.Y1 = (bf16_t*)take((size_t)MALL * DM * 2);
    p.F = (float*)take((size_t)MALL * DM * 4); p.X1 = (float*)take((size_t)MALL * DM * 4); p.H2 = (bf16_t*)take((size_t)MALL * DM * 2);
    p.ACT = (bf16_t*)take((size_t)MALL * DFF * 2); p.X2 = (float*)take((size_t)MALL * DM * 4); p.X2b = (bf16_t*)take((size_t)MALL * DM * 2);
    p.Pb = (bf16_t*)take((size_t)MALL * PLE * 2);
    if (off > ws_size) { fprintf(stderr, "workspace too small: need %zu have %zu\n", off, ws_size); return; }
    (void)hipMemsetAsync(p.OCAT + (size_t)(MP + NS) * DM, 0, (size_t)(MALL - MP - NS) * DM * 2, stream);
#if MK_MULTI
    launch_all<0>(p, 256, stream);
#else
    constexpr size_t kDynLds = LDS_BYTES + 48;
    static int grid = 0;
    if (!grid) {
        int dev = 0, cus = 0, per_cu = 0;
        (void)hipGetDevice(&dev);
        (void)hipDeviceGetAttribute(&cus, hipDeviceAttributeMultiprocessorCount, dev);
        (void)hipFuncSetAttribute((const void*)k_all, hipFuncAttributeMaxDynamicSharedMemorySize, (int)kDynLds);
        (void)hipOccupancyMaxActiveBlocksPerMultiprocessor(&per_cu, (const void*)k_all, 512, kDynLds);
        grid = cus * (per_cu < 1 ? per_cu : 1);
        if (grid <= 0) { fprintf(stderr, "k_all: occupancy query says %d blocks per CU\n", per_cu); grid = 0; return; }
    }
    (void)hipMemsetAsync(p.bar, 0, XCD_BAR_WORDS * sizeof(unsigned), stream);
    k_all<<<grid, 512, kDynLds, stream>>>(p);
#endif
}
```

```cpp
#include <hip/hip_runtime.h>
#include <stdint.h>
#include <cstdio>

typedef unsigned short bf16_t;
typedef short bf16x8 __attribute__((ext_vector_type(8)));
typedef float f32x4 __attribute__((ext_vector_type(4)));
typedef float f32x2 __attribute__((ext_vector_type(2)));
typedef unsigned u32x4 __attribute__((ext_vector_type(4)));
typedef unsigned u32x2 __attribute__((ext_vector_type(2)));
#define LAS __attribute__((address_space(3)))

constexpr int DM = 1024, NB = 4, SEQ = 8192, MP = NB * SEQ, NS = 32, MALL = MP + 256, PAST = 16384, PAGE = 128, NPG = 128;
constexpr int NH = 8, NG = 2, HPG = 4, DH = 64, QD = 512, WIN = 512, GMD = 512, DFF = 2816, PLE = 256, IND = 4376, INP = 4608;
constexpr int NCP = 511, NCS = 1023;
constexpr float EPS = 1e-6f;
constexpr float LOG2E = 1.4426950408889634f, QSCALE = 0.125f * LOG2E;
constexpr long O_YP = 0, O_YS = 33554432, O_CMPP = 33587200, O_SLCP = 41975808, O_WINP = 50364416, O_CMPS = 50888704,
               O_SLCS = 50896896, O_WINS = 50905088, O_GMV = 55099392;

struct Params {
    const float *x_prompt, *x_sample, *cache_cmp, *cache_slc, *state_win; const int* page_table;
    const float *p_prompt, *p_sample, *rel_bias, *ln_mix_pre, *w_in, *pe_k, *w1_k, *w2_k, *pe_v, *w1_v, *w2_v;
    const float *gm_ln_g, *gm_ln_b, *gm_ws, *gm_bs, *w_br_nsa, *w_br_gm, *w_out, *ln_mix_post, *ln_ffn_pre;
    const float *w_gate, *w_up, *w_down, *ln_ffn_post, *w_ple, *w_ple_gate, *ln_ple_post;
    float* out;
    unsigned* bar;
    bf16_t *WinT, *WnT, *WgT, *WoT, *WguT, *WdT, *WpgT, *WpT, *W1T;
    bf16_t *H, *Qb, *CMPb, *SLCb, *WINb, *U, *Vg, *GA, *GB;
    float* GATE;
    float *PART, *PEB, *KCP, *VCP, *KCS, *VCS, *KN;
    bf16_t *KCb, *VCT, *SLCvT, *WINvT, *SLCkF, *WINkF, *GWb, *W2T;
    bf16_t* OCAT; float* T; bf16_t* Y1; float* F; float* X1; bf16_t* H2; bf16_t* ACT; float* X2; bf16_t* X2b; bf16_t* Pb;
};

__device__ __forceinline__ unsigned cvt_pk_bf16(float lo, float hi) { unsigned r; asm volatile("v_cvt_pk_bf16_f32 %0, %1, %2" : "=v"(r) : "v"(lo), "v"(hi)); return r; }
__device__ __forceinline__ bf16_t f2bf(float f) { return (bf16_t)(cvt_pk_bf16(f, 0.f) & 0xffffu); }
__device__ __forceinline__ float bf2f(bf16_t h) { return __uint_as_float(((unsigned)h) << 16); }
__device__ __forceinline__ float bflo(unsigned w) { return __uint_as_float(w << 16); }
__device__ __forceinline__ float bfhi(unsigned w) { return __uint_as_float(w & 0xffff0000u); }
__device__ __forceinline__ float ex2(float x) { return __builtin_amdgcn_exp2f(x); }
__device__ __forceinline__ float sigmoidf_(float x) { return 1.0f / (1.0f + __expf(-x)); }
__device__ __forceinline__ float siluf_(float x) { return x * sigmoidf_(x); }
__device__ __forceinline__ float geluf_(float x) {
    const float u = 0.7978845608028654f * (x + 0.044715f * x * x * x);
    const float e = __expf(2.0f * u);
    const float th = 1.0f - 2.0f / (e + 1.0f);
    return 0.5f * x * (1.0f + th);
}
__device__ __forceinline__ float wave_sum(float v) {
#pragma unroll
    for (int o = 32; o > 0; o >>= 1) v += __shfl_xor(v, o);
    return v;
}
__device__ __forceinline__ float wave_max(float v) {
#pragma unroll
    for (int o = 32; o > 0; o >>= 1) v = fmaxf(v, __shfl_xor(v, o));
    return v;
}
__device__ __forceinline__ int t5_bucket(int d) {
    if (d < 16) return d;
    if (d >= 128) return 31;
    const int b = 16 + (int)(__logf((float)d * (1.0f / 16.0f)) * (16.0f / 2.0794415416798357f));
    return b < 31 ? b : 31;
}

extern __shared__ __attribute__((aligned(16))) unsigned char smem[];
#ifndef PROBE_DUP
#define PROBE_DUP 0
#endif
#define PROBE_LDS_OFF 131072
#ifndef PROBE_SPIN
#define PROBE_SPIN 0
#endif
#ifndef PROBE_SEG
#define PROBE_SEG 5
#endif
__device__ __forceinline__ unsigned long long probe_now() { unsigned long long t; asm volatile("s_memrealtime %0\n\ts_waitcnt lgkmcnt(0)" : "=s"(t) :: "memory"); return t; }
#define PROBE_TS ((volatile LAS unsigned long long*)((LAS unsigned char*)smem + PROBE_LDS_OFF + 16))
#if PROBE_SPIN
#define PROBE_BEGIN(seg) unsigned long long pb_##seg = 0; if (PROBE_SEG == seg && threadIdx.x == 0) pb_##seg = probe_now();
#define PROBE_END(seg) if (PROBE_SEG == seg && threadIdx.x == 0) { PROBE_TS[2] = PROBE_TS[2] + (probe_now() - pb_##seg); }
#else
#define PROBE_BEGIN(seg)
#define PROBE_END(seg)
#endif

constexpr int BM = 256, BK = 64, HALF = 128, HT = HALF * BK, GEMM_LDS = 8 * HT * 2;
__device__ __forceinline__ int lds_byte(int r, int c) { const int st = (r >> 4) * 2 + (c >> 5), rr = r & 15, cc = c & 31, ob = rr * 64 + cc * 2; return st * 1024 + (ob ^ (((ob >> 9) & 1) << 5)); }
__device__ __forceinline__ void stage_rc(int b, int& R, int& C) { const int st = b / 1024, sb = b % 1024, swz = sb ^ (((sb >> 9) & 1) << 5); R = (st >> 1) * 16 + swz / 64; C = (st & 1) * 32 + (swz % 64) / 2; }

constexpr int HTB = HALF * BK * 2;
template <class F>
__device__ __forceinline__ void for_each_frag(const f32x4 (&acc)[2][2][4][2], int brow, int bcol, int wr, int wc, int fr, int fq, F&& f) {
#pragma unroll
    for (int ai = 0; ai < 2; ++ai)
#pragma unroll
        for (int m = 0; m < 4; ++m)
#pragma unroll
            for (int bj = 0; bj < 2; ++bj)
#pragma unroll
                for (int n = 0; n < 2; ++n)
                    f(brow + ai * HALF + wr * 64 + m * 16 + fr, bcol + bj * HALF + wc * 32 + n * 16 + fq * 4, acc[ai][bj][m][n]);
}

struct ZNone { __device__ __forceinline__ size_t a(int) const { return 0; } __device__ __forceinline__ size_t b(int) const { return 0; } };
template <class Epi, class ZMap = ZNone, bool HAS_MID = false>
__device__ __forceinline__ void gemm_phase(const bf16_t* A, int lda, const bf16_t* Bt, int K, int nM, int nN, const Epi& E, int nZ = 1, ZMap zm = ZMap(), int kstepA_el = BK) {
    LAS unsigned char* lds = (LAS unsigned char*)smem;
    int tid = threadIdx.x; asm volatile("" : "+v"(tid));
    const int wid = __builtin_amdgcn_readfirstlane(tid >> 6), lane = tid & 63, wr = wid >> 2, wc = wid & 3, fr = lane & 15, fq = lane >> 4;
    const int nt = K / BK, nmn = nM * nN, nu = nmn * nZ, G = gridDim.x;
    int u = blockIdx.x;
    if (u >= nu) return;
    unsigned voffA[2], voffB[2];
#pragma unroll
    for (int i = 0; i < 2; ++i) { int R, C; stage_rc(tid * 16 + i * 8192, R, C); voffA[i] = (unsigned)(R * lda + C) * 2u; voffB[i] = (unsigned)(R * K + C) * 2u; }
    const size_t kstep = (size_t)(BK * 2), kstepA = (size_t)kstepA_el * 2;
    const size_t hstepA = (size_t)HALF * lda * 2, hstepB = (size_t)HALF * K * 2, tstepA = 2 * hstepA, tstepB = 2 * hstepB;
    const unsigned ldsw = (unsigned)wid * 1024u;
    const int aoff = lds_byte(wr * 64 + fr, fq * 8), boff = lds_byte(wc * 32 + fr, fq * 8);
#define PG8_SA(b, h) (((b) * 2 + (h)) * HTB)
#define PG8_SB(b, h) ((4 + (b) * 2 + (h)) * HTB)
#define PG8_STAGE(bufoff, gbase, voff) do { _Pragma("unroll") for (int _i = 0; _i < 2; ++_i) \
        __builtin_amdgcn_global_load_lds((const unsigned*)((const char*)(gbase) + (voff)[_i]), (LAS unsigned*)(lds + (bufoff) + ldsw + _i * 8192), 16, 0, 0); } while (0)
#define PG8_LDA(dst, b, h) do { _Pragma("unroll") for (int m = 0; m < 4; ++m) _Pragma("unroll") for (int k = 0; k < 2; ++k) dst[m][k] = *(const LAS bf16x8*)(lds + PG8_SA(b, h) + aoff + m * 2048 + k * 1024); } while (0)
#define PG8_LDB(dst, b, h) do { _Pragma("unroll") for (int n = 0; n < 2; ++n) _Pragma("unroll") for (int k = 0; k < 2; ++k) dst[n][k] = *(const LAS bf16x8*)(lds + PG8_SB(b, h) + boff + n * 2048 + k * 1024); } while (0)
#define PG8_MMA(ai, bj, At, Bt_) do { __builtin_amdgcn_s_setprio(1); _Pragma("unroll") for (int m = 0; m < 4; ++m) _Pragma("unroll") for (int n = 0; n < 2; ++n) _Pragma("unroll") for (int k = 0; k < 2; ++k) \
        acc[ai][bj][m][n] = __builtin_amdgcn_mfma_f32_16x16x32_bf16(Bt_[n][k], At[m][k], acc[ai][bj][m][n], 0, 0, 0); __builtin_amdgcn_s_setprio(0); } while (0)
#define PG8_WAIT_V(n) asm volatile("s_waitcnt vmcnt(" #n ")" ::: "memory")
#define PG8_WAIT_L(n) asm volatile("s_waitcnt lgkmcnt(" #n ")" ::: "memory")
#define PG8_BAR __builtin_amdgcn_s_barrier()
#define PG8_SCHED __builtin_amdgcn_sched_barrier(0)
    f32x4 acc[2][2][4][2];
#pragma unroll
    for (int a = 0; a < 2; ++a)
#pragma unroll
        for (int b = 0; b < 2; ++b)
#pragma unroll
            for (int m = 0; m < 4; ++m)
#pragma unroll
                for (int n = 0; n < 2; ++n) acc[a][b][m][n] = (f32x4){0.f, 0.f, 0.f, 0.f};
    bf16x8 At[4][2], B0[2][2], B1[2][2];
    auto unit_of = [&](int uu, int& z_, int& pm_, int& pn_) {
        if (nZ == 1) {
            int wg = uu; { const int q = nu / 8, r = nu % 8, xcd = wg % 8, off = wg / 8; wg = (xcd < r ? xcd * (q + 1) : r * (q + 1) + (xcd - r) * q) + off; }
            const int nig = 8 * nN, gid = wg / nig, fm = gid * 8, gsz = (nM - fm) < 8 ? (nM - fm) : 8;
            z_ = 0; pm_ = fm + ((wg % nig) % gsz); pn_ = (wg % nig) / gsz;
        } else { z_ = uu / nmn; pm_ = (uu - z_ * nmn) / nN; pn_ = (uu - z_ * nmn) - pm_ * nN; }
    };
    int z, pm, pn; unit_of(u, z, pm, pn);
    const char* cA = (const char*)(A + zm.a(z)) + (size_t)pm * tstepA; const char* cB = (const char*)(Bt + zm.b(z)) + (size_t)pn * tstepB;
    PG8_STAGE(PG8_SB(0, 0), cB, voffB); PG8_STAGE(PG8_SA(0, 0), cA, voffA); PG8_STAGE(PG8_SB(0, 1), cB + hstepB, voffB); PG8_STAGE(PG8_SA(0, 1), cA + hstepA, voffA);
    if (wr == 1) PG8_BAR;
    PG8_WAIT_V(4); PG8_BAR;
    PG8_STAGE(PG8_SB(1, 0), cB + kstep, voffB); PG8_STAGE(PG8_SA(1, 0), cA + kstepA, voffA); PG8_STAGE(PG8_SB(1, 1), cB + hstepB + kstep, voffB);
    PG8_WAIT_V(6); PG8_BAR;
    for (;;) {
        const int un = u + G; const bool has_next = un < nu;
        int nz = z, npm = pm, npn = pn; if (has_next) unit_of(un, nz, npm, npn);
        const char* nA = (const char*)(A + zm.a(nz)) + (size_t)npm * tstepA; const char* nB = (const char*)(Bt + zm.b(nz)) + (size_t)npn * tstepB;
        auto kiter = [&](int t) {
            const bool last = (t == nt - 2);
            const char* a1 = cA + (size_t)(t + 1) * kstepA;
            const char* a2 = last ? nA : cA + (size_t)(t + 2) * kstepA; const char* b2 = last ? nB : cB + (size_t)(t + 2) * kstep;
            const char* a3 = a2 + kstepA; const char* b3 = b2 + kstep;
            PG8_LDB(B0, 0, 0); PG8_SCHED; PG8_LDA(At, 0, 0); PG8_STAGE(PG8_SA(1, 1), a1 + hstepA, voffA);
            PG8_WAIT_L(8); PG8_BAR; PG8_WAIT_L(0); PG8_MMA(0, 0, At, B0); PG8_BAR; PG8_SCHED;
            PG8_LDB(B1, 0, 1); PG8_STAGE(PG8_SB(0, 0), b2, voffB);
            PG8_BAR; PG8_WAIT_L(0); PG8_MMA(0, 1, At, B1); PG8_BAR;
            PG8_LDA(At, 0, 1); PG8_STAGE(PG8_SA(0, 0), a2, voffA);
            PG8_BAR; PG8_WAIT_L(0); PG8_MMA(1, 0, At, B0); PG8_BAR; PG8_SCHED;
            PG8_STAGE(PG8_SB(0, 1), b2 + hstepB, voffB);
            PG8_WAIT_V(6); PG8_BAR; PG8_MMA(1, 1, At, B1); PG8_BAR;
            PG8_LDB(B0, 1, 0); PG8_SCHED; PG8_LDA(At, 1, 0); PG8_STAGE(PG8_SA(0, 1), a2 + hstepA, voffA);
            PG8_WAIT_L(8); PG8_BAR; PG8_WAIT_L(0); PG8_MMA(0, 0, At, B0); PG8_BAR; PG8_SCHED;
            PG8_LDB(B1, 1, 1); PG8_STAGE(PG8_SB(1, 0), b3, voffB);
            PG8_BAR; PG8_WAIT_L(0); PG8_MMA(0, 1, At, B1); PG8_BAR;
            PG8_LDA(At, 1, 1); PG8_STAGE(PG8_SA(1, 0), a3, voffA);
            PG8_BAR; PG8_WAIT_L(0); PG8_MMA(1, 0, At, B0); PG8_BAR; PG8_SCHED;
            PG8_STAGE(PG8_SB(1, 1), b3 + hstepB, voffB);
            PG8_WAIT_V(6); PG8_BAR; PG8_MMA(1, 1, At, B1); PG8_BAR;
        };
        if constexpr (HAS_MID) {
            for (int t = 0; t < (nt >> 1); t += 2) kiter(t);
            E.mid(acc, pm * BM, pn * BM, wr, wc, fr, fq);
            for (int t = nt >> 1; t < nt; t += 2) kiter(t);
        } else {
            for (int t = 0; t < nt; t += 2) kiter(t);
        }
        E(acc, pm * BM, pn * BM + (z << 20), wr, wc, fr, fq);
        if (!has_next) break;
#pragma unroll
        for (int a = 0; a < 2; ++a)
#pragma unroll
            for (int b = 0; b < 2; ++b)
#pragma unroll
                for (int m = 0; m < 4; ++m)
#pragma unroll
                    for (int n = 0; n < 2; ++n) acc[a][b][m][n] = (f32x4){0.f, 0.f, 0.f, 0.f};
        u = un; z = nz; pm = npm; pn = npn; cA = nA; cB = nB;
    }
    PG8_WAIT_V(0);
    if (wr == 0) PG8_BAR;
    PG8_BAR;
#undef PG8_SA
#undef PG8_SB
#undef PG8_STAGE
#undef PG8_LDA
#undef PG8_LDB
#undef PG8_MMA
#undef PG8_WAIT_V
#undef PG8_WAIT_L
#undef PG8_BAR
#undef PG8_SCHED
}

__device__ __forceinline__ f32x4 mfma16(bf16x8 a, bf16x8 b, f32x4 c) { return __builtin_amdgcn_mfma_f32_16x16x32_bf16(a, b, c, 0, 0, 0); }
__device__ __forceinline__ bf16x8 pack_p(const f32x4& a, const f32x4& b) {
    u32x4 w; w.x = cvt_pk_bf16(a[0], a[1]); w.y = cvt_pk_bf16(a[2], a[3]); w.z = cvt_pk_bf16(b[0], b[1]); w.w = cvt_pk_bf16(b[2], b[3]);
    return __builtin_bit_cast(bf16x8, w);
}
__device__ __forceinline__ size_t kfrag_off(int key, int d) { return ((size_t)((key >> 4) * 2 + (d >> 5)) * 64 + ((d >> 3) & 3) * 16 + (key & 15)) * 8 + (d & 7); }
__device__ __forceinline__ size_t vfrag_off(int key, int d) {
    return ((size_t)((key >> 5) * 4 + (d >> 4)) * 64 + ((key >> 2) & 3) * 16 + (d & 15)) * 8 + ((key >> 4) & 1) * 4 + (key & 3);
}
__device__ __forceinline__ void st_bf16x4(bf16_t* p, f32x4 v) { u32x2 w; w.x = cvt_pk_bf16(v[0], v[1]); w.y = cvt_pk_bf16(v[2], v[3]); *(u32x2*)p = w; }

struct EpiIn {
    const Params& p;
    __device__ __forceinline__ void apply(int row, int col, f32x4 v) const {
        const Params& P = p; const int pn = col >> 8, c = col & 255;
        if (pn < 2) st_bf16x4(P.Qb + (size_t)row * QD + col, v * QSCALE);
        else if (pn < 5) {
            if (pn != 2) st_bf16x4((pn == 3 ? P.SLCb : P.WINb) + (size_t)row * 256 + c, v);
            if (pn < 4) *(f32x4*)(P.out + (pn == 2 ? O_CMPS : O_SLCS) + (size_t)(row - MP) * 256 + c) = v;
            else *(f32x4*)(P.out + O_WINS + ((size_t)(row - MP) * WIN + (WIN - 1)) * 256 + c) = v;
        } else if (pn < 9) {
            f32x4 g; g[0] = geluf_(v[0]); g[1] = geluf_(v[1]); g[2] = geluf_(v[2]); g[3] = geluf_(v[3]);
            st_bf16x4((pn < 7 ? P.U : P.Vg) + (size_t)row * GMD + (col - (pn < 7 ? 1280 : 1792)), g);
        } else if (pn < 17) {
            f32x4 g; g[0] = sigmoidf_(v[0]); g[1] = sigmoidf_(v[1]); g[2] = sigmoidf_(v[2]); g[3] = sigmoidf_(v[3]);
            st_bf16x4((pn < 13 ? P.GA : P.GB) + (size_t)row * DM + (col - (pn < 13 ? 2304 : 3328)), g);
        } else if (c < 24) { f32x4 g; g[0] = sigmoidf_(v[0]); g[1] = sigmoidf_(v[1]); g[2] = sigmoidf_(v[2]); g[3] = sigmoidf_(v[3]); *(f32x4*)(P.GATE + (size_t)row * 32 + c) = g; }
    }
    __device__ __forceinline__ void operator()(const f32x4 (&acc)[2][2][4][2], int brow, int bcol, int wr, int wc, int fr, int fq) const {
        const int pn = bcol >> 8;
        const Params& P = p;
        if (pn < 2) {
            for_each_frag(acc, brow, bcol, wr, wc, fr, fq, [&](int row, int col, f32x4 v) { st_bf16x4(P.Qb + (size_t)row * QD + col, v * QSCALE); });
        } else if (pn < 5) {
            bf16_t* cp = pn == 2 ? P.CMPb : pn == 3 ? P.SLCb : P.WINb;
            for_each_frag(acc, brow, bcol, wr, wc, fr, fq, [&](int row, int col, f32x4 v) {
                const int c = col & 255;
                if (pn == 2) st_bf16x4(cp + (size_t)row * 256 + c, v);
                if (pn >= 3 && c < 128 && row < MP) {
                    st_bf16x4((pn == 3 ? P.SLCkF : P.WINkF) + ((size_t)(row >> 13) * NG + (c >> 6)) * SEQ * 64 + kfrag_off(row & (SEQ - 1), c & 63), v);
                }
                if (pn >= 3 && c >= 128 && row < MP) {
                    const int t = row & (SEQ - 1), dc = c - 128;
                    bf16_t* vt = (pn == 3 ? P.SLCvT : P.WINvT) + ((size_t)(row >> 13) * NG + (dc >> 6)) * SEQ * 64 + vfrag_off(t, dc & 63);
                    vt[0] = f2bf(v[0]); vt[8] = f2bf(v[1]); vt[16] = f2bf(v[2]); vt[24] = f2bf(v[3]);
                }
                if (pn < 4) {
                    if (row < MP) *(f32x4*)(P.out + (pn == 2 ? O_CMPP : O_SLCP) + (size_t)row * 256 + c) = v;
                    else if (row < MP + NS) *(f32x4*)(P.out + (pn == 2 ? O_CMPS : O_SLCS) + (size_t)(row - MP) * 256 + c) = v;
                } else {
                    if (row < MP) { const int t = row & (SEQ - 1), b = row >> 13; if (t >= SEQ - WIN) *(f32x4*)(P.out + O_WINP + ((size_t)b * WIN + (t - (SEQ - WIN))) * 256 + c) = v; }
                    else if (row < MP + NS) *(f32x4*)(P.out + O_WINS + ((size_t)(row - MP) * WIN + (WIN - 1)) * 256 + c) = v;
                }
            });
        } else if (pn < 9) {
            bf16_t* dst = pn < 7 ? P.U : P.Vg; const int c0 = pn < 7 ? 1280 : 1792;
            for_each_frag(acc, brow, bcol, wr, wc, fr, fq, [&](int row, int col, f32x4 v) {
                f32x4 g; g[0] = geluf_(v[0]); g[1] = geluf_(v[1]); g[2] = geluf_(v[2]); g[3] = geluf_(v[3]);
                st_bf16x4(dst + (size_t)row * GMD + (col - c0), g); });
        } else if (pn < 17) {
            bf16_t* dst = pn < 13 ? P.GA : P.GB; const int c0 = pn < 13 ? 2304 : 3328;
            for_each_frag(acc, brow, bcol, wr, wc, fr, fq, [&](int row, int col, f32x4 v) {
                f32x4 g; g[0] = sigmoidf_(v[0]); g[1] = sigmoidf_(v[1]); g[2] = sigmoidf_(v[2]); g[3] = sigmoidf_(v[3]);
                st_bf16x4(dst + (size_t)row * DM + (col - c0), g); });
        } else {
            for_each_frag(acc, brow, bcol, wr, wc, fr, fq, [&](int row, int col, f32x4 v) {
                const int c = col & 255;
                if (c < 24) { f32x4 g; g[0] = sigmoidf_(v[0]); g[1] = sigmoidf_(v[1]); g[2] = sigmoidf_(v[2]); g[3] = sigmoidf_(v[3]); *(f32x4*)(P.GATE + (size_t)row * 32 + c) = g; } });
        }
    }
};
struct EpiBranch {
    const bf16_t* GA; const bf16_t* GB; bf16_t* Y1;
    __device__ __forceinline__ void mid(f32x4 (&acc)[2][2][4][2], int brow, int bcol, int wr, int wc, int fr, int fq) const {
#pragma unroll
        for (int ai = 0; ai < 2; ++ai)
#pragma unroll
            for (int m = 0; m < 4; ++m)
#pragma unroll
                for (int bj = 0; bj < 2; ++bj)
#pragma unroll
                    for (int n = 0; n < 2; ++n) {
                        const size_t o = (size_t)(brow + ai * HALF + wr * 64 + m * 16 + fr) * DM + bcol + bj * HALF + wc * 32 + n * 16 + fq * 4;
                        const u32x2 a = *(const u32x2*)(GA + o), b = *(const u32x2*)(GB + o);
                        f32x4& v = acc[ai][bj][m][n];
                        v[0] *= bflo(a.x) / fmaxf(bflo(b.x), 1e-30f); v[1] *= bfhi(a.x) / fmaxf(bfhi(b.x), 1e-30f);
                        v[2] *= bflo(a.y) / fmaxf(bflo(b.y), 1e-30f); v[3] *= bfhi(a.y) / fmaxf(bfhi(b.y), 1e-30f);
                        if (bj == 1 && n == 1) __builtin_amdgcn_sched_barrier(0);
                    }
    }
    __device__ __forceinline__ void operator()(const f32x4 (&acc)[2][2][4][2], int brow, int bcol, int wr, int wc, int fr, int fq) const {
        for_each_frag(acc, brow, bcol, wr, wc, fr, fq, [&](int row, int col, f32x4 v) {
            const u32x2 b = *(const u32x2*)(GB + (size_t)row * DM + col);
            f32x4 o; o[0] = v[0] * fmaxf(bflo(b.x), 1e-30f); o[1] = v[1] * fmaxf(bfhi(b.x), 1e-30f); o[2] = v[2] * fmaxf(bflo(b.y), 1e-30f); o[3] = v[3] * fmaxf(bfhi(b.y), 1e-30f);
            st_bf16x4(Y1 + (size_t)row * DM + col, o); });
    }
    __device__ __forceinline__ void apply2(int row, int col, f32x4 v1, f32x4 v2) const {
        const u32x2 a = *(const u32x2*)(GA + (size_t)row * DM + col), b = *(const u32x2*)(GB + (size_t)row * DM + col);
        f32x4 o; o[0] = v1[0] * bflo(a.x) + v2[0] * bflo(b.x); o[1] = v1[1] * bfhi(a.x) + v2[1] * bfhi(b.x); o[2] = v1[2] * bflo(a.y) + v2[2] * bflo(b.y); o[3] = v1[3] * bfhi(a.y) + v2[3] * bfhi(b.y);
        st_bf16x4(Y1 + (size_t)row * DM + col, o);
    }
};
struct EpiF32 {
    float* F; int ld;
    __device__ __forceinline__ void apply(int row, int col, f32x4 v) const { *(f32x4*)(F + (size_t)row * ld + col) = v; }
    __device__ __forceinline__ void operator()(const f32x4 (&acc)[2][2][4][2], int brow, int bcol, int wr, int wc, int fr, int fq) const {
        for_each_frag(acc, brow, bcol, wr, wc, fr, fq, [&](int row, int col, f32x4 v) { *(f32x4*)(F + (size_t)row * ld + col) = v; });
    }
};
struct EpiBf16 {
    bf16_t* O; int ld;
    __device__ __forceinline__ void apply(int row, int col, f32x4 v) const { st_bf16x4(O + (size_t)row * ld + col, v); }
    __device__ __forceinline__ void operator()(const f32x4 (&acc)[2][2][4][2], int brow, int bcol, int wr, int wc, int fr, int fq) const {
        for_each_frag(acc, brow, bcol, wr, wc, fr, fq, [&](int row, int col, f32x4 v) { apply(row, col, v); });
    }
};
struct EpiPart {
    bf16_t* PART;
    __device__ __forceinline__ void operator()(const f32x4 (&acc)[2][2][4][2], int brow, int bcol, int wr, int wc, int fr, int fq) const {
        const int z = bcol >> 20;
        for_each_frag(acc, brow, 0, wr, wc, fr, fq, [&](int row, int col, f32x4 v) { st_bf16x4(PART + ((size_t)row * 4 + z) * 256 + col, v); });
    }
};
struct ZCmp { __device__ __forceinline__ size_t a(int z) const { return (size_t)z * 64; } __device__ __forceinline__ size_t b(int z) const { return (size_t)(z >> 1) * 256 * 1024; } };
struct EpiSwiGLU {
    bf16_t* ACT;
    __device__ __forceinline__ void apply(int row, int col, f32x4 v) const { *(unsigned*)(ACT + (size_t)row * DFF + (col >> 1)) = cvt_pk_bf16(siluf_(v[0]) * v[1], siluf_(v[2]) * v[3]); }
    __device__ __forceinline__ void operator()(const f32x4 (&acc)[2][2][4][2], int brow, int bcol, int wr, int wc, int fr, int fq) const {
        for_each_frag(acc, brow, bcol, wr, wc, fr, fq, [&](int row, int col, f32x4 v) {
            *(unsigned*)(ACT + (size_t)row * DFF + (col >> 1)) = cvt_pk_bf16(siluf_(v[0]) * v[1], siluf_(v[2]) * v[3]); });
    }
};
struct EpiPleGate {
    const bf16_t* E; bf16_t* F;
    __device__ __forceinline__ void apply(int row, int col, f32x4 v) const {
        const u32x2 w = *(const u32x2*)(E + (size_t)row * DM + col);
        f32x4 o; o[0] = sigmoidf_(v[0]) * bflo(w.x); o[1] = sigmoidf_(v[1]) * bfhi(w.x); o[2] = sigmoidf_(v[2]) * bflo(w.y); o[3] = sigmoidf_(v[3]) * bfhi(w.y);
        st_bf16x4(F + (size_t)row * DM + col, o); }
    __device__ __forceinline__ void operator()(const f32x4 (&acc)[2][2][4][2], int brow, int bcol, int wr, int wc, int fr, int fq) const {
        for_each_frag(acc, brow, bcol, wr, wc, fr, fq, [&](int row, int col, f32x4 v) { apply(row, col, v); });
    }
};

template <class Epi>
__device__ __forceinline__ void gemm_skinny(const bf16_t* A  , int lda, const bf16_t* Bt, int K, int N, const Epi& E) {
    int tid = threadIdx.x; asm volatile("" : "+v"(tid));
    const int wid = __builtin_amdgcn_readfirstlane(tid >> 6), lane = tid & 63, c = lane & 15, G = lane >> 4;
    LAS f32x4* red = (LAS f32x4*)smem;
    const int nsteps = K / 32;
#pragma unroll 1
    for (int ct = blockIdx.x; ct < N / 16; ct += gridDim.x) {
        f32x4 acc0 = {0.f, 0.f, 0.f, 0.f}, acc1 = {0.f, 0.f, 0.f, 0.f};
        const bf16_t* bp = Bt + (size_t)(ct * 16 + c) * K + G * 8;
        const bf16_t* a0 = A + (size_t)c * lda + G * 8; const bf16_t* a1 = A + (size_t)(16 + c) * lda + G * 8;
#pragma unroll 4
        for (int kk = wid; kk < nsteps; kk += 8) {
            const bf16x8 bf = *(const bf16x8*)(bp + kk * 32), x0 = *(const bf16x8*)(a0 + kk * 32), x1 = *(const bf16x8*)(a1 + kk * 32);
            acc0 = mfma16(bf, x0, acc0); acc1 = mfma16(bf, x1, acc1);
        }
        __syncthreads();
        red[(wid * 2 + 0) * 64 + lane] = acc0; red[(wid * 2 + 1) * 64 + lane] = acc1;
        __syncthreads();
        if (tid < 128) {
            const int rt = tid >> 6;
            f32x4 v = red[rt * 64 + lane];
#pragma unroll
            for (int w = 1; w < 8; ++w) v = v + red[(w * 2 + rt) * 64 + lane];
            E.apply(MP + rt * 16 + c, ct * 16 + 4 * G, v);
        }
    }
    __syncthreads();
}

template <class Epi>
__device__ __forceinline__ void gemm_skinny2(const bf16_t* A  , int lda, const bf16_t* Bt, int K, int N, const Epi& E) {
    int tid = threadIdx.x; asm volatile("" : "+v"(tid));
    const int wid = __builtin_amdgcn_readfirstlane(tid >> 6), lane = tid & 63, c = lane & 15, G = lane >> 4;
    LAS f32x4* red = (LAS f32x4*)smem;
    const int hsteps = K / 64;
#pragma unroll 1
    for (int ct = blockIdx.x; ct < N / 16; ct += gridDim.x) {
        f32x4 acc[4] = {{0.f, 0.f, 0.f, 0.f}, {0.f, 0.f, 0.f, 0.f}, {0.f, 0.f, 0.f, 0.f}, {0.f, 0.f, 0.f, 0.f}};
        const bf16_t* bp = Bt + (size_t)(ct * 16 + c) * K + G * 8;
        const bf16_t* a0 = A + (size_t)c * lda + G * 8; const bf16_t* a1 = A + (size_t)(16 + c) * lda + G * 8;
#pragma unroll
        for (int h = 0; h < 2; ++h) {
#pragma unroll 2
            for (int kk = h * hsteps + wid; kk < (h + 1) * hsteps; kk += 8) {
                const bf16x8 bf = *(const bf16x8*)(bp + kk * 32), x0 = *(const bf16x8*)(a0 + kk * 32), x1 = *(const bf16x8*)(a1 + kk * 32);
                acc[h * 2] = mfma16(bf, x0, acc[h * 2]); acc[h * 2 + 1] = mfma16(bf, x1, acc[h * 2 + 1]);
            }
        }
        __syncthreads();
#pragma unroll
        for (int q = 0; q < 4; ++q) red[(wid * 4 + q) * 64 + lane] = acc[q];
        __syncthreads();
        if (tid < 128) {
            const int rt = tid >> 6;
            f32x4 v1 = red[rt * 64 + lane], v2 = red[(2 + rt) * 64 + lane];
#pragma unroll
            for (int w = 1; w < 8; ++w) { v1 = v1 + red[(w * 4 + rt) * 64 + lane]; v2 = v2 + red[(w * 4 + 2 + rt) * 64 + lane]; }
            E.apply2(MP + rt * 16 + c, ct * 16 + 4 * G, v1, v2);
        }
    }
    __syncthreads();
}

template <class Map>
__device__ __forceinline__ void transpose_tile(const float* W, int K, int N, bf16_t* Wt, int ldk, int kt, int ntile, Map map) {
    LAS float* tile = (LAS float*)smem;
    const int t = threadIdx.x;
    __syncthreads();
#pragma unroll
    for (int i = 0; i < 2; ++i) {
        const int k = (t >> 4) + 32 * i, n = (t & 15) * 4, gn = ntile * 64 + n;
        f32x4 v = (f32x4){0.f, 0.f, 0.f, 0.f};
        if (gn < N) v = *(const f32x4*)(W + (size_t)(kt * 64 + k) * N + gn);
        tile[k * 65 + n] = v[0]; tile[k * 65 + n + 1] = v[1]; tile[k * 65 + n + 2] = v[2]; tile[k * 65 + n + 3] = v[3];
    }
    __syncthreads();
    const int n = t >> 3, kc = (t & 7) * 8, gn = ntile * 64 + n;
    if (gn < N) {
        u32x4 w;
        w.x = cvt_pk_bf16(tile[(kc + 0) * 65 + n], tile[(kc + 1) * 65 + n]); w.y = cvt_pk_bf16(tile[(kc + 2) * 65 + n], tile[(kc + 3) * 65 + n]);
        w.z = cvt_pk_bf16(tile[(kc + 4) * 65 + n], tile[(kc + 5) * 65 + n]); w.w = cvt_pk_bf16(tile[(kc + 6) * 65 + n], tile[(kc + 7) * 65 + n]);
        *(u32x4*)(Wt + (size_t)map(gn) * ldk + kt * 64 + kc) = w;
    }
}
template <class Map>
__device__ __forceinline__ void transpose_all(const float* W, int K, int N, bf16_t* Wt, int ldk, Map map, int& base) {
    const int nkt = K / 64, nnt = (N + 63) / 64, ntl = nkt * nnt;
    for (int it = blockIdx.x; it < base + ntl; it += gridDim.x) {
        if (it < base) continue;
        const int l = it - base;
        transpose_tile(W, K, N, Wt, ldk, l / nnt, l % nnt, map);
    }
    base += ntl;
}
template <class Map>
__device__ __forceinline__ void transpose_all_sub(const float* W, int K, int N, bf16_t* Wt, int ldk, Map map, int& base) {
    const int nkt = K / 64, nnt = (N + 63) / 64, ntl = nkt * nnt, nb = gridDim.x - 32, me = blockIdx.x - 32;
    int first = base - (base % nb) + me; if (first < base) first += nb;
    for (int it = first; it < base + ntl; it += nb) { const int l = it - base; transpose_tile(W, K, N, Wt, ldk, l / nnt, l % nnt, map); }
    base += ntl;
}
__device__ __forceinline__ int map_win(int n) {
    if (n < 1280) return n;
    if (n < 1304) return 4352 + (n - 1280);
    if (n < 2328) return 1280 + (n - 1304);
    return 2304 + (n - 2328);
}

__device__ __forceinline__ float row_rstd(const f32x4 (&v)[4]) {
    float s = 0.f;
#pragma unroll
    for (int k = 0; k < 4; ++k) s += v[k][0] * v[k][0] + v[k][1] * v[k][1] + v[k][2] * v[k][2] + v[k][3] * v[k][3];
    s = wave_sum(s);
    return rsqrtf(s * (1.0f / DM) + EPS);
}
__device__ __forceinline__ const float* xrow_ptr(const Params& p, int row) {
    return row < MP ? p.x_prompt + (size_t)row * DM : p.x_sample + (size_t)(row - MP) * DM;
}

__device__ __forceinline__ void phase_prologue(const Params& p) {
    const int wid = threadIdx.x >> 6, lane = threadIdx.x & 63;
    const int gw = blockIdx.x * 8 + wid, nw = gridDim.x * 8;
    auto do_transposes = [&]() {
    int base = 0;
    transpose_all(p.w_in, DM, IND, p.WinT, DM, [](int n) { return map_win(n); }, base);
    for (int kv = 0; kv < 2; ++kv) for (int j = 0; j < 2; ++j)
        transpose_all((kv ? p.w1_v : p.w1_k) + (size_t)j * 1024 * 128, 1024, 128, p.W1T + ((size_t)kv * 256 + j * 128) * 1024, 1024, [](int n) { return n; }, base);
    };
    do_transposes();
    __syncthreads();
    for (int i = blockIdx.x * 512 + threadIdx.x; i < (INP - IND) * DM / 8; i += gridDim.x * 512) ((u32x4*)(p.WinT + (size_t)IND * DM))[i] = (u32x4){0u, 0u, 0u, 0u};
    for (int row = gw; row < MALL; row += nw) {
        u32x2* hd = (u32x2*)(p.H + (size_t)row * DM);
        if (row < MP + NS) {
            const float* xr = xrow_ptr(p, row);
            f32x4 v[4];
#pragma unroll
            for (int k = 0; k < 4; ++k) v[k] = *(const f32x4*)(xr + lane * 4 + k * 256);
            const float r = row_rstd(v);
#pragma unroll
            for (int k = 0; k < 4; ++k) { const f32x4 g = *(const f32x4*)(p.ln_mix_pre + lane * 4 + k * 256); const f32x4 o = v[k] * r * g; u32x2 w; w.x = cvt_pk_bf16(o[0], o[1]); w.y = cvt_pk_bf16(o[2], o[3]); hd[lane + k * 64] = w; }
            const float* pr = row < MP ? p.p_prompt + (size_t)row * PLE : p.p_sample + (size_t)(row - MP) * PLE;
            const f32x4 pv = *(const f32x4*)(pr + lane * 4);
            u32x2 w; w.x = cvt_pk_bf16(pv[0], pv[1]); w.y = cvt_pk_bf16(pv[2], pv[3]);
            ((u32x2*)(p.Pb + (size_t)row * PLE))[lane] = w;
        } else {
#pragma unroll
            for (int k = 0; k < 4; ++k) hd[lane + k * 64] = (u32x2){0u, 0u};
            ((u32x2*)(p.Pb + (size_t)row * PLE))[lane] = (u32x2){0u, 0u};
        }
    }
    for (int i = blockIdx.x * 512 + threadIdx.x; i < 4 * 128 * 128; i += gridDim.x * 512) { const int t = (i >> 7) & 127, s = i & 127; p.GWb[i] = f2bf(s <= t ? p.gm_ws[i] : 0.f); }
    for (int i = blockIdx.x * 512 + threadIdx.x; i < 2 * 64 * 128; i += gridDim.x * 512) { const int kv = i >> 13, d = (i >> 7) & 63, h = i & 127; p.W2T[i] = f2bf((kv ? p.w2_v : p.w2_k)[h * 64 + d]); }
    if (gw < 4) {
        const int kv = gw >> 1, h = (gw & 1) * 64 + lane;
        const float* pe = kv ? p.pe_v : p.pe_k; const float* w1 = kv ? p.w1_v : p.w1_k;
        float s = 0.f;
        for (int k = 0; k < 2048; ++k) s += pe[k] * w1[(size_t)k * 128 + h];
        p.PEB[kv * 128 + h] = s;
    }
    for (int i = blockIdx.x * 512 + threadIdx.x; i < NS * (WIN - 1) * 64; i += gridDim.x * 512) {
        const int b = i / ((WIN - 1) * 64), r = i % ((WIN - 1) * 64);
        ((f32x4*)(p.out + O_WINS + (size_t)b * WIN * 256))[r] = ((const f32x4*)(p.state_win + (size_t)b * WIN * 256 + 256))[r];
    }
}

__device__ __forceinline__ void phase_deferred_transposes(const Params& p) {
    if (blockIdx.x < 32) return;
    int base = 0;
    transpose_all_sub(p.w_br_nsa, QD, DM, p.WnT, DM, [](int n) { return n; }, base);
    transpose_all_sub(p.w_br_gm, GMD, DM, p.WnT + QD, DM, [](int n) { return n; }, base);
    transpose_all_sub(p.w_out, DM, DM, p.WoT, DM, [](int n) { return n; }, base);
    transpose_all_sub(p.w_gate, DM, DFF, p.WguT, DM, [](int n) { return 2 * n; }, base);
    transpose_all_sub(p.w_up, DM, DFF, p.WguT, DM, [](int n) { return 2 * n + 1; }, base);
    transpose_all_sub(p.w_down, DFF, DM, p.WdT, DFF, [](int n) { return n; }, base);
    transpose_all_sub(p.w_ple_gate, DM, DM, p.WpgT, DM, [](int n) { return n; }, base);
    transpose_all_sub(p.w_ple, PLE, DM, p.WpT, PLE, [](int n) { return n; }, base);
    __syncthreads();
}
__device__ __forceinline__ void phase_gather(const Params& p) {
    int tid = threadIdx.x; asm volatile("" : "+v"(tid));
    const int wid = tid >> 6, lane = tid & 63;
    const int gw = (blockIdx.x >> 1) * 8 + wid, nw = (gridDim.x >> 1) * 8;
    const int cls = blockIdx.x & 1;
#pragma unroll 1
    for (int r8h = gw; r8h < NS * PAST / 16; r8h += nw) {
        const int r8 = r8h * 2 + cls;
        const int r = r8 * 8, b = r >> 14, pos = r & (PAST - 1), l5 = lane & 31, hrow = lane >> 5;
        const float* s = p.cache_cmp + ((size_t)p.page_table[b * NPG + (pos >> 7)] * PAGE + (pos & 127) + hrow) * 256 + l5 * 8;
        f32x4 a[4], cc[4];
#pragma unroll
        for (int k = 0; k < 4; ++k) { a[k] = *(const f32x4*)(s + (size_t)k * 512); cc[k] = *(const f32x4*)(s + (size_t)k * 512 + 4); }
#pragma unroll
        for (int k = 0; k < 4; ++k) {
            u32x4 w; w.x = cvt_pk_bf16(a[k][0], a[k][1]); w.y = cvt_pk_bf16(a[k][2], a[k][3]); w.z = cvt_pk_bf16(cc[k][0], cc[k][1]); w.w = cvt_pk_bf16(cc[k][2], cc[k][3]);
            *(u32x4*)(p.CMPb + ((size_t)MP + r + 2 * k + hrow) * 256 + l5 * 8) = w;
        }
    }
}

__device__ __forceinline__ void phase_cmp_final(const Params& p) {
    const int wid = threadIdx.x >> 6, lane = threadIdx.x & 63;
    {
        const int c = lane & 15, G = lane >> 4;
        const int ngrp_p = NB * 4 * 32, ngrp_s = NS * 4 * 64;
#pragma unroll 1
        for (int it = blockIdx.x * 8 + wid; it < ngrp_p + ngrp_s; it += gridDim.x * 8) {
            const bool smp = it >= ngrp_p; const int l = smp ? it - ngrp_p : it;
            const int nch = smp ? 64 : 32, nc = smp ? NCS : NCP;
            const int ch = l % nch, z = (l / nch) & 3, seq = l / (nch * 4), kv = z >> 1, g = z & 1, n0 = ch * 16;
            const size_t r0 = smp ? (size_t)2048 + (size_t)seq * 1024 : (size_t)seq * 512;
            const int nr = n0 + c < nc ? n0 + c : nc - 1;
            const bf16_t* p0 = (const bf16_t*)p.PART + ((r0 + nr) * 4 + z) * 256;
            const bf16_t* p1 = (const bf16_t*)p.PART + ((r0 + nr + 1) * 4 + z) * 256 + 128;
            const float* pb = p.PEB + kv * 128;
            f32x4 acc[4] = {{0.f, 0.f, 0.f, 0.f}, {0.f, 0.f, 0.f, 0.f}, {0.f, 0.f, 0.f, 0.f}, {0.f, 0.f, 0.f, 0.f}};
#pragma unroll
            for (int ks = 0; ks < 4; ++ks) {
                const int h0 = 32 * ks + 8 * G;
                const u32x4 wa = *(const u32x4*)(p0 + h0), wb = *(const u32x4*)(p1 + h0);
                const f32x4 a0 = {bflo(wa.x), bfhi(wa.x), bflo(wa.y), bfhi(wa.y)}, a1 = {bflo(wa.z), bfhi(wa.z), bflo(wa.w), bfhi(wa.w)};
                const f32x4 b0 = {bflo(wb.x), bfhi(wb.x), bflo(wb.y), bfhi(wb.y)}, b1 = {bflo(wb.z), bfhi(wb.z), bflo(wb.w), bfhi(wb.w)};
                const f32x4 e0 = *(const f32x4*)(pb + h0), e1 = *(const f32x4*)(pb + h0 + 4);
                f32x4 x0 = a0 + b0 + e0, x1 = a1 + b1 + e1;
#pragma unroll
                for (int i = 0; i < 4; ++i) { x0[i] = siluf_(x0[i]); x1[i] = siluf_(x1[i]); }
                const bf16x8 A = pack_p(x0, x1);
#pragma unroll
                for (int nt = 0; nt < 4; ++nt) {
                    const bf16x8 B = *(const bf16x8*)(p.W2T + ((size_t)kv * 64 + nt * 16 + c) * 128 + h0);
                    acc[nt] = mfma16(A, B, acc[nt]);
                }
            }
#pragma unroll
            for (int nt = 0; nt < 4; ++nt) {
                const int d = nt * 16 + c;
#pragma unroll
                for (int i = 0; i < 4; ++i) {
                    const int n = n0 + 4 * G + i;
                    if (n < nc) {
                        if (smp) ((kv ? p.VCS : p.KCS) + (((size_t)seq * NG + g) * 1024 + n) * 64)[d] = acc[nt][i];
                        else if (kv == 0) p.KCb[((size_t)seq * NG + g) * 512 * 64 + kfrag_off(n, d)] = f2bf(acc[nt][i]);
                    }
                }
                if (!smp && kv == 1) {
                    f32x4 v = acc[nt];
#pragma unroll
                    for (int i = 0; i < 4; ++i) if (n0 + 4 * G + i >= nc) v[i] = 0.f;
                    st_bf16x4(p.VCT + ((size_t)seq * NG + g) * 512 * 64 + vfrag_off(n0 + 4 * G, d), v);
                }
            }
        }
    }
}

template <bool SAMPLE>
__device__ __forceinline__ void kv_row_ptr(const Params& p, int branch  , int b, int pos, int kv, int g, const bf16_t*& pb, const float*& pf) {
    const int off = kv * 128 + g * 64;
    if (!SAMPLE) { pf = nullptr; pb = (branch == 1 ? p.SLCb : p.WINb) + ((size_t)b * SEQ + pos) * 256 + off; }
    else if (pos >= PAST) { pf = nullptr; pb = (branch == 1 ? p.SLCb : p.WINb) + ((size_t)MP + b) * 256 + off; }
    else if (branch == 1) { pb = nullptr; pf = p.cache_slc + ((size_t)p.page_table[b * NPG + (pos >> 7)] * PAGE + (pos & 127)) * 256 + off; }
    else { pb = nullptr; pf = p.state_win + ((size_t)b * WIN + (pos - (PAST - WIN))) * 256 + off; }
}
__device__ __forceinline__ void dot4x64(const bf16_t* pb, const float* pf, const LAS float* qs_, float (&s)[4]) {
    s[0] = s[1] = s[2] = s[3] = 0.f;
    const LAS float* qs = qs_; asm volatile("" : "+v"(qs));
    if (pf) {
#pragma unroll 4
        for (int c = 0; c < 16; ++c) {
            const f32x4 kx = *(const f32x4*)(pf + c * 4);
#pragma unroll
            for (int h = 0; h < 4; ++h) { const f32x4 q = *(const LAS f32x4*)(qs + h * 64 + c * 4); s[h] += q[0] * kx[0] + q[1] * kx[1] + q[2] * kx[2] + q[3] * kx[3]; }
        }
    } else {
#pragma unroll 2
        for (int c = 0; c < 8; ++c) {
            const u32x4 w = *(const u32x4*)(pb + c * 8);
            const float k0 = bflo(w.x), k1 = bfhi(w.x), k2 = bflo(w.y), k3 = bfhi(w.y), k4 = bflo(w.z), k5 = bfhi(w.z), k6 = bflo(w.w), k7 = bfhi(w.w);
#pragma unroll
            for (int h = 0; h < 4; ++h) {
                const f32x4 qa = *(const LAS f32x4*)(qs + h * 64 + c * 8), qb = *(const LAS f32x4*)(qs + h * 64 + c * 8 + 4);
                s[h] += qa[0] * k0 + qa[1] * k1 + qa[2] * k2 + qa[3] * k3 + qb[0] * k4 + qb[1] * k5 + qb[2] * k6 + qb[3] * k7;
            }
        }
    }
}
template <bool SAMPLE>
__device__ __forceinline__ void attn_chunk(const Params& p, int branch, int b, int g, int t, int pos0, int lo, int hi,
                                           float (&m)[4], float (&l)[4], float (&o)[4], const LAS float* qs, LAS float* pbk, const LAS float* relb, int lane) {
    const int pos = pos0 + lane;
    const bool valid = pos >= lo && pos <= hi;
    float s[4] = {-1e30f, -1e30f, -1e30f, -1e30f};
    if (valid) {
        const bf16_t* pb; const float* pf; kv_row_ptr<SAMPLE>(p, branch, b, pos, 0, g, pb, pf);
        dot4x64(pb, pf, qs, s);
        const int bk = t5_bucket(t - pos);
#pragma unroll
        for (int h = 0; h < 4; ++h) s[h] += relb[bk * 8 + g * 4 + h];
    }
#pragma unroll
    for (int h = 0; h < 4; ++h) {
        const float mx = wave_max(s[h]);
        const float mn = fmaxf(m[h], mx);
        const float pr = valid ? ex2(s[h] - mn) : 0.f;
        const float sm = wave_sum(pr);
        const float al = ex2(m[h] - mn);
        l[h] = l[h] * al + sm; o[h] *= al; m[h] = mn;
        pbk[h * 64 + lane] = pr;
    }
    __builtin_amdgcn_wave_barrier();
    const int k0 = (lo > pos0 ? lo : pos0) - pos0, k1 = (hi < pos0 + 63 ? hi : pos0 + 63) - pos0;
    if (SAMPLE) {
        const int kend = (PAST - 1 - pos0) < k1 ? (PAST - 1 - pos0) : k1;
        if (kend >= k0) {
            const bf16_t* pb; const float* pf; kv_row_ptr<SAMPLE>(p, branch, b, pos0 + k0, 1, g, pb, pf);
            pf += lane;
#pragma unroll 8
            for (int k = k0; k <= kend; ++k) {
                const float v = pf[(size_t)(k - k0) * 256];
#pragma unroll
                for (int h = 0; h < 4; ++h) o[h] += pbk[h * 64 + k] * v;
            }
        }
        if (k1 > kend) {
            const bf16_t* pb; const float* pf; kv_row_ptr<SAMPLE>(p, branch, b, pos0 + k1, 1, g, pb, pf);
            const float v = bf2f(pb[lane]);
#pragma unroll
            for (int h = 0; h < 4; ++h) o[h] += pbk[h * 64 + k1] * v;
        }
    } else {
#pragma unroll 1
    for (int k = k0; k <= k1; ++k) {
        const bf16_t* pb; const float* pf; kv_row_ptr<SAMPLE>(p, branch, b, pos0 + k, 1, g, pb, pf);
        const float v = pf ? pf[lane] : bf2f(pb[lane]);
#pragma unroll
        for (int h = 0; h < 4; ++h) o[h] += pbk[h * 64 + k] * v;
    }
    }
    __builtin_amdgcn_wave_barrier();
}

constexpr int S_QS = 0, S_SC = 1024, S_PHS = S_SC + 4 * 1024 * 4, S_PBK = S_PHS + 1088 * 4, S_PART = S_PBK + 8 * 1024, S_RED = S_PART + 2 * 8 * 272 * 4, S_OCP = S_RED + 512,
              S_SEL = S_OCP + 2048, S_RELB = S_SEL + 64, ATTS_LDS = S_RELB + 1024;
__device__ __forceinline__ void attn_sample_item(const Params& p, int b, int g) {
    const int tid = threadIdx.x, wid = tid >> 6, lane = tid & 63;
    constexpr int t = PAST, NC = NCS, NSEL = 257, NJR = 5, qblk = PAST >> 6;
    const int row = MP + b;
    LAS unsigned char* L = (LAS unsigned char*)smem;
    LAS float* qs = (LAS float*)(L + S_QS); LAS float* sc = (LAS float*)(L + S_SC); LAS float* phs = (LAS float*)(L + S_PHS); LAS float* pbk = (LAS float*)(L + S_PBK) + wid * 256;
    LAS float* part = (LAS float*)(L + S_PART); LAS float* red = (LAS float*)(L + S_RED); LAS float* ocp = (LAS float*)(L + S_OCP); LAS int* sel = (LAS int*)(L + S_SEL);
    LAS float* relb = (LAS float*)(L + S_RELB);
    __syncthreads();
    if (tid < 256) { relb[tid] = p.rel_bias[tid] * LOG2E; qs[tid] = bf2f(p.Qb[(size_t)row * QD + g * 256 + tid]); }
    __syncthreads();
    const float* kc = p.KCS + ((size_t)b * NG + g) * 1024 * 64;
    const float* vc = p.VCS + ((size_t)b * NG + g) * 1024 * 64;
    {
        float mx[4] = {-1e30f, -1e30f, -1e30f, -1e30f};
#pragma unroll 1
        for (int r = wid; r < 16; r += 8) {
            const int n = r * 64 + lane;
            float s[4] = {-1e30f, -1e30f, -1e30f, -1e30f};
            if (n < NC) {
                dot4x64(nullptr, kc + (size_t)n * 64, qs, s);
                const int bk = t5_bucket(t - (16 * n + 31));
#pragma unroll
                for (int h = 0; h < 4; ++h) s[h] += relb[bk * 8 + g * 4 + h];
            }
#pragma unroll
            for (int h = 0; h < 4; ++h) { sc[h * 1024 + n] = s[h]; mx[h] = fmaxf(mx[h], s[h]); }
        }
#pragma unroll
        for (int h = 0; h < 4; ++h) { const float m = wave_max(mx[h]); if (lane == 0) red[wid * 4 + h] = m; }
    }
    __syncthreads();
    float gmx[4], inv[4];
#pragma unroll
    for (int h = 0; h < 4; ++h) { float m = red[h]; for (int w = 1; w < 8; ++w) m = fmaxf(m, red[w * 4 + h]); gmx[h] = m; }
    {
        float sum[4] = {0.f, 0.f, 0.f, 0.f};
#pragma unroll
        for (int k = 0; k < 2; ++k) { const int n = tid + 512 * k;
#pragma unroll
            for (int h = 0; h < 4; ++h) { const float e = n < NC ? ex2(sc[h * 1024 + n] - gmx[h]) : 0.f; sc[h * 1024 + n] = e; sum[h] += e; } }
#pragma unroll
        for (int h = 0; h < 4; ++h) { const float s = wave_sum(sum[h]); if (lane == 0) red[32 + wid * 4 + h] = s; }
    }
    __syncthreads();
#pragma unroll
    for (int h = 0; h < 4; ++h) { float s = 0.f; for (int w = 0; w < 8; ++w) s += red[32 + w * 4 + h]; inv[h] = s > 0.f ? 1.0f / s : 0.f; }
    for (int n = tid; n < 1088; n += 512) phs[n] = n < NC ? (sc[n] * inv[0] + sc[1024 + n] * inv[1]) + (sc[2048 + n] * inv[2] + sc[3072 + n] * inv[3]) : 0.f;
    {
        float a[4] = {0.f, 0.f, 0.f, 0.f};
#pragma unroll 8
        for (int n = wid; n < NC; n += 8) {
            const float v = vc[(size_t)n * 64 + lane];
#pragma unroll
            for (int h = 0; h < 4; ++h) a[h] += sc[h * 1024 + n] * v;
        }
#pragma unroll
        for (int h = 0; h < 4; ++h) part[(wid * 4 + h) * 68 + lane] = a[h] * inv[h];
    }
    __syncthreads();
    if (tid < 256) { float a = 0.f; for (int w = 0; w < 8; ++w) a += part[(w * 4 + (tid >> 6)) * 68 + (tid & 63)]; ocp[tid] = a; }
    __syncthreads();
    if (wid == 0) {
        unsigned long long key[NJR];
#pragma unroll
        for (int jr = 0; jr < NJR; ++jr) {
            const int j = jr * 64 + lane;
            key[jr] = 0ull;
            if (j >= 1 && j <= qblk - 2 && j < NSEL) {
                float im = 0.f;
#pragma unroll
                for (int n = 4 * j - 1; n <= 4 * j + 3; ++n) im += (n < NC) ? phs[n] : 0.f;
                key[jr] = ((unsigned long long)__float_as_uint(im) << 32) | (unsigned)(0xFFFF - j) | 0x10000ull;
            }
        }
        if (lane == 0) { sel[0] = 0; sel[1] = qblk - 1; sel[2] = qblk; }
#pragma unroll 1
        for (int it = 0; it < 13; ++it) {
            unsigned long long best = 0ull;
#pragma unroll
            for (int jr = 0; jr < NJR; ++jr) best = key[jr] > best ? key[jr] : best;
#pragma unroll
            for (int o = 32; o > 0; o >>= 1) { const unsigned long long ot = __shfl_xor(best, o); best = ot > best ? ot : best; }
            const int j = 0xFFFF - (int)(best & 0xFFFFull);
#pragma unroll
            for (int jr = 0; jr < NJR; ++jr) if (key[jr] == best) key[jr] = 0ull;
            if (lane == 0) sel[3 + it] = j;
        }
    }
    __syncthreads();
    {
        float ms[4] = {-1e30f, -1e30f, -1e30f, -1e30f}, ls[4] = {0.f, 0.f, 0.f, 0.f}, os[4] = {0.f, 0.f, 0.f, 0.f};
#pragma unroll 1
        for (int i = wid; i < 16; i += 8) attn_chunk<true>(p, 1, b, g, t, sel[i] * 64, 0, t, ms, ls, os, qs, pbk, relb, lane);
        float mw[4] = {-1e30f, -1e30f, -1e30f, -1e30f}, lw[4] = {0.f, 0.f, 0.f, 0.f}, ow[4] = {0.f, 0.f, 0.f, 0.f};
#pragma unroll 1
        for (int c = wid; c < 9; c += 8) attn_chunk<true>(p, 2, b, g, t, t - 63 - 64 * c, t - WIN, t, mw, lw, ow, qs, pbk, relb, lane);
#pragma unroll
        for (int h = 0; h < 4; ++h) {
            LAS float* ps = part + (wid * 4 + h) * 68; LAS float* pw = part + 8 * 272 + (wid * 4 + h) * 68;
            ps[lane] = os[h]; pw[lane] = ow[h];
            if (lane == 0) { ps[64] = ms[h]; ps[65] = ls[h]; pw[64] = mw[h]; pw[65] = lw[h]; }
        }
    }
    __syncthreads();
    if (tid < 256) {
        const int h = tid >> 6, d = tid & 63;
        float res[2];
#pragma unroll
        for (int br = 0; br < 2; ++br) {
            const LAS float* pp = part + br * 8 * 272 + h * 68;
            float m = -1e30f;
            for (int w = 0; w < 8; ++w) m = fmaxf(m, pp[w * 272 + 64]);
            float l = 0.f, o = 0.f;
            for (int w = 0; w < 8; ++w) { const float sc_ = ex2(pp[w * 272 + 64] - m); l += pp[w * 272 + 65] * sc_; o += pp[w * 272 + d] * sc_; }
            res[br] = o / l;
        }
        const float* gt = p.GATE + (size_t)row * 32 + (g * 4 + h) * 3;
        const float v = gt[0] * ocp[tid] + gt[1] * res[0] + gt[2] * res[1];
        p.OCAT[(size_t)row * DM + (g * 4 + h) * 64 + d] = f2bf(v);
    }
    __syncthreads();
}

constexpr int A_OST = 0, OST_LD = 68, A_LST = A_OST + 256 * OST_LD * 4, A_M0 = A_LST + 1024, A_MB = A_M0 + 1024, MB_LD = 132, A_MKN = A_MB + 64 * MB_LD,
              A_LIST = A_MKN + 256, A_CNT = A_LIST + 132 * 64, A_PK = A_CNT + 544, A_KN = A_PK + 400 * 4, A_T2 = A_KN + 512, A_NP = A_T2 + 132 * 8 * 4, A_QT = A_NP + 16, ATT2_LDS = A_QT + 64 * 512;
static_assert(ATT2_LDS <= GEMM_LDS && ATTS_LDS <= GEMM_LDS, "attention LDS");

__device__ __forceinline__ void qk64(const bf16_t* kb, int c, int G, const bf16x8 (&qB)[2], f32x4 (&s)[4]) {
#pragma unroll
    for (int kt = 0; kt < 4; ++kt) {
        const bf16_t* r = kb + (size_t)(16 * kt + c) * 256 + G * 8;
        const bf16x8 a0 = *(const bf16x8*)r, a1 = *(const bf16x8*)(r + 32);
        s[kt] = mfma16(a0, qB[0], (f32x4){0.f, 0.f, 0.f, 0.f}); s[kt] = mfma16(a1, qB[1], s[kt]);
    }
}
__device__ __forceinline__ void pv64(const bf16_t* vf, int key0, int lane, const f32x4 (&pr)[4], f32x4 (&o)[4]) {
#pragma unroll
    for (int ks = 0; ks < 2; ++ks) {
        const bf16x8 pB = pack_p(pr[2 * ks], pr[2 * ks + 1]);
#pragma unroll
        for (int dt = 0; dt < 4; ++dt) {
            const bf16x8 vA = *(const bf16x8*)(vf + ((size_t)(((key0 >> 5) + ks) * 4 + dt) * 64 + lane) * 8);
            o[dt] = mfma16(vA, pB, o[dt]);
        }
    }
}
__device__ __forceinline__ int qt_off(int qi, int hh, int k) { return (qi * 4 + hh) * 128 + ((k ^ (((qi & 3) << 1) | (hh >> 1))) << 4); }
__device__ __forceinline__ float grp_max(float v) {
    auto r = __builtin_amdgcn_permlane16_swap(__float_as_uint(v), __float_as_uint(v), false, false); v = fmaxf(__uint_as_float(r[0]), __uint_as_float(r[1]));
    r = __builtin_amdgcn_permlane32_swap(__float_as_uint(v), __float_as_uint(v), false, false); return fmaxf(__uint_as_float(r[0]), __uint_as_float(r[1]));
}
__device__ __forceinline__ float grp_sum(float v) {
    auto r = __builtin_amdgcn_permlane16_swap(__float_as_uint(v), __float_as_uint(v), false, false); v = __uint_as_float(r[0]) + __uint_as_float(r[1]);
    r = __builtin_amdgcn_permlane32_swap(__float_as_uint(v), __float_as_uint(v), false, false); return __uint_as_float(r[0]) + __uint_as_float(r[1]);
}
__device__ __forceinline__ int grp_min_i(int v) {
    auto r = __builtin_amdgcn_permlane16_swap((unsigned)v, (unsigned)v, false, false); v = (int)r[0] < (int)r[1] ? (int)r[0] : (int)r[1];
    r = __builtin_amdgcn_permlane32_swap((unsigned)v, (unsigned)v, false, false); return (int)r[0] < (int)r[1] ? (int)r[0] : (int)r[1];
}
__device__ __forceinline__ float dpp_x1(float v) { return __uint_as_float(__builtin_amdgcn_mov_dpp(__float_as_uint(v), 0xB1, 0xF, 0xF, true)); }
__device__ __forceinline__ float dpp_x2(float v) { return __uint_as_float(__builtin_amdgcn_mov_dpp(__float_as_uint(v), 0x4E, 0xF, 0xF, true)); }
__device__ __forceinline__ int dpp_x1i(int v) { return (int)__builtin_amdgcn_mov_dpp((unsigned)v, 0xB1, 0xF, 0xF, true); }
__device__ __forceinline__ int dpp_x2i(int v) { return (int)__builtin_amdgcn_mov_dpp((unsigned)v, 0x4E, 0xF, 0xF, true); }
__device__ __forceinline__ unsigned row_or_q(unsigned u) {
    u |= __builtin_amdgcn_mov_dpp(u, 0x124, 0xF, 0xF, true); u |= __builtin_amdgcn_mov_dpp(u, 0x128, 0xF, 0xF, true); return u;
}

__device__ __forceinline__ void attn_cmp(const Params& p, int b, int g, int t0, int lane_, LAS unsigned char* L, unsigned (&msk)[4]) {
    f32x4 oacc[4];
    int lane = lane_; asm volatile("" : "+v"(lane));
    const int c = lane & 15, G = lane >> 4, qs = c >> 2, hh = c & 3;
    const int qb = t0 >> 6, tc = t0 + qs;
    const size_t qrow = (size_t)b * SEQ + tc;
    const LAS float* T2 = (const LAS float*)(L + A_T2);
    const float b31 = T2[128 * 8 + g * 4 + hh];
    bf16x8 qB[2];
    qB[0] = *(const bf16x8*)(p.Qb + qrow * QD + (g * 4 + hh) * 64 + G * 8); qB[1] = *(const bf16x8*)(p.Qb + qrow * QD + (g * 4 + hh) * 64 + 32 + G * 8);
    const float* gate = p.GATE + qrow * 32 + (g * 4 + hh) * 3;
    msk[0] = msk[1] = msk[2] = msk[3] = 0u;
    {
        const int ncv_c = tc >= 31 ? ((tc - 31) >> 4) + 1 : 0;
        const int ncv_m = t0 + 3 >= 31 ? ((t0 + 3 - 31) >> 4) + 1 : 0;
        const int NT = (ncv_m + 15) >> 4;
        const int mt_far = t0 >= 399 ? (t0 - 399) / 256 + 1 : 0;
        const bf16_t* kcb = p.KCb + (size_t)(b * NG + g) * 512 * 64;
        f32x4 sc[32];
        float mxf = -1e30f, mxn = -1e30f;
        bf16x8 kbuf[2][4][2];
        auto ldkg = [&](int grp, bf16x8 (&kb)[4][2]) __attribute__((always_inline)) {
#pragma unroll
            for (int q = 0; q < 4; ++q) { const bf16_t* r = kcb + ((size_t)((grp * 4 + q) * 2) * 64 + lane) * 8; kb[q][0] = *(const bf16x8*)r; kb[q][1] = *(const bf16x8*)(r + 512); }
        };
        ldkg(0, kbuf[0]);
#pragma unroll
        for (int grp = 0; grp < 8; ++grp) {
            if (4 * grp < NT) {
                if (4 * (grp + 1) < NT) ldkg(grp + 1, kbuf[(grp + 1) & 1]);
                __builtin_amdgcn_sched_barrier(0);
#pragma unroll
                for (int q = 0; q < 4; ++q) {
                    const int mt = grp * 4 + q;
                    f32x4 s = mfma16(kbuf[grp & 1][q][0], qB[0], (f32x4){0.f, 0.f, 0.f, 0.f}); s = mfma16(kbuf[grp & 1][q][1], qB[1], s);
                    if (mt < mt_far) { mxf = fmaxf(mxf, fmaxf(fmaxf(s[0], s[1]), fmaxf(s[2], s[3]))); }
                    else {
#pragma unroll
                        for (int i = 0; i < 4; ++i) { const int n = 16 * mt + 4 * G + i; int dist = tc - (16 * n + 31); const bool ok = n < ncv_c; dist = dist < 0 ? 0 : (dist > 128 ? 128 : dist);
                            s[i] = ok ? s[i] + T2[dist * 8 + g * 4 + hh] : -1e30f; }
                        mxn = fmaxf(mxn, fmaxf(fmaxf(s[0], s[1]), fmaxf(s[2], s[3])));
                    }
                    sc[mt] = s;
                }
            } else {
#pragma unroll
                for (int q = 0; q < 4; ++q) sc[grp * 4 + q] = (f32x4){0.f, 0.f, 0.f, 0.f};
            }
        }
        const float mx = grp_max(fmaxf(mxf + b31, mxn));
        const float shf = mx - b31;
#pragma unroll
        for (int mt = 0; mt < 32; ++mt) if ((mt & ~3) < NT) {
            const float sh = mt < mt_far ? shf : mx;
#pragma unroll
            for (int i = 0; i < 4; ++i) sc[mt][i] = ex2(sc[mt][i] - sh);
        }
        const bf16_t* vct = p.VCT + (size_t)(b * NG + g) * 64 * 512;
        const bf16x8 ones = __builtin_bit_cast(bf16x8, (u32x4){0x3F803F80u, 0x3F803F80u, 0x3F803F80u, 0x3F803F80u});
        f32x4 oc[4] = {{0.f, 0.f, 0.f, 0.f}, {0.f, 0.f, 0.f, 0.f}, {0.f, 0.f, 0.f, 0.f}, {0.f, 0.f, 0.f, 0.f}};
        f32x4 rs = {0.f, 0.f, 0.f, 0.f};
        bf16x8 vbuf[2][2][4];
        auto ldvg = [&](int grp, bf16x8 (&vb)[2][4]) __attribute__((always_inline)) {
#pragma unroll
            for (int q = 0; q < 2; ++q)
#pragma unroll
                for (int dt = 0; dt < 4; ++dt) vb[q][dt] = *(const bf16x8*)(vct + ((size_t)((grp * 2 + q) * 4 + dt) * 64 + lane) * 8);
        };
        ldvg(0, vbuf[0]);
#pragma unroll
        for (int grp = 0; grp < 8; ++grp) if (4 * grp < NT) {
            if (4 * (grp + 1) < NT) ldvg(grp + 1, vbuf[(grp + 1) & 1]);
            __builtin_amdgcn_sched_barrier(0);
#pragma unroll
            for (int q = 0; q < 2; ++q) {
                const int k2 = grp * 2 + q;
                const bf16x8 pB = pack_p(sc[2 * k2], sc[2 * k2 + 1]);
                rs = mfma16(ones, pB, rs);
#pragma unroll
                for (int dt = 0; dt < 4; ++dt) oc[dt] = mfma16(vbuf[grp & 1][q][dt], pB, oc[dt]);
            }
        }
        const float inv = ncv_c > 0 ? 1.0f / rs[0] : 0.f;
        if (qb <= 15) {
            msk[0] = (qb >= 31) ? 0xffffffffu : ((2u << qb) - 1u);
        } else {
            unsigned cand[8];
#pragma unroll
            for (int k = 0; k < 8; ++k) cand[k] = 0u;
            float prevB = 0.f;
#pragma unroll
            for (int mt = 0; mt < 32; ++mt) if (mt < NT) {
                const unsigned x3 = __float_as_uint(sc[mt][3]);
                const auto p16 = __builtin_amdgcn_permlane16_swap(x3, x3, false, false);
                const auto p32 = __builtin_amdgcn_permlane32_swap(p16[1], p16[1], false, false);
                const float r1 = G == 2 ? __uint_as_float(p32[0]) : __uint_as_float(p16[0]);
                float v = ((sc[mt][0] + sc[mt][1]) + (sc[mt][2] + sc[mt][3]) + (G == 0 ? prevB : r1)) * inv;
                prevB = __uint_as_float(p32[1]);
                v += dpp_x1(v); v += dpp_x2(v);
                const int j = 4 * mt + G;
                if ((mt & 3) == hh) cand[mt >> 2] = (j >= 1 && j <= qb - 2) ? ((__float_as_uint(v) & ~127u) | (unsigned)(127 - j)) : 0u;
            }
            auto setbit = [&](int j) { const unsigned bit = 1u << (j & 31); const int w = j >> 5; msk[0] |= w == 0 ? bit : 0u; msk[1] |= w == 1 ? bit : 0u; msk[2] |= w == 2 ? bit : 0u; msk[3] |= w == 3 ? bit : 0u; };
            setbit(0); setbit(qb); setbit(qb - 1);
#pragma unroll 1
            for (int it = 0; it < 13; ++it) {
                unsigned bv = cand[0];
#pragma unroll
                for (int k = 1; k < 8; ++k) bv = bv > cand[k] ? bv : cand[k];
                { unsigned o = __builtin_amdgcn_mov_dpp(bv, 0xB1, 0xF, 0xF, true); bv = o > bv ? o : bv; o = __builtin_amdgcn_mov_dpp(bv, 0x4E, 0xF, 0xF, true); bv = o > bv ? o : bv;
                  auto r = __builtin_amdgcn_permlane16_swap(bv, bv, false, false); bv = r[0] > r[1] ? r[0] : r[1]; r = __builtin_amdgcn_permlane32_swap(bv, bv, false, false); bv = r[0] > r[1] ? r[0] : r[1]; }
#pragma unroll
                for (int k = 0; k < 8; ++k) cand[k] = cand[k] == bv ? 0u : cand[k];
                setbit(127 - (int)(bv & 127u));
            }
        }
        const float g0 = gate[0] * inv;
#pragma unroll
        for (int dt = 0; dt < 4; ++dt) oacc[dt] = oc[dt] * g0;
    }
    bf16_t* orow = p.OCAT + qrow * DM + (g * 4 + hh) * 64 + 4 * G;
#pragma unroll
    for (int dt = 0; dt < 4; ++dt) st_bf16x4(orow + dt * 16, oacc[dt]);
}

struct PackSt { bf16x8 q0, q1; float m; f32x4 l4; f32x4 o[4]; };
__device__ __forceinline__ void attn_selwin_pair(const Params& p, int b, int g, int t0, int lane_, LAS unsigned char* L, const unsigned (&mskA)[4], const unsigned (&mskB)[4]) {
    int lane = lane_; asm volatile("" : "+v"(lane));
    const int c = lane & 15, G = lane >> 4, qs = c >> 2, hh = c & 3;
    const int qb = t0 >> 6;
    const LAS float* T2 = (const LAS float*)(L + A_T2);
    const float b31 = T2[128 * 8 + g * 4 + hh];
    const int tcA = t0 + qs, tcB = t0 + 4 + qs;
    const size_t qrowA = (size_t)b * SEQ + tcA;
    PackSt A, B;
    {
        const bf16_t* qa = p.Qb + qrowA * QD + (g * 4 + hh) * 64 + G * 8;
        A.q0 = *(const bf16x8*)qa; A.q1 = *(const bf16x8*)(qa + 32); B.q0 = *(const bf16x8*)(qa + 4 * QD); B.q1 = *(const bf16x8*)(qa + 4 * QD + 32);
    }
    auto reset = [&](PackSt& S) __attribute__((always_inline)) { S.m = -1e30f; S.l4 = (f32x4){0.f, 0.f, 0.f, 0.f};
#pragma unroll
        for (int dt = 0; dt < 4; ++dt) S.o[dt] = (f32x4){0.f, 0.f, 0.f, 0.f}; };
    const bf16x8 ones = __builtin_bit_cast(bf16x8, (u32x4){0x3F803F80u, 0x3F803F80u, 0x3F803F80u, 0x3F803F80u});
    auto finish = [&](PackSt& S, f32x4 (&s)[4], float cb, bool mine, const bf16x8 (&vf)[2][4]) __attribute__((always_inline)) {
        float cm = fmaxf(fmaxf(fmaxf(s[0][0], s[0][1]), fmaxf(s[0][2], s[0][3])), fmaxf(fmaxf(s[1][0], s[1][1]), fmaxf(s[1][2], s[1][3])));
        cm = fmaxf(cm, fmaxf(fmaxf(fmaxf(s[2][0], s[2][1]), fmaxf(s[2][2], s[2][3])), fmaxf(fmaxf(s[3][0], s[3][1]), fmaxf(s[3][2], s[3][3]))));
        cm = grp_max(mine ? cm + cb : -1e30f);
        const float mn = fmaxf(S.m, cm), al = ex2(S.m - mn);
        const float sh = (mine ? mn : 1e30f) - cb;
#pragma unroll
        for (int kt = 0; kt < 4; ++kt)
#pragma unroll
            for (int i = 0; i < 4; ++i) s[kt][i] = ex2(s[kt][i] - sh);
        S.m = mn;
        f32x4 rs = {0.f, 0.f, 0.f, 0.f};
#pragma unroll
        for (int dt = 0; dt < 4; ++dt) S.o[dt] = S.o[dt] * al;
#pragma unroll
        for (int ks = 0; ks < 2; ++ks) { const bf16x8 pB = pack_p(s[2 * ks], s[2 * ks + 1]);
            rs = mfma16(ones, pB, rs);
#pragma unroll
            for (int dt = 0; dt < 4; ++dt) S.o[dt] = mfma16(vf[ks][dt], pB, S.o[dt]); }
        S.l4[0] = S.l4[0] * al + rs[0];
    };
    auto addout = [&](PackSt& S, size_t qrow, int br) __attribute__((always_inline)) {
        const float gs = p.GATE[qrow * 32 + (g * 4 + hh) * 3 + br] / S.l4[0];
        bf16_t* orow = p.OCAT + qrow * DM + (g * 4 + hh) * 64 + 4 * G;
#pragma unroll
        for (int dt = 0; dt < 4; ++dt) { const u32x2 w = *(const u32x2*)(orow + dt * 16); f32x4 pa; pa[0] = bflo(w.x); pa[1] = bfhi(w.x); pa[2] = bflo(w.y); pa[3] = bfhi(w.y);
            st_bf16x4(orow + dt * 16, pa + S.o[dt] * gs); }
    };
    {
        unsigned umA[4], umB[4], um[4];
#pragma unroll
        for (int w = 0; w < 4; ++w) {
            umA[w] = __builtin_amdgcn_readfirstlane(row_or_q(mskA[w]));
            umB[w] = __builtin_amdgcn_readfirstlane(row_or_q(mskB[w]));
            um[w] = umA[w] | umB[w];
        }
        reset(A); reset(B);
        const bf16_t* klane = p.SLCkF + (size_t)(b * NG + g) * SEQ * 64 + lane * 8;
        const bf16_t* vlane = p.SLCvT + (size_t)(b * NG + g) * SEQ * 64 + lane * 8;
        auto ldfr = [&](int j_, bf16x8 (&kf_)[4][2], bf16x8 (&vf_)[2][4]) __attribute__((always_inline)) {
            const bf16_t* kr = klane + (size_t)j_ * 4096; const bf16_t* vr = vlane + (size_t)j_ * 4096;
#pragma unroll
            for (int kt = 0; kt < 4; ++kt) { kf_[kt][0] = *(const bf16x8*)(kr + (kt * 2) * 512); kf_[kt][1] = *(const bf16x8*)(kr + (kt * 2 + 1) * 512); }
#pragma unroll
            for (int ks = 0; ks < 2; ++ks)
#pragma unroll
                for (int dt = 0; dt < 4; ++dt) vf_[ks][dt] = *(const bf16x8*)(vr + (ks * 4 + dt) * 512);
        };
        auto nextj = [&](int& j_) __attribute__((always_inline)) {
            int w = um[0] ? 0 : um[1] ? 1 : um[2] ? 2 : um[3] ? 3 : -1;
            if (w < 0) return false;
            const unsigned u = w == 0 ? um[0] : w == 1 ? um[1] : w == 2 ? um[2] : um[3];
            const int bpos = __builtin_ctz(u);
            j_ = w * 32 + bpos;
            const unsigned cl = ~(1u << bpos);
            if (w == 0) um[0] &= cl; else if (w == 1) um[1] &= cl; else if (w == 2) um[2] &= cl; else um[3] &= cl;
            return true;
        };
        auto packstep = [&](PackSt& S, const unsigned (&msk)[4], int tc, int j, const bf16x8 (&kf)[4][2], const bf16x8 (&vf)[2][4]) __attribute__((always_inline)) {
            const unsigned mw = (j >> 5) == 0 ? msk[0] : (j >> 5) == 1 ? msk[1] : (j >> 5) == 2 ? msk[2] : msk[3];
            const bool mine = (mw >> (j & 31)) & 1u;
            const bool farb = j <= qb - 3;
            f32x4 s[4];
#pragma unroll
            for (int kt = 0; kt < 4; ++kt) { s[kt] = mfma16(kf[kt][0], S.q0, (f32x4){0.f, 0.f, 0.f, 0.f}); s[kt] = mfma16(kf[kt][1], S.q1, s[kt]); }
            if (!farb) {
#pragma unroll
                for (int kt = 0; kt < 4; ++kt)
#pragma unroll
                    for (int i = 0; i < 4; ++i) { const int dist = tc - (j * 64 + 16 * kt + 4 * G + i); const int dd = dist < 0 ? 0 : (dist > 128 ? 128 : dist);
                        s[kt][i] = dist >= 0 ? s[kt][i] + T2[dd * 8 + g * 4 + hh] : -1e30f; }
            }
            finish(S, s, farb ? b31 : 0.f, mine, vf);
        };
        auto blockstep = [&](int j, const bf16x8 (&kf)[4][2], const bf16x8 (&vf)[2][4]) __attribute__((always_inline)) {
            const int w = j >> 5; const unsigned bit = 1u << (j & 31);
            const unsigned ua = w == 0 ? umA[0] : w == 1 ? umA[1] : w == 2 ? umA[2] : umA[3];
            const unsigned ub = w == 0 ? umB[0] : w == 1 ? umB[1] : w == 2 ? umB[2] : umB[3];
            if (ua & bit) packstep(A, mskA, tcA, j, kf, vf);
            if (ub & bit) packstep(B, mskB, tcB, j, kf, vf);
        };
        auto ldk = [&](int j_, bf16x8 (&kf_)[4][2]) __attribute__((always_inline)) {
            const bf16_t* kr = klane + (size_t)j_ * 4096;
#pragma unroll
            for (int kt = 0; kt < 4; ++kt) { kf_[kt][0] = *(const bf16x8*)(kr + (kt * 2) * 512); kf_[kt][1] = *(const bf16x8*)(kr + (kt * 2 + 1) * 512); }
        };
        auto ldv = [&](int j_, bf16x8 (&vf_)[2][4]) __attribute__((always_inline)) {
            const bf16_t* vr = vlane + (size_t)j_ * 4096;
#pragma unroll
            for (int ks = 0; ks < 2; ++ks)
#pragma unroll
                for (int dt = 0; dt < 4; ++dt) vf_[ks][dt] = *(const bf16x8*)(vr + (ks * 4 + dt) * 512);
        };
        bf16x8 kfA[4][2], kfB[4][2], vf[2][4];
        int j = 0; bool have = nextj(j);
        ldk(j, kfA);
#pragma unroll 1
        while (have) {
            int jn = j; bool haven = nextj(jn);
            ldv(j, vf); ldk(jn, kfB);
            __builtin_amdgcn_sched_barrier(0);
            blockstep(j, kfA, vf);
            if (!haven) break;
            j = jn; have = nextj(jn);
            ldv(j, vf); ldk(jn, kfA);
            __builtin_amdgcn_sched_barrier(0);
            blockstep(j, kfB, vf);
            j = jn;
        }
        addout(A, qrowA, 1); addout(B, qrowA + 4, 1);
    }
    {
        reset(A); reset(B);
        const int loA = t0 - WIN > 0 ? t0 - WIN : 0, hiA = t0 + 3, loB = t0 + 4 - WIN > 0 ? t0 + 4 - WIN : 0, hiB = t0 + 7;
        const bf16_t* klane = p.WINkF + (size_t)(b * NG + g) * SEQ * 64 + lane * 8;
        const bf16_t* vlane = p.WINvT + (size_t)(b * NG + g) * SEQ * 64 + lane * 8;
        auto ldfr = [&](int cb_, bf16x8 (&kf_)[4][2], bf16x8 (&vf_)[2][4]) __attribute__((always_inline)) {
            const bf16_t* kr = klane + (size_t)cb_ * 64; const bf16_t* vr = vlane + (size_t)cb_ * 64;
#pragma unroll
            for (int kt = 0; kt < 4; ++kt) { kf_[kt][0] = *(const bf16x8*)(kr + (kt * 2) * 512); kf_[kt][1] = *(const bf16x8*)(kr + (kt * 2 + 1) * 512); }
#pragma unroll
            for (int ks = 0; ks < 2; ++ks)
#pragma unroll
                for (int dt = 0; dt < 4; ++dt) vf_[ks][dt] = *(const bf16x8*)(vr + (ks * 4 + dt) * 512);
        };
        auto packstep = [&](PackSt& S, int tq0, int tc, int cb, const bf16x8 (&kf)[4][2], const bf16x8 (&vf)[2][4]) __attribute__((always_inline)) {
            const bool far = (cb + 63 <= tq0 - 128) && (cb >= tq0 + 3 - WIN);
            f32x4 s[4];
#pragma unroll
            for (int kt = 0; kt < 4; ++kt) { s[kt] = mfma16(kf[kt][0], S.q0, (f32x4){0.f, 0.f, 0.f, 0.f}); s[kt] = mfma16(kf[kt][1], S.q1, s[kt]); }
            if (!far) {
#pragma unroll
                for (int kt = 0; kt < 4; ++kt)
#pragma unroll
                    for (int i = 0; i < 4; ++i) { const int dist = tc - (cb + 16 * kt + 4 * G + i); const bool ok = dist >= 0 && dist <= WIN; const int dd = dist < 0 ? 0 : (dist > 128 ? 128 : dist);
                        s[kt][i] = ok ? s[kt][i] + T2[dd * 8 + g * 4 + hh] : -1e30f; }
            }
            finish(S, s, far ? b31 : 0.f, true, vf);
        };
        auto chunkstep = [&](int cb, const bf16x8 (&kf)[4][2], const bf16x8 (&vf)[2][4]) __attribute__((always_inline)) {
            if (cb <= hiA) packstep(A, t0, tcA, cb, kf, vf);
            if (cb + 63 >= loB) packstep(B, t0 + 4, tcB, cb, kf, vf);
        };
        auto ldk = [&](int cb_, bf16x8 (&kf_)[4][2]) __attribute__((always_inline)) {
            const bf16_t* kr = klane + (size_t)cb_ * 64;
#pragma unroll
            for (int kt = 0; kt < 4; ++kt) { kf_[kt][0] = *(const bf16x8*)(kr + (kt * 2) * 512); kf_[kt][1] = *(const bf16x8*)(kr + (kt * 2 + 1) * 512); }
        };
        auto ldv = [&](int cb_, bf16x8 (&vf_)[2][4]) __attribute__((always_inline)) {
            const bf16_t* vr = vlane + (size_t)cb_ * 64;
#pragma unroll
            for (int ks = 0; ks < 2; ++ks)
#pragma unroll
                for (int dt = 0; dt < 4; ++dt) vf_[ks][dt] = *(const bf16x8*)(vr + (ks * 4 + dt) * 512);
        };
        bf16x8 kfA[4][2], kfB[4][2], vf[2][4];
        int cb = loA & ~63;
        ldk(cb, kfA);
#pragma unroll 1
        for (;;) {
            ldv(cb, vf); ldk(cb + 64 <= hiB ? cb + 64 : cb, kfB);
            __builtin_amdgcn_sched_barrier(0);
            chunkstep(cb, kfA, vf);
            cb += 64; if (cb > hiB) break;
            ldv(cb, vf); ldk(cb + 64 <= hiB ? cb + 64 : cb, kfA);
            __builtin_amdgcn_sched_barrier(0);
            chunkstep(cb, kfB, vf);
            cb += 64; if (cb > hiB) break;
        }
        addout(A, qrowA, 2); addout(B, qrowA + 4, 2);
    }
}

__device__ __forceinline__ void phase_attn(const Params& p) {
    const int wid = threadIdx.x >> 6, lane = threadIdx.x & 63;
    { PROBE_BEGIN(3)
    if (blockIdx.x < NS * NG) attn_sample_item(p, blockIdx.x >> 1, blockIdx.x & 1);
    PROBE_END(3) }
    LAS unsigned char* L = (LAS unsigned char*)smem;
    for (int i = threadIdx.x; i < 129 * 8; i += 512) ((LAS float*)(L + A_T2))[i] = p.rel_bias[t5_bucket(i >> 3) * 8 + (i & 7)] * LOG2E;
    __syncthreads();
    {
        const int wid2 = __builtin_amdgcn_readfirstlane(threadIdx.x >> 6);
#pragma unroll 1
        for (;;) {
            __syncthreads();
            if (threadIdx.x == 0) ((LAS int*)(L + A_NP))[1] = (int)__hip_atomic_fetch_add(p.bar, 1u, __ATOMIC_RELAXED, __HIP_MEMORY_SCOPE_AGENT);
            __syncthreads();
            const int T = ((const LAS int*)(L + A_NP))[1];
            if (T >= NB * NG * (SEQ / 64)) break;
            const int bg = T & 7, qb = (SEQ / 64 - 1) - (T >> 3), t0 = qb * 64 + wid2 * 8;
            unsigned mA[4], mB[4];
            PROBE_BEGIN(6)
            attn_cmp(p, bg >> 1, bg & 1, t0, lane, L, mA);
            attn_cmp(p, bg >> 1, bg & 1, t0 + 4, lane, L, mB);
            PROBE_END(6)
            PROBE_BEGIN(7)
            attn_selwin_pair(p, bg >> 1, bg & 1, t0, lane, L, mA, mB);
            PROBE_END(7)
        }
    }
    __syncthreads();
}

constexpr int GM_LD = 136, GM_LDS = 128 * GM_LD * 2 + 1024;
__device__ __forceinline__ void phase_gmlp(const Params& p) {
    int tid = threadIdx.x; asm volatile("" : "+v"(tid));
    const int wid = __builtin_amdgcn_readfirstlane(tid >> 6), lane = tid & 63;
    LAS bf16_t* vnT = (LAS bf16_t*)smem;
    LAS float* mu = (LAS float*)(smem + 128 * GM_LD * 2);
    const int c = lane & 15, G = lane >> 4;
#pragma unroll 1
    for (int u = blockIdx.x; u < NB * 64; u += gridDim.x) {
        const int b = u >> 6, ch = u & 63; const size_t row0 = (size_t)b * SEQ + ch * 128;
        __syncthreads();
        for (int r = wid; r < 128; r += 8) {
            const u32x4 w = *(const u32x4*)(p.Vg + (row0 + r) * GMD + lane * 8);
            const float x[8] = {bflo(w.x), bfhi(w.x), bflo(w.y), bfhi(w.y), bflo(w.z), bfhi(w.z), bflo(w.w), bfhi(w.w)};
            float s = 0.f;
#pragma unroll
            for (int i = 0; i < 8; ++i) s += x[i];
            const float mean = wave_sum(s) * (1.0f / GMD);
            float q = 0.f;
#pragma unroll
            for (int i = 0; i < 8; ++i) q += (x[i] - mean) * (x[i] - mean);
            const float var = wave_sum(q) * (1.0f / GMD);
            if (lane == 0) { mu[r] = mean; mu[128 + r] = rsqrtf(var + EPS); }
        }
#pragma unroll 1
        for (int g = 0; g < 4; ++g) {
            __syncthreads();
#pragma unroll
            for (int k = 0; k < 4; ++k) {
                const int e = tid + 512 * k, s = e & 127, d0 = (e >> 7) * 8;
                const u32x4 w = *(const u32x4*)(p.Vg + (row0 + s) * GMD + g * 128 + d0);
                const float x[8] = {bflo(w.x), bfhi(w.x), bflo(w.y), bfhi(w.y), bflo(w.z), bfhi(w.z), bflo(w.w), bfhi(w.w)};
                const float m = mu[s], rs = mu[128 + s];
#pragma unroll
                for (int i = 0; i < 8; ++i) { const int cc = g * 128 + d0 + i; vnT[(d0 + i) * GM_LD + s] = f2bf((x[i] - m) * rs * p.gm_ln_g[cc] + p.gm_ln_b[cc]); }
            }
            __syncthreads();
            f32x4 acc[8];
#pragma unroll
            for (int dt = 0; dt < 8; ++dt) acc[dt] = (f32x4){0.f, 0.f, 0.f, 0.f};
            const bf16_t* wrow = p.GWb + ((size_t)g * 128 + 16 * wid + c) * 128 + 8 * G;
#pragma unroll 1
            for (int ks = 0; ks <= (wid >> 1); ++ks) {
                const bf16x8 B = *(const bf16x8*)(wrow + 32 * ks);
#pragma unroll
                for (int dt = 0; dt < 8; ++dt) {
                    const bf16x8 A = *(const LAS bf16x8*)(vnT + (dt * 16 + c) * GM_LD + 32 * ks + 8 * G);
                    acc[dt] = mfma16(A, B, acc[dt]);
                }
            }
            const int t = 16 * wid + c;
            const float bs = p.gm_bs[g * 128 + t];
#pragma unroll
            for (int dt = 0; dt < 8; ++dt) {
                const int d = dt * 16 + 4 * G;
                const u32x2 uw = *(const u32x2*)(p.U + (row0 + t) * GMD + g * 128 + d);
                f32x4 o; o[0] = bflo(uw.x) * (acc[dt][0] + bs); o[1] = bfhi(uw.x) * (acc[dt][1] + bs); o[2] = bflo(uw.y) * (acc[dt][2] + bs); o[3] = bfhi(uw.y) * (acc[dt][3] + bs);
                st_bf16x4(p.OCAT + (row0 + t) * DM + QD + g * 128 + d, o);
            }
        }
    }
    for (int it = blockIdx.x * 8 + wid; it < NS; it += gridDim.x * 8) {
        const size_t row = (size_t)MP + it;
        const u32x4 w = *(const u32x4*)(p.Vg + row * GMD + lane * 8);
        const float x[8] = {bflo(w.x), bfhi(w.x), bflo(w.y), bfhi(w.y), bflo(w.z), bfhi(w.z), bflo(w.w), bfhi(w.w)};
        float s = 0.f;
#pragma unroll
        for (int i = 0; i < 8; ++i) s += x[i];
        const float mean = wave_sum(s) * (1.0f / GMD);
        float q = 0.f;
#pragma unroll
        for (int i = 0; i < 8; ++i) q += (x[i] - mean) * (x[i] - mean);
        const float rs = rsqrtf(wave_sum(q) * (1.0f / GMD) + EPS);
#pragma unroll
        for (int i = 0; i < 8; ++i) {
            const int c = lane * 8 + i, g = c >> 7;
            const float v = (x[i] - mean) * rs * p.gm_ln_g[c] + p.gm_ln_b[c];
            p.out[O_GMV + (size_t)it * GMD + c] = v;
            const float a = p.gm_ws[(size_t)g * 128 * 128] * v + p.gm_bs[g * 128];
            p.OCAT[row * DM + QD + c] = f2bf(bf2f(p.U[row * GMD + c]) * a);
        }
    }
}

template <int MODE>
__device__ __forceinline__ void phase_norm(const Params& p) {
    const int wid = threadIdx.x >> 6, lane = threadIdx.x & 63;
    const float* gpost = MODE == 0 ? p.ln_mix_post : MODE == 1 ? p.ln_ffn_post : p.ln_ple_post;
    for (int row = blockIdx.x * 8 + wid; row < MP + NS; row += gridDim.x * 8) {
        const bf16_t* fr = (const bf16_t*)p.F + (size_t)row * DM;
        const bf16_t* xb = MODE == 1 ? (const bf16_t*)p.X1 + (size_t)row * DM : p.X2b + (size_t)row * DM;
        f32x4 f[4], x[4];
#pragma unroll
        for (int k = 0; k < 4; ++k) { const u32x2 w = *(const u32x2*)(fr + lane * 4 + k * 256); f[k][0] = bflo(w.x); f[k][1] = bfhi(w.x); f[k][2] = bflo(w.y); f[k][3] = bfhi(w.y);
            if (MODE == 0) x[k] = *(const f32x4*)(xrow_ptr(p, row) + lane * 4 + k * 256);
            else { const u32x2 v = *(const u32x2*)(xb + lane * 4 + k * 256); x[k][0] = bflo(v.x); x[k][1] = bfhi(v.x); x[k][2] = bflo(v.y); x[k][3] = bfhi(v.y); } }
        const float r = row_rstd(f);
#pragma unroll
        for (int k = 0; k < 4; ++k) { const f32x4 g = *(const f32x4*)(gpost + lane * 4 + k * 256); x[k] = x[k] + f[k] * r * g; }
        if (MODE == 0) {
            const float r2 = row_rstd(x);
#pragma unroll
            for (int k = 0; k < 4; ++k) {
                st_bf16x4((bf16_t*)p.X1 + (size_t)row * DM + lane * 4 + k * 256, x[k]);
                const f32x4 g = *(const f32x4*)(p.ln_ffn_pre + lane * 4 + k * 256); const f32x4 o = x[k] * r2 * g;
                st_bf16x4(p.H2 + (size_t)row * DM + lane * 4 + k * 256, o);
            }
        } else if (MODE == 1) {
#pragma unroll
            for (int k = 0; k < 4; ++k) st_bf16x4(p.X2b + (size_t)row * DM + lane * 4 + k * 256, x[k]);
        } else {
            float* yr = row < MP ? p.out + O_YP + (size_t)row * DM : p.out + O_YS + (size_t)(row - MP) * DM;
#pragma unroll
            for (int k = 0; k < 4; ++k) *(f32x4*)(yr + lane * 4 + k * 256) = x[k];
        }
    }
}


#define XB_TMO      128
#define XB_XCNT(j)  (256  + 64 * (j))
#define XB_XSUB(j)  (1280 + 64 * (j))
#define XB_XGEN(j)  (2304 + 64 * (j))
#define XB_TOP      3328
#define XB_TOPGEN   3392
#define XCD_BAR_WORDS 3456
#define XB_SPIN_CAP (1u << 22)

__device__ __forceinline__ unsigned xb_ld(unsigned* p)              { return __hip_atomic_load(p, __ATOMIC_RELAXED, __HIP_MEMORY_SCOPE_AGENT); }
__device__ __forceinline__ unsigned xb_add(unsigned* p, unsigned v) { return __hip_atomic_fetch_add(p, v, __ATOMIC_RELAXED, __HIP_MEMORY_SCOPE_AGENT); }
__device__ __forceinline__ unsigned xb_xcc_id() { return (unsigned)__builtin_amdgcn_s_getreg((3 << 11) | 20) & 0xFu; }
#define XB_SPIN(cond, bar) do { unsigned _sp = 0; while (cond) { __builtin_amdgcn_s_sleep(1); \
    if ((++_sp & 255u) == 0u) { if (xb_ld(&(bar)[XB_TMO])) break; if (_sp > XB_SPIN_CAP) { atomicAdd(&(bar)[XB_TMO], 1u); break; } } } } while (0)

struct XcdBarrier {
    unsigned* bar; unsigned x;
    volatile LAS unsigned* st;
};

__device__ __forceinline__ XcdBarrier xcd_barrier_post(unsigned* bar, volatile LAS unsigned* st) {
    XcdBarrier b; b.bar = bar; b.x = xb_xcc_id(); b.st = st;
    if (threadIdx.x == 0) (void)xb_add(&bar[XB_XCNT(b.x)], 1u);
    return b;
}
__device__ __forceinline__ void xcd_barrier_complete(unsigned* bar, unsigned x, unsigned& nloc, unsigned& nx) {
    const unsigned G = gridDim.x * gridDim.y * gridDim.z;
    unsigned sum, cnt, mine, sp = 0u;
    for (;;) {
        sum = 0u; cnt = 0u; mine = 0u;
#pragma unroll
        for (unsigned j = 0; j < 16; ++j) { const unsigned c = xb_ld(&bar[XB_XCNT(j)]); sum += c; cnt += (c > 0u) ? 1u : 0u; mine = (j == x) ? c : mine; }
        if (sum == G) break;
        __builtin_amdgcn_s_sleep(1);
        if ((++sp & 255u) == 0u) { if (xb_ld(&bar[XB_TMO])) break; if (sp > XB_SPIN_CAP) { atomicAdd(&bar[XB_TMO], 1u); break; } }
    }
    nloc = mine > 0u ? mine : 1u; nx = cnt > 0u ? cnt : 1u;
}

__device__ __forceinline__ void xcd_barrier(const XcdBarrier& b) {
    asm volatile("s_waitcnt vmcnt(0)" ::: "memory");
    __syncthreads();
    if (threadIdx.x == 0) {
        unsigned* bar = b.bar;
        __builtin_amdgcn_s_waitcnt(0);
        unsigned nloc = b.st[0], nx = b.st[1];
        if (nloc == 0u) { xcd_barrier_complete(bar, b.x, nloc, nx); b.st[0] = nloc; b.st[1] = nx; }
        const unsigned old = xb_add(&bar[XB_XSUB(b.x)], 1u);
        const unsigned gen = old / nloc;
        if (old + 1u == (gen + 1u) * nloc) {
            __builtin_amdgcn_fence(__ATOMIC_RELEASE, "agent");
            asm volatile("s_waitcnt vmcnt(0)" ::: "memory");
            const unsigned og = xb_add(&bar[XB_TOP], 1u);
            const unsigned tg = og / nx;
            if (og + 1u == (tg + 1u) * nx) xb_add(&bar[XB_TOPGEN], 1u);
            else XB_SPIN(xb_ld(&bar[XB_TOPGEN]) == tg, bar);
            __builtin_amdgcn_fence(__ATOMIC_ACQUIRE, "agent");
            xb_add(&bar[XB_XGEN(b.x)], 1u);
            asm volatile("s_waitcnt vmcnt(0)" ::: "memory");
        } else {
            XB_SPIN(xb_ld(&bar[XB_XGEN(b.x)]) == gen, bar);
            __builtin_amdgcn_fence(__ATOMIC_ACQUIRE, "agent");
            asm volatile("s_waitcnt vmcnt(0)" ::: "memory");
        }
    }
    __syncthreads();
}

constexpr int NPHASE = 16;
constexpr int LDS_BYTES = GEMM_LDS;
static_assert(GM_LDS <= LDS_BYTES, "lds");
constexpr int NMT = MALL / BM;

constexpr int NMP = MP / BM;
template <int PH>
__device__ __forceinline__ void run_phase(const Params& p) {
    if (PH == 0) phase_prologue(p);
    if (PH == 1) { EpiIn e{p}; if (blockIdx.x & 1) phase_gather(p); gemm_phase(p.H, DM, p.WinT, DM, NMP, INP / BM, e); gemm_skinny(p.H + (size_t)MP * DM, DM, p.WinT, DM, INP, e); if (!(blockIdx.x & 1)) phase_gather(p); }
    if (PH == 2) { EpiPart e{(bf16_t*)p.PART}; gemm_phase(p.CMPb, 4096, p.W1T, 1024, (2048 + NS * 1024) / BM, 1, e, 4, ZCmp(), 256); phase_deferred_transposes(p); }
    if (PH == 3) phase_cmp_final(p);
    if (PH == 4) phase_attn(p);
    if (PH == 5) phase_gmlp(p);
    if (PH == 6) { EpiBranch e{p.GA, p.GB, p.Y1}; gemm_phase<EpiBranch, ZNone, true>(p.OCAT, DM, p.WnT, DM, NMP, DM / BM, e); gemm_skinny2(p.OCAT + (size_t)MP * DM, DM, p.WnT, DM, DM, e); }
    if (PH == 8) { EpiBf16 e{(bf16_t*)p.F, DM}; gemm_phase(p.Y1, DM, p.WoT, DM, NMP, DM / BM, e); gemm_skinny(p.Y1 + (size_t)MP * DM, DM, p.WoT, DM, DM, e); }
    if (PH == 9) phase_norm<0>(p);
    if (PH == 10) { EpiSwiGLU e{p.ACT}; gemm_phase(p.H2, DM, p.WguT, DM, NMP, 2 * DFF / BM, e); gemm_skinny(p.H2 + (size_t)MP * DM, DM, p.WguT, DM, 2 * DFF, e); }
    if (PH == 11) { EpiBf16 e{(bf16_t*)p.F, DM}; gemm_phase(p.ACT, DFF, p.WdT, DFF, NMP, DM / BM, e); gemm_skinny(p.ACT + (size_t)MP * DFF, DFF, p.WdT, DFF, DM, e); }
    if (PH == 12) phase_norm<1>(p);
    if (PH == 13) { EpiBf16 e{(bf16_t*)p.T, DM}; gemm_phase(p.Pb, PLE, p.WpT, PLE, NMP, DM / BM, e); gemm_skinny(p.Pb + (size_t)MP * PLE, PLE, p.WpT, PLE, DM, e); }
    if (PH == 14) { EpiPleGate e{(const bf16_t*)p.T, (bf16_t*)p.F}; gemm_phase(p.X2b, DM, p.WpgT, DM, NMP, DM / BM, e); gemm_skinny(p.X2b + (size_t)MP * DM, DM, p.WpgT, DM, DM, e); }
    if (PH == 15) phase_norm<2>(p);
}

#ifndef MK_MULTI
#define MK_MULTI 0
#endif
template <int PH>
__global__ void __launch_bounds__(512, 2) k_phase(Params p) { run_phase<PH>(p); }

__global__ void __launch_bounds__(512, 2) k_all(Params p) {
    volatile LAS unsigned* st = (volatile LAS unsigned*)((LAS unsigned char*)smem + LDS_BYTES);
    if (threadIdx.x < 12) st[threadIdx.x] = 0u;
    __syncthreads();
    XcdBarrier bar = xcd_barrier_post(p.bar, st);
#if PROBE_DUP == 100
    run_phase<0>(p);  xcd_barrier(bar);
#endif
    run_phase<0>(p);  xcd_barrier(bar);
    run_phase<1>(p);  xcd_barrier(bar);
    run_phase<2>(p);  xcd_barrier(bar);
#if PROBE_DUP == 100
    run_phase<3>(p);  xcd_barrier(bar);
#endif
    run_phase<3>(p);  xcd_barrier(bar);
#if PROBE_DUP == 104
    run_phase<4>(p);  xcd_barrier(bar);
#endif
    run_phase<4>(p);
#if PROBE_DUP == 100
    run_phase<5>(p);  xcd_barrier(bar);
#endif
    run_phase<5>(p);  xcd_barrier(bar);
    run_phase<6>(p);  xcd_barrier(bar);
    run_phase<8>(p);  xcd_barrier(bar);
    run_phase<9>(p);  xcd_barrier(bar);
    run_phase<10>(p); xcd_barrier(bar);
    run_phase<11>(p); xcd_barrier(bar);
    run_phase<12>(p);
    run_phase<13>(p); xcd_barrier(bar);
    run_phase<14>(p); xcd_barrier(bar);
    run_phase<15>(p);
#if PROBE_SPIN
    if (blockIdx.x == 0 && threadIdx.x == 0) {
        const unsigned long long d = PROBE_TS[2] * PROBE_SPIN, t0 = probe_now();
        while (probe_now() - t0 < d) __builtin_amdgcn_s_sleep(8);
    }
#endif
}

static inline size_t al256(size_t x) { return (x + 255) & ~(size_t)255; }
template <int PH> static void launch_phase(const Params& p, int grid, hipStream_t s) {
    static bool attr = false;
    if (!attr) { (void)hipFuncSetAttribute((const void*)k_phase<PH>, hipFuncAttributeMaxDynamicSharedMemorySize, LDS_BYTES); attr = true; }
    k_phase<PH><<<grid, 512, LDS_BYTES, s>>>(p);
}
template <int PH> static void launch_all(const Params& p, int grid, hipStream_t s) {
    launch_phase<PH>(p, grid, s);
    if constexpr (PH + 1 < NPHASE) launch_all<PH + 1>(p, grid, s);
}

extern "C" void kernel_launch(void* const* d_in, const int* in_sizes, int n_in, void* d_out, int out_size, void* d_ws, size_t ws_size, hipStream_t stream) {
    Params p{};
    p.x_prompt = (const float*)d_in[0]; p.x_sample = (const float*)d_in[1]; p.cache_cmp = (const float*)d_in[2]; p.cache_slc = (const float*)d_in[3];
    p.state_win = (const float*)d_in[4]; p.page_table = (const int*)d_in[5]; p.p_prompt = (const float*)d_in[6]; p.p_sample = (const float*)d_in[7];
    p.rel_bias = (const float*)d_in[8]; p.ln_mix_pre = (const float*)d_in[9]; p.w_in = (const float*)d_in[10];
    p.pe_k = (const float*)d_in[11]; p.w1_k = (const float*)d_in[12]; p.w2_k = (const float*)d_in[13];
    p.pe_v = (const float*)d_in[14]; p.w1_v = (const float*)d_in[15]; p.w2_v = (const float*)d_in[16];
    p.gm_ln_g = (const float*)d_in[17]; p.gm_ln_b = (const float*)d_in[18]; p.gm_ws = (const float*)d_in[19]; p.gm_bs = (const float*)d_in[20];
    p.w_br_nsa = (const float*)d_in[21]; p.w_br_gm = (const float*)d_in[22]; p.w_out = (const float*)d_in[23];
    p.ln_mix_post = (const float*)d_in[24]; p.ln_ffn_pre = (const float*)d_in[25]; p.w_gate = (const float*)d_in[26]; p.w_up = (const float*)d_in[27];
    p.w_down = (const float*)d_in[28]; p.ln_ffn_post = (const float*)d_in[29]; p.w_ple = (const float*)d_in[30]; p.w_ple_gate = (const float*)d_in[31];
    p.ln_ple_post = (const float*)d_in[32];
    p.out = (float*)d_out;
    unsigned char* w = (unsigned char*)d_ws; size_t off = 0;
    auto take = [&](size_t bytes) { void* r = w + off; off = al256(off + bytes); return r; };
    p.bar = (unsigned*)take(16384);
    p.WinT = (bf16_t*)take((size_t)INP * DM * 2); p.WnT = (bf16_t*)take((size_t)DM * DM * 2); p.WgT = nullptr;
    p.WoT = (bf16_t*)take((size_t)DM * DM * 2); p.WguT = (bf16_t*)take((size_t)2 * DFF * DM * 2); p.WdT = (bf16_t*)take((size_t)DM * DFF * 2);
    p.WpgT = (bf16_t*)take((size_t)DM * DM * 2); p.WpT = (bf16_t*)take((size_t)DM * PLE * 2); p.W1T = (bf16_t*)take((size_t)2 * 256 * 1024 * 2);
    p.H = (bf16_t*)take((size_t)MALL * DM * 2); p.Qb = (bf16_t*)take((size_t)MALL * QD * 2);
    p.CMPb = (bf16_t*)take(((size_t)MP + (size_t)NS * PAST) * 256 * 2); p.SLCb = (bf16_t*)take((size_t)MALL * 256 * 2); p.WINb = (bf16_t*)take((size_t)MALL * 256 * 2);
    p.U = (bf16_t*)take((size_t)MALL * GMD * 2); p.Vg = (bf16_t*)take((size_t)MALL * GMD * 2);
    p.GA = (bf16_t*)take((size_t)MALL * DM * 2); p.GB = (bf16_t*)take((size_t)MALL * DM * 2);
    p.GATE = (float*)take((size_t)MALL * 32 * 4);
    p.PART = (float*)take((size_t)(2048 + NS * 1024) * 4 * 256 * 4); p.PEB = (float*)take(256 * 4);
    p.KCP = (float*)take((size_t)NB * NG * 512 * 64 * 4); p.VCP = (float*)take((size_t)NB * NG * 512 * 64 * 4);
    p.KCS = (float*)take((size_t)NS * NG * 1024 * 64 * 4); p.VCS = (float*)take((size_t)NS * NG * 1024 * 64 * 4); p.KN = (float*)take(NB * NG * 128 * 4);
    p.KCb = (bf16_t*)take((size_t)NB * NG * 512 * 64 * 2); p.VCT = (bf16_t*)take((size_t)NB * NG * 64 * 512 * 2);
    p.SLCvT = (bf16_t*)take((size_t)NB * NG * 64 * SEQ * 2); p.WINvT = (bf16_t*)take((size_t)NB * NG * 64 * SEQ * 2);
    p.GWb = (bf16_t*)take(4 * 128 * 128 * 2); p.W2T = (bf16_t*)take(2 * 64 * 128 * 2);
    p.SLCkF = (bf16_t*)take((size_t)NB * NG * 64 * SEQ * 2); p.WINkF = (bf16_t*)take((size_t)NB * NG * 64 * SEQ * 2);
    p.OCAT = (bf16_t*)take((size_t)MALL * DM * 2); p.T = (float*)take((size_t)MALL * DM * 4); p.Y1 = (bf16_t*)take((size_t)MALL * DM * 2);
    p.F = (float*)take((size_t)MALL * DM * 4); p.X1 = (float*)take((size_t)MALL * DM * 4); p.H2 = (bf16_t*)take((size_t)MALL * DM * 2);
    p.ACT = (bf16_t*)take((size_t)MALL * DFF * 2); p.X2 = (float*)take((size_t)MALL * DM * 4); p.X2b = (bf16_t*)take((size_t)MALL * DM * 2);
    p.Pb = (bf16_t*)take((size_t)MALL * PLE * 2);
    if (off > ws_size) { fprintf(stderr, "workspace too small: need %zu have %zu\n", off, ws_size); return; }
    (void)hipMemsetAsync(p.OCAT + (size_t)(MP + NS) * DM, 0, (size_t)(MALL - MP - NS) * DM * 2, stream);
#if MK_MULTI
    launch_all<0>(p, 256, stream);
#else
    constexpr size_t kDynLds = LDS_BYTES + 48;
    static int grid = 0;
    if (!grid) {
        int dev = 0, cus = 0, per_cu = 0;
        (void)hipGetDevice(&dev);
        (void)hipDeviceGetAttribute(&cus, hipDeviceAttributeMultiprocessorCount, dev);
        (void)hipFuncSetAttribute((const void*)k_all, hipFuncAttributeMaxDynamicSharedMemorySize, (int)kDynLds);
        (void)hipOccupancyMaxActiveBlocksPerMultiprocessor(&per_cu, (const void*)k_all, 512, kDynLds);
        grid = cus * (per_cu < 1 ? per_cu : 1);
        if (grid <= 0) { fprintf(stderr, "k_all: occupancy query says %d blocks per CU\n", per_cu); grid = 0; return; }
    }
    (void)hipMemsetAsync(p.bar, 0, XCD_BAR_WORDS * sizeof(unsigned), stream);
    k_all<<<grid, 512, kDynLds, stream>>>(p);
#endif
}
```

```cpp
#include <hip/hip_runtime.h>
#include <stdint.h>
#include <cstdio>

typedef unsigned short bf16_t;
typedef short bf16x8 __attribute__((ext_vector_type(8)));
typedef float f32x4 __attribute__((ext_vector_type(4)));
typedef float f32x2 __attribute__((ext_vector_type(2)));
typedef unsigned u32x4 __attribute__((ext_vector_type(4)));
typedef unsigned u32x2 __attribute__((ext_vector_type(2)));
#define LAS __attribute__((address_space(3)))

constexpr int DM = 1024, NB = 4, SEQ = 8192, MP = NB * SEQ, NS = 32, MALL = MP + 256, PAST = 16384, PAGE = 128, NPG = 128;
constexpr int NH = 8, NG = 2, HPG = 4, DH = 64, QD = 512, WIN = 512, GMD = 512, DFF = 2816, PLE = 256, IND = 4376, INP = 4608;
constexpr int NCP = 511, NCS = 1023;
constexpr float EPS = 1e-6f;
constexpr float LOG2E = 1.4426950408889634f, QSCALE = 0.125f * LOG2E;
constexpr long O_YP = 0, O_YS = 33554432, O_CMPP = 33587200, O_SLCP = 41975808, O_WINP = 50364416, O_CMPS = 50888704,
               O_SLCS = 50896896, O_WINS = 50905088, O_GMV = 55099392;

struct Params {
    const float *x_prompt, *x_sample, *cache_cmp, *cache_slc, *state_win; const int* page_table;
    const float *p_prompt, *p_sample, *rel_bias, *ln_mix_pre, *w_in, *pe_k, *w1_k, *w2_k, *pe_v, *w1_v, *w2_v;
    const float *gm_ln_g, *gm_ln_b, *gm_ws, *gm_bs, *w_br_nsa, *w_br_gm, *w_out, *ln_mix_post, *ln_ffn_pre;
    const float *w_gate, *w_up, *w_down, *ln_ffn_post, *w_ple, *w_ple_gate, *ln_ple_post;
    float* out;
    unsigned* bar;
    bf16_t *WinT, *WnT, *WgT, *WoT, *WguT, *WdT, *WpgT, *WpT, *W1T;
    bf16_t *H, *Qb, *CMPb, *SLCb, *WINb, *U, *Vg, *GA, *GB;
    float* GATE;
    float *PART, *PEB, *KCP, *VCP, *KCS, *VCS, *KN;
    bf16_t *KCb, *VCT, *SLCvT, *WINvT, *SLCkF, *WINkF, *GWb, *W2T;
    bf16_t* OCAT; float* T; bf16_t* Y1; float* F; float* X1; bf16_t* H2; bf16_t* ACT; float* X2; bf16_t* X2b; bf16_t* Pb;
};

__device__ __forceinline__ unsigned cvt_pk_bf16(float lo, float hi) { unsigned r; asm volatile("v_cvt_pk_bf16_f32 %0, %1, %2" : "=v"(r) : "v"(lo), "v"(hi)); return r; }
__device__ __forceinline__ bf16_t f2bf(float f) { return (bf16_t)(cvt_pk_bf16(f, 0.f) & 0xffffu); }
__device__ __forceinline__ float bf2f(bf16_t h) { return __uint_as_float(((unsigned)h) << 16); }
__device__ __forceinline__ float bflo(unsigned w) { return __uint_as_float(w << 16); }
__device__ __forceinline__ float bfhi(unsigned w) { return __uint_as_float(w & 0xffff0000u); }
__device__ __forceinline__ float ex2(float x) { return __builtin_amdgcn_exp2f(x); }
__device__ __forceinline__ float sigmoidf_(float x) { return 1.0f / (1.0f + __expf(-x)); }
__device__ __forceinline__ float siluf_(float x) { return x * sigmoidf_(x); }
__device__ __forceinline__ float geluf_(float x) {
    const float u = 0.7978845608028654f * (x + 0.044715f * x * x * x);
    const float e = __expf(2.0f * u);
    const float th = 1.0f - 2.0f / (e + 1.0f);
    return 0.5f * x * (1.0f + th);
}
__device__ __forceinline__ float wave_sum(float v) {
#pragma unroll
    for (int o = 32; o > 0; o >>= 1) v += __shfl_xor(v, o);
    return v;
}
__device__ __forceinline__ float wave_max(float v) {
#pragma unroll
    for (int o = 32; o > 0; o >>= 1) v = fmaxf(v, __shfl_xor(v, o));
    return v;
}
__device__ __forceinline__ int t5_bucket(int d) {
    if (d < 16) return d;
    if (d >= 128) return 31;
    const int b = 16 + (int)(__logf((float)d * (1.0f / 16.0f)) * (16.0f / 2.0794415416798357f));
    return b < 31 ? b : 31;
}

extern __shared__ __attribute__((aligned(16))) unsigned char smem[];
#ifndef PROBE_DUP
#define PROBE_DUP 0
#endif
#define PROBE_LDS_OFF 131072
#ifndef PROBE_SPIN
#define PROBE_SPIN 0
#endif
#ifndef PROBE_SEG
#define PROBE_SEG 5
#endif
__device__ __forceinline__ unsigned long long probe_now() { unsigned long long t; asm volatile("s_memrealtime %0\n\ts_waitcnt lgkmcnt(0)" : "=s"(t) :: "memory"); return t; }
#define PROBE_TS ((volatile LAS unsigned long long*)((LAS unsigned char*)smem + PROBE_LDS_OFF + 16))
#if PROBE_SPIN
#define PROBE_BEGIN(seg) unsigned long long pb_##seg = 0; if (PROBE_SEG == seg && threadIdx.x == 0) pb_##seg = probe_now();
#define PROBE_END(seg) if (PROBE_SEG == seg && threadIdx.x == 0) { PROBE_TS[2] = PROBE_TS[2] + (probe_now() - pb_##seg); }
#else
#define PROBE_BEGIN(seg)
#define PROBE_END(seg)
#endif

constexpr int BM = 256, BK = 64, HALF = 128, HT = HALF * BK, GEMM_LDS = 8 * HT * 2;
__device__ __forceinline__ int lds_byte(int r, int c) { const int st = (r >> 4) * 2 + (c >> 5), rr = r & 15, cc = c & 31, ob = rr * 64 + cc * 2; return st * 1024 + (ob ^ (((ob >> 9) & 1) << 5)); }
__device__ __forceinline__ void stage_rc(int b, int& R, int& C) { const int st = b / 1024, sb = b % 1024, swz = sb ^ (((sb >> 9) & 1) << 5); R = (st >> 1) * 16 + swz / 64; C = (st & 1) * 32 + (swz % 64) / 2; }

constexpr int HTB = HALF * BK * 2;
template <class F>
__device__ __forceinline__ void for_each_frag(const f32x4 (&acc)[2][2][4][2], int brow, int bcol, int wr, int wc, int fr, int fq, F&& f) {
#pragma unroll
    for (int ai = 0; ai < 2; ++ai)
#pragma unroll
        for (int m = 0; m < 4; ++m)
#pragma unroll
            for (int bj = 0; bj < 2; ++bj)
#pragma unroll
                for (int n = 0; n < 2; ++n)
                    f(brow + ai * HALF + wr * 64 + m * 16 + fr, bcol + bj * HALF + wc * 32 + n * 16 + fq * 4, acc[ai][bj][m][n]);
}

struct ZNone { __device__ __forceinline__ size_t a(int) const { return 0; } __device__ __forceinline__ size_t b(int) const { return 0; } };
template <class Epi, class ZMap = ZNone, bool HAS_MID = false>
__device__ __forceinline__ void gemm_phase(const bf16_t* A, int lda, const bf16_t* Bt, int K, int nM, int nN, const Epi& E, int nZ = 1, ZMap zm = ZMap(), int kstepA_el = BK) {
    LAS unsigned char* lds = (LAS unsigned char*)smem;
    int tid = threadIdx.x; asm volatile("" : "+v"(tid));
    const int wid = __builtin_amdgcn_readfirstlane(tid >> 6), lane = tid & 63, wr = wid >> 2, wc = wid & 3, fr = lane & 15, fq = lane >> 4;
    const int nt = K / BK, nmn = nM * nN, nu = nmn * nZ, G = gridDim.x;
    int u = blockIdx.x;
    if (u >= nu) return;
    unsigned voffA[2], voffB[2];
#pragma unroll
    for (int i = 0; i < 2; ++i) { int R, C; stage_rc(tid * 16 + i * 8192, R, C); voffA[i] = (unsigned)(R * lda + C) * 2u; voffB[i] = (unsigned)(R * K + C) * 2u; }
    const size_t kstep = (size_t)(BK * 2), kstepA = (size_t)kstepA_el * 2;
    const size_t hstepA = (size_t)HALF * lda * 2, hstepB = (size_t)HALF * K * 2, tstepA = 2 * hstepA, tstepB = 2 * hstepB;
    const unsigned ldsw = (unsigned)wid * 1024u;
    const int aoff = lds_byte(wr * 64 + fr, fq * 8), boff = lds_byte(wc * 32 + fr, fq * 8);
#define PG8_SA(b, h) (((b) * 2 + (h)) * HTB)
#define PG8_SB(b, h) ((4 + (b) * 2 + (h)) * HTB)
#define PG8_STAGE(bufoff, gbase, voff) do { _Pragma("unroll") for (int _i = 0; _i < 2; ++_i) \
        __builtin_amdgcn_global_load_lds((const unsigned*)((const char*)(gbase) + (voff)[_i]), (LAS unsigned*)(lds + (bufoff) + ldsw + _i * 8192), 16, 0, 0); } while (0)
#define PG8_LDA(dst, b, h) do { _Pragma("unroll") for (int m = 0; m < 4; ++m) _Pragma("unroll") for (int k = 0; k < 2; ++k) dst[m][k] = *(const LAS bf16x8*)(lds + PG8_SA(b, h) + aoff + m * 2048 + k * 1024); } while (0)
#define PG8_LDB(dst, b, h) do { _Pragma("unroll") for (int n = 0; n < 2; ++n) _Pragma("unroll") for (int k = 0; k < 2; ++k) dst[n][k] = *(const LAS bf16x8*)(lds + PG8_SB(b, h) + boff + n * 2048 + k * 1024); } while (0)
#define PG8_MMA(ai, bj, At, Bt_) do { __builtin_amdgcn_s_setprio(1); _Pragma("unroll") for (int m = 0; m < 4; ++m) _Pragma("unroll") for (int n = 0; n < 2; ++n) _Pragma("unroll") for (int k = 0; k < 2; ++k) \
        acc[ai][bj][m][n] = __builtin_amdgcn_mfma_f32_16x16x32_bf16(Bt_[n][k], At[m][k], acc[ai][bj][m][n], 0, 0, 0); __builtin_amdgcn_s_setprio(0); } while (0)
#define PG8_WAIT_V(n) asm volatile("s_waitcnt vmcnt(" #n ")" ::: "memory")
#define PG8_WAIT_L(n) asm volatile("s_waitcnt lgkmcnt(" #n ")" ::: "memory")
#define PG8_BAR __builtin_amdgcn_s_barrier()
#define PG8_SCHED __builtin_amdgcn_sched_barrier(0)
    f32x4 acc[2][2][4][2];
#pragma unroll
    for (int a = 0; a < 2; ++a)
#pragma unroll
        for (int b = 0; b < 2; ++b)
#pragma unroll
            for (int m = 0; m < 4; ++m)
#pragma unroll
                for (int n = 0; n < 2; ++n) acc[a][b][m][n] = (f32x4){0.f, 0.f, 0.f, 0.f};
    bf16x8 At[4][2], B0[2][2], B1[2][2];
    auto unit_of = [&](int uu, int& z_, int& pm_, int& pn_) {
        if (nZ == 1) {
            int wg = uu; { const int q = nu / 8, r = nu % 8, xcd = wg % 8, off = wg / 8; wg = (xcd < r ? xcd * (q + 1) : r * (q + 1) + (xcd - r) * q) + off; }
            const int nig = 8 * nN, gid = wg / nig, fm = gid * 8, gsz = (nM - fm) < 8 ? (nM - fm) : 8;
            z_ = 0; pm_ = fm + ((wg % nig) % gsz); pn_ = (wg % nig) / gsz;
        } else { z_ = uu / nmn; pm_ = (uu - z_ * nmn) / nN; pn_ = (uu - z_ * nmn) - pm_ * nN; }
    };
    int z, pm, pn; unit_of(u, z, pm, pn);
    const char* cA = (const char*)(A + zm.a(z)) + (size_t)pm * tstepA; const char* cB = (const char*)(Bt + zm.b(z)) + (size_t)pn * tstepB;
    PG8_STAGE(PG8_SB(0, 0), cB, voffB); PG8_STAGE(PG8_SA(0, 0), cA, voffA); PG8_STAGE(PG8_SB(0, 1), cB + hstepB, voffB); PG8_STAGE(PG8_SA(0, 1), cA + hstepA, voffA);
    if (wr == 1) PG8_BAR;
    PG8_WAIT_V(4); PG8_BAR;
    PG8_STAGE(PG8_SB(1, 0), cB + kstep, voffB); PG8_STAGE(PG8_SA(1, 0), cA + kstepA, voffA); PG8_STAGE(PG8_SB(1, 1), cB + hstepB + kstep, voffB);
    PG8_WAIT_V(6); PG8_BAR;
    for (;;) {
        const int un = u + G; const bool has_next = un < nu;
        int nz = z, npm = pm, npn = pn; if (has_next) unit_of(un, nz, npm, npn);
        const char* nA = (const char*)(A + zm.a(nz)) + (size_t)npm * tstepA; const char* nB = (const char*)(Bt + zm.b(nz)) + (size_t)npn * tstepB;
        auto kiter = [&](int t) {
            const bool last = (t == nt - 2);
            const char* a1 = cA + (size_t)(t + 1) * kstepA;
            const char* a2 = last ? nA : cA + (size_t)(t + 2) * kstepA; const char* b2 = last ? nB : cB + (size_t)(t + 2) * kstep;
            const char* a3 = a2 + kstepA; const char* b3 = b2 + kstep;
            PG8_LDB(B0, 0, 0); PG8_SCHED; PG8_LDA(At, 0, 0); PG8_STAGE(PG8_SA(1, 1), a1 + hstepA, voffA);
            PG8_WAIT_L(8); PG8_BAR; PG8_WAIT_L(0); PG8_MMA(0, 0, At, B0); PG8_BAR; PG8_SCHED;
            PG8_LDB(B1, 0, 1); PG8_STAGE(PG8_SB(0, 0), b2, voffB);
            PG8_BAR; PG8_WAIT_L(0); PG8_MMA(0, 1, At, B1); PG8_BAR;
            PG8_LDA(At, 0, 1); PG8_STAGE(PG8_SA(0, 0), a2, voffA);
            PG8_BAR; PG8_WAIT_L(0); PG8_MMA(1, 0, At, B0); PG8_BAR; PG8_SCHED;
            PG8_STAGE(PG8_SB(0, 1), b2 + hstepB, voffB);
            PG8_WAIT_V(6); PG8_BAR; PG8_MMA(1, 1, At, B1); PG8_BAR;
            PG8_LDB(B0, 1, 0); PG8_SCHED; PG8_LDA(At, 1, 0); PG8_STAGE(PG8_SA(0, 1), a2 + hstepA, voffA);
            PG8_WAIT_L(8); PG8_BAR; PG8_WAIT_L(0); PG8_MMA(0, 0, At, B0); PG8_BAR; PG8_SCHED;
            PG8_LDB(B1, 1, 1); PG8_STAGE(PG8_SB(1, 0), b3, voffB);
            PG8_BAR; PG8_WAIT_L(0); PG8_MMA(0, 1, At, B1); PG8_BAR;
            PG8_LDA(At, 1, 1); PG8_STAGE(PG8_SA(1, 0), a3, voffA);
            PG8_BAR; PG8_WAIT_L(0); PG8_MMA(1, 0, At, B0); PG8_BAR; PG8_SCHED;
            PG8_STAGE(PG8_SB(1, 1), b3 + hstepB, voffB);
            PG8_WAIT_V(6); PG8_BAR; PG8_MMA(1, 1, At, B1); PG8_BAR;
        };
        if constexpr (HAS_MID) {
            for (int t = 0; t < (nt >> 1); t += 2) kiter(t);
            E.mid(acc, pm * BM, pn * BM, wr, wc, fr, fq);
            for (int t = nt >> 1; t < nt; t += 2) kiter(t);
        } else {
            for (int t = 0; t < nt; t += 2) kiter(t);
        }
        E(acc, pm * BM, pn * BM + (z << 20), wr, wc, fr, fq);
        if (!has_next) break;
#pragma unroll
        for (int a = 0; a < 2; ++a)
#pragma unroll
            for (int b = 0; b < 2; ++b)
#pragma unroll
                for (int m = 0; m < 4; ++m)
#pragma unroll
                    for (int n = 0; n < 2; ++n) acc[a][b][m][n] = (f32x4){0.f, 0.f, 0.f, 0.f};
        u = un; z = nz; pm = npm; pn = npn; cA = nA; cB = nB;
    }
    PG8_WAIT_V(0);
    if (wr == 0) PG8_BAR;
    PG8_BAR;
#undef PG8_SA
#undef PG8_SB
#undef PG8_STAGE
#undef PG8_LDA
#undef PG8_LDB
#undef PG8_MMA
#undef PG8_WAIT_V
#undef PG8_WAIT_L
#undef PG8_BAR
#undef PG8_SCHED
}

__device__ __forceinline__ f32x4 mfma16(bf16x8 a, bf16x8 b, f32x4 c) { return __builtin_amdgcn_mfma_f32_16x16x32_bf16(a, b, c, 0, 0, 0); }
__device__ __forceinline__ bf16x8 pack_p(const f32x4& a, const f32x4& b) {
    u32x4 w; w.x = cvt_pk_bf16(a[0], a[1]); w.y = cvt_pk_bf16(a[2], a[3]); w.z = cvt_pk_bf16(b[0], b[1]); w.w = cvt_pk_bf16(b[2], b[3]);
    return __builtin_bit_cast(bf16x8, w);
}
__device__ __forceinline__ size_t kfrag_off(int key, int d) { return ((size_t)((key >> 4) * 2 + (d >> 5)) * 64 + ((d >> 3) & 3) * 16 + (key & 15)) * 8 + (d & 7); }
__device__ __forceinline__ size_t vfrag_off(int key, int d) {
    return ((size_t)((key >> 5) * 4 + (d >> 4)) * 64 + ((key >> 2) & 3) * 16 + (d & 15)) * 8 + ((key >> 4) & 1) * 4 + (key & 3);
}
__device__ __forceinline__ void st_bf16x4(bf16_t* p, f32x4 v) { u32x2 w; w.x = cvt_pk_bf16(v[0], v[1]); w.y = cvt_pk_bf16(v[2], v[3]); *(u32x2*)p = w; }

struct EpiIn {
    const Params& p;
    __device__ __forceinline__ void apply(int row, int col, f32x4 v) const {
        const Params& P = p; const int pn = col >> 8, c = col & 255;
        if (pn < 2) st_bf16x4(P.Qb + (size_t)row * QD + col, v * QSCALE);
        else if (pn < 5) {
            if (pn != 2) st_bf16x4((pn == 3 ? P.SLCb : P.WINb) + (size_t)row * 256 + c, v);
            if (pn < 4) *(f32x4*)(P.out + (pn == 2 ? O_CMPS : O_SLCS) + (size_t)(row - MP) * 256 + c) = v;
            else *(f32x4*)(P.out + O_WINS + ((size_t)(row - MP) * WIN + (WIN - 1)) * 256 + c) = v;
        } else if (pn < 9) {
            f32x4 g; g[0] = geluf_(v[0]); g[1] = geluf_(v[1]); g[2] = geluf_(v[2]); g[3] = geluf_(v[3]);
            st_bf16x4((pn < 7 ? P.U : P.Vg) + (size_t)row * GMD + (col - (pn < 7 ? 1280 : 1792)), g);
        } else if (pn < 17) {
            f32x4 g; g[0] = sigmoidf_(v[0]); g[1] = sigmoidf_(v[1]); g[2] = sigmoidf_(v[2]); g[3] = sigmoidf_(v[3]);
            st_bf16x4((pn < 13 ? P.GA : P.GB) + (size_t)row * DM + (col - (pn < 13 ? 2304 : 3328)), g);
        } else if (c < 24) { f32x4 g; g[0] = sigmoidf_(v[0]); g[1] = sigmoidf_(v[1]); g[2] = sigmoidf_(v[2]); g[3] = sigmoidf_(v[3]); *(f32x4*)(P.GATE + (size_t)row * 32 + c) = g; }
    }
    __device__ __forceinline__ void operator()(const f32x4 (&acc)[2][2][4][2], int brow, int bcol, int wr, int wc, int fr, int fq) const {
        const int pn = bcol >> 8;
        const Params& P = p;
        if (pn < 2) {
            for_each_frag(acc, brow, bcol, wr, wc, fr, fq, [&](int row, int col, f32x4 v) { st_bf16x4(P.Qb + (size_t)row * QD + col, v * QSCALE); });
        } else if (pn < 5) {
            bf16_t* cp = pn == 2 ? P.CMPb : pn == 3 ? P.SLCb : P.WINb;
            for_each_frag(acc, brow, bcol, wr, wc, fr, fq, [&](int row, int col, f32x4 v) {
                const int c = col & 255;
                if (pn == 2) st_bf16x4(cp + (size_t)row * 256 + c, v);
                if (pn >= 3 && c < 128 && row < MP) {
                    st_bf16x4((pn == 3 ? P.SLCkF : P.WINkF) + ((size_t)(row >> 13) * NG + (c >> 6)) * SEQ * 64 + kfrag_off(row & (SEQ - 1), c & 63), v);
                }
                if (pn >= 3 && c >= 128 && row < MP) {
                    const int t = row & (SEQ - 1), dc = c - 128;
                    bf16_t* vt = (pn == 3 ? P.SLCvT : P.WINvT) + ((size_t)(row >> 13) * NG + (dc >> 6)) * SEQ * 64 + vfrag_off(t, dc & 63);
                    vt[0] = f2bf(v[0]); vt[8] = f2bf(v[1]); vt[16] = f2bf(v[2]); vt[24] = f2bf(v[3]);
                }
                if (pn < 4) {
                    if (row < MP) *(f32x4*)(P.out + (pn == 2 ? O_CMPP : O_SLCP) + (size_t)row * 256 + c) = v;
                    else if (row < MP + NS) *(f32x4*)(P.out + (pn == 2 ? O_CMPS : O_SLCS) + (size_t)(row - MP) * 256 + c) = v;
                } else {
                    if (row < MP) { const int t = row & (SEQ - 1), b = row >> 13; if (t >= SEQ - WIN) *(f32x4*)(P.out + O_WINP + ((size_t)b * WIN + (t - (SEQ - WIN))) * 256 + c) = v; }
                    else if (row < MP + NS) *(f32x4*)(P.out + O_WINS + ((size_t)(row - MP) * WIN + (WIN - 1)) * 256 + c) = v;
                }
            });
        } else if (pn < 9) {
            bf16_t* dst = pn < 7 ? P.U : P.Vg; const int c0 = pn < 7 ? 1280 : 1792;
            for_each_frag(acc, brow, bcol, wr, wc, fr, fq, [&](int row, int col, f32x4 v) {
                f32x4 g; g[0] = geluf_(v[0]); g[1] = geluf_(v[1]); g[2] = geluf_(v[2]); g[3] = geluf_(v[3]);
                st_bf16x4(dst + (size_t)row * GMD + (col - c0), g); });
        } else if (pn < 17) {
            bf16_t* dst = pn < 13 ? P.GA : P.GB; const int c0 = pn < 13 ? 2304 : 3328;
            for_each_frag(acc, brow, bcol, wr, wc, fr, fq, [&](int row, int col, f32x4 v) {
                f32x4 g; g[0] = sigmoidf_(v[0]); g[1] = sigmoidf_(v[1]); g[2] = sigmoidf_(v[2]); g[3] = sigmoidf_(v[3]);
                st_bf16x4(dst + (size_t)row * DM + (col - c0), g); });
        } else {
            for_each_frag(acc, brow, bcol, wr, wc, fr, fq, [&](int row, int col, f32x4 v) {
                const int c = col & 255;
                if (c < 24) { f32x4 g; g[0] = sigmoidf_(v[0]); g[1] = sigmoidf_(v[1]); g[2] = sigmoidf_(v[2]); g[3] = sigmoidf_(v[3]); *(f32x4*)(P.GATE + (size_t)row * 32 + c) = g; } });
        }
    }
};
struct EpiBranch {
    const bf16_t* GA; const bf16_t* GB; bf16_t* Y1;
    __device__ __forceinline__ void mid(f32x4 (&acc)[2][2][4][2], int brow, int bcol, int wr, int wc, int fr, int fq) const {
#pragma unroll
        for (int ai = 0; ai < 2; ++ai)
#pragma unroll
            for (int m = 0; m < 4; ++m)
#pragma unroll
                for (int bj = 0; bj < 2; ++bj)
#pragma unroll
                    for (int n = 0; n < 2; ++n) {
                        const size_t o = (size_t)(brow + ai * HALF + wr * 64 + m * 16 + fr) * DM + bcol + bj * HALF + wc * 32 + n * 16 + fq * 4;
                        const u32x2 a = *(const u32x2*)(GA + o), b = *(const u32x2*)(GB + o);
                        f32x4& v = acc[ai][bj][m][n];
                        v[0] *= bflo(a.x) / fmaxf(bflo(b.x), 1e-30f); v[1] *= bfhi(a.x) / fmaxf(bfhi(b.x), 1e-30f);
                        v[2] *= bflo(a.y) / fmaxf(bflo(b.y), 1e-30f); v[3] *= bfhi(a.y) / fmaxf(bfhi(b.y), 1e-30f);
                        if (bj == 1 && n == 1) __builtin_amdgcn_sched_barrier(0);
                    }
    }
    __device__ __forceinline__ void operator()(const f32x4 (&acc)[2][2][4][2], int brow, int bcol, int wr, int wc, int fr, int fq) const {
        for_each_frag(acc, brow, bcol, wr, wc, fr, fq, [&](int row, int col, f32x4 v) {
            const u32x2 b = *(const u32x2*)(GB + (size_t)row * DM + col);
            f32x4 o; o[0] = v[0] * fmaxf(bflo(b.x), 1e-30f); o[1] = v[1] * fmaxf(bfhi(b.x), 1e-30f); o[2] = v[2] * fmaxf(bflo(b.y), 1e-30f); o[3] = v[3] * fmaxf(bfhi(b.y), 1e-30f);
            st_bf16x4(Y1 + (size_t)row * DM + col, o); });
    }
    __device__ __forceinline__ void apply2(int row, int col, f32x4 v1, f32x4 v2) const {
        const u32x2 a = *(const u32x2*)(GA + (size_t)row * DM + col), b = *(const u32x2*)(GB + (size_t)row * DM + col);
        f32x4 o; o[0] = v1[0] * bflo(a.x) + v2[0] * bflo(b.x); o[1] = v1[1] * bfhi(a.x) + v2[1] * bfhi(b.x); o[2] = v1[2] * bflo(a.y) + v2[2] * bflo(b.y); o[3] = v1[3] * bfhi(a.y) + v2[3] * bfhi(b.y);
        st_bf16x4(Y1 + (size_t)row * DM + col, o);
    }
};
struct EpiF32 {
    float* F; int ld;
    __device__ __forceinline__ void apply(int row, int col, f32x4 v) const { *(f32x4*)(F + (size_t)row * ld + col) = v; }
    __device__ __forceinline__ void operator()(const f32x4 (&acc)[2][2][4][2], int brow, int bcol, int wr, int wc, int fr, int fq) const {
        for_each_frag(acc, brow, bcol, wr, wc, fr, fq, [&](int row, int col, f32x4 v) { *(f32x4*)(F + (size_t)row * ld + col) = v; });
    }
};
struct EpiBf16 {
    bf16_t* O; int ld;
    __device__ __forceinline__ void apply(int row, int col, f32x4 v) const { st_bf16x4(O + (size_t)row * ld + col, v); }
    __device__ __forceinline__ void operator()(const f32x4 (&acc)[2][2][4][2], int brow, int bcol, int wr, int wc, int fr, int fq) const {
        for_each_frag(acc, brow, bcol, wr, wc, fr, fq, [&](int row, int col, f32x4 v) { apply(row, col, v); });
    }
};
struct EpiPart {
    bf16_t* PART;
    __device__ __forceinline__ void operator()(const f32x4 (&acc)[2][2][4][2], int brow, int bcol, int wr, int wc, int fr, int fq) const {
        const int z = bcol >> 20;
        for_each_frag(acc, brow, 0, wr, wc, fr, fq, [&](int row, int col, f32x4 v) { st_bf16x4(PART + ((size_t)row * 4 + z) * 256 + col, v); });
    }
};
struct ZCmp { __device__ __forceinline__ size_t a(int z) const { return (size_t)z * 64; } __device__ __forceinline__ size_t b(int z) const { return (size_t)(z >> 1) * 256 * 1024; } };
struct EpiSwiGLU {
    bf16_t* ACT;
    __device__ __forceinline__ void apply(int row, int col, f32x4 v) const { *(unsigned*)(ACT + (size_t)row * DFF + (col >> 1)) = cvt_pk_bf16(siluf_(v[0]) * v[1], siluf_(v[2]) * v[3]); }
    __device__ __forceinline__ void operator()(const f32x4 (&acc)[2][2][4][2], int brow, int bcol, int wr, int wc, int fr, int fq) const {
        for_each_frag(acc, brow, bcol, wr, wc, fr, fq, [&](int row, int col, f32x4 v) {
            *(unsigned*)(ACT + (size_t)row * DFF + (col >> 1)) = cvt_pk_bf16(siluf_(v[0]) * v[1], siluf_(v[2]) * v[3]); });
    }
};
struct EpiPleGate {
    const bf16_t* E; bf16_t* F;
    __device__ __forceinline__ void apply(int row, int col, f32x4 v) const {
        const u32x2 w = *(const u32x2*)(E + (size_t)row * DM + col);
        f32x4 o; o[0] = sigmoidf_(v[0]) * bflo(w.x); o[1] = sigmoidf_(v[1]) * bfhi(w.x); o[2] = sigmoidf_(v[2]) * bflo(w.y); o[3] = sigmoidf_(v[3]) * bfhi(w.y);
        st_bf16x4(F + (size_t)row * DM + col, o); }
    __device__ __forceinline__ void operator()(const f32x4 (&acc)[2][2][4][2], int brow, int bcol, int wr, int wc, int fr, int fq) const {
        for_each_frag(acc, brow, bcol, wr, wc, fr, fq, [&](int row, int col, f32x4 v) { apply(row, col, v); });
    }
};

template <class Epi>
__device__ __forceinline__ void gemm_skinny(const bf16_t* A  , int lda, const bf16_t* Bt, int K, int N, const Epi& E) {
    int tid = threadIdx.x; asm volatile("" : "+v"(tid));
    const int wid = __builtin_amdgcn_readfirstlane(tid >> 6), lane = tid & 63, c = lane & 15, G = lane >> 4;
    LAS f32x4* red = (LAS f32x4*)smem;
    const int nsteps = K / 32;
#pragma unroll 1
    for (int ct = blockIdx.x; ct < N / 16; ct += gridDim.x) {
        f32x4 acc0 = {0.f, 0.f, 0.f, 0.f}, acc1 = {0.f, 0.f, 0.f, 0.f};
        const bf16_t* bp = Bt + (size_t)(ct * 16 + c) * K + G * 8;
        const bf16_t* a0 = A + (size_t)c * lda + G * 8; const bf16_t* a1 = A + (size_t)(16 + c) * lda + G * 8;
#pragma unroll 4
        for (int kk = wid; kk < nsteps; kk += 8) {
            const bf16x8 bf = *(const bf16x8*)(bp + kk * 32), x0 = *(const bf16x8*)(a0 + kk * 32), x1 = *(const bf16x8*)(a1 + kk * 32);
            acc0 = mfma16(bf, x0, acc0); acc1 = mfma16(bf, x1, acc1);
        }
        __syncthreads();
        red[(wid * 2 + 0) * 64 + lane] = acc0; red[(wid * 2 + 1) * 64 + lane] = acc1;
        __syncthreads();
        if (tid < 128) {
            const int rt = tid >> 6;
            f32x4 v = red[rt * 64 + lane];
#pragma unroll
            for (int w = 1; w < 8; ++w) v = v + red[(w * 2 + rt) * 64 + lane];
            E.apply(MP + rt * 16 + c, ct * 16 + 4 * G, v);
        }
    }
    __syncthreads();
}

template <class Epi>
__device__ __forceinline__ void gemm_skinny2(const bf16_t* A  , int lda, const bf16_t* Bt, int K, int N, const Epi& E) {
    int tid = threadIdx.x; asm volatile("" : "+v"(tid));
    const int wid = __builtin_amdgcn_readfirstlane(tid >> 6), lane = tid & 63, c = lane & 15, G = lane >> 4;
    LAS f32x4* red = (LAS f32x4*)smem;
    const int hsteps = K / 64;
#pragma unroll 1
    for (int ct = blockIdx.x; ct < N / 16; ct += gridDim.x) {
        f32x4 acc[4] = {{0.f, 0.f, 0.f, 0.f}, {0.f, 0.f, 0.f, 0.f}, {0.f, 0.f, 0.f, 0.f}, {0.f, 0.f, 0.f, 0.f}};
        const bf16_t* bp = Bt + (size_t)(ct * 16 + c) * K + G * 8;
        const bf16_t* a0 = A + (size_t)c * lda + G * 8; const bf16_t* a1 = A + (size_t)(16 + c) * lda + G * 8;
#pragma unroll
        for (int h = 0; h < 2; ++h) {
#pragma unroll 2
            for (int kk = h * hsteps + wid; kk < (h + 1) * hsteps; kk += 8) {
                const bf16x8 bf = *(const bf16x8*)(bp + kk * 32), x0 = *(const bf16x8*)(a0 + kk * 32), x1 = *(const bf16x8*)(a1 + kk * 32);
                acc[h * 2] = mfma16(bf, x0, acc[h * 2]); acc[h * 2 + 1] = mfma16(bf, x1, acc[h * 2 + 1]);
            }
        }
        __syncthreads();
#pragma unroll
        for (int q = 0; q < 4; ++q) red[(wid * 4 + q) * 64 + lane] = acc[q];
        __syncthreads();
        if (tid < 128) {
            const int rt = tid >> 6;
            f32x4 v1 = red[rt * 64 + lane], v2 = red[(2 + rt) * 64 + lane];
#pragma unroll
            for (int w = 1; w < 8; ++w) { v1 = v1 + red[(w * 4 + rt) * 64 + lane]; v2 = v2 + red[(w * 4 + 2 + rt) * 64 + lane]; }
            E.apply2(MP + rt * 16 + c, ct * 16 + 4 * G, v1, v2);
        }
    }
    __syncthreads();
}

template <class Map>
__device__ __forceinline__ void transpose_tile(const float* W, int K, int N, bf16_t* Wt, int ldk, int kt, int ntile, Map map) {
    LAS float* tile = (LAS float*)smem;
    const int t = threadIdx.x;
    __syncthreads();
#pragma unroll
    for (int i = 0; i < 2; ++i) {
        const int k = (t >> 4) + 32 * i, n = (t & 15) * 4, gn = ntile * 64 + n;
        f32x4 v = (f32x4){0.f, 0.f, 0.f, 0.f};
        if (gn < N) v = *(const f32x4*)(W + (size_t)(kt * 64 + k) * N + gn);
        tile[k * 65 + n] = v[0]; tile[k * 65 + n + 1] = v[1]; tile[k * 65 + n + 2] = v[2]; tile[k * 65 + n + 3] = v[3];
    }
    __syncthreads();
    const int n = t >> 3, kc = (t & 7) * 8, gn = ntile * 64 + n;
    if (gn < N) {
        u32x4 w;
        w.x = cvt_pk_bf16(tile[(kc + 0) * 65 + n], tile[(kc + 1) * 65 + n]); w.y = cvt_pk_bf16(tile[(kc + 2) * 65 + n], tile[(kc + 3) * 65 + n]);
        w.z = cvt_pk_bf16(tile[(kc + 4) * 65 + n], tile[(kc + 5) * 65 + n]); w.w = cvt_pk_bf16(tile[(kc + 6) * 65 + n], tile[(kc + 7) * 65 + n]);
        *(u32x4*)(Wt + (size_t)map(gn) * ldk + kt * 64 + kc) = w;
    }
}
template <class Map>
__device__ __forceinline__ void transpose_all(const float* W, int K, int N, bf16_t* Wt, int ldk, Map map, int& base) {
    const int nkt = K / 64, nnt = (N + 63) / 64, ntl = nkt * nnt;
    for (int it = blockIdx.x; it < base + ntl; it += gridDim.x) {
        if (it < base) continue;
        const int l = it - base;
        transpose_tile(W, K, N, Wt, ldk, l / nnt, l % nnt, map);
    }
    base += ntl;
}
template <class Map>
__device__ __forceinline__ void transpose_all_sub(const float* W, int K, int N, bf16_t* Wt, int ldk, Map map, int& base) {
    const int nkt = K / 64, nnt = (N + 63) / 64, ntl = nkt * nnt, nb = gridDim.x - 32, me = blockIdx.x - 32;
    int first = base - (base % nb) + me; if (first < base) first += nb;
    for (int it = first; it < base + ntl; it += nb) { const int l = it - base; transpose_tile(W, K, N, Wt, ldk, l / nnt, l % nnt, map); }
    base += ntl;
}
__device__ __forceinline__ int map_win(int n) {
    if (n < 1280) return n;
    if (n < 1304) return 4352 + (n - 1280);
    if (n < 2328) return 1280 + (n - 1304);
    return 2304 + (n - 2328);
}

__device__ __forceinline__ float row_rstd(const f32x4 (&v)[4]) {
    float s = 0.f;
#pragma unroll
    for (int k = 0; k < 4; ++k) s += v[k][0] * v[k][0] + v[k][1] * v[k][1] + v[k][2] * v[k][2] + v[k][3] * v[k][3];
    s = wave_sum(s);
    return rsqrtf(s * (1.0f / DM) + EPS);
}
__device__ __forceinline__ const float* xrow_ptr(const Params& p, int row) {
    return row < MP ? p.x_prompt + (size_t)row * DM : p.x_sample + (size_t)(row - MP) * DM;
}

__device__ __forceinline__ void phase_prologue(const Params& p) {
    const int wid = threadIdx.x >> 6, lane = threadIdx.x & 63;
    const int gw = blockIdx.x * 8 + wid, nw = gridDim.x * 8;
    auto do_transposes = [&]() {
    int base = 0;
    transpose_all(p.w_in, DM, IND, p.WinT, DM, [](int n) { return map_win(n); }, base);
    for (int kv = 0; kv < 2; ++kv) for (int j = 0; j < 2; ++j)
        transpose_all((kv ? p.w1_v : p.w1_k) + (size_t)j * 1024 * 128, 1024, 128, p.W1T + ((size_t)kv * 256 + j * 128) * 1024, 1024, [](int n) { return n; }, base);
    };
    do_transposes();
    __syncthreads();
    for (int i = blockIdx.x * 512 + threadIdx.x; i < (INP - IND) * DM / 8; i += gridDim.x * 512) ((u32x4*)(p.WinT + (size_t)IND * DM))[i] = (u32x4){0u, 0u, 0u, 0u};
    for (int row0 = gw * 2; row0 < MP + NS; row0 += nw * 2) {
        f32x4 v[2][4];
#pragma unroll
        for (int q = 0; q < 2; ++q) { const float* xr = xrow_ptr(p, row0 + q);
#pragma unroll
            for (int k = 0; k < 4; ++k) v[q][k] = *(const f32x4*)(xr + lane * 4 + k * 256); }
#pragma unroll
        for (int q = 0; q < 2; ++q) {
            const int row = row0 + q;
            u32x2* hd = (u32x2*)(p.H + (size_t)row * DM);
            const float r = row_rstd(v[q]);
#pragma unroll
            for (int k = 0; k < 4; ++k) { const f32x4 g = *(const f32x4*)(p.ln_mix_pre + lane * 4 + k * 256); const f32x4 o = v[q][k] * r * g; u32x2 w; w.x = cvt_pk_bf16(o[0], o[1]); w.y = cvt_pk_bf16(o[2], o[3]); hd[lane + k * 64] = w; }
            const float* pr = row < MP ? p.p_prompt + (size_t)row * PLE : p.p_sample + (size_t)(row - MP) * PLE;
            const f32x4 pv = *(const f32x4*)(pr + lane * 4);
            u32x2 w; w.x = cvt_pk_bf16(pv[0], pv[1]); w.y = cvt_pk_bf16(pv[2], pv[3]);
            ((u32x2*)(p.Pb + (size_t)row * PLE))[lane] = w;
        }
    }
    for (int i = blockIdx.x * 512 + threadIdx.x; i < 4 * 128 * 128; i += gridDim.x * 512) { const int t = (i >> 7) & 127, s = i & 127; p.GWb[i] = f2bf(s <= t ? p.gm_ws[i] : 0.f); }
    for (int i = blockIdx.x * 512 + threadIdx.x; i < 2 * 64 * 128; i += gridDim.x * 512) { const int kv = i >> 13, d = (i >> 7) & 63, h = i & 127; p.W2T[i] = f2bf((kv ? p.w2_v : p.w2_k)[h * 64 + d]); }
    if (gw < 256) {
        const int kv = gw >> 7, h = gw & 127;
        const float* pe = kv ? p.pe_v : p.pe_k; const float* w1 = kv ? p.w1_v : p.w1_k;
        float s = 0.f;
#pragma unroll 8
        for (int k = lane; k < 2048; k += 64) s += pe[k] * w1[(size_t)k * 128 + h];
        s = wave_sum(s);
        if (lane == 0) p.PEB[kv * 128 + h] = s;
    }
    for (int i = blockIdx.x * 512 + threadIdx.x; i < NS * (WIN - 1) * 64; i += gridDim.x * 512) {
        const int b = i / ((WIN - 1) * 64), r = i % ((WIN - 1) * 64);
        ((f32x4*)(p.out + O_WINS + (size_t)b * WIN * 256))[r] = ((const f32x4*)(p.state_win + (size_t)b * WIN * 256 + 256))[r];
    }
}

__device__ __forceinline__ void phase_deferred_transposes(const Params& p) {
    if (blockIdx.x < 32) return;
    int base = 0;
    transpose_all_sub(p.w_br_nsa, QD, DM, p.WnT, DM, [](int n) { return n; }, base);
    transpose_all_sub(p.w_br_gm, GMD, DM, p.WnT + QD, DM, [](int n) { return n; }, base);
    transpose_all_sub(p.w_out, DM, DM, p.WoT, DM, [](int n) { return n; }, base);
    transpose_all_sub(p.w_gate, DM, DFF, p.WguT, DM, [](int n) { return 2 * n; }, base);
    transpose_all_sub(p.w_up, DM, DFF, p.WguT, DM, [](int n) { return 2 * n + 1; }, base);
    transpose_all_sub(p.w_down, DFF, DM, p.WdT, DFF, [](int n) { return n; }, base);
    transpose_all_sub(p.w_ple_gate, DM, DM, p.WpgT, DM, [](int n) { return n; }, base);
    transpose_all_sub(p.w_ple, PLE, DM, p.WpT, PLE, [](int n) { return n; }, base);
    __syncthreads();
}
__device__ __forceinline__ void phase_gather(const Params& p) {
    int tid = threadIdx.x; asm volatile("" : "+v"(tid));
    const int wid = tid >> 6, lane = tid & 63;
    const int gw = (blockIdx.x >> 1) * 8 + wid, nw = (gridDim.x >> 1) * 8;
    const int cls = blockIdx.x & 1;
#pragma unroll 1
    for (int r8h = gw; r8h < NS * PAST / 16; r8h += nw) {
        const int r8 = r8h * 2 + cls;
        const int r = r8 * 8, b = r >> 14, pos = r & (PAST - 1), l5 = lane & 31, hrow = lane >> 5;
        const float* s = p.cache_cmp + ((size_t)p.page_table[b * NPG + (pos >> 7)] * PAGE + (pos & 127) + hrow) * 256 + l5 * 8;
        f32x4 a[4], cc[4];
#pragma unroll
        for (int k = 0; k < 4; ++k) { a[k] = *(const f32x4*)(s + (size_t)k * 512); cc[k] = *(const f32x4*)(s + (size_t)k * 512 + 4); }
#pragma unroll
        for (int k = 0; k < 4; ++k) {
            u32x4 w; w.x = cvt_pk_bf16(a[k][0], a[k][1]); w.y = cvt_pk_bf16(a[k][2], a[k][3]); w.z = cvt_pk_bf16(cc[k][0], cc[k][1]); w.w = cvt_pk_bf16(cc[k][2], cc[k][3]);
            *(u32x4*)(p.CMPb + ((size_t)MP + r + 2 * k + hrow) * 256 + l5 * 8) = w;
        }
    }
}

__device__ __forceinline__ void phase_cmp_final(const Params& p) {
    const int wid = threadIdx.x >> 6, lane = threadIdx.x & 63;
    {
        const int c = lane & 15, G = lane >> 4;
        const int ngrp_p = NB * 4 * 32, ngrp_s = NS * 4 * 64;
#pragma unroll 1
        for (int it = blockIdx.x * 8 + wid; it < ngrp_p + ngrp_s; it += gridDim.x * 8) {
            const bool smp = it >= ngrp_p; const int l = smp ? it - ngrp_p : it;
            const int nch = smp ? 64 : 32, nc = smp ? NCS : NCP;
            const int ch = l % nch, z = (l / nch) & 3, seq = l / (nch * 4), kv = z >> 1, g = z & 1, n0 = ch * 16;
            const size_t r0 = smp ? (size_t)2048 + (size_t)seq * 1024 : (size_t)seq * 512;
            const int nr = n0 + c < nc ? n0 + c : nc - 1;
            const bf16_t* p0 = (const bf16_t*)p.PART + ((r0 + nr) * 4 + z) * 256;
            const bf16_t* p1 = (const bf16_t*)p.PART + ((r0 + nr + 1) * 4 + z) * 256 + 128;
            const float* pb = p.PEB + kv * 128;
            f32x4 acc[4] = {{0.f, 0.f, 0.f, 0.f}, {0.f, 0.f, 0.f, 0.f}, {0.f, 0.f, 0.f, 0.f}, {0.f, 0.f, 0.f, 0.f}};
#pragma unroll
            for (int ks = 0; ks < 4; ++ks) {
                const int h0 = 32 * ks + 8 * G;
                const u32x4 wa = *(const u32x4*)(p0 + h0), wb = *(const u32x4*)(p1 + h0);
                const f32x4 a0 = {bflo(wa.x), bfhi(wa.x), bflo(wa.y), bfhi(wa.y)}, a1 = {bflo(wa.z), bfhi(wa.z), bflo(wa.w), bfhi(wa.w)};
                const f32x4 b0 = {bflo(wb.x), bfhi(wb.x), bflo(wb.y), bfhi(wb.y)}, b1 = {bflo(wb.z), bfhi(wb.z), bflo(wb.w), bfhi(wb.w)};
                const f32x4 e0 = *(const f32x4*)(pb + h0), e1 = *(const f32x4*)(pb + h0 + 4);
                f32x4 x0 = a0 + b0 + e0, x1 = a1 + b1 + e1;
#pragma unroll
                for (int i = 0; i < 4; ++i) { x0[i] = siluf_(x0[i]); x1[i] = siluf_(x1[i]); }
                const bf16x8 A = pack_p(x0, x1);
#pragma unroll
                for (int nt = 0; nt < 4; ++nt) {
                    const bf16x8 B = *(const bf16x8*)(p.W2T + ((size_t)kv * 64 + nt * 16 + c) * 128 + h0);
                    acc[nt] = mfma16(A, B, acc[nt]);
                }
            }
#pragma unroll
            for (int nt = 0; nt < 4; ++nt) {
                const int d = nt * 16 + c;
#pragma unroll
                for (int i = 0; i < 4; ++i) {
                    const int n = n0 + 4 * G + i;
                    if (n < nc) {
                        if (smp) ((kv ? p.VCS : p.KCS) + (((size_t)seq * NG + g) * 1024 + n) * 64)[d] = acc[nt][i];
                        else if (kv == 0) p.KCb[((size_t)seq * NG + g) * 512 * 64 + kfrag_off(n, d)] = f2bf(acc[nt][i]);
                    }
                }
                if (!smp && kv == 1) {
                    f32x4 v = acc[nt];
#pragma unroll
                    for (int i = 0; i < 4; ++i) if (n0 + 4 * G + i >= nc) v[i] = 0.f;
                    st_bf16x4(p.VCT + ((size_t)seq * NG + g) * 512 * 64 + vfrag_off(n0 + 4 * G, d), v);
                }
            }
        }
    }
}

template <bool SAMPLE>
__device__ __forceinline__ void kv_row_ptr(const Params& p, int branch  , int b, int pos, int kv, int g, const bf16_t*& pb, const float*& pf) {
    const int off = kv * 128 + g * 64;
    if (!SAMPLE) { pf = nullptr; pb = (branch == 1 ? p.SLCb : p.WINb) + ((size_t)b * SEQ + pos) * 256 + off; }
    else if (pos >= PAST) { pf = nullptr; pb = (branch == 1 ? p.SLCb : p.WINb) + ((size_t)MP + b) * 256 + off; }
    else if (branch == 1) { pb = nullptr; pf = p.cache_slc + ((size_t)p.page_table[b * NPG + (pos >> 7)] * PAGE + (pos & 127)) * 256 + off; }
    else { pb = nullptr; pf = p.state_win + ((size_t)b * WIN + (pos - (PAST - WIN))) * 256 + off; }
}
__device__ __forceinline__ void dot4x64(const bf16_t* pb, const float* pf, const LAS float* qs_, float (&s)[4]) {
    s[0] = s[1] = s[2] = s[3] = 0.f;
    const LAS float* qs = qs_; asm volatile("" : "+v"(qs));
    if (pf) {
#pragma unroll 8
        for (int c = 0; c < 16; ++c) {
            const f32x4 kx = *(const f32x4*)(pf + c * 4);
#pragma unroll
            for (int h = 0; h < 4; ++h) { const f32x4 q = *(const LAS f32x4*)(qs + h * 64 + c * 4); s[h] += q[0] * kx[0] + q[1] * kx[1] + q[2] * kx[2] + q[3] * kx[3]; }
        }
    } else {
#pragma unroll 2
        for (int c = 0; c < 8; ++c) {
            const u32x4 w = *(const u32x4*)(pb + c * 8);
            const float k0 = bflo(w.x), k1 = bfhi(w.x), k2 = bflo(w.y), k3 = bfhi(w.y), k4 = bflo(w.z), k5 = bfhi(w.z), k6 = bflo(w.w), k7 = bfhi(w.w);
#pragma unroll
            for (int h = 0; h < 4; ++h) {
                const f32x4 qa = *(const LAS f32x4*)(qs + h * 64 + c * 8), qb = *(const LAS f32x4*)(qs + h * 64 + c * 8 + 4);
                s[h] += qa[0] * k0 + qa[1] * k1 + qa[2] * k2 + qa[3] * k3 + qb[0] * k4 + qb[1] * k5 + qb[2] * k6 + qb[3] * k7;
            }
        }
    }
}
template <bool SAMPLE>
__device__ __forceinline__ void attn_chunk(const Params& p, int branch, int b, int g, int t, int pos0, int lo, int hi,
                                           float (&m)[4], float (&l)[4], float (&o)[4], const LAS float* qs, LAS float* pbk, const LAS float* relb, int lane) {
    const int pos = pos0 + lane;
    const bool valid = pos >= lo && pos <= hi;
    float s[4] = {-1e30f, -1e30f, -1e30f, -1e30f};
    if (valid) {
        const bf16_t* pb; const float* pf; kv_row_ptr<SAMPLE>(p, branch, b, pos, 0, g, pb, pf);
        dot4x64(pb, pf, qs, s);
        const int bk = t5_bucket(t - pos);
#pragma unroll
        for (int h = 0; h < 4; ++h) s[h] += relb[bk * 8 + g * 4 + h];
    }
#pragma unroll
    for (int h = 0; h < 4; ++h) {
        const float mx = wave_max(s[h]);
        const float mn = fmaxf(m[h], mx);
        const float pr = valid ? ex2(s[h] - mn) : 0.f;
        const float sm = wave_sum(pr);
        const float al = ex2(m[h] - mn);
        l[h] = l[h] * al + sm; o[h] *= al; m[h] = mn;
        pbk[h * 64 + lane] = pr;
    }
    __builtin_amdgcn_wave_barrier();
    const int k0 = (lo > pos0 ? lo : pos0) - pos0, k1 = (hi < pos0 + 63 ? hi : pos0 + 63) - pos0;
    if (SAMPLE) {
        const int kend = (PAST - 1 - pos0) < k1 ? (PAST - 1 - pos0) : k1;
        if (kend >= k0) {
            const bf16_t* pb; const float* pf; kv_row_ptr<SAMPLE>(p, branch, b, pos0 + k0, 1, g, pb, pf);
            pf += lane;
#pragma unroll 16
            for (int k = k0; k <= kend; ++k) {
                const float v = pf[(size_t)(k - k0) * 256];
#pragma unroll
                for (int h = 0; h < 4; ++h) o[h] += pbk[h * 64 + k] * v;
            }
        }
        if (k1 > kend) {
            const bf16_t* pb; const float* pf; kv_row_ptr<SAMPLE>(p, branch, b, pos0 + k1, 1, g, pb, pf);
            const float v = bf2f(pb[lane]);
#pragma unroll
            for (int h = 0; h < 4; ++h) o[h] += pbk[h * 64 + k1] * v;
        }
    } else {
#pragma unroll 1
    for (int k = k0; k <= k1; ++k) {
        const bf16_t* pb; const float* pf; kv_row_ptr<SAMPLE>(p, branch, b, pos0 + k, 1, g, pb, pf);
        const float v = pf ? pf[lane] : bf2f(pb[lane]);
#pragma unroll
        for (int h = 0; h < 4; ++h) o[h] += pbk[h * 64 + k] * v;
    }
    }
    __builtin_amdgcn_wave_barrier();
}

constexpr int S_QS = 0, S_SC = 1024, S_PHS = S_SC + 4 * 1024 * 4, S_PBK = S_PHS + 1088 * 4, S_PART = S_PBK + 8 * 1024, S_RED = S_PART + 2 * 8 * 272 * 4, S_OCP = S_RED + 512,
              S_SEL = S_OCP + 2048, S_RELB = S_SEL + 64, ATTS_LDS = S_RELB + 1024;
__device__ __forceinline__ void attn_sample_item(const Params& p, int b, int g) {
    const int tid = threadIdx.x, wid = tid >> 6, lane = tid & 63;
    constexpr int t = PAST, NC = NCS, NSEL = 257, NJR = 5, qblk = PAST >> 6;
    const int row = MP + b;
    LAS unsigned char* L = (LAS unsigned char*)smem;
    LAS float* qs = (LAS float*)(L + S_QS); LAS float* sc = (LAS float*)(L + S_SC); LAS float* phs = (LAS float*)(L + S_PHS); LAS float* pbk = (LAS float*)(L + S_PBK) + wid * 256;
    LAS float* part = (LAS float*)(L + S_PART); LAS float* red = (LAS float*)(L + S_RED); LAS float* ocp = (LAS float*)(L + S_OCP); LAS int* sel = (LAS int*)(L + S_SEL);
    LAS float* relb = (LAS float*)(L + S_RELB);
    __syncthreads();
    if (tid < 256) { relb[tid] = p.rel_bias[tid] * LOG2E; qs[tid] = bf2f(p.Qb[(size_t)row * QD + g * 256 + tid]); }
    __syncthreads();
    const float* kc = p.KCS + ((size_t)b * NG + g) * 1024 * 64;
    const float* vc = p.VCS + ((size_t)b * NG + g) * 1024 * 64;
    {
        float mx[4] = {-1e30f, -1e30f, -1e30f, -1e30f};
#pragma unroll 1
        for (int r = wid; r < 16; r += 8) {
            const int n = r * 64 + lane;
            float s[4] = {-1e30f, -1e30f, -1e30f, -1e30f};
            if (n < NC) {
                dot4x64(nullptr, kc + (size_t)n * 64, qs, s);
                const int bk = t5_bucket(t - (16 * n + 31));
#pragma unroll
                for (int h = 0; h < 4; ++h) s[h] += relb[bk * 8 + g * 4 + h];
            }
#pragma unroll
            for (int h = 0; h < 4; ++h) { sc[h * 1024 + n] = s[h]; mx[h] = fmaxf(mx[h], s[h]); }
        }
#pragma unroll
        for (int h = 0; h < 4; ++h) { const float m = wave_max(mx[h]); if (lane == 0) red[wid * 4 + h] = m; }
    }
    __syncthreads();
    float gmx[4], inv[4];
#pragma unroll
    for (int h = 0; h < 4; ++h) { float m = red[h]; for (int w = 1; w < 8; ++w) m = fmaxf(m, red[w * 4 + h]); gmx[h] = m; }
    {
        float sum[4] = {0.f, 0.f, 0.f, 0.f};
#pragma unroll
        for (int k = 0; k < 2; ++k) { const int n = tid + 512 * k;
#pragma unroll
            for (int h = 0; h < 4; ++h) { const float e = n < NC ? ex2(sc[h * 1024 + n] - gmx[h]) : 0.f; sc[h * 1024 + n] = e; sum[h] += e; } }
#pragma unroll
        for (int h = 0; h < 4; ++h) { const float s = wave_sum(sum[h]); if (lane == 0) red[32 + wid * 4 + h] = s; }
    }
    __syncthreads();
#pragma unroll
    for (int h = 0; h < 4; ++h) { float s = 0.f; for (int w = 0; w < 8; ++w) s += red[32 + w * 4 + h]; inv[h] = s > 0.f ? 1.0f / s : 0.f; }
    for (int n = tid; n < 1088; n += 512) phs[n] = n < NC ? (sc[n] * inv[0] + sc[1024 + n] * inv[1]) + (sc[2048 + n] * inv[2] + sc[3072 + n] * inv[3]) : 0.f;
    {
        float a[4] = {0.f, 0.f, 0.f, 0.f};
#pragma unroll 16
        for (int n = wid; n < NC; n += 8) {
            const float v = vc[(size_t)n * 64 + lane];
#pragma unroll
            for (int h = 0; h < 4; ++h) a[h] += sc[h * 1024 + n] * v;
        }
#pragma unroll
        for (int h = 0; h < 4; ++h) part[(wid * 4 + h) * 68 + lane] = a[h] * inv[h];
    }
    __syncthreads();
    if (tid < 256) { float a = 0.f; for (int w = 0; w < 8; ++w) a += part[(w * 4 + (tid >> 6)) * 68 + (tid & 63)]; ocp[tid] = a; }
    __syncthreads();
    if (wid == 0) {
        unsigned long long key[NJR];
#pragma unroll
        for (int jr = 0; jr < NJR; ++jr) {
            const int j = jr * 64 + lane;
            key[jr] = 0ull;
            if (j >= 1 && j <= qblk - 2 && j < NSEL) {
                float im = 0.f;
#pragma unroll
                for (int n = 4 * j - 1; n <= 4 * j + 3; ++n) im += (n < NC) ? phs[n] : 0.f;
                key[jr] = ((unsigned long long)__float_as_uint(im) << 32) | (unsigned)(0xFFFF - j) | 0x10000ull;
            }
        }
        if (lane == 0) { sel[0] = 0; sel[1] = qblk - 1; sel[2] = qblk; }
#pragma unroll 1
        for (int it = 0; it < 13; ++it) {
            unsigned long long best = 0ull;
#pragma unroll
            for (int jr = 0; jr < NJR; ++jr) best = key[jr] > best ? key[jr] : best;
#pragma unroll
            for (int o = 32; o > 0; o >>= 1) { const unsigned long long ot = __shfl_xor(best, o); best = ot > best ? ot : best; }
            const int j = 0xFFFF - (int)(best & 0xFFFFull);
#pragma unroll
            for (int jr = 0; jr < NJR; ++jr) if (key[jr] == best) key[jr] = 0ull;
            if (lane == 0) sel[3 + it] = j;
        }
    }
    __syncthreads();
    {
        float ms[4] = {-1e30f, -1e30f, -1e30f, -1e30f}, ls[4] = {0.f, 0.f, 0.f, 0.f}, os[4] = {0.f, 0.f, 0.f, 0.f};
#pragma unroll 1
        for (int i = wid; i < 16; i += 8) attn_chunk<true>(p, 1, b, g, t, sel[i] * 64, 0, t, ms, ls, os, qs, pbk, relb, lane);
        float mw[4] = {-1e30f, -1e30f, -1e30f, -1e30f}, lw[4] = {0.f, 0.f, 0.f, 0.f}, ow[4] = {0.f, 0.f, 0.f, 0.f};
#pragma unroll 1
        for (int c = wid; c < 9; c += 8) attn_chunk<true>(p, 2, b, g, t, t - 63 - 64 * c, t - WIN, t, mw, lw, ow, qs, pbk, relb, lane);
#pragma unroll
        for (int h = 0; h < 4; ++h) {
            LAS float* ps = part + (wid * 4 + h) * 68; LAS float* pw = part + 8 * 272 + (wid * 4 + h) * 68;
            ps[lane] = os[h]; pw[lane] = ow[h];
            if (lane == 0) { ps[64] = ms[h]; ps[65] = ls[h]; pw[64] = mw[h]; pw[65] = lw[h]; }
        }
    }
    __syncthreads();
    if (tid < 256) {
        const int h = tid >> 6, d = tid & 63;
        float res[2];
#pragma unroll
        for (int br = 0; br < 2; ++br) {
            const LAS float* pp = part + br * 8 * 272 + h * 68;
            float m = -1e30f;
            for (int w = 0; w < 8; ++w) m = fmaxf(m, pp[w * 272 + 64]);
            float l = 0.f, o = 0.f;
            for (int w = 0; w < 8; ++w) { const float sc_ = ex2(pp[w * 272 + 64] - m); l += pp[w * 272 + 65] * sc_; o += pp[w * 272 + d] * sc_; }
            res[br] = o / l;
        }
        const float* gt = p.GATE + (size_t)row * 32 + (g * 4 + h) * 3;
        const float v = gt[0] * ocp[tid] + gt[1] * res[0] + gt[2] * res[1];
        p.OCAT[(size_t)row * DM + (g * 4 + h) * 64 + d] = f2bf(v);
    }
    __syncthreads();
}

constexpr int A_OST = 0, OST_LD = 68, A_LST = A_OST + 256 * OST_LD * 4, A_M0 = A_LST + 1024, A_MB = A_M0 + 1024, MB_LD = 132, A_MKN = A_MB + 64 * MB_LD,
              A_LIST = A_MKN + 256, A_CNT = A_LIST + 132 * 64, A_PK = A_CNT + 544, A_KN = A_PK + 400 * 4, A_T2 = A_KN + 512, A_NP = A_T2 + 132 * 8 * 4, A_QT = A_NP + 16, ATT2_LDS = A_QT + 64 * 512;
static_assert(ATT2_LDS <= GEMM_LDS && ATTS_LDS <= GEMM_LDS, "attention LDS");

__device__ __forceinline__ void qk64(const bf16_t* kb, int c, int G, const bf16x8 (&qB)[2], f32x4 (&s)[4]) {
#pragma unroll
    for (int kt = 0; kt < 4; ++kt) {
        const bf16_t* r = kb + (size_t)(16 * kt + c) * 256 + G * 8;
        const bf16x8 a0 = *(const bf16x8*)r, a1 = *(const bf16x8*)(r + 32);
        s[kt] = mfma16(a0, qB[0], (f32x4){0.f, 0.f, 0.f, 0.f}); s[kt] = mfma16(a1, qB[1], s[kt]);
    }
}
__device__ __forceinline__ void pv64(const bf16_t* vf, int key0, int lane, const f32x4 (&pr)[4], f32x4 (&o)[4]) {
#pragma unroll
    for (int ks = 0; ks < 2; ++ks) {
        const bf16x8 pB = pack_p(pr[2 * ks], pr[2 * ks + 1]);
#pragma unroll
        for (int dt = 0; dt < 4; ++dt) {
            const bf16x8 vA = *(const bf16x8*)(vf + ((size_t)(((key0 >> 5) + ks) * 4 + dt) * 64 + lane) * 8);
            o[dt] = mfma16(vA, pB, o[dt]);
        }
    }
}
__device__ __forceinline__ int qt_off(int qi, int hh, int k) { return (qi * 4 + hh) * 128 + ((k ^ (((qi & 3) << 1) | (hh >> 1))) << 4); }
__device__ __forceinline__ float grp_max(float v) {
    auto r = __builtin_amdgcn_permlane16_swap(__float_as_uint(v), __float_as_uint(v), false, false); v = fmaxf(__uint_as_float(r[0]), __uint_as_float(r[1]));
    r = __builtin_amdgcn_permlane32_swap(__float_as_uint(v), __float_as_uint(v), false, false); return fmaxf(__uint_as_float(r[0]), __uint_as_float(r[1]));
}
__device__ __forceinline__ float grp_sum(float v) {
    auto r = __builtin_amdgcn_permlane16_swap(__float_as_uint(v), __float_as_uint(v), false, false); v = __uint_as_float(r[0]) + __uint_as_float(r[1]);
    r = __builtin_amdgcn_permlane32_swap(__float_as_uint(v), __float_as_uint(v), false, false); return __uint_as_float(r[0]) + __uint_as_float(r[1]);
}
__device__ __forceinline__ int grp_min_i(int v) {
    auto r = __builtin_amdgcn_permlane16_swap((unsigned)v, (unsigned)v, false, false); v = (int)r[0] < (int)r[1] ? (int)r[0] : (int)r[1];
    r = __builtin_amdgcn_permlane32_swap((unsigned)v, (unsigned)v, false, false); return (int)r[0] < (int)r[1] ? (int)r[0] : (int)r[1];
}
__device__ __forceinline__ float dpp_x1(float v) { return __uint_as_float(__builtin_amdgcn_mov_dpp(__float_as_uint(v), 0xB1, 0xF, 0xF, true)); }
__device__ __forceinline__ float dpp_x2(float v) { return __uint_as_float(__builtin_amdgcn_mov_dpp(__float_as_uint(v), 0x4E, 0xF, 0xF, true)); }
__device__ __forceinline__ int dpp_x1i(int v) { return (int)__builtin_amdgcn_mov_dpp((unsigned)v, 0xB1, 0xF, 0xF, true); }
__device__ __forceinline__ int dpp_x2i(int v) { return (int)__builtin_amdgcn_mov_dpp((unsigned)v, 0x4E, 0xF, 0xF, true); }
__device__ __forceinline__ unsigned row_or_q(unsigned u) {
    u |= __builtin_amdgcn_mov_dpp(u, 0x124, 0xF, 0xF, true); u |= __builtin_amdgcn_mov_dpp(u, 0x128, 0xF, 0xF, true); return u;
}

__device__ __forceinline__ void attn_cmp(const Params& p, int b, int g, int t0, int lane_, LAS unsigned char* L, unsigned (&msk)[4]) {
    f32x4 oacc[4];
    int lane = lane_; asm volatile("" : "+v"(lane));
    const int c = lane & 15, G = lane >> 4, qs = c >> 2, hh = c & 3;
    const int qb = t0 >> 6, tc = t0 + qs;
    const size_t qrow = (size_t)b * SEQ + tc;
    const LAS float* T2 = (const LAS float*)(L + A_T2);
    const float b31 = T2[128 * 8 + g * 4 + hh];
    bf16x8 qB[2];
    qB[0] = *(const bf16x8*)(p.Qb + qrow * QD + (g * 4 + hh) * 64 + G * 8); qB[1] = *(const bf16x8*)(p.Qb + qrow * QD + (g * 4 + hh) * 64 + 32 + G * 8);
    const float* gate = p.GATE + qrow * 32 + (g * 4 + hh) * 3;
    msk[0] = msk[1] = msk[2] = msk[3] = 0u;
    {
        const int ncv_c = tc >= 31 ? ((tc - 31) >> 4) + 1 : 0;
        const int ncv_m = t0 + 3 >= 31 ? ((t0 + 3 - 31) >> 4) + 1 : 0;
        const int NT = (ncv_m + 15) >> 4;
        const int mt_far = t0 >= 399 ? (t0 - 399) / 256 + 1 : 0;
        const bf16_t* kcb = p.KCb + (size_t)(b * NG + g) * 512 * 64;
        f32x4 sc[32];
        float mxf = -1e30f, mxn = -1e30f;
        bf16x8 kbuf[2][4][2];
        auto ldkg = [&](int grp, bf16x8 (&kb)[4][2]) __attribute__((always_inline)) {
#pragma unroll
            for (int q = 0; q < 4; ++q) { const bf16_t* r = kcb + ((size_t)((grp * 4 + q) * 2) * 64 + lane) * 8; kb[q][0] = *(const bf16x8*)r; kb[q][1] = *(const bf16x8*)(r + 512); }
        };
        ldkg(0, kbuf[0]);
#pragma unroll
        for (int grp = 0; grp < 8; ++grp) {
            if (4 * grp < NT) {
                if (4 * (grp + 1) < NT) ldkg(grp + 1, kbuf[(grp + 1) & 1]);
                __builtin_amdgcn_sched_barrier(0);
#pragma unroll
                for (int q = 0; q < 4; ++q) {
                    const int mt = grp * 4 + q;
                    f32x4 s = mfma16(kbuf[grp & 1][q][0], qB[0], (f32x4){0.f, 0.f, 0.f, 0.f}); s = mfma16(kbuf[grp & 1][q][1], qB[1], s);
                    if (mt < mt_far) { mxf = fmaxf(mxf, fmaxf(fmaxf(s[0], s[1]), fmaxf(s[2], s[3]))); }
                    else {
#pragma unroll
                        for (int i = 0; i < 4; ++i) { const int n = 16 * mt + 4 * G + i; int dist = tc - (16 * n + 31); const bool ok = n < ncv_c; dist = dist < 0 ? 0 : (dist > 128 ? 128 : dist);
                            s[i] = ok ? s[i] + T2[dist * 8 + g * 4 + hh] : -1e30f; }
                        mxn = fmaxf(mxn, fmaxf(fmaxf(s[0], s[1]), fmaxf(s[2], s[3])));
                    }
                    sc[mt] = s;
                }
            } else {
#pragma unroll
                for (int q = 0; q < 4; ++q) sc[grp * 4 + q] = (f32x4){0.f, 0.f, 0.f, 0.f};
            }
        }
        const float mx = grp_max(fmaxf(mxf + b31, mxn));
        const float shf = mx - b31;
#pragma unroll
        for (int mt = 0; mt < 32; ++mt) if ((mt & ~3) < NT) {
            const float sh = mt < mt_far ? shf : mx;
#pragma unroll
            for (int i = 0; i < 4; ++i) sc[mt][i] = ex2(sc[mt][i] - sh);
        }
        const bf16_t* vct = p.VCT + (size_t)(b * NG + g) * 64 * 512;
        const bf16x8 ones = __builtin_bit_cast(bf16x8, (u32x4){0x3F803F80u, 0x3F803F80u, 0x3F803F80u, 0x3F803F80u});
        f32x4 oc[4] = {{0.f, 0.f, 0.f, 0.f}, {0.f, 0.f, 0.f, 0.f}, {0.f, 0.f, 0.f, 0.f}, {0.f, 0.f, 0.f, 0.f}};
        f32x4 rs = {0.f, 0.f, 0.f, 0.f};
        bf16x8 vbuf[2][2][4];
        auto ldvg = [&](int grp, bf16x8 (&vb)[2][4]) __attribute__((always_inline)) {
#pragma unroll
            for (int q = 0; q < 2; ++q)
#pragma unroll
                for (int dt = 0; dt < 4; ++dt) vb[q][dt] = *(const bf16x8*)(vct + ((size_t)((grp * 2 + q) * 4 + dt) * 64 + lane) * 8);
        };
        ldvg(0, vbuf[0]);
#pragma unroll
        for (int grp = 0; grp < 8; ++grp) if (4 * grp < NT) {
            if (4 * (grp + 1) < NT) ldvg(grp + 1, vbuf[(grp + 1) & 1]);
            __builtin_amdgcn_sched_barrier(0);
#pragma unroll
            for (int q = 0; q < 2; ++q) {
                const int k2 = grp * 2 + q;
                const bf16x8 pB = pack_p(sc[2 * k2], sc[2 * k2 + 1]);
                rs = mfma16(ones, pB, rs);
#pragma unroll
                for (int dt = 0; dt < 4; ++dt) oc[dt] = mfma16(vbuf[grp & 1][q][dt], pB, oc[dt]);
            }
        }
        const float inv = ncv_c > 0 ? 1.0f / rs[0] : 0.f;
        if (qb <= 15) {
            msk[0] = (qb >= 31) ? 0xffffffffu : ((2u << qb) - 1u);
        } else {
            unsigned cand[8];
#pragma unroll
            for (int k = 0; k < 8; ++k) cand[k] = 0u;
            float prevB = 0.f;
#pragma unroll
            for (int mt = 0; mt < 32; ++mt) if (mt < NT) {
                const unsigned x3 = __float_as_uint(sc[mt][3]);
                const auto p16 = __builtin_amdgcn_permlane16_swap(x3, x3, false, false);
                const auto p32 = __builtin_amdgcn_permlane32_swap(p16[1], p16[1], false, false);
                const float r1 = G == 2 ? __uint_as_float(p32[0]) : __uint_as_float(p16[0]);
                float v = ((sc[mt][0] + sc[mt][1]) + (sc[mt][2] + sc[mt][3]) + (G == 0 ? prevB : r1)) * inv;
                prevB = __uint_as_float(p32[1]);
                v += dpp_x1(v); v += dpp_x2(v);
                const int j = 4 * mt + G;
                if ((mt & 3) == hh) cand[mt >> 2] = (j >= 1 && j <= qb - 2) ? ((__float_as_uint(v) & ~127u) | (unsigned)(127 - j)) : 0u;
            }
            auto setbit = [&](int j) { const unsigned bit = 1u << (j & 31); const int w = j >> 5; msk[0] |= w == 0 ? bit : 0u; msk[1] |= w == 1 ? bit : 0u; msk[2] |= w == 2 ? bit : 0u; msk[3] |= w == 3 ? bit : 0u; };
            setbit(0); setbit(qb); setbit(qb - 1);
#pragma unroll 1
            for (int it = 0; it < 13; ++it) {
                unsigned bv = cand[0];
#pragma unroll
                for (int k = 1; k < 8; ++k) bv = bv > cand[k] ? bv : cand[k];
                { unsigned o = __builtin_amdgcn_mov_dpp(bv, 0xB1, 0xF, 0xF, true); bv = o > bv ? o : bv; o = __builtin_amdgcn_mov_dpp(bv, 0x4E, 0xF, 0xF, true); bv = o > bv ? o : bv;
                  auto r = __builtin_amdgcn_permlane16_swap(bv, bv, false, false); bv = r[0] > r[1] ? r[0] : r[1]; r = __builtin_amdgcn_permlane32_swap(bv, bv, false, false); bv = r[0] > r[1] ? r[0] : r[1]; }
#pragma unroll
                for (int k = 0; k < 8; ++k) cand[k] = cand[k] == bv ? 0u : cand[k];
                setbit(127 - (int)(bv & 127u));
            }
        }
        const float g0 = gate[0] * inv;
#pragma unroll
        for (int dt = 0; dt < 4; ++dt) oacc[dt] = oc[dt] * g0;
    }
    bf16_t* orow = p.OCAT + qrow * DM + (g * 4 + hh) * 64 + 4 * G;
#pragma unroll
    for (int dt = 0; dt < 4; ++dt) st_bf16x4(orow + dt * 16, oacc[dt]);
}

struct PackSt { bf16x8 q0, q1; float m; f32x4 l4; f32x4 o[4]; };
__device__ __forceinline__ void attn_selwin_pair(const Params& p, int b, int g, int t0, int lane_, LAS unsigned char* L, const unsigned (&mskA)[4], const unsigned (&mskB)[4]) {
    int lane = lane_; asm volatile("" : "+v"(lane));
    const int c = lane & 15, G = lane >> 4, qs = c >> 2, hh = c & 3;
    const int qb = t0 >> 6;
    const LAS float* T2 = (const LAS float*)(L + A_T2);
    const float b31 = T2[128 * 8 + g * 4 + hh];
    const int tcA = t0 + qs, tcB = t0 + 4 + qs;
    const size_t qrowA = (size_t)b * SEQ + tcA;
    PackSt A, B;
    {
        const bf16_t* qa = p.Qb + qrowA * QD + (g * 4 + hh) * 64 + G * 8;
        A.q0 = *(const bf16x8*)qa; A.q1 = *(const bf16x8*)(qa + 32); B.q0 = *(const bf16x8*)(qa + 4 * QD); B.q1 = *(const bf16x8*)(qa + 4 * QD + 32);
    }
    auto reset = [&](PackSt& S) __attribute__((always_inline)) { S.m = -1e30f; S.l4 = (f32x4){0.f, 0.f, 0.f, 0.f};
#pragma unroll
        for (int dt = 0; dt < 4; ++dt) S.o[dt] = (f32x4){0.f, 0.f, 0.f, 0.f}; };
    const bf16x8 ones = __builtin_bit_cast(bf16x8, (u32x4){0x3F803F80u, 0x3F803F80u, 0x3F803F80u, 0x3F803F80u});
    auto finish = [&](PackSt& S, f32x4 (&s)[4], float cb, bool mine, const bf16x8 (&vf)[2][4]) __attribute__((always_inline)) {
        float cm = fmaxf(fmaxf(fmaxf(s[0][0], s[0][1]), fmaxf(s[0][2], s[0][3])), fmaxf(fmaxf(s[1][0], s[1][1]), fmaxf(s[1][2], s[1][3])));
        cm = fmaxf(cm, fmaxf(fmaxf(fmaxf(s[2][0], s[2][1]), fmaxf(s[2][2], s[2][3])), fmaxf(fmaxf(s[3][0], s[3][1]), fmaxf(s[3][2], s[3][3]))));
        cm = grp_max(mine ? cm + cb : -1e30f);
        const float mn = fmaxf(S.m, cm), al = ex2(S.m - mn);
        const float sh = (mine ? mn : 1e30f) - cb;
#pragma unroll
        for (int kt = 0; kt < 4; ++kt)
#pragma unroll
            for (int i = 0; i < 4; ++i) s[kt][i] = ex2(s[kt][i] - sh);
        S.m = mn;
        f32x4 rs = {0.f, 0.f, 0.f, 0.f};
#pragma unroll
        for (int dt = 0; dt < 4; ++dt) S.o[dt] = S.o[dt] * al;
#pragma unroll
        for (int ks = 0; ks < 2; ++ks) { const bf16x8 pB = pack_p(s[2 * ks], s[2 * ks + 1]);
            rs = mfma16(ones, pB, rs);
#pragma unroll
            for (int dt = 0; dt < 4; ++dt) S.o[dt] = mfma16(vf[ks][dt], pB, S.o[dt]); }
        S.l4[0] = S.l4[0] * al + rs[0];
    };
    auto addout = [&](PackSt& S, size_t qrow, int br) __attribute__((always_inline)) {
        const float gs = p.GATE[qrow * 32 + (g * 4 + hh) * 3 + br] / S.l4[0];
        bf16_t* orow = p.OCAT + qrow * DM + (g * 4 + hh) * 64 + 4 * G;
#pragma unroll
        for (int dt = 0; dt < 4; ++dt) { const u32x2 w = *(const u32x2*)(orow + dt * 16); f32x4 pa; pa[0] = bflo(w.x); pa[1] = bfhi(w.x); pa[2] = bflo(w.y); pa[3] = bfhi(w.y);
            st_bf16x4(orow + dt * 16, pa + S.o[dt] * gs); }
    };
    {
        unsigned umA[4], umB[4], um[4];
#pragma unroll
        for (int w = 0; w < 4; ++w) {
            umA[w] = __builtin_amdgcn_readfirstlane(row_or_q(mskA[w]));
            umB[w] = __builtin_amdgcn_readfirstlane(row_or_q(mskB[w]));
            um[w] = umA[w] | umB[w];
        }
        reset(A); reset(B);
        const bf16_t* klane = p.SLCkF + (size_t)(b * NG + g) * SEQ * 64 + lane * 8;
        const bf16_t* vlane = p.SLCvT + (size_t)(b * NG + g) * SEQ * 64 + lane * 8;
        auto ldfr = [&](int j_, bf16x8 (&kf_)[4][2], bf16x8 (&vf_)[2][4]) __attribute__((always_inline)) {
            const bf16_t* kr = klane + (size_t)j_ * 4096; const bf16_t* vr = vlane + (size_t)j_ * 4096;
#pragma unroll
            for (int kt = 0; kt < 4; ++kt) { kf_[kt][0] = *(const bf16x8*)(kr + (kt * 2) * 512); kf_[kt][1] = *(const bf16x8*)(kr + (kt * 2 + 1) * 512); }
#pragma unroll
            for (int ks = 0; ks < 2; ++ks)
#pragma unroll
                for (int dt = 0; dt < 4; ++dt) vf_[ks][dt] = *(const bf16x8*)(vr + (ks * 4 + dt) * 512);
        };
        auto nextj = [&](int& j_) __attribute__((always_inline)) {
            int w = um[0] ? 0 : um[1] ? 1 : um[2] ? 2 : um[3] ? 3 : -1;
            if (w < 0) return false;
            const unsigned u = w == 0 ? um[0] : w == 1 ? um[1] : w == 2 ? um[2] : um[3];
            const int bpos = __builtin_ctz(u);
            j_ = w * 32 + bpos;
            const unsigned cl = ~(1u << bpos);
            if (w == 0) um[0] &= cl; else if (w == 1) um[1] &= cl; else if (w == 2) um[2] &= cl; else um[3] &= cl;
            return true;
        };
        auto packstep = [&](PackSt& S, const unsigned (&msk)[4], int tc, int j, const bf16x8 (&kf)[4][2], const bf16x8 (&vf)[2][4]) __attribute__((always_inline)) {
            const unsigned mw = (j >> 5) == 0 ? msk[0] : (j >> 5) == 1 ? msk[1] : (j >> 5) == 2 ? msk[2] : msk[3];
            const bool mine = (mw >> (j & 31)) & 1u;
            const bool farb = j <= qb - 3;
            f32x4 s[4];
#pragma unroll
            for (int kt = 0; kt < 4; ++kt) { s[kt] = mfma16(kf[kt][0], S.q0, (f32x4){0.f, 0.f, 0.f, 0.f}); s[kt] = mfma16(kf[kt][1], S.q1, s[kt]); }
            if (!farb) {
#pragma unroll
                for (int kt = 0; kt < 4; ++kt)
#pragma unroll
                    for (int i = 0; i < 4; ++i) { const int dist = tc - (j * 64 + 16 * kt + 4 * G + i); const int dd = dist < 0 ? 0 : (dist > 128 ? 128 : dist);
                        s[kt][i] = dist >= 0 ? s[kt][i] + T2[dd * 8 + g * 4 + hh] : -1e30f; }
            }
            finish(S, s, farb ? b31 : 0.f, mine, vf);
        };
        auto blockstep = [&](int j, const bf16x8 (&kf)[4][2], const bf16x8 (&vf)[2][4]) __attribute__((always_inline)) {
            const int w = j >> 5; const unsigned bit = 1u << (j & 31);
            const unsigned ua = w == 0 ? umA[0] : w == 1 ? umA[1] : w == 2 ? umA[2] : umA[3];
            const unsigned ub = w == 0 ? umB[0] : w == 1 ? umB[1] : w == 2 ? umB[2] : umB[3];
            if (ua & bit) packstep(A, mskA, tcA, j, kf, vf);
            if (ub & bit) packstep(B, mskB, tcB, j, kf, vf);
        };
        auto ldk = [&](int j_, bf16x8 (&kf_)[4][2]) __attribute__((always_inline)) {
            const bf16_t* kr = klane + (size_t)j_ * 4096;
#pragma unroll
            for (int kt = 0; kt < 4; ++kt) { kf_[kt][0] = *(const bf16x8*)(kr + (kt * 2) * 512); kf_[kt][1] = *(const bf16x8*)(kr + (kt * 2 + 1) * 512); }
        };
        auto ldv = [&](int j_, bf16x8 (&vf_)[2][4]) __attribute__((always_inline)) {
            const bf16_t* vr = vlane + (size_t)j_ * 4096;
#pragma unroll
            for (int ks = 0; ks < 2; ++ks)
#pragma unroll
                for (int dt = 0; dt < 4; ++dt) vf_[ks][dt] = *(const bf16x8*)(vr + (ks * 4 + dt) * 512);
        };
        bf16x8 kfA[4][2], kfB[4][2], vf[2][4];
        int j = 0; bool have = nextj(j);
        ldk(j, kfA);
#pragma unroll 1
        while (have) {
            int jn = j; bool haven = nextj(jn);
            ldv(j, vf); ldk(jn, kfB);
            __builtin_amdgcn_sched_barrier(0);
            blockstep(j, kfA, vf);
            if (!haven) break;
            j = jn; have = nextj(jn);
            ldv(j, vf); ldk(jn, kfA);
            __builtin_amdgcn_sched_barrier(0);
            blockstep(j, kfB, vf);
            j = jn;
        }
        addout(A, qrowA, 1); addout(B, qrowA + 4, 1);
    }
    {
        reset(A); reset(B);
        const int loA = t0 - WIN > 0 ? t0 - WIN : 0, hiA = t0 + 3, loB = t0 + 4 - WIN > 0 ? t0 + 4 - WIN : 0, hiB = t0 + 7;
        const bf16_t* klane = p.WINkF + (size_t)(b * NG + g) * SEQ * 64 + lane * 8;
        const bf16_t* vlane = p.WINvT + (size_t)(b * NG + g) * SEQ * 64 + lane * 8;
        auto ldfr = [&](int cb_, bf16x8 (&kf_)[4][2], bf16x8 (&vf_)[2][4]) __attribute__((always_inline)) {
            const bf16_t* kr = klane + (size_t)cb_ * 64; const bf16_t* vr = vlane + (size_t)cb_ * 64;
#pragma unroll
            for (int kt = 0; kt < 4; ++kt) { kf_[kt][0] = *(const bf16x8*)(kr + (kt * 2) * 512); kf_[kt][1] = *(const bf16x8*)(kr + (kt * 2 + 1) * 512); }
#pragma unroll
            for (int ks = 0; ks < 2; ++ks)
#pragma unroll
                for (int dt = 0; dt < 4; ++dt) vf_[ks][dt] = *(const bf16x8*)(vr + (ks * 4 + dt) * 512);
        };
        auto packstep = [&](PackSt& S, int tq0, int tc, int cb, const bf16x8 (&kf)[4][2], const bf16x8 (&vf)[2][4]) __attribute__((always_inline)) {
            const bool far = (cb + 63 <= tq0 - 128) && (cb >= tq0 + 3 - WIN);
            f32x4 s[4];
#pragma unroll
            for (int kt = 0; kt < 4; ++kt) { s[kt] = mfma16(kf[kt][0], S.q0, (f32x4){0.f, 0.f, 0.f, 0.f}); s[kt] = mfma16(kf[kt][1], S.q1, s[kt]); }
            if (!far) {
#pragma unroll
                for (int kt = 0; kt < 4; ++kt)
#pragma unroll
                    for (int i = 0; i < 4; ++i) { const int dist = tc - (cb + 16 * kt + 4 * G + i); const bool ok = dist >= 0 && dist <= WIN; const int dd = dist < 0 ? 0 : (dist > 128 ? 128 : dist);
                        s[kt][i] = ok ? s[kt][i] + T2[dd * 8 + g * 4 + hh] : -1e30f; }
            }
            finish(S, s, far ? b31 : 0.f, true, vf);
        };
        auto chunkstep = [&](int cb, const bf16x8 (&kf)[4][2], const bf16x8 (&vf)[2][4]) __attribute__((always_inline)) {
            if (cb <= hiA) packstep(A, t0, tcA, cb, kf, vf);
            if (cb + 63 >= loB) packstep(B, t0 + 4, tcB, cb, kf, vf);
        };
        auto ldk = [&](int cb_, bf16x8 (&kf_)[4][2]) __attribute__((always_inline)) {
            const bf16_t* kr = klane + (size_t)cb_ * 64;
#pragma unroll
            for (int kt = 0; kt < 4; ++kt) { kf_[kt][0] = *(const bf16x8*)(kr + (kt * 2) * 512); kf_[kt][1] = *(const bf16x8*)(kr + (kt * 2 + 1) * 512); }
        };
        auto ldv = [&](int cb_, bf16x8 (&vf_)[2][4]) __attribute__((always_inline)) {
            const bf16_t* vr = vlane + (size_t)cb_ * 64;
#pragma unroll
            for (int ks = 0; ks < 2; ++ks)
#pragma unroll
                for (int dt = 0; dt < 4; ++dt) vf_[ks][dt] = *(const bf16x8*)(vr + (ks * 4 + dt) * 512);
        };
        bf16x8 kfA[4][2], kfB[4][2], vf[2][4];
        int cb = loA & ~63;
        ldk(cb, kfA);
#pragma unroll 1
        for (;;) {
            ldv(cb, vf); ldk(cb + 64 <= hiB ? cb + 64 : cb, kfB);
            __builtin_amdgcn_sched_barrier(0);
            chunkstep(cb, kfA, vf);
            cb += 64; if (cb > hiB) break;
            ldv(cb, vf); ldk(cb + 64 <= hiB ? cb + 64 : cb, kfA);
            __builtin_amdgcn_sched_barrier(0);
            chunkstep(cb, kfB, vf);
            cb += 64; if (cb > hiB) break;
        }
        addout(A, qrowA, 2); addout(B, qrowA + 4, 2);
    }
}

__device__ __forceinline__ void phase_attn(const Params& p) {
    const int wid = threadIdx.x >> 6, lane = threadIdx.x & 63;
    { PROBE_BEGIN(3)
    if (blockIdx.x < NS * NG) attn_sample_item(p, blockIdx.x >> 1, blockIdx.x & 1);
    PROBE_END(3) }
    LAS unsigned char* L = (LAS unsigned char*)smem;
    for (int i = threadIdx.x; i < 129 * 8; i += 512) ((LAS float*)(L + A_T2))[i] = p.rel_bias[t5_bucket(i >> 3) * 8 + (i & 7)] * LOG2E;
    __syncthreads();
    {
        const int wid2 = __builtin_amdgcn_readfirstlane(threadIdx.x >> 6);
#pragma unroll 1
        for (;;) {
            __syncthreads();
            if (threadIdx.x == 0) ((LAS int*)(L + A_NP))[1] = (int)__hip_atomic_fetch_add(p.bar, 1u, __ATOMIC_RELAXED, __HIP_MEMORY_SCOPE_AGENT);
            __syncthreads();
            const int T = ((const LAS int*)(L + A_NP))[1];
            if (T >= NB * NG * (SEQ / 64)) break;
            const int bg = T & 7, qb = (SEQ / 64 - 1) - (T >> 3), t0 = qb * 64 + wid2 * 8;
            unsigned mA[4], mB[4];
            PROBE_BEGIN(6)
            attn_cmp(p, bg >> 1, bg & 1, t0, lane, L, mA);
            attn_cmp(p, bg >> 1, bg & 1, t0 + 4, lane, L, mB);
            PROBE_END(6)
            PROBE_BEGIN(7)
            attn_selwin_pair(p, bg >> 1, bg & 1, t0, lane, L, mA, mB);
            PROBE_END(7)
        }
    }
    __syncthreads();
}

constexpr int GM_LD = 136, GM_LDS = 128 * GM_LD * 2 + 1024;
__device__ __forceinline__ void phase_gmlp(const Params& p) {
    int tid = threadIdx.x; asm volatile("" : "+v"(tid));
    const int wid = __builtin_amdgcn_readfirstlane(tid >> 6), lane = tid & 63;
    LAS bf16_t* vnT = (LAS bf16_t*)smem;
    LAS float* mu = (LAS float*)(smem + 128 * GM_LD * 2);
    const int c = lane & 15, G = lane >> 4;
#pragma unroll 1
    for (int u = blockIdx.x; u < NB * 64; u += gridDim.x) {
        const int b = u >> 6, ch = u & 63; const size_t row0 = (size_t)b * SEQ + ch * 128;
        __syncthreads();
        for (int r = wid; r < 128; r += 8) {
            const u32x4 w = *(const u32x4*)(p.Vg + (row0 + r) * GMD + lane * 8);
            const float x[8] = {bflo(w.x), bfhi(w.x), bflo(w.y), bfhi(w.y), bflo(w.z), bfhi(w.z), bflo(w.w), bfhi(w.w)};
            float s = 0.f;
#pragma unroll
            for (int i = 0; i < 8; ++i) s += x[i];
            const float mean = wave_sum(s) * (1.0f / GMD);
            float q = 0.f;
#pragma unroll
            for (int i = 0; i < 8; ++i) q += (x[i] - mean) * (x[i] - mean);
            const float var = wave_sum(q) * (1.0f / GMD);
            if (lane == 0) { mu[r] = mean; mu[128 + r] = rsqrtf(var + EPS); }
        }
#pragma unroll 1
        for (int g = 0; g < 4; ++g) {
            __syncthreads();
#pragma unroll
            for (int k = 0; k < 4; ++k) {
                const int e = tid + 512 * k, s = e & 127, d0 = (e >> 7) * 8;
                const u32x4 w = *(const u32x4*)(p.Vg + (row0 + s) * GMD + g * 128 + d0);
                const float x[8] = {bflo(w.x), bfhi(w.x), bflo(w.y), bfhi(w.y), bflo(w.z), bfhi(w.z), bflo(w.w), bfhi(w.w)};
                const float m = mu[s], rs = mu[128 + s];
#pragma unroll
                for (int i = 0; i < 8; ++i) { const int cc = g * 128 + d0 + i; vnT[(d0 + i) * GM_LD + s] = f2bf((x[i] - m) * rs * p.gm_ln_g[cc] + p.gm_ln_b[cc]); }
            }
            __syncthreads();
            f32x4 acc[8];
#pragma unroll
            for (int dt = 0; dt < 8; ++dt) acc[dt] = (f32x4){0.f, 0.f, 0.f, 0.f};
            const bf16_t* wrow = p.GWb + ((size_t)g * 128 + 16 * wid + c) * 128 + 8 * G;
#pragma unroll 1
            for (int ks = 0; ks <= (wid >> 1); ++ks) {
                const bf16x8 B = *(const bf16x8*)(wrow + 32 * ks);
#pragma unroll
                for (int dt = 0; dt < 8; ++dt) {
                    const bf16x8 A = *(const LAS bf16x8*)(vnT + (dt * 16 + c) * GM_LD + 32 * ks + 8 * G);
                    acc[dt] = mfma16(A, B, acc[dt]);
                }
            }
            const int t = 16 * wid + c;
            const float bs = p.gm_bs[g * 128 + t];
#pragma unroll
            for (int dt = 0; dt < 8; ++dt) {
                const int d = dt * 16 + 4 * G;
                const u32x2 uw = *(const u32x2*)(p.U + (row0 + t) * GMD + g * 128 + d);
                f32x4 o; o[0] = bflo(uw.x) * (acc[dt][0] + bs); o[1] = bfhi(uw.x) * (acc[dt][1] + bs); o[2] = bflo(uw.y) * (acc[dt][2] + bs); o[3] = bfhi(uw.y) * (acc[dt][3] + bs);
                st_bf16x4(p.OCAT + (row0 + t) * DM + QD + g * 128 + d, o);
            }
        }
    }
    for (int it = blockIdx.x * 8 + wid; it < NS; it += gridDim.x * 8) {
        const size_t row = (size_t)MP + it;
        const u32x4 w = *(const u32x4*)(p.Vg + row * GMD + lane * 8);
        const float x[8] = {bflo(w.x), bfhi(w.x), bflo(w.y), bfhi(w.y), bflo(w.z), bfhi(w.z), bflo(w.w), bfhi(w.w)};
        float s = 0.f;
#pragma unroll
        for (int i = 0; i < 8; ++i) s += x[i];
        const float mean = wave_sum(s) * (1.0f / GMD);
        float q = 0.f;
#pragma unroll
        for (int i = 0; i < 8; ++i) q += (x[i] - mean) * (x[i] - mean);
        const float rs = rsqrtf(wave_sum(q) * (1.0f / GMD) + EPS);
#pragma unroll
        for (int i = 0; i < 8; ++i) {
            const int c = lane * 8 + i, g = c >> 7;
            const float v = (x[i] - mean) * rs * p.gm_ln_g[c] + p.gm_ln_b[c];
            p.out[O_GMV + (size_t)it * GMD + c] = v;
            const float a = p.gm_ws[(size_t)g * 128 * 128] * v + p.gm_bs[g * 128];
            p.OCAT[row * DM + QD + c] = f2bf(bf2f(p.U[row * GMD + c]) * a);
        }
    }
}

template <int MODE>
__device__ __forceinline__ void phase_norm(const Params& p) {
    const int wid = threadIdx.x >> 6, lane = threadIdx.x & 63;
    const float* gpost = MODE == 0 ? p.ln_mix_post : MODE == 1 ? p.ln_ffn_post : p.ln_ple_post;
    for (int row = blockIdx.x * 8 + wid; row < MP + NS; row += gridDim.x * 8) {
        const bf16_t* fr = (const bf16_t*)p.F + (size_t)row * DM;
        const bf16_t* xb = MODE == 1 ? (const bf16_t*)p.X1 + (size_t)row * DM : p.X2b + (size_t)row * DM;
        f32x4 f[4], x[4];
#pragma unroll
        for (int k = 0; k < 4; ++k) { const u32x2 w = *(const u32x2*)(fr + lane * 4 + k * 256); f[k][0] = bflo(w.x); f[k][1] = bfhi(w.x); f[k][2] = bflo(w.y); f[k][3] = bfhi(w.y);
            if (MODE == 0) x[k] = *(const f32x4*)(xrow_ptr(p, row) + lane * 4 + k * 256);
            else { const u32x2 v = *(const u32x2*)(xb + lane * 4 + k * 256); x[k][0] = bflo(v.x); x[k][1] = bfhi(v.x); x[k][2] = bflo(v.y); x[k][3] = bfhi(v.y); } }
        const float r = row_rstd(f);
#pragma unroll
        for (int k = 0; k < 4; ++k) { const f32x4 g = *(const f32x4*)(gpost + lane * 4 + k * 256); x[k] = x[k] + f[k] * r * g; }
        if (MODE == 0) {
            const float r2 = row_rstd(x);
#pragma unroll
            for (int k = 0; k < 4; ++k) {
                st_bf16x4((bf16_t*)p.X1 + (size_t)row * DM + lane * 4 + k * 256, x[k]);
                const f32x4 g = *(const f32x4*)(p.ln_ffn_pre + lane * 4 + k * 256); const f32x4 o = x[k] * r2 * g;
                st_bf16x4(p.H2 + (size_t)row * DM + lane * 4 + k * 256, o);
            }
        } else if (MODE == 1) {
#pragma unroll
            for (int k = 0; k < 4; ++k) st_bf16x4(p.X2b + (size_t)row * DM + lane * 4 + k * 256, x[k]);
        } else {
            float* yr = row < MP ? p.out + O_YP + (size_t)row * DM : p.out + O_YS + (size_t)(row - MP) * DM;
#pragma unroll
            for (int k = 0; k < 4; ++k) *(f32x4*)(yr + lane * 4 + k * 256) = x[k];
        }
    }
}


#define XB_TMO      128
#define XB_XCNT(j)  (256  + 64 * (j))
#define XB_XSUB(j)  (1280 + 64 * (j))
#define XB_XGEN(j)  (2304 + 64 * (j))
#define XB_TOP      3328
#define XB_TOPGEN   3392
#define XCD_BAR_WORDS 3456
#define XB_SPIN_CAP (1u << 22)

__device__ __forceinline__ unsigned xb_ld(unsigned* p)              { return __hip_atomic_load(p, __ATOMIC_RELAXED, __HIP_MEMORY_SCOPE_AGENT); }
__device__ __forceinline__ unsigned xb_add(unsigned* p, unsigned v) { return __hip_atomic_fetch_add(p, v, __ATOMIC_RELAXED, __HIP_MEMORY_SCOPE_AGENT); }
__device__ __forceinline__ unsigned xb_xcc_id() { return (unsigned)__builtin_amdgcn_s_getreg((3 << 11) | 20) & 0xFu; }
#define XB_SPIN(cond, bar) do { unsigned _sp = 0; while (cond) { __builtin_amdgcn_s_sleep(1); \
    if ((++_sp & 255u) == 0u) { if (xb_ld(&(bar)[XB_TMO])) break; if (_sp > XB_SPIN_CAP) { atomicAdd(&(bar)[XB_TMO], 1u); break; } } } } while (0)

struct XcdBarrier {
    unsigned* bar; unsigned x;
    volatile LAS unsigned* st;
};

__device__ __forceinline__ XcdBarrier xcd_barrier_post(unsigned* bar, volatile LAS unsigned* st) {
    XcdBarrier b; b.bar = bar; b.x = xb_xcc_id(); b.st = st;
    if (threadIdx.x == 0) (void)xb_add(&bar[XB_XCNT(b.x)], 1u);
    return b;
}
__device__ __forceinline__ void xcd_barrier_complete(unsigned* bar, unsigned x, unsigned& nloc, unsigned& nx) {
    const unsigned G = gridDim.x * gridDim.y * gridDim.z;
    unsigned sum, cnt, mine, sp = 0u;
    for (;;) {
        sum = 0u; cnt = 0u; mine = 0u;
#pragma unroll
        for (unsigned j = 0; j < 16; ++j) { const unsigned c = xb_ld(&bar[XB_XCNT(j)]); sum += c; cnt += (c > 0u) ? 1u : 0u; mine = (j == x) ? c : mine; }
        if (sum == G) break;
        __builtin_amdgcn_s_sleep(1);
        if ((++sp & 255u) == 0u) { if (xb_ld(&bar[XB_TMO])) break; if (sp > XB_SPIN_CAP) { atomicAdd(&bar[XB_TMO], 1u); break; } }
    }
    nloc = mine > 0u ? mine : 1u; nx = cnt > 0u ? cnt : 1u;
}

__device__ __forceinline__ void xcd_barrier(const XcdBarrier& b) {
    asm volatile("s_waitcnt vmcnt(0)" ::: "memory");
    __syncthreads();
    if (threadIdx.x == 0) {
        unsigned* bar = b.bar;
        __builtin_amdgcn_s_waitcnt(0);
        unsigned nloc = b.st[0], nx = b.st[1];
        if (nloc == 0u) { xcd_barrier_complete(bar, b.x, nloc, nx); b.st[0] = nloc; b.st[1] = nx; }
        const unsigned old = xb_add(&bar[XB_XSUB(b.x)], 1u);
        const unsigned gen = old / nloc;
        if (old + 1u == (gen + 1u) * nloc) {
            __builtin_amdgcn_fence(__ATOMIC_RELEASE, "agent");
            asm volatile("s_waitcnt vmcnt(0)" ::: "memory");
            const unsigned og = xb_add(&bar[XB_TOP], 1u);
            const unsigned tg = og / nx;
            if (og + 1u == (tg + 1u) * nx) xb_add(&bar[XB_TOPGEN], 1u);
            else XB_SPIN(xb_ld(&bar[XB_TOPGEN]) == tg, bar);
            __builtin_amdgcn_fence(__ATOMIC_ACQUIRE, "agent");
            xb_add(&bar[XB_XGEN(b.x)], 1u);
            asm volatile("s_waitcnt vmcnt(0)" ::: "memory");
        } else {
            XB_SPIN(xb_ld(&bar[XB_XGEN(b.x)]) == gen, bar);
            __builtin_amdgcn_fence(__ATOMIC_ACQUIRE, "agent");
            asm volatile("s_waitcnt vmcnt(0)" ::: "memory");
        }
    }
    __syncthreads();
}

constexpr int NPHASE = 16;
constexpr int LDS_BYTES = GEMM_LDS;
static_assert(GM_LDS <= LDS_BYTES, "lds");
constexpr int NMT = MALL / BM;

constexpr int NMP = MP / BM;
template <int PH>
__device__ __forceinline__ void run_phase(const Params& p) {
    if (PH == 0) phase_prologue(p);
    if (PH == 1) { EpiIn e{p}; if (blockIdx.x & 1) phase_gather(p); gemm_phase(p.H, DM, p.WinT, DM, NMP, INP / BM, e); gemm_skinny(p.H + (size_t)MP * DM, DM, p.WinT, DM, INP, e); if (!(blockIdx.x & 1)) phase_gather(p); }
    if (PH == 2) { EpiPart e{(bf16_t*)p.PART}; gemm_phase(p.CMPb, 4096, p.W1T, 1024, (2048 + NS * 1024) / BM, 1, e, 4, ZCmp(), 256); phase_deferred_transposes(p); }
    if (PH == 3) phase_cmp_final(p);
    if (PH == 4) phase_attn(p);
    if (PH == 5) phase_gmlp(p);
    if (PH == 6) { EpiBranch e{p.GA, p.GB, p.Y1}; gemm_phase<EpiBranch, ZNone, true>(p.OCAT, DM, p.WnT, DM, NMP, DM / BM, e); gemm_skinny2(p.OCAT + (size_t)MP * DM, DM, p.WnT, DM, DM, e); }
    if (PH == 8) { EpiBf16 e{(bf16_t*)p.F, DM}; gemm_phase(p.Y1, DM, p.WoT, DM, NMP, DM / BM, e); gemm_skinny(p.Y1 + (size_t)MP * DM, DM, p.WoT, DM, DM, e); }
    if (PH == 9) phase_norm<0>(p);
    if (PH == 10) { EpiSwiGLU e{p.ACT}; gemm_phase(p.H2, DM, p.WguT, DM, NMP, 2 * DFF / BM, e); gemm_skinny(p.H2 + (size_t)MP * DM, DM, p.WguT, DM, 2 * DFF, e); }
    if (PH == 11) { EpiBf16 e{(bf16_t*)p.F, DM}; gemm_phase(p.ACT, DFF, p.WdT, DFF, NMP, DM / BM, e); gemm_skinny(p.ACT + (size_t)MP * DFF, DFF, p.WdT, DFF, DM, e); }
    if (PH == 12) phase_norm<1>(p);
    if (PH == 13) { EpiBf16 e{(bf16_t*)p.T, DM}; gemm_phase(p.Pb, PLE, p.WpT, PLE, NMP, DM / BM, e); gemm_skinny(p.Pb + (size_t)MP * PLE, PLE, p.WpT, PLE, DM, e); }
    if (PH == 14) { EpiPleGate e{(const bf16_t*)p.T, (bf16_t*)p.F}; gemm_phase(p.X2b, DM, p.WpgT, DM, NMP, DM / BM, e); gemm_skinny(p.X2b + (size_t)MP * DM, DM, p.WpgT, DM, DM, e); }
    if (PH == 15) phase_norm<2>(p);
}

#ifndef MK_MULTI
#define MK_MULTI 0
#endif
template <int PH>
__global__ void __launch_bounds__(512, 2) k_phase(Params p) { run_phase<PH>(p); }

__global__ void __launch_bounds__(512, 2) k_all(Params p) {
    volatile LAS unsigned* st = (volatile LAS unsigned*)((LAS unsigned char*)smem + LDS_BYTES);
    if (threadIdx.x < 12) st[threadIdx.x] = 0u;
    __syncthreads();
    XcdBarrier bar = xcd_barrier_post(p.bar, st);
#if PROBE_DUP == 100
    run_phase<0>(p);  xcd_barrier(bar);
#endif
#if PROBE_SPIN >= 100
    if (threadIdx.x == 0) PROBE_TS[3] = probe_now();
#define PROBE_STAMP(k) if (threadIdx.x == 0 && PROBE_SEG == (k)) PROBE_TS[2] = probe_now() - PROBE_TS[3];
#else
#define PROBE_STAMP(k)
#endif
    run_phase<0>(p);  xcd_barrier(bar);
    PROBE_STAMP(20)
    run_phase<1>(p);  xcd_barrier(bar);
    PROBE_STAMP(21)
    run_phase<2>(p);  xcd_barrier(bar);
#if PROBE_DUP == 100
    run_phase<3>(p);  xcd_barrier(bar);
#endif
    run_phase<3>(p);  xcd_barrier(bar);
    PROBE_STAMP(23)
#if PROBE_DUP == 104
    run_phase<4>(p);  xcd_barrier(bar);
#endif
    run_phase<4>(p);
#if PROBE_DUP == 100
    run_phase<5>(p);  xcd_barrier(bar);
#endif
    run_phase<5>(p);  xcd_barrier(bar);
    PROBE_STAMP(25)
    run_phase<6>(p);  xcd_barrier(bar);
    run_phase<8>(p);  xcd_barrier(bar);
    PROBE_STAMP(28)
    run_phase<9>(p);  xcd_barrier(bar);
    PROBE_STAMP(29)
    run_phase<10>(p); xcd_barrier(bar);
    PROBE_STAMP(30)
    run_phase<11>(p); xcd_barrier(bar);
    PROBE_STAMP(31)
    run_phase<12>(p);
    run_phase<13>(p); xcd_barrier(bar);
    run_phase<14>(p); xcd_barrier(bar);
    PROBE_STAMP(34)
    run_phase<15>(p);
#if PROBE_SPIN
    if (blockIdx.x == 0 && threadIdx.x == 0) {
        const unsigned long long d = PROBE_TS[2] * (PROBE_SPIN >= 100 ? PROBE_SPIN - 100 : PROBE_SPIN), t0 = probe_now();
        while (probe_now() - t0 < d) __builtin_amdgcn_s_sleep(8);
    }
#endif
}

static inline size_t al256(size_t x) { return (x + 255) & ~(size_t)255; }
template <int PH> static void launch_phase(const Params& p, int grid, hipStream_t s) {
    static bool attr = false;
    if (!attr) { (void)hipFuncSetAttribute((const void*)k_phase<PH>, hipFuncAttributeMaxDynamicSharedMemorySize, LDS_BYTES); attr = true; }
    k_phase<PH><<<grid, 512, LDS_BYTES, s>>>(p);
}
template <int PH> static void launch_all(const Params& p, int grid, hipStream_t s) {
    launch_phase<PH>(p, grid, s);
    if constexpr (PH + 1 < NPHASE) launch_all<PH + 1>(p, grid, s);
}

extern "C" void kernel_launch(void* const* d_in, const int* in_sizes, int n_in, void* d_out, int out_size, void* d_ws, size_t ws_size, hipStream_t stream) {
    Params p{};
    p.x_prompt = (const float*)d_in[0]; p.x_sample = (const float*)d_in[1]; p.cache_cmp = (const float*)d_in[2]; p.cache_slc = (const float*)d_in[3];
    p.state_win = (const float*)d_in[4]; p.page_table = (const int*)d_in[5]; p.p_prompt = (const float*)d_in[6]; p.p_sample = (const float*)d_in[7];
    p.rel_bias = (const float*)d_in[8]; p.ln_mix_pre = (const float*)d_in[9]; p.w_in = (const float*)d_in[10];
    p.pe_k = (const float*)d_in[11]; p.w1_k = (const float*)d_in[12]; p.w2_k = (const float*)d_in[13];
    p.pe_v = (const float*)d_in[14]; p.w1_v = (const float*)d_in[15]; p.w2_v = (const float*)d_in[16];
    p.gm_ln_g = (const float*)d_in[17]; p.gm_ln_b = (const float*)d_in[18]; p.gm_ws = (const float*)d_in[19]; p.gm_bs = (const float*)d_in[20];
    p.w_br_nsa = (const float*)d_in[21]; p.w_br_gm = (const float*)d_in[22]; p.w_out = (const float*)d_in[23];
    p.ln_mix_post = (const float*)d_in[24]; p.ln_ffn_pre = (const float*)d_in[25]; p.w_gate = (const float*)d_in[26]; p.w_up = (const float*)d_in[27];
    p.w_down = (const float*)d_in[28]; p.ln_ffn_post = (const float*)d_in[29]; p.w_ple = (const float*)d_in[30]; p.w_ple_gate = (const float*)d_in[31];
    p.ln_ple_post = (const float*)d_in[32];
    p.out = (float*)d_out;
    unsigned char* w = (unsigned char*)d_ws; size_t off = 0;
    auto take = [&](size_t bytes) { void* r = w + off; off = al256(off + bytes); return r; };
    p.bar = (unsigned*)take(16384);
    p.WinT = (bf16_t*)take((size_t)INP * DM * 2); p.WnT = (bf16_t*)take((size_t)DM * DM * 2); p.WgT = nullptr;
    p.WoT = (bf16_t*)take((size_t)DM * DM * 2); p.WguT = (bf16_t*)take((size_t)2 * DFF * DM * 2); p.WdT = (bf16_t*)take((size_t)DM * DFF * 2);
    p.WpgT = (bf16_t*)take((size_t)DM * DM * 2); p.WpT = (bf16_t*)take((size_t)DM * PLE * 2); p.W1T = (bf16_t*)take((size_t)2 * 256 * 1024 * 2);
    p.H = (bf16_t*)take((size_t)MALL * DM * 2); p.Qb = (bf16_t*)take((size_t)MALL * QD * 2);
    p.CMPb = (bf16_t*)take(((size_t)MP + (size_t)NS * PAST) * 256 * 2); p.SLCb = (bf16_t*)take((size_t)MALL * 256 * 2); p.WINb = (bf16_t*)take((size_t)MALL * 256 * 2);
    p.U = (bf16_t*)take((size_t)MALL * GMD * 2); p.Vg = (bf16_t*)take((size_t)MALL * GMD * 2);
    p.GA = (bf16_t*)take((size_t)MALL * DM * 2); p.GB = (bf16_t*)take((size_t)MALL * DM * 2);
    p.GATE = (float*)take((size_t)MALL * 32 * 4);
    p.PART = (float*)take((size_t)(2048 + NS * 1024) * 4 * 256 * 4); p.PEB = (float*)take(256 * 4);
    p.KCP = (float*)take((size_t)NB * NG * 512 * 64 * 4); p.VCP = (float*)take((size_t)NB * NG * 512 * 64 * 4);
    p.KCS = (float*)take((size_t)NS * NG * 1024 * 64 * 4); p.VCS = (float*)take((size_t)NS * NG * 1024 * 64 * 4); p.KN = (float*)take(NB * NG * 128 * 4);
    p.KCb = (bf16_t*)take((size_t)NB * NG * 512 * 64 * 2); p.VCT = (bf16_t*)take((size_t)NB * NG * 64 * 512 * 2);
    p.SLCvT = (bf16_t*)take((size_t)NB * NG * 64 * SEQ * 2); p.WINvT = (bf16_t*)take((size_t)NB * NG * 64 * SEQ * 2);
    p.GWb = (bf16_t*)take(4 * 128 * 128 * 2); p.W2T = (bf16_t*)take(2 * 64 * 128 * 2);
    p.SLCkF = (bf16_t*)take((size_t)NB * NG * 64 * SEQ * 2); p.WINkF = (bf16_t*)take((size_t)NB * NG * 64 * SEQ * 2);
    p.OCAT = (bf16_t*)take((size_t)MALL * DM * 2); p.T = (float*)take((size_t)MALL * DM * 4); p.Y1 = (bf16_t*)take((size_t)MALL * DM * 2);
    p.F = (float*)take((size_t)MALL * DM * 4); p.X1 = (float*)take((size_t)MALL * DM * 4); p.H2 = (bf16_t*)take((size_t)MALL * DM * 2);
    p.ACT = (bf16_t*)take((size_t)MALL * DFF * 2); p.X2 = (float*)take((size_t)MALL * DM * 4); p.X2b = (bf16_t*)take((size_t)MALL * DM * 2);
    p.Pb = (bf16_t*)take((size_t)MALL * PLE * 2);
    if (off > ws_size) { fprintf(stderr, "workspace too small: need %zu have %zu\n", off, ws_size); return; }
    (void)hipMemsetAsync(p.OCAT + (size_t)(MP + NS) * DM, 0, (size_t)(MALL - MP - NS) * DM * 2, stream);
#if MK_MULTI
    launch_all<0>(p, 256, stream);
#else
    constexpr size_t kDynLds = LDS_BYTES + 48;
    static int grid = 0;
    if (!grid) {
        int dev = 0, cus = 0, per_cu = 0;
        (void)hipGetDevice(&dev);
        (void)hipDeviceGetAttribute(&cus, hipDeviceAttributeMultiprocessorCount, dev);
        (void)hipFuncSetAttribute((const void*)k_all, hipFuncAttributeMaxDynamicSharedMemorySize, (int)kDynLds);
        (void)hipOccupancyMaxActiveBlocksPerMultiprocessor(&per_cu, (const void*)k_all, 512, kDynLds);
        grid = cus * (per_cu < 1 ? per_cu : 1);
        if (grid <= 0) { fprintf(stderr, "k_all: occupancy query says %d blocks per CU\n", per_cu); grid = 0; return; }
    }
    (void)hipMemsetAsync(p.bar, 0, XCD_BAR_WORDS * sizeof(unsigned), stream);
    k_all<<<grid, 512, kDynLds, stream>>>(p);
#endif
}
```

```cpp
#include <hip/hip_runtime.h>
#include <stdint.h>
#include <cstdio>

typedef unsigned short bf16_t;
typedef short bf16x8 __attribute__((ext_vector_type(8)));
typedef float f32x4 __attribute__((ext_vector_type(4)));
typedef float f32x2 __attribute__((ext_vector_type(2)));
typedef unsigned u32x4 __attribute__((ext_vector_type(4)));
typedef unsigned u32x2 __attribute__((ext_vector_type(2)));
#define LAS __attribute__((address_space(3)))

constexpr int DM = 1024, NB = 4, SEQ = 8192, MP = NB * SEQ, NS = 32, MALL = MP + 256, PAST = 16384, PAGE = 128, NPG = 128;
constexpr int NH = 8, NG = 2, HPG = 4, DH = 64, QD = 512, WIN = 512, GMD = 512, DFF = 2816, PLE = 256, IND = 4376, INP = 4608;
constexpr int NCP = 511, NCS = 1023;
constexpr float EPS = 1e-6f;
constexpr float LOG2E = 1.4426950408889634f, QSCALE = 0.125f * LOG2E;
constexpr long O_YP = 0, O_YS = 33554432, O_CMPP = 33587200, O_SLCP = 41975808, O_WINP = 50364416, O_CMPS = 50888704,
               O_SLCS = 50896896, O_WINS = 50905088, O_GMV = 55099392;

struct Params {
    const float *x_prompt, *x_sample, *cache_cmp, *cache_slc, *state_win; const int* page_table;
    const float *p_prompt, *p_sample, *rel_bias, *ln_mix_pre, *w_in, *pe_k, *w1_k, *w2_k, *pe_v, *w1_v, *w2_v;
    const float *gm_ln_g, *gm_ln_b, *gm_ws, *gm_bs, *w_br_nsa, *w_br_gm, *w_out, *ln_mix_post, *ln_ffn_pre;
    const float *w_gate, *w_up, *w_down, *ln_ffn_post, *w_ple, *w_ple_gate, *ln_ple_post;
    float* out;
    unsigned* bar;
    bf16_t *WinT, *WnT, *WgT, *WoT, *WguT, *WdT, *WpgT, *WpT, *W1T;
    bf16_t *H, *Qb, *CMPb, *SLCb, *WINb, *U, *Vg, *GA, *GB;
    float* GATE;
    float *PART, *PEB, *KCP, *VCP, *KCS, *VCS, *KN;
    bf16_t *KCb, *VCT, *SLCvT, *WINvT, *SLCkF, *WINkF, *GWb, *W2T;
    bf16_t* OCAT; float* T; bf16_t* Y1; float* F; float* X1; bf16_t* H2; bf16_t* ACT; float* X2; bf16_t* X2b; bf16_t* Pb;
};

__device__ __forceinline__ unsigned cvt_pk_bf16(float lo, float hi) { unsigned r; asm volatile("v_cvt_pk_bf16_f32 %0, %1, %2" : "=v"(r) : "v"(lo), "v"(hi)); return r; }
__device__ __forceinline__ bf16_t f2bf(float f) { return (bf16_t)(cvt_pk_bf16(f, 0.f) & 0xffffu); }
__device__ __forceinline__ float bf2f(bf16_t h) { return __uint_as_float(((unsigned)h) << 16); }
__device__ __forceinline__ float bflo(unsigned w) { return __uint_as_float(w << 16); }
__device__ __forceinline__ float bfhi(unsigned w) { return __uint_as_float(w & 0xffff0000u); }
__device__ __forceinline__ float ex2(float x) { return __builtin_amdgcn_exp2f(x); }
__device__ __forceinline__ float sigmoidf_(float x) { return 1.0f / (1.0f + __expf(-x)); }
__device__ __forceinline__ float siluf_(float x) { return x * sigmoidf_(x); }
__device__ __forceinline__ float geluf_(float x) {
    const float u = 0.7978845608028654f * (x + 0.044715f * x * x * x);
    const float e = __expf(2.0f * u);
    const float th = 1.0f - 2.0f / (e + 1.0f);
    return 0.5f * x * (1.0f + th);
}
__device__ __forceinline__ float wave_sum(float v) {
#pragma unroll
    for (int o = 32; o > 0; o >>= 1) v += __shfl_xor(v, o);
    return v;
}
__device__ __forceinline__ float wave_max(float v) {
#pragma unroll
    for (int o = 32; o > 0; o >>= 1) v = fmaxf(v, __shfl_xor(v, o));
    return v;
}
__device__ __forceinline__ int t5_bucket(int d) {
    if (d < 16) return d;
    if (d >= 128) return 31;
    const int b = 16 + (int)(__logf((float)d * (1.0f / 16.0f)) * (16.0f / 2.0794415416798357f));
    return b < 31 ? b : 31;
}

extern __shared__ __attribute__((aligned(16))) unsigned char smem[];
#ifndef PROBE_DUP
#define PROBE_DUP 0
#endif
#define PROBE_LDS_OFF 131072
#ifndef PROBE_SPIN
#define PROBE_SPIN 0
#endif
#ifndef PROBE_SEG
#define PROBE_SEG 5
#endif
__device__ __forceinline__ unsigned long long probe_now() { unsigned long long t; asm volatile("s_memrealtime %0\n\ts_waitcnt lgkmcnt(0)" : "=s"(t) :: "memory"); return t; }
#define PROBE_TS ((volatile LAS unsigned long long*)((LAS unsigned char*)smem + PROBE_LDS_OFF + 16))
#if PROBE_SPIN
#define PROBE_BEGIN(seg) unsigned long long pb_##seg = 0; if (PROBE_SEG == seg && threadIdx.x == 0) pb_##seg = probe_now();
#define PROBE_END(seg) if (PROBE_SEG == seg && threadIdx.x == 0) { PROBE_TS[2] = PROBE_TS[2] + (probe_now() - pb_##seg); }
#else
#define PROBE_BEGIN(seg)
#define PROBE_END(seg)
#endif

constexpr int BM = 256, BK = 64, HALF = 128, HT = HALF * BK, GEMM_LDS = 8 * HT * 2;
__device__ __forceinline__ int lds_byte(int r, int c) { const int st = (r >> 4) * 2 + (c >> 5), rr = r & 15, cc = c & 31, ob = rr * 64 + cc * 2; return st * 1024 + (ob ^ (((ob >> 9) & 1) << 5)); }
__device__ __forceinline__ void stage_rc(int b, int& R, int& C) { const int st = b / 1024, sb = b % 1024, swz = sb ^ (((sb >> 9) & 1) << 5); R = (st >> 1) * 16 + swz / 64; C = (st & 1) * 32 + (swz % 64) / 2; }

constexpr int HTB = HALF * BK * 2;
template <class F>
__device__ __forceinline__ void for_each_frag(const f32x4 (&acc)[2][2][4][2], int brow, int bcol, int wr, int wc, int fr, int fq, F&& f) {
#pragma unroll
    for (int ai = 0; ai < 2; ++ai)
#pragma unroll
        for (int m = 0; m < 4; ++m)
#pragma unroll
            for (int bj = 0; bj < 2; ++bj)
#pragma unroll
                for (int n = 0; n < 2; ++n)
                    f(brow + ai * HALF + wr * 64 + m * 16 + fr, bcol + bj * HALF + wc * 32 + n * 16 + fq * 4, acc[ai][bj][m][n]);
}

struct ZNone { __device__ __forceinline__ size_t a(int) const { return 0; } __device__ __forceinline__ size_t b(int) const { return 0; } };
template <class Epi, class ZMap = ZNone, bool HAS_MID = false>
__device__ __forceinline__ void gemm_phase(const bf16_t* A, int lda, const bf16_t* Bt, int K, int nM, int nN, const Epi& E, int nZ = 1, ZMap zm = ZMap(), int kstepA_el = BK) {
    LAS unsigned char* lds = (LAS unsigned char*)smem;
    int tid = threadIdx.x; asm volatile("" : "+v"(tid));
    const int wid = __builtin_amdgcn_readfirstlane(tid >> 6), lane = tid & 63, wr = wid >> 2, wc = wid & 3, fr = lane & 15, fq = lane >> 4;
    const int nt = K / BK, nmn = nM * nN, nu = nmn * nZ, G = gridDim.x;
    int u = blockIdx.x;
    if (u >= nu) return;
    unsigned voffA[2], voffB[2];
#pragma unroll
    for (int i = 0; i < 2; ++i) { int R, C; stage_rc(tid * 16 + i * 8192, R, C); voffA[i] = (unsigned)(R * lda + C) * 2u; voffB[i] = (unsigned)(R * K + C) * 2u; }
    const size_t kstep = (size_t)(BK * 2), kstepA = (size_t)kstepA_el * 2;
    const size_t hstepA = (size_t)HALF * lda * 2, hstepB = (size_t)HALF * K * 2, tstepA = 2 * hstepA, tstepB = 2 * hstepB;
    const unsigned ldsw = (unsigned)wid * 1024u;
    const int aoff = lds_byte(wr * 64 + fr, fq * 8), boff = lds_byte(wc * 32 + fr, fq * 8);
#define PG8_SA(b, h) (((b) * 2 + (h)) * HTB)
#define PG8_SB(b, h) ((4 + (b) * 2 + (h)) * HTB)
#define PG8_STAGE(bufoff, gbase, voff) do { _Pragma("unroll") for (int _i = 0; _i < 2; ++_i) \
        __builtin_amdgcn_global_load_lds((const unsigned*)((const char*)(gbase) + (voff)[_i]), (LAS unsigned*)(lds + (bufoff) + ldsw + _i * 8192), 16, 0, 0); } while (0)
#define PG8_LDA(dst, b, h) do { _Pragma("unroll") for (int m = 0; m < 4; ++m) _Pragma("unroll") for (int k = 0; k < 2; ++k) dst[m][k] = *(const LAS bf16x8*)(lds + PG8_SA(b, h) + aoff + m * 2048 + k * 1024); } while (0)
#define PG8_LDB(dst, b, h) do { _Pragma("unroll") for (int n = 0; n < 2; ++n) _Pragma("unroll") for (int k = 0; k < 2; ++k) dst[n][k] = *(const LAS bf16x8*)(lds + PG8_SB(b, h) + boff + n * 2048 + k * 1024); } while (0)
#define PG8_MMA(ai, bj, At, Bt_) do { __builtin_amdgcn_s_setprio(1); _Pragma("unroll") for (int m = 0; m < 4; ++m) _Pragma("unroll") for (int n = 0; n < 2; ++n) _Pragma("unroll") for (int k = 0; k < 2; ++k) \
        acc[ai][bj][m][n] = __builtin_amdgcn_mfma_f32_16x16x32_bf16(Bt_[n][k], At[m][k], acc[ai][bj][m][n], 0, 0, 0); __builtin_amdgcn_s_setprio(0); } while (0)
#define PG8_WAIT_V(n) asm volatile("s_waitcnt vmcnt(" #n ")" ::: "memory")
#define PG8_WAIT_L(n) asm volatile("s_waitcnt lgkmcnt(" #n ")" ::: "memory")
#define PG8_BAR __builtin_amdgcn_s_barrier()
#define PG8_SCHED __builtin_amdgcn_sched_barrier(0)
    f32x4 acc[2][2][4][2];
#pragma unroll
    for (int a = 0; a < 2; ++a)
#pragma unroll
        for (int b = 0; b < 2; ++b)
#pragma unroll
            for (int m = 0; m < 4; ++m)
#pragma unroll
                for (int n = 0; n < 2; ++n) acc[a][b][m][n] = (f32x4){0.f, 0.f, 0.f, 0.f};
    bf16x8 At[4][2], B0[2][2], B1[2][2];
    auto unit_of = [&](int uu, int& z_, int& pm_, int& pn_) {
        if (nZ == 1) {
            int wg = uu; { const int q = nu / 8, r = nu % 8, xcd = wg % 8, off = wg / 8; wg = (xcd < r ? xcd * (q + 1) : r * (q + 1) + (xcd - r) * q) + off; }
            const int nig = 8 * nN, gid = wg / nig, fm = gid * 8, gsz = (nM - fm) < 8 ? (nM - fm) : 8;
            z_ = 0; pm_ = fm + ((wg % nig) % gsz); pn_ = (wg % nig) / gsz;
        } else { z_ = uu / nmn; pm_ = (uu - z_ * nmn) / nN; pn_ = (uu - z_ * nmn) - pm_ * nN; }
    };
    int z, pm, pn; unit_of(u, z, pm, pn);
    const char* cA = (const char*)(A + zm.a(z)) + (size_t)pm * tstepA; const char* cB = (const char*)(Bt + zm.b(z)) + (size_t)pn * tstepB;
    PG8_STAGE(PG8_SB(0, 0), cB, voffB); PG8_STAGE(PG8_SA(0, 0), cA, voffA); PG8_STAGE(PG8_SB(0, 1), cB + hstepB, voffB); PG8_STAGE(PG8_SA(0, 1), cA + hstepA, voffA);
    if (wr == 1) PG8_BAR;
    PG8_WAIT_V(4); PG8_BAR;
    PG8_STAGE(PG8_SB(1, 0), cB + kstep, voffB); PG8_STAGE(PG8_SA(1, 0), cA + kstepA, voffA); PG8_STAGE(PG8_SB(1, 1), cB + hstepB + kstep, voffB);
    PG8_WAIT_V(6); PG8_BAR;
    for (;;) {
        const int un = u + G; const bool has_next = un < nu;
        int nz = z, npm = pm, npn = pn; if (has_next) unit_of(un, nz, npm, npn);
        const char* nA = (const char*)(A + zm.a(nz)) + (size_t)npm * tstepA; const char* nB = (const char*)(Bt + zm.b(nz)) + (size_t)npn * tstepB;
        auto kiter = [&](int t) {
            const bool last = (t == nt - 2);
            const char* a1 = cA + (size_t)(t + 1) * kstepA;
            const char* a2 = last ? nA : cA + (size_t)(t + 2) * kstepA; const char* b2 = last ? nB : cB + (size_t)(t + 2) * kstep;
            const char* a3 = a2 + kstepA; const char* b3 = b2 + kstep;
            PG8_LDB(B0, 0, 0); PG8_SCHED; PG8_LDA(At, 0, 0); PG8_STAGE(PG8_SA(1, 1), a1 + hstepA, voffA);
            PG8_WAIT_L(8); PG8_BAR; PG8_WAIT_L(0); PG8_MMA(0, 0, At, B0); PG8_BAR; PG8_SCHED;
            PG8_LDB(B1, 0, 1); PG8_STAGE(PG8_SB(0, 0), b2, voffB);
            PG8_BAR; PG8_WAIT_L(0); PG8_MMA(0, 1, At, B1); PG8_BAR;
            PG8_LDA(At, 0, 1); PG8_STAGE(PG8_SA(0, 0), a2, voffA);
            PG8_BAR; PG8_WAIT_L(0); PG8_MMA(1, 0, At, B0); PG8_BAR; PG8_SCHED;
            PG8_STAGE(PG8_SB(0, 1), b2 + hstepB, voffB);
            PG8_WAIT_V(6); PG8_BAR; PG8_MMA(1, 1, At, B1); PG8_BAR;
            PG8_LDB(B0, 1, 0); PG8_SCHED; PG8_LDA(At, 1, 0); PG8_STAGE(PG8_SA(0, 1), a2 + hstepA, voffA);
            PG8_WAIT_L(8); PG8_BAR; PG8_WAIT_L(0); PG8_MMA(0, 0, At, B0); PG8_BAR; PG8_SCHED;
            PG8_LDB(B1, 1, 1); PG8_STAGE(PG8_SB(1, 0), b3, voffB);
            PG8_BAR; PG8_WAIT_L(0); PG8_MMA(0, 1, At, B1); PG8_BAR;
            PG8_LDA(At, 1, 1); PG8_STAGE(PG8_SA(1, 0), a3, voffA);
            PG8_BAR; PG8_WAIT_L(0); PG8_MMA(1, 0, At, B0); PG8_BAR; PG8_SCHED;
            PG8_STAGE(PG8_SB(1, 1), b3 + hstepB, voffB);
            PG8_WAIT_V(6); PG8_BAR; PG8_MMA(1, 1, At, B1); PG8_BAR;
        };
        if constexpr (HAS_MID) {
            for (int t = 0; t < (nt >> 1); t += 2) kiter(t);
            E.mid(acc, pm * BM, pn * BM, wr, wc, fr, fq);
            for (int t = nt >> 1; t < nt; t += 2) kiter(t);
        } else {
            for (int t = 0; t < nt; t += 2) kiter(t);
        }
        E(acc, pm * BM, pn * BM + (z << 20), wr, wc, fr, fq);
        if (!has_next) break;
#pragma unroll
        for (int a = 0; a < 2; ++a)
#pragma unroll
            for (int b = 0; b < 2; ++b)
#pragma unroll
                for (int m = 0; m < 4; ++m)
#pragma unroll
                    for (int n = 0; n < 2; ++n) acc[a][b][m][n] = (f32x4){0.f, 0.f, 0.f, 0.f};
        u = un; z = nz; pm = npm; pn = npn; cA = nA; cB = nB;
    }
    PG8_WAIT_V(0);
    if (wr == 0) PG8_BAR;
    PG8_BAR;
#undef PG8_SA
#undef PG8_SB
#undef PG8_STAGE
#undef PG8_LDA
#undef PG8_LDB
#undef PG8_MMA
#undef PG8_WAIT_V
#undef PG8_WAIT_L
#undef PG8_BAR
#undef PG8_SCHED
}

__device__ __forceinline__ f32x4 mfma16(bf16x8 a, bf16x8 b, f32x4 c) { return __builtin_amdgcn_mfma_f32_16x16x32_bf16(a, b, c, 0, 0, 0); }
__device__ __forceinline__ bf16x8 pack_p(const f32x4& a, const f32x4& b) {
    u32x4 w; w.x = cvt_pk_bf16(a[0], a[1]); w.y = cvt_pk_bf16(a[2], a[3]); w.z = cvt_pk_bf16(b[0], b[1]); w.w = cvt_pk_bf16(b[2], b[3]);
    return __builtin_bit_cast(bf16x8, w);
}
__device__ __forceinline__ size_t kfrag_off(int key, int d) { return ((size_t)((key >> 4) * 2 + (d >> 5)) * 64 + ((d >> 3) & 3) * 16 + (key & 15)) * 8 + (d & 7); }
__device__ __forceinline__ size_t vfrag_off(int key, int d) {
    return ((size_t)((key >> 5) * 4 + (d >> 4)) * 64 + ((key >> 2) & 3) * 16 + (d & 15)) * 8 + ((key >> 4) & 1) * 4 + (key & 3);
}
__device__ __forceinline__ void st_bf16x4(bf16_t* p, f32x4 v) { u32x2 w; w.x = cvt_pk_bf16(v[0], v[1]); w.y = cvt_pk_bf16(v[2], v[3]); *(u32x2*)p = w; }

struct EpiIn {
    const Params& p;
    __device__ __forceinline__ void apply(int row, int col, f32x4 v) const {
        const Params& P = p; const int pn = col >> 8, c = col & 255;
        if (pn < 2) st_bf16x4(P.Qb + (size_t)row * QD + col, v * QSCALE);
        else if (pn < 5) {
            if (pn != 2) st_bf16x4((pn == 3 ? P.SLCb : P.WINb) + (size_t)row * 256 + c, v);
            if (pn < 4) *(f32x4*)(P.out + (pn == 2 ? O_CMPS : O_SLCS) + (size_t)(row - MP) * 256 + c) = v;
            else *(f32x4*)(P.out + O_WINS + ((size_t)(row - MP) * WIN + (WIN - 1)) * 256 + c) = v;
        } else if (pn < 9) {
            f32x4 g; g[0] = geluf_(v[0]); g[1] = geluf_(v[1]); g[2] = geluf_(v[2]); g[3] = geluf_(v[3]);
            st_bf16x4((pn < 7 ? P.U : P.Vg) + (size_t)row * GMD + (col - (pn < 7 ? 1280 : 1792)), g);
        } else if (pn < 17) {
            f32x4 g; g[0] = sigmoidf_(v[0]); g[1] = sigmoidf_(v[1]); g[2] = sigmoidf_(v[2]); g[3] = sigmoidf_(v[3]);
            st_bf16x4((pn < 13 ? P.GA : P.GB) + (size_t)row * DM + (col - (pn < 13 ? 2304 : 3328)), g);
        } else if (c < 24) { f32x4 g; g[0] = sigmoidf_(v[0]); g[1] = sigmoidf_(v[1]); g[2] = sigmoidf_(v[2]); g[3] = sigmoidf_(v[3]); *(f32x4*)(P.GATE + (size_t)row * 32 + c) = g; }
    }
    __device__ __forceinline__ void operator()(const f32x4 (&acc)[2][2][4][2], int brow, int bcol, int wr, int wc, int fr, int fq) const {
        const int pn = bcol >> 8;
        const Params& P = p;
        if (pn < 2) {
            for_each_frag(acc, brow, bcol, wr, wc, fr, fq, [&](int row, int col, f32x4 v) { st_bf16x4(P.Qb + (size_t)row * QD + col, v * QSCALE); });
        } else if (pn < 5) {
            bf16_t* cp = pn == 2 ? P.CMPb : pn == 3 ? P.SLCb : P.WINb;
            for_each_frag(acc, brow, bcol, wr, wc, fr, fq, [&](int row, int col, f32x4 v) {
                const int c = col & 255;
                if (pn == 2) st_bf16x4(cp + (size_t)row * 256 + c, v);
                if (pn >= 3 && c < 128 && row < MP) {
                    st_bf16x4((pn == 3 ? P.SLCkF : P.WINkF) + ((size_t)(row >> 13) * NG + (c >> 6)) * SEQ * 64 + kfrag_off(row & (SEQ - 1), c & 63), v);
                }
                if (pn >= 3 && c >= 128 && row < MP) {
                    const int t = row & (SEQ - 1), dc = c - 128;
                    bf16_t* vt = (pn == 3 ? P.SLCvT : P.WINvT) + ((size_t)(row >> 13) * NG + (dc >> 6)) * SEQ * 64 + vfrag_off(t, dc & 63);
                    vt[0] = f2bf(v[0]); vt[8] = f2bf(v[1]); vt[16] = f2bf(v[2]); vt[24] = f2bf(v[3]);
                }
                if (pn < 4) {
                    if (row < MP) *(f32x4*)(P.out + (pn == 2 ? O_CMPP : O_SLCP) + (size_t)row * 256 + c) = v;
                    else if (row < MP + NS) *(f32x4*)(P.out + (pn == 2 ? O_CMPS : O_SLCS) + (size_t)(row - MP) * 256 + c) = v;
                } else {
                    if (row < MP) { const int t = row & (SEQ - 1), b = row >> 13; if (t >= SEQ - WIN) *(f32x4*)(P.out + O_WINP + ((size_t)b * WIN + (t - (SEQ - WIN))) * 256 + c) = v; }
                    else if (row < MP + NS) *(f32x4*)(P.out + O_WINS + ((size_t)(row - MP) * WIN + (WIN - 1)) * 256 + c) = v;
                }
            });
        } else if (pn < 9) {
            bf16_t* dst = pn < 7 ? P.U : P.Vg; const int c0 = pn < 7 ? 1280 : 1792;
            for_each_frag(acc, brow, bcol, wr, wc, fr, fq, [&](int row, int col, f32x4 v) {
                f32x4 g; g[0] = geluf_(v[0]); g[1] = geluf_(v[1]); g[2] = geluf_(v[2]); g[3] = geluf_(v[3]);
                st_bf16x4(dst + (size_t)row * GMD + (col - c0), g); });
        } else if (pn < 17) {
            bf16_t* dst = pn < 13 ? P.GA : P.GB; const int c0 = pn < 13 ? 2304 : 3328;
            for_each_frag(acc, brow, bcol, wr, wc, fr, fq, [&](int row, int col, f32x4 v) {
                f32x4 g; g[0] = sigmoidf_(v[0]); g[1] = sigmoidf_(v[1]); g[2] = sigmoidf_(v[2]); g[3] = sigmoidf_(v[3]);
                st_bf16x4(dst + (size_t)row * DM + (col - c0), g); });
        } else {
            for_each_frag(acc, brow, bcol, wr, wc, fr, fq, [&](int row, int col, f32x4 v) {
                const int c = col & 255;
                if (c < 24) { f32x4 g; g[0] = sigmoidf_(v[0]); g[1] = sigmoidf_(v[1]); g[2] = sigmoidf_(v[2]); g[3] = sigmoidf_(v[3]); *(f32x4*)(P.GATE + (size_t)row * 32 + c) = g; } });
        }
    }
};
struct EpiBranch {
    const bf16_t* GA; const bf16_t* GB; bf16_t* Y1;
    __device__ __forceinline__ void mid(f32x4 (&acc)[2][2][4][2], int brow, int bcol, int wr, int wc, int fr, int fq) const {
#pragma unroll
        for (int ai = 0; ai < 2; ++ai)
#pragma unroll
            for (int m = 0; m < 4; ++m)
#pragma unroll
                for (int bj = 0; bj < 2; ++bj)
#pragma unroll
                    for (int n = 0; n < 2; ++n) {
                        const size_t o = (size_t)(brow + ai * HALF + wr * 64 + m * 16 + fr) * DM + bcol + bj * HALF + wc * 32 + n * 16 + fq * 4;
                        const u32x2 a = *(const u32x2*)(GA + o), b = *(const u32x2*)(GB + o);
                        f32x4& v = acc[ai][bj][m][n];
                        v[0] *= bflo(a.x) / fmaxf(bflo(b.x), 1e-30f); v[1] *= bfhi(a.x) / fmaxf(bfhi(b.x), 1e-30f);
                        v[2] *= bflo(a.y) / fmaxf(bflo(b.y), 1e-30f); v[3] *= bfhi(a.y) / fmaxf(bfhi(b.y), 1e-30f);
                        if (bj == 1 && n == 1) __builtin_amdgcn_sched_barrier(0);
                    }
    }
    __device__ __forceinline__ void operator()(const f32x4 (&acc)[2][2][4][2], int brow, int bcol, int wr, int wc, int fr, int fq) const {
        for_each_frag(acc, brow, bcol, wr, wc, fr, fq, [&](int row, int col, f32x4 v) {
            const u32x2 b = *(const u32x2*)(GB + (size_t)row * DM + col);
            f32x4 o; o[0] = v[0] * fmaxf(bflo(b.x), 1e-30f); o[1] = v[1] * fmaxf(bfhi(b.x), 1e-30f); o[2] = v[2] * fmaxf(bflo(b.y), 1e-30f); o[3] = v[3] * fmaxf(bfhi(b.y), 1e-30f);
            st_bf16x4(Y1 + (size_t)row * DM + col, o); });
    }
    __device__ __forceinline__ void apply2(int row, int col, f32x4 v1, f32x4 v2) const {
        const u32x2 a = *(const u32x2*)(GA + (size_t)row * DM + col), b = *(const u32x2*)(GB + (size_t)row * DM + col);
        f32x4 o; o[0] = v1[0] * bflo(a.x) + v2[0] * bflo(b.x); o[1] = v1[1] * bfhi(a.x) + v2[1] * bfhi(b.x); o[2] = v1[2] * bflo(a.y) + v2[2] * bflo(b.y); o[3] = v1[3] * bfhi(a.y) + v2[3] * bfhi(b.y);
        st_bf16x4(Y1 + (size_t)row * DM + col, o);
    }
};
struct EpiF32 {
    float* F; int ld;
    __device__ __forceinline__ void apply(int row, int col, f32x4 v) const { *(f32x4*)(F + (size_t)row * ld + col) = v; }
    __device__ __forceinline__ void operator()(const f32x4 (&acc)[2][2][4][2], int brow, int bcol, int wr, int wc, int fr, int fq) const {
        for_each_frag(acc, brow, bcol, wr, wc, fr, fq, [&](int row, int col, f32x4 v) { *(f32x4*)(F + (size_t)row * ld + col) = v; });
    }
};
struct EpiBf16 {
    bf16_t* O; int ld;
    __device__ __forceinline__ void apply(int row, int col, f32x4 v) const { st_bf16x4(O + (size_t)row * ld + col, v); }
    __device__ __forceinline__ void operator()(const f32x4 (&acc)[2][2][4][2], int brow, int bcol, int wr, int wc, int fr, int fq) const {
        for_each_frag(acc, brow, bcol, wr, wc, fr, fq, [&](int row, int col, f32x4 v) { apply(row, col, v); });
    }
};
struct EpiPart {
    bf16_t* PART;
    __device__ __forceinline__ void operator()(const f32x4 (&acc)[2][2][4][2], int brow, int bcol, int wr, int wc, int fr, int fq) const {
        const int z = bcol >> 20;
        for_each_frag(acc, brow, 0, wr, wc, fr, fq, [&](int row, int col, f32x4 v) { st_bf16x4(PART + ((size_t)row * 4 + z) * 256 + col, v); });
    }
};
struct ZCmp { __device__ __forceinline__ size_t a(int z) const { return (size_t)z * 64; } __device__ __forceinline__ size_t b(int z) const { return (size_t)(z >> 1) * 256 * 1024; } };
struct EpiSwiGLU {
    bf16_t* ACT;
    __device__ __forceinline__ void apply(int row, int col, f32x4 v) const { *(unsigned*)(ACT + (size_t)row * DFF + (col >> 1)) = cvt_pk_bf16(siluf_(v[0]) * v[1], siluf_(v[2]) * v[3]); }
    __device__ __forceinline__ void operator()(const f32x4 (&acc)[2][2][4][2], int brow, int bcol, int wr, int wc, int fr, int fq) const {
        for_each_frag(acc, brow, bcol, wr, wc, fr, fq, [&](int row, int col, f32x4 v) {
            *(unsigned*)(ACT + (size_t)row * DFF + (col >> 1)) = cvt_pk_bf16(siluf_(v[0]) * v[1], siluf_(v[2]) * v[3]); });
    }
};
struct EpiPleGate {
    const bf16_t* E; bf16_t* F;
    __device__ __forceinline__ void apply(int row, int col, f32x4 v) const {
        const u32x2 w = *(const u32x2*)(E + (size_t)row * DM + col);
        f32x4 o; o[0] = sigmoidf_(v[0]) * bflo(w.x); o[1] = sigmoidf_(v[1]) * bfhi(w.x); o[2] = sigmoidf_(v[2]) * bflo(w.y); o[3] = sigmoidf_(v[3]) * bfhi(w.y);
        st_bf16x4(F + (size_t)row * DM + col, o); }
    __device__ __forceinline__ void operator()(const f32x4 (&acc)[2][2][4][2], int brow, int bcol, int wr, int wc, int fr, int fq) const {
        for_each_frag(acc, brow, bcol, wr, wc, fr, fq, [&](int row, int col, f32x4 v) { apply(row, col, v); });
    }
};

template <class Epi>
__device__ __forceinline__ void gemm_skinny(const bf16_t* A  , int lda, const bf16_t* Bt, int K, int N, const Epi& E) {
    int tid = threadIdx.x; asm volatile("" : "+v"(tid));
    const int wid = __builtin_amdgcn_readfirstlane(tid >> 6), lane = tid & 63, c = lane & 15, G = lane >> 4;
    LAS f32x4* red = (LAS f32x4*)smem;
    const int nsteps = K / 32;
#pragma unroll 1
    for (int ct = blockIdx.x; ct < N / 16; ct += gridDim.x) {
        f32x4 acc0 = {0.f, 0.f, 0.f, 0.f}, acc1 = {0.f, 0.f, 0.f, 0.f};
        const bf16_t* bp = Bt + (size_t)(ct * 16 + c) * K + G * 8;
        const bf16_t* a0 = A + (size_t)c * lda + G * 8; const bf16_t* a1 = A + (size_t)(16 + c) * lda + G * 8;
#pragma unroll 4
        for (int kk = wid; kk < nsteps; kk += 8) {
            const bf16x8 bf = *(const bf16x8*)(bp + kk * 32), x0 = *(const bf16x8*)(a0 + kk * 32), x1 = *(const bf16x8*)(a1 + kk * 32);
            acc0 = mfma16(bf, x0, acc0); acc1 = mfma16(bf, x1, acc1);
        }
        __syncthreads();
        red[(wid * 2 + 0) * 64 + lane] = acc0; red[(wid * 2 + 1) * 64 + lane] = acc1;
        __syncthreads();
        if (tid < 128) {
            const int rt = tid >> 6;
            f32x4 v = red[rt * 64 + lane];
#pragma unroll
            for (int w = 1; w < 8; ++w) v = v + red[(w * 2 + rt) * 64 + lane];
            E.apply(MP + rt * 16 + c, ct * 16 + 4 * G, v);
        }
    }
    __syncthreads();
}

template <class Epi>
__device__ __forceinline__ void gemm_skinny2(const bf16_t* A  , int lda, const bf16_t* Bt, int K, int N, const Epi& E) {
    int tid = threadIdx.x; asm volatile("" : "+v"(tid));
    const int wid = __builtin_amdgcn_readfirstlane(tid >> 6), lane = tid & 63, c = lane & 15, G = lane >> 4;
    LAS f32x4* red = (LAS f32x4*)smem;
    const int hsteps = K / 64;
#pragma unroll 1
    for (int ct = blockIdx.x; ct < N / 16; ct += gridDim.x) {
        f32x4 acc[4] = {{0.f, 0.f, 0.f, 0.f}, {0.f, 0.f, 0.f, 0.f}, {0.f, 0.f, 0.f, 0.f}, {0.f, 0.f, 0.f, 0.f}};
        const bf16_t* bp = Bt + (size_t)(ct * 16 + c) * K + G * 8;
        const bf16_t* a0 = A + (size_t)c * lda + G * 8; const bf16_t* a1 = A + (size_t)(16 + c) * lda + G * 8;
#pragma unroll
        for (int h = 0; h < 2; ++h) {
#pragma unroll 2
            for (int kk = h * hsteps + wid; kk < (h + 1) * hsteps; kk += 8) {
                const bf16x8 bf = *(const bf16x8*)(bp + kk * 32), x0 = *(const bf16x8*)(a0 + kk * 32), x1 = *(const bf16x8*)(a1 + kk * 32);
                acc[h * 2] = mfma16(bf, x0, acc[h * 2]); acc[h * 2 + 1] = mfma16(bf, x1, acc[h * 2 + 1]);
            }
        }
        __syncthreads();
#pragma unroll
        for (int q = 0; q < 4; ++q) red[(wid * 4 + q) * 64 + lane] = acc[q];
        __syncthreads();
        if (tid < 128) {
            const int rt = tid >> 6;
            f32x4 v1 = red[rt * 64 + lane], v2 = red[(2 + rt) * 64 + lane];
#pragma unroll
            for (int w = 1; w < 8; ++w) { v1 = v1 + red[(w * 4 + rt) * 64 + lane]; v2 = v2 + red[(w * 4 + 2 + rt) * 64 + lane]; }
            E.apply2(MP + rt * 16 + c, ct * 16 + 4 * G, v1, v2);
        }
    }
    __syncthreads();
}

template <class Map>
__device__ __forceinline__ void transpose_tile(const float* W, int K, int N, bf16_t* Wt, int ldk, int kt, int ntile, Map map) {
    LAS float* tile = (LAS float*)smem;
    const int t = threadIdx.x;
    __syncthreads();
#pragma unroll
    for (int i = 0; i < 2; ++i) {
        const int k = (t >> 4) + 32 * i, n = (t & 15) * 4, gn = ntile * 64 + n;
        f32x4 v = (f32x4){0.f, 0.f, 0.f, 0.f};
        if (gn < N) v = *(const f32x4*)(W + (size_t)(kt * 64 + k) * N + gn);
        tile[k * 65 + n] = v[0]; tile[k * 65 + n + 1] = v[1]; tile[k * 65 + n + 2] = v[2]; tile[k * 65 + n + 3] = v[3];
    }
    __syncthreads();
    const int n = t >> 3, kc = (t & 7) * 8, gn = ntile * 64 + n;
    if (gn < N) {
        u32x4 w;
        w.x = cvt_pk_bf16(tile[(kc + 0) * 65 + n], tile[(kc + 1) * 65 + n]); w.y = cvt_pk_bf16(tile[(kc + 2) * 65 + n], tile[(kc + 3) * 65 + n]);
        w.z = cvt_pk_bf16(tile[(kc + 4) * 65 + n], tile[(kc + 5) * 65 + n]); w.w = cvt_pk_bf16(tile[(kc + 6) * 65 + n], tile[(kc + 7) * 65 + n]);
        *(u32x4*)(Wt + (size_t)map(gn) * ldk + kt * 64 + kc) = w;
    }
}
template <class Map>
__device__ __forceinline__ void transpose_all(const float* W, int K, int N, bf16_t* Wt, int ldk, Map map, int& base) {
    const int nkt = K / 64, nnt = (N + 63) / 64, ntl = nkt * nnt;
    for (int it = blockIdx.x; it < base + ntl; it += gridDim.x) {
        if (it < base) continue;
        const int l = it - base;
        transpose_tile(W, K, N, Wt, ldk, l / nnt, l % nnt, map);
    }
    base += ntl;
}
template <class Map>
__device__ __forceinline__ void transpose_all_sub(const float* W, int K, int N, bf16_t* Wt, int ldk, Map map, int& base) {
    const int nkt = K / 64, nnt = (N + 63) / 64, ntl = nkt * nnt, nb = gridDim.x - 32, me = blockIdx.x - 32;
    int first = base - (base % nb) + me; if (first < base) first += nb;
    for (int it = first; it < base + ntl; it += nb) { const int l = it - base; transpose_tile(W, K, N, Wt, ldk, l / nnt, l % nnt, map); }
    base += ntl;
}
__device__ __forceinline__ int map_win(int n) {
    if (n < 1280) return n;
    if (n < 1304) return 4352 + (n - 1280);
    if (n < 2328) return 1280 + (n - 1304);
    return 2304 + (n - 2328);
}

__device__ __forceinline__ float row_rstd(const f32x4 (&v)[4]) {
    float s = 0.f;
#pragma unroll
    for (int k = 0; k < 4; ++k) s += v[k][0] * v[k][0] + v[k][1] * v[k][1] + v[k][2] * v[k][2] + v[k][3] * v[k][3];
    s = wave_sum(s);
    return rsqrtf(s * (1.0f / DM) + EPS);
}
__device__ __forceinline__ const float* xrow_ptr(const Params& p, int row) {
    return row < MP ? p.x_prompt + (size_t)row * DM : p.x_sample + (size_t)(row - MP) * DM;
}

__device__ __forceinline__ void phase_prologue(const Params& p) {
    const int wid = threadIdx.x >> 6, lane = threadIdx.x & 63;
    const int gw = blockIdx.x * 8 + wid, nw = gridDim.x * 8;
    auto do_transposes = [&]() {
    int base = 0;
    transpose_all(p.w_in, DM, IND, p.WinT, DM, [](int n) { return map_win(n); }, base);
    for (int kv = 0; kv < 2; ++kv) for (int j = 0; j < 2; ++j)
        transpose_all((kv ? p.w1_v : p.w1_k) + (size_t)j * 1024 * 128, 1024, 128, p.W1T + ((size_t)kv * 256 + j * 128) * 1024, 1024, [](int n) { return n; }, base);
    };
    do_transposes();
    __syncthreads();
    for (int i = blockIdx.x * 512 + threadIdx.x; i < (INP - IND) * DM / 8; i += gridDim.x * 512) ((u32x4*)(p.WinT + (size_t)IND * DM))[i] = (u32x4){0u, 0u, 0u, 0u};
    for (int row0 = gw * 2; row0 < MP + NS; row0 += nw * 2) {
        f32x4 v[2][4];
#pragma unroll
        for (int q = 0; q < 2; ++q) { const float* xr = xrow_ptr(p, row0 + q);
#pragma unroll
            for (int k = 0; k < 4; ++k) v[q][k] = *(const f32x4*)(xr + lane * 4 + k * 256); }
#pragma unroll
        for (int q = 0; q < 2; ++q) {
            const int row = row0 + q;
            u32x2* hd = (u32x2*)(p.H + (size_t)row * DM);
            const float r = row_rstd(v[q]);
#pragma unroll
            for (int k = 0; k < 4; ++k) { const f32x4 g = *(const f32x4*)(p.ln_mix_pre + lane * 4 + k * 256); const f32x4 o = v[q][k] * r * g; u32x2 w; w.x = cvt_pk_bf16(o[0], o[1]); w.y = cvt_pk_bf16(o[2], o[3]); hd[lane + k * 64] = w; }
            const float* pr = row < MP ? p.p_prompt + (size_t)row * PLE : p.p_sample + (size_t)(row - MP) * PLE;
            const f32x4 pv = *(const f32x4*)(pr + lane * 4);
            u32x2 w; w.x = cvt_pk_bf16(pv[0], pv[1]); w.y = cvt_pk_bf16(pv[2], pv[3]);
            ((u32x2*)(p.Pb + (size_t)row * PLE))[lane] = w;
        }
    }
    for (int i = blockIdx.x * 512 + threadIdx.x; i < 4 * 128 * 128; i += gridDim.x * 512) { const int t = (i >> 7) & 127, s = i & 127; p.GWb[i] = f2bf(s <= t ? p.gm_ws[i] : 0.f); }
    for (int i = blockIdx.x * 512 + threadIdx.x; i < 2 * 64 * 128; i += gridDim.x * 512) { const int kv = i >> 13, d = (i >> 7) & 63, h = i & 127; p.W2T[i] = f2bf((kv ? p.w2_v : p.w2_k)[h * 64 + d]); }
    if (gw < 256) {
        const int kv = gw >> 7, h = gw & 127;
        const float* pe = kv ? p.pe_v : p.pe_k; const float* w1 = kv ? p.w1_v : p.w1_k;
        float s = 0.f;
#pragma unroll 8
        for (int k = lane; k < 2048; k += 64) s += pe[k] * w1[(size_t)k * 128 + h];
        s = wave_sum(s);
        if (lane == 0) p.PEB[kv * 128 + h] = s;
    }
    for (int i = blockIdx.x * 512 + threadIdx.x; i < NS * (WIN - 1) * 64; i += gridDim.x * 512) {
        const int b = i / ((WIN - 1) * 64), r = i % ((WIN - 1) * 64);
        ((f32x4*)(p.out + O_WINS + (size_t)b * WIN * 256))[r] = ((const f32x4*)(p.state_win + (size_t)b * WIN * 256 + 256))[r];
    }
}

__device__ __forceinline__ void phase_deferred_transposes(const Params& p) {
    if (blockIdx.x < 32) return;
    int base = 0;
    transpose_all_sub(p.w_br_nsa, QD, DM, p.WnT, DM, [](int n) { return n; }, base);
    transpose_all_sub(p.w_br_gm, GMD, DM, p.WnT + QD, DM, [](int n) { return n; }, base);
    transpose_all_sub(p.w_out, DM, DM, p.WoT, DM, [](int n) { return n; }, base);
    transpose_all_sub(p.w_gate, DM, DFF, p.WguT, DM, [](int n) { return 2 * n; }, base);
    transpose_all_sub(p.w_up, DM, DFF, p.WguT, DM, [](int n) { return 2 * n + 1; }, base);
    transpose_all_sub(p.w_down, DFF, DM, p.WdT, DFF, [](int n) { return n; }, base);
    transpose_all_sub(p.w_ple_gate, DM, DM, p.WpgT, DM, [](int n) { return n; }, base);
    transpose_all_sub(p.w_ple, PLE, DM, p.WpT, PLE, [](int n) { return n; }, base);
    __syncthreads();
}
__device__ __forceinline__ void phase_gather(const Params& p) {
    int tid = threadIdx.x; asm volatile("" : "+v"(tid));
    const int wid = tid >> 6, lane = tid & 63;
    const int gw = (blockIdx.x >> 1) * 8 + wid, nw = (gridDim.x >> 1) * 8;
    const int cls = blockIdx.x & 1;
#pragma unroll 1
    for (int r8h = gw; r8h < NS * PAST / 16; r8h += nw) {
        const int r8 = r8h * 2 + cls;
        const int r = r8 * 8, b = r >> 14, pos = r & (PAST - 1), l5 = lane & 31, hrow = lane >> 5;
        const float* s = p.cache_cmp + ((size_t)p.page_table[b * NPG + (pos >> 7)] * PAGE + (pos & 127) + hrow) * 256 + l5 * 8;
        f32x4 a[4], cc[4];
#pragma unroll
        for (int k = 0; k < 4; ++k) { a[k] = *(const f32x4*)(s + (size_t)k * 512); cc[k] = *(const f32x4*)(s + (size_t)k * 512 + 4); }
#pragma unroll
        for (int k = 0; k < 4; ++k) {
            u32x4 w; w.x = cvt_pk_bf16(a[k][0], a[k][1]); w.y = cvt_pk_bf16(a[k][2], a[k][3]); w.z = cvt_pk_bf16(cc[k][0], cc[k][1]); w.w = cvt_pk_bf16(cc[k][2], cc[k][3]);
            *(u32x4*)(p.CMPb + ((size_t)MP + r + 2 * k + hrow) * 256 + l5 * 8) = w;
        }
    }
}

__device__ __forceinline__ void phase_cmp_final(const Params& p) {
    const int wid = threadIdx.x >> 6, lane = threadIdx.x & 63;
    {
        const int c = lane & 15, G = lane >> 4;
        const int ngrp_p = NB * 4 * 32, ngrp_s = NS * 4 * 64;
#pragma unroll 1
        for (int it = blockIdx.x * 8 + wid; it < ngrp_p + ngrp_s; it += gridDim.x * 8) {
            const bool smp = it >= ngrp_p; const int l = smp ? it - ngrp_p : it;
            const int nch = smp ? 64 : 32, nc = smp ? NCS : NCP;
            const int ch = l % nch, z = (l / nch) & 3, seq = l / (nch * 4), kv = z >> 1, g = z & 1, n0 = ch * 16;
            const size_t r0 = smp ? (size_t)2048 + (size_t)seq * 1024 : (size_t)seq * 512;
            const int nr = n0 + c < nc ? n0 + c : nc - 1;
            const bf16_t* p0 = (const bf16_t*)p.PART + ((r0 + nr) * 4 + z) * 256;
            const bf16_t* p1 = (const bf16_t*)p.PART + ((r0 + nr + 1) * 4 + z) * 256 + 128;
            const float* pb = p.PEB + kv * 128;
            f32x4 acc[4] = {{0.f, 0.f, 0.f, 0.f}, {0.f, 0.f, 0.f, 0.f}, {0.f, 0.f, 0.f, 0.f}, {0.f, 0.f, 0.f, 0.f}};
#pragma unroll
            for (int ks = 0; ks < 4; ++ks) {
                const int h0 = 32 * ks + 8 * G;
                const u32x4 wa = *(const u32x4*)(p0 + h0), wb = *(const u32x4*)(p1 + h0);
                const f32x4 a0 = {bflo(wa.x), bfhi(wa.x), bflo(wa.y), bfhi(wa.y)}, a1 = {bflo(wa.z), bfhi(wa.z), bflo(wa.w), bfhi(wa.w)};
                const f32x4 b0 = {bflo(wb.x), bfhi(wb.x), bflo(wb.y), bfhi(wb.y)}, b1 = {bflo(wb.z), bfhi(wb.z), bflo(wb.w), bfhi(wb.w)};
                const f32x4 e0 = *(const f32x4*)(pb + h0), e1 = *(const f32x4*)(pb + h0 + 4);
                f32x4 x0 = a0 + b0 + e0, x1 = a1 + b1 + e1;
#pragma unroll
                for (int i = 0; i < 4; ++i) { x0[i] = siluf_(x0[i]); x1[i] = siluf_(x1[i]); }
                const bf16x8 A = pack_p(x0, x1);
#pragma unroll
                for (int nt = 0; nt < 4; ++nt) {
                    const bf16x8 B = *(const bf16x8*)(p.W2T + ((size_t)kv * 64 + nt * 16 + c) * 128 + h0);
                    acc[nt] = mfma16(A, B, acc[nt]);
                }
            }
#pragma unroll
            for (int nt = 0; nt < 4; ++nt) {
                const int d = nt * 16 + c;
#pragma unroll
                for (int i = 0; i < 4; ++i) {
                    const int n = n0 + 4 * G + i;
                    if (n < nc) {
                        if (smp) ((kv ? p.VCS : p.KCS) + (((size_t)seq * NG + g) * 1024 + n) * 64)[d] = acc[nt][i];
                        else if (kv == 0) p.KCb[((size_t)seq * NG + g) * 512 * 64 + kfrag_off(n, d)] = f2bf(acc[nt][i]);
                    }
                }
                if (!smp && kv == 1) {
                    f32x4 v = acc[nt];
#pragma unroll
                    for (int i = 0; i < 4; ++i) if (n0 + 4 * G + i >= nc) v[i] = 0.f;
                    st_bf16x4(p.VCT + ((size_t)seq * NG + g) * 512 * 64 + vfrag_off(n0 + 4 * G, d), v);
                }
            }
        }
    }
}

template <bool SAMPLE>
__device__ __forceinline__ void kv_row_ptr(const Params& p, int branch  , int b, int pos, int kv, int g, const bf16_t*& pb, const float*& pf) {
    const int off = kv * 128 + g * 64;
    if (!SAMPLE) { pf = nullptr; pb = (branch == 1 ? p.SLCb : p.WINb) + ((size_t)b * SEQ + pos) * 256 + off; }
    else if (pos >= PAST) { pf = nullptr; pb = (branch == 1 ? p.SLCb : p.WINb) + ((size_t)MP + b) * 256 + off; }
    else if (branch == 1) { pb = nullptr; pf = p.cache_slc + ((size_t)p.page_table[b * NPG + (pos >> 7)] * PAGE + (pos & 127)) * 256 + off; }
    else { pb = nullptr; pf = p.state_win + ((size_t)b * WIN + (pos - (PAST - WIN))) * 256 + off; }
}
__device__ __forceinline__ void dot4x64(const bf16_t* pb, const float* pf, const LAS float* qs_, float (&s)[4]) {
    s[0] = s[1] = s[2] = s[3] = 0.f;
    const LAS float* qs = qs_; asm volatile("" : "+v"(qs));
    if (pf) {
#pragma unroll 8
        for (int c = 0; c < 16; ++c) {
            const f32x4 kx = *(const f32x4*)(pf + c * 4);
#pragma unroll
            for (int h = 0; h < 4; ++h) { const f32x4 q = *(const LAS f32x4*)(qs + h * 64 + c * 4); s[h] += q[0] * kx[0] + q[1] * kx[1] + q[2] * kx[2] + q[3] * kx[3]; }
        }
    } else {
#pragma unroll 2
        for (int c = 0; c < 8; ++c) {
            const u32x4 w = *(const u32x4*)(pb + c * 8);
            const float k0 = bflo(w.x), k1 = bfhi(w.x), k2 = bflo(w.y), k3 = bfhi(w.y), k4 = bflo(w.z), k5 = bfhi(w.z), k6 = bflo(w.w), k7 = bfhi(w.w);
#pragma unroll
            for (int h = 0; h < 4; ++h) {
                const f32x4 qa = *(const LAS f32x4*)(qs + h * 64 + c * 8), qb = *(const LAS f32x4*)(qs + h * 64 + c * 8 + 4);
                s[h] += qa[0] * k0 + qa[1] * k1 + qa[2] * k2 + qa[3] * k3 + qb[0] * k4 + qb[1] * k5 + qb[2] * k6 + qb[3] * k7;
            }
        }
    }
}
template <bool SAMPLE>
__device__ __forceinline__ void attn_chunk(const Params& p, int branch, int b, int g, int t, int pos0, int lo, int hi,
                                           float (&m)[4], float (&l)[4], float (&o)[4], const LAS float* qs, LAS float* pbk, const LAS float* relb, int lane) {
    const int pos = pos0 + lane;
    const bool valid = pos >= lo && pos <= hi;
    float s[4] = {-1e30f, -1e30f, -1e30f, -1e30f};
    if (valid) {
        const bf16_t* pb; const float* pf; kv_row_ptr<SAMPLE>(p, branch, b, pos, 0, g, pb, pf);
        dot4x64(pb, pf, qs, s);
        const int bk = t5_bucket(t - pos);
#pragma unroll
        for (int h = 0; h < 4; ++h) s[h] += relb[bk * 8 + g * 4 + h];
    }
#pragma unroll
    for (int h = 0; h < 4; ++h) {
        const float mx = wave_max(s[h]);
        const float mn = fmaxf(m[h], mx);
        const float pr = valid ? ex2(s[h] - mn) : 0.f;
        const float sm = wave_sum(pr);
        const float al = ex2(m[h] - mn);
        l[h] = l[h] * al + sm; o[h] *= al; m[h] = mn;
        pbk[h * 64 + lane] = pr;
    }
    __builtin_amdgcn_wave_barrier();
    const int k0 = (lo > pos0 ? lo : pos0) - pos0, k1 = (hi < pos0 + 63 ? hi : pos0 + 63) - pos0;
    if (SAMPLE) {
        const int kend = (PAST - 1 - pos0) < k1 ? (PAST - 1 - pos0) : k1;
        if (kend >= k0) {
            const bf16_t* pb; const float* pf; kv_row_ptr<SAMPLE>(p, branch, b, pos0 + k0, 1, g, pb, pf);
            pf += lane;
#pragma unroll 16
            for (int k = k0; k <= kend; ++k) {
                const float v = pf[(size_t)(k - k0) * 256];
#pragma unroll
                for (int h = 0; h < 4; ++h) o[h] += pbk[h * 64 + k] * v;
            }
        }
        if (k1 > kend) {
            const bf16_t* pb; const float* pf; kv_row_ptr<SAMPLE>(p, branch, b, pos0 + k1, 1, g, pb, pf);
            const float v = bf2f(pb[lane]);
#pragma unroll
            for (int h = 0; h < 4; ++h) o[h] += pbk[h * 64 + k1] * v;
        }
    } else {
#pragma unroll 1
    for (int k = k0; k <= k1; ++k) {
        const bf16_t* pb; const float* pf; kv_row_ptr<SAMPLE>(p, branch, b, pos0 + k, 1, g, pb, pf);
        const float v = pf ? pf[lane] : bf2f(pb[lane]);
#pragma unroll
        for (int h = 0; h < 4; ++h) o[h] += pbk[h * 64 + k] * v;
    }
    }
    __builtin_amdgcn_wave_barrier();
}

constexpr int S_QS = 0, S_SC = 1024, S_PHS = S_SC + 4 * 1024 * 4, S_PBK = S_PHS + 1088 * 4, S_PART = S_PBK + 8 * 1024, S_RED = S_PART + 2 * 8 * 272 * 4, S_OCP = S_RED + 512,
              S_SEL = S_OCP + 2048, S_RELB = S_SEL + 64, ATTS_LDS = S_RELB + 1024;
__device__ __forceinline__ void attn_sample_item(const Params& p, int b, int g) {
    const int tid = threadIdx.x, wid = tid >> 6, lane = tid & 63;
    constexpr int t = PAST, NC = NCS, NSEL = 257, NJR = 5, qblk = PAST >> 6;
    const int row = MP + b;
    LAS unsigned char* L = (LAS unsigned char*)smem;
    LAS float* qs = (LAS float*)(L + S_QS); LAS float* sc = (LAS float*)(L + S_SC); LAS float* phs = (LAS float*)(L + S_PHS); LAS float* pbk = (LAS float*)(L + S_PBK) + wid * 256;
    LAS float* part = (LAS float*)(L + S_PART); LAS float* red = (LAS float*)(L + S_RED); LAS float* ocp = (LAS float*)(L + S_OCP); LAS int* sel = (LAS int*)(L + S_SEL);
    LAS float* relb = (LAS float*)(L + S_RELB);
    __syncthreads();
    if (tid < 256) { relb[tid] = p.rel_bias[tid] * LOG2E; qs[tid] = bf2f(p.Qb[(size_t)row * QD + g * 256 + tid]); }
    __syncthreads();
    const float* kc = p.KCS + ((size_t)b * NG + g) * 1024 * 64;
    const float* vc = p.VCS + ((size_t)b * NG + g) * 1024 * 64;
    {
        float mx[4] = {-1e30f, -1e30f, -1e30f, -1e30f};
#pragma unroll 1
        for (int r = wid; r < 16; r += 8) {
            const int n = r * 64 + lane;
            float s[4] = {-1e30f, -1e30f, -1e30f, -1e30f};
            if (n < NC) {
                dot4x64(nullptr, kc + (size_t)n * 64, qs, s);
                const int bk = t5_bucket(t - (16 * n + 31));
#pragma unroll
                for (int h = 0; h < 4; ++h) s[h] += relb[bk * 8 + g * 4 + h];
            }
#pragma unroll
            for (int h = 0; h < 4; ++h) { sc[h * 1024 + n] = s[h]; mx[h] = fmaxf(mx[h], s[h]); }
        }
#pragma unroll
        for (int h = 0; h < 4; ++h) { const float m = wave_max(mx[h]); if (lane == 0) red[wid * 4 + h] = m; }
    }
    __syncthreads();
    float gmx[4], inv[4];
#pragma unroll
    for (int h = 0; h < 4; ++h) { float m = red[h]; for (int w = 1; w < 8; ++w) m = fmaxf(m, red[w * 4 + h]); gmx[h] = m; }
    {
        float sum[4] = {0.f, 0.f, 0.f, 0.f};
#pragma unroll
        for (int k = 0; k < 2; ++k) { const int n = tid + 512 * k;
#pragma unroll
            for (int h = 0; h < 4; ++h) { const float e = n < NC ? ex2(sc[h * 1024 + n] - gmx[h]) : 0.f; sc[h * 1024 + n] = e; sum[h] += e; } }
#pragma unroll
        for (int h = 0; h < 4; ++h) { const float s = wave_sum(sum[h]); if (lane == 0) red[32 + wid * 4 + h] = s; }
    }
    __syncthreads();
#pragma unroll
    for (int h = 0; h < 4; ++h) { float s = 0.f; for (int w = 0; w < 8; ++w) s += red[32 + w * 4 + h]; inv[h] = s > 0.f ? 1.0f / s : 0.f; }
    for (int n = tid; n < 1088; n += 512) phs[n] = n < NC ? (sc[n] * inv[0] + sc[1024 + n] * inv[1]) + (sc[2048 + n] * inv[2] + sc[3072 + n] * inv[3]) : 0.f;
    {
        float a[4] = {0.f, 0.f, 0.f, 0.f};
#pragma unroll 16
        for (int n = wid; n < NC; n += 8) {
            const float v = vc[(size_t)n * 64 + lane];
#pragma unroll
            for (int h = 0; h < 4; ++h) a[h] += sc[h * 1024 + n] * v;
        }
#pragma unroll
        for (int h = 0; h < 4; ++h) part[(wid * 4 + h) * 68 + lane] = a[h] * inv[h];
    }
    __syncthreads();
    if (tid < 256) { float a = 0.f; for (int w = 0; w < 8; ++w) a += part[(w * 4 + (tid >> 6)) * 68 + (tid & 63)]; ocp[tid] = a; }
    __syncthreads();
    if (wid == 0) {
        unsigned long long key[NJR];
#pragma unroll
        for (int jr = 0; jr < NJR; ++jr) {
            const int j = jr * 64 + lane;
            key[jr] = 0ull;
            if (j >= 1 && j <= qblk - 2 && j < NSEL) {
                float im = 0.f;
#pragma unroll
                for (int n = 4 * j - 1; n <= 4 * j + 3; ++n) im += (n < NC) ? phs[n] : 0.f;
                key[jr] = ((unsigned long long)__float_as_uint(im) << 32) | (unsigned)(0xFFFF - j) | 0x10000ull;
            }
        }
        if (lane == 0) { sel[0] = 0; sel[1] = qblk - 1; sel[2] = qblk; }
#pragma unroll 1
        for (int it = 0; it < 13; ++it) {
            unsigned long long best = 0ull;
#pragma unroll
            for (int jr = 0; jr < NJR; ++jr) best = key[jr] > best ? key[jr] : best;
#pragma unroll
            for (int o = 32; o > 0; o >>= 1) { const unsigned long long ot = __shfl_xor(best, o); best = ot > best ? ot : best; }
            const int j = 0xFFFF - (int)(best & 0xFFFFull);
#pragma unroll
            for (int jr = 0; jr < NJR; ++jr) if (key[jr] == best) key[jr] = 0ull;
            if (lane == 0) sel[3 + it] = j;
        }
    }
    __syncthreads();
    {
        float ms[4] = {-1e30f, -1e30f, -1e30f, -1e30f}, ls[4] = {0.f, 0.f, 0.f, 0.f}, os[4] = {0.f, 0.f, 0.f, 0.f};
#pragma unroll 1
        for (int i = wid; i < 16; i += 8) attn_chunk<true>(p, 1, b, g, t, sel[i] * 64, 0, t, ms, ls, os, qs, pbk, relb, lane);
        float mw[4] = {-1e30f, -1e30f, -1e30f, -1e30f}, lw[4] = {0.f, 0.f, 0.f, 0.f}, ow[4] = {0.f, 0.f, 0.f, 0.f};
#pragma unroll 1
        for (int c = wid; c < 9; c += 8) attn_chunk<true>(p, 2, b, g, t, t - 63 - 64 * c, t - WIN, t, mw, lw, ow, qs, pbk, relb, lane);
#pragma unroll
        for (int h = 0; h < 4; ++h) {
            LAS float* ps = part + (wid * 4 + h) * 68; LAS float* pw = part + 8 * 272 + (wid * 4 + h) * 68;
            ps[lane] = os[h]; pw[lane] = ow[h];
            if (lane == 0) { ps[64] = ms[h]; ps[65] = ls[h]; pw[64] = mw[h]; pw[65] = lw[h]; }
        }
    }
    __syncthreads();
    if (tid < 256) {
        const int h = tid >> 6, d = tid & 63;
        float res[2];
#pragma unroll
        for (int br = 0; br < 2; ++br) {
            const LAS float* pp = part + br * 8 * 272 + h * 68;
            float m = -1e30f;
            for (int w = 0; w < 8; ++w) m = fmaxf(m, pp[w * 272 + 64]);
            float l = 0.f, o = 0.f;
            for (int w = 0; w < 8; ++w) { const float sc_ = ex2(pp[w * 272 + 64] - m); l += pp[w * 272 + 65] * sc_; o += pp[w * 272 + d] * sc_; }
            res[br] = o / l;
        }
        const float* gt = p.GATE + (size_t)row * 32 + (g * 4 + h) * 3;
        const float v = gt[0] * ocp[tid] + gt[1] * res[0] + gt[2] * res[1];
        p.OCAT[(size_t)row * DM + (g * 4 + h) * 64 + d] = f2bf(v);
    }
    __syncthreads();
}

constexpr int A_OST = 0, OST_LD = 68, A_LST = A_OST + 256 * OST_LD * 4, A_M0 = A_LST + 1024, A_MB = A_M0 + 1024, MB_LD = 132, A_MKN = A_MB + 64 * MB_LD,
              A_LIST = A_MKN + 256, A_CNT = A_LIST + 132 * 64, A_PK = A_CNT + 544, A_KN = A_PK + 400 * 4, A_T2 = A_KN + 512, A_NP = A_T2 + 132 * 8 * 4, A_QT = A_NP + 16, ATT2_LDS = A_QT + 64 * 512;
static_assert(ATT2_LDS <= GEMM_LDS && ATTS_LDS <= GEMM_LDS, "attention LDS");

__device__ __forceinline__ void qk64(const bf16_t* kb, int c, int G, const bf16x8 (&qB)[2], f32x4 (&s)[4]) {
#pragma unroll
    for (int kt = 0; kt < 4; ++kt) {
        const bf16_t* r = kb + (size_t)(16 * kt + c) * 256 + G * 8;
        const bf16x8 a0 = *(const bf16x8*)r, a1 = *(const bf16x8*)(r + 32);
        s[kt] = mfma16(a0, qB[0], (f32x4){0.f, 0.f, 0.f, 0.f}); s[kt] = mfma16(a1, qB[1], s[kt]);
    }
}
__device__ __forceinline__ void pv64(const bf16_t* vf, int key0, int lane, const f32x4 (&pr)[4], f32x4 (&o)[4]) {
#pragma unroll
    for (int ks = 0; ks < 2; ++ks) {
        const bf16x8 pB = pack_p(pr[2 * ks], pr[2 * ks + 1]);
#pragma unroll
        for (int dt = 0; dt < 4; ++dt) {
            const bf16x8 vA = *(const bf16x8*)(vf + ((size_t)(((key0 >> 5) + ks) * 4 + dt) * 64 + lane) * 8);
            o[dt] = mfma16(vA, pB, o[dt]);
        }
    }
}
__device__ __forceinline__ int qt_off(int qi, int hh, int k) { return (qi * 4 + hh) * 128 + ((k ^ (((qi & 3) << 1) | (hh >> 1))) << 4); }
__device__ __forceinline__ float grp_max(float v) {
    auto r = __builtin_amdgcn_permlane16_swap(__float_as_uint(v), __float_as_uint(v), false, false); v = fmaxf(__uint_as_float(r[0]), __uint_as_float(r[1]));
    r = __builtin_amdgcn_permlane32_swap(__float_as_uint(v), __float_as_uint(v), false, false); return fmaxf(__uint_as_float(r[0]), __uint_as_float(r[1]));
}
__device__ __forceinline__ float grp_sum(float v) {
    auto r = __builtin_amdgcn_permlane16_swap(__float_as_uint(v), __float_as_uint(v), false, false); v = __uint_as_float(r[0]) + __uint_as_float(r[1]);
    r = __builtin_amdgcn_permlane32_swap(__float_as_uint(v), __float_as_uint(v), false, false); return __uint_as_float(r[0]) + __uint_as_float(r[1]);
}
__device__ __forceinline__ int grp_min_i(int v) {
    auto r = __builtin_amdgcn_permlane16_swap((unsigned)v, (unsigned)v, false, false); v = (int)r[0] < (int)r[1] ? (int)r[0] : (int)r[1];
    r = __builtin_amdgcn_permlane32_swap((unsigned)v, (unsigned)v, false, false); return (int)r[0] < (int)r[1] ? (int)r[0] : (int)r[1];
}
__device__ __forceinline__ float dpp_x1(float v) { return __uint_as_float(__builtin_amdgcn_mov_dpp(__float_as_uint(v), 0xB1, 0xF, 0xF, true)); }
__device__ __forceinline__ float dpp_x2(float v) { return __uint_as_float(__builtin_amdgcn_mov_dpp(__float_as_uint(v), 0x4E, 0xF, 0xF, true)); }
__device__ __forceinline__ int dpp_x1i(int v) { return (int)__builtin_amdgcn_mov_dpp((unsigned)v, 0xB1, 0xF, 0xF, true); }
__device__ __forceinline__ int dpp_x2i(int v) { return (int)__builtin_amdgcn_mov_dpp((unsigned)v, 0x4E, 0xF, 0xF, true); }
__device__ __forceinline__ unsigned row_or_q(unsigned u) {
    u |= __builtin_amdgcn_mov_dpp(u, 0x124, 0xF, 0xF, true); u |= __builtin_amdgcn_mov_dpp(u, 0x128, 0xF, 0xF, true); return u;
}

__device__ __forceinline__ void attn_cmp(const Params& p, int b, int g, int t0, int lane_, LAS unsigned char* L, unsigned (&msk)[4]) {
    f32x4 oacc[4];
    int lane = lane_; asm volatile("" : "+v"(lane));
    const int c = lane & 15, G = lane >> 4, qs = c >> 2, hh = c & 3;
    const int qb = t0 >> 6, tc = t0 + qs;
    const size_t qrow = (size_t)b * SEQ + tc;
    const LAS float* T2 = (const LAS float*)(L + A_T2);
    const float b31 = T2[128 * 8 + g * 4 + hh];
    bf16x8 qB[2];
    qB[0] = *(const bf16x8*)(p.Qb + qrow * QD + (g * 4 + hh) * 64 + G * 8); qB[1] = *(const bf16x8*)(p.Qb + qrow * QD + (g * 4 + hh) * 64 + 32 + G * 8);
    const float* gate = p.GATE + qrow * 32 + (g * 4 + hh) * 3;
    msk[0] = msk[1] = msk[2] = msk[3] = 0u;
    {
        const int ncv_c = tc >= 31 ? ((tc - 31) >> 4) + 1 : 0;
        const int ncv_m = t0 + 3 >= 31 ? ((t0 + 3 - 31) >> 4) + 1 : 0;
        const int NT = (ncv_m + 15) >> 4;
        const int mt_far = t0 >= 399 ? (t0 - 399) / 256 + 1 : 0;
        const bf16_t* kcb = p.KCb + (size_t)(b * NG + g) * 512 * 64;
        f32x4 sc[32];
        float mxf = -1e30f, mxn = -1e30f;
        bf16x8 kbuf[2][4][2];
        auto ldkg = [&](int grp, bf16x8 (&kb)[4][2]) __attribute__((always_inline)) {
#pragma unroll
            for (int q = 0; q < 4; ++q) { const bf16_t* r = kcb + ((size_t)((grp * 4 + q) * 2) * 64 + lane) * 8; kb[q][0] = *(const bf16x8*)r; kb[q][1] = *(const bf16x8*)(r + 512); }
        };
        ldkg(0, kbuf[0]);
#pragma unroll
        for (int grp = 0; grp < 8; ++grp) {
            if (4 * grp < NT) {
                if (4 * (grp + 1) < NT) ldkg(grp + 1, kbuf[(grp + 1) & 1]);
                __builtin_amdgcn_sched_barrier(0);
#pragma unroll
                for (int q = 0; q < 4; ++q) {
                    const int mt = grp * 4 + q;
                    f32x4 s = mfma16(kbuf[grp & 1][q][0], qB[0], (f32x4){0.f, 0.f, 0.f, 0.f}); s = mfma16(kbuf[grp & 1][q][1], qB[1], s);
                    if (mt < mt_far) { mxf = fmaxf(mxf, fmaxf(fmaxf(s[0], s[1]), fmaxf(s[2], s[3]))); }
                    else {
#pragma unroll
                        for (int i = 0; i < 4; ++i) { const int n = 16 * mt + 4 * G + i; int dist = tc - (16 * n + 31); const bool ok = n < ncv_c; dist = dist < 0 ? 0 : (dist > 128 ? 128 : dist);
                            s[i] = ok ? s[i] + T2[dist * 8 + g * 4 + hh] : -1e30f; }
                        mxn = fmaxf(mxn, fmaxf(fmaxf(s[0], s[1]), fmaxf(s[2], s[3])));
                    }
                    sc[mt] = s;
                }
            } else {
#pragma unroll
                for (int q = 0; q < 4; ++q) sc[grp * 4 + q] = (f32x4){0.f, 0.f, 0.f, 0.f};
            }
        }
        const float mx = grp_max(fmaxf(mxf + b31, mxn));
        const float shf = mx - b31;
#pragma unroll
        for (int mt = 0; mt < 32; ++mt) if ((mt & ~3) < NT) {
            const float sh = mt < mt_far ? shf : mx;
#pragma unroll
            for (int i = 0; i < 4; ++i) sc[mt][i] = ex2(sc[mt][i] - sh);
        }
        const bf16_t* vct = p.VCT + (size_t)(b * NG + g) * 64 * 512;
        const bf16x8 ones = __builtin_bit_cast(bf16x8, (u32x4){0x3F803F80u, 0x3F803F80u, 0x3F803F80u, 0x3F803F80u});
        f32x4 oc[4] = {{0.f, 0.f, 0.f, 0.f}, {0.f, 0.f, 0.f, 0.f}, {0.f, 0.f, 0.f, 0.f}, {0.f, 0.f, 0.f, 0.f}};
        f32x4 rs = {0.f, 0.f, 0.f, 0.f};
        bf16x8 vbuf[2][2][4];
        auto ldvg = [&](int grp, bf16x8 (&vb)[2][4]) __attribute__((always_inline)) {
#pragma unroll
            for (int q = 0; q < 2; ++q)
#pragma unroll
                for (int dt = 0; dt < 4; ++dt) vb[q][dt] = *(const bf16x8*)(vct + ((size_t)((grp * 2 + q) * 4 + dt) * 64 + lane) * 8);
        };
        ldvg(0, vbuf[0]);
#pragma unroll
        for (int grp = 0; grp < 8; ++grp) if (4 * grp < NT) {
            if (4 * (grp + 1) < NT) ldvg(grp + 1, vbuf[(grp + 1) & 1]);
            __builtin_amdgcn_sched_barrier(0);
#pragma unroll
            for (int q = 0; q < 2; ++q) {
                const int k2 = grp * 2 + q;
                const bf16x8 pB = pack_p(sc[2 * k2], sc[2 * k2 + 1]);
                rs = mfma16(ones, pB, rs);
#pragma unroll
                for (int dt = 0; dt < 4; ++dt) oc[dt] = mfma16(vbuf[grp & 1][q][dt], pB, oc[dt]);
            }
        }
        const float inv = ncv_c > 0 ? 1.0f / rs[0] : 0.f;
        if (qb <= 15) {
            msk[0] = (qb >= 31) ? 0xffffffffu : ((2u << qb) - 1u);
        } else {
            unsigned cand[8];
#pragma unroll
            for (int k = 0; k < 8; ++k) cand[k] = 0u;
            float prevB = 0.f;
#pragma unroll
            for (int mt = 0; mt < 32; ++mt) if (mt < NT) {
                const unsigned x3 = __float_as_uint(sc[mt][3]);
                const auto p16 = __builtin_amdgcn_permlane16_swap(x3, x3, false, false);
                const auto p32 = __builtin_amdgcn_permlane32_swap(p16[1], p16[1], false, false);
                const float r1 = G == 2 ? __uint_as_float(p32[0]) : __uint_as_float(p16[0]);
                float v = ((sc[mt][0] + sc[mt][1]) + (sc[mt][2] + sc[mt][3]) + (G == 0 ? prevB : r1)) * inv;
                prevB = __uint_as_float(p32[1]);
                v += dpp_x1(v); v += dpp_x2(v);
                const int j = 4 * mt + G;
                if ((mt & 3) == hh) cand[mt >> 2] = (j >= 1 && j <= qb - 2) ? ((__float_as_uint(v) & ~127u) | (unsigned)(127 - j)) : 0u;
            }
            auto setbit = [&](int j) { const unsigned bit = 1u << (j & 31); const int w = j >> 5; msk[0] |= w == 0 ? bit : 0u; msk[1] |= w == 1 ? bit : 0u; msk[2] |= w == 2 ? bit : 0u; msk[3] |= w == 3 ? bit : 0u; };
            setbit(0); setbit(qb); setbit(qb - 1);
#pragma unroll 1
            for (int it = 0; it < 13; ++it) {
                unsigned bv = cand[0];
#pragma unroll
                for (int k = 1; k < 8; ++k) bv = bv > cand[k] ? bv : cand[k];
                { unsigned o = __builtin_amdgcn_mov_dpp(bv, 0xB1, 0xF, 0xF, true); bv = o > bv ? o : bv; o = __builtin_amdgcn_mov_dpp(bv, 0x4E, 0xF, 0xF, true); bv = o > bv ? o : bv;
                  auto r = __builtin_amdgcn_permlane16_swap(bv, bv, false, false); bv = r[0] > r[1] ? r[0] : r[1]; r = __builtin_amdgcn_permlane32_swap(bv, bv, false, false); bv = r[0] > r[1] ? r[0] : r[1]; }
#pragma unroll
                for (int k = 0; k < 8; ++k) cand[k] = cand[k] == bv ? 0u : cand[k];
                setbit(127 - (int)(bv & 127u));
            }
        }
        const float g0 = gate[0] * inv;
#pragma unroll
        for (int dt = 0; dt < 4; ++dt) oacc[dt] = oc[dt] * g0;
    }
    bf16_t* orow = p.OCAT + qrow * DM + (g * 4 + hh) * 64 + 4 * G;
#pragma unroll
    for (int dt = 0; dt < 4; ++dt) st_bf16x4(orow + dt * 16, oacc[dt]);
}

struct PackSt { bf16x8 q0, q1; float m; f32x4 l4; f32x4 o[4]; };
__device__ __forceinline__ void attn_selwin_pair(const Params& p, int b, int g, int t0, int lane_, LAS unsigned char* L, const unsigned (&mskA)[4], const unsigned (&mskB)[4]) {
    int lane = lane_; asm volatile("" : "+v"(lane));
    const int c = lane & 15, G = lane >> 4, qs = c >> 2, hh = c & 3;
    const int qb = t0 >> 6;
    const LAS float* T2 = (const LAS float*)(L + A_T2);
    const float b31 = T2[128 * 8 + g * 4 + hh];
    const int tcA = t0 + qs, tcB = t0 + 4 + qs;
    const size_t qrowA = (size_t)b * SEQ + tcA;
    PackSt A, B;
    {
        const bf16_t* qa = p.Qb + qrowA * QD + (g * 4 + hh) * 64 + G * 8;
        A.q0 = *(const bf16x8*)qa; A.q1 = *(const bf16x8*)(qa + 32); B.q0 = *(const bf16x8*)(qa + 4 * QD); B.q1 = *(const bf16x8*)(qa + 4 * QD + 32);
    }
    auto reset = [&](PackSt& S) __attribute__((always_inline)) { S.m = -1e30f; S.l4 = (f32x4){0.f, 0.f, 0.f, 0.f};
#pragma unroll
        for (int dt = 0; dt < 4; ++dt) S.o[dt] = (f32x4){0.f, 0.f, 0.f, 0.f}; };
    const bf16x8 ones = __builtin_bit_cast(bf16x8, (u32x4){0x3F803F80u, 0x3F803F80u, 0x3F803F80u, 0x3F803F80u});
    auto finish = [&](PackSt& S, f32x4 (&s)[4], float cb, bool mine, const bf16x8 (&vf)[2][4]) __attribute__((always_inline)) {
        float cm = fmaxf(fmaxf(fmaxf(s[0][0], s[0][1]), fmaxf(s[0][2], s[0][3])), fmaxf(fmaxf(s[1][0], s[1][1]), fmaxf(s[1][2], s[1][3])));
        cm = fmaxf(cm, fmaxf(fmaxf(fmaxf(s[2][0], s[2][1]), fmaxf(s[2][2], s[2][3])), fmaxf(fmaxf(s[3][0], s[3][1]), fmaxf(s[3][2], s[3][3]))));
        cm = grp_max(mine ? cm + cb : -1e30f);
        const float mn = fmaxf(S.m, cm), al = ex2(S.m - mn);
        const float sh = (mine ? mn : 1e30f) - cb;
#pragma unroll
        for (int kt = 0; kt < 4; ++kt)
#pragma unroll
            for (int i = 0; i < 4; ++i) s[kt][i] = ex2(s[kt][i] - sh);
        S.m = mn;
        f32x4 rs = {0.f, 0.f, 0.f, 0.f};
#pragma unroll
        for (int dt = 0; dt < 4; ++dt) S.o[dt] = S.o[dt] * al;
#pragma unroll
        for (int ks = 0; ks < 2; ++ks) { const bf16x8 pB = pack_p(s[2 * ks], s[2 * ks + 1]);
            rs = mfma16(ones, pB, rs);
#pragma unroll
            for (int dt = 0; dt < 4; ++dt) S.o[dt] = mfma16(vf[ks][dt], pB, S.o[dt]); }
        S.l4[0] = S.l4[0] * al + rs[0];
    };
    auto addout = [&](PackSt& S, size_t qrow, int br) __attribute__((always_inline)) {
        const float gs = p.GATE[qrow * 32 + (g * 4 + hh) * 3 + br] / S.l4[0];
        bf16_t* orow = p.OCAT + qrow * DM + (g * 4 + hh) * 64 + 4 * G;
#pragma unroll
        for (int dt = 0; dt < 4; ++dt) { const u32x2 w = *(const u32x2*)(orow + dt * 16); f32x4 pa; pa[0] = bflo(w.x); pa[1] = bfhi(w.x); pa[2] = bflo(w.y); pa[3] = bfhi(w.y);
            st_bf16x4(orow + dt * 16, pa + S.o[dt] * gs); }
    };
    {
        unsigned umA[4], umB[4], um[4];
#pragma unroll
        for (int w = 0; w < 4; ++w) {
            umA[w] = __builtin_amdgcn_readfirstlane(row_or_q(mskA[w]));
            umB[w] = __builtin_amdgcn_readfirstlane(row_or_q(mskB[w]));
            um[w] = umA[w] | umB[w];
        }
        reset(A); reset(B);
        const bf16_t* klane = p.SLCkF + (size_t)(b * NG + g) * SEQ * 64 + lane * 8;
        const bf16_t* vlane = p.SLCvT + (size_t)(b * NG + g) * SEQ * 64 + lane * 8;
        auto ldfr = [&](int j_, bf16x8 (&kf_)[4][2], bf16x8 (&vf_)[2][4]) __attribute__((always_inline)) {
            const bf16_t* kr = klane + (size_t)j_ * 4096; const bf16_t* vr = vlane + (size_t)j_ * 4096;
#pragma unroll
            for (int kt = 0; kt < 4; ++kt) { kf_[kt][0] = *(const bf16x8*)(kr + (kt * 2) * 512); kf_[kt][1] = *(const bf16x8*)(kr + (kt * 2 + 1) * 512); }
#pragma unroll
            for (int ks = 0; ks < 2; ++ks)
#pragma unroll
                for (int dt = 0; dt < 4; ++dt) vf_[ks][dt] = *(const bf16x8*)(vr + (ks * 4 + dt) * 512);
        };
        auto nextj = [&](int& j_) __attribute__((always_inline)) {
            int w = um[0] ? 0 : um[1] ? 1 : um[2] ? 2 : um[3] ? 3 : -1;
            if (w < 0) return false;
            const unsigned u = w == 0 ? um[0] : w == 1 ? um[1] : w == 2 ? um[2] : um[3];
            const int bpos = __builtin_ctz(u);
            j_ = w * 32 + bpos;
            const unsigned cl = ~(1u << bpos);
            if (w == 0) um[0] &= cl; else if (w == 1) um[1] &= cl; else if (w == 2) um[2] &= cl; else um[3] &= cl;
            return true;
        };
        auto packstep = [&](PackSt& S, const unsigned (&msk)[4], int tc, int j, const bf16x8 (&kf)[4][2], const bf16x8 (&vf)[2][4]) __attribute__((always_inline)) {
            const unsigned mw = (j >> 5) == 0 ? msk[0] : (j >> 5) == 1 ? msk[1] : (j >> 5) == 2 ? msk[2] : msk[3];
            const bool mine = (mw >> (j & 31)) & 1u;
            const bool farb = j <= qb - 3;
            f32x4 s[4];
#pragma unroll
            for (int kt = 0; kt < 4; ++kt) { s[kt] = mfma16(kf[kt][0], S.q0, (f32x4){0.f, 0.f, 0.f, 0.f}); s[kt] = mfma16(kf[kt][1], S.q1, s[kt]); }
            if (!farb) {
#pragma unroll
                for (int kt = 0; kt < 4; ++kt)
#pragma unroll
                    for (int i = 0; i < 4; ++i) { const int dist = tc - (j * 64 + 16 * kt + 4 * G + i); const int dd = dist < 0 ? 0 : (dist > 128 ? 128 : dist);
                        s[kt][i] = dist >= 0 ? s[kt][i] + T2[dd * 8 + g * 4 + hh] : -1e30f; }
            }
            finish(S, s, farb ? b31 : 0.f, mine, vf);
        };
        auto blockstep = [&](int j, const bf16x8 (&kf)[4][2], const bf16x8 (&vf)[2][4]) __attribute__((always_inline)) {
            const int w = j >> 5; const unsigned bit = 1u << (j & 31);
            const unsigned ua = w == 0 ? umA[0] : w == 1 ? umA[1] : w == 2 ? umA[2] : umA[3];
            const unsigned ub = w == 0 ? umB[0] : w == 1 ? umB[1] : w == 2 ? umB[2] : umB[3];
            if (ua & bit) packstep(A, mskA, tcA, j, kf, vf);
            if (ub & bit) packstep(B, mskB, tcB, j, kf, vf);
        };
        auto ldk = [&](int j_, bf16x8 (&kf_)[4][2]) __attribute__((always_inline)) {
            const bf16_t* kr = klane + (size_t)j_ * 4096;
#pragma unroll
            for (int kt = 0; kt < 4; ++kt) { kf_[kt][0] = *(const bf16x8*)(kr + (kt * 2) * 512); kf_[kt][1] = *(const bf16x8*)(kr + (kt * 2 + 1) * 512); }
        };
        auto ldv = [&](int j_, bf16x8 (&vf_)[2][4]) __attribute__((always_inline)) {
            const bf16_t* vr = vlane + (size_t)j_ * 4096;
#pragma unroll
            for (int ks = 0; ks < 2; ++ks)
#pragma unroll
                for (int dt = 0; dt < 4; ++dt) vf_[ks][dt] = *(const bf16x8*)(vr + (ks * 4 + dt) * 512);
        };
        bf16x8 kfA[4][2], kfB[4][2], vf[2][4];
        int j = 0; bool have = nextj(j);
        ldk(j, kfA);
#pragma unroll 1
        while (have) {
            int jn = j; bool haven = nextj(jn);
            ldv(j, vf); ldk(jn, kfB);
            __builtin_amdgcn_sched_barrier(0);
            blockstep(j, kfA, vf);
            if (!haven) break;
            j = jn; have = nextj(jn);
            ldv(j, vf); ldk(jn, kfA);
            __builtin_amdgcn_sched_barrier(0);
            blockstep(j, kfB, vf);
            j = jn;
        }
        addout(A, qrowA, 1); addout(B, qrowA + 4, 1);
    }
    {
        reset(A); reset(B);
        const int loA = t0 - WIN > 0 ? t0 - WIN : 0, hiA = t0 + 3, loB = t0 + 4 - WIN > 0 ? t0 + 4 - WIN : 0, hiB = t0 + 7;
        const bf16_t* klane = p.WINkF + (size_t)(b * NG + g) * SEQ * 64 + lane * 8;
        const bf16_t* vlane = p.WINvT + (size_t)(b * NG + g) * SEQ * 64 + lane * 8;
        auto ldfr = [&](int cb_, bf16x8 (&kf_)[4][2], bf16x8 (&vf_)[2][4]) __attribute__((always_inline)) {
            const bf16_t* kr = klane + (size_t)cb_ * 64; const bf16_t* vr = vlane + (size_t)cb_ * 64;
#pragma unroll
            for (int kt = 0; kt < 4; ++kt) { kf_[kt][0] = *(const bf16x8*)(kr + (kt * 2) * 512); kf_[kt][1] = *(const bf16x8*)(kr + (kt * 2 + 1) * 512); }
#pragma unroll
            for (int ks = 0; ks < 2; ++ks)
#pragma unroll
                for (int dt = 0; dt < 4; ++dt) vf_[ks][dt] = *(const bf16x8*)(vr + (ks * 4 + dt) * 512);
        };
        auto packstep = [&](PackSt& S, int tq0, int tc, int cb, const bf16x8 (&kf)[4][2], const bf16x8 (&vf)[2][4]) __attribute__((always_inline)) {
            const bool far = (cb + 63 <= tq0 - 128) && (cb >= tq0 + 3 - WIN);
            f32x4 s[4];
#pragma unroll
            for (int kt = 0; kt < 4; ++kt) { s[kt] = mfma16(kf[kt][0], S.q0, (f32x4){0.f, 0.f, 0.f, 0.f}); s[kt] = mfma16(kf[kt][1], S.q1, s[kt]); }
            if (!far) {
#pragma unroll
                for (int kt = 0; kt < 4; ++kt)
#pragma unroll
                    for (int i = 0; i < 4; ++i) { const int dist = tc - (cb + 16 * kt + 4 * G + i); const bool ok = dist >= 0 && dist <= WIN; const int dd = dist < 0 ? 0 : (dist > 128 ? 128 : dist);
                        s[kt][i] = ok ? s[kt][i] + T2[dd * 8 + g * 4 + hh] : -1e30f; }
            }
            finish(S, s, far ? b31 : 0.f, true, vf);
        };
        auto chunkstep = [&](int cb, const bf16x8 (&kf)[4][2], const bf16x8 (&vf)[2][4]) __attribute__((always_inline)) {
            if (cb <= hiA) packstep(A, t0, tcA, cb, kf, vf);
            if (cb + 63 >= loB) packstep(B, t0 + 4, tcB, cb, kf, vf);
        };
        auto ldk = [&](int cb_, bf16x8 (&kf_)[4][2]) __attribute__((always_inline)) {
            const bf16_t* kr = klane + (size_t)cb_ * 64;
#pragma unroll
            for (int kt = 0; kt < 4; ++kt) { kf_[kt][0] = *(const bf16x8*)(kr + (kt * 2) * 512); kf_[kt][1] = *(const bf16x8*)(kr + (kt * 2 + 1) * 512); }
        };
        auto ldv = [&](int cb_, bf16x8 (&vf_)[2][4]) __attribute__((always_inline)) {
            const bf16_t* vr = vlane + (size_t)cb_ * 64;
#pragma unroll
            for (int ks = 0; ks < 2; ++ks)
#pragma unroll
                for (int dt = 0; dt < 4; ++dt) vf_[ks][dt] = *(const bf16x8*)(vr + (ks * 4 + dt) * 512);
        };
        bf16x8 kfA[4][2], kfB[4][2], vf[2][4];
        int cb = loA & ~63;
        ldk(cb, kfA);
#pragma unroll 1
        for (;;) {
            ldv(cb, vf); ldk(cb + 64 <= hiB ? cb + 64 : cb, kfB);
            __builtin_amdgcn_sched_barrier(0);
            chunkstep(cb, kfA, vf);
            cb += 64; if (cb > hiB) break;
            ldv(cb, vf); ldk(cb + 64 <= hiB ? cb + 64 : cb, kfA);
            __builtin_amdgcn_sched_barrier(0);
            chunkstep(cb, kfB, vf);
            cb += 64; if (cb > hiB) break;
        }
        addout(A, qrowA, 2); addout(B, qrowA + 4, 2);
    }
}

__device__ __forceinline__ void phase_attn(const Params& p) {
    const int wid = threadIdx.x >> 6, lane = threadIdx.x & 63;
    { PROBE_BEGIN(3)
    if (blockIdx.x < NS * NG) attn_sample_item(p, blockIdx.x >> 1, blockIdx.x & 1);
    PROBE_END(3) }
    LAS unsigned char* L = (LAS unsigned char*)smem;
    for (int i = threadIdx.x; i < 129 * 8; i += 512) ((LAS float*)(L + A_T2))[i] = p.rel_bias[t5_bucket(i >> 3) * 8 + (i & 7)] * LOG2E;
    __syncthreads();
    {
        const int wid2 = __builtin_amdgcn_readfirstlane(threadIdx.x >> 6);
#pragma unroll 1
        for (;;) {
            __syncthreads();
            if (threadIdx.x == 0) ((LAS int*)(L + A_NP))[1] = (int)__hip_atomic_fetch_add(p.bar, 1u, __ATOMIC_RELAXED, __HIP_MEMORY_SCOPE_AGENT);
            __syncthreads();
            const int T = ((const LAS int*)(L + A_NP))[1];
            if (T >= NB * NG * (SEQ / 64)) break;
            const int bg = T & 7, qb = (SEQ / 64 - 1) - (T >> 3), t0 = qb * 64 + wid2 * 8;
            unsigned mA[4], mB[4];
            PROBE_BEGIN(6)
            attn_cmp(p, bg >> 1, bg & 1, t0, lane, L, mA);
            attn_cmp(p, bg >> 1, bg & 1, t0 + 4, lane, L, mB);
            PROBE_END(6)
            PROBE_BEGIN(7)
            attn_selwin_pair(p, bg >> 1, bg & 1, t0, lane, L, mA, mB);
            PROBE_END(7)
        }
    }
    __syncthreads();
}

constexpr int GM_LD = 136, GM_LDS = 128 * GM_LD * 2 + 1024;
__device__ __forceinline__ void phase_gmlp(const Params& p) {
    int tid = threadIdx.x; asm volatile("" : "+v"(tid));
    const int wid = __builtin_amdgcn_readfirstlane(tid >> 6), lane = tid & 63;
    LAS bf16_t* vnT = (LAS bf16_t*)smem;
    LAS float* mu = (LAS float*)(smem + 128 * GM_LD * 2);
    const int c = lane & 15, G = lane >> 4;
#pragma unroll 1
    for (int u = blockIdx.x; u < NB * 64; u += gridDim.x) {
        const int b = u >> 6, ch = u & 63; const size_t row0 = (size_t)b * SEQ + ch * 128;
        __syncthreads();
        for (int r = wid; r < 128; r += 8) {
            const u32x4 w = *(const u32x4*)(p.Vg + (row0 + r) * GMD + lane * 8);
            const float x[8] = {bflo(w.x), bfhi(w.x), bflo(w.y), bfhi(w.y), bflo(w.z), bfhi(w.z), bflo(w.w), bfhi(w.w)};
            float s = 0.f;
#pragma unroll
            for (int i = 0; i < 8; ++i) s += x[i];
            const float mean = wave_sum(s) * (1.0f / GMD);
            float q = 0.f;
#pragma unroll
            for (int i = 0; i < 8; ++i) q += (x[i] - mean) * (x[i] - mean);
            const float var = wave_sum(q) * (1.0f / GMD);
            if (lane == 0) { mu[r] = mean; mu[128 + r] = rsqrtf(var + EPS); }
        }
#pragma unroll 1
        for (int g = 0; g < 4; ++g) {
            __syncthreads();
#pragma unroll
            for (int k = 0; k < 4; ++k) {
                const int e = tid + 512 * k, s = e & 127, d0 = (e >> 7) * 8;
                const u32x4 w = *(const u32x4*)(p.Vg + (row0 + s) * GMD + g * 128 + d0);
                const float x[8] = {bflo(w.x), bfhi(w.x), bflo(w.y), bfhi(w.y), bflo(w.z), bfhi(w.z), bflo(w.w), bfhi(w.w)};
                const float m = mu[s], rs = mu[128 + s];
#pragma unroll
                for (int i = 0; i < 8; ++i) { const int cc = g * 128 + d0 + i; vnT[(d0 + i) * GM_LD + s] = f2bf((x[i] - m) * rs * p.gm_ln_g[cc] + p.gm_ln_b[cc]); }
            }
            __syncthreads();
            f32x4 acc[8];
#pragma unroll
            for (int dt = 0; dt < 8; ++dt) acc[dt] = (f32x4){0.f, 0.f, 0.f, 0.f};
            const bf16_t* wrow = p.GWb + ((size_t)g * 128 + 16 * wid + c) * 128 + 8 * G;
#pragma unroll 1
            for (int ks = 0; ks <= (wid >> 1); ++ks) {
                const bf16x8 B = *(const bf16x8*)(wrow + 32 * ks);
#pragma unroll
                for (int dt = 0; dt < 8; ++dt) {
                    const bf16x8 A = *(const LAS bf16x8*)(vnT + (dt * 16 + c) * GM_LD + 32 * ks + 8 * G);
                    acc[dt] = mfma16(A, B, acc[dt]);
                }
            }
            const int t = 16 * wid + c;
            const float bs = p.gm_bs[g * 128 + t];
#pragma unroll
            for (int dt = 0; dt < 8; ++dt) {
                const int d = dt * 16 + 4 * G;
                const u32x2 uw = *(const u32x2*)(p.U + (row0 + t) * GMD + g * 128 + d);
                f32x4 o; o[0] = bflo(uw.x) * (acc[dt][0] + bs); o[1] = bfhi(uw.x) * (acc[dt][1] + bs); o[2] = bflo(uw.y) * (acc[dt][2] + bs); o[3] = bfhi(uw.y) * (acc[dt][3] + bs);
                st_bf16x4(p.OCAT + (row0 + t) * DM + QD + g * 128 + d, o);
            }
        }
    }
    for (int it = blockIdx.x * 8 + wid; it < NS; it += gridDim.x * 8) {
        const size_t row = (size_t)MP + it;
        const u32x4 w = *(const u32x4*)(p.Vg + row * GMD + lane * 8);
        const float x[8] = {bflo(w.x), bfhi(w.x), bflo(w.y), bfhi(w.y), bflo(w.z), bfhi(w.z), bflo(w.w), bfhi(w.w)};
        float s = 0.f;
#pragma unroll
        for (int i = 0; i < 8; ++i) s += x[i];
        const float mean = wave_sum(s) * (1.0f / GMD);
        float q = 0.f;
#pragma unroll
        for (int i = 0; i < 8; ++i) q += (x[i] - mean) * (x[i] - mean);
        const float rs = rsqrtf(wave_sum(q) * (1.0f / GMD) + EPS);
#pragma unroll
        for (int i = 0; i < 8; ++i) {
            const int c = lane * 8 + i, g = c >> 7;
            const float v = (x[i] - mean) * rs * p.gm_ln_g[c] + p.gm_ln_b[c];
            p.out[O_GMV + (size_t)it * GMD + c] = v;
            const float a = p.gm_ws[(size_t)g * 128 * 128] * v + p.gm_bs[g * 128];
            p.OCAT[row * DM + QD + c] = f2bf(bf2f(p.U[row * GMD + c]) * a);
        }
    }
}

template <int MODE>
__device__ __forceinline__ void phase_norm(const Params& p) {
    const int wid = threadIdx.x >> 6, lane = threadIdx.x & 63;
    const float* gpost = MODE == 0 ? p.ln_mix_post : MODE == 1 ? p.ln_ffn_post : p.ln_ple_post;
    for (int row = blockIdx.x * 8 + wid; row < MP + NS; row += gridDim.x * 8) {
        const bf16_t* fr = (const bf16_t*)p.F + (size_t)row * DM;
        const bf16_t* xb = MODE == 1 ? (const bf16_t*)p.X1 + (size_t)row * DM : p.X2b + (size_t)row * DM;
        f32x4 f[4], x[4];
#pragma unroll
        for (int k = 0; k < 4; ++k) { const u32x2 w = *(const u32x2*)(fr + lane * 4 + k * 256); f[k][0] = bflo(w.x); f[k][1] = bfhi(w.x); f[k][2] = bflo(w.y); f[k][3] = bfhi(w.y);
            if (MODE == 0) x[k] = *(const f32x4*)(xrow_ptr(p, row) + lane * 4 + k * 256);
            else { const u32x2 v = *(const u32x2*)(xb + lane * 4 + k * 256); x[k][0] = bflo(v.x); x[k][1] = bfhi(v.x); x[k][2] = bflo(v.y); x[k][3] = bfhi(v.y); } }
        const float r = row_rstd(f);
#pragma unroll
        for (int k = 0; k < 4; ++k) { const f32x4 g = *(const f32x4*)(gpost + lane * 4 + k * 256); x[k] = x[k] + f[k] * r * g; }
        if (MODE == 0) {
            const float r2 = row_rstd(x);
#pragma unroll
            for (int k = 0; k < 4; ++k) {
                st_bf16x4((bf16_t*)p.X1 + (size_t)row * DM + lane * 4 + k * 256, x[k]);
                const f32x4 g = *(const f32x4*)(p.ln_ffn_pre + lane * 4 + k * 256); const f32x4 o = x[k] * r2 * g;
                st_bf16x4(p.H2 + (size_t)row * DM + lane * 4 + k * 256, o);
            }
        } else if (MODE == 1) {
#pragma unroll
            for (int k = 0; k < 4; ++k) st_bf16x4(p.X2b + (size_t)row * DM + lane * 4 + k * 256, x[k]);
        } else {
            float* yr = row < MP ? p.out + O_YP + (size_t)row * DM : p.out + O_YS + (size_t)(row - MP) * DM;
#pragma unroll
            for (int k = 0; k < 4; ++k) *(f32x4*)(yr + lane * 4 + k * 256) = x[k];
        }
    }
}


#define XB_TMO      128
#define XB_XCNT(j)  (256  + 64 * (j))
#define XB_XSUB(j)  (1280 + 64 * (j))
#define XB_XGEN(j)  (2304 + 64 * (j))
#define XB_TOP      3328
#define XB_TOPGEN   3392
#define XCD_BAR_WORDS 3456
#define XB_SPIN_CAP (1u << 22)

__device__ __forceinline__ unsigned xb_ld(unsigned* p)              { return __hip_atomic_load(p, __ATOMIC_RELAXED, __HIP_MEMORY_SCOPE_AGENT); }
__device__ __forceinline__ unsigned xb_add(unsigned* p, unsigned v) { return __hip_atomic_fetch_add(p, v, __ATOMIC_RELAXED, __HIP_MEMORY_SCOPE_AGENT); }
__device__ __forceinline__ unsigned xb_xcc_id() { return (unsigned)__builtin_amdgcn_s_getreg((3 << 11) | 20) & 0xFu; }
#define XB_SPIN(cond, bar) do { unsigned _sp = 0; while (cond) { __builtin_amdgcn_s_sleep(1); \
    if ((++_sp & 255u) == 0u) { if (xb_ld(&(bar)[XB_TMO])) break; if (_sp > XB_SPIN_CAP) { atomicAdd(&(bar)[XB_TMO], 1u); break; } } } } while (0)

struct XcdBarrier {
    unsigned* bar; unsigned x;
    volatile LAS unsigned* st;
};

__device__ __forceinline__ XcdBarrier xcd_barrier_post(unsigned* bar, volatile LAS unsigned* st) {
    XcdBarrier b; b.bar = bar; b.x = xb_xcc_id(); b.st = st;
    if (threadIdx.x == 0) (void)xb_add(&bar[XB_XCNT(b.x)], 1u);
    return b;
}
__device__ __forceinline__ void xcd_barrier_complete(unsigned* bar, unsigned x, unsigned& nloc, unsigned& nx) {
    const unsigned G = gridDim.x * gridDim.y * gridDim.z;
    unsigned sum, cnt, mine, sp = 0u;
    for (;;) {
        sum = 0u; cnt = 0u; mine = 0u;
#pragma unroll
        for (unsigned j = 0; j < 16; ++j) { const unsigned c = xb_ld(&bar[XB_XCNT(j)]); sum += c; cnt += (c > 0u) ? 1u : 0u; mine = (j == x) ? c : mine; }
        if (sum == G) break;
        __builtin_amdgcn_s_sleep(1);
        if ((++sp & 255u) == 0u) { if (xb_ld(&bar[XB_TMO])) break; if (sp > XB_SPIN_CAP) { atomicAdd(&bar[XB_TMO], 1u); break; } }
    }
    nloc = mine > 0u ? mine : 1u; nx = cnt > 0u ? cnt : 1u;
}

__device__ __forceinline__ void xcd_barrier(const XcdBarrier& b) {
    asm volatile("s_waitcnt vmcnt(0)" ::: "memory");
    __syncthreads();
    if (threadIdx.x == 0) {
        unsigned* bar = b.bar;
        __builtin_amdgcn_s_waitcnt(0);
        unsigned nloc = b.st[0], nx = b.st[1];
        if (nloc == 0u) { xcd_barrier_complete(bar, b.x, nloc, nx); b.st[0] = nloc; b.st[1] = nx; }
        const unsigned old = xb_add(&bar[XB_XSUB(b.x)], 1u);
        const unsigned gen = old / nloc;
        if (old + 1u == (gen + 1u) * nloc) {
            __builtin_amdgcn_fence(__ATOMIC_RELEASE, "agent");
            asm volatile("s_waitcnt vmcnt(0)" ::: "memory");
            const unsigned og = xb_add(&bar[XB_TOP], 1u);
            const unsigned tg = og / nx;
            if (og + 1u == (tg + 1u) * nx) xb_add(&bar[XB_TOPGEN], 1u);
            else XB_SPIN(xb_ld(&bar[XB_TOPGEN]) == tg, bar);
            __builtin_amdgcn_fence(__ATOMIC_ACQUIRE, "agent");
            xb_add(&bar[XB_XGEN(b.x)], 1u);
            asm volatile("s_waitcnt vmcnt(0)" ::: "memory");
        } else {
            XB_SPIN(xb_ld(&bar[XB_XGEN(b.x)]) == gen, bar);
            __builtin_amdgcn_fence(__ATOMIC_ACQUIRE, "agent");
            asm volatile("s_waitcnt vmcnt(0)" ::: "memory");
        }
    }
    __syncthreads();
}

constexpr int NPHASE = 16;
constexpr int LDS_BYTES = GEMM_LDS;
static_assert(GM_LDS <= LDS_BYTES, "lds");
constexpr int NMT = MALL / BM;

constexpr int NMP = MP / BM;
template <int PH>
__device__ __forceinline__ void run_phase(const Params& p) {
    if (PH == 0) phase_prologue(p);
    if (PH == 1) { EpiIn e{p}; if (blockIdx.x & 1) phase_gather(p); gemm_phase(p.H, DM, p.WinT, DM, NMP, INP / BM, e); gemm_skinny(p.H + (size_t)MP * DM, DM, p.WinT, DM, INP, e); if (!(blockIdx.x & 1)) phase_gather(p); }
    if (PH == 2) { EpiPart e{(bf16_t*)p.PART}; gemm_phase(p.CMPb, 4096, p.W1T, 1024, (2048 + NS * 1024) / BM, 1, e, 4, ZCmp(), 256); phase_deferred_transposes(p); }
    if (PH == 3) phase_cmp_final(p);
    if (PH == 4) phase_attn(p);
    if (PH == 5) phase_gmlp(p);
    if (PH == 6) { EpiBranch e{p.GA, p.GB, p.Y1}; gemm_phase<EpiBranch, ZNone, true>(p.OCAT, DM, p.WnT, DM, NMP, DM / BM, e); gemm_skinny2(p.OCAT + (size_t)MP * DM, DM, p.WnT, DM, DM, e); }
    if (PH == 8) { EpiBf16 e{(bf16_t*)p.F, DM}; gemm_phase(p.Y1, DM, p.WoT, DM, NMP, DM / BM, e); gemm_skinny(p.Y1 + (size_t)MP * DM, DM, p.WoT, DM, DM, e); }
    if (PH == 9) phase_norm<0>(p);
    if (PH == 10) { EpiSwiGLU e{p.ACT}; gemm_phase(p.H2, DM, p.WguT, DM, NMP, 2 * DFF / BM, e); gemm_skinny(p.H2 + (size_t)MP * DM, DM, p.WguT, DM, 2 * DFF, e); }
    if (PH == 11) { EpiBf16 e{(bf16_t*)p.F, DM}; gemm_phase(p.ACT, DFF, p.WdT, DFF, NMP, DM / BM, e); gemm_skinny(p.ACT + (size_t)MP * DFF, DFF, p.WdT, DFF, DM, e); }
    if (PH == 12) phase_norm<1>(p);
    if (PH == 13) { EpiBf16 e{(bf16_t*)p.T, DM}; gemm_phase(p.Pb, PLE, p.WpT, PLE, NMP, DM / BM, e); gemm_skinny(p.Pb + (size_t)MP * PLE, PLE, p.WpT, PLE, DM, e); }
    if (PH == 14) { EpiPleGate e{(const bf16_t*)p.T, (bf16_t*)p.F}; gemm_phase(p.X2b, DM, p.WpgT, DM, NMP, DM / BM, e); gemm_skinny(p.X2b + (size_t)MP * DM, DM, p.WpgT, DM, DM, e); }
    if (PH == 15) phase_norm<2>(p);
}

#ifndef MK_MULTI
#define MK_MULTI 0
#endif
template <int PH>
__global__ void __launch_bounds__(512, 2) k_phase(Params p) { run_phase<PH>(p); }

__global__ void __launch_bounds__(512, 2) k_all(Params p) {
    volatile LAS unsigned* st = (volatile LAS unsigned*)((LAS unsigned char*)smem + LDS_BYTES);
    if (threadIdx.x < 12) st[threadIdx.x] = 0u;
    __syncthreads();
    XcdBarrier bar = xcd_barrier_post(p.bar, st);
#if PROBE_DUP == 100
    run_phase<0>(p);  xcd_barrier(bar);
#endif
#if PROBE_SPIN >= 100
    if (threadIdx.x == 0) PROBE_TS[3] = probe_now();
#define PROBE_STAMP(k) if (threadIdx.x == 0 && PROBE_SEG == (k)) PROBE_TS[2] = probe_now() - PROBE_TS[3];
#else
#define PROBE_STAMP(k)
#endif
    run_phase<0>(p);  xcd_barrier(bar);
    PROBE_STAMP(20)
    run_phase<1>(p);  xcd_barrier(bar);
    PROBE_STAMP(21)
    run_phase<2>(p);  xcd_barrier(bar);
#if PROBE_DUP == 100
    run_phase<3>(p);  xcd_barrier(bar);
#endif
    run_phase<3>(p);  xcd_barrier(bar);
    PROBE_STAMP(23)
#if PROBE_DUP == 104
    run_phase<4>(p);  xcd_barrier(bar);
#endif
    run_phase<4>(p);
#if PROBE_DUP == 100
    run_phase<5>(p);  xcd_barrier(bar);
#endif
    run_phase<5>(p);  xcd_barrier(bar);
    PROBE_STAMP(25)
    run_phase<6>(p);  xcd_barrier(bar);
    run_phase<8>(p);  xcd_barrier(bar);
    PROBE_STAMP(28)
    run_phase<9>(p);  xcd_barrier(bar);
    PROBE_STAMP(29)
    run_phase<10>(p); xcd_barrier(bar);
    PROBE_STAMP(30)
    run_phase<11>(p); xcd_barrier(bar);
    PROBE_STAMP(31)
    run_phase<12>(p);
    run_phase<13>(p); xcd_barrier(bar);
    run_phase<14>(p); xcd_barrier(bar);
    PROBE_STAMP(34)
    run_phase<15>(p);
#if PROBE_SPIN
    if (blockIdx.x == 0 && threadIdx.x == 0) {
        const unsigned long long d = PROBE_TS[2] * (PROBE_SPIN >= 100 ? PROBE_SPIN - 100 : PROBE_SPIN), t0 = probe_now();
        while (probe_now() - t0 < d) __builtin_amdgcn_s_sleep(8);
    }
#endif
}

static inline size_t al256(size_t x) { return (x + 255) & ~(size_t)255; }
template <int PH> static void launch_phase(const Params& p, int grid, hipStream_t s) {
    static bool attr = false;
    if (!attr) { (void)hipFuncSetAttribute((const void*)k_phase<PH>, hipFuncAttributeMaxDynamicSharedMemorySize, LDS_BYTES); attr = true; }
    k_phase<PH><<<grid, 512, LDS_BYTES, s>>>(p);
}
template <int PH> static void launch_all(const Params& p, int grid, hipStream_t s) {
    launch_phase<PH>(p, grid, s);
    if constexpr (PH + 1 < NPHASE) launch_all<PH + 1>(p, grid, s);
}

extern "C" void kernel_launch(void* const* d_in, const int* in_sizes, int n_in, void* d_out, int out_size, void* d_ws, size_t ws_size, hipStream_t stream) {
    Params p{};
    p.x_prompt = (const float*)d_in[0]; p.x_sample = (const float*)d_in[1]; p.cache_cmp = (const float*)d_in[2]; p.cache_slc = (const float*)d_in[3];
    p.state_win = (const float*)d_in[4]; p.page_table = (const int*)d_in[5]; p.p_prompt = (const float*)d_in[6]; p.p_sample = (const float*)d_in[7];
    p.rel_bias = (const float*)d_in[8]; p.ln_mix_pre = (const float*)d_in[9]; p.w_in = (const float*)d_in[10];
    p.pe_k = (const float*)d_in[11]; p.w1_k = (const float*)d_in[12]; p.w2_k = (const float*)d_in[13];
    p.pe_v = (const float*)d_in[14]; p.w1_v = (const float*)d_in[15]; p.w2_v = (const float*)d_in[16];
    p.gm_ln_g = (const float*)d_in[17]; p.gm_ln_b = (const float*)d_in[18]; p.gm_ws = (const float*)d_in[19]; p.gm_bs = (const float*)d_in[20];
    p.w_br_nsa = (const float*)d_in[21]; p.w_br_gm = (const float*)d_in[22]; p.w_out = (const float*)d_in[23];
    p.ln_mix_post = (const float*)d_in[24]; p.ln_ffn_pre = (const float*)d_in[25]; p.w_gate = (const float*)d_in[26]; p.w_up = (const float*)d_in[27];
    p.w_down = (const float*)d_in[28]; p.ln_ffn_post = (const float*)d_in[29]; p.w_ple = (const float*)d_in[30]; p.w_ple_gate = (const float*)d_in[31];
    p.ln_ple_post = (const float*)d_in[32];
    p.out = (float*)d_out;
    unsigned char* w = (unsigned char*)d_ws; size_t off = 0;
    auto take = [&](size_t bytes) { void* r = w + off; off = al256(off + bytes); return r; };
    p.bar = (unsigned*)take(16384);
    p.WinT = (bf16_t*)take((size_t)INP * DM * 2); p.WnT = (bf16_t*)take((size_t)DM * DM * 2); p.WgT = nullptr;
    p.WoT = (bf16_t*)take((size_t)DM * DM * 2); p.WguT = (bf16_t*)take((size_t)2 * DFF * DM * 2); p.WdT = (bf16_t*)take((size_t)DM * DFF * 2);
    p.WpgT = (bf16_t*)take((size_t)DM * DM * 2); p.WpT = (bf16_t*)take((size_t)DM * PLE * 2); p.W1T = (bf16_t*)take((size_t)2 * 256 * 1024 * 2);
    p.H = (bf16_t*)take((size_t)MALL * DM * 2); p.Qb = (bf16_t*)take((size_t)MALL * QD * 2);
    p.CMPb = (bf16_t*)take(((size_t)MP + (size_t)NS * PAST) * 256 * 2); p.SLCb = (bf16_t*)take((size_t)MALL * 256 * 2); p.WINb = (bf16_t*)take((size_t)MALL * 256 * 2);
    p.U = (bf16_t*)take((size_t)MALL * GMD * 2); p.Vg = (bf16_t*)take((size_t)MALL * GMD * 2);
    p.GA = (bf16_t*)take((size_t)MALL * DM * 2); p.GB = (bf16_t*)take((size_t)MALL * DM * 2);
    p.GATE = (float*)take((size_t)MALL * 32 * 4);
    p.PART = (float*)take((size_t)(2048 + NS * 1024) * 4 * 256 * 4); p.PEB = (float*)take(256 * 4);
    p.KCP = (float*)take((size_t)NB * NG * 512 * 64 * 4); p.VCP = (float*)take((size_t)NB * NG * 512 * 64 * 4);
    p.KCS = (float*)take((size_t)NS * NG * 1024 * 64 * 4); p.VCS = (float*)take((size_t)NS * NG * 1024 * 64 * 4); p.KN = (float*)take(NB * NG * 128 * 4);
    p.KCb = (bf16_t*)take((size_t)NB * NG * 512 * 64 * 2); p.VCT = (bf16_t*)take((size_t)NB * NG * 64 * 512 * 2);
    p.SLCvT = (bf16_t*)take((size_t)NB * NG * 64 * SEQ * 2); p.WINvT = (bf16_t*)take((size_t)NB * NG * 64 * SEQ * 2);
    p.GWb = (bf16_t*)take(4 * 128 * 128 * 2); p.W2T = (bf16_t*)take(2 * 64 * 128 * 2);
    p.SLCkF = (bf16_t*)take((size_t)NB * NG * 64 * SEQ * 2); p.WINkF = (bf16_t*)take((size_t)NB * NG * 64 * SEQ * 2);
    p.OCAT = (bf16_t*)take((size_t)MALL * DM * 2); p.T = (float*)take((size_t)MALL * DM * 4); p.Y1 = (bf16_t*)take((size_t)MALL * DM * 2);
    p.F = (float*)take((size_t)MALL * DM * 4); p.X1 = (float*)take((size_t)MALL * DM * 4); p.H2 = (bf16_t*)take((size_t)MALL * DM * 2);
    p.ACT = (bf16_t*)take((size_t)MALL * DFF * 2); p.X2 = (float*)take((size_t)MALL * DM * 4); p.X2b = (bf16_t*)take((size_t)MALL * DM * 2);
    p.Pb = (bf16_t*)take((size_t)MALL * PLE * 2);
    if (off > ws_size) { fprintf(stderr, "workspace too small: need %zu have %zu\n", off, ws_size); return; }
#if MK_MULTI
    launch_all<0>(p, 256, stream);
#else
    constexpr size_t kDynLds = LDS_BYTES + 48;
    static int grid = 0;
    if (!grid) {
        int dev = 0, cus = 0, per_cu = 0;
        (void)hipGetDevice(&dev);
        (void)hipDeviceGetAttribute(&cus, hipDeviceAttributeMultiprocessorCount, dev);
        (void)hipFuncSetAttribute((const void*)k_all, hipFuncAttributeMaxDynamicSharedMemorySize, (int)kDynLds);
        (void)hipOccupancyMaxActiveBlocksPerMultiprocessor(&per_cu, (const void*)k_all, 512, kDynLds);
        grid = cus * (per_cu < 1 ? per_cu : 1);
        if (grid <= 0) { fprintf(stderr, "k_all: occupancy query says %d blocks per CU\n", per_cu); grid = 0; return; }
    }
    (void)hipMemsetAsync(p.bar, 0, XCD_BAR_WORDS * sizeof(unsigned), stream);
    k_all<<<grid, 512, kDynLds, stream>>>(p);
#endif
}
```

```cpp
#include <hip/hip_runtime.h>
#include <stdint.h>
#include <cstdio>

typedef unsigned short bf16_t;
typedef short bf16x8 __attribute__((ext_vector_type(8)));
typedef float f32x4 __attribute__((ext_vector_type(4)));
typedef float f32x2 __attribute__((ext_vector_type(2)));
typedef unsigned u32x4 __attribute__((ext_vector_type(4)));
typedef unsigned u32x2 __attribute__((ext_vector_type(2)));
#define LAS __attribute__((address_space(3)))

constexpr int DM = 1024, NB = 4, SEQ = 8192, MP = NB * SEQ, NS = 32, MALL = MP + 256, PAST = 16384, PAGE = 128, NPG = 128;
constexpr int NH = 8, NG = 2, HPG = 4, DH = 64, QD = 512, WIN = 512, GMD = 512, DFF = 2816, PLE = 256, IND = 4376, INP = 4608;
constexpr int NCP = 511, NCS = 1023;
constexpr float EPS = 1e-6f;
constexpr float LOG2E = 1.4426950408889634f, QSCALE = 0.125f * LOG2E;
constexpr long O_YP = 0, O_YS = 33554432, O_CMPP = 33587200, O_SLCP = 41975808, O_WINP = 50364416, O_CMPS = 50888704,
               O_SLCS = 50896896, O_WINS = 50905088, O_GMV = 55099392;

struct Params {
    const float *x_prompt, *x_sample, *cache_cmp, *cache_slc, *state_win; const int* page_table;
    const float *p_prompt, *p_sample, *rel_bias, *ln_mix_pre, *w_in, *pe_k, *w1_k, *w2_k, *pe_v, *w1_v, *w2_v;
    const float *gm_ln_g, *gm_ln_b, *gm_ws, *gm_bs, *w_br_nsa, *w_br_gm, *w_out, *ln_mix_post, *ln_ffn_pre;
    const float *w_gate, *w_up, *w_down, *ln_ffn_post, *w_ple, *w_ple_gate, *ln_ple_post;
    float* out;
    unsigned* bar;
    bf16_t *WinT, *WnT, *WgT, *WoT, *WguT, *WdT, *WpgT, *WpT, *W1T;
    bf16_t *H, *Qb, *CMPb, *SLCb, *WINb, *U, *Vg, *GA, *GB;
    float* GATE;
    float *PART, *PEB, *KCP, *VCP, *KCS, *VCS, *KN;
    bf16_t *KCb, *VCT, *SLCvT, *WINvT, *SLCkF, *WINkF, *GWb, *W2T;
    bf16_t* OCAT; float* T; bf16_t* Y1; float* F; float* X1; bf16_t* H2; bf16_t* ACT; float* X2; bf16_t* X2b; bf16_t* Pb;
};

__device__ __forceinline__ unsigned cvt_pk_bf16(float lo, float hi) { unsigned r; asm volatile("v_cvt_pk_bf16_f32 %0, %1, %2" : "=v"(r) : "v"(lo), "v"(hi)); return r; }
__device__ __forceinline__ bf16_t f2bf(float f) { return (bf16_t)(cvt_pk_bf16(f, 0.f) & 0xffffu); }
__device__ __forceinline__ float bf2f(bf16_t h) { return __uint_as_float(((unsigned)h) << 16); }
__device__ __forceinline__ float bflo(unsigned w) { return __uint_as_float(w << 16); }
__device__ __forceinline__ float bfhi(unsigned w) { return __uint_as_float(w & 0xffff0000u); }
__device__ __forceinline__ float ex2(float x) { return __builtin_amdgcn_exp2f(x); }
__device__ __forceinline__ float sigmoidf_(float x) { return 1.0f / (1.0f + __expf(-x)); }
__device__ __forceinline__ float siluf_(float x) { return x * sigmoidf_(x); }
__device__ __forceinline__ float geluf_(float x) {
    const float u = 0.7978845608028654f * (x + 0.044715f * x * x * x);
    const float e = __expf(2.0f * u);
    const float th = 1.0f - 2.0f / (e + 1.0f);
    return 0.5f * x * (1.0f + th);
}
__device__ __forceinline__ float wave_sum(float v) {
#pragma unroll
    for (int o = 32; o > 0; o >>= 1) v += __shfl_xor(v, o);
    return v;
}
__device__ __forceinline__ float wave_max(float v) {
#pragma unroll
    for (int o = 32; o > 0; o >>= 1) v = fmaxf(v, __shfl_xor(v, o));
    return v;
}
__device__ __forceinline__ int t5_bucket(int d) {
    if (d < 16) return d;
    if (d >= 128) return 31;
    const int b = 16 + (int)(__logf((float)d * (1.0f / 16.0f)) * (16.0f / 2.0794415416798357f));
    return b < 31 ? b : 31;
}

extern __shared__ __attribute__((aligned(16))) unsigned char smem[];
#ifndef PROBE_DUP
#define PROBE_DUP 0
#endif
#define PROBE_LDS_OFF 131072
#ifndef PROBE_SPIN
#define PROBE_SPIN 0
#endif
#ifndef PROBE_SEG
#define PROBE_SEG 5
#endif
__device__ __forceinline__ unsigned long long probe_now() { unsigned long long t; asm volatile("s_memrealtime %0\n\ts_waitcnt lgkmcnt(0)" : "=s"(t) :: "memory"); return t; }
#define PROBE_TS ((volatile LAS unsigned long long*)((LAS unsigned char*)smem + PROBE_LDS_OFF + 16))
#if PROBE_SPIN
#define PROBE_BEGIN(seg) unsigned long long pb_##seg = 0; if (PROBE_SEG == seg && threadIdx.x == 0) pb_##seg = probe_now();
#define PROBE_END(seg) if (PROBE_SEG == seg && threadIdx.x == 0) { PROBE_TS[2] = PROBE_TS[2] + (probe_now() - pb_##seg); }
#else
#define PROBE_BEGIN(seg)
#define PROBE_END(seg)
#endif

constexpr int BM = 256, BK = 64, HALF = 128, HT = HALF * BK, GEMM_LDS = 8 * HT * 2;
__device__ __forceinline__ int lds_byte(int r, int c) { const int st = (r >> 4) * 2 + (c >> 5), rr = r & 15, cc = c & 31, ob = rr * 64 + cc * 2; return st * 1024 + (ob ^ (((ob >> 9) & 1) << 5)); }
__device__ __forceinline__ void stage_rc(int b, int& R, int& C) { const int st = b / 1024, sb = b % 1024, swz = sb ^ (((sb >> 9) & 1) << 5); R = (st >> 1) * 16 + swz / 64; C = (st & 1) * 32 + (swz % 64) / 2; }

constexpr int HTB = HALF * BK * 2;
template <class F>
__device__ __forceinline__ void for_each_frag(const f32x4 (&acc)[2][2][4][2], int brow, int bcol, int wr, int wc, int fr, int fq, F&& f) {
#pragma unroll
    for (int ai = 0; ai < 2; ++ai)
#pragma unroll
        for (int m = 0; m < 4; ++m)
#pragma unroll
            for (int bj = 0; bj < 2; ++bj)
#pragma unroll
                for (int n = 0; n < 2; ++n)
                    f(brow + ai * HALF + wr * 64 + m * 16 + fr, bcol + bj * HALF + wc * 32 + n * 16 + fq * 4, acc[ai][bj][m][n]);
}

struct ZNone { __device__ __forceinline__ size_t a(int) const { return 0; } __device__ __forceinline__ size_t b(int) const { return 0; } };
template <class Epi, class ZMap = ZNone, bool HAS_MID = false>
__device__ __forceinline__ void gemm_phase(const bf16_t* A, int lda, const bf16_t* Bt, int K, int nM, int nN, const Epi& E, int nZ = 1, ZMap zm = ZMap(), int kstepA_el = BK) {
    LAS unsigned char* lds = (LAS unsigned char*)smem;
    int tid = threadIdx.x; asm volatile("" : "+v"(tid));
    const int wid = __builtin_amdgcn_readfirstlane(tid >> 6), lane = tid & 63, wr = wid >> 2, wc = wid & 3, fr = lane & 15, fq = lane >> 4;
    const int nt = K / BK, nmn = nM * nN, nu = nmn * nZ, G = gridDim.x;
    int u = blockIdx.x;
    if (u >= nu) return;
    unsigned voffA[2], voffB[2];
#pragma unroll
    for (int i = 0; i < 2; ++i) { int R, C; stage_rc(tid * 16 + i * 8192, R, C); voffA[i] = (unsigned)(R * lda + C) * 2u; voffB[i] = (unsigned)(R * K + C) * 2u; }
    const size_t kstep = (size_t)(BK * 2), kstepA = (size_t)kstepA_el * 2;
    const size_t hstepA = (size_t)HALF * lda * 2, hstepB = (size_t)HALF * K * 2, tstepA = 2 * hstepA, tstepB = 2 * hstepB;
    const unsigned ldsw = (unsigned)wid * 1024u;
    const int aoff = lds_byte(wr * 64 + fr, fq * 8), boff = lds_byte(wc * 32 + fr, fq * 8);
#define PG8_SA(b, h) (((b) * 2 + (h)) * HTB)
#define PG8_SB(b, h) ((4 + (b) * 2 + (h)) * HTB)
#define PG8_STAGE(bufoff, gbase, voff) do { _Pragma("unroll") for (int _i = 0; _i < 2; ++_i) \
        __builtin_amdgcn_global_load_lds((const unsigned*)((const char*)(gbase) + (voff)[_i]), (LAS unsigned*)(lds + (bufoff) + ldsw + _i * 8192), 16, 0, 0); } while (0)
#define PG8_LDA(dst, b, h) do { _Pragma("unroll") for (int m = 0; m < 4; ++m) _Pragma("unroll") for (int k = 0; k < 2; ++k) dst[m][k] = *(const LAS bf16x8*)(lds + PG8_SA(b, h) + aoff + m * 2048 + k * 1024); } while (0)
#define PG8_LDB(dst, b, h) do { _Pragma("unroll") for (int n = 0; n < 2; ++n) _Pragma("unroll") for (int k = 0; k < 2; ++k) dst[n][k] = *(const LAS bf16x8*)(lds + PG8_SB(b, h) + boff + n * 2048 + k * 1024); } while (0)
#define PG8_MMA(ai, bj, At, Bt_) do { __builtin_amdgcn_s_setprio(1); _Pragma("unroll") for (int m = 0; m < 4; ++m) _Pragma("unroll") for (int n = 0; n < 2; ++n) _Pragma("unroll") for (int k = 0; k < 2; ++k) \
        acc[ai][bj][m][n] = __builtin_amdgcn_mfma_f32_16x16x32_bf16(Bt_[n][k], At[m][k], acc[ai][bj][m][n], 0, 0, 0); __builtin_amdgcn_s_setprio(0); } while (0)
#define PG8_WAIT_V(n) asm volatile("s_waitcnt vmcnt(" #n ")" ::: "memory")
#define PG8_WAIT_L(n) asm volatile("s_waitcnt lgkmcnt(" #n ")" ::: "memory")
#define PG8_BAR __builtin_amdgcn_s_barrier()
#define PG8_SCHED __builtin_amdgcn_sched_barrier(0)
    f32x4 acc[2][2][4][2];
#pragma unroll
    for (int a = 0; a < 2; ++a)
#pragma unroll
        for (int b = 0; b < 2; ++b)
#pragma unroll
            for (int m = 0; m < 4; ++m)
#pragma unroll
                for (int n = 0; n < 2; ++n) acc[a][b][m][n] = (f32x4){0.f, 0.f, 0.f, 0.f};
    bf16x8 At[4][2], B0[2][2], B1[2][2];
    auto unit_of = [&](int uu, int& z_, int& pm_, int& pn_) {
        if (nZ == 1) {
            int wg = uu; { const int q = nu / 8, r = nu % 8, xcd = wg % 8, off = wg / 8; wg = (xcd < r ? xcd * (q + 1) : r * (q + 1) + (xcd - r) * q) + off; }
            const int nig = 8 * nN, gid = wg / nig, fm = gid * 8, gsz = (nM - fm) < 8 ? (nM - fm) : 8;
            z_ = 0; pm_ = fm + ((wg % nig) % gsz); pn_ = (wg % nig) / gsz;
        } else { z_ = uu / nmn; pm_ = (uu - z_ * nmn) / nN; pn_ = (uu - z_ * nmn) - pm_ * nN; }
    };
    int z, pm, pn; unit_of(u, z, pm, pn);
    const char* cA = (const char*)(A + zm.a(z)) + (size_t)pm * tstepA; const char* cB = (const char*)(Bt + zm.b(z)) + (size_t)pn * tstepB;
    PG8_STAGE(PG8_SB(0, 0), cB, voffB); PG8_STAGE(PG8_SA(0, 0), cA, voffA); PG8_STAGE(PG8_SB(0, 1), cB + hstepB, voffB); PG8_STAGE(PG8_SA(0, 1), cA + hstepA, voffA);
    if (wr == 1) PG8_BAR;
    PG8_WAIT_V(4); PG8_BAR;
    PG8_STAGE(PG8_SB(1, 0), cB + kstep, voffB); PG8_STAGE(PG8_SA(1, 0), cA + kstepA, voffA); PG8_STAGE(PG8_SB(1, 1), cB + hstepB + kstep, voffB);
    PG8_WAIT_V(6); PG8_BAR;
    for (;;) {
        const int un = u + G; const bool has_next = un < nu;
        int nz = z, npm = pm, npn = pn; if (has_next) unit_of(un, nz, npm, npn);
        const char* nA = (const char*)(A + zm.a(nz)) + (size_t)npm * tstepA; const char* nB = (const char*)(Bt + zm.b(nz)) + (size_t)npn * tstepB;
        auto kiter = [&](int t) {
            const bool last = (t == nt - 2);
            const bool bnd = last || (HAS_MID && t == (nt >> 1) - 2);
            const char* a1 = cA + (size_t)(t + 1) * kstepA;
            const char* a2 = last ? nA : cA + (size_t)(t + 2) * kstepA; const char* b2 = last ? nB : cB + (size_t)(t + 2) * kstep;
            const char* a3 = a2 + kstepA; const char* b3 = b2 + kstep;
            PG8_LDB(B0, 0, 0); PG8_SCHED; PG8_LDA(At, 0, 0); PG8_STAGE(PG8_SA(1, 1), a1 + hstepA, voffA);
            PG8_WAIT_L(8); PG8_BAR; PG8_WAIT_L(0); PG8_MMA(0, 0, At, B0); PG8_BAR; PG8_SCHED;
            PG8_LDB(B1, 0, 1); PG8_STAGE(PG8_SB(0, 0), b2, voffB);
            PG8_BAR; PG8_WAIT_L(0); PG8_MMA(0, 1, At, B1); PG8_BAR;
            PG8_LDA(At, 0, 1); PG8_STAGE(PG8_SA(0, 0), a2, voffA);
            PG8_BAR; PG8_WAIT_L(0); PG8_MMA(1, 0, At, B0); PG8_BAR; PG8_SCHED;
            PG8_STAGE(PG8_SB(0, 1), b2 + hstepB, voffB);
            PG8_WAIT_V(6); PG8_BAR; PG8_MMA(1, 1, At, B1); PG8_BAR;
            PG8_LDB(B0, 1, 0); PG8_SCHED; PG8_LDA(At, 1, 0); PG8_STAGE(PG8_SA(0, 1), a2 + hstepA, voffA);
            PG8_WAIT_L(8); PG8_BAR; PG8_WAIT_L(0); PG8_MMA(0, 0, At, B0); PG8_BAR; PG8_SCHED;
            PG8_LDB(B1, 1, 1); PG8_STAGE(PG8_SB(1, 0), b3, voffB);
            PG8_BAR; PG8_WAIT_L(0); PG8_MMA(0, 1, At, B1); PG8_BAR;
            PG8_LDA(At, 1, 1); PG8_STAGE(PG8_SA(1, 0), a3, voffA);
            PG8_BAR; PG8_WAIT_L(0); PG8_MMA(1, 0, At, B0); PG8_BAR; PG8_SCHED;
            PG8_STAGE(PG8_SB(1, 1), b3 + hstepB, voffB);
            PG8_WAIT_V(6); PG8_BAR; PG8_MMA(1, 1, At, B1);
            if (!(bnd && wr == 1)) PG8_BAR;
        };
        if constexpr (HAS_MID) {
            for (int t = 0; t < (nt >> 1); t += 2) kiter(t);
            { int pmo = pm, pno = pn; asm volatile("" : "+s"(pmo), "+s"(pno));
              E.mid(acc, pmo * BM, pno * BM, wr, wc, fr, fq); }
            PG8_SCHED; PG8_BAR; if (wr == 1) PG8_BAR;
            for (int t = nt >> 1; t < nt; t += 2) kiter(t);
        } else {
            for (int t = 0; t < nt; t += 2) kiter(t);
        }
        { int pmo = pm, pno = pn; asm volatile("" : "+s"(pmo), "+s"(pno));
          E(acc, pmo * BM, pno * BM + (z << 20), wr, wc, fr, fq); }
        PG8_SCHED; PG8_BAR;
        if (!has_next) break;
        if (wr == 1) PG8_BAR;
#pragma unroll
        for (int a = 0; a < 2; ++a)
#pragma unroll
            for (int b = 0; b < 2; ++b)
#pragma unroll
                for (int m = 0; m < 4; ++m)
#pragma unroll
                    for (int n = 0; n < 2; ++n) acc[a][b][m][n] = (f32x4){0.f, 0.f, 0.f, 0.f};
        u = un; z = nz; pm = npm; pn = npn; cA = nA; cB = nB;
    }
    PG8_WAIT_V(0);
    PG8_BAR;
#undef PG8_SA
#undef PG8_SB
#undef PG8_STAGE
#undef PG8_LDA
#undef PG8_LDB
#undef PG8_MMA
#undef PG8_WAIT_V
#undef PG8_WAIT_L
#undef PG8_BAR
#undef PG8_SCHED
}

__device__ __forceinline__ f32x4 mfma16(bf16x8 a, bf16x8 b, f32x4 c) { return __builtin_amdgcn_mfma_f32_16x16x32_bf16(a, b, c, 0, 0, 0); }
__device__ __forceinline__ bf16x8 pack_p(const f32x4& a, const f32x4& b) {
    u32x4 w; w.x = cvt_pk_bf16(a[0], a[1]); w.y = cvt_pk_bf16(a[2], a[3]); w.z = cvt_pk_bf16(b[0], b[1]); w.w = cvt_pk_bf16(b[2], b[3]);
    return __builtin_bit_cast(bf16x8, w);
}
__device__ __forceinline__ size_t kfrag_off(int key, int d) { return ((size_t)((key >> 4) * 2 + (d >> 5)) * 64 + ((d >> 3) & 3) * 16 + (key & 15)) * 8 + (d & 7); }
__device__ __forceinline__ size_t vfrag_off(int key, int d) {
    return ((size_t)((key >> 5) * 4 + (d >> 4)) * 64 + ((key >> 2) & 3) * 16 + (d & 15)) * 8 + ((key >> 4) & 1) * 4 + (key & 3);
}
__device__ __forceinline__ void st_bf16x4(bf16_t* p, f32x4 v) { u32x2 w; w.x = cvt_pk_bf16(v[0], v[1]); w.y = cvt_pk_bf16(v[2], v[3]); *(u32x2*)p = w; }

struct EpiIn {
    const Params& p;
    __device__ __forceinline__ void apply(int row, int col, f32x4 v) const {
        const Params& P = p; const int pn = col >> 8, c = col & 255;
        if (pn < 2) st_bf16x4(P.Qb + (size_t)row * QD + col, v * QSCALE);
        else if (pn < 5) {
            if (pn != 2) st_bf16x4((pn == 3 ? P.SLCb : P.WINb) + (size_t)row * 256 + c, v);
            if (pn < 4) *(f32x4*)(P.out + (pn == 2 ? O_CMPS : O_SLCS) + (size_t)(row - MP) * 256 + c) = v;
            else *(f32x4*)(P.out + O_WINS + ((size_t)(row - MP) * WIN + (WIN - 1)) * 256 + c) = v;
        } else if (pn < 9) {
            f32x4 g; g[0] = geluf_(v[0]); g[1] = geluf_(v[1]); g[2] = geluf_(v[2]); g[3] = geluf_(v[3]);
            st_bf16x4((pn < 7 ? P.U : P.Vg) + (size_t)row * GMD + (col - (pn < 7 ? 1280 : 1792)), g);
        } else if (pn < 17) {
            f32x4 g; g[0] = sigmoidf_(v[0]); g[1] = sigmoidf_(v[1]); g[2] = sigmoidf_(v[2]); g[3] = sigmoidf_(v[3]);
            st_bf16x4((pn < 13 ? P.GA : P.GB) + (size_t)row * DM + (col - (pn < 13 ? 2304 : 3328)), g);
        } else if (c < 24) { f32x4 g; g[0] = sigmoidf_(v[0]); g[1] = sigmoidf_(v[1]); g[2] = sigmoidf_(v[2]); g[3] = sigmoidf_(v[3]); *(f32x4*)(P.GATE + (size_t)row * 32 + c) = g; }
    }
    __device__ __forceinline__ void operator()(const f32x4 (&acc)[2][2][4][2], int brow, int bcol, int wr, int wc, int fr, int fq) const {
        const int pn = bcol >> 8;
        const Params& P = p;
        if (pn < 2) {
            for_each_frag(acc, brow, bcol, wr, wc, fr, fq, [&](int row, int col, f32x4 v) { st_bf16x4(P.Qb + (size_t)row * QD + col, v * QSCALE); });
        } else if (pn < 5) {
            bf16_t* cp = pn == 2 ? P.CMPb : pn == 3 ? P.SLCb : P.WINb;
            for_each_frag(acc, brow, bcol, wr, wc, fr, fq, [&](int row, int col, f32x4 v) {
                const int c = col & 255;
                if (pn == 2) st_bf16x4(cp + (size_t)row * 256 + c, v);
                if (pn >= 3 && c < 128 && row < MP) {
                    st_bf16x4((pn == 3 ? P.SLCkF : P.WINkF) + ((size_t)(row >> 13) * NG + (c >> 6)) * SEQ * 64 + kfrag_off(row & (SEQ - 1), c & 63), v);
                }
                if (pn >= 3 && c >= 128 && row < MP) {
                    const int t = row & (SEQ - 1), dc = c - 128;
                    bf16_t* vt = (pn == 3 ? P.SLCvT : P.WINvT) + ((size_t)(row >> 13) * NG + (dc >> 6)) * SEQ * 64 + vfrag_off(t, dc & 63);
                    vt[0] = f2bf(v[0]); vt[8] = f2bf(v[1]); vt[16] = f2bf(v[2]); vt[24] = f2bf(v[3]);
                }
                if (pn < 4) {
                    if (row < MP) *(f32x4*)(P.out + (pn == 2 ? O_CMPP : O_SLCP) + (size_t)row * 256 + c) = v;
                    else if (row < MP + NS) *(f32x4*)(P.out + (pn == 2 ? O_CMPS : O_SLCS) + (size_t)(row - MP) * 256 + c) = v;
                } else {
                    if (row < MP) { const int t = row & (SEQ - 1), b = row >> 13; if (t >= SEQ - WIN) *(f32x4*)(P.out + O_WINP + ((size_t)b * WIN + (t - (SEQ - WIN))) * 256 + c) = v; }
                    else if (row < MP + NS) *(f32x4*)(P.out + O_WINS + ((size_t)(row - MP) * WIN + (WIN - 1)) * 256 + c) = v;
                }
            });
        } else if (pn < 9) {
            bf16_t* dst = pn < 7 ? P.U : P.Vg; const int c0 = pn < 7 ? 1280 : 1792;
            for_each_frag(acc, brow, bcol, wr, wc, fr, fq, [&](int row, int col, f32x4 v) {
                f32x4 g; g[0] = geluf_(v[0]); g[1] = geluf_(v[1]); g[2] = geluf_(v[2]); g[3] = geluf_(v[3]);
                st_bf16x4(dst + (size_t)row * GMD + (col - c0), g); });
        } else if (pn < 17) {
            bf16_t* dst = pn < 13 ? P.GA : P.GB; const int c0 = pn < 13 ? 2304 : 3328;
            for_each_frag(acc, brow, bcol, wr, wc, fr, fq, [&](int row, int col, f32x4 v) {
                f32x4 g; g[0] = sigmoidf_(v[0]); g[1] = sigmoidf_(v[1]); g[2] = sigmoidf_(v[2]); g[3] = sigmoidf_(v[3]);
                st_bf16x4(dst + (size_t)row * DM + (col - c0), g); });
        } else {
            for_each_frag(acc, brow, bcol, wr, wc, fr, fq, [&](int row, int col, f32x4 v) {
                const int c = col & 255;
                if (c < 24) { f32x4 g; g[0] = sigmoidf_(v[0]); g[1] = sigmoidf_(v[1]); g[2] = sigmoidf_(v[2]); g[3] = sigmoidf_(v[3]); *(f32x4*)(P.GATE + (size_t)row * 32 + c) = g; } });
        }
    }
};
struct EpiBranch {
    const bf16_t* GA; const bf16_t* GB; bf16_t* Y1;
    __device__ __forceinline__ void mid(f32x4 (&acc)[2][2][4][2], int brow, int bcol, int wr, int wc, int fr, int fq) const {
#pragma unroll
        for (int ai = 0; ai < 2; ++ai)
#pragma unroll
            for (int m = 0; m < 4; ++m)
#pragma unroll
                for (int bj = 0; bj < 2; ++bj)
#pragma unroll
                    for (int n = 0; n < 2; ++n) {
                        const size_t o = (size_t)(brow + ai * HALF + wr * 64 + m * 16 + fr) * DM + bcol + bj * HALF + wc * 32 + n * 16 + fq * 4;
                        const u32x2 a = *(const u32x2*)(GA + o), b = *(const u32x2*)(GB + o);
                        f32x4& v = acc[ai][bj][m][n];
                        v[0] *= bflo(a.x) / fmaxf(bflo(b.x), 1e-30f); v[1] *= bfhi(a.x) / fmaxf(bfhi(b.x), 1e-30f);
                        v[2] *= bflo(a.y) / fmaxf(bflo(b.y), 1e-30f); v[3] *= bfhi(a.y) / fmaxf(bfhi(b.y), 1e-30f);
                        asm volatile("" : "+v"(v));
                        if (bj == 1 && n == 1) __builtin_amdgcn_sched_barrier(0);
                    }
    }
    __device__ __forceinline__ void operator()(const f32x4 (&acc)[2][2][4][2], int brow, int bcol, int wr, int wc, int fr, int fq) const {
        for_each_frag(acc, brow, bcol, wr, wc, fr, fq, [&](int row, int col, f32x4 v) {
            const u32x2 b = *(const u32x2*)(GB + (size_t)row * DM + col);
            f32x4 o; o[0] = v[0] * fmaxf(bflo(b.x), 1e-30f); o[1] = v[1] * fmaxf(bfhi(b.x), 1e-30f); o[2] = v[2] * fmaxf(bflo(b.y), 1e-30f); o[3] = v[3] * fmaxf(bfhi(b.y), 1e-30f);
            st_bf16x4(Y1 + (size_t)row * DM + col, o); });
    }
    __device__ __forceinline__ void apply2(int row, int col, f32x4 v1, f32x4 v2) const {
        const u32x2 a = *(const u32x2*)(GA + (size_t)row * DM + col), b = *(const u32x2*)(GB + (size_t)row * DM + col);
        f32x4 o; o[0] = v1[0] * bflo(a.x) + v2[0] * bflo(b.x); o[1] = v1[1] * bfhi(a.x) + v2[1] * bfhi(b.x); o[2] = v1[2] * bflo(a.y) + v2[2] * bflo(b.y); o[3] = v1[3] * bfhi(a.y) + v2[3] * bfhi(b.y);
        st_bf16x4(Y1 + (size_t)row * DM + col, o);
    }
};
struct EpiF32 {
    float* F; int ld;
    __device__ __forceinline__ void apply(int row, int col, f32x4 v) const { *(f32x4*)(F + (size_t)row * ld + col) = v; }
    __device__ __forceinline__ void operator()(const f32x4 (&acc)[2][2][4][2], int brow, int bcol, int wr, int wc, int fr, int fq) const {
        for_each_frag(acc, brow, bcol, wr, wc, fr, fq, [&](int row, int col, f32x4 v) { *(f32x4*)(F + (size_t)row * ld + col) = v; });
    }
};
struct EpiBf16 {
    bf16_t* O; int ld;
    __device__ __forceinline__ void apply(int row, int col, f32x4 v) const { st_bf16x4(O + (size_t)row * ld + col, v); }
    __device__ __forceinline__ void operator()(const f32x4 (&acc)[2][2][4][2], int brow, int bcol, int wr, int wc, int fr, int fq) const {
        for_each_frag(acc, brow, bcol, wr, wc, fr, fq, [&](int row, int col, f32x4 v) { apply(row, col, v); });
    }
};
struct EpiPart {
    bf16_t* PART;
    __device__ __forceinline__ void operator()(const f32x4 (&acc)[2][2][4][2], int brow, int bcol, int wr, int wc, int fr, int fq) const {
        const int z = bcol >> 20;
        for_each_frag(acc, brow, 0, wr, wc, fr, fq, [&](int row, int col, f32x4 v) { st_bf16x4(PART + ((size_t)row * 4 + z) * 256 + col, v); });
    }
};
struct ZCmp { __device__ __forceinline__ size_t a(int z) const { return (size_t)z * 64; } __device__ __forceinline__ size_t b(int z) const { return (size_t)(z >> 1) * 256 * 1024; } };
struct EpiSwiGLU {
    bf16_t* ACT;
    __device__ __forceinline__ void apply(int row, int col, f32x4 v) const { *(unsigned*)(ACT + (size_t)row * DFF + (col >> 1)) = cvt_pk_bf16(siluf_(v[0]) * v[1], siluf_(v[2]) * v[3]); }
    __device__ __forceinline__ void operator()(const f32x4 (&acc)[2][2][4][2], int brow, int bcol, int wr, int wc, int fr, int fq) const {
        for_each_frag(acc, brow, bcol, wr, wc, fr, fq, [&](int row, int col, f32x4 v) {
            *(unsigned*)(ACT + (size_t)row * DFF + (col >> 1)) = cvt_pk_bf16(siluf_(v[0]) * v[1], siluf_(v[2]) * v[3]); });
    }
};
struct EpiPleGate {
    const bf16_t* E; bf16_t* F;
    __device__ __forceinline__ void apply(int row, int col, f32x4 v) const {
        const u32x2 w = *(const u32x2*)(E + (size_t)row * DM + col);
        f32x4 o; o[0] = sigmoidf_(v[0]) * bflo(w.x); o[1] = sigmoidf_(v[1]) * bfhi(w.x); o[2] = sigmoidf_(v[2]) * bflo(w.y); o[3] = sigmoidf_(v[3]) * bfhi(w.y);
        st_bf16x4(F + (size_t)row * DM + col, o); }
    __device__ __forceinline__ void operator()(const f32x4 (&acc)[2][2][4][2], int brow, int bcol, int wr, int wc, int fr, int fq) const {
        for_each_frag(acc, brow, bcol, wr, wc, fr, fq, [&](int row, int col, f32x4 v) { apply(row, col, v); });
    }
};

template <class Epi>
__device__ __forceinline__ void gemm_skinny(const bf16_t* A  , int lda, const bf16_t* Bt, int K, int N, const Epi& E) {
    int tid = threadIdx.x; asm volatile("" : "+v"(tid));
    const int wid = __builtin_amdgcn_readfirstlane(tid >> 6), lane = tid & 63, c = lane & 15, G = lane >> 4;
    LAS f32x4* red = (LAS f32x4*)smem;
    const int nsteps = K / 32;
#pragma unroll 1
    for (int ct = blockIdx.x; ct < N / 16; ct += gridDim.x) {
        f32x4 acc0 = {0.f, 0.f, 0.f, 0.f}, acc1 = {0.f, 0.f, 0.f, 0.f};
        const bf16_t* bp = Bt + (size_t)(ct * 16 + c) * K + G * 8;
        const bf16_t* a0 = A + (size_t)c * lda + G * 8; const bf16_t* a1 = A + (size_t)(16 + c) * lda + G * 8;
#pragma unroll 4
        for (int kk = wid; kk < nsteps; kk += 8) {
            const bf16x8 bf = *(const bf16x8*)(bp + kk * 32), x0 = *(const bf16x8*)(a0 + kk * 32), x1 = *(const bf16x8*)(a1 + kk * 32);
            acc0 = mfma16(bf, x0, acc0); acc1 = mfma16(bf, x1, acc1);
        }
        __syncthreads();
        red[(wid * 2 + 0) * 64 + lane] = acc0; red[(wid * 2 + 1) * 64 + lane] = acc1;
        __syncthreads();
        if (tid < 128) {
            const int rt = tid >> 6;
            f32x4 v = red[rt * 64 + lane];
#pragma unroll
            for (int w = 1; w < 8; ++w) v = v + red[(w * 2 + rt) * 64 + lane];
            E.apply(MP + rt * 16 + c, ct * 16 + 4 * G, v);
        }
    }
    __syncthreads();
}

template <class Epi>
__device__ __forceinline__ void gemm_skinny2(const bf16_t* A  , int lda, const bf16_t* Bt, int K, int N, const Epi& E) {
    int tid = threadIdx.x; asm volatile("" : "+v"(tid));
    const int wid = __builtin_amdgcn_readfirstlane(tid >> 6), lane = tid & 63, c = lane & 15, G = lane >> 4;
    LAS f32x4* red = (LAS f32x4*)smem;
    const int hsteps = K / 64;
#pragma unroll 1
    for (int ct = blockIdx.x; ct < N / 16; ct += gridDim.x) {
        f32x4 acc[4] = {{0.f, 0.f, 0.f, 0.f}, {0.f, 0.f, 0.f, 0.f}, {0.f, 0.f, 0.f, 0.f}, {0.f, 0.f, 0.f, 0.f}};
        const bf16_t* bp = Bt + (size_t)(ct * 16 + c) * K + G * 8;
        const bf16_t* a0 = A + (size_t)c * lda + G * 8; const bf16_t* a1 = A + (size_t)(16 + c) * lda + G * 8;
#pragma unroll
        for (int h = 0; h < 2; ++h) {
#pragma unroll 2
            for (int kk = h * hsteps + wid; kk < (h + 1) * hsteps; kk += 8) {
                const bf16x8 bf = *(const bf16x8*)(bp + kk * 32), x0 = *(const bf16x8*)(a0 + kk * 32), x1 = *(const bf16x8*)(a1 + kk * 32);
                acc[h * 2] = mfma16(bf, x0, acc[h * 2]); acc[h * 2 + 1] = mfma16(bf, x1, acc[h * 2 + 1]);
            }
        }
        __syncthreads();
#pragma unroll
        for (int q = 0; q < 4; ++q) red[(wid * 4 + q) * 64 + lane] = acc[q];
        __syncthreads();
        if (tid < 128) {
            const int rt = tid >> 6;
            f32x4 v1 = red[rt * 64 + lane], v2 = red[(2 + rt) * 64 + lane];
#pragma unroll
            for (int w = 1; w < 8; ++w) { v1 = v1 + red[(w * 4 + rt) * 64 + lane]; v2 = v2 + red[(w * 4 + 2 + rt) * 64 + lane]; }
            E.apply2(MP + rt * 16 + c, ct * 16 + 4 * G, v1, v2);
        }
    }
    __syncthreads();
}

template <class Map>
__device__ __forceinline__ void transpose_tile(const float* W, int K, int N, bf16_t* Wt, int ldk, int kt, int ntile, Map map) {
    LAS float* tile = (LAS float*)smem;
    const int t = threadIdx.x;
    __syncthreads();
#pragma unroll
    for (int i = 0; i < 2; ++i) {
        const int k = (t >> 4) + 32 * i, n = (t & 15) * 4, gn = ntile * 64 + n;
        f32x4 v = (f32x4){0.f, 0.f, 0.f, 0.f};
        if (gn < N) v = *(const f32x4*)(W + (size_t)(kt * 64 + k) * N + gn);
        tile[k * 65 + n] = v[0]; tile[k * 65 + n + 1] = v[1]; tile[k * 65 + n + 2] = v[2]; tile[k * 65 + n + 3] = v[3];
    }
    __syncthreads();
    const int n = t >> 3, kc = (t & 7) * 8, gn = ntile * 64 + n;
    if (gn < N) {
        u32x4 w;
        w.x = cvt_pk_bf16(tile[(kc + 0) * 65 + n], tile[(kc + 1) * 65 + n]); w.y = cvt_pk_bf16(tile[(kc + 2) * 65 + n], tile[(kc + 3) * 65 + n]);
        w.z = cvt_pk_bf16(tile[(kc + 4) * 65 + n], tile[(kc + 5) * 65 + n]); w.w = cvt_pk_bf16(tile[(kc + 6) * 65 + n], tile[(kc + 7) * 65 + n]);
        *(u32x4*)(Wt + (size_t)map(gn) * ldk + kt * 64 + kc) = w;
    }
}
template <class Map>
__device__ __forceinline__ void transpose_all(const float* W, int K, int N, bf16_t* Wt, int ldk, Map map, int& base) {
    const int nkt = K / 64, nnt = (N + 63) / 64, ntl = nkt * nnt;
    for (int it = blockIdx.x; it < base + ntl; it += gridDim.x) {
        if (it < base) continue;
        const int l = it - base;
        transpose_tile(W, K, N, Wt, ldk, l / nnt, l % nnt, map);
    }
    base += ntl;
}
template <class Map>
__device__ __forceinline__ void transpose_all_sub(const float* W, int K, int N, bf16_t* Wt, int ldk, Map map, int& base) {
    const int nkt = K / 64, nnt = (N + 63) / 64, ntl = nkt * nnt, nb = gridDim.x - 32, me = blockIdx.x - 32;
    int first = base - (base % nb) + me; if (first < base) first += nb;
    for (int it = first; it < base + ntl; it += nb) { const int l = it - base; transpose_tile(W, K, N, Wt, ldk, l / nnt, l % nnt, map); }
    base += ntl;
}
__device__ __forceinline__ int map_win(int n) {
    if (n < 1280) return n;
    if (n < 1304) return 4352 + (n - 1280);
    if (n < 2328) return 1280 + (n - 1304);
    return 2304 + (n - 2328);
}

__device__ __forceinline__ float row_rstd(const f32x4 (&v)[4]) {
    float s = 0.f;
#pragma unroll
    for (int k = 0; k < 4; ++k) s += v[k][0] * v[k][0] + v[k][1] * v[k][1] + v[k][2] * v[k][2] + v[k][3] * v[k][3];
    s = wave_sum(s);
    return rsqrtf(s * (1.0f / DM) + EPS);
}
__device__ __forceinline__ const float* xrow_ptr(const Params& p, int row) {
    return row < MP ? p.x_prompt + (size_t)row * DM : p.x_sample + (size_t)(row - MP) * DM;
}

__device__ __forceinline__ void phase_prologue(const Params& p) {
    const int wid = threadIdx.x >> 6, lane = threadIdx.x & 63;
    const int gw = blockIdx.x * 8 + wid, nw = gridDim.x * 8;
    auto do_transposes = [&]() {
    int base = 0;
    transpose_all(p.w_in, DM, IND, p.WinT, DM, [](int n) { return map_win(n); }, base);
    for (int kv = 0; kv < 2; ++kv) for (int j = 0; j < 2; ++j)
        transpose_all((kv ? p.w1_v : p.w1_k) + (size_t)j * 1024 * 128, 1024, 128, p.W1T + ((size_t)kv * 256 + j * 128) * 1024, 1024, [](int n) { return n; }, base);
    };
    do_transposes();
    __syncthreads();
    for (int i = blockIdx.x * 512 + threadIdx.x; i < (INP - IND) * DM / 8; i += gridDim.x * 512) ((u32x4*)(p.WinT + (size_t)IND * DM))[i] = (u32x4){0u, 0u, 0u, 0u};
    for (int row0 = gw * 2; row0 < MP + NS; row0 += nw * 2) {
        f32x4 v[2][4];
#pragma unroll
        for (int q = 0; q < 2; ++q) { const float* xr = xrow_ptr(p, row0 + q);
#pragma unroll
            for (int k = 0; k < 4; ++k) v[q][k] = *(const f32x4*)(xr + lane * 4 + k * 256); }
#pragma unroll
        for (int q = 0; q < 2; ++q) {
            const int row = row0 + q;
            u32x2* hd = (u32x2*)(p.H + (size_t)row * DM);
            const float r = row_rstd(v[q]);
#pragma unroll
            for (int k = 0; k < 4; ++k) { const f32x4 g = *(const f32x4*)(p.ln_mix_pre + lane * 4 + k * 256); const f32x4 o = v[q][k] * r * g; u32x2 w; w.x = cvt_pk_bf16(o[0], o[1]); w.y = cvt_pk_bf16(o[2], o[3]); hd[lane + k * 64] = w; }
            const float* pr = row < MP ? p.p_prompt + (size_t)row * PLE : p.p_sample + (size_t)(row - MP) * PLE;
            const f32x4 pv = *(const f32x4*)(pr + lane * 4);
            u32x2 w; w.x = cvt_pk_bf16(pv[0], pv[1]); w.y = cvt_pk_bf16(pv[2], pv[3]);
            ((u32x2*)(p.Pb + (size_t)row * PLE))[lane] = w;
        }
    }
    for (int i = blockIdx.x * 512 + threadIdx.x; i < 4 * 128 * 128; i += gridDim.x * 512) { const int t = (i >> 7) & 127, s = i & 127; p.GWb[i] = f2bf(s <= t ? p.gm_ws[i] : 0.f); }
    for (int i = blockIdx.x * 512 + threadIdx.x; i < 2 * 64 * 128; i += gridDim.x * 512) { const int kv = i >> 13, d = (i >> 7) & 63, h = i & 127; p.W2T[i] = f2bf((kv ? p.w2_v : p.w2_k)[h * 64 + d]); }
    if (gw < 256) {
        const int kv = gw >> 7, h = gw & 127;
        const float* pe = kv ? p.pe_v : p.pe_k; const float* w1 = kv ? p.w1_v : p.w1_k;
        float s = 0.f;
#pragma unroll 8
        for (int k = lane; k < 2048; k += 64) s += pe[k] * w1[(size_t)k * 128 + h];
        s = wave_sum(s);
        if (lane == 0) p.PEB[kv * 128 + h] = s;
    }
    for (int i = blockIdx.x * 512 + threadIdx.x; i < NS * (WIN - 1) * 64; i += gridDim.x * 512) {
        const int b = i / ((WIN - 1) * 64), r = i % ((WIN - 1) * 64);
        ((f32x4*)(p.out + O_WINS + (size_t)b * WIN * 256))[r] = ((const f32x4*)(p.state_win + (size_t)b * WIN * 256 + 256))[r];
    }
}

__device__ __forceinline__ void phase_deferred_transposes(const Params& p) {
    if (blockIdx.x < 32) return;
    int base = 0;
    transpose_all_sub(p.w_br_nsa, QD, DM, p.WnT, DM, [](int n) { return n; }, base);
    transpose_all_sub(p.w_br_gm, GMD, DM, p.WnT + QD, DM, [](int n) { return n; }, base);
    transpose_all_sub(p.w_out, DM, DM, p.WoT, DM, [](int n) { return n; }, base);
    transpose_all_sub(p.w_gate, DM, DFF, p.WguT, DM, [](int n) { return 2 * n; }, base);
    transpose_all_sub(p.w_up, DM, DFF, p.WguT, DM, [](int n) { return 2 * n + 1; }, base);
    transpose_all_sub(p.w_down, DFF, DM, p.WdT, DFF, [](int n) { return n; }, base);
    transpose_all_sub(p.w_ple_gate, DM, DM, p.WpgT, DM, [](int n) { return n; }, base);
    transpose_all_sub(p.w_ple, PLE, DM, p.WpT, PLE, [](int n) { return n; }, base);
    __syncthreads();
}
__device__ __forceinline__ void phase_gather(const Params& p) {
    int tid = threadIdx.x; asm volatile("" : "+v"(tid));
    const int wid = tid >> 6, lane = tid & 63;
    const int gw = (blockIdx.x >> 1) * 8 + wid, nw = (gridDim.x >> 1) * 8;
    const int cls = blockIdx.x & 1;
#pragma unroll 1
    for (int r8h = gw; r8h < NS * PAST / 16; r8h += nw) {
        const int r8 = r8h * 2 + cls;
        const int r = r8 * 8, b = r >> 14, pos = r & (PAST - 1), l5 = lane & 31, hrow = lane >> 5;
        const float* s = p.cache_cmp + ((size_t)p.page_table[b * NPG + (pos >> 7)] * PAGE + (pos & 127) + hrow) * 256 + l5 * 8;
        f32x4 a[4], cc[4];
#pragma unroll
        for (int k = 0; k < 4; ++k) { a[k] = *(const f32x4*)(s + (size_t)k * 512); cc[k] = *(const f32x4*)(s + (size_t)k * 512 + 4); }
#pragma unroll
        for (int k = 0; k < 4; ++k) {
            u32x4 w; w.x = cvt_pk_bf16(a[k][0], a[k][1]); w.y = cvt_pk_bf16(a[k][2], a[k][3]); w.z = cvt_pk_bf16(cc[k][0], cc[k][1]); w.w = cvt_pk_bf16(cc[k][2], cc[k][3]);
            *(u32x4*)(p.CMPb + ((size_t)MP + r + 2 * k + hrow) * 256 + l5 * 8) = w;
        }
    }
}

__device__ __forceinline__ void phase_cmp_final(const Params& p) {
    const int wid = threadIdx.x >> 6, lane = threadIdx.x & 63;
    {
        const int c = lane & 15, G = lane >> 4;
        const int ngrp_p = NB * 4 * 32, ngrp_s = NS * 4 * 64;
#pragma unroll 1
        for (int it = blockIdx.x * 8 + wid; it < ngrp_p + ngrp_s; it += gridDim.x * 8) {
            const bool smp = it >= ngrp_p; const int l = smp ? it - ngrp_p : it;
            const int nch = smp ? 64 : 32, nc = smp ? NCS : NCP;
            const int ch = l % nch, z = (l / nch) & 3, seq = l / (nch * 4), kv = z >> 1, g = z & 1, n0 = ch * 16;
            const size_t r0 = smp ? (size_t)2048 + (size_t)seq * 1024 : (size_t)seq * 512;
            const int nr = n0 + c < nc ? n0 + c : nc - 1;
            const bf16_t* p0 = (const bf16_t*)p.PART + ((r0 + nr) * 4 + z) * 256;
            const bf16_t* p1 = (const bf16_t*)p.PART + ((r0 + nr + 1) * 4 + z) * 256 + 128;
            const float* pb = p.PEB + kv * 128;
            f32x4 acc[4] = {{0.f, 0.f, 0.f, 0.f}, {0.f, 0.f, 0.f, 0.f}, {0.f, 0.f, 0.f, 0.f}, {0.f, 0.f, 0.f, 0.f}};
#pragma unroll
            for (int ks = 0; ks < 4; ++ks) {
                const int h0 = 32 * ks + 8 * G;
                const u32x4 wa = *(const u32x4*)(p0 + h0), wb = *(const u32x4*)(p1 + h0);
                const f32x4 a0 = {bflo(wa.x), bfhi(wa.x), bflo(wa.y), bfhi(wa.y)}, a1 = {bflo(wa.z), bfhi(wa.z), bflo(wa.w), bfhi(wa.w)};
                const f32x4 b0 = {bflo(wb.x), bfhi(wb.x), bflo(wb.y), bfhi(wb.y)}, b1 = {bflo(wb.z), bfhi(wb.z), bflo(wb.w), bfhi(wb.w)};
                const f32x4 e0 = *(const f32x4*)(pb + h0), e1 = *(const f32x4*)(pb + h0 + 4);
                f32x4 x0 = a0 + b0 + e0, x1 = a1 + b1 + e1;
#pragma unroll
                for (int i = 0; i < 4; ++i) { x0[i] = siluf_(x0[i]); x1[i] = siluf_(x1[i]); }
                const bf16x8 A = pack_p(x0, x1);
#pragma unroll
                for (int nt = 0; nt < 4; ++nt) {
                    const bf16x8 B = *(const bf16x8*)(p.W2T + ((size_t)kv * 64 + nt * 16 + c) * 128 + h0);
                    acc[nt] = mfma16(A, B, acc[nt]);
                }
            }
#pragma unroll
            for (int nt = 0; nt < 4; ++nt) {
                const int d = nt * 16 + c;
#pragma unroll
                for (int i = 0; i < 4; ++i) {
                    const int n = n0 + 4 * G + i;
                    if (n < nc) {
                        if (smp) ((kv ? p.VCS : p.KCS) + (((size_t)seq * NG + g) * 1024 + n) * 64)[d] = acc[nt][i];
                        else if (kv == 0) p.KCb[((size_t)seq * NG + g) * 512 * 64 + kfrag_off(n, d)] = f2bf(acc[nt][i]);
                    }
                }
                if (!smp && kv == 1) {
                    f32x4 v = acc[nt];
#pragma unroll
                    for (int i = 0; i < 4; ++i) if (n0 + 4 * G + i >= nc) v[i] = 0.f;
                    st_bf16x4(p.VCT + ((size_t)seq * NG + g) * 512 * 64 + vfrag_off(n0 + 4 * G, d), v);
                }
            }
        }
    }
}

template <bool SAMPLE>
__device__ __forceinline__ void kv_row_ptr(const Params& p, int branch  , int b, int pos, int kv, int g, const bf16_t*& pb, const float*& pf) {
    const int off = kv * 128 + g * 64;
    if (!SAMPLE) { pf = nullptr; pb = (branch == 1 ? p.SLCb : p.WINb) + ((size_t)b * SEQ + pos) * 256 + off; }
    else if (pos >= PAST) { pf = nullptr; pb = (branch == 1 ? p.SLCb : p.WINb) + ((size_t)MP + b) * 256 + off; }
    else if (branch == 1) { pb = nullptr; pf = p.cache_slc + ((size_t)p.page_table[b * NPG + (pos >> 7)] * PAGE + (pos & 127)) * 256 + off; }
    else { pb = nullptr; pf = p.state_win + ((size_t)b * WIN + (pos - (PAST - WIN))) * 256 + off; }
}
__device__ __forceinline__ void dot4x64(const bf16_t* pb, const float* pf, const LAS float* qs_, float (&s)[4]) {
    s[0] = s[1] = s[2] = s[3] = 0.f;
    const LAS float* qs = qs_; asm volatile("" : "+v"(qs));
    if (pf) {
#pragma unroll 8
        for (int c = 0; c < 16; ++c) {
            const f32x4 kx = *(const f32x4*)(pf + c * 4);
#pragma unroll
            for (int h = 0; h < 4; ++h) { const f32x4 q = *(const LAS f32x4*)(qs + h * 64 + c * 4); s[h] += q[0] * kx[0] + q[1] * kx[1] + q[2] * kx[2] + q[3] * kx[3]; }
        }
    } else {
#pragma unroll 2
        for (int c = 0; c < 8; ++c) {
            const u32x4 w = *(const u32x4*)(pb + c * 8);
            const float k0 = bflo(w.x), k1 = bfhi(w.x), k2 = bflo(w.y), k3 = bfhi(w.y), k4 = bflo(w.z), k5 = bfhi(w.z), k6 = bflo(w.w), k7 = bfhi(w.w);
#pragma unroll
            for (int h = 0; h < 4; ++h) {
                const f32x4 qa = *(const LAS f32x4*)(qs + h * 64 + c * 8), qb = *(const LAS f32x4*)(qs + h * 64 + c * 8 + 4);
                s[h] += qa[0] * k0 + qa[1] * k1 + qa[2] * k2 + qa[3] * k3 + qb[0] * k4 + qb[1] * k5 + qb[2] * k6 + qb[3] * k7;
            }
        }
    }
}
template <bool SAMPLE>
__device__ __forceinline__ void attn_chunk(const Params& p, int branch, int b, int g, int t, int pos0, int lo, int hi,
                                           float (&m)[4], float (&l)[4], float (&o)[4], const LAS float* qs, LAS float* pbk, const LAS float* relb, int lane) {
    const int pos = pos0 + lane;
    const bool valid = pos >= lo && pos <= hi;
    float s[4] = {-1e30f, -1e30f, -1e30f, -1e30f};
    if (valid) {
        const bf16_t* pb; const float* pf; kv_row_ptr<SAMPLE>(p, branch, b, pos, 0, g, pb, pf);
        dot4x64(pb, pf, qs, s);
        const int bk = t5_bucket(t - pos);
#pragma unroll
        for (int h = 0; h < 4; ++h) s[h] += relb[bk * 8 + g * 4 + h];
    }
#pragma unroll
    for (int h = 0; h < 4; ++h) {
        const float mx = wave_max(s[h]);
        const float mn = fmaxf(m[h], mx);
        const float pr = valid ? ex2(s[h] - mn) : 0.f;
        const float sm = wave_sum(pr);
        const float al = ex2(m[h] - mn);
        l[h] = l[h] * al + sm; o[h] *= al; m[h] = mn;
        pbk[h * 64 + lane] = pr;
    }
    __builtin_amdgcn_wave_barrier();
    const int k0 = (lo > pos0 ? lo : pos0) - pos0, k1 = (hi < pos0 + 63 ? hi : pos0 + 63) - pos0;
    if (SAMPLE) {
        const int kend = (PAST - 1 - pos0) < k1 ? (PAST - 1 - pos0) : k1;
        if (kend >= k0) {
            const bf16_t* pb; const float* pf; kv_row_ptr<SAMPLE>(p, branch, b, pos0 + k0, 1, g, pb, pf);
            pf += lane;
#pragma unroll 16
            for (int k = k0; k <= kend; ++k) {
                const float v = pf[(size_t)(k - k0) * 256];
#pragma unroll
                for (int h = 0; h < 4; ++h) o[h] += pbk[h * 64 + k] * v;
            }
        }
        if (k1 > kend) {
            const bf16_t* pb; const float* pf; kv_row_ptr<SAMPLE>(p, branch, b, pos0 + k1, 1, g, pb, pf);
            const float v = bf2f(pb[lane]);
#pragma unroll
            for (int h = 0; h < 4; ++h) o[h] += pbk[h * 64 + k1] * v;
        }
    } else {
#pragma unroll 1
    for (int k = k0; k <= k1; ++k) {
        const bf16_t* pb; const float* pf; kv_row_ptr<SAMPLE>(p, branch, b, pos0 + k, 1, g, pb, pf);
        const float v = pf ? pf[lane] : bf2f(pb[lane]);
#pragma unroll
        for (int h = 0; h < 4; ++h) o[h] += pbk[h * 64 + k] * v;
    }
    }
    __builtin_amdgcn_wave_barrier();
}

constexpr int S_QS = 0, S_SC = 1024, S_PHS = S_SC + 4 * 1024 * 4, S_PBK = S_PHS + 1088 * 4, S_PART = S_PBK + 8 * 1024, S_RED = S_PART + 2 * 8 * 272 * 4, S_OCP = S_RED + 512,
              S_SEL = S_OCP + 2048, S_RELB = S_SEL + 64, ATTS_LDS = S_RELB + 1024;
__device__ __forceinline__ void attn_sample_item(const Params& p, int b, int g) {
    const int tid = threadIdx.x, wid = tid >> 6, lane = tid & 63;
    constexpr int t = PAST, NC = NCS, NSEL = 257, NJR = 5, qblk = PAST >> 6;
    const int row = MP + b;
    LAS unsigned char* L = (LAS unsigned char*)smem;
    LAS float* qs = (LAS float*)(L + S_QS); LAS float* sc = (LAS float*)(L + S_SC); LAS float* phs = (LAS float*)(L + S_PHS); LAS float* pbk = (LAS float*)(L + S_PBK) + wid * 256;
    LAS float* part = (LAS float*)(L + S_PART); LAS float* red = (LAS float*)(L + S_RED); LAS float* ocp = (LAS float*)(L + S_OCP); LAS int* sel = (LAS int*)(L + S_SEL);
    LAS float* relb = (LAS float*)(L + S_RELB);
    __syncthreads();
    if (tid < 256) { relb[tid] = p.rel_bias[tid] * LOG2E; qs[tid] = bf2f(p.Qb[(size_t)row * QD + g * 256 + tid]); }
    __syncthreads();
    const float* kc = p.KCS + ((size_t)b * NG + g) * 1024 * 64;
    const float* vc = p.VCS + ((size_t)b * NG + g) * 1024 * 64;
    {
        float mx[4] = {-1e30f, -1e30f, -1e30f, -1e30f};
#pragma unroll 1
        for (int r = wid; r < 16; r += 8) {
            const int n = r * 64 + lane;
            float s[4] = {-1e30f, -1e30f, -1e30f, -1e30f};
            if (n < NC) {
                dot4x64(nullptr, kc + (size_t)n * 64, qs, s);
                const int bk = t5_bucket(t - (16 * n + 31));
#pragma unroll
                for (int h = 0; h < 4; ++h) s[h] += relb[bk * 8 + g * 4 + h];
            }
#pragma unroll
            for (int h = 0; h < 4; ++h) { sc[h * 1024 + n] = s[h]; mx[h] = fmaxf(mx[h], s[h]); }
        }
#pragma unroll
        for (int h = 0; h < 4; ++h) { const float m = wave_max(mx[h]); if (lane == 0) red[wid * 4 + h] = m; }
    }
    __syncthreads();
    float gmx[4], inv[4];
#pragma unroll
    for (int h = 0; h < 4; ++h) { float m = red[h]; for (int w = 1; w < 8; ++w) m = fmaxf(m, red[w * 4 + h]); gmx[h] = m; }
    {
        float sum[4] = {0.f, 0.f, 0.f, 0.f};
#pragma unroll
        for (int k = 0; k < 2; ++k) { const int n = tid + 512 * k;
#pragma unroll
            for (int h = 0; h < 4; ++h) { const float e = n < NC ? ex2(sc[h * 1024 + n] - gmx[h]) : 0.f; sc[h * 1024 + n] = e; sum[h] += e; } }
#pragma unroll
        for (int h = 0; h < 4; ++h) { const float s = wave_sum(sum[h]); if (lane == 0) red[32 + wid * 4 + h] = s; }
    }
    __syncthreads();
#pragma unroll
    for (int h = 0; h < 4; ++h) { float s = 0.f; for (int w = 0; w < 8; ++w) s += red[32 + w * 4 + h]; inv[h] = s > 0.f ? 1.0f / s : 0.f; }
    for (int n = tid; n < 1088; n += 512) phs[n] = n < NC ? (sc[n] * inv[0] + sc[1024 + n] * inv[1]) + (sc[2048 + n] * inv[2] + sc[3072 + n] * inv[3]) : 0.f;
    {
        float a[4] = {0.f, 0.f, 0.f, 0.f};
#pragma unroll 16
        for (int n = wid; n < NC; n += 8) {
            const float v = vc[(size_t)n * 64 + lane];
#pragma unroll
            for (int h = 0; h < 4; ++h) a[h] += sc[h * 1024 + n] * v;
        }
#pragma unroll
        for (int h = 0; h < 4; ++h) part[(wid * 4 + h) * 68 + lane] = a[h] * inv[h];
    }
    __syncthreads();
    if (tid < 256) { float a = 0.f; for (int w = 0; w < 8; ++w) a += part[(w * 4 + (tid >> 6)) * 68 + (tid & 63)]; ocp[tid] = a; }
    __syncthreads();
    if (wid == 0) {
        unsigned long long key[NJR];
#pragma unroll
        for (int jr = 0; jr < NJR; ++jr) {
            const int j = jr * 64 + lane;
            key[jr] = 0ull;
            if (j >= 1 && j <= qblk - 2 && j < NSEL) {
                float im = 0.f;
#pragma unroll
                for (int n = 4 * j - 1; n <= 4 * j + 3; ++n) im += (n < NC) ? phs[n] : 0.f;
                key[jr] = ((unsigned long long)__float_as_uint(im) << 32) | (unsigned)(0xFFFF - j) | 0x10000ull;
            }
        }
        if (lane == 0) { sel[0] = 0; sel[1] = qblk - 1; sel[2] = qblk; }
#pragma unroll 1
        for (int it = 0; it < 13; ++it) {
            unsigned long long best = 0ull;
#pragma unroll
            for (int jr = 0; jr < NJR; ++jr) best = key[jr] > best ? key[jr] : best;
#pragma unroll
            for (int o = 32; o > 0; o >>= 1) { const unsigned long long ot = __shfl_xor(best, o); best = ot > best ? ot : best; }
            const int j = 0xFFFF - (int)(best & 0xFFFFull);
#pragma unroll
            for (int jr = 0; jr < NJR; ++jr) if (key[jr] == best) key[jr] = 0ull;
            if (lane == 0) sel[3 + it] = j;
        }
    }
    __syncthreads();
    {
        float ms[4] = {-1e30f, -1e30f, -1e30f, -1e30f}, ls[4] = {0.f, 0.f, 0.f, 0.f}, os[4] = {0.f, 0.f, 0.f, 0.f};
#pragma unroll 1
        for (int i = wid; i < 16; i += 8) attn_chunk<true>(p, 1, b, g, t, sel[i] * 64, 0, t, ms, ls, os, qs, pbk, relb, lane);
        float mw[4] = {-1e30f, -1e30f, -1e30f, -1e30f}, lw[4] = {0.f, 0.f, 0.f, 0.f}, ow[4] = {0.f, 0.f, 0.f, 0.f};
#pragma unroll 1
        for (int c = wid; c < 9; c += 8) attn_chunk<true>(p, 2, b, g, t, t - 63 - 64 * c, t - WIN, t, mw, lw, ow, qs, pbk, relb, lane);
#pragma unroll
        for (int h = 0; h < 4; ++h) {
            LAS float* ps = part + (wid * 4 + h) * 68; LAS float* pw = part + 8 * 272 + (wid * 4 + h) * 68;
            ps[lane] = os[h]; pw[lane] = ow[h];
            if (lane == 0) { ps[64] = ms[h]; ps[65] = ls[h]; pw[64] = mw[h]; pw[65] = lw[h]; }
        }
    }
    __syncthreads();
    if (tid < 256) {
        const int h = tid >> 6, d = tid & 63;
        float res[2];
#pragma unroll
        for (int br = 0; br < 2; ++br) {
            const LAS float* pp = part + br * 8 * 272 + h * 68;
            float m = -1e30f;
            for (int w = 0; w < 8; ++w) m = fmaxf(m, pp[w * 272 + 64]);
            float l = 0.f, o = 0.f;
            for (int w = 0; w < 8; ++w) { const float sc_ = ex2(pp[w * 272 + 64] - m); l += pp[w * 272 + 65] * sc_; o += pp[w * 272 + d] * sc_; }
            res[br] = o / l;
        }
        const float* gt = p.GATE + (size_t)row * 32 + (g * 4 + h) * 3;
        const float v = gt[0] * ocp[tid] + gt[1] * res[0] + gt[2] * res[1];
        p.OCAT[(size_t)row * DM + (g * 4 + h) * 64 + d] = f2bf(v);
    }
    __syncthreads();
}

constexpr int A_OST = 0, OST_LD = 68, A_LST = A_OST + 256 * OST_LD * 4, A_M0 = A_LST + 1024, A_MB = A_M0 + 1024, MB_LD = 132, A_MKN = A_MB + 64 * MB_LD,
              A_LIST = A_MKN + 256, A_CNT = A_LIST + 132 * 64, A_PK = A_CNT + 544, A_KN = A_PK + 400 * 4, A_T2 = A_KN + 512, A_NP = A_T2 + 132 * 8 * 4, A_QT = A_NP + 16, ATT2_LDS = A_QT + 64 * 512;
static_assert(ATT2_LDS <= GEMM_LDS && ATTS_LDS <= GEMM_LDS, "attention LDS");

__device__ __forceinline__ void qk64(const bf16_t* kb, int c, int G, const bf16x8 (&qB)[2], f32x4 (&s)[4]) {
#pragma unroll
    for (int kt = 0; kt < 4; ++kt) {
        const bf16_t* r = kb + (size_t)(16 * kt + c) * 256 + G * 8;
        const bf16x8 a0 = *(const bf16x8*)r, a1 = *(const bf16x8*)(r + 32);
        s[kt] = mfma16(a0, qB[0], (f32x4){0.f, 0.f, 0.f, 0.f}); s[kt] = mfma16(a1, qB[1], s[kt]);
    }
}
__device__ __forceinline__ void pv64(const bf16_t* vf, int key0, int lane, const f32x4 (&pr)[4], f32x4 (&o)[4]) {
#pragma unroll
    for (int ks = 0; ks < 2; ++ks) {
        const bf16x8 pB = pack_p(pr[2 * ks], pr[2 * ks + 1]);
#pragma unroll
        for (int dt = 0; dt < 4; ++dt) {
            const bf16x8 vA = *(const bf16x8*)(vf + ((size_t)(((key0 >> 5) + ks) * 4 + dt) * 64 + lane) * 8);
            o[dt] = mfma16(vA, pB, o[dt]);
        }
    }
}
__device__ __forceinline__ int qt_off(int qi, int hh, int k) { return (qi * 4 + hh) * 128 + ((k ^ (((qi & 3) << 1) | (hh >> 1))) << 4); }
__device__ __forceinline__ float grp_max(float v) {
    auto r = __builtin_amdgcn_permlane16_swap(__float_as_uint(v), __float_as_uint(v), false, false); v = fmaxf(__uint_as_float(r[0]), __uint_as_float(r[1]));
    r = __builtin_amdgcn_permlane32_swap(__float_as_uint(v), __float_as_uint(v), false, false); return fmaxf(__uint_as_float(r[0]), __uint_as_float(r[1]));
}
__device__ __forceinline__ float grp_sum(float v) {
    auto r = __builtin_amdgcn_permlane16_swap(__float_as_uint(v), __float_as_uint(v), false, false); v = __uint_as_float(r[0]) + __uint_as_float(r[1]);
    r = __builtin_amdgcn_permlane32_swap(__float_as_uint(v), __float_as_uint(v), false, false); return __uint_as_float(r[0]) + __uint_as_float(r[1]);
}
__device__ __forceinline__ int grp_min_i(int v) {
    auto r = __builtin_amdgcn_permlane16_swap((unsigned)v, (unsigned)v, false, false); v = (int)r[0] < (int)r[1] ? (int)r[0] : (int)r[1];
    r = __builtin_amdgcn_permlane32_swap((unsigned)v, (unsigned)v, false, false); return (int)r[0] < (int)r[1] ? (int)r[0] : (int)r[1];
}
__device__ __forceinline__ float dpp_x1(float v) { return __uint_as_float(__builtin_amdgcn_mov_dpp(__float_as_uint(v), 0xB1, 0xF, 0xF, true)); }
__device__ __forceinline__ float dpp_x2(float v) { return __uint_as_float(__builtin_amdgcn_mov_dpp(__float_as_uint(v), 0x4E, 0xF, 0xF, true)); }
__device__ __forceinline__ int dpp_x1i(int v) { return (int)__builtin_amdgcn_mov_dpp((unsigned)v, 0xB1, 0xF, 0xF, true); }
__device__ __forceinline__ int dpp_x2i(int v) { return (int)__builtin_amdgcn_mov_dpp((unsigned)v, 0x4E, 0xF, 0xF, true); }
__device__ __forceinline__ unsigned row_or_q(unsigned u) {
    u |= __builtin_amdgcn_mov_dpp(u, 0x124, 0xF, 0xF, true); u |= __builtin_amdgcn_mov_dpp(u, 0x128, 0xF, 0xF, true); return u;
}

__device__ __forceinline__ void attn_cmp(const Params& p, int b, int g, int t0, int lane_, LAS unsigned char* L, unsigned (&msk)[4]) {
    f32x4 oacc[4];
    int lane = lane_; asm volatile("" : "+v"(lane));
    const int c = lane & 15, G = lane >> 4, qs = c >> 2, hh = c & 3;
    const int qb = t0 >> 6, tc = t0 + qs;
    const size_t qrow = (size_t)b * SEQ + tc;
    const LAS float* T2 = (const LAS float*)(L + A_T2);
    const float b31 = T2[128 * 8 + g * 4 + hh];
    bf16x8 qB[2];
    qB[0] = *(const bf16x8*)(p.Qb + qrow * QD + (g * 4 + hh) * 64 + G * 8); qB[1] = *(const bf16x8*)(p.Qb + qrow * QD + (g * 4 + hh) * 64 + 32 + G * 8);
    const float* gate = p.GATE + qrow * 32 + (g * 4 + hh) * 3;
    msk[0] = msk[1] = msk[2] = msk[3] = 0u;
    {
        const int ncv_c = tc >= 31 ? ((tc - 31) >> 4) + 1 : 0;
        const int ncv_m = t0 + 3 >= 31 ? ((t0 + 3 - 31) >> 4) + 1 : 0;
        const int NT = (ncv_m + 15) >> 4;
        const int mt_far = t0 >= 399 ? (t0 - 399) / 256 + 1 : 0;
        const bf16_t* kcb = p.KCb + (size_t)(b * NG + g) * 512 * 64;
        f32x4 sc[32];
        float mxf = -1e30f, mxn = -1e30f;
        bf16x8 kbuf[2][4][2];
        auto ldkg = [&](int grp, bf16x8 (&kb)[4][2]) __attribute__((always_inline)) {
#pragma unroll
            for (int q = 0; q < 4; ++q) { const bf16_t* r = kcb + ((size_t)((grp * 4 + q) * 2) * 64 + lane) * 8; kb[q][0] = *(const bf16x8*)r; kb[q][1] = *(const bf16x8*)(r + 512); }
        };
        ldkg(0, kbuf[0]);
#pragma unroll
        for (int grp = 0; grp < 8; ++grp) {
            if (4 * grp < NT) {
                if (4 * (grp + 1) < NT) ldkg(grp + 1, kbuf[(grp + 1) & 1]);
                __builtin_amdgcn_sched_barrier(0);
#pragma unroll
                for (int q = 0; q < 4; ++q) {
                    const int mt = grp * 4 + q;
                    f32x4 s = mfma16(kbuf[grp & 1][q][0], qB[0], (f32x4){0.f, 0.f, 0.f, 0.f}); s = mfma16(kbuf[grp & 1][q][1], qB[1], s);
                    if (mt < mt_far) { mxf = fmaxf(mxf, fmaxf(fmaxf(s[0], s[1]), fmaxf(s[2], s[3]))); }
                    else {
#pragma unroll
                        for (int i = 0; i < 4; ++i) { const int n = 16 * mt + 4 * G + i; int dist = tc - (16 * n + 31); const bool ok = n < ncv_c; dist = dist < 0 ? 0 : (dist > 128 ? 128 : dist);
                            s[i] = ok ? s[i] + T2[dist * 8 + g * 4 + hh] : -1e30f; }
                        mxn = fmaxf(mxn, fmaxf(fmaxf(s[0], s[1]), fmaxf(s[2], s[3])));
                    }
                    sc[mt] = s;
                }
            } else {
#pragma unroll
                for (int q = 0; q < 4; ++q) sc[grp * 4 + q] = (f32x4){0.f, 0.f, 0.f, 0.f};
            }
        }
        const float mx = grp_max(fmaxf(mxf + b31, mxn));
        const float shf = mx - b31;
#pragma unroll
        for (int mt = 0; mt < 32; ++mt) if ((mt & ~3) < NT) {
            const float sh = mt < mt_far ? shf : mx;
#pragma unroll
            for (int i = 0; i < 4; ++i) sc[mt][i] = ex2(sc[mt][i] - sh);
        }
        const bf16_t* vct = p.VCT + (size_t)(b * NG + g) * 64 * 512;
        const bf16x8 ones = __builtin_bit_cast(bf16x8, (u32x4){0x3F803F80u, 0x3F803F80u, 0x3F803F80u, 0x3F803F80u});
        f32x4 oc[4] = {{0.f, 0.f, 0.f, 0.f}, {0.f, 0.f, 0.f, 0.f}, {0.f, 0.f, 0.f, 0.f}, {0.f, 0.f, 0.f, 0.f}};
        f32x4 rs = {0.f, 0.f, 0.f, 0.f};
        bf16x8 vbuf[2][2][4];
        auto ldvg = [&](int grp, bf16x8 (&vb)[2][4]) __attribute__((always_inline)) {
#pragma unroll
            for (int q = 0; q < 2; ++q)
#pragma unroll
                for (int dt = 0; dt < 4; ++dt) vb[q][dt] = *(const bf16x8*)(vct + ((size_t)((grp * 2 + q) * 4 + dt) * 64 + lane) * 8);
        };
        ldvg(0, vbuf[0]);
#pragma unroll
        for (int grp = 0; grp < 8; ++grp) if (4 * grp < NT) {
            if (4 * (grp + 1) < NT) ldvg(grp + 1, vbuf[(grp + 1) & 1]);
            __builtin_amdgcn_sched_barrier(0);
#pragma unroll
            for (int q = 0; q < 2; ++q) {
                const int k2 = grp * 2 + q;
                const bf16x8 pB = pack_p(sc[2 * k2], sc[2 * k2 + 1]);
                rs = mfma16(ones, pB, rs);
#pragma unroll
                for (int dt = 0; dt < 4; ++dt) oc[dt] = mfma16(vbuf[grp & 1][q][dt], pB, oc[dt]);
            }
        }
        const float inv = ncv_c > 0 ? 1.0f / rs[0] : 0.f;
        if (qb <= 15) {
            msk[0] = (qb >= 31) ? 0xffffffffu : ((2u << qb) - 1u);
        } else {
            unsigned cand[8];
#pragma unroll
            for (int k = 0; k < 8; ++k) cand[k] = 0u;
            float prevB = 0.f;
#pragma unroll
            for (int mt = 0; mt < 32; ++mt) if (mt < NT) {
                const unsigned x3 = __float_as_uint(sc[mt][3]);
                const auto p16 = __builtin_amdgcn_permlane16_swap(x3, x3, false, false);
                const auto p32 = __builtin_amdgcn_permlane32_swap(p16[1], p16[1], false, false);
                const float r1 = G == 2 ? __uint_as_float(p32[0]) : __uint_as_float(p16[0]);
                float v = ((sc[mt][0] + sc[mt][1]) + (sc[mt][2] + sc[mt][3]) + (G == 0 ? prevB : r1)) * inv;
                prevB = __uint_as_float(p32[1]);
                v += dpp_x1(v); v += dpp_x2(v);
                const int j = 4 * mt + G;
                if ((mt & 3) == hh) cand[mt >> 2] = (j >= 1 && j <= qb - 2) ? ((__float_as_uint(v) & ~127u) | (unsigned)(127 - j)) : 0u;
            }
            auto setbit = [&](int j) { const unsigned bit = 1u << (j & 31); const int w = j >> 5; msk[0] |= w == 0 ? bit : 0u; msk[1] |= w == 1 ? bit : 0u; msk[2] |= w == 2 ? bit : 0u; msk[3] |= w == 3 ? bit : 0u; };
            setbit(0); setbit(qb); setbit(qb - 1);
#pragma unroll 1
            for (int it = 0; it < 13; ++it) {
                unsigned bv = cand[0];
#pragma unroll
                for (int k = 1; k < 8; ++k) bv = bv > cand[k] ? bv : cand[k];
                { unsigned o = __builtin_amdgcn_mov_dpp(bv, 0xB1, 0xF, 0xF, true); bv = o > bv ? o : bv; o = __builtin_amdgcn_mov_dpp(bv, 0x4E, 0xF, 0xF, true); bv = o > bv ? o : bv;
                  auto r = __builtin_amdgcn_permlane16_swap(bv, bv, false, false); bv = r[0] > r[1] ? r[0] : r[1]; r = __builtin_amdgcn_permlane32_swap(bv, bv, false, false); bv = r[0] > r[1] ? r[0] : r[1]; }
#pragma unroll
                for (int k = 0; k < 8; ++k) cand[k] = cand[k] == bv ? 0u : cand[k];
                setbit(127 - (int)(bv & 127u));
            }
        }
        const float g0 = gate[0] * inv;
#pragma unroll
        for (int dt = 0; dt < 4; ++dt) oacc[dt] = oc[dt] * g0;
    }
    bf16_t* orow = p.OCAT + qrow * DM + (g * 4 + hh) * 64 + 4 * G;
#pragma unroll
    for (int dt = 0; dt < 4; ++dt) st_bf16x4(orow + dt * 16, oacc[dt]);
}

struct PackSt { bf16x8 q0, q1; float m; f32x4 l4; f32x4 o[4]; };
__device__ __forceinline__ void attn_selwin_pair(const Params& p, int b, int g, int t0, int lane_, LAS unsigned char* L, const unsigned (&mskA)[4], const unsigned (&mskB)[4]) {
    int lane = lane_; asm volatile("" : "+v"(lane));
    const int c = lane & 15, G = lane >> 4, qs = c >> 2, hh = c & 3;
    const int qb = t0 >> 6;
    const LAS float* T2 = (const LAS float*)(L + A_T2);
    const float b31 = T2[128 * 8 + g * 4 + hh];
    const int tcA = t0 + qs, tcB = t0 + 4 + qs;
    const size_t qrowA = (size_t)b * SEQ + tcA;
    PackSt A, B;
    {
        const bf16_t* qa = p.Qb + qrowA * QD + (g * 4 + hh) * 64 + G * 8;
        A.q0 = *(const bf16x8*)qa; A.q1 = *(const bf16x8*)(qa + 32); B.q0 = *(const bf16x8*)(qa + 4 * QD); B.q1 = *(const bf16x8*)(qa + 4 * QD + 32);
    }
    auto reset = [&](PackSt& S) __attribute__((always_inline)) { S.m = -1e30f; S.l4 = (f32x4){0.f, 0.f, 0.f, 0.f};
#pragma unroll
        for (int dt = 0; dt < 4; ++dt) S.o[dt] = (f32x4){0.f, 0.f, 0.f, 0.f}; };
    const bf16x8 ones = __builtin_bit_cast(bf16x8, (u32x4){0x3F803F80u, 0x3F803F80u, 0x3F803F80u, 0x3F803F80u});
    auto finish = [&](PackSt& S, f32x4 (&s)[4], float cb, bool mine, const bf16x8 (&vf)[2][4]) __attribute__((always_inline)) {
        float cm = fmaxf(fmaxf(fmaxf(s[0][0], s[0][1]), fmaxf(s[0][2], s[0][3])), fmaxf(fmaxf(s[1][0], s[1][1]), fmaxf(s[1][2], s[1][3])));
        cm = fmaxf(cm, fmaxf(fmaxf(fmaxf(s[2][0], s[2][1]), fmaxf(s[2][2], s[2][3])), fmaxf(fmaxf(s[3][0], s[3][1]), fmaxf(s[3][2], s[3][3]))));
        cm = grp_max(mine ? cm + cb : -1e30f);
        const float mn = fmaxf(S.m, cm), al = ex2(S.m - mn);
        const float sh = (mine ? mn : 1e30f) - cb;
#pragma unroll
        for (int kt = 0; kt < 4; ++kt)
#pragma unroll
            for (int i = 0; i < 4; ++i) s[kt][i] = ex2(s[kt][i] - sh);
        S.m = mn;
        f32x4 rs = {0.f, 0.f, 0.f, 0.f};
#pragma unroll
        for (int dt = 0; dt < 4; ++dt) S.o[dt] = S.o[dt] * al;
#pragma unroll
        for (int ks = 0; ks < 2; ++ks) { const bf16x8 pB = pack_p(s[2 * ks], s[2 * ks + 1]);
            rs = mfma16(ones, pB, rs);
#pragma unroll
            for (int dt = 0; dt < 4; ++dt) S.o[dt] = mfma16(vf[ks][dt], pB, S.o[dt]); }
        S.l4[0] = S.l4[0] * al + rs[0];
    };
    auto addout = [&](PackSt& S, size_t qrow, int br) __attribute__((always_inline)) {
        const float gs = p.GATE[qrow * 32 + (g * 4 + hh) * 3 + br] / S.l4[0];
        bf16_t* orow = p.OCAT + qrow * DM + (g * 4 + hh) * 64 + 4 * G;
#pragma unroll
        for (int dt = 0; dt < 4; ++dt) { const u32x2 w = *(const u32x2*)(orow + dt * 16); f32x4 pa; pa[0] = bflo(w.x); pa[1] = bfhi(w.x); pa[2] = bflo(w.y); pa[3] = bfhi(w.y);
            st_bf16x4(orow + dt * 16, pa + S.o[dt] * gs); }
    };
    {
        unsigned umA[4], umB[4], um[4];
#pragma unroll
        for (int w = 0; w < 4; ++w) {
            umA[w] = __builtin_amdgcn_readfirstlane(row_or_q(mskA[w]));
            umB[w] = __builtin_amdgcn_readfirstlane(row_or_q(mskB[w]));
            um[w] = umA[w] | umB[w];
        }
        reset(A); reset(B);
        const bf16_t* klane = p.SLCkF + (size_t)(b * NG + g) * SEQ * 64 + lane * 8;
        const bf16_t* vlane = p.SLCvT + (size_t)(b * NG + g) * SEQ * 64 + lane * 8;
        auto ldfr = [&](int j_, bf16x8 (&kf_)[4][2], bf16x8 (&vf_)[2][4]) __attribute__((always_inline)) {
            const bf16_t* kr = klane + (size_t)j_ * 4096; const bf16_t* vr = vlane + (size_t)j_ * 4096;
#pragma unroll
            for (int kt = 0; kt < 4; ++kt) { kf_[kt][0] = *(const bf16x8*)(kr + (kt * 2) * 512); kf_[kt][1] = *(const bf16x8*)(kr + (kt * 2 + 1) * 512); }
#pragma unroll
            for (int ks = 0; ks < 2; ++ks)
#pragma unroll
                for (int dt = 0; dt < 4; ++dt) vf_[ks][dt] = *(const bf16x8*)(vr + (ks * 4 + dt) * 512);
        };
        auto nextj = [&](int& j_) __attribute__((always_inline)) {
            int w = um[0] ? 0 : um[1] ? 1 : um[2] ? 2 : um[3] ? 3 : -1;
            if (w < 0) return false;
            const unsigned u = w == 0 ? um[0] : w == 1 ? um[1] : w == 2 ? um[2] : um[3];
            const int bpos = __builtin_ctz(u);
            j_ = w * 32 + bpos;
            const unsigned cl = ~(1u << bpos);
            if (w == 0) um[0] &= cl; else if (w == 1) um[1] &= cl; else if (w == 2) um[2] &= cl; else um[3] &= cl;
            return true;
        };
        auto packstep = [&](PackSt& S, const unsigned (&msk)[4], int tc, int j, const bf16x8 (&kf)[4][2], const bf16x8 (&vf)[2][4]) __attribute__((always_inline)) {
            const unsigned mw = (j >> 5) == 0 ? msk[0] : (j >> 5) == 1 ? msk[1] : (j >> 5) == 2 ? msk[2] : msk[3];
            const bool mine = (mw >> (j & 31)) & 1u;
            const bool farb = j <= qb - 3;
            f32x4 s[4];
#pragma unroll
            for (int kt = 0; kt < 4; ++kt) { s[kt] = mfma16(kf[kt][0], S.q0, (f32x4){0.f, 0.f, 0.f, 0.f}); s[kt] = mfma16(kf[kt][1], S.q1, s[kt]); }
            if (!farb) {
#pragma unroll
                for (int kt = 0; kt < 4; ++kt)
#pragma unroll
                    for (int i = 0; i < 4; ++i) { const int dist = tc - (j * 64 + 16 * kt + 4 * G + i); const int dd = dist < 0 ? 0 : (dist > 128 ? 128 : dist);
                        s[kt][i] = dist >= 0 ? s[kt][i] + T2[dd * 8 + g * 4 + hh] : -1e30f; }
            }
            finish(S, s, farb ? b31 : 0.f, mine, vf);
        };
        auto blockstep = [&](int j, const bf16x8 (&kf)[4][2], const bf16x8 (&vf)[2][4]) __attribute__((always_inline)) {
            const int w = j >> 5; const unsigned bit = 1u << (j & 31);
            const unsigned ua = w == 0 ? umA[0] : w == 1 ? umA[1] : w == 2 ? umA[2] : umA[3];
            const unsigned ub = w == 0 ? umB[0] : w == 1 ? umB[1] : w == 2 ? umB[2] : umB[3];
            if (ua & bit) packstep(A, mskA, tcA, j, kf, vf);
            if (ub & bit) packstep(B, mskB, tcB, j, kf, vf);
        };
        auto ldk = [&](int j_, bf16x8 (&kf_)[4][2]) __attribute__((always_inline)) {
            const bf16_t* kr = klane + (size_t)j_ * 4096;
#pragma unroll
            for (int kt = 0; kt < 4; ++kt) { kf_[kt][0] = *(const bf16x8*)(kr + (kt * 2) * 512); kf_[kt][1] = *(const bf16x8*)(kr + (kt * 2 + 1) * 512); }
        };
        auto ldv = [&](int j_, bf16x8 (&vf_)[2][4]) __attribute__((always_inline)) {
            const bf16_t* vr = vlane + (size_t)j_ * 4096;
#pragma unroll
            for (int ks = 0; ks < 2; ++ks)
#pragma unroll
                for (int dt = 0; dt < 4; ++dt) vf_[ks][dt] = *(const bf16x8*)(vr + (ks * 4 + dt) * 512);
        };
        bf16x8 kfA[4][2], kfB[4][2], vf[2][4];
        int j = 0; bool have = nextj(j);
        ldk(j, kfA);
#pragma unroll 1
        while (have) {
            int jn = j; bool haven = nextj(jn);
            ldv(j, vf); ldk(jn, kfB);
            __builtin_amdgcn_sched_barrier(0);
            blockstep(j, kfA, vf);
            if (!haven) break;
            j = jn; have = nextj(jn);
            ldv(j, vf); ldk(jn, kfA);
            __builtin_amdgcn_sched_barrier(0);
            blockstep(j, kfB, vf);
            j = jn;
        }
        addout(A, qrowA, 1); addout(B, qrowA + 4, 1);
    }
    {
        reset(A); reset(B);
        const int loA = t0 - WIN > 0 ? t0 - WIN : 0, hiA = t0 + 3, loB = t0 + 4 - WIN > 0 ? t0 + 4 - WIN : 0, hiB = t0 + 7;
        const bf16_t* klane = p.WINkF + (size_t)(b * NG + g) * SEQ * 64 + lane * 8;
        const bf16_t* vlane = p.WINvT + (size_t)(b * NG + g) * SEQ * 64 + lane * 8;
        auto ldfr = [&](int cb_, bf16x8 (&kf_)[4][2], bf16x8 (&vf_)[2][4]) __attribute__((always_inline)) {
            const bf16_t* kr = klane + (size_t)cb_ * 64; const bf16_t* vr = vlane + (size_t)cb_ * 64;
#pragma unroll
            for (int kt = 0; kt < 4; ++kt) { kf_[kt][0] = *(const bf16x8*)(kr + (kt * 2) * 512); kf_[kt][1] = *(const bf16x8*)(kr + (kt * 2 + 1) * 512); }
#pragma unroll
            for (int ks = 0; ks < 2; ++ks)
#pragma unroll
                for (int dt = 0; dt < 4; ++dt) vf_[ks][dt] = *(const bf16x8*)(vr + (ks * 4 + dt) * 512);
        };
        auto packstep = [&](PackSt& S, int tq0, int tc, int cb, const bf16x8 (&kf)[4][2], const bf16x8 (&vf)[2][4]) __attribute__((always_inline)) {
            const bool far = (cb + 63 <= tq0 - 128) && (cb >= tq0 + 3 - WIN);
            f32x4 s[4];
#pragma unroll
            for (int kt = 0; kt < 4; ++kt) { s[kt] = mfma16(kf[kt][0], S.q0, (f32x4){0.f, 0.f, 0.f, 0.f}); s[kt] = mfma16(kf[kt][1], S.q1, s[kt]); }
            if (!far) {
#pragma unroll
                for (int kt = 0; kt < 4; ++kt)
#pragma unroll
                    for (int i = 0; i < 4; ++i) { const int dist = tc - (cb + 16 * kt + 4 * G + i); const bool ok = dist >= 0 && dist <= WIN; const int dd = dist < 0 ? 0 : (dist > 128 ? 128 : dist);
                        s[kt][i] = ok ? s[kt][i] + T2[dd * 8 + g * 4 + hh] : -1e30f; }
            }
            finish(S, s, far ? b31 : 0.f, true, vf);
        };
        auto chunkstep = [&](int cb, const bf16x8 (&kf)[4][2], const bf16x8 (&vf)[2][4]) __attribute__((always_inline)) {
            if (cb <= hiA) packstep(A, t0, tcA, cb, kf, vf);
            if (cb + 63 >= loB) packstep(B, t0 + 4, tcB, cb, kf, vf);
        };
        auto ldk = [&](int cb_, bf16x8 (&kf_)[4][2]) __attribute__((always_inline)) {
            const bf16_t* kr = klane + (size_t)cb_ * 64;
#pragma unroll
            for (int kt = 0; kt < 4; ++kt) { kf_[kt][0] = *(const bf16x8*)(kr + (kt * 2) * 512); kf_[kt][1] = *(const bf16x8*)(kr + (kt * 2 + 1) * 512); }
        };
        auto ldv = [&](int cb_, bf16x8 (&vf_)[2][4]) __attribute__((always_inline)) {
            const bf16_t* vr = vlane + (size_t)cb_ * 64;
#pragma unroll
            for (int ks = 0; ks < 2; ++ks)
#pragma unroll
                for (int dt = 0; dt < 4; ++dt) vf_[ks][dt] = *(const bf16x8*)(vr + (ks * 4 + dt) * 512);
        };
        bf16x8 kfA[4][2], kfB[4][2], vf[2][4];
        int cb = loA & ~63;
        ldk(cb, kfA);
#pragma unroll 1
        for (;;) {
            ldv(cb, vf); ldk(cb + 64 <= hiB ? cb + 64 : cb, kfB);
            __builtin_amdgcn_sched_barrier(0);
            chunkstep(cb, kfA, vf);
            cb += 64; if (cb > hiB) break;
            ldv(cb, vf); ldk(cb + 64 <= hiB ? cb + 64 : cb, kfA);
            __builtin_amdgcn_sched_barrier(0);
            chunkstep(cb, kfB, vf);
            cb += 64; if (cb > hiB) break;
        }
        addout(A, qrowA, 2); addout(B, qrowA + 4, 2);
    }
}

__device__ __forceinline__ void phase_attn(const Params& p) {
    const int wid = threadIdx.x >> 6, lane = threadIdx.x & 63;
    { PROBE_BEGIN(3)
    if (blockIdx.x < NS * NG) attn_sample_item(p, blockIdx.x >> 1, blockIdx.x & 1);
    PROBE_END(3) }
    LAS unsigned char* L = (LAS unsigned char*)smem;
    for (int i = threadIdx.x; i < 129 * 8; i += 512) ((LAS float*)(L + A_T2))[i] = p.rel_bias[t5_bucket(i >> 3) * 8 + (i & 7)] * LOG2E;
    __syncthreads();
    {
        const int wid2 = __builtin_amdgcn_readfirstlane(threadIdx.x >> 6);
#pragma unroll 1
        for (;;) {
            __syncthreads();
            if (threadIdx.x == 0) ((LAS int*)(L + A_NP))[1] = (int)__hip_atomic_fetch_add(p.bar, 1u, __ATOMIC_RELAXED, __HIP_MEMORY_SCOPE_AGENT);
            __syncthreads();
            const int T = ((const LAS int*)(L + A_NP))[1];
            if (T >= NB * NG * (SEQ / 64)) break;
            const int bg = T & 7, qb = (SEQ / 64 - 1) - (T >> 3), t0 = qb * 64 + wid2 * 8;
            unsigned mA[4], mB[4];
            PROBE_BEGIN(6)
            attn_cmp(p, bg >> 1, bg & 1, t0, lane, L, mA);
            attn_cmp(p, bg >> 1, bg & 1, t0 + 4, lane, L, mB);
            PROBE_END(6)
            PROBE_BEGIN(7)
            attn_selwin_pair(p, bg >> 1, bg & 1, t0, lane, L, mA, mB);
            PROBE_END(7)
        }
    }
    __syncthreads();
}

constexpr int GM_LD = 136, GM_LDS = 128 * GM_LD * 2 + 1024;
__device__ __forceinline__ void phase_gmlp(const Params& p) {
    int tid = threadIdx.x; asm volatile("" : "+v"(tid));
    const int wid = __builtin_amdgcn_readfirstlane(tid >> 6), lane = tid & 63;
    LAS bf16_t* vnT = (LAS bf16_t*)smem;
    LAS float* mu = (LAS float*)(smem + 128 * GM_LD * 2);
    const int c = lane & 15, G = lane >> 4;
#pragma unroll 1
    for (int u = blockIdx.x; u < NB * 64; u += gridDim.x) {
        const int b = u >> 6, ch = u & 63; const size_t row0 = (size_t)b * SEQ + ch * 128;
        __syncthreads();
        for (int r = wid; r < 128; r += 8) {
            const u32x4 w = *(const u32x4*)(p.Vg + (row0 + r) * GMD + lane * 8);
            const float x[8] = {bflo(w.x), bfhi(w.x), bflo(w.y), bfhi(w.y), bflo(w.z), bfhi(w.z), bflo(w.w), bfhi(w.w)};
            float s = 0.f;
#pragma unroll
            for (int i = 0; i < 8; ++i) s += x[i];
            const float mean = wave_sum(s) * (1.0f / GMD);
            float q = 0.f;
#pragma unroll
            for (int i = 0; i < 8; ++i) q += (x[i] - mean) * (x[i] - mean);
            const float var = wave_sum(q) * (1.0f / GMD);
            if (lane == 0) { mu[r] = mean; mu[128 + r] = rsqrtf(var + EPS); }
        }
#pragma unroll 1
        for (int g = 0; g < 4; ++g) {
            __syncthreads();
#pragma unroll
            for (int k = 0; k < 4; ++k) {
                const int e = tid + 512 * k, s = e & 127, d0 = (e >> 7) * 8;
                const u32x4 w = *(const u32x4*)(p.Vg + (row0 + s) * GMD + g * 128 + d0);
                const float x[8] = {bflo(w.x), bfhi(w.x), bflo(w.y), bfhi(w.y), bflo(w.z), bfhi(w.z), bflo(w.w), bfhi(w.w)};
                const float m = mu[s], rs = mu[128 + s];
#pragma unroll
                for (int i = 0; i < 8; ++i) { const int cc = g * 128 + d0 + i; vnT[(d0 + i) * GM_LD + s] = f2bf((x[i] - m) * rs * p.gm_ln_g[cc] + p.gm_ln_b[cc]); }
            }
            __syncthreads();
            f32x4 acc[8];
#pragma unroll
            for (int dt = 0; dt < 8; ++dt) acc[dt] = (f32x4){0.f, 0.f, 0.f, 0.f};
            const bf16_t* wrow = p.GWb + ((size_t)g * 128 + 16 * wid + c) * 128 + 8 * G;
#pragma unroll 1
            for (int ks = 0; ks <= (wid >> 1); ++ks) {
                const bf16x8 B = *(const bf16x8*)(wrow + 32 * ks);
#pragma unroll
                for (int dt = 0; dt < 8; ++dt) {
                    const bf16x8 A = *(const LAS bf16x8*)(vnT + (dt * 16 + c) * GM_LD + 32 * ks + 8 * G);
                    acc[dt] = mfma16(A, B, acc[dt]);
                }
            }
            const int t = 16 * wid + c;
            const float bs = p.gm_bs[g * 128 + t];
#pragma unroll
            for (int dt = 0; dt < 8; ++dt) {
                const int d = dt * 16 + 4 * G;
                const u32x2 uw = *(const u32x2*)(p.U + (row0 + t) * GMD + g * 128 + d);
                f32x4 o; o[0] = bflo(uw.x) * (acc[dt][0] + bs); o[1] = bfhi(uw.x) * (acc[dt][1] + bs); o[2] = bflo(uw.y) * (acc[dt][2] + bs); o[3] = bfhi(uw.y) * (acc[dt][3] + bs);
                st_bf16x4(p.OCAT + (row0 + t) * DM + QD + g * 128 + d, o);
            }
        }
    }
    for (int it = blockIdx.x * 8 + wid; it < NS; it += gridDim.x * 8) {
        const size_t row = (size_t)MP + it;
        const u32x4 w = *(const u32x4*)(p.Vg + row * GMD + lane * 8);
        const float x[8] = {bflo(w.x), bfhi(w.x), bflo(w.y), bfhi(w.y), bflo(w.z), bfhi(w.z), bflo(w.w), bfhi(w.w)};
        float s = 0.f;
#pragma unroll
        for (int i = 0; i < 8; ++i) s += x[i];
        const float mean = wave_sum(s) * (1.0f / GMD);
        float q = 0.f;
#pragma unroll
        for (int i = 0; i < 8; ++i) q += (x[i] - mean) * (x[i] - mean);
        const float rs = rsqrtf(wave_sum(q) * (1.0f / GMD) + EPS);
#pragma unroll
        for (int i = 0; i < 8; ++i) {
            const int c = lane * 8 + i, g = c >> 7;
            const float v = (x[i] - mean) * rs * p.gm_ln_g[c] + p.gm_ln_b[c];
            p.out[O_GMV + (size_t)it * GMD + c] = v;
            const float a = p.gm_ws[(size_t)g * 128 * 128] * v + p.gm_bs[g * 128];
            p.OCAT[row * DM + QD + c] = f2bf(bf2f(p.U[row * GMD + c]) * a);
        }
    }
}

template <int MODE>
__device__ __forceinline__ void phase_norm(const Params& p) {
    const int wid = threadIdx.x >> 6, lane = threadIdx.x & 63;
    const float* gpost = MODE == 0 ? p.ln_mix_post : MODE == 1 ? p.ln_ffn_post : p.ln_ple_post;
    for (int row = blockIdx.x * 8 + wid; row < MP + NS; row += gridDim.x * 8) {
        const bf16_t* fr = (const bf16_t*)p.F + (size_t)row * DM;
        const bf16_t* xb = MODE == 1 ? (const bf16_t*)p.X1 + (size_t)row * DM : p.X2b + (size_t)row * DM;
        f32x4 f[4], x[4];
#pragma unroll
        for (int k = 0; k < 4; ++k) { const u32x2 w = *(const u32x2*)(fr + lane * 4 + k * 256); f[k][0] = bflo(w.x); f[k][1] = bfhi(w.x); f[k][2] = bflo(w.y); f[k][3] = bfhi(w.y);
            if (MODE == 0) x[k] = *(const f32x4*)(xrow_ptr(p, row) + lane * 4 + k * 256);
            else { const u32x2 v = *(const u32x2*)(xb + lane * 4 + k * 256); x[k][0] = bflo(v.x); x[k][1] = bfhi(v.x); x[k][2] = bflo(v.y); x[k][3] = bfhi(v.y); } }
        const float r = row_rstd(f);
#pragma unroll
        for (int k = 0; k < 4; ++k) { const f32x4 g = *(const f32x4*)(gpost + lane * 4 + k * 256); x[k] = x[k] + f[k] * r * g; }
        if (MODE == 0) {
            const float r2 = row_rstd(x);
#pragma unroll
            for (int k = 0; k < 4; ++k) {
                st_bf16x4((bf16_t*)p.X1 + (size_t)row * DM + lane * 4 + k * 256, x[k]);
                const f32x4 g = *(const f32x4*)(p.ln_ffn_pre + lane * 4 + k * 256); const f32x4 o = x[k] * r2 * g;
                st_bf16x4(p.H2 + (size_t)row * DM + lane * 4 + k * 256, o);
            }
        } else if (MODE == 1) {
#pragma unroll
            for (int k = 0; k < 4; ++k) st_bf16x4(p.X2b + (size_t)row * DM + lane * 4 + k * 256, x[k]);
        } else {
            float* yr = row < MP ? p.out + O_YP + (size_t)row * DM : p.out + O_YS + (size_t)(row - MP) * DM;
#pragma unroll
            for (int k = 0; k < 4; ++k) *(f32x4*)(yr + lane * 4 + k * 256) = x[k];
        }
    }
}


#define XB_TMO      128
#define XB_XCNT(j)  (256  + 64 * (j))
#define XB_XSUB(j)  (1280 + 64 * (j))
#define XB_XGEN(j)  (2304 + 64 * (j))
#define XB_TOP      3328
#define XB_TOPGEN   3392
#define XCD_BAR_WORDS 3456
#define XB_SPIN_CAP (1u << 22)

__device__ __forceinline__ unsigned xb_ld(unsigned* p)              { return __hip_atomic_load(p, __ATOMIC_RELAXED, __HIP_MEMORY_SCOPE_AGENT); }
__device__ __forceinline__ unsigned xb_add(unsigned* p, unsigned v) { return __hip_atomic_fetch_add(p, v, __ATOMIC_RELAXED, __HIP_MEMORY_SCOPE_AGENT); }
__device__ __forceinline__ unsigned xb_xcc_id() { return (unsigned)__builtin_amdgcn_s_getreg((3 << 11) | 20) & 0xFu; }
#define XB_SPIN(cond, bar) do { unsigned _sp = 0; while (cond) { __builtin_amdgcn_s_sleep(1); \
    if ((++_sp & 255u) == 0u) { if (xb_ld(&(bar)[XB_TMO])) break; if (_sp > XB_SPIN_CAP) { atomicAdd(&(bar)[XB_TMO], 1u); break; } } } } while (0)

struct XcdBarrier {
    unsigned* bar; unsigned x;
    volatile LAS unsigned* st;
};

__device__ __forceinline__ XcdBarrier xcd_barrier_post(unsigned* bar, volatile LAS unsigned* st) {
    XcdBarrier b; b.bar = bar; b.x = xb_xcc_id(); b.st = st;
    if (threadIdx.x == 0) (void)xb_add(&bar[XB_XCNT(b.x)], 1u);
    return b;
}
__device__ __forceinline__ void xcd_barrier_complete(unsigned* bar, unsigned x, unsigned& nloc, unsigned& nx) {
    const unsigned G = gridDim.x * gridDim.y * gridDim.z;
    unsigned sum, cnt, mine, sp = 0u;
    for (;;) {
        sum = 0u; cnt = 0u; mine = 0u;
#pragma unroll
        for (unsigned j = 0; j < 16; ++j) { const unsigned c = xb_ld(&bar[XB_XCNT(j)]); sum += c; cnt += (c > 0u) ? 1u : 0u; mine = (j == x) ? c : mine; }
        if (sum == G) break;
        __builtin_amdgcn_s_sleep(1);
        if ((++sp & 255u) == 0u) { if (xb_ld(&bar[XB_TMO])) break; if (sp > XB_SPIN_CAP) { atomicAdd(&bar[XB_TMO], 1u); break; } }
    }
    nloc = mine > 0u ? mine : 1u; nx = cnt > 0u ? cnt : 1u;
}

__device__ __forceinline__ void xcd_barrier(const XcdBarrier& b) {
    asm volatile("s_waitcnt vmcnt(0)" ::: "memory");
    __syncthreads();
    if (threadIdx.x == 0) {
        unsigned* bar = b.bar;
        __builtin_amdgcn_s_waitcnt(0);
        unsigned nloc = b.st[0], nx = b.st[1];
        if (nloc == 0u) { xcd_barrier_complete(bar, b.x, nloc, nx); b.st[0] = nloc; b.st[1] = nx; }
        const unsigned old = xb_add(&bar[XB_XSUB(b.x)], 1u);
        const unsigned gen = old / nloc;
        if (old + 1u == (gen + 1u) * nloc) {
            __builtin_amdgcn_fence(__ATOMIC_RELEASE, "agent");
            asm volatile("s_waitcnt vmcnt(0)" ::: "memory");
            const unsigned og = xb_add(&bar[XB_TOP], 1u);
            const unsigned tg = og / nx;
            if (og + 1u == (tg + 1u) * nx) xb_add(&bar[XB_TOPGEN], 1u);
            else XB_SPIN(xb_ld(&bar[XB_TOPGEN]) == tg, bar);
            __builtin_amdgcn_fence(__ATOMIC_ACQUIRE, "agent");
            xb_add(&bar[XB_XGEN(b.x)], 1u);
            asm volatile("s_waitcnt vmcnt(0)" ::: "memory");
        } else {
            XB_SPIN(xb_ld(&bar[XB_XGEN(b.x)]) == gen, bar);
            __builtin_amdgcn_fence(__ATOMIC_ACQUIRE, "agent");
            asm volatile("s_waitcnt vmcnt(0)" ::: "memory");
        }
    }
    __syncthreads();
}

constexpr int NPHASE = 16;
constexpr int LDS_BYTES = GEMM_LDS;
static_assert(GM_LDS <= LDS_BYTES, "lds");
constexpr int NMT = MALL / BM;

constexpr int NMP = MP / BM;
template <int PH>
__device__ __forceinline__ void run_phase(const Params& p) {
    if (PH == 0) phase_prologue(p);
    if (PH == 1) { EpiIn e{p}; if (blockIdx.x & 1) phase_gather(p); gemm_phase(p.H, DM, p.WinT, DM, NMP, INP / BM, e); gemm_skinny(p.H + (size_t)MP * DM, DM, p.WinT, DM, INP, e); if (!(blockIdx.x & 1)) phase_gather(p); }
    if (PH == 2) { EpiPart e{(bf16_t*)p.PART}; gemm_phase(p.CMPb, 4096, p.W1T, 1024, (2048 + NS * 1024) / BM, 1, e, 4, ZCmp(), 256); phase_deferred_transposes(p); }
    if (PH == 3) phase_cmp_final(p);
    if (PH == 4) phase_attn(p);
    if (PH == 5) phase_gmlp(p);
    if (PH == 6) { EpiBranch e{p.GA, p.GB, p.Y1}; gemm_phase<EpiBranch, ZNone, true>(p.OCAT, DM, p.WnT, DM, NMP, DM / BM, e); gemm_skinny2(p.OCAT + (size_t)MP * DM, DM, p.WnT, DM, DM, e); }
    if (PH == 8) { EpiBf16 e{(bf16_t*)p.F, DM}; gemm_phase(p.Y1, DM, p.WoT, DM, NMP, DM / BM, e); gemm_skinny(p.Y1 + (size_t)MP * DM, DM, p.WoT, DM, DM, e); }
    if (PH == 9) phase_norm<0>(p);
    if (PH == 10) { EpiSwiGLU e{p.ACT}; gemm_phase(p.H2, DM, p.WguT, DM, NMP, 2 * DFF / BM, e); gemm_skinny(p.H2 + (size_t)MP * DM, DM, p.WguT, DM, 2 * DFF, e); }
    if (PH == 11) { EpiBf16 e{(bf16_t*)p.F, DM}; gemm_phase(p.ACT, DFF, p.WdT, DFF, NMP, DM / BM, e); gemm_skinny(p.ACT + (size_t)MP * DFF, DFF, p.WdT, DFF, DM, e); }
    if (PH == 12) phase_norm<1>(p);
    if (PH == 13) { EpiBf16 e{(bf16_t*)p.T, DM}; gemm_phase(p.Pb, PLE, p.WpT, PLE, NMP, DM / BM, e); gemm_skinny(p.Pb + (size_t)MP * PLE, PLE, p.WpT, PLE, DM, e); }
    if (PH == 14) { EpiPleGate e{(const bf16_t*)p.T, (bf16_t*)p.F}; gemm_phase(p.X2b, DM, p.WpgT, DM, NMP, DM / BM, e); gemm_skinny(p.X2b + (size_t)MP * DM, DM, p.WpgT, DM, DM, e); }
    if (PH == 15) phase_norm<2>(p);
}

#ifndef MK_MULTI
#define MK_MULTI 0
#endif
template <int PH>
__global__ void __launch_bounds__(512, 2) k_phase(Params p) { run_phase<PH>(p); }

__global__ void __launch_bounds__(512, 2) k_all(Params p) {
    volatile LAS unsigned* st = (volatile LAS unsigned*)((LAS unsigned char*)smem + LDS_BYTES);
    if (threadIdx.x < 12) st[threadIdx.x] = 0u;
    __syncthreads();
    XcdBarrier bar = xcd_barrier_post(p.bar, st);
#if PROBE_DUP == 100
    run_phase<0>(p);  xcd_barrier(bar);
#endif
#if PROBE_SPIN >= 100
    if (threadIdx.x == 0) PROBE_TS[3] = probe_now();
#define PROBE_STAMP(k) if (threadIdx.x == 0 && PROBE_SEG == (k)) PROBE_TS[2] = probe_now() - PROBE_TS[3];
#else
#define PROBE_STAMP(k)
#endif
    run_phase<0>(p);  xcd_barrier(bar);
    PROBE_STAMP(20)
    run_phase<1>(p);  xcd_barrier(bar);
    PROBE_STAMP(21)
    run_phase<2>(p);  xcd_barrier(bar);
#if PROBE_DUP == 100
    run_phase<3>(p);  xcd_barrier(bar);
#endif
    run_phase<3>(p);  xcd_barrier(bar);
    PROBE_STAMP(23)
#if PROBE_DUP == 104
    run_phase<4>(p);  xcd_barrier(bar);
#endif
    run_phase<4>(p);
#if PROBE_DUP == 100
    run_phase<5>(p);  xcd_barrier(bar);
#endif
    run_phase<5>(p);  xcd_barrier(bar);
    PROBE_STAMP(25)
    run_phase<6>(p);  xcd_barrier(bar);
    run_phase<8>(p);  xcd_barrier(bar);
    PROBE_STAMP(28)
    run_phase<9>(p);  xcd_barrier(bar);
    PROBE_STAMP(29)
    run_phase<10>(p); xcd_barrier(bar);
    PROBE_STAMP(30)
    run_phase<11>(p); xcd_barrier(bar);
    PROBE_STAMP(31)
    run_phase<12>(p);
    run_phase<13>(p); xcd_barrier(bar);
    run_phase<14>(p); xcd_barrier(bar);
    PROBE_STAMP(34)
    run_phase<15>(p);
#if PROBE_SPIN
    if (blockIdx.x == 0 && threadIdx.x == 0) {
        const unsigned long long d = PROBE_TS[2] * (PROBE_SPIN >= 100 ? PROBE_SPIN - 100 : PROBE_SPIN), t0 = probe_now();
        while (probe_now() - t0 < d) __builtin_amdgcn_s_sleep(8);
    }
#endif
}

static inline size_t al256(size_t x) { return (x + 255) & ~(size_t)255; }
template <int PH> static void launch_phase(const Params& p, int grid, hipStream_t s) {
    static bool attr = false;
    if (!attr) { (void)hipFuncSetAttribute((const void*)k_phase<PH>, hipFuncAttributeMaxDynamicSharedMemorySize, LDS_BYTES); attr = true; }
    k_phase<PH><<<grid, 512, LDS_BYTES, s>>>(p);
}
template <int PH> static void launch_all(const Params& p, int grid, hipStream_t s) {
    launch_phase<PH>(p, grid, s);
    if constexpr (PH + 1 < NPHASE) launch_all<PH + 1>(p, grid, s);
}

extern "C" void kernel_launch(void* const* d_in, const int* in_sizes, int n_in, void* d_out, int out_size, void* d_ws, size_t ws_size, hipStream_t stream) {
    Params p{};
    p.x_prompt = (const float*)d_in[0]; p.x_sample = (const float*)d_in[1]; p.cache_cmp = (const float*)d_in[2]; p.cache_slc = (const float*)d_in[3];
    p.state_win = (const float*)d_in[4]; p.page_table = (const int*)d_in[5]; p.p_prompt = (const float*)d_in[6]; p.p_sample = (const float*)d_in[7];
    p.rel_bias = (const float*)d_in[8]; p.ln_mix_pre = (const float*)d_in[9]; p.w_in = (const float*)d_in[10];
    p.pe_k = (const float*)d_in[11]; p.w1_k = (const float*)d_in[12]; p.w2_k = (const float*)d_in[13];
    p.pe_v = (const float*)d_in[14]; p.w1_v = (const float*)d_in[15]; p.w2_v = (const float*)d_in[16];
    p.gm_ln_g = (const float*)d_in[17]; p.gm_ln_b = (const float*)d_in[18]; p.gm_ws = (const float*)d_in[19]; p.gm_bs = (const float*)d_in[20];
    p.w_br_nsa = (const float*)d_in[21]; p.w_br_gm = (const float*)d_in[22]; p.w_out = (const float*)d_in[23];
    p.ln_mix_post = (const float*)d_in[24]; p.ln_ffn_pre = (const float*)d_in[25]; p.w_gate = (const float*)d_in[26]; p.w_up = (const float*)d_in[27];
    p.w_down = (const float*)d_in[28]; p.ln_ffn_post = (const float*)d_in[29]; p.w_ple = (const float*)d_in[30]; p.w_ple_gate = (const float*)d_in[31];
    p.ln_ple_post = (const float*)d_in[32];
    p.out = (float*)d_out;
    unsigned char* w = (unsigned char*)d_ws; size_t off = 0;
    auto take = [&](size_t bytes) { void* r = w + off; off = al256(off + bytes); return r; };
    p.bar = (unsigned*)take(16384);
    p.WinT = (bf16_t*)take((size_t)INP * DM * 2); p.WnT = (bf16_t*)take((size_t)DM * DM * 2); p.WgT = nullptr;
    p.WoT = (bf16_t*)take((size_t)DM * DM * 2); p.WguT = (bf16_t*)take((size_t)2 * DFF * DM * 2); p.WdT = (bf16_t*)take((size_t)DM * DFF * 2);
    p.WpgT = (bf16_t*)take((size_t)DM * DM * 2); p.WpT = (bf16_t*)take((size_t)DM * PLE * 2); p.W1T = (bf16_t*)take((size_t)2 * 256 * 1024 * 2);
    p.H = (bf16_t*)take((size_t)MALL * DM * 2); p.Qb = (bf16_t*)take((size_t)MALL * QD * 2);
    p.CMPb = (bf16_t*)take(((size_t)MP + (size_t)NS * PAST) * 256 * 2); p.SLCb = (bf16_t*)take((size_t)MALL * 256 * 2); p.WINb = (bf16_t*)take((size_t)MALL * 256 * 2);
    p.U = (bf16_t*)take((size_t)MALL * GMD * 2); p.Vg = (bf16_t*)take((size_t)MALL * GMD * 2);
    p.GA = (bf16_t*)take((size_t)MALL * DM * 2); p.GB = (bf16_t*)take((size_t)MALL * DM * 2);
    p.GATE = (float*)take((size_t)MALL * 32 * 4);
    p.PART = (float*)take((size_t)(2048 + NS * 1024) * 4 * 256 * 4); p.PEB = (float*)take(256 * 4);
    p.KCP = (float*)take((size_t)NB * NG * 512 * 64 * 4); p.VCP = (float*)take((size_t)NB * NG * 512 * 64 * 4);
    p.KCS = (float*)take((size_t)NS * NG * 1024 * 64 * 4); p.VCS = (float*)take((size_t)NS * NG * 1024 * 64 * 4); p.KN = (float*)take(NB * NG * 128 * 4);
    p.KCb = (bf16_t*)take((size_t)NB * NG * 512 * 64 * 2); p.VCT = (bf16_t*)take((size_t)NB * NG * 64 * 512 * 2);
    p.SLCvT = (bf16_t*)take((size_t)NB * NG * 64 * SEQ * 2); p.WINvT = (bf16_t*)take((size_t)NB * NG * 64 * SEQ * 2);
    p.GWb = (bf16_t*)take(4 * 128 * 128 * 2); p.W2T = (bf16_t*)take(2 * 64 * 128 * 2);
    p.SLCkF = (bf16_t*)take((size_t)NB * NG * 64 * SEQ * 2); p.WINkF = (bf16_t*)take((size_t)NB * NG * 64 * SEQ * 2);
    p.OCAT = (bf16_t*)take((size_t)MALL * DM * 2); p.T = (float*)take((size_t)MALL * DM * 4); p.Y1 = (bf16_t*)take((size_t)MALL * DM * 2);
    p.F = (float*)take((size_t)MALL * DM * 4); p.X1 = (float*)take((size_t)MALL * DM * 4); p.H2 = (bf16_t*)take((size_t)MALL * DM * 2);
    p.ACT = (bf16_t*)take((size_t)MALL * DFF * 2); p.X2 = (float*)take((size_t)MALL * DM * 4); p.X2b = (bf16_t*)take((size_t)MALL * DM * 2);
    p.Pb = (bf16_t*)take((size_t)MALL * PLE * 2);
    if (off > ws_size) { fprintf(stderr, "workspace too small: need %zu have %zu\n", off, ws_size); return; }
#if MK_MULTI
    launch_all<0>(p, 256, stream);
#else
    constexpr size_t kDynLds = LDS_BYTES + 48;
    static int grid = 0;
    if (!grid) {
        int dev = 0, cus = 0, per_cu = 0;
        (void)hipGetDevice(&dev);
        (void)hipDeviceGetAttribute(&cus, hipDeviceAttributeMultiprocessorCount, dev);
        (void)hipFuncSetAttribute((const void*)k_all, hipFuncAttributeMaxDynamicSharedMemorySize, (int)kDynLds);
        (void)hipOccupancyMaxActiveBlocksPerMultiprocessor(&per_cu, (const void*)k_all, 512, kDynLds);
        grid = cus * (per_cu < 1 ? per_cu : 1);
        if (grid <= 0) { fprintf(stderr, "k_all: occupancy query says %d blocks per CU\n", per_cu); grid = 0; return; }
    }
    (void)hipMemsetAsync(p.bar, 0, XCD_BAR_WORDS * sizeof(unsigned), stream);
    k_all<<<grid, 512, kDynLds, stream>>>(p);
#endif
}
```

```cpp
#include <hip/hip_runtime.h>
#include <stdint.h>
#include <cstdio>

typedef unsigned short bf16_t;
typedef short bf16x8 __attribute__((ext_vector_type(8)));
typedef float f32x4 __attribute__((ext_vector_type(4)));
typedef float f32x2 __attribute__((ext_vector_type(2)));
typedef unsigned u32x4 __attribute__((ext_vector_type(4)));
typedef unsigned u32x2 __attribute__((ext_vector_type(2)));
#define LAS __attribute__((address_space(3)))

constexpr int DM = 1024, NB = 4, SEQ = 8192, MP = NB * SEQ, NS = 32, MALL = MP + 256, PAST = 16384, PAGE = 128, NPG = 128;
constexpr int NH = 8, NG = 2, HPG = 4, DH = 64, QD = 512, WIN = 512, GMD = 512, DFF = 2816, PLE = 256, IND = 4376, INP = 4608;
constexpr int NCP = 511, NCS = 1023;
constexpr float EPS = 1e-6f;
constexpr float LOG2E = 1.4426950408889634f, QSCALE = 0.125f * LOG2E;
constexpr long O_YP = 0, O_YS = 33554432, O_CMPP = 33587200, O_SLCP = 41975808, O_WINP = 50364416, O_CMPS = 50888704,
               O_SLCS = 50896896, O_WINS = 50905088, O_GMV = 55099392;

struct Params {
    const float *x_prompt, *x_sample, *cache_cmp, *cache_slc, *state_win; const int* page_table;
    const float *p_prompt, *p_sample, *rel_bias, *ln_mix_pre, *w_in, *pe_k, *w1_k, *w2_k, *pe_v, *w1_v, *w2_v;
    const float *gm_ln_g, *gm_ln_b, *gm_ws, *gm_bs, *w_br_nsa, *w_br_gm, *w_out, *ln_mix_post, *ln_ffn_pre;
    const float *w_gate, *w_up, *w_down, *ln_ffn_post, *w_ple, *w_ple_gate, *ln_ple_post;
    float* out;
    unsigned* bar;
    bf16_t *WinT, *WnT, *WgT, *WoT, *WguT, *WdT, *WpgT, *WpT, *W1T;
    bf16_t *H, *Qb, *CMPb, *SLCb, *WINb, *U, *Vg, *GA, *GB;
    float* GATE;
    float *PART, *PEB, *KCP, *VCP, *KCS, *VCS, *KN;
    bf16_t *KCb, *VCT, *SLCvT, *WINvT, *SLCkF, *WINkF, *GWb, *W2T;
    bf16_t* OCAT; float* T; bf16_t* Y1; float* F; float* X1; bf16_t* H2; bf16_t* ACT; float* X2; bf16_t* X2b; bf16_t* Pb;
};

__device__ __forceinline__ unsigned cvt_pk_bf16(float lo, float hi) { unsigned r; asm volatile("v_cvt_pk_bf16_f32 %0, %1, %2" : "=v"(r) : "v"(lo), "v"(hi)); return r; }
__device__ __forceinline__ bf16_t f2bf(float f) { return (bf16_t)(cvt_pk_bf16(f, 0.f) & 0xffffu); }
__device__ __forceinline__ float bf2f(bf16_t h) { return __uint_as_float(((unsigned)h) << 16); }
__device__ __forceinline__ float bflo(unsigned w) { return __uint_as_float(w << 16); }
__device__ __forceinline__ float bfhi(unsigned w) { return __uint_as_float(w & 0xffff0000u); }
__device__ __forceinline__ float ex2(float x) { return __builtin_amdgcn_exp2f(x); }
__device__ __forceinline__ float sigmoidf_(float x) { return 1.0f / (1.0f + __expf(-x)); }
__device__ __forceinline__ float siluf_(float x) { return x * sigmoidf_(x); }
__device__ __forceinline__ float silu_fast(float x) { return x * __builtin_amdgcn_rcpf(1.0f + __builtin_amdgcn_exp2f(x * -1.4426950408889634f)); }
__device__ __forceinline__ float geluf_(float x) {
    const float u = 0.7978845608028654f * (x + 0.044715f * x * x * x);
    const float e = __expf(2.0f * u);
    const float th = 1.0f - 2.0f / (e + 1.0f);
    return 0.5f * x * (1.0f + th);
}
__device__ __forceinline__ float wave_sum(float v) {
#pragma unroll
    for (int o = 32; o > 0; o >>= 1) v += __shfl_xor(v, o);
    return v;
}
__device__ __forceinline__ float wave_max(float v) {
#pragma unroll
    for (int o = 32; o > 0; o >>= 1) v = fmaxf(v, __shfl_xor(v, o));
    return v;
}
__device__ __forceinline__ int t5_bucket(int d) {
    if (d < 16) return d;
    if (d >= 128) return 31;
    const int b = 16 + (int)(__logf((float)d * (1.0f / 16.0f)) * (16.0f / 2.0794415416798357f));
    return b < 31 ? b : 31;
}

extern __shared__ __attribute__((aligned(16))) unsigned char smem[];
#ifndef PROBE_DUP
#define PROBE_DUP 0
#endif
#define PROBE_LDS_OFF 131072
#ifndef PROBE_SPIN
#define PROBE_SPIN 0
#endif
#ifndef PROBE_SEG
#define PROBE_SEG 5
#endif
__device__ __forceinline__ unsigned long long probe_now() { unsigned long long t; asm volatile("s_memrealtime %0\n\ts_waitcnt lgkmcnt(0)" : "=s"(t) :: "memory"); return t; }
#define PROBE_TS ((volatile LAS unsigned long long*)((LAS unsigned char*)smem + PROBE_LDS_OFF + 16))
#if PROBE_SPIN
#define PROBE_BEGIN(seg) unsigned long long pb_##seg = 0; if (PROBE_SEG == seg && threadIdx.x == 0) pb_##seg = probe_now();
#define PROBE_END(seg) if (PROBE_SEG == seg && threadIdx.x == 0) { PROBE_TS[2] = PROBE_TS[2] + (probe_now() - pb_##seg); }
#else
#define PROBE_BEGIN(seg)
#define PROBE_END(seg)
#endif

constexpr int BM = 256, BK = 64, HALF = 128, HT = HALF * BK, GEMM_LDS = 8 * HT * 2;
__device__ __forceinline__ int lds_byte(int r, int c) { const int st = (r >> 4) * 2 + (c >> 5), rr = r & 15, cc = c & 31, ob = rr * 64 + cc * 2; return st * 1024 + (ob ^ (((ob >> 9) & 1) << 5)); }
__device__ __forceinline__ void stage_rc(int b, int& R, int& C) { const int st = b / 1024, sb = b % 1024, swz = sb ^ (((sb >> 9) & 1) << 5); R = (st >> 1) * 16 + swz / 64; C = (st & 1) * 32 + (swz % 64) / 2; }

constexpr int HTB = HALF * BK * 2;
template <class F>
__device__ __forceinline__ void for_each_frag(const f32x4 (&acc)[2][2][4][2], int brow, int bcol, int wr, int wc, int fr, int fq, F&& f) {
#pragma unroll
    for (int ai = 0; ai < 2; ++ai)
#pragma unroll
        for (int m = 0; m < 4; ++m)
#pragma unroll
            for (int bj = 0; bj < 2; ++bj)
#pragma unroll
                for (int n = 0; n < 2; ++n)
                    f(brow + ai * HALF + wr * 64 + m * 16 + fr, bcol + bj * HALF + wc * 32 + n * 16 + fq * 4, acc[ai][bj][m][n]);
}

__host__ __device__ __forceinline__ int inv_a(int ca) { return ((ca >> 5) & 1) * 128 + (ca >> 6) * 32 + ((ca >> 2) & 1) * 16 + ((ca >> 3) & 3) * 4 + (ca & 3); }
__host__ __device__ __forceinline__ int row_a(int n) { return (n & ~255) + inv_a(n & 255); }
__host__ __device__ __forceinline__ int inv_s(int o, int s) { return ((o >> 2) & 1) * 128 + (o >> 5) * 32 + ((o >> 1) & 1) * 16 + ((o >> 3) & 3) * 4 + (o & 1) * 2 + s; }
__host__ __device__ __forceinline__ int row_s(int n, int s) { return (n >> 7) * 256 + inv_s(n & 127, s); }
__host__ __device__ __forceinline__ int lcol_a(int r) { const int cg = r & 255; return (r & ~255) + ((cg >> 5) & 3) * 64 + (cg >> 7) * 32 + ((cg >> 2) & 3) * 8 + ((cg >> 4) & 1) * 4; }
__host__ __device__ __forceinline__ int lcol_s(int r) { const int cg = r & 255; return (r & ~255) + 2 * (((cg >> 5) & 3) * 32 + ((cg >> 2) & 3) * 8 + (cg >> 7) * 4 + ((cg >> 4) & 1) * 2); }
template <class F>
__device__ __forceinline__ void for_each_frag8(const f32x4 (&acc)[2][2][4][2], int brow, int bcol, int wr, int wc, int fr, int fq, F&& f) {
#pragma unroll
    for (int ai = 0; ai < 2; ++ai)
#pragma unroll
        for (int m = 0; m < 4; ++m)
#pragma unroll
            for (int bj = 0; bj < 2; ++bj)
                f(brow + ai * HALF + wr * 64 + m * 16 + fr, bcol + wc * 64 + bj * 32 + fq * 8, acc[ai][bj][m][0], acc[ai][bj][m][1]);
}

struct ZNone { __device__ __forceinline__ size_t a(int) const { return 0; } __device__ __forceinline__ size_t b(int) const { return 0; } };
template <class Epi, class ZMap = ZNone, bool HAS_MID = false>
__device__ __forceinline__ void gemm_phase(const bf16_t* A, int lda, const bf16_t* Bt, int K, int nM, int nN, const Epi& E, int nZ = 1, ZMap zm = ZMap(), int kstepA_el = BK) {
    LAS unsigned char* lds = (LAS unsigned char*)smem;
    int tid = threadIdx.x; asm volatile("" : "+v"(tid));
    const int wid = __builtin_amdgcn_readfirstlane(tid >> 6), lane = tid & 63, wr = wid >> 2, wc = wid & 3, fr = lane & 15, fq = lane >> 4;
    const int nt = K / BK, nmn = nM * nN, nu = nmn * nZ, G = gridDim.x;
    int u = blockIdx.x;
    if (u >= nu) return;
    unsigned voffA[2], voffB[2];
#pragma unroll
    for (int i = 0; i < 2; ++i) { int R, C; stage_rc(tid * 16 + i * 8192, R, C); voffA[i] = (unsigned)(R * lda + C) * 2u; voffB[i] = (unsigned)(R * K + C) * 2u; }
    const size_t kstep = (size_t)(BK * 2), kstepA = (size_t)kstepA_el * 2;
    const size_t hstepA = (size_t)HALF * lda * 2, hstepB = (size_t)HALF * K * 2, tstepA = 2 * hstepA, tstepB = 2 * hstepB;
    const unsigned ldsw = (unsigned)wid * 1024u;
    const int aoff = lds_byte(wr * 64 + fr, fq * 8), boff = lds_byte(wc * 32 + fr, fq * 8);
#define PG8_SA(b, h) (((b) * 2 + (h)) * HTB)
#define PG8_SB(b, h) ((4 + (b) * 2 + (h)) * HTB)
#define PG8_STAGE(bufoff, gbase, voff) do { _Pragma("unroll") for (int _i = 0; _i < 2; ++_i) \
        __builtin_amdgcn_global_load_lds((const unsigned*)((const char*)(gbase) + (voff)[_i]), (LAS unsigned*)(lds + (bufoff) + ldsw + _i * 8192), 16, 0, 0); } while (0)
#define PG8_LDA(dst, b, h) do { _Pragma("unroll") for (int m = 0; m < 4; ++m) _Pragma("unroll") for (int k = 0; k < 2; ++k) dst[m][k] = *(const LAS bf16x8*)(lds + PG8_SA(b, h) + aoff + m * 2048 + k * 1024); } while (0)
#define PG8_LDB(dst, b, h) do { _Pragma("unroll") for (int n = 0; n < 2; ++n) _Pragma("unroll") for (int k = 0; k < 2; ++k) dst[n][k] = *(const LAS bf16x8*)(lds + PG8_SB(b, h) + boff + n * 2048 + k * 1024); } while (0)
#define PG8_MMA(ai, bj, At, Bt_) do { __builtin_amdgcn_s_setprio(1); _Pragma("unroll") for (int m = 0; m < 4; ++m) _Pragma("unroll") for (int n = 0; n < 2; ++n) _Pragma("unroll") for (int k = 0; k < 2; ++k) \
        acc[ai][bj][m][n] = __builtin_amdgcn_mfma_f32_16x16x32_bf16(Bt_[n][k], At[m][k], acc[ai][bj][m][n], 0, 0, 0); __builtin_amdgcn_s_setprio(0); } while (0)
#define PG8_WAIT_V(n) asm volatile("s_waitcnt vmcnt(" #n ")" ::: "memory")
#define PG8_WAIT_L(n) asm volatile("s_waitcnt lgkmcnt(" #n ")" ::: "memory")
#define PG8_BAR __builtin_amdgcn_s_barrier()
#define PG8_SCHED __builtin_amdgcn_sched_barrier(0)
    f32x4 acc[2][2][4][2];
#pragma unroll
    for (int a = 0; a < 2; ++a)
#pragma unroll
        for (int b = 0; b < 2; ++b)
#pragma unroll
            for (int m = 0; m < 4; ++m)
#pragma unroll
                for (int n = 0; n < 2; ++n) acc[a][b][m][n] = (f32x4){0.f, 0.f, 0.f, 0.f};
    bf16x8 At[4][2], B0[2][2], B1[2][2];
    auto unit_of = [&](int uu, int& z_, int& pm_, int& pn_) {
        if (nZ == 1) {
            int wg = uu; { const int q = nu / 8, r = nu % 8, xcd = wg % 8, off = wg / 8; wg = (xcd < r ? xcd * (q + 1) : r * (q + 1) + (xcd - r) * q) + off; }
            const int nig = 8 * nN, gid = wg / nig, fm = gid * 8, gsz = (nM - fm) < 8 ? (nM - fm) : 8;
            z_ = 0; pm_ = fm + ((wg % nig) % gsz); pn_ = (wg % nig) / gsz;
        } else { z_ = uu / nmn; pm_ = (uu - z_ * nmn) / nN; pn_ = (uu - z_ * nmn) - pm_ * nN; }
    };
    int z, pm, pn; unit_of(u, z, pm, pn);
    const char* cA = (const char*)(A + zm.a(z)) + (size_t)pm * tstepA; const char* cB = (const char*)(Bt + zm.b(z)) + (size_t)pn * tstepB;
    PG8_STAGE(PG8_SB(0, 0), cB, voffB); PG8_STAGE(PG8_SA(0, 0), cA, voffA); PG8_STAGE(PG8_SB(0, 1), cB + hstepB, voffB); PG8_STAGE(PG8_SA(0, 1), cA + hstepA, voffA);
    if (wr == 1) PG8_BAR;
    PG8_WAIT_V(4); PG8_BAR;
    PG8_STAGE(PG8_SB(1, 0), cB + kstep, voffB); PG8_STAGE(PG8_SA(1, 0), cA + kstepA, voffA); PG8_STAGE(PG8_SB(1, 1), cB + hstepB + kstep, voffB);
    PG8_WAIT_V(6); PG8_BAR;
    for (;;) {
        const int un = u + G; const bool has_next = un < nu;
        int nz = z, npm = pm, npn = pn; if (has_next) unit_of(un, nz, npm, npn);
        const char* nA = (const char*)(A + zm.a(nz)) + (size_t)npm * tstepA; const char* nB = (const char*)(Bt + zm.b(nz)) + (size_t)npn * tstepB;
        auto kiter = [&](int t) {
            const bool last = (t == nt - 2);
            const bool bnd = last || (HAS_MID && t == (nt >> 1) - 2);
            const char* a1 = cA + (size_t)(t + 1) * kstepA;
            const char* a2 = last ? nA : cA + (size_t)(t + 2) * kstepA; const char* b2 = last ? nB : cB + (size_t)(t + 2) * kstep;
            const char* a3 = a2 + kstepA; const char* b3 = b2 + kstep;
            PG8_LDB(B0, 0, 0); PG8_SCHED; PG8_LDA(At, 0, 0); PG8_STAGE(PG8_SA(1, 1), a1 + hstepA, voffA);
            PG8_WAIT_L(8); PG8_BAR; PG8_WAIT_L(0); PG8_MMA(0, 0, At, B0); PG8_BAR; PG8_SCHED;
            PG8_LDB(B1, 0, 1); PG8_STAGE(PG8_SB(0, 0), b2, voffB);
            PG8_BAR; PG8_WAIT_L(0); PG8_MMA(0, 1, At, B1); PG8_BAR;
            PG8_LDA(At, 0, 1); PG8_STAGE(PG8_SA(0, 0), a2, voffA);
            PG8_BAR; PG8_WAIT_L(0); PG8_MMA(1, 0, At, B0); PG8_BAR; PG8_SCHED;
            PG8_STAGE(PG8_SB(0, 1), b2 + hstepB, voffB);
            PG8_WAIT_V(6); PG8_BAR; PG8_MMA(1, 1, At, B1); PG8_BAR;
            PG8_LDB(B0, 1, 0); PG8_SCHED; PG8_LDA(At, 1, 0); PG8_STAGE(PG8_SA(0, 1), a2 + hstepA, voffA);
            PG8_WAIT_L(8); PG8_BAR; PG8_WAIT_L(0); PG8_MMA(0, 0, At, B0); PG8_BAR; PG8_SCHED;
            PG8_LDB(B1, 1, 1); PG8_STAGE(PG8_SB(1, 0), b3, voffB);
            PG8_BAR; PG8_WAIT_L(0); PG8_MMA(0, 1, At, B1); PG8_BAR;
            PG8_LDA(At, 1, 1); PG8_STAGE(PG8_SA(1, 0), a3, voffA);
            PG8_BAR; PG8_WAIT_L(0); PG8_MMA(1, 0, At, B0); PG8_BAR; PG8_SCHED;
            PG8_STAGE(PG8_SB(1, 1), b3 + hstepB, voffB);
            PG8_WAIT_V(6); PG8_BAR; PG8_MMA(1, 1, At, B1);
            if (!(bnd && wr == 1)) PG8_BAR;
        };
        if constexpr (HAS_MID) {
            for (int t = 0; t < (nt >> 1); t += 2) kiter(t);
            { int pmo = pm, pno = pn; asm volatile("" : "+s"(pmo), "+s"(pno));
              E.mid(acc, pmo * BM, pno * BM, wr, wc, fr, fq); }
            PG8_SCHED; PG8_BAR; if (wr == 1) PG8_BAR;
            for (int t = nt >> 1; t < nt; t += 2) kiter(t);
        } else {
            for (int t = 0; t < nt; t += 2) kiter(t);
        }
        { int pmo = pm, pno = pn; asm volatile("" : "+s"(pmo), "+s"(pno));
          E(acc, pmo * BM, pno * BM + (z << 20), wr, wc, fr, fq); }
        PG8_SCHED; PG8_BAR;
        if (!has_next) break;
        if (wr == 1) PG8_BAR;
#pragma unroll
        for (int a = 0; a < 2; ++a)
#pragma unroll
            for (int b = 0; b < 2; ++b)
#pragma unroll
                for (int m = 0; m < 4; ++m)
#pragma unroll
                    for (int n = 0; n < 2; ++n) acc[a][b][m][n] = (f32x4){0.f, 0.f, 0.f, 0.f};
        u = un; z = nz; pm = npm; pn = npn; cA = nA; cB = nB;
    }
    PG8_WAIT_V(0);
    PG8_BAR;
#undef PG8_SA
#undef PG8_SB
#undef PG8_STAGE
#undef PG8_LDA
#undef PG8_LDB
#undef PG8_MMA
#undef PG8_WAIT_V
#undef PG8_WAIT_L
#undef PG8_BAR
#undef PG8_SCHED
}

__device__ __forceinline__ f32x4 mfma16(bf16x8 a, bf16x8 b, f32x4 c) { return __builtin_amdgcn_mfma_f32_16x16x32_bf16(a, b, c, 0, 0, 0); }
__device__ __forceinline__ bf16x8 pack_p(const f32x4& a, const f32x4& b) {
    u32x4 w; w.x = cvt_pk_bf16(a[0], a[1]); w.y = cvt_pk_bf16(a[2], a[3]); w.z = cvt_pk_bf16(b[0], b[1]); w.w = cvt_pk_bf16(b[2], b[3]);
    return __builtin_bit_cast(bf16x8, w);
}
__device__ __forceinline__ size_t kfrag_off(int key, int d) { return ((size_t)((key >> 4) * 2 + (d >> 5)) * 64 + ((d >> 3) & 3) * 16 + (key & 15)) * 8 + (d & 7); }
__device__ __forceinline__ size_t vfrag_off(int key, int d) {
    return ((size_t)((key >> 5) * 4 + (d >> 4)) * 64 + ((key >> 2) & 3) * 16 + (d & 15)) * 8 + ((key >> 4) & 1) * 4 + (key & 3);
}
__device__ __forceinline__ void st_bf16x4(bf16_t* p, f32x4 v) { u32x2 w; w.x = cvt_pk_bf16(v[0], v[1]); w.y = cvt_pk_bf16(v[2], v[3]); *(u32x2*)p = w; }
__device__ __forceinline__ void st_bf16x8(bf16_t* p, f32x4 a, f32x4 b) { u32x4 w; w.x = cvt_pk_bf16(a[0], a[1]); w.y = cvt_pk_bf16(a[2], a[3]); w.z = cvt_pk_bf16(b[0], b[1]); w.w = cvt_pk_bf16(b[2], b[3]); *(u32x4*)p = w; }
__device__ __forceinline__ bool win_tile_a(int pn) { return pn < 2 || (pn >= 5 && pn < 17); }

struct EpiIn {
    const Params& p;
    __device__ __forceinline__ void apply(int row, int col, f32x4 v) const {
        const Params& P = p; const int pn = col >> 8, c = col & 255;
        if (pn < 2) st_bf16x4(P.Qb + (size_t)row * QD + col, v * QSCALE);
        else if (pn < 5) {
            if (pn != 2) st_bf16x4((pn == 3 ? P.SLCb : P.WINb) + (size_t)row * 256 + c, v);
            if (pn < 4) *(f32x4*)(P.out + (pn == 2 ? O_CMPS : O_SLCS) + (size_t)(row - MP) * 256 + c) = v;
            else *(f32x4*)(P.out + O_WINS + ((size_t)(row - MP) * WIN + (WIN - 1)) * 256 + c) = v;
        } else if (pn < 9) {
            f32x4 g; g[0] = geluf_(v[0]); g[1] = geluf_(v[1]); g[2] = geluf_(v[2]); g[3] = geluf_(v[3]);
            st_bf16x4((pn < 7 ? P.U : P.Vg) + (size_t)row * GMD + (col - (pn < 7 ? 1280 : 1792)), g);
        } else if (pn < 17) {
            f32x4 g; g[0] = sigmoidf_(v[0]); g[1] = sigmoidf_(v[1]); g[2] = sigmoidf_(v[2]); g[3] = sigmoidf_(v[3]);
            st_bf16x4((pn < 13 ? P.GA : P.GB) + (size_t)row * DM + (col - (pn < 13 ? 2304 : 3328)), g);
        } else if (c < 24) { f32x4 g; g[0] = sigmoidf_(v[0]); g[1] = sigmoidf_(v[1]); g[2] = sigmoidf_(v[2]); g[3] = sigmoidf_(v[3]); *(f32x4*)(P.GATE + (size_t)row * 32 + c) = g; }
    }
    __device__ __forceinline__ int lcol(int r) const { return win_tile_a(r >> 8) ? lcol_a(r) : r; }
    __device__ __forceinline__ void operator()(const f32x4 (&acc)[2][2][4][2], int brow, int bcol, int wr, int wc, int fr, int fq) const {
        const int pn = bcol >> 8;
        const Params& P = p;
        if (pn < 2) {
            for_each_frag8(acc, brow, bcol, wr, wc, fr, fq, [&](int row, int col, f32x4 a, f32x4 b) { st_bf16x8(P.Qb + (size_t)row * QD + col, a * QSCALE, b * QSCALE); });
        } else if (pn < 5) {
            bf16_t* cp = pn == 2 ? P.CMPb : pn == 3 ? P.SLCb : P.WINb;
            for_each_frag(acc, brow, bcol, wr, wc, fr, fq, [&](int row, int col, f32x4 v) {
                const int c = col & 255;
                if (pn == 2) st_bf16x4(cp + (size_t)row * 256 + c, v);
                if (pn >= 3 && c < 128 && row < MP) {
                    st_bf16x4((pn == 3 ? P.SLCkF : P.WINkF) + ((size_t)(row >> 13) * NG + (c >> 6)) * SEQ * 64 + kfrag_off(row & (SEQ - 1), c & 63), v);
                }
                if (pn >= 3 && c >= 128 && row < MP) {
                    const int t = row & (SEQ - 1), dc = c - 128;
                    bf16_t* vt = (pn == 3 ? P.SLCvT : P.WINvT) + ((size_t)(row >> 13) * NG + (dc >> 6)) * SEQ * 64 + vfrag_off(t, dc & 63);
                    vt[0] = f2bf(v[0]); vt[8] = f2bf(v[1]); vt[16] = f2bf(v[2]); vt[24] = f2bf(v[3]);
                }
                if (pn < 4) {
                    if (row < MP) *(f32x4*)(P.out + (pn == 2 ? O_CMPP : O_SLCP) + (size_t)row * 256 + c) = v;
                    else if (row < MP + NS) *(f32x4*)(P.out + (pn == 2 ? O_CMPS : O_SLCS) + (size_t)(row - MP) * 256 + c) = v;
                } else {
                    if (row < MP) { const int t = row & (SEQ - 1), b = row >> 13; if (t >= SEQ - WIN) *(f32x4*)(P.out + O_WINP + ((size_t)b * WIN + (t - (SEQ - WIN))) * 256 + c) = v; }
                    else if (row < MP + NS) *(f32x4*)(P.out + O_WINS + ((size_t)(row - MP) * WIN + (WIN - 1)) * 256 + c) = v;
                }
            });
        } else if (pn < 9) {
            bf16_t* dst = pn < 7 ? P.U : P.Vg; const int c0 = pn < 7 ? 1280 : 1792;
            for_each_frag8(acc, brow, bcol, wr, wc, fr, fq, [&](int row, int col, f32x4 a, f32x4 b) {
                f32x4 g, h; g[0] = geluf_(a[0]); g[1] = geluf_(a[1]); g[2] = geluf_(a[2]); g[3] = geluf_(a[3]); h[0] = geluf_(b[0]); h[1] = geluf_(b[1]); h[2] = geluf_(b[2]); h[3] = geluf_(b[3]);
                st_bf16x8(dst + (size_t)row * GMD + (col - c0), g, h); });
        } else if (pn < 17) {
            bf16_t* dst = pn < 13 ? P.GA : P.GB; const int c0 = pn < 13 ? 2304 : 3328;
            for_each_frag8(acc, brow, bcol, wr, wc, fr, fq, [&](int row, int col, f32x4 a, f32x4 b) {
                f32x4 g, h; g[0] = sigmoidf_(a[0]); g[1] = sigmoidf_(a[1]); g[2] = sigmoidf_(a[2]); g[3] = sigmoidf_(a[3]); h[0] = sigmoidf_(b[0]); h[1] = sigmoidf_(b[1]); h[2] = sigmoidf_(b[2]); h[3] = sigmoidf_(b[3]);
                st_bf16x8(dst + (size_t)row * DM + (col - c0), g, h); });
        } else {
            for_each_frag(acc, brow, bcol, wr, wc, fr, fq, [&](int row, int col, f32x4 v) {
                const int c = col & 255;
                if (c < 24) { f32x4 g; g[0] = sigmoidf_(v[0]); g[1] = sigmoidf_(v[1]); g[2] = sigmoidf_(v[2]); g[3] = sigmoidf_(v[3]); *(f32x4*)(P.GATE + (size_t)row * 32 + c) = g; } });
        }
    }
};
struct EpiBranch {
    const bf16_t* GA; const bf16_t* GB; bf16_t* Y1;
    __device__ __forceinline__ void mid(f32x4 (&acc)[2][2][4][2], int brow, int bcol, int wr, int wc, int fr, int fq) const {
#pragma unroll
        for (int ai = 0; ai < 2; ++ai)
#pragma unroll
            for (int m = 0; m < 4; ++m)
#pragma unroll
                for (int bj = 0; bj < 2; ++bj) {
                    const size_t o = (size_t)(brow + ai * HALF + wr * 64 + m * 16 + fr) * DM + bcol + wc * 64 + bj * 32 + fq * 8;
                    const u32x4 a = *(const u32x4*)(GA + o), b = *(const u32x4*)(GB + o);
                    f32x4& v = acc[ai][bj][m][0]; f32x4& w = acc[ai][bj][m][1];
                    v[0] *= bflo(a.x) / fmaxf(bflo(b.x), 1e-30f); v[1] *= bfhi(a.x) / fmaxf(bfhi(b.x), 1e-30f);
                    v[2] *= bflo(a.y) / fmaxf(bflo(b.y), 1e-30f); v[3] *= bfhi(a.y) / fmaxf(bfhi(b.y), 1e-30f);
                    w[0] *= bflo(a.z) / fmaxf(bflo(b.z), 1e-30f); w[1] *= bfhi(a.z) / fmaxf(bfhi(b.z), 1e-30f);
                    w[2] *= bflo(a.w) / fmaxf(bflo(b.w), 1e-30f); w[3] *= bfhi(a.w) / fmaxf(bfhi(b.w), 1e-30f);
                    asm volatile("" : "+v"(v), "+v"(w));
                    if (bj == 1) __builtin_amdgcn_sched_barrier(0);
                }
    }
    __device__ __forceinline__ int lcol(int r) const { return lcol_a(r); }
    __device__ __forceinline__ void operator()(const f32x4 (&acc)[2][2][4][2], int brow, int bcol, int wr, int wc, int fr, int fq) const {
        for_each_frag8(acc, brow, bcol, wr, wc, fr, fq, [&](int row, int col, f32x4 v, f32x4 w) {
            const u32x4 b = *(const u32x4*)(GB + (size_t)row * DM + col);
            f32x4 o, q; o[0] = v[0] * fmaxf(bflo(b.x), 1e-30f); o[1] = v[1] * fmaxf(bfhi(b.x), 1e-30f); o[2] = v[2] * fmaxf(bflo(b.y), 1e-30f); o[3] = v[3] * fmaxf(bfhi(b.y), 1e-30f);
            q[0] = w[0] * fmaxf(bflo(b.z), 1e-30f); q[1] = w[1] * fmaxf(bfhi(b.z), 1e-30f); q[2] = w[2] * fmaxf(bflo(b.w), 1e-30f); q[3] = w[3] * fmaxf(bfhi(b.w), 1e-30f);
            st_bf16x8(Y1 + (size_t)row * DM + col, o, q); });
    }
    __device__ __forceinline__ void apply2(int row, int col, f32x4 v1, f32x4 v2) const {
        const u32x2 a = *(const u32x2*)(GA + (size_t)row * DM + col), b = *(const u32x2*)(GB + (size_t)row * DM + col);
        f32x4 o; o[0] = v1[0] * bflo(a.x) + v2[0] * bflo(b.x); o[1] = v1[1] * bfhi(a.x) + v2[1] * bfhi(b.x); o[2] = v1[2] * bflo(a.y) + v2[2] * bflo(b.y); o[3] = v1[3] * bfhi(a.y) + v2[3] * bfhi(b.y);
        st_bf16x4(Y1 + (size_t)row * DM + col, o);
    }
};
struct EpiF32 {
    float* F; int ld;
    __device__ __forceinline__ void apply(int row, int col, f32x4 v) const { *(f32x4*)(F + (size_t)row * ld + col) = v; }
    __device__ __forceinline__ void operator()(const f32x4 (&acc)[2][2][4][2], int brow, int bcol, int wr, int wc, int fr, int fq) const {
        for_each_frag(acc, brow, bcol, wr, wc, fr, fq, [&](int row, int col, f32x4 v) { *(f32x4*)(F + (size_t)row * ld + col) = v; });
    }
};
struct EpiBf16 {
    bf16_t* O; int ld;
    __device__ __forceinline__ int lcol(int r) const { return lcol_a(r); }
    __device__ __forceinline__ void apply(int row, int col, f32x4 v) const { st_bf16x4(O + (size_t)row * ld + col, v); }
    __device__ __forceinline__ void operator()(const f32x4 (&acc)[2][2][4][2], int brow, int bcol, int wr, int wc, int fr, int fq) const {
        for_each_frag8(acc, brow, bcol, wr, wc, fr, fq, [&](int row, int col, f32x4 a, f32x4 b) { st_bf16x8(O + (size_t)row * ld + col, a, b); });
    }
};
struct EpiPart {
    bf16_t* PART;
    __device__ __forceinline__ void operator()(const f32x4 (&acc)[2][2][4][2], int brow, int bcol, int wr, int wc, int fr, int fq) const {
        const int z = bcol >> 20;
        for_each_frag8(acc, brow, 0, wr, wc, fr, fq, [&](int row, int col, f32x4 a, f32x4 b) { st_bf16x8(PART + ((size_t)row * 4 + z) * 256 + col, a, b); });
    }
};
struct ZCmp { __device__ __forceinline__ size_t a(int z) const { return (size_t)z * 64; } __device__ __forceinline__ size_t b(int z) const { return (size_t)(z >> 1) * 256 * 1024; } };
struct EpiSwiGLU {
    bf16_t* ACT;
    __device__ __forceinline__ int lcol(int r) const { return lcol_s(r); }
    __device__ __forceinline__ void apply(int row, int col, f32x4 v) const { *(unsigned*)(ACT + (size_t)row * DFF + (col >> 1)) = cvt_pk_bf16(silu_fast(v[0]) * v[1], silu_fast(v[2]) * v[3]); }
    __device__ __forceinline__ void operator()(const f32x4 (&acc)[2][2][4][2], int brow, int bcol, int wr, int wc, int fr, int fq) const {
#pragma unroll
        for (int ai = 0; ai < 2; ++ai)
#pragma unroll
            for (int m = 0; m < 4; ++m) {
                const f32x4 &a = acc[ai][0][m][0], &b = acc[ai][0][m][1], &c = acc[ai][1][m][0], &d = acc[ai][1][m][1];
                u32x4 w;
                w.x = cvt_pk_bf16(silu_fast(a[0]) * a[1], silu_fast(a[2]) * a[3]); w.y = cvt_pk_bf16(silu_fast(b[0]) * b[1], silu_fast(b[2]) * b[3]);
                w.z = cvt_pk_bf16(silu_fast(c[0]) * c[1], silu_fast(c[2]) * c[3]); w.w = cvt_pk_bf16(silu_fast(d[0]) * d[1], silu_fast(d[2]) * d[3]);
                *(u32x4*)(ACT + (size_t)(brow + ai * HALF + wr * 64 + m * 16 + fr) * DFF + (bcol >> 1) + wc * 32 + fq * 8) = w;
            }
    }
};
struct EpiPleGate {
    const bf16_t* E; bf16_t* F;
    __device__ __forceinline__ void apply(int row, int col, f32x4 v) const {
        const u32x2 w = *(const u32x2*)(E + (size_t)row * DM + col);
        f32x4 o; o[0] = sigmoidf_(v[0]) * bflo(w.x); o[1] = sigmoidf_(v[1]) * bfhi(w.x); o[2] = sigmoidf_(v[2]) * bflo(w.y); o[3] = sigmoidf_(v[3]) * bfhi(w.y);
        st_bf16x4(F + (size_t)row * DM + col, o); }
    __device__ __forceinline__ int lcol(int r) const { return lcol_a(r); }
    __device__ __forceinline__ void operator()(const f32x4 (&acc)[2][2][4][2], int brow, int bcol, int wr, int wc, int fr, int fq) const {
        for_each_frag8(acc, brow, bcol, wr, wc, fr, fq, [&](int row, int col, f32x4 a, f32x4 b) {
            const u32x4 w = *(const u32x4*)(E + (size_t)row * DM + col);
            f32x4 o, q; o[0] = sigmoidf_(a[0]) * bflo(w.x); o[1] = sigmoidf_(a[1]) * bfhi(w.x); o[2] = sigmoidf_(a[2]) * bflo(w.y); o[3] = sigmoidf_(a[3]) * bfhi(w.y);
            q[0] = sigmoidf_(b[0]) * bflo(w.z); q[1] = sigmoidf_(b[1]) * bfhi(w.z); q[2] = sigmoidf_(b[2]) * bflo(w.w); q[3] = sigmoidf_(b[3]) * bfhi(w.w);
            st_bf16x8(F + (size_t)row * DM + col, o, q); });
    }
};

template <class Epi>
__device__ __forceinline__ void gemm_skinny(const bf16_t* A  , int lda, const bf16_t* Bt, int K, int N, const Epi& E) {
    int tid = threadIdx.x; asm volatile("" : "+v"(tid));
    const int wid = __builtin_amdgcn_readfirstlane(tid >> 6), lane = tid & 63, c = lane & 15, G = lane >> 4;
    LAS f32x4* red = (LAS f32x4*)smem;
    const int nsteps = K / 32;
#pragma unroll 1
    for (int ct = blockIdx.x; ct < N / 16; ct += gridDim.x) {
        f32x4 acc0 = {0.f, 0.f, 0.f, 0.f}, acc1 = {0.f, 0.f, 0.f, 0.f};
        const bf16_t* bp = Bt + (size_t)(ct * 16 + c) * K + G * 8;
        const bf16_t* a0 = A + (size_t)c * lda + G * 8; const bf16_t* a1 = A + (size_t)(16 + c) * lda + G * 8;
#pragma unroll 4
        for (int kk = wid; kk < nsteps; kk += 8) {
            const bf16x8 bf = *(const bf16x8*)(bp + kk * 32), x0 = *(const bf16x8*)(a0 + kk * 32), x1 = *(const bf16x8*)(a1 + kk * 32);
            acc0 = mfma16(bf, x0, acc0); acc1 = mfma16(bf, x1, acc1);
        }
        __syncthreads();
        red[(wid * 2 + 0) * 64 + lane] = acc0; red[(wid * 2 + 1) * 64 + lane] = acc1;
        __syncthreads();
        if (tid < 128) {
            const int rt = tid >> 6;
            f32x4 v = red[rt * 64 + lane];
#pragma unroll
            for (int w = 1; w < 8; ++w) v = v + red[(w * 2 + rt) * 64 + lane];
            E.apply(MP + rt * 16 + c, E.lcol(ct * 16 + 4 * G), v);
        }
    }
    __syncthreads();
}

template <class Epi>
__device__ __forceinline__ void gemm_skinny2(const bf16_t* A  , int lda, const bf16_t* Bt, int K, int N, const Epi& E) {
    int tid = threadIdx.x; asm volatile("" : "+v"(tid));
    const int wid = __builtin_amdgcn_readfirstlane(tid >> 6), lane = tid & 63, c = lane & 15, G = lane >> 4;
    LAS f32x4* red = (LAS f32x4*)smem;
    const int hsteps = K / 64;
#pragma unroll 1
    for (int ct = blockIdx.x; ct < N / 16; ct += gridDim.x) {
        f32x4 acc[4] = {{0.f, 0.f, 0.f, 0.f}, {0.f, 0.f, 0.f, 0.f}, {0.f, 0.f, 0.f, 0.f}, {0.f, 0.f, 0.f, 0.f}};
        const bf16_t* bp = Bt + (size_t)(ct * 16 + c) * K + G * 8;
        const bf16_t* a0 = A + (size_t)c * lda + G * 8; const bf16_t* a1 = A + (size_t)(16 + c) * lda + G * 8;
#pragma unroll
        for (int h = 0; h < 2; ++h) {
#pragma unroll 2
            for (int kk = h * hsteps + wid; kk < (h + 1) * hsteps; kk += 8) {
                const bf16x8 bf = *(const bf16x8*)(bp + kk * 32), x0 = *(const bf16x8*)(a0 + kk * 32), x1 = *(const bf16x8*)(a1 + kk * 32);
                acc[h * 2] = mfma16(bf, x0, acc[h * 2]); acc[h * 2 + 1] = mfma16(bf, x1, acc[h * 2 + 1]);
            }
        }
        __syncthreads();
#pragma unroll
        for (int q = 0; q < 4; ++q) red[(wid * 4 + q) * 64 + lane] = acc[q];
        __syncthreads();
        if (tid < 128) {
            const int rt = tid >> 6;
            f32x4 v1 = red[rt * 64 + lane], v2 = red[(2 + rt) * 64 + lane];
#pragma unroll
            for (int w = 1; w < 8; ++w) { v1 = v1 + red[(w * 4 + rt) * 64 + lane]; v2 = v2 + red[(w * 4 + 2 + rt) * 64 + lane]; }
            E.apply2(MP + rt * 16 + c, E.lcol(ct * 16 + 4 * G), v1, v2);
        }
    }
    __syncthreads();
}

template <class Map>
__device__ __forceinline__ void transpose_tile(const float* W, int K, int N, bf16_t* Wt, int ldk, int kt, int ntile, Map map) {
    LAS float* tile = (LAS float*)smem;
    const int t = threadIdx.x;
    __syncthreads();
#pragma unroll
    for (int i = 0; i < 2; ++i) {
        const int k = (t >> 4) + 32 * i, n = (t & 15) * 4, gn = ntile * 64 + n;
        f32x4 v = (f32x4){0.f, 0.f, 0.f, 0.f};
        if (gn < N) v = *(const f32x4*)(W + (size_t)(kt * 64 + k) * N + gn);
        tile[k * 65 + n] = v[0]; tile[k * 65 + n + 1] = v[1]; tile[k * 65 + n + 2] = v[2]; tile[k * 65 + n + 3] = v[3];
    }
    __syncthreads();
    const int n = t >> 3, kc = (t & 7) * 8, gn = ntile * 64 + n;
    if (gn < N) {
        u32x4 w;
        w.x = cvt_pk_bf16(tile[(kc + 0) * 65 + n], tile[(kc + 1) * 65 + n]); w.y = cvt_pk_bf16(tile[(kc + 2) * 65 + n], tile[(kc + 3) * 65 + n]);
        w.z = cvt_pk_bf16(tile[(kc + 4) * 65 + n], tile[(kc + 5) * 65 + n]); w.w = cvt_pk_bf16(tile[(kc + 6) * 65 + n], tile[(kc + 7) * 65 + n]);
        *(u32x4*)(Wt + (size_t)map(gn) * ldk + kt * 64 + kc) = w;
    }
}
template <class Map>
__device__ __forceinline__ void transpose_all(const float* W, int K, int N, bf16_t* Wt, int ldk, Map map, int& base) {
    const int nkt = K / 64, nnt = (N + 63) / 64, ntl = nkt * nnt;
    for (int it = blockIdx.x; it < base + ntl; it += gridDim.x) {
        if (it < base) continue;
        const int l = it - base;
        transpose_tile(W, K, N, Wt, ldk, l / nnt, l % nnt, map);
    }
    base += ntl;
}
template <class Map>
__device__ __forceinline__ void transpose_all_sub(const float* W, int K, int N, bf16_t* Wt, int ldk, Map map, int& base) {
    const int nkt = K / 64, nnt = (N + 63) / 64, ntl = nkt * nnt, nb = gridDim.x - 32, me = blockIdx.x - 32;
    int first = base - (base % nb) + me; if (first < base) first += nb;
    for (int it = first; it < base + ntl; it += nb) { const int l = it - base; transpose_tile(W, K, N, Wt, ldk, l / nnt, l % nnt, map); }
    base += ntl;
}
__device__ __forceinline__ int map_win(int n) {
    if (n < 1280) return n;
    if (n < 1304) return 4352 + (n - 1280);
    if (n < 2328) return 1280 + (n - 1304);
    return 2304 + (n - 2328);
}

__device__ __forceinline__ float row_rstd(const f32x4 (&v)[4]) {
    float s = 0.f;
#pragma unroll
    for (int k = 0; k < 4; ++k) s += v[k][0] * v[k][0] + v[k][1] * v[k][1] + v[k][2] * v[k][2] + v[k][3] * v[k][3];
    s = wave_sum(s);
    return rsqrtf(s * (1.0f / DM) + EPS);
}
__device__ __forceinline__ const float* xrow_ptr(const Params& p, int row) {
    return row < MP ? p.x_prompt + (size_t)row * DM : p.x_sample + (size_t)(row - MP) * DM;
}

__device__ __forceinline__ void phase_prologue(const Params& p) {
    const int wid = threadIdx.x >> 6, lane = threadIdx.x & 63;
    const int gw = blockIdx.x * 8 + wid, nw = gridDim.x * 8;
    auto do_transposes = [&]() {
    int base = 0;
    transpose_all(p.w_in, DM, IND, p.WinT, DM, [](int n) { const int l = map_win(n); return win_tile_a(l >> 8) ? row_a(l) : l; }, base);
    for (int kv = 0; kv < 2; ++kv) for (int j = 0; j < 2; ++j)
        transpose_all((kv ? p.w1_v : p.w1_k) + (size_t)j * 1024 * 128, 1024, 128, p.W1T + (size_t)kv * 256 * 1024, 1024, [j](int n) { return inv_a(j * 128 + n); }, base);
    };
    do_transposes();
    __syncthreads();
    for (int i = blockIdx.x * 512 + threadIdx.x; i < (INP - IND) * DM / 8; i += gridDim.x * 512) ((u32x4*)(p.WinT + (size_t)IND * DM))[i] = (u32x4){0u, 0u, 0u, 0u};
    for (int row0 = gw * 2; row0 < MP + NS; row0 += nw * 2) {
        f32x4 v[2][4];
#pragma unroll
        for (int q = 0; q < 2; ++q) { const float* xr = xrow_ptr(p, row0 + q);
#pragma unroll
            for (int k = 0; k < 4; ++k) v[q][k] = *(const f32x4*)(xr + lane * 4 + k * 256); }
#pragma unroll
        for (int q = 0; q < 2; ++q) {
            const int row = row0 + q;
            u32x2* hd = (u32x2*)(p.H + (size_t)row * DM);
            const float r = row_rstd(v[q]);
#pragma unroll
            for (int k = 0; k < 4; ++k) { const f32x4 g = *(const f32x4*)(p.ln_mix_pre + lane * 4 + k * 256); const f32x4 o = v[q][k] * r * g; u32x2 w; w.x = cvt_pk_bf16(o[0], o[1]); w.y = cvt_pk_bf16(o[2], o[3]); hd[lane + k * 64] = w; }
            const float* pr = row < MP ? p.p_prompt + (size_t)row * PLE : p.p_sample + (size_t)(row - MP) * PLE;
            const f32x4 pv = *(const f32x4*)(pr + lane * 4);
            u32x2 w; w.x = cvt_pk_bf16(pv[0], pv[1]); w.y = cvt_pk_bf16(pv[2], pv[3]);
            ((u32x2*)(p.Pb + (size_t)row * PLE))[lane] = w;
        }
    }
    for (int i = blockIdx.x * 512 + threadIdx.x; i < 4 * 128 * 128; i += gridDim.x * 512) { const int t = (i >> 7) & 127, s = i & 127; p.GWb[i] = f2bf(s <= t ? p.gm_ws[i] : 0.f); }
    for (int i = blockIdx.x * 512 + threadIdx.x; i < 2 * 64 * 128; i += gridDim.x * 512) { const int kv = i >> 13, d = (i >> 7) & 63, h = i & 127; p.W2T[i] = f2bf((kv ? p.w2_v : p.w2_k)[h * 64 + d]); }
    if (gw < 256) {
        const int kv = gw >> 7, h = gw & 127;
        const float* pe = kv ? p.pe_v : p.pe_k; const float* w1 = kv ? p.w1_v : p.w1_k;
        float s = 0.f;
#pragma unroll 8
        for (int k = lane; k < 2048; k += 64) s += pe[k] * w1[(size_t)k * 128 + h];
        s = wave_sum(s);
        if (lane == 0) p.PEB[kv * 128 + h] = s;
    }
    for (int i = blockIdx.x * 512 + threadIdx.x; i < NS * (WIN - 1) * 64; i += gridDim.x * 512) {
        const int b = i / ((WIN - 1) * 64), r = i % ((WIN - 1) * 64);
        ((f32x4*)(p.out + O_WINS + (size_t)b * WIN * 256))[r] = ((const f32x4*)(p.state_win + (size_t)b * WIN * 256 + 256))[r];
    }
}

__device__ __forceinline__ void phase_deferred_transposes(const Params& p) {
    if (blockIdx.x < 32) return;
    int base = 0;
    transpose_all_sub(p.w_br_nsa, QD, DM, p.WnT, DM, [](int n) { return row_a(n); }, base);
    transpose_all_sub(p.w_br_gm, GMD, DM, p.WnT + QD, DM, [](int n) { return row_a(n); }, base);
    transpose_all_sub(p.w_out, DM, DM, p.WoT, DM, [](int n) { return row_a(n); }, base);
    transpose_all_sub(p.w_gate, DM, DFF, p.WguT, DM, [](int n) { return row_s(n, 0); }, base);
    transpose_all_sub(p.w_up, DM, DFF, p.WguT, DM, [](int n) { return row_s(n, 1); }, base);
    transpose_all_sub(p.w_down, DFF, DM, p.WdT, DFF, [](int n) { return row_a(n); }, base);
    transpose_all_sub(p.w_ple_gate, DM, DM, p.WpgT, DM, [](int n) { return row_a(n); }, base);
    transpose_all_sub(p.w_ple, PLE, DM, p.WpT, PLE, [](int n) { return row_a(n); }, base);
    __syncthreads();
}
__device__ __forceinline__ void phase_gather(const Params& p) {
    int tid = threadIdx.x; asm volatile("" : "+v"(tid));
    const int wid = tid >> 6, lane = tid & 63;
    const int gw = (blockIdx.x >> 1) * 8 + wid, nw = (gridDim.x >> 1) * 8;
    const int cls = blockIdx.x & 1;
#pragma unroll 1
    for (int r8h = gw; r8h < NS * PAST / 16; r8h += nw) {
        const int r8 = r8h * 2 + cls;
        const int r = r8 * 8, b = r >> 14, pos = r & (PAST - 1), l5 = lane & 31, hrow = lane >> 5;
        const float* s = p.cache_cmp + ((size_t)p.page_table[b * NPG + (pos >> 7)] * PAGE + (pos & 127) + hrow) * 256 + l5 * 8;
        f32x4 a[4], cc[4];
#pragma unroll
        for (int k = 0; k < 4; ++k) { a[k] = *(const f32x4*)(s + (size_t)k * 512); cc[k] = *(const f32x4*)(s + (size_t)k * 512 + 4); }
#pragma unroll
        for (int k = 0; k < 4; ++k) {
            u32x4 w; w.x = cvt_pk_bf16(a[k][0], a[k][1]); w.y = cvt_pk_bf16(a[k][2], a[k][3]); w.z = cvt_pk_bf16(cc[k][0], cc[k][1]); w.w = cvt_pk_bf16(cc[k][2], cc[k][3]);
            *(u32x4*)(p.CMPb + ((size_t)MP + r + 2 * k + hrow) * 256 + l5 * 8) = w;
        }
    }
}

__device__ __forceinline__ void phase_cmp_final(const Params& p) {
    const int wid = threadIdx.x >> 6, lane = threadIdx.x & 63;
    {
        const int c = lane & 15, G = lane >> 4;
        const int ngrp_p = NB * 4 * 32, ngrp_s = NS * 4 * 64;
#pragma unroll 1
        for (int it = blockIdx.x * 8 + wid; it < ngrp_p + ngrp_s; it += gridDim.x * 8) {
            const bool smp = it >= ngrp_p; const int l = smp ? it - ngrp_p : it;
            const int nch = smp ? 64 : 32, nc = smp ? NCS : NCP;
            const int ch = l % nch, z = (l / nch) & 3, seq = l / (nch * 4), kv = z >> 1, g = z & 1, n0 = ch * 16;
            const size_t r0 = smp ? (size_t)2048 + (size_t)seq * 1024 : (size_t)seq * 512;
            const int nr = n0 + c < nc ? n0 + c : nc - 1;
            const bf16_t* p0 = (const bf16_t*)p.PART + ((r0 + nr) * 4 + z) * 256;
            const bf16_t* p1 = (const bf16_t*)p.PART + ((r0 + nr + 1) * 4 + z) * 256 + 128;
            const float* pb = p.PEB + kv * 128;
            f32x4 acc[4] = {{0.f, 0.f, 0.f, 0.f}, {0.f, 0.f, 0.f, 0.f}, {0.f, 0.f, 0.f, 0.f}, {0.f, 0.f, 0.f, 0.f}};
#pragma unroll
            for (int ks = 0; ks < 4; ++ks) {
                const int h0 = 32 * ks + 8 * G;
                const u32x4 wa = *(const u32x4*)(p0 + h0), wb = *(const u32x4*)(p1 + h0);
                const f32x4 a0 = {bflo(wa.x), bfhi(wa.x), bflo(wa.y), bfhi(wa.y)}, a1 = {bflo(wa.z), bfhi(wa.z), bflo(wa.w), bfhi(wa.w)};
                const f32x4 b0 = {bflo(wb.x), bfhi(wb.x), bflo(wb.y), bfhi(wb.y)}, b1 = {bflo(wb.z), bfhi(wb.z), bflo(wb.w), bfhi(wb.w)};
                const f32x4 e0 = *(const f32x4*)(pb + h0), e1 = *(const f32x4*)(pb + h0 + 4);
                f32x4 x0 = a0 + b0 + e0, x1 = a1 + b1 + e1;
#pragma unroll
                for (int i = 0; i < 4; ++i) { x0[i] = siluf_(x0[i]); x1[i] = siluf_(x1[i]); }
                const bf16x8 A = pack_p(x0, x1);
#pragma unroll
                for (int nt = 0; nt < 4; ++nt) {
                    const bf16x8 B = *(const bf16x8*)(p.W2T + ((size_t)kv * 64 + nt * 16 + c) * 128 + h0);
                    acc[nt] = mfma16(A, B, acc[nt]);
                }
            }
#pragma unroll
            for (int nt = 0; nt < 4; ++nt) {
                const int d = nt * 16 + c;
#pragma unroll
                for (int i = 0; i < 4; ++i) {
                    const int n = n0 + 4 * G + i;
                    if (n < nc) {
                        if (smp) ((kv ? p.VCS : p.KCS) + (((size_t)seq * NG + g) * 1024 + n) * 64)[d] = acc[nt][i];
                        else if (kv == 0) p.KCb[((size_t)seq * NG + g) * 512 * 64 + kfrag_off(n, d)] = f2bf(acc[nt][i]);
                    }
                }
                if (!smp && kv == 1) {
                    f32x4 v = acc[nt];
#pragma unroll
                    for (int i = 0; i < 4; ++i) if (n0 + 4 * G + i >= nc) v[i] = 0.f;
                    st_bf16x4(p.VCT + ((size_t)seq * NG + g) * 512 * 64 + vfrag_off(n0 + 4 * G, d), v);
                }
            }
        }
    }
}

template <bool SAMPLE>
__device__ __forceinline__ void kv_row_ptr(const Params& p, int branch  , int b, int pos, int kv, int g, const bf16_t*& pb, const float*& pf) {
    const int off = kv * 128 + g * 64;
    if (!SAMPLE) { pf = nullptr; pb = (branch == 1 ? p.SLCb : p.WINb) + ((size_t)b * SEQ + pos) * 256 + off; }
    else if (pos >= PAST) { pf = nullptr; pb = (branch == 1 ? p.SLCb : p.WINb) + ((size_t)MP + b) * 256 + off; }
    else if (branch == 1) { pb = nullptr; pf = p.cache_slc + ((size_t)p.page_table[b * NPG + (pos >> 7)] * PAGE + (pos & 127)) * 256 + off; }
    else { pb = nullptr; pf = p.state_win + ((size_t)b * WIN + (pos - (PAST - WIN))) * 256 + off; }
}
__device__ __forceinline__ void dot4x64(const bf16_t* pb, const float* pf, const LAS float* qs_, float (&s)[4]) {
    s[0] = s[1] = s[2] = s[3] = 0.f;
    const LAS float* qs = qs_; asm volatile("" : "+v"(qs));
    if (pf) {
#pragma unroll 8
        for (int c = 0; c < 16; ++c) {
            const f32x4 kx = *(const f32x4*)(pf + c * 4);
#pragma unroll
            for (int h = 0; h < 4; ++h) { const f32x4 q = *(const LAS f32x4*)(qs + h * 64 + c * 4); s[h] += q[0] * kx[0] + q[1] * kx[1] + q[2] * kx[2] + q[3] * kx[3]; }
        }
    } else {
#pragma unroll 2
        for (int c = 0; c < 8; ++c) {
            const u32x4 w = *(const u32x4*)(pb + c * 8);
            const float k0 = bflo(w.x), k1 = bfhi(w.x), k2 = bflo(w.y), k3 = bfhi(w.y), k4 = bflo(w.z), k5 = bfhi(w.z), k6 = bflo(w.w), k7 = bfhi(w.w);
#pragma unroll
            for (int h = 0; h < 4; ++h) {
                const f32x4 qa = *(const LAS f32x4*)(qs + h * 64 + c * 8), qb = *(const LAS f32x4*)(qs + h * 64 + c * 8 + 4);
                s[h] += qa[0] * k0 + qa[1] * k1 + qa[2] * k2 + qa[3] * k3 + qb[0] * k4 + qb[1] * k5 + qb[2] * k6 + qb[3] * k7;
            }
        }
    }
}
template <bool SAMPLE>
__device__ __forceinline__ void attn_chunk(const Params& p, int branch, int b, int g, int t, int pos0, int lo, int hi,
                                           float (&m)[4], float (&l)[4], float (&o)[4], const LAS float* qs, LAS float* pbk, const LAS float* relb, int lane) {
    const int pos = pos0 + lane;
    const bool valid = pos >= lo && pos <= hi;
    float s[4] = {-1e30f, -1e30f, -1e30f, -1e30f};
    if (valid) {
        const bf16_t* pb; const float* pf; kv_row_ptr<SAMPLE>(p, branch, b, pos, 0, g, pb, pf);
        dot4x64(pb, pf, qs, s);
        const int bk = t5_bucket(t - pos);
#pragma unroll
        for (int h = 0; h < 4; ++h) s[h] += relb[bk * 8 + g * 4 + h];
    }
#pragma unroll
    for (int h = 0; h < 4; ++h) {
        const float mx = wave_max(s[h]);
        const float mn = fmaxf(m[h], mx);
        const float pr = valid ? ex2(s[h] - mn) : 0.f;
        const float sm = wave_sum(pr);
        const float al = ex2(m[h] - mn);
        l[h] = l[h] * al + sm; o[h] *= al; m[h] = mn;
        pbk[h * 64 + lane] = pr;
    }
    __builtin_amdgcn_wave_barrier();
    const int k0 = (lo > pos0 ? lo : pos0) - pos0, k1 = (hi < pos0 + 63 ? hi : pos0 + 63) - pos0;
    if (SAMPLE) {
        const int kend = (PAST - 1 - pos0) < k1 ? (PAST - 1 - pos0) : k1;
        if (kend >= k0) {
            const bf16_t* pb; const float* pf; kv_row_ptr<SAMPLE>(p, branch, b, pos0 + k0, 1, g, pb, pf);
            pf += lane;
#pragma unroll 16
            for (int k = k0; k <= kend; ++k) {
                const float v = pf[(size_t)(k - k0) * 256];
#pragma unroll
                for (int h = 0; h < 4; ++h) o[h] += pbk[h * 64 + k] * v;
            }
        }
        if (k1 > kend) {
            const bf16_t* pb; const float* pf; kv_row_ptr<SAMPLE>(p, branch, b, pos0 + k1, 1, g, pb, pf);
            const float v = bf2f(pb[lane]);
#pragma unroll
            for (int h = 0; h < 4; ++h) o[h] += pbk[h * 64 + k1] * v;
        }
    } else {
#pragma unroll 1
    for (int k = k0; k <= k1; ++k) {
        const bf16_t* pb; const float* pf; kv_row_ptr<SAMPLE>(p, branch, b, pos0 + k, 1, g, pb, pf);
        const float v = pf ? pf[lane] : bf2f(pb[lane]);
#pragma unroll
        for (int h = 0; h < 4; ++h) o[h] += pbk[h * 64 + k] * v;
    }
    }
    __builtin_amdgcn_wave_barrier();
}

constexpr int S_QS = 0, S_SC = 1024, S_PHS = S_SC + 4 * 1024 * 4, S_PBK = S_PHS + 1088 * 4, S_PART = S_PBK + 8 * 1024, S_RED = S_PART + 2 * 8 * 272 * 4, S_OCP = S_RED + 512,
              S_SEL = S_OCP + 2048, S_RELB = S_SEL + 64, ATTS_LDS = S_RELB + 1024;
__device__ __forceinline__ void attn_sample_item(const Params& p, int b, int g) {
    const int tid = threadIdx.x, wid = tid >> 6, lane = tid & 63;
    constexpr int t = PAST, NC = NCS, NSEL = 257, NJR = 5, qblk = PAST >> 6;
    const int row = MP + b;
    LAS unsigned char* L = (LAS unsigned char*)smem;
    LAS float* qs = (LAS float*)(L + S_QS); LAS float* sc = (LAS float*)(L + S_SC); LAS float* phs = (LAS float*)(L + S_PHS); LAS float* pbk = (LAS float*)(L + S_PBK) + wid * 256;
    LAS float* part = (LAS float*)(L + S_PART); LAS float* red = (LAS float*)(L + S_RED); LAS float* ocp = (LAS float*)(L + S_OCP); LAS int* sel = (LAS int*)(L + S_SEL);
    LAS float* relb = (LAS float*)(L + S_RELB);
    __syncthreads();
    if (tid < 256) { relb[tid] = p.rel_bias[tid] * LOG2E; qs[tid] = bf2f(p.Qb[(size_t)row * QD + g * 256 + tid]); }
    __syncthreads();
    const float* kc = p.KCS + ((size_t)b * NG + g) * 1024 * 64;
    const float* vc = p.VCS + ((size_t)b * NG + g) * 1024 * 64;
    {
        float mx[4] = {-1e30f, -1e30f, -1e30f, -1e30f};
#pragma unroll 1
        for (int r = wid; r < 16; r += 8) {
            const int n = r * 64 + lane;
            float s[4] = {-1e30f, -1e30f, -1e30f, -1e30f};
            if (n < NC) {
                dot4x64(nullptr, kc + (size_t)n * 64, qs, s);
                const int bk = t5_bucket(t - (16 * n + 31));
#pragma unroll
                for (int h = 0; h < 4; ++h) s[h] += relb[bk * 8 + g * 4 + h];
            }
#pragma unroll
            for (int h = 0; h < 4; ++h) { sc[h * 1024 + n] = s[h]; mx[h] = fmaxf(mx[h], s[h]); }
        }
#pragma unroll
        for (int h = 0; h < 4; ++h) { const float m = wave_max(mx[h]); if (lane == 0) red[wid * 4 + h] = m; }
    }
    __syncthreads();
    float gmx[4], inv[4];
#pragma unroll
    for (int h = 0; h < 4; ++h) { float m = red[h]; for (int w = 1; w < 8; ++w) m = fmaxf(m, red[w * 4 + h]); gmx[h] = m; }
    {
        float sum[4] = {0.f, 0.f, 0.f, 0.f};
#pragma unroll
        for (int k = 0; k < 2; ++k) { const int n = tid + 512 * k;
#pragma unroll
            for (int h = 0; h < 4; ++h) { const float e = n < NC ? ex2(sc[h * 1024 + n] - gmx[h]) : 0.f; sc[h * 1024 + n] = e; sum[h] += e; } }
#pragma unroll
        for (int h = 0; h < 4; ++h) { const float s = wave_sum(sum[h]); if (lane == 0) red[32 + wid * 4 + h] = s; }
    }
    __syncthreads();
#pragma unroll
    for (int h = 0; h < 4; ++h) { float s = 0.f; for (int w = 0; w < 8; ++w) s += red[32 + w * 4 + h]; inv[h] = s > 0.f ? 1.0f / s : 0.f; }
    for (int n = tid; n < 1088; n += 512) phs[n] = n < NC ? (sc[n] * inv[0] + sc[1024 + n] * inv[1]) + (sc[2048 + n] * inv[2] + sc[3072 + n] * inv[3]) : 0.f;
    {
        float a[4] = {0.f, 0.f, 0.f, 0.f};
#pragma unroll 16
        for (int n = wid; n < NC; n += 8) {
            const float v = vc[(size_t)n * 64 + lane];
#pragma unroll
            for (int h = 0; h < 4; ++h) a[h] += sc[h * 1024 + n] * v;
        }
#pragma unroll
        for (int h = 0; h < 4; ++h) part[(wid * 4 + h) * 68 + lane] = a[h] * inv[h];
    }
    __syncthreads();
    if (tid < 256) { float a = 0.f; for (int w = 0; w < 8; ++w) a += part[(w * 4 + (tid >> 6)) * 68 + (tid & 63)]; ocp[tid] = a; }
    __syncthreads();
    if (wid == 0) {
        unsigned long long key[NJR];
#pragma unroll
        for (int jr = 0; jr < NJR; ++jr) {
            const int j = jr * 64 + lane;
            key[jr] = 0ull;
            if (j >= 1 && j <= qblk - 2 && j < NSEL) {
                float im = 0.f;
#pragma unroll
                for (int n = 4 * j - 1; n <= 4 * j + 3; ++n) im += (n < NC) ? phs[n] : 0.f;
                key[jr] = ((unsigned long long)__float_as_uint(im) << 32) | (unsigned)(0xFFFF - j) | 0x10000ull;
            }
        }
        if (lane == 0) { sel[0] = 0; sel[1] = qblk - 1; sel[2] = qblk; }
#pragma unroll 1
        for (int it = 0; it < 13; ++it) {
            unsigned long long best = 0ull;
#pragma unroll
            for (int jr = 0; jr < NJR; ++jr) best = key[jr] > best ? key[jr] : best;
#pragma unroll
            for (int o = 32; o > 0; o >>= 1) { const unsigned long long ot = __shfl_xor(best, o); best = ot > best ? ot : best; }
            const int j = 0xFFFF - (int)(best & 0xFFFFull);
#pragma unroll
            for (int jr = 0; jr < NJR; ++jr) if (key[jr] == best) key[jr] = 0ull;
            if (lane == 0) sel[3 + it] = j;
        }
    }
    __syncthreads();
    {
        float ms[4] = {-1e30f, -1e30f, -1e30f, -1e30f}, ls[4] = {0.f, 0.f, 0.f, 0.f}, os[4] = {0.f, 0.f, 0.f, 0.f};
#pragma unroll 1
        for (int i = wid; i < 16; i += 8) attn_chunk<true>(p, 1, b, g, t, sel[i] * 64, 0, t, ms, ls, os, qs, pbk, relb, lane);
        float mw[4] = {-1e30f, -1e30f, -1e30f, -1e30f}, lw[4] = {0.f, 0.f, 0.f, 0.f}, ow[4] = {0.f, 0.f, 0.f, 0.f};
#pragma unroll 1
        for (int c = wid; c < 9; c += 8) attn_chunk<true>(p, 2, b, g, t, t - 63 - 64 * c, t - WIN, t, mw, lw, ow, qs, pbk, relb, lane);
#pragma unroll
        for (int h = 0; h < 4; ++h) {
            LAS float* ps = part + (wid * 4 + h) * 68; LAS float* pw = part + 8 * 272 + (wid * 4 + h) * 68;
            ps[lane] = os[h]; pw[lane] = ow[h];
            if (lane == 0) { ps[64] = ms[h]; ps[65] = ls[h]; pw[64] = mw[h]; pw[65] = lw[h]; }
        }
    }
    __syncthreads();
    if (tid < 256) {
        const int h = tid >> 6, d = tid & 63;
        float res[2];
#pragma unroll
        for (int br = 0; br < 2; ++br) {
            const LAS float* pp = part + br * 8 * 272 + h * 68;
            float m = -1e30f;
            for (int w = 0; w < 8; ++w) m = fmaxf(m, pp[w * 272 + 64]);
            float l = 0.f, o = 0.f;
            for (int w = 0; w < 8; ++w) { const float sc_ = ex2(pp[w * 272 + 64] - m); l += pp[w * 272 + 65] * sc_; o += pp[w * 272 + d] * sc_; }
            res[br] = o / l;
        }
        const float* gt = p.GATE + (size_t)row * 32 + (g * 4 + h) * 3;
        const float v = gt[0] * ocp[tid] + gt[1] * res[0] + gt[2] * res[1];
        p.OCAT[(size_t)row * DM + (g * 4 + h) * 64 + d] = f2bf(v);
    }
    __syncthreads();
}

constexpr int A_OST = 0, OST_LD = 68, A_LST = A_OST + 256 * OST_LD * 4, A_M0 = A_LST + 1024, A_MB = A_M0 + 1024, MB_LD = 132, A_MKN = A_MB + 64 * MB_LD,
              A_LIST = A_MKN + 256, A_CNT = A_LIST + 132 * 64, A_PK = A_CNT + 544, A_KN = A_PK + 400 * 4, A_T2 = A_KN + 512, A_NP = A_T2 + 132 * 8 * 4, A_QT = A_NP + 16, ATT2_LDS = A_QT + 64 * 512;
static_assert(ATT2_LDS <= GEMM_LDS && ATTS_LDS <= GEMM_LDS, "attention LDS");

__device__ __forceinline__ void qk64(const bf16_t* kb, int c, int G, const bf16x8 (&qB)[2], f32x4 (&s)[4]) {
#pragma unroll
    for (int kt = 0; kt < 4; ++kt) {
        const bf16_t* r = kb + (size_t)(16 * kt + c) * 256 + G * 8;
        const bf16x8 a0 = *(const bf16x8*)r, a1 = *(const bf16x8*)(r + 32);
        s[kt] = mfma16(a0, qB[0], (f32x4){0.f, 0.f, 0.f, 0.f}); s[kt] = mfma16(a1, qB[1], s[kt]);
    }
}
__device__ __forceinline__ void pv64(const bf16_t* vf, int key0, int lane, const f32x4 (&pr)[4], f32x4 (&o)[4]) {
#pragma unroll
    for (int ks = 0; ks < 2; ++ks) {
        const bf16x8 pB = pack_p(pr[2 * ks], pr[2 * ks + 1]);
#pragma unroll
        for (int dt = 0; dt < 4; ++dt) {
            const bf16x8 vA = *(const bf16x8*)(vf + ((size_t)(((key0 >> 5) + ks) * 4 + dt) * 64 + lane) * 8);
            o[dt] = mfma16(vA, pB, o[dt]);
        }
    }
}
__device__ __forceinline__ int qt_off(int qi, int hh, int k) { return (qi * 4 + hh) * 128 + ((k ^ (((qi & 3) << 1) | (hh >> 1))) << 4); }
__device__ __forceinline__ float grp_max(float v) {
    auto r = __builtin_amdgcn_permlane16_swap(__float_as_uint(v), __float_as_uint(v), false, false); v = fmaxf(__uint_as_float(r[0]), __uint_as_float(r[1]));
    r = __builtin_amdgcn_permlane32_swap(__float_as_uint(v), __float_as_uint(v), false, false); return fmaxf(__uint_as_float(r[0]), __uint_as_float(r[1]));
}
__device__ __forceinline__ float grp_sum(float v) {
    auto r = __builtin_amdgcn_permlane16_swap(__float_as_uint(v), __float_as_uint(v), false, false); v = __uint_as_float(r[0]) + __uint_as_float(r[1]);
    r = __builtin_amdgcn_permlane32_swap(__float_as_uint(v), __float_as_uint(v), false, false); return __uint_as_float(r[0]) + __uint_as_float(r[1]);
}
__device__ __forceinline__ int grp_min_i(int v) {
    auto r = __builtin_amdgcn_permlane16_swap((unsigned)v, (unsigned)v, false, false); v = (int)r[0] < (int)r[1] ? (int)r[0] : (int)r[1];
    r = __builtin_amdgcn_permlane32_swap((unsigned)v, (unsigned)v, false, false); return (int)r[0] < (int)r[1] ? (int)r[0] : (int)r[1];
}
__device__ __forceinline__ float dpp_x1(float v) { return __uint_as_float(__builtin_amdgcn_mov_dpp(__float_as_uint(v), 0xB1, 0xF, 0xF, true)); }
__device__ __forceinline__ float dpp_x2(float v) { return __uint_as_float(__builtin_amdgcn_mov_dpp(__float_as_uint(v), 0x4E, 0xF, 0xF, true)); }
__device__ __forceinline__ int dpp_x1i(int v) { return (int)__builtin_amdgcn_mov_dpp((unsigned)v, 0xB1, 0xF, 0xF, true); }
__device__ __forceinline__ int dpp_x2i(int v) { return (int)__builtin_amdgcn_mov_dpp((unsigned)v, 0x4E, 0xF, 0xF, true); }
__device__ __forceinline__ unsigned row_or_q(unsigned u) {
    u |= __builtin_amdgcn_mov_dpp(u, 0x124, 0xF, 0xF, true); u |= __builtin_amdgcn_mov_dpp(u, 0x128, 0xF, 0xF, true); return u;
}

__device__ __forceinline__ void attn_cmp(const Params& p, int b, int g, int t0, int lane_, LAS unsigned char* L, unsigned (&msk)[4]) {
    f32x4 oacc[4];
    int lane = lane_; asm volatile("" : "+v"(lane));
    const int c = lane & 15, G = lane >> 4, qs = c >> 2, hh = c & 3;
    const int qb = t0 >> 6, tc = t0 + qs;
    const size_t qrow = (size_t)b * SEQ + tc;
    const LAS float* T2 = (const LAS float*)(L + A_T2);
    const float b31 = T2[128 * 8 + g * 4 + hh];
    bf16x8 qB[2];
    qB[0] = *(const bf16x8*)(p.Qb + qrow * QD + (g * 4 + hh) * 64 + G * 8); qB[1] = *(const bf16x8*)(p.Qb + qrow * QD + (g * 4 + hh) * 64 + 32 + G * 8);
    const float* gate = p.GATE + qrow * 32 + (g * 4 + hh) * 3;
    msk[0] = msk[1] = msk[2] = msk[3] = 0u;
    {
        const int ncv_c = tc >= 31 ? ((tc - 31) >> 4) + 1 : 0;
        const int ncv_m = t0 + 3 >= 31 ? ((t0 + 3 - 31) >> 4) + 1 : 0;
        const int NT = (ncv_m + 15) >> 4;
        const int mt_far = t0 >= 399 ? (t0 - 399) / 256 + 1 : 0;
        const bf16_t* kcb = p.KCb + (size_t)(b * NG + g) * 512 * 64;
        f32x4 sc[32];
        float mxf = -1e30f, mxn = -1e30f;
        bf16x8 kbuf[2][4][2];
        auto ldkg = [&](int grp, bf16x8 (&kb)[4][2]) __attribute__((always_inline)) {
#pragma unroll
            for (int q = 0; q < 4; ++q) { const bf16_t* r = kcb + ((size_t)((grp * 4 + q) * 2) * 64 + lane) * 8; kb[q][0] = *(const bf16x8*)r; kb[q][1] = *(const bf16x8*)(r + 512); }
        };
        ldkg(0, kbuf[0]);
#pragma unroll
        for (int grp = 0; grp < 8; ++grp) {
            if (4 * grp < NT) {
                if (4 * (grp + 1) < NT) ldkg(grp + 1, kbuf[(grp + 1) & 1]);
                __builtin_amdgcn_sched_barrier(0);
#pragma unroll
                for (int q = 0; q < 4; ++q) {
                    const int mt = grp * 4 + q;
                    f32x4 s = mfma16(kbuf[grp & 1][q][0], qB[0], (f32x4){0.f, 0.f, 0.f, 0.f}); s = mfma16(kbuf[grp & 1][q][1], qB[1], s);
                    if (mt < mt_far) { mxf = fmaxf(mxf, fmaxf(fmaxf(s[0], s[1]), fmaxf(s[2], s[3]))); }
                    else {
#pragma unroll
                        for (int i = 0; i < 4; ++i) { const int n = 16 * mt + 4 * G + i; int dist = tc - (16 * n + 31); const bool ok = n < ncv_c; dist = dist < 0 ? 0 : (dist > 128 ? 128 : dist);
                            s[i] = ok ? s[i] + T2[dist * 8 + g * 4 + hh] : -1e30f; }
                        mxn = fmaxf(mxn, fmaxf(fmaxf(s[0], s[1]), fmaxf(s[2], s[3])));
                    }
                    sc[mt] = s;
                }
            } else {
#pragma unroll
                for (int q = 0; q < 4; ++q) sc[grp * 4 + q] = (f32x4){0.f, 0.f, 0.f, 0.f};
            }
        }
        const float mx = grp_max(fmaxf(mxf + b31, mxn));
        const float shf = mx - b31;
#pragma unroll
        for (int mt = 0; mt < 32; ++mt) if ((mt & ~3) < NT) {
            const float sh = mt < mt_far ? shf : mx;
#pragma unroll
            for (int i = 0; i < 4; ++i) sc[mt][i] = ex2(sc[mt][i] - sh);
        }
        const bf16_t* vct = p.VCT + (size_t)(b * NG + g) * 64 * 512;
        const bf16x8 ones = __builtin_bit_cast(bf16x8, (u32x4){0x3F803F80u, 0x3F803F80u, 0x3F803F80u, 0x3F803F80u});
        f32x4 oc[4] = {{0.f, 0.f, 0.f, 0.f}, {0.f, 0.f, 0.f, 0.f}, {0.f, 0.f, 0.f, 0.f}, {0.f, 0.f, 0.f, 0.f}};
        f32x4 rs = {0.f, 0.f, 0.f, 0.f};
        bf16x8 vbuf[2][2][4];
        auto ldvg = [&](int grp, bf16x8 (&vb)[2][4]) __attribute__((always_inline)) {
#pragma unroll
            for (int q = 0; q < 2; ++q)
#pragma unroll
                for (int dt = 0; dt < 4; ++dt) vb[q][dt] = *(const bf16x8*)(vct + ((size_t)((grp * 2 + q) * 4 + dt) * 64 + lane) * 8);
        };
        ldvg(0, vbuf[0]);
#pragma unroll
        for (int grp = 0; grp < 8; ++grp) if (4 * grp < NT) {
            if (4 * (grp + 1) < NT) ldvg(grp + 1, vbuf[(grp + 1) & 1]);
            __builtin_amdgcn_sched_barrier(0);
#pragma unroll
            for (int q = 0; q < 2; ++q) {
                const int k2 = grp * 2 + q;
                const bf16x8 pB = pack_p(sc[2 * k2], sc[2 * k2 + 1]);
                rs = mfma16(ones, pB, rs);
#pragma unroll
                for (int dt = 0; dt < 4; ++dt) oc[dt] = mfma16(vbuf[grp & 1][q][dt], pB, oc[dt]);
            }
        }
        const float inv = ncv_c > 0 ? 1.0f / rs[0] : 0.f;
        if (qb <= 15) {
            msk[0] = (qb >= 31) ? 0xffffffffu : ((2u << qb) - 1u);
        } else {
            unsigned cand[8];
#pragma unroll
            for (int k = 0; k < 8; ++k) cand[k] = 0u;
            float prevB = 0.f;
#pragma unroll
            for (int mt = 0; mt < 32; ++mt) if (mt < NT) {
                const unsigned x3 = __float_as_uint(sc[mt][3]);
                const auto p16 = __builtin_amdgcn_permlane16_swap(x3, x3, false, false);
                const auto p32 = __builtin_amdgcn_permlane32_swap(p16[1], p16[1], false, false);
                const float r1 = G == 2 ? __uint_as_float(p32[0]) : __uint_as_float(p16[0]);
                float v = ((sc[mt][0] + sc[mt][1]) + (sc[mt][2] + sc[mt][3]) + (G == 0 ? prevB : r1)) * inv;
                prevB = __uint_as_float(p32[1]);
                v += dpp_x1(v); v += dpp_x2(v);
                const int j = 4 * mt + G;
                if ((mt & 3) == hh) cand[mt >> 2] = (j >= 1 && j <= qb - 2) ? ((__float_as_uint(v) & ~127u) | (unsigned)(127 - j)) : 0u;
            }
            auto setbit = [&](int j) { const unsigned bit = 1u << (j & 31); const int w = j >> 5; msk[0] |= w == 0 ? bit : 0u; msk[1] |= w == 1 ? bit : 0u; msk[2] |= w == 2 ? bit : 0u; msk[3] |= w == 3 ? bit : 0u; };
            setbit(0); setbit(qb); setbit(qb - 1);
#pragma unroll 1
            for (int it = 0; it < 13; ++it) {
                unsigned bv = cand[0];
#pragma unroll
                for (int k = 1; k < 8; ++k) bv = bv > cand[k] ? bv : cand[k];
                { unsigned o = __builtin_amdgcn_mov_dpp(bv, 0xB1, 0xF, 0xF, true); bv = o > bv ? o : bv; o = __builtin_amdgcn_mov_dpp(bv, 0x4E, 0xF, 0xF, true); bv = o > bv ? o : bv;
                  auto r = __builtin_amdgcn_permlane16_swap(bv, bv, false, false); bv = r[0] > r[1] ? r[0] : r[1]; r = __builtin_amdgcn_permlane32_swap(bv, bv, false, false); bv = r[0] > r[1] ? r[0] : r[1]; }
#pragma unroll
                for (int k = 0; k < 8; ++k) cand[k] = cand[k] == bv ? 0u : cand[k];
                setbit(127 - (int)(bv & 127u));
            }
        }
        const float g0 = gate[0] * inv;
#pragma unroll
        for (int dt = 0; dt < 4; ++dt) oacc[dt] = oc[dt] * g0;
    }
    bf16_t* orow = p.OCAT + qrow * DM + (g * 4 + hh) * 64 + 4 * G;
#pragma unroll
    for (int dt = 0; dt < 4; ++dt) st_bf16x4(orow + dt * 16, oacc[dt]);
}

struct PackSt { bf16x8 q0, q1; float m; f32x4 l4; f32x4 o[4]; };
__device__ __forceinline__ void attn_selwin_pair(const Params& p, int b, int g, int t0, int lane_, LAS unsigned char* L, const unsigned (&mskA)[4], const unsigned (&mskB)[4]) {
    int lane = lane_; asm volatile("" : "+v"(lane));
    const int c = lane & 15, G = lane >> 4, qs = c >> 2, hh = c & 3;
    const int qb = t0 >> 6;
    const LAS float* T2 = (const LAS float*)(L + A_T2);
    const float b31 = T2[128 * 8 + g * 4 + hh];
    const int tcA = t0 + qs, tcB = t0 + 4 + qs;
    const size_t qrowA = (size_t)b * SEQ + tcA;
    PackSt A, B;
    {
        const bf16_t* qa = p.Qb + qrowA * QD + (g * 4 + hh) * 64 + G * 8;
        A.q0 = *(const bf16x8*)qa; A.q1 = *(const bf16x8*)(qa + 32); B.q0 = *(const bf16x8*)(qa + 4 * QD); B.q1 = *(const bf16x8*)(qa + 4 * QD + 32);
    }
    auto reset = [&](PackSt& S) __attribute__((always_inline)) { S.m = -1e30f; S.l4 = (f32x4){0.f, 0.f, 0.f, 0.f};
#pragma unroll
        for (int dt = 0; dt < 4; ++dt) S.o[dt] = (f32x4){0.f, 0.f, 0.f, 0.f}; };
    const bf16x8 ones = __builtin_bit_cast(bf16x8, (u32x4){0x3F803F80u, 0x3F803F80u, 0x3F803F80u, 0x3F803F80u});
    auto finish = [&](PackSt& S, f32x4 (&s)[4], float cb, bool mine, const bf16x8 (&vf)[2][4]) __attribute__((always_inline)) {
        float cm = fmaxf(fmaxf(fmaxf(s[0][0], s[0][1]), fmaxf(s[0][2], s[0][3])), fmaxf(fmaxf(s[1][0], s[1][1]), fmaxf(s[1][2], s[1][3])));
        cm = fmaxf(cm, fmaxf(fmaxf(fmaxf(s[2][0], s[2][1]), fmaxf(s[2][2], s[2][3])), fmaxf(fmaxf(s[3][0], s[3][1]), fmaxf(s[3][2], s[3][3]))));
        cm = grp_max(mine ? cm + cb : -1e30f);
        const float mn = fmaxf(S.m, cm), al = ex2(S.m - mn);
        const float sh = (mine ? mn : 1e30f) - cb;
#pragma unroll
        for (int kt = 0; kt < 4; ++kt)
#pragma unroll
            for (int i = 0; i < 4; ++i) s[kt][i] = ex2(s[kt][i] - sh);
        S.m = mn;
        f32x4 rs = {0.f, 0.f, 0.f, 0.f};
#pragma unroll
        for (int dt = 0; dt < 4; ++dt) S.o[dt] = S.o[dt] * al;
#pragma unroll
        for (int ks = 0; ks < 2; ++ks) { const bf16x8 pB = pack_p(s[2 * ks], s[2 * ks + 1]);
            rs = mfma16(ones, pB, rs);
#pragma unroll
            for (int dt = 0; dt < 4; ++dt) S.o[dt] = mfma16(vf[ks][dt], pB, S.o[dt]); }
        S.l4[0] = S.l4[0] * al + rs[0];
    };
    auto addout = [&](PackSt& S, size_t qrow, int br) __attribute__((always_inline)) {
        const float gs = p.GATE[qrow * 32 + (g * 4 + hh) * 3 + br] / S.l4[0];
        bf16_t* orow = p.OCAT + qrow * DM + (g * 4 + hh) * 64 + 4 * G;
#pragma unroll
        for (int dt = 0; dt < 4; ++dt) { const u32x2 w = *(const u32x2*)(orow + dt * 16); f32x4 pa; pa[0] = bflo(w.x); pa[1] = bfhi(w.x); pa[2] = bflo(w.y); pa[3] = bfhi(w.y);
            st_bf16x4(orow + dt * 16, pa + S.o[dt] * gs); }
    };
    {
        unsigned umA[4], umB[4], um[4];
#pragma unroll
        for (int w = 0; w < 4; ++w) {
            umA[w] = __builtin_amdgcn_readfirstlane(row_or_q(mskA[w]));
            umB[w] = __builtin_amdgcn_readfirstlane(row_or_q(mskB[w]));
            um[w] = umA[w] | umB[w];
        }
        reset(A); reset(B);
        const bf16_t* klane = p.SLCkF + (size_t)(b * NG + g) * SEQ * 64 + lane * 8;
        const bf16_t* vlane = p.SLCvT + (size_t)(b * NG + g) * SEQ * 64 + lane * 8;
        auto ldfr = [&](int j_, bf16x8 (&kf_)[4][2], bf16x8 (&vf_)[2][4]) __attribute__((always_inline)) {
            const bf16_t* kr = klane + (size_t)j_ * 4096; const bf16_t* vr = vlane + (size_t)j_ * 4096;
#pragma unroll
            for (int kt = 0; kt < 4; ++kt) { kf_[kt][0] = *(const bf16x8*)(kr + (kt * 2) * 512); kf_[kt][1] = *(const bf16x8*)(kr + (kt * 2 + 1) * 512); }
#pragma unroll
            for (int ks = 0; ks < 2; ++ks)
#pragma unroll
                for (int dt = 0; dt < 4; ++dt) vf_[ks][dt] = *(const bf16x8*)(vr + (ks * 4 + dt) * 512);
        };
        auto nextj = [&](int& j_) __attribute__((always_inline)) {
            int w = um[0] ? 0 : um[1] ? 1 : um[2] ? 2 : um[3] ? 3 : -1;
            if (w < 0) return false;
            const unsigned u = w == 0 ? um[0] : w == 1 ? um[1] : w == 2 ? um[2] : um[3];
            const int bpos = __builtin_ctz(u);
            j_ = w * 32 + bpos;
            const unsigned cl = ~(1u << bpos);
            if (w == 0) um[0] &= cl; else if (w == 1) um[1] &= cl; else if (w == 2) um[2] &= cl; else um[3] &= cl;
            return true;
        };
        auto packstep = [&](PackSt& S, const unsigned (&msk)[4], int tc, int j, const bf16x8 (&kf)[4][2], const bf16x8 (&vf)[2][4]) __attribute__((always_inline)) {
            const unsigned mw = (j >> 5) == 0 ? msk[0] : (j >> 5) == 1 ? msk[1] : (j >> 5) == 2 ? msk[2] : msk[3];
            const bool mine = (mw >> (j & 31)) & 1u;
            const bool farb = j <= qb - 3;
            f32x4 s[4];
#pragma unroll
            for (int kt = 0; kt < 4; ++kt) { s[kt] = mfma16(kf[kt][0], S.q0, (f32x4){0.f, 0.f, 0.f, 0.f}); s[kt] = mfma16(kf[kt][1], S.q1, s[kt]); }
            if (!farb) {
#pragma unroll
                for (int kt = 0; kt < 4; ++kt)
#pragma unroll
                    for (int i = 0; i < 4; ++i) { const int dist = tc - (j * 64 + 16 * kt + 4 * G + i); const int dd = dist < 0 ? 0 : (dist > 128 ? 128 : dist);
                        s[kt][i] = dist >= 0 ? s[kt][i] + T2[dd * 8 + g * 4 + hh] : -1e30f; }
            }
            finish(S, s, farb ? b31 : 0.f, mine, vf);
        };
        auto blockstep = [&](int j, const bf16x8 (&kf)[4][2], const bf16x8 (&vf)[2][4]) __attribute__((always_inline)) {
            const int w = j >> 5; const unsigned bit = 1u << (j & 31);
            const unsigned ua = w == 0 ? umA[0] : w == 1 ? umA[1] : w == 2 ? umA[2] : umA[3];
            const unsigned ub = w == 0 ? umB[0] : w == 1 ? umB[1] : w == 2 ? umB[2] : umB[3];
            if (ua & bit) packstep(A, mskA, tcA, j, kf, vf);
            if (ub & bit) packstep(B, mskB, tcB, j, kf, vf);
        };
        auto ldk = [&](int j_, bf16x8 (&kf_)[4][2]) __attribute__((always_inline)) {
            const bf16_t* kr = klane + (size_t)j_ * 4096;
#pragma unroll
            for (int kt = 0; kt < 4; ++kt) { kf_[kt][0] = *(const bf16x8*)(kr + (kt * 2) * 512); kf_[kt][1] = *(const bf16x8*)(kr + (kt * 2 + 1) * 512); }
        };
        auto ldv = [&](int j_, bf16x8 (&vf_)[2][4]) __attribute__((always_inline)) {
            const bf16_t* vr = vlane + (size_t)j_ * 4096;
#pragma unroll
            for (int ks = 0; ks < 2; ++ks)
#pragma unroll
                for (int dt = 0; dt < 4; ++dt) vf_[ks][dt] = *(const bf16x8*)(vr + (ks * 4 + dt) * 512);
        };
        bf16x8 kfA[4][2], kfB[4][2], vf[2][4];
        int j = 0; bool have = nextj(j);
        ldk(j, kfA);
#pragma unroll 1
        while (have) {
            int jn = j; bool haven = nextj(jn);
            ldv(j, vf); ldk(jn, kfB);
            __builtin_amdgcn_sched_barrier(0);
            blockstep(j, kfA, vf);
            if (!haven) break;
            j = jn; have = nextj(jn);
            ldv(j, vf); ldk(jn, kfA);
            __builtin_amdgcn_sched_barrier(0);
            blockstep(j, kfB, vf);
            j = jn;
        }
        addout(A, qrowA, 1); addout(B, qrowA + 4, 1);
    }
    {
        reset(A); reset(B);
        const int loA = t0 - WIN > 0 ? t0 - WIN : 0, hiA = t0 + 3, loB = t0 + 4 - WIN > 0 ? t0 + 4 - WIN : 0, hiB = t0 + 7;
        const bf16_t* klane = p.WINkF + (size_t)(b * NG + g) * SEQ * 64 + lane * 8;
        const bf16_t* vlane = p.WINvT + (size_t)(b * NG + g) * SEQ * 64 + lane * 8;
        auto ldfr = [&](int cb_, bf16x8 (&kf_)[4][2], bf16x8 (&vf_)[2][4]) __attribute__((always_inline)) {
            const bf16_t* kr = klane + (size_t)cb_ * 64; const bf16_t* vr = vlane + (size_t)cb_ * 64;
#pragma unroll
            for (int kt = 0; kt < 4; ++kt) { kf_[kt][0] = *(const bf16x8*)(kr + (kt * 2) * 512); kf_[kt][1] = *(const bf16x8*)(kr + (kt * 2 + 1) * 512); }
#pragma unroll
            for (int ks = 0; ks < 2; ++ks)
#pragma unroll
                for (int dt = 0; dt < 4; ++dt) vf_[ks][dt] = *(const bf16x8*)(vr + (ks * 4 + dt) * 512);
        };
        auto packstep = [&](PackSt& S, int tq0, int tc, int cb, const bf16x8 (&kf)[4][2], const bf16x8 (&vf)[2][4]) __attribute__((always_inline)) {
            const bool far = (cb + 63 <= tq0 - 128) && (cb >= tq0 + 3 - WIN);
            f32x4 s[4];
#pragma unroll
            for (int kt = 0; kt < 4; ++kt) { s[kt] = mfma16(kf[kt][0], S.q0, (f32x4){0.f, 0.f, 0.f, 0.f}); s[kt] = mfma16(kf[kt][1], S.q1, s[kt]); }
            if (!far) {
#pragma unroll
                for (int kt = 0; kt < 4; ++kt)
#pragma unroll
                    for (int i = 0; i < 4; ++i) { const int dist = tc - (cb + 16 * kt + 4 * G + i); const bool ok = dist >= 0 && dist <= WIN; const int dd = dist < 0 ? 0 : (dist > 128 ? 128 : dist);
                        s[kt][i] = ok ? s[kt][i] + T2[dd * 8 + g * 4 + hh] : -1e30f; }
            }
            finish(S, s, far ? b31 : 0.f, true, vf);
        };
        auto chunkstep = [&](int cb, const bf16x8 (&kf)[4][2], const bf16x8 (&vf)[2][4]) __attribute__((always_inline)) {
            if (cb <= hiA) packstep(A, t0, tcA, cb, kf, vf);
            if (cb + 63 >= loB) packstep(B, t0 + 4, tcB, cb, kf, vf);
        };
        auto ldk = [&](int cb_, bf16x8 (&kf_)[4][2]) __attribute__((always_inline)) {
            const bf16_t* kr = klane + (size_t)cb_ * 64;
#pragma unroll
            for (int kt = 0; kt < 4; ++kt) { kf_[kt][0] = *(const bf16x8*)(kr + (kt * 2) * 512); kf_[kt][1] = *(const bf16x8*)(kr + (kt * 2 + 1) * 512); }
        };
        auto ldv = [&](int cb_, bf16x8 (&vf_)[2][4]) __attribute__((always_inline)) {
            const bf16_t* vr = vlane + (size_t)cb_ * 64;
#pragma unroll
            for (int ks = 0; ks < 2; ++ks)
#pragma unroll
                for (int dt = 0; dt < 4; ++dt) vf_[ks][dt] = *(const bf16x8*)(vr + (ks * 4 + dt) * 512);
        };
        bf16x8 kfA[4][2], kfB[4][2], vf[2][4];
        int cb = loA & ~63;
        ldk(cb, kfA);
#pragma unroll 1
        for (;;) {
            ldv(cb, vf); ldk(cb + 64 <= hiB ? cb + 64 : cb, kfB);
            __builtin_amdgcn_sched_barrier(0);
            chunkstep(cb, kfA, vf);
            cb += 64; if (cb > hiB) break;
            ldv(cb, vf); ldk(cb + 64 <= hiB ? cb + 64 : cb, kfA);
            __builtin_amdgcn_sched_barrier(0);
            chunkstep(cb, kfB, vf);
            cb += 64; if (cb > hiB) break;
        }
        addout(A, qrowA, 2); addout(B, qrowA + 4, 2);
    }
}

__device__ __forceinline__ void phase_attn(const Params& p) {
    const int wid = threadIdx.x >> 6, lane = threadIdx.x & 63;
    { PROBE_BEGIN(3)
    if (blockIdx.x < NS * NG) attn_sample_item(p, blockIdx.x >> 1, blockIdx.x & 1);
    PROBE_END(3) }
    LAS unsigned char* L = (LAS unsigned char*)smem;
    for (int i = threadIdx.x; i < 129 * 8; i += 512) ((LAS float*)(L + A_T2))[i] = p.rel_bias[t5_bucket(i >> 3) * 8 + (i & 7)] * LOG2E;
    __syncthreads();
    {
        const int wid2 = __builtin_amdgcn_readfirstlane(threadIdx.x >> 6);
#pragma unroll 1
        for (;;) {
            __syncthreads();
            if (threadIdx.x == 0) ((LAS int*)(L + A_NP))[1] = (int)__hip_atomic_fetch_add(p.bar, 1u, __ATOMIC_RELAXED, __HIP_MEMORY_SCOPE_AGENT);
            __syncthreads();
            const int T = ((const LAS int*)(L + A_NP))[1];
            if (T >= NB * NG * (SEQ / 64)) break;
            const int bg = T & 7, qb = (SEQ / 64 - 1) - (T >> 3), t0 = qb * 64 + wid2 * 8;
            unsigned mA[4], mB[4];
            PROBE_BEGIN(6)
            attn_cmp(p, bg >> 1, bg & 1, t0, lane, L, mA);
            attn_cmp(p, bg >> 1, bg & 1, t0 + 4, lane, L, mB);
            PROBE_END(6)
            PROBE_BEGIN(7)
            attn_selwin_pair(p, bg >> 1, bg & 1, t0, lane, L, mA, mB);
            PROBE_END(7)
        }
    }
    __syncthreads();
}

constexpr int GM_LD = 136, GM_LDS = 128 * GM_LD * 2 + 1024;
__device__ __forceinline__ void phase_gmlp(const Params& p) {
    int tid = threadIdx.x; asm volatile("" : "+v"(tid));
    const int wid = __builtin_amdgcn_readfirstlane(tid >> 6), lane = tid & 63;
    LAS bf16_t* vnT = (LAS bf16_t*)smem;
    LAS float* mu = (LAS float*)(smem + 128 * GM_LD * 2);
    const int c = lane & 15, G = lane >> 4;
#pragma unroll 1
    for (int u = blockIdx.x; u < NB * 64; u += gridDim.x) {
        const int b = u >> 6, ch = u & 63; const size_t row0 = (size_t)b * SEQ + ch * 128;
        __syncthreads();
        for (int r = wid; r < 128; r += 8) {
            const u32x4 w = *(const u32x4*)(p.Vg + (row0 + r) * GMD + lane * 8);
            const float x[8] = {bflo(w.x), bfhi(w.x), bflo(w.y), bfhi(w.y), bflo(w.z), bfhi(w.z), bflo(w.w), bfhi(w.w)};
            float s = 0.f;
#pragma unroll
            for (int i = 0; i < 8; ++i) s += x[i];
            const float mean = wave_sum(s) * (1.0f / GMD);
            float q = 0.f;
#pragma unroll
            for (int i = 0; i < 8; ++i) q += (x[i] - mean) * (x[i] - mean);
            const float var = wave_sum(q) * (1.0f / GMD);
            if (lane == 0) { mu[r] = mean; mu[128 + r] = rsqrtf(var + EPS); }
        }
#pragma unroll 1
        for (int g = 0; g < 4; ++g) {
            __syncthreads();
#pragma unroll
            for (int k = 0; k < 4; ++k) {
                const int e = tid + 512 * k, s = e & 127, d0 = (e >> 7) * 8;
                const u32x4 w = *(const u32x4*)(p.Vg + (row0 + s) * GMD + g * 128 + d0);
                const float x[8] = {bflo(w.x), bfhi(w.x), bflo(w.y), bfhi(w.y), bflo(w.z), bfhi(w.z), bflo(w.w), bfhi(w.w)};
                const float m = mu[s], rs = mu[128 + s];
#pragma unroll
                for (int i = 0; i < 8; ++i) { const int cc = g * 128 + d0 + i; vnT[(d0 + i) * GM_LD + s] = f2bf((x[i] - m) * rs * p.gm_ln_g[cc] + p.gm_ln_b[cc]); }
            }
            __syncthreads();
            f32x4 acc[8];
#pragma unroll
            for (int dt = 0; dt < 8; ++dt) acc[dt] = (f32x4){0.f, 0.f, 0.f, 0.f};
            const bf16_t* wrow = p.GWb + ((size_t)g * 128 + 16 * wid + c) * 128 + 8 * G;
#pragma unroll 1
            for (int ks = 0; ks <= (wid >> 1); ++ks) {
                const bf16x8 B = *(const bf16x8*)(wrow + 32 * ks);
#pragma unroll
                for (int dt = 0; dt < 8; ++dt) {
                    const bf16x8 A = *(const LAS bf16x8*)(vnT + (dt * 16 + c) * GM_LD + 32 * ks + 8 * G);
                    acc[dt] = mfma16(A, B, acc[dt]);
                }
            }
            const int t = 16 * wid + c;
            const float bs = p.gm_bs[g * 128 + t];
#pragma unroll
            for (int dt = 0; dt < 8; ++dt) {
                const int d = dt * 16 + 4 * G;
                const u32x2 uw = *(const u32x2*)(p.U + (row0 + t) * GMD + g * 128 + d);
                f32x4 o; o[0] = bflo(uw.x) * (acc[dt][0] + bs); o[1] = bfhi(uw.x) * (acc[dt][1] + bs); o[2] = bflo(uw.y) * (acc[dt][2] + bs); o[3] = bfhi(uw.y) * (acc[dt][3] + bs);
                st_bf16x4(p.OCAT + (row0 + t) * DM + QD + g * 128 + d, o);
            }
        }
    }
    for (int it = blockIdx.x * 8 + wid; it < NS; it += gridDim.x * 8) {
        const size_t row = (size_t)MP + it;
        const u32x4 w = *(const u32x4*)(p.Vg + row * GMD + lane * 8);
        const float x[8] = {bflo(w.x), bfhi(w.x), bflo(w.y), bfhi(w.y), bflo(w.z), bfhi(w.z), bflo(w.w), bfhi(w.w)};
        float s = 0.f;
#pragma unroll
        for (int i = 0; i < 8; ++i) s += x[i];
        const float mean = wave_sum(s) * (1.0f / GMD);
        float q = 0.f;
#pragma unroll
        for (int i = 0; i < 8; ++i) q += (x[i] - mean) * (x[i] - mean);
        const float rs = rsqrtf(wave_sum(q) * (1.0f / GMD) + EPS);
#pragma unroll
        for (int i = 0; i < 8; ++i) {
            const int c = lane * 8 + i, g = c >> 7;
            const float v = (x[i] - mean) * rs * p.gm_ln_g[c] + p.gm_ln_b[c];
            p.out[O_GMV + (size_t)it * GMD + c] = v;
            const float a = p.gm_ws[(size_t)g * 128 * 128] * v + p.gm_bs[g * 128];
            p.OCAT[row * DM + QD + c] = f2bf(bf2f(p.U[row * GMD + c]) * a);
        }
    }
}

template <int MODE>
__device__ __forceinline__ void phase_norm(const Params& p) {
    const int wid = threadIdx.x >> 6, lane = threadIdx.x & 63;
    const float* gpost = MODE == 0 ? p.ln_mix_post : MODE == 1 ? p.ln_ffn_post : p.ln_ple_post;
    for (int row = blockIdx.x * 8 + wid; row < MP + NS; row += gridDim.x * 8) {
        const bf16_t* fr = (const bf16_t*)p.F + (size_t)row * DM;
        const bf16_t* xb = MODE == 1 ? (const bf16_t*)p.X1 + (size_t)row * DM : p.X2b + (size_t)row * DM;
        f32x4 f[4], x[4];
#pragma unroll
        for (int k = 0; k < 4; ++k) { const u32x2 w = *(const u32x2*)(fr + lane * 4 + k * 256); f[k][0] = bflo(w.x); f[k][1] = bfhi(w.x); f[k][2] = bflo(w.y); f[k][3] = bfhi(w.y);
            if (MODE == 0) x[k] = *(const f32x4*)(xrow_ptr(p, row) + lane * 4 + k * 256);
            else { const u32x2 v = *(const u32x2*)(xb + lane * 4 + k * 256); x[k][0] = bflo(v.x); x[k][1] = bfhi(v.x); x[k][2] = bflo(v.y); x[k][3] = bfhi(v.y); } }
        const float r = row_rstd(f);
#pragma unroll
        for (int k = 0; k < 4; ++k) { const f32x4 g = *(const f32x4*)(gpost + lane * 4 + k * 256); x[k] = x[k] + f[k] * r * g; }
        if (MODE == 0) {
            const float r2 = row_rstd(x);
#pragma unroll
            for (int k = 0; k < 4; ++k) {
                st_bf16x4((bf16_t*)p.X1 + (size_t)row * DM + lane * 4 + k * 256, x[k]);
                const f32x4 g = *(const f32x4*)(p.ln_ffn_pre + lane * 4 + k * 256); const f32x4 o = x[k] * r2 * g;
                st_bf16x4(p.H2 + (size_t)row * DM + lane * 4 + k * 256, o);
            }
        } else if (MODE == 1) {
#pragma unroll
            for (int k = 0; k < 4; ++k) st_bf16x4(p.X2b + (size_t)row * DM + lane * 4 + k * 256, x[k]);
        } else {
            float* yr = row < MP ? p.out + O_YP + (size_t)row * DM : p.out + O_YS + (size_t)(row - MP) * DM;
#pragma unroll
            for (int k = 0; k < 4; ++k) *(f32x4*)(yr + lane * 4 + k * 256) = x[k];
        }
    }
}


#define XB_TMO      128
#define XB_XCNT(j)  (256  + 64 * (j))
#define XB_XSUB(j)  (1280 + 64 * (j))
#define XB_XGEN(j)  (2304 + 64 * (j))
#define XB_TOP      3328
#define XB_TOPGEN   3392
#define XCD_BAR_WORDS 3456
#define XB_SPIN_CAP (1u << 22)

__device__ __forceinline__ unsigned xb_ld(unsigned* p)              { return __hip_atomic_load(p, __ATOMIC_RELAXED, __HIP_MEMORY_SCOPE_AGENT); }
__device__ __forceinline__ unsigned xb_add(unsigned* p, unsigned v) { return __hip_atomic_fetch_add(p, v, __ATOMIC_RELAXED, __HIP_MEMORY_SCOPE_AGENT); }
__device__ __forceinline__ unsigned xb_xcc_id() { return (unsigned)__builtin_amdgcn_s_getreg((3 << 11) | 20) & 0xFu; }
#define XB_SPIN(cond, bar) do { unsigned _sp = 0; while (cond) { __builtin_amdgcn_s_sleep(1); \
    if ((++_sp & 255u) == 0u) { if (xb_ld(&(bar)[XB_TMO])) break; if (_sp > XB_SPIN_CAP) { atomicAdd(&(bar)[XB_TMO], 1u); break; } } } } while (0)

struct XcdBarrier {
    unsigned* bar; unsigned x;
    volatile LAS unsigned* st;
};

__device__ __forceinline__ XcdBarrier xcd_barrier_post(unsigned* bar, volatile LAS unsigned* st) {
    XcdBarrier b; b.bar = bar; b.x = xb_xcc_id(); b.st = st;
    if (threadIdx.x == 0) (void)xb_add(&bar[XB_XCNT(b.x)], 1u);
    return b;
}
__device__ __forceinline__ void xcd_barrier_complete(unsigned* bar, unsigned x, unsigned& nloc, unsigned& nx) {
    const unsigned G = gridDim.x * gridDim.y * gridDim.z;
    unsigned sum, cnt, mine, sp = 0u;
    for (;;) {
        sum = 0u; cnt = 0u; mine = 0u;
#pragma unroll
        for (unsigned j = 0; j < 16; ++j) { const unsigned c = xb_ld(&bar[XB_XCNT(j)]); sum += c; cnt += (c > 0u) ? 1u : 0u; mine = (j == x) ? c : mine; }
        if (sum == G) break;
        __builtin_amdgcn_s_sleep(1);
        if ((++sp & 255u) == 0u) { if (xb_ld(&bar[XB_TMO])) break; if (sp > XB_SPIN_CAP) { atomicAdd(&bar[XB_TMO], 1u); break; } }
    }
    nloc = mine > 0u ? mine : 1u; nx = cnt > 0u ? cnt : 1u;
}

__device__ __forceinline__ void xcd_barrier(const XcdBarrier& b) {
    asm volatile("s_waitcnt vmcnt(0)" ::: "memory");
    __syncthreads();
    if (threadIdx.x == 0) {
        unsigned* bar = b.bar;
        __builtin_amdgcn_s_waitcnt(0);
        unsigned nloc = b.st[0], nx = b.st[1];
        if (nloc == 0u) { xcd_barrier_complete(bar, b.x, nloc, nx); b.st[0] = nloc; b.st[1] = nx; }
        const unsigned old = xb_add(&bar[XB_XSUB(b.x)], 1u);
        const unsigned gen = old / nloc;
        if (old + 1u == (gen + 1u) * nloc) {
            __builtin_amdgcn_fence(__ATOMIC_RELEASE, "agent");
            asm volatile("s_waitcnt vmcnt(0)" ::: "memory");
            const unsigned og = xb_add(&bar[XB_TOP], 1u);
            const unsigned tg = og / nx;
            if (og + 1u == (tg + 1u) * nx) xb_add(&bar[XB_TOPGEN], 1u);
            else XB_SPIN(xb_ld(&bar[XB_TOPGEN]) == tg, bar);
            __builtin_amdgcn_fence(__ATOMIC_ACQUIRE, "agent");
            xb_add(&bar[XB_XGEN(b.x)], 1u);
            asm volatile("s_waitcnt vmcnt(0)" ::: "memory");
        } else {
            XB_SPIN(xb_ld(&bar[XB_XGEN(b.x)]) == gen, bar);
            __builtin_amdgcn_fence(__ATOMIC_ACQUIRE, "agent");
            asm volatile("s_waitcnt vmcnt(0)" ::: "memory");
        }
    }
    __syncthreads();
}

constexpr int NPHASE = 16;
constexpr int LDS_BYTES = GEMM_LDS;
static_assert(GM_LDS <= LDS_BYTES, "lds");
constexpr int NMT = MALL / BM;

constexpr int NMP = MP / BM;
template <int PH>
__device__ __forceinline__ void run_phase(const Params& p) {
    if (PH == 0) phase_prologue(p);
    if (PH == 1) { EpiIn e{p}; if (blockIdx.x & 1) phase_gather(p); gemm_phase(p.H, DM, p.WinT, DM, NMP, INP / BM, e); gemm_skinny(p.H + (size_t)MP * DM, DM, p.WinT, DM, INP, e); if (!(blockIdx.x & 1)) phase_gather(p); }
    if (PH == 2) { EpiPart e{(bf16_t*)p.PART}; gemm_phase(p.CMPb, 4096, p.W1T, 1024, (2048 + NS * 1024) / BM, 1, e, 4, ZCmp(), 256); phase_deferred_transposes(p); }
    if (PH == 3) phase_cmp_final(p);
    if (PH == 4) phase_attn(p);
    if (PH == 5) phase_gmlp(p);
    if (PH == 6) { EpiBranch e{p.GA, p.GB, p.Y1}; gemm_phase<EpiBranch, ZNone, true>(p.OCAT, DM, p.WnT, DM, NMP, DM / BM, e); gemm_skinny2(p.OCAT + (size_t)MP * DM, DM, p.WnT, DM, DM, e); }
    if (PH == 8) { EpiBf16 e{(bf16_t*)p.F, DM}; gemm_phase(p.Y1, DM, p.WoT, DM, NMP, DM / BM, e); gemm_skinny(p.Y1 + (size_t)MP * DM, DM, p.WoT, DM, DM, e); }
    if (PH == 9) phase_norm<0>(p);
    if (PH == 10) { EpiSwiGLU e{p.ACT}; gemm_phase(p.H2, DM, p.WguT, DM, NMP, 2 * DFF / BM, e); gemm_skinny(p.H2 + (size_t)MP * DM, DM, p.WguT, DM, 2 * DFF, e); }
    if (PH == 11) { EpiBf16 e{(bf16_t*)p.F, DM}; gemm_phase(p.ACT, DFF, p.WdT, DFF, NMP, DM / BM, e); gemm_skinny(p.ACT + (size_t)MP * DFF, DFF, p.WdT, DFF, DM, e); }
    if (PH == 12) phase_norm<1>(p);
    if (PH == 13) { EpiBf16 e{(bf16_t*)p.T, DM}; gemm_phase(p.Pb, PLE, p.WpT, PLE, NMP, DM / BM, e); gemm_skinny(p.Pb + (size_t)MP * PLE, PLE, p.WpT, PLE, DM, e); }
    if (PH == 14) { EpiPleGate e{(const bf16_t*)p.T, (bf16_t*)p.F}; gemm_phase(p.X2b, DM, p.WpgT, DM, NMP, DM / BM, e); gemm_skinny(p.X2b + (size_t)MP * DM, DM, p.WpgT, DM, DM, e); }
    if (PH == 15) phase_norm<2>(p);
}

#ifndef MK_MULTI
#define MK_MULTI 0
#endif
template <int PH>
__global__ void __launch_bounds__(512, 2) k_phase(Params p) { run_phase<PH>(p); }

__global__ void __launch_bounds__(512, 2) k_all(Params p) {
    volatile LAS unsigned* st = (volatile LAS unsigned*)((LAS unsigned char*)smem + LDS_BYTES);
    if (threadIdx.x < 12) st[threadIdx.x] = 0u;
    __syncthreads();
    XcdBarrier bar = xcd_barrier_post(p.bar, st);
#if PROBE_DUP == 100
    run_phase<0>(p);  xcd_barrier(bar);
#endif
#if PROBE_SPIN >= 100
    if (threadIdx.x == 0) PROBE_TS[3] = probe_now();
#define PROBE_STAMP(k) if (threadIdx.x == 0 && PROBE_SEG == (k)) PROBE_TS[2] = probe_now() - PROBE_TS[3];
#else
#define PROBE_STAMP(k)
#endif
    run_phase<0>(p);  xcd_barrier(bar);
    PROBE_STAMP(20)
    run_phase<1>(p);  xcd_barrier(bar);
    PROBE_STAMP(21)
    run_phase<2>(p);  xcd_barrier(bar);
#if PROBE_DUP == 100
    run_phase<3>(p);  xcd_barrier(bar);
#endif
    run_phase<3>(p);  xcd_barrier(bar);
    PROBE_STAMP(23)
#if PROBE_DUP == 104
    run_phase<4>(p);  xcd_barrier(bar);
#endif
    run_phase<4>(p);
#if PROBE_DUP == 100
    run_phase<5>(p);  xcd_barrier(bar);
#endif
    run_phase<5>(p);  xcd_barrier(bar);
    PROBE_STAMP(25)
    run_phase<6>(p);  xcd_barrier(bar);
    run_phase<8>(p);  xcd_barrier(bar);
    PROBE_STAMP(28)
    run_phase<9>(p);  xcd_barrier(bar);
    PROBE_STAMP(29)
    run_phase<10>(p); xcd_barrier(bar);
    PROBE_STAMP(30)
    run_phase<11>(p); xcd_barrier(bar);
    PROBE_STAMP(31)
    run_phase<12>(p);
    run_phase<13>(p); xcd_barrier(bar);
    run_phase<14>(p); xcd_barrier(bar);
    PROBE_STAMP(34)
    run_phase<15>(p);
#if PROBE_SPIN
    if (blockIdx.x == 0 && threadIdx.x == 0) {
        const unsigned long long d = PROBE_TS[2] * (PROBE_SPIN >= 100 ? PROBE_SPIN - 100 : PROBE_SPIN), t0 = probe_now();
        while (probe_now() - t0 < d) __builtin_amdgcn_s_sleep(8);
    }
#endif
}

static inline size_t al256(size_t x) { return (x + 255) & ~(size_t)255; }
template <int PH> static void launch_phase(const Params& p, int grid, hipStream_t s) {
    static bool attr = false;
    if (!attr) { (void)hipFuncSetAttribute((const void*)k_phase<PH>, hipFuncAttributeMaxDynamicSharedMemorySize, LDS_BYTES); attr = true; }
    k_phase<PH><<<grid, 512, LDS_BYTES, s>>>(p);
}
template <int PH> static void launch_all(const Params& p, int grid, hipStream_t s) {
    launch_phase<PH>(p, grid, s);
    if constexpr (PH + 1 < NPHASE) launch_all<PH + 1>(p, grid, s);
}

extern "C" void kernel_launch(void* const* d_in, const int* in_sizes, int n_in, void* d_out, int out_size, void* d_ws, size_t ws_size, hipStream_t stream) {
    Params p{};
    p.x_prompt = (const float*)d_in[0]; p.x_sample = (const float*)d_in[1]; p.cache_cmp = (const float*)d_in[2]; p.cache_slc = (const float*)d_in[3];
    p.state_win = (const float*)d_in[4]; p.page_table = (const int*)d_in[5]; p.p_prompt = (const float*)d_in[6]; p.p_sample = (const float*)d_in[7];
    p.rel_bias = (const float*)d_in[8]; p.ln_mix_pre = (const float*)d_in[9]; p.w_in = (const float*)d_in[10];
    p.pe_k = (const float*)d_in[11]; p.w1_k = (const float*)d_in[12]; p.w2_k = (const float*)d_in[13];
    p.pe_v = (const float*)d_in[14]; p.w1_v = (const float*)d_in[15]; p.w2_v = (const float*)d_in[16];
    p.gm_ln_g = (const float*)d_in[17]; p.gm_ln_b = (const float*)d_in[18]; p.gm_ws = (const float*)d_in[19]; p.gm_bs = (const float*)d_in[20];
    p.w_br_nsa = (const float*)d_in[21]; p.w_br_gm = (const float*)d_in[22]; p.w_out = (const float*)d_in[23];
    p.ln_mix_post = (const float*)d_in[24]; p.ln_ffn_pre = (const float*)d_in[25]; p.w_gate = (const float*)d_in[26]; p.w_up = (const float*)d_in[27];
    p.w_down = (const float*)d_in[28]; p.ln_ffn_post = (const float*)d_in[29]; p.w_ple = (const float*)d_in[30]; p.w_ple_gate = (const float*)d_in[31];
    p.ln_ple_post = (const float*)d_in[32];
    p.out = (float*)d_out;
    unsigned char* w = (unsigned char*)d_ws; size_t off = 0;
    auto take = [&](size_t bytes) { void* r = w + off; off = al256(off + bytes); return r; };
    p.bar = (unsigned*)take(16384);
    p.WinT = (bf16_t*)take((size_t)INP * DM * 2); p.WnT = (bf16_t*)take((size_t)DM * DM * 2); p.WgT = nullptr;
    p.WoT = (bf16_t*)take((size_t)DM * DM * 2); p.WguT = (bf16_t*)take((size_t)2 * DFF * DM * 2); p.WdT = (bf16_t*)take((size_t)DM * DFF * 2);
    p.WpgT = (bf16_t*)take((size_t)DM * DM * 2); p.WpT = (bf16_t*)take((size_t)DM * PLE * 2); p.W1T = (bf16_t*)take((size_t)2 * 256 * 1024 * 2);
    p.H = (bf16_t*)take((size_t)MALL * DM * 2); p.Qb = (bf16_t*)take((size_t)MALL * QD * 2);
    p.CMPb = (bf16_t*)take(((size_t)MP + (size_t)NS * PAST) * 256 * 2); p.SLCb = (bf16_t*)take((size_t)MALL * 256 * 2); p.WINb = (bf16_t*)take((size_t)MALL * 256 * 2);
    p.U = (bf16_t*)take((size_t)MALL * GMD * 2); p.Vg = (bf16_t*)take((size_t)MALL * GMD * 2);
    p.GA = (bf16_t*)take((size_t)MALL * DM * 2); p.GB = (bf16_t*)take((size_t)MALL * DM * 2);
    p.GATE = (float*)take((size_t)MALL * 32 * 4);
    p.PART = (float*)take((size_t)(2048 + NS * 1024) * 4 * 256 * 4); p.PEB = (float*)take(256 * 4);
    p.KCP = (float*)take((size_t)NB * NG * 512 * 64 * 4); p.VCP = (float*)take((size_t)NB * NG * 512 * 64 * 4);
    p.KCS = (float*)take((size_t)NS * NG * 1024 * 64 * 4); p.VCS = (float*)take((size_t)NS * NG * 1024 * 64 * 4); p.KN = (float*)take(NB * NG * 128 * 4);
    p.KCb = (bf16_t*)take((size_t)NB * NG * 512 * 64 * 2); p.VCT = (bf16_t*)take((size_t)NB * NG * 64 * 512 * 2);
    p.SLCvT = (bf16_t*)take((size_t)NB * NG * 64 * SEQ * 2); p.WINvT = (bf16_t*)take((size_t)NB * NG * 64 * SEQ * 2);
    p.GWb = (bf16_t*)take(4 * 128 * 128 * 2); p.W2T = (bf16_t*)take(2 * 64 * 128 * 2);
    p.SLCkF = (bf16_t*)take((size_t)NB * NG * 64 * SEQ * 2); p.WINkF = (bf16_t*)take((size_t)NB * NG * 64 * SEQ * 2);
    p.OCAT = (bf16_t*)take((size_t)MALL * DM * 2); p.T = (float*)take((size_t)MALL * DM * 4); p.Y1 = (bf16_t*)take((size_t)MALL * DM * 2);
    p.F = (float*)take((size_t)MALL * DM * 4); p.X1 = (float*)take((size_t)MALL * DM * 4); p.H2 = (bf16_t*)take((size_t)MALL * DM * 2);
    p.ACT = (bf16_t*)take((size_t)MALL * DFF * 2); p.X2 = (float*)take((size_t)MALL * DM * 4); p.X2b = (bf16_t*)take((size_t)MALL * DM * 2);
    p.Pb = (bf16_t*)take((size_t)MALL * PLE * 2);
    if (off > ws_size) { fprintf(stderr, "workspace too small: need %zu have %zu\n", off, ws_size); return; }
#if MK_MULTI
    launch_all<0>(p, 256, stream);
#else
    constexpr size_t kDynLds = LDS_BYTES + 48;
    static int grid = 0;
    if (!grid) {
        int dev = 0, cus = 0, per_cu = 0;
        (void)hipGetDevice(&dev);
        (void)hipDeviceGetAttribute(&cus, hipDeviceAttributeMultiprocessorCount, dev);
        (void)hipFuncSetAttribute((const void*)k_all, hipFuncAttributeMaxDynamicSharedMemorySize, (int)kDynLds);
        (void)hipOccupancyMaxActiveBlocksPerMultiprocessor(&per_cu, (const void*)k_all, 512, kDynLds);
        grid = cus * (per_cu < 1 ? per_cu : 1);
        if (grid <= 0) { fprintf(stderr, "k_all: occupancy query says %d blocks per CU\n", per_cu); grid = 0; return; }
    }
    (void)hipMemsetAsync(p.bar, 0, XCD_BAR_WORDS * sizeof(unsigned), stream);
    k_all<<<grid, 512, kDynLds, stream>>>(p);
#endif
}
```

```cpp
#include <hip/hip_runtime.h>
#include <stdint.h>
#include <cstdio>

typedef unsigned short bf16_t;
typedef short bf16x8 __attribute__((ext_vector_type(8)));
typedef float f32x4 __attribute__((ext_vector_type(4)));
typedef float f32x2 __attribute__((ext_vector_type(2)));
typedef unsigned u32x4 __attribute__((ext_vector_type(4)));
typedef unsigned u32x2 __attribute__((ext_vector_type(2)));
#define LAS __attribute__((address_space(3)))

constexpr int DM = 1024, NB = 4, SEQ = 8192, MP = NB * SEQ, NS = 32, MALL = MP + 256, PAST = 16384, PAGE = 128, NPG = 128;
constexpr int NH = 8, NG = 2, HPG = 4, DH = 64, QD = 512, WIN = 512, GMD = 512, DFF = 2816, PLE = 256, IND = 4376, INP = 4608;
constexpr int NCP = 511, NCS = 1023;
constexpr float EPS = 1e-6f;
constexpr float LOG2E = 1.4426950408889634f, QSCALE = 0.125f * LOG2E;
constexpr long O_YP = 0, O_YS = 33554432, O_CMPP = 33587200, O_SLCP = 41975808, O_WINP = 50364416, O_CMPS = 50888704,
               O_SLCS = 50896896, O_WINS = 50905088, O_GMV = 55099392;

struct Params {
    const float *x_prompt, *x_sample, *cache_cmp, *cache_slc, *state_win; const int* page_table;
    const float *p_prompt, *p_sample, *rel_bias, *ln_mix_pre, *w_in, *pe_k, *w1_k, *w2_k, *pe_v, *w1_v, *w2_v;
    const float *gm_ln_g, *gm_ln_b, *gm_ws, *gm_bs, *w_br_nsa, *w_br_gm, *w_out, *ln_mix_post, *ln_ffn_pre;
    const float *w_gate, *w_up, *w_down, *ln_ffn_post, *w_ple, *w_ple_gate, *ln_ple_post;
    float* out;
    unsigned* bar;
    bf16_t *WinT, *WnT, *WgT, *WoT, *WguT, *WdT, *WpgT, *WpT, *W1T;
    bf16_t *H, *Qb, *CMPb, *SLCb, *WINb, *U, *Vg, *GA, *GB;
    float* GATE;
    float *PART, *PEB, *KCP, *VCP, *KCS, *VCS, *KN;
    bf16_t *KCb, *VCT, *SLCvT, *WINvT, *SLCkF, *WINkF, *GWb, *W2T;
    bf16_t* OCAT; float* T; bf16_t* Y1; float* F; float* X1; bf16_t* H2; bf16_t* ACT; float* X2; bf16_t* X2b; bf16_t* Pb;
};

__device__ __forceinline__ unsigned cvt_pk_bf16(float lo, float hi) { unsigned r; asm volatile("v_cvt_pk_bf16_f32 %0, %1, %2" : "=v"(r) : "v"(lo), "v"(hi)); return r; }
__device__ __forceinline__ unsigned cvt_pk_bf16_t(float lo, float hi) { unsigned r; asm volatile("s_nop 1\n\tv_cvt_pk_bf16_f32 %0, %1, %2" : "=v"(r) : "v"(lo), "v"(hi)); return r; }
__device__ __forceinline__ bf16_t f2bf(float f) { return (bf16_t)(cvt_pk_bf16(f, 0.f) & 0xffffu); }
__device__ __forceinline__ float bf2f(bf16_t h) { return __uint_as_float(((unsigned)h) << 16); }
__device__ __forceinline__ float bflo(unsigned w) { return __uint_as_float(w << 16); }
__device__ __forceinline__ float bfhi(unsigned w) { return __uint_as_float(w & 0xffff0000u); }
__device__ __forceinline__ float ex2(float x) { return __builtin_amdgcn_exp2f(x); }
__device__ __forceinline__ float sigmoidf_(float x) { return 1.0f / (1.0f + __expf(-x)); }
__device__ __forceinline__ float siluf_(float x) { return x * sigmoidf_(x); }
__device__ __forceinline__ float sigmoid_fast(float x) { return __builtin_amdgcn_rcpf(1.0f + __builtin_amdgcn_exp2f(x * -1.4426950408889634f)); }
__device__ __forceinline__ float gelu_fast(float x) {
    const float t = x * (-2.0f * 0.7978845608028654f * 1.4426950408889634f) * (1.0f + 0.044715f * x * x);
    return x * __builtin_amdgcn_rcpf(1.0f + __builtin_amdgcn_exp2f(t));
}
__device__ __forceinline__ float silu_fast(float x) { return x * __builtin_amdgcn_rcpf(1.0f + __builtin_amdgcn_exp2f(x * -1.4426950408889634f)); }
__device__ __forceinline__ float geluf_(float x) {
    const float u = 0.7978845608028654f * (x + 0.044715f * x * x * x);
    const float e = __expf(2.0f * u);
    const float th = 1.0f - 2.0f / (e + 1.0f);
    return 0.5f * x * (1.0f + th);
}
__device__ __forceinline__ float wave_sum(float v) {
#pragma unroll
    for (int o = 32; o > 0; o >>= 1) v += __shfl_xor(v, o);
    return v;
}
__device__ __forceinline__ float wave_max(float v) {
#pragma unroll
    for (int o = 32; o > 0; o >>= 1) v = fmaxf(v, __shfl_xor(v, o));
    return v;
}
__device__ __forceinline__ int t5_bucket(int d) {
    if (d < 16) return d;
    if (d >= 128) return 31;
    const int b = 16 + (int)(__logf((float)d * (1.0f / 16.0f)) * (16.0f / 2.0794415416798357f));
    return b < 31 ? b : 31;
}

extern __shared__ __attribute__((aligned(16))) unsigned char smem[];
#ifndef PROBE_DUP
#define PROBE_DUP 0
#endif
#define PROBE_LDS_OFF 131072
#ifndef PROBE_SPIN
#define PROBE_SPIN 0
#endif
#ifndef PROBE_SEG
#define PROBE_SEG 5
#endif
__device__ __forceinline__ unsigned long long probe_now() { unsigned long long t; asm volatile("s_memrealtime %0\n\ts_waitcnt lgkmcnt(0)" : "=s"(t) :: "memory"); return t; }
#define PROBE_TS ((volatile LAS unsigned long long*)((LAS unsigned char*)smem + PROBE_LDS_OFF + 16))
#if PROBE_SPIN
#define PROBE_BEGIN(seg) unsigned long long pb_##seg = 0; if (PROBE_SEG == seg && threadIdx.x == 0) pb_##seg = probe_now();
#define PROBE_END(seg) if (PROBE_SEG == seg && threadIdx.x == 0) { PROBE_TS[2] = PROBE_TS[2] + (probe_now() - pb_##seg); }
#else
#define PROBE_BEGIN(seg)
#define PROBE_END(seg)
#endif

constexpr int BM = 256, BK = 64, HALF = 128, HT = HALF * BK, GEMM_LDS = 8 * HT * 2;
__device__ __forceinline__ int lds_byte(int r, int c) { const int st = (r >> 4) * 2 + (c >> 5), rr = r & 15, cc = c & 31, ob = rr * 64 + cc * 2; return st * 1024 + (ob ^ (((ob >> 9) & 1) << 5)); }
__device__ __forceinline__ void stage_rc(int b, int& R, int& C) { const int st = b / 1024, sb = b % 1024, swz = sb ^ (((sb >> 9) & 1) << 5); R = (st >> 1) * 16 + swz / 64; C = (st & 1) * 32 + (swz % 64) / 2; }

constexpr int HTB = HALF * BK * 2;
template <class F>
__device__ __forceinline__ void for_each_frag(const f32x4 (&acc)[2][2][4][2], int brow, int bcol, int wr, int wc, int fr, int fq, F&& f) {
#pragma unroll
    for (int ai = 0; ai < 2; ++ai)
#pragma unroll
        for (int m = 0; m < 4; ++m)
#pragma unroll
            for (int bj = 0; bj < 2; ++bj)
#pragma unroll
                for (int n = 0; n < 2; ++n)
                    f(brow + ai * HALF + wr * 64 + m * 16 + fr, bcol + bj * HALF + wc * 32 + n * 16 + fq * 4, acc[ai][bj][m][n]);
}

__host__ __device__ __forceinline__ int inv_a(int ca) { return ((ca >> 5) & 1) * 128 + (ca >> 6) * 32 + ((ca >> 2) & 1) * 16 + ((ca >> 3) & 3) * 4 + (ca & 3); }
__host__ __device__ __forceinline__ int row_a(int n) { return (n & ~255) + inv_a(n & 255); }
__host__ __device__ __forceinline__ int inv_s(int o, int s) { return ((o >> 2) & 1) * 128 + (o >> 5) * 32 + ((o >> 1) & 1) * 16 + ((o >> 3) & 3) * 4 + (o & 1) * 2 + s; }
__host__ __device__ __forceinline__ int row_s(int n, int s) { return (n >> 7) * 256 + inv_s(n & 127, s); }
__host__ __device__ __forceinline__ int lcol_a(int r) { const int cg = r & 255; return (r & ~255) + ((cg >> 5) & 3) * 64 + (cg >> 7) * 32 + ((cg >> 2) & 3) * 8 + ((cg >> 4) & 1) * 4; }
__host__ __device__ __forceinline__ int lcol_s(int r) { const int cg = r & 255; return (r & ~255) + 2 * (((cg >> 5) & 3) * 32 + ((cg >> 2) & 3) * 8 + (cg >> 7) * 4 + ((cg >> 4) & 1) * 2); }
template <class F>
__device__ __forceinline__ void for_each_frag8(const f32x4 (&acc)[2][2][4][2], int brow, int bcol, int wr, int wc, int fr, int fq, F&& f) {
#pragma unroll
    for (int ai = 0; ai < 2; ++ai)
#pragma unroll
        for (int m = 0; m < 4; ++m)
#pragma unroll
            for (int bj = 0; bj < 2; ++bj)
                f(brow + ai * HALF + wr * 64 + m * 16 + fr, bcol + wc * 64 + bj * 32 + fq * 8, acc[ai][bj][m][0], acc[ai][bj][m][1]);
}

struct ZNone { __device__ __forceinline__ size_t a(int) const { return 0; } __device__ __forceinline__ size_t b(int) const { return 0; } };
template <class Epi, class ZMap = ZNone, bool HAS_MID = false>
__device__ __forceinline__ void gemm_phase(const bf16_t* A, int lda, const bf16_t* Bt, int K, int nM, int nN, const Epi& E, int nZ = 1, ZMap zm = ZMap(), int kstepA_el = BK) {
    LAS unsigned char* lds = (LAS unsigned char*)smem;
    int tid = threadIdx.x; asm volatile("" : "+v"(tid));
    const int wid = __builtin_amdgcn_readfirstlane(tid >> 6), lane = tid & 63, wr = wid >> 2, wc = wid & 3, fr = lane & 15, fq = lane >> 4;
    const int nt = K / BK, nmn = nM * nN, nu = nmn * nZ, G = gridDim.x;
    int u = blockIdx.x;
    if (u >= nu) return;
    unsigned voffA[2], voffB[2];
#pragma unroll
    for (int i = 0; i < 2; ++i) { int R, C; stage_rc(tid * 16 + i * 8192, R, C); voffA[i] = (unsigned)(R * lda + C) * 2u; voffB[i] = (unsigned)(R * K + C) * 2u; }
    const size_t kstep = (size_t)(BK * 2), kstepA = (size_t)kstepA_el * 2;
    const size_t hstepA = (size_t)HALF * lda * 2, hstepB = (size_t)HALF * K * 2, tstepA = 2 * hstepA, tstepB = 2 * hstepB;
    const unsigned ldsw = (unsigned)wid * 1024u;
    const int aoff = lds_byte(wr * 64 + fr, fq * 8), boff = lds_byte(wc * 32 + fr, fq * 8);
#define PG8_SA(b, h) (((b) * 2 + (h)) * HTB)
#define PG8_SB(b, h) ((4 + (b) * 2 + (h)) * HTB)
#define PG8_STAGE(bufoff, gbase, voff) do { _Pragma("unroll") for (int _i = 0; _i < 2; ++_i) \
        __builtin_amdgcn_global_load_lds((const unsigned*)((const char*)(gbase) + (voff)[_i]), (LAS unsigned*)(lds + (bufoff) + ldsw + _i * 8192), 16, 0, 0); } while (0)
#define PG8_LDA(dst, b, h) do { _Pragma("unroll") for (int m = 0; m < 4; ++m) _Pragma("unroll") for (int k = 0; k < 2; ++k) dst[m][k] = *(const LAS bf16x8*)(lds + PG8_SA(b, h) + aoff + m * 2048 + k * 1024); } while (0)
#define PG8_LDB(dst, b, h) do { _Pragma("unroll") for (int n = 0; n < 2; ++n) _Pragma("unroll") for (int k = 0; k < 2; ++k) dst[n][k] = *(const LAS bf16x8*)(lds + PG8_SB(b, h) + boff + n * 2048 + k * 1024); } while (0)
#define PG8_MMA(ai, bj, At, Bt_) do { __builtin_amdgcn_s_setprio(1); _Pragma("unroll") for (int m = 0; m < 4; ++m) _Pragma("unroll") for (int n = 0; n < 2; ++n) _Pragma("unroll") for (int k = 0; k < 2; ++k) \
        acc[ai][bj][m][n] = __builtin_amdgcn_mfma_f32_16x16x32_bf16(Bt_[n][k], At[m][k], acc[ai][bj][m][n], 0, 0, 0); __builtin_amdgcn_s_setprio(0); } while (0)
#define PG8_WAIT_V(n) asm volatile("s_waitcnt vmcnt(" #n ")" ::: "memory")
#define PG8_WAIT_L(n) asm volatile("s_waitcnt lgkmcnt(" #n ")" ::: "memory")
#define PG8_BAR __builtin_amdgcn_s_barrier()
#define PG8_SCHED __builtin_amdgcn_sched_barrier(0)
    f32x4 acc[2][2][4][2];
#pragma unroll
    for (int a = 0; a < 2; ++a)
#pragma unroll
        for (int b = 0; b < 2; ++b)
#pragma unroll
            for (int m = 0; m < 4; ++m)
#pragma unroll
                for (int n = 0; n < 2; ++n) acc[a][b][m][n] = (f32x4){0.f, 0.f, 0.f, 0.f};
    bf16x8 At[4][2], B0[2][2], B1[2][2];
    auto unit_of = [&](int uu, int& z_, int& pm_, int& pn_) {
        if (nZ == 1) {
            int wg = uu; { const int q = nu / 8, r = nu % 8, xcd = wg % 8, off = wg / 8; wg = (xcd < r ? xcd * (q + 1) : r * (q + 1) + (xcd - r) * q) + off; }
            const int nig = 8 * nN, gid = wg / nig, fm = gid * 8, gsz = (nM - fm) < 8 ? (nM - fm) : 8;
            z_ = 0; pm_ = fm + ((wg % nig) % gsz); pn_ = (wg % nig) / gsz;
        } else { z_ = uu / nmn; pm_ = (uu - z_ * nmn) / nN; pn_ = (uu - z_ * nmn) - pm_ * nN; }
    };
    int z, pm, pn; unit_of(u, z, pm, pn);
    const char* cA = (const char*)(A + zm.a(z)) + (size_t)pm * tstepA; const char* cB = (const char*)(Bt + zm.b(z)) + (size_t)pn * tstepB;
    PG8_STAGE(PG8_SB(0, 0), cB, voffB); PG8_STAGE(PG8_SA(0, 0), cA, voffA); PG8_STAGE(PG8_SB(0, 1), cB + hstepB, voffB); PG8_STAGE(PG8_SA(0, 1), cA + hstepA, voffA);
    if (wr == 1) PG8_BAR;
    PG8_WAIT_V(4); PG8_BAR;
    PG8_STAGE(PG8_SB(1, 0), cB + kstep, voffB); PG8_STAGE(PG8_SA(1, 0), cA + kstepA, voffA); PG8_STAGE(PG8_SB(1, 1), cB + hstepB + kstep, voffB);
    PG8_WAIT_V(6); PG8_BAR;
    for (;;) {
        const int un = u + G; const bool has_next = un < nu;
        int nz = z, npm = pm, npn = pn; if (has_next) unit_of(un, nz, npm, npn);
        const char* nA = (const char*)(A + zm.a(nz)) + (size_t)npm * tstepA; const char* nB = (const char*)(Bt + zm.b(nz)) + (size_t)npn * tstepB;
        auto kiter = [&](int t) {
            const bool last = (t == nt - 2);
            const bool bnd = last || (HAS_MID && t == (nt >> 1) - 2);
            const char* a1 = cA + (size_t)(t + 1) * kstepA;
            const char* a2 = last ? nA : cA + (size_t)(t + 2) * kstepA; const char* b2 = last ? nB : cB + (size_t)(t + 2) * kstep;
            const char* a3 = a2 + kstepA; const char* b3 = b2 + kstep;
            PG8_LDB(B0, 0, 0); PG8_SCHED; PG8_LDA(At, 0, 0); PG8_STAGE(PG8_SA(1, 1), a1 + hstepA, voffA);
            PG8_WAIT_L(8); PG8_BAR; PG8_WAIT_L(0); PG8_MMA(0, 0, At, B0); PG8_BAR; PG8_SCHED;
            PG8_LDB(B1, 0, 1); PG8_STAGE(PG8_SB(0, 0), b2, voffB);
            PG8_BAR; PG8_WAIT_L(0); PG8_MMA(0, 1, At, B1); PG8_BAR;
            PG8_LDA(At, 0, 1); PG8_STAGE(PG8_SA(0, 0), a2, voffA);
            PG8_BAR; PG8_WAIT_L(0); PG8_MMA(1, 0, At, B0); PG8_BAR; PG8_SCHED;
            PG8_STAGE(PG8_SB(0, 1), b2 + hstepB, voffB);
            PG8_WAIT_V(6); PG8_BAR; PG8_MMA(1, 1, At, B1); PG8_BAR;
            PG8_LDB(B0, 1, 0); PG8_SCHED; PG8_LDA(At, 1, 0); PG8_STAGE(PG8_SA(0, 1), a2 + hstepA, voffA);
            PG8_WAIT_L(8); PG8_BAR; PG8_WAIT_L(0); PG8_MMA(0, 0, At, B0); PG8_BAR; PG8_SCHED;
            PG8_LDB(B1, 1, 1); PG8_STAGE(PG8_SB(1, 0), b3, voffB);
            PG8_BAR; PG8_WAIT_L(0); PG8_MMA(0, 1, At, B1); PG8_BAR;
            PG8_LDA(At, 1, 1); PG8_STAGE(PG8_SA(1, 0), a3, voffA);
            PG8_BAR; PG8_WAIT_L(0); PG8_MMA(1, 0, At, B0); PG8_BAR; PG8_SCHED;
            PG8_STAGE(PG8_SB(1, 1), b3 + hstepB, voffB);
            PG8_WAIT_V(6); PG8_BAR; PG8_MMA(1, 1, At, B1);
            if (!(bnd && wr == 1)) PG8_BAR;
        };
        if constexpr (HAS_MID) {
            for (int t = 0; t < (nt >> 1); t += 2) kiter(t);
            { int pmo = pm, pno = pn; asm volatile("" : "+s"(pmo), "+s"(pno));
              E.mid(acc, pmo * BM, pno * BM, wr, wc, fr, fq); }
            PG8_SCHED; PG8_BAR; if (wr == 1) PG8_BAR;
            for (int t = nt >> 1; t < nt; t += 2) kiter(t);
        } else {
            for (int t = 0; t < nt; t += 2) kiter(t);
        }
        { int pmo = pm, pno = pn; asm volatile("" : "+s"(pmo), "+s"(pno));
          E(acc, pmo * BM, pno * BM + (z << 20), wr, wc, fr, fq); }
        PG8_SCHED; PG8_BAR;
        if (!has_next) break;
        if (wr == 1) PG8_BAR;
#pragma unroll
        for (int a = 0; a < 2; ++a)
#pragma unroll
            for (int b = 0; b < 2; ++b)
#pragma unroll
                for (int m = 0; m < 4; ++m)
#pragma unroll
                    for (int n = 0; n < 2; ++n) acc[a][b][m][n] = (f32x4){0.f, 0.f, 0.f, 0.f};
        u = un; z = nz; pm = npm; pn = npn; cA = nA; cB = nB;
    }
    PG8_WAIT_V(0);
    PG8_BAR;
#undef PG8_SA
#undef PG8_SB
#undef PG8_STAGE
#undef PG8_LDA
#undef PG8_LDB
#undef PG8_MMA
#undef PG8_WAIT_V
#undef PG8_WAIT_L
#undef PG8_BAR
#undef PG8_SCHED
}

__device__ __forceinline__ f32x4 mfma16(bf16x8 a, bf16x8 b, f32x4 c) { return __builtin_amdgcn_mfma_f32_16x16x32_bf16(a, b, c, 0, 0, 0); }
__device__ __forceinline__ bf16x8 pack_p(const f32x4& a, const f32x4& b) {
    u32x4 w; w.x = cvt_pk_bf16(a[0], a[1]); w.y = cvt_pk_bf16(a[2], a[3]); w.z = cvt_pk_bf16(b[0], b[1]); w.w = cvt_pk_bf16(b[2], b[3]);
    return __builtin_bit_cast(bf16x8, w);
}
__device__ __forceinline__ size_t kfrag_off(int key, int d) { return ((size_t)((key >> 4) * 2 + (d >> 5)) * 64 + ((d >> 3) & 3) * 16 + (key & 15)) * 8 + (d & 7); }
__device__ __forceinline__ size_t vfrag_off(int key, int d) {
    return ((size_t)((key >> 5) * 4 + (d >> 4)) * 64 + ((key >> 2) & 3) * 16 + (d & 15)) * 8 + ((key >> 4) & 1) * 4 + (key & 3);
}
__device__ __forceinline__ void st_bf16x4(bf16_t* p, f32x4 v) { u32x2 w; w.x = cvt_pk_bf16(v[0], v[1]); w.y = cvt_pk_bf16(v[2], v[3]); *(u32x2*)p = w; }
__device__ __forceinline__ void st_bf16x8(bf16_t* p, f32x4 a, f32x4 b) { u32x4 w; w.x = cvt_pk_bf16(a[0], a[1]); w.y = cvt_pk_bf16(a[2], a[3]); w.z = cvt_pk_bf16(b[0], b[1]); w.w = cvt_pk_bf16(b[2], b[3]); *(u32x4*)p = w; }
__device__ __forceinline__ void st_bf16x8_t(bf16_t* p, f32x4 a, f32x4 b) { u32x4 w; w.x = cvt_pk_bf16_t(a[0], a[1]); w.y = cvt_pk_bf16_t(a[2], a[3]); w.z = cvt_pk_bf16_t(b[0], b[1]); w.w = cvt_pk_bf16_t(b[2], b[3]); *(u32x4*)p = w; }
__device__ __forceinline__ void st_bf16x4_t(bf16_t* p, f32x4 v) { u32x2 w; w.x = cvt_pk_bf16_t(v[0], v[1]); w.y = cvt_pk_bf16_t(v[2], v[3]); *(u32x2*)p = w; }
__device__ __forceinline__ bool win_tile_a(int pn) { return pn < 2 || (pn >= 5 && pn < 17); }

struct EpiIn {
    const Params& p;
    __device__ __forceinline__ void apply(int row, int col, f32x4 v) const {
        const Params& P = p; const int pn = col >> 8, c = col & 255;
        if (pn < 2) st_bf16x4(P.Qb + (size_t)row * QD + col, v * QSCALE);
        else if (pn < 5) {
            if (pn != 2) st_bf16x4((pn == 3 ? P.SLCb : P.WINb) + (size_t)row * 256 + c, v);
            if (pn < 4) *(f32x4*)(P.out + (pn == 2 ? O_CMPS : O_SLCS) + (size_t)(row - MP) * 256 + c) = v;
            else *(f32x4*)(P.out + O_WINS + ((size_t)(row - MP) * WIN + (WIN - 1)) * 256 + c) = v;
        } else if (pn < 9) {
            f32x4 g; g[0] = gelu_fast(v[0]); g[1] = gelu_fast(v[1]); g[2] = gelu_fast(v[2]); g[3] = gelu_fast(v[3]);
            st_bf16x4((pn < 7 ? P.U : P.Vg) + (size_t)row * GMD + (col - (pn < 7 ? 1280 : 1792)), g);
        } else if (pn < 17) {
            f32x4 g; g[0] = sigmoid_fast(v[0]); g[1] = sigmoid_fast(v[1]); g[2] = sigmoid_fast(v[2]); g[3] = sigmoid_fast(v[3]);
            st_bf16x4_t((pn < 13 ? P.GA : P.GB) + (size_t)row * DM + (col - (pn < 13 ? 2304 : 3328)), g);
        } else if (c < 24) { f32x4 g; g[0] = sigmoid_fast(v[0]); g[1] = sigmoid_fast(v[1]); g[2] = sigmoid_fast(v[2]); g[3] = sigmoid_fast(v[3]); *(f32x4*)(P.GATE + (size_t)row * 32 + c) = g; }
    }
    __device__ __forceinline__ int lcol(int r) const { return win_tile_a(r >> 8) ? lcol_a(r) : r; }
    __device__ __forceinline__ void operator()(const f32x4 (&acc)[2][2][4][2], int brow, int bcol, int wr, int wc, int fr, int fq) const {
        const int pn = bcol >> 8;
        const Params& P = p;
        if (pn < 2) {
            for_each_frag8(acc, brow, bcol, wr, wc, fr, fq, [&](int row, int col, f32x4 a, f32x4 b) { st_bf16x8(P.Qb + (size_t)row * QD + col, a * QSCALE, b * QSCALE); });
        } else if (pn < 5) {
            bf16_t* cp = pn == 2 ? P.CMPb : pn == 3 ? P.SLCb : P.WINb;
            for_each_frag(acc, brow, bcol, wr, wc, fr, fq, [&](int row, int col, f32x4 v) {
                const int c = col & 255;
                if (pn == 2) st_bf16x4(cp + (size_t)row * 256 + c, v);
                if (pn >= 3 && c < 128 && row < MP) {
                    st_bf16x4((pn == 3 ? P.SLCkF : P.WINkF) + ((size_t)(row >> 13) * NG + (c >> 6)) * SEQ * 64 + kfrag_off(row & (SEQ - 1), c & 63), v);
                }
                if (pn >= 3 && c >= 128 && row < MP) {
                    const int t = row & (SEQ - 1), dc = c - 128;
                    bf16_t* vt = (pn == 3 ? P.SLCvT : P.WINvT) + ((size_t)(row >> 13) * NG + (dc >> 6)) * SEQ * 64 + vfrag_off(t, dc & 63);
                    vt[0] = f2bf(v[0]); vt[8] = f2bf(v[1]); vt[16] = f2bf(v[2]); vt[24] = f2bf(v[3]);
                }
                if (pn < 4) {
                    if (row < MP) *(f32x4*)(P.out + (pn == 2 ? O_CMPP : O_SLCP) + (size_t)row * 256 + c) = v;
                    else if (row < MP + NS) *(f32x4*)(P.out + (pn == 2 ? O_CMPS : O_SLCS) + (size_t)(row - MP) * 256 + c) = v;
                } else {
                    if (row < MP) { const int t = row & (SEQ - 1), b = row >> 13; if (t >= SEQ - WIN) *(f32x4*)(P.out + O_WINP + ((size_t)b * WIN + (t - (SEQ - WIN))) * 256 + c) = v; }
                    else if (row < MP + NS) *(f32x4*)(P.out + O_WINS + ((size_t)(row - MP) * WIN + (WIN - 1)) * 256 + c) = v;
                }
            });
        } else if (pn < 9) {
            bf16_t* dst = pn < 7 ? P.U : P.Vg; const int c0 = pn < 7 ? 1280 : 1792;
            for_each_frag8(acc, brow, bcol, wr, wc, fr, fq, [&](int row, int col, f32x4 a, f32x4 b) {
                f32x4 g, h; g[0] = gelu_fast(a[0]); g[1] = gelu_fast(a[1]); g[2] = gelu_fast(a[2]); g[3] = gelu_fast(a[3]); h[0] = gelu_fast(b[0]); h[1] = gelu_fast(b[1]); h[2] = gelu_fast(b[2]); h[3] = gelu_fast(b[3]);
                st_bf16x8(dst + (size_t)row * GMD + (col - c0), g, h); });
        } else if (pn < 17) {
            bf16_t* dst = pn < 13 ? P.GA : P.GB; const int c0 = pn < 13 ? 2304 : 3328;
            for_each_frag8(acc, brow, bcol, wr, wc, fr, fq, [&](int row, int col, f32x4 a, f32x4 b) {
                f32x4 g, h; g[0] = sigmoid_fast(a[0]); g[1] = sigmoid_fast(a[1]); g[2] = sigmoid_fast(a[2]); g[3] = sigmoid_fast(a[3]); h[0] = sigmoid_fast(b[0]); h[1] = sigmoid_fast(b[1]); h[2] = sigmoid_fast(b[2]); h[3] = sigmoid_fast(b[3]);
                st_bf16x8_t(dst + (size_t)row * DM + (col - c0), g, h); });
        } else {
            for_each_frag(acc, brow, bcol, wr, wc, fr, fq, [&](int row, int col, f32x4 v) {
                const int c = col & 255;
                if (c < 24) { f32x4 g; g[0] = sigmoid_fast(v[0]); g[1] = sigmoid_fast(v[1]); g[2] = sigmoid_fast(v[2]); g[3] = sigmoid_fast(v[3]); *(f32x4*)(P.GATE + (size_t)row * 32 + c) = g; } });
        }
    }
};
struct EpiBranch {
    const bf16_t* GA; const bf16_t* GB; bf16_t* Y1;
    __device__ __forceinline__ void mid(f32x4 (&acc)[2][2][4][2], int brow, int bcol, int wr, int wc, int fr, int fq) const {
#pragma unroll
        for (int ai = 0; ai < 2; ++ai)
#pragma unroll
            for (int m = 0; m < 4; ++m)
#pragma unroll
                for (int bj = 0; bj < 2; ++bj) {
                    const size_t o = (size_t)(brow + ai * HALF + wr * 64 + m * 16 + fr) * DM + bcol + wc * 64 + bj * 32 + fq * 8;
                    const u32x4 a = *(const u32x4*)(GA + o), b = *(const u32x4*)(GB + o);
                    f32x4& v = acc[ai][bj][m][0]; f32x4& w = acc[ai][bj][m][1];
                    v[0] *= bflo(a.x) / fmaxf(bflo(b.x), 1e-30f); v[1] *= bfhi(a.x) / fmaxf(bfhi(b.x), 1e-30f);
                    v[2] *= bflo(a.y) / fmaxf(bflo(b.y), 1e-30f); v[3] *= bfhi(a.y) / fmaxf(bfhi(b.y), 1e-30f);
                    w[0] *= bflo(a.z) / fmaxf(bflo(b.z), 1e-30f); w[1] *= bfhi(a.z) / fmaxf(bfhi(b.z), 1e-30f);
                    w[2] *= bflo(a.w) / fmaxf(bflo(b.w), 1e-30f); w[3] *= bfhi(a.w) / fmaxf(bfhi(b.w), 1e-30f);
                    asm volatile("" : "+v"(v), "+v"(w));
                    if (bj == 1) __builtin_amdgcn_sched_barrier(0);
                }
    }
    __device__ __forceinline__ int lcol(int r) const { return lcol_a(r); }
    __device__ __forceinline__ void operator()(const f32x4 (&acc)[2][2][4][2], int brow, int bcol, int wr, int wc, int fr, int fq) const {
        for_each_frag8(acc, brow, bcol, wr, wc, fr, fq, [&](int row, int col, f32x4 v, f32x4 w) {
            const u32x4 b = *(const u32x4*)(GB + (size_t)row * DM + col);
            f32x4 o, q; o[0] = v[0] * fmaxf(bflo(b.x), 1e-30f); o[1] = v[1] * fmaxf(bfhi(b.x), 1e-30f); o[2] = v[2] * fmaxf(bflo(b.y), 1e-30f); o[3] = v[3] * fmaxf(bfhi(b.y), 1e-30f);
            q[0] = w[0] * fmaxf(bflo(b.z), 1e-30f); q[1] = w[1] * fmaxf(bfhi(b.z), 1e-30f); q[2] = w[2] * fmaxf(bflo(b.w), 1e-30f); q[3] = w[3] * fmaxf(bfhi(b.w), 1e-30f);
            st_bf16x8(Y1 + (size_t)row * DM + col, o, q); });
    }
    __device__ __forceinline__ void apply2(int row, int col, f32x4 v1, f32x4 v2) const {
        const u32x2 a = *(const u32x2*)(GA + (size_t)row * DM + col), b = *(const u32x2*)(GB + (size_t)row * DM + col);
        f32x4 o; o[0] = v1[0] * bflo(a.x) + v2[0] * bflo(b.x); o[1] = v1[1] * bfhi(a.x) + v2[1] * bfhi(b.x); o[2] = v1[2] * bflo(a.y) + v2[2] * bflo(b.y); o[3] = v1[3] * bfhi(a.y) + v2[3] * bfhi(b.y);
        st_bf16x4(Y1 + (size_t)row * DM + col, o);
    }
};
struct EpiF32 {
    float* F; int ld;
    __device__ __forceinline__ void apply(int row, int col, f32x4 v) const { *(f32x4*)(F + (size_t)row * ld + col) = v; }
    __device__ __forceinline__ void operator()(const f32x4 (&acc)[2][2][4][2], int brow, int bcol, int wr, int wc, int fr, int fq) const {
        for_each_frag(acc, brow, bcol, wr, wc, fr, fq, [&](int row, int col, f32x4 v) { *(f32x4*)(F + (size_t)row * ld + col) = v; });
    }
};
struct EpiBf16 {
    bf16_t* O; int ld;
    __device__ __forceinline__ int lcol(int r) const { return lcol_a(r); }
    __device__ __forceinline__ void apply(int row, int col, f32x4 v) const { st_bf16x4(O + (size_t)row * ld + col, v); }
    __device__ __forceinline__ void operator()(const f32x4 (&acc)[2][2][4][2], int brow, int bcol, int wr, int wc, int fr, int fq) const {
        for_each_frag8(acc, brow, bcol, wr, wc, fr, fq, [&](int row, int col, f32x4 a, f32x4 b) { st_bf16x8(O + (size_t)row * ld + col, a, b); });
    }
};
struct EpiPart {
    bf16_t* PART;
    __device__ __forceinline__ void operator()(const f32x4 (&acc)[2][2][4][2], int brow, int bcol, int wr, int wc, int fr, int fq) const {
        const int z = bcol >> 20;
        for_each_frag8(acc, brow, 0, wr, wc, fr, fq, [&](int row, int col, f32x4 a, f32x4 b) { st_bf16x8(PART + ((size_t)row * 4 + z) * 256 + col, a, b); });
    }
};
struct ZCmp { __device__ __forceinline__ size_t a(int z) const { return (size_t)z * 64; } __device__ __forceinline__ size_t b(int z) const { return (size_t)(z >> 1) * 256 * 1024; } };
struct EpiSwiGLU {
    bf16_t* ACT;
    __device__ __forceinline__ int lcol(int r) const { return lcol_s(r); }
    __device__ __forceinline__ void apply(int row, int col, f32x4 v) const { *(unsigned*)(ACT + (size_t)row * DFF + (col >> 1)) = cvt_pk_bf16(silu_fast(v[0]) * v[1], silu_fast(v[2]) * v[3]); }
    __device__ __forceinline__ void operator()(const f32x4 (&acc)[2][2][4][2], int brow, int bcol, int wr, int wc, int fr, int fq) const {
#pragma unroll
        for (int ai = 0; ai < 2; ++ai)
#pragma unroll
            for (int m = 0; m < 4; ++m) {
                const f32x4 &a = acc[ai][0][m][0], &b = acc[ai][0][m][1], &c = acc[ai][1][m][0], &d = acc[ai][1][m][1];
                u32x4 w;
                w.x = cvt_pk_bf16(silu_fast(a[0]) * a[1], silu_fast(a[2]) * a[3]); w.y = cvt_pk_bf16(silu_fast(b[0]) * b[1], silu_fast(b[2]) * b[3]);
                w.z = cvt_pk_bf16(silu_fast(c[0]) * c[1], silu_fast(c[2]) * c[3]); w.w = cvt_pk_bf16(silu_fast(d[0]) * d[1], silu_fast(d[2]) * d[3]);
                *(u32x4*)(ACT + (size_t)(brow + ai * HALF + wr * 64 + m * 16 + fr) * DFF + (bcol >> 1) + wc * 32 + fq * 8) = w;
            }
    }
};
struct EpiPleGate {
    const bf16_t* E; bf16_t* F;
    __device__ __forceinline__ void apply(int row, int col, f32x4 v) const {
        const u32x2 w = *(const u32x2*)(E + (size_t)row * DM + col);
        f32x4 o; o[0] = sigmoidf_(v[0]) * bflo(w.x); o[1] = sigmoidf_(v[1]) * bfhi(w.x); o[2] = sigmoidf_(v[2]) * bflo(w.y); o[3] = sigmoidf_(v[3]) * bfhi(w.y);
        st_bf16x4(F + (size_t)row * DM + col, o); }
    __device__ __forceinline__ int lcol(int r) const { return lcol_a(r); }
    __device__ __forceinline__ void operator()(const f32x4 (&acc)[2][2][4][2], int brow, int bcol, int wr, int wc, int fr, int fq) const {
        for_each_frag8(acc, brow, bcol, wr, wc, fr, fq, [&](int row, int col, f32x4 a, f32x4 b) {
            const u32x4 w = *(const u32x4*)(E + (size_t)row * DM + col);
            f32x4 o, q; o[0] = sigmoidf_(a[0]) * bflo(w.x); o[1] = sigmoidf_(a[1]) * bfhi(w.x); o[2] = sigmoidf_(a[2]) * bflo(w.y); o[3] = sigmoidf_(a[3]) * bfhi(w.y);
            q[0] = sigmoidf_(b[0]) * bflo(w.z); q[1] = sigmoidf_(b[1]) * bfhi(w.z); q[2] = sigmoidf_(b[2]) * bflo(w.w); q[3] = sigmoidf_(b[3]) * bfhi(w.w);
            st_bf16x8(F + (size_t)row * DM + col, o, q); });
    }
};

template <class Epi>
__device__ __forceinline__ void gemm_skinny(const bf16_t* A  , int lda, const bf16_t* Bt, int K, int N, const Epi& E) {
    int tid = threadIdx.x; asm volatile("" : "+v"(tid));
    const int wid = __builtin_amdgcn_readfirstlane(tid >> 6), lane = tid & 63, c = lane & 15, G = lane >> 4;
    LAS f32x4* red = (LAS f32x4*)smem;
    const int nsteps = K / 32;
#pragma unroll 1
    for (int ct = blockIdx.x; ct < N / 16; ct += gridDim.x) {
        f32x4 acc0 = {0.f, 0.f, 0.f, 0.f}, acc1 = {0.f, 0.f, 0.f, 0.f};
        const bf16_t* bp = Bt + (size_t)(ct * 16 + c) * K + G * 8;
        const bf16_t* a0 = A + (size_t)c * lda + G * 8; const bf16_t* a1 = A + (size_t)(16 + c) * lda + G * 8;
#pragma unroll 4
        for (int kk = wid; kk < nsteps; kk += 8) {
            const bf16x8 bf = *(const bf16x8*)(bp + kk * 32), x0 = *(const bf16x8*)(a0 + kk * 32), x1 = *(const bf16x8*)(a1 + kk * 32);
            acc0 = mfma16(bf, x0, acc0); acc1 = mfma16(bf, x1, acc1);
        }
        __syncthreads();
        red[(wid * 2 + 0) * 64 + lane] = acc0; red[(wid * 2 + 1) * 64 + lane] = acc1;
        __syncthreads();
        if (tid < 128) {
            const int rt = tid >> 6;
            f32x4 v = red[rt * 64 + lane];
#pragma unroll
            for (int w = 1; w < 8; ++w) v = v + red[(w * 2 + rt) * 64 + lane];
            E.apply(MP + rt * 16 + c, E.lcol(ct * 16 + 4 * G), v);
        }
    }
    __syncthreads();
}

template <class Epi>
__device__ __forceinline__ void gemm_skinny2(const bf16_t* A  , int lda, const bf16_t* Bt, int K, int N, const Epi& E) {
    int tid = threadIdx.x; asm volatile("" : "+v"(tid));
    const int wid = __builtin_amdgcn_readfirstlane(tid >> 6), lane = tid & 63, c = lane & 15, G = lane >> 4;
    LAS f32x4* red = (LAS f32x4*)smem;
    const int hsteps = K / 64;
#pragma unroll 1
    for (int ct = blockIdx.x; ct < N / 16; ct += gridDim.x) {
        f32x4 acc[4] = {{0.f, 0.f, 0.f, 0.f}, {0.f, 0.f, 0.f, 0.f}, {0.f, 0.f, 0.f, 0.f}, {0.f, 0.f, 0.f, 0.f}};
        const bf16_t* bp = Bt + (size_t)(ct * 16 + c) * K + G * 8;
        const bf16_t* a0 = A + (size_t)c * lda + G * 8; const bf16_t* a1 = A + (size_t)(16 + c) * lda + G * 8;
#pragma unroll
        for (int h = 0; h < 2; ++h) {
#pragma unroll 2
            for (int kk = h * hsteps + wid; kk < (h + 1) * hsteps; kk += 8) {
                const bf16x8 bf = *(const bf16x8*)(bp + kk * 32), x0 = *(const bf16x8*)(a0 + kk * 32), x1 = *(const bf16x8*)(a1 + kk * 32);
                acc[h * 2] = mfma16(bf, x0, acc[h * 2]); acc[h * 2 + 1] = mfma16(bf, x1, acc[h * 2 + 1]);
            }
        }
        __syncthreads();
#pragma unroll
        for (int q = 0; q < 4; ++q) red[(wid * 4 + q) * 64 + lane] = acc[q];
        __syncthreads();
        if (tid < 128) {
            const int rt = tid >> 6;
            f32x4 v1 = red[rt * 64 + lane], v2 = red[(2 + rt) * 64 + lane];
#pragma unroll
            for (int w = 1; w < 8; ++w) { v1 = v1 + red[(w * 4 + rt) * 64 + lane]; v2 = v2 + red[(w * 4 + 2 + rt) * 64 + lane]; }
            E.apply2(MP + rt * 16 + c, E.lcol(ct * 16 + 4 * G), v1, v2);
        }
    }
    __syncthreads();
}

template <class Map>
__device__ __forceinline__ void transpose_tile(const float* W, int K, int N, bf16_t* Wt, int ldk, int kt, int ntile, Map map) {
    LAS float* tile = (LAS float*)smem;
    const int t = threadIdx.x;
    __syncthreads();
#pragma unroll
    for (int i = 0; i < 2; ++i) {
        const int k = (t >> 4) + 32 * i, n = (t & 15) * 4, gn = ntile * 64 + n;
        f32x4 v = (f32x4){0.f, 0.f, 0.f, 0.f};
        if (gn < N) v = *(const f32x4*)(W + (size_t)(kt * 64 + k) * N + gn);
        tile[k * 65 + n] = v[0]; tile[k * 65 + n + 1] = v[1]; tile[k * 65 + n + 2] = v[2]; tile[k * 65 + n + 3] = v[3];
    }
    __syncthreads();
    const int n = t >> 3, kc = (t & 7) * 8, gn = ntile * 64 + n;
    if (gn < N) {
        u32x4 w;
        w.x = cvt_pk_bf16(tile[(kc + 0) * 65 + n], tile[(kc + 1) * 65 + n]); w.y = cvt_pk_bf16(tile[(kc + 2) * 65 + n], tile[(kc + 3) * 65 + n]);
        w.z = cvt_pk_bf16(tile[(kc + 4) * 65 + n], tile[(kc + 5) * 65 + n]); w.w = cvt_pk_bf16(tile[(kc + 6) * 65 + n], tile[(kc + 7) * 65 + n]);
        *(u32x4*)(Wt + (size_t)map(gn) * ldk + kt * 64 + kc) = w;
    }
}
template <class Map>
__device__ __forceinline__ void transpose_all(const float* W, int K, int N, bf16_t* Wt, int ldk, Map map, int& base) {
    const int nkt = K / 64, nnt = (N + 63) / 64, ntl = nkt * nnt;
    for (int it = blockIdx.x; it < base + ntl; it += gridDim.x) {
        if (it < base) continue;
        const int l = it - base;
        transpose_tile(W, K, N, Wt, ldk, l / nnt, l % nnt, map);
    }
    base += ntl;
}
template <class Map>
__device__ __forceinline__ void transpose_all_sub(const float* W, int K, int N, bf16_t* Wt, int ldk, Map map, int& base) {
    const int nkt = K / 64, nnt = (N + 63) / 64, ntl = nkt * nnt, nb = gridDim.x - 32, me = blockIdx.x - 32;
    int first = base - (base % nb) + me; if (first < base) first += nb;
    for (int it = first; it < base + ntl; it += nb) { const int l = it - base; transpose_tile(W, K, N, Wt, ldk, l / nnt, l % nnt, map); }
    base += ntl;
}
__device__ __forceinline__ int map_win(int n) {
    if (n < 1280) return n;
    if (n < 1304) return 4352 + (n - 1280);
    if (n < 2328) return 1280 + (n - 1304);
    return 2304 + (n - 2328);
}

__device__ __forceinline__ float row_rstd(const f32x4 (&v)[4]) {
    float s = 0.f;
#pragma unroll
    for (int k = 0; k < 4; ++k) s += v[k][0] * v[k][0] + v[k][1] * v[k][1] + v[k][2] * v[k][2] + v[k][3] * v[k][3];
    s = wave_sum(s);
    return rsqrtf(s * (1.0f / DM) + EPS);
}
__device__ __forceinline__ const float* xrow_ptr(const Params& p, int row) {
    return row < MP ? p.x_prompt + (size_t)row * DM : p.x_sample + (size_t)(row - MP) * DM;
}

__device__ __forceinline__ void phase_prologue(const Params& p) {
    const int wid = threadIdx.x >> 6, lane = threadIdx.x & 63;
    const int gw = blockIdx.x * 8 + wid, nw = gridDim.x * 8;
    auto do_transposes = [&]() {
    int base = 0;
    transpose_all(p.w_in, DM, IND, p.WinT, DM, [](int n) { const int l = map_win(n); return win_tile_a(l >> 8) ? row_a(l) : l; }, base);
    for (int kv = 0; kv < 2; ++kv) for (int j = 0; j < 2; ++j)
        transpose_all((kv ? p.w1_v : p.w1_k) + (size_t)j * 1024 * 128, 1024, 128, p.W1T + (size_t)kv * 256 * 1024, 1024, [j](int n) { return inv_a(j * 128 + n); }, base);
    };
    do_transposes();
    __syncthreads();
    for (int i = blockIdx.x * 512 + threadIdx.x; i < (INP - IND) * DM / 8; i += gridDim.x * 512) ((u32x4*)(p.WinT + (size_t)IND * DM))[i] = (u32x4){0u, 0u, 0u, 0u};
    for (int row0 = gw * 2; row0 < MP + NS; row0 += nw * 2) {
        f32x4 v[2][4];
#pragma unroll
        for (int q = 0; q < 2; ++q) { const float* xr = xrow_ptr(p, row0 + q);
#pragma unroll
            for (int k = 0; k < 4; ++k) v[q][k] = *(const f32x4*)(xr + lane * 4 + k * 256); }
#pragma unroll
        for (int q = 0; q < 2; ++q) {
            const int row = row0 + q;
            u32x2* hd = (u32x2*)(p.H + (size_t)row * DM);
            const float r = row_rstd(v[q]);
#pragma unroll
            for (int k = 0; k < 4; ++k) { const f32x4 g = *(const f32x4*)(p.ln_mix_pre + lane * 4 + k * 256); const f32x4 o = v[q][k] * r * g; u32x2 w; w.x = cvt_pk_bf16(o[0], o[1]); w.y = cvt_pk_bf16(o[2], o[3]); hd[lane + k * 64] = w; }
            const float* pr = row < MP ? p.p_prompt + (size_t)row * PLE : p.p_sample + (size_t)(row - MP) * PLE;
            const f32x4 pv = *(const f32x4*)(pr + lane * 4);
            u32x2 w; w.x = cvt_pk_bf16(pv[0], pv[1]); w.y = cvt_pk_bf16(pv[2], pv[3]);
            ((u32x2*)(p.Pb + (size_t)row * PLE))[lane] = w;
        }
    }
    for (int i = blockIdx.x * 512 + threadIdx.x; i < 4 * 128 * 128; i += gridDim.x * 512) { const int t = (i >> 7) & 127, s = i & 127; p.GWb[i] = f2bf(s <= t ? p.gm_ws[i] : 0.f); }
    for (int i = blockIdx.x * 512 + threadIdx.x; i < 2 * 64 * 128; i += gridDim.x * 512) { const int kv = i >> 13, d = (i >> 7) & 63, h = i & 127; p.W2T[i] = f2bf((kv ? p.w2_v : p.w2_k)[h * 64 + d]); }
    if (gw < 256) {
        const int kv = gw >> 7, h = gw & 127;
        const float* pe = kv ? p.pe_v : p.pe_k; const float* w1 = kv ? p.w1_v : p.w1_k;
        float s = 0.f;
#pragma unroll 8
        for (int k = lane; k < 2048; k += 64) s += pe[k] * w1[(size_t)k * 128 + h];
        s = wave_sum(s);
        if (lane == 0) p.PEB[kv * 128 + h] = s;
    }
    for (int i = blockIdx.x * 512 + threadIdx.x; i < NS * (WIN - 1) * 64; i += gridDim.x * 512) {
        const int b = i / ((WIN - 1) * 64), r = i % ((WIN - 1) * 64);
        ((f32x4*)(p.out + O_WINS + (size_t)b * WIN * 256))[r] = ((const f32x4*)(p.state_win + (size_t)b * WIN * 256 + 256))[r];
    }
}

__device__ __forceinline__ void phase_deferred_transposes(const Params& p) {
    if (blockIdx.x < 32) return;
    int base = 0;
    transpose_all_sub(p.w_br_nsa, QD, DM, p.WnT, DM, [](int n) { return row_a(n); }, base);
    transpose_all_sub(p.w_br_gm, GMD, DM, p.WnT + QD, DM, [](int n) { return row_a(n); }, base);
    transpose_all_sub(p.w_out, DM, DM, p.WoT, DM, [](int n) { return row_a(n); }, base);
    transpose_all_sub(p.w_gate, DM, DFF, p.WguT, DM, [](int n) { return row_s(n, 0); }, base);
    transpose_all_sub(p.w_up, DM, DFF, p.WguT, DM, [](int n) { return row_s(n, 1); }, base);
    transpose_all_sub(p.w_down, DFF, DM, p.WdT, DFF, [](int n) { return row_a(n); }, base);
    transpose_all_sub(p.w_ple_gate, DM, DM, p.WpgT, DM, [](int n) { return row_a(n); }, base);
    transpose_all_sub(p.w_ple, PLE, DM, p.WpT, PLE, [](int n) { return row_a(n); }, base);
    __syncthreads();
}
__device__ __forceinline__ void phase_gather(const Params& p) {
    int tid = threadIdx.x; asm volatile("" : "+v"(tid));
    const int wid = tid >> 6, lane = tid & 63;
    const int gw = (blockIdx.x >> 1) * 8 + wid, nw = (gridDim.x >> 1) * 8;
    const int cls = blockIdx.x & 1;
    auto ld8 = [&](int r8h, f32x4 (&a)[4], f32x4 (&cc)[4]) __attribute__((always_inline)) {
        const int r = (r8h * 2 + cls) * 8, b = r >> 14, pos = r & (PAST - 1), l5 = lane & 31, hrow = lane >> 5;
        const float* s = p.cache_cmp + ((size_t)p.page_table[b * NPG + (pos >> 7)] * PAGE + (pos & 127) + hrow) * 256 + l5 * 8;
#pragma unroll
        for (int k = 0; k < 4; ++k) { a[k] = *(const f32x4*)(s + (size_t)k * 512); cc[k] = *(const f32x4*)(s + (size_t)k * 512 + 4); }
    };
    auto st8 = [&](int r8h, const f32x4 (&a)[4], const f32x4 (&cc)[4]) __attribute__((always_inline)) {
        const int r = (r8h * 2 + cls) * 8, l5 = lane & 31, hrow = lane >> 5;
#pragma unroll
        for (int k = 0; k < 4; ++k) {
            u32x4 w; w.x = cvt_pk_bf16(a[k][0], a[k][1]); w.y = cvt_pk_bf16(a[k][2], a[k][3]); w.z = cvt_pk_bf16(cc[k][0], cc[k][1]); w.w = cvt_pk_bf16(cc[k][2], cc[k][3]);
            *(u32x4*)(p.CMPb + ((size_t)MP + r + 2 * k + hrow) * 256 + l5 * 8) = w;
        }
    };
#pragma unroll 1
    for (int r8h = gw; r8h < NS * PAST / 16; r8h += 2 * nw) {
        f32x4 a0[4], c0[4], a1[4], c1[4];
        const bool two = r8h + nw < NS * PAST / 16;
        ld8(r8h, a0, c0);
        if (two) ld8(r8h + nw, a1, c1);
        st8(r8h, a0, c0);
        if (two) st8(r8h + nw, a1, c1);
    }
}

__device__ __forceinline__ void phase_cmp_final(const Params& p) {
    const int wid = threadIdx.x >> 6, lane = threadIdx.x & 63;
    {
        const int c = lane & 15, G = lane >> 4;
        const int ngrp_p = NB * 4 * 32, ngrp_s = NS * 4 * 64;
#pragma unroll 1
        for (int it = blockIdx.x * 8 + wid; it < ngrp_p + ngrp_s; it += gridDim.x * 8) {
            const bool smp = it >= ngrp_p; const int l = smp ? it - ngrp_p : it;
            const int nch = smp ? 64 : 32, nc = smp ? NCS : NCP;
            const int ch = l % nch, z = (l / nch) & 3, seq = l / (nch * 4), kv = z >> 1, g = z & 1, n0 = ch * 16;
            const size_t r0 = smp ? (size_t)2048 + (size_t)seq * 1024 : (size_t)seq * 512;
            const int nr = n0 + c < nc ? n0 + c : nc - 1;
            const bf16_t* p0 = (const bf16_t*)p.PART + ((r0 + nr) * 4 + z) * 256;
            const bf16_t* p1 = (const bf16_t*)p.PART + ((r0 + nr + 1) * 4 + z) * 256 + 128;
            const float* pb = p.PEB + kv * 128;
            f32x4 acc[4] = {{0.f, 0.f, 0.f, 0.f}, {0.f, 0.f, 0.f, 0.f}, {0.f, 0.f, 0.f, 0.f}, {0.f, 0.f, 0.f, 0.f}};
#pragma unroll
            for (int ks = 0; ks < 4; ++ks) {
                const int h0 = 32 * ks + 8 * G;
                const u32x4 wa = *(const u32x4*)(p0 + h0), wb = *(const u32x4*)(p1 + h0);
                const f32x4 a0 = {bflo(wa.x), bfhi(wa.x), bflo(wa.y), bfhi(wa.y)}, a1 = {bflo(wa.z), bfhi(wa.z), bflo(wa.w), bfhi(wa.w)};
                const f32x4 b0 = {bflo(wb.x), bfhi(wb.x), bflo(wb.y), bfhi(wb.y)}, b1 = {bflo(wb.z), bfhi(wb.z), bflo(wb.w), bfhi(wb.w)};
                const f32x4 e0 = *(const f32x4*)(pb + h0), e1 = *(const f32x4*)(pb + h0 + 4);
                f32x4 x0 = a0 + b0 + e0, x1 = a1 + b1 + e1;
#pragma unroll
                for (int i = 0; i < 4; ++i) { x0[i] = siluf_(x0[i]); x1[i] = siluf_(x1[i]); }
                const bf16x8 A = pack_p(x0, x1);
#pragma unroll
                for (int nt = 0; nt < 4; ++nt) {
                    const bf16x8 B = *(const bf16x8*)(p.W2T + ((size_t)kv * 64 + nt * 16 + c) * 128 + h0);
                    acc[nt] = mfma16(A, B, acc[nt]);
                }
            }
#pragma unroll
            for (int nt = 0; nt < 4; ++nt) {
                const int d = nt * 16 + c;
#pragma unroll
                for (int i = 0; i < 4; ++i) {
                    const int n = n0 + 4 * G + i;
                    if (n < nc) {
                        if (smp) ((kv ? p.VCS : p.KCS) + (((size_t)seq * NG + g) * 1024 + n) * 64)[d] = acc[nt][i];
                        else if (kv == 0) p.KCb[((size_t)seq * NG + g) * 512 * 64 + kfrag_off(n, d)] = f2bf(acc[nt][i]);
                    }
                }
                if (!smp && kv == 1) {
                    f32x4 v = acc[nt];
#pragma unroll
                    for (int i = 0; i < 4; ++i) if (n0 + 4 * G + i >= nc) v[i] = 0.f;
                    st_bf16x4(p.VCT + ((size_t)seq * NG + g) * 512 * 64 + vfrag_off(n0 + 4 * G, d), v);
                }
            }
        }
    }
}

template <bool SAMPLE>
__device__ __forceinline__ void kv_row_ptr(const Params& p, int branch  , int b, int pos, int kv, int g, const bf16_t*& pb, const float*& pf) {
    const int off = kv * 128 + g * 64;
    if (!SAMPLE) { pf = nullptr; pb = (branch == 1 ? p.SLCb : p.WINb) + ((size_t)b * SEQ + pos) * 256 + off; }
    else if (pos >= PAST) { pf = nullptr; pb = (branch == 1 ? p.SLCb : p.WINb) + ((size_t)MP + b) * 256 + off; }
    else if (branch == 1) { pb = nullptr; pf = p.cache_slc + ((size_t)p.page_table[b * NPG + (pos >> 7)] * PAGE + (pos & 127)) * 256 + off; }
    else { pb = nullptr; pf = p.state_win + ((size_t)b * WIN + (pos - (PAST - WIN))) * 256 + off; }
}
__device__ __forceinline__ void dot4x64(const bf16_t* pb, const float* pf, const LAS float* qs_, float (&s)[4]) {
    s[0] = s[1] = s[2] = s[3] = 0.f;
    const LAS float* qs = qs_; asm volatile("" : "+v"(qs));
    if (pf) {
#pragma unroll 8
        for (int c = 0; c < 16; ++c) {
            const f32x4 kx = *(const f32x4*)(pf + c * 4);
#pragma unroll
            for (int h = 0; h < 4; ++h) { const f32x4 q = *(const LAS f32x4*)(qs + h * 64 + c * 4); s[h] += q[0] * kx[0] + q[1] * kx[1] + q[2] * kx[2] + q[3] * kx[3]; }
        }
    } else {
#pragma unroll 2
        for (int c = 0; c < 8; ++c) {
            const u32x4 w = *(const u32x4*)(pb + c * 8);
            const float k0 = bflo(w.x), k1 = bfhi(w.x), k2 = bflo(w.y), k3 = bfhi(w.y), k4 = bflo(w.z), k5 = bfhi(w.z), k6 = bflo(w.w), k7 = bfhi(w.w);
#pragma unroll
            for (int h = 0; h < 4; ++h) {
                const f32x4 qa = *(const LAS f32x4*)(qs + h * 64 + c * 8), qb = *(const LAS f32x4*)(qs + h * 64 + c * 8 + 4);
                s[h] += qa[0] * k0 + qa[1] * k1 + qa[2] * k2 + qa[3] * k3 + qb[0] * k4 + qb[1] * k5 + qb[2] * k6 + qb[3] * k7;
            }
        }
    }
}
template <bool SAMPLE>
__device__ __forceinline__ void attn_chunk(const Params& p, int branch, int b, int g, int t, int pos0, int lo, int hi,
                                           float (&m)[4], float (&l)[4], float (&o)[4], const LAS float* qs, LAS float* pbk, const LAS float* relb, int lane) {
    const int pos = pos0 + lane;
    const bool valid = pos >= lo && pos <= hi;
    float s[4] = {-1e30f, -1e30f, -1e30f, -1e30f};
    if (valid) {
        const bf16_t* pb; const float* pf; kv_row_ptr<SAMPLE>(p, branch, b, pos, 0, g, pb, pf);
        dot4x64(pb, pf, qs, s);
        const int bk = t5_bucket(t - pos);
#pragma unroll
        for (int h = 0; h < 4; ++h) s[h] += relb[bk * 8 + g * 4 + h];
    }
#pragma unroll
    for (int h = 0; h < 4; ++h) {
        const float mx = wave_max(s[h]);
        const float mn = fmaxf(m[h], mx);
        const float pr = valid ? ex2(s[h] - mn) : 0.f;
        const float sm = wave_sum(pr);
        const float al = ex2(m[h] - mn);
        l[h] = l[h] * al + sm; o[h] *= al; m[h] = mn;
        pbk[h * 64 + lane] = pr;
    }
    __builtin_amdgcn_wave_barrier();
    const int k0 = (lo > pos0 ? lo : pos0) - pos0, k1 = (hi < pos0 + 63 ? hi : pos0 + 63) - pos0;
    if (SAMPLE) {
        const int kend = (PAST - 1 - pos0) < k1 ? (PAST - 1 - pos0) : k1;
        if (kend >= k0) {
            const bf16_t* pb; const float* pf; kv_row_ptr<SAMPLE>(p, branch, b, pos0 + k0, 1, g, pb, pf);
            pf += lane;
#pragma unroll 16
            for (int k = k0; k <= kend; ++k) {
                const float v = pf[(size_t)(k - k0) * 256];
#pragma unroll
                for (int h = 0; h < 4; ++h) o[h] += pbk[h * 64 + k] * v;
            }
        }
        if (k1 > kend) {
            const bf16_t* pb; const float* pf; kv_row_ptr<SAMPLE>(p, branch, b, pos0 + k1, 1, g, pb, pf);
            const float v = bf2f(pb[lane]);
#pragma unroll
            for (int h = 0; h < 4; ++h) o[h] += pbk[h * 64 + k1] * v;
        }
    } else {
#pragma unroll 1
    for (int k = k0; k <= k1; ++k) {
        const bf16_t* pb; const float* pf; kv_row_ptr<SAMPLE>(p, branch, b, pos0 + k, 1, g, pb, pf);
        const float v = pf ? pf[lane] : bf2f(pb[lane]);
#pragma unroll
        for (int h = 0; h < 4; ++h) o[h] += pbk[h * 64 + k] * v;
    }
    }
    __builtin_amdgcn_wave_barrier();
}

constexpr int S_QS = 0, S_SC = 1024, S_PHS = S_SC + 4 * 1024 * 4, S_PBK = S_PHS + 1088 * 4, S_PART = S_PBK + 8 * 1024, S_RED = S_PART + 2 * 8 * 272 * 4, S_OCP = S_RED + 512,
              S_SEL = S_OCP + 2048, S_RELB = S_SEL + 64, ATTS_LDS = S_RELB + 1024;
__device__ __forceinline__ void attn_sample_item(const Params& p, int b, int g) {
    const int tid = threadIdx.x, wid = tid >> 6, lane = tid & 63;
    constexpr int t = PAST, NC = NCS, NSEL = 257, NJR = 5, qblk = PAST >> 6;
    const int row = MP + b;
    LAS unsigned char* L = (LAS unsigned char*)smem;
    LAS float* qs = (LAS float*)(L + S_QS); LAS float* sc = (LAS float*)(L + S_SC); LAS float* phs = (LAS float*)(L + S_PHS); LAS float* pbk = (LAS float*)(L + S_PBK) + wid * 256;
    LAS float* part = (LAS float*)(L + S_PART); LAS float* red = (LAS float*)(L + S_RED); LAS float* ocp = (LAS float*)(L + S_OCP); LAS int* sel = (LAS int*)(L + S_SEL);
    LAS float* relb = (LAS float*)(L + S_RELB);
    __syncthreads();
    if (tid < 256) { relb[tid] = p.rel_bias[tid] * LOG2E; qs[tid] = bf2f(p.Qb[(size_t)row * QD + g * 256 + tid]); }
    __syncthreads();
    const float* kc = p.KCS + ((size_t)b * NG + g) * 1024 * 64;
    const float* vc = p.VCS + ((size_t)b * NG + g) * 1024 * 64;
    {
        float mx[4] = {-1e30f, -1e30f, -1e30f, -1e30f};
#pragma unroll 1
        for (int r = wid; r < 16; r += 8) {
            const int n = r * 64 + lane;
            float s[4] = {-1e30f, -1e30f, -1e30f, -1e30f};
            if (n < NC) {
                dot4x64(nullptr, kc + (size_t)n * 64, qs, s);
                const int bk = t5_bucket(t - (16 * n + 31));
#pragma unroll
                for (int h = 0; h < 4; ++h) s[h] += relb[bk * 8 + g * 4 + h];
            }
#pragma unroll
            for (int h = 0; h < 4; ++h) { sc[h * 1024 + n] = s[h]; mx[h] = fmaxf(mx[h], s[h]); }
        }
#pragma unroll
        for (int h = 0; h < 4; ++h) { const float m = wave_max(mx[h]); if (lane == 0) red[wid * 4 + h] = m; }
    }
    __syncthreads();
    float gmx[4], inv[4];
#pragma unroll
    for (int h = 0; h < 4; ++h) { float m = red[h]; for (int w = 1; w < 8; ++w) m = fmaxf(m, red[w * 4 + h]); gmx[h] = m; }
    {
        float sum[4] = {0.f, 0.f, 0.f, 0.f};
#pragma unroll
        for (int k = 0; k < 2; ++k) { const int n = tid + 512 * k;
#pragma unroll
            for (int h = 0; h < 4; ++h) { const float e = n < NC ? ex2(sc[h * 1024 + n] - gmx[h]) : 0.f; sc[h * 1024 + n] = e; sum[h] += e; } }
#pragma unroll
        for (int h = 0; h < 4; ++h) { const float s = wave_sum(sum[h]); if (lane == 0) red[32 + wid * 4 + h] = s; }
    }
    __syncthreads();
#pragma unroll
    for (int h = 0; h < 4; ++h) { float s = 0.f; for (int w = 0; w < 8; ++w) s += red[32 + w * 4 + h]; inv[h] = s > 0.f ? 1.0f / s : 0.f; }
    for (int n = tid; n < 1088; n += 512) phs[n] = n < NC ? (sc[n] * inv[0] + sc[1024 + n] * inv[1]) + (sc[2048 + n] * inv[2] + sc[3072 + n] * inv[3]) : 0.f;
    {
        float a[4] = {0.f, 0.f, 0.f, 0.f};
#pragma unroll 16
        for (int n = wid; n < NC; n += 8) {
            const float v = vc[(size_t)n * 64 + lane];
#pragma unroll
            for (int h = 0; h < 4; ++h) a[h] += sc[h * 1024 + n] * v;
        }
#pragma unroll
        for (int h = 0; h < 4; ++h) part[(wid * 4 + h) * 68 + lane] = a[h] * inv[h];
    }
    __syncthreads();
    if (tid < 256) { float a = 0.f; for (int w = 0; w < 8; ++w) a += part[(w * 4 + (tid >> 6)) * 68 + (tid & 63)]; ocp[tid] = a; }
    __syncthreads();
    if (wid == 0) {
        unsigned long long key[NJR];
#pragma unroll
        for (int jr = 0; jr < NJR; ++jr) {
            const int j = jr * 64 + lane;
            key[jr] = 0ull;
            if (j >= 1 && j <= qblk - 2 && j < NSEL) {
                float im = 0.f;
#pragma unroll
                for (int n = 4 * j - 1; n <= 4 * j + 3; ++n) im += (n < NC) ? phs[n] : 0.f;
                key[jr] = ((unsigned long long)__float_as_uint(im) << 32) | (unsigned)(0xFFFF - j) | 0x10000ull;
            }
        }
        if (lane == 0) { sel[0] = 0; sel[1] = qblk - 1; sel[2] = qblk; }
#pragma unroll 1
        for (int it = 0; it < 13; ++it) {
            unsigned long long best = 0ull;
#pragma unroll
            for (int jr = 0; jr < NJR; ++jr) best = key[jr] > best ? key[jr] : best;
#pragma unroll
            for (int o = 32; o > 0; o >>= 1) { const unsigned long long ot = __shfl_xor(best, o); best = ot > best ? ot : best; }
            const int j = 0xFFFF - (int)(best & 0xFFFFull);
#pragma unroll
            for (int jr = 0; jr < NJR; ++jr) if (key[jr] == best) key[jr] = 0ull;
            if (lane == 0) sel[3 + it] = j;
        }
    }
    __syncthreads();
    {
        float ms[4] = {-1e30f, -1e30f, -1e30f, -1e30f}, ls[4] = {0.f, 0.f, 0.f, 0.f}, os[4] = {0.f, 0.f, 0.f, 0.f};
#pragma unroll 1
        for (int i = wid; i < 16; i += 8) attn_chunk<true>(p, 1, b, g, t, sel[i] * 64, 0, t, ms, ls, os, qs, pbk, relb, lane);
        float mw[4] = {-1e30f, -1e30f, -1e30f, -1e30f}, lw[4] = {0.f, 0.f, 0.f, 0.f}, ow[4] = {0.f, 0.f, 0.f, 0.f};
#pragma unroll 1
        for (int c = wid; c < 9; c += 8) attn_chunk<true>(p, 2, b, g, t, t - 63 - 64 * c, t - WIN, t, mw, lw, ow, qs, pbk, relb, lane);
#pragma unroll
        for (int h = 0; h < 4; ++h) {
            LAS float* ps = part + (wid * 4 + h) * 68; LAS float* pw = part + 8 * 272 + (wid * 4 + h) * 68;
            ps[lane] = os[h]; pw[lane] = ow[h];
            if (lane == 0) { ps[64] = ms[h]; ps[65] = ls[h]; pw[64] = mw[h]; pw[65] = lw[h]; }
        }
    }
    __syncthreads();
    if (tid < 256) {
        const int h = tid >> 6, d = tid & 63;
        float res[2];
#pragma unroll
        for (int br = 0; br < 2; ++br) {
            const LAS float* pp = part + br * 8 * 272 + h * 68;
            float m = -1e30f;
            for (int w = 0; w < 8; ++w) m = fmaxf(m, pp[w * 272 + 64]);
            float l = 0.f, o = 0.f;
            for (int w = 0; w < 8; ++w) { const float sc_ = ex2(pp[w * 272 + 64] - m); l += pp[w * 272 + 65] * sc_; o += pp[w * 272 + d] * sc_; }
            res[br] = o / l;
        }
        const float* gt = p.GATE + (size_t)row * 32 + (g * 4 + h) * 3;
        const float v = gt[0] * ocp[tid] + gt[1] * res[0] + gt[2] * res[1];
        p.OCAT[(size_t)row * DM + (g * 4 + h) * 64 + d] = f2bf(v);
    }
    __syncthreads();
}

constexpr int A_OST = 0, OST_LD = 68, A_LST = A_OST + 256 * OST_LD * 4, A_M0 = A_LST + 1024, A_MB = A_M0 + 1024, MB_LD = 132, A_MKN = A_MB + 64 * MB_LD,
              A_LIST = A_MKN + 256, A_CNT = A_LIST + 132 * 64, A_PK = A_CNT + 544, A_KN = A_PK + 400 * 4, A_T2 = A_KN + 512, A_NP = A_T2 + 132 * 8 * 4, A_QT = A_NP + 16, ATT2_LDS = A_QT + 64 * 512;
static_assert(ATT2_LDS <= GEMM_LDS && ATTS_LDS <= GEMM_LDS, "attention LDS");

__device__ __forceinline__ void qk64(const bf16_t* kb, int c, int G, const bf16x8 (&qB)[2], f32x4 (&s)[4]) {
#pragma unroll
    for (int kt = 0; kt < 4; ++kt) {
        const bf16_t* r = kb + (size_t)(16 * kt + c) * 256 + G * 8;
        const bf16x8 a0 = *(const bf16x8*)r, a1 = *(const bf16x8*)(r + 32);
        s[kt] = mfma16(a0, qB[0], (f32x4){0.f, 0.f, 0.f, 0.f}); s[kt] = mfma16(a1, qB[1], s[kt]);
    }
}
__device__ __forceinline__ void pv64(const bf16_t* vf, int key0, int lane, const f32x4 (&pr)[4], f32x4 (&o)[4]) {
#pragma unroll
    for (int ks = 0; ks < 2; ++ks) {
        const bf16x8 pB = pack_p(pr[2 * ks], pr[2 * ks + 1]);
#pragma unroll
        for (int dt = 0; dt < 4; ++dt) {
            const bf16x8 vA = *(const bf16x8*)(vf + ((size_t)(((key0 >> 5) + ks) * 4 + dt) * 64 + lane) * 8);
            o[dt] = mfma16(vA, pB, o[dt]);
        }
    }
}
__device__ __forceinline__ int qt_off(int qi, int hh, int k) { return (qi * 4 + hh) * 128 + ((k ^ (((qi & 3) << 1) | (hh >> 1))) << 4); }
__device__ __forceinline__ float grp_max(float v) {
    auto r = __builtin_amdgcn_permlane16_swap(__float_as_uint(v), __float_as_uint(v), false, false); v = fmaxf(__uint_as_float(r[0]), __uint_as_float(r[1]));
    r = __builtin_amdgcn_permlane32_swap(__float_as_uint(v), __float_as_uint(v), false, false); return fmaxf(__uint_as_float(r[0]), __uint_as_float(r[1]));
}
__device__ __forceinline__ float grp_sum(float v) {
    auto r = __builtin_amdgcn_permlane16_swap(__float_as_uint(v), __float_as_uint(v), false, false); v = __uint_as_float(r[0]) + __uint_as_float(r[1]);
    r = __builtin_amdgcn_permlane32_swap(__float_as_uint(v), __float_as_uint(v), false, false); return __uint_as_float(r[0]) + __uint_as_float(r[1]);
}
__device__ __forceinline__ int grp_min_i(int v) {
    auto r = __builtin_amdgcn_permlane16_swap((unsigned)v, (unsigned)v, false, false); v = (int)r[0] < (int)r[1] ? (int)r[0] : (int)r[1];
    r = __builtin_amdgcn_permlane32_swap((unsigned)v, (unsigned)v, false, false); return (int)r[0] < (int)r[1] ? (int)r[0] : (int)r[1];
}
__device__ __forceinline__ float dpp_x1(float v) { return __uint_as_float(__builtin_amdgcn_mov_dpp(__float_as_uint(v), 0xB1, 0xF, 0xF, true)); }
__device__ __forceinline__ float dpp_x2(float v) { return __uint_as_float(__builtin_amdgcn_mov_dpp(__float_as_uint(v), 0x4E, 0xF, 0xF, true)); }
__device__ __forceinline__ int dpp_x1i(int v) { return (int)__builtin_amdgcn_mov_dpp((unsigned)v, 0xB1, 0xF, 0xF, true); }
__device__ __forceinline__ int dpp_x2i(int v) { return (int)__builtin_amdgcn_mov_dpp((unsigned)v, 0x4E, 0xF, 0xF, true); }
__device__ __forceinline__ unsigned row_or_q(unsigned u) {
    u |= __builtin_amdgcn_mov_dpp(u, 0x124, 0xF, 0xF, true); u |= __builtin_amdgcn_mov_dpp(u, 0x128, 0xF, 0xF, true); return u;
}

__device__ __forceinline__ void attn_cmp(const Params& p, int b, int g, int t0, int lane_, LAS unsigned char* L, unsigned (&msk)[4]) {
    f32x4 oacc[4];
    int lane = lane_; asm volatile("" : "+v"(lane));
    const int c = lane & 15, G = lane >> 4, qs = c >> 2, hh = c & 3;
    const int qb = t0 >> 6, tc = t0 + qs;
    const size_t qrow = (size_t)b * SEQ + tc;
    const LAS float* T2 = (const LAS float*)(L + A_T2);
    const float b31 = T2[128 * 8 + g * 4 + hh];
    bf16x8 qB[2];
    qB[0] = *(const bf16x8*)(p.Qb + qrow * QD + (g * 4 + hh) * 64 + G * 8); qB[1] = *(const bf16x8*)(p.Qb + qrow * QD + (g * 4 + hh) * 64 + 32 + G * 8);
    const float* gate = p.GATE + qrow * 32 + (g * 4 + hh) * 3;
    msk[0] = msk[1] = msk[2] = msk[3] = 0u;
    {
        const int ncv_c = tc >= 31 ? ((tc - 31) >> 4) + 1 : 0;
        const int ncv_m = t0 + 3 >= 31 ? ((t0 + 3 - 31) >> 4) + 1 : 0;
        const int NT = (ncv_m + 15) >> 4;
        const int mt_far = t0 >= 399 ? (t0 - 399) / 256 + 1 : 0;
        const bf16_t* kcb = p.KCb + (size_t)(b * NG + g) * 512 * 64;
        f32x4 sc[32];
        float mxf = -1e30f, mxn = -1e30f;
        bf16x8 kbuf[2][4][2];
        auto ldkg = [&](int grp, bf16x8 (&kb)[4][2]) __attribute__((always_inline)) {
#pragma unroll
            for (int q = 0; q < 4; ++q) { const bf16_t* r = kcb + ((size_t)((grp * 4 + q) * 2) * 64 + lane) * 8; kb[q][0] = *(const bf16x8*)r; kb[q][1] = *(const bf16x8*)(r + 512); }
        };
        ldkg(0, kbuf[0]);
#pragma unroll
        for (int grp = 0; grp < 8; ++grp) {
            if (4 * grp < NT) {
                if (4 * (grp + 1) < NT) ldkg(grp + 1, kbuf[(grp + 1) & 1]);
                __builtin_amdgcn_sched_barrier(0);
#pragma unroll
                for (int q = 0; q < 4; ++q) {
                    const int mt = grp * 4 + q;
                    f32x4 s = mfma16(kbuf[grp & 1][q][0], qB[0], (f32x4){0.f, 0.f, 0.f, 0.f}); s = mfma16(kbuf[grp & 1][q][1], qB[1], s);
                    if (mt < mt_far) { mxf = fmaxf(mxf, fmaxf(fmaxf(s[0], s[1]), fmaxf(s[2], s[3]))); }
                    else {
#pragma unroll
                        for (int i = 0; i < 4; ++i) { const int n = 16 * mt + 4 * G + i; int dist = tc - (16 * n + 31); const bool ok = n < ncv_c; dist = dist < 0 ? 0 : (dist > 128 ? 128 : dist);
                            s[i] = ok ? s[i] + T2[dist * 8 + g * 4 + hh] : -1e30f; }
                        mxn = fmaxf(mxn, fmaxf(fmaxf(s[0], s[1]), fmaxf(s[2], s[3])));
                    }
                    sc[mt] = s;
                }
            } else {
#pragma unroll
                for (int q = 0; q < 4; ++q) sc[grp * 4 + q] = (f32x4){0.f, 0.f, 0.f, 0.f};
            }
        }
        const float mx = grp_max(fmaxf(mxf + b31, mxn));
        const float shf = mx - b31;
#pragma unroll
        for (int mt = 0; mt < 32; ++mt) if ((mt & ~3) < NT) {
            const float sh = mt < mt_far ? shf : mx;
#pragma unroll
            for (int i = 0; i < 4; ++i) sc[mt][i] = ex2(sc[mt][i] - sh);
        }
        const bf16_t* vct = p.VCT + (size_t)(b * NG + g) * 64 * 512;
        const bf16x8 ones = __builtin_bit_cast(bf16x8, (u32x4){0x3F803F80u, 0x3F803F80u, 0x3F803F80u, 0x3F803F80u});
        f32x4 oc[4] = {{0.f, 0.f, 0.f, 0.f}, {0.f, 0.f, 0.f, 0.f}, {0.f, 0.f, 0.f, 0.f}, {0.f, 0.f, 0.f, 0.f}};
        f32x4 rs = {0.f, 0.f, 0.f, 0.f};
        bf16x8 vbuf[2][2][4];
        auto ldvg = [&](int grp, bf16x8 (&vb)[2][4]) __attribute__((always_inline)) {
#pragma unroll
            for (int q = 0; q < 2; ++q)
#pragma unroll
                for (int dt = 0; dt < 4; ++dt) vb[q][dt] = *(const bf16x8*)(vct + ((size_t)((grp * 2 + q) * 4 + dt) * 64 + lane) * 8);
        };
        ldvg(0, vbuf[0]);
#pragma unroll
        for (int grp = 0; grp < 8; ++grp) if (4 * grp < NT) {
            if (4 * (grp + 1) < NT) ldvg(grp + 1, vbuf[(grp + 1) & 1]);
            __builtin_amdgcn_sched_barrier(0);
#pragma unroll
            for (int q = 0; q < 2; ++q) {
                const int k2 = grp * 2 + q;
                const bf16x8 pB = pack_p(sc[2 * k2], sc[2 * k2 + 1]);
                rs = mfma16(ones, pB, rs);
#pragma unroll
                for (int dt = 0; dt < 4; ++dt) oc[dt] = mfma16(vbuf[grp & 1][q][dt], pB, oc[dt]);
            }
        }
        const float inv = ncv_c > 0 ? 1.0f / rs[0] : 0.f;
        if (qb <= 15) {
            msk[0] = (qb >= 31) ? 0xffffffffu : ((2u << qb) - 1u);
        } else {
            unsigned cand[8];
#pragma unroll
            for (int k = 0; k < 8; ++k) cand[k] = 0u;
            float prevB = 0.f;
#pragma unroll
            for (int mt = 0; mt < 32; ++mt) if (mt < NT) {
                const unsigned x3 = __float_as_uint(sc[mt][3]);
                const auto p16 = __builtin_amdgcn_permlane16_swap(x3, x3, false, false);
                const auto p32 = __builtin_amdgcn_permlane32_swap(p16[1], p16[1], false, false);
                const float r1 = G == 2 ? __uint_as_float(p32[0]) : __uint_as_float(p16[0]);
                float v = ((sc[mt][0] + sc[mt][1]) + (sc[mt][2] + sc[mt][3]) + (G == 0 ? prevB : r1)) * inv;
                prevB = __uint_as_float(p32[1]);
                v += dpp_x1(v); v += dpp_x2(v);
                const int j = 4 * mt + G;
                if ((mt & 3) == hh) cand[mt >> 2] = (j >= 1 && j <= qb - 2) ? ((__float_as_uint(v) & ~127u) | (unsigned)(127 - j)) : 0u;
            }
            auto setbit = [&](int j) { const unsigned bit = 1u << (j & 31); const int w = j >> 5; msk[0] |= w == 0 ? bit : 0u; msk[1] |= w == 1 ? bit : 0u; msk[2] |= w == 2 ? bit : 0u; msk[3] |= w == 3 ? bit : 0u; };
            setbit(0); setbit(qb); setbit(qb - 1);
#pragma unroll 1
            for (int it = 0; it < 13; ++it) {
                unsigned bv = cand[0];
#pragma unroll
                for (int k = 1; k < 8; ++k) bv = bv > cand[k] ? bv : cand[k];
                { unsigned o = __builtin_amdgcn_mov_dpp(bv, 0xB1, 0xF, 0xF, true); bv = o > bv ? o : bv; o = __builtin_amdgcn_mov_dpp(bv, 0x4E, 0xF, 0xF, true); bv = o > bv ? o : bv;
                  auto r = __builtin_amdgcn_permlane16_swap(bv, bv, false, false); bv = r[0] > r[1] ? r[0] : r[1]; r = __builtin_amdgcn_permlane32_swap(bv, bv, false, false); bv = r[0] > r[1] ? r[0] : r[1]; }
#pragma unroll
                for (int k = 0; k < 8; ++k) cand[k] = cand[k] == bv ? 0u : cand[k];
                setbit(127 - (int)(bv & 127u));
            }
        }
        const float g0 = gate[0] * inv;
#pragma unroll
        for (int dt = 0; dt < 4; ++dt) oacc[dt] = oc[dt] * g0;
    }
    bf16_t* orow = p.OCAT + qrow * DM + (g * 4 + hh) * 64 + 4 * G;
#pragma unroll
    for (int dt = 0; dt < 4; ++dt) st_bf16x4(orow + dt * 16, oacc[dt]);
}

struct PackSt { bf16x8 q0, q1; float m; f32x4 l4; f32x4 o[4]; };
__device__ __forceinline__ void attn_selwin_pair(const Params& p, int b, int g, int t0, int lane_, LAS unsigned char* L, const unsigned (&mskA)[4], const unsigned (&mskB)[4]) {
    int lane = lane_; asm volatile("" : "+v"(lane));
    const int c = lane & 15, G = lane >> 4, qs = c >> 2, hh = c & 3;
    const int qb = t0 >> 6;
    const LAS float* T2 = (const LAS float*)(L + A_T2);
    const float b31 = T2[128 * 8 + g * 4 + hh];
    const int tcA = t0 + qs, tcB = t0 + 4 + qs;
    const size_t qrowA = (size_t)b * SEQ + tcA;
    PackSt A, B;
    {
        const bf16_t* qa = p.Qb + qrowA * QD + (g * 4 + hh) * 64 + G * 8;
        A.q0 = *(const bf16x8*)qa; A.q1 = *(const bf16x8*)(qa + 32); B.q0 = *(const bf16x8*)(qa + 4 * QD); B.q1 = *(const bf16x8*)(qa + 4 * QD + 32);
    }
    auto reset = [&](PackSt& S) __attribute__((always_inline)) { S.m = -1e30f; S.l4 = (f32x4){0.f, 0.f, 0.f, 0.f};
#pragma unroll
        for (int dt = 0; dt < 4; ++dt) S.o[dt] = (f32x4){0.f, 0.f, 0.f, 0.f}; };
    const bf16x8 ones = __builtin_bit_cast(bf16x8, (u32x4){0x3F803F80u, 0x3F803F80u, 0x3F803F80u, 0x3F803F80u});
    auto finish = [&](PackSt& S, f32x4 (&s)[4], float cb, bool mine, const bf16x8 (&vf)[2][4]) __attribute__((always_inline)) {
        float cm = fmaxf(fmaxf(fmaxf(s[0][0], s[0][1]), fmaxf(s[0][2], s[0][3])), fmaxf(fmaxf(s[1][0], s[1][1]), fmaxf(s[1][2], s[1][3])));
        cm = fmaxf(cm, fmaxf(fmaxf(fmaxf(s[2][0], s[2][1]), fmaxf(s[2][2], s[2][3])), fmaxf(fmaxf(s[3][0], s[3][1]), fmaxf(s[3][2], s[3][3]))));
        cm = grp_max(mine ? cm + cb : -1e30f);
        const float mn = fmaxf(S.m, cm), al = ex2(S.m - mn);
        const float sh = (mine ? mn : 1e30f) - cb;
#pragma unroll
        for (int kt = 0; kt < 4; ++kt)
#pragma unroll
            for (int i = 0; i < 4; ++i) s[kt][i] = ex2(s[kt][i] - sh);
        S.m = mn;
        f32x4 rs = {0.f, 0.f, 0.f, 0.f};
#pragma unroll
        for (int dt = 0; dt < 4; ++dt) S.o[dt] = S.o[dt] * al;
#pragma unroll
        for (int ks = 0; ks < 2; ++ks) { const bf16x8 pB = pack_p(s[2 * ks], s[2 * ks + 1]);
            rs = mfma16(ones, pB, rs);
#pragma unroll
            for (int dt = 0; dt < 4; ++dt) S.o[dt] = mfma16(vf[ks][dt], pB, S.o[dt]); }
        S.l4[0] = S.l4[0] * al + rs[0];
    };
    auto addout = [&](PackSt& S, size_t qrow, int br) __attribute__((always_inline)) {
        const float gs = p.GATE[qrow * 32 + (g * 4 + hh) * 3 + br] / S.l4[0];
        bf16_t* orow = p.OCAT + qrow * DM + (g * 4 + hh) * 64 + 4 * G;
#pragma unroll
        for (int dt = 0; dt < 4; ++dt) { const u32x2 w = *(const u32x2*)(orow + dt * 16); f32x4 pa; pa[0] = bflo(w.x); pa[1] = bfhi(w.x); pa[2] = bflo(w.y); pa[3] = bfhi(w.y);
            st_bf16x4(orow + dt * 16, pa + S.o[dt] * gs); }
    };
    {
        unsigned umA[4], umB[4], um[4];
#pragma unroll
        for (int w = 0; w < 4; ++w) {
            umA[w] = __builtin_amdgcn_readfirstlane(row_or_q(mskA[w]));
            umB[w] = __builtin_amdgcn_readfirstlane(row_or_q(mskB[w]));
            um[w] = umA[w] | umB[w];
        }
        reset(A); reset(B);
        const bf16_t* klane = p.SLCkF + (size_t)(b * NG + g) * SEQ * 64 + lane * 8;
        const bf16_t* vlane = p.SLCvT + (size_t)(b * NG + g) * SEQ * 64 + lane * 8;
        auto ldfr = [&](int j_, bf16x8 (&kf_)[4][2], bf16x8 (&vf_)[2][4]) __attribute__((always_inline)) {
            const bf16_t* kr = klane + (size_t)j_ * 4096; const bf16_t* vr = vlane + (size_t)j_ * 4096;
#pragma unroll
            for (int kt = 0; kt < 4; ++kt) { kf_[kt][0] = *(const bf16x8*)(kr + (kt * 2) * 512); kf_[kt][1] = *(const bf16x8*)(kr + (kt * 2 + 1) * 512); }
#pragma unroll
            for (int ks = 0; ks < 2; ++ks)
#pragma unroll
                for (int dt = 0; dt < 4; ++dt) vf_[ks][dt] = *(const bf16x8*)(vr + (ks * 4 + dt) * 512);
        };
        auto nextj = [&](int& j_) __attribute__((always_inline)) {
            int w = um[0] ? 0 : um[1] ? 1 : um[2] ? 2 : um[3] ? 3 : -1;
            if (w < 0) return false;
            const unsigned u = w == 0 ? um[0] : w == 1 ? um[1] : w == 2 ? um[2] : um[3];
            const int bpos = __builtin_ctz(u);
            j_ = w * 32 + bpos;
            const unsigned cl = ~(1u << bpos);
            if (w == 0) um[0] &= cl; else if (w == 1) um[1] &= cl; else if (w == 2) um[2] &= cl; else um[3] &= cl;
            return true;
        };
        auto packstep = [&](PackSt& S, const unsigned (&msk)[4], int tc, int j, const bf16x8 (&kf)[4][2], const bf16x8 (&vf)[2][4]) __attribute__((always_inline)) {
            const unsigned mw = (j >> 5) == 0 ? msk[0] : (j >> 5) == 1 ? msk[1] : (j >> 5) == 2 ? msk[2] : msk[3];
            const bool mine = (mw >> (j & 31)) & 1u;
            const bool farb = j <= qb - 3;
            f32x4 s[4];
#pragma unroll
            for (int kt = 0; kt < 4; ++kt) { s[kt] = mfma16(kf[kt][0], S.q0, (f32x4){0.f, 0.f, 0.f, 0.f}); s[kt] = mfma16(kf[kt][1], S.q1, s[kt]); }
            if (!farb) {
#pragma unroll
                for (int kt = 0; kt < 4; ++kt)
#pragma unroll
                    for (int i = 0; i < 4; ++i) { const int dist = tc - (j * 64 + 16 * kt + 4 * G + i); const int dd = dist < 0 ? 0 : (dist > 128 ? 128 : dist);
                        s[kt][i] = dist >= 0 ? s[kt][i] + T2[dd * 8 + g * 4 + hh] : -1e30f; }
            }
            finish(S, s, farb ? b31 : 0.f, mine, vf);
        };
        auto blockstep = [&](int j, const bf16x8 (&kf)[4][2], const bf16x8 (&vf)[2][4]) __attribute__((always_inline)) {
            const int w = j >> 5; const unsigned bit = 1u << (j & 31);
            const unsigned ua = w == 0 ? umA[0] : w == 1 ? umA[1] : w == 2 ? umA[2] : umA[3];
            const unsigned ub = w == 0 ? umB[0] : w == 1 ? umB[1] : w == 2 ? umB[2] : umB[3];
            if (ua & bit) packstep(A, mskA, tcA, j, kf, vf);
            if (ub & bit) packstep(B, mskB, tcB, j, kf, vf);
        };
        auto ldk = [&](int j_, bf16x8 (&kf_)[4][2]) __attribute__((always_inline)) {
            const bf16_t* kr = klane + (size_t)j_ * 4096;
#pragma unroll
            for (int kt = 0; kt < 4; ++kt) { kf_[kt][0] = *(const bf16x8*)(kr + (kt * 2) * 512); kf_[kt][1] = *(const bf16x8*)(kr + (kt * 2 + 1) * 512); }
        };
        auto ldv = [&](int j_, bf16x8 (&vf_)[2][4]) __attribute__((always_inline)) {
            const bf16_t* vr = vlane + (size_t)j_ * 4096;
#pragma unroll
            for (int ks = 0; ks < 2; ++ks)
#pragma unroll
                for (int dt = 0; dt < 4; ++dt) vf_[ks][dt] = *(const bf16x8*)(vr + (ks * 4 + dt) * 512);
        };
        bf16x8 kfA[4][2], kfB[4][2], vf[2][4];
        int j = 0; bool have = nextj(j);
        ldk(j, kfA);
#pragma unroll 1
        while (have) {
            int jn = j; bool haven = nextj(jn);
            ldv(j, vf); ldk(jn, kfB);
            __builtin_amdgcn_sched_barrier(0);
            blockstep(j, kfA, vf);
            if (!haven) break;
            j = jn; have = nextj(jn);
            ldv(j, vf); ldk(jn, kfA);
            __builtin_amdgcn_sched_barrier(0);
            blockstep(j, kfB, vf);
            j = jn;
        }
        addout(A, qrowA, 1); addout(B, qrowA + 4, 1);
    }
    {
        reset(A); reset(B);
        const int loA = t0 - WIN > 0 ? t0 - WIN : 0, hiA = t0 + 3, loB = t0 + 4 - WIN > 0 ? t0 + 4 - WIN : 0, hiB = t0 + 7;
        const bf16_t* klane = p.WINkF + (size_t)(b * NG + g) * SEQ * 64 + lane * 8;
        const bf16_t* vlane = p.WINvT + (size_t)(b * NG + g) * SEQ * 64 + lane * 8;
        auto ldfr = [&](int cb_, bf16x8 (&kf_)[4][2], bf16x8 (&vf_)[2][4]) __attribute__((always_inline)) {
            const bf16_t* kr = klane + (size_t)cb_ * 64; const bf16_t* vr = vlane + (size_t)cb_ * 64;
#pragma unroll
            for (int kt = 0; kt < 4; ++kt) { kf_[kt][0] = *(const bf16x8*)(kr + (kt * 2) * 512); kf_[kt][1] = *(const bf16x8*)(kr + (kt * 2 + 1) * 512); }
#pragma unroll
            for (int ks = 0; ks < 2; ++ks)
#pragma unroll
                for (int dt = 0; dt < 4; ++dt) vf_[ks][dt] = *(const bf16x8*)(vr + (ks * 4 + dt) * 512);
        };
        auto packstep = [&](PackSt& S, int tq0, int tc, int cb, const bf16x8 (&kf)[4][2], const bf16x8 (&vf)[2][4]) __attribute__((always_inline)) {
            const bool far = (cb + 63 <= tq0 - 128) && (cb >= tq0 + 3 - WIN);
            f32x4 s[4];
#pragma unroll
            for (int kt = 0; kt < 4; ++kt) { s[kt] = mfma16(kf[kt][0], S.q0, (f32x4){0.f, 0.f, 0.f, 0.f}); s[kt] = mfma16(kf[kt][1], S.q1, s[kt]); }
            if (!far) {
#pragma unroll
                for (int kt = 0; kt < 4; ++kt)
#pragma unroll
                    for (int i = 0; i < 4; ++i) { const int dist = tc - (cb + 16 * kt + 4 * G + i); const bool ok = dist >= 0 && dist <= WIN; const int dd = dist < 0 ? 0 : (dist > 128 ? 128 : dist);
                        s[kt][i] = ok ? s[kt][i] + T2[dd * 8 + g * 4 + hh] : -1e30f; }
            }
            finish(S, s, far ? b31 : 0.f, true, vf);
        };
        auto chunkstep = [&](int cb, const bf16x8 (&kf)[4][2], const bf16x8 (&vf)[2][4]) __attribute__((always_inline)) {
            if (cb <= hiA) packstep(A, t0, tcA, cb, kf, vf);
            if (cb + 63 >= loB) packstep(B, t0 + 4, tcB, cb, kf, vf);
        };
        auto ldk = [&](int cb_, bf16x8 (&kf_)[4][2]) __attribute__((always_inline)) {
            const bf16_t* kr = klane + (size_t)cb_ * 64;
#pragma unroll
            for (int kt = 0; kt < 4; ++kt) { kf_[kt][0] = *(const bf16x8*)(kr + (kt * 2) * 512); kf_[kt][1] = *(const bf16x8*)(kr + (kt * 2 + 1) * 512); }
        };
        auto ldv = [&](int cb_, bf16x8 (&vf_)[2][4]) __attribute__((always_inline)) {
            const bf16_t* vr = vlane + (size_t)cb_ * 64;
#pragma unroll
            for (int ks = 0; ks < 2; ++ks)
#pragma unroll
                for (int dt = 0; dt < 4; ++dt) vf_[ks][dt] = *(const bf16x8*)(vr + (ks * 4 + dt) * 512);
        };
        bf16x8 kfA[4][2], kfB[4][2], vf[2][4];
        int cb = loA & ~63;
        ldk(cb, kfA);
#pragma unroll 1
        for (;;) {
            ldv(cb, vf); ldk(cb + 64 <= hiB ? cb + 64 : cb, kfB);
            __builtin_amdgcn_sched_barrier(0);
            chunkstep(cb, kfA, vf);
            cb += 64; if (cb > hiB) break;
            ldv(cb, vf); ldk(cb + 64 <= hiB ? cb + 64 : cb, kfA);
            __builtin_amdgcn_sched_barrier(0);
            chunkstep(cb, kfB, vf);
            cb += 64; if (cb > hiB) break;
        }
        addout(A, qrowA, 2); addout(B, qrowA + 4, 2);
    }
}

__device__ __forceinline__ void phase_attn(const Params& p) {
    const int wid = threadIdx.x >> 6, lane = threadIdx.x & 63;
    { PROBE_BEGIN(3)
    if (blockIdx.x < NS * NG) attn_sample_item(p, blockIdx.x >> 1, blockIdx.x & 1);
    PROBE_END(3) }
    LAS unsigned char* L = (LAS unsigned char*)smem;
    for (int i = threadIdx.x; i < 129 * 8; i += 512) ((LAS float*)(L + A_T2))[i] = p.rel_bias[t5_bucket(i >> 3) * 8 + (i & 7)] * LOG2E;
    __syncthreads();
    {
        const int wid2 = __builtin_amdgcn_readfirstlane(threadIdx.x >> 6);
#pragma unroll 1
        for (;;) {
            __syncthreads();
            if (threadIdx.x == 0) ((LAS int*)(L + A_NP))[1] = (int)__hip_atomic_fetch_add(p.bar, 1u, __ATOMIC_RELAXED, __HIP_MEMORY_SCOPE_AGENT);
            __syncthreads();
            const int T = ((const LAS int*)(L + A_NP))[1];
            if (T >= NB * NG * (SEQ / 64)) break;
            const int bg = T & 7, qb = (SEQ / 64 - 1) - (T >> 3), t0 = qb * 64 + wid2 * 8;
            unsigned mA[4], mB[4];
            PROBE_BEGIN(6)
            attn_cmp(p, bg >> 1, bg & 1, t0, lane, L, mA);
            attn_cmp(p, bg >> 1, bg & 1, t0 + 4, lane, L, mB);
            PROBE_END(6)
            PROBE_BEGIN(7)
            attn_selwin_pair(p, bg >> 1, bg & 1, t0, lane, L, mA, mB);
            PROBE_END(7)
        }
    }
    __syncthreads();
}

constexpr int GM_LD = 136, GM_LDS = 128 * GM_LD * 2 + 1024;
__device__ __forceinline__ void phase_gmlp(const Params& p) {
    int tid = threadIdx.x; asm volatile("" : "+v"(tid));
    const int wid = __builtin_amdgcn_readfirstlane(tid >> 6), lane = tid & 63;
    LAS bf16_t* vnT = (LAS bf16_t*)smem;
    LAS float* mu = (LAS float*)(smem + 128 * GM_LD * 2);
    const int c = lane & 15, G = lane >> 4;
#pragma unroll 1
    for (int u = blockIdx.x; u < NB * 64; u += gridDim.x) {
        const int b = u >> 6, ch = u & 63; const size_t row0 = (size_t)b * SEQ + ch * 128;
        __syncthreads();
        for (int r = wid; r < 128; r += 8) {
            const u32x4 w = *(const u32x4*)(p.Vg + (row0 + r) * GMD + lane * 8);
            const float x[8] = {bflo(w.x), bfhi(w.x), bflo(w.y), bfhi(w.y), bflo(w.z), bfhi(w.z), bflo(w.w), bfhi(w.w)};
            float s = 0.f;
#pragma unroll
            for (int i = 0; i < 8; ++i) s += x[i];
            const float mean = wave_sum(s) * (1.0f / GMD);
            float q = 0.f;
#pragma unroll
            for (int i = 0; i < 8; ++i) q += (x[i] - mean) * (x[i] - mean);
            const float var = wave_sum(q) * (1.0f / GMD);
            if (lane == 0) { mu[r] = mean; mu[128 + r] = rsqrtf(var + EPS); }
        }
#pragma unroll 1
        for (int g = 0; g < 4; ++g) {
            __syncthreads();
#pragma unroll
            for (int k = 0; k < 4; ++k) {
                const int e = tid + 512 * k, s = e & 127, d0 = (e >> 7) * 8;
                const u32x4 w = *(const u32x4*)(p.Vg + (row0 + s) * GMD + g * 128 + d0);
                const float x[8] = {bflo(w.x), bfhi(w.x), bflo(w.y), bfhi(w.y), bflo(w.z), bfhi(w.z), bflo(w.w), bfhi(w.w)};
                const float m = mu[s], rs = mu[128 + s];
#pragma unroll
                for (int i = 0; i < 8; ++i) { const int cc = g * 128 + d0 + i; vnT[(d0 + i) * GM_LD + s] = f2bf((x[i] - m) * rs * p.gm_ln_g[cc] + p.gm_ln_b[cc]); }
            }
            __syncthreads();
            f32x4 acc[8];
#pragma unroll
            for (int dt = 0; dt < 8; ++dt) acc[dt] = (f32x4){0.f, 0.f, 0.f, 0.f};
            const bf16_t* wrow = p.GWb + ((size_t)g * 128 + 16 * wid + c) * 128 + 8 * G;
#pragma unroll 1
            for (int ks = 0; ks <= (wid >> 1); ++ks) {
                const bf16x8 B = *(const bf16x8*)(wrow + 32 * ks);
#pragma unroll
                for (int dt = 0; dt < 8; ++dt) {
                    const bf16x8 A = *(const LAS bf16x8*)(vnT + (dt * 16 + c) * GM_LD + 32 * ks + 8 * G);
                    acc[dt] = mfma16(A, B, acc[dt]);
                }
            }
            const int t = 16 * wid + c;
            const float bs = p.gm_bs[g * 128 + t];
#pragma unroll
            for (int dt = 0; dt < 8; ++dt) {
                const int d = dt * 16 + 4 * G;
                const u32x2 uw = *(const u32x2*)(p.U + (row0 + t) * GMD + g * 128 + d);
                f32x4 o; o[0] = bflo(uw.x) * (acc[dt][0] + bs); o[1] = bfhi(uw.x) * (acc[dt][1] + bs); o[2] = bflo(uw.y) * (acc[dt][2] + bs); o[3] = bfhi(uw.y) * (acc[dt][3] + bs);
                st_bf16x4(p.OCAT + (row0 + t) * DM + QD + g * 128 + d, o);
            }
        }
    }
    for (int it = blockIdx.x * 8 + wid; it < NS; it += gridDim.x * 8) {
        const size_t row = (size_t)MP + it;
        const u32x4 w = *(const u32x4*)(p.Vg + row * GMD + lane * 8);
        const float x[8] = {bflo(w.x), bfhi(w.x), bflo(w.y), bfhi(w.y), bflo(w.z), bfhi(w.z), bflo(w.w), bfhi(w.w)};
        float s = 0.f;
#pragma unroll
        for (int i = 0; i < 8; ++i) s += x[i];
        const float mean = wave_sum(s) * (1.0f / GMD);
        float q = 0.f;
#pragma unroll
        for (int i = 0; i < 8; ++i) q += (x[i] - mean) * (x[i] - mean);
        const float rs = rsqrtf(wave_sum(q) * (1.0f / GMD) + EPS);
#pragma unroll
        for (int i = 0; i < 8; ++i) {
            const int c = lane * 8 + i, g = c >> 7;
            const float v = (x[i] - mean) * rs * p.gm_ln_g[c] + p.gm_ln_b[c];
            p.out[O_GMV + (size_t)it * GMD + c] = v;
            const float a = p.gm_ws[(size_t)g * 128 * 128] * v + p.gm_bs[g * 128];
            p.OCAT[row * DM + QD + c] = f2bf(bf2f(p.U[row * GMD + c]) * a);
        }
    }
}

template <int MODE>
__device__ __forceinline__ void phase_norm(const Params& p) {
    const int wid = threadIdx.x >> 6, lane = threadIdx.x & 63;
    const float* gpost = MODE == 0 ? p.ln_mix_post : MODE == 1 ? p.ln_ffn_post : p.ln_ple_post;
    for (int row = blockIdx.x * 8 + wid; row < MP + NS; row += gridDim.x * 8) {
        const bf16_t* fr = (const bf16_t*)p.F + (size_t)row * DM;
        const bf16_t* xb = MODE == 1 ? (const bf16_t*)p.X1 + (size_t)row * DM : p.X2b + (size_t)row * DM;
        f32x4 f[4], x[4];
#pragma unroll
        for (int k = 0; k < 4; ++k) { const u32x2 w = *(const u32x2*)(fr + lane * 4 + k * 256); f[k][0] = bflo(w.x); f[k][1] = bfhi(w.x); f[k][2] = bflo(w.y); f[k][3] = bfhi(w.y);
            if (MODE == 0) x[k] = *(const f32x4*)(xrow_ptr(p, row) + lane * 4 + k * 256);
            else { const u32x2 v = *(const u32x2*)(xb + lane * 4 + k * 256); x[k][0] = bflo(v.x); x[k][1] = bfhi(v.x); x[k][2] = bflo(v.y); x[k][3] = bfhi(v.y); } }
        const float r = row_rstd(f);
#pragma unroll
        for (int k = 0; k < 4; ++k) { const f32x4 g = *(const f32x4*)(gpost + lane * 4 + k * 256); x[k] = x[k] + f[k] * r * g; }
        if (MODE == 0) {
            const float r2 = row_rstd(x);
#pragma unroll
            for (int k = 0; k < 4; ++k) {
                st_bf16x4((bf16_t*)p.X1 + (size_t)row * DM + lane * 4 + k * 256, x[k]);
                const f32x4 g = *(const f32x4*)(p.ln_ffn_pre + lane * 4 + k * 256); const f32x4 o = x[k] * r2 * g;
                st_bf16x4(p.H2 + (size_t)row * DM + lane * 4 + k * 256, o);
            }
        } else if (MODE == 1) {
#pragma unroll
            for (int k = 0; k < 4; ++k) st_bf16x4(p.X2b + (size_t)row * DM + lane * 4 + k * 256, x[k]);
        } else {
            float* yr = row < MP ? p.out + O_YP + (size_t)row * DM : p.out + O_YS + (size_t)(row - MP) * DM;
#pragma unroll
            for (int k = 0; k < 4; ++k) *(f32x4*)(yr + lane * 4 + k * 256) = x[k];
        }
    }
}


#define XB_TMO      128
#define XB_XCNT(j)  (256  + 64 * (j))
#define XB_XSUB(j)  (1280 + 64 * (j))
#define XB_XGEN(j)  (2304 + 64 * (j))
#define XB_TOP      3328
#define XB_TOPGEN   3392
#define XCD_BAR_WORDS 3456
#define XB_SPIN_CAP (1u << 22)

__device__ __forceinline__ unsigned xb_ld(unsigned* p)              { return __hip_atomic_load(p, __ATOMIC_RELAXED, __HIP_MEMORY_SCOPE_AGENT); }
__device__ __forceinline__ unsigned xb_add(unsigned* p, unsigned v) { return __hip_atomic_fetch_add(p, v, __ATOMIC_RELAXED, __HIP_MEMORY_SCOPE_AGENT); }
__device__ __forceinline__ unsigned xb_xcc_id() { return (unsigned)__builtin_amdgcn_s_getreg((3 << 11) | 20) & 0xFu; }
#define XB_SPIN(cond, bar) do { unsigned _sp = 0; while (cond) { __builtin_amdgcn_s_sleep(1); \
    if ((++_sp & 255u) == 0u) { if (xb_ld(&(bar)[XB_TMO])) break; if (_sp > XB_SPIN_CAP) { atomicAdd(&(bar)[XB_TMO], 1u); break; } } } } while (0)

struct XcdBarrier {
    unsigned* bar; unsigned x;
    volatile LAS unsigned* st;
};

__device__ __forceinline__ XcdBarrier xcd_barrier_post(unsigned* bar, volatile LAS unsigned* st) {
    XcdBarrier b; b.bar = bar; b.x = xb_xcc_id(); b.st = st;
    if (threadIdx.x == 0) (void)xb_add(&bar[XB_XCNT(b.x)], 1u);
    return b;
}
__device__ __forceinline__ void xcd_barrier_complete(unsigned* bar, unsigned x, unsigned& nloc, unsigned& nx) {
    const unsigned G = gridDim.x * gridDim.y * gridDim.z;
    unsigned sum, cnt, mine, sp = 0u;
    for (;;) {
        sum = 0u; cnt = 0u; mine = 0u;
#pragma unroll
        for (unsigned j = 0; j < 16; ++j) { const unsigned c = xb_ld(&bar[XB_XCNT(j)]); sum += c; cnt += (c > 0u) ? 1u : 0u; mine = (j == x) ? c : mine; }
        if (sum == G) break;
        __builtin_amdgcn_s_sleep(1);
        if ((++sp & 255u) == 0u) { if (xb_ld(&bar[XB_TMO])) break; if (sp > XB_SPIN_CAP) { atomicAdd(&bar[XB_TMO], 1u); break; } }
    }
    nloc = mine > 0u ? mine : 1u; nx = cnt > 0u ? cnt : 1u;
}

__device__ __forceinline__ void xcd_barrier(const XcdBarrier& b) {
    asm volatile("s_waitcnt vmcnt(0)" ::: "memory");
    __syncthreads();
    if (threadIdx.x == 0) {
        unsigned* bar = b.bar;
        __builtin_amdgcn_s_waitcnt(0);
        unsigned nloc = b.st[0], nx = b.st[1];
        if (nloc == 0u) { xcd_barrier_complete(bar, b.x, nloc, nx); b.st[0] = nloc; b.st[1] = nx; }
        const unsigned old = xb_add(&bar[XB_XSUB(b.x)], 1u);
        const unsigned gen = old / nloc;
        if (old + 1u == (gen + 1u) * nloc) {
            __builtin_amdgcn_fence(__ATOMIC_RELEASE, "agent");
            asm volatile("s_waitcnt vmcnt(0)" ::: "memory");
            const unsigned og = xb_add(&bar[XB_TOP], 1u);
            const unsigned tg = og / nx;
            if (og + 1u == (tg + 1u) * nx) xb_add(&bar[XB_TOPGEN], 1u);
            else XB_SPIN(xb_ld(&bar[XB_TOPGEN]) == tg, bar);
            __builtin_amdgcn_fence(__ATOMIC_ACQUIRE, "agent");
            xb_add(&bar[XB_XGEN(b.x)], 1u);
            asm volatile("s_waitcnt vmcnt(0)" ::: "memory");
        } else {
            XB_SPIN(xb_ld(&bar[XB_XGEN(b.x)]) == gen, bar);
            __builtin_amdgcn_fence(__ATOMIC_ACQUIRE, "agent");
            asm volatile("s_waitcnt vmcnt(0)" ::: "memory");
        }
    }
    __syncthreads();
}

constexpr int NPHASE = 16;
constexpr int LDS_BYTES = GEMM_LDS;
static_assert(GM_LDS <= LDS_BYTES, "lds");
constexpr int NMT = MALL / BM;

constexpr int NMP = MP / BM;
template <int PH>
__device__ __forceinline__ void run_phase(const Params& p) {
    if (PH == 0) phase_prologue(p);
    if (PH == 1) { EpiIn e{p}; if (blockIdx.x & 1) phase_gather(p); gemm_phase(p.H, DM, p.WinT, DM, NMP, INP / BM, e); gemm_skinny(p.H + (size_t)MP * DM, DM, p.WinT, DM, INP, e); if (!(blockIdx.x & 1)) phase_gather(p); }
    if (PH == 2) { EpiPart e{(bf16_t*)p.PART}; gemm_phase(p.CMPb, 4096, p.W1T, 1024, (2048 + NS * 1024) / BM, 1, e, 4, ZCmp(), 256); phase_deferred_transposes(p); }
    if (PH == 3) phase_cmp_final(p);
    if (PH == 4) phase_attn(p);
    if (PH == 5) phase_gmlp(p);
    if (PH == 6) { EpiBranch e{p.GA, p.GB, p.Y1}; gemm_phase<EpiBranch, ZNone, true>(p.OCAT, DM, p.WnT, DM, NMP, DM / BM, e); gemm_skinny2(p.OCAT + (size_t)MP * DM, DM, p.WnT, DM, DM, e); }
    if (PH == 8) { EpiBf16 e{(bf16_t*)p.F, DM}; gemm_phase(p.Y1, DM, p.WoT, DM, NMP, DM / BM, e); gemm_skinny(p.Y1 + (size_t)MP * DM, DM, p.WoT, DM, DM, e); }
    if (PH == 9) phase_norm<0>(p);
    if (PH == 10) { EpiSwiGLU e{p.ACT}; gemm_phase(p.H2, DM, p.WguT, DM, NMP, 2 * DFF / BM, e); gemm_skinny(p.H2 + (size_t)MP * DM, DM, p.WguT, DM, 2 * DFF, e); }
    if (PH == 11) { EpiBf16 e{(bf16_t*)p.F, DM}; gemm_phase(p.ACT, DFF, p.WdT, DFF, NMP, DM / BM, e); gemm_skinny(p.ACT + (size_t)MP * DFF, DFF, p.WdT, DFF, DM, e); }
    if (PH == 12) phase_norm<1>(p);
    if (PH == 13) { EpiBf16 e{(bf16_t*)p.T, DM}; gemm_phase(p.Pb, PLE, p.WpT, PLE, NMP, DM / BM, e); gemm_skinny(p.Pb + (size_t)MP * PLE, PLE, p.WpT, PLE, DM, e); }
    if (PH == 14) { EpiPleGate e{(const bf16_t*)p.T, (bf16_t*)p.F}; gemm_phase(p.X2b, DM, p.WpgT, DM, NMP, DM / BM, e); gemm_skinny(p.X2b + (size_t)MP * DM, DM, p.WpgT, DM, DM, e); }
    if (PH == 15) phase_norm<2>(p);
}

#ifndef MK_MULTI
#define MK_MULTI 0
#endif
template <int PH>
__global__ void __launch_bounds__(512, 2) k_phase(Params p) { run_phase<PH>(p); }

__global__ void __launch_bounds__(512, 2) k_all(Params p) {
    volatile LAS unsigned* st = (volatile LAS unsigned*)((LAS unsigned char*)smem + LDS_BYTES);
    if (threadIdx.x < 12) st[threadIdx.x] = 0u;
    __syncthreads();
    XcdBarrier bar = xcd_barrier_post(p.bar, st);
#if PROBE_DUP == 100
    run_phase<0>(p);  xcd_barrier(bar);
#endif
#if PROBE_SPIN >= 100
    if (threadIdx.x == 0) PROBE_TS[3] = probe_now();
#define PROBE_STAMP(k) if (threadIdx.x == 0 && PROBE_SEG == (k)) PROBE_TS[2] = probe_now() - PROBE_TS[3];
#else
#define PROBE_STAMP(k)
#endif
    run_phase<0>(p);  xcd_barrier(bar);
    PROBE_STAMP(20)
    run_phase<1>(p);  xcd_barrier(bar);
    PROBE_STAMP(21)
    run_phase<2>(p);  xcd_barrier(bar);
#if PROBE_DUP == 100
    run_phase<3>(p);  xcd_barrier(bar);
#endif
    run_phase<3>(p);  xcd_barrier(bar);
    PROBE_STAMP(23)
#if PROBE_DUP == 104
    run_phase<4>(p);  xcd_barrier(bar);
#endif
    run_phase<4>(p);
#if PROBE_DUP == 100
    run_phase<5>(p);  xcd_barrier(bar);
#endif
    run_phase<5>(p);  xcd_barrier(bar);
    PROBE_STAMP(25)
    run_phase<6>(p);  xcd_barrier(bar);
    run_phase<8>(p);  xcd_barrier(bar);
    PROBE_STAMP(28)
    run_phase<9>(p);  xcd_barrier(bar);
    PROBE_STAMP(29)
    run_phase<10>(p); xcd_barrier(bar);
    PROBE_STAMP(30)
    run_phase<11>(p); xcd_barrier(bar);
    PROBE_STAMP(31)
    run_phase<12>(p);
    run_phase<13>(p); xcd_barrier(bar);
    run_phase<14>(p); xcd_barrier(bar);
    PROBE_STAMP(34)
    run_phase<15>(p);
#if PROBE_SPIN
    if (blockIdx.x == 0 && threadIdx.x == 0) {
        const unsigned long long d = PROBE_TS[2] * (PROBE_SPIN >= 100 ? PROBE_SPIN - 100 : PROBE_SPIN), t0 = probe_now();
        while (probe_now() - t0 < d) __builtin_amdgcn_s_sleep(8);
    }
#endif
}

static inline size_t al256(size_t x) { return (x + 255) & ~(size_t)255; }
template <int PH> static void launch_phase(const Params& p, int grid, hipStream_t s) {
    static bool attr = false;
    if (!attr) { (void)hipFuncSetAttribute((const void*)k_phase<PH>, hipFuncAttributeMaxDynamicSharedMemorySize, LDS_BYTES); attr = true; }
    k_phase<PH><<<grid, 512, LDS_BYTES, s>>>(p);
}
template <int PH> static void launch_all(const Params& p, int grid, hipStream_t s) {
    launch_phase<PH>(p, grid, s);
    if constexpr (PH + 1 < NPHASE) launch_all<PH + 1>(p, grid, s);
}

extern "C" void kernel_launch(void* const* d_in, const int* in_sizes, int n_in, void* d_out, int out_size, void* d_ws, size_t ws_size, hipStream_t stream) {
    Params p{};
    p.x_prompt = (const float*)d_in[0]; p.x_sample = (const float*)d_in[1]; p.cache_cmp = (const float*)d_in[2]; p.cache_slc = (const float*)d_in[3];
    p.state_win = (const float*)d_in[4]; p.page_table = (const int*)d_in[5]; p.p_prompt = (const float*)d_in[6]; p.p_sample = (const float*)d_in[7];
    p.rel_bias = (const float*)d_in[8]; p.ln_mix_pre = (const float*)d_in[9]; p.w_in = (const float*)d_in[10];
    p.pe_k = (const float*)d_in[11]; p.w1_k = (const float*)d_in[12]; p.w2_k = (const float*)d_in[13];
    p.pe_v = (const float*)d_in[14]; p.w1_v = (const float*)d_in[15]; p.w2_v = (const float*)d_in[16];
    p.gm_ln_g = (const float*)d_in[17]; p.gm_ln_b = (const float*)d_in[18]; p.gm_ws = (const float*)d_in[19]; p.gm_bs = (const float*)d_in[20];
    p.w_br_nsa = (const float*)d_in[21]; p.w_br_gm = (const float*)d_in[22]; p.w_out = (const float*)d_in[23];
    p.ln_mix_post = (const float*)d_in[24]; p.ln_ffn_pre = (const float*)d_in[25]; p.w_gate = (const float*)d_in[26]; p.w_up = (const float*)d_in[27];
    p.w_down = (const float*)d_in[28]; p.ln_ffn_post = (const float*)d_in[29]; p.w_ple = (const float*)d_in[30]; p.w_ple_gate = (const float*)d_in[31];
    p.ln_ple_post = (const float*)d_in[32];
    p.out = (float*)d_out;
    unsigned char* w = (unsigned char*)d_ws; size_t off = 0;
    auto take = [&](size_t bytes) { void* r = w + off; off = al256(off + bytes); return r; };
    p.bar = (unsigned*)take(16384);
    p.WinT = (bf16_t*)take((size_t)INP * DM * 2); p.WnT = (bf16_t*)take((size_t)DM * DM * 2); p.WgT = nullptr;
    p.WoT = (bf16_t*)take((size_t)DM * DM * 2); p.WguT = (bf16_t*)take((size_t)2 * DFF * DM * 2); p.WdT = (bf16_t*)take((size_t)DM * DFF * 2);
    p.WpgT = (bf16_t*)take((size_t)DM * DM * 2); p.WpT = (bf16_t*)take((size_t)DM * PLE * 2); p.W1T = (bf16_t*)take((size_t)2 * 256 * 1024 * 2);
    p.H = (bf16_t*)take((size_t)MALL * DM * 2); p.Qb = (bf16_t*)take((size_t)MALL * QD * 2);
    p.CMPb = (bf16_t*)take(((size_t)MP + (size_t)NS * PAST) * 256 * 2); p.SLCb = (bf16_t*)take((size_t)MALL * 256 * 2); p.WINb = (bf16_t*)take((size_t)MALL * 256 * 2);
    p.U = (bf16_t*)take((size_t)MALL * GMD * 2); p.Vg = (bf16_t*)take((size_t)MALL * GMD * 2);
    p.GA = (bf16_t*)take((size_t)MALL * DM * 2); p.GB = (bf16_t*)take((size_t)MALL * DM * 2);
    p.GATE = (float*)take((size_t)MALL * 32 * 4);
    p.PART = (float*)take((size_t)(2048 + NS * 1024) * 4 * 256 * 4); p.PEB = (float*)take(256 * 4);
    p.KCP = (float*)take((size_t)NB * NG * 512 * 64 * 4); p.VCP = (float*)take((size_t)NB * NG * 512 * 64 * 4);
    p.KCS = (float*)take((size_t)NS * NG * 1024 * 64 * 4); p.VCS = (float*)take((size_t)NS * NG * 1024 * 64 * 4); p.KN = (float*)take(NB * NG * 128 * 4);
    p.KCb = (bf16_t*)take((size_t)NB * NG * 512 * 64 * 2); p.VCT = (bf16_t*)take((size_t)NB * NG * 64 * 512 * 2);
    p.SLCvT = (bf16_t*)take((size_t)NB * NG * 64 * SEQ * 2); p.WINvT = (bf16_t*)take((size_t)NB * NG * 64 * SEQ * 2);
    p.GWb = (bf16_t*)take(4 * 128 * 128 * 2); p.W2T = (bf16_t*)take(2 * 64 * 128 * 2);
    p.SLCkF = (bf16_t*)take((size_t)NB * NG * 64 * SEQ * 2); p.WINkF = (bf16_t*)take((size_t)NB * NG * 64 * SEQ * 2);
    p.OCAT = (bf16_t*)take((size_t)MALL * DM * 2); p.T = (float*)take((size_t)MALL * DM * 4); p.Y1 = (bf16_t*)take((size_t)MALL * DM * 2);
    p.F = (float*)take((size_t)MALL * DM * 4); p.X1 = (float*)take((size_t)MALL * DM * 4); p.H2 = (bf16_t*)take((size_t)MALL * DM * 2);
    p.ACT = (bf16_t*)take((size_t)MALL * DFF * 2); p.X2 = (float*)take((size_t)MALL * DM * 4); p.X2b = (bf16_t*)take((size_t)MALL * DM * 2);
    p.Pb = (bf16_t*)take((size_t)MALL * PLE * 2);
    if (off > ws_size) { fprintf(stderr, "workspace too small: need %zu have %zu\n", off, ws_size); return; }
#if MK_MULTI
    launch_all<0>(p, 256, stream);
#else
    constexpr size_t kDynLds = LDS_BYTES + 48;
    static int grid = 0;
    if (!grid) {
        int dev = 0, cus = 0, per_cu = 0;
        (void)hipGetDevice(&dev);
        (void)hipDeviceGetAttribute(&cus, hipDeviceAttributeMultiprocessorCount, dev);
        (void)hipFuncSetAttribute((const void*)k_all, hipFuncAttributeMaxDynamicSharedMemorySize, (int)kDynLds);
        (void)hipOccupancyMaxActiveBlocksPerMultiprocessor(&per_cu, (const void*)k_all, 512, kDynLds);
        grid = cus * (per_cu < 1 ? per_cu : 1);
        if (grid <= 0) { fprintf(stderr, "k_all: occupancy query says %d blocks per CU\n", per_cu); grid = 0; return; }
    }
    (void)hipMemsetAsync(p.bar, 0, XCD_BAR_WORDS * sizeof(unsigned), stream);
    k_all<<<grid, 512, kDynLds, stream>>>(p);
#endif
}
```

```cpp
#include <hip/hip_runtime.h>
#include <stdint.h>
#include <cstdio>

typedef unsigned short bf16_t;
typedef short bf16x8 __attribute__((ext_vector_type(8)));
typedef float f32x4 __attribute__((ext_vector_type(4)));
typedef float f32x2 __attribute__((ext_vector_type(2)));
typedef unsigned u32x4 __attribute__((ext_vector_type(4)));
typedef unsigned u32x2 __attribute__((ext_vector_type(2)));
#define LAS __attribute__((address_space(3)))

constexpr int DM = 1024, NB = 4, SEQ = 8192, MP = NB * SEQ, NS = 32, MALL = MP + 256, PAST = 16384, PAGE = 128, NPG = 128;
constexpr int NH = 8, NG = 2, HPG = 4, DH = 64, QD = 512, WIN = 512, GMD = 512, DFF = 2816, PLE = 256, IND = 4376, INP = 4608;
constexpr int NCP = 511, NCS = 1023;
constexpr float EPS = 1e-6f;
constexpr float LOG2E = 1.4426950408889634f, QSCALE = 0.125f * LOG2E;
constexpr long O_YP = 0, O_YS = 33554432, O_CMPP = 33587200, O_SLCP = 41975808, O_WINP = 50364416, O_CMPS = 50888704,
               O_SLCS = 50896896, O_WINS = 50905088, O_GMV = 55099392;

struct Params {
    const float *x_prompt, *x_sample, *cache_cmp, *cache_slc, *state_win; const int* page_table;
    const float *p_prompt, *p_sample, *rel_bias, *ln_mix_pre, *w_in, *pe_k, *w1_k, *w2_k, *pe_v, *w1_v, *w2_v;
    const float *gm_ln_g, *gm_ln_b, *gm_ws, *gm_bs, *w_br_nsa, *w_br_gm, *w_out, *ln_mix_post, *ln_ffn_pre;
    const float *w_gate, *w_up, *w_down, *ln_ffn_post, *w_ple, *w_ple_gate, *ln_ple_post;
    float* out;
    unsigned* bar;
    bf16_t *WinT, *WnT, *WgT, *WoT, *WguT, *WdT, *WpgT, *WpT, *W1T;
    bf16_t *H, *Qb, *CMPb, *SLCb, *WINb, *U, *Vg, *GA, *GB;
    float* GATE;
    float *PART, *PEB, *KCP, *VCP, *KCS, *VCS, *KN;
    bf16_t *KCb, *VCT, *SLCvT, *WINvT, *SLCkF, *WINkF, *GWb, *W2T;
    bf16_t* OCAT; float* T; bf16_t* Y1; float* F; float* X1; bf16_t* H2; bf16_t* ACT; float* X2; bf16_t* X2b; bf16_t* Pb;
};

typedef __bf16 bf16v2_t __attribute__((ext_vector_type(2)));
__device__ __forceinline__ unsigned cvt_pk_bf16(float lo, float hi) { const f32x2 v = {lo, hi}; return __builtin_bit_cast(unsigned, __builtin_convertvector(v, bf16v2_t)); }
__device__ __forceinline__ unsigned cvt_pk_bf16_t(float lo, float hi) { unsigned r; asm volatile("s_nop 1\n\tv_cvt_pk_bf16_f32 %0, %1, %2" : "=v"(r) : "v"(lo), "v"(hi)); return r; }
__device__ __forceinline__ bf16_t f2bf(float f) { return (bf16_t)(cvt_pk_bf16(f, 0.f) & 0xffffu); }
__device__ __forceinline__ float bf2f(bf16_t h) { return __uint_as_float(((unsigned)h) << 16); }
__device__ __forceinline__ float bflo(unsigned w) { return __uint_as_float(w << 16); }
__device__ __forceinline__ float bfhi(unsigned w) { return __uint_as_float(w & 0xffff0000u); }
__device__ __forceinline__ float ex2(float x) { return __builtin_amdgcn_exp2f(x); }
__device__ __forceinline__ float sigmoidf_(float x) { return __builtin_amdgcn_rcpf(1.0f + __builtin_amdgcn_exp2f(x * -1.4426950408889634f)); }
__device__ __forceinline__ float siluf_(float x) { return x * sigmoidf_(x); }
__device__ __forceinline__ float sigmoid_fast(float x) { return __builtin_amdgcn_rcpf(1.0f + __builtin_amdgcn_exp2f(x * -1.4426950408889634f)); }
__device__ __forceinline__ float gelu_fast(float x) {
    const float t = x * (-2.0f * 0.7978845608028654f * 1.4426950408889634f) * (1.0f + 0.044715f * x * x);
    return x * __builtin_amdgcn_rcpf(1.0f + __builtin_amdgcn_exp2f(t));
}
__device__ __forceinline__ float silu_fast(float x) { return x * __builtin_amdgcn_rcpf(1.0f + __builtin_amdgcn_exp2f(x * -1.4426950408889634f)); }
__device__ __forceinline__ float geluf_(float x) {
    const float u = 0.7978845608028654f * (x + 0.044715f * x * x * x);
    const float e = __expf(2.0f * u);
    const float th = 1.0f - 2.0f / (e + 1.0f);
    return 0.5f * x * (1.0f + th);
}
__device__ __forceinline__ float wave_sum(float v) {
#pragma unroll
    for (int o = 32; o > 0; o >>= 1) v += __shfl_xor(v, o);
    return v;
}
__device__ __forceinline__ float wave_max(float v) {
#pragma unroll
    for (int o = 32; o > 0; o >>= 1) v = fmaxf(v, __shfl_xor(v, o));
    return v;
}
__device__ __forceinline__ int t5_bucket(int d) {
    if (d < 16) return d;
    if (d >= 128) return 31;
    const int b = 16 + (int)(__logf((float)d * (1.0f / 16.0f)) * (16.0f / 2.0794415416798357f));
    return b < 31 ? b : 31;
}

extern __shared__ __attribute__((aligned(16))) unsigned char smem[];
#ifndef PROBE_DUP
#define PROBE_DUP 0
#endif
#define PROBE_LDS_OFF 131072
#ifndef PROBE_SPIN
#define PROBE_SPIN 0
#endif
#ifndef PROBE_SEG
#define PROBE_SEG 5
#endif
__device__ __forceinline__ unsigned long long probe_now() { unsigned long long t; asm volatile("s_memrealtime %0\n\ts_waitcnt lgkmcnt(0)" : "=s"(t) :: "memory"); return t; }
#define PROBE_TS ((volatile LAS unsigned long long*)((LAS unsigned char*)smem + PROBE_LDS_OFF + 16))
#if PROBE_SPIN
#define PROBE_BEGIN(seg) unsigned long long pb_##seg = 0; if (PROBE_SEG == seg && threadIdx.x == 0) pb_##seg = probe_now();
#define PROBE_END(seg) if (PROBE_SEG == seg && threadIdx.x == 0) { PROBE_TS[2] = PROBE_TS[2] + (probe_now() - pb_##seg); }
#else
#define PROBE_BEGIN(seg)
#define PROBE_END(seg)
#endif

constexpr int BM = 256, BK = 64, HALF = 128, HT = HALF * BK, GEMM_LDS = 8 * HT * 2;
__device__ __forceinline__ int lds_byte(int r, int c) { const int st = (r >> 4) * 2 + (c >> 5), rr = r & 15, cc = c & 31, ob = rr * 64 + cc * 2; return st * 1024 + (ob ^ (((ob >> 9) & 1) << 5)); }
__device__ __forceinline__ void stage_rc(int b, int& R, int& C) { const int st = b / 1024, sb = b % 1024, swz = sb ^ (((sb >> 9) & 1) << 5); R = (st >> 1) * 16 + swz / 64; C = (st & 1) * 32 + (swz % 64) / 2; }

constexpr int HTB = HALF * BK * 2;
template <class F>
__device__ __forceinline__ void for_each_frag(const f32x4 (&acc)[2][2][4][2], int brow, int bcol, int wr, int wc, int fr, int fq, F&& f) {
#pragma unroll
    for (int ai = 0; ai < 2; ++ai)
#pragma unroll
        for (int m = 0; m < 4; ++m)
#pragma unroll
            for (int bj = 0; bj < 2; ++bj)
#pragma unroll
                for (int n = 0; n < 2; ++n)
                    f(brow + ai * HALF + wr * 64 + m * 16 + fr, bcol + bj * HALF + wc * 32 + n * 16 + fq * 4, acc[ai][bj][m][n]);
}

__host__ __device__ __forceinline__ int inv_a(int ca) { return ((ca >> 5) & 1) * 128 + (ca >> 6) * 32 + ((ca >> 2) & 1) * 16 + ((ca >> 3) & 3) * 4 + (ca & 3); }
__host__ __device__ __forceinline__ int row_a(int n) { return (n & ~255) + inv_a(n & 255); }
__host__ __device__ __forceinline__ int inv_s(int o, int s) { return ((o >> 2) & 1) * 128 + (o >> 5) * 32 + ((o >> 1) & 1) * 16 + ((o >> 3) & 3) * 4 + (o & 1) * 2 + s; }
__host__ __device__ __forceinline__ int row_s(int n, int s) { return (n >> 7) * 256 + inv_s(n & 127, s); }
__host__ __device__ __forceinline__ int lcol_a(int r) { const int cg = r & 255; return (r & ~255) + ((cg >> 5) & 3) * 64 + (cg >> 7) * 32 + ((cg >> 2) & 3) * 8 + ((cg >> 4) & 1) * 4; }
__host__ __device__ __forceinline__ int lcol_s(int r) { const int cg = r & 255; return (r & ~255) + 2 * (((cg >> 5) & 3) * 32 + ((cg >> 2) & 3) * 8 + (cg >> 7) * 4 + ((cg >> 4) & 1) * 2); }
template <class F>
__device__ __forceinline__ void for_each_frag8(const f32x4 (&acc)[2][2][4][2], int brow, int bcol, int wr, int wc, int fr, int fq, F&& f) {
#pragma unroll
    for (int ai = 0; ai < 2; ++ai)
#pragma unroll
        for (int m = 0; m < 4; ++m)
#pragma unroll
            for (int bj = 0; bj < 2; ++bj)
                f(brow + ai * HALF + wr * 64 + m * 16 + fr, bcol + wc * 64 + bj * 32 + fq * 8, acc[ai][bj][m][0], acc[ai][bj][m][1]);
}

struct ZNone { __device__ __forceinline__ size_t a(int) const { return 0; } __device__ __forceinline__ size_t b(int) const { return 0; } };
template <class Epi, class ZMap = ZNone, bool HAS_MID = false>
__device__ __forceinline__ void gemm_phase(const bf16_t* A, int lda, const bf16_t* Bt, int K, int nM, int nN, const Epi& E, int nZ = 1, ZMap zm = ZMap(), int kstepA_el = BK) {
    LAS unsigned char* lds = (LAS unsigned char*)smem;
    int tid = threadIdx.x; asm volatile("" : "+v"(tid));
    const int wid = __builtin_amdgcn_readfirstlane(tid >> 6), lane = tid & 63, wr = wid >> 2, wc = wid & 3, fr = lane & 15, fq = lane >> 4;
    const int nt = K / BK, nmn = nM * nN, nu = nmn * nZ, G = gridDim.x;
    int u = blockIdx.x;
    if (u >= nu) return;
    unsigned voffA[2], voffB[2];
#pragma unroll
    for (int i = 0; i < 2; ++i) { int R, C; stage_rc(tid * 16 + i * 8192, R, C); voffA[i] = (unsigned)(R * lda + C) * 2u; voffB[i] = (unsigned)(R * K + C) * 2u; }
    const size_t kstep = (size_t)(BK * 2), kstepA = (size_t)kstepA_el * 2;
    const size_t hstepA = (size_t)HALF * lda * 2, hstepB = (size_t)HALF * K * 2, tstepA = 2 * hstepA, tstepB = 2 * hstepB;
    const unsigned ldsw = (unsigned)wid * 1024u;
    const int aoff = lds_byte(wr * 64 + fr, fq * 8), boff = lds_byte(wc * 32 + fr, fq * 8);
#define PG8_SA(b, h) (((b) * 2 + (h)) * HTB)
#define PG8_SB(b, h) ((4 + (b) * 2 + (h)) * HTB)
#define PG8_STAGE(bufoff, gbase, voff) do { _Pragma("unroll") for (int _i = 0; _i < 2; ++_i) \
        __builtin_amdgcn_global_load_lds((const unsigned*)((const char*)(gbase) + (voff)[_i]), (LAS unsigned*)(lds + (bufoff) + ldsw + _i * 8192), 16, 0, 0); } while (0)
#define PG8_LDA(dst, b, h) do { _Pragma("unroll") for (int m = 0; m < 4; ++m) _Pragma("unroll") for (int k = 0; k < 2; ++k) dst[m][k] = *(const LAS bf16x8*)(lds + PG8_SA(b, h) + aoff + m * 2048 + k * 1024); } while (0)
#define PG8_LDB(dst, b, h) do { _Pragma("unroll") for (int n = 0; n < 2; ++n) _Pragma("unroll") for (int k = 0; k < 2; ++k) dst[n][k] = *(const LAS bf16x8*)(lds + PG8_SB(b, h) + boff + n * 2048 + k * 1024); } while (0)
#define PG8_MMA(ai, bj, At, Bt_) do { __builtin_amdgcn_s_setprio(1); _Pragma("unroll") for (int m = 0; m < 4; ++m) _Pragma("unroll") for (int n = 0; n < 2; ++n) _Pragma("unroll") for (int k = 0; k < 2; ++k) \
        acc[ai][bj][m][n] = __builtin_amdgcn_mfma_f32_16x16x32_bf16(Bt_[n][k], At[m][k], acc[ai][bj][m][n], 0, 0, 0); __builtin_amdgcn_s_setprio(0); } while (0)
#define PG8_WAIT_V(n) asm volatile("s_waitcnt vmcnt(" #n ")" ::: "memory")
#define PG8_WAIT_L(n) asm volatile("s_waitcnt lgkmcnt(" #n ")" ::: "memory")
#define PG8_BAR __builtin_amdgcn_s_barrier()
#define PG8_SCHED __builtin_amdgcn_sched_barrier(0)
    f32x4 acc[2][2][4][2];
#pragma unroll
    for (int a = 0; a < 2; ++a)
#pragma unroll
        for (int b = 0; b < 2; ++b)
#pragma unroll
            for (int m = 0; m < 4; ++m)
#pragma unroll
                for (int n = 0; n < 2; ++n) acc[a][b][m][n] = (f32x4){0.f, 0.f, 0.f, 0.f};
    bf16x8 At[4][2], B0[2][2], B1[2][2];
    auto unit_of = [&](int uu, int& z_, int& pm_, int& pn_) {
        if (nZ == 1) {
            int wg = uu; { const int q = nu / 8, r = nu % 8, xcd = wg % 8, off = wg / 8; wg = (xcd < r ? xcd * (q + 1) : r * (q + 1) + (xcd - r) * q) + off; }
            const int nig = 8 * nN, gid = wg / nig, fm = gid * 8, gsz = (nM - fm) < 8 ? (nM - fm) : 8;
            z_ = 0; pm_ = fm + ((wg % nig) % gsz); pn_ = (wg % nig) / gsz;
        } else { z_ = uu / nmn; pm_ = (uu - z_ * nmn) / nN; pn_ = (uu - z_ * nmn) - pm_ * nN; }
    };
    int z, pm, pn; unit_of(u, z, pm, pn);
    const char* cA = (const char*)(A + zm.a(z)) + (size_t)pm * tstepA; const char* cB = (const char*)(Bt + zm.b(z)) + (size_t)pn * tstepB;
    PG8_STAGE(PG8_SB(0, 0), cB, voffB); PG8_STAGE(PG8_SA(0, 0), cA, voffA); PG8_STAGE(PG8_SB(0, 1), cB + hstepB, voffB); PG8_STAGE(PG8_SA(0, 1), cA + hstepA, voffA);
    if (wr == 1) PG8_BAR;
    PG8_WAIT_V(4); PG8_BAR;
    PG8_STAGE(PG8_SB(1, 0), cB + kstep, voffB); PG8_STAGE(PG8_SA(1, 0), cA + kstepA, voffA); PG8_STAGE(PG8_SB(1, 1), cB + hstepB + kstep, voffB);
    PG8_WAIT_V(6); PG8_BAR;
    for (;;) {
        const int un = u + G; const bool has_next = un < nu;
        int nz = z, npm = pm, npn = pn; if (has_next) unit_of(un, nz, npm, npn);
        const char* nA = (const char*)(A + zm.a(nz)) + (size_t)npm * tstepA; const char* nB = (const char*)(Bt + zm.b(nz)) + (size_t)npn * tstepB;
        auto kiter = [&](int t) {
            const bool last = (t == nt - 2);
            const bool bnd = last || (HAS_MID && t == (nt >> 1) - 2);
            const char* a1 = cA + (size_t)(t + 1) * kstepA;
            const char* a2 = last ? nA : cA + (size_t)(t + 2) * kstepA; const char* b2 = last ? nB : cB + (size_t)(t + 2) * kstep;
            const char* a3 = a2 + kstepA; const char* b3 = b2 + kstep;
            PG8_LDB(B0, 0, 0); PG8_SCHED; PG8_LDA(At, 0, 0); PG8_STAGE(PG8_SA(1, 1), a1 + hstepA, voffA);
            PG8_WAIT_L(8); PG8_BAR; PG8_WAIT_L(0); PG8_MMA(0, 0, At, B0); PG8_BAR; PG8_SCHED;
            PG8_LDB(B1, 0, 1); PG8_STAGE(PG8_SB(0, 0), b2, voffB);
            PG8_BAR; PG8_WAIT_L(0); PG8_MMA(0, 1, At, B1); PG8_BAR;
            PG8_LDA(At, 0, 1); PG8_STAGE(PG8_SA(0, 0), a2, voffA);
            PG8_BAR; PG8_WAIT_L(0); PG8_MMA(1, 0, At, B0); PG8_BAR; PG8_SCHED;
            PG8_STAGE(PG8_SB(0, 1), b2 + hstepB, voffB);
            PG8_WAIT_V(6); PG8_BAR; PG8_MMA(1, 1, At, B1); PG8_BAR;
            PG8_LDB(B0, 1, 0); PG8_SCHED; PG8_LDA(At, 1, 0); PG8_STAGE(PG8_SA(0, 1), a2 + hstepA, voffA);
            PG8_WAIT_L(8); PG8_BAR; PG8_WAIT_L(0); PG8_MMA(0, 0, At, B0); PG8_BAR; PG8_SCHED;
            PG8_LDB(B1, 1, 1); PG8_STAGE(PG8_SB(1, 0), b3, voffB);
            PG8_BAR; PG8_WAIT_L(0); PG8_MMA(0, 1, At, B1); PG8_BAR;
            PG8_LDA(At, 1, 1); PG8_STAGE(PG8_SA(1, 0), a3, voffA);
            PG8_BAR; PG8_WAIT_L(0); PG8_MMA(1, 0, At, B0); PG8_BAR; PG8_SCHED;
            PG8_STAGE(PG8_SB(1, 1), b3 + hstepB, voffB);
            PG8_WAIT_V(6); PG8_BAR; PG8_MMA(1, 1, At, B1);
            if (!(bnd && wr == 1)) PG8_BAR;
        };
        if constexpr (HAS_MID) {
            for (int t = 0; t < (nt >> 1); t += 2) kiter(t);
            { int pmo = pm, pno = pn; asm volatile("" : "+s"(pmo), "+s"(pno));
              E.mid(acc, pmo * BM, pno * BM, wr, wc, fr, fq); }
            PG8_SCHED; PG8_BAR; if (wr == 1) PG8_BAR;
            for (int t = nt >> 1; t < nt; t += 2) kiter(t);
        } else {
            for (int t = 0; t < nt; t += 2) kiter(t);
        }
        { int pmo = pm, pno = pn; asm volatile("" : "+s"(pmo), "+s"(pno));
          E(acc, pmo * BM, pno * BM + (z << 20), wr, wc, fr, fq); }
        PG8_SCHED; PG8_BAR;
        if (!has_next) break;
        if (wr == 1) PG8_BAR;
#pragma unroll
        for (int a = 0; a < 2; ++a)
#pragma unroll
            for (int b = 0; b < 2; ++b)
#pragma unroll
                for (int m = 0; m < 4; ++m)
#pragma unroll
                    for (int n = 0; n < 2; ++n) acc[a][b][m][n] = (f32x4){0.f, 0.f, 0.f, 0.f};
        u = un; z = nz; pm = npm; pn = npn; cA = nA; cB = nB;
    }
    PG8_WAIT_V(0);
    PG8_BAR;
#undef PG8_SA
#undef PG8_SB
#undef PG8_STAGE
#undef PG8_LDA
#undef PG8_LDB
#undef PG8_MMA
#undef PG8_WAIT_V
#undef PG8_WAIT_L
#undef PG8_BAR
#undef PG8_SCHED
}

__device__ __forceinline__ f32x4 mfma16(bf16x8 a, bf16x8 b, f32x4 c) { return __builtin_amdgcn_mfma_f32_16x16x32_bf16(a, b, c, 0, 0, 0); }
__device__ __forceinline__ bf16x8 pack_p(const f32x4& a, const f32x4& b) {
    u32x4 w; w.x = cvt_pk_bf16(a[0], a[1]); w.y = cvt_pk_bf16(a[2], a[3]); w.z = cvt_pk_bf16(b[0], b[1]); w.w = cvt_pk_bf16(b[2], b[3]);
    return __builtin_bit_cast(bf16x8, w);
}
__device__ __forceinline__ size_t kfrag_off(int key, int d) { return ((size_t)((key >> 4) * 2 + (d >> 5)) * 64 + ((d >> 3) & 3) * 16 + (key & 15)) * 8 + (d & 7); }
__device__ __forceinline__ size_t vfrag_off(int key, int d) {
    return ((size_t)((key >> 5) * 4 + (d >> 4)) * 64 + ((key >> 2) & 3) * 16 + (d & 15)) * 8 + ((key >> 4) & 1) * 4 + (key & 3);
}
__device__ __forceinline__ void st_bf16x4(bf16_t* p, f32x4 v) { u32x2 w; w.x = cvt_pk_bf16(v[0], v[1]); w.y = cvt_pk_bf16(v[2], v[3]); *(u32x2*)p = w; }
__device__ __forceinline__ void st_bf16x8(bf16_t* p, f32x4 a, f32x4 b) { u32x4 w; w.x = cvt_pk_bf16(a[0], a[1]); w.y = cvt_pk_bf16(a[2], a[3]); w.z = cvt_pk_bf16(b[0], b[1]); w.w = cvt_pk_bf16(b[2], b[3]); *(u32x4*)p = w; }
__device__ __forceinline__ void st_bf16x8_t(bf16_t* p, f32x4 a, f32x4 b) { u32x4 w; w.x = cvt_pk_bf16_t(a[0], a[1]); w.y = cvt_pk_bf16_t(a[2], a[3]); w.z = cvt_pk_bf16_t(b[0], b[1]); w.w = cvt_pk_bf16_t(b[2], b[3]); *(u32x4*)p = w; }
__device__ __forceinline__ void st_bf16x4_t(bf16_t* p, f32x4 v) { u32x2 w; w.x = cvt_pk_bf16_t(v[0], v[1]); w.y = cvt_pk_bf16_t(v[2], v[3]); *(u32x2*)p = w; }
__device__ __forceinline__ bool win_tile_a(int pn) { return pn < 2 || (pn >= 5 && pn < 17); }

struct EpiIn {
    const Params& p;
    __device__ __forceinline__ void apply(int row, int col, f32x4 v) const {
        const Params& P = p; const int pn = col >> 8, c = col & 255;
        if (pn < 2) st_bf16x4(P.Qb + (size_t)row * QD + col, v * QSCALE);
        else if (pn < 5) {
            if (pn != 2) st_bf16x4((pn == 3 ? P.SLCb : P.WINb) + (size_t)row * 256 + c, v);
            if (pn < 4) *(f32x4*)(P.out + (pn == 2 ? O_CMPS : O_SLCS) + (size_t)(row - MP) * 256 + c) = v;
            else *(f32x4*)(P.out + O_WINS + ((size_t)(row - MP) * WIN + (WIN - 1)) * 256 + c) = v;
        } else if (pn < 9) {
            f32x4 g; g[0] = gelu_fast(v[0]); g[1] = gelu_fast(v[1]); g[2] = gelu_fast(v[2]); g[3] = gelu_fast(v[3]);
            st_bf16x4((pn < 7 ? P.U : P.Vg) + (size_t)row * GMD + (col - (pn < 7 ? 1280 : 1792)), g);
        } else if (pn < 17) {
            f32x4 g; g[0] = sigmoid_fast(v[0]); g[1] = sigmoid_fast(v[1]); g[2] = sigmoid_fast(v[2]); g[3] = sigmoid_fast(v[3]);
            st_bf16x4((pn < 13 ? P.GA : P.GB) + (size_t)row * DM + (col - (pn < 13 ? 2304 : 3328)), g);
        } else if (c < 24) { f32x4 g; g[0] = sigmoid_fast(v[0]); g[1] = sigmoid_fast(v[1]); g[2] = sigmoid_fast(v[2]); g[3] = sigmoid_fast(v[3]); *(f32x4*)(P.GATE + (size_t)row * 32 + c) = g; }
    }
    __device__ __forceinline__ int lcol(int r) const { return win_tile_a(r >> 8) ? lcol_a(r) : r; }
    __device__ __forceinline__ void operator()(const f32x4 (&acc)[2][2][4][2], int brow, int bcol, int wr, int wc, int fr, int fq) const {
        const int pn = bcol >> 8;
        const Params& P = p;
        if (pn < 2) {
            for_each_frag8(acc, brow, bcol, wr, wc, fr, fq, [&](int row, int col, f32x4 a, f32x4 b) { st_bf16x8(P.Qb + (size_t)row * QD + col, a * QSCALE, b * QSCALE); });
        } else if (pn < 5) {
            bf16_t* cp = pn == 2 ? P.CMPb : pn == 3 ? P.SLCb : P.WINb;
            for_each_frag(acc, brow, bcol, wr, wc, fr, fq, [&](int row, int col, f32x4 v) {
                const int c = col & 255;
                if (pn == 2) st_bf16x4(cp + (size_t)row * 256 + c, v);
                if (pn >= 3 && c < 128 && row < MP) {
                    st_bf16x4((pn == 3 ? P.SLCkF : P.WINkF) + ((size_t)(row >> 13) * NG + (c >> 6)) * SEQ * 64 + kfrag_off(row & (SEQ - 1), c & 63), v);
                }
                if (pn >= 3 && c >= 128 && row < MP) {
                    const int t = row & (SEQ - 1), dc = c - 128;
                    bf16_t* vt = (pn == 3 ? P.SLCvT : P.WINvT) + ((size_t)(row >> 13) * NG + (dc >> 6)) * SEQ * 64 + vfrag_off(t, dc & 63);
                    vt[0] = f2bf(v[0]); vt[8] = f2bf(v[1]); vt[16] = f2bf(v[2]); vt[24] = f2bf(v[3]);
                }
                if (pn < 4) {
                    if (row < MP) *(f32x4*)(P.out + (pn == 2 ? O_CMPP : O_SLCP) + (size_t)row * 256 + c) = v;
                    else if (row < MP + NS) *(f32x4*)(P.out + (pn == 2 ? O_CMPS : O_SLCS) + (size_t)(row - MP) * 256 + c) = v;
                } else {
                    if (row < MP) { const int t = row & (SEQ - 1), b = row >> 13; if (t >= SEQ - WIN) *(f32x4*)(P.out + O_WINP + ((size_t)b * WIN + (t - (SEQ - WIN))) * 256 + c) = v; }
                    else if (row < MP + NS) *(f32x4*)(P.out + O_WINS + ((size_t)(row - MP) * WIN + (WIN - 1)) * 256 + c) = v;
                }
            });
        } else if (pn < 9) {
            bf16_t* dst = pn < 7 ? P.U : P.Vg; const int c0 = pn < 7 ? 1280 : 1792;
            for_each_frag8(acc, brow, bcol, wr, wc, fr, fq, [&](int row, int col, f32x4 a, f32x4 b) {
                f32x4 g, h; g[0] = gelu_fast(a[0]); g[1] = gelu_fast(a[1]); g[2] = gelu_fast(a[2]); g[3] = gelu_fast(a[3]); h[0] = gelu_fast(b[0]); h[1] = gelu_fast(b[1]); h[2] = gelu_fast(b[2]); h[3] = gelu_fast(b[3]);
                st_bf16x8(dst + (size_t)row * GMD + (col - c0), g, h); });
        } else if (pn < 17) {
            bf16_t* dst = pn < 13 ? P.GA : P.GB; const int c0 = pn < 13 ? 2304 : 3328;
            for_each_frag8(acc, brow, bcol, wr, wc, fr, fq, [&](int row, int col, f32x4 a, f32x4 b) {
                f32x4 g, h; g[0] = sigmoid_fast(a[0]); g[1] = sigmoid_fast(a[1]); g[2] = sigmoid_fast(a[2]); g[3] = sigmoid_fast(a[3]); h[0] = sigmoid_fast(b[0]); h[1] = sigmoid_fast(b[1]); h[2] = sigmoid_fast(b[2]); h[3] = sigmoid_fast(b[3]);
                st_bf16x8(dst + (size_t)row * DM + (col - c0), g, h); });
        } else {
            for_each_frag(acc, brow, bcol, wr, wc, fr, fq, [&](int row, int col, f32x4 v) {
                const int c = col & 255;
                if (c < 24) { f32x4 g; g[0] = sigmoid_fast(v[0]); g[1] = sigmoid_fast(v[1]); g[2] = sigmoid_fast(v[2]); g[3] = sigmoid_fast(v[3]); *(f32x4*)(P.GATE + (size_t)row * 32 + c) = g; } });
        }
    }
};
struct EpiBranch {
    const bf16_t* GA; const bf16_t* GB; bf16_t* Y1;
    __device__ __forceinline__ void mid(f32x4 (&acc)[2][2][4][2], int brow, int bcol, int wr, int wc, int fr, int fq) const {
#pragma unroll
        for (int ai = 0; ai < 2; ++ai)
#pragma unroll
            for (int m = 0; m < 4; ++m)
#pragma unroll
                for (int bj = 0; bj < 2; ++bj) {
                    const size_t o = (size_t)(brow + ai * HALF + wr * 64 + m * 16 + fr) * DM + bcol + wc * 64 + bj * 32 + fq * 8;
                    const u32x4 a = *(const u32x4*)(GA + o), b = *(const u32x4*)(GB + o);
                    f32x4& v = acc[ai][bj][m][0]; f32x4& w = acc[ai][bj][m][1];
                    v[0] *= bflo(a.x) * __builtin_amdgcn_rcpf(fmaxf(bflo(b.x), 1e-30f)); v[1] *= bfhi(a.x) * __builtin_amdgcn_rcpf(fmaxf(bfhi(b.x), 1e-30f));
                    v[2] *= bflo(a.y) * __builtin_amdgcn_rcpf(fmaxf(bflo(b.y), 1e-30f)); v[3] *= bfhi(a.y) * __builtin_amdgcn_rcpf(fmaxf(bfhi(b.y), 1e-30f));
                    w[0] *= bflo(a.z) * __builtin_amdgcn_rcpf(fmaxf(bflo(b.z), 1e-30f)); w[1] *= bfhi(a.z) * __builtin_amdgcn_rcpf(fmaxf(bfhi(b.z), 1e-30f));
                    w[2] *= bflo(a.w) * __builtin_amdgcn_rcpf(fmaxf(bflo(b.w), 1e-30f)); w[3] *= bfhi(a.w) * __builtin_amdgcn_rcpf(fmaxf(bfhi(b.w), 1e-30f));
                    asm volatile("" : "+v"(v), "+v"(w));
                    if (bj == 1) __builtin_amdgcn_sched_barrier(0);
                }
    }
    __device__ __forceinline__ int lcol(int r) const { return lcol_a(r); }
    __device__ __forceinline__ void operator()(const f32x4 (&acc)[2][2][4][2], int brow, int bcol, int wr, int wc, int fr, int fq) const {
        for_each_frag8(acc, brow, bcol, wr, wc, fr, fq, [&](int row, int col, f32x4 v, f32x4 w) {
            const u32x4 b = *(const u32x4*)(GB + (size_t)row * DM + col);
            f32x4 o, q; o[0] = v[0] * fmaxf(bflo(b.x), 1e-30f); o[1] = v[1] * fmaxf(bfhi(b.x), 1e-30f); o[2] = v[2] * fmaxf(bflo(b.y), 1e-30f); o[3] = v[3] * fmaxf(bfhi(b.y), 1e-30f);
            q[0] = w[0] * fmaxf(bflo(b.z), 1e-30f); q[1] = w[1] * fmaxf(bfhi(b.z), 1e-30f); q[2] = w[2] * fmaxf(bflo(b.w), 1e-30f); q[3] = w[3] * fmaxf(bfhi(b.w), 1e-30f);
            st_bf16x8(Y1 + (size_t)row * DM + col, o, q); });
    }
    __device__ __forceinline__ void apply2(int row, int col, f32x4 v1, f32x4 v2) const {
        const u32x2 a = *(const u32x2*)(GA + (size_t)row * DM + col), b = *(const u32x2*)(GB + (size_t)row * DM + col);
        f32x4 o; o[0] = v1[0] * bflo(a.x) + v2[0] * bflo(b.x); o[1] = v1[1] * bfhi(a.x) + v2[1] * bfhi(b.x); o[2] = v1[2] * bflo(a.y) + v2[2] * bflo(b.y); o[3] = v1[3] * bfhi(a.y) + v2[3] * bfhi(b.y);
        st_bf16x4(Y1 + (size_t)row * DM + col, o);
    }
};
struct EpiF32 {
    float* F; int ld;
    __device__ __forceinline__ void apply(int row, int col, f32x4 v) const { *(f32x4*)(F + (size_t)row * ld + col) = v; }
    __device__ __forceinline__ void operator()(const f32x4 (&acc)[2][2][4][2], int brow, int bcol, int wr, int wc, int fr, int fq) const {
        for_each_frag(acc, brow, bcol, wr, wc, fr, fq, [&](int row, int col, f32x4 v) { *(f32x4*)(F + (size_t)row * ld + col) = v; });
    }
};
struct EpiBf16 {
    bf16_t* O; int ld;
    __device__ __forceinline__ int lcol(int r) const { return lcol_a(r); }
    __device__ __forceinline__ void apply(int row, int col, f32x4 v) const { st_bf16x4(O + (size_t)row * ld + col, v); }
    __device__ __forceinline__ void operator()(const f32x4 (&acc)[2][2][4][2], int brow, int bcol, int wr, int wc, int fr, int fq) const {
        for_each_frag8(acc, brow, bcol, wr, wc, fr, fq, [&](int row, int col, f32x4 a, f32x4 b) { st_bf16x8(O + (size_t)row * ld + col, a, b); });
    }
};
struct EpiPart {
    bf16_t* PART;
    __device__ __forceinline__ void operator()(const f32x4 (&acc)[2][2][4][2], int brow, int bcol, int wr, int wc, int fr, int fq) const {
        const int z = bcol >> 20;
        for_each_frag8(acc, brow, 0, wr, wc, fr, fq, [&](int row, int col, f32x4 a, f32x4 b) { st_bf16x8(PART + ((size_t)row * 4 + z) * 256 + col, a, b); });
    }
};
struct ZCmp { __device__ __forceinline__ size_t a(int z) const { return (size_t)z * 64; } __device__ __forceinline__ size_t b(int z) const { return (size_t)(z >> 1) * 256 * 1024; } };
struct EpiSwiGLU {
    bf16_t* ACT;
    __device__ __forceinline__ int lcol(int r) const { return lcol_s(r); }
    __device__ __forceinline__ void apply(int row, int col, f32x4 v) const { *(unsigned*)(ACT + (size_t)row * DFF + (col >> 1)) = cvt_pk_bf16(silu_fast(v[0]) * v[1], silu_fast(v[2]) * v[3]); }
    __device__ __forceinline__ void operator()(const f32x4 (&acc)[2][2][4][2], int brow, int bcol, int wr, int wc, int fr, int fq) const {
#pragma unroll
        for (int ai = 0; ai < 2; ++ai)
#pragma unroll
            for (int m = 0; m < 4; ++m) {
                const f32x4 &a = acc[ai][0][m][0], &b = acc[ai][0][m][1], &c = acc[ai][1][m][0], &d = acc[ai][1][m][1];
                u32x4 w;
                w.x = cvt_pk_bf16(silu_fast(a[0]) * a[1], silu_fast(a[2]) * a[3]); w.y = cvt_pk_bf16(silu_fast(b[0]) * b[1], silu_fast(b[2]) * b[3]);
                w.z = cvt_pk_bf16(silu_fast(c[0]) * c[1], silu_fast(c[2]) * c[3]); w.w = cvt_pk_bf16(silu_fast(d[0]) * d[1], silu_fast(d[2]) * d[3]);
                *(u32x4*)(ACT + (size_t)(brow + ai * HALF + wr * 64 + m * 16 + fr) * DFF + (bcol >> 1) + wc * 32 + fq * 8) = w;
            }
    }
};
struct EpiPleGate {
    const bf16_t* E; bf16_t* F;
    __device__ __forceinline__ void apply(int row, int col, f32x4 v) const {
        const u32x2 w = *(const u32x2*)(E + (size_t)row * DM + col);
        f32x4 o; o[0] = sigmoidf_(v[0]) * bflo(w.x); o[1] = sigmoidf_(v[1]) * bfhi(w.x); o[2] = sigmoidf_(v[2]) * bflo(w.y); o[3] = sigmoidf_(v[3]) * bfhi(w.y);
        st_bf16x4(F + (size_t)row * DM + col, o); }
    __device__ __forceinline__ int lcol(int r) const { return lcol_a(r); }
    __device__ __forceinline__ void operator()(const f32x4 (&acc)[2][2][4][2], int brow, int bcol, int wr, int wc, int fr, int fq) const {
        for_each_frag8(acc, brow, bcol, wr, wc, fr, fq, [&](int row, int col, f32x4 a, f32x4 b) {
            const u32x4 w = *(const u32x4*)(E + (size_t)row * DM + col);
            f32x4 o, q; o[0] = sigmoidf_(a[0]) * bflo(w.x); o[1] = sigmoidf_(a[1]) * bfhi(w.x); o[2] = sigmoidf_(a[2]) * bflo(w.y); o[3] = sigmoidf_(a[3]) * bfhi(w.y);
            q[0] = sigmoidf_(b[0]) * bflo(w.z); q[1] = sigmoidf_(b[1]) * bfhi(w.z); q[2] = sigmoidf_(b[2]) * bflo(w.w); q[3] = sigmoidf_(b[3]) * bfhi(w.w);
            st_bf16x8(F + (size_t)row * DM + col, o, q); });
    }
};

template <class Epi>
__device__ __forceinline__ void gemm_skinny(const bf16_t* A  , int lda, const bf16_t* Bt, int K, int N, const Epi& E) {
    int tid = threadIdx.x; asm volatile("" : "+v"(tid));
    const int wid = __builtin_amdgcn_readfirstlane(tid >> 6), lane = tid & 63, c = lane & 15, G = lane >> 4;
    LAS f32x4* red = (LAS f32x4*)smem;
    const int nsteps = K / 32;
#pragma unroll 1
    for (int ct = blockIdx.x; ct < N / 16; ct += gridDim.x) {
        f32x4 acc0 = {0.f, 0.f, 0.f, 0.f}, acc1 = {0.f, 0.f, 0.f, 0.f};
        const bf16_t* bp = Bt + (size_t)(ct * 16 + c) * K + G * 8;
        const bf16_t* a0 = A + (size_t)c * lda + G * 8; const bf16_t* a1 = A + (size_t)(16 + c) * lda + G * 8;
#pragma unroll 4
        for (int kk = wid; kk < nsteps; kk += 8) {
            const bf16x8 bf = *(const bf16x8*)(bp + kk * 32), x0 = *(const bf16x8*)(a0 + kk * 32), x1 = *(const bf16x8*)(a1 + kk * 32);
            acc0 = mfma16(bf, x0, acc0); acc1 = mfma16(bf, x1, acc1);
        }
        __syncthreads();
        red[(wid * 2 + 0) * 64 + lane] = acc0; red[(wid * 2 + 1) * 64 + lane] = acc1;
        __syncthreads();
        if (tid < 128) {
            const int rt = tid >> 6;
            f32x4 v = red[rt * 64 + lane];
#pragma unroll
            for (int w = 1; w < 8; ++w) v = v + red[(w * 2 + rt) * 64 + lane];
            E.apply(MP + rt * 16 + c, E.lcol(ct * 16 + 4 * G), v);
        }
    }
    __syncthreads();
}

template <class Epi>
__device__ __forceinline__ void gemm_skinny2(const bf16_t* A  , int lda, const bf16_t* Bt, int K, int N, const Epi& E) {
    int tid = threadIdx.x; asm volatile("" : "+v"(tid));
    const int wid = __builtin_amdgcn_readfirstlane(tid >> 6), lane = tid & 63, c = lane & 15, G = lane >> 4;
    LAS f32x4* red = (LAS f32x4*)smem;
    const int hsteps = K / 64;
#pragma unroll 1
    for (int ct = blockIdx.x; ct < N / 16; ct += gridDim.x) {
        f32x4 acc[4] = {{0.f, 0.f, 0.f, 0.f}, {0.f, 0.f, 0.f, 0.f}, {0.f, 0.f, 0.f, 0.f}, {0.f, 0.f, 0.f, 0.f}};
        const bf16_t* bp = Bt + (size_t)(ct * 16 + c) * K + G * 8;
        const bf16_t* a0 = A + (size_t)c * lda + G * 8; const bf16_t* a1 = A + (size_t)(16 + c) * lda + G * 8;
#pragma unroll
        for (int h = 0; h < 2; ++h) {
#pragma unroll 2
            for (int kk = h * hsteps + wid; kk < (h + 1) * hsteps; kk += 8) {
                const bf16x8 bf = *(const bf16x8*)(bp + kk * 32), x0 = *(const bf16x8*)(a0 + kk * 32), x1 = *(const bf16x8*)(a1 + kk * 32);
                acc[h * 2] = mfma16(bf, x0, acc[h * 2]); acc[h * 2 + 1] = mfma16(bf, x1, acc[h * 2 + 1]);
            }
        }
        __syncthreads();
#pragma unroll
        for (int q = 0; q < 4; ++q) red[(wid * 4 + q) * 64 + lane] = acc[q];
        __syncthreads();
        if (tid < 128) {
            const int rt = tid >> 6;
            f32x4 v1 = red[rt * 64 + lane], v2 = red[(2 + rt) * 64 + lane];
#pragma unroll
            for (int w = 1; w < 8; ++w) { v1 = v1 + red[(w * 4 + rt) * 64 + lane]; v2 = v2 + red[(w * 4 + 2 + rt) * 64 + lane]; }
            E.apply2(MP + rt * 16 + c, E.lcol(ct * 16 + 4 * G), v1, v2);
        }
    }
    __syncthreads();
}

template <class Map>
__device__ __forceinline__ void transpose_tile(const float* W, int K, int N, bf16_t* Wt, int ldk, int kt, int ntile, Map map) {
    LAS float* tile = (LAS float*)smem;
    const int t = threadIdx.x;
    __syncthreads();
#pragma unroll
    for (int i = 0; i < 2; ++i) {
        const int k = (t >> 4) + 32 * i, n = (t & 15) * 4, gn = ntile * 64 + n;
        f32x4 v = (f32x4){0.f, 0.f, 0.f, 0.f};
        if (gn < N) v = *(const f32x4*)(W + (size_t)(kt * 64 + k) * N + gn);
        tile[k * 65 + n] = v[0]; tile[k * 65 + n + 1] = v[1]; tile[k * 65 + n + 2] = v[2]; tile[k * 65 + n + 3] = v[3];
    }
    __syncthreads();
    const int n = t >> 3, kc = (t & 7) * 8, gn = ntile * 64 + n;
    if (gn < N) {
        u32x4 w;
        w.x = cvt_pk_bf16(tile[(kc + 0) * 65 + n], tile[(kc + 1) * 65 + n]); w.y = cvt_pk_bf16(tile[(kc + 2) * 65 + n], tile[(kc + 3) * 65 + n]);
        w.z = cvt_pk_bf16(tile[(kc + 4) * 65 + n], tile[(kc + 5) * 65 + n]); w.w = cvt_pk_bf16(tile[(kc + 6) * 65 + n], tile[(kc + 7) * 65 + n]);
        *(u32x4*)(Wt + (size_t)map(gn) * ldk + kt * 64 + kc) = w;
    }
}
template <class Map>
__device__ __forceinline__ void transpose_all(const float* W, int K, int N, bf16_t* Wt, int ldk, Map map, int& base) {
    const int nkt = K / 64, nnt = (N + 63) / 64, ntl = nkt * nnt;
    for (int it = blockIdx.x; it < base + ntl; it += gridDim.x) {
        if (it < base) continue;
        const int l = it - base;
        transpose_tile(W, K, N, Wt, ldk, l / nnt, l % nnt, map);
    }
    base += ntl;
}
template <class Map>
__device__ __forceinline__ void transpose_all_sub(const float* W, int K, int N, bf16_t* Wt, int ldk, Map map, int& base) {
    const int nkt = K / 64, nnt = (N + 63) / 64, ntl = nkt * nnt, nb = gridDim.x - 32, me = blockIdx.x - 32;
    int first = base - (base % nb) + me; if (first < base) first += nb;
    for (int it = first; it < base + ntl; it += nb) { const int l = it - base; transpose_tile(W, K, N, Wt, ldk, l / nnt, l % nnt, map); }
    base += ntl;
}
__device__ __forceinline__ int map_win(int n) {
    if (n < 1280) return n;
    if (n < 1304) return 4352 + (n - 1280);
    if (n < 2328) return 1280 + (n - 1304);
    return 2304 + (n - 2328);
}

__device__ __forceinline__ float row_rstd(const f32x4 (&v)[4]) {
    float s = 0.f;
#pragma unroll
    for (int k = 0; k < 4; ++k) s += v[k][0] * v[k][0] + v[k][1] * v[k][1] + v[k][2] * v[k][2] + v[k][3] * v[k][3];
    s = wave_sum(s);
    return rsqrtf(s * (1.0f / DM) + EPS);
}
__device__ __forceinline__ const float* xrow_ptr(const Params& p, int row) {
    return row < MP ? p.x_prompt + (size_t)row * DM : p.x_sample + (size_t)(row - MP) * DM;
}

__device__ __forceinline__ void phase_prologue(const Params& p) {
    const int wid = threadIdx.x >> 6, lane = threadIdx.x & 63;
    const int gw = blockIdx.x * 8 + wid, nw = gridDim.x * 8;
    auto do_transposes = [&]() {
    int base = 0;
    transpose_all(p.w_in, DM, IND, p.WinT, DM, [](int n) { const int l = map_win(n); return win_tile_a(l >> 8) ? row_a(l) : l; }, base);
    for (int kv = 0; kv < 2; ++kv) for (int j = 0; j < 2; ++j)
        transpose_all((kv ? p.w1_v : p.w1_k) + (size_t)j * 1024 * 128, 1024, 128, p.W1T + (size_t)kv * 256 * 1024, 1024, [j](int n) { return inv_a(j * 128 + n); }, base);
    };
    do_transposes();
    __syncthreads();
    for (int i = blockIdx.x * 512 + threadIdx.x; i < (INP - IND) * DM / 8; i += gridDim.x * 512) ((u32x4*)(p.WinT + (size_t)IND * DM))[i] = (u32x4){0u, 0u, 0u, 0u};
    for (int row0 = gw * 2; row0 < MP + NS; row0 += nw * 2) {
        f32x4 v[2][4];
#pragma unroll
        for (int q = 0; q < 2; ++q) { const float* xr = xrow_ptr(p, row0 + q);
#pragma unroll
            for (int k = 0; k < 4; ++k) v[q][k] = *(const f32x4*)(xr + lane * 4 + k * 256); }
#pragma unroll
        for (int q = 0; q < 2; ++q) {
            const int row = row0 + q;
            u32x2* hd = (u32x2*)(p.H + (size_t)row * DM);
            const float r = row_rstd(v[q]);
#pragma unroll
            for (int k = 0; k < 4; ++k) { const f32x4 g = *(const f32x4*)(p.ln_mix_pre + lane * 4 + k * 256); const f32x4 o = v[q][k] * r * g; u32x2 w; w.x = cvt_pk_bf16(o[0], o[1]); w.y = cvt_pk_bf16(o[2], o[3]); hd[lane + k * 64] = w; }
            const float* pr = row < MP ? p.p_prompt + (size_t)row * PLE : p.p_sample + (size_t)(row - MP) * PLE;
            const f32x4 pv = *(const f32x4*)(pr + lane * 4);
            u32x2 w; w.x = cvt_pk_bf16(pv[0], pv[1]); w.y = cvt_pk_bf16(pv[2], pv[3]);
            ((u32x2*)(p.Pb + (size_t)row * PLE))[lane] = w;
        }
    }
    for (int i = blockIdx.x * 512 + threadIdx.x; i < 4 * 128 * 128; i += gridDim.x * 512) { const int t = (i >> 7) & 127, s = i & 127; p.GWb[i] = f2bf(s <= t ? p.gm_ws[i] : 0.f); }
    for (int i = blockIdx.x * 512 + threadIdx.x; i < 2 * 64 * 128; i += gridDim.x * 512) { const int kv = i >> 13, d = (i >> 7) & 63, h = i & 127; p.W2T[i] = f2bf((kv ? p.w2_v : p.w2_k)[h * 64 + d]); }
    if (gw < 256) {
        const int kv = gw >> 7, h = gw & 127;
        const float* pe = kv ? p.pe_v : p.pe_k; const float* w1 = kv ? p.w1_v : p.w1_k;
        float s = 0.f;
#pragma unroll 8
        for (int k = lane; k < 2048; k += 64) s += pe[k] * w1[(size_t)k * 128 + h];
        s = wave_sum(s);
        if (lane == 0) p.PEB[kv * 128 + h] = s;
    }
    for (int i = blockIdx.x * 512 + threadIdx.x; i < NS * (WIN - 1) * 64; i += gridDim.x * 512) {
        const int b = i / ((WIN - 1) * 64), r = i % ((WIN - 1) * 64);
        ((f32x4*)(p.out + O_WINS + (size_t)b * WIN * 256))[r] = ((const f32x4*)(p.state_win + (size_t)b * WIN * 256 + 256))[r];
    }
}

__device__ __forceinline__ void phase_deferred_transposes(const Params& p) {
    if (blockIdx.x < 32) return;
    int base = 0;
    transpose_all_sub(p.w_br_nsa, QD, DM, p.WnT, DM, [](int n) { return row_a(n); }, base);
    transpose_all_sub(p.w_br_gm, GMD, DM, p.WnT + QD, DM, [](int n) { return row_a(n); }, base);
    transpose_all_sub(p.w_out, DM, DM, p.WoT, DM, [](int n) { return row_a(n); }, base);
    transpose_all_sub(p.w_gate, DM, DFF, p.WguT, DM, [](int n) { return row_s(n, 0); }, base);
    transpose_all_sub(p.w_up, DM, DFF, p.WguT, DM, [](int n) { return row_s(n, 1); }, base);
    transpose_all_sub(p.w_down, DFF, DM, p.WdT, DFF, [](int n) { return row_a(n); }, base);
    transpose_all_sub(p.w_ple_gate, DM, DM, p.WpgT, DM, [](int n) { return row_a(n); }, base);
    transpose_all_sub(p.w_ple, PLE, DM, p.WpT, PLE, [](int n) { return row_a(n); }, base);
    __syncthreads();
}
__device__ __forceinline__ void phase_gather(const Params& p) {
    int tid = threadIdx.x; asm volatile("" : "+v"(tid));
    const int wid = tid >> 6, lane = tid & 63;
    const int gw = (blockIdx.x >> 1) * 8 + wid, nw = (gridDim.x >> 1) * 8;
    const int cls = blockIdx.x & 1;
    auto ld8 = [&](int r8h, f32x4 (&a)[4], f32x4 (&cc)[4]) __attribute__((always_inline)) {
        const int r = (r8h * 2 + cls) * 8, b = r >> 14, pos = r & (PAST - 1), l5 = lane & 31, hrow = lane >> 5;
        const float* s = p.cache_cmp + ((size_t)p.page_table[b * NPG + (pos >> 7)] * PAGE + (pos & 127) + hrow) * 256 + l5 * 8;
#pragma unroll
        for (int k = 0; k < 4; ++k) { a[k] = *(const f32x4*)(s + (size_t)k * 512); cc[k] = *(const f32x4*)(s + (size_t)k * 512 + 4); }
    };
    auto st8 = [&](int r8h, const f32x4 (&a)[4], const f32x4 (&cc)[4]) __attribute__((always_inline)) {
        const int r = (r8h * 2 + cls) * 8, l5 = lane & 31, hrow = lane >> 5;
#pragma unroll
        for (int k = 0; k < 4; ++k) {
            u32x4 w; w.x = cvt_pk_bf16(a[k][0], a[k][1]); w.y = cvt_pk_bf16(a[k][2], a[k][3]); w.z = cvt_pk_bf16(cc[k][0], cc[k][1]); w.w = cvt_pk_bf16(cc[k][2], cc[k][3]);
            *(u32x4*)(p.CMPb + ((size_t)MP + r + 2 * k + hrow) * 256 + l5 * 8) = w;
        }
    };
#pragma unroll 1
    for (int r8h = gw; r8h < NS * PAST / 16; r8h += 2 * nw) {
        f32x4 a0[4], c0[4], a1[4], c1[4];
        const bool two = r8h + nw < NS * PAST / 16;
        ld8(r8h, a0, c0);
        if (two) ld8(r8h + nw, a1, c1);
        st8(r8h, a0, c0);
        if (two) st8(r8h + nw, a1, c1);
    }
}

__device__ __forceinline__ void phase_cmp_final(const Params& p) {
    const int wid = threadIdx.x >> 6, lane = threadIdx.x & 63;
    {
        const int c = lane & 15, G = lane >> 4;
        const int ngrp_p = NB * 4 * 32, ngrp_s = NS * 4 * 64;
#pragma unroll 1
        for (int it = blockIdx.x * 8 + wid; it < ngrp_p + ngrp_s; it += gridDim.x * 8) {
            const bool smp = it >= ngrp_p; const int l = smp ? it - ngrp_p : it;
            const int nch = smp ? 64 : 32, nc = smp ? NCS : NCP;
            const int ch = l % nch, z = (l / nch) & 3, seq = l / (nch * 4), kv = z >> 1, g = z & 1, n0 = ch * 16;
            const size_t r0 = smp ? (size_t)2048 + (size_t)seq * 1024 : (size_t)seq * 512;
            const int nr = n0 + c < nc ? n0 + c : nc - 1;
            const bf16_t* p0 = (const bf16_t*)p.PART + ((r0 + nr) * 4 + z) * 256;
            const bf16_t* p1 = (const bf16_t*)p.PART + ((r0 + nr + 1) * 4 + z) * 256 + 128;
            const float* pb = p.PEB + kv * 128;
            f32x4 acc[4] = {{0.f, 0.f, 0.f, 0.f}, {0.f, 0.f, 0.f, 0.f}, {0.f, 0.f, 0.f, 0.f}, {0.f, 0.f, 0.f, 0.f}};
#pragma unroll
            for (int ks = 0; ks < 4; ++ks) {
                const int h0 = 32 * ks + 8 * G;
                const u32x4 wa = *(const u32x4*)(p0 + h0), wb = *(const u32x4*)(p1 + h0);
                const f32x4 a0 = {bflo(wa.x), bfhi(wa.x), bflo(wa.y), bfhi(wa.y)}, a1 = {bflo(wa.z), bfhi(wa.z), bflo(wa.w), bfhi(wa.w)};
                const f32x4 b0 = {bflo(wb.x), bfhi(wb.x), bflo(wb.y), bfhi(wb.y)}, b1 = {bflo(wb.z), bfhi(wb.z), bflo(wb.w), bfhi(wb.w)};
                const f32x4 e0 = *(const f32x4*)(pb + h0), e1 = *(const f32x4*)(pb + h0 + 4);
                f32x4 x0 = a0 + b0 + e0, x1 = a1 + b1 + e1;
#pragma unroll
                for (int i = 0; i < 4; ++i) { x0[i] = siluf_(x0[i]); x1[i] = siluf_(x1[i]); }
                const bf16x8 A = pack_p(x0, x1);
#pragma unroll
                for (int nt = 0; nt < 4; ++nt) {
                    const bf16x8 B = *(const bf16x8*)(p.W2T + ((size_t)kv * 64 + nt * 16 + c) * 128 + h0);
                    acc[nt] = mfma16(A, B, acc[nt]);
                }
            }
#pragma unroll
            for (int nt = 0; nt < 4; ++nt) {
                const int d = nt * 16 + c;
#pragma unroll
                for (int i = 0; i < 4; ++i) {
                    const int n = n0 + 4 * G + i;
                    if (n < nc) {
                        if (smp) ((kv ? p.VCS : p.KCS) + (((size_t)seq * NG + g) * 1024 + n) * 64)[d] = acc[nt][i];
                        else if (kv == 0) p.KCb[((size_t)seq * NG + g) * 512 * 64 + kfrag_off(n, d)] = f2bf(acc[nt][i]);
                    }
                }
                if (!smp && kv == 1) {
                    f32x4 v = acc[nt];
#pragma unroll
                    for (int i = 0; i < 4; ++i) if (n0 + 4 * G + i >= nc) v[i] = 0.f;
                    st_bf16x4(p.VCT + ((size_t)seq * NG + g) * 512 * 64 + vfrag_off(n0 + 4 * G, d), v);
                }
            }
        }
    }
}

template <bool SAMPLE>
__device__ __forceinline__ void kv_row_ptr(const Params& p, int branch  , int b, int pos, int kv, int g, const bf16_t*& pb, const float*& pf) {
    const int off = kv * 128 + g * 64;
    if (!SAMPLE) { pf = nullptr; pb = (branch == 1 ? p.SLCb : p.WINb) + ((size_t)b * SEQ + pos) * 256 + off; }
    else if (pos >= PAST) { pf = nullptr; pb = (branch == 1 ? p.SLCb : p.WINb) + ((size_t)MP + b) * 256 + off; }
    else if (branch == 1) { pb = nullptr; pf = p.cache_slc + ((size_t)p.page_table[b * NPG + (pos >> 7)] * PAGE + (pos & 127)) * 256 + off; }
    else { pb = nullptr; pf = p.state_win + ((size_t)b * WIN + (pos - (PAST - WIN))) * 256 + off; }
}
__device__ __forceinline__ void dot4x64(const bf16_t* pb, const float* pf, const LAS float* qs_, float (&s)[4]) {
    s[0] = s[1] = s[2] = s[3] = 0.f;
    const LAS float* qs = qs_; asm volatile("" : "+v"(qs));
    if (pf) {
#pragma unroll 8
        for (int c = 0; c < 16; ++c) {
            const f32x4 kx = *(const f32x4*)(pf + c * 4);
#pragma unroll
            for (int h = 0; h < 4; ++h) { const f32x4 q = *(const LAS f32x4*)(qs + h * 64 + c * 4); s[h] += q[0] * kx[0] + q[1] * kx[1] + q[2] * kx[2] + q[3] * kx[3]; }
        }
    } else {
#pragma unroll 2
        for (int c = 0; c < 8; ++c) {
            const u32x4 w = *(const u32x4*)(pb + c * 8);
            const float k0 = bflo(w.x), k1 = bfhi(w.x), k2 = bflo(w.y), k3 = bfhi(w.y), k4 = bflo(w.z), k5 = bfhi(w.z), k6 = bflo(w.w), k7 = bfhi(w.w);
#pragma unroll
            for (int h = 0; h < 4; ++h) {
                const f32x4 qa = *(const LAS f32x4*)(qs + h * 64 + c * 8), qb = *(const LAS f32x4*)(qs + h * 64 + c * 8 + 4);
                s[h] += qa[0] * k0 + qa[1] * k1 + qa[2] * k2 + qa[3] * k3 + qb[0] * k4 + qb[1] * k5 + qb[2] * k6 + qb[3] * k7;
            }
        }
    }
}
template <bool SAMPLE>
__device__ __forceinline__ void attn_chunk(const Params& p, int branch, int b, int g, int t, int pos0, int lo, int hi,
                                           float (&m)[4], float (&l)[4], float (&o)[4], const LAS float* qs, LAS float* pbk, const LAS float* relb, int lane) {
    const int pos = pos0 + lane;
    const bool valid = pos >= lo && pos <= hi;
    float s[4] = {-1e30f, -1e30f, -1e30f, -1e30f};
    if (valid) {
        const bf16_t* pb; const float* pf; kv_row_ptr<SAMPLE>(p, branch, b, pos, 0, g, pb, pf);
        dot4x64(pb, pf, qs, s);
        const int bk = t5_bucket(t - pos);
#pragma unroll
        for (int h = 0; h < 4; ++h) s[h] += relb[bk * 8 + g * 4 + h];
    }
#pragma unroll
    for (int h = 0; h < 4; ++h) {
        const float mx = wave_max(s[h]);
        const float mn = fmaxf(m[h], mx);
        const float pr = valid ? ex2(s[h] - mn) : 0.f;
        const float sm = wave_sum(pr);
        const float al = ex2(m[h] - mn);
        l[h] = l[h] * al + sm; o[h] *= al; m[h] = mn;
        pbk[h * 64 + lane] = pr;
    }
    __builtin_amdgcn_wave_barrier();
    const int k0 = (lo > pos0 ? lo : pos0) - pos0, k1 = (hi < pos0 + 63 ? hi : pos0 + 63) - pos0;
    if (SAMPLE) {
        const int kend = (PAST - 1 - pos0) < k1 ? (PAST - 1 - pos0) : k1;
        if (kend >= k0) {
            const bf16_t* pb; const float* pf; kv_row_ptr<SAMPLE>(p, branch, b, pos0 + k0, 1, g, pb, pf);
            pf += lane;
#pragma unroll 16
            for (int k = k0; k <= kend; ++k) {
                const float v = pf[(size_t)(k - k0) * 256];
#pragma unroll
                for (int h = 0; h < 4; ++h) o[h] += pbk[h * 64 + k] * v;
            }
        }
        if (k1 > kend) {
            const bf16_t* pb; const float* pf; kv_row_ptr<SAMPLE>(p, branch, b, pos0 + k1, 1, g, pb, pf);
            const float v = bf2f(pb[lane]);
#pragma unroll
            for (int h = 0; h < 4; ++h) o[h] += pbk[h * 64 + k1] * v;
        }
    } else {
#pragma unroll 1
    for (int k = k0; k <= k1; ++k) {
        const bf16_t* pb; const float* pf; kv_row_ptr<SAMPLE>(p, branch, b, pos0 + k, 1, g, pb, pf);
        const float v = pf ? pf[lane] : bf2f(pb[lane]);
#pragma unroll
        for (int h = 0; h < 4; ++h) o[h] += pbk[h * 64 + k] * v;
    }
    }
    __builtin_amdgcn_wave_barrier();
}

constexpr int S_QS = 0, S_SC = 1024, S_PHS = S_SC + 4 * 1024 * 4, S_PBK = S_PHS + 1088 * 4, S_PART = S_PBK + 8 * 1024, S_RED = S_PART + 2 * 8 * 272 * 4, S_OCP = S_RED + 512,
              S_SEL = S_OCP + 2048, S_RELB = S_SEL + 64, ATTS_LDS = S_RELB + 1024;
__device__ __forceinline__ void attn_sample_item(const Params& p, int b, int g) {
    const int tid = threadIdx.x, wid = tid >> 6, lane = tid & 63;
    constexpr int t = PAST, NC = NCS, NSEL = 257, NJR = 5, qblk = PAST >> 6;
    const int row = MP + b;
    LAS unsigned char* L = (LAS unsigned char*)smem;
    LAS float* qs = (LAS float*)(L + S_QS); LAS float* sc = (LAS float*)(L + S_SC); LAS float* phs = (LAS float*)(L + S_PHS); LAS float* pbk = (LAS float*)(L + S_PBK) + wid * 256;
    LAS float* part = (LAS float*)(L + S_PART); LAS float* red = (LAS float*)(L + S_RED); LAS float* ocp = (LAS float*)(L + S_OCP); LAS int* sel = (LAS int*)(L + S_SEL);
    LAS float* relb = (LAS float*)(L + S_RELB);
    __syncthreads();
    if (tid < 256) { relb[tid] = p.rel_bias[tid] * LOG2E; qs[tid] = bf2f(p.Qb[(size_t)row * QD + g * 256 + tid]); }
    __syncthreads();
    const float* kc = p.KCS + ((size_t)b * NG + g) * 1024 * 64;
    const float* vc = p.VCS + ((size_t)b * NG + g) * 1024 * 64;
    {
        float mx[4] = {-1e30f, -1e30f, -1e30f, -1e30f};
#pragma unroll 1
        for (int r = wid; r < 16; r += 8) {
            const int n = r * 64 + lane;
            float s[4] = {-1e30f, -1e30f, -1e30f, -1e30f};
            if (n < NC) {
                dot4x64(nullptr, kc + (size_t)n * 64, qs, s);
                const int bk = t5_bucket(t - (16 * n + 31));
#pragma unroll
                for (int h = 0; h < 4; ++h) s[h] += relb[bk * 8 + g * 4 + h];
            }
#pragma unroll
            for (int h = 0; h < 4; ++h) { sc[h * 1024 + n] = s[h]; mx[h] = fmaxf(mx[h], s[h]); }
        }
#pragma unroll
        for (int h = 0; h < 4; ++h) { const float m = wave_max(mx[h]); if (lane == 0) red[wid * 4 + h] = m; }
    }
    __syncthreads();
    float gmx[4], inv[4];
#pragma unroll
    for (int h = 0; h < 4; ++h) { float m = red[h]; for (int w = 1; w < 8; ++w) m = fmaxf(m, red[w * 4 + h]); gmx[h] = m; }
    {
        float sum[4] = {0.f, 0.f, 0.f, 0.f};
#pragma unroll
        for (int k = 0; k < 2; ++k) { const int n = tid + 512 * k;
#pragma unroll
            for (int h = 0; h < 4; ++h) { const float e = n < NC ? ex2(sc[h * 1024 + n] - gmx[h]) : 0.f; sc[h * 1024 + n] = e; sum[h] += e; } }
#pragma unroll
        for (int h = 0; h < 4; ++h) { const float s = wave_sum(sum[h]); if (lane == 0) red[32 + wid * 4 + h] = s; }
    }
    __syncthreads();
#pragma unroll
    for (int h = 0; h < 4; ++h) { float s = 0.f; for (int w = 0; w < 8; ++w) s += red[32 + w * 4 + h]; inv[h] = s > 0.f ? 1.0f / s : 0.f; }
    for (int n = tid; n < 1088; n += 512) phs[n] = n < NC ? (sc[n] * inv[0] + sc[1024 + n] * inv[1]) + (sc[2048 + n] * inv[2] + sc[3072 + n] * inv[3]) : 0.f;
    {
        float a[4] = {0.f, 0.f, 0.f, 0.f};
#pragma unroll 16
        for (int n = wid; n < NC; n += 8) {
            const float v = vc[(size_t)n * 64 + lane];
#pragma unroll
            for (int h = 0; h < 4; ++h) a[h] += sc[h * 1024 + n] * v;
        }
#pragma unroll
        for (int h = 0; h < 4; ++h) part[(wid * 4 + h) * 68 + lane] = a[h] * inv[h];
    }
    __syncthreads();
    if (tid < 256) { float a = 0.f; for (int w = 0; w < 8; ++w) a += part[(w * 4 + (tid >> 6)) * 68 + (tid & 63)]; ocp[tid] = a; }
    __syncthreads();
    if (wid == 0) {
        unsigned long long key[NJR];
#pragma unroll
        for (int jr = 0; jr < NJR; ++jr) {
            const int j = jr * 64 + lane;
            key[jr] = 0ull;
            if (j >= 1 && j <= qblk - 2 && j < NSEL) {
                float im = 0.f;
#pragma unroll
                for (int n = 4 * j - 1; n <= 4 * j + 3; ++n) im += (n < NC) ? phs[n] : 0.f;
                key[jr] = ((unsigned long long)__float_as_uint(im) << 32) | (unsigned)(0xFFFF - j) | 0x10000ull;
            }
        }
        if (lane == 0) { sel[0] = 0; sel[1] = qblk - 1; sel[2] = qblk; }
#pragma unroll 1
        for (int it = 0; it < 13; ++it) {
            unsigned long long best = 0ull;
#pragma unroll
            for (int jr = 0; jr < NJR; ++jr) best = key[jr] > best ? key[jr] : best;
#pragma unroll
            for (int o = 32; o > 0; o >>= 1) { const unsigned long long ot = __shfl_xor(best, o); best = ot > best ? ot : best; }
            const int j = 0xFFFF - (int)(best & 0xFFFFull);
#pragma unroll
            for (int jr = 0; jr < NJR; ++jr) if (key[jr] == best) key[jr] = 0ull;
            if (lane == 0) sel[3 + it] = j;
        }
    }
    __syncthreads();
    {
        float ms[4] = {-1e30f, -1e30f, -1e30f, -1e30f}, ls[4] = {0.f, 0.f, 0.f, 0.f}, os[4] = {0.f, 0.f, 0.f, 0.f};
#pragma unroll 1
        for (int i = wid; i < 16; i += 8) attn_chunk<true>(p, 1, b, g, t, sel[i] * 64, 0, t, ms, ls, os, qs, pbk, relb, lane);
        float mw[4] = {-1e30f, -1e30f, -1e30f, -1e30f}, lw[4] = {0.f, 0.f, 0.f, 0.f}, ow[4] = {0.f, 0.f, 0.f, 0.f};
#pragma unroll 1
        for (int c = wid; c < 9; c += 8) attn_chunk<true>(p, 2, b, g, t, t - 63 - 64 * c, t - WIN, t, mw, lw, ow, qs, pbk, relb, lane);
#pragma unroll
        for (int h = 0; h < 4; ++h) {
            LAS float* ps = part + (wid * 4 + h) * 68; LAS float* pw = part + 8 * 272 + (wid * 4 + h) * 68;
            ps[lane] = os[h]; pw[lane] = ow[h];
            if (lane == 0) { ps[64] = ms[h]; ps[65] = ls[h]; pw[64] = mw[h]; pw[65] = lw[h]; }
        }
    }
    __syncthreads();
    if (tid < 256) {
        const int h = tid >> 6, d = tid & 63;
        float res[2];
#pragma unroll
        for (int br = 0; br < 2; ++br) {
            const LAS float* pp = part + br * 8 * 272 + h * 68;
            float m = -1e30f;
            for (int w = 0; w < 8; ++w) m = fmaxf(m, pp[w * 272 + 64]);
            float l = 0.f, o = 0.f;
            for (int w = 0; w < 8; ++w) { const float sc_ = ex2(pp[w * 272 + 64] - m); l += pp[w * 272 + 65] * sc_; o += pp[w * 272 + d] * sc_; }
            res[br] = o / l;
        }
        const float* gt = p.GATE + (size_t)row * 32 + (g * 4 + h) * 3;
        const float v = gt[0] * ocp[tid] + gt[1] * res[0] + gt[2] * res[1];
        p.OCAT[(size_t)row * DM + (g * 4 + h) * 64 + d] = f2bf(v);
    }
    __syncthreads();
}

constexpr int A_OST = 0, OST_LD = 68, A_LST = A_OST + 256 * OST_LD * 4, A_M0 = A_LST + 1024, A_MB = A_M0 + 1024, MB_LD = 132, A_MKN = A_MB + 64 * MB_LD,
              A_LIST = A_MKN + 256, A_CNT = A_LIST + 132 * 64, A_PK = A_CNT + 544, A_KN = A_PK + 400 * 4, A_T2 = A_KN + 512, A_NP = A_T2 + 132 * 8 * 4, A_QT = A_NP + 16, ATT2_LDS = A_QT + 64 * 512;
static_assert(ATT2_LDS <= GEMM_LDS && ATTS_LDS <= GEMM_LDS, "attention LDS");

__device__ __forceinline__ void qk64(const bf16_t* kb, int c, int G, const bf16x8 (&qB)[2], f32x4 (&s)[4]) {
#pragma unroll
    for (int kt = 0; kt < 4; ++kt) {
        const bf16_t* r = kb + (size_t)(16 * kt + c) * 256 + G * 8;
        const bf16x8 a0 = *(const bf16x8*)r, a1 = *(const bf16x8*)(r + 32);
        s[kt] = mfma16(a0, qB[0], (f32x4){0.f, 0.f, 0.f, 0.f}); s[kt] = mfma16(a1, qB[1], s[kt]);
    }
}
__device__ __forceinline__ void pv64(const bf16_t* vf, int key0, int lane, const f32x4 (&pr)[4], f32x4 (&o)[4]) {
#pragma unroll
    for (int ks = 0; ks < 2; ++ks) {
        const bf16x8 pB = pack_p(pr[2 * ks], pr[2 * ks + 1]);
#pragma unroll
        for (int dt = 0; dt < 4; ++dt) {
            const bf16x8 vA = *(const bf16x8*)(vf + ((size_t)(((key0 >> 5) + ks) * 4 + dt) * 64 + lane) * 8);
            o[dt] = mfma16(vA, pB, o[dt]);
        }
    }
}
__device__ __forceinline__ int qt_off(int qi, int hh, int k) { return (qi * 4 + hh) * 128 + ((k ^ (((qi & 3) << 1) | (hh >> 1))) << 4); }
__device__ __forceinline__ float grp_max(float v) {
    auto r = __builtin_amdgcn_permlane16_swap(__float_as_uint(v), __float_as_uint(v), false, false); v = fmaxf(__uint_as_float(r[0]), __uint_as_float(r[1]));
    r = __builtin_amdgcn_permlane32_swap(__float_as_uint(v), __float_as_uint(v), false, false); return fmaxf(__uint_as_float(r[0]), __uint_as_float(r[1]));
}
__device__ __forceinline__ float grp_sum(float v) {
    auto r = __builtin_amdgcn_permlane16_swap(__float_as_uint(v), __float_as_uint(v), false, false); v = __uint_as_float(r[0]) + __uint_as_float(r[1]);
    r = __builtin_amdgcn_permlane32_swap(__float_as_uint(v), __float_as_uint(v), false, false); return __uint_as_float(r[0]) + __uint_as_float(r[1]);
}
__device__ __forceinline__ int grp_min_i(int v) {
    auto r = __builtin_amdgcn_permlane16_swap((unsigned)v, (unsigned)v, false, false); v = (int)r[0] < (int)r[1] ? (int)r[0] : (int)r[1];
    r = __builtin_amdgcn_permlane32_swap((unsigned)v, (unsigned)v, false, false); return (int)r[0] < (int)r[1] ? (int)r[0] : (int)r[1];
}
__device__ __forceinline__ float dpp_x1(float v) { return __uint_as_float(__builtin_amdgcn_mov_dpp(__float_as_uint(v), 0xB1, 0xF, 0xF, true)); }
__device__ __forceinline__ float dpp_x2(float v) { return __uint_as_float(__builtin_amdgcn_mov_dpp(__float_as_uint(v), 0x4E, 0xF, 0xF, true)); }
__device__ __forceinline__ int dpp_x1i(int v) { return (int)__builtin_amdgcn_mov_dpp((unsigned)v, 0xB1, 0xF, 0xF, true); }
__device__ __forceinline__ int dpp_x2i(int v) { return (int)__builtin_amdgcn_mov_dpp((unsigned)v, 0x4E, 0xF, 0xF, true); }
__device__ __forceinline__ unsigned row_or_q(unsigned u) {
    u |= __builtin_amdgcn_mov_dpp(u, 0x124, 0xF, 0xF, true); u |= __builtin_amdgcn_mov_dpp(u, 0x128, 0xF, 0xF, true); return u;
}

__device__ __forceinline__ void attn_cmp(const Params& p, int b, int g, int t0, int lane_, LAS unsigned char* L, unsigned (&msk)[4]) {
    f32x4 oacc[4];
    int lane = lane_; asm volatile("" : "+v"(lane));
    const int c = lane & 15, G = lane >> 4, qs = c >> 2, hh = c & 3;
    const int qb = t0 >> 6, tc = t0 + qs;
    const size_t qrow = (size_t)b * SEQ + tc;
    const LAS float* T2 = (const LAS float*)(L + A_T2);
    const float b31 = T2[128 * 8 + g * 4 + hh];
    bf16x8 qB[2];
    qB[0] = *(const bf16x8*)(p.Qb + qrow * QD + (g * 4 + hh) * 64 + G * 8); qB[1] = *(const bf16x8*)(p.Qb + qrow * QD + (g * 4 + hh) * 64 + 32 + G * 8);
    const float* gate = p.GATE + qrow * 32 + (g * 4 + hh) * 3;
    msk[0] = msk[1] = msk[2] = msk[3] = 0u;
    {
        const int ncv_c = tc >= 31 ? ((tc - 31) >> 4) + 1 : 0;
        const int ncv_m = t0 + 3 >= 31 ? ((t0 + 3 - 31) >> 4) + 1 : 0;
        const int NT = (ncv_m + 15) >> 4;
        const int mt_far = t0 >= 399 ? (t0 - 399) / 256 + 1 : 0;
        const bf16_t* kcb = p.KCb + (size_t)(b * NG + g) * 512 * 64;
        f32x4 sc[32];
        float mxf = -1e30f, mxn = -1e30f;
        bf16x8 kbuf[2][4][2];
        auto ldkg = [&](int grp, bf16x8 (&kb)[4][2]) __attribute__((always_inline)) {
#pragma unroll
            for (int q = 0; q < 4; ++q) { const bf16_t* r = kcb + ((size_t)((grp * 4 + q) * 2) * 64 + lane) * 8; kb[q][0] = *(const bf16x8*)r; kb[q][1] = *(const bf16x8*)(r + 512); }
        };
        ldkg(0, kbuf[0]);
#pragma unroll
        for (int grp = 0; grp < 8; ++grp) {
            if (4 * grp < NT) {
                if (4 * (grp + 1) < NT) ldkg(grp + 1, kbuf[(grp + 1) & 1]);
                __builtin_amdgcn_sched_barrier(0);
#pragma unroll
                for (int q = 0; q < 4; ++q) {
                    const int mt = grp * 4 + q;
                    f32x4 s = mfma16(kbuf[grp & 1][q][0], qB[0], (f32x4){0.f, 0.f, 0.f, 0.f}); s = mfma16(kbuf[grp & 1][q][1], qB[1], s);
                    if (mt < mt_far) { mxf = fmaxf(mxf, fmaxf(fmaxf(s[0], s[1]), fmaxf(s[2], s[3]))); }
                    else {
#pragma unroll
                        for (int i = 0; i < 4; ++i) { const int n = 16 * mt + 4 * G + i; int dist = tc - (16 * n + 31); const bool ok = n < ncv_c; dist = dist < 0 ? 0 : (dist > 128 ? 128 : dist);
                            s[i] = ok ? s[i] + T2[dist * 8 + g * 4 + hh] : -1e30f; }
                        mxn = fmaxf(mxn, fmaxf(fmaxf(s[0], s[1]), fmaxf(s[2], s[3])));
                    }
                    sc[mt] = s;
                }
            } else {
#pragma unroll
                for (int q = 0; q < 4; ++q) sc[grp * 4 + q] = (f32x4){0.f, 0.f, 0.f, 0.f};
            }
        }
        const float mx = grp_max(fmaxf(mxf + b31, mxn));
        const float shf = mx - b31;
#pragma unroll
        for (int mt = 0; mt < 32; ++mt) if ((mt & ~3) < NT) {
            const float sh = mt < mt_far ? shf : mx;
#pragma unroll
            for (int i = 0; i < 4; ++i) sc[mt][i] = ex2(sc[mt][i] - sh);
        }
        const bf16_t* vct = p.VCT + (size_t)(b * NG + g) * 64 * 512;
        const bf16x8 ones = __builtin_bit_cast(bf16x8, (u32x4){0x3F803F80u, 0x3F803F80u, 0x3F803F80u, 0x3F803F80u});
        f32x4 oc[4] = {{0.f, 0.f, 0.f, 0.f}, {0.f, 0.f, 0.f, 0.f}, {0.f, 0.f, 0.f, 0.f}, {0.f, 0.f, 0.f, 0.f}};
        f32x4 rs = {0.f, 0.f, 0.f, 0.f};
        bf16x8 vbuf[2][2][4];
        auto ldvg = [&](int grp, bf16x8 (&vb)[2][4]) __attribute__((always_inline)) {
#pragma unroll
            for (int q = 0; q < 2; ++q)
#pragma unroll
                for (int dt = 0; dt < 4; ++dt) vb[q][dt] = *(const bf16x8*)(vct + ((size_t)((grp * 2 + q) * 4 + dt) * 64 + lane) * 8);
        };
        ldvg(0, vbuf[0]);
#pragma unroll
        for (int grp = 0; grp < 8; ++grp) if (4 * grp < NT) {
            if (4 * (grp + 1) < NT) ldvg(grp + 1, vbuf[(grp + 1) & 1]);
            __builtin_amdgcn_sched_barrier(0);
#pragma unroll
            for (int q = 0; q < 2; ++q) {
                const int k2 = grp * 2 + q;
                const bf16x8 pB = pack_p(sc[2 * k2], sc[2 * k2 + 1]);
                rs = mfma16(ones, pB, rs);
#pragma unroll
                for (int dt = 0; dt < 4; ++dt) oc[dt] = mfma16(vbuf[grp & 1][q][dt], pB, oc[dt]);
            }
        }
        const float inv = ncv_c > 0 ? __builtin_amdgcn_rcpf(rs[0]) : 0.f;
        if (qb <= 15) {
            msk[0] = (qb >= 31) ? 0xffffffffu : ((2u << qb) - 1u);
        } else {
            unsigned cand[8];
#pragma unroll
            for (int k = 0; k < 8; ++k) cand[k] = 0u;
            float prevB = 0.f;
#pragma unroll
            for (int mt = 0; mt < 32; ++mt) if (mt < NT) {
                const unsigned x3 = __float_as_uint(sc[mt][3]);
                const auto p16 = __builtin_amdgcn_permlane16_swap(x3, x3, false, false);
                const auto p32 = __builtin_amdgcn_permlane32_swap(p16[1], p16[1], false, false);
                const float r1 = G == 2 ? __uint_as_float(p32[0]) : __uint_as_float(p16[0]);
                float v = ((sc[mt][0] + sc[mt][1]) + (sc[mt][2] + sc[mt][3]) + (G == 0 ? prevB : r1)) * inv;
                prevB = __uint_as_float(p32[1]);
                v += dpp_x1(v); v += dpp_x2(v);
                const int j = 4 * mt + G;
                if ((mt & 3) == hh) cand[mt >> 2] = (j >= 1 && j <= qb - 2) ? ((__float_as_uint(v) & ~127u) | (unsigned)(127 - j)) : 0u;
            }
            auto setbit = [&](int j) { const unsigned bit = 1u << (j & 31); const int w = j >> 5; msk[0] |= w == 0 ? bit : 0u; msk[1] |= w == 1 ? bit : 0u; msk[2] |= w == 2 ? bit : 0u; msk[3] |= w == 3 ? bit : 0u; };
            setbit(0); setbit(qb); setbit(qb - 1);
#pragma unroll 1
            for (int it = 0; it < 13; ++it) {
                unsigned bv = cand[0];
#pragma unroll
                for (int k = 1; k < 8; ++k) bv = bv > cand[k] ? bv : cand[k];
                { unsigned o = __builtin_amdgcn_mov_dpp(bv, 0xB1, 0xF, 0xF, true); bv = o > bv ? o : bv; o = __builtin_amdgcn_mov_dpp(bv, 0x4E, 0xF, 0xF, true); bv = o > bv ? o : bv;
                  auto r = __builtin_amdgcn_permlane16_swap(bv, bv, false, false); bv = r[0] > r[1] ? r[0] : r[1]; r = __builtin_amdgcn_permlane32_swap(bv, bv, false, false); bv = r[0] > r[1] ? r[0] : r[1]; }
#pragma unroll
                for (int k = 0; k < 8; ++k) cand[k] = cand[k] == bv ? 0u : cand[k];
                setbit(127 - (int)(bv & 127u));
            }
        }
        const float g0 = gate[0] * inv;
#pragma unroll
        for (int dt = 0; dt < 4; ++dt) oacc[dt] = oc[dt] * g0;
    }
    bf16_t* orow = p.OCAT + qrow * DM + (g * 4 + hh) * 64 + 4 * G;
#pragma unroll
    for (int dt = 0; dt < 4; ++dt) st_bf16x4(orow + dt * 16, oacc[dt]);
}

struct PackSt { bf16x8 q0, q1; float m; f32x4 l4; f32x4 o[4]; };
__device__ __forceinline__ void attn_selwin_pair(const Params& p, int b, int g, int t0, int lane_, LAS unsigned char* L, const unsigned (&mskA)[4], const unsigned (&mskB)[4]) {
    int lane = lane_; asm volatile("" : "+v"(lane));
    const int c = lane & 15, G = lane >> 4, qs = c >> 2, hh = c & 3;
    const int qb = t0 >> 6;
    const LAS float* T2 = (const LAS float*)(L + A_T2);
    const float b31 = T2[128 * 8 + g * 4 + hh];
    const int tcA = t0 + qs, tcB = t0 + 4 + qs;
    const size_t qrowA = (size_t)b * SEQ + tcA;
    PackSt A, B;
    {
        const bf16_t* qa = p.Qb + qrowA * QD + (g * 4 + hh) * 64 + G * 8;
        A.q0 = *(const bf16x8*)qa; A.q1 = *(const bf16x8*)(qa + 32); B.q0 = *(const bf16x8*)(qa + 4 * QD); B.q1 = *(const bf16x8*)(qa + 4 * QD + 32);
    }
    auto reset = [&](PackSt& S) __attribute__((always_inline)) { S.m = -1e30f; S.l4 = (f32x4){0.f, 0.f, 0.f, 0.f};
#pragma unroll
        for (int dt = 0; dt < 4; ++dt) S.o[dt] = (f32x4){0.f, 0.f, 0.f, 0.f}; };
    const bf16x8 ones = __builtin_bit_cast(bf16x8, (u32x4){0x3F803F80u, 0x3F803F80u, 0x3F803F80u, 0x3F803F80u});
    auto finish = [&](PackSt& S, f32x4 (&s)[4], float cb, bool mine, const bf16x8 (&vf)[2][4]) __attribute__((always_inline)) {
        float cm = fmaxf(fmaxf(fmaxf(s[0][0], s[0][1]), fmaxf(s[0][2], s[0][3])), fmaxf(fmaxf(s[1][0], s[1][1]), fmaxf(s[1][2], s[1][3])));
        cm = fmaxf(cm, fmaxf(fmaxf(fmaxf(s[2][0], s[2][1]), fmaxf(s[2][2], s[2][3])), fmaxf(fmaxf(s[3][0], s[3][1]), fmaxf(s[3][2], s[3][3]))));
        cm = grp_max(mine ? cm + cb : -1e30f);
        const float mn = fmaxf(S.m, cm), al = ex2(S.m - mn);
        const float sh = (mine ? mn : 1e30f) - cb;
#pragma unroll
        for (int kt = 0; kt < 4; ++kt)
#pragma unroll
            for (int i = 0; i < 4; ++i) s[kt][i] = ex2(s[kt][i] - sh);
        S.m = mn;
        f32x4 rs = {0.f, 0.f, 0.f, 0.f};
#pragma unroll
        for (int dt = 0; dt < 4; ++dt) S.o[dt] = S.o[dt] * al;
#pragma unroll
        for (int ks = 0; ks < 2; ++ks) { const bf16x8 pB = pack_p(s[2 * ks], s[2 * ks + 1]);
            rs = mfma16(ones, pB, rs);
#pragma unroll
            for (int dt = 0; dt < 4; ++dt) S.o[dt] = mfma16(vf[ks][dt], pB, S.o[dt]); }
        S.l4[0] = S.l4[0] * al + rs[0];
    };
    auto addout = [&](PackSt& S, size_t qrow, int br) __attribute__((always_inline)) {
        const float gs = p.GATE[qrow * 32 + (g * 4 + hh) * 3 + br] * __builtin_amdgcn_rcpf(S.l4[0]);
        bf16_t* orow = p.OCAT + qrow * DM + (g * 4 + hh) * 64 + 4 * G;
#pragma unroll
        for (int dt = 0; dt < 4; ++dt) { const u32x2 w = *(const u32x2*)(orow + dt * 16); f32x4 pa; pa[0] = bflo(w.x); pa[1] = bfhi(w.x); pa[2] = bflo(w.y); pa[3] = bfhi(w.y);
            st_bf16x4(orow + dt * 16, pa + S.o[dt] * gs); }
    };
    {
        unsigned umA[4], umB[4], um[4];
#pragma unroll
        for (int w = 0; w < 4; ++w) {
            umA[w] = __builtin_amdgcn_readfirstlane(row_or_q(mskA[w]));
            umB[w] = __builtin_amdgcn_readfirstlane(row_or_q(mskB[w]));
            um[w] = umA[w] | umB[w];
        }
        reset(A); reset(B);
        const bf16_t* klane = p.SLCkF + (size_t)(b * NG + g) * SEQ * 64 + lane * 8;
        const bf16_t* vlane = p.SLCvT + (size_t)(b * NG + g) * SEQ * 64 + lane * 8;
        auto ldfr = [&](int j_, bf16x8 (&kf_)[4][2], bf16x8 (&vf_)[2][4]) __attribute__((always_inline)) {
            const bf16_t* kr = klane + (size_t)j_ * 4096; const bf16_t* vr = vlane + (size_t)j_ * 4096;
#pragma unroll
            for (int kt = 0; kt < 4; ++kt) { kf_[kt][0] = *(const bf16x8*)(kr + (kt * 2) * 512); kf_[kt][1] = *(const bf16x8*)(kr + (kt * 2 + 1) * 512); }
#pragma unroll
            for (int ks = 0; ks < 2; ++ks)
#pragma unroll
                for (int dt = 0; dt < 4; ++dt) vf_[ks][dt] = *(const bf16x8*)(vr + (ks * 4 + dt) * 512);
        };
        auto nextj = [&](int& j_) __attribute__((always_inline)) {
            int w = um[0] ? 0 : um[1] ? 1 : um[2] ? 2 : um[3] ? 3 : -1;
            if (w < 0) return false;
            const unsigned u = w == 0 ? um[0] : w == 1 ? um[1] : w == 2 ? um[2] : um[3];
            const int bpos = __builtin_ctz(u);
            j_ = w * 32 + bpos;
            const unsigned cl = ~(1u << bpos);
            if (w == 0) um[0] &= cl; else if (w == 1) um[1] &= cl; else if (w == 2) um[2] &= cl; else um[3] &= cl;
            return true;
        };
        auto packstep = [&](PackSt& S, const unsigned (&msk)[4], int tc, int j, const bf16x8 (&kf)[4][2], const bf16x8 (&vf)[2][4]) __attribute__((always_inline)) {
            const unsigned mw = (j >> 5) == 0 ? msk[0] : (j >> 5) == 1 ? msk[1] : (j >> 5) == 2 ? msk[2] : msk[3];
            const bool mine = (mw >> (j & 31)) & 1u;
            const bool farb = j <= qb - 3;
            f32x4 s[4];
#pragma unroll
            for (int kt = 0; kt < 4; ++kt) { s[kt] = mfma16(kf[kt][0], S.q0, (f32x4){0.f, 0.f, 0.f, 0.f}); s[kt] = mfma16(kf[kt][1], S.q1, s[kt]); }
            if (!farb) {
#pragma unroll
                for (int kt = 0; kt < 4; ++kt)
#pragma unroll
                    for (int i = 0; i < 4; ++i) { const int dist = tc - (j * 64 + 16 * kt + 4 * G + i); const int dd = dist < 0 ? 0 : (dist > 128 ? 128 : dist);
                        s[kt][i] = dist >= 0 ? s[kt][i] + T2[dd * 8 + g * 4 + hh] : -1e30f; }
            }
            finish(S, s, farb ? b31 : 0.f, mine, vf);
        };
        auto blockstep = [&](int j, const bf16x8 (&kf)[4][2], const bf16x8 (&vf)[2][4]) __attribute__((always_inline)) {
            const int w = j >> 5; const unsigned bit = 1u << (j & 31);
            const unsigned ua = w == 0 ? umA[0] : w == 1 ? umA[1] : w == 2 ? umA[2] : umA[3];
            const unsigned ub = w == 0 ? umB[0] : w == 1 ? umB[1] : w == 2 ? umB[2] : umB[3];
            if (ua & bit) packstep(A, mskA, tcA, j, kf, vf);
            if (ub & bit) packstep(B, mskB, tcB, j, kf, vf);
        };
        auto ldk = [&](int j_, bf16x8 (&kf_)[4][2]) __attribute__((always_inline)) {
            const bf16_t* kr = klane + (size_t)j_ * 4096;
#pragma unroll
            for (int kt = 0; kt < 4; ++kt) { kf_[kt][0] = *(const bf16x8*)(kr + (kt * 2) * 512); kf_[kt][1] = *(const bf16x8*)(kr + (kt * 2 + 1) * 512); }
        };
        auto ldv = [&](int j_, bf16x8 (&vf_)[2][4]) __attribute__((always_inline)) {
            const bf16_t* vr = vlane + (size_t)j_ * 4096;
#pragma unroll
            for (int ks = 0; ks < 2; ++ks)
#pragma unroll
                for (int dt = 0; dt < 4; ++dt) vf_[ks][dt] = *(const bf16x8*)(vr + (ks * 4 + dt) * 512);
        };
        bf16x8 kfA[4][2], kfB[4][2], vf[2][4];
        int j = 0; bool have = nextj(j);
        ldk(j, kfA);
#pragma unroll 1
        while (have) {
            int jn = j; bool haven = nextj(jn);
            ldv(j, vf); ldk(jn, kfB);
            __builtin_amdgcn_sched_barrier(0);
            blockstep(j, kfA, vf);
            if (!haven) break;
            j = jn; have = nextj(jn);
            ldv(j, vf); ldk(jn, kfA);
            __builtin_amdgcn_sched_barrier(0);
            blockstep(j, kfB, vf);
            j = jn;
        }
        addout(A, qrowA, 1); addout(B, qrowA + 4, 1);
    }
    {
        reset(A); reset(B);
        const int loA = t0 - WIN > 0 ? t0 - WIN : 0, hiA = t0 + 3, loB = t0 + 4 - WIN > 0 ? t0 + 4 - WIN : 0, hiB = t0 + 7;
        const bf16_t* klane = p.WINkF + (size_t)(b * NG + g) * SEQ * 64 + lane * 8;
        const bf16_t* vlane = p.WINvT + (size_t)(b * NG + g) * SEQ * 64 + lane * 8;
        auto ldfr = [&](int cb_, bf16x8 (&kf_)[4][2], bf16x8 (&vf_)[2][4]) __attribute__((always_inline)) {
            const bf16_t* kr = klane + (size_t)cb_ * 64; const bf16_t* vr = vlane + (size_t)cb_ * 64;
#pragma unroll
            for (int kt = 0; kt < 4; ++kt) { kf_[kt][0] = *(const bf16x8*)(kr + (kt * 2) * 512); kf_[kt][1] = *(const bf16x8*)(kr + (kt * 2 + 1) * 512); }
#pragma unroll
            for (int ks = 0; ks < 2; ++ks)
#pragma unroll
                for (int dt = 0; dt < 4; ++dt) vf_[ks][dt] = *(const bf16x8*)(vr + (ks * 4 + dt) * 512);
        };
        auto packstep = [&](PackSt& S, int tq0, int tc, int cb, const bf16x8 (&kf)[4][2], const bf16x8 (&vf)[2][4]) __attribute__((always_inline)) {
            const bool far = (cb + 63 <= tq0 - 128) && (cb >= tq0 + 3 - WIN);
            f32x4 s[4];
#pragma unroll
            for (int kt = 0; kt < 4; ++kt) { s[kt] = mfma16(kf[kt][0], S.q0, (f32x4){0.f, 0.f, 0.f, 0.f}); s[kt] = mfma16(kf[kt][1], S.q1, s[kt]); }
            if (!far) {
#pragma unroll
                for (int kt = 0; kt < 4; ++kt)
#pragma unroll
                    for (int i = 0; i < 4; ++i) { const int dist = tc - (cb + 16 * kt + 4 * G + i); const bool ok = dist >= 0 && dist <= WIN; const int dd = dist < 0 ? 0 : (dist > 128 ? 128 : dist);
                        s[kt][i] = ok ? s[kt][i] + T2[dd * 8 + g * 4 + hh] : -1e30f; }
            }
            finish(S, s, far ? b31 : 0.f, true, vf);
        };
        auto chunkstep = [&](int cb, const bf16x8 (&kf)[4][2], const bf16x8 (&vf)[2][4]) __attribute__((always_inline)) {
            if (cb <= hiA) packstep(A, t0, tcA, cb, kf, vf);
            if (cb + 63 >= loB) packstep(B, t0 + 4, tcB, cb, kf, vf);
        };
        auto ldk = [&](int cb_, bf16x8 (&kf_)[4][2]) __attribute__((always_inline)) {
            const bf16_t* kr = klane + (size_t)cb_ * 64;
#pragma unroll
            for (int kt = 0; kt < 4; ++kt) { kf_[kt][0] = *(const bf16x8*)(kr + (kt * 2) * 512); kf_[kt][1] = *(const bf16x8*)(kr + (kt * 2 + 1) * 512); }
        };
        auto ldv = [&](int cb_, bf16x8 (&vf_)[2][4]) __attribute__((always_inline)) {
            const bf16_t* vr = vlane + (size_t)cb_ * 64;
#pragma unroll
            for (int ks = 0; ks < 2; ++ks)
#pragma unroll
                for (int dt = 0; dt < 4; ++dt) vf_[ks][dt] = *(const bf16x8*)(vr + (ks * 4 + dt) * 512);
        };
        bf16x8 kfA[4][2], kfB[4][2], vf[2][4];
        int cb = loA & ~63;
        ldk(cb, kfA);
#pragma unroll 1
        for (;;) {
            ldv(cb, vf); ldk(cb + 64 <= hiB ? cb + 64 : cb, kfB);
            __builtin_amdgcn_sched_barrier(0);
            chunkstep(cb, kfA, vf);
            cb += 64; if (cb > hiB) break;
            ldv(cb, vf); ldk(cb + 64 <= hiB ? cb + 64 : cb, kfA);
            __builtin_amdgcn_sched_barrier(0);
            chunkstep(cb, kfB, vf);
            cb += 64; if (cb > hiB) break;
        }
        addout(A, qrowA, 2); addout(B, qrowA + 4, 2);
    }
}

__device__ __forceinline__ void phase_attn(const Params& p) {
    const int wid = threadIdx.x >> 6, lane = threadIdx.x & 63;
    { PROBE_BEGIN(3)
    if (blockIdx.x < NS * NG) attn_sample_item(p, blockIdx.x >> 1, blockIdx.x & 1);
    PROBE_END(3) }
    LAS unsigned char* L = (LAS unsigned char*)smem;
    for (int i = threadIdx.x; i < 129 * 8; i += 512) ((LAS float*)(L + A_T2))[i] = p.rel_bias[t5_bucket(i >> 3) * 8 + (i & 7)] * LOG2E;
    __syncthreads();
    {
        const int wid2 = __builtin_amdgcn_readfirstlane(threadIdx.x >> 6);
#pragma unroll 1
        for (;;) {
            __syncthreads();
            if (threadIdx.x == 0) ((LAS int*)(L + A_NP))[1] = (int)__hip_atomic_fetch_add(p.bar, 1u, __ATOMIC_RELAXED, __HIP_MEMORY_SCOPE_AGENT);
            __syncthreads();
            const int T = ((const LAS int*)(L + A_NP))[1];
            if (T >= NB * NG * (SEQ / 64)) break;
            const int bg = T & 7, qb = (SEQ / 64 - 1) - (T >> 3), t0 = qb * 64 + wid2 * 8;
            unsigned mA[4], mB[4];
            PROBE_BEGIN(6)
            attn_cmp(p, bg >> 1, bg & 1, t0, lane, L, mA);
            attn_cmp(p, bg >> 1, bg & 1, t0 + 4, lane, L, mB);
            PROBE_END(6)
            PROBE_BEGIN(7)
            attn_selwin_pair(p, bg >> 1, bg & 1, t0, lane, L, mA, mB);
            PROBE_END(7)
        }
    }
    __syncthreads();
}

constexpr int GM_LD = 136, GM_LDS = 128 * GM_LD * 2 + 1024;
__device__ __forceinline__ void phase_gmlp(const Params& p) {
    int tid = threadIdx.x; asm volatile("" : "+v"(tid));
    const int wid = __builtin_amdgcn_readfirstlane(tid >> 6), lane = tid & 63;
    LAS bf16_t* vnT = (LAS bf16_t*)smem;
    LAS float* mu = (LAS float*)(smem + 128 * GM_LD * 2);
    const int c = lane & 15, G = lane >> 4;
#pragma unroll 1
    for (int u = blockIdx.x; u < NB * 64; u += gridDim.x) {
        const int b = u >> 6, ch = u & 63; const size_t row0 = (size_t)b * SEQ + ch * 128;
        __syncthreads();
        for (int r = wid; r < 128; r += 8) {
            const u32x4 w = *(const u32x4*)(p.Vg + (row0 + r) * GMD + lane * 8);
            const float x[8] = {bflo(w.x), bfhi(w.x), bflo(w.y), bfhi(w.y), bflo(w.z), bfhi(w.z), bflo(w.w), bfhi(w.w)};
            float s = 0.f;
#pragma unroll
            for (int i = 0; i < 8; ++i) s += x[i];
            const float mean = wave_sum(s) * (1.0f / GMD);
            float q = 0.f;
#pragma unroll
            for (int i = 0; i < 8; ++i) q += (x[i] - mean) * (x[i] - mean);
            const float var = wave_sum(q) * (1.0f / GMD);
            if (lane == 0) { mu[r] = mean; mu[128 + r] = rsqrtf(var + EPS); }
        }
#pragma unroll 1
        for (int g = 0; g < 4; ++g) {
            __syncthreads();
#pragma unroll
            for (int k = 0; k < 4; ++k) {
                const int e = tid + 512 * k, s = e & 127, d0 = (e >> 7) * 8;
                const u32x4 w = *(const u32x4*)(p.Vg + (row0 + s) * GMD + g * 128 + d0);
                const float x[8] = {bflo(w.x), bfhi(w.x), bflo(w.y), bfhi(w.y), bflo(w.z), bfhi(w.z), bflo(w.w), bfhi(w.w)};
                const float m = mu[s], rs = mu[128 + s];
#pragma unroll
                for (int i = 0; i < 8; ++i) { const int cc = g * 128 + d0 + i; vnT[(d0 + i) * GM_LD + s] = f2bf((x[i] - m) * rs * p.gm_ln_g[cc] + p.gm_ln_b[cc]); }
            }
            __syncthreads();
            f32x4 acc[8];
#pragma unroll
            for (int dt = 0; dt < 8; ++dt) acc[dt] = (f32x4){0.f, 0.f, 0.f, 0.f};
            const bf16_t* wrow = p.GWb + ((size_t)g * 128 + 16 * wid + c) * 128 + 8 * G;
#pragma unroll 1
            for (int ks = 0; ks <= (wid >> 1); ++ks) {
                const bf16x8 B = *(const bf16x8*)(wrow + 32 * ks);
#pragma unroll
                for (int dt = 0; dt < 8; ++dt) {
                    const bf16x8 A = *(const LAS bf16x8*)(vnT + (dt * 16 + c) * GM_LD + 32 * ks + 8 * G);
                    acc[dt] = mfma16(A, B, acc[dt]);
                }
            }
            const int t = 16 * wid + c;
            const float bs = p.gm_bs[g * 128 + t];
#pragma unroll
            for (int dt = 0; dt < 8; ++dt) {
                const int d = dt * 16 + 4 * G;
                const u32x2 uw = *(const u32x2*)(p.U + (row0 + t) * GMD + g * 128 + d);
                f32x4 o; o[0] = bflo(uw.x) * (acc[dt][0] + bs); o[1] = bfhi(uw.x) * (acc[dt][1] + bs); o[2] = bflo(uw.y) * (acc[dt][2] + bs); o[3] = bfhi(uw.y) * (acc[dt][3] + bs);
                st_bf16x4(p.OCAT + (row0 + t) * DM + QD + g * 128 + d, o);
            }
        }
    }
    for (int it = blockIdx.x * 8 + wid; it < NS; it += gridDim.x * 8) {
        const size_t row = (size_t)MP + it;
        const u32x4 w = *(const u32x4*)(p.Vg + row * GMD + lane * 8);
        const float x[8] = {bflo(w.x), bfhi(w.x), bflo(w.y), bfhi(w.y), bflo(w.z), bfhi(w.z), bflo(w.w), bfhi(w.w)};
        float s = 0.f;
#pragma unroll
        for (int i = 0; i < 8; ++i) s += x[i];
        const float mean = wave_sum(s) * (1.0f / GMD);
        float q = 0.f;
#pragma unroll
        for (int i = 0; i < 8; ++i) q += (x[i] - mean) * (x[i] - mean);
        const float rs = rsqrtf(wave_sum(q) * (1.0f / GMD) + EPS);
#pragma unroll
        for (int i = 0; i < 8; ++i) {
            const int c = lane * 8 + i, g = c >> 7;
            const float v = (x[i] - mean) * rs * p.gm_ln_g[c] + p.gm_ln_b[c];
            p.out[O_GMV + (size_t)it * GMD + c] = v;
            const float a = p.gm_ws[(size_t)g * 128 * 128] * v + p.gm_bs[g * 128];
            p.OCAT[row * DM + QD + c] = f2bf(bf2f(p.U[row * GMD + c]) * a);
        }
    }
}

template <int MODE>
__device__ __forceinline__ void phase_norm(const Params& p) {
    const int wid = threadIdx.x >> 6, lane = threadIdx.x & 63;
    const float* gpost = MODE == 0 ? p.ln_mix_post : MODE == 1 ? p.ln_ffn_post : p.ln_ple_post;
    for (int row = blockIdx.x * 8 + wid; row < MP + NS; row += gridDim.x * 8) {
        const bf16_t* fr = (const bf16_t*)p.F + (size_t)row * DM;
        const bf16_t* xb = MODE == 1 ? (const bf16_t*)p.X1 + (size_t)row * DM : p.X2b + (size_t)row * DM;
        f32x4 f[4], x[4];
#pragma unroll
        for (int k = 0; k < 4; ++k) { const u32x2 w = *(const u32x2*)(fr + lane * 4 + k * 256); f[k][0] = bflo(w.x); f[k][1] = bfhi(w.x); f[k][2] = bflo(w.y); f[k][3] = bfhi(w.y);
            if (MODE == 0) x[k] = *(const f32x4*)(xrow_ptr(p, row) + lane * 4 + k * 256);
            else { const u32x2 v = *(const u32x2*)(xb + lane * 4 + k * 256); x[k][0] = bflo(v.x); x[k][1] = bfhi(v.x); x[k][2] = bflo(v.y); x[k][3] = bfhi(v.y); } }
        const float r = row_rstd(f);
#pragma unroll
        for (int k = 0; k < 4; ++k) { const f32x4 g = *(const f32x4*)(gpost + lane * 4 + k * 256); x[k] = x[k] + f[k] * r * g; }
        if (MODE == 0) {
            const float r2 = row_rstd(x);
#pragma unroll
            for (int k = 0; k < 4; ++k) {
                st_bf16x4((bf16_t*)p.X1 + (size_t)row * DM + lane * 4 + k * 256, x[k]);
                const f32x4 g = *(const f32x4*)(p.ln_ffn_pre + lane * 4 + k * 256); const f32x4 o = x[k] * r2 * g;
                st_bf16x4(p.H2 + (size_t)row * DM + lane * 4 + k * 256, o);
            }
        } else if (MODE == 1) {
#pragma unroll
            for (int k = 0; k < 4; ++k) st_bf16x4(p.X2b + (size_t)row * DM + lane * 4 + k * 256, x[k]);
        } else {
            float* yr = row < MP ? p.out + O_YP + (size_t)row * DM : p.out + O_YS + (size_t)(row - MP) * DM;
#pragma unroll
            for (int k = 0; k < 4; ++k) *(f32x4*)(yr + lane * 4 + k * 256) = x[k];
        }
    }
}


#define XB_TMO      128
#define XB_XCNT(j)  (256  + 64 * (j))
#define XB_XSUB(j)  (1280 + 64 * (j))
#define XB_XGEN(j)  (2304 + 64 * (j))
#define XB_TOP      3328
#define XB_TOPGEN   3392
#define XCD_BAR_WORDS 3456
#define XB_SPIN_CAP (1u << 22)

__device__ __forceinline__ unsigned xb_ld(unsigned* p)              { return __hip_atomic_load(p, __ATOMIC_RELAXED, __HIP_MEMORY_SCOPE_AGENT); }
__device__ __forceinline__ unsigned xb_add(unsigned* p, unsigned v) { return __hip_atomic_fetch_add(p, v, __ATOMIC_RELAXED, __HIP_MEMORY_SCOPE_AGENT); }
__device__ __forceinline__ unsigned xb_xcc_id() { return (unsigned)__builtin_amdgcn_s_getreg((3 << 11) | 20) & 0xFu; }
#define XB_SPIN(cond, bar) do { unsigned _sp = 0; while (cond) { __builtin_amdgcn_s_sleep(1); \
    if ((++_sp & 255u) == 0u) { if (xb_ld(&(bar)[XB_TMO])) break; if (_sp > XB_SPIN_CAP) { atomicAdd(&(bar)[XB_TMO], 1u); break; } } } } while (0)

struct XcdBarrier {
    unsigned* bar; unsigned x;
    volatile LAS unsigned* st;
};

__device__ __forceinline__ XcdBarrier xcd_barrier_post(unsigned* bar, volatile LAS unsigned* st) {
    XcdBarrier b; b.bar = bar; b.x = xb_xcc_id(); b.st = st;
    if (threadIdx.x == 0) (void)xb_add(&bar[XB_XCNT(b.x)], 1u);
    return b;
}
__device__ __forceinline__ void xcd_barrier_complete(unsigned* bar, unsigned x, unsigned& nloc, unsigned& nx) {
    const unsigned G = gridDim.x * gridDim.y * gridDim.z;
    unsigned sum, cnt, mine, sp = 0u;
    for (;;) {
        sum = 0u; cnt = 0u; mine = 0u;
#pragma unroll
        for (unsigned j = 0; j < 16; ++j) { const unsigned c = xb_ld(&bar[XB_XCNT(j)]); sum += c; cnt += (c > 0u) ? 1u : 0u; mine = (j == x) ? c : mine; }
        if (sum == G) break;
        __builtin_amdgcn_s_sleep(1);
        if ((++sp & 255u) == 0u) { if (xb_ld(&bar[XB_TMO])) break; if (sp > XB_SPIN_CAP) { atomicAdd(&bar[XB_TMO], 1u); break; } }
    }
    nloc = mine > 0u ? mine : 1u; nx = cnt > 0u ? cnt : 1u;
}

__device__ __forceinline__ void xcd_barrier(const XcdBarrier& b) {
    asm volatile("s_waitcnt vmcnt(0)" ::: "memory");
    __syncthreads();
    if (threadIdx.x == 0) {
        unsigned* bar = b.bar;
        __builtin_amdgcn_s_waitcnt(0);
        unsigned nloc = b.st[0], nx = b.st[1];
        if (nloc == 0u) { xcd_barrier_complete(bar, b.x, nloc, nx); b.st[0] = nloc; b.st[1] = nx; }
        const unsigned old = xb_add(&bar[XB_XSUB(b.x)], 1u);
        const unsigned gen = old / nloc;
        if (old + 1u == (gen + 1u) * nloc) {
            __builtin_amdgcn_fence(__ATOMIC_RELEASE, "agent");
            asm volatile("s_waitcnt vmcnt(0)" ::: "memory");
            const unsigned og = xb_add(&bar[XB_TOP], 1u);
            const unsigned tg = og / nx;
            if (og + 1u == (tg + 1u) * nx) xb_add(&bar[XB_TOPGEN], 1u);
            else XB_SPIN(xb_ld(&bar[XB_TOPGEN]) == tg, bar);
            __builtin_amdgcn_fence(__ATOMIC_ACQUIRE, "agent");
            xb_add(&bar[XB_XGEN(b.x)], 1u);
            asm volatile("s_waitcnt vmcnt(0)" ::: "memory");
        } else {
            XB_SPIN(xb_ld(&bar[XB_XGEN(b.x)]) == gen, bar);
            __builtin_amdgcn_fence(__ATOMIC_ACQUIRE, "agent");
            asm volatile("s_waitcnt vmcnt(0)" ::: "memory");
        }
    }
    __syncthreads();
}

constexpr int NPHASE = 16;
constexpr int LDS_BYTES = GEMM_LDS;
static_assert(GM_LDS <= LDS_BYTES, "lds");
constexpr int NMT = MALL / BM;

constexpr int NMP = MP / BM;
template <int PH>
__device__ __forceinline__ void run_phase(const Params& p) {
    if (PH == 0) phase_prologue(p);
    if (PH == 1) { EpiIn e{p}; if (blockIdx.x & 1) phase_gather(p); gemm_phase(p.H, DM, p.WinT, DM, NMP, INP / BM, e); gemm_skinny(p.H + (size_t)MP * DM, DM, p.WinT, DM, INP, e); if (!(blockIdx.x & 1)) phase_gather(p); }
    if (PH == 2) { EpiPart e{(bf16_t*)p.PART}; gemm_phase(p.CMPb, 4096, p.W1T, 1024, (2048 + NS * 1024) / BM, 1, e, 4, ZCmp(), 256); phase_deferred_transposes(p); }
    if (PH == 3) phase_cmp_final(p);
    if (PH == 4) phase_attn(p);
    if (PH == 5) phase_gmlp(p);
    if (PH == 6) { EpiBranch e{p.GA, p.GB, p.Y1}; gemm_phase<EpiBranch, ZNone, true>(p.OCAT, DM, p.WnT, DM, NMP, DM / BM, e); gemm_skinny2(p.OCAT + (size_t)MP * DM, DM, p.WnT, DM, DM, e); }
    if (PH == 8) { EpiBf16 e{(bf16_t*)p.F, DM}; gemm_phase(p.Y1, DM, p.WoT, DM, NMP, DM / BM, e); gemm_skinny(p.Y1 + (size_t)MP * DM, DM, p.WoT, DM, DM, e); }
    if (PH == 9) phase_norm<0>(p);
    if (PH == 10) { EpiSwiGLU e{p.ACT}; gemm_phase(p.H2, DM, p.WguT, DM, NMP, 2 * DFF / BM, e); gemm_skinny(p.H2 + (size_t)MP * DM, DM, p.WguT, DM, 2 * DFF, e); }
    if (PH == 11) { EpiBf16 e{(bf16_t*)p.F, DM}; gemm_phase(p.ACT, DFF, p.WdT, DFF, NMP, DM / BM, e); gemm_skinny(p.ACT + (size_t)MP * DFF, DFF, p.WdT, DFF, DM, e); }
    if (PH == 12) phase_norm<1>(p);
    if (PH == 13) { EpiBf16 e{(bf16_t*)p.T, DM}; gemm_phase(p.Pb, PLE, p.WpT, PLE, NMP, DM / BM, e); gemm_skinny(p.Pb + (size_t)MP * PLE, PLE, p.WpT, PLE, DM, e); }
    if (PH == 14) { EpiPleGate e{(const bf16_t*)p.T, (bf16_t*)p.F}; gemm_phase(p.X2b, DM, p.WpgT, DM, NMP, DM / BM, e); gemm_skinny(p.X2b + (size_t)MP * DM, DM, p.WpgT, DM, DM, e); }
    if (PH == 15) phase_norm<2>(p);
}

#ifndef MK_MULTI
#define MK_MULTI 0
#endif
template <int PH>
__global__ void __launch_bounds__(512, 2) k_phase(Params p) { run_phase<PH>(p); }

__global__ void __launch_bounds__(512, 2) k_all(Params p) {
    volatile LAS unsigned* st = (volatile LAS unsigned*)((LAS unsigned char*)smem + LDS_BYTES);
    if (threadIdx.x < 12) st[threadIdx.x] = 0u;
    __syncthreads();
    XcdBarrier bar = xcd_barrier_post(p.bar, st);
#if PROBE_DUP == 100
    run_phase<0>(p);  xcd_barrier(bar);
#endif
#if PROBE_SPIN >= 100
    if (threadIdx.x == 0) PROBE_TS[3] = probe_now();
#define PROBE_STAMP(k) if (threadIdx.x == 0 && PROBE_SEG == (k)) PROBE_TS[2] = probe_now() - PROBE_TS[3];
#else
#define PROBE_STAMP(k)
#endif
    run_phase<0>(p);  xcd_barrier(bar);
    PROBE_STAMP(20)
    run_phase<1>(p);  xcd_barrier(bar);
    PROBE_STAMP(21)
    run_phase<2>(p);  xcd_barrier(bar);
#if PROBE_DUP == 100
    run_phase<3>(p);  xcd_barrier(bar);
#endif
    run_phase<3>(p);  xcd_barrier(bar);
    PROBE_STAMP(23)
#if PROBE_DUP == 104
    run_phase<4>(p);  xcd_barrier(bar);
#endif
    run_phase<4>(p);
#if PROBE_DUP == 100
    run_phase<5>(p);  xcd_barrier(bar);
#endif
    run_phase<5>(p);  xcd_barrier(bar);
    PROBE_STAMP(25)
    run_phase<6>(p);  xcd_barrier(bar);
    run_phase<8>(p);  xcd_barrier(bar);
    PROBE_STAMP(28)
    run_phase<9>(p);  xcd_barrier(bar);
    PROBE_STAMP(29)
    run_phase<10>(p); xcd_barrier(bar);
    PROBE_STAMP(30)
    run_phase<11>(p); xcd_barrier(bar);
    PROBE_STAMP(31)
    run_phase<12>(p);
    run_phase<13>(p); xcd_barrier(bar);
    run_phase<14>(p); xcd_barrier(bar);
    PROBE_STAMP(34)
    run_phase<15>(p);
#if PROBE_SPIN
    if (blockIdx.x == 0 && threadIdx.x == 0) {
        const unsigned long long d = PROBE_TS[2] * (PROBE_SPIN >= 100 ? PROBE_SPIN - 100 : PROBE_SPIN), t0 = probe_now();
        while (probe_now() - t0 < d) __builtin_amdgcn_s_sleep(8);
    }
#endif
}

static inline size_t al256(size_t x) { return (x + 255) & ~(size_t)255; }
template <int PH> static void launch_phase(const Params& p, int grid, hipStream_t s) {
    static bool attr = false;
    if (!attr) { (void)hipFuncSetAttribute((const void*)k_phase<PH>, hipFuncAttributeMaxDynamicSharedMemorySize, LDS_BYTES); attr = true; }
    k_phase<PH><<<grid, 512, LDS_BYTES, s>>>(p);
}
template <int PH> static void launch_all(const Params& p, int grid, hipStream_t s) {
    launch_phase<PH>(p, grid, s);
    if constexpr (PH + 1 < NPHASE) launch_all<PH + 1>(p, grid, s);
}

extern "C" void kernel_launch(void* const* d_in, const int* in_sizes, int n_in, void* d_out, int out_size, void* d_ws, size_t ws_size, hipStream_t stream) {
    Params p{};
    p.x_prompt = (const float*)d_in[0]; p.x_sample = (const float*)d_in[1]; p.cache_cmp = (const float*)d_in[2]; p.cache_slc = (const float*)d_in[3];
    p.state_win = (const float*)d_in[4]; p.page_table = (const int*)d_in[5]; p.p_prompt = (const float*)d_in[6]; p.p_sample = (const float*)d_in[7];
    p.rel_bias = (const float*)d_in[8]; p.ln_mix_pre = (const float*)d_in[9]; p.w_in = (const float*)d_in[10];
    p.pe_k = (const float*)d_in[11]; p.w1_k = (const float*)d_in[12]; p.w2_k = (const float*)d_in[13];
    p.pe_v = (const float*)d_in[14]; p.w1_v = (const float*)d_in[15]; p.w2_v = (const float*)d_in[16];
    p.gm_ln_g = (const float*)d_in[17]; p.gm_ln_b = (const float*)d_in[18]; p.gm_ws = (const float*)d_in[19]; p.gm_bs = (const float*)d_in[20];
    p.w_br_nsa = (const float*)d_in[21]; p.w_br_gm = (const float*)d_in[22]; p.w_out = (const float*)d_in[23];
    p.ln_mix_post = (const float*)d_in[24]; p.ln_ffn_pre = (const float*)d_in[25]; p.w_gate = (const float*)d_in[26]; p.w_up = (const float*)d_in[27];
    p.w_down = (const float*)d_in[28]; p.ln_ffn_post = (const float*)d_in[29]; p.w_ple = (const float*)d_in[30]; p.w_ple_gate = (const float*)d_in[31];
    p.ln_ple_post = (const float*)d_in[32];
    p.out = (float*)d_out;
    unsigned char* w = (unsigned char*)d_ws; size_t off = 0;
    auto take = [&](size_t bytes) { void* r = w + off; off = al256(off + bytes); return r; };
    p.bar = (unsigned*)take(16384);
    p.WinT = (bf16_t*)take((size_t)INP * DM * 2); p.WnT = (bf16_t*)take((size_t)DM * DM * 2); p.WgT = nullptr;
    p.WoT = (bf16_t*)take((size_t)DM * DM * 2); p.WguT = (bf16_t*)take((size_t)2 * DFF * DM * 2); p.WdT = (bf16_t*)take((size_t)DM * DFF * 2);
    p.WpgT = (bf16_t*)take((size_t)DM * DM * 2); p.WpT = (bf16_t*)take((size_t)DM * PLE * 2); p.W1T = (bf16_t*)take((size_t)2 * 256 * 1024 * 2);
    p.H = (bf16_t*)take((size_t)MALL * DM * 2); p.Qb = (bf16_t*)take((size_t)MALL * QD * 2);
    p.CMPb = (bf16_t*)take(((size_t)MP + (size_t)NS * PAST) * 256 * 2); p.SLCb = (bf16_t*)take((size_t)MALL * 256 * 2); p.WINb = (bf16_t*)take((size_t)MALL * 256 * 2);
    p.U = (bf16_t*)take((size_t)MALL * GMD * 2); p.Vg = (bf16_t*)take((size_t)MALL * GMD * 2);
    p.GA = (bf16_t*)take((size_t)MALL * DM * 2); p.GB = (bf16_t*)take((size_t)MALL * DM * 2);
    p.GATE = (float*)take((size_t)MALL * 32 * 4);
    p.PART = (float*)take((size_t)(2048 + NS * 1024) * 4 * 256 * 4); p.PEB = (float*)take(256 * 4);
    p.KCP = (float*)take((size_t)NB * NG * 512 * 64 * 4); p.VCP = (float*)take((size_t)NB * NG * 512 * 64 * 4);
    p.KCS = (float*)take((size_t)NS * NG * 1024 * 64 * 4); p.VCS = (float*)take((size_t)NS * NG * 1024 * 64 * 4); p.KN = (float*)take(NB * NG * 128 * 4);
    p.KCb = (bf16_t*)take((size_t)NB * NG * 512 * 64 * 2); p.VCT = (bf16_t*)take((size_t)NB * NG * 64 * 512 * 2);
    p.SLCvT = (bf16_t*)take((size_t)NB * NG * 64 * SEQ * 2); p.WINvT = (bf16_t*)take((size_t)NB * NG * 64 * SEQ * 2);
    p.GWb = (bf16_t*)take(4 * 128 * 128 * 2); p.W2T = (bf16_t*)take(2 * 64 * 128 * 2);
    p.SLCkF = (bf16_t*)take((size_t)NB * NG * 64 * SEQ * 2); p.WINkF = (bf16_t*)take((size_t)NB * NG * 64 * SEQ * 2);
    p.OCAT = (bf16_t*)take((size_t)MALL * DM * 2); p.T = (float*)take((size_t)MALL * DM * 4); p.Y1 = (bf16_t*)take((size_t)MALL * DM * 2);
    p.F = (float*)take((size_t)MALL * DM * 4); p.X1 = (float*)take((size_t)MALL * DM * 4); p.H2 = (bf16_t*)take((size_t)MALL * DM * 2);
    p.ACT = (bf16_t*)take((size_t)MALL * DFF * 2); p.X2 = (float*)take((size_t)MALL * DM * 4); p.X2b = (bf16_t*)take((size_t)MALL * DM * 2);
    p.Pb = (bf16_t*)take((size_t)MALL * PLE * 2);
    if (off > ws_size) { fprintf(stderr, "workspace too small: need %zu have %zu\n", off, ws_size); return; }
#if MK_MULTI
    launch_all<0>(p, 256, stream);
#else
    constexpr size_t kDynLds = LDS_BYTES + 48;
    static int grid = 0;
    if (!grid) {
        int dev = 0, cus = 0, per_cu = 0;
        (void)hipGetDevice(&dev);
        (void)hipDeviceGetAttribute(&cus, hipDeviceAttributeMultiprocessorCount, dev);
        (void)hipFuncSetAttribute((const void*)k_all, hipFuncAttributeMaxDynamicSharedMemorySize, (int)kDynLds);
        (void)hipOccupancyMaxActiveBlocksPerMultiprocessor(&per_cu, (const void*)k_all, 512, kDynLds);
        grid = cus * (per_cu < 1 ? per_cu : 1);
        if (grid <= 0) { fprintf(stderr, "k_all: occupancy query says %d blocks per CU\n", per_cu); grid = 0; return; }
    }
    (void)hipMemsetAsync(p.bar, 0, XCD_BAR_WORDS * sizeof(unsigned), stream);
    k_all<<<grid, 512, kDynLds, stream>>>(p);
#endif
}
```

```cpp
#include <hip/hip_runtime.h>
#include <stdint.h>
#include <cstdio>

typedef unsigned short bf16_t;
typedef short bf16x8 __attribute__((ext_vector_type(8)));
typedef float f32x4 __attribute__((ext_vector_type(4)));
typedef float f32x2 __attribute__((ext_vector_type(2)));
typedef unsigned u32x4 __attribute__((ext_vector_type(4)));
typedef unsigned u32x2 __attribute__((ext_vector_type(2)));
#define LAS __attribute__((address_space(3)))

constexpr int DM = 1024, NB = 4, SEQ = 8192, MP = NB * SEQ, NS = 32, MALL = MP + 256, PAST = 16384, PAGE = 128, NPG = 128;
constexpr int NH = 8, NG = 2, HPG = 4, DH = 64, QD = 512, WIN = 512, GMD = 512, DFF = 2816, PLE = 256, IND = 4376, INP = 4608;
constexpr int NCP = 511, NCS = 1023;
constexpr float EPS = 1e-6f;
constexpr float LOG2E = 1.4426950408889634f, QSCALE = 0.125f * LOG2E;
constexpr long O_YP = 0, O_YS = 33554432, O_CMPP = 33587200, O_SLCP = 41975808, O_WINP = 50364416, O_CMPS = 50888704,
               O_SLCS = 50896896, O_WINS = 50905088, O_GMV = 55099392;

struct Params {
    const float *x_prompt, *x_sample, *cache_cmp, *cache_slc, *state_win; const int* page_table;
    const float *p_prompt, *p_sample, *rel_bias, *ln_mix_pre, *w_in, *pe_k, *w1_k, *w2_k, *pe_v, *w1_v, *w2_v;
    const float *gm_ln_g, *gm_ln_b, *gm_ws, *gm_bs, *w_br_nsa, *w_br_gm, *w_out, *ln_mix_post, *ln_ffn_pre;
    const float *w_gate, *w_up, *w_down, *ln_ffn_post, *w_ple, *w_ple_gate, *ln_ple_post;
    float* out;
    unsigned* bar;
    bf16_t *WinT, *WnT, *WgT, *WoT, *WguT, *WdT, *WpgT, *WpT, *W1T;
    bf16_t *H, *Qb, *CMPb, *SLCb, *WINb, *U, *Vg, *GA, *GB;
    float* GATE;
    float *PART, *PEB, *KCP, *VCP, *KCS, *VCS, *KN;
    bf16_t *KCb, *VCT, *SLCvT, *WINvT, *SLCkF, *WINkF, *GWb, *W2T;
    bf16_t* OCAT; float* T; bf16_t* Y1; float* F; float* X1; bf16_t* H2; bf16_t* ACT; float* X2; bf16_t* X2b; bf16_t* Pb;
};

typedef __bf16 bf16v2_t __attribute__((ext_vector_type(2)));
__device__ __forceinline__ unsigned cvt_pk_bf16(float lo, float hi) { const f32x2 v = {lo, hi}; return __builtin_bit_cast(unsigned, __builtin_convertvector(v, bf16v2_t)); }
__device__ __forceinline__ unsigned cvt_pk_bf16_t(float lo, float hi) { unsigned r; asm volatile("s_nop 1\n\tv_cvt_pk_bf16_f32 %0, %1, %2" : "=v"(r) : "v"(lo), "v"(hi)); return r; }
__device__ __forceinline__ bf16_t f2bf(float f) { return (bf16_t)(cvt_pk_bf16(f, 0.f) & 0xffffu); }
__device__ __forceinline__ float bf2f(bf16_t h) { return __uint_as_float(((unsigned)h) << 16); }
__device__ __forceinline__ float bflo(unsigned w) { return __uint_as_float(w << 16); }
__device__ __forceinline__ float bfhi(unsigned w) { return __uint_as_float(w & 0xffff0000u); }
__device__ __forceinline__ float ex2(float x) { return __builtin_amdgcn_exp2f(x); }
__device__ __forceinline__ float sigmoidf_(float x) { return __builtin_amdgcn_rcpf(1.0f + __builtin_amdgcn_exp2f(x * -1.4426950408889634f)); }
__device__ __forceinline__ float siluf_(float x) { return x * sigmoidf_(x); }
__device__ __forceinline__ float sigmoid_fast(float x) { return __builtin_amdgcn_rcpf(1.0f + __builtin_amdgcn_exp2f(x * -1.4426950408889634f)); }
__device__ __forceinline__ float gelu_fast(float x) {
    const float t = x * (-2.0f * 0.7978845608028654f * 1.4426950408889634f) * (1.0f + 0.044715f * x * x);
    return x * __builtin_amdgcn_rcpf(1.0f + __builtin_amdgcn_exp2f(t));
}
__device__ __forceinline__ float silu_fast(float x) { return x * __builtin_amdgcn_rcpf(1.0f + __builtin_amdgcn_exp2f(x * -1.4426950408889634f)); }
__device__ __forceinline__ float geluf_(float x) {
    const float u = 0.7978845608028654f * (x + 0.044715f * x * x * x);
    const float e = __expf(2.0f * u);
    const float th = 1.0f - 2.0f / (e + 1.0f);
    return 0.5f * x * (1.0f + th);
}
__device__ __forceinline__ float wave_sum(float v) {
#pragma unroll
    for (int o = 32; o > 0; o >>= 1) v += __shfl_xor(v, o);
    return v;
}
__device__ __forceinline__ float wave_max(float v) {
#pragma unroll
    for (int o = 32; o > 0; o >>= 1) v = fmaxf(v, __shfl_xor(v, o));
    return v;
}
__device__ __forceinline__ int t5_bucket(int d) {
    if (d < 16) return d;
    if (d >= 128) return 31;
    const int b = 16 + (int)(__logf((float)d * (1.0f / 16.0f)) * (16.0f / 2.0794415416798357f));
    return b < 31 ? b : 31;
}

extern __shared__ __attribute__((aligned(16))) unsigned char smem[];
#ifndef PROBE_DUP
#define PROBE_DUP 0
#endif
#define PROBE_LDS_OFF 131072
#ifndef PROBE_SPIN
#define PROBE_SPIN 0
#endif
#ifndef PROBE_SEG
#define PROBE_SEG 5
#endif
__device__ __forceinline__ unsigned long long probe_now() { unsigned long long t; asm volatile("s_memrealtime %0\n\ts_waitcnt lgkmcnt(0)" : "=s"(t) :: "memory"); return t; }
#define PROBE_TS ((volatile LAS unsigned long long*)((LAS unsigned char*)smem + PROBE_LDS_OFF + 16))
#if PROBE_SPIN
#define PROBE_BEGIN(seg) unsigned long long pb_##seg = 0; if (PROBE_SEG == seg && threadIdx.x == 0) pb_##seg = probe_now();
#define PROBE_END(seg) if (PROBE_SEG == seg && threadIdx.x == 0) { PROBE_TS[2] = PROBE_TS[2] + (probe_now() - pb_##seg); }
#else
#define PROBE_BEGIN(seg)
#define PROBE_END(seg)
#endif

constexpr int BM = 256, BK = 64, HALF = 128, HT = HALF * BK, GEMM_LDS = 8 * HT * 2;
__device__ __forceinline__ int lds_byte(int r, int c) { const int st = (r >> 4) * 2 + (c >> 5), rr = r & 15, cc = c & 31, ob = rr * 64 + cc * 2; return st * 1024 + (ob ^ (((ob >> 9) & 1) << 5)); }
__device__ __forceinline__ void stage_rc(int b, int& R, int& C) { const int st = b / 1024, sb = b % 1024, swz = sb ^ (((sb >> 9) & 1) << 5); R = (st >> 1) * 16 + swz / 64; C = (st & 1) * 32 + (swz % 64) / 2; }

constexpr int HTB = HALF * BK * 2;
template <class F>
__device__ __forceinline__ void for_each_frag(const f32x4 (&acc)[2][2][4][2], int brow, int bcol, int wr, int wc, int fr, int fq, F&& f) {
#pragma unroll
    for (int ai = 0; ai < 2; ++ai)
#pragma unroll
        for (int m = 0; m < 4; ++m)
#pragma unroll
            for (int bj = 0; bj < 2; ++bj)
#pragma unroll
                for (int n = 0; n < 2; ++n)
                    f(brow + ai * HALF + wr * 64 + m * 16 + fr, bcol + bj * HALF + wc * 32 + n * 16 + fq * 4, acc[ai][bj][m][n]);
}

__host__ __device__ __forceinline__ int inv_a(int ca) { return ((ca >> 5) & 1) * 128 + (ca >> 6) * 32 + ((ca >> 2) & 1) * 16 + ((ca >> 3) & 3) * 4 + (ca & 3); }
__host__ __device__ __forceinline__ int row_a(int n) { return (n & ~255) + inv_a(n & 255); }
__host__ __device__ __forceinline__ int inv_s(int o, int s) { return ((o >> 2) & 1) * 128 + (o >> 5) * 32 + ((o >> 1) & 1) * 16 + ((o >> 3) & 3) * 4 + (o & 1) * 2 + s; }
__host__ __device__ __forceinline__ int row_s(int n, int s) { return (n >> 7) * 256 + inv_s(n & 127, s); }
__host__ __device__ __forceinline__ int lcol_a(int r) { const int cg = r & 255; return (r & ~255) + ((cg >> 5) & 3) * 64 + (cg >> 7) * 32 + ((cg >> 2) & 3) * 8 + ((cg >> 4) & 1) * 4; }
__host__ __device__ __forceinline__ int lcol_s(int r) { const int cg = r & 255; return (r & ~255) + 2 * (((cg >> 5) & 3) * 32 + ((cg >> 2) & 3) * 8 + (cg >> 7) * 4 + ((cg >> 4) & 1) * 2); }
template <class F>
__device__ __forceinline__ void for_each_frag8(const f32x4 (&acc)[2][2][4][2], int brow, int bcol, int wr, int wc, int fr, int fq, F&& f) {
#pragma unroll
    for (int ai = 0; ai < 2; ++ai)
#pragma unroll
        for (int m = 0; m < 4; ++m)
#pragma unroll
            for (int bj = 0; bj < 2; ++bj)
                f(brow + ai * HALF + wr * 64 + m * 16 + fr, bcol + wc * 64 + bj * 32 + fq * 8, acc[ai][bj][m][0], acc[ai][bj][m][1]);
}

struct ZNone { __device__ __forceinline__ size_t a(int) const { return 0; } __device__ __forceinline__ size_t b(int) const { return 0; } };
template <class Epi, class ZMap = ZNone, bool HAS_MID = false>
__device__ __forceinline__ void gemm_phase(const bf16_t* A, int lda, const bf16_t* Bt, int K, int nM, int nN, const Epi& E, int nZ = 1, ZMap zm = ZMap(), int kstepA_el = BK) {
    LAS unsigned char* lds = (LAS unsigned char*)smem;
    int tid = threadIdx.x; asm volatile("" : "+v"(tid));
    const int wid = __builtin_amdgcn_readfirstlane(tid >> 6), lane = tid & 63, wr = wid >> 2, wc = wid & 3, fr = lane & 15, fq = lane >> 4;
    const int nt = K / BK, nmn = nM * nN, nu = nmn * nZ, G = gridDim.x;
    int u = blockIdx.x;
    if (u >= nu) return;
    unsigned voffA[2], voffB[2];
#pragma unroll
    for (int i = 0; i < 2; ++i) { int R, C; stage_rc(tid * 16 + i * 8192, R, C); voffA[i] = (unsigned)(R * lda + C) * 2u; voffB[i] = (unsigned)(R * K + C) * 2u; }
    const size_t kstep = (size_t)(BK * 2), kstepA = (size_t)kstepA_el * 2;
    const size_t hstepA = (size_t)HALF * lda * 2, hstepB = (size_t)HALF * K * 2, tstepA = 2 * hstepA, tstepB = 2 * hstepB;
    const unsigned ldsw = (unsigned)wid * 1024u;
    const int aoff = lds_byte(wr * 64 + fr, fq * 8), boff = lds_byte(wc * 32 + fr, fq * 8);
#define PG8_SA(b, h) (((b) * 2 + (h)) * HTB)
#define PG8_SB(b, h) ((4 + (b) * 2 + (h)) * HTB)
#define PG8_STAGE(bufoff, gbase, voff) do { _Pragma("unroll") for (int _i = 0; _i < 2; ++_i) \
        __builtin_amdgcn_global_load_lds((const unsigned*)((const char*)(gbase) + (voff)[_i]), (LAS unsigned*)(lds + (bufoff) + ldsw + _i * 8192), 16, 0, 0); } while (0)
#define PG8_LDA(dst, b, h) do { _Pragma("unroll") for (int m = 0; m < 4; ++m) _Pragma("unroll") for (int k = 0; k < 2; ++k) dst[m][k] = *(const LAS bf16x8*)(lds + PG8_SA(b, h) + aoff + m * 2048 + k * 1024); } while (0)
#define PG8_LDB(dst, b, h) do { _Pragma("unroll") for (int n = 0; n < 2; ++n) _Pragma("unroll") for (int k = 0; k < 2; ++k) dst[n][k] = *(const LAS bf16x8*)(lds + PG8_SB(b, h) + boff + n * 2048 + k * 1024); } while (0)
#define PG8_MMA(ai, bj, At, Bt_) do { __builtin_amdgcn_s_setprio(1); _Pragma("unroll") for (int m = 0; m < 4; ++m) _Pragma("unroll") for (int n = 0; n < 2; ++n) _Pragma("unroll") for (int k = 0; k < 2; ++k) \
        acc[ai][bj][m][n] = __builtin_amdgcn_mfma_f32_16x16x32_bf16(Bt_[n][k], At[m][k], acc[ai][bj][m][n], 0, 0, 0); __builtin_amdgcn_s_setprio(0); } while (0)
#define PG8_WAIT_V(n) asm volatile("s_waitcnt vmcnt(" #n ")" ::: "memory")
#define PG8_WAIT_L(n) asm volatile("s_waitcnt lgkmcnt(" #n ")" ::: "memory")
#define PG8_BAR __builtin_amdgcn_s_barrier()
#define PG8_SCHED __builtin_amdgcn_sched_barrier(0)
    f32x4 acc[2][2][4][2];
#pragma unroll
    for (int a = 0; a < 2; ++a)
#pragma unroll
        for (int b = 0; b < 2; ++b)
#pragma unroll
            for (int m = 0; m < 4; ++m)
#pragma unroll
                for (int n = 0; n < 2; ++n) acc[a][b][m][n] = (f32x4){0.f, 0.f, 0.f, 0.f};
    bf16x8 At[4][2], B0[2][2], B1[2][2];
    auto unit_of = [&](int uu, int& z_, int& pm_, int& pn_) {
        if (nZ == 1) {
            int wg = uu; { const int q = nu / 8, r = nu % 8, xcd = wg % 8, off = wg / 8; wg = (xcd < r ? xcd * (q + 1) : r * (q + 1) + (xcd - r) * q) + off; }
            const int nig = 8 * nN, gid = wg / nig, fm = gid * 8, gsz = (nM - fm) < 8 ? (nM - fm) : 8;
            z_ = 0; pm_ = fm + ((wg % nig) % gsz); pn_ = (wg % nig) / gsz;
        } else { z_ = uu / nmn; pm_ = (uu - z_ * nmn) / nN; pn_ = (uu - z_ * nmn) - pm_ * nN; }
    };
    int z, pm, pn; unit_of(u, z, pm, pn);
    const char* cA = (const char*)(A + zm.a(z)) + (size_t)pm * tstepA; const char* cB = (const char*)(Bt + zm.b(z)) + (size_t)pn * tstepB;
    PG8_STAGE(PG8_SB(0, 0), cB, voffB); PG8_STAGE(PG8_SA(0, 0), cA, voffA); PG8_STAGE(PG8_SB(0, 1), cB + hstepB, voffB); PG8_STAGE(PG8_SA(0, 1), cA + hstepA, voffA);
    if (wr == 1) PG8_BAR;
    PG8_WAIT_V(4); PG8_BAR;
    PG8_STAGE(PG8_SB(1, 0), cB + kstep, voffB); PG8_STAGE(PG8_SA(1, 0), cA + kstepA, voffA); PG8_STAGE(PG8_SB(1, 1), cB + hstepB + kstep, voffB);
    PG8_WAIT_V(6); PG8_BAR;
    for (;;) {
        const int un = u + G; const bool has_next = un < nu;
        int nz = z, npm = pm, npn = pn; if (has_next) unit_of(un, nz, npm, npn);
        const char* nA = (const char*)(A + zm.a(nz)) + (size_t)npm * tstepA; const char* nB = (const char*)(Bt + zm.b(nz)) + (size_t)npn * tstepB;
        auto kiter = [&](int t) {
            const bool last = (t == nt - 2);
            const bool bnd = last || (HAS_MID && t == (nt >> 1) - 2);
            const char* a1 = cA + (size_t)(t + 1) * kstepA;
            const char* a2 = last ? nA : cA + (size_t)(t + 2) * kstepA; const char* b2 = last ? nB : cB + (size_t)(t + 2) * kstep;
            const char* a3 = a2 + kstepA; const char* b3 = b2 + kstep;
            PG8_LDB(B0, 0, 0); PG8_SCHED; PG8_LDA(At, 0, 0); PG8_STAGE(PG8_SA(1, 1), a1 + hstepA, voffA);
            PG8_WAIT_L(8); PG8_BAR; PG8_WAIT_L(0); PG8_MMA(0, 0, At, B0); PG8_BAR; PG8_SCHED;
            PG8_LDB(B1, 0, 1); PG8_STAGE(PG8_SB(0, 0), b2, voffB);
            PG8_BAR; PG8_WAIT_L(0); PG8_MMA(0, 1, At, B1); PG8_BAR;
            PG8_LDA(At, 0, 1); PG8_STAGE(PG8_SA(0, 0), a2, voffA);
            PG8_BAR; PG8_WAIT_L(0); PG8_MMA(1, 0, At, B0); PG8_BAR; PG8_SCHED;
            PG8_STAGE(PG8_SB(0, 1), b2 + hstepB, voffB);
            PG8_WAIT_V(6); PG8_BAR; PG8_MMA(1, 1, At, B1); PG8_BAR;
            PG8_LDB(B0, 1, 0); PG8_SCHED; PG8_LDA(At, 1, 0); PG8_STAGE(PG8_SA(0, 1), a2 + hstepA, voffA);
            PG8_WAIT_L(8); PG8_BAR; PG8_WAIT_L(0); PG8_MMA(0, 0, At, B0); PG8_BAR; PG8_SCHED;
            PG8_LDB(B1, 1, 1); PG8_STAGE(PG8_SB(1, 0), b3, voffB);
            PG8_BAR; PG8_WAIT_L(0); PG8_MMA(0, 1, At, B1); PG8_BAR;
            PG8_LDA(At, 1, 1); PG8_STAGE(PG8_SA(1, 0), a3, voffA);
            PG8_BAR; PG8_WAIT_L(0); PG8_MMA(1, 0, At, B0); PG8_BAR; PG8_SCHED;
            PG8_STAGE(PG8_SB(1, 1), b3 + hstepB, voffB);
            PG8_WAIT_V(6); PG8_BAR; PG8_MMA(1, 1, At, B1);
            if (!(bnd && wr == 1)) PG8_BAR;
        };
        if constexpr (HAS_MID) {
            for (int t = 0; t < (nt >> 1); t += 2) kiter(t);
            { int pmo = pm, pno = pn; asm volatile("" : "+s"(pmo), "+s"(pno));
              E.mid(acc, pmo * BM, pno * BM, wr, wc, fr, fq); }
            PG8_SCHED; PG8_BAR; if (wr == 1) PG8_BAR;
            for (int t = nt >> 1; t < nt; t += 2) kiter(t);
        } else {
            for (int t = 0; t < nt; t += 2) kiter(t);
        }
        { int pmo = pm, pno = pn; asm volatile("" : "+s"(pmo), "+s"(pno));
          E(acc, pmo * BM, pno * BM + (z << 20), wr, wc, fr, fq); }
        PG8_SCHED; PG8_BAR;
        if (!has_next) break;
        if (wr == 1) PG8_BAR;
#pragma unroll
        for (int a = 0; a < 2; ++a)
#pragma unroll
            for (int b = 0; b < 2; ++b)
#pragma unroll
                for (int m = 0; m < 4; ++m)
#pragma unroll
                    for (int n = 0; n < 2; ++n) acc[a][b][m][n] = (f32x4){0.f, 0.f, 0.f, 0.f};
        u = un; z = nz; pm = npm; pn = npn; cA = nA; cB = nB;
    }
    PG8_WAIT_V(0);
    PG8_BAR;
#undef PG8_SA
#undef PG8_SB
#undef PG8_STAGE
#undef PG8_LDA
#undef PG8_LDB
#undef PG8_MMA
#undef PG8_WAIT_V
#undef PG8_WAIT_L
#undef PG8_BAR
#undef PG8_SCHED
}

__device__ __forceinline__ f32x4 mfma16(bf16x8 a, bf16x8 b, f32x4 c) { return __builtin_amdgcn_mfma_f32_16x16x32_bf16(a, b, c, 0, 0, 0); }
__device__ __forceinline__ bf16x8 pack_p(const f32x4& a, const f32x4& b) {
    u32x4 w; w.x = cvt_pk_bf16(a[0], a[1]); w.y = cvt_pk_bf16(a[2], a[3]); w.z = cvt_pk_bf16(b[0], b[1]); w.w = cvt_pk_bf16(b[2], b[3]);
    return __builtin_bit_cast(bf16x8, w);
}
__device__ __forceinline__ size_t kfrag_off(int key, int d) { return ((size_t)((key >> 4) * 2 + (d >> 5)) * 64 + ((d >> 3) & 3) * 16 + (key & 15)) * 8 + (d & 7); }
__device__ __forceinline__ size_t vfrag_off(int key, int d) {
    return ((size_t)((key >> 5) * 4 + (d >> 4)) * 64 + ((key >> 2) & 3) * 16 + (d & 15)) * 8 + ((key >> 4) & 1) * 4 + (key & 3);
}
__device__ __forceinline__ void st_bf16x4(bf16_t* p, f32x4 v) { u32x2 w; w.x = cvt_pk_bf16(v[0], v[1]); w.y = cvt_pk_bf16(v[2], v[3]); *(u32x2*)p = w; }
__device__ __forceinline__ void st_bf16x8(bf16_t* p, f32x4 a, f32x4 b) { u32x4 w; w.x = cvt_pk_bf16(a[0], a[1]); w.y = cvt_pk_bf16(a[2], a[3]); w.z = cvt_pk_bf16(b[0], b[1]); w.w = cvt_pk_bf16(b[2], b[3]); *(u32x4*)p = w; }
__device__ __forceinline__ void st_bf16x8_t(bf16_t* p, f32x4 a, f32x4 b) { u32x4 w; w.x = cvt_pk_bf16_t(a[0], a[1]); w.y = cvt_pk_bf16_t(a[2], a[3]); w.z = cvt_pk_bf16_t(b[0], b[1]); w.w = cvt_pk_bf16_t(b[2], b[3]); *(u32x4*)p = w; }
__device__ __forceinline__ void st_bf16x4_t(bf16_t* p, f32x4 v) { u32x2 w; w.x = cvt_pk_bf16_t(v[0], v[1]); w.y = cvt_pk_bf16_t(v[2], v[3]); *(u32x2*)p = w; }
__device__ __forceinline__ bool win_tile_a(int pn) { return pn < 2 || (pn >= 5 && pn < 17); }

struct EpiIn {
    const Params& p;
    __device__ __forceinline__ void apply(int row, int col, f32x4 v) const {
        const Params& P = p; const int pn = col >> 8, c = col & 255;
        if (pn < 2) st_bf16x4(P.Qb + (size_t)row * QD + col, v * QSCALE);
        else if (pn < 5) {
            if (pn != 2) st_bf16x4((pn == 3 ? P.SLCb : P.WINb) + (size_t)row * 256 + c, v);
            if (pn < 4) *(f32x4*)(P.out + (pn == 2 ? O_CMPS : O_SLCS) + (size_t)(row - MP) * 256 + c) = v;
            else *(f32x4*)(P.out + O_WINS + ((size_t)(row - MP) * WIN + (WIN - 1)) * 256 + c) = v;
        } else if (pn < 9) {
            f32x4 g; g[0] = gelu_fast(v[0]); g[1] = gelu_fast(v[1]); g[2] = gelu_fast(v[2]); g[3] = gelu_fast(v[3]);
            st_bf16x4((pn < 7 ? P.U : P.Vg) + (size_t)row * GMD + (col - (pn < 7 ? 1280 : 1792)), g);
        } else if (pn < 17) {
            f32x4 g; g[0] = sigmoid_fast(v[0]); g[1] = sigmoid_fast(v[1]); g[2] = sigmoid_fast(v[2]); g[3] = sigmoid_fast(v[3]);
            st_bf16x4((pn < 13 ? P.GA : P.GB) + (size_t)row * DM + (col - (pn < 13 ? 2304 : 3328)), g);
        } else if (c < 24) { f32x4 g; g[0] = sigmoid_fast(v[0]); g[1] = sigmoid_fast(v[1]); g[2] = sigmoid_fast(v[2]); g[3] = sigmoid_fast(v[3]); *(f32x4*)(P.GATE + (size_t)row * 32 + c) = g; }
    }
    __device__ __forceinline__ int lcol(int r) const { return win_tile_a(r >> 8) ? lcol_a(r) : r; }
    __device__ __forceinline__ void operator()(const f32x4 (&acc)[2][2][4][2], int brow, int bcol, int wr, int wc, int fr, int fq) const {
        const int pn = bcol >> 8;
        const Params& P = p;
        if (pn < 2) {
            for_each_frag8(acc, brow, bcol, wr, wc, fr, fq, [&](int row, int col, f32x4 a, f32x4 b) { st_bf16x8(P.Qb + (size_t)row * QD + col, a * QSCALE, b * QSCALE); });
        } else if (pn < 5) {
            bf16_t* cp = pn == 2 ? P.CMPb : pn == 3 ? P.SLCb : P.WINb;
            for_each_frag(acc, brow, bcol, wr, wc, fr, fq, [&](int row, int col, f32x4 v) {
                const int c = col & 255;
                if (pn == 2) st_bf16x4(cp + (size_t)row * 256 + c, v);
                if (pn >= 3 && c < 128 && row < MP) {
                    st_bf16x4((pn == 3 ? P.SLCkF : P.WINkF) + ((size_t)(row >> 13) * NG + (c >> 6)) * SEQ * 64 + kfrag_off(row & (SEQ - 1), c & 63), v);
                }
                if (pn >= 3 && c >= 128 && row < MP) {
                    const int t = row & (SEQ - 1), dc = c - 128;
                    bf16_t* vt = (pn == 3 ? P.SLCvT : P.WINvT) + ((size_t)(row >> 13) * NG + (dc >> 6)) * SEQ * 64 + vfrag_off(t, dc & 63);
                    vt[0] = f2bf(v[0]); vt[8] = f2bf(v[1]); vt[16] = f2bf(v[2]); vt[24] = f2bf(v[3]);
                }
                if (pn < 4) {
                    if (row < MP) __builtin_nontemporal_store(v, (f32x4*)(P.out + (pn == 2 ? O_CMPP : O_SLCP) + (size_t)row * 256 + c));
                    else if (row < MP + NS) *(f32x4*)(P.out + (pn == 2 ? O_CMPS : O_SLCS) + (size_t)(row - MP) * 256 + c) = v;
                } else {
                    if (row < MP) { const int t = row & (SEQ - 1), b = row >> 13; if (t >= SEQ - WIN) *(f32x4*)(P.out + O_WINP + ((size_t)b * WIN + (t - (SEQ - WIN))) * 256 + c) = v; }
                    else if (row < MP + NS) *(f32x4*)(P.out + O_WINS + ((size_t)(row - MP) * WIN + (WIN - 1)) * 256 + c) = v;
                }
            });
        } else if (pn < 9) {
            bf16_t* dst = pn < 7 ? P.U : P.Vg; const int c0 = pn < 7 ? 1280 : 1792;
            for_each_frag8(acc, brow, bcol, wr, wc, fr, fq, [&](int row, int col, f32x4 a, f32x4 b) {
                f32x4 g, h; g[0] = gelu_fast(a[0]); g[1] = gelu_fast(a[1]); g[2] = gelu_fast(a[2]); g[3] = gelu_fast(a[3]); h[0] = gelu_fast(b[0]); h[1] = gelu_fast(b[1]); h[2] = gelu_fast(b[2]); h[3] = gelu_fast(b[3]);
                st_bf16x8(dst + (size_t)row * GMD + (col - c0), g, h); });
        } else if (pn < 17) {
            bf16_t* dst = pn < 13 ? P.GA : P.GB; const int c0 = pn < 13 ? 2304 : 3328;
            for_each_frag8(acc, brow, bcol, wr, wc, fr, fq, [&](int row, int col, f32x4 a, f32x4 b) {
                f32x4 g, h; g[0] = sigmoid_fast(a[0]); g[1] = sigmoid_fast(a[1]); g[2] = sigmoid_fast(a[2]); g[3] = sigmoid_fast(a[3]); h[0] = sigmoid_fast(b[0]); h[1] = sigmoid_fast(b[1]); h[2] = sigmoid_fast(b[2]); h[3] = sigmoid_fast(b[3]);
                st_bf16x8(dst + (size_t)row * DM + (col - c0), g, h); });
        } else {
            for_each_frag(acc, brow, bcol, wr, wc, fr, fq, [&](int row, int col, f32x4 v) {
                const int c = col & 255;
                if (c < 24) { f32x4 g; g[0] = sigmoid_fast(v[0]); g[1] = sigmoid_fast(v[1]); g[2] = sigmoid_fast(v[2]); g[3] = sigmoid_fast(v[3]); *(f32x4*)(P.GATE + (size_t)row * 32 + c) = g; } });
        }
    }
};
struct EpiBranch {
    const bf16_t* GA; const bf16_t* GB; bf16_t* Y1;
    __device__ __forceinline__ void mid(f32x4 (&acc)[2][2][4][2], int brow, int bcol, int wr, int wc, int fr, int fq) const {
#pragma unroll
        for (int ai = 0; ai < 2; ++ai)
#pragma unroll
            for (int m = 0; m < 4; ++m)
#pragma unroll
                for (int bj = 0; bj < 2; ++bj) {
                    const size_t o = (size_t)(brow + ai * HALF + wr * 64 + m * 16 + fr) * DM + bcol + wc * 64 + bj * 32 + fq * 8;
                    const u32x4 a = *(const u32x4*)(GA + o), b = *(const u32x4*)(GB + o);
                    f32x4& v = acc[ai][bj][m][0]; f32x4& w = acc[ai][bj][m][1];
                    v[0] *= bflo(a.x) * __builtin_amdgcn_rcpf(fmaxf(bflo(b.x), 1e-30f)); v[1] *= bfhi(a.x) * __builtin_amdgcn_rcpf(fmaxf(bfhi(b.x), 1e-30f));
                    v[2] *= bflo(a.y) * __builtin_amdgcn_rcpf(fmaxf(bflo(b.y), 1e-30f)); v[3] *= bfhi(a.y) * __builtin_amdgcn_rcpf(fmaxf(bfhi(b.y), 1e-30f));
                    w[0] *= bflo(a.z) * __builtin_amdgcn_rcpf(fmaxf(bflo(b.z), 1e-30f)); w[1] *= bfhi(a.z) * __builtin_amdgcn_rcpf(fmaxf(bfhi(b.z), 1e-30f));
                    w[2] *= bflo(a.w) * __builtin_amdgcn_rcpf(fmaxf(bflo(b.w), 1e-30f)); w[3] *= bfhi(a.w) * __builtin_amdgcn_rcpf(fmaxf(bfhi(b.w), 1e-30f));
                    asm volatile("" : "+v"(v), "+v"(w));
                    if (bj == 1) __builtin_amdgcn_sched_barrier(0);
                }
    }
    __device__ __forceinline__ int lcol(int r) const { return lcol_a(r); }
    __device__ __forceinline__ void operator()(const f32x4 (&acc)[2][2][4][2], int brow, int bcol, int wr, int wc, int fr, int fq) const {
        for_each_frag8(acc, brow, bcol, wr, wc, fr, fq, [&](int row, int col, f32x4 v, f32x4 w) {
            const u32x4 b = *(const u32x4*)(GB + (size_t)row * DM + col);
            f32x4 o, q; o[0] = v[0] * fmaxf(bflo(b.x), 1e-30f); o[1] = v[1] * fmaxf(bfhi(b.x), 1e-30f); o[2] = v[2] * fmaxf(bflo(b.y), 1e-30f); o[3] = v[3] * fmaxf(bfhi(b.y), 1e-30f);
            q[0] = w[0] * fmaxf(bflo(b.z), 1e-30f); q[1] = w[1] * fmaxf(bfhi(b.z), 1e-30f); q[2] = w[2] * fmaxf(bflo(b.w), 1e-30f); q[3] = w[3] * fmaxf(bfhi(b.w), 1e-30f);
            st_bf16x8(Y1 + (size_t)row * DM + col, o, q); });
    }
    __device__ __forceinline__ void apply2(int row, int col, f32x4 v1, f32x4 v2) const {
        const u32x2 a = *(const u32x2*)(GA + (size_t)row * DM + col), b = *(const u32x2*)(GB + (size_t)row * DM + col);
        f32x4 o; o[0] = v1[0] * bflo(a.x) + v2[0] * bflo(b.x); o[1] = v1[1] * bfhi(a.x) + v2[1] * bfhi(b.x); o[2] = v1[2] * bflo(a.y) + v2[2] * bflo(b.y); o[3] = v1[3] * bfhi(a.y) + v2[3] * bfhi(b.y);
        st_bf16x4(Y1 + (size_t)row * DM + col, o);
    }
};
struct EpiF32 {
    float* F; int ld;
    __device__ __forceinline__ void apply(int row, int col, f32x4 v) const { *(f32x4*)(F + (size_t)row * ld + col) = v; }
    __device__ __forceinline__ void operator()(const f32x4 (&acc)[2][2][4][2], int brow, int bcol, int wr, int wc, int fr, int fq) const {
        for_each_frag(acc, brow, bcol, wr, wc, fr, fq, [&](int row, int col, f32x4 v) { *(f32x4*)(F + (size_t)row * ld + col) = v; });
    }
};
struct EpiBf16 {
    bf16_t* O; int ld;
    __device__ __forceinline__ int lcol(int r) const { return lcol_a(r); }
    __device__ __forceinline__ void apply(int row, int col, f32x4 v) const { st_bf16x4(O + (size_t)row * ld + col, v); }
    __device__ __forceinline__ void operator()(const f32x4 (&acc)[2][2][4][2], int brow, int bcol, int wr, int wc, int fr, int fq) const {
        for_each_frag8(acc, brow, bcol, wr, wc, fr, fq, [&](int row, int col, f32x4 a, f32x4 b) { st_bf16x8(O + (size_t)row * ld + col, a, b); });
    }
};
struct EpiPart {
    bf16_t* PART;
    __device__ __forceinline__ void operator()(const f32x4 (&acc)[2][2][4][2], int brow, int bcol, int wr, int wc, int fr, int fq) const {
        const int z = bcol >> 20;
        for_each_frag8(acc, brow, 0, wr, wc, fr, fq, [&](int row, int col, f32x4 a, f32x4 b) { st_bf16x8(PART + ((size_t)row * 4 + z) * 256 + col, a, b); });
    }
};
struct ZCmp { __device__ __forceinline__ size_t a(int z) const { return (size_t)z * 64; } __device__ __forceinline__ size_t b(int z) const { return (size_t)(z >> 1) * 256 * 1024; } };
struct EpiSwiGLU {
    bf16_t* ACT;
    __device__ __forceinline__ int lcol(int r) const { return lcol_s(r); }
    __device__ __forceinline__ void apply(int row, int col, f32x4 v) const { *(unsigned*)(ACT + (size_t)row * DFF + (col >> 1)) = cvt_pk_bf16(silu_fast(v[0]) * v[1], silu_fast(v[2]) * v[3]); }
    __device__ __forceinline__ void operator()(const f32x4 (&acc)[2][2][4][2], int brow, int bcol, int wr, int wc, int fr, int fq) const {
#pragma unroll
        for (int ai = 0; ai < 2; ++ai)
#pragma unroll
            for (int m = 0; m < 4; ++m) {
                const f32x4 &a = acc[ai][0][m][0], &b = acc[ai][0][m][1], &c = acc[ai][1][m][0], &d = acc[ai][1][m][1];
                u32x4 w;
                w.x = cvt_pk_bf16(silu_fast(a[0]) * a[1], silu_fast(a[2]) * a[3]); w.y = cvt_pk_bf16(silu_fast(b[0]) * b[1], silu_fast(b[2]) * b[3]);
                w.z = cvt_pk_bf16(silu_fast(c[0]) * c[1], silu_fast(c[2]) * c[3]); w.w = cvt_pk_bf16(silu_fast(d[0]) * d[1], silu_fast(d[2]) * d[3]);
                *(u32x4*)(ACT + (size_t)(brow + ai * HALF + wr * 64 + m * 16 + fr) * DFF + (bcol >> 1) + wc * 32 + fq * 8) = w;
            }
    }
};
struct EpiPleGate {
    const bf16_t* E; bf16_t* F;
    __device__ __forceinline__ void apply(int row, int col, f32x4 v) const {
        const u32x2 w = *(const u32x2*)(E + (size_t)row * DM + col);
        f32x4 o; o[0] = sigmoidf_(v[0]) * bflo(w.x); o[1] = sigmoidf_(v[1]) * bfhi(w.x); o[2] = sigmoidf_(v[2]) * bflo(w.y); o[3] = sigmoidf_(v[3]) * bfhi(w.y);
        st_bf16x4(F + (size_t)row * DM + col, o); }
    __device__ __forceinline__ int lcol(int r) const { return lcol_a(r); }
    __device__ __forceinline__ void operator()(const f32x4 (&acc)[2][2][4][2], int brow, int bcol, int wr, int wc, int fr, int fq) const {
        for_each_frag8(acc, brow, bcol, wr, wc, fr, fq, [&](int row, int col, f32x4 a, f32x4 b) {
            const u32x4 w = *(const u32x4*)(E + (size_t)row * DM + col);
            f32x4 o, q; o[0] = sigmoidf_(a[0]) * bflo(w.x); o[1] = sigmoidf_(a[1]) * bfhi(w.x); o[2] = sigmoidf_(a[2]) * bflo(w.y); o[3] = sigmoidf_(a[3]) * bfhi(w.y);
            q[0] = sigmoidf_(b[0]) * bflo(w.z); q[1] = sigmoidf_(b[1]) * bfhi(w.z); q[2] = sigmoidf_(b[2]) * bflo(w.w); q[3] = sigmoidf_(b[3]) * bfhi(w.w);
            st_bf16x8(F + (size_t)row * DM + col, o, q); });
    }
};

template <class Epi>
__device__ __forceinline__ void gemm_skinny(const bf16_t* A  , int lda, const bf16_t* Bt, int K, int N, const Epi& E) {
    int tid = threadIdx.x; asm volatile("" : "+v"(tid));
    const int wid = __builtin_amdgcn_readfirstlane(tid >> 6), lane = tid & 63, c = lane & 15, G = lane >> 4;
    LAS f32x4* red = (LAS f32x4*)smem;
    const int nsteps = K / 32;
#pragma unroll 1
    for (int ct = blockIdx.x; ct < N / 16; ct += gridDim.x) {
        f32x4 acc0 = {0.f, 0.f, 0.f, 0.f}, acc1 = {0.f, 0.f, 0.f, 0.f};
        const bf16_t* bp = Bt + (size_t)(ct * 16 + c) * K + G * 8;
        const bf16_t* a0 = A + (size_t)c * lda + G * 8; const bf16_t* a1 = A + (size_t)(16 + c) * lda + G * 8;
#pragma unroll 4
        for (int kk = wid; kk < nsteps; kk += 8) {
            const bf16x8 bf = *(const bf16x8*)(bp + kk * 32), x0 = *(const bf16x8*)(a0 + kk * 32), x1 = *(const bf16x8*)(a1 + kk * 32);
            acc0 = mfma16(bf, x0, acc0); acc1 = mfma16(bf, x1, acc1);
        }
        __syncthreads();
        red[(wid * 2 + 0) * 64 + lane] = acc0; red[(wid * 2 + 1) * 64 + lane] = acc1;
        __syncthreads();
        if (tid < 128) {
            const int rt = tid >> 6;
            f32x4 v = red[rt * 64 + lane];
#pragma unroll
            for (int w = 1; w < 8; ++w) v = v + red[(w * 2 + rt) * 64 + lane];
            E.apply(MP + rt * 16 + c, E.lcol(ct * 16 + 4 * G), v);
        }
    }
    __syncthreads();
}

template <class Epi>
__device__ __forceinline__ void gemm_skinny2(const bf16_t* A  , int lda, const bf16_t* Bt, int K, int N, const Epi& E) {
    int tid = threadIdx.x; asm volatile("" : "+v"(tid));
    const int wid = __builtin_amdgcn_readfirstlane(tid >> 6), lane = tid & 63, c = lane & 15, G = lane >> 4;
    LAS f32x4* red = (LAS f32x4*)smem;
    const int hsteps = K / 64;
#pragma unroll 1
    for (int ct = blockIdx.x; ct < N / 16; ct += gridDim.x) {
        f32x4 acc[4] = {{0.f, 0.f, 0.f, 0.f}, {0.f, 0.f, 0.f, 0.f}, {0.f, 0.f, 0.f, 0.f}, {0.f, 0.f, 0.f, 0.f}};
        const bf16_t* bp = Bt + (size_t)(ct * 16 + c) * K + G * 8;
        const bf16_t* a0 = A + (size_t)c * lda + G * 8; const bf16_t* a1 = A + (size_t)(16 + c) * lda + G * 8;
#pragma unroll
        for (int h = 0; h < 2; ++h) {
#pragma unroll 2
            for (int kk = h * hsteps + wid; kk < (h + 1) * hsteps; kk += 8) {
                const bf16x8 bf = *(const bf16x8*)(bp + kk * 32), x0 = *(const bf16x8*)(a0 + kk * 32), x1 = *(const bf16x8*)(a1 + kk * 32);
                acc[h * 2] = mfma16(bf, x0, acc[h * 2]); acc[h * 2 + 1] = mfma16(bf, x1, acc[h * 2 + 1]);
            }
        }
        __syncthreads();
#pragma unroll
        for (int q = 0; q < 4; ++q) red[(wid * 4 + q) * 64 + lane] = acc[q];
        __syncthreads();
        if (tid < 128) {
            const int rt = tid >> 6;
            f32x4 v1 = red[rt * 64 + lane], v2 = red[(2 + rt) * 64 + lane];
#pragma unroll
            for (int w = 1; w < 8; ++w) { v1 = v1 + red[(w * 4 + rt) * 64 + lane]; v2 = v2 + red[(w * 4 + 2 + rt) * 64 + lane]; }
            E.apply2(MP + rt * 16 + c, E.lcol(ct * 16 + 4 * G), v1, v2);
        }
    }
    __syncthreads();
}

template <class Map>
__device__ __forceinline__ void transpose_tile(const float* W, int K, int N, bf16_t* Wt, int ldk, int kt, int ntile, Map map) {
    LAS float* tile = (LAS float*)smem;
    const int t = threadIdx.x;
    __syncthreads();
#pragma unroll
    for (int i = 0; i < 2; ++i) {
        const int k = (t >> 4) + 32 * i, n = (t & 15) * 4, gn = ntile * 64 + n;
        f32x4 v = (f32x4){0.f, 0.f, 0.f, 0.f};
        if (gn < N) v = *(const f32x4*)(W + (size_t)(kt * 64 + k) * N + gn);
        tile[k * 65 + n] = v[0]; tile[k * 65 + n + 1] = v[1]; tile[k * 65 + n + 2] = v[2]; tile[k * 65 + n + 3] = v[3];
    }
    __syncthreads();
    const int n = t >> 3, kc = (t & 7) * 8, gn = ntile * 64 + n;
    if (gn < N) {
        u32x4 w;
        w.x = cvt_pk_bf16(tile[(kc + 0) * 65 + n], tile[(kc + 1) * 65 + n]); w.y = cvt_pk_bf16(tile[(kc + 2) * 65 + n], tile[(kc + 3) * 65 + n]);
        w.z = cvt_pk_bf16(tile[(kc + 4) * 65 + n], tile[(kc + 5) * 65 + n]); w.w = cvt_pk_bf16(tile[(kc + 6) * 65 + n], tile[(kc + 7) * 65 + n]);
        *(u32x4*)(Wt + (size_t)map(gn) * ldk + kt * 64 + kc) = w;
    }
}
template <class Map>
__device__ __forceinline__ void transpose_all(const float* W, int K, int N, bf16_t* Wt, int ldk, Map map, int& base) {
    const int nkt = K / 64, nnt = (N + 63) / 64, ntl = nkt * nnt;
    for (int it = blockIdx.x; it < base + ntl; it += gridDim.x) {
        if (it < base) continue;
        const int l = it - base;
        transpose_tile(W, K, N, Wt, ldk, l / nnt, l % nnt, map);
    }
    base += ntl;
}
template <class Map>
__device__ __forceinline__ void transpose_all_sub(const float* W, int K, int N, bf16_t* Wt, int ldk, Map map, int& base) {
    const int nkt = K / 64, nnt = (N + 63) / 64, ntl = nkt * nnt, nb = gridDim.x - 32, me = blockIdx.x - 32;
    int first = base - (base % nb) + me; if (first < base) first += nb;
    for (int it = first; it < base + ntl; it += nb) { const int l = it - base; transpose_tile(W, K, N, Wt, ldk, l / nnt, l % nnt, map); }
    base += ntl;
}
__device__ __forceinline__ int map_win(int n) {
    if (n < 1280) return n;
    if (n < 1304) return 4352 + (n - 1280);
    if (n < 2328) return 1280 + (n - 1304);
    return 2304 + (n - 2328);
}

__device__ __forceinline__ float row_rstd(const f32x4 (&v)[4]) {
    float s = 0.f;
#pragma unroll
    for (int k = 0; k < 4; ++k) s += v[k][0] * v[k][0] + v[k][1] * v[k][1] + v[k][2] * v[k][2] + v[k][3] * v[k][3];
    s = wave_sum(s);
    return rsqrtf(s * (1.0f / DM) + EPS);
}
__device__ __forceinline__ const float* xrow_ptr(const Params& p, int row) {
    return row < MP ? p.x_prompt + (size_t)row * DM : p.x_sample + (size_t)(row - MP) * DM;
}

__device__ __forceinline__ void phase_prologue(const Params& p) {
    const int wid = threadIdx.x >> 6, lane = threadIdx.x & 63;
    const int gw = blockIdx.x * 8 + wid, nw = gridDim.x * 8;
    auto do_transposes = [&]() {
    int base = 0;
    transpose_all(p.w_in, DM, IND, p.WinT, DM, [](int n) { const int l = map_win(n); return win_tile_a(l >> 8) ? row_a(l) : l; }, base);
    for (int kv = 0; kv < 2; ++kv) for (int j = 0; j < 2; ++j)
        transpose_all((kv ? p.w1_v : p.w1_k) + (size_t)j * 1024 * 128, 1024, 128, p.W1T + (size_t)kv * 256 * 1024, 1024, [j](int n) { return inv_a(j * 128 + n); }, base);
    };
    do_transposes();
    __syncthreads();
    for (int i = blockIdx.x * 512 + threadIdx.x; i < (INP - IND) * DM / 8; i += gridDim.x * 512) ((u32x4*)(p.WinT + (size_t)IND * DM))[i] = (u32x4){0u, 0u, 0u, 0u};
    for (int row0 = gw * 2; row0 < MP + NS; row0 += nw * 2) {
        f32x4 v[2][4];
#pragma unroll
        for (int q = 0; q < 2; ++q) { const float* xr = xrow_ptr(p, row0 + q);
#pragma unroll
            for (int k = 0; k < 4; ++k) v[q][k] = *(const f32x4*)(xr + lane * 4 + k * 256); }
#pragma unroll
        for (int q = 0; q < 2; ++q) {
            const int row = row0 + q;
            u32x2* hd = (u32x2*)(p.H + (size_t)row * DM);
            const float r = row_rstd(v[q]);
#pragma unroll
            for (int k = 0; k < 4; ++k) { const f32x4 g = *(const f32x4*)(p.ln_mix_pre + lane * 4 + k * 256); const f32x4 o = v[q][k] * r * g; u32x2 w; w.x = cvt_pk_bf16(o[0], o[1]); w.y = cvt_pk_bf16(o[2], o[3]); hd[lane + k * 64] = w; }
            const float* pr = row < MP ? p.p_prompt + (size_t)row * PLE : p.p_sample + (size_t)(row - MP) * PLE;
            const f32x4 pv = *(const f32x4*)(pr + lane * 4);
            u32x2 w; w.x = cvt_pk_bf16(pv[0], pv[1]); w.y = cvt_pk_bf16(pv[2], pv[3]);
            ((u32x2*)(p.Pb + (size_t)row * PLE))[lane] = w;
        }
    }
    for (int i = blockIdx.x * 512 + threadIdx.x; i < 4 * 128 * 128; i += gridDim.x * 512) { const int t = (i >> 7) & 127, s = i & 127; p.GWb[i] = f2bf(s <= t ? p.gm_ws[i] : 0.f); }
    for (int i = blockIdx.x * 512 + threadIdx.x; i < 2 * 64 * 128; i += gridDim.x * 512) { const int kv = i >> 13, d = (i >> 7) & 63, h = i & 127; p.W2T[i] = f2bf((kv ? p.w2_v : p.w2_k)[h * 64 + d]); }
    if (gw < 256) {
        const int kv = gw >> 7, h = gw & 127;
        const float* pe = kv ? p.pe_v : p.pe_k; const float* w1 = kv ? p.w1_v : p.w1_k;
        float s = 0.f;
#pragma unroll 8
        for (int k = lane; k < 2048; k += 64) s += pe[k] * w1[(size_t)k * 128 + h];
        s = wave_sum(s);
        if (lane == 0) p.PEB[kv * 128 + h] = s;
    }
    for (int i = blockIdx.x * 512 + threadIdx.x; i < NS * (WIN - 1) * 64; i += gridDim.x * 512) {
        const int b = i / ((WIN - 1) * 64), r = i % ((WIN - 1) * 64);
        ((f32x4*)(p.out + O_WINS + (size_t)b * WIN * 256))[r] = ((const f32x4*)(p.state_win + (size_t)b * WIN * 256 + 256))[r];
    }
}

__device__ __forceinline__ void phase_deferred_transposes(const Params& p) {
    if (blockIdx.x < 32) return;
    int base = 0;
    transpose_all_sub(p.w_br_nsa, QD, DM, p.WnT, DM, [](int n) { return row_a(n); }, base);
    transpose_all_sub(p.w_br_gm, GMD, DM, p.WnT + QD, DM, [](int n) { return row_a(n); }, base);
    transpose_all_sub(p.w_out, DM, DM, p.WoT, DM, [](int n) { return row_a(n); }, base);
    transpose_all_sub(p.w_gate, DM, DFF, p.WguT, DM, [](int n) { return row_s(n, 0); }, base);
    transpose_all_sub(p.w_up, DM, DFF, p.WguT, DM, [](int n) { return row_s(n, 1); }, base);
    transpose_all_sub(p.w_down, DFF, DM, p.WdT, DFF, [](int n) { return row_a(n); }, base);
    transpose_all_sub(p.w_ple_gate, DM, DM, p.WpgT, DM, [](int n) { return row_a(n); }, base);
    transpose_all_sub(p.w_ple, PLE, DM, p.WpT, PLE, [](int n) { return row_a(n); }, base);
    __syncthreads();
}
__device__ __forceinline__ void phase_gather(const Params& p) {
    int tid = threadIdx.x; asm volatile("" : "+v"(tid));
    const int wid = tid >> 6, lane = tid & 63;
    const int gw = (blockIdx.x >> 1) * 8 + wid, nw = (gridDim.x >> 1) * 8;
    const int cls = blockIdx.x & 1;
    auto ld8 = [&](int r8h, f32x4 (&a)[4], f32x4 (&cc)[4]) __attribute__((always_inline)) {
        const int r = (r8h * 2 + cls) * 8, b = r >> 14, pos = r & (PAST - 1), l5 = lane & 31, hrow = lane >> 5;
        const float* s = p.cache_cmp + ((size_t)p.page_table[b * NPG + (pos >> 7)] * PAGE + (pos & 127) + hrow) * 256 + l5 * 8;
#pragma unroll
        for (int k = 0; k < 4; ++k) { a[k] = *(const f32x4*)(s + (size_t)k * 512); cc[k] = *(const f32x4*)(s + (size_t)k * 512 + 4); }
    };
    auto st8 = [&](int r8h, const f32x4 (&a)[4], const f32x4 (&cc)[4]) __attribute__((always_inline)) {
        const int r = (r8h * 2 + cls) * 8, l5 = lane & 31, hrow = lane >> 5;
#pragma unroll
        for (int k = 0; k < 4; ++k) {
            u32x4 w; w.x = cvt_pk_bf16(a[k][0], a[k][1]); w.y = cvt_pk_bf16(a[k][2], a[k][3]); w.z = cvt_pk_bf16(cc[k][0], cc[k][1]); w.w = cvt_pk_bf16(cc[k][2], cc[k][3]);
            *(u32x4*)(p.CMPb + ((size_t)MP + r + 2 * k + hrow) * 256 + l5 * 8) = w;
        }
    };
#pragma unroll 1
    for (int r8h = gw; r8h < NS * PAST / 16; r8h += 2 * nw) {
        f32x4 a0[4], c0[4], a1[4], c1[4];
        const bool two = r8h + nw < NS * PAST / 16;
        ld8(r8h, a0, c0);
        if (two) ld8(r8h + nw, a1, c1);
        st8(r8h, a0, c0);
        if (two) st8(r8h + nw, a1, c1);
    }
}

__device__ __forceinline__ void phase_cmp_final(const Params& p) {
    const int wid = threadIdx.x >> 6, lane = threadIdx.x & 63;
    {
        const int c = lane & 15, G = lane >> 4;
        const int ngrp_p = NB * 4 * 32, ngrp_s = NS * 4 * 64;
#pragma unroll 1
        for (int it = blockIdx.x * 8 + wid; it < ngrp_p + ngrp_s; it += gridDim.x * 8) {
            const bool smp = it >= ngrp_p; const int l = smp ? it - ngrp_p : it;
            const int nch = smp ? 64 : 32, nc = smp ? NCS : NCP;
            const int ch = l % nch, z = (l / nch) & 3, seq = l / (nch * 4), kv = z >> 1, g = z & 1, n0 = ch * 16;
            const size_t r0 = smp ? (size_t)2048 + (size_t)seq * 1024 : (size_t)seq * 512;
            const int nr = n0 + c < nc ? n0 + c : nc - 1;
            const bf16_t* p0 = (const bf16_t*)p.PART + ((r0 + nr) * 4 + z) * 256;
            const bf16_t* p1 = (const bf16_t*)p.PART + ((r0 + nr + 1) * 4 + z) * 256 + 128;
            const float* pb = p.PEB + kv * 128;
            f32x4 acc[4] = {{0.f, 0.f, 0.f, 0.f}, {0.f, 0.f, 0.f, 0.f}, {0.f, 0.f, 0.f, 0.f}, {0.f, 0.f, 0.f, 0.f}};
#pragma unroll
            for (int ks = 0; ks < 4; ++ks) {
                const int h0 = 32 * ks + 8 * G;
                const u32x4 wa = *(const u32x4*)(p0 + h0), wb = *(const u32x4*)(p1 + h0);
                const f32x4 a0 = {bflo(wa.x), bfhi(wa.x), bflo(wa.y), bfhi(wa.y)}, a1 = {bflo(wa.z), bfhi(wa.z), bflo(wa.w), bfhi(wa.w)};
                const f32x4 b0 = {bflo(wb.x), bfhi(wb.x), bflo(wb.y), bfhi(wb.y)}, b1 = {bflo(wb.z), bfhi(wb.z), bflo(wb.w), bfhi(wb.w)};
                const f32x4 e0 = *(const f32x4*)(pb + h0), e1 = *(const f32x4*)(pb + h0 + 4);
                f32x4 x0 = a0 + b0 + e0, x1 = a1 + b1 + e1;
#pragma unroll
                for (int i = 0; i < 4; ++i) { x0[i] = siluf_(x0[i]); x1[i] = siluf_(x1[i]); }
                const bf16x8 A = pack_p(x0, x1);
#pragma unroll
                for (int nt = 0; nt < 4; ++nt) {
                    const bf16x8 B = *(const bf16x8*)(p.W2T + ((size_t)kv * 64 + nt * 16 + c) * 128 + h0);
                    acc[nt] = mfma16(A, B, acc[nt]);
                }
            }
#pragma unroll
            for (int nt = 0; nt < 4; ++nt) {
                const int d = nt * 16 + c;
#pragma unroll
                for (int i = 0; i < 4; ++i) {
                    const int n = n0 + 4 * G + i;
                    if (n < nc) {
                        if (smp) ((kv ? p.VCS : p.KCS) + (((size_t)seq * NG + g) * 1024 + n) * 64)[d] = acc[nt][i];
                        else if (kv == 0) p.KCb[((size_t)seq * NG + g) * 512 * 64 + kfrag_off(n, d)] = f2bf(acc[nt][i]);
                    }
                }
                if (!smp && kv == 1) {
                    f32x4 v = acc[nt];
#pragma unroll
                    for (int i = 0; i < 4; ++i) if (n0 + 4 * G + i >= nc) v[i] = 0.f;
                    st_bf16x4(p.VCT + ((size_t)seq * NG + g) * 512 * 64 + vfrag_off(n0 + 4 * G, d), v);
                }
            }
        }
    }
}

template <bool SAMPLE>
__device__ __forceinline__ void kv_row_ptr(const Params& p, int branch  , int b, int pos, int kv, int g, const bf16_t*& pb, const float*& pf) {
    const int off = kv * 128 + g * 64;
    if (!SAMPLE) { pf = nullptr; pb = (branch == 1 ? p.SLCb : p.WINb) + ((size_t)b * SEQ + pos) * 256 + off; }
    else if (pos >= PAST) { pf = nullptr; pb = (branch == 1 ? p.SLCb : p.WINb) + ((size_t)MP + b) * 256 + off; }
    else if (branch == 1) { pb = nullptr; pf = p.cache_slc + ((size_t)p.page_table[b * NPG + (pos >> 7)] * PAGE + (pos & 127)) * 256 + off; }
    else { pb = nullptr; pf = p.state_win + ((size_t)b * WIN + (pos - (PAST - WIN))) * 256 + off; }
}
__device__ __forceinline__ void dot4x64(const bf16_t* pb, const float* pf, const LAS float* qs_, float (&s)[4]) {
    s[0] = s[1] = s[2] = s[3] = 0.f;
    const LAS float* qs = qs_; asm volatile("" : "+v"(qs));
    if (pf) {
#pragma unroll 8
        for (int c = 0; c < 16; ++c) {
            const f32x4 kx = *(const f32x4*)(pf + c * 4);
#pragma unroll
            for (int h = 0; h < 4; ++h) { const f32x4 q = *(const LAS f32x4*)(qs + h * 64 + c * 4); s[h] += q[0] * kx[0] + q[1] * kx[1] + q[2] * kx[2] + q[3] * kx[3]; }
        }
    } else {
#pragma unroll 2
        for (int c = 0; c < 8; ++c) {
            const u32x4 w = *(const u32x4*)(pb + c * 8);
            const float k0 = bflo(w.x), k1 = bfhi(w.x), k2 = bflo(w.y), k3 = bfhi(w.y), k4 = bflo(w.z), k5 = bfhi(w.z), k6 = bflo(w.w), k7 = bfhi(w.w);
#pragma unroll
            for (int h = 0; h < 4; ++h) {
                const f32x4 qa = *(const LAS f32x4*)(qs + h * 64 + c * 8), qb = *(const LAS f32x4*)(qs + h * 64 + c * 8 + 4);
                s[h] += qa[0] * k0 + qa[1] * k1 + qa[2] * k2 + qa[3] * k3 + qb[0] * k4 + qb[1] * k5 + qb[2] * k6 + qb[3] * k7;
            }
        }
    }
}
template <bool SAMPLE>
__device__ __forceinline__ void attn_chunk(const Params& p, int branch, int b, int g, int t, int pos0, int lo, int hi,
                                           float (&m)[4], float (&l)[4], float (&o)[4], const LAS float* qs, LAS float* pbk, const LAS float* relb, int lane) {
    const int pos = pos0 + lane;
    const bool valid = pos >= lo && pos <= hi;
    float s[4] = {-1e30f, -1e30f, -1e30f, -1e30f};
    if (valid) {
        const bf16_t* pb; const float* pf; kv_row_ptr<SAMPLE>(p, branch, b, pos, 0, g, pb, pf);
        dot4x64(pb, pf, qs, s);
        const int bk = t5_bucket(t - pos);
#pragma unroll
        for (int h = 0; h < 4; ++h) s[h] += relb[bk * 8 + g * 4 + h];
    }
#pragma unroll
    for (int h = 0; h < 4; ++h) {
        const float mx = wave_max(s[h]);
        const float mn = fmaxf(m[h], mx);
        const float pr = valid ? ex2(s[h] - mn) : 0.f;
        const float sm = wave_sum(pr);
        const float al = ex2(m[h] - mn);
        l[h] = l[h] * al + sm; o[h] *= al; m[h] = mn;
        pbk[h * 64 + lane] = pr;
    }
    __builtin_amdgcn_wave_barrier();
    const int k0 = (lo > pos0 ? lo : pos0) - pos0, k1 = (hi < pos0 + 63 ? hi : pos0 + 63) - pos0;
    if (SAMPLE) {
        const int kend = (PAST - 1 - pos0) < k1 ? (PAST - 1 - pos0) : k1;
        if (kend >= k0) {
            const bf16_t* pb; const float* pf; kv_row_ptr<SAMPLE>(p, branch, b, pos0 + k0, 1, g, pb, pf);
            pf += lane;
#pragma unroll 16
            for (int k = k0; k <= kend; ++k) {
                const float v = pf[(size_t)(k - k0) * 256];
#pragma unroll
                for (int h = 0; h < 4; ++h) o[h] += pbk[h * 64 + k] * v;
            }
        }
        if (k1 > kend) {
            const bf16_t* pb; const float* pf; kv_row_ptr<SAMPLE>(p, branch, b, pos0 + k1, 1, g, pb, pf);
            const float v = bf2f(pb[lane]);
#pragma unroll
            for (int h = 0; h < 4; ++h) o[h] += pbk[h * 64 + k1] * v;
        }
    } else {
#pragma unroll 1
    for (int k = k0; k <= k1; ++k) {
        const bf16_t* pb; const float* pf; kv_row_ptr<SAMPLE>(p, branch, b, pos0 + k, 1, g, pb, pf);
        const float v = pf ? pf[lane] : bf2f(pb[lane]);
#pragma unroll
        for (int h = 0; h < 4; ++h) o[h] += pbk[h * 64 + k] * v;
    }
    }
    __builtin_amdgcn_wave_barrier();
}

constexpr int S_QS = 0, S_SC = 1024, S_PHS = S_SC + 4 * 1024 * 4, S_PBK = S_PHS + 1088 * 4, S_PART = S_PBK + 8 * 1024, S_RED = S_PART + 2 * 8 * 272 * 4, S_OCP = S_RED + 512,
              S_SEL = S_OCP + 2048, S_RELB = S_SEL + 64, ATTS_LDS = S_RELB + 1024;
__device__ __forceinline__ void attn_sample_item(const Params& p, int b, int g) {
    const int tid = threadIdx.x, wid = tid >> 6, lane = tid & 63;
    constexpr int t = PAST, NC = NCS, NSEL = 257, NJR = 5, qblk = PAST >> 6;
    const int row = MP + b;
    LAS unsigned char* L = (LAS unsigned char*)smem;
    LAS float* qs = (LAS float*)(L + S_QS); LAS float* sc = (LAS float*)(L + S_SC); LAS float* phs = (LAS float*)(L + S_PHS); LAS float* pbk = (LAS float*)(L + S_PBK) + wid * 256;
    LAS float* part = (LAS float*)(L + S_PART); LAS float* red = (LAS float*)(L + S_RED); LAS float* ocp = (LAS float*)(L + S_OCP); LAS int* sel = (LAS int*)(L + S_SEL);
    LAS float* relb = (LAS float*)(L + S_RELB);
    __syncthreads();
    if (tid < 256) { relb[tid] = p.rel_bias[tid] * LOG2E; qs[tid] = bf2f(p.Qb[(size_t)row * QD + g * 256 + tid]); }
    __syncthreads();
    const float* kc = p.KCS + ((size_t)b * NG + g) * 1024 * 64;
    const float* vc = p.VCS + ((size_t)b * NG + g) * 1024 * 64;
    {
        float mx[4] = {-1e30f, -1e30f, -1e30f, -1e30f};
#pragma unroll 1
        for (int r = wid; r < 16; r += 8) {
            const int n = r * 64 + lane;
            float s[4] = {-1e30f, -1e30f, -1e30f, -1e30f};
            if (n < NC) {
                dot4x64(nullptr, kc + (size_t)n * 64, qs, s);
                const int bk = t5_bucket(t - (16 * n + 31));
#pragma unroll
                for (int h = 0; h < 4; ++h) s[h] += relb[bk * 8 + g * 4 + h];
            }
#pragma unroll
            for (int h = 0; h < 4; ++h) { sc[h * 1024 + n] = s[h]; mx[h] = fmaxf(mx[h], s[h]); }
        }
#pragma unroll
        for (int h = 0; h < 4; ++h) { const float m = wave_max(mx[h]); if (lane == 0) red[wid * 4 + h] = m; }
    }
    __syncthreads();
    float gmx[4], inv[4];
#pragma unroll
    for (int h = 0; h < 4; ++h) { float m = red[h]; for (int w = 1; w < 8; ++w) m = fmaxf(m, red[w * 4 + h]); gmx[h] = m; }
    {
        float sum[4] = {0.f, 0.f, 0.f, 0.f};
#pragma unroll
        for (int k = 0; k < 2; ++k) { const int n = tid + 512 * k;
#pragma unroll
            for (int h = 0; h < 4; ++h) { const float e = n < NC ? ex2(sc[h * 1024 + n] - gmx[h]) : 0.f; sc[h * 1024 + n] = e; sum[h] += e; } }
#pragma unroll
        for (int h = 0; h < 4; ++h) { const float s = wave_sum(sum[h]); if (lane == 0) red[32 + wid * 4 + h] = s; }
    }
    __syncthreads();
#pragma unroll
    for (int h = 0; h < 4; ++h) { float s = 0.f; for (int w = 0; w < 8; ++w) s += red[32 + w * 4 + h]; inv[h] = s > 0.f ? 1.0f / s : 0.f; }
    for (int n = tid; n < 1088; n += 512) phs[n] = n < NC ? (sc[n] * inv[0] + sc[1024 + n] * inv[1]) + (sc[2048 + n] * inv[2] + sc[3072 + n] * inv[3]) : 0.f;
    {
        float a[4] = {0.f, 0.f, 0.f, 0.f};
#pragma unroll 16
        for (int n = wid; n < NC; n += 8) {
            const float v = vc[(size_t)n * 64 + lane];
#pragma unroll
            for (int h = 0; h < 4; ++h) a[h] += sc[h * 1024 + n] * v;
        }
#pragma unroll
        for (int h = 0; h < 4; ++h) part[(wid * 4 + h) * 68 + lane] = a[h] * inv[h];
    }
    __syncthreads();
    if (tid < 256) { float a = 0.f; for (int w = 0; w < 8; ++w) a += part[(w * 4 + (tid >> 6)) * 68 + (tid & 63)]; ocp[tid] = a; }
    __syncthreads();
    if (wid == 0) {
        unsigned long long key[NJR];
#pragma unroll
        for (int jr = 0; jr < NJR; ++jr) {
            const int j = jr * 64 + lane;
            key[jr] = 0ull;
            if (j >= 1 && j <= qblk - 2 && j < NSEL) {
                float im = 0.f;
#pragma unroll
                for (int n = 4 * j - 1; n <= 4 * j + 3; ++n) im += (n < NC) ? phs[n] : 0.f;
                key[jr] = ((unsigned long long)__float_as_uint(im) << 32) | (unsigned)(0xFFFF - j) | 0x10000ull;
            }
        }
        if (lane == 0) { sel[0] = 0; sel[1] = qblk - 1; sel[2] = qblk; }
#pragma unroll 1
        for (int it = 0; it < 13; ++it) {
            unsigned long long best = 0ull;
#pragma unroll
            for (int jr = 0; jr < NJR; ++jr) best = key[jr] > best ? key[jr] : best;
#pragma unroll
            for (int o = 32; o > 0; o >>= 1) { const unsigned long long ot = __shfl_xor(best, o); best = ot > best ? ot : best; }
            const int j = 0xFFFF - (int)(best & 0xFFFFull);
#pragma unroll
            for (int jr = 0; jr < NJR; ++jr) if (key[jr] == best) key[jr] = 0ull;
            if (lane == 0) sel[3 + it] = j;
        }
    }
    __syncthreads();
    {
        float ms[4] = {-1e30f, -1e30f, -1e30f, -1e30f}, ls[4] = {0.f, 0.f, 0.f, 0.f}, os[4] = {0.f, 0.f, 0.f, 0.f};
#pragma unroll 1
        for (int i = wid; i < 16; i += 8) attn_chunk<true>(p, 1, b, g, t, sel[i] * 64, 0, t, ms, ls, os, qs, pbk, relb, lane);
        float mw[4] = {-1e30f, -1e30f, -1e30f, -1e30f}, lw[4] = {0.f, 0.f, 0.f, 0.f}, ow[4] = {0.f, 0.f, 0.f, 0.f};
#pragma unroll 1
        for (int c = wid; c < 9; c += 8) attn_chunk<true>(p, 2, b, g, t, t - 63 - 64 * c, t - WIN, t, mw, lw, ow, qs, pbk, relb, lane);
#pragma unroll
        for (int h = 0; h < 4; ++h) {
            LAS float* ps = part + (wid * 4 + h) * 68; LAS float* pw = part + 8 * 272 + (wid * 4 + h) * 68;
            ps[lane] = os[h]; pw[lane] = ow[h];
            if (lane == 0) { ps[64] = ms[h]; ps[65] = ls[h]; pw[64] = mw[h]; pw[65] = lw[h]; }
        }
    }
    __syncthreads();
    if (tid < 256) {
        const int h = tid >> 6, d = tid & 63;
        float res[2];
#pragma unroll
        for (int br = 0; br < 2; ++br) {
            const LAS float* pp = part + br * 8 * 272 + h * 68;
            float m = -1e30f;
            for (int w = 0; w < 8; ++w) m = fmaxf(m, pp[w * 272 + 64]);
            float l = 0.f, o = 0.f;
            for (int w = 0; w < 8; ++w) { const float sc_ = ex2(pp[w * 272 + 64] - m); l += pp[w * 272 + 65] * sc_; o += pp[w * 272 + d] * sc_; }
            res[br] = o / l;
        }
        const float* gt = p.GATE + (size_t)row * 32 + (g * 4 + h) * 3;
        const float v = gt[0] * ocp[tid] + gt[1] * res[0] + gt[2] * res[1];
        p.OCAT[(size_t)row * DM + (g * 4 + h) * 64 + d] = f2bf(v);
    }
    __syncthreads();
}

constexpr int A_OST = 0, OST_LD = 68, A_LST = A_OST + 256 * OST_LD * 4, A_M0 = A_LST + 1024, A_MB = A_M0 + 1024, MB_LD = 132, A_MKN = A_MB + 64 * MB_LD,
              A_LIST = A_MKN + 256, A_CNT = A_LIST + 132 * 64, A_PK = A_CNT + 544, A_KN = A_PK + 400 * 4, A_T2 = A_KN + 512, A_NP = A_T2 + 132 * 8 * 4, A_QT = A_NP + 16, ATT2_LDS = A_QT + 64 * 512;
static_assert(ATT2_LDS <= GEMM_LDS && ATTS_LDS <= GEMM_LDS, "attention LDS");

__device__ __forceinline__ void qk64(const bf16_t* kb, int c, int G, const bf16x8 (&qB)[2], f32x4 (&s)[4]) {
#pragma unroll
    for (int kt = 0; kt < 4; ++kt) {
        const bf16_t* r = kb + (size_t)(16 * kt + c) * 256 + G * 8;
        const bf16x8 a0 = *(const bf16x8*)r, a1 = *(const bf16x8*)(r + 32);
        s[kt] = mfma16(a0, qB[0], (f32x4){0.f, 0.f, 0.f, 0.f}); s[kt] = mfma16(a1, qB[1], s[kt]);
    }
}
__device__ __forceinline__ void pv64(const bf16_t* vf, int key0, int lane, const f32x4 (&pr)[4], f32x4 (&o)[4]) {
#pragma unroll
    for (int ks = 0; ks < 2; ++ks) {
        const bf16x8 pB = pack_p(pr[2 * ks], pr[2 * ks + 1]);
#pragma unroll
        for (int dt = 0; dt < 4; ++dt) {
            const bf16x8 vA = *(const bf16x8*)(vf + ((size_t)(((key0 >> 5) + ks) * 4 + dt) * 64 + lane) * 8);
            o[dt] = mfma16(vA, pB, o[dt]);
        }
    }
}
__device__ __forceinline__ int qt_off(int qi, int hh, int k) { return (qi * 4 + hh) * 128 + ((k ^ (((qi & 3) << 1) | (hh >> 1))) << 4); }
__device__ __forceinline__ float grp_max(float v) {
    auto r = __builtin_amdgcn_permlane16_swap(__float_as_uint(v), __float_as_uint(v), false, false); v = fmaxf(__uint_as_float(r[0]), __uint_as_float(r[1]));
    r = __builtin_amdgcn_permlane32_swap(__float_as_uint(v), __float_as_uint(v), false, false); return fmaxf(__uint_as_float(r[0]), __uint_as_float(r[1]));
}
__device__ __forceinline__ float grp_sum(float v) {
    auto r = __builtin_amdgcn_permlane16_swap(__float_as_uint(v), __float_as_uint(v), false, false); v = __uint_as_float(r[0]) + __uint_as_float(r[1]);
    r = __builtin_amdgcn_permlane32_swap(__float_as_uint(v), __float_as_uint(v), false, false); return __uint_as_float(r[0]) + __uint_as_float(r[1]);
}
__device__ __forceinline__ int grp_min_i(int v) {
    auto r = __builtin_amdgcn_permlane16_swap((unsigned)v, (unsigned)v, false, false); v = (int)r[0] < (int)r[1] ? (int)r[0] : (int)r[1];
    r = __builtin_amdgcn_permlane32_swap((unsigned)v, (unsigned)v, false, false); return (int)r[0] < (int)r[1] ? (int)r[0] : (int)r[1];
}
__device__ __forceinline__ float dpp_x1(float v) { return __uint_as_float(__builtin_amdgcn_mov_dpp(__float_as_uint(v), 0xB1, 0xF, 0xF, true)); }
__device__ __forceinline__ float dpp_x2(float v) { return __uint_as_float(__builtin_amdgcn_mov_dpp(__float_as_uint(v), 0x4E, 0xF, 0xF, true)); }
__device__ __forceinline__ int dpp_x1i(int v) { return (int)__builtin_amdgcn_mov_dpp((unsigned)v, 0xB1, 0xF, 0xF, true); }
__device__ __forceinline__ int dpp_x2i(int v) { return (int)__builtin_amdgcn_mov_dpp((unsigned)v, 0x4E, 0xF, 0xF, true); }
__device__ __forceinline__ unsigned row_or_q(unsigned u) {
    u |= __builtin_amdgcn_mov_dpp(u, 0x124, 0xF, 0xF, true); u |= __builtin_amdgcn_mov_dpp(u, 0x128, 0xF, 0xF, true); return u;
}

__device__ __forceinline__ void attn_cmp(const Params& p, int b, int g, int t0, int lane_, LAS unsigned char* L, unsigned (&msk)[4]) {
    f32x4 oacc[4];
    int lane = lane_; asm volatile("" : "+v"(lane));
    const int c = lane & 15, G = lane >> 4, qs = c >> 2, hh = c & 3;
    const int qb = t0 >> 6, tc = t0 + qs;
    const size_t qrow = (size_t)b * SEQ + tc;
    const LAS float* T2 = (const LAS float*)(L + A_T2);
    const float b31 = T2[128 * 8 + g * 4 + hh];
    bf16x8 qB[2];
    qB[0] = *(const bf16x8*)(p.Qb + qrow * QD + (g * 4 + hh) * 64 + G * 8); qB[1] = *(const bf16x8*)(p.Qb + qrow * QD + (g * 4 + hh) * 64 + 32 + G * 8);
    const float* gate = p.GATE + qrow * 32 + (g * 4 + hh) * 3;
    msk[0] = msk[1] = msk[2] = msk[3] = 0u;
    {
        const int ncv_c = tc >= 31 ? ((tc - 31) >> 4) + 1 : 0;
        const int ncv_m = t0 + 3 >= 31 ? ((t0 + 3 - 31) >> 4) + 1 : 0;
        const int NT = (ncv_m + 15) >> 4;
        const int mt_far = t0 >= 399 ? (t0 - 399) / 256 + 1 : 0;
        const bf16_t* kcb = p.KCb + (size_t)(b * NG + g) * 512 * 64;
        f32x4 sc[32];
        float mxf = -1e30f, mxn = -1e30f;
        bf16x8 kbuf[2][4][2];
        auto ldkg = [&](int grp, bf16x8 (&kb)[4][2]) __attribute__((always_inline)) {
#pragma unroll
            for (int q = 0; q < 4; ++q) { const bf16_t* r = kcb + ((size_t)((grp * 4 + q) * 2) * 64 + lane) * 8; kb[q][0] = *(const bf16x8*)r; kb[q][1] = *(const bf16x8*)(r + 512); }
        };
        ldkg(0, kbuf[0]);
#pragma unroll
        for (int grp = 0; grp < 8; ++grp) {
            if (4 * grp < NT) {
                if (4 * (grp + 1) < NT) ldkg(grp + 1, kbuf[(grp + 1) & 1]);
                __builtin_amdgcn_sched_barrier(0);
#pragma unroll
                for (int q = 0; q < 4; ++q) {
                    const int mt = grp * 4 + q;
                    f32x4 s = mfma16(kbuf[grp & 1][q][0], qB[0], (f32x4){0.f, 0.f, 0.f, 0.f}); s = mfma16(kbuf[grp & 1][q][1], qB[1], s);
                    if (mt < mt_far) { mxf = fmaxf(mxf, fmaxf(fmaxf(s[0], s[1]), fmaxf(s[2], s[3]))); }
                    else {
#pragma unroll
                        for (int i = 0; i < 4; ++i) { const int n = 16 * mt + 4 * G + i; int dist = tc - (16 * n + 31); const bool ok = n < ncv_c; dist = dist < 0 ? 0 : (dist > 128 ? 128 : dist);
                            s[i] = ok ? s[i] + T2[dist * 8 + g * 4 + hh] : -1e30f; }
                        mxn = fmaxf(mxn, fmaxf(fmaxf(s[0], s[1]), fmaxf(s[2], s[3])));
                    }
                    sc[mt] = s;
                }
            } else {
#pragma unroll
                for (int q = 0; q < 4; ++q) sc[grp * 4 + q] = (f32x4){0.f, 0.f, 0.f, 0.f};
            }
        }
        const float mx = grp_max(fmaxf(mxf + b31, mxn));
        const float shf = mx - b31;
#pragma unroll
        for (int mt = 0; mt < 32; ++mt) if ((mt & ~3) < NT) {
            const float sh = mt < mt_far ? shf : mx;
#pragma unroll
            for (int i = 0; i < 4; ++i) sc[mt][i] = ex2(sc[mt][i] - sh);
        }
        const bf16_t* vct = p.VCT + (size_t)(b * NG + g) * 64 * 512;
        const bf16x8 ones = __builtin_bit_cast(bf16x8, (u32x4){0x3F803F80u, 0x3F803F80u, 0x3F803F80u, 0x3F803F80u});
        f32x4 oc[4] = {{0.f, 0.f, 0.f, 0.f}, {0.f, 0.f, 0.f, 0.f}, {0.f, 0.f, 0.f, 0.f}, {0.f, 0.f, 0.f, 0.f}};
        f32x4 rs = {0.f, 0.f, 0.f, 0.f};
        bf16x8 vbuf[2][2][4];
        auto ldvg = [&](int grp, bf16x8 (&vb)[2][4]) __attribute__((always_inline)) {
#pragma unroll
            for (int q = 0; q < 2; ++q)
#pragma unroll
                for (int dt = 0; dt < 4; ++dt) vb[q][dt] = *(const bf16x8*)(vct + ((size_t)((grp * 2 + q) * 4 + dt) * 64 + lane) * 8);
        };
        ldvg(0, vbuf[0]);
#pragma unroll
        for (int grp = 0; grp < 8; ++grp) if (4 * grp < NT) {
            if (4 * (grp + 1) < NT) ldvg(grp + 1, vbuf[(grp + 1) & 1]);
            __builtin_amdgcn_sched_barrier(0);
#pragma unroll
            for (int q = 0; q < 2; ++q) {
                const int k2 = grp * 2 + q;
                const bf16x8 pB = pack_p(sc[2 * k2], sc[2 * k2 + 1]);
                rs = mfma16(ones, pB, rs);
#pragma unroll
                for (int dt = 0; dt < 4; ++dt) oc[dt] = mfma16(vbuf[grp & 1][q][dt], pB, oc[dt]);
            }
        }
        const float inv = ncv_c > 0 ? __builtin_amdgcn_rcpf(rs[0]) : 0.f;
        if (qb <= 15) {
            msk[0] = (qb >= 31) ? 0xffffffffu : ((2u << qb) - 1u);
        } else {
            unsigned cand[8];
#pragma unroll
            for (int k = 0; k < 8; ++k) cand[k] = 0u;
            float prevB = 0.f;
#pragma unroll
            for (int mt = 0; mt < 32; ++mt) if (mt < NT) {
                const unsigned x3 = __float_as_uint(sc[mt][3]);
                const auto p16 = __builtin_amdgcn_permlane16_swap(x3, x3, false, false);
                const auto p32 = __builtin_amdgcn_permlane32_swap(p16[1], p16[1], false, false);
                const float r1 = G == 2 ? __uint_as_float(p32[0]) : __uint_as_float(p16[0]);
                float v = ((sc[mt][0] + sc[mt][1]) + (sc[mt][2] + sc[mt][3]) + (G == 0 ? prevB : r1)) * inv;
                prevB = __uint_as_float(p32[1]);
                v += dpp_x1(v); v += dpp_x2(v);
                const int j = 4 * mt + G;
                if ((mt & 3) == hh) cand[mt >> 2] = (j >= 1 && j <= qb - 2) ? ((__float_as_uint(v) & ~127u) | (unsigned)(127 - j)) : 0u;
            }
            auto setbit = [&](int j) { const unsigned bit = 1u << (j & 31); const int w = j >> 5; msk[0] |= w == 0 ? bit : 0u; msk[1] |= w == 1 ? bit : 0u; msk[2] |= w == 2 ? bit : 0u; msk[3] |= w == 3 ? bit : 0u; };
            setbit(0); setbit(qb); setbit(qb - 1);
#pragma unroll 1
            for (int it = 0; it < 13; ++it) {
                unsigned bv = cand[0];
#pragma unroll
                for (int k = 1; k < 8; ++k) bv = bv > cand[k] ? bv : cand[k];
                { unsigned o = __builtin_amdgcn_mov_dpp(bv, 0xB1, 0xF, 0xF, true); bv = o > bv ? o : bv; o = __builtin_amdgcn_mov_dpp(bv, 0x4E, 0xF, 0xF, true); bv = o > bv ? o : bv;
                  auto r = __builtin_amdgcn_permlane16_swap(bv, bv, false, false); bv = r[0] > r[1] ? r[0] : r[1]; r = __builtin_amdgcn_permlane32_swap(bv, bv, false, false); bv = r[0] > r[1] ? r[0] : r[1]; }
#pragma unroll
                for (int k = 0; k < 8; ++k) cand[k] = cand[k] == bv ? 0u : cand[k];
                setbit(127 - (int)(bv & 127u));
            }
        }
        const float g0 = gate[0] * inv;
#pragma unroll
        for (int dt = 0; dt < 4; ++dt) oacc[dt] = oc[dt] * g0;
    }
    bf16_t* orow = p.OCAT + qrow * DM + (g * 4 + hh) * 64 + 4 * G;
#pragma unroll
    for (int dt = 0; dt < 4; ++dt) st_bf16x4(orow + dt * 16, oacc[dt]);
}

struct PackSt { bf16x8 q0, q1; float m; f32x4 l4; f32x4 o[4]; };
__device__ __forceinline__ void attn_selwin_pair(const Params& p, int b, int g, int t0, int lane_, LAS unsigned char* L, const unsigned (&mskA)[4], const unsigned (&mskB)[4]) {
    int lane = lane_; asm volatile("" : "+v"(lane));
    const int c = lane & 15, G = lane >> 4, qs = c >> 2, hh = c & 3;
    const int qb = t0 >> 6;
    const LAS float* T2 = (const LAS float*)(L + A_T2);
    const float b31 = T2[128 * 8 + g * 4 + hh];
    const int tcA = t0 + qs, tcB = t0 + 4 + qs;
    const size_t qrowA = (size_t)b * SEQ + tcA;
    PackSt A, B;
    {
        const bf16_t* qa = p.Qb + qrowA * QD + (g * 4 + hh) * 64 + G * 8;
        A.q0 = *(const bf16x8*)qa; A.q1 = *(const bf16x8*)(qa + 32); B.q0 = *(const bf16x8*)(qa + 4 * QD); B.q1 = *(const bf16x8*)(qa + 4 * QD + 32);
    }
    auto reset = [&](PackSt& S) __attribute__((always_inline)) { S.m = -1e30f; S.l4 = (f32x4){0.f, 0.f, 0.f, 0.f};
#pragma unroll
        for (int dt = 0; dt < 4; ++dt) S.o[dt] = (f32x4){0.f, 0.f, 0.f, 0.f}; };
    const bf16x8 ones = __builtin_bit_cast(bf16x8, (u32x4){0x3F803F80u, 0x3F803F80u, 0x3F803F80u, 0x3F803F80u});
    auto finish = [&](PackSt& S, f32x4 (&s)[4], float cb, bool mine, const bf16x8 (&vf)[2][4]) __attribute__((always_inline)) {
        float cm = fmaxf(fmaxf(fmaxf(s[0][0], s[0][1]), fmaxf(s[0][2], s[0][3])), fmaxf(fmaxf(s[1][0], s[1][1]), fmaxf(s[1][2], s[1][3])));
        cm = fmaxf(cm, fmaxf(fmaxf(fmaxf(s[2][0], s[2][1]), fmaxf(s[2][2], s[2][3])), fmaxf(fmaxf(s[3][0], s[3][1]), fmaxf(s[3][2], s[3][3]))));
        cm = grp_max(mine ? cm + cb : -1e30f);
        const float mn = fmaxf(S.m, cm), al = ex2(S.m - mn);
        const float sh = (mine ? mn : 1e30f) - cb;
#pragma unroll
        for (int kt = 0; kt < 4; ++kt)
#pragma unroll
            for (int i = 0; i < 4; ++i) s[kt][i] = ex2(s[kt][i] - sh);
        S.m = mn;
        f32x4 rs = {0.f, 0.f, 0.f, 0.f};
#pragma unroll
        for (int dt = 0; dt < 4; ++dt) S.o[dt] = S.o[dt] * al;
#pragma unroll
        for (int ks = 0; ks < 2; ++ks) { const bf16x8 pB = pack_p(s[2 * ks], s[2 * ks + 1]);
            rs = mfma16(ones, pB, rs);
#pragma unroll
            for (int dt = 0; dt < 4; ++dt) S.o[dt] = mfma16(vf[ks][dt], pB, S.o[dt]); }
        S.l4[0] = S.l4[0] * al + rs[0];
    };
    auto addout = [&](PackSt& S, size_t qrow, int br) __attribute__((always_inline)) {
        const float gs = p.GATE[qrow * 32 + (g * 4 + hh) * 3 + br] * __builtin_amdgcn_rcpf(S.l4[0]);
        bf16_t* orow = p.OCAT + qrow * DM + (g * 4 + hh) * 64 + 4 * G;
#pragma unroll
        for (int dt = 0; dt < 4; ++dt) { const u32x2 w = *(const u32x2*)(orow + dt * 16); f32x4 pa; pa[0] = bflo(w.x); pa[1] = bfhi(w.x); pa[2] = bflo(w.y); pa[3] = bfhi(w.y);
            st_bf16x4(orow + dt * 16, pa + S.o[dt] * gs); }
    };
    {
        unsigned umA[4], umB[4], um[4];
#pragma unroll
        for (int w = 0; w < 4; ++w) {
            umA[w] = __builtin_amdgcn_readfirstlane(row_or_q(mskA[w]));
            umB[w] = __builtin_amdgcn_readfirstlane(row_or_q(mskB[w]));
            um[w] = umA[w] | umB[w];
        }
        reset(A); reset(B);
        const bf16_t* klane = p.SLCkF + (size_t)(b * NG + g) * SEQ * 64 + lane * 8;
        const bf16_t* vlane = p.SLCvT + (size_t)(b * NG + g) * SEQ * 64 + lane * 8;
        auto ldfr = [&](int j_, bf16x8 (&kf_)[4][2], bf16x8 (&vf_)[2][4]) __attribute__((always_inline)) {
            const bf16_t* kr = klane + (size_t)j_ * 4096; const bf16_t* vr = vlane + (size_t)j_ * 4096;
#pragma unroll
            for (int kt = 0; kt < 4; ++kt) { kf_[kt][0] = *(const bf16x8*)(kr + (kt * 2) * 512); kf_[kt][1] = *(const bf16x8*)(kr + (kt * 2 + 1) * 512); }
#pragma unroll
            for (int ks = 0; ks < 2; ++ks)
#pragma unroll
                for (int dt = 0; dt < 4; ++dt) vf_[ks][dt] = *(const bf16x8*)(vr + (ks * 4 + dt) * 512);
        };
        auto nextj = [&](int& j_) __attribute__((always_inline)) {
            int w = um[0] ? 0 : um[1] ? 1 : um[2] ? 2 : um[3] ? 3 : -1;
            if (w < 0) return false;
            const unsigned u = w == 0 ? um[0] : w == 1 ? um[1] : w == 2 ? um[2] : um[3];
            const int bpos = __builtin_ctz(u);
            j_ = w * 32 + bpos;
            const unsigned cl = ~(1u << bpos);
            if (w == 0) um[0] &= cl; else if (w == 1) um[1] &= cl; else if (w == 2) um[2] &= cl; else um[3] &= cl;
            return true;
        };
        auto packstep = [&](PackSt& S, const unsigned (&msk)[4], int tc, int j, const bf16x8 (&kf)[4][2], const bf16x8 (&vf)[2][4]) __attribute__((always_inline)) {
            const unsigned mw = (j >> 5) == 0 ? msk[0] : (j >> 5) == 1 ? msk[1] : (j >> 5) == 2 ? msk[2] : msk[3];
            const bool mine = (mw >> (j & 31)) & 1u;
            const bool farb = j <= qb - 3;
            f32x4 s[4];
#pragma unroll
            for (int kt = 0; kt < 4; ++kt) { s[kt] = mfma16(kf[kt][0], S.q0, (f32x4){0.f, 0.f, 0.f, 0.f}); s[kt] = mfma16(kf[kt][1], S.q1, s[kt]); }
            if (!farb) {
#pragma unroll
                for (int kt = 0; kt < 4; ++kt)
#pragma unroll
                    for (int i = 0; i < 4; ++i) { const int dist = tc - (j * 64 + 16 * kt + 4 * G + i); const int dd = dist < 0 ? 0 : (dist > 128 ? 128 : dist);
                        s[kt][i] = dist >= 0 ? s[kt][i] + T2[dd * 8 + g * 4 + hh] : -1e30f; }
            }
            finish(S, s, farb ? b31 : 0.f, mine, vf);
        };
        auto blockstep = [&](int j, const bf16x8 (&kf)[4][2], const bf16x8 (&vf)[2][4]) __attribute__((always_inline)) {
            const int w = j >> 5; const unsigned bit = 1u << (j & 31);
            const unsigned ua = w == 0 ? umA[0] : w == 1 ? umA[1] : w == 2 ? umA[2] : umA[3];
            const unsigned ub = w == 0 ? umB[0] : w == 1 ? umB[1] : w == 2 ? umB[2] : umB[3];
            if (ua & bit) packstep(A, mskA, tcA, j, kf, vf);
            if (ub & bit) packstep(B, mskB, tcB, j, kf, vf);
        };
        auto ldk = [&](int j_, bf16x8 (&kf_)[4][2]) __attribute__((always_inline)) {
            const bf16_t* kr = klane + (size_t)j_ * 4096;
#pragma unroll
            for (int kt = 0; kt < 4; ++kt) { kf_[kt][0] = *(const bf16x8*)(kr + (kt * 2) * 512); kf_[kt][1] = *(const bf16x8*)(kr + (kt * 2 + 1) * 512); }
        };
        auto ldv = [&](int j_, bf16x8 (&vf_)[2][4]) __attribute__((always_inline)) {
            const bf16_t* vr = vlane + (size_t)j_ * 4096;
#pragma unroll
            for (int ks = 0; ks < 2; ++ks)
#pragma unroll
                for (int dt = 0; dt < 4; ++dt) vf_[ks][dt] = *(const bf16x8*)(vr + (ks * 4 + dt) * 512);
        };
        bf16x8 kfA[4][2], kfB[4][2], vf[2][4];
        int j = 0; bool have = nextj(j);
        ldk(j, kfA);
#pragma unroll 1
        while (have) {
            int jn = j; bool haven = nextj(jn);
            ldv(j, vf); ldk(jn, kfB);
            __builtin_amdgcn_sched_barrier(0);
            blockstep(j, kfA, vf);
            if (!haven) break;
            j = jn; have = nextj(jn);
            ldv(j, vf); ldk(jn, kfA);
            __builtin_amdgcn_sched_barrier(0);
            blockstep(j, kfB, vf);
            j = jn;
        }
        addout(A, qrowA, 1); addout(B, qrowA + 4, 1);
    }
    {
        reset(A); reset(B);
        const int loA = t0 - WIN > 0 ? t0 - WIN : 0, hiA = t0 + 3, loB = t0 + 4 - WIN > 0 ? t0 + 4 - WIN : 0, hiB = t0 + 7;
        const bf16_t* klane = p.WINkF + (size_t)(b * NG + g) * SEQ * 64 + lane * 8;
        const bf16_t* vlane = p.WINvT + (size_t)(b * NG + g) * SEQ * 64 + lane * 8;
        auto ldfr = [&](int cb_, bf16x8 (&kf_)[4][2], bf16x8 (&vf_)[2][4]) __attribute__((always_inline)) {
            const bf16_t* kr = klane + (size_t)cb_ * 64; const bf16_t* vr = vlane + (size_t)cb_ * 64;
#pragma unroll
            for (int kt = 0; kt < 4; ++kt) { kf_[kt][0] = *(const bf16x8*)(kr + (kt * 2) * 512); kf_[kt][1] = *(const bf16x8*)(kr + (kt * 2 + 1) * 512); }
#pragma unroll
            for (int ks = 0; ks < 2; ++ks)
#pragma unroll
                for (int dt = 0; dt < 4; ++dt) vf_[ks][dt] = *(const bf16x8*)(vr + (ks * 4 + dt) * 512);
        };
        auto packstep = [&](PackSt& S, int tq0, int tc, int cb, const bf16x8 (&kf)[4][2], const bf16x8 (&vf)[2][4]) __attribute__((always_inline)) {
            const bool far = (cb + 63 <= tq0 - 128) && (cb >= tq0 + 3 - WIN);
            f32x4 s[4];
#pragma unroll
            for (int kt = 0; kt < 4; ++kt) { s[kt] = mfma16(kf[kt][0], S.q0, (f32x4){0.f, 0.f, 0.f, 0.f}); s[kt] = mfma16(kf[kt][1], S.q1, s[kt]); }
            if (!far) {
#pragma unroll
                for (int kt = 0; kt < 4; ++kt)
#pragma unroll
                    for (int i = 0; i < 4; ++i) { const int dist = tc - (cb + 16 * kt + 4 * G + i); const bool ok = dist >= 0 && dist <= WIN; const int dd = dist < 0 ? 0 : (dist > 128 ? 128 : dist);
                        s[kt][i] = ok ? s[kt][i] + T2[dd * 8 + g * 4 + hh] : -1e30f; }
            }
            finish(S, s, far ? b31 : 0.f, true, vf);
        };
        auto chunkstep = [&](int cb, const bf16x8 (&kf)[4][2], const bf16x8 (&vf)[2][4]) __attribute__((always_inline)) {
            if (cb <= hiA) packstep(A, t0, tcA, cb, kf, vf);
            if (cb + 63 >= loB) packstep(B, t0 + 4, tcB, cb, kf, vf);
        };
        auto ldk = [&](int cb_, bf16x8 (&kf_)[4][2]) __attribute__((always_inline)) {
            const bf16_t* kr = klane + (size_t)cb_ * 64;
#pragma unroll
            for (int kt = 0; kt < 4; ++kt) { kf_[kt][0] = *(const bf16x8*)(kr + (kt * 2) * 512); kf_[kt][1] = *(const bf16x8*)(kr + (kt * 2 + 1) * 512); }
        };
        auto ldv = [&](int cb_, bf16x8 (&vf_)[2][4]) __attribute__((always_inline)) {
            const bf16_t* vr = vlane + (size_t)cb_ * 64;
#pragma unroll
            for (int ks = 0; ks < 2; ++ks)
#pragma unroll
                for (int dt = 0; dt < 4; ++dt) vf_[ks][dt] = *(const bf16x8*)(vr + (ks * 4 + dt) * 512);
        };
        bf16x8 kfA[4][2], kfB[4][2], vf[2][4];
        int cb = loA & ~63;
        ldk(cb, kfA);
#pragma unroll 1
        for (;;) {
            ldv(cb, vf); ldk(cb + 64 <= hiB ? cb + 64 : cb, kfB);
            __builtin_amdgcn_sched_barrier(0);
            chunkstep(cb, kfA, vf);
            cb += 64; if (cb > hiB) break;
            ldv(cb, vf); ldk(cb + 64 <= hiB ? cb + 64 : cb, kfA);
            __builtin_amdgcn_sched_barrier(0);
            chunkstep(cb, kfB, vf);
            cb += 64; if (cb > hiB) break;
        }
        addout(A, qrowA, 2); addout(B, qrowA + 4, 2);
    }
}

__device__ __forceinline__ void phase_attn(const Params& p) {
    const int wid = threadIdx.x >> 6, lane = threadIdx.x & 63;
    { PROBE_BEGIN(3)
    if (blockIdx.x < NS * NG) attn_sample_item(p, blockIdx.x >> 1, blockIdx.x & 1);
    PROBE_END(3) }
    LAS unsigned char* L = (LAS unsigned char*)smem;
    for (int i = threadIdx.x; i < 129 * 8; i += 512) ((LAS float*)(L + A_T2))[i] = p.rel_bias[t5_bucket(i >> 3) * 8 + (i & 7)] * LOG2E;
    __syncthreads();
    {
        const int wid2 = __builtin_amdgcn_readfirstlane(threadIdx.x >> 6);
#pragma unroll 1
        for (;;) {
            __syncthreads();
            if (threadIdx.x == 0) ((LAS int*)(L + A_NP))[1] = (int)__hip_atomic_fetch_add(p.bar, 1u, __ATOMIC_RELAXED, __HIP_MEMORY_SCOPE_AGENT);
            __syncthreads();
            const int T = ((const LAS int*)(L + A_NP))[1];
            if (T >= NB * NG * (SEQ / 64)) break;
            const int bg = T & 7, qb = (SEQ / 64 - 1) - (T >> 3), t0 = qb * 64 + wid2 * 8;
            unsigned mA[4], mB[4];
            PROBE_BEGIN(6)
            attn_cmp(p, bg >> 1, bg & 1, t0, lane, L, mA);
            attn_cmp(p, bg >> 1, bg & 1, t0 + 4, lane, L, mB);
            PROBE_END(6)
            PROBE_BEGIN(7)
            attn_selwin_pair(p, bg >> 1, bg & 1, t0, lane, L, mA, mB);
            PROBE_END(7)
        }
    }
    __syncthreads();
}

constexpr int GM_LD = 136, GM_LDS = 128 * GM_LD * 2 + 1024;
__device__ __forceinline__ void phase_gmlp(const Params& p) {
    int tid = threadIdx.x; asm volatile("" : "+v"(tid));
    const int wid = __builtin_amdgcn_readfirstlane(tid >> 6), lane = tid & 63;
    LAS bf16_t* vnT = (LAS bf16_t*)smem;
    LAS float* mu = (LAS float*)(smem + 128 * GM_LD * 2);
    const int c = lane & 15, G = lane >> 4;
#pragma unroll 1
    for (int u = blockIdx.x; u < NB * 64; u += gridDim.x) {
        const int b = u >> 6, ch = u & 63; const size_t row0 = (size_t)b * SEQ + ch * 128;
        __syncthreads();
        for (int r = wid; r < 128; r += 8) {
            const u32x4 w = *(const u32x4*)(p.Vg + (row0 + r) * GMD + lane * 8);
            const float x[8] = {bflo(w.x), bfhi(w.x), bflo(w.y), bfhi(w.y), bflo(w.z), bfhi(w.z), bflo(w.w), bfhi(w.w)};
            float s = 0.f;
#pragma unroll
            for (int i = 0; i < 8; ++i) s += x[i];
            const float mean = wave_sum(s) * (1.0f / GMD);
            float q = 0.f;
#pragma unroll
            for (int i = 0; i < 8; ++i) q += (x[i] - mean) * (x[i] - mean);
            const float var = wave_sum(q) * (1.0f / GMD);
            if (lane == 0) { mu[r] = mean; mu[128 + r] = rsqrtf(var + EPS); }
        }
#pragma unroll 1
        for (int g = 0; g < 4; ++g) {
            __syncthreads();
#pragma unroll
            for (int k = 0; k < 4; ++k) {
                const int e = tid + 512 * k, s = e & 127, d0 = (e >> 7) * 8;
                const u32x4 w = *(const u32x4*)(p.Vg + (row0 + s) * GMD + g * 128 + d0);
                const float x[8] = {bflo(w.x), bfhi(w.x), bflo(w.y), bfhi(w.y), bflo(w.z), bfhi(w.z), bflo(w.w), bfhi(w.w)};
                const float m = mu[s], rs = mu[128 + s];
#pragma unroll
                for (int i = 0; i < 8; ++i) { const int cc = g * 128 + d0 + i; vnT[(d0 + i) * GM_LD + s] = f2bf((x[i] - m) * rs * p.gm_ln_g[cc] + p.gm_ln_b[cc]); }
            }
            __syncthreads();
            f32x4 acc[8];
#pragma unroll
            for (int dt = 0; dt < 8; ++dt) acc[dt] = (f32x4){0.f, 0.f, 0.f, 0.f};
            const bf16_t* wrow = p.GWb + ((size_t)g * 128 + 16 * wid + c) * 128 + 8 * G;
#pragma unroll 1
            for (int ks = 0; ks <= (wid >> 1); ++ks) {
                const bf16x8 B = *(const bf16x8*)(wrow + 32 * ks);
#pragma unroll
                for (int dt = 0; dt < 8; ++dt) {
                    const bf16x8 A = *(const LAS bf16x8*)(vnT + (dt * 16 + c) * GM_LD + 32 * ks + 8 * G);
                    acc[dt] = mfma16(A, B, acc[dt]);
                }
            }
            const int t = 16 * wid + c;
            const float bs = p.gm_bs[g * 128 + t];
#pragma unroll
            for (int dt = 0; dt < 8; ++dt) {
                const int d = dt * 16 + 4 * G;
                const u32x2 uw = *(const u32x2*)(p.U + (row0 + t) * GMD + g * 128 + d);
                f32x4 o; o[0] = bflo(uw.x) * (acc[dt][0] + bs); o[1] = bfhi(uw.x) * (acc[dt][1] + bs); o[2] = bflo(uw.y) * (acc[dt][2] + bs); o[3] = bfhi(uw.y) * (acc[dt][3] + bs);
                st_bf16x4(p.OCAT + (row0 + t) * DM + QD + g * 128 + d, o);
            }
        }
    }
    for (int it = blockIdx.x * 8 + wid; it < NS; it += gridDim.x * 8) {
        const size_t row = (size_t)MP + it;
        const u32x4 w = *(const u32x4*)(p.Vg + row * GMD + lane * 8);
        const float x[8] = {bflo(w.x), bfhi(w.x), bflo(w.y), bfhi(w.y), bflo(w.z), bfhi(w.z), bflo(w.w), bfhi(w.w)};
        float s = 0.f;
#pragma unroll
        for (int i = 0; i < 8; ++i) s += x[i];
        const float mean = wave_sum(s) * (1.0f / GMD);
        float q = 0.f;
#pragma unroll
        for (int i = 0; i < 8; ++i) q += (x[i] - mean) * (x[i] - mean);
        const float rs = rsqrtf(wave_sum(q) * (1.0f / GMD) + EPS);
#pragma unroll
        for (int i = 0; i < 8; ++i) {
            const int c = lane * 8 + i, g = c >> 7;
            const float v = (x[i] - mean) * rs * p.gm_ln_g[c] + p.gm_ln_b[c];
            p.out[O_GMV + (size_t)it * GMD + c] = v;
            const float a = p.gm_ws[(size_t)g * 128 * 128] * v + p.gm_bs[g * 128];
            p.OCAT[row * DM + QD + c] = f2bf(bf2f(p.U[row * GMD + c]) * a);
        }
    }
}

template <int MODE>
__device__ __forceinline__ void phase_norm(const Params& p) {
    const int wid = threadIdx.x >> 6, lane = threadIdx.x & 63;
    const float* gpost = MODE == 0 ? p.ln_mix_post : MODE == 1 ? p.ln_ffn_post : p.ln_ple_post;
    for (int row = blockIdx.x * 8 + wid; row < MP + NS; row += gridDim.x * 8) {
        const bf16_t* fr = (const bf16_t*)p.F + (size_t)row * DM;
        const bf16_t* xb = MODE == 1 ? (const bf16_t*)p.X1 + (size_t)row * DM : p.X2b + (size_t)row * DM;
        f32x4 f[4], x[4];
#pragma unroll
        for (int k = 0; k < 4; ++k) { const u32x2 w = *(const u32x2*)(fr + lane * 4 + k * 256); f[k][0] = bflo(w.x); f[k][1] = bfhi(w.x); f[k][2] = bflo(w.y); f[k][3] = bfhi(w.y);
            if (MODE == 0) x[k] = *(const f32x4*)(xrow_ptr(p, row) + lane * 4 + k * 256);
            else { const u32x2 v = *(const u32x2*)(xb + lane * 4 + k * 256); x[k][0] = bflo(v.x); x[k][1] = bfhi(v.x); x[k][2] = bflo(v.y); x[k][3] = bfhi(v.y); } }
        const float r = row_rstd(f);
#pragma unroll
        for (int k = 0; k < 4; ++k) { const f32x4 g = *(const f32x4*)(gpost + lane * 4 + k * 256); x[k] = x[k] + f[k] * r * g; }
        if (MODE == 0) {
            const float r2 = row_rstd(x);
#pragma unroll
            for (int k = 0; k < 4; ++k) {
                st_bf16x4((bf16_t*)p.X1 + (size_t)row * DM + lane * 4 + k * 256, x[k]);
                const f32x4 g = *(const f32x4*)(p.ln_ffn_pre + lane * 4 + k * 256); const f32x4 o = x[k] * r2 * g;
                st_bf16x4(p.H2 + (size_t)row * DM + lane * 4 + k * 256, o);
            }
        } else if (MODE == 1) {
#pragma unroll
            for (int k = 0; k < 4; ++k) st_bf16x4(p.X2b + (size_t)row * DM + lane * 4 + k * 256, x[k]);
        } else {
            float* yr = row < MP ? p.out + O_YP + (size_t)row * DM : p.out + O_YS + (size_t)(row - MP) * DM;
#pragma unroll
            for (int k = 0; k < 4; ++k) __builtin_nontemporal_store(x[k], (f32x4*)(yr + lane * 4 + k * 256));
        }
    }
}


#define XB_TMO      128
#define XB_XCNT(j)  (256  + 64 * (j))
#define XB_XSUB(j)  (1280 + 64 * (j))
#define XB_XGEN(j)  (2304 + 64 * (j))
#define XB_TOP      3328
#define XB_TOPGEN   3392
#define XCD_BAR_WORDS 3456
#define XB_SPIN_CAP (1u << 22)

__device__ __forceinline__ unsigned xb_ld(unsigned* p)              { return __hip_atomic_load(p, __ATOMIC_RELAXED, __HIP_MEMORY_SCOPE_AGENT); }
__device__ __forceinline__ unsigned xb_add(unsigned* p, unsigned v) { return __hip_atomic_fetch_add(p, v, __ATOMIC_RELAXED, __HIP_MEMORY_SCOPE_AGENT); }
__device__ __forceinline__ unsigned xb_xcc_id() { return (unsigned)__builtin_amdgcn_s_getreg((3 << 11) | 20) & 0xFu; }
#define XB_SPIN(cond, bar) do { unsigned _sp = 0; while (cond) { __builtin_amdgcn_s_sleep(1); \
    if ((++_sp & 255u) == 0u) { if (xb_ld(&(bar)[XB_TMO])) break; if (_sp > XB_SPIN_CAP) { atomicAdd(&(bar)[XB_TMO], 1u); break; } } } } while (0)

struct XcdBarrier {
    unsigned* bar; unsigned x;
    volatile LAS unsigned* st;
};

__device__ __forceinline__ XcdBarrier xcd_barrier_post(unsigned* bar, volatile LAS unsigned* st) {
    XcdBarrier b; b.bar = bar; b.x = xb_xcc_id(); b.st = st;
    if (threadIdx.x == 0) (void)xb_add(&bar[XB_XCNT(b.x)], 1u);
    return b;
}
__device__ __forceinline__ void xcd_barrier_complete(unsigned* bar, unsigned x, unsigned& nloc, unsigned& nx) {
    const unsigned G = gridDim.x * gridDim.y * gridDim.z;
    unsigned sum, cnt, mine, sp = 0u;
    for (;;) {
        sum = 0u; cnt = 0u; mine = 0u;
#pragma unroll
        for (unsigned j = 0; j < 16; ++j) { const unsigned c = xb_ld(&bar[XB_XCNT(j)]); sum += c; cnt += (c > 0u) ? 1u : 0u; mine = (j == x) ? c : mine; }
        if (sum == G) break;
        __builtin_amdgcn_s_sleep(1);
        if ((++sp & 255u) == 0u) { if (xb_ld(&bar[XB_TMO])) break; if (sp > XB_SPIN_CAP) { atomicAdd(&bar[XB_TMO], 1u); break; } }
    }
    nloc = mine > 0u ? mine : 1u; nx = cnt > 0u ? cnt : 1u;
}

__device__ __forceinline__ void xcd_barrier(const XcdBarrier& b) {
    asm volatile("s_waitcnt vmcnt(0)" ::: "memory");
    __syncthreads();
    if (threadIdx.x == 0) {
        unsigned* bar = b.bar;
        __builtin_amdgcn_s_waitcnt(0);
        unsigned nloc = b.st[0], nx = b.st[1];
        if (nloc == 0u) { xcd_barrier_complete(bar, b.x, nloc, nx); b.st[0] = nloc; b.st[1] = nx; }
        const unsigned old = xb_add(&bar[XB_XSUB(b.x)], 1u);
        const unsigned gen = old / nloc;
        if (old + 1u == (gen + 1u) * nloc) {
            __builtin_amdgcn_fence(__ATOMIC_RELEASE, "agent");
            asm volatile("s_waitcnt vmcnt(0)" ::: "memory");
            const unsigned og = xb_add(&bar[XB_TOP], 1u);
            const unsigned tg = og / nx;
            if (og + 1u == (tg + 1u) * nx) xb_add(&bar[XB_TOPGEN], 1u);
            else XB_SPIN(xb_ld(&bar[XB_TOPGEN]) == tg, bar);
            __builtin_amdgcn_fence(__ATOMIC_ACQUIRE, "agent");
            xb_add(&bar[XB_XGEN(b.x)], 1u);
            asm volatile("s_waitcnt vmcnt(0)" ::: "memory");
        } else {
            XB_SPIN(xb_ld(&bar[XB_XGEN(b.x)]) == gen, bar);
            __builtin_amdgcn_fence(__ATOMIC_ACQUIRE, "agent");
            asm volatile("s_waitcnt vmcnt(0)" ::: "memory");
        }
    }
    __syncthreads();
}

constexpr int NPHASE = 16;
constexpr int LDS_BYTES = GEMM_LDS;
static_assert(GM_LDS <= LDS_BYTES, "lds");
constexpr int NMT = MALL / BM;

constexpr int NMP = MP / BM;
template <int PH>
__device__ __forceinline__ void run_phase(const Params& p) {
    if (PH == 0) phase_prologue(p);
    if (PH == 1) { EpiIn e{p}; if (blockIdx.x & 1) phase_gather(p); gemm_phase(p.H, DM, p.WinT, DM, NMP, INP / BM, e); gemm_skinny(p.H + (size_t)MP * DM, DM, p.WinT, DM, INP, e); if (!(blockIdx.x & 1)) phase_gather(p); }
    if (PH == 2) { EpiPart e{(bf16_t*)p.PART}; gemm_phase(p.CMPb, 4096, p.W1T, 1024, (2048 + NS * 1024) / BM, 1, e, 4, ZCmp(), 256); phase_deferred_transposes(p); }
    if (PH == 3) phase_cmp_final(p);
    if (PH == 4) phase_attn(p);
    if (PH == 5) phase_gmlp(p);
    if (PH == 6) { EpiBranch e{p.GA, p.GB, p.Y1}; gemm_phase<EpiBranch, ZNone, true>(p.OCAT, DM, p.WnT, DM, NMP, DM / BM, e); gemm_skinny2(p.OCAT + (size_t)MP * DM, DM, p.WnT, DM, DM, e); }
    if (PH == 8) { EpiBf16 e{(bf16_t*)p.F, DM}; gemm_phase(p.Y1, DM, p.WoT, DM, NMP, DM / BM, e); gemm_skinny(p.Y1 + (size_t)MP * DM, DM, p.WoT, DM, DM, e); }
    if (PH == 9) phase_norm<0>(p);
    if (PH == 10) { EpiSwiGLU e{p.ACT}; gemm_phase(p.H2, DM, p.WguT, DM, NMP, 2 * DFF / BM, e); gemm_skinny(p.H2 + (size_t)MP * DM, DM, p.WguT, DM, 2 * DFF, e); }
    if (PH == 11) { EpiBf16 e{(bf16_t*)p.F, DM}; gemm_phase(p.ACT, DFF, p.WdT, DFF, NMP, DM / BM, e); gemm_skinny(p.ACT + (size_t)MP * DFF, DFF, p.WdT, DFF, DM, e); }
    if (PH == 12) phase_norm<1>(p);
    if (PH == 13) { EpiBf16 e{(bf16_t*)p.T, DM}; gemm_phase(p.Pb, PLE, p.WpT, PLE, NMP, DM / BM, e); gemm_skinny(p.Pb + (size_t)MP * PLE, PLE, p.WpT, PLE, DM, e); }
    if (PH == 14) { EpiPleGate e{(const bf16_t*)p.T, (bf16_t*)p.F}; gemm_phase(p.X2b, DM, p.WpgT, DM, NMP, DM / BM, e); gemm_skinny(p.X2b + (size_t)MP * DM, DM, p.WpgT, DM, DM, e); }
    if (PH == 15) phase_norm<2>(p);
}

#ifndef MK_MULTI
#define MK_MULTI 0
#endif
template <int PH>
__global__ void __launch_bounds__(512, 2) k_phase(Params p) { run_phase<PH>(p); }

__global__ void __launch_bounds__(512, 2) k_all(Params p) {
    volatile LAS unsigned* st = (volatile LAS unsigned*)((LAS unsigned char*)smem + LDS_BYTES);
    if (threadIdx.x < 12) st[threadIdx.x] = 0u;
    __syncthreads();
    XcdBarrier bar = xcd_barrier_post(p.bar, st);
#if PROBE_DUP == 100
    run_phase<0>(p);  xcd_barrier(bar);
#endif
#if PROBE_SPIN >= 100
    if (threadIdx.x == 0) PROBE_TS[3] = probe_now();
#define PROBE_STAMP(k) if (threadIdx.x == 0 && PROBE_SEG == (k)) PROBE_TS[2] = probe_now() - PROBE_TS[3];
#else
#define PROBE_STAMP(k)
#endif
    run_phase<0>(p);  xcd_barrier(bar);
    PROBE_STAMP(20)
    run_phase<1>(p);  xcd_barrier(bar);
    PROBE_STAMP(21)
    run_phase<2>(p);  xcd_barrier(bar);
#if PROBE_DUP == 100
    run_phase<3>(p);  xcd_barrier(bar);
#endif
    run_phase<3>(p);  xcd_barrier(bar);
    PROBE_STAMP(23)
#if PROBE_DUP == 104
    run_phase<4>(p);  xcd_barrier(bar);
#endif
    run_phase<4>(p);
#if PROBE_DUP == 100
    run_phase<5>(p);  xcd_barrier(bar);
#endif
    run_phase<5>(p);  xcd_barrier(bar);
    PROBE_STAMP(25)
    run_phase<6>(p);  xcd_barrier(bar);
    run_phase<8>(p);  xcd_barrier(bar);
    PROBE_STAMP(28)
    run_phase<9>(p);  xcd_barrier(bar);
    PROBE_STAMP(29)
    run_phase<10>(p); xcd_barrier(bar);
    PROBE_STAMP(30)
    run_phase<11>(p); xcd_barrier(bar);
    PROBE_STAMP(31)
    run_phase<12>(p);
    run_phase<13>(p); xcd_barrier(bar);
    run_phase<14>(p); xcd_barrier(bar);
    PROBE_STAMP(34)
    run_phase<15>(p);
#if PROBE_SPIN
    if (blockIdx.x == 0 && threadIdx.x == 0) {
        const unsigned long long d = PROBE_TS[2] * (PROBE_SPIN >= 100 ? PROBE_SPIN - 100 : PROBE_SPIN), t0 = probe_now();
        while (probe_now() - t0 < d) __builtin_amdgcn_s_sleep(8);
    }
#endif
}

static inline size_t al256(size_t x) { return (x + 255) & ~(size_t)255; }
template <int PH> static void launch_phase(const Params& p, int grid, hipStream_t s) {
    static bool attr = false;
    if (!attr) { (void)hipFuncSetAttribute((const void*)k_phase<PH>, hipFuncAttributeMaxDynamicSharedMemorySize, LDS_BYTES); attr = true; }
    k_phase<PH><<<grid, 512, LDS_BYTES, s>>>(p);
}
template <int PH> static void launch_all(const Params& p, int grid, hipStream_t s) {
    launch_phase<PH>(p, grid, s);
    if constexpr (PH + 1 < NPHASE) launch_all<PH + 1>(p, grid, s);
}

extern "C" void kernel_launch(void* const* d_in, const int* in_sizes, int n_in, void* d_out, int out_size, void* d_ws, size_t ws_size, hipStream_t stream) {
    Params p{};
    p.x_prompt = (const float*)d_in[0]; p.x_sample = (const float*)d_in[1]; p.cache_cmp = (const float*)d_in[2]; p.cache_slc = (const float*)d_in[3];
    p.state_win = (const float*)d_in[4]; p.page_table = (const int*)d_in[5]; p.p_prompt = (const float*)d_in[6]; p.p_sample = (const float*)d_in[7];
    p.rel_bias = (const float*)d_in[8]; p.ln_mix_pre = (const float*)d_in[9]; p.w_in = (const float*)d_in[10];
    p.pe_k = (const float*)d_in[11]; p.w1_k = (const float*)d_in[12]; p.w2_k = (const float*)d_in[13];
    p.pe_v = (const float*)d_in[14]; p.w1_v = (const float*)d_in[15]; p.w2_v = (const float*)d_in[16];
    p.gm_ln_g = (const float*)d_in[17]; p.gm_ln_b = (const float*)d_in[18]; p.gm_ws = (const float*)d_in[19]; p.gm_bs = (const float*)d_in[20];
    p.w_br_nsa = (const float*)d_in[21]; p.w_br_gm = (const float*)d_in[22]; p.w_out = (const float*)d_in[23];
    p.ln_mix_post = (const float*)d_in[24]; p.ln_ffn_pre = (const float*)d_in[25]; p.w_gate = (const float*)d_in[26]; p.w_up = (const float*)d_in[27];
    p.w_down = (const float*)d_in[28]; p.ln_ffn_post = (const float*)d_in[29]; p.w_ple = (const float*)d_in[30]; p.w_ple_gate = (const float*)d_in[31];
    p.ln_ple_post = (const float*)d_in[32];
    p.out = (float*)d_out;
    unsigned char* w = (unsigned char*)d_ws; size_t off = 0;
    auto take = [&](size_t bytes) { void* r = w + off; off = al256(off + bytes); return r; };
    p.bar = (unsigned*)take(16384);
    p.WinT = (bf16_t*)take((size_t)INP * DM * 2); p.WnT = (bf16_t*)take((size_t)DM * DM * 2); p.WgT = nullptr;
    p.WoT = (bf16_t*)take((size_t)DM * DM * 2); p.WguT = (bf16_t*)take((size_t)2 * DFF * DM * 2); p.WdT = (bf16_t*)take((size_t)DM * DFF * 2);
    p.WpgT = (bf16_t*)take((size_t)DM * DM * 2); p.WpT = (bf16_t*)take((size_t)DM * PLE * 2); p.W1T = (bf16_t*)take((size_t)2 * 256 * 1024 * 2);
    p.H = (bf16_t*)take((size_t)MALL * DM * 2); p.Qb = (bf16_t*)take((size_t)MALL * QD * 2);
    p.CMPb = (bf16_t*)take(((size_t)MP + (size_t)NS * PAST) * 256 * 2); p.SLCb = (bf16_t*)take((size_t)MALL * 256 * 2); p.WINb = (bf16_t*)take((size_t)MALL * 256 * 2);
    p.U = (bf16_t*)take((size_t)MALL * GMD * 2); p.Vg = (bf16_t*)take((size_t)MALL * GMD * 2);
    p.GA = (bf16_t*)take((size_t)MALL * DM * 2); p.GB = (bf16_t*)take((size_t)MALL * DM * 2);
    p.GATE = (float*)take((size_t)MALL * 32 * 4);
    p.PART = (float*)take((size_t)(2048 + NS * 1024) * 4 * 256 * 4); p.PEB = (float*)take(256 * 4);
    p.KCP = (float*)take((size_t)NB * NG * 512 * 64 * 4); p.VCP = (float*)take((size_t)NB * NG * 512 * 64 * 4);
    p.KCS = (float*)take((size_t)NS * NG * 1024 * 64 * 4); p.VCS = (float*)take((size_t)NS * NG * 1024 * 64 * 4); p.KN = (float*)take(NB * NG * 128 * 4);
    p.KCb = (bf16_t*)take((size_t)NB * NG * 512 * 64 * 2); p.VCT = (bf16_t*)take((size_t)NB * NG * 64 * 512 * 2);
    p.SLCvT = (bf16_t*)take((size_t)NB * NG * 64 * SEQ * 2); p.WINvT = (bf16_t*)take((size_t)NB * NG * 64 * SEQ * 2);
    p.GWb = (bf16_t*)take(4 * 128 * 128 * 2); p.W2T = (bf16_t*)take(2 * 64 * 128 * 2);
    p.SLCkF = (bf16_t*)take((size_t)NB * NG * 64 * SEQ * 2); p.WINkF = (bf16_t*)take((size_t)NB * NG * 64 * SEQ * 2);
    p.OCAT = (bf16_t*)take((size_t)MALL * DM * 2); p.T = (float*)take((size_t)MALL * DM * 4); p.Y1 = (bf16_t*)take((size_t)MALL * DM * 2);
    p.F = (float*)take((size_t)MALL * DM * 4); p.X1 = (float*)take((size_t)MALL * DM * 4); p.H2 = (bf16_t*)take((size_t)MALL * DM * 2);
    p.ACT = (bf16_t*)take((size_t)MALL * DFF * 2); p.X2 = (float*)take((size_t)MALL * DM * 4); p.X2b = (bf16_t*)take((size_t)MALL * DM * 2);
    p.Pb = (bf16_t*)take((size_t)MALL * PLE * 2);
    if (off > ws_size) { fprintf(stderr, "workspace too small: need %zu have %zu\n", off, ws_size); return; }
#if MK_MULTI
    launch_all<0>(p, 256, stream);
#else
    constexpr size_t kDynLds = LDS_BYTES + 48;
    static int grid = 0;
    if (!grid) {
        int dev = 0, cus = 0, per_cu = 0;
        (void)hipGetDevice(&dev);
        (void)hipDeviceGetAttribute(&cus, hipDeviceAttributeMultiprocessorCount, dev);
        (void)hipFuncSetAttribute((const void*)k_all, hipFuncAttributeMaxDynamicSharedMemorySize, (int)kDynLds);
        (void)hipOccupancyMaxActiveBlocksPerMultiprocessor(&per_cu, (const void*)k_all, 512, kDynLds);
        grid = cus * (per_cu < 1 ? per_cu : 1);
        if (grid <= 0) { fprintf(stderr, "k_all: occupancy query says %d blocks per CU\n", per_cu); grid = 0; return; }
    }
    (void)hipMemsetAsync(p.bar, 0, XCD_BAR_WORDS * sizeof(unsigned), stream);
    k_all<<<grid, 512, kDynLds, stream>>>(p);
#endif
}
```

```cpp
#include <hip/hip_runtime.h>
#include <stdint.h>
#include <cstdio>

typedef unsigned short bf16_t;
typedef short bf16x8 __attribute__((ext_vector_type(8)));
typedef float f32x4 __attribute__((ext_vector_type(4)));
typedef float f32x2 __attribute__((ext_vector_type(2)));
typedef unsigned u32x4 __attribute__((ext_vector_type(4)));
typedef unsigned u32x2 __attribute__((ext_vector_type(2)));
#define LAS __attribute__((address_space(3)))

constexpr int DM = 1024, NB = 4, SEQ = 8192, MP = NB * SEQ, NS = 32, MALL = MP + 256, PAST = 16384, PAGE = 128, NPG = 128;
constexpr int NH = 8, NG = 2, HPG = 4, DH = 64, QD = 512, WIN = 512, GMD = 512, DFF = 2816, PLE = 256, IND = 4376, INP = 4608;
constexpr int NCP = 511, NCS = 1023;
constexpr float EPS = 1e-6f;
constexpr float LOG2E = 1.4426950408889634f, QSCALE = 0.125f * LOG2E;
constexpr long O_YP = 0, O_YS = 33554432, O_CMPP = 33587200, O_SLCP = 41975808, O_WINP = 50364416, O_CMPS = 50888704,
               O_SLCS = 50896896, O_WINS = 50905088, O_GMV = 55099392;

struct Params {
    const float *x_prompt, *x_sample, *cache_cmp, *cache_slc, *state_win; const int* page_table;
    const float *p_prompt, *p_sample, *rel_bias, *ln_mix_pre, *w_in, *pe_k, *w1_k, *w2_k, *pe_v, *w1_v, *w2_v;
    const float *gm_ln_g, *gm_ln_b, *gm_ws, *gm_bs, *w_br_nsa, *w_br_gm, *w_out, *ln_mix_post, *ln_ffn_pre;
    const float *w_gate, *w_up, *w_down, *ln_ffn_post, *w_ple, *w_ple_gate, *ln_ple_post;
    float* out;
    unsigned* bar;
    bf16_t *WinT, *WnT, *WgT, *WoT, *WguT, *WdT, *WpgT, *WpT, *W1T;
    bf16_t *H, *Qb, *CMPb, *SLCb, *WINb, *U, *Vg, *GA, *GB;
    float* GATE;
    float *PART, *PEB, *KCP, *VCP, *KCS, *VCS, *KN;
    bf16_t *KCb, *VCT, *SLCvT, *WINvT, *SLCkF, *WINkF, *GWb, *W2T;
    bf16_t* OCAT; float* T; bf16_t* Y1; float* F; float* X1; bf16_t* H2; bf16_t* ACT; float* X2; bf16_t* X2b; bf16_t* Pb;
};

typedef __bf16 bf16v2_t __attribute__((ext_vector_type(2)));
__device__ __forceinline__ unsigned cvt_pk_bf16(float lo, float hi) { const f32x2 v = {lo, hi}; return __builtin_bit_cast(unsigned, __builtin_convertvector(v, bf16v2_t)); }
__device__ __forceinline__ unsigned cvt_pk_bf16_t(float lo, float hi) { unsigned r; asm volatile("s_nop 1\n\tv_cvt_pk_bf16_f32 %0, %1, %2" : "=v"(r) : "v"(lo), "v"(hi)); return r; }
__device__ __forceinline__ bf16_t f2bf(float f) { return (bf16_t)(cvt_pk_bf16(f, 0.f) & 0xffffu); }
__device__ __forceinline__ float bf2f(bf16_t h) { return __uint_as_float(((unsigned)h) << 16); }
__device__ __forceinline__ float bflo(unsigned w) { return __uint_as_float(w << 16); }
__device__ __forceinline__ float bfhi(unsigned w) { return __uint_as_float(w & 0xffff0000u); }
__device__ __forceinline__ float ex2(float x) { return __builtin_amdgcn_exp2f(x); }
__device__ __forceinline__ float sigmoidf_(float x) { return __builtin_amdgcn_rcpf(1.0f + __builtin_amdgcn_exp2f(x * -1.4426950408889634f)); }
__device__ __forceinline__ float siluf_(float x) { return x * sigmoidf_(x); }
__device__ __forceinline__ float sigmoid_fast(float x) { return __builtin_amdgcn_rcpf(1.0f + __builtin_amdgcn_exp2f(x * -1.4426950408889634f)); }
__device__ __forceinline__ float gelu_fast(float x) {
    const float t = x * (-2.0f * 0.7978845608028654f * 1.4426950408889634f) * (1.0f + 0.044715f * x * x);
    return x * __builtin_amdgcn_rcpf(1.0f + __builtin_amdgcn_exp2f(t));
}
__device__ __forceinline__ float silu_fast(float x) { return x * __builtin_amdgcn_rcpf(1.0f + __builtin_amdgcn_exp2f(x * -1.4426950408889634f)); }
__device__ __forceinline__ float geluf_(float x) {
    const float u = 0.7978845608028654f * (x + 0.044715f * x * x * x);
    const float e = __expf(2.0f * u);
    const float th = 1.0f - 2.0f / (e + 1.0f);
    return 0.5f * x * (1.0f + th);
}
__device__ __forceinline__ float wave_sum(float v) {
#pragma unroll
    for (int o = 32; o > 0; o >>= 1) v += __shfl_xor(v, o);
    return v;
}
__device__ __forceinline__ float wave_max(float v) {
#pragma unroll
    for (int o = 32; o > 0; o >>= 1) v = fmaxf(v, __shfl_xor(v, o));
    return v;
}
__device__ __forceinline__ int t5_bucket(int d) {
    if (d < 16) return d;
    if (d >= 128) return 31;
    const int b = 16 + (int)(__logf((float)d * (1.0f / 16.0f)) * (16.0f / 2.0794415416798357f));
    return b < 31 ? b : 31;
}

extern __shared__ __attribute__((aligned(16))) unsigned char smem[];
#ifndef PROBE_DUP
#define PROBE_DUP 0
#endif
#define PROBE_LDS_OFF 131072
#ifndef PROBE_SPIN
#define PROBE_SPIN 0
#endif
#ifndef PROBE_SEG
#define PROBE_SEG 5
#endif
__device__ __forceinline__ unsigned long long probe_now() { unsigned long long t; asm volatile("s_memrealtime %0\n\ts_waitcnt lgkmcnt(0)" : "=s"(t) :: "memory"); return t; }
#define PROBE_TS ((volatile LAS unsigned long long*)((LAS unsigned char*)smem + PROBE_LDS_OFF + 16))
#if PROBE_SPIN
#define PROBE_BEGIN(seg) unsigned long long pb_##seg = 0; if (PROBE_SEG == seg && threadIdx.x == 0) pb_##seg = probe_now();
#define PROBE_END(seg) if (PROBE_SEG == seg && threadIdx.x == 0) { PROBE_TS[2] = PROBE_TS[2] + (probe_now() - pb_##seg); }
#else
#define PROBE_BEGIN(seg)
#define PROBE_END(seg)
#endif

constexpr int BM = 256, BK = 64, HALF = 128, HT = HALF * BK, GEMM_LDS = 8 * HT * 2;
__device__ __forceinline__ int lds_byte(int r, int c) { const int st = (r >> 4) * 2 + (c >> 5), rr = r & 15, cc = c & 31, ob = rr * 64 + cc * 2; return st * 1024 + (ob ^ (((ob >> 9) & 1) << 5)); }
__device__ __forceinline__ void stage_rc(int b, int& R, int& C) { const int st = b / 1024, sb = b % 1024, swz = sb ^ (((sb >> 9) & 1) << 5); R = (st >> 1) * 16 + swz / 64; C = (st & 1) * 32 + (swz % 64) / 2; }

constexpr int HTB = HALF * BK * 2;
template <class F>
__device__ __forceinline__ void for_each_frag(const f32x4 (&acc)[2][2][4][2], int brow, int bcol, int wr, int wc, int fr, int fq, F&& f) {
#pragma unroll
    for (int ai = 0; ai < 2; ++ai)
#pragma unroll
        for (int m = 0; m < 4; ++m)
#pragma unroll
            for (int bj = 0; bj < 2; ++bj)
#pragma unroll
                for (int n = 0; n < 2; ++n)
                    f(brow + ai * HALF + wr * 64 + m * 16 + fr, bcol + bj * HALF + wc * 32 + n * 16 + fq * 4, acc[ai][bj][m][n]);
}

__host__ __device__ __forceinline__ int inv_a(int ca) { return ((ca >> 5) & 1) * 128 + (ca >> 6) * 32 + ((ca >> 2) & 1) * 16 + ((ca >> 3) & 3) * 4 + (ca & 3); }
__host__ __device__ __forceinline__ int row_a(int n) { return (n & ~255) + inv_a(n & 255); }
__host__ __device__ __forceinline__ int inv_s(int o, int s) { return ((o >> 2) & 1) * 128 + (o >> 5) * 32 + ((o >> 1) & 1) * 16 + ((o >> 3) & 3) * 4 + (o & 1) * 2 + s; }
__host__ __device__ __forceinline__ int row_s(int n, int s) { return (n >> 7) * 256 + inv_s(n & 127, s); }
__host__ __device__ __forceinline__ int lcol_a(int r) { const int cg = r & 255; return (r & ~255) + ((cg >> 5) & 3) * 64 + (cg >> 7) * 32 + ((cg >> 2) & 3) * 8 + ((cg >> 4) & 1) * 4; }
__host__ __device__ __forceinline__ int lcol_s(int r) { const int cg = r & 255; return (r & ~255) + 2 * (((cg >> 5) & 3) * 32 + ((cg >> 2) & 3) * 8 + (cg >> 7) * 4 + ((cg >> 4) & 1) * 2); }
template <class F>
__device__ __forceinline__ void for_each_frag8(const f32x4 (&acc)[2][2][4][2], int brow, int bcol, int wr, int wc, int fr, int fq, F&& f) {
#pragma unroll
    for (int ai = 0; ai < 2; ++ai)
#pragma unroll
        for (int m = 0; m < 4; ++m)
#pragma unroll
            for (int bj = 0; bj < 2; ++bj)
                f(brow + ai * HALF + wr * 64 + m * 16 + fr, bcol + wc * 64 + bj * 32 + fq * 8, acc[ai][bj][m][0], acc[ai][bj][m][1]);
}

struct ZNone { __device__ __forceinline__ size_t a(int) const { return 0; } __device__ __forceinline__ size_t b(int) const { return 0; } };
template <class Epi, class ZMap = ZNone, bool HAS_MID = false>
__device__ __forceinline__ void gemm_phase(const bf16_t* A, int lda, const bf16_t* Bt, int K, int nM, int nN, const Epi& E, int nZ = 1, ZMap zm = ZMap(), int kstepA_el = BK) {
    LAS unsigned char* lds = (LAS unsigned char*)smem;
    int tid = threadIdx.x; asm volatile("" : "+v"(tid));
    const int wid = __builtin_amdgcn_readfirstlane(tid >> 6), lane = tid & 63, wr = wid >> 2, wc = wid & 3, fr = lane & 15, fq = lane >> 4;
    const int nt = K / BK, nmn = nM * nN, nu = nmn * nZ, G = gridDim.x;
    int u = blockIdx.x;
    if (u >= nu) return;
    unsigned voffA[2], voffB[2];
#pragma unroll
    for (int i = 0; i < 2; ++i) { int R, C; stage_rc(tid * 16 + i * 8192, R, C); voffA[i] = (unsigned)(R * lda + C) * 2u; voffB[i] = (unsigned)(R * K + C) * 2u; }
    const size_t kstep = (size_t)(BK * 2), kstepA = (size_t)kstepA_el * 2;
    const size_t hstepA = (size_t)HALF * lda * 2, hstepB = (size_t)HALF * K * 2, tstepA = 2 * hstepA, tstepB = 2 * hstepB;
    const unsigned ldsw = (unsigned)wid * 1024u;
    const int aoff = lds_byte(wr * 64 + fr, fq * 8), boff = lds_byte(wc * 32 + fr, fq * 8);
#define PG8_SA(b, h) (((b) * 2 + (h)) * HTB)
#define PG8_SB(b, h) ((4 + (b) * 2 + (h)) * HTB)
#define PG8_STAGE(bufoff, gbase, voff) do { _Pragma("unroll") for (int _i = 0; _i < 2; ++_i) \
        __builtin_amdgcn_global_load_lds((const unsigned*)((const char*)(gbase) + (voff)[_i]), (LAS unsigned*)(lds + (bufoff) + ldsw + _i * 8192), 16, 0, 0); } while (0)
#define PG8_LDA(dst, b, h) do { _Pragma("unroll") for (int m = 0; m < 4; ++m) _Pragma("unroll") for (int k = 0; k < 2; ++k) dst[m][k] = *(const LAS bf16x8*)(lds + PG8_SA(b, h) + aoff + m * 2048 + k * 1024); } while (0)
#define PG8_LDB(dst, b, h) do { _Pragma("unroll") for (int n = 0; n < 2; ++n) _Pragma("unroll") for (int k = 0; k < 2; ++k) dst[n][k] = *(const LAS bf16x8*)(lds + PG8_SB(b, h) + boff + n * 2048 + k * 1024); } while (0)
#define PG8_MMA(ai, bj, At, Bt_) do { __builtin_amdgcn_s_setprio(1); _Pragma("unroll") for (int m = 0; m < 4; ++m) _Pragma("unroll") for (int n = 0; n < 2; ++n) _Pragma("unroll") for (int k = 0; k < 2; ++k) \
        acc[ai][bj][m][n] = __builtin_amdgcn_mfma_f32_16x16x32_bf16(Bt_[n][k], At[m][k], acc[ai][bj][m][n], 0, 0, 0); __builtin_amdgcn_s_setprio(0); } while (0)
#define PG8_WAIT_V(n) asm volatile("s_waitcnt vmcnt(" #n ")" ::: "memory")
#define PG8_WAIT_L(n) asm volatile("s_waitcnt lgkmcnt(" #n ")" ::: "memory")
#define PG8_BAR __builtin_amdgcn_s_barrier()
#define PG8_SCHED __builtin_amdgcn_sched_barrier(0)
    f32x4 acc[2][2][4][2];
#pragma unroll
    for (int a = 0; a < 2; ++a)
#pragma unroll
        for (int b = 0; b < 2; ++b)
#pragma unroll
            for (int m = 0; m < 4; ++m)
#pragma unroll
                for (int n = 0; n < 2; ++n) acc[a][b][m][n] = (f32x4){0.f, 0.f, 0.f, 0.f};
    bf16x8 At[4][2], B0[2][2], B1[2][2];
    auto unit_of = [&](int uu, int& z_, int& pm_, int& pn_) {
        if (nZ == 1) {
            int wg = uu; { const int q = nu / 8, r = nu % 8, xcd = wg % 8, off = wg / 8; wg = (xcd < r ? xcd * (q + 1) : r * (q + 1) + (xcd - r) * q) + off; }
            const int nig = 8 * nN, gid = wg / nig, fm = gid * 8, gsz = (nM - fm) < 8 ? (nM - fm) : 8;
            z_ = 0; pm_ = fm + ((wg % nig) % gsz); pn_ = (wg % nig) / gsz;
        } else { z_ = uu / nmn; pm_ = (uu - z_ * nmn) / nN; pn_ = (uu - z_ * nmn) - pm_ * nN; }
    };
    int z, pm, pn; unit_of(u, z, pm, pn);
    const char* cA = (const char*)(A + zm.a(z)) + (size_t)pm * tstepA; const char* cB = (const char*)(Bt + zm.b(z)) + (size_t)pn * tstepB;
    PG8_STAGE(PG8_SB(0, 0), cB, voffB); PG8_STAGE(PG8_SA(0, 0), cA, voffA); PG8_STAGE(PG8_SB(0, 1), cB + hstepB, voffB); PG8_STAGE(PG8_SA(0, 1), cA + hstepA, voffA);
    if (wr == 1) PG8_BAR;
    PG8_WAIT_V(4); PG8_BAR;
    PG8_STAGE(PG8_SB(1, 0), cB + kstep, voffB); PG8_STAGE(PG8_SA(1, 0), cA + kstepA, voffA); PG8_STAGE(PG8_SB(1, 1), cB + hstepB + kstep, voffB);
    PG8_WAIT_V(6); PG8_BAR;
    for (;;) {
        const int un = u + G; const bool has_next = un < nu;
        int nz = z, npm = pm, npn = pn; if (has_next) unit_of(un, nz, npm, npn);
        const char* nA = (const char*)(A + zm.a(nz)) + (size_t)npm * tstepA; const char* nB = (const char*)(Bt + zm.b(nz)) + (size_t)npn * tstepB;
        auto kiter = [&](int t) {
            const bool last = (t == nt - 2);
            const bool bnd = last || (HAS_MID && t == (nt >> 1) - 2);
            const char* a1 = cA + (size_t)(t + 1) * kstepA;
            const char* a2 = last ? nA : cA + (size_t)(t + 2) * kstepA; const char* b2 = last ? nB : cB + (size_t)(t + 2) * kstep;
            const char* a3 = a2 + kstepA; const char* b3 = b2 + kstep;
            PG8_LDB(B0, 0, 0); PG8_SCHED; PG8_LDA(At, 0, 0); PG8_STAGE(PG8_SA(1, 1), a1 + hstepA, voffA);
            PG8_WAIT_L(8); PG8_BAR; PG8_WAIT_L(0); PG8_MMA(0, 0, At, B0); PG8_BAR; PG8_SCHED;
            PG8_LDB(B1, 0, 1); PG8_STAGE(PG8_SB(0, 0), b2, voffB);
            PG8_BAR; PG8_WAIT_L(0); PG8_MMA(0, 1, At, B1); PG8_BAR;
            PG8_LDA(At, 0, 1); PG8_STAGE(PG8_SA(0, 0), a2, voffA);
            PG8_BAR; PG8_WAIT_L(0); PG8_MMA(1, 0, At, B0); PG8_BAR; PG8_SCHED;
            PG8_STAGE(PG8_SB(0, 1), b2 + hstepB, voffB);
            PG8_WAIT_V(6); PG8_BAR; PG8_MMA(1, 1, At, B1); PG8_BAR;
            PG8_LDB(B0, 1, 0); PG8_SCHED; PG8_LDA(At, 1, 0); PG8_STAGE(PG8_SA(0, 1), a2 + hstepA, voffA);
            PG8_WAIT_L(8); PG8_BAR; PG8_WAIT_L(0); PG8_MMA(0, 0, At, B0); PG8_BAR; PG8_SCHED;
            PG8_LDB(B1, 1, 1); PG8_STAGE(PG8_SB(1, 0), b3, voffB);
            PG8_BAR; PG8_WAIT_L(0); PG8_MMA(0, 1, At, B1); PG8_BAR;
            PG8_LDA(At, 1, 1); PG8_STAGE(PG8_SA(1, 0), a3, voffA);
            PG8_BAR; PG8_WAIT_L(0); PG8_MMA(1, 0, At, B0); PG8_BAR; PG8_SCHED;
            PG8_STAGE(PG8_SB(1, 1), b3 + hstepB, voffB);
            PG8_WAIT_V(6); PG8_BAR; PG8_MMA(1, 1, At, B1);
            if (!(bnd && wr == 1)) PG8_BAR;
        };
        if constexpr (HAS_MID) {
            for (int t = 0; t < (nt >> 1); t += 2) kiter(t);
            { int pmo = pm, pno = pn; asm volatile("" : "+s"(pmo), "+s"(pno));
              E.mid(acc, pmo * BM, pno * BM, wr, wc, fr, fq); }
            PG8_SCHED; PG8_BAR; if (wr == 1) PG8_BAR;
            for (int t = nt >> 1; t < nt; t += 2) kiter(t);
        } else {
            for (int t = 0; t < nt; t += 2) kiter(t);
        }
        { int pmo = pm, pno = pn; asm volatile("" : "+s"(pmo), "+s"(pno));
          E(acc, pmo * BM, pno * BM + (z << 20), wr, wc, fr, fq); }
        PG8_SCHED; PG8_BAR;
        if (!has_next) break;
        if (wr == 1) PG8_BAR;
#pragma unroll
        for (int a = 0; a < 2; ++a)
#pragma unroll
            for (int b = 0; b < 2; ++b)
#pragma unroll
                for (int m = 0; m < 4; ++m)
#pragma unroll
                    for (int n = 0; n < 2; ++n) acc[a][b][m][n] = (f32x4){0.f, 0.f, 0.f, 0.f};
        u = un; z = nz; pm = npm; pn = npn; cA = nA; cB = nB;
    }
    PG8_WAIT_V(0);
    PG8_BAR;
#undef PG8_SA
#undef PG8_SB
#undef PG8_STAGE
#undef PG8_LDA
#undef PG8_LDB
#undef PG8_MMA
#undef PG8_WAIT_V
#undef PG8_WAIT_L
#undef PG8_BAR
#undef PG8_SCHED
}

__device__ __forceinline__ f32x4 mfma16(bf16x8 a, bf16x8 b, f32x4 c) { return __builtin_amdgcn_mfma_f32_16x16x32_bf16(a, b, c, 0, 0, 0); }
__device__ __forceinline__ bf16x8 pack_p(const f32x4& a, const f32x4& b) {
    u32x4 w; w.x = cvt_pk_bf16(a[0], a[1]); w.y = cvt_pk_bf16(a[2], a[3]); w.z = cvt_pk_bf16(b[0], b[1]); w.w = cvt_pk_bf16(b[2], b[3]);
    return __builtin_bit_cast(bf16x8, w);
}
__device__ __forceinline__ size_t kfrag_off(int key, int d) { return ((size_t)((key >> 4) * 2 + (d >> 5)) * 64 + ((d >> 3) & 3) * 16 + (key & 15)) * 8 + (d & 7); }
__device__ __forceinline__ size_t vfrag_off(int key, int d) {
    return ((size_t)((key >> 5) * 4 + (d >> 4)) * 64 + ((key >> 2) & 3) * 16 + (d & 15)) * 8 + ((key >> 4) & 1) * 4 + (key & 3);
}
__device__ __forceinline__ void st_bf16x4(bf16_t* p, f32x4 v) { u32x2 w; w.x = cvt_pk_bf16(v[0], v[1]); w.y = cvt_pk_bf16(v[2], v[3]); *(u32x2*)p = w; }
__device__ __forceinline__ void st_bf16x8(bf16_t* p, f32x4 a, f32x4 b) { u32x4 w; w.x = cvt_pk_bf16(a[0], a[1]); w.y = cvt_pk_bf16(a[2], a[3]); w.z = cvt_pk_bf16(b[0], b[1]); w.w = cvt_pk_bf16(b[2], b[3]); *(u32x4*)p = w; }
__device__ __forceinline__ void st_bf16x8_t(bf16_t* p, f32x4 a, f32x4 b) { u32x4 w; w.x = cvt_pk_bf16_t(a[0], a[1]); w.y = cvt_pk_bf16_t(a[2], a[3]); w.z = cvt_pk_bf16_t(b[0], b[1]); w.w = cvt_pk_bf16_t(b[2], b[3]); *(u32x4*)p = w; }
__device__ __forceinline__ void st_bf16x4_t(bf16_t* p, f32x4 v) { u32x2 w; w.x = cvt_pk_bf16_t(v[0], v[1]); w.y = cvt_pk_bf16_t(v[2], v[3]); *(u32x2*)p = w; }
__device__ __forceinline__ u32x4 pk_bf16x8(f32x4 a, f32x4 b) { u32x4 w; w.x = cvt_pk_bf16(a[0], a[1]); w.y = cvt_pk_bf16(a[2], a[3]); w.z = cvt_pk_bf16(b[0], b[1]); w.w = cvt_pk_bf16(b[2], b[3]); return w; }
__device__ __forceinline__ unsigned dpp_ror8(unsigned v) { return __builtin_amdgcn_mov_dpp(v, 0x128, 0xF, 0xF, true); }
template <class F>
__device__ __forceinline__ void store_tile_lines(const f32x4 (&acc)[2][2][4][2], int brow, int bcol, int wr, int wc, int fr, int fq, bf16_t* base, size_t ld, F&& pack) {
    const bool lo = fr < 8; const int r = fr & 7, hc = (fr >> 3) * 32 + fq * 8;
#pragma unroll
    for (int ai = 0; ai < 2; ++ai)
#pragma unroll
        for (int m = 0; m < 4; ++m) {
            const int row0 = brow + ai * HALF + wr * 64 + m * 16, col0 = bcol + wc * 64;
            const u32x4 w0 = pack(row0 + fr, col0 + fq * 8, acc[ai][0][m][0], acc[ai][0][m][1]), w1 = pack(row0 + fr, col0 + 32 + fq * 8, acc[ai][1][m][0], acc[ai][1][m][1]);
            u32x4 x, y, a, b;
            x.x = lo ? w1.x : w0.x; x.y = lo ? w1.y : w0.y; x.z = lo ? w1.z : w0.z; x.w = lo ? w1.w : w0.w;
            y.x = dpp_ror8(x.x); y.y = dpp_ror8(x.y); y.z = dpp_ror8(x.z); y.w = dpp_ror8(x.w);
            a.x = lo ? w0.x : y.x; a.y = lo ? w0.y : y.y; a.z = lo ? w0.z : y.z; a.w = lo ? w0.w : y.w;
            b.x = lo ? y.x : w1.x; b.y = lo ? y.y : w1.y; b.z = lo ? y.z : w1.z; b.w = lo ? y.w : w1.w;
            *(u32x4*)(base + (size_t)(row0 + r) * ld + col0 + hc) = a;
            *(u32x4*)(base + (size_t)(row0 + 8 + r) * ld + col0 + hc) = b;
        }
}
__device__ __forceinline__ bool win_tile_a(int pn) { return pn < 2 || (pn >= 5 && pn < 17); }

struct EpiIn {
    const Params& p;
    __device__ __forceinline__ void apply(int row, int col, f32x4 v) const {
        const Params& P = p; const int pn = col >> 8, c = col & 255;
        if (pn < 2) st_bf16x4(P.Qb + (size_t)row * QD + col, v * QSCALE);
        else if (pn < 5) {
            if (pn != 2) st_bf16x4((pn == 3 ? P.SLCb : P.WINb) + (size_t)row * 256 + c, v);
            if (pn < 4) *(f32x4*)(P.out + (pn == 2 ? O_CMPS : O_SLCS) + (size_t)(row - MP) * 256 + c) = v;
            else *(f32x4*)(P.out + O_WINS + ((size_t)(row - MP) * WIN + (WIN - 1)) * 256 + c) = v;
        } else if (pn < 9) {
            f32x4 g; g[0] = gelu_fast(v[0]); g[1] = gelu_fast(v[1]); g[2] = gelu_fast(v[2]); g[3] = gelu_fast(v[3]);
            st_bf16x4((pn < 7 ? P.U : P.Vg) + (size_t)row * GMD + (col - (pn < 7 ? 1280 : 1792)), g);
        } else if (pn < 17) {
            f32x4 g; g[0] = sigmoid_fast(v[0]); g[1] = sigmoid_fast(v[1]); g[2] = sigmoid_fast(v[2]); g[3] = sigmoid_fast(v[3]);
            st_bf16x4((pn < 13 ? P.GA : P.GB) + (size_t)row * DM + (col - (pn < 13 ? 2304 : 3328)), g);
        } else if (c < 24) { f32x4 g; g[0] = sigmoid_fast(v[0]); g[1] = sigmoid_fast(v[1]); g[2] = sigmoid_fast(v[2]); g[3] = sigmoid_fast(v[3]); *(f32x4*)(P.GATE + (size_t)row * 32 + c) = g; }
    }
    __device__ __forceinline__ int lcol(int r) const { return win_tile_a(r >> 8) ? lcol_a(r) : r; }
    __device__ __forceinline__ void operator()(const f32x4 (&acc)[2][2][4][2], int brow, int bcol, int wr, int wc, int fr, int fq) const {
        const int pn = bcol >> 8;
        const Params& P = p;
        if (pn < 2) {
            store_tile_lines(acc, brow, bcol, wr, wc, fr, fq, P.Qb, QD, [&](int, int, f32x4 a, f32x4 b) { return pk_bf16x8(a * QSCALE, b * QSCALE); });
        } else if (pn < 5) {
            bf16_t* cp = pn == 2 ? P.CMPb : pn == 3 ? P.SLCb : P.WINb;
            for_each_frag(acc, brow, bcol, wr, wc, fr, fq, [&](int row, int col, f32x4 v) {
                const int c = col & 255;
                if (pn == 2) st_bf16x4(cp + (size_t)row * 256 + c, v);
                if (pn >= 3 && c < 128 && row < MP) {
                    st_bf16x4((pn == 3 ? P.SLCkF : P.WINkF) + ((size_t)(row >> 13) * NG + (c >> 6)) * SEQ * 64 + kfrag_off(row & (SEQ - 1), c & 63), v);
                }
                if (pn >= 3 && c >= 128 && row < MP) {
                    const int t = row & (SEQ - 1), dc = c - 128;
                    bf16_t* vt = (pn == 3 ? P.SLCvT : P.WINvT) + ((size_t)(row >> 13) * NG + (dc >> 6)) * SEQ * 64 + vfrag_off(t, dc & 63);
                    vt[0] = f2bf(v[0]); vt[8] = f2bf(v[1]); vt[16] = f2bf(v[2]); vt[24] = f2bf(v[3]);
                }
                if (pn < 4) {
                    if (row < MP) __builtin_nontemporal_store(v, (f32x4*)(P.out + (pn == 2 ? O_CMPP : O_SLCP) + (size_t)row * 256 + c));
                    else if (row < MP + NS) *(f32x4*)(P.out + (pn == 2 ? O_CMPS : O_SLCS) + (size_t)(row - MP) * 256 + c) = v;
                } else {
                    if (row < MP) { const int t = row & (SEQ - 1), b = row >> 13; if (t >= SEQ - WIN) *(f32x4*)(P.out + O_WINP + ((size_t)b * WIN + (t - (SEQ - WIN))) * 256 + c) = v; }
                    else if (row < MP + NS) *(f32x4*)(P.out + O_WINS + ((size_t)(row - MP) * WIN + (WIN - 1)) * 256 + c) = v;
                }
            });
        } else if (pn < 9) {
            bf16_t* dst = pn < 7 ? P.U : P.Vg; const int c0 = pn < 7 ? 1280 : 1792;
            store_tile_lines(acc, brow, bcol, wr, wc, fr, fq, dst - c0, GMD, [&](int, int, f32x4 a, f32x4 b) {
                f32x4 g, h; g[0] = gelu_fast(a[0]); g[1] = gelu_fast(a[1]); g[2] = gelu_fast(a[2]); g[3] = gelu_fast(a[3]); h[0] = gelu_fast(b[0]); h[1] = gelu_fast(b[1]); h[2] = gelu_fast(b[2]); h[3] = gelu_fast(b[3]);
                return pk_bf16x8(g, h); });
        } else if (pn < 17) {
            bf16_t* dst = pn < 13 ? P.GA : P.GB; const int c0 = pn < 13 ? 2304 : 3328;
            store_tile_lines(acc, brow, bcol, wr, wc, fr, fq, dst - c0, DM, [&](int, int, f32x4 a, f32x4 b) {
                f32x4 g, h; g[0] = sigmoid_fast(a[0]); g[1] = sigmoid_fast(a[1]); g[2] = sigmoid_fast(a[2]); g[3] = sigmoid_fast(a[3]); h[0] = sigmoid_fast(b[0]); h[1] = sigmoid_fast(b[1]); h[2] = sigmoid_fast(b[2]); h[3] = sigmoid_fast(b[3]);
                return pk_bf16x8(g, h); });
        } else {
            for_each_frag(acc, brow, bcol, wr, wc, fr, fq, [&](int row, int col, f32x4 v) {
                const int c = col & 255;
                if (c < 24) { f32x4 g; g[0] = sigmoid_fast(v[0]); g[1] = sigmoid_fast(v[1]); g[2] = sigmoid_fast(v[2]); g[3] = sigmoid_fast(v[3]); *(f32x4*)(P.GATE + (size_t)row * 32 + c) = g; } });
        }
    }
};
struct EpiBranch {
    const bf16_t* GA; const bf16_t* GB; bf16_t* Y1;
    __device__ __forceinline__ void mid(f32x4 (&acc)[2][2][4][2], int brow, int bcol, int wr, int wc, int fr, int fq) const {
#pragma unroll
        for (int ai = 0; ai < 2; ++ai)
#pragma unroll
            for (int m = 0; m < 4; ++m)
#pragma unroll
                for (int bj = 0; bj < 2; ++bj) {
                    const size_t o = (size_t)(brow + ai * HALF + wr * 64 + m * 16 + fr) * DM + bcol + wc * 64 + bj * 32 + fq * 8;
                    const u32x4 a = *(const u32x4*)(GA + o), b = *(const u32x4*)(GB + o);
                    f32x4& v = acc[ai][bj][m][0]; f32x4& w = acc[ai][bj][m][1];
                    v[0] *= bflo(a.x) * __builtin_amdgcn_rcpf(fmaxf(bflo(b.x), 1e-30f)); v[1] *= bfhi(a.x) * __builtin_amdgcn_rcpf(fmaxf(bfhi(b.x), 1e-30f));
                    v[2] *= bflo(a.y) * __builtin_amdgcn_rcpf(fmaxf(bflo(b.y), 1e-30f)); v[3] *= bfhi(a.y) * __builtin_amdgcn_rcpf(fmaxf(bfhi(b.y), 1e-30f));
                    w[0] *= bflo(a.z) * __builtin_amdgcn_rcpf(fmaxf(bflo(b.z), 1e-30f)); w[1] *= bfhi(a.z) * __builtin_amdgcn_rcpf(fmaxf(bfhi(b.z), 1e-30f));
                    w[2] *= bflo(a.w) * __builtin_amdgcn_rcpf(fmaxf(bflo(b.w), 1e-30f)); w[3] *= bfhi(a.w) * __builtin_amdgcn_rcpf(fmaxf(bfhi(b.w), 1e-30f));
                    asm volatile("" : "+v"(v), "+v"(w));
                    if (bj == 1) __builtin_amdgcn_sched_barrier(0);
                }
    }
    __device__ __forceinline__ int lcol(int r) const { return lcol_a(r); }
    __device__ __forceinline__ void operator()(const f32x4 (&acc)[2][2][4][2], int brow, int bcol, int wr, int wc, int fr, int fq) const {
        store_tile_lines(acc, brow, bcol, wr, wc, fr, fq, Y1, DM, [&](int row, int col, f32x4 v, f32x4 w) {
            const u32x4 b = *(const u32x4*)(GB + (size_t)row * DM + col);
            f32x4 o, q; o[0] = v[0] * fmaxf(bflo(b.x), 1e-30f); o[1] = v[1] * fmaxf(bfhi(b.x), 1e-30f); o[2] = v[2] * fmaxf(bflo(b.y), 1e-30f); o[3] = v[3] * fmaxf(bfhi(b.y), 1e-30f);
            q[0] = w[0] * fmaxf(bflo(b.z), 1e-30f); q[1] = w[1] * fmaxf(bfhi(b.z), 1e-30f); q[2] = w[2] * fmaxf(bflo(b.w), 1e-30f); q[3] = w[3] * fmaxf(bfhi(b.w), 1e-30f);
            return pk_bf16x8(o, q); });
    }
    __device__ __forceinline__ void apply2(int row, int col, f32x4 v1, f32x4 v2) const {
        const u32x2 a = *(const u32x2*)(GA + (size_t)row * DM + col), b = *(const u32x2*)(GB + (size_t)row * DM + col);
        f32x4 o; o[0] = v1[0] * bflo(a.x) + v2[0] * bflo(b.x); o[1] = v1[1] * bfhi(a.x) + v2[1] * bfhi(b.x); o[2] = v1[2] * bflo(a.y) + v2[2] * bflo(b.y); o[3] = v1[3] * bfhi(a.y) + v2[3] * bfhi(b.y);
        st_bf16x4(Y1 + (size_t)row * DM + col, o);
    }
};
struct EpiF32 {
    float* F; int ld;
    __device__ __forceinline__ void apply(int row, int col, f32x4 v) const { *(f32x4*)(F + (size_t)row * ld + col) = v; }
    __device__ __forceinline__ void operator()(const f32x4 (&acc)[2][2][4][2], int brow, int bcol, int wr, int wc, int fr, int fq) const {
        for_each_frag(acc, brow, bcol, wr, wc, fr, fq, [&](int row, int col, f32x4 v) { *(f32x4*)(F + (size_t)row * ld + col) = v; });
    }
};
struct EpiBf16 {
    bf16_t* O; int ld;
    __device__ __forceinline__ int lcol(int r) const { return lcol_a(r); }
    __device__ __forceinline__ void apply(int row, int col, f32x4 v) const { st_bf16x4(O + (size_t)row * ld + col, v); }
    __device__ __forceinline__ void operator()(const f32x4 (&acc)[2][2][4][2], int brow, int bcol, int wr, int wc, int fr, int fq) const {
        store_tile_lines(acc, brow, bcol, wr, wc, fr, fq, O, (size_t)ld, [&](int, int, f32x4 a, f32x4 b) { return pk_bf16x8(a, b); });
    }
};
struct EpiPart {
    bf16_t* PART;
    __device__ __forceinline__ void operator()(const f32x4 (&acc)[2][2][4][2], int brow, int bcol, int wr, int wc, int fr, int fq) const {
        const int z = bcol >> 20;
        store_tile_lines(acc, brow, 0, wr, wc, fr, fq, PART + (size_t)z * 256, (size_t)1024, [&](int, int, f32x4 a, f32x4 b) { return pk_bf16x8(a, b); });
    }
};
struct ZCmp { __device__ __forceinline__ size_t a(int z) const { return (size_t)z * 64; } __device__ __forceinline__ size_t b(int z) const { return (size_t)(z >> 1) * 256 * 1024; } };
struct EpiSwiGLU {
    bf16_t* ACT;
    __device__ __forceinline__ int lcol(int r) const { return lcol_s(r); }
    __device__ __forceinline__ void apply(int row, int col, f32x4 v) const { *(unsigned*)(ACT + (size_t)row * DFF + (col >> 1)) = cvt_pk_bf16(silu_fast(v[0]) * v[1], silu_fast(v[2]) * v[3]); }
    __device__ __forceinline__ void operator()(const f32x4 (&acc)[2][2][4][2], int brow, int bcol, int wr, int wc, int fr, int fq) const {
#pragma unroll
        for (int ai = 0; ai < 2; ++ai)
#pragma unroll
            for (int m = 0; m < 4; ++m) {
                const f32x4 &a = acc[ai][0][m][0], &b = acc[ai][0][m][1], &c = acc[ai][1][m][0], &d = acc[ai][1][m][1];
                u32x4 w;
                w.x = cvt_pk_bf16(silu_fast(a[0]) * a[1], silu_fast(a[2]) * a[3]); w.y = cvt_pk_bf16(silu_fast(b[0]) * b[1], silu_fast(b[2]) * b[3]);
                w.z = cvt_pk_bf16(silu_fast(c[0]) * c[1], silu_fast(c[2]) * c[3]); w.w = cvt_pk_bf16(silu_fast(d[0]) * d[1], silu_fast(d[2]) * d[3]);
                *(u32x4*)(ACT + (size_t)(brow + ai * HALF + wr * 64 + m * 16 + fr) * DFF + (bcol >> 1) + wc * 32 + fq * 8) = w;
            }
    }
};
struct EpiPleGate {
    const bf16_t* E; bf16_t* F;
    __device__ __forceinline__ void apply(int row, int col, f32x4 v) const {
        const u32x2 w = *(const u32x2*)(E + (size_t)row * DM + col);
        f32x4 o; o[0] = sigmoidf_(v[0]) * bflo(w.x); o[1] = sigmoidf_(v[1]) * bfhi(w.x); o[2] = sigmoidf_(v[2]) * bflo(w.y); o[3] = sigmoidf_(v[3]) * bfhi(w.y);
        st_bf16x4(F + (size_t)row * DM + col, o); }
    __device__ __forceinline__ int lcol(int r) const { return lcol_a(r); }
    __device__ __forceinline__ void operator()(const f32x4 (&acc)[2][2][4][2], int brow, int bcol, int wr, int wc, int fr, int fq) const {
        store_tile_lines(acc, brow, bcol, wr, wc, fr, fq, F, DM, [&](int row, int col, f32x4 a, f32x4 b) {
            const u32x4 w = *(const u32x4*)(E + (size_t)row * DM + col);
            f32x4 o, q; o[0] = sigmoidf_(a[0]) * bflo(w.x); o[1] = sigmoidf_(a[1]) * bfhi(w.x); o[2] = sigmoidf_(a[2]) * bflo(w.y); o[3] = sigmoidf_(a[3]) * bfhi(w.y);
            q[0] = sigmoidf_(b[0]) * bflo(w.z); q[1] = sigmoidf_(b[1]) * bfhi(w.z); q[2] = sigmoidf_(b[2]) * bflo(w.w); q[3] = sigmoidf_(b[3]) * bfhi(w.w);
            return pk_bf16x8(o, q); });
    }
};

template <class Epi>
__device__ __forceinline__ void gemm_skinny(const bf16_t* A  , int lda, const bf16_t* Bt, int K, int N, const Epi& E) {
    int tid = threadIdx.x; asm volatile("" : "+v"(tid));
    const int wid = __builtin_amdgcn_readfirstlane(tid >> 6), lane = tid & 63, c = lane & 15, G = lane >> 4;
    LAS f32x4* red = (LAS f32x4*)smem;
    const int nsteps = K / 32;
#pragma unroll 1
    for (int ct = blockIdx.x; ct < N / 16; ct += gridDim.x) {
        f32x4 acc0 = {0.f, 0.f, 0.f, 0.f}, acc1 = {0.f, 0.f, 0.f, 0.f};
        const bf16_t* bp = Bt + (size_t)(ct * 16 + c) * K + G * 8;
        const bf16_t* a0 = A + (size_t)c * lda + G * 8; const bf16_t* a1 = A + (size_t)(16 + c) * lda + G * 8;
#pragma unroll 4
        for (int kk = wid; kk < nsteps; kk += 8) {
            const bf16x8 bf = *(const bf16x8*)(bp + kk * 32), x0 = *(const bf16x8*)(a0 + kk * 32), x1 = *(const bf16x8*)(a1 + kk * 32);
            acc0 = mfma16(bf, x0, acc0); acc1 = mfma16(bf, x1, acc1);
        }
        __syncthreads();
        red[(wid * 2 + 0) * 64 + lane] = acc0; red[(wid * 2 + 1) * 64 + lane] = acc1;
        __syncthreads();
        if (tid < 128) {
            const int rt = tid >> 6;
            f32x4 v = red[rt * 64 + lane];
#pragma unroll
            for (int w = 1; w < 8; ++w) v = v + red[(w * 2 + rt) * 64 + lane];
            E.apply(MP + rt * 16 + c, E.lcol(ct * 16 + 4 * G), v);
        }
    }
    __syncthreads();
}

template <class Epi>
__device__ __forceinline__ void gemm_skinny2(const bf16_t* A  , int lda, const bf16_t* Bt, int K, int N, const Epi& E) {
    int tid = threadIdx.x; asm volatile("" : "+v"(tid));
    const int wid = __builtin_amdgcn_readfirstlane(tid >> 6), lane = tid & 63, c = lane & 15, G = lane >> 4;
    LAS f32x4* red = (LAS f32x4*)smem;
    const int hsteps = K / 64;
#pragma unroll 1
    for (int ct = blockIdx.x; ct < N / 16; ct += gridDim.x) {
        f32x4 acc[4] = {{0.f, 0.f, 0.f, 0.f}, {0.f, 0.f, 0.f, 0.f}, {0.f, 0.f, 0.f, 0.f}, {0.f, 0.f, 0.f, 0.f}};
        const bf16_t* bp = Bt + (size_t)(ct * 16 + c) * K + G * 8;
        const bf16_t* a0 = A + (size_t)c * lda + G * 8; const bf16_t* a1 = A + (size_t)(16 + c) * lda + G * 8;
#pragma unroll
        for (int h = 0; h < 2; ++h) {
#pragma unroll 2
            for (int kk = h * hsteps + wid; kk < (h + 1) * hsteps; kk += 8) {
                const bf16x8 bf = *(const bf16x8*)(bp + kk * 32), x0 = *(const bf16x8*)(a0 + kk * 32), x1 = *(const bf16x8*)(a1 + kk * 32);
                acc[h * 2] = mfma16(bf, x0, acc[h * 2]); acc[h * 2 + 1] = mfma16(bf, x1, acc[h * 2 + 1]);
            }
        }
        __syncthreads();
#pragma unroll
        for (int q = 0; q < 4; ++q) red[(wid * 4 + q) * 64 + lane] = acc[q];
        __syncthreads();
        if (tid < 128) {
            const int rt = tid >> 6;
            f32x4 v1 = red[rt * 64 + lane], v2 = red[(2 + rt) * 64 + lane];
#pragma unroll
            for (int w = 1; w < 8; ++w) { v1 = v1 + red[(w * 4 + rt) * 64 + lane]; v2 = v2 + red[(w * 4 + 2 + rt) * 64 + lane]; }
            E.apply2(MP + rt * 16 + c, E.lcol(ct * 16 + 4 * G), v1, v2);
        }
    }
    __syncthreads();
}

template <class Map>
__device__ __forceinline__ void transpose_tile(const float* W, int K, int N, bf16_t* Wt, int ldk, int kt, int ntile, Map map) {
    LAS float* tile = (LAS float*)smem;
    const int t = threadIdx.x;
    __syncthreads();
#pragma unroll
    for (int i = 0; i < 2; ++i) {
        const int k = (t >> 4) + 32 * i, n = (t & 15) * 4, gn = ntile * 64 + n;
        f32x4 v = (f32x4){0.f, 0.f, 0.f, 0.f};
        if (gn < N) v = *(const f32x4*)(W + (size_t)(kt * 64 + k) * N + gn);
        tile[k * 65 + n] = v[0]; tile[k * 65 + n + 1] = v[1]; tile[k * 65 + n + 2] = v[2]; tile[k * 65 + n + 3] = v[3];
    }
    __syncthreads();
    const int n = t >> 3, kc = (t & 7) * 8, gn = ntile * 64 + n;
    if (gn < N) {
        u32x4 w;
        w.x = cvt_pk_bf16(tile[(kc + 0) * 65 + n], tile[(kc + 1) * 65 + n]); w.y = cvt_pk_bf16(tile[(kc + 2) * 65 + n], tile[(kc + 3) * 65 + n]);
        w.z = cvt_pk_bf16(tile[(kc + 4) * 65 + n], tile[(kc + 5) * 65 + n]); w.w = cvt_pk_bf16(tile[(kc + 6) * 65 + n], tile[(kc + 7) * 65 + n]);
        *(u32x4*)(Wt + (size_t)map(gn) * ldk + kt * 64 + kc) = w;
    }
}
template <class Map>
__device__ __forceinline__ void transpose_all(const float* W, int K, int N, bf16_t* Wt, int ldk, Map map, int& base) {
    const int nkt = K / 64, nnt = (N + 63) / 64, ntl = nkt * nnt;
    for (int it = blockIdx.x; it < base + ntl; it += gridDim.x) {
        if (it < base) continue;
        const int l = it - base;
        transpose_tile(W, K, N, Wt, ldk, l / nnt, l % nnt, map);
    }
    base += ntl;
}
template <class Map>
__device__ __forceinline__ void transpose_all_sub(const float* W, int K, int N, bf16_t* Wt, int ldk, Map map, int& base) {
    const int nkt = K / 64, nnt = (N + 63) / 64, ntl = nkt * nnt, nb = gridDim.x - 32, me = blockIdx.x - 32;
    int first = base - (base % nb) + me; if (first < base) first += nb;
    for (int it = first; it < base + ntl; it += nb) { const int l = it - base; transpose_tile(W, K, N, Wt, ldk, l / nnt, l % nnt, map); }
    base += ntl;
}
__device__ __forceinline__ int map_win(int n) {
    if (n < 1280) return n;
    if (n < 1304) return 4352 + (n - 1280);
    if (n < 2328) return 1280 + (n - 1304);
    return 2304 + (n - 2328);
}

__device__ __forceinline__ float row_rstd(const f32x4 (&v)[4]) {
    float s = 0.f;
#pragma unroll
    for (int k = 0; k < 4; ++k) s += v[k][0] * v[k][0] + v[k][1] * v[k][1] + v[k][2] * v[k][2] + v[k][3] * v[k][3];
    s = wave_sum(s);
    return rsqrtf(s * (1.0f / DM) + EPS);
}
__device__ __forceinline__ const float* xrow_ptr(const Params& p, int row) {
    return row < MP ? p.x_prompt + (size_t)row * DM : p.x_sample + (size_t)(row - MP) * DM;
}

__device__ __forceinline__ void phase_prologue(const Params& p) {
    const int wid = threadIdx.x >> 6, lane = threadIdx.x & 63;
    const int gw = blockIdx.x * 8 + wid, nw = gridDim.x * 8;
    auto do_transposes = [&]() {
    int base = 0;
    transpose_all(p.w_in, DM, IND, p.WinT, DM, [](int n) { const int l = map_win(n); return win_tile_a(l >> 8) ? row_a(l) : l; }, base);
    for (int kv = 0; kv < 2; ++kv) for (int j = 0; j < 2; ++j)
        transpose_all((kv ? p.w1_v : p.w1_k) + (size_t)j * 1024 * 128, 1024, 128, p.W1T + (size_t)kv * 256 * 1024, 1024, [j](int n) { return inv_a(j * 128 + n); }, base);
    };
    do_transposes();
    __syncthreads();
    for (int i = blockIdx.x * 512 + threadIdx.x; i < (INP - IND) * DM / 8; i += gridDim.x * 512) ((u32x4*)(p.WinT + (size_t)IND * DM))[i] = (u32x4){0u, 0u, 0u, 0u};
    for (int row0 = gw * 2; row0 < MP + NS; row0 += nw * 2) {
        f32x4 v[2][4];
#pragma unroll
        for (int q = 0; q < 2; ++q) { const float* xr = xrow_ptr(p, row0 + q);
#pragma unroll
            for (int k = 0; k < 4; ++k) v[q][k] = *(const f32x4*)(xr + lane * 4 + k * 256); }
#pragma unroll
        for (int q = 0; q < 2; ++q) {
            const int row = row0 + q;
            u32x2* hd = (u32x2*)(p.H + (size_t)row * DM);
            const float r = row_rstd(v[q]);
#pragma unroll
            for (int k = 0; k < 4; ++k) { const f32x4 g = *(const f32x4*)(p.ln_mix_pre + lane * 4 + k * 256); const f32x4 o = v[q][k] * r * g; u32x2 w; w.x = cvt_pk_bf16(o[0], o[1]); w.y = cvt_pk_bf16(o[2], o[3]); hd[lane + k * 64] = w; }
            const float* pr = row < MP ? p.p_prompt + (size_t)row * PLE : p.p_sample + (size_t)(row - MP) * PLE;
            const f32x4 pv = *(const f32x4*)(pr + lane * 4);
            u32x2 w; w.x = cvt_pk_bf16(pv[0], pv[1]); w.y = cvt_pk_bf16(pv[2], pv[3]);
            ((u32x2*)(p.Pb + (size_t)row * PLE))[lane] = w;
        }
    }
    for (int i = blockIdx.x * 512 + threadIdx.x; i < 4 * 128 * 128; i += gridDim.x * 512) { const int t = (i >> 7) & 127, s = i & 127; p.GWb[i] = f2bf(s <= t ? p.gm_ws[i] : 0.f); }
    for (int i = blockIdx.x * 512 + threadIdx.x; i < 2 * 64 * 128; i += gridDim.x * 512) { const int kv = i >> 13, d = (i >> 7) & 63, h = i & 127; p.W2T[i] = f2bf((kv ? p.w2_v : p.w2_k)[h * 64 + d]); }
    if (gw < 256) {
        const int kv = gw >> 7, h = gw & 127;
        const float* pe = kv ? p.pe_v : p.pe_k; const float* w1 = kv ? p.w1_v : p.w1_k;
        float s = 0.f;
#pragma unroll 8
        for (int k = lane; k < 2048; k += 64) s += pe[k] * w1[(size_t)k * 128 + h];
        s = wave_sum(s);
        if (lane == 0) p.PEB[kv * 128 + h] = s;
    }
    const int cskip = gridDim.x > 64 ? 32 : 0;
    if ((int)blockIdx.x >= cskip)
    for (int i = (blockIdx.x - cskip) * 512 + threadIdx.x; i < NS * (WIN - 1) * 64; i += (gridDim.x - cskip) * 512) {
        const int b = i / ((WIN - 1) * 64), r = i % ((WIN - 1) * 64);
        ((f32x4*)(p.out + O_WINS + (size_t)b * WIN * 256))[r] = ((const f32x4*)(p.state_win + (size_t)b * WIN * 256 + 256))[r];
    }
}

__device__ __forceinline__ void phase_deferred_transposes(const Params& p) {
    if (blockIdx.x < 32) return;
    int base = 0;
    transpose_all_sub(p.w_br_nsa, QD, DM, p.WnT, DM, [](int n) { return row_a(n); }, base);
    transpose_all_sub(p.w_br_gm, GMD, DM, p.WnT + QD, DM, [](int n) { return row_a(n); }, base);
    transpose_all_sub(p.w_out, DM, DM, p.WoT, DM, [](int n) { return row_a(n); }, base);
    transpose_all_sub(p.w_gate, DM, DFF, p.WguT, DM, [](int n) { return row_s(n, 0); }, base);
    transpose_all_sub(p.w_up, DM, DFF, p.WguT, DM, [](int n) { return row_s(n, 1); }, base);
    transpose_all_sub(p.w_down, DFF, DM, p.WdT, DFF, [](int n) { return row_a(n); }, base);
    transpose_all_sub(p.w_ple_gate, DM, DM, p.WpgT, DM, [](int n) { return row_a(n); }, base);
    transpose_all_sub(p.w_ple, PLE, DM, p.WpT, PLE, [](int n) { return row_a(n); }, base);
    __syncthreads();
}
__device__ __forceinline__ void phase_gather(const Params& p) {
    int tid = threadIdx.x; asm volatile("" : "+v"(tid));
    const int wid = tid >> 6, lane = tid & 63;
    const int gw = (blockIdx.x >> 1) * 8 + wid, nw = (gridDim.x >> 1) * 8;
    const int cls = blockIdx.x & 1;
    auto ld8 = [&](int r8h, f32x4 (&a)[4], f32x4 (&cc)[4]) __attribute__((always_inline)) {
        const int r = (r8h * 2 + cls) * 8, b = r >> 14, pos = r & (PAST - 1), l5 = lane & 31, hrow = lane >> 5;
        const float* s = p.cache_cmp + ((size_t)p.page_table[b * NPG + (pos >> 7)] * PAGE + (pos & 127) + hrow) * 256 + l5 * 8;
#pragma unroll
        for (int k = 0; k < 4; ++k) { a[k] = *(const f32x4*)(s + (size_t)k * 512); cc[k] = *(const f32x4*)(s + (size_t)k * 512 + 4); }
    };
    auto st8 = [&](int r8h, const f32x4 (&a)[4], const f32x4 (&cc)[4]) __attribute__((always_inline)) {
        const int r = (r8h * 2 + cls) * 8, l5 = lane & 31, hrow = lane >> 5;
#pragma unroll
        for (int k = 0; k < 4; ++k) {
            u32x4 w; w.x = cvt_pk_bf16(a[k][0], a[k][1]); w.y = cvt_pk_bf16(a[k][2], a[k][3]); w.z = cvt_pk_bf16(cc[k][0], cc[k][1]); w.w = cvt_pk_bf16(cc[k][2], cc[k][3]);
            *(u32x4*)(p.CMPb + ((size_t)MP + r + 2 * k + hrow) * 256 + l5 * 8) = w;
        }
    };
#pragma unroll 1
    for (int r8h = gw; r8h < NS * PAST / 16; r8h += 2 * nw) {
        f32x4 a0[4], c0[4], a1[4], c1[4];
        const bool two = r8h + nw < NS * PAST / 16;
        ld8(r8h, a0, c0);
        if (two) ld8(r8h + nw, a1, c1);
        st8(r8h, a0, c0);
        if (two) st8(r8h + nw, a1, c1);
    }
}

__device__ __forceinline__ void phase_cmp_final(const Params& p) {
    const int wid = threadIdx.x >> 6, lane = threadIdx.x & 63;
    {
        const int c = lane & 15, G = lane >> 4;
        const int ngrp_p = NB * 4 * 32, ngrp_s = NS * 4 * 64;
#pragma unroll 1
        for (int it = blockIdx.x * 8 + wid; it < ngrp_p + ngrp_s; it += gridDim.x * 8) {
            const bool smp = it >= ngrp_p; const int l = smp ? it - ngrp_p : it;
            const int nch = smp ? 64 : 32, nc = smp ? NCS : NCP;
            const int ch = l % nch, z = (l / nch) & 3, seq = l / (nch * 4), kv = z >> 1, g = z & 1, n0 = ch * 16;
            const size_t r0 = smp ? (size_t)2048 + (size_t)seq * 1024 : (size_t)seq * 512;
            const int nr = n0 + c < nc ? n0 + c : nc - 1;
            const bf16_t* p0 = (const bf16_t*)p.PART + ((r0 + nr) * 4 + z) * 256;
            const bf16_t* p1 = (const bf16_t*)p.PART + ((r0 + nr + 1) * 4 + z) * 256 + 128;
            const float* pb = p.PEB + kv * 128;
            f32x4 acc[4] = {{0.f, 0.f, 0.f, 0.f}, {0.f, 0.f, 0.f, 0.f}, {0.f, 0.f, 0.f, 0.f}, {0.f, 0.f, 0.f, 0.f}};
#pragma unroll
            for (int ks = 0; ks < 4; ++ks) {
                const int h0 = 32 * ks + 8 * G;
                const u32x4 wa = *(const u32x4*)(p0 + h0), wb = *(const u32x4*)(p1 + h0);
                const f32x4 a0 = {bflo(wa.x), bfhi(wa.x), bflo(wa.y), bfhi(wa.y)}, a1 = {bflo(wa.z), bfhi(wa.z), bflo(wa.w), bfhi(wa.w)};
                const f32x4 b0 = {bflo(wb.x), bfhi(wb.x), bflo(wb.y), bfhi(wb.y)}, b1 = {bflo(wb.z), bfhi(wb.z), bflo(wb.w), bfhi(wb.w)};
                const f32x4 e0 = *(const f32x4*)(pb + h0), e1 = *(const f32x4*)(pb + h0 + 4);
                f32x4 x0 = a0 + b0 + e0, x1 = a1 + b1 + e1;
#pragma unroll
                for (int i = 0; i < 4; ++i) { x0[i] = siluf_(x0[i]); x1[i] = siluf_(x1[i]); }
                const bf16x8 A = pack_p(x0, x1);
#pragma unroll
                for (int nt = 0; nt < 4; ++nt) {
                    const bf16x8 B = *(const bf16x8*)(p.W2T + ((size_t)kv * 64 + nt * 16 + c) * 128 + h0);
                    acc[nt] = mfma16(A, B, acc[nt]);
                }
            }
#pragma unroll
            for (int nt = 0; nt < 4; ++nt) {
                const int d = nt * 16 + c;
#pragma unroll
                for (int i = 0; i < 4; ++i) {
                    const int n = n0 + 4 * G + i;
                    if (n < nc) {
                        if (smp) ((kv ? p.VCS : p.KCS) + (((size_t)seq * NG + g) * 1024 + n) * 64)[d] = acc[nt][i];
                        else if (kv == 0) p.KCb[((size_t)seq * NG + g) * 512 * 64 + kfrag_off(n, d)] = f2bf(acc[nt][i]);
                    }
                }
                if (!smp && kv == 1) {
                    f32x4 v = acc[nt];
#pragma unroll
                    for (int i = 0; i < 4; ++i) if (n0 + 4 * G + i >= nc) v[i] = 0.f;
                    st_bf16x4(p.VCT + ((size_t)seq * NG + g) * 512 * 64 + vfrag_off(n0 + 4 * G, d), v);
                }
            }
        }
    }
}

template <bool SAMPLE>
__device__ __forceinline__ void kv_row_ptr(const Params& p, int branch  , int b, int pos, int kv, int g, const bf16_t*& pb, const float*& pf) {
    const int off = kv * 128 + g * 64;
    if (!SAMPLE) { pf = nullptr; pb = (branch == 1 ? p.SLCb : p.WINb) + ((size_t)b * SEQ + pos) * 256 + off; }
    else if (pos >= PAST) { pf = nullptr; pb = (branch == 1 ? p.SLCb : p.WINb) + ((size_t)MP + b) * 256 + off; }
    else if (branch == 1) { pb = nullptr; pf = p.cache_slc + ((size_t)p.page_table[b * NPG + (pos >> 7)] * PAGE + (pos & 127)) * 256 + off; }
    else { pb = nullptr; pf = p.state_win + ((size_t)b * WIN + (pos - (PAST - WIN))) * 256 + off; }
}
__device__ __forceinline__ void dot4x64(const bf16_t* pb, const float* pf, const LAS float* qs_, float (&s)[4]) {
    s[0] = s[1] = s[2] = s[3] = 0.f;
    const LAS float* qs = qs_; asm volatile("" : "+v"(qs));
    if (pf) {
#pragma unroll 8
        for (int c = 0; c < 16; ++c) {
            const f32x4 kx = *(const f32x4*)(pf + c * 4);
#pragma unroll
            for (int h = 0; h < 4; ++h) { const f32x4 q = *(const LAS f32x4*)(qs + h * 64 + c * 4); s[h] += q[0] * kx[0] + q[1] * kx[1] + q[2] * kx[2] + q[3] * kx[3]; }
        }
    } else {
#pragma unroll 2
        for (int c = 0; c < 8; ++c) {
            const u32x4 w = *(const u32x4*)(pb + c * 8);
            const float k0 = bflo(w.x), k1 = bfhi(w.x), k2 = bflo(w.y), k3 = bfhi(w.y), k4 = bflo(w.z), k5 = bfhi(w.z), k6 = bflo(w.w), k7 = bfhi(w.w);
#pragma unroll
            for (int h = 0; h < 4; ++h) {
                const f32x4 qa = *(const LAS f32x4*)(qs + h * 64 + c * 8), qb = *(const LAS f32x4*)(qs + h * 64 + c * 8 + 4);
                s[h] += qa[0] * k0 + qa[1] * k1 + qa[2] * k2 + qa[3] * k3 + qb[0] * k4 + qb[1] * k5 + qb[2] * k6 + qb[3] * k7;
            }
        }
    }
}
template <bool SAMPLE>
__device__ __forceinline__ void attn_chunk(const Params& p, int branch, int b, int g, int t, int pos0, int lo, int hi,
                                           float (&m)[4], float (&l)[4], float (&o)[4], const LAS float* qs, LAS float* pbk, const LAS float* relb, int lane) {
    const int pos = pos0 + lane;
    const bool valid = pos >= lo && pos <= hi;
    float s[4] = {-1e30f, -1e30f, -1e30f, -1e30f};
    if (valid) {
        const bf16_t* pb; const float* pf; kv_row_ptr<SAMPLE>(p, branch, b, pos, 0, g, pb, pf);
        dot4x64(pb, pf, qs, s);
        const int bk = t5_bucket(t - pos);
#pragma unroll
        for (int h = 0; h < 4; ++h) s[h] += relb[bk * 8 + g * 4 + h];
    }
#pragma unroll
    for (int h = 0; h < 4; ++h) {
        const float mx = wave_max(s[h]);
        const float mn = fmaxf(m[h], mx);
        const float pr = valid ? ex2(s[h] - mn) : 0.f;
        const float sm = wave_sum(pr);
        const float al = ex2(m[h] - mn);
        l[h] = l[h] * al + sm; o[h] *= al; m[h] = mn;
        pbk[h * 64 + lane] = pr;
    }
    __builtin_amdgcn_wave_barrier();
    const int k0 = (lo > pos0 ? lo : pos0) - pos0, k1 = (hi < pos0 + 63 ? hi : pos0 + 63) - pos0;
    if (SAMPLE) {
        const int kend = (PAST - 1 - pos0) < k1 ? (PAST - 1 - pos0) : k1;
        if (kend >= k0) {
            const bf16_t* pb; const float* pf; kv_row_ptr<SAMPLE>(p, branch, b, pos0 + k0, 1, g, pb, pf);
            pf += lane;
#pragma unroll 16
            for (int k = k0; k <= kend; ++k) {
                const float v = pf[(size_t)(k - k0) * 256];
#pragma unroll
                for (int h = 0; h < 4; ++h) o[h] += pbk[h * 64 + k] * v;
            }
        }
        if (k1 > kend) {
            const bf16_t* pb; const float* pf; kv_row_ptr<SAMPLE>(p, branch, b, pos0 + k1, 1, g, pb, pf);
            const float v = bf2f(pb[lane]);
#pragma unroll
            for (int h = 0; h < 4; ++h) o[h] += pbk[h * 64 + k1] * v;
        }
    } else {
#pragma unroll 1
    for (int k = k0; k <= k1; ++k) {
        const bf16_t* pb; const float* pf; kv_row_ptr<SAMPLE>(p, branch, b, pos0 + k, 1, g, pb, pf);
        const float v = pf ? pf[lane] : bf2f(pb[lane]);
#pragma unroll
        for (int h = 0; h < 4; ++h) o[h] += pbk[h * 64 + k] * v;
    }
    }
    __builtin_amdgcn_wave_barrier();
}

constexpr int S_QS = 0, S_SC = 1024, S_PHS = S_SC + 4 * 1024 * 4, S_PBK = S_PHS + 1088 * 4, S_PART = S_PBK + 8 * 1024, S_RED = S_PART + 2 * 8 * 272 * 4, S_OCP = S_RED + 512,
              S_SEL = S_OCP + 2048, S_RELB = S_SEL + 64, ATTS_LDS = S_RELB + 1024;
__device__ __forceinline__ void attn_sample_item(const Params& p, int b, int g) {
    const int tid = threadIdx.x, wid = tid >> 6, lane = tid & 63;
    constexpr int t = PAST, NC = NCS, NSEL = 257, NJR = 5, qblk = PAST >> 6;
    const int row = MP + b;
    LAS unsigned char* L = (LAS unsigned char*)smem;
    LAS float* qs = (LAS float*)(L + S_QS); LAS float* sc = (LAS float*)(L + S_SC); LAS float* phs = (LAS float*)(L + S_PHS); LAS float* pbk = (LAS float*)(L + S_PBK) + wid * 256;
    LAS float* part = (LAS float*)(L + S_PART); LAS float* red = (LAS float*)(L + S_RED); LAS float* ocp = (LAS float*)(L + S_OCP); LAS int* sel = (LAS int*)(L + S_SEL);
    LAS float* relb = (LAS float*)(L + S_RELB);
    __syncthreads();
    if (tid < 256) { relb[tid] = p.rel_bias[tid] * LOG2E; qs[tid] = bf2f(p.Qb[(size_t)row * QD + g * 256 + tid]); }
    __syncthreads();
    const float* kc = p.KCS + ((size_t)b * NG + g) * 1024 * 64;
    const float* vc = p.VCS + ((size_t)b * NG + g) * 1024 * 64;
    {
        float mx[4] = {-1e30f, -1e30f, -1e30f, -1e30f};
#pragma unroll 1
        for (int r = wid; r < 16; r += 8) {
            const int n = r * 64 + lane;
            float s[4] = {-1e30f, -1e30f, -1e30f, -1e30f};
            if (n < NC) {
                dot4x64(nullptr, kc + (size_t)n * 64, qs, s);
                const int bk = t5_bucket(t - (16 * n + 31));
#pragma unroll
                for (int h = 0; h < 4; ++h) s[h] += relb[bk * 8 + g * 4 + h];
            }
#pragma unroll
            for (int h = 0; h < 4; ++h) { sc[h * 1024 + n] = s[h]; mx[h] = fmaxf(mx[h], s[h]); }
        }
#pragma unroll
        for (int h = 0; h < 4; ++h) { const float m = wave_max(mx[h]); if (lane == 0) red[wid * 4 + h] = m; }
    }
    __syncthreads();
    float gmx[4], inv[4];
#pragma unroll
    for (int h = 0; h < 4; ++h) { float m = red[h]; for (int w = 1; w < 8; ++w) m = fmaxf(m, red[w * 4 + h]); gmx[h] = m; }
    {
        float sum[4] = {0.f, 0.f, 0.f, 0.f};
#pragma unroll
        for (int k = 0; k < 2; ++k) { const int n = tid + 512 * k;
#pragma unroll
            for (int h = 0; h < 4; ++h) { const float e = n < NC ? ex2(sc[h * 1024 + n] - gmx[h]) : 0.f; sc[h * 1024 + n] = e; sum[h] += e; } }
#pragma unroll
        for (int h = 0; h < 4; ++h) { const float s = wave_sum(sum[h]); if (lane == 0) red[32 + wid * 4 + h] = s; }
    }
    __syncthreads();
#pragma unroll
    for (int h = 0; h < 4; ++h) { float s = 0.f; for (int w = 0; w < 8; ++w) s += red[32 + w * 4 + h]; inv[h] = s > 0.f ? 1.0f / s : 0.f; }
    for (int n = tid; n < 1088; n += 512) phs[n] = n < NC ? (sc[n] * inv[0] + sc[1024 + n] * inv[1]) + (sc[2048 + n] * inv[2] + sc[3072 + n] * inv[3]) : 0.f;
    {
        float a[4] = {0.f, 0.f, 0.f, 0.f};
#pragma unroll 16
        for (int n = wid; n < NC; n += 8) {
            const float v = vc[(size_t)n * 64 + lane];
#pragma unroll
            for (int h = 0; h < 4; ++h) a[h] += sc[h * 1024 + n] * v;
        }
#pragma unroll
        for (int h = 0; h < 4; ++h) part[(wid * 4 + h) * 68 + lane] = a[h] * inv[h];
    }
    __syncthreads();
    if (tid < 256) { float a = 0.f; for (int w = 0; w < 8; ++w) a += part[(w * 4 + (tid >> 6)) * 68 + (tid & 63)]; ocp[tid] = a; }
    __syncthreads();
    if (wid == 0) {
        unsigned long long key[NJR];
#pragma unroll
        for (int jr = 0; jr < NJR; ++jr) {
            const int j = jr * 64 + lane;
            key[jr] = 0ull;
            if (j >= 1 && j <= qblk - 2 && j < NSEL) {
                float im = 0.f;
#pragma unroll
                for (int n = 4 * j - 1; n <= 4 * j + 3; ++n) im += (n < NC) ? phs[n] : 0.f;
                key[jr] = ((unsigned long long)__float_as_uint(im) << 32) | (unsigned)(0xFFFF - j) | 0x10000ull;
            }
        }
        if (lane == 0) { sel[0] = 0; sel[1] = qblk - 1; sel[2] = qblk; }
#pragma unroll 1
        for (int it = 0; it < 13; ++it) {
            unsigned long long best = 0ull;
#pragma unroll
            for (int jr = 0; jr < NJR; ++jr) best = key[jr] > best ? key[jr] : best;
#pragma unroll
            for (int o = 32; o > 0; o >>= 1) { const unsigned long long ot = __shfl_xor(best, o); best = ot > best ? ot : best; }
            const int j = 0xFFFF - (int)(best & 0xFFFFull);
#pragma unroll
            for (int jr = 0; jr < NJR; ++jr) if (key[jr] == best) key[jr] = 0ull;
            if (lane == 0) sel[3 + it] = j;
        }
    }
    __syncthreads();
    {
        float ms[4] = {-1e30f, -1e30f, -1e30f, -1e30f}, ls[4] = {0.f, 0.f, 0.f, 0.f}, os[4] = {0.f, 0.f, 0.f, 0.f};
#pragma unroll 1
        for (int i = wid; i < 16; i += 8) attn_chunk<true>(p, 1, b, g, t, sel[i] * 64, 0, t, ms, ls, os, qs, pbk, relb, lane);
        float mw[4] = {-1e30f, -1e30f, -1e30f, -1e30f}, lw[4] = {0.f, 0.f, 0.f, 0.f}, ow[4] = {0.f, 0.f, 0.f, 0.f};
#pragma unroll 1
        for (int c = wid; c < 9; c += 8) attn_chunk<true>(p, 2, b, g, t, t - 63 - 64 * c, t - WIN, t, mw, lw, ow, qs, pbk, relb, lane);
#pragma unroll
        for (int h = 0; h < 4; ++h) {
            LAS float* ps = part + (wid * 4 + h) * 68; LAS float* pw = part + 8 * 272 + (wid * 4 + h) * 68;
            ps[lane] = os[h]; pw[lane] = ow[h];
            if (lane == 0) { ps[64] = ms[h]; ps[65] = ls[h]; pw[64] = mw[h]; pw[65] = lw[h]; }
        }
    }
    __syncthreads();
    if (tid < 256) {
        const int h = tid >> 6, d = tid & 63;
        float res[2];
#pragma unroll
        for (int br = 0; br < 2; ++br) {
            const LAS float* pp = part + br * 8 * 272 + h * 68;
            float m = -1e30f;
            for (int w = 0; w < 8; ++w) m = fmaxf(m, pp[w * 272 + 64]);
            float l = 0.f, o = 0.f;
            for (int w = 0; w < 8; ++w) { const float sc_ = ex2(pp[w * 272 + 64] - m); l += pp[w * 272 + 65] * sc_; o += pp[w * 272 + d] * sc_; }
            res[br] = o / l;
        }
        const float* gt = p.GATE + (size_t)row * 32 + (g * 4 + h) * 3;
        const float v = gt[0] * ocp[tid] + gt[1] * res[0] + gt[2] * res[1];
        p.OCAT[(size_t)row * DM + (g * 4 + h) * 64 + d] = f2bf(v);
    }
    __syncthreads();
}

constexpr int A_OST = 0, OST_LD = 68, A_LST = A_OST + 256 * OST_LD * 4, A_M0 = A_LST + 1024, A_MB = A_M0 + 1024, MB_LD = 132, A_MKN = A_MB + 64 * MB_LD,
              A_LIST = A_MKN + 256, A_CNT = A_LIST + 132 * 64, A_PK = A_CNT + 544, A_KN = A_PK + 400 * 4, A_T2 = A_KN + 512, A_NP = A_T2 + 132 * 8 * 4, A_QT = A_NP + 16, ATT2_LDS = A_QT + 64 * 512;
static_assert(ATT2_LDS <= GEMM_LDS && ATTS_LDS <= GEMM_LDS, "attention LDS");

__device__ __forceinline__ void qk64(const bf16_t* kb, int c, int G, const bf16x8 (&qB)[2], f32x4 (&s)[4]) {
#pragma unroll
    for (int kt = 0; kt < 4; ++kt) {
        const bf16_t* r = kb + (size_t)(16 * kt + c) * 256 + G * 8;
        const bf16x8 a0 = *(const bf16x8*)r, a1 = *(const bf16x8*)(r + 32);
        s[kt] = mfma16(a0, qB[0], (f32x4){0.f, 0.f, 0.f, 0.f}); s[kt] = mfma16(a1, qB[1], s[kt]);
    }
}
__device__ __forceinline__ void pv64(const bf16_t* vf, int key0, int lane, const f32x4 (&pr)[4], f32x4 (&o)[4]) {
#pragma unroll
    for (int ks = 0; ks < 2; ++ks) {
        const bf16x8 pB = pack_p(pr[2 * ks], pr[2 * ks + 1]);
#pragma unroll
        for (int dt = 0; dt < 4; ++dt) {
            const bf16x8 vA = *(const bf16x8*)(vf + ((size_t)(((key0 >> 5) + ks) * 4 + dt) * 64 + lane) * 8);
            o[dt] = mfma16(vA, pB, o[dt]);
        }
    }
}
__device__ __forceinline__ int qt_off(int qi, int hh, int k) { return (qi * 4 + hh) * 128 + ((k ^ (((qi & 3) << 1) | (hh >> 1))) << 4); }
__device__ __forceinline__ float grp_max(float v) {
    auto r = __builtin_amdgcn_permlane16_swap(__float_as_uint(v), __float_as_uint(v), false, false); v = fmaxf(__uint_as_float(r[0]), __uint_as_float(r[1]));
    r = __builtin_amdgcn_permlane32_swap(__float_as_uint(v), __float_as_uint(v), false, false); return fmaxf(__uint_as_float(r[0]), __uint_as_float(r[1]));
}
__device__ __forceinline__ float grp_sum(float v) {
    auto r = __builtin_amdgcn_permlane16_swap(__float_as_uint(v), __float_as_uint(v), false, false); v = __uint_as_float(r[0]) + __uint_as_float(r[1]);
    r = __builtin_amdgcn_permlane32_swap(__float_as_uint(v), __float_as_uint(v), false, false); return __uint_as_float(r[0]) + __uint_as_float(r[1]);
}
__device__ __forceinline__ int grp_min_i(int v) {
    auto r = __builtin_amdgcn_permlane16_swap((unsigned)v, (unsigned)v, false, false); v = (int)r[0] < (int)r[1] ? (int)r[0] : (int)r[1];
    r = __builtin_amdgcn_permlane32_swap((unsigned)v, (unsigned)v, false, false); return (int)r[0] < (int)r[1] ? (int)r[0] : (int)r[1];
}
__device__ __forceinline__ float dpp_x1(float v) { return __uint_as_float(__builtin_amdgcn_mov_dpp(__float_as_uint(v), 0xB1, 0xF, 0xF, true)); }
__device__ __forceinline__ float dpp_x2(float v) { return __uint_as_float(__builtin_amdgcn_mov_dpp(__float_as_uint(v), 0x4E, 0xF, 0xF, true)); }
__device__ __forceinline__ int dpp_x1i(int v) { return (int)__builtin_amdgcn_mov_dpp((unsigned)v, 0xB1, 0xF, 0xF, true); }
__device__ __forceinline__ int dpp_x2i(int v) { return (int)__builtin_amdgcn_mov_dpp((unsigned)v, 0x4E, 0xF, 0xF, true); }
__device__ __forceinline__ unsigned row_or_q(unsigned u) {
    u |= __builtin_amdgcn_mov_dpp(u, 0x124, 0xF, 0xF, true); u |= __builtin_amdgcn_mov_dpp(u, 0x128, 0xF, 0xF, true); return u;
}

__device__ __forceinline__ void attn_cmp(const Params& p, int b, int g, int t0, int lane_, LAS unsigned char* L, unsigned (&msk)[4]) {
    f32x4 oacc[4];
    int lane = lane_; asm volatile("" : "+v"(lane));
    const int c = lane & 15, G = lane >> 4, qs = c >> 2, hh = c & 3;
    const int qb = t0 >> 6, tc = t0 + qs;
    const size_t qrow = (size_t)b * SEQ + tc;
    const LAS float* T2 = (const LAS float*)(L + A_T2);
    const float b31 = T2[128 * 8 + g * 4 + hh];
    bf16x8 qB[2];
    qB[0] = *(const bf16x8*)(p.Qb + qrow * QD + (g * 4 + hh) * 64 + G * 8); qB[1] = *(const bf16x8*)(p.Qb + qrow * QD + (g * 4 + hh) * 64 + 32 + G * 8);
    const float* gate = p.GATE + qrow * 32 + (g * 4 + hh) * 3;
    msk[0] = msk[1] = msk[2] = msk[3] = 0u;
    {
        const int ncv_c = tc >= 31 ? ((tc - 31) >> 4) + 1 : 0;
        const int ncv_m = t0 + 3 >= 31 ? ((t0 + 3 - 31) >> 4) + 1 : 0;
        const int NT = (ncv_m + 15) >> 4;
        const int mt_far = t0 >= 399 ? (t0 - 399) / 256 + 1 : 0;
        const bf16_t* kcb = p.KCb + (size_t)(b * NG + g) * 512 * 64;
        f32x4 sc[32];
        float mxf = -1e30f, mxn = -1e30f;
        bf16x8 kbuf[2][4][2];
        auto ldkg = [&](int grp, bf16x8 (&kb)[4][2]) __attribute__((always_inline)) {
#pragma unroll
            for (int q = 0; q < 4; ++q) { const bf16_t* r = kcb + ((size_t)((grp * 4 + q) * 2) * 64 + lane) * 8; kb[q][0] = *(const bf16x8*)r; kb[q][1] = *(const bf16x8*)(r + 512); }
        };
        ldkg(0, kbuf[0]);
#pragma unroll
        for (int grp = 0; grp < 8; ++grp) {
            if (4 * grp < NT) {
                if (4 * (grp + 1) < NT) ldkg(grp + 1, kbuf[(grp + 1) & 1]);
                __builtin_amdgcn_sched_barrier(0);
#pragma unroll
                for (int q = 0; q < 4; ++q) {
                    const int mt = grp * 4 + q;
                    f32x4 s = mfma16(kbuf[grp & 1][q][0], qB[0], (f32x4){0.f, 0.f, 0.f, 0.f}); s = mfma16(kbuf[grp & 1][q][1], qB[1], s);
                    if (mt < mt_far) { mxf = fmaxf(mxf, fmaxf(fmaxf(s[0], s[1]), fmaxf(s[2], s[3]))); }
                    else {
#pragma unroll
                        for (int i = 0; i < 4; ++i) { const int n = 16 * mt + 4 * G + i; int dist = tc - (16 * n + 31); const bool ok = n < ncv_c; dist = dist < 0 ? 0 : (dist > 128 ? 128 : dist);
                            s[i] = ok ? s[i] + T2[dist * 8 + g * 4 + hh] : -1e30f; }
                        mxn = fmaxf(mxn, fmaxf(fmaxf(s[0], s[1]), fmaxf(s[2], s[3])));
                    }
                    sc[mt] = s;
                }
            } else {
#pragma unroll
                for (int q = 0; q < 4; ++q) sc[grp * 4 + q] = (f32x4){0.f, 0.f, 0.f, 0.f};
            }
        }
        const float mx = grp_max(fmaxf(mxf + b31, mxn));
        const float shf = mx - b31;
#pragma unroll
        for (int mt = 0; mt < 32; ++mt) if ((mt & ~3) < NT) {
            const float sh = mt < mt_far ? shf : mx;
#pragma unroll
            for (int i = 0; i < 4; ++i) sc[mt][i] = ex2(sc[mt][i] - sh);
        }
        const bf16_t* vct = p.VCT + (size_t)(b * NG + g) * 64 * 512;
        const bf16x8 ones = __builtin_bit_cast(bf16x8, (u32x4){0x3F803F80u, 0x3F803F80u, 0x3F803F80u, 0x3F803F80u});
        f32x4 oc[4] = {{0.f, 0.f, 0.f, 0.f}, {0.f, 0.f, 0.f, 0.f}, {0.f, 0.f, 0.f, 0.f}, {0.f, 0.f, 0.f, 0.f}};
        f32x4 rs = {0.f, 0.f, 0.f, 0.f};
        bf16x8 vbuf[2][2][4];
        auto ldvg = [&](int grp, bf16x8 (&vb)[2][4]) __attribute__((always_inline)) {
#pragma unroll
            for (int q = 0; q < 2; ++q)
#pragma unroll
                for (int dt = 0; dt < 4; ++dt) vb[q][dt] = *(const bf16x8*)(vct + ((size_t)((grp * 2 + q) * 4 + dt) * 64 + lane) * 8);
        };
        ldvg(0, vbuf[0]);
#pragma unroll
        for (int grp = 0; grp < 8; ++grp) if (4 * grp < NT) {
            if (4 * (grp + 1) < NT) ldvg(grp + 1, vbuf[(grp + 1) & 1]);
            __builtin_amdgcn_sched_barrier(0);
#pragma unroll
            for (int q = 0; q < 2; ++q) {
                const int k2 = grp * 2 + q;
                const bf16x8 pB = pack_p(sc[2 * k2], sc[2 * k2 + 1]);
                rs = mfma16(ones, pB, rs);
#pragma unroll
                for (int dt = 0; dt < 4; ++dt) oc[dt] = mfma16(vbuf[grp & 1][q][dt], pB, oc[dt]);
            }
        }
        const float inv = ncv_c > 0 ? __builtin_amdgcn_rcpf(rs[0]) : 0.f;
        if (qb <= 15) {
            msk[0] = (qb >= 31) ? 0xffffffffu : ((2u << qb) - 1u);
        } else {
            unsigned cand[8];
#pragma unroll
            for (int k = 0; k < 8; ++k) cand[k] = 0u;
            float prevB = 0.f;
#pragma unroll
            for (int mt = 0; mt < 32; ++mt) if (mt < NT) {
                const unsigned x3 = __float_as_uint(sc[mt][3]);
                const auto p16 = __builtin_amdgcn_permlane16_swap(x3, x3, false, false);
                const auto p32 = __builtin_amdgcn_permlane32_swap(p16[1], p16[1], false, false);
                const float r1 = G == 2 ? __uint_as_float(p32[0]) : __uint_as_float(p16[0]);
                float v = ((sc[mt][0] + sc[mt][1]) + (sc[mt][2] + sc[mt][3]) + (G == 0 ? prevB : r1)) * inv;
                prevB = __uint_as_float(p32[1]);
                v += dpp_x1(v); v += dpp_x2(v);
                const int j = 4 * mt + G;
                if ((mt & 3) == hh) cand[mt >> 2] = (j >= 1 && j <= qb - 2) ? ((__float_as_uint(v) & ~127u) | (unsigned)(127 - j)) : 0u;
            }
            auto setbit = [&](int j) { const unsigned bit = 1u << (j & 31); const int w = j >> 5; msk[0] |= w == 0 ? bit : 0u; msk[1] |= w == 1 ? bit : 0u; msk[2] |= w == 2 ? bit : 0u; msk[3] |= w == 3 ? bit : 0u; };
            setbit(0); setbit(qb); setbit(qb - 1);
#pragma unroll 1
            for (int it = 0; it < 13; ++it) {
                unsigned bv = cand[0];
#pragma unroll
                for (int k = 1; k < 8; ++k) bv = bv > cand[k] ? bv : cand[k];
                { unsigned o = __builtin_amdgcn_mov_dpp(bv, 0xB1, 0xF, 0xF, true); bv = o > bv ? o : bv; o = __builtin_amdgcn_mov_dpp(bv, 0x4E, 0xF, 0xF, true); bv = o > bv ? o : bv;
                  auto r = __builtin_amdgcn_permlane16_swap(bv, bv, false, false); bv = r[0] > r[1] ? r[0] : r[1]; r = __builtin_amdgcn_permlane32_swap(bv, bv, false, false); bv = r[0] > r[1] ? r[0] : r[1]; }
#pragma unroll
                for (int k = 0; k < 8; ++k) cand[k] = cand[k] == bv ? 0u : cand[k];
                setbit(127 - (int)(bv & 127u));
            }
        }
        const float g0 = gate[0] * inv;
#pragma unroll
        for (int dt = 0; dt < 4; ++dt) oacc[dt] = oc[dt] * g0;
    }
    bf16_t* orow = p.OCAT + qrow * DM + (g * 4 + hh) * 64 + 4 * G;
#pragma unroll
    for (int dt = 0; dt < 4; ++dt) st_bf16x4(orow + dt * 16, oacc[dt]);
}

struct PackSt { bf16x8 q0, q1; float m; f32x4 l4; f32x4 o[4]; };
__device__ __forceinline__ void attn_selwin_pair(const Params& p, int b, int g, int t0, int lane_, LAS unsigned char* L, const unsigned (&mskA)[4], const unsigned (&mskB)[4]) {
    int lane = lane_; asm volatile("" : "+v"(lane));
    const int c = lane & 15, G = lane >> 4, qs = c >> 2, hh = c & 3;
    const int qb = t0 >> 6;
    const LAS float* T2 = (const LAS float*)(L + A_T2);
    const float b31 = T2[128 * 8 + g * 4 + hh];
    const int tcA = t0 + qs, tcB = t0 + 4 + qs;
    const size_t qrowA = (size_t)b * SEQ + tcA;
    PackSt A, B;
    {
        const bf16_t* qa = p.Qb + qrowA * QD + (g * 4 + hh) * 64 + G * 8;
        A.q0 = *(const bf16x8*)qa; A.q1 = *(const bf16x8*)(qa + 32); B.q0 = *(const bf16x8*)(qa + 4 * QD); B.q1 = *(const bf16x8*)(qa + 4 * QD + 32);
    }
    auto reset = [&](PackSt& S) __attribute__((always_inline)) { S.m = -1e30f; S.l4 = (f32x4){0.f, 0.f, 0.f, 0.f};
#pragma unroll
        for (int dt = 0; dt < 4; ++dt) S.o[dt] = (f32x4){0.f, 0.f, 0.f, 0.f}; };
    const bf16x8 ones = __builtin_bit_cast(bf16x8, (u32x4){0x3F803F80u, 0x3F803F80u, 0x3F803F80u, 0x3F803F80u});
    auto finish = [&](PackSt& S, f32x4 (&s)[4], float cb, bool mine, const bf16x8 (&vf)[2][4]) __attribute__((always_inline)) {
        float cm = fmaxf(fmaxf(fmaxf(s[0][0], s[0][1]), fmaxf(s[0][2], s[0][3])), fmaxf(fmaxf(s[1][0], s[1][1]), fmaxf(s[1][2], s[1][3])));
        cm = fmaxf(cm, fmaxf(fmaxf(fmaxf(s[2][0], s[2][1]), fmaxf(s[2][2], s[2][3])), fmaxf(fmaxf(s[3][0], s[3][1]), fmaxf(s[3][2], s[3][3]))));
        cm = grp_max(mine ? cm + cb : -1e30f);
        const float mn = fmaxf(S.m, cm), al = ex2(S.m - mn);
        const float sh = (mine ? mn : 1e30f) - cb;
#pragma unroll
        for (int kt = 0; kt < 4; ++kt)
#pragma unroll
            for (int i = 0; i < 4; ++i) s[kt][i] = ex2(s[kt][i] - sh);
        S.m = mn;
        f32x4 rs = {0.f, 0.f, 0.f, 0.f};
#pragma unroll
        for (int dt = 0; dt < 4; ++dt) S.o[dt] = S.o[dt] * al;
#pragma unroll
        for (int ks = 0; ks < 2; ++ks) { const bf16x8 pB = pack_p(s[2 * ks], s[2 * ks + 1]);
            rs = mfma16(ones, pB, rs);
#pragma unroll
            for (int dt = 0; dt < 4; ++dt) S.o[dt] = mfma16(vf[ks][dt], pB, S.o[dt]); }
        S.l4[0] = S.l4[0] * al + rs[0];
    };
    auto addout = [&](PackSt& S, size_t qrow, int br) __attribute__((always_inline)) {
        const float gs = p.GATE[qrow * 32 + (g * 4 + hh) * 3 + br] * __builtin_amdgcn_rcpf(S.l4[0]);
        bf16_t* orow = p.OCAT + qrow * DM + (g * 4 + hh) * 64 + 4 * G;
#pragma unroll
        for (int dt = 0; dt < 4; ++dt) { const u32x2 w = *(const u32x2*)(orow + dt * 16); f32x4 pa; pa[0] = bflo(w.x); pa[1] = bfhi(w.x); pa[2] = bflo(w.y); pa[3] = bfhi(w.y);
            st_bf16x4(orow + dt * 16, pa + S.o[dt] * gs); }
    };
    {
        unsigned umA[4], umB[4], um[4];
#pragma unroll
        for (int w = 0; w < 4; ++w) {
            umA[w] = __builtin_amdgcn_readfirstlane(row_or_q(mskA[w]));
            umB[w] = __builtin_amdgcn_readfirstlane(row_or_q(mskB[w]));
            um[w] = umA[w] | umB[w];
        }
        reset(A); reset(B);
        const bf16_t* klane = p.SLCkF + (size_t)(b * NG + g) * SEQ * 64 + lane * 8;
        const bf16_t* vlane = p.SLCvT + (size_t)(b * NG + g) * SEQ * 64 + lane * 8;
        auto ldfr = [&](int j_, bf16x8 (&kf_)[4][2], bf16x8 (&vf_)[2][4]) __attribute__((always_inline)) {
            const bf16_t* kr = klane + (size_t)j_ * 4096; const bf16_t* vr = vlane + (size_t)j_ * 4096;
#pragma unroll
            for (int kt = 0; kt < 4; ++kt) { kf_[kt][0] = *(const bf16x8*)(kr + (kt * 2) * 512); kf_[kt][1] = *(const bf16x8*)(kr + (kt * 2 + 1) * 512); }
#pragma unroll
            for (int ks = 0; ks < 2; ++ks)
#pragma unroll
                for (int dt = 0; dt < 4; ++dt) vf_[ks][dt] = *(const bf16x8*)(vr + (ks * 4 + dt) * 512);
        };
        auto nextj = [&](int& j_) __attribute__((always_inline)) {
            int w = um[0] ? 0 : um[1] ? 1 : um[2] ? 2 : um[3] ? 3 : -1;
            if (w < 0) return false;
            const unsigned u = w == 0 ? um[0] : w == 1 ? um[1] : w == 2 ? um[2] : um[3];
            const int bpos = __builtin_ctz(u);
            j_ = w * 32 + bpos;
            const unsigned cl = ~(1u << bpos);
            if (w == 0) um[0] &= cl; else if (w == 1) um[1] &= cl; else if (w == 2) um[2] &= cl; else um[3] &= cl;
            return true;
        };
        auto packstep = [&](PackSt& S, const unsigned (&msk)[4], int tc, int j, const bf16x8 (&kf)[4][2], const bf16x8 (&vf)[2][4]) __attribute__((always_inline)) {
            const unsigned mw = (j >> 5) == 0 ? msk[0] : (j >> 5) == 1 ? msk[1] : (j >> 5) == 2 ? msk[2] : msk[3];
            const bool mine = (mw >> (j & 31)) & 1u;
            const bool farb = j <= qb - 3;
            f32x4 s[4];
#pragma unroll
            for (int kt = 0; kt < 4; ++kt) { s[kt] = mfma16(kf[kt][0], S.q0, (f32x4){0.f, 0.f, 0.f, 0.f}); s[kt] = mfma16(kf[kt][1], S.q1, s[kt]); }
            if (!farb) {
#pragma unroll
                for (int kt = 0; kt < 4; ++kt)
#pragma unroll
                    for (int i = 0; i < 4; ++i) { const int dist = tc - (j * 64 + 16 * kt + 4 * G + i); const int dd = dist < 0 ? 0 : (dist > 128 ? 128 : dist);
                        s[kt][i] = dist >= 0 ? s[kt][i] + T2[dd * 8 + g * 4 + hh] : -1e30f; }
            }
            finish(S, s, farb ? b31 : 0.f, mine, vf);
        };
        auto blockstep = [&](int j, const bf16x8 (&kf)[4][2], const bf16x8 (&vf)[2][4]) __attribute__((always_inline)) {
            const int w = j >> 5; const unsigned bit = 1u << (j & 31);
            const unsigned ua = w == 0 ? umA[0] : w == 1 ? umA[1] : w == 2 ? umA[2] : umA[3];
            const unsigned ub = w == 0 ? umB[0] : w == 1 ? umB[1] : w == 2 ? umB[2] : umB[3];
            if (ua & bit) packstep(A, mskA, tcA, j, kf, vf);
            if (ub & bit) packstep(B, mskB, tcB, j, kf, vf);
        };
        auto ldk = [&](int j_, bf16x8 (&kf_)[4][2]) __attribute__((always_inline)) {
            const bf16_t* kr = klane + (size_t)j_ * 4096;
#pragma unroll
            for (int kt = 0; kt < 4; ++kt) { kf_[kt][0] = *(const bf16x8*)(kr + (kt * 2) * 512); kf_[kt][1] = *(const bf16x8*)(kr + (kt * 2 + 1) * 512); }
        };
        auto ldv = [&](int j_, bf16x8 (&vf_)[2][4]) __attribute__((always_inline)) {
            const bf16_t* vr = vlane + (size_t)j_ * 4096;
#pragma unroll
            for (int ks = 0; ks < 2; ++ks)
#pragma unroll
                for (int dt = 0; dt < 4; ++dt) vf_[ks][dt] = *(const bf16x8*)(vr + (ks * 4 + dt) * 512);
        };
        bf16x8 kfA[4][2], kfB[4][2], vf[2][4];
        int j = 0; bool have = nextj(j);
        ldk(j, kfA);
#pragma unroll 1
        while (have) {
            int jn = j; bool haven = nextj(jn);
            ldv(j, vf); ldk(jn, kfB);
            __builtin_amdgcn_sched_barrier(0);
            blockstep(j, kfA, vf);
            if (!haven) break;
            j = jn; have = nextj(jn);
            ldv(j, vf); ldk(jn, kfA);
            __builtin_amdgcn_sched_barrier(0);
            blockstep(j, kfB, vf);
            j = jn;
        }
        addout(A, qrowA, 1); addout(B, qrowA + 4, 1);
    }
    {
        reset(A); reset(B);
        const int loA = t0 - WIN > 0 ? t0 - WIN : 0, hiA = t0 + 3, loB = t0 + 4 - WIN > 0 ? t0 + 4 - WIN : 0, hiB = t0 + 7;
        const bf16_t* klane = p.WINkF + (size_t)(b * NG + g) * SEQ * 64 + lane * 8;
        const bf16_t* vlane = p.WINvT + (size_t)(b * NG + g) * SEQ * 64 + lane * 8;
        auto ldfr = [&](int cb_, bf16x8 (&kf_)[4][2], bf16x8 (&vf_)[2][4]) __attribute__((always_inline)) {
            const bf16_t* kr = klane + (size_t)cb_ * 64; const bf16_t* vr = vlane + (size_t)cb_ * 64;
#pragma unroll
            for (int kt = 0; kt < 4; ++kt) { kf_[kt][0] = *(const bf16x8*)(kr + (kt * 2) * 512); kf_[kt][1] = *(const bf16x8*)(kr + (kt * 2 + 1) * 512); }
#pragma unroll
            for (int ks = 0; ks < 2; ++ks)
#pragma unroll
                for (int dt = 0; dt < 4; ++dt) vf_[ks][dt] = *(const bf16x8*)(vr + (ks * 4 + dt) * 512);
        };
        auto packstep = [&](PackSt& S, int tq0, int tc, int cb, const bf16x8 (&kf)[4][2], const bf16x8 (&vf)[2][4]) __attribute__((always_inline)) {
            const bool far = (cb + 63 <= tq0 - 128) && (cb >= tq0 + 3 - WIN);
            f32x4 s[4];
#pragma unroll
            for (int kt = 0; kt < 4; ++kt) { s[kt] = mfma16(kf[kt][0], S.q0, (f32x4){0.f, 0.f, 0.f, 0.f}); s[kt] = mfma16(kf[kt][1], S.q1, s[kt]); }
            if (!far) {
#pragma unroll
                for (int kt = 0; kt < 4; ++kt)
#pragma unroll
                    for (int i = 0; i < 4; ++i) { const int dist = tc - (cb + 16 * kt + 4 * G + i); const bool ok = dist >= 0 && dist <= WIN; const int dd = dist < 0 ? 0 : (dist > 128 ? 128 : dist);
                        s[kt][i] = ok ? s[kt][i] + T2[dd * 8 + g * 4 + hh] : -1e30f; }
            }
            finish(S, s, far ? b31 : 0.f, true, vf);
        };
        auto chunkstep = [&](int cb, const bf16x8 (&kf)[4][2], const bf16x8 (&vf)[2][4]) __attribute__((always_inline)) {
            if (cb <= hiA) packstep(A, t0, tcA, cb, kf, vf);
            if (cb + 63 >= loB) packstep(B, t0 + 4, tcB, cb, kf, vf);
        };
        auto ldk = [&](int cb_, bf16x8 (&kf_)[4][2]) __attribute__((always_inline)) {
            const bf16_t* kr = klane + (size_t)cb_ * 64;
#pragma unroll
            for (int kt = 0; kt < 4; ++kt) { kf_[kt][0] = *(const bf16x8*)(kr + (kt * 2) * 512); kf_[kt][1] = *(const bf16x8*)(kr + (kt * 2 + 1) * 512); }
        };
        auto ldv = [&](int cb_, bf16x8 (&vf_)[2][4]) __attribute__((always_inline)) {
            const bf16_t* vr = vlane + (size_t)cb_ * 64;
#pragma unroll
            for (int ks = 0; ks < 2; ++ks)
#pragma unroll
                for (int dt = 0; dt < 4; ++dt) vf_[ks][dt] = *(const bf16x8*)(vr + (ks * 4 + dt) * 512);
        };
        bf16x8 kfA[4][2], kfB[4][2], vf[2][4];
        int cb = loA & ~63;
        ldk(cb, kfA);
#pragma unroll 1
        for (;;) {
            ldv(cb, vf); ldk(cb + 64 <= hiB ? cb + 64 : cb, kfB);
            __builtin_amdgcn_sched_barrier(0);
            chunkstep(cb, kfA, vf);
            cb += 64; if (cb > hiB) break;
            ldv(cb, vf); ldk(cb + 64 <= hiB ? cb + 64 : cb, kfA);
            __builtin_amdgcn_sched_barrier(0);
            chunkstep(cb, kfB, vf);
            cb += 64; if (cb > hiB) break;
        }
        addout(A, qrowA, 2); addout(B, qrowA + 4, 2);
    }
}

__device__ __forceinline__ void phase_attn(const Params& p) {
    const int wid = threadIdx.x >> 6, lane = threadIdx.x & 63;
    { PROBE_BEGIN(3)
    if (blockIdx.x < NS * NG) attn_sample_item(p, blockIdx.x >> 1, blockIdx.x & 1);
    PROBE_END(3) }
    LAS unsigned char* L = (LAS unsigned char*)smem;
    for (int i = threadIdx.x; i < 129 * 8; i += 512) ((LAS float*)(L + A_T2))[i] = p.rel_bias[t5_bucket(i >> 3) * 8 + (i & 7)] * LOG2E;
    __syncthreads();
    {
        const int wid2 = __builtin_amdgcn_readfirstlane(threadIdx.x >> 6);
#pragma unroll 1
        for (;;) {
            __syncthreads();
            if (threadIdx.x == 0) ((LAS int*)(L + A_NP))[1] = (int)__hip_atomic_fetch_add(p.bar, 1u, __ATOMIC_RELAXED, __HIP_MEMORY_SCOPE_AGENT);
            __syncthreads();
            const int T = ((const LAS int*)(L + A_NP))[1];
            if (T >= NB * NG * (SEQ / 64)) break;
            const int bg = T & 7, qb = (SEQ / 64 - 1) - (T >> 3), t0 = qb * 64 + wid2 * 8;
            unsigned mA[4], mB[4];
            PROBE_BEGIN(6)
            attn_cmp(p, bg >> 1, bg & 1, t0, lane, L, mA);
            attn_cmp(p, bg >> 1, bg & 1, t0 + 4, lane, L, mB);
            PROBE_END(6)
            PROBE_BEGIN(7)
            attn_selwin_pair(p, bg >> 1, bg & 1, t0, lane, L, mA, mB);
            PROBE_END(7)
        }
    }
    __syncthreads();
}

constexpr int GM_LD = 136, GM_LDS = 128 * GM_LD * 2 + 1024;
__device__ __forceinline__ void phase_gmlp(const Params& p) {
    int tid = threadIdx.x; asm volatile("" : "+v"(tid));
    const int wid = __builtin_amdgcn_readfirstlane(tid >> 6), lane = tid & 63;
    LAS bf16_t* vnT = (LAS bf16_t*)smem;
    LAS float* mu = (LAS float*)(smem + 128 * GM_LD * 2);
    const int c = lane & 15, G = lane >> 4;
#pragma unroll 1
    for (int u = blockIdx.x; u < NB * 64; u += gridDim.x) {
        const int b = u >> 6, ch = u & 63; const size_t row0 = (size_t)b * SEQ + ch * 128;
        __syncthreads();
        for (int r = wid; r < 128; r += 8) {
            const u32x4 w = *(const u32x4*)(p.Vg + (row0 + r) * GMD + lane * 8);
            const float x[8] = {bflo(w.x), bfhi(w.x), bflo(w.y), bfhi(w.y), bflo(w.z), bfhi(w.z), bflo(w.w), bfhi(w.w)};
            float s = 0.f;
#pragma unroll
            for (int i = 0; i < 8; ++i) s += x[i];
            const float mean = wave_sum(s) * (1.0f / GMD);
            float q = 0.f;
#pragma unroll
            for (int i = 0; i < 8; ++i) q += (x[i] - mean) * (x[i] - mean);
            const float var = wave_sum(q) * (1.0f / GMD);
            if (lane == 0) { mu[r] = mean; mu[128 + r] = rsqrtf(var + EPS); }
        }
#pragma unroll 1
        for (int g = 0; g < 4; ++g) {
            __syncthreads();
#pragma unroll
            for (int k = 0; k < 4; ++k) {
                const int e = tid + 512 * k, s = e & 127, d0 = (e >> 7) * 8;
                const u32x4 w = *(const u32x4*)(p.Vg + (row0 + s) * GMD + g * 128 + d0);
                const float x[8] = {bflo(w.x), bfhi(w.x), bflo(w.y), bfhi(w.y), bflo(w.z), bfhi(w.z), bflo(w.w), bfhi(w.w)};
                const float m = mu[s], rs = mu[128 + s];
#pragma unroll
                for (int i = 0; i < 8; ++i) { const int cc = g * 128 + d0 + i; vnT[(d0 + i) * GM_LD + s] = f2bf((x[i] - m) * rs * p.gm_ln_g[cc] + p.gm_ln_b[cc]); }
            }
            __syncthreads();
            f32x4 acc[8];
#pragma unroll
            for (int dt = 0; dt < 8; ++dt) acc[dt] = (f32x4){0.f, 0.f, 0.f, 0.f};
            const bf16_t* wrow = p.GWb + ((size_t)g * 128 + 16 * wid + c) * 128 + 8 * G;
#pragma unroll 1
            for (int ks = 0; ks <= (wid >> 1); ++ks) {
                const bf16x8 B = *(const bf16x8*)(wrow + 32 * ks);
#pragma unroll
                for (int dt = 0; dt < 8; ++dt) {
                    const bf16x8 A = *(const LAS bf16x8*)(vnT + (dt * 16 + c) * GM_LD + 32 * ks + 8 * G);
                    acc[dt] = mfma16(A, B, acc[dt]);
                }
            }
            const int t = 16 * wid + c;
            const float bs = p.gm_bs[g * 128 + t];
#pragma unroll
            for (int dt = 0; dt < 8; ++dt) {
                const int d = dt * 16 + 4 * G;
                const u32x2 uw = *(const u32x2*)(p.U + (row0 + t) * GMD + g * 128 + d);
                f32x4 o; o[0] = bflo(uw.x) * (acc[dt][0] + bs); o[1] = bfhi(uw.x) * (acc[dt][1] + bs); o[2] = bflo(uw.y) * (acc[dt][2] + bs); o[3] = bfhi(uw.y) * (acc[dt][3] + bs);
                st_bf16x4(p.OCAT + (row0 + t) * DM + QD + g * 128 + d, o);
            }
        }
    }
    for (int it = blockIdx.x * 8 + wid; it < NS; it += gridDim.x * 8) {
        const size_t row = (size_t)MP + it;
        const u32x4 w = *(const u32x4*)(p.Vg + row * GMD + lane * 8);
        const float x[8] = {bflo(w.x), bfhi(w.x), bflo(w.y), bfhi(w.y), bflo(w.z), bfhi(w.z), bflo(w.w), bfhi(w.w)};
        float s = 0.f;
#pragma unroll
        for (int i = 0; i < 8; ++i) s += x[i];
        const float mean = wave_sum(s) * (1.0f / GMD);
        float q = 0.f;
#pragma unroll
        for (int i = 0; i < 8; ++i) q += (x[i] - mean) * (x[i] - mean);
        const float rs = rsqrtf(wave_sum(q) * (1.0f / GMD) + EPS);
#pragma unroll
        for (int i = 0; i < 8; ++i) {
            const int c = lane * 8 + i, g = c >> 7;
            const float v = (x[i] - mean) * rs * p.gm_ln_g[c] + p.gm_ln_b[c];
            p.out[O_GMV + (size_t)it * GMD + c] = v;
            const float a = p.gm_ws[(size_t)g * 128 * 128] * v + p.gm_bs[g * 128];
            p.OCAT[row * DM + QD + c] = f2bf(bf2f(p.U[row * GMD + c]) * a);
        }
    }
}

template <int MODE>
__device__ __forceinline__ void phase_norm(const Params& p) {
    int tid = threadIdx.x; asm volatile("" : "+v"(tid));
    const int wid = tid >> 6, lane = tid & 63;
    const float* gpost = MODE == 0 ? p.ln_mix_post : MODE == 1 ? p.ln_ffn_post : p.ln_ple_post;
    for (int row = blockIdx.x * 8 + wid; row < MP + NS; row += gridDim.x * 8) {
        const bf16_t* fr = (const bf16_t*)p.F + (size_t)row * DM;
        const bf16_t* xb = MODE == 1 ? (const bf16_t*)p.X1 + (size_t)row * DM : p.X2b + (size_t)row * DM;
        f32x4 f[4], x[4];
#pragma unroll
        for (int k = 0; k < 4; ++k) { const u32x2 w = *(const u32x2*)(fr + lane * 4 + k * 256); f[k][0] = bflo(w.x); f[k][1] = bfhi(w.x); f[k][2] = bflo(w.y); f[k][3] = bfhi(w.y);
            if (MODE == 0) x[k] = *(const f32x4*)(xrow_ptr(p, row) + lane * 4 + k * 256);
            else { const u32x2 v = *(const u32x2*)(xb + lane * 4 + k * 256); x[k][0] = bflo(v.x); x[k][1] = bfhi(v.x); x[k][2] = bflo(v.y); x[k][3] = bfhi(v.y); } }
        const float r = row_rstd(f);
#pragma unroll
        for (int k = 0; k < 4; ++k) { const f32x4 g = *(const f32x4*)(gpost + lane * 4 + k * 256); x[k] = x[k] + f[k] * r * g; }
        if (MODE == 0) {
            const float r2 = row_rstd(x);
#pragma unroll
            for (int k = 0; k < 4; ++k) {
                st_bf16x4((bf16_t*)p.X1 + (size_t)row * DM + lane * 4 + k * 256, x[k]);
                const f32x4 g = *(const f32x4*)(p.ln_ffn_pre + lane * 4 + k * 256); const f32x4 o = x[k] * r2 * g;
                st_bf16x4(p.H2 + (size_t)row * DM + lane * 4 + k * 256, o);
            }
        } else if (MODE == 1) {
#pragma unroll
            for (int k = 0; k < 4; ++k) st_bf16x4(p.X2b + (size_t)row * DM + lane * 4 + k * 256, x[k]);
        } else {
            float* yr = row < MP ? p.out + O_YP + (size_t)row * DM : p.out + O_YS + (size_t)(row - MP) * DM;
#pragma unroll
            for (int k = 0; k < 4; ++k) __builtin_nontemporal_store(x[k], (f32x4*)(yr + lane * 4 + k * 256));
        }
    }
}


#define XB_TMO      128
#define XB_XCNT(j)  (256  + 64 * (j))
#define XB_XSUB(j)  (1280 + 64 * (j))
#define XB_XGEN(j)  (2304 + 64 * (j))
#define XB_TOP      3328
#define XB_TOPGEN   3392
#define XCD_BAR_WORDS 3456
#define XB_SPIN_CAP (1u << 22)

__device__ __forceinline__ unsigned xb_ld(unsigned* p)              { return __hip_atomic_load(p, __ATOMIC_RELAXED, __HIP_MEMORY_SCOPE_AGENT); }
__device__ __forceinline__ unsigned xb_add(unsigned* p, unsigned v) { return __hip_atomic_fetch_add(p, v, __ATOMIC_RELAXED, __HIP_MEMORY_SCOPE_AGENT); }
__device__ __forceinline__ unsigned xb_xcc_id() { return (unsigned)__builtin_amdgcn_s_getreg((3 << 11) | 20) & 0xFu; }
#define XB_SPIN(cond, bar) do { unsigned _sp = 0; while (cond) { __builtin_amdgcn_s_sleep(1); \
    if ((++_sp & 255u) == 0u) { if (xb_ld(&(bar)[XB_TMO])) break; if (_sp > XB_SPIN_CAP) { atomicAdd(&(bar)[XB_TMO], 1u); break; } } } } while (0)

struct XcdBarrier {
    unsigned* bar; unsigned x;
    volatile LAS unsigned* st;
};

__device__ __forceinline__ XcdBarrier xcd_barrier_post(unsigned* bar, volatile LAS unsigned* st) {
    XcdBarrier b; b.bar = bar; b.x = xb_xcc_id(); b.st = st;
    if (threadIdx.x == 0) (void)xb_add(&bar[XB_XCNT(b.x)], 1u);
    return b;
}
__device__ __forceinline__ void xcd_barrier_complete(unsigned* bar, unsigned x, unsigned& nloc, unsigned& nx) {
    const unsigned G = gridDim.x * gridDim.y * gridDim.z;
    unsigned sum, cnt, mine, sp = 0u;
    for (;;) {
        sum = 0u; cnt = 0u; mine = 0u;
#pragma unroll
        for (unsigned j = 0; j < 16; ++j) { const unsigned c = xb_ld(&bar[XB_XCNT(j)]); sum += c; cnt += (c > 0u) ? 1u : 0u; mine = (j == x) ? c : mine; }
        if (sum == G) break;
        __builtin_amdgcn_s_sleep(1);
        if ((++sp & 255u) == 0u) { if (xb_ld(&bar[XB_TMO])) break; if (sp > XB_SPIN_CAP) { atomicAdd(&bar[XB_TMO], 1u); break; } }
    }
    nloc = mine > 0u ? mine : 1u; nx = cnt > 0u ? cnt : 1u;
}

__device__ __forceinline__ void xcd_barrier(const XcdBarrier& b) {
    asm volatile("s_waitcnt vmcnt(0)" ::: "memory");
    __syncthreads();
    if (threadIdx.x == 0) {
        unsigned* bar = b.bar;
        __builtin_amdgcn_s_waitcnt(0);
        unsigned nloc = b.st[0], nx = b.st[1];
        if (nloc == 0u) { xcd_barrier_complete(bar, b.x, nloc, nx); b.st[0] = nloc; b.st[1] = nx; }
        const unsigned old = xb_add(&bar[XB_XSUB(b.x)], 1u);
        const unsigned gen = old / nloc;
        if (old + 1u == (gen + 1u) * nloc) {
            __builtin_amdgcn_fence(__ATOMIC_RELEASE, "agent");
            asm volatile("s_waitcnt vmcnt(0)" ::: "memory");
            const unsigned og = xb_add(&bar[XB_TOP], 1u);
            const unsigned tg = og / nx;
            if (og + 1u == (tg + 1u) * nx) xb_add(&bar[XB_TOPGEN], 1u);
            else XB_SPIN(xb_ld(&bar[XB_TOPGEN]) == tg, bar);
            __builtin_amdgcn_fence(__ATOMIC_ACQUIRE, "agent");
            xb_add(&bar[XB_XGEN(b.x)], 1u);
            asm volatile("s_waitcnt vmcnt(0)" ::: "memory");
        } else {
            XB_SPIN(xb_ld(&bar[XB_XGEN(b.x)]) == gen, bar);
            __builtin_amdgcn_fence(__ATOMIC_ACQUIRE, "agent");
            asm volatile("s_waitcnt vmcnt(0)" ::: "memory");
        }
    }
    __syncthreads();
}

constexpr int NPHASE = 16;
constexpr int LDS_BYTES = GEMM_LDS;
static_assert(GM_LDS <= LDS_BYTES, "lds");
constexpr int NMT = MALL / BM;

constexpr int NMP = MP / BM;
template <int PH>
__device__ __forceinline__ void run_phase(const Params& p) {
    if (PH == 0) phase_prologue(p);
    if (PH == 1) { EpiIn e{p}; if (blockIdx.x & 1) phase_gather(p); gemm_phase(p.H, DM, p.WinT, DM, NMP, INP / BM, e); gemm_skinny(p.H + (size_t)MP * DM, DM, p.WinT, DM, INP, e); if (!(blockIdx.x & 1)) phase_gather(p); }
    if (PH == 2) { EpiPart e{(bf16_t*)p.PART}; gemm_phase(p.CMPb, 4096, p.W1T, 1024, (2048 + NS * 1024) / BM, 1, e, 4, ZCmp(), 256); phase_deferred_transposes(p); }
    if (PH == 3) phase_cmp_final(p);
    if (PH == 4) phase_attn(p);
    if (PH == 5) phase_gmlp(p);
    if (PH == 6) { EpiBranch e{p.GA, p.GB, p.Y1}; gemm_phase<EpiBranch, ZNone, true>(p.OCAT, DM, p.WnT, DM, NMP, DM / BM, e); gemm_skinny2(p.OCAT + (size_t)MP * DM, DM, p.WnT, DM, DM, e); }
    if (PH == 8) { EpiBf16 e{(bf16_t*)p.F, DM}; gemm_phase(p.Y1, DM, p.WoT, DM, NMP, DM / BM, e); gemm_skinny(p.Y1 + (size_t)MP * DM, DM, p.WoT, DM, DM, e); }
    if (PH == 9) phase_norm<0>(p);
    if (PH == 10) { EpiSwiGLU e{p.ACT}; gemm_phase(p.H2, DM, p.WguT, DM, NMP, 2 * DFF / BM, e); gemm_skinny(p.H2 + (size_t)MP * DM, DM, p.WguT, DM, 2 * DFF, e); }
    if (PH == 11) { EpiBf16 e{(bf16_t*)p.F, DM}; gemm_phase(p.ACT, DFF, p.WdT, DFF, NMP, DM / BM, e); gemm_skinny(p.ACT + (size_t)MP * DFF, DFF, p.WdT, DFF, DM, e); }
    if (PH == 12) phase_norm<1>(p);
    if (PH == 13) { EpiBf16 e{(bf16_t*)p.T, DM}; gemm_phase(p.Pb, PLE, p.WpT, PLE, NMP, DM / BM, e); gemm_skinny(p.Pb + (size_t)MP * PLE, PLE, p.WpT, PLE, DM, e); }
    if (PH == 14) { EpiPleGate e{(const bf16_t*)p.T, (bf16_t*)p.F}; gemm_phase(p.X2b, DM, p.WpgT, DM, NMP, DM / BM, e); gemm_skinny(p.X2b + (size_t)MP * DM, DM, p.WpgT, DM, DM, e); }
    if (PH == 15) phase_norm<2>(p);
}

#ifndef MK_MULTI
#define MK_MULTI 0
#endif
template <int PH>
__global__ void __launch_bounds__(512, 2) k_phase(Params p) { run_phase<PH>(p); }

__global__ void __launch_bounds__(512, 2) k_all(Params p) {
    volatile LAS unsigned* st = (volatile LAS unsigned*)((LAS unsigned char*)smem + LDS_BYTES);
    if (threadIdx.x < 12) st[threadIdx.x] = 0u;
    __syncthreads();
    XcdBarrier bar = xcd_barrier_post(p.bar, st);
#if PROBE_DUP == 100
    run_phase<0>(p);  xcd_barrier(bar);
#endif
#if PROBE_SPIN >= 100
    if (threadIdx.x == 0) PROBE_TS[3] = probe_now();
#define PROBE_STAMP(k) if (threadIdx.x == 0 && PROBE_SEG == (k)) PROBE_TS[2] = probe_now() - PROBE_TS[3];
#else
#define PROBE_STAMP(k)
#endif
    run_phase<0>(p);  xcd_barrier(bar);
    PROBE_STAMP(20)
    run_phase<1>(p);  xcd_barrier(bar);
    PROBE_STAMP(21)
    run_phase<2>(p);  xcd_barrier(bar);
#if PROBE_DUP == 100
    run_phase<3>(p);  xcd_barrier(bar);
#endif
    run_phase<3>(p);  xcd_barrier(bar);
    PROBE_STAMP(23)
#if PROBE_DUP == 104
    run_phase<4>(p);  xcd_barrier(bar);
#endif
    run_phase<4>(p);
#if PROBE_DUP == 100
    run_phase<5>(p);  xcd_barrier(bar);
#endif
    run_phase<5>(p);  xcd_barrier(bar);
    PROBE_STAMP(25)
    run_phase<6>(p);  xcd_barrier(bar);
    run_phase<8>(p);  xcd_barrier(bar);
    PROBE_STAMP(28)
    run_phase<9>(p);  xcd_barrier(bar);
    PROBE_STAMP(29)
    run_phase<10>(p); xcd_barrier(bar);
    PROBE_STAMP(30)
    run_phase<11>(p); xcd_barrier(bar);
    PROBE_STAMP(31)
    run_phase<12>(p);
    run_phase<13>(p); xcd_barrier(bar);
    run_phase<14>(p); xcd_barrier(bar);
    PROBE_STAMP(34)
    run_phase<15>(p);
#if PROBE_SPIN
    if (blockIdx.x == 0 && threadIdx.x == 0) {
        const unsigned long long d = PROBE_TS[2] * (PROBE_SPIN >= 100 ? PROBE_SPIN - 100 : PROBE_SPIN), t0 = probe_now();
        while (probe_now() - t0 < d) __builtin_amdgcn_s_sleep(8);
    }
#endif
}

static inline size_t al256(size_t x) { return (x + 255) & ~(size_t)255; }
template <int PH> static void launch_phase(const Params& p, int grid, hipStream_t s) {
    static bool attr = false;
    if (!attr) { (void)hipFuncSetAttribute((const void*)k_phase<PH>, hipFuncAttributeMaxDynamicSharedMemorySize, LDS_BYTES); attr = true; }
    k_phase<PH><<<grid, 512, LDS_BYTES, s>>>(p);
}
template <int PH> static void launch_all(const Params& p, int grid, hipStream_t s) {
    launch_phase<PH>(p, grid, s);
    if constexpr (PH + 1 < NPHASE) launch_all<PH + 1>(p, grid, s);
}

extern "C" void kernel_launch(void* const* d_in, const int* in_sizes, int n_in, void* d_out, int out_size, void* d_ws, size_t ws_size, hipStream_t stream) {
    Params p{};
    p.x_prompt = (const float*)d_in[0]; p.x_sample = (const float*)d_in[1]; p.cache_cmp = (const float*)d_in[2]; p.cache_slc = (const float*)d_in[3];
    p.state_win = (const float*)d_in[4]; p.page_table = (const int*)d_in[5]; p.p_prompt = (const float*)d_in[6]; p.p_sample = (const float*)d_in[7];
    p.rel_bias = (const float*)d_in[8]; p.ln_mix_pre = (const float*)d_in[9]; p.w_in = (const float*)d_in[10];
    p.pe_k = (const float*)d_in[11]; p.w1_k = (const float*)d_in[12]; p.w2_k = (const float*)d_in[13];
    p.pe_v = (const float*)d_in[14]; p.w1_v = (const float*)d_in[15]; p.w2_v = (const float*)d_in[16];
    p.gm_ln_g = (const float*)d_in[17]; p.gm_ln_b = (const float*)d_in[18]; p.gm_ws = (const float*)d_in[19]; p.gm_bs = (const float*)d_in[20];
    p.w_br_nsa = (const float*)d_in[21]; p.w_br_gm = (const float*)d_in[22]; p.w_out = (const float*)d_in[23];
    p.ln_mix_post = (const float*)d_in[24]; p.ln_ffn_pre = (const float*)d_in[25]; p.w_gate = (const float*)d_in[26]; p.w_up = (const float*)d_in[27];
    p.w_down = (const float*)d_in[28]; p.ln_ffn_post = (const float*)d_in[29]; p.w_ple = (const float*)d_in[30]; p.w_ple_gate = (const float*)d_in[31];
    p.ln_ple_post = (const float*)d_in[32];
    p.out = (float*)d_out;
    unsigned char* w = (unsigned char*)d_ws; size_t off = 0;
    auto take = [&](size_t bytes) { void* r = w + off; off = al256(off + bytes); return r; };
    p.bar = (unsigned*)take(16384);
    p.WinT = (bf16_t*)take((size_t)INP * DM * 2); p.WnT = (bf16_t*)take((size_t)DM * DM * 2); p.WgT = nullptr;
    p.WoT = (bf16_t*)take((size_t)DM * DM * 2); p.WguT = (bf16_t*)take((size_t)2 * DFF * DM * 2); p.WdT = (bf16_t*)take((size_t)DM * DFF * 2);
    p.WpgT = (bf16_t*)take((size_t)DM * DM * 2); p.WpT = (bf16_t*)take((size_t)DM * PLE * 2); p.W1T = (bf16_t*)take((size_t)2 * 256 * 1024 * 2);
    p.H = (bf16_t*)take((size_t)MALL * DM * 2); p.Qb = (bf16_t*)take((size_t)MALL * QD * 2);
    p.CMPb = (bf16_t*)take(((size_t)MP + (size_t)NS * PAST) * 256 * 2); p.SLCb = (bf16_t*)take((size_t)MALL * 256 * 2); p.WINb = (bf16_t*)take((size_t)MALL * 256 * 2);
    p.U = (bf16_t*)take((size_t)MALL * GMD * 2); p.Vg = (bf16_t*)take((size_t)MALL * GMD * 2);
    p.GA = (bf16_t*)take((size_t)MALL * DM * 2); p.GB = (bf16_t*)take((size_t)MALL * DM * 2);
    p.GATE = (float*)take((size_t)MALL * 32 * 4);
    p.PART = (float*)take((size_t)(2048 + NS * 1024) * 4 * 256 * 4); p.PEB = (float*)take(256 * 4);
    p.KCP = (float*)take((size_t)NB * NG * 512 * 64 * 4); p.VCP = (float*)take((size_t)NB * NG * 512 * 64 * 4);
    p.KCS = (float*)take((size_t)NS * NG * 1024 * 64 * 4); p.VCS = (float*)take((size_t)NS * NG * 1024 * 64 * 4); p.KN = (float*)take(NB * NG * 128 * 4);
    p.KCb = (bf16_t*)take((size_t)NB * NG * 512 * 64 * 2); p.VCT = (bf16_t*)take((size_t)NB * NG * 64 * 512 * 2);
    p.SLCvT = (bf16_t*)take((size_t)NB * NG * 64 * SEQ * 2); p.WINvT = (bf16_t*)take((size_t)NB * NG * 64 * SEQ * 2);
    p.GWb = (bf16_t*)take(4 * 128 * 128 * 2); p.W2T = (bf16_t*)take(2 * 64 * 128 * 2);
    p.SLCkF = (bf16_t*)take((size_t)NB * NG * 64 * SEQ * 2); p.WINkF = (bf16_t*)take((size_t)NB * NG * 64 * SEQ * 2);
    p.OCAT = (bf16_t*)take((size_t)MALL * DM * 2); p.T = (float*)take((size_t)MALL * DM * 4); p.Y1 = (bf16_t*)take((size_t)MALL * DM * 2);
    p.F = (float*)take((size_t)MALL * DM * 4); p.X1 = (float*)take((size_t)MALL * DM * 4); p.H2 = (bf16_t*)take((size_t)MALL * DM * 2);
    p.ACT = (bf16_t*)take((size_t)MALL * DFF * 2); p.X2 = (float*)take((size_t)MALL * DM * 4); p.X2b = (bf16_t*)take((size_t)MALL * DM * 2);
    p.Pb = (bf16_t*)take((size_t)MALL * PLE * 2);
    if (off > ws_size) { fprintf(stderr, "workspace too small: need %zu have %zu\n", off, ws_size); return; }
#if MK_MULTI
    launch_all<0>(p, 256, stream);
#else
    constexpr size_t kDynLds = LDS_BYTES + 48;
    static int grid = 0;
    if (!grid) {
        int dev = 0, cus = 0, per_cu = 0;
        (void)hipGetDevice(&dev);
        (void)hipDeviceGetAttribute(&cus, hipDeviceAttributeMultiprocessorCount, dev);
        (void)hipFuncSetAttribute((const void*)k_all, hipFuncAttributeMaxDynamicSharedMemorySize, (int)kDynLds);
        (void)hipOccupancyMaxActiveBlocksPerMultiprocessor(&per_cu, (const void*)k_all, 512, kDynLds);
        grid = cus * (per_cu < 1 ? per_cu : 1);
        if (grid <= 0) { fprintf(stderr, "k_all: occupancy query says %d blocks per CU\n", per_cu); grid = 0; return; }
    }
    (void)hipMemsetAsync(p.bar, 0, XCD_BAR_WORDS * sizeof(unsigned), stream);
    k_all<<<grid, 512, kDynLds, stream>>>(p);
#endif
}
```

```cpp
#include <hip/hip_runtime.h>
#include <stdint.h>
#include <cstdio>

typedef unsigned short bf16_t;
typedef short bf16x8 __attribute__((ext_vector_type(8)));
typedef float f32x4 __attribute__((ext_vector_type(4)));
typedef float f32x2 __attribute__((ext_vector_type(2)));
typedef unsigned u32x4 __attribute__((ext_vector_type(4)));
typedef unsigned u32x2 __attribute__((ext_vector_type(2)));
#define LAS __attribute__((address_space(3)))

constexpr int DM = 1024, NB = 4, SEQ = 8192, MP = NB * SEQ, NS = 32, MALL = MP + 256, PAST = 16384, PAGE = 128, NPG = 128;
constexpr int NH = 8, NG = 2, HPG = 4, DH = 64, QD = 512, WIN = 512, GMD = 512, DFF = 2816, PLE = 256, IND = 4376, INP = 4608;
constexpr int NCP = 511, NCS = 1023;
constexpr float EPS = 1e-6f;
constexpr float LOG2E = 1.4426950408889634f, QSCALE = 0.125f * LOG2E;
constexpr long O_YP = 0, O_YS = 33554432, O_CMPP = 33587200, O_SLCP = 41975808, O_WINP = 50364416, O_CMPS = 50888704,
               O_SLCS = 50896896, O_WINS = 50905088, O_GMV = 55099392;

struct Params {
    const float *x_prompt, *x_sample, *cache_cmp, *cache_slc, *state_win; const int* page_table;
    const float *p_prompt, *p_sample, *rel_bias, *ln_mix_pre, *w_in, *pe_k, *w1_k, *w2_k, *pe_v, *w1_v, *w2_v;
    const float *gm_ln_g, *gm_ln_b, *gm_ws, *gm_bs, *w_br_nsa, *w_br_gm, *w_out, *ln_mix_post, *ln_ffn_pre;
    const float *w_gate, *w_up, *w_down, *ln_ffn_post, *w_ple, *w_ple_gate, *ln_ple_post;
    float* out;
    unsigned* bar;
    bf16_t *WinT, *WnT, *WgT, *WoT, *WguT, *WdT, *WpgT, *WpT, *W1T;
    bf16_t *H, *Qb, *CMPb, *SLCb, *WINb, *U, *Vg, *GA, *GB;
    float* GATE;
    float *PART, *PEB, *KCP, *VCP, *KCS, *VCS, *KN;
    bf16_t *KCb, *VCT, *SLCvT, *WINvT, *SLCkF, *WINkF, *GWb, *W2T;
    bf16_t* OCAT; float* T; bf16_t* Y1; float* F; float* X1; bf16_t* H2; bf16_t* ACT; float* X2; bf16_t* X2b; bf16_t* Pb;
};

typedef __bf16 bf16v2_t __attribute__((ext_vector_type(2)));
__device__ __forceinline__ unsigned cvt_pk_bf16(float lo, float hi) { const f32x2 v = {lo, hi}; return __builtin_bit_cast(unsigned, __builtin_convertvector(v, bf16v2_t)); }
__device__ __forceinline__ unsigned cvt_pk_bf16_t(float lo, float hi) { unsigned r; asm volatile("s_nop 1\n\tv_cvt_pk_bf16_f32 %0, %1, %2" : "=v"(r) : "v"(lo), "v"(hi)); return r; }
__device__ __forceinline__ bf16_t f2bf(float f) { return (bf16_t)(cvt_pk_bf16(f, 0.f) & 0xffffu); }
__device__ __forceinline__ float bf2f(bf16_t h) { return __uint_as_float(((unsigned)h) << 16); }
__device__ __forceinline__ float bflo(unsigned w) { return __uint_as_float(w << 16); }
__device__ __forceinline__ float bfhi(unsigned w) { return __uint_as_float(w & 0xffff0000u); }
__device__ __forceinline__ float ex2(float x) { return __builtin_amdgcn_exp2f(x); }
__device__ __forceinline__ float sigmoidf_(float x) { return __builtin_amdgcn_rcpf(1.0f + __builtin_amdgcn_exp2f(x * -1.4426950408889634f)); }
__device__ __forceinline__ float siluf_(float x) { return x * sigmoidf_(x); }
__device__ __forceinline__ float sigmoid_fast(float x) { return __builtin_amdgcn_rcpf(1.0f + __builtin_amdgcn_exp2f(x * -1.4426950408889634f)); }
__device__ __forceinline__ float gelu_fast(float x) {
    const float t = x * (-2.0f * 0.7978845608028654f * 1.4426950408889634f) * (1.0f + 0.044715f * x * x);
    return x * __builtin_amdgcn_rcpf(1.0f + __builtin_amdgcn_exp2f(t));
}
__device__ __forceinline__ float silu_fast(float x) { return x * __builtin_amdgcn_rcpf(1.0f + __builtin_amdgcn_exp2f(x * -1.4426950408889634f)); }
__device__ __forceinline__ float geluf_(float x) {
    const float u = 0.7978845608028654f * (x + 0.044715f * x * x * x);
    const float e = __expf(2.0f * u);
    const float th = 1.0f - 2.0f / (e + 1.0f);
    return 0.5f * x * (1.0f + th);
}
__device__ __forceinline__ float wave_sum(float v) {
#pragma unroll
    for (int o = 32; o > 0; o >>= 1) v += __shfl_xor(v, o);
    return v;
}
__device__ __forceinline__ float wave_max(float v) {
#pragma unroll
    for (int o = 32; o > 0; o >>= 1) v = fmaxf(v, __shfl_xor(v, o));
    return v;
}
__device__ __forceinline__ int t5_bucket(int d) {
    if (d < 16) return d;
    if (d >= 128) return 31;
    const int b = 16 + (int)(__logf((float)d * (1.0f / 16.0f)) * (16.0f / 2.0794415416798357f));
    return b < 31 ? b : 31;
}

extern __shared__ __attribute__((aligned(16))) unsigned char smem[];
#ifndef PROBE_DUP
#define PROBE_DUP 0
#endif
#define PROBE_LDS_OFF 131072
#ifndef PROBE_SPIN
#define PROBE_SPIN 0
#endif
#ifndef PROBE_SEG
#define PROBE_SEG 5
#endif
__device__ __forceinline__ unsigned long long probe_now() { unsigned long long t; asm volatile("s_memrealtime %0\n\ts_waitcnt lgkmcnt(0)" : "=s"(t) :: "memory"); return t; }
#define PROBE_TS ((volatile LAS unsigned long long*)((LAS unsigned char*)smem + PROBE_LDS_OFF + 16))
#if PROBE_SPIN
#define PROBE_BEGIN(seg) unsigned long long pb_##seg = 0; if (PROBE_SEG == seg && threadIdx.x == 0) pb_##seg = probe_now();
#define PROBE_END(seg) if (PROBE_SEG == seg && threadIdx.x == 0) { PROBE_TS[2] = PROBE_TS[2] + (probe_now() - pb_##seg); }
#else
#define PROBE_BEGIN(seg)
#define PROBE_END(seg)
#endif

constexpr int BM = 256, BK = 64, HALF = 128, HT = HALF * BK, GEMM_LDS = 8 * HT * 2;
__device__ __forceinline__ int lds_byte(int r, int c) { const int st = (r >> 4) * 2 + (c >> 5), rr = r & 15, cc = c & 31, ob = rr * 64 + cc * 2; return st * 1024 + (ob ^ (((ob >> 9) & 1) << 5)); }
__device__ __forceinline__ void stage_rc(int b, int& R, int& C) { const int st = b / 1024, sb = b % 1024, swz = sb ^ (((sb >> 9) & 1) << 5); R = (st >> 1) * 16 + swz / 64; C = (st & 1) * 32 + (swz % 64) / 2; }

constexpr int HTB = HALF * BK * 2;
template <class F>
__device__ __forceinline__ void for_each_frag(const f32x4 (&acc)[2][2][4][2], int brow, int bcol, int wr, int wc, int fr, int fq, F&& f) {
#pragma unroll
    for (int ai = 0; ai < 2; ++ai)
#pragma unroll
        for (int m = 0; m < 4; ++m)
#pragma unroll
            for (int bj = 0; bj < 2; ++bj)
#pragma unroll
                for (int n = 0; n < 2; ++n)
                    f(brow + ai * HALF + wr * 64 + m * 16 + fr, bcol + bj * HALF + wc * 32 + n * 16 + fq * 4, acc[ai][bj][m][n]);
}

__host__ __device__ __forceinline__ int inv_a(int ca) { return ((ca >> 5) & 1) * 128 + (ca >> 6) * 32 + ((ca >> 2) & 1) * 16 + ((ca >> 3) & 3) * 4 + (ca & 3); }
__host__ __device__ __forceinline__ int row_a(int n) { return (n & ~255) + inv_a(n & 255); }
__host__ __device__ __forceinline__ int inv_s(int o, int s) { return ((o >> 2) & 1) * 128 + (o >> 5) * 32 + ((o >> 1) & 1) * 16 + ((o >> 3) & 3) * 4 + (o & 1) * 2 + s; }
__host__ __device__ __forceinline__ int row_s(int n, int s) { return (n >> 7) * 256 + inv_s(n & 127, s); }
__host__ __device__ __forceinline__ int lcol_a(int r) { const int cg = r & 255; return (r & ~255) + ((cg >> 5) & 3) * 64 + (cg >> 7) * 32 + ((cg >> 2) & 3) * 8 + ((cg >> 4) & 1) * 4; }
__host__ __device__ __forceinline__ int lcol_s(int r) { const int cg = r & 255; return (r & ~255) + 2 * (((cg >> 5) & 3) * 32 + ((cg >> 2) & 3) * 8 + (cg >> 7) * 4 + ((cg >> 4) & 1) * 2); }
template <class F>
__device__ __forceinline__ void for_each_frag8(const f32x4 (&acc)[2][2][4][2], int brow, int bcol, int wr, int wc, int fr, int fq, F&& f) {
#pragma unroll
    for (int ai = 0; ai < 2; ++ai)
#pragma unroll
        for (int m = 0; m < 4; ++m)
#pragma unroll
            for (int bj = 0; bj < 2; ++bj)
                f(brow + ai * HALF + wr * 64 + m * 16 + fr, bcol + wc * 64 + bj * 32 + fq * 8, acc[ai][bj][m][0], acc[ai][bj][m][1]);
}

struct ZNone { __device__ __forceinline__ size_t a(int) const { return 0; } __device__ __forceinline__ size_t b(int) const { return 0; } };
template <class Epi, class ZMap = ZNone, bool HAS_MID = false>
__device__ __forceinline__ void gemm_phase(const bf16_t* A, int lda, const bf16_t* Bt, int K, int nM, int nN, const Epi& E, int nZ = 1, ZMap zm = ZMap(), int kstepA_el = BK) {
    LAS unsigned char* lds = (LAS unsigned char*)smem;
    int tid = threadIdx.x; asm volatile("" : "+v"(tid));
    const int wid = __builtin_amdgcn_readfirstlane(tid >> 6), lane = tid & 63, wr = wid >> 2, wc = wid & 3, fr = lane & 15, fq = lane >> 4;
    const int nt = K / BK, nmn = nM * nN, nu = nmn * nZ, G = gridDim.x;
    int u = blockIdx.x;
    if (u >= nu) return;
    unsigned voffA[2], voffB[2];
#pragma unroll
    for (int i = 0; i < 2; ++i) { int R, C; stage_rc(tid * 16 + i * 8192, R, C); voffA[i] = (unsigned)(R * lda + C) * 2u; voffB[i] = (unsigned)(R * K + C) * 2u; }
    const size_t kstep = (size_t)(BK * 2), kstepA = (size_t)kstepA_el * 2;
    const size_t hstepA = (size_t)HALF * lda * 2, hstepB = (size_t)HALF * K * 2, tstepA = 2 * hstepA, tstepB = 2 * hstepB;
    const unsigned ldsw = (unsigned)wid * 1024u;
    const int aoff = lds_byte(wr * 64 + fr, fq * 8), boff = lds_byte(wc * 32 + fr, fq * 8);
#define PG8_SA(b, h) (((b) * 2 + (h)) * HTB)
#define PG8_SB(b, h) ((4 + (b) * 2 + (h)) * HTB)
#define PG8_STAGE(bufoff, gbase, voff) do { _Pragma("unroll") for (int _i = 0; _i < 2; ++_i) \
        __builtin_amdgcn_global_load_lds((const unsigned*)((const char*)(gbase) + (voff)[_i]), (LAS unsigned*)(lds + (bufoff) + ldsw + _i * 8192), 16, 0, 0); } while (0)
#define PG8_LDA(dst, b, h) do { _Pragma("unroll") for (int m = 0; m < 4; ++m) _Pragma("unroll") for (int k = 0; k < 2; ++k) dst[m][k] = *(const LAS bf16x8*)(lds + PG8_SA(b, h) + aoff + m * 2048 + k * 1024); } while (0)
#define PG8_LDB(dst, b, h) do { _Pragma("unroll") for (int n = 0; n < 2; ++n) _Pragma("unroll") for (int k = 0; k < 2; ++k) dst[n][k] = *(const LAS bf16x8*)(lds + PG8_SB(b, h) + boff + n * 2048 + k * 1024); } while (0)
#define PG8_MMA(ai, bj, At, Bt_) do { __builtin_amdgcn_s_setprio(1); _Pragma("unroll") for (int m = 0; m < 4; ++m) _Pragma("unroll") for (int n = 0; n < 2; ++n) _Pragma("unroll") for (int k = 0; k < 2; ++k) \
        acc[ai][bj][m][n] = __builtin_amdgcn_mfma_f32_16x16x32_bf16(Bt_[n][k], At[m][k], acc[ai][bj][m][n], 0, 0, 0); __builtin_amdgcn_s_setprio(0); } while (0)
#define PG8_WAIT_V(n) asm volatile("s_waitcnt vmcnt(" #n ")" ::: "memory")
#define PG8_WAIT_L(n) asm volatile("s_waitcnt lgkmcnt(" #n ")" ::: "memory")
#define PG8_BAR __builtin_amdgcn_s_barrier()
#define PG8_SCHED __builtin_amdgcn_sched_barrier(0)
    f32x4 acc[2][2][4][2];
#pragma unroll
    for (int a = 0; a < 2; ++a)
#pragma unroll
        for (int b = 0; b < 2; ++b)
#pragma unroll
            for (int m = 0; m < 4; ++m)
#pragma unroll
                for (int n = 0; n < 2; ++n) acc[a][b][m][n] = (f32x4){0.f, 0.f, 0.f, 0.f};
    bf16x8 At[4][2], B0[2][2], B1[2][2];
    auto unit_of = [&](int uu, int& z_, int& pm_, int& pn_) {
        if (nZ == 1) {
            int wg = uu; { const int q = nu / 8, r = nu % 8, xcd = wg % 8, off = wg / 8; wg = (xcd < r ? xcd * (q + 1) : r * (q + 1) + (xcd - r) * q) + off; }
            const int nig = 8 * nN, gid = wg / nig, fm = gid * 8, gsz = (nM - fm) < 8 ? (nM - fm) : 8;
            z_ = 0; pm_ = fm + ((wg % nig) % gsz); pn_ = (wg % nig) / gsz;
        } else { z_ = uu / nmn; pm_ = (uu - z_ * nmn) / nN; pn_ = (uu - z_ * nmn) - pm_ * nN; }
    };
    int z, pm, pn; unit_of(u, z, pm, pn);
    const char* cA = (const char*)(A + zm.a(z)) + (size_t)pm * tstepA; const char* cB = (const char*)(Bt + zm.b(z)) + (size_t)pn * tstepB;
    PG8_STAGE(PG8_SB(0, 0), cB, voffB); PG8_STAGE(PG8_SA(0, 0), cA, voffA); PG8_STAGE(PG8_SB(0, 1), cB + hstepB, voffB); PG8_STAGE(PG8_SA(0, 1), cA + hstepA, voffA);
    if (wr == 1) PG8_BAR;
    PG8_WAIT_V(4); PG8_BAR;
    PG8_STAGE(PG8_SB(1, 0), cB + kstep, voffB); PG8_STAGE(PG8_SA(1, 0), cA + kstepA, voffA); PG8_STAGE(PG8_SB(1, 1), cB + hstepB + kstep, voffB);
    PG8_WAIT_V(6); PG8_BAR;
    for (;;) {
        const int un = u + G; const bool has_next = un < nu;
        int nz = z, npm = pm, npn = pn; if (has_next) unit_of(un, nz, npm, npn);
        const char* nA = (const char*)(A + zm.a(nz)) + (size_t)npm * tstepA; const char* nB = (const char*)(Bt + zm.b(nz)) + (size_t)npn * tstepB;
        auto kiter = [&](int t) {
            const bool last = (t == nt - 2);
            const bool bnd = last || (HAS_MID && t == (nt >> 1) - 2);
            const char* a1 = cA + (size_t)(t + 1) * kstepA;
            const char* a2 = last ? nA : cA + (size_t)(t + 2) * kstepA; const char* b2 = last ? nB : cB + (size_t)(t + 2) * kstep;
            const char* a3 = a2 + kstepA; const char* b3 = b2 + kstep;
            PG8_LDB(B0, 0, 0); PG8_SCHED; PG8_LDA(At, 0, 0); PG8_STAGE(PG8_SA(1, 1), a1 + hstepA, voffA);
            PG8_WAIT_L(8); PG8_BAR; PG8_WAIT_L(0); PG8_MMA(0, 0, At, B0); PG8_BAR; PG8_SCHED;
            PG8_LDB(B1, 0, 1); PG8_STAGE(PG8_SB(0, 0), b2, voffB);
            PG8_BAR; PG8_WAIT_L(0); PG8_MMA(0, 1, At, B1); PG8_BAR;
            PG8_LDA(At, 0, 1); PG8_STAGE(PG8_SA(0, 0), a2, voffA);
            PG8_BAR; PG8_WAIT_L(0); PG8_MMA(1, 0, At, B0); PG8_BAR; PG8_SCHED;
            PG8_STAGE(PG8_SB(0, 1), b2 + hstepB, voffB);
            PG8_WAIT_V(6); PG8_BAR; PG8_MMA(1, 1, At, B1); PG8_BAR;
            PG8_LDB(B0, 1, 0); PG8_SCHED; PG8_LDA(At, 1, 0); PG8_STAGE(PG8_SA(0, 1), a2 + hstepA, voffA);
            PG8_WAIT_L(8); PG8_BAR; PG8_WAIT_L(0); PG8_MMA(0, 0, At, B0); PG8_BAR; PG8_SCHED;
            PG8_LDB(B1, 1, 1); PG8_STAGE(PG8_SB(1, 0), b3, voffB);
            PG8_BAR; PG8_WAIT_L(0); PG8_MMA(0, 1, At, B1); PG8_BAR;
            PG8_LDA(At, 1, 1); PG8_STAGE(PG8_SA(1, 0), a3, voffA);
            PG8_BAR; PG8_WAIT_L(0); PG8_MMA(1, 0, At, B0); PG8_BAR; PG8_SCHED;
            PG8_STAGE(PG8_SB(1, 1), b3 + hstepB, voffB);
            PG8_WAIT_V(6); PG8_BAR; PG8_MMA(1, 1, At, B1);
            if (!(bnd && wr == 1)) PG8_BAR;
        };
        if constexpr (HAS_MID) {
            for (int t = 0; t < (nt >> 1); t += 2) kiter(t);
            { int pmo = pm, pno = pn; asm volatile("" : "+s"(pmo), "+s"(pno));
              E.mid(acc, pmo * BM, pno * BM, wr, wc, fr, fq); }
            PG8_SCHED; PG8_BAR; if (wr == 1) PG8_BAR;
            for (int t = nt >> 1; t < nt; t += 2) kiter(t);
        } else {
            for (int t = 0; t < nt; t += 2) kiter(t);
        }
        { int pmo = pm, pno = pn; asm volatile("" : "+s"(pmo), "+s"(pno));
          E(acc, pmo * BM, pno * BM + (z << 20), wr, wc, fr, fq); }
        PG8_SCHED; PG8_BAR;
        if (!has_next) break;
        if (wr == 1) PG8_BAR;
#pragma unroll
        for (int a = 0; a < 2; ++a)
#pragma unroll
            for (int b = 0; b < 2; ++b)
#pragma unroll
                for (int m = 0; m < 4; ++m)
#pragma unroll
                    for (int n = 0; n < 2; ++n) acc[a][b][m][n] = (f32x4){0.f, 0.f, 0.f, 0.f};
        u = un; z = nz; pm = npm; pn = npn; cA = nA; cB = nB;
    }
    PG8_WAIT_V(0);
    PG8_BAR;
#undef PG8_SA
#undef PG8_SB
#undef PG8_STAGE
#undef PG8_LDA
#undef PG8_LDB
#undef PG8_MMA
#undef PG8_WAIT_V
#undef PG8_WAIT_L
#undef PG8_BAR
#undef PG8_SCHED
}

__device__ __forceinline__ f32x4 mfma16(bf16x8 a, bf16x8 b, f32x4 c) { return __builtin_amdgcn_mfma_f32_16x16x32_bf16(a, b, c, 0, 0, 0); }
__device__ __forceinline__ bf16x8 pack_p(const f32x4& a, const f32x4& b) {
    u32x4 w; w.x = cvt_pk_bf16(a[0], a[1]); w.y = cvt_pk_bf16(a[2], a[3]); w.z = cvt_pk_bf16(b[0], b[1]); w.w = cvt_pk_bf16(b[2], b[3]);
    return __builtin_bit_cast(bf16x8, w);
}
__device__ __forceinline__ size_t kfrag_off(int key, int d) { return ((size_t)((key >> 4) * 2 + (d >> 5)) * 64 + ((d >> 3) & 3) * 16 + (key & 15)) * 8 + (d & 7); }
__device__ __forceinline__ size_t vfrag_off(int key, int d) {
    return ((size_t)((key >> 5) * 4 + (d >> 4)) * 64 + ((key >> 2) & 3) * 16 + (d & 15)) * 8 + ((key >> 4) & 1) * 4 + (key & 3);
}
__device__ __forceinline__ void st_bf16x4(bf16_t* p, f32x4 v) { u32x2 w; w.x = cvt_pk_bf16(v[0], v[1]); w.y = cvt_pk_bf16(v[2], v[3]); *(u32x2*)p = w; }
__device__ __forceinline__ void st_bf16x8(bf16_t* p, f32x4 a, f32x4 b) { u32x4 w; w.x = cvt_pk_bf16(a[0], a[1]); w.y = cvt_pk_bf16(a[2], a[3]); w.z = cvt_pk_bf16(b[0], b[1]); w.w = cvt_pk_bf16(b[2], b[3]); *(u32x4*)p = w; }
__device__ __forceinline__ void st_bf16x8_t(bf16_t* p, f32x4 a, f32x4 b) { u32x4 w; w.x = cvt_pk_bf16_t(a[0], a[1]); w.y = cvt_pk_bf16_t(a[2], a[3]); w.z = cvt_pk_bf16_t(b[0], b[1]); w.w = cvt_pk_bf16_t(b[2], b[3]); *(u32x4*)p = w; }
__device__ __forceinline__ void st_bf16x4_t(bf16_t* p, f32x4 v) { u32x2 w; w.x = cvt_pk_bf16_t(v[0], v[1]); w.y = cvt_pk_bf16_t(v[2], v[3]); *(u32x2*)p = w; }
__device__ __forceinline__ u32x4 pk_bf16x8(f32x4 a, f32x4 b) { u32x4 w; w.x = cvt_pk_bf16(a[0], a[1]); w.y = cvt_pk_bf16(a[2], a[3]); w.z = cvt_pk_bf16(b[0], b[1]); w.w = cvt_pk_bf16(b[2], b[3]); return w; }
__device__ __forceinline__ unsigned dpp_ror8(unsigned v) { return __builtin_amdgcn_mov_dpp(v, 0x128, 0xF, 0xF, true); }
template <class F>
__device__ __forceinline__ void store_tile_lines(const f32x4 (&acc)[2][2][4][2], int brow, int bcol, int wr, int wc, int fr, int fq, bf16_t* base, size_t ld, F&& pack) {
    const bool lo = fr < 8; const int r = fr & 7, hc = (fr >> 3) * 32 + fq * 8;
#pragma unroll
    for (int ai = 0; ai < 2; ++ai)
#pragma unroll
        for (int m = 0; m < 4; ++m) {
            const int row0 = brow + ai * HALF + wr * 64 + m * 16, col0 = bcol + wc * 64;
            const u32x4 w0 = pack(row0 + fr, col0 + fq * 8, acc[ai][0][m][0], acc[ai][0][m][1]), w1 = pack(row0 + fr, col0 + 32 + fq * 8, acc[ai][1][m][0], acc[ai][1][m][1]);
            u32x4 x, y, a, b;
            x.x = lo ? w1.x : w0.x; x.y = lo ? w1.y : w0.y; x.z = lo ? w1.z : w0.z; x.w = lo ? w1.w : w0.w;
            y.x = dpp_ror8(x.x); y.y = dpp_ror8(x.y); y.z = dpp_ror8(x.z); y.w = dpp_ror8(x.w);
            a.x = lo ? w0.x : y.x; a.y = lo ? w0.y : y.y; a.z = lo ? w0.z : y.z; a.w = lo ? w0.w : y.w;
            b.x = lo ? y.x : w1.x; b.y = lo ? y.y : w1.y; b.z = lo ? y.z : w1.z; b.w = lo ? y.w : w1.w;
            *(u32x4*)(base + (size_t)(row0 + r) * ld + col0 + hc) = a;
            *(u32x4*)(base + (size_t)(row0 + 8 + r) * ld + col0 + hc) = b;
        }
}
__device__ __forceinline__ bool win_tile_a(int pn) { return pn < 2 || (pn >= 5 && pn < 17); }

struct EpiIn {
    const Params& p;
    __device__ __forceinline__ void apply(int row, int col, f32x4 v) const {
        const Params& P = p; const int pn = col >> 8, c = col & 255;
        if (pn < 2) st_bf16x4(P.Qb + (size_t)row * QD + col, v * QSCALE);
        else if (pn < 5) {
            if (pn != 2) st_bf16x4((pn == 3 ? P.SLCb : P.WINb) + (size_t)row * 256 + c, v);
            if (pn < 4) *(f32x4*)(P.out + (pn == 2 ? O_CMPS : O_SLCS) + (size_t)(row - MP) * 256 + c) = v;
            else *(f32x4*)(P.out + O_WINS + ((size_t)(row - MP) * WIN + (WIN - 1)) * 256 + c) = v;
        } else if (pn < 9) {
            f32x4 g; g[0] = gelu_fast(v[0]); g[1] = gelu_fast(v[1]); g[2] = gelu_fast(v[2]); g[3] = gelu_fast(v[3]);
            st_bf16x4((pn < 7 ? P.U : P.Vg) + (size_t)row * GMD + (col - (pn < 7 ? 1280 : 1792)), g);
        } else if (pn < 17) {
            f32x4 g; g[0] = sigmoid_fast(v[0]); g[1] = sigmoid_fast(v[1]); g[2] = sigmoid_fast(v[2]); g[3] = sigmoid_fast(v[3]);
            st_bf16x4((pn < 13 ? P.GA : P.GB) + (size_t)row * DM + (col - (pn < 13 ? 2304 : 3328)), g);
        } else if (c < 24) { f32x4 g; g[0] = sigmoid_fast(v[0]); g[1] = sigmoid_fast(v[1]); g[2] = sigmoid_fast(v[2]); g[3] = sigmoid_fast(v[3]); *(f32x4*)(P.GATE + (size_t)row * 32 + c) = g; }
    }
    __device__ __forceinline__ int lcol(int r) const { return win_tile_a(r >> 8) ? lcol_a(r) : r; }
    __device__ __forceinline__ void operator()(const f32x4 (&acc)[2][2][4][2], int brow, int bcol, int wr, int wc, int fr, int fq) const {
        const int pn = bcol >> 8;
        const Params& P = p;
        if (pn < 2) {
            store_tile_lines(acc, brow, bcol, wr, wc, fr, fq, P.Qb, QD, [&](int, int, f32x4 a, f32x4 b) { return pk_bf16x8(a * QSCALE, b * QSCALE); });
        } else if (pn < 5) {
            bf16_t* cp = pn == 2 ? P.CMPb : pn == 3 ? P.SLCb : P.WINb;
            for_each_frag(acc, brow, bcol, wr, wc, fr, fq, [&](int row, int col, f32x4 v) {
                const int c = col & 255;
                if (pn == 2) st_bf16x4(cp + (size_t)row * 256 + c, v);
                if (pn >= 3 && c < 128 && row < MP) {
                    st_bf16x4((pn == 3 ? P.SLCkF : P.WINkF) + ((size_t)(row >> 13) * NG + (c >> 6)) * SEQ * 64 + kfrag_off(row & (SEQ - 1), c & 63), v);
                }
                if (pn >= 3 && c >= 128 && row < MP) {
                    const int t = row & (SEQ - 1), dc = c - 128;
                    bf16_t* vt = (pn == 3 ? P.SLCvT : P.WINvT) + ((size_t)(row >> 13) * NG + (dc >> 6)) * SEQ * 64 + vfrag_off(t, dc & 63);
                    vt[0] = f2bf(v[0]); vt[8] = f2bf(v[1]); vt[16] = f2bf(v[2]); vt[24] = f2bf(v[3]);
                }
                if (pn < 4) {
                    if (row < MP) __builtin_nontemporal_store(v, (f32x4*)(P.out + (pn == 2 ? O_CMPP : O_SLCP) + (size_t)row * 256 + c));
                    else if (row < MP + NS) *(f32x4*)(P.out + (pn == 2 ? O_CMPS : O_SLCS) + (size_t)(row - MP) * 256 + c) = v;
                } else {
                    if (row < MP) { const int t = row & (SEQ - 1), b = row >> 13; if (t >= SEQ - WIN) __builtin_nontemporal_store(v, (f32x4*)(P.out + O_WINP + ((size_t)b * WIN + (t - (SEQ - WIN))) * 256 + c)); }
                    else if (row < MP + NS) *(f32x4*)(P.out + O_WINS + ((size_t)(row - MP) * WIN + (WIN - 1)) * 256 + c) = v;
                }
            });
        } else if (pn < 9) {
            bf16_t* dst = pn < 7 ? P.U : P.Vg; const int c0 = pn < 7 ? 1280 : 1792;
            store_tile_lines(acc, brow, bcol, wr, wc, fr, fq, dst - c0, GMD, [&](int, int, f32x4 a, f32x4 b) {
                f32x4 g, h; g[0] = gelu_fast(a[0]); g[1] = gelu_fast(a[1]); g[2] = gelu_fast(a[2]); g[3] = gelu_fast(a[3]); h[0] = gelu_fast(b[0]); h[1] = gelu_fast(b[1]); h[2] = gelu_fast(b[2]); h[3] = gelu_fast(b[3]);
                return pk_bf16x8(g, h); });
        } else if (pn < 17) {
            bf16_t* dst = pn < 13 ? P.GA : P.GB; const int c0 = pn < 13 ? 2304 : 3328;
            store_tile_lines(acc, brow, bcol, wr, wc, fr, fq, dst - c0, DM, [&](int, int, f32x4 a, f32x4 b) {
                f32x4 g, h; g[0] = sigmoid_fast(a[0]); g[1] = sigmoid_fast(a[1]); g[2] = sigmoid_fast(a[2]); g[3] = sigmoid_fast(a[3]); h[0] = sigmoid_fast(b[0]); h[1] = sigmoid_fast(b[1]); h[2] = sigmoid_fast(b[2]); h[3] = sigmoid_fast(b[3]);
                return pk_bf16x8(g, h); });
        } else {
            for_each_frag(acc, brow, bcol, wr, wc, fr, fq, [&](int row, int col, f32x4 v) {
                const int c = col & 255;
                if (c < 24) { f32x4 g; g[0] = sigmoid_fast(v[0]); g[1] = sigmoid_fast(v[1]); g[2] = sigmoid_fast(v[2]); g[3] = sigmoid_fast(v[3]); *(f32x4*)(P.GATE + (size_t)row * 32 + c) = g; } });
        }
    }
};
struct EpiBranch {
    const bf16_t* GA; const bf16_t* GB; bf16_t* Y1;
    __device__ __forceinline__ void mid(f32x4 (&acc)[2][2][4][2], int brow, int bcol, int wr, int wc, int fr, int fq) const {
#pragma unroll
        for (int ai = 0; ai < 2; ++ai)
#pragma unroll
            for (int m = 0; m < 4; ++m)
#pragma unroll
                for (int bj = 0; bj < 2; ++bj) {
                    const size_t o = (size_t)(brow + ai * HALF + wr * 64 + m * 16 + fr) * DM + bcol + wc * 64 + bj * 32 + fq * 8;
                    const u32x4 a = *(const u32x4*)(GA + o), b = *(const u32x4*)(GB + o);
                    f32x4& v = acc[ai][bj][m][0]; f32x4& w = acc[ai][bj][m][1];
                    v[0] *= bflo(a.x) * __builtin_amdgcn_rcpf(fmaxf(bflo(b.x), 1e-30f)); v[1] *= bfhi(a.x) * __builtin_amdgcn_rcpf(fmaxf(bfhi(b.x), 1e-30f));
                    v[2] *= bflo(a.y) * __builtin_amdgcn_rcpf(fmaxf(bflo(b.y), 1e-30f)); v[3] *= bfhi(a.y) * __builtin_amdgcn_rcpf(fmaxf(bfhi(b.y), 1e-30f));
                    w[0] *= bflo(a.z) * __builtin_amdgcn_rcpf(fmaxf(bflo(b.z), 1e-30f)); w[1] *= bfhi(a.z) * __builtin_amdgcn_rcpf(fmaxf(bfhi(b.z), 1e-30f));
                    w[2] *= bflo(a.w) * __builtin_amdgcn_rcpf(fmaxf(bflo(b.w), 1e-30f)); w[3] *= bfhi(a.w) * __builtin_amdgcn_rcpf(fmaxf(bfhi(b.w), 1e-30f));
                    asm volatile("" : "+v"(v), "+v"(w));
                    if (bj == 1) __builtin_amdgcn_sched_barrier(0);
                }
    }
    __device__ __forceinline__ int lcol(int r) const { return lcol_a(r); }
    __device__ __forceinline__ void operator()(const f32x4 (&acc)[2][2][4][2], int brow, int bcol, int wr, int wc, int fr, int fq) const {
        store_tile_lines(acc, brow, bcol, wr, wc, fr, fq, Y1, DM, [&](int row, int col, f32x4 v, f32x4 w) {
            const u32x4 b = *(const u32x4*)(GB + (size_t)row * DM + col);
            f32x4 o, q; o[0] = v[0] * fmaxf(bflo(b.x), 1e-30f); o[1] = v[1] * fmaxf(bfhi(b.x), 1e-30f); o[2] = v[2] * fmaxf(bflo(b.y), 1e-30f); o[3] = v[3] * fmaxf(bfhi(b.y), 1e-30f);
            q[0] = w[0] * fmaxf(bflo(b.z), 1e-30f); q[1] = w[1] * fmaxf(bfhi(b.z), 1e-30f); q[2] = w[2] * fmaxf(bflo(b.w), 1e-30f); q[3] = w[3] * fmaxf(bfhi(b.w), 1e-30f);
            return pk_bf16x8(o, q); });
    }
    __device__ __forceinline__ void apply2(int row, int col, f32x4 v1, f32x4 v2) const {
        const u32x2 a = *(const u32x2*)(GA + (size_t)row * DM + col), b = *(const u32x2*)(GB + (size_t)row * DM + col);
        f32x4 o; o[0] = v1[0] * bflo(a.x) + v2[0] * bflo(b.x); o[1] = v1[1] * bfhi(a.x) + v2[1] * bfhi(b.x); o[2] = v1[2] * bflo(a.y) + v2[2] * bflo(b.y); o[3] = v1[3] * bfhi(a.y) + v2[3] * bfhi(b.y);
        st_bf16x4(Y1 + (size_t)row * DM + col, o);
    }
};
struct EpiF32 {
    float* F; int ld;
    __device__ __forceinline__ void apply(int row, int col, f32x4 v) const { *(f32x4*)(F + (size_t)row * ld + col) = v; }
    __device__ __forceinline__ void operator()(const f32x4 (&acc)[2][2][4][2], int brow, int bcol, int wr, int wc, int fr, int fq) const {
        for_each_frag(acc, brow, bcol, wr, wc, fr, fq, [&](int row, int col, f32x4 v) { *(f32x4*)(F + (size_t)row * ld + col) = v; });
    }
};
struct EpiBf16 {
    bf16_t* O; int ld;
    __device__ __forceinline__ int lcol(int r) const { return lcol_a(r); }
    __device__ __forceinline__ void apply(int row, int col, f32x4 v) const { st_bf16x4(O + (size_t)row * ld + col, v); }
    __device__ __forceinline__ void operator()(const f32x4 (&acc)[2][2][4][2], int brow, int bcol, int wr, int wc, int fr, int fq) const {
        store_tile_lines(acc, brow, bcol, wr, wc, fr, fq, O, (size_t)ld, [&](int, int, f32x4 a, f32x4 b) { return pk_bf16x8(a, b); });
    }
};
struct EpiPart {
    bf16_t* PART;
    __device__ __forceinline__ void operator()(const f32x4 (&acc)[2][2][4][2], int brow, int bcol, int wr, int wc, int fr, int fq) const {
        const int z = bcol >> 20;
        store_tile_lines(acc, brow, 0, wr, wc, fr, fq, PART + (size_t)z * 256, (size_t)1024, [&](int, int, f32x4 a, f32x4 b) { return pk_bf16x8(a, b); });
    }
};
struct ZCmp { __device__ __forceinline__ size_t a(int z) const { return (size_t)z * 64; } __device__ __forceinline__ size_t b(int z) const { return (size_t)(z >> 1) * 256 * 1024; } };
struct EpiSwiGLU {
    bf16_t* ACT;
    __device__ __forceinline__ int lcol(int r) const { return lcol_s(r); }
    __device__ __forceinline__ void apply(int row, int col, f32x4 v) const { *(unsigned*)(ACT + (size_t)row * DFF + (col >> 1)) = cvt_pk_bf16(silu_fast(v[0]) * v[1], silu_fast(v[2]) * v[3]); }
    __device__ __forceinline__ void operator()(const f32x4 (&acc)[2][2][4][2], int brow, int bcol, int wr, int wc, int fr, int fq) const {
#pragma unroll
        for (int ai = 0; ai < 2; ++ai)
#pragma unroll
            for (int m = 0; m < 4; ++m) {
                const f32x4 &a = acc[ai][0][m][0], &b = acc[ai][0][m][1], &c = acc[ai][1][m][0], &d = acc[ai][1][m][1];
                u32x4 w;
                w.x = cvt_pk_bf16(silu_fast(a[0]) * a[1], silu_fast(a[2]) * a[3]); w.y = cvt_pk_bf16(silu_fast(b[0]) * b[1], silu_fast(b[2]) * b[3]);
                w.z = cvt_pk_bf16(silu_fast(c[0]) * c[1], silu_fast(c[2]) * c[3]); w.w = cvt_pk_bf16(silu_fast(d[0]) * d[1], silu_fast(d[2]) * d[3]);
                *(u32x4*)(ACT + (size_t)(brow + ai * HALF + wr * 64 + m * 16 + fr) * DFF + (bcol >> 1) + wc * 32 + fq * 8) = w;
            }
    }
};
struct EpiPleGate {
    const bf16_t* E; bf16_t* F;
    __device__ __forceinline__ void apply(int row, int col, f32x4 v) const {
        const u32x2 w = *(const u32x2*)(E + (size_t)row * DM + col);
        f32x4 o; o[0] = sigmoidf_(v[0]) * bflo(w.x); o[1] = sigmoidf_(v[1]) * bfhi(w.x); o[2] = sigmoidf_(v[2]) * bflo(w.y); o[3] = sigmoidf_(v[3]) * bfhi(w.y);
        st_bf16x4(F + (size_t)row * DM + col, o); }
    __device__ __forceinline__ int lcol(int r) const { return lcol_a(r); }
    __device__ __forceinline__ void operator()(const f32x4 (&acc)[2][2][4][2], int brow, int bcol, int wr, int wc, int fr, int fq) const {
        store_tile_lines(acc, brow, bcol, wr, wc, fr, fq, F, DM, [&](int row, int col, f32x4 a, f32x4 b) {
            const u32x4 w = *(const u32x4*)(E + (size_t)row * DM + col);
            f32x4 o, q; o[0] = sigmoidf_(a[0]) * bflo(w.x); o[1] = sigmoidf_(a[1]) * bfhi(w.x); o[2] = sigmoidf_(a[2]) * bflo(w.y); o[3] = sigmoidf_(a[3]) * bfhi(w.y);
            q[0] = sigmoidf_(b[0]) * bflo(w.z); q[1] = sigmoidf_(b[1]) * bfhi(w.z); q[2] = sigmoidf_(b[2]) * bflo(w.w); q[3] = sigmoidf_(b[3]) * bfhi(w.w);
            return pk_bf16x8(o, q); });
    }
};

template <class Epi>
__device__ __forceinline__ void gemm_skinny(const bf16_t* A  , int lda, const bf16_t* Bt, int K, int N, const Epi& E) {
    int tid = threadIdx.x; asm volatile("" : "+v"(tid));
    const int wid = __builtin_amdgcn_readfirstlane(tid >> 6), lane = tid & 63, c = lane & 15, G = lane >> 4;
    LAS f32x4* red = (LAS f32x4*)smem;
    const int nsteps = K / 32;
#pragma unroll 1
    for (int ct = blockIdx.x; ct < N / 16; ct += gridDim.x) {
        f32x4 acc0 = {0.f, 0.f, 0.f, 0.f}, acc1 = {0.f, 0.f, 0.f, 0.f};
        const bf16_t* bp = Bt + (size_t)(ct * 16 + c) * K + G * 8;
        const bf16_t* a0 = A + (size_t)c * lda + G * 8; const bf16_t* a1 = A + (size_t)(16 + c) * lda + G * 8;
#pragma unroll 4
        for (int kk = wid; kk < nsteps; kk += 8) {
            const bf16x8 bf = *(const bf16x8*)(bp + kk * 32), x0 = *(const bf16x8*)(a0 + kk * 32), x1 = *(const bf16x8*)(a1 + kk * 32);
            acc0 = mfma16(bf, x0, acc0); acc1 = mfma16(bf, x1, acc1);
        }
        __syncthreads();
        red[(wid * 2 + 0) * 64 + lane] = acc0; red[(wid * 2 + 1) * 64 + lane] = acc1;
        __syncthreads();
        if (tid < 128) {
            const int rt = tid >> 6;
            f32x4 v = red[rt * 64 + lane];
#pragma unroll
            for (int w = 1; w < 8; ++w) v = v + red[(w * 2 + rt) * 64 + lane];
            E.apply(MP + rt * 16 + c, E.lcol(ct * 16 + 4 * G), v);
        }
    }
    __syncthreads();
}

template <class Epi>
__device__ __forceinline__ void gemm_skinny2(const bf16_t* A  , int lda, const bf16_t* Bt, int K, int N, const Epi& E) {
    int tid = threadIdx.x; asm volatile("" : "+v"(tid));
    const int wid = __builtin_amdgcn_readfirstlane(tid >> 6), lane = tid & 63, c = lane & 15, G = lane >> 4;
    LAS f32x4* red = (LAS f32x4*)smem;
    const int hsteps = K / 64;
#pragma unroll 1
    for (int ct = blockIdx.x; ct < N / 16; ct += gridDim.x) {
        f32x4 acc[4] = {{0.f, 0.f, 0.f, 0.f}, {0.f, 0.f, 0.f, 0.f}, {0.f, 0.f, 0.f, 0.f}, {0.f, 0.f, 0.f, 0.f}};
        const bf16_t* bp = Bt + (size_t)(ct * 16 + c) * K + G * 8;
        const bf16_t* a0 = A + (size_t)c * lda + G * 8; const bf16_t* a1 = A + (size_t)(16 + c) * lda + G * 8;
#pragma unroll
        for (int h = 0; h < 2; ++h) {
#pragma unroll 2
            for (int kk = h * hsteps + wid; kk < (h + 1) * hsteps; kk += 8) {
                const bf16x8 bf = *(const bf16x8*)(bp + kk * 32), x0 = *(const bf16x8*)(a0 + kk * 32), x1 = *(const bf16x8*)(a1 + kk * 32);
                acc[h * 2] = mfma16(bf, x0, acc[h * 2]); acc[h * 2 + 1] = mfma16(bf, x1, acc[h * 2 + 1]);
            }
        }
        __syncthreads();
#pragma unroll
        for (int q = 0; q < 4; ++q) red[(wid * 4 + q) * 64 + lane] = acc[q];
        __syncthreads();
        if (tid < 128) {
            const int rt = tid >> 6;
            f32x4 v1 = red[rt * 64 + lane], v2 = red[(2 + rt) * 64 + lane];
#pragma unroll
            for (int w = 1; w < 8; ++w) { v1 = v1 + red[(w * 4 + rt) * 64 + lane]; v2 = v2 + red[(w * 4 + 2 + rt) * 64 + lane]; }
            E.apply2(MP + rt * 16 + c, E.lcol(ct * 16 + 4 * G), v1, v2);
        }
    }
    __syncthreads();
}

template <class Map>
__device__ __forceinline__ void transpose_tile(const float* W, int K, int N, bf16_t* Wt, int ldk, int kt, int ntile, Map map) {
    LAS float* tile = (LAS float*)smem;
    const int t = threadIdx.x;
    __syncthreads();
#pragma unroll
    for (int i = 0; i < 2; ++i) {
        const int k = (t >> 4) + 32 * i, n = (t & 15) * 4, gn = ntile * 64 + n;
        f32x4 v = (f32x4){0.f, 0.f, 0.f, 0.f};
        if (gn < N) v = *(const f32x4*)(W + (size_t)(kt * 64 + k) * N + gn);
        tile[k * 65 + n] = v[0]; tile[k * 65 + n + 1] = v[1]; tile[k * 65 + n + 2] = v[2]; tile[k * 65 + n + 3] = v[3];
    }
    __syncthreads();
    const int n = t >> 3, kc = (t & 7) * 8, gn = ntile * 64 + n;
    if (gn < N) {
        u32x4 w;
        w.x = cvt_pk_bf16(tile[(kc + 0) * 65 + n], tile[(kc + 1) * 65 + n]); w.y = cvt_pk_bf16(tile[(kc + 2) * 65 + n], tile[(kc + 3) * 65 + n]);
        w.z = cvt_pk_bf16(tile[(kc + 4) * 65 + n], tile[(kc + 5) * 65 + n]); w.w = cvt_pk_bf16(tile[(kc + 6) * 65 + n], tile[(kc + 7) * 65 + n]);
        *(u32x4*)(Wt + (size_t)map(gn) * ldk + kt * 64 + kc) = w;
    }
}
template <class Map>
__device__ __forceinline__ void transpose_all(const float* W, int K, int N, bf16_t* Wt, int ldk, Map map, int& base) {
    const int nkt = K / 64, nnt = (N + 63) / 64, ntl = nkt * nnt;
    for (int it = blockIdx.x; it < base + ntl; it += gridDim.x) {
        if (it < base) continue;
        const int l = it - base;
        transpose_tile(W, K, N, Wt, ldk, l / nnt, l % nnt, map);
    }
    base += ntl;
}
template <class Map>
__device__ __forceinline__ void transpose_all_sub(const float* W, int K, int N, bf16_t* Wt, int ldk, Map map, int& base) {
    const int nkt = K / 64, nnt = (N + 63) / 64, ntl = nkt * nnt, nb = gridDim.x - 32, me = blockIdx.x - 32;
    int first = base - (base % nb) + me; if (first < base) first += nb;
    for (int it = first; it < base + ntl; it += nb) { const int l = it - base; transpose_tile(W, K, N, Wt, ldk, l / nnt, l % nnt, map); }
    base += ntl;
}
__device__ __forceinline__ int map_win(int n) {
    if (n < 1280) return n;
    if (n < 1304) return 4352 + (n - 1280);
    if (n < 2328) return 1280 + (n - 1304);
    return 2304 + (n - 2328);
}

__device__ __forceinline__ float row_rstd(const f32x4 (&v)[4]) {
    float s = 0.f;
#pragma unroll
    for (int k = 0; k < 4; ++k) s += v[k][0] * v[k][0] + v[k][1] * v[k][1] + v[k][2] * v[k][2] + v[k][3] * v[k][3];
    s = wave_sum(s);
    return rsqrtf(s * (1.0f / DM) + EPS);
}
__device__ __forceinline__ const float* xrow_ptr(const Params& p, int row) {
    return row < MP ? p.x_prompt + (size_t)row * DM : p.x_sample + (size_t)(row - MP) * DM;
}

__device__ __forceinline__ void phase_prologue(const Params& p) {
    const int wid = threadIdx.x >> 6, lane = threadIdx.x & 63;
    const int gw = blockIdx.x * 8 + wid, nw = gridDim.x * 8;
    auto do_transposes = [&]() {
    int base = 0;
    transpose_all(p.w_in, DM, IND, p.WinT, DM, [](int n) { const int l = map_win(n); return win_tile_a(l >> 8) ? row_a(l) : l; }, base);
    for (int kv = 0; kv < 2; ++kv) for (int j = 0; j < 2; ++j)
        transpose_all((kv ? p.w1_v : p.w1_k) + (size_t)j * 1024 * 128, 1024, 128, p.W1T + (size_t)kv * 256 * 1024, 1024, [j](int n) { return inv_a(j * 128 + n); }, base);
    };
    do_transposes();
    __syncthreads();
    for (int i = blockIdx.x * 512 + threadIdx.x; i < (INP - IND) * DM / 8; i += gridDim.x * 512) ((u32x4*)(p.WinT + (size_t)IND * DM))[i] = (u32x4){0u, 0u, 0u, 0u};
    for (int row0 = gw * 2; row0 < MP + NS; row0 += nw * 2) {
        f32x4 v[2][4];
#pragma unroll
        for (int q = 0; q < 2; ++q) { const float* xr = xrow_ptr(p, row0 + q);
#pragma unroll
            for (int k = 0; k < 4; ++k) v[q][k] = *(const f32x4*)(xr + lane * 4 + k * 256); }
#pragma unroll
        for (int q = 0; q < 2; ++q) {
            const int row = row0 + q;
            u32x2* hd = (u32x2*)(p.H + (size_t)row * DM);
            const float r = row_rstd(v[q]);
#pragma unroll
            for (int k = 0; k < 4; ++k) { const f32x4 g = *(const f32x4*)(p.ln_mix_pre + lane * 4 + k * 256); const f32x4 o = v[q][k] * r * g; u32x2 w; w.x = cvt_pk_bf16(o[0], o[1]); w.y = cvt_pk_bf16(o[2], o[3]); hd[lane + k * 64] = w; }
            const float* pr = row < MP ? p.p_prompt + (size_t)row * PLE : p.p_sample + (size_t)(row - MP) * PLE;
            const f32x4 pv = *(const f32x4*)(pr + lane * 4);
            u32x2 w; w.x = cvt_pk_bf16(pv[0], pv[1]); w.y = cvt_pk_bf16(pv[2], pv[3]);
            ((u32x2*)(p.Pb + (size_t)row * PLE))[lane] = w;
        }
    }
    for (int i = blockIdx.x * 512 + threadIdx.x; i < 4 * 128 * 128; i += gridDim.x * 512) { const int t = (i >> 7) & 127, s = i & 127; p.GWb[i] = f2bf(s <= t ? p.gm_ws[i] : 0.f); }
    for (int i = blockIdx.x * 512 + threadIdx.x; i < 2 * 64 * 128; i += gridDim.x * 512) { const int kv = i >> 13, d = (i >> 7) & 63, h = i & 127; p.W2T[i] = f2bf((kv ? p.w2_v : p.w2_k)[h * 64 + d]); }
    if (gw < 256) {
        const int kv = gw >> 7, h = gw & 127;
        const float* pe = kv ? p.pe_v : p.pe_k; const float* w1 = kv ? p.w1_v : p.w1_k;
        float s = 0.f;
#pragma unroll 8
        for (int k = lane; k < 2048; k += 64) s += pe[k] * w1[(size_t)k * 128 + h];
        s = wave_sum(s);
        if (lane == 0) p.PEB[kv * 128 + h] = s;
    }
    const int cskip = gridDim.x > 64 ? 32 : 0;
    if ((int)blockIdx.x >= cskip)
    for (int i = (blockIdx.x - cskip) * 512 + threadIdx.x; i < NS * (WIN - 1) * 64; i += (gridDim.x - cskip) * 512) {
        const int b = i / ((WIN - 1) * 64), r = i % ((WIN - 1) * 64);
        __builtin_nontemporal_store(((const f32x4*)(p.state_win + (size_t)b * WIN * 256 + 256))[r], (f32x4*)(p.out + O_WINS + (size_t)b * WIN * 256) + r);
    }
}

__device__ __forceinline__ void phase_deferred_transposes(const Params& p) {
    if (blockIdx.x < 32) return;
    int base = 0;
    transpose_all_sub(p.w_br_nsa, QD, DM, p.WnT, DM, [](int n) { return row_a(n); }, base);
    transpose_all_sub(p.w_br_gm, GMD, DM, p.WnT + QD, DM, [](int n) { return row_a(n); }, base);
    transpose_all_sub(p.w_out, DM, DM, p.WoT, DM, [](int n) { return row_a(n); }, base);
    transpose_all_sub(p.w_gate, DM, DFF, p.WguT, DM, [](int n) { return row_s(n, 0); }, base);
    transpose_all_sub(p.w_up, DM, DFF, p.WguT, DM, [](int n) { return row_s(n, 1); }, base);
    transpose_all_sub(p.w_down, DFF, DM, p.WdT, DFF, [](int n) { return row_a(n); }, base);
    transpose_all_sub(p.w_ple_gate, DM, DM, p.WpgT, DM, [](int n) { return row_a(n); }, base);
    transpose_all_sub(p.w_ple, PLE, DM, p.WpT, PLE, [](int n) { return row_a(n); }, base);
    __syncthreads();
}
__device__ __forceinline__ void phase_gather(const Params& p) {
    int tid = threadIdx.x; asm volatile("" : "+v"(tid));
    const int wid = tid >> 6, lane = tid & 63;
    const int gw = (blockIdx.x >> 1) * 8 + wid, nw = (gridDim.x >> 1) * 8;
    const int cls = blockIdx.x & 1;
    auto ld8 = [&](int r8h, f32x4 (&a)[4], f32x4 (&cc)[4]) __attribute__((always_inline)) {
        const int r = (r8h * 2 + cls) * 8, b = r >> 14, pos = r & (PAST - 1), l5 = lane & 31, hrow = lane >> 5;
        const float* s = p.cache_cmp + ((size_t)p.page_table[b * NPG + (pos >> 7)] * PAGE + (pos & 127) + hrow) * 256 + l5 * 8;
#pragma unroll
        for (int k = 0; k < 4; ++k) { a[k] = *(const f32x4*)(s + (size_t)k * 512); cc[k] = *(const f32x4*)(s + (size_t)k * 512 + 4); }
    };
    auto st8 = [&](int r8h, const f32x4 (&a)[4], const f32x4 (&cc)[4]) __attribute__((always_inline)) {
        const int r = (r8h * 2 + cls) * 8, l5 = lane & 31, hrow = lane >> 5;
#pragma unroll
        for (int k = 0; k < 4; ++k) {
            u32x4 w; w.x = cvt_pk_bf16(a[k][0], a[k][1]); w.y = cvt_pk_bf16(a[k][2], a[k][3]); w.z = cvt_pk_bf16(cc[k][0], cc[k][1]); w.w = cvt_pk_bf16(cc[k][2], cc[k][3]);
            *(u32x4*)(p.CMPb + ((size_t)MP + r + 2 * k + hrow) * 256 + l5 * 8) = w;
        }
    };
#pragma unroll 1
    for (int r8h = gw; r8h < NS * PAST / 16; r8h += 2 * nw) {
        f32x4 a0[4], c0[4], a1[4], c1[4];
        const bool two = r8h + nw < NS * PAST / 16;
        ld8(r8h, a0, c0);
        if (two) ld8(r8h + nw, a1, c1);
        st8(r8h, a0, c0);
        if (two) st8(r8h + nw, a1, c1);
    }
}

__device__ __forceinline__ void phase_cmp_final(const Params& p) {
    const int wid = threadIdx.x >> 6, lane = threadIdx.x & 63;
    {
        const int c = lane & 15, G = lane >> 4;
        const int ngrp_p = NB * 4 * 32, ngrp_s = NS * 4 * 64;
#pragma unroll 1
        for (int it = blockIdx.x * 8 + wid; it < ngrp_p + ngrp_s; it += gridDim.x * 8) {
            const bool smp = it >= ngrp_p; const int l = smp ? it - ngrp_p : it;
            const int nch = smp ? 64 : 32, nc = smp ? NCS : NCP;
            const int ch = l % nch, z = (l / nch) & 3, seq = l / (nch * 4), kv = z >> 1, g = z & 1, n0 = ch * 16;
            const size_t r0 = smp ? (size_t)2048 + (size_t)seq * 1024 : (size_t)seq * 512;
            const int nr = n0 + c < nc ? n0 + c : nc - 1;
            const bf16_t* p0 = (const bf16_t*)p.PART + ((r0 + nr) * 4 + z) * 256;
            const bf16_t* p1 = (const bf16_t*)p.PART + ((r0 + nr + 1) * 4 + z) * 256 + 128;
            const float* pb = p.PEB + kv * 128;
            f32x4 acc[4] = {{0.f, 0.f, 0.f, 0.f}, {0.f, 0.f, 0.f, 0.f}, {0.f, 0.f, 0.f, 0.f}, {0.f, 0.f, 0.f, 0.f}};
#pragma unroll
            for (int ks = 0; ks < 4; ++ks) {
                const int h0 = 32 * ks + 8 * G;
                const u32x4 wa = *(const u32x4*)(p0 + h0), wb = *(const u32x4*)(p1 + h0);
                const f32x4 a0 = {bflo(wa.x), bfhi(wa.x), bflo(wa.y), bfhi(wa.y)}, a1 = {bflo(wa.z), bfhi(wa.z), bflo(wa.w), bfhi(wa.w)};
                const f32x4 b0 = {bflo(wb.x), bfhi(wb.x), bflo(wb.y), bfhi(wb.y)}, b1 = {bflo(wb.z), bfhi(wb.z), bflo(wb.w), bfhi(wb.w)};
                const f32x4 e0 = *(const f32x4*)(pb + h0), e1 = *(const f32x4*)(pb + h0 + 4);
                f32x4 x0 = a0 + b0 + e0, x1 = a1 + b1 + e1;
#pragma unroll
                for (int i = 0; i < 4; ++i) { x0[i] = siluf_(x0[i]); x1[i] = siluf_(x1[i]); }
                const bf16x8 A = pack_p(x0, x1);
#pragma unroll
                for (int nt = 0; nt < 4; ++nt) {
                    const bf16x8 B = *(const bf16x8*)(p.W2T + ((size_t)kv * 64 + nt * 16 + c) * 128 + h0);
                    acc[nt] = mfma16(A, B, acc[nt]);
                }
            }
#pragma unroll
            for (int nt = 0; nt < 4; ++nt) {
                const int d = nt * 16 + c;
#pragma unroll
                for (int i = 0; i < 4; ++i) {
                    const int n = n0 + 4 * G + i;
                    if (n < nc) {
                        if (smp) ((kv ? p.VCS : p.KCS) + (((size_t)seq * NG + g) * 1024 + n) * 64)[d] = acc[nt][i];
                        else if (kv == 0) p.KCb[((size_t)seq * NG + g) * 512 * 64 + kfrag_off(n, d)] = f2bf(acc[nt][i]);
                    }
                }
                if (!smp && kv == 1) {
                    f32x4 v = acc[nt];
#pragma unroll
                    for (int i = 0; i < 4; ++i) if (n0 + 4 * G + i >= nc) v[i] = 0.f;
                    st_bf16x4(p.VCT + ((size_t)seq * NG + g) * 512 * 64 + vfrag_off(n0 + 4 * G, d), v);
                }
            }
        }
    }
}

template <bool SAMPLE>
__device__ __forceinline__ void kv_row_ptr(const Params& p, int branch  , int b, int pos, int kv, int g, const bf16_t*& pb, const float*& pf) {
    const int off = kv * 128 + g * 64;
    if (!SAMPLE) { pf = nullptr; pb = (branch == 1 ? p.SLCb : p.WINb) + ((size_t)b * SEQ + pos) * 256 + off; }
    else if (pos >= PAST) { pf = nullptr; pb = (branch == 1 ? p.SLCb : p.WINb) + ((size_t)MP + b) * 256 + off; }
    else if (branch == 1) { pb = nullptr; pf = p.cache_slc + ((size_t)p.page_table[b * NPG + (pos >> 7)] * PAGE + (pos & 127)) * 256 + off; }
    else { pb = nullptr; pf = p.state_win + ((size_t)b * WIN + (pos - (PAST - WIN))) * 256 + off; }
}
__device__ __forceinline__ void dot4x64(const bf16_t* pb, const float* pf, const LAS float* qs_, float (&s)[4]) {
    s[0] = s[1] = s[2] = s[3] = 0.f;
    const LAS float* qs = qs_; asm volatile("" : "+v"(qs));
    if (pf) {
#pragma unroll 8
        for (int c = 0; c < 16; ++c) {
            const f32x4 kx = *(const f32x4*)(pf + c * 4);
#pragma unroll
            for (int h = 0; h < 4; ++h) { const f32x4 q = *(const LAS f32x4*)(qs + h * 64 + c * 4); s[h] += q[0] * kx[0] + q[1] * kx[1] + q[2] * kx[2] + q[3] * kx[3]; }
        }
    } else {
#pragma unroll 2
        for (int c = 0; c < 8; ++c) {
            const u32x4 w = *(const u32x4*)(pb + c * 8);
            const float k0 = bflo(w.x), k1 = bfhi(w.x), k2 = bflo(w.y), k3 = bfhi(w.y), k4 = bflo(w.z), k5 = bfhi(w.z), k6 = bflo(w.w), k7 = bfhi(w.w);
#pragma unroll
            for (int h = 0; h < 4; ++h) {
                const f32x4 qa = *(const LAS f32x4*)(qs + h * 64 + c * 8), qb = *(const LAS f32x4*)(qs + h * 64 + c * 8 + 4);
                s[h] += qa[0] * k0 + qa[1] * k1 + qa[2] * k2 + qa[3] * k3 + qb[0] * k4 + qb[1] * k5 + qb[2] * k6 + qb[3] * k7;
            }
        }
    }
}
template <bool SAMPLE>
__device__ __forceinline__ void attn_chunk(const Params& p, int branch, int b, int g, int t, int pos0, int lo, int hi,
                                           float (&m)[4], float (&l)[4], float (&o)[4], const LAS float* qs, LAS float* pbk, const LAS float* relb, int lane) {
    const int pos = pos0 + lane;
    const bool valid = pos >= lo && pos <= hi;
    float s[4] = {-1e30f, -1e30f, -1e30f, -1e30f};
    if (valid) {
        const bf16_t* pb; const float* pf; kv_row_ptr<SAMPLE>(p, branch, b, pos, 0, g, pb, pf);
        dot4x64(pb, pf, qs, s);
        const int bk = t5_bucket(t - pos);
#pragma unroll
        for (int h = 0; h < 4; ++h) s[h] += relb[bk * 8 + g * 4 + h];
    }
#pragma unroll
    for (int h = 0; h < 4; ++h) {
        const float mx = wave_max(s[h]);
        const float mn = fmaxf(m[h], mx);
        const float pr = valid ? ex2(s[h] - mn) : 0.f;
        const float sm = wave_sum(pr);
        const float al = ex2(m[h] - mn);
        l[h] = l[h] * al + sm; o[h] *= al; m[h] = mn;
        pbk[h * 64 + lane] = pr;
    }
    __builtin_amdgcn_wave_barrier();
    const int k0 = (lo > pos0 ? lo : pos0) - pos0, k1 = (hi < pos0 + 63 ? hi : pos0 + 63) - pos0;
    if (SAMPLE) {
        const int kend = (PAST - 1 - pos0) < k1 ? (PAST - 1 - pos0) : k1;
        if (kend >= k0) {
            const bf16_t* pb; const float* pf; kv_row_ptr<SAMPLE>(p, branch, b, pos0 + k0, 1, g, pb, pf);
            pf += lane;
#pragma unroll 16
            for (int k = k0; k <= kend; ++k) {
                const float v = pf[(size_t)(k - k0) * 256];
#pragma unroll
                for (int h = 0; h < 4; ++h) o[h] += pbk[h * 64 + k] * v;
            }
        }
        if (k1 > kend) {
            const bf16_t* pb; const float* pf; kv_row_ptr<SAMPLE>(p, branch, b, pos0 + k1, 1, g, pb, pf);
            const float v = bf2f(pb[lane]);
#pragma unroll
            for (int h = 0; h < 4; ++h) o[h] += pbk[h * 64 + k1] * v;
        }
    } else {
#pragma unroll 1
    for (int k = k0; k <= k1; ++k) {
        const bf16_t* pb; const float* pf; kv_row_ptr<SAMPLE>(p, branch, b, pos0 + k, 1, g, pb, pf);
        const float v = pf ? pf[lane] : bf2f(pb[lane]);
#pragma unroll
        for (int h = 0; h < 4; ++h) o[h] += pbk[h * 64 + k] * v;
    }
    }
    __builtin_amdgcn_wave_barrier();
}

constexpr int S_QS = 0, S_SC = 1024, S_PHS = S_SC + 4 * 1024 * 4, S_PBK = S_PHS + 1088 * 4, S_PART = S_PBK + 8 * 1024, S_RED = S_PART + 2 * 8 * 272 * 4, S_OCP = S_RED + 512,
              S_SEL = S_OCP + 2048, S_RELB = S_SEL + 64, ATTS_LDS = S_RELB + 1024;
__device__ __forceinline__ void attn_sample_item(const Params& p, int b, int g) {
    const int tid = threadIdx.x, wid = tid >> 6, lane = tid & 63;
    constexpr int t = PAST, NC = NCS, NSEL = 257, NJR = 5, qblk = PAST >> 6;
    const int row = MP + b;
    LAS unsigned char* L = (LAS unsigned char*)smem;
    LAS float* qs = (LAS float*)(L + S_QS); LAS float* sc = (LAS float*)(L + S_SC); LAS float* phs = (LAS float*)(L + S_PHS); LAS float* pbk = (LAS float*)(L + S_PBK) + wid * 256;
    LAS float* part = (LAS float*)(L + S_PART); LAS float* red = (LAS float*)(L + S_RED); LAS float* ocp = (LAS float*)(L + S_OCP); LAS int* sel = (LAS int*)(L + S_SEL);
    LAS float* relb = (LAS float*)(L + S_RELB);
    __syncthreads();
    if (tid < 256) { relb[tid] = p.rel_bias[tid] * LOG2E; qs[tid] = bf2f(p.Qb[(size_t)row * QD + g * 256 + tid]); }
    __syncthreads();
    const float* kc = p.KCS + ((size_t)b * NG + g) * 1024 * 64;
    const float* vc = p.VCS + ((size_t)b * NG + g) * 1024 * 64;
    {
        float mx[4] = {-1e30f, -1e30f, -1e30f, -1e30f};
#pragma unroll 1
        for (int r = wid; r < 16; r += 8) {
            const int n = r * 64 + lane;
            float s[4] = {-1e30f, -1e30f, -1e30f, -1e30f};
            if (n < NC) {
                dot4x64(nullptr, kc + (size_t)n * 64, qs, s);
                const int bk = t5_bucket(t - (16 * n + 31));
#pragma unroll
                for (int h = 0; h < 4; ++h) s[h] += relb[bk * 8 + g * 4 + h];
            }
#pragma unroll
            for (int h = 0; h < 4; ++h) { sc[h * 1024 + n] = s[h]; mx[h] = fmaxf(mx[h], s[h]); }
        }
#pragma unroll
        for (int h = 0; h < 4; ++h) { const float m = wave_max(mx[h]); if (lane == 0) red[wid * 4 + h] = m; }
    }
    __syncthreads();
    float gmx[4], inv[4];
#pragma unroll
    for (int h = 0; h < 4; ++h) { float m = red[h]; for (int w = 1; w < 8; ++w) m = fmaxf(m, red[w * 4 + h]); gmx[h] = m; }
    {
        float sum[4] = {0.f, 0.f, 0.f, 0.f};
#pragma unroll
        for (int k = 0; k < 2; ++k) { const int n = tid + 512 * k;
#pragma unroll
            for (int h = 0; h < 4; ++h) { const float e = n < NC ? ex2(sc[h * 1024 + n] - gmx[h]) : 0.f; sc[h * 1024 + n] = e; sum[h] += e; } }
#pragma unroll
        for (int h = 0; h < 4; ++h) { const float s = wave_sum(sum[h]); if (lane == 0) red[32 + wid * 4 + h] = s; }
    }
    __syncthreads();
#pragma unroll
    for (int h = 0; h < 4; ++h) { float s = 0.f; for (int w = 0; w < 8; ++w) s += red[32 + w * 4 + h]; inv[h] = s > 0.f ? 1.0f / s : 0.f; }
    for (int n = tid; n < 1088; n += 512) phs[n] = n < NC ? (sc[n] * inv[0] + sc[1024 + n] * inv[1]) + (sc[2048 + n] * inv[2] + sc[3072 + n] * inv[3]) : 0.f;
    {
        float a[4] = {0.f, 0.f, 0.f, 0.f};
#pragma unroll 16
        for (int n = wid; n < NC; n += 8) {
            const float v = vc[(size_t)n * 64 + lane];
#pragma unroll
            for (int h = 0; h < 4; ++h) a[h] += sc[h * 1024 + n] * v;
        }
#pragma unroll
        for (int h = 0; h < 4; ++h) part[(wid * 4 + h) * 68 + lane] = a[h] * inv[h];
    }
    __syncthreads();
    if (tid < 256) { float a = 0.f; for (int w = 0; w < 8; ++w) a += part[(w * 4 + (tid >> 6)) * 68 + (tid & 63)]; ocp[tid] = a; }
    __syncthreads();
    if (wid == 0) {
        unsigned long long key[NJR];
#pragma unroll
        for (int jr = 0; jr < NJR; ++jr) {
            const int j = jr * 64 + lane;
            key[jr] = 0ull;
            if (j >= 1 && j <= qblk - 2 && j < NSEL) {
                float im = 0.f;
#pragma unroll
                for (int n = 4 * j - 1; n <= 4 * j + 3; ++n) im += (n < NC) ? phs[n] : 0.f;
                key[jr] = ((unsigned long long)__float_as_uint(im) << 32) | (unsigned)(0xFFFF - j) | 0x10000ull;
            }
        }
        if (lane == 0) { sel[0] = 0; sel[1] = qblk - 1; sel[2] = qblk; }
#pragma unroll 1
        for (int it = 0; it < 13; ++it) {
            unsigned long long best = 0ull;
#pragma unroll
            for (int jr = 0; jr < NJR; ++jr) best = key[jr] > best ? key[jr] : best;
#pragma unroll
            for (int o = 32; o > 0; o >>= 1) { const unsigned long long ot = __shfl_xor(best, o); best = ot > best ? ot : best; }
            const int j = 0xFFFF - (int)(best & 0xFFFFull);
#pragma unroll
            for (int jr = 0; jr < NJR; ++jr) if (key[jr] == best) key[jr] = 0ull;
            if (lane == 0) sel[3 + it] = j;
        }
    }
    __syncthreads();
    {
        float ms[4] = {-1e30f, -1e30f, -1e30f, -1e30f}, ls[4] = {0.f, 0.f, 0.f, 0.f}, os[4] = {0.f, 0.f, 0.f, 0.f};
#pragma unroll 1
        for (int i = wid; i < 16; i += 8) attn_chunk<true>(p, 1, b, g, t, sel[i] * 64, 0, t, ms, ls, os, qs, pbk, relb, lane);
        float mw[4] = {-1e30f, -1e30f, -1e30f, -1e30f}, lw[4] = {0.f, 0.f, 0.f, 0.f}, ow[4] = {0.f, 0.f, 0.f, 0.f};
#pragma unroll 1
        for (int c = wid; c < 9; c += 8) attn_chunk<true>(p, 2, b, g, t, t - 63 - 64 * c, t - WIN, t, mw, lw, ow, qs, pbk, relb, lane);
#pragma unroll
        for (int h = 0; h < 4; ++h) {
            LAS float* ps = part + (wid * 4 + h) * 68; LAS float* pw = part + 8 * 272 + (wid * 4 + h) * 68;
            ps[lane] = os[h]; pw[lane] = ow[h];
            if (lane == 0) { ps[64] = ms[h]; ps[65] = ls[h]; pw[64] = mw[h]; pw[65] = lw[h]; }
        }
    }
    __syncthreads();
    if (tid < 256) {
        const int h = tid >> 6, d = tid & 63;
        float res[2];
#pragma unroll
        for (int br = 0; br < 2; ++br) {
            const LAS float* pp = part + br * 8 * 272 + h * 68;
            float m = -1e30f;
            for (int w = 0; w < 8; ++w) m = fmaxf(m, pp[w * 272 + 64]);
            float l = 0.f, o = 0.f;
            for (int w = 0; w < 8; ++w) { const float sc_ = ex2(pp[w * 272 + 64] - m); l += pp[w * 272 + 65] * sc_; o += pp[w * 272 + d] * sc_; }
            res[br] = o / l;
        }
        const float* gt = p.GATE + (size_t)row * 32 + (g * 4 + h) * 3;
        const float v = gt[0] * ocp[tid] + gt[1] * res[0] + gt[2] * res[1];
        p.OCAT[(size_t)row * DM + (g * 4 + h) * 64 + d] = f2bf(v);
    }
    __syncthreads();
}

constexpr int A_OST = 0, OST_LD = 68, A_LST = A_OST + 256 * OST_LD * 4, A_M0 = A_LST + 1024, A_MB = A_M0 + 1024, MB_LD = 132, A_MKN = A_MB + 64 * MB_LD,
              A_LIST = A_MKN + 256, A_CNT = A_LIST + 132 * 64, A_PK = A_CNT + 544, A_KN = A_PK + 400 * 4, A_T2 = A_KN + 512, A_NP = A_T2 + 132 * 8 * 4, A_QT = A_NP + 16, ATT2_LDS = A_QT + 64 * 512;
static_assert(ATT2_LDS <= GEMM_LDS && ATTS_LDS <= GEMM_LDS, "attention LDS");

__device__ __forceinline__ void qk64(const bf16_t* kb, int c, int G, const bf16x8 (&qB)[2], f32x4 (&s)[4]) {
#pragma unroll
    for (int kt = 0; kt < 4; ++kt) {
        const bf16_t* r = kb + (size_t)(16 * kt + c) * 256 + G * 8;
        const bf16x8 a0 = *(const bf16x8*)r, a1 = *(const bf16x8*)(r + 32);
        s[kt] = mfma16(a0, qB[0], (f32x4){0.f, 0.f, 0.f, 0.f}); s[kt] = mfma16(a1, qB[1], s[kt]);
    }
}
__device__ __forceinline__ void pv64(const bf16_t* vf, int key0, int lane, const f32x4 (&pr)[4], f32x4 (&o)[4]) {
#pragma unroll
    for (int ks = 0; ks < 2; ++ks) {
        const bf16x8 pB = pack_p(pr[2 * ks], pr[2 * ks + 1]);
#pragma unroll
        for (int dt = 0; dt < 4; ++dt) {
            const bf16x8 vA = *(const bf16x8*)(vf + ((size_t)(((key0 >> 5) + ks) * 4 + dt) * 64 + lane) * 8);
            o[dt] = mfma16(vA, pB, o[dt]);
        }
    }
}
__device__ __forceinline__ int qt_off(int qi, int hh, int k) { return (qi * 4 + hh) * 128 + ((k ^ (((qi & 3) << 1) | (hh >> 1))) << 4); }
__device__ __forceinline__ float grp_max(float v) {
    auto r = __builtin_amdgcn_permlane16_swap(__float_as_uint(v), __float_as_uint(v), false, false); v = fmaxf(__uint_as_float(r[0]), __uint_as_float(r[1]));
    r = __builtin_amdgcn_permlane32_swap(__float_as_uint(v), __float_as_uint(v), false, false); return fmaxf(__uint_as_float(r[0]), __uint_as_float(r[1]));
}
__device__ __forceinline__ float grp_sum(float v) {
    auto r = __builtin_amdgcn_permlane16_swap(__float_as_uint(v), __float_as_uint(v), false, false); v = __uint_as_float(r[0]) + __uint_as_float(r[1]);
    r = __builtin_amdgcn_permlane32_swap(__float_as_uint(v), __float_as_uint(v), false, false); return __uint_as_float(r[0]) + __uint_as_float(r[1]);
}
__device__ __forceinline__ int grp_min_i(int v) {
    auto r = __builtin_amdgcn_permlane16_swap((unsigned)v, (unsigned)v, false, false); v = (int)r[0] < (int)r[1] ? (int)r[0] : (int)r[1];
    r = __builtin_amdgcn_permlane32_swap((unsigned)v, (unsigned)v, false, false); return (int)r[0] < (int)r[1] ? (int)r[0] : (int)r[1];
}
__device__ __forceinline__ float dpp_x1(float v) { return __uint_as_float(__builtin_amdgcn_mov_dpp(__float_as_uint(v), 0xB1, 0xF, 0xF, true)); }
__device__ __forceinline__ float dpp_x2(float v) { return __uint_as_float(__builtin_amdgcn_mov_dpp(__float_as_uint(v), 0x4E, 0xF, 0xF, true)); }
__device__ __forceinline__ int dpp_x1i(int v) { return (int)__builtin_amdgcn_mov_dpp((unsigned)v, 0xB1, 0xF, 0xF, true); }
__device__ __forceinline__ int dpp_x2i(int v) { return (int)__builtin_amdgcn_mov_dpp((unsigned)v, 0x4E, 0xF, 0xF, true); }
__device__ __forceinline__ unsigned row_or_q(unsigned u) {
    u |= __builtin_amdgcn_mov_dpp(u, 0x124, 0xF, 0xF, true); u |= __builtin_amdgcn_mov_dpp(u, 0x128, 0xF, 0xF, true); return u;
}

__device__ __forceinline__ void attn_cmp(const Params& p, int b, int g, int t0, int lane_, LAS unsigned char* L, unsigned (&msk)[4]) {
    f32x4 oacc[4];
    int lane = lane_; asm volatile("" : "+v"(lane));
    const int c = lane & 15, G = lane >> 4, qs = c >> 2, hh = c & 3;
    const int qb = t0 >> 6, tc = t0 + qs;
    const size_t qrow = (size_t)b * SEQ + tc;
    const LAS float* T2 = (const LAS float*)(L + A_T2);
    const float b31 = T2[128 * 8 + g * 4 + hh];
    bf16x8 qB[2];
    qB[0] = *(const bf16x8*)(p.Qb + qrow * QD + (g * 4 + hh) * 64 + G * 8); qB[1] = *(const bf16x8*)(p.Qb + qrow * QD + (g * 4 + hh) * 64 + 32 + G * 8);
    const float* gate = p.GATE + qrow * 32 + (g * 4 + hh) * 3;
    msk[0] = msk[1] = msk[2] = msk[3] = 0u;
    {
        const int ncv_c = tc >= 31 ? ((tc - 31) >> 4) + 1 : 0;
        const int ncv_m = t0 + 3 >= 31 ? ((t0 + 3 - 31) >> 4) + 1 : 0;
        const int NT = (ncv_m + 15) >> 4;
        const int mt_far = t0 >= 399 ? (t0 - 399) / 256 + 1 : 0;
        const bf16_t* kcb = p.KCb + (size_t)(b * NG + g) * 512 * 64;
        f32x4 sc[32];
        float mxf = -1e30f, mxn = -1e30f;
        bf16x8 kbuf[2][4][2];
        auto ldkg = [&](int grp, bf16x8 (&kb)[4][2]) __attribute__((always_inline)) {
#pragma unroll
            for (int q = 0; q < 4; ++q) { const bf16_t* r = kcb + ((size_t)((grp * 4 + q) * 2) * 64 + lane) * 8; kb[q][0] = *(const bf16x8*)r; kb[q][1] = *(const bf16x8*)(r + 512); }
        };
        ldkg(0, kbuf[0]);
#pragma unroll
        for (int grp = 0; grp < 8; ++grp) {
            if (4 * grp < NT) {
                if (4 * (grp + 1) < NT) ldkg(grp + 1, kbuf[(grp + 1) & 1]);
                __builtin_amdgcn_sched_barrier(0);
#pragma unroll
                for (int q = 0; q < 4; ++q) {
                    const int mt = grp * 4 + q;
                    f32x4 s = mfma16(kbuf[grp & 1][q][0], qB[0], (f32x4){0.f, 0.f, 0.f, 0.f}); s = mfma16(kbuf[grp & 1][q][1], qB[1], s);
                    if (mt < mt_far) { mxf = fmaxf(mxf, fmaxf(fmaxf(s[0], s[1]), fmaxf(s[2], s[3]))); }
                    else {
#pragma unroll
                        for (int i = 0; i < 4; ++i) { const int n = 16 * mt + 4 * G + i; int dist = tc - (16 * n + 31); const bool ok = n < ncv_c; dist = dist < 0 ? 0 : (dist > 128 ? 128 : dist);
                            s[i] = ok ? s[i] + T2[dist * 8 + g * 4 + hh] : -1e30f; }
                        mxn = fmaxf(mxn, fmaxf(fmaxf(s[0], s[1]), fmaxf(s[2], s[3])));
                    }
                    sc[mt] = s;
                }
            } else {
#pragma unroll
                for (int q = 0; q < 4; ++q) sc[grp * 4 + q] = (f32x4){0.f, 0.f, 0.f, 0.f};
            }
        }
        const float mx = grp_max(fmaxf(mxf + b31, mxn));
        const float shf = mx - b31;
#pragma unroll
        for (int mt = 0; mt < 32; ++mt) if ((mt & ~3) < NT) {
            const float sh = mt < mt_far ? shf : mx;
#pragma unroll
            for (int i = 0; i < 4; ++i) sc[mt][i] = ex2(sc[mt][i] - sh);
        }
        const bf16_t* vct = p.VCT + (size_t)(b * NG + g) * 64 * 512;
        const bf16x8 ones = __builtin_bit_cast(bf16x8, (u32x4){0x3F803F80u, 0x3F803F80u, 0x3F803F80u, 0x3F803F80u});
        f32x4 oc[4] = {{0.f, 0.f, 0.f, 0.f}, {0.f, 0.f, 0.f, 0.f}, {0.f, 0.f, 0.f, 0.f}, {0.f, 0.f, 0.f, 0.f}};
        f32x4 rs = {0.f, 0.f, 0.f, 0.f};
        bf16x8 vbuf[2][2][4];
        auto ldvg = [&](int grp, bf16x8 (&vb)[2][4]) __attribute__((always_inline)) {
#pragma unroll
            for (int q = 0; q < 2; ++q)
#pragma unroll
                for (int dt = 0; dt < 4; ++dt) vb[q][dt] = *(const bf16x8*)(vct + ((size_t)((grp * 2 + q) * 4 + dt) * 64 + lane) * 8);
        };
        ldvg(0, vbuf[0]);
#pragma unroll
        for (int grp = 0; grp < 8; ++grp) if (4 * grp < NT) {
            if (4 * (grp + 1) < NT) ldvg(grp + 1, vbuf[(grp + 1) & 1]);
            __builtin_amdgcn_sched_barrier(0);
#pragma unroll
            for (int q = 0; q < 2; ++q) {
                const int k2 = grp * 2 + q;
                const bf16x8 pB = pack_p(sc[2 * k2], sc[2 * k2 + 1]);
                rs = mfma16(ones, pB, rs);
#pragma unroll
                for (int dt = 0; dt < 4; ++dt) oc[dt] = mfma16(vbuf[grp & 1][q][dt], pB, oc[dt]);
            }
        }
        const float inv = ncv_c > 0 ? __builtin_amdgcn_rcpf(rs[0]) : 0.f;
        if (qb <= 15) {
            msk[0] = (qb >= 31) ? 0xffffffffu : ((2u << qb) - 1u);
        } else {
            unsigned cand[8];
#pragma unroll
            for (int k = 0; k < 8; ++k) cand[k] = 0u;
            float prevB = 0.f;
#pragma unroll
            for (int mt = 0; mt < 32; ++mt) if (mt < NT) {
                const unsigned x3 = __float_as_uint(sc[mt][3]);
                const auto p16 = __builtin_amdgcn_permlane16_swap(x3, x3, false, false);
                const auto p32 = __builtin_amdgcn_permlane32_swap(p16[1], p16[1], false, false);
                const float r1 = G == 2 ? __uint_as_float(p32[0]) : __uint_as_float(p16[0]);
                float v = ((sc[mt][0] + sc[mt][1]) + (sc[mt][2] + sc[mt][3]) + (G == 0 ? prevB : r1)) * inv;
                prevB = __uint_as_float(p32[1]);
                v += dpp_x1(v); v += dpp_x2(v);
                const int j = 4 * mt + G;
                if ((mt & 3) == hh) cand[mt >> 2] = (j >= 1 && j <= qb - 2) ? ((__float_as_uint(v) & ~127u) | (unsigned)(127 - j)) : 0u;
            }
            auto setbit = [&](int j) { const unsigned bit = 1u << (j & 31); const int w = j >> 5; msk[0] |= w == 0 ? bit : 0u; msk[1] |= w == 1 ? bit : 0u; msk[2] |= w == 2 ? bit : 0u; msk[3] |= w == 3 ? bit : 0u; };
            setbit(0); setbit(qb); setbit(qb - 1);
#pragma unroll 1
            for (int it = 0; it < 13; ++it) {
                unsigned bv = cand[0];
#pragma unroll
                for (int k = 1; k < 8; ++k) bv = bv > cand[k] ? bv : cand[k];
                { unsigned o = __builtin_amdgcn_mov_dpp(bv, 0xB1, 0xF, 0xF, true); bv = o > bv ? o : bv; o = __builtin_amdgcn_mov_dpp(bv, 0x4E, 0xF, 0xF, true); bv = o > bv ? o : bv;
                  auto r = __builtin_amdgcn_permlane16_swap(bv, bv, false, false); bv = r[0] > r[1] ? r[0] : r[1]; r = __builtin_amdgcn_permlane32_swap(bv, bv, false, false); bv = r[0] > r[1] ? r[0] : r[1]; }
#pragma unroll
                for (int k = 0; k < 8; ++k) cand[k] = cand[k] == bv ? 0u : cand[k];
                setbit(127 - (int)(bv & 127u));
            }
        }
        const float g0 = gate[0] * inv;
#pragma unroll
        for (int dt = 0; dt < 4; ++dt) oacc[dt] = oc[dt] * g0;
    }
    bf16_t* orow = p.OCAT + qrow * DM + (g * 4 + hh) * 64 + 4 * G;
#pragma unroll
    for (int dt = 0; dt < 4; ++dt) st_bf16x4(orow + dt * 16, oacc[dt]);
}

struct PackSt { bf16x8 q0, q1; float m; f32x4 l4; f32x4 o[4]; };
__device__ __forceinline__ void attn_selwin_pair(const Params& p, int b, int g, int t0, int lane_, LAS unsigned char* L, const unsigned (&mskA)[4], const unsigned (&mskB)[4]) {
    int lane = lane_; asm volatile("" : "+v"(lane));
    const int c = lane & 15, G = lane >> 4, qs = c >> 2, hh = c & 3;
    const int qb = t0 >> 6;
    const LAS float* T2 = (const LAS float*)(L + A_T2);
    const float b31 = T2[128 * 8 + g * 4 + hh];
    const int tcA = t0 + qs, tcB = t0 + 4 + qs;
    const size_t qrowA = (size_t)b * SEQ + tcA;
    PackSt A, B;
    {
        const bf16_t* qa = p.Qb + qrowA * QD + (g * 4 + hh) * 64 + G * 8;
        A.q0 = *(const bf16x8*)qa; A.q1 = *(const bf16x8*)(qa + 32); B.q0 = *(const bf16x8*)(qa + 4 * QD); B.q1 = *(const bf16x8*)(qa + 4 * QD + 32);
    }
    auto reset = [&](PackSt& S) __attribute__((always_inline)) { S.m = -1e30f; S.l4 = (f32x4){0.f, 0.f, 0.f, 0.f};
#pragma unroll
        for (int dt = 0; dt < 4; ++dt) S.o[dt] = (f32x4){0.f, 0.f, 0.f, 0.f}; };
    const bf16x8 ones = __builtin_bit_cast(bf16x8, (u32x4){0x3F803F80u, 0x3F803F80u, 0x3F803F80u, 0x3F803F80u});
    auto finish = [&](PackSt& S, f32x4 (&s)[4], float cb, bool mine, const bf16x8 (&vf)[2][4]) __attribute__((always_inline)) {
        float cm = fmaxf(fmaxf(fmaxf(s[0][0], s[0][1]), fmaxf(s[0][2], s[0][3])), fmaxf(fmaxf(s[1][0], s[1][1]), fmaxf(s[1][2], s[1][3])));
        cm = fmaxf(cm, fmaxf(fmaxf(fmaxf(s[2][0], s[2][1]), fmaxf(s[2][2], s[2][3])), fmaxf(fmaxf(s[3][0], s[3][1]), fmaxf(s[3][2], s[3][3]))));
        cm = grp_max(mine ? cm + cb : -1e30f);
        const float mn = fmaxf(S.m, cm), al = ex2(S.m - mn);
        const float sh = (mine ? mn : 1e30f) - cb;
#pragma unroll
        for (int kt = 0; kt < 4; ++kt)
#pragma unroll
            for (int i = 0; i < 4; ++i) s[kt][i] = ex2(s[kt][i] - sh);
        S.m = mn;
        f32x4 rs = {0.f, 0.f, 0.f, 0.f};
#pragma unroll
        for (int dt = 0; dt < 4; ++dt) S.o[dt] = S.o[dt] * al;
#pragma unroll
        for (int ks = 0; ks < 2; ++ks) { const bf16x8 pB = pack_p(s[2 * ks], s[2 * ks + 1]);
            rs = mfma16(ones, pB, rs);
#pragma unroll
            for (int dt = 0; dt < 4; ++dt) S.o[dt] = mfma16(vf[ks][dt], pB, S.o[dt]); }
        S.l4[0] = S.l4[0] * al + rs[0];
    };
    auto addout = [&](PackSt& S, size_t qrow, int br) __attribute__((always_inline)) {
        const float gs = p.GATE[qrow * 32 + (g * 4 + hh) * 3 + br] * __builtin_amdgcn_rcpf(S.l4[0]);
        bf16_t* orow = p.OCAT + qrow * DM + (g * 4 + hh) * 64 + 4 * G;
#pragma unroll
        for (int dt = 0; dt < 4; ++dt) { const u32x2 w = *(const u32x2*)(orow + dt * 16); f32x4 pa; pa[0] = bflo(w.x); pa[1] = bfhi(w.x); pa[2] = bflo(w.y); pa[3] = bfhi(w.y);
            st_bf16x4(orow + dt * 16, pa + S.o[dt] * gs); }
    };
    {
        unsigned umA[4], umB[4], um[4];
#pragma unroll
        for (int w = 0; w < 4; ++w) {
            umA[w] = __builtin_amdgcn_readfirstlane(row_or_q(mskA[w]));
            umB[w] = __builtin_amdgcn_readfirstlane(row_or_q(mskB[w]));
            um[w] = umA[w] | umB[w];
        }
        reset(A); reset(B);
        const bf16_t* klane = p.SLCkF + (size_t)(b * NG + g) * SEQ * 64 + lane * 8;
        const bf16_t* vlane = p.SLCvT + (size_t)(b * NG + g) * SEQ * 64 + lane * 8;
        auto ldfr = [&](int j_, bf16x8 (&kf_)[4][2], bf16x8 (&vf_)[2][4]) __attribute__((always_inline)) {
            const bf16_t* kr = klane + (size_t)j_ * 4096; const bf16_t* vr = vlane + (size_t)j_ * 4096;
#pragma unroll
            for (int kt = 0; kt < 4; ++kt) { kf_[kt][0] = *(const bf16x8*)(kr + (kt * 2) * 512); kf_[kt][1] = *(const bf16x8*)(kr + (kt * 2 + 1) * 512); }
#pragma unroll
            for (int ks = 0; ks < 2; ++ks)
#pragma unroll
                for (int dt = 0; dt < 4; ++dt) vf_[ks][dt] = *(const bf16x8*)(vr + (ks * 4 + dt) * 512);
        };
        auto nextj = [&](int& j_) __attribute__((always_inline)) {
            int w = um[0] ? 0 : um[1] ? 1 : um[2] ? 2 : um[3] ? 3 : -1;
            if (w < 0) return false;
            const unsigned u = w == 0 ? um[0] : w == 1 ? um[1] : w == 2 ? um[2] : um[3];
            const int bpos = __builtin_ctz(u);
            j_ = w * 32 + bpos;
            const unsigned cl = ~(1u << bpos);
            if (w == 0) um[0] &= cl; else if (w == 1) um[1] &= cl; else if (w == 2) um[2] &= cl; else um[3] &= cl;
            return true;
        };
        auto packstep = [&](PackSt& S, const unsigned (&msk)[4], int tc, int j, const bf16x8 (&kf)[4][2], const bf16x8 (&vf)[2][4]) __attribute__((always_inline)) {
            const unsigned mw = (j >> 5) == 0 ? msk[0] : (j >> 5) == 1 ? msk[1] : (j >> 5) == 2 ? msk[2] : msk[3];
            const bool mine = (mw >> (j & 31)) & 1u;
            const bool farb = j <= qb - 3;
            f32x4 s[4];
#pragma unroll
            for (int kt = 0; kt < 4; ++kt) { s[kt] = mfma16(kf[kt][0], S.q0, (f32x4){0.f, 0.f, 0.f, 0.f}); s[kt] = mfma16(kf[kt][1], S.q1, s[kt]); }
            if (!farb) {
#pragma unroll
                for (int kt = 0; kt < 4; ++kt)
#pragma unroll
                    for (int i = 0; i < 4; ++i) { const int dist = tc - (j * 64 + 16 * kt + 4 * G + i); const int dd = dist < 0 ? 0 : (dist > 128 ? 128 : dist);
                        s[kt][i] = dist >= 0 ? s[kt][i] + T2[dd * 8 + g * 4 + hh] : -1e30f; }
            }
            finish(S, s, farb ? b31 : 0.f, mine, vf);
        };
        auto blockstep = [&](int j, const bf16x8 (&kf)[4][2], const bf16x8 (&vf)[2][4]) __attribute__((always_inline)) {
            const int w = j >> 5; const unsigned bit = 1u << (j & 31);
            const unsigned ua = w == 0 ? umA[0] : w == 1 ? umA[1] : w == 2 ? umA[2] : umA[3];
            const unsigned ub = w == 0 ? umB[0] : w == 1 ? umB[1] : w == 2 ? umB[2] : umB[3];
            if (ua & bit) packstep(A, mskA, tcA, j, kf, vf);
            if (ub & bit) packstep(B, mskB, tcB, j, kf, vf);
        };
        auto ldk = [&](int j_, bf16x8 (&kf_)[4][2]) __attribute__((always_inline)) {
            const bf16_t* kr = klane + (size_t)j_ * 4096;
#pragma unroll
            for (int kt = 0; kt < 4; ++kt) { kf_[kt][0] = *(const bf16x8*)(kr + (kt * 2) * 512); kf_[kt][1] = *(const bf16x8*)(kr + (kt * 2 + 1) * 512); }
        };
        auto ldv = [&](int j_, bf16x8 (&vf_)[2][4]) __attribute__((always_inline)) {
            const bf16_t* vr = vlane + (size_t)j_ * 4096;
#pragma unroll
            for (int ks = 0; ks < 2; ++ks)
#pragma unroll
                for (int dt = 0; dt < 4; ++dt) vf_[ks][dt] = *(const bf16x8*)(vr + (ks * 4 + dt) * 512);
        };
        bf16x8 kfA[4][2], kfB[4][2], vf[2][4];
        int j = 0; bool have = nextj(j);
        ldk(j, kfA);
#pragma unroll 1
        while (have) {
            int jn = j; bool haven = nextj(jn);
            ldv(j, vf); ldk(jn, kfB);
            __builtin_amdgcn_sched_barrier(0);
            blockstep(j, kfA, vf);
            if (!haven) break;
            j = jn; have = nextj(jn);
            ldv(j, vf); ldk(jn, kfA);
            __builtin_amdgcn_sched_barrier(0);
            blockstep(j, kfB, vf);
            j = jn;
        }
        addout(A, qrowA, 1); addout(B, qrowA + 4, 1);
    }
    {
        reset(A); reset(B);
        const int loA = t0 - WIN > 0 ? t0 - WIN : 0, hiA = t0 + 3, loB = t0 + 4 - WIN > 0 ? t0 + 4 - WIN : 0, hiB = t0 + 7;
        const bf16_t* klane = p.WINkF + (size_t)(b * NG + g) * SEQ * 64 + lane * 8;
        const bf16_t* vlane = p.WINvT + (size_t)(b * NG + g) * SEQ * 64 + lane * 8;
        auto ldfr = [&](int cb_, bf16x8 (&kf_)[4][2], bf16x8 (&vf_)[2][4]) __attribute__((always_inline)) {
            const bf16_t* kr = klane + (size_t)cb_ * 64; const bf16_t* vr = vlane + (size_t)cb_ * 64;
#pragma unroll
            for (int kt = 0; kt < 4; ++kt) { kf_[kt][0] = *(const bf16x8*)(kr + (kt * 2) * 512); kf_[kt][1] = *(const bf16x8*)(kr + (kt * 2 + 1) * 512); }
#pragma unroll
            for (int ks = 0; ks < 2; ++ks)
#pragma unroll
                for (int dt = 0; dt < 4; ++dt) vf_[ks][dt] = *(const bf16x8*)(vr + (ks * 4 + dt) * 512);
        };
        auto packstep = [&](PackSt& S, int tq0, int tc, int cb, const bf16x8 (&kf)[4][2], const bf16x8 (&vf)[2][4]) __attribute__((always_inline)) {
            const bool far = (cb + 63 <= tq0 - 128) && (cb >= tq0 + 3 - WIN);
            f32x4 s[4];
#pragma unroll
            for (int kt = 0; kt < 4; ++kt) { s[kt] = mfma16(kf[kt][0], S.q0, (f32x4){0.f, 0.f, 0.f, 0.f}); s[kt] = mfma16(kf[kt][1], S.q1, s[kt]); }
            if (!far) {
#pragma unroll
                for (int kt = 0; kt < 4; ++kt)
#pragma unroll
                    for (int i = 0; i < 4; ++i) { const int dist = tc - (cb + 16 * kt + 4 * G + i); const bool ok = dist >= 0 && dist <= WIN; const int dd = dist < 0 ? 0 : (dist > 128 ? 128 : dist);
                        s[kt][i] = ok ? s[kt][i] + T2[dd * 8 + g * 4 + hh] : -1e30f; }
            }
            finish(S, s, far ? b31 : 0.f, true, vf);
        };
        auto chunkstep = [&](int cb, const bf16x8 (&kf)[4][2], const bf16x8 (&vf)[2][4]) __attribute__((always_inline)) {
            if (cb <= hiA) packstep(A, t0, tcA, cb, kf, vf);
            if (cb + 63 >= loB) packstep(B, t0 + 4, tcB, cb, kf, vf);
        };
        auto ldk = [&](int cb_, bf16x8 (&kf_)[4][2]) __attribute__((always_inline)) {
            const bf16_t* kr = klane + (size_t)cb_ * 64;
#pragma unroll
            for (int kt = 0; kt < 4; ++kt) { kf_[kt][0] = *(const bf16x8*)(kr + (kt * 2) * 512); kf_[kt][1] = *(const bf16x8*)(kr + (kt * 2 + 1) * 512); }
        };
        auto ldv = [&](int cb_, bf16x8 (&vf_)[2][4]) __attribute__((always_inline)) {
            const bf16_t* vr = vlane + (size_t)cb_ * 64;
#pragma unroll
            for (int ks = 0; ks < 2; ++ks)
#pragma unroll
                for (int dt = 0; dt < 4; ++dt) vf_[ks][dt] = *(const bf16x8*)(vr + (ks * 4 + dt) * 512);
        };
        bf16x8 kfA[4][2], kfB[4][2], vf[2][4];
        int cb = loA & ~63;
        ldk(cb, kfA);
#pragma unroll 1
        for (;;) {
            ldv(cb, vf); ldk(cb + 64 <= hiB ? cb + 64 : cb, kfB);
            __builtin_amdgcn_sched_barrier(0);
            chunkstep(cb, kfA, vf);
            cb += 64; if (cb > hiB) break;
            ldv(cb, vf); ldk(cb + 64 <= hiB ? cb + 64 : cb, kfA);
            __builtin_amdgcn_sched_barrier(0);
            chunkstep(cb, kfB, vf);
            cb += 64; if (cb > hiB) break;
        }
        addout(A, qrowA, 2); addout(B, qrowA + 4, 2);
    }
}

__device__ __forceinline__ void phase_attn(const Params& p) {
    const int wid = threadIdx.x >> 6, lane = threadIdx.x & 63;
    { PROBE_BEGIN(3)
    if (blockIdx.x < NS * NG) attn_sample_item(p, blockIdx.x >> 1, blockIdx.x & 1);
    PROBE_END(3) }
    LAS unsigned char* L = (LAS unsigned char*)smem;
    for (int i = threadIdx.x; i < 129 * 8; i += 512) ((LAS float*)(L + A_T2))[i] = p.rel_bias[t5_bucket(i >> 3) * 8 + (i & 7)] * LOG2E;
    __syncthreads();
    {
        const int wid2 = __builtin_amdgcn_readfirstlane(threadIdx.x >> 6);
#pragma unroll 1
        for (;;) {
            __syncthreads();
            if (threadIdx.x == 0) ((LAS int*)(L + A_NP))[1] = (int)__hip_atomic_fetch_add(p.bar, 1u, __ATOMIC_RELAXED, __HIP_MEMORY_SCOPE_AGENT);
            __syncthreads();
            const int T = ((const LAS int*)(L + A_NP))[1];
            if (T >= NB * NG * (SEQ / 64)) break;
            const int bg = T & 7, qb = (SEQ / 64 - 1) - (T >> 3), t0 = qb * 64 + wid2 * 8;
            unsigned mA[4], mB[4];
            PROBE_BEGIN(6)
            attn_cmp(p, bg >> 1, bg & 1, t0, lane, L, mA);
            attn_cmp(p, bg >> 1, bg & 1, t0 + 4, lane, L, mB);
            PROBE_END(6)
            PROBE_BEGIN(7)
            attn_selwin_pair(p, bg >> 1, bg & 1, t0, lane, L, mA, mB);
            PROBE_END(7)
        }
    }
    __syncthreads();
}

constexpr int GM_LD = 136, GM_LDS = 128 * GM_LD * 2 + 1024;
__device__ __forceinline__ void phase_gmlp(const Params& p) {
    int tid = threadIdx.x; asm volatile("" : "+v"(tid));
    const int wid = __builtin_amdgcn_readfirstlane(tid >> 6), lane = tid & 63;
    LAS bf16_t* vnT = (LAS bf16_t*)smem;
    LAS float* mu = (LAS float*)(smem + 128 * GM_LD * 2);
    const int c = lane & 15, G = lane >> 4;
#pragma unroll 1
    for (int u = blockIdx.x; u < NB * 64; u += gridDim.x) {
        const int b = u >> 6, ch = u & 63; const size_t row0 = (size_t)b * SEQ + ch * 128;
        __syncthreads();
        for (int r = wid; r < 128; r += 8) {
            const u32x4 w = *(const u32x4*)(p.Vg + (row0 + r) * GMD + lane * 8);
            const float x[8] = {bflo(w.x), bfhi(w.x), bflo(w.y), bfhi(w.y), bflo(w.z), bfhi(w.z), bflo(w.w), bfhi(w.w)};
            float s = 0.f;
#pragma unroll
            for (int i = 0; i < 8; ++i) s += x[i];
            const float mean = wave_sum(s) * (1.0f / GMD);
            float q = 0.f;
#pragma unroll
            for (int i = 0; i < 8; ++i) q += (x[i] - mean) * (x[i] - mean);
            const float var = wave_sum(q) * (1.0f / GMD);
            if (lane == 0) { mu[r] = mean; mu[128 + r] = rsqrtf(var + EPS); }
        }
#pragma unroll 1
        for (int g = 0; g < 4; ++g) {
            __syncthreads();
#pragma unroll
            for (int k = 0; k < 4; ++k) {
                const int e = tid + 512 * k, s = e & 127, d0 = (e >> 7) * 8;
                const u32x4 w = *(const u32x4*)(p.Vg + (row0 + s) * GMD + g * 128 + d0);
                const float x[8] = {bflo(w.x), bfhi(w.x), bflo(w.y), bfhi(w.y), bflo(w.z), bfhi(w.z), bflo(w.w), bfhi(w.w)};
                const float m = mu[s], rs = mu[128 + s];
#pragma unroll
                for (int i = 0; i < 8; ++i) { const int cc = g * 128 + d0 + i; vnT[(d0 + i) * GM_LD + s] = f2bf((x[i] - m) * rs * p.gm_ln_g[cc] + p.gm_ln_b[cc]); }
            }
            __syncthreads();
            f32x4 acc[8];
#pragma unroll
            for (int dt = 0; dt < 8; ++dt) acc[dt] = (f32x4){0.f, 0.f, 0.f, 0.f};
            const bf16_t* wrow = p.GWb + ((size_t)g * 128 + 16 * wid + c) * 128 + 8 * G;
#pragma unroll 1
            for (int ks = 0; ks <= (wid >> 1); ++ks) {
                const bf16x8 B = *(const bf16x8*)(wrow + 32 * ks);
#pragma unroll
                for (int dt = 0; dt < 8; ++dt) {
                    const bf16x8 A = *(const LAS bf16x8*)(vnT + (dt * 16 + c) * GM_LD + 32 * ks + 8 * G);
                    acc[dt] = mfma16(A, B, acc[dt]);
                }
            }
            const int t = 16 * wid + c;
            const float bs = p.gm_bs[g * 128 + t];
#pragma unroll
            for (int dt = 0; dt < 8; ++dt) {
                const int d = dt * 16 + 4 * G;
                const u32x2 uw = *(const u32x2*)(p.U + (row0 + t) * GMD + g * 128 + d);
                f32x4 o; o[0] = bflo(uw.x) * (acc[dt][0] + bs); o[1] = bfhi(uw.x) * (acc[dt][1] + bs); o[2] = bflo(uw.y) * (acc[dt][2] + bs); o[3] = bfhi(uw.y) * (acc[dt][3] + bs);
                st_bf16x4(p.OCAT + (row0 + t) * DM + QD + g * 128 + d, o);
            }
        }
    }
    for (int it = blockIdx.x * 8 + wid; it < NS; it += gridDim.x * 8) {
        const size_t row = (size_t)MP + it;
        const u32x4 w = *(const u32x4*)(p.Vg + row * GMD + lane * 8);
        const float x[8] = {bflo(w.x), bfhi(w.x), bflo(w.y), bfhi(w.y), bflo(w.z), bfhi(w.z), bflo(w.w), bfhi(w.w)};
        float s = 0.f;
#pragma unroll
        for (int i = 0; i < 8; ++i) s += x[i];
        const float mean = wave_sum(s) * (1.0f / GMD);
        float q = 0.f;
#pragma unroll
        for (int i = 0; i < 8; ++i) q += (x[i] - mean) * (x[i] - mean);
        const float rs = rsqrtf(wave_sum(q) * (1.0f / GMD) + EPS);
#pragma unroll
        for (int i = 0; i < 8; ++i) {
            const int c = lane * 8 + i, g = c >> 7;
            const float v = (x[i] - mean) * rs * p.gm_ln_g[c] + p.gm_ln_b[c];
            p.out[O_GMV + (size_t)it * GMD + c] = v;
            const float a = p.gm_ws[(size_t)g * 128 * 128] * v + p.gm_bs[g * 128];
            p.OCAT[row * DM + QD + c] = f2bf(bf2f(p.U[row * GMD + c]) * a);
        }
    }
}

template <int MODE>
__device__ __forceinline__ void phase_norm(const Params& p) {
    int tid = threadIdx.x; asm volatile("" : "+v"(tid));
    const int wid = tid >> 6, lane = tid & 63;
    const float* gpost = MODE == 0 ? p.ln_mix_post : MODE == 1 ? p.ln_ffn_post : p.ln_ple_post;
    for (int row = blockIdx.x * 8 + wid; row < MP + NS; row += gridDim.x * 8) {
        const bf16_t* fr = (const bf16_t*)p.F + (size_t)row * DM;
        const bf16_t* xb = MODE == 1 ? (const bf16_t*)p.X1 + (size_t)row * DM : p.X2b + (size_t)row * DM;
        f32x4 f[4], x[4];
#pragma unroll
        for (int k = 0; k < 4; ++k) { const u32x2 w = *(const u32x2*)(fr + lane * 4 + k * 256); f[k][0] = bflo(w.x); f[k][1] = bfhi(w.x); f[k][2] = bflo(w.y); f[k][3] = bfhi(w.y);
            if (MODE == 0) x[k] = *(const f32x4*)(xrow_ptr(p, row) + lane * 4 + k * 256);
            else { const u32x2 v = *(const u32x2*)(xb + lane * 4 + k * 256); x[k][0] = bflo(v.x); x[k][1] = bfhi(v.x); x[k][2] = bflo(v.y); x[k][3] = bfhi(v.y); } }
        const float r = row_rstd(f);
#pragma unroll
        for (int k = 0; k < 4; ++k) { const f32x4 g = *(const f32x4*)(gpost + lane * 4 + k * 256); x[k] = x[k] + f[k] * r * g; }
        if (MODE == 0) {
            const float r2 = row_rstd(x);
#pragma unroll
            for (int k = 0; k < 4; ++k) {
                st_bf16x4((bf16_t*)p.X1 + (size_t)row * DM + lane * 4 + k * 256, x[k]);
                const f32x4 g = *(const f32x4*)(p.ln_ffn_pre + lane * 4 + k * 256); const f32x4 o = x[k] * r2 * g;
                st_bf16x4(p.H2 + (size_t)row * DM + lane * 4 + k * 256, o);
            }
        } else if (MODE == 1) {
#pragma unroll
            for (int k = 0; k < 4; ++k) st_bf16x4(p.X2b + (size_t)row * DM + lane * 4 + k * 256, x[k]);
        } else {
            float* yr = row < MP ? p.out + O_YP + (size_t)row * DM : p.out + O_YS + (size_t)(row - MP) * DM;
#pragma unroll
            for (int k = 0; k < 4; ++k) __builtin_nontemporal_store(x[k], (f32x4*)(yr + lane * 4 + k * 256));
        }
    }
}


#define XB_TMO      128
#define XB_XCNT(j)  (256  + 64 * (j))
#define XB_XSUB(j)  (1280 + 64 * (j))
#define XB_XGEN(j)  (2304 + 64 * (j))
#define XB_TOP      3328
#define XB_TOPGEN   3392
#define XCD_BAR_WORDS 3456
#define XB_SPIN_CAP (1u << 22)

__device__ __forceinline__ unsigned xb_ld(unsigned* p)              { return __hip_atomic_load(p, __ATOMIC_RELAXED, __HIP_MEMORY_SCOPE_AGENT); }
__device__ __forceinline__ unsigned xb_add(unsigned* p, unsigned v) { return __hip_atomic_fetch_add(p, v, __ATOMIC_RELAXED, __HIP_MEMORY_SCOPE_AGENT); }
__device__ __forceinline__ unsigned xb_xcc_id() { return (unsigned)__builtin_amdgcn_s_getreg((3 << 11) | 20) & 0xFu; }
#define XB_SPIN(cond, bar) do { unsigned _sp = 0; while (cond) { __builtin_amdgcn_s_sleep(1); \
    if ((++_sp & 255u) == 0u) { if (xb_ld(&(bar)[XB_TMO])) break; if (_sp > XB_SPIN_CAP) { atomicAdd(&(bar)[XB_TMO], 1u); break; } } } } while (0)

struct XcdBarrier {
    unsigned* bar; unsigned x;
    volatile LAS unsigned* st;
};

__device__ __forceinline__ XcdBarrier xcd_barrier_post(unsigned* bar, volatile LAS unsigned* st) {
    XcdBarrier b; b.bar = bar; b.x = xb_xcc_id(); b.st = st;
    if (threadIdx.x == 0) (void)xb_add(&bar[XB_XCNT(b.x)], 1u);
    return b;
}
__device__ __forceinline__ void xcd_barrier_complete(unsigned* bar, unsigned x, unsigned& nloc, unsigned& nx) {
    const unsigned G = gridDim.x * gridDim.y * gridDim.z;
    unsigned sum, cnt, mine, sp = 0u;
    for (;;) {
        sum = 0u; cnt = 0u; mine = 0u;
#pragma unroll
        for (unsigned j = 0; j < 16; ++j) { const unsigned c = xb_ld(&bar[XB_XCNT(j)]); sum += c; cnt += (c > 0u) ? 1u : 0u; mine = (j == x) ? c : mine; }
        if (sum == G) break;
        __builtin_amdgcn_s_sleep(1);
        if ((++sp & 255u) == 0u) { if (xb_ld(&bar[XB_TMO])) break; if (sp > XB_SPIN_CAP) { atomicAdd(&bar[XB_TMO], 1u); break; } }
    }
    nloc = mine > 0u ? mine : 1u; nx = cnt > 0u ? cnt : 1u;
}

__device__ __forceinline__ void xcd_barrier(const XcdBarrier& b) {
    asm volatile("s_waitcnt vmcnt(0)" ::: "memory");
    __syncthreads();
    if (threadIdx.x == 0) {
        unsigned* bar = b.bar;
        __builtin_amdgcn_s_waitcnt(0);
        unsigned nloc = b.st[0], nx = b.st[1];
        if (nloc == 0u) { xcd_barrier_complete(bar, b.x, nloc, nx); b.st[0] = nloc; b.st[1] = nx; }
        const unsigned old = xb_add(&bar[XB_XSUB(b.x)], 1u);
        const unsigned gen = old / nloc;
        if (old + 1u == (gen + 1u) * nloc) {
            __builtin_amdgcn_fence(__ATOMIC_RELEASE, "agent");
            asm volatile("s_waitcnt vmcnt(0)" ::: "memory");
            const unsigned og = xb_add(&bar[XB_TOP], 1u);
            const unsigned tg = og / nx;
            if (og + 1u == (tg + 1u) * nx) xb_add(&bar[XB_TOPGEN], 1u);
            else XB_SPIN(xb_ld(&bar[XB_TOPGEN]) == tg, bar);
            __builtin_amdgcn_fence(__ATOMIC_ACQUIRE, "agent");
            xb_add(&bar[XB_XGEN(b.x)], 1u);
            asm volatile("s_waitcnt vmcnt(0)" ::: "memory");
        } else {
            XB_SPIN(xb_ld(&bar[XB_XGEN(b.x)]) == gen, bar);
            __builtin_amdgcn_fence(__ATOMIC_ACQUIRE, "agent");
            asm volatile("s_waitcnt vmcnt(0)" ::: "memory");
        }
    }
    __syncthreads();
}

constexpr int NPHASE = 16;
constexpr int LDS_BYTES = GEMM_LDS;
static_assert(GM_LDS <= LDS_BYTES, "lds");
constexpr int NMT = MALL / BM;

constexpr int NMP = MP / BM;
template <int PH>
__device__ __forceinline__ void run_phase(const Params& p) {
    if (PH == 0) phase_prologue(p);
    if (PH == 1) { EpiIn e{p}; if (blockIdx.x & 1) phase_gather(p); gemm_phase(p.H, DM, p.WinT, DM, NMP, INP / BM, e); gemm_skinny(p.H + (size_t)MP * DM, DM, p.WinT, DM, INP, e); if (!(blockIdx.x & 1)) phase_gather(p); }
    if (PH == 2) { EpiPart e{(bf16_t*)p.PART}; gemm_phase(p.CMPb, 4096, p.W1T, 1024, (2048 + NS * 1024) / BM, 1, e, 4, ZCmp(), 256); phase_deferred_transposes(p); }
    if (PH == 3) phase_cmp_final(p);
    if (PH == 4) phase_attn(p);
    if (PH == 5) phase_gmlp(p);
    if (PH == 6) { EpiBranch e{p.GA, p.GB, p.Y1}; gemm_phase<EpiBranch, ZNone, true>(p.OCAT, DM, p.WnT, DM, NMP, DM / BM, e); gemm_skinny2(p.OCAT + (size_t)MP * DM, DM, p.WnT, DM, DM, e); }
    if (PH == 8) { EpiBf16 e{(bf16_t*)p.F, DM}; gemm_phase(p.Y1, DM, p.WoT, DM, NMP, DM / BM, e); gemm_skinny(p.Y1 + (size_t)MP * DM, DM, p.WoT, DM, DM, e); }
    if (PH == 9) phase_norm<0>(p);
    if (PH == 10) { EpiSwiGLU e{p.ACT}; gemm_phase(p.H2, DM, p.WguT, DM, NMP, 2 * DFF / BM, e); gemm_skinny(p.H2 + (size_t)MP * DM, DM, p.WguT, DM, 2 * DFF, e); }
    if (PH == 11) { EpiBf16 e{(bf16_t*)p.F, DM}; gemm_phase(p.ACT, DFF, p.WdT, DFF, NMP, DM / BM, e); gemm_skinny(p.ACT + (size_t)MP * DFF, DFF, p.WdT, DFF, DM, e); }
    if (PH == 12) phase_norm<1>(p);
    if (PH == 13) { EpiBf16 e{(bf16_t*)p.T, DM}; gemm_phase(p.Pb, PLE, p.WpT, PLE, NMP, DM / BM, e); gemm_skinny(p.Pb + (size_t)MP * PLE, PLE, p.WpT, PLE, DM, e); }
    if (PH == 14) { EpiPleGate e{(const bf16_t*)p.T, (bf16_t*)p.F}; gemm_phase(p.X2b, DM, p.WpgT, DM, NMP, DM / BM, e); gemm_skinny(p.X2b + (size_t)MP * DM, DM, p.WpgT, DM, DM, e); }
    if (PH == 15) phase_norm<2>(p);
}

#ifndef MK_MULTI
#define MK_MULTI 0
#endif
template <int PH>
__global__ void __launch_bounds__(512, 2) k_phase(Params p) { run_phase<PH>(p); }

__global__ void __launch_bounds__(512, 2) k_all(Params p) {
    volatile LAS unsigned* st = (volatile LAS unsigned*)((LAS unsigned char*)smem + LDS_BYTES);
    if (threadIdx.x < 12) st[threadIdx.x] = 0u;
    __syncthreads();
    XcdBarrier bar = xcd_barrier_post(p.bar, st);
#if PROBE_DUP == 100
    run_phase<0>(p);  xcd_barrier(bar);
#endif
#if PROBE_SPIN >= 100
    if (threadIdx.x == 0) PROBE_TS[3] = probe_now();
#define PROBE_STAMP(k) if (threadIdx.x == 0 && PROBE_SEG == (k)) PROBE_TS[2] = probe_now() - PROBE_TS[3];
#else
#define PROBE_STAMP(k)
#endif
    run_phase<0>(p);  xcd_barrier(bar);
    PROBE_STAMP(20)
    run_phase<1>(p);  xcd_barrier(bar);
    PROBE_STAMP(21)
    run_phase<2>(p);  xcd_barrier(bar);
#if PROBE_DUP == 100
    run_phase<3>(p);  xcd_barrier(bar);
#endif
    run_phase<3>(p);  xcd_barrier(bar);
    PROBE_STAMP(23)
#if PROBE_DUP == 104
    run_phase<4>(p);  xcd_barrier(bar);
#endif
    run_phase<4>(p);
#if PROBE_DUP == 100
    run_phase<5>(p);  xcd_barrier(bar);
#endif
    run_phase<5>(p);  xcd_barrier(bar);
    PROBE_STAMP(25)
    run_phase<6>(p);  xcd_barrier(bar);
    run_phase<8>(p);  xcd_barrier(bar);
    PROBE_STAMP(28)
    run_phase<9>(p);  xcd_barrier(bar);
    PROBE_STAMP(29)
    run_phase<10>(p); xcd_barrier(bar);
    PROBE_STAMP(30)
    run_phase<11>(p); xcd_barrier(bar);
    PROBE_STAMP(31)
    run_phase<12>(p);
    run_phase<13>(p); xcd_barrier(bar);
    run_phase<14>(p); xcd_barrier(bar);
    PROBE_STAMP(34)
    run_phase<15>(p);
#if PROBE_SPIN
    if (blockIdx.x == 0 && threadIdx.x == 0) {
        const unsigned long long d = PROBE_TS[2] * (PROBE_SPIN >= 100 ? PROBE_SPIN - 100 : PROBE_SPIN), t0 = probe_now();
        while (probe_now() - t0 < d) __builtin_amdgcn_s_sleep(8);
    }
#endif
}

static inline size_t al256(size_t x) { return (x + 255) & ~(size_t)255; }
template <int PH> static void launch_phase(const Params& p, int grid, hipStream_t s) {
    static bool attr = false;
    if (!attr) { (void)hipFuncSetAttribute((const void*)k_phase<PH>, hipFuncAttributeMaxDynamicSharedMemorySize, LDS_BYTES); attr = true; }
    k_phase<PH><<<grid, 512, LDS_BYTES, s>>>(p);
}
template <int PH> static void launch_all(const Params& p, int grid, hipStream_t s) {
    launch_phase<PH>(p, grid, s);
    if constexpr (PH + 1 < NPHASE) launch_all<PH + 1>(p, grid, s);
}

extern "C" void kernel_launch(void* const* d_in, const int* in_sizes, int n_in, void* d_out, int out_size, void* d_ws, size_t ws_size, hipStream_t stream) {
    Params p{};
    p.x_prompt = (const float*)d_in[0]; p.x_sample = (const float*)d_in[1]; p.cache_cmp = (const float*)d_in[2]; p.cache_slc = (const float*)d_in[3];
    p.state_win = (const float*)d_in[4]; p.page_table = (const int*)d_in[5]; p.p_prompt = (const float*)d_in[6]; p.p_sample = (const float*)d_in[7];
    p.rel_bias = (const float*)d_in[8]; p.ln_mix_pre = (const float*)d_in[9]; p.w_in = (const float*)d_in[10];
    p.pe_k = (const float*)d_in[11]; p.w1_k = (const float*)d_in[12]; p.w2_k = (const float*)d_in[13];
    p.pe_v = (const float*)d_in[14]; p.w1_v = (const float*)d_in[15]; p.w2_v = (const float*)d_in[16];
    p.gm_ln_g = (const float*)d_in[17]; p.gm_ln_b = (const float*)d_in[18]; p.gm_ws = (const float*)d_in[19]; p.gm_bs = (const float*)d_in[20];
    p.w_br_nsa = (const float*)d_in[21]; p.w_br_gm = (const float*)d_in[22]; p.w_out = (const float*)d_in[23];
    p.ln_mix_post = (const float*)d_in[24]; p.ln_ffn_pre = (const float*)d_in[25]; p.w_gate = (const float*)d_in[26]; p.w_up = (const float*)d_in[27];
    p.w_down = (const float*)d_in[28]; p.ln_ffn_post = (const float*)d_in[29]; p.w_ple = (const float*)d_in[30]; p.w_ple_gate = (const float*)d_in[31];
    p.ln_ple_post = (const float*)d_in[32];
    p.out = (float*)d_out;
    unsigned char* w = (unsigned char*)d_ws; size_t off = 0;
    auto take = [&](size_t bytes) { void* r = w + off; off = al256(off + bytes); return r; };
    p.bar = (unsigned*)take(16384);
    p.WinT = (bf16_t*)take((size_t)INP * DM * 2); p.WnT = (bf16_t*)take((size_t)DM * DM * 2); p.WgT = nullptr;
    p.WoT = (bf16_t*)take((size_t)DM * DM * 2); p.WguT = (bf16_t*)take((size_t)2 * DFF * DM * 2); p.WdT = (bf16_t*)take((size_t)DM * DFF * 2);
    p.WpgT = (bf16_t*)take((size_t)DM * DM * 2); p.WpT = (bf16_t*)take((size_t)DM * PLE * 2); p.W1T = (bf16_t*)take((size_t)2 * 256 * 1024 * 2);
    p.H = (bf16_t*)take((size_t)MALL * DM * 2); p.Qb = (bf16_t*)take((size_t)MALL * QD * 2);
    p.CMPb = (bf16_t*)take(((size_t)MP + (size_t)NS * PAST) * 256 * 2); p.SLCb = (bf16_t*)take((size_t)MALL * 256 * 2); p.WINb = (bf16_t*)take((size_t)MALL * 256 * 2);
    p.U = (bf16_t*)take((size_t)MALL * GMD * 2); p.Vg = (bf16_t*)take((size_t)MALL * GMD * 2);
    p.GA = (bf16_t*)take((size_t)MALL * DM * 2); p.GB = (bf16_t*)take((size_t)MALL * DM * 2);
    p.GATE = (float*)take((size_t)MALL * 32 * 4);
    p.PART = (float*)take((size_t)(2048 + NS * 1024) * 4 * 256 * 4); p.PEB = (float*)take(256 * 4);
    p.KCP = (float*)take((size_t)NB * NG * 512 * 64 * 4); p.VCP = (float*)take((size_t)NB * NG * 512 * 64 * 4);
    p.KCS = (float*)take((size_t)NS * NG * 1024 * 64 * 4); p.VCS = (float*)take((size_t)NS * NG * 1024 * 64 * 4); p.KN = (float*)take(NB * NG * 128 * 4);
    p.KCb = (bf16_t*)take((size_t)NB * NG * 512 * 64 * 2); p.VCT = (bf16_t*)take((size_t)NB * NG * 64 * 512 * 2);
    p.SLCvT = (bf16_t*)take((size_t)NB * NG * 64 * SEQ * 2); p.WINvT = (bf16_t*)take((size_t)NB * NG * 64 * SEQ * 2);
    p.GWb = (bf16_t*)take(4 * 128 * 128 * 2); p.W2T = (bf16_t*)take(2 * 64 * 128 * 2);
    p.SLCkF = (bf16_t*)take((size_t)NB * NG * 64 * SEQ * 2); p.WINkF = (bf16_t*)take((size_t)NB * NG * 64 * SEQ * 2);
    p.OCAT = (bf16_t*)take((size_t)MALL * DM * 2); p.T = (float*)take((size_t)MALL * DM * 4); p.Y1 = (bf16_t*)take((size_t)MALL * DM * 2);
    p.F = (float*)take((size_t)MALL * DM * 4); p.X1 = (float*)take((size_t)MALL * DM * 4); p.H2 = (bf16_t*)take((size_t)MALL * DM * 2);
    p.ACT = (bf16_t*)take((size_t)MALL * DFF * 2); p.X2 = (float*)take((size_t)MALL * DM * 4); p.X2b = (bf16_t*)take((size_t)MALL * DM * 2);
    p.Pb = (bf16_t*)take((size_t)MALL * PLE * 2);
    if (off > ws_size) { fprintf(stderr, "workspace too small: need %zu have %zu\n", off, ws_size); return; }
#if MK_MULTI
    launch_all<0>(p, 256, stream);
#else
    constexpr size_t kDynLds = LDS_BYTES + 48;
    static int grid = 0;
    if (!grid) {
        int dev = 0, cus = 0, per_cu = 0;
        (void)hipGetDevice(&dev);
        (void)hipDeviceGetAttribute(&cus, hipDeviceAttributeMultiprocessorCount, dev);
        (void)hipFuncSetAttribute((const void*)k_all, hipFuncAttributeMaxDynamicSharedMemorySize, (int)kDynLds);
        (void)hipOccupancyMaxActiveBlocksPerMultiprocessor(&per_cu, (const void*)k_all, 512, kDynLds);
        grid = cus * (per_cu < 1 ? per_cu : 1);
        if (grid <= 0) { fprintf(stderr, "k_all: occupancy query says %d blocks per CU\n", per_cu); grid = 0; return; }
    }
    (void)hipMemsetAsync(p.bar, 0, XCD_BAR_WORDS * sizeof(unsigned), stream);
    k_all<<<grid, 512, kDynLds, stream>>>(p);
#endif
}
```

```cpp
#include <hip/hip_runtime.h>
#include <stdint.h>
#include <cstdio>

typedef unsigned short bf16_t;
typedef short bf16x8 __attribute__((ext_vector_type(8)));
typedef float f32x4 __attribute__((ext_vector_type(4)));
typedef float f32x2 __attribute__((ext_vector_type(2)));
typedef unsigned u32x4 __attribute__((ext_vector_type(4)));
typedef unsigned u32x2 __attribute__((ext_vector_type(2)));
#define LAS __attribute__((address_space(3)))

constexpr int DM = 1024, NB = 4, SEQ = 8192, MP = NB * SEQ, NS = 32, MALL = MP + 256, PAST = 16384, PAGE = 128, NPG = 128;
constexpr int NH = 8, NG = 2, HPG = 4, DH = 64, QD = 512, WIN = 512, GMD = 512, DFF = 2816, PLE = 256, IND = 4376, INP = 4608;
constexpr int NCP = 511, NCS = 1023;
constexpr float EPS = 1e-6f;
constexpr float LOG2E = 1.4426950408889634f, QSCALE = 0.125f * LOG2E;
constexpr long O_YP = 0, O_YS = 33554432, O_CMPP = 33587200, O_SLCP = 41975808, O_WINP = 50364416, O_CMPS = 50888704,
               O_SLCS = 50896896, O_WINS = 50905088, O_GMV = 55099392;

struct Params {
    const float *x_prompt, *x_sample, *cache_cmp, *cache_slc, *state_win; const int* page_table;
    const float *p_prompt, *p_sample, *rel_bias, *ln_mix_pre, *w_in, *pe_k, *w1_k, *w2_k, *pe_v, *w1_v, *w2_v;
    const float *gm_ln_g, *gm_ln_b, *gm_ws, *gm_bs, *w_br_nsa, *w_br_gm, *w_out, *ln_mix_post, *ln_ffn_pre;
    const float *w_gate, *w_up, *w_down, *ln_ffn_post, *w_ple, *w_ple_gate, *ln_ple_post;
    float* out;
    unsigned* bar;
    bf16_t *WinT, *WnT, *WgT, *WoT, *WguT, *WdT, *WpgT, *WpT, *W1T;
    bf16_t *H, *Qb, *CMPb, *SLCb, *WINb, *U, *Vg, *GA, *GB;
    float* GATE;
    float *PART, *PEB, *KCP, *VCP, *KCS, *VCS, *KN;
    bf16_t *KCb, *VCT, *SLCvT, *WINvT, *SLCkF, *WINkF, *GWb, *W2T;
    bf16_t* OCAT; float* T; bf16_t* Y1; float* F; float* X1; bf16_t* H2; bf16_t* ACT; float* X2; bf16_t* X2b; bf16_t* Pb;
};

typedef __bf16 bf16v2_t __attribute__((ext_vector_type(2)));
__device__ __forceinline__ unsigned cvt_pk_bf16(float lo, float hi) { const f32x2 v = {lo, hi}; return __builtin_bit_cast(unsigned, __builtin_convertvector(v, bf16v2_t)); }
__device__ __forceinline__ unsigned cvt_pk_bf16_t(float lo, float hi) { unsigned r; asm volatile("s_nop 1\n\tv_cvt_pk_bf16_f32 %0, %1, %2" : "=v"(r) : "v"(lo), "v"(hi)); return r; }
__device__ __forceinline__ bf16_t f2bf(float f) { return (bf16_t)(cvt_pk_bf16(f, 0.f) & 0xffffu); }
__device__ __forceinline__ float bf2f(bf16_t h) { return __uint_as_float(((unsigned)h) << 16); }
__device__ __forceinline__ float bflo(unsigned w) { return __uint_as_float(w << 16); }
__device__ __forceinline__ float bfhi(unsigned w) { return __uint_as_float(w & 0xffff0000u); }
__device__ __forceinline__ float ex2(float x) { return __builtin_amdgcn_exp2f(x); }
__device__ __forceinline__ float sigmoidf_(float x) { return __builtin_amdgcn_rcpf(1.0f + __builtin_amdgcn_exp2f(x * -1.4426950408889634f)); }
__device__ __forceinline__ float siluf_(float x) { return x * sigmoidf_(x); }
__device__ __forceinline__ float sigmoid_fast(float x) { return __builtin_amdgcn_rcpf(1.0f + __builtin_amdgcn_exp2f(x * -1.4426950408889634f)); }
__device__ __forceinline__ float gelu_fast(float x) {
    const float t = x * (-2.0f * 0.7978845608028654f * 1.4426950408889634f) * (1.0f + 0.044715f * x * x);
    return x * __builtin_amdgcn_rcpf(1.0f + __builtin_amdgcn_exp2f(t));
}
__device__ __forceinline__ float silu_fast(float x) { return x * __builtin_amdgcn_rcpf(1.0f + __builtin_amdgcn_exp2f(x * -1.4426950408889634f)); }
__device__ __forceinline__ float geluf_(float x) {
    const float u = 0.7978845608028654f * (x + 0.044715f * x * x * x);
    const float e = __expf(2.0f * u);
    const float th = 1.0f - 2.0f / (e + 1.0f);
    return 0.5f * x * (1.0f + th);
}
__device__ __forceinline__ float wave_sum(float v) {
#pragma unroll
    for (int o = 32; o > 0; o >>= 1) v += __shfl_xor(v, o);
    return v;
}
__device__ __forceinline__ float wave_max(float v) {
#pragma unroll
    for (int o = 32; o > 0; o >>= 1) v = fmaxf(v, __shfl_xor(v, o));
    return v;
}
__device__ __forceinline__ int t5_bucket(int d) {
    if (d < 16) return d;
    if (d >= 128) return 31;
    const int b = 16 + (int)(__logf((float)d * (1.0f / 16.0f)) * (16.0f / 2.0794415416798357f));
    return b < 31 ? b : 31;
}

extern __shared__ __attribute__((aligned(16))) unsigned char smem[];
#ifndef PROBE_DUP
#define PROBE_DUP 0
#endif
#define PROBE_LDS_OFF 131072
#ifndef PROBE_SPIN
#define PROBE_SPIN 0
#endif
#ifndef PROBE_SEG
#define PROBE_SEG 5
#endif
__device__ __forceinline__ unsigned long long probe_now() { unsigned long long t; asm volatile("s_memrealtime %0\n\ts_waitcnt lgkmcnt(0)" : "=s"(t) :: "memory"); return t; }
#define PROBE_TS ((volatile LAS unsigned long long*)((LAS unsigned char*)smem + PROBE_LDS_OFF + 16))
#if PROBE_SPIN
#define PROBE_BEGIN(seg) unsigned long long pb_##seg = 0; if (PROBE_SEG == seg && threadIdx.x == 0) pb_##seg = probe_now();
#define PROBE_END(seg) if (PROBE_SEG == seg && threadIdx.x == 0) { PROBE_TS[2] = PROBE_TS[2] + (probe_now() - pb_##seg); }
#else
#define PROBE_BEGIN(seg)
#define PROBE_END(seg)
#endif

constexpr int BM = 256, BK = 64, HALF = 128, HT = HALF * BK, GEMM_LDS = 8 * HT * 2;
__device__ __forceinline__ int lds_byte(int r, int c) { const int st = (r >> 4) * 2 + (c >> 5), rr = r & 15, cc = c & 31, ob = rr * 64 + cc * 2; return st * 1024 + (ob ^ (((ob >> 9) & 1) << 5)); }
__device__ __forceinline__ void stage_rc(int b, int& R, int& C) { const int st = b / 1024, sb = b % 1024, swz = sb ^ (((sb >> 9) & 1) << 5); R = (st >> 1) * 16 + swz / 64; C = (st & 1) * 32 + (swz % 64) / 2; }

constexpr int HTB = HALF * BK * 2;
template <class F>
__device__ __forceinline__ void for_each_frag(const f32x4 (&acc)[2][2][4][2], int brow, int bcol, int wr, int wc, int fr, int fq, F&& f) {
#pragma unroll
    for (int ai = 0; ai < 2; ++ai)
#pragma unroll
        for (int m = 0; m < 4; ++m)
#pragma unroll
            for (int bj = 0; bj < 2; ++bj)
#pragma unroll
                for (int n = 0; n < 2; ++n)
                    f(brow + ai * HALF + wr * 64 + m * 16 + fr, bcol + bj * HALF + wc * 32 + n * 16 + fq * 4, acc[ai][bj][m][n]);
}

__host__ __device__ __forceinline__ int inv_a(int ca) { return ((ca >> 5) & 1) * 128 + (ca >> 6) * 32 + ((ca >> 2) & 1) * 16 + ((ca >> 3) & 3) * 4 + (ca & 3); }
__host__ __device__ __forceinline__ int row_a(int n) { return (n & ~255) + inv_a(n & 255); }
__host__ __device__ __forceinline__ int inv_s(int o, int s) { return ((o >> 2) & 1) * 128 + (o >> 5) * 32 + ((o >> 1) & 1) * 16 + ((o >> 3) & 3) * 4 + (o & 1) * 2 + s; }
__host__ __device__ __forceinline__ int row_s(int n, int s) { return (n >> 7) * 256 + inv_s(n & 127, s); }
__host__ __device__ __forceinline__ int lcol_a(int r) { const int cg = r & 255; return (r & ~255) + ((cg >> 5) & 3) * 64 + (cg >> 7) * 32 + ((cg >> 2) & 3) * 8 + ((cg >> 4) & 1) * 4; }
__host__ __device__ __forceinline__ int lcol_s(int r) { const int cg = r & 255; return (r & ~255) + 2 * (((cg >> 5) & 3) * 32 + ((cg >> 2) & 3) * 8 + (cg >> 7) * 4 + ((cg >> 4) & 1) * 2); }
template <class F>
__device__ __forceinline__ void for_each_frag8(const f32x4 (&acc)[2][2][4][2], int brow, int bcol, int wr, int wc, int fr, int fq, F&& f) {
#pragma unroll
    for (int ai = 0; ai < 2; ++ai)
#pragma unroll
        for (int m = 0; m < 4; ++m)
#pragma unroll
            for (int bj = 0; bj < 2; ++bj)
                f(brow + ai * HALF + wr * 64 + m * 16 + fr, bcol + wc * 64 + bj * 32 + fq * 8, acc[ai][bj][m][0], acc[ai][bj][m][1]);
}

struct ZNone { __device__ __forceinline__ size_t a(int) const { return 0; } __device__ __forceinline__ size_t b(int) const { return 0; } };
template <class Epi, class ZMap = ZNone, bool HAS_MID = false>
__device__ __forceinline__ void gemm_phase(const bf16_t* A, int lda, const bf16_t* Bt, int K, int nM, int nN, const Epi& E, int nZ = 1, ZMap zm = ZMap(), int kstepA_el = BK) {
    LAS unsigned char* lds = (LAS unsigned char*)smem;
    int tid = threadIdx.x; asm volatile("" : "+v"(tid));
    const int wid = __builtin_amdgcn_readfirstlane(tid >> 6), lane = tid & 63, wr = wid >> 2, wc = wid & 3, fr = lane & 15, fq = lane >> 4;
    const int nt = K / BK, nmn = nM * nN, nu = nmn * nZ, G = gridDim.x;
    int u = blockIdx.x;
    if (u >= nu) return;
    unsigned voffA[2], voffB[2];
#pragma unroll
    for (int i = 0; i < 2; ++i) { int R, C; stage_rc(tid * 16 + i * 8192, R, C); voffA[i] = (unsigned)(R * lda + C) * 2u; voffB[i] = (unsigned)(R * K + C) * 2u; }
    const size_t kstep = (size_t)(BK * 2), kstepA = (size_t)kstepA_el * 2;
    const size_t hstepA = (size_t)HALF * lda * 2, hstepB = (size_t)HALF * K * 2, tstepA = 2 * hstepA, tstepB = 2 * hstepB;
    const unsigned ldsw = (unsigned)wid * 1024u;
    const int aoff = lds_byte(wr * 64 + fr, fq * 8), boff = lds_byte(wc * 32 + fr, fq * 8);
#define PG8_SA(b, h) (((b) * 2 + (h)) * HTB)
#define PG8_SB(b, h) ((4 + (b) * 2 + (h)) * HTB)
#define PG8_STAGE(bufoff, gbase, voff) do { _Pragma("unroll") for (int _i = 0; _i < 2; ++_i) \
        __builtin_amdgcn_global_load_lds((const unsigned*)((const char*)(gbase) + (voff)[_i]), (LAS unsigned*)(lds + (bufoff) + ldsw + _i * 8192), 16, 0, 0); } while (0)
#define PG8_LDA(dst, b, h) do { _Pragma("unroll") for (int m = 0; m < 4; ++m) _Pragma("unroll") for (int k = 0; k < 2; ++k) dst[m][k] = *(const LAS bf16x8*)(lds + PG8_SA(b, h) + aoff + m * 2048 + k * 1024); } while (0)
#define PG8_LDB(dst, b, h) do { _Pragma("unroll") for (int n = 0; n < 2; ++n) _Pragma("unroll") for (int k = 0; k < 2; ++k) dst[n][k] = *(const LAS bf16x8*)(lds + PG8_SB(b, h) + boff + n * 2048 + k * 1024); } while (0)
#define PG8_MMA(ai, bj, At, Bt_) do { __builtin_amdgcn_s_setprio(1); _Pragma("unroll") for (int m = 0; m < 4; ++m) _Pragma("unroll") for (int n = 0; n < 2; ++n) _Pragma("unroll") for (int k = 0; k < 2; ++k) \
        acc[ai][bj][m][n] = __builtin_amdgcn_mfma_f32_16x16x32_bf16(Bt_[n][k], At[m][k], acc[ai][bj][m][n], 0, 0, 0); __builtin_amdgcn_s_setprio(0); } while (0)
#define PG8_WAIT_V(n) asm volatile("s_waitcnt vmcnt(" #n ")" ::: "memory")
#define PG8_WAIT_L(n) asm volatile("s_waitcnt lgkmcnt(" #n ")" ::: "memory")
#define PG8_BAR __builtin_amdgcn_s_barrier()
#define PG8_SCHED __builtin_amdgcn_sched_barrier(0)
    f32x4 acc[2][2][4][2];
#pragma unroll
    for (int a = 0; a < 2; ++a)
#pragma unroll
        for (int b = 0; b < 2; ++b)
#pragma unroll
            for (int m = 0; m < 4; ++m)
#pragma unroll
                for (int n = 0; n < 2; ++n) acc[a][b][m][n] = (f32x4){0.f, 0.f, 0.f, 0.f};
    bf16x8 At[4][2], B0[2][2], B1[2][2];
    auto unit_of = [&](int uu, int& z_, int& pm_, int& pn_) {
        if (nZ == 1) {
            int wg = uu; { const int q = nu / 8, r = nu % 8, xcd = wg % 8, off = wg / 8; wg = (xcd < r ? xcd * (q + 1) : r * (q + 1) + (xcd - r) * q) + off; }
            const int nig = 8 * nN, gid = wg / nig, fm = gid * 8, gsz = (nM - fm) < 8 ? (nM - fm) : 8;
            z_ = 0; pm_ = fm + ((wg % nig) % gsz); pn_ = (wg % nig) / gsz;
        } else { z_ = uu / nmn; pm_ = (uu - z_ * nmn) / nN; pn_ = (uu - z_ * nmn) - pm_ * nN; }
    };
    int z, pm, pn; unit_of(u, z, pm, pn);
    const char* cA = (const char*)(A + zm.a(z)) + (size_t)pm * tstepA; const char* cB = (const char*)(Bt + zm.b(z)) + (size_t)pn * tstepB;
    PG8_STAGE(PG8_SB(0, 0), cB, voffB); PG8_STAGE(PG8_SA(0, 0), cA, voffA); PG8_STAGE(PG8_SB(0, 1), cB + hstepB, voffB); PG8_STAGE(PG8_SA(0, 1), cA + hstepA, voffA);
    if (wr == 1) PG8_BAR;
    PG8_WAIT_V(4); PG8_BAR;
    PG8_STAGE(PG8_SB(1, 0), cB + kstep, voffB); PG8_STAGE(PG8_SA(1, 0), cA + kstepA, voffA); PG8_STAGE(PG8_SB(1, 1), cB + hstepB + kstep, voffB);
    PG8_WAIT_V(6); PG8_BAR;
    for (;;) {
        const int un = u + G; const bool has_next = un < nu;
        int nz = z, npm = pm, npn = pn; if (has_next) unit_of(un, nz, npm, npn);
        const char* nA = (const char*)(A + zm.a(nz)) + (size_t)npm * tstepA; const char* nB = (const char*)(Bt + zm.b(nz)) + (size_t)npn * tstepB;
        auto kiter = [&](int t) {
            const bool last = (t == nt - 2);
            const bool bnd = last || (HAS_MID && t == (nt >> 1) - 2);
            const char* a1 = cA + (size_t)(t + 1) * kstepA;
            const char* a2 = last ? nA : cA + (size_t)(t + 2) * kstepA; const char* b2 = last ? nB : cB + (size_t)(t + 2) * kstep;
            const char* a3 = a2 + kstepA; const char* b3 = b2 + kstep;
            PG8_LDB(B0, 0, 0); PG8_SCHED; PG8_LDA(At, 0, 0); PG8_STAGE(PG8_SA(1, 1), a1 + hstepA, voffA);
            PG8_WAIT_L(8); PG8_BAR; PG8_WAIT_L(0); PG8_MMA(0, 0, At, B0); PG8_BAR; PG8_SCHED;
            PG8_LDB(B1, 0, 1); PG8_STAGE(PG8_SB(0, 0), b2, voffB);
            PG8_BAR; PG8_WAIT_L(0); PG8_MMA(0, 1, At, B1); PG8_BAR;
            PG8_LDA(At, 0, 1); PG8_STAGE(PG8_SA(0, 0), a2, voffA);
            PG8_BAR; PG8_WAIT_L(0); PG8_MMA(1, 0, At, B0); PG8_BAR; PG8_SCHED;
            PG8_STAGE(PG8_SB(0, 1), b2 + hstepB, voffB);
            PG8_WAIT_V(6); PG8_BAR; PG8_MMA(1, 1, At, B1); PG8_BAR;
            PG8_LDB(B0, 1, 0); PG8_SCHED; PG8_LDA(At, 1, 0); PG8_STAGE(PG8_SA(0, 1), a2 + hstepA, voffA);
            PG8_WAIT_L(8); PG8_BAR; PG8_WAIT_L(0); PG8_MMA(0, 0, At, B0); PG8_BAR; PG8_SCHED;
            PG8_LDB(B1, 1, 1); PG8_STAGE(PG8_SB(1, 0), b3, voffB);
            PG8_BAR; PG8_WAIT_L(0); PG8_MMA(0, 1, At, B1); PG8_BAR;
            PG8_LDA(At, 1, 1); PG8_STAGE(PG8_SA(1, 0), a3, voffA);
            PG8_BAR; PG8_WAIT_L(0); PG8_MMA(1, 0, At, B0); PG8_BAR; PG8_SCHED;
            PG8_STAGE(PG8_SB(1, 1), b3 + hstepB, voffB);
            PG8_WAIT_V(6); PG8_BAR; PG8_MMA(1, 1, At, B1);
            if (!(bnd && wr == 1)) PG8_BAR;
        };
        if constexpr (HAS_MID) {
            for (int t = 0; t < (nt >> 1); t += 2) kiter(t);
            { int pmo = pm, pno = pn; asm volatile("" : "+s"(pmo), "+s"(pno));
              E.mid(acc, pmo * BM, pno * BM, wr, wc, fr, fq); }
            PG8_SCHED; PG8_BAR; if (wr == 1) PG8_BAR;
            for (int t = nt >> 1; t < nt; t += 2) kiter(t);
        } else {
            for (int t = 0; t < nt; t += 2) kiter(t);
        }
        { int pmo = pm, pno = pn; asm volatile("" : "+s"(pmo), "+s"(pno));
          E(acc, pmo * BM, pno * BM + (z << 20), wr, wc, fr, fq); }
        PG8_SCHED; PG8_BAR;
        if (!has_next) break;
        if (wr == 1) PG8_BAR;
#pragma unroll
        for (int a = 0; a < 2; ++a)
#pragma unroll
            for (int b = 0; b < 2; ++b)
#pragma unroll
                for (int m = 0; m < 4; ++m)
#pragma unroll
                    for (int n = 0; n < 2; ++n) acc[a][b][m][n] = (f32x4){0.f, 0.f, 0.f, 0.f};
        u = un; z = nz; pm = npm; pn = npn; cA = nA; cB = nB;
    }
    PG8_WAIT_V(0);
    PG8_BAR;
#undef PG8_SA
#undef PG8_SB
#undef PG8_STAGE
#undef PG8_LDA
#undef PG8_LDB
#undef PG8_MMA
#undef PG8_WAIT_V
#undef PG8_WAIT_L
#undef PG8_BAR
#undef PG8_SCHED
}

__device__ __forceinline__ f32x4 mfma16(bf16x8 a, bf16x8 b, f32x4 c) { return __builtin_amdgcn_mfma_f32_16x16x32_bf16(a, b, c, 0, 0, 0); }
__device__ __forceinline__ bf16x8 pack_p(const f32x4& a, const f32x4& b) {
    u32x4 w; w.x = cvt_pk_bf16(a[0], a[1]); w.y = cvt_pk_bf16(a[2], a[3]); w.z = cvt_pk_bf16(b[0], b[1]); w.w = cvt_pk_bf16(b[2], b[3]);
    return __builtin_bit_cast(bf16x8, w);
}
__device__ __forceinline__ size_t kfrag_off(int key, int d) { return ((size_t)((key >> 4) * 2 + (d >> 5)) * 64 + ((d >> 3) & 3) * 16 + (key & 15)) * 8 + (d & 7); }
__device__ __forceinline__ size_t vfrag_off(int key, int d) {
    return ((size_t)((key >> 5) * 4 + (d >> 4)) * 64 + ((key >> 2) & 3) * 16 + (d & 15)) * 8 + ((key >> 4) & 1) * 4 + (key & 3);
}
__device__ __forceinline__ void st_bf16x4(bf16_t* p, f32x4 v) { u32x2 w; w.x = cvt_pk_bf16(v[0], v[1]); w.y = cvt_pk_bf16(v[2], v[3]); *(u32x2*)p = w; }
__device__ __forceinline__ void st_bf16x8(bf16_t* p, f32x4 a, f32x4 b) { u32x4 w; w.x = cvt_pk_bf16(a[0], a[1]); w.y = cvt_pk_bf16(a[2], a[3]); w.z = cvt_pk_bf16(b[0], b[1]); w.w = cvt_pk_bf16(b[2], b[3]); *(u32x4*)p = w; }
__device__ __forceinline__ void st_bf16x8_t(bf16_t* p, f32x4 a, f32x4 b) { u32x4 w; w.x = cvt_pk_bf16_t(a[0], a[1]); w.y = cvt_pk_bf16_t(a[2], a[3]); w.z = cvt_pk_bf16_t(b[0], b[1]); w.w = cvt_pk_bf16_t(b[2], b[3]); *(u32x4*)p = w; }
__device__ __forceinline__ void st_bf16x4_t(bf16_t* p, f32x4 v) { u32x2 w; w.x = cvt_pk_bf16_t(v[0], v[1]); w.y = cvt_pk_bf16_t(v[2], v[3]); *(u32x2*)p = w; }
__device__ __forceinline__ u32x4 pk_bf16x8(f32x4 a, f32x4 b) { u32x4 w; w.x = cvt_pk_bf16(a[0], a[1]); w.y = cvt_pk_bf16(a[2], a[3]); w.z = cvt_pk_bf16(b[0], b[1]); w.w = cvt_pk_bf16(b[2], b[3]); return w; }
__device__ __forceinline__ unsigned dpp_ror8(unsigned v) { return __builtin_amdgcn_mov_dpp(v, 0x128, 0xF, 0xF, true); }
template <class F>
__device__ __forceinline__ void store_tile_lines(const f32x4 (&acc)[2][2][4][2], int brow, int bcol, int wr, int wc, int fr, int fq, bf16_t* base, size_t ld, F&& pack) {
    const bool lo = fr < 8; const int r = fr & 7, hc = (fr >> 3) * 32 + fq * 8;
#pragma unroll
    for (int ai = 0; ai < 2; ++ai)
#pragma unroll
        for (int m = 0; m < 4; ++m) {
            const int row0 = brow + ai * HALF + wr * 64 + m * 16, col0 = bcol + wc * 64;
            const u32x4 w0 = pack(row0 + fr, col0 + fq * 8, acc[ai][0][m][0], acc[ai][0][m][1]), w1 = pack(row0 + fr, col0 + 32 + fq * 8, acc[ai][1][m][0], acc[ai][1][m][1]);
            u32x4 x, y, a, b;
            x.x = lo ? w1.x : w0.x; x.y = lo ? w1.y : w0.y; x.z = lo ? w1.z : w0.z; x.w = lo ? w1.w : w0.w;
            y.x = dpp_ror8(x.x); y.y = dpp_ror8(x.y); y.z = dpp_ror8(x.z); y.w = dpp_ror8(x.w);
            a.x = lo ? w0.x : y.x; a.y = lo ? w0.y : y.y; a.z = lo ? w0.z : y.z; a.w = lo ? w0.w : y.w;
            b.x = lo ? y.x : w1.x; b.y = lo ? y.y : w1.y; b.z = lo ? y.z : w1.z; b.w = lo ? y.w : w1.w;
            *(u32x4*)(base + (size_t)(row0 + r) * ld + col0 + hc) = a;
            *(u32x4*)(base + (size_t)(row0 + 8 + r) * ld + col0 + hc) = b;
        }
}
__device__ __forceinline__ bool win_tile_a(int pn) { return pn < 2 || (pn >= 5 && pn < 17); }

struct EpiIn {
    const Params& p;
    __device__ __forceinline__ void apply(int row, int col, f32x4 v) const {
        const Params& P = p; const int pn = col >> 8, c = col & 255;
        if (pn < 2) st_bf16x4(P.Qb + (size_t)row * QD + col, v * QSCALE);
        else if (pn < 5) {
            if (pn != 2) st_bf16x4((pn == 3 ? P.SLCb : P.WINb) + (size_t)row * 256 + c, v);
            if (pn < 4) *(f32x4*)(P.out + (pn == 2 ? O_CMPS : O_SLCS) + (size_t)(row - MP) * 256 + c) = v;
            else *(f32x4*)(P.out + O_WINS + ((size_t)(row - MP) * WIN + (WIN - 1)) * 256 + c) = v;
        } else if (pn < 9) {
            f32x4 g; g[0] = gelu_fast(v[0]); g[1] = gelu_fast(v[1]); g[2] = gelu_fast(v[2]); g[3] = gelu_fast(v[3]);
            st_bf16x4((pn < 7 ? P.U : P.Vg) + (size_t)row * GMD + (col - (pn < 7 ? 1280 : 1792)), g);
        } else if (pn < 17) {
            f32x4 g; g[0] = sigmoid_fast(v[0]); g[1] = sigmoid_fast(v[1]); g[2] = sigmoid_fast(v[2]); g[3] = sigmoid_fast(v[3]);
            st_bf16x4((pn < 13 ? P.GA : P.GB) + (size_t)row * DM + (col - (pn < 13 ? 2304 : 3328)), g);
        } else if (c < 24) { f32x4 g; g[0] = sigmoid_fast(v[0]); g[1] = sigmoid_fast(v[1]); g[2] = sigmoid_fast(v[2]); g[3] = sigmoid_fast(v[3]); *(f32x4*)(P.GATE + (size_t)row * 32 + c) = g; }
    }
    __device__ __forceinline__ int lcol(int r) const { return win_tile_a(r >> 8) ? lcol_a(r) : r; }
    __device__ __forceinline__ void operator()(const f32x4 (&acc)[2][2][4][2], int brow, int bcol, int wr, int wc, int fr, int fq) const {
        const int pn = bcol >> 8;
        const Params& P = p;
        if (pn < 2) {
            store_tile_lines(acc, brow, bcol, wr, wc, fr, fq, P.Qb, QD, [&](int, int, f32x4 a, f32x4 b) { return pk_bf16x8(a * QSCALE, b * QSCALE); });
        } else if (pn < 5) {
            bf16_t* cp = pn == 2 ? P.CMPb : pn == 3 ? P.SLCb : P.WINb;
            for_each_frag(acc, brow, bcol, wr, wc, fr, fq, [&](int row, int col, f32x4 v) {
                const int c = col & 255;
                if (pn == 2) st_bf16x4(cp + (size_t)row * 256 + c, v);
                if (pn >= 3 && c < 128 && row < MP) {
                    st_bf16x4((pn == 3 ? P.SLCkF : P.WINkF) + ((size_t)(row >> 13) * NG + (c >> 6)) * SEQ * 64 + kfrag_off(row & (SEQ - 1), c & 63), v);
                }
                if (pn >= 3 && c >= 128 && row < MP) {
                    const int t = row & (SEQ - 1), dc = c - 128;
                    bf16_t* vt = (pn == 3 ? P.SLCvT : P.WINvT) + ((size_t)(row >> 13) * NG + (dc >> 6)) * SEQ * 64 + vfrag_off(t, dc & 63);
                    vt[0] = f2bf(v[0]); vt[8] = f2bf(v[1]); vt[16] = f2bf(v[2]); vt[24] = f2bf(v[3]);
                }
                if (pn < 4) {
                    if (row < MP) __builtin_nontemporal_store(v, (f32x4*)(P.out + (pn == 2 ? O_CMPP : O_SLCP) + (size_t)row * 256 + c));
                    else if (row < MP + NS) *(f32x4*)(P.out + (pn == 2 ? O_CMPS : O_SLCS) + (size_t)(row - MP) * 256 + c) = v;
                } else {
                    if (row < MP) { const int t = row & (SEQ - 1), b = row >> 13; if (t >= SEQ - WIN) __builtin_nontemporal_store(v, (f32x4*)(P.out + O_WINP + ((size_t)b * WIN + (t - (SEQ - WIN))) * 256 + c)); }
                    else if (row < MP + NS) *(f32x4*)(P.out + O_WINS + ((size_t)(row - MP) * WIN + (WIN - 1)) * 256 + c) = v;
                }
            });
        } else if (pn < 9) {
            bf16_t* dst = pn < 7 ? P.U : P.Vg; const int c0 = pn < 7 ? 1280 : 1792;
            store_tile_lines(acc, brow, bcol, wr, wc, fr, fq, dst - c0, GMD, [&](int, int, f32x4 a, f32x4 b) {
                f32x4 g, h; g[0] = gelu_fast(a[0]); g[1] = gelu_fast(a[1]); g[2] = gelu_fast(a[2]); g[3] = gelu_fast(a[3]); h[0] = gelu_fast(b[0]); h[1] = gelu_fast(b[1]); h[2] = gelu_fast(b[2]); h[3] = gelu_fast(b[3]);
                return pk_bf16x8(g, h); });
        } else if (pn < 17) {
            bf16_t* dst = pn < 13 ? P.GA : P.GB; const int c0 = pn < 13 ? 2304 : 3328;
            store_tile_lines(acc, brow, bcol, wr, wc, fr, fq, dst - c0, DM, [&](int, int, f32x4 a, f32x4 b) {
                f32x4 g, h; g[0] = sigmoid_fast(a[0]); g[1] = sigmoid_fast(a[1]); g[2] = sigmoid_fast(a[2]); g[3] = sigmoid_fast(a[3]); h[0] = sigmoid_fast(b[0]); h[1] = sigmoid_fast(b[1]); h[2] = sigmoid_fast(b[2]); h[3] = sigmoid_fast(b[3]);
                return pk_bf16x8(g, h); });
        } else {
            for_each_frag(acc, brow, bcol, wr, wc, fr, fq, [&](int row, int col, f32x4 v) {
                const int c = col & 255;
                if (c < 24) { f32x4 g; g[0] = sigmoid_fast(v[0]); g[1] = sigmoid_fast(v[1]); g[2] = sigmoid_fast(v[2]); g[3] = sigmoid_fast(v[3]); *(f32x4*)(P.GATE + (size_t)row * 32 + c) = g; } });
        }
    }
};
struct EpiBranch {
    const bf16_t* GA; const bf16_t* GB; bf16_t* Y1;
    __device__ __forceinline__ void mid(f32x4 (&acc)[2][2][4][2], int brow, int bcol, int wr, int wc, int fr, int fq) const {
#pragma unroll
        for (int ai = 0; ai < 2; ++ai)
#pragma unroll
            for (int m = 0; m < 4; ++m)
#pragma unroll
                for (int bj = 0; bj < 2; ++bj) {
                    const size_t o = (size_t)(brow + ai * HALF + wr * 64 + m * 16 + fr) * DM + bcol + wc * 64 + bj * 32 + fq * 8;
                    const u32x4 a = *(const u32x4*)(GA + o), b = *(const u32x4*)(GB + o);
                    f32x4& v = acc[ai][bj][m][0]; f32x4& w = acc[ai][bj][m][1];
                    v[0] *= bflo(a.x) * __builtin_amdgcn_rcpf(fmaxf(bflo(b.x), 1e-30f)); v[1] *= bfhi(a.x) * __builtin_amdgcn_rcpf(fmaxf(bfhi(b.x), 1e-30f));
                    v[2] *= bflo(a.y) * __builtin_amdgcn_rcpf(fmaxf(bflo(b.y), 1e-30f)); v[3] *= bfhi(a.y) * __builtin_amdgcn_rcpf(fmaxf(bfhi(b.y), 1e-30f));
                    w[0] *= bflo(a.z) * __builtin_amdgcn_rcpf(fmaxf(bflo(b.z), 1e-30f)); w[1] *= bfhi(a.z) * __builtin_amdgcn_rcpf(fmaxf(bfhi(b.z), 1e-30f));
                    w[2] *= bflo(a.w) * __builtin_amdgcn_rcpf(fmaxf(bflo(b.w), 1e-30f)); w[3] *= bfhi(a.w) * __builtin_amdgcn_rcpf(fmaxf(bfhi(b.w), 1e-30f));
                    asm volatile("" : "+v"(v), "+v"(w));
                    if (bj == 1) __builtin_amdgcn_sched_barrier(0);
                }
    }
    __device__ __forceinline__ int lcol(int r) const { return lcol_a(r); }
    __device__ __forceinline__ void operator()(const f32x4 (&acc)[2][2][4][2], int brow, int bcol, int wr, int wc, int fr, int fq) const {
        store_tile_lines(acc, brow, bcol, wr, wc, fr, fq, Y1, DM, [&](int row, int col, f32x4 v, f32x4 w) {
            const u32x4 b = *(const u32x4*)(GB + (size_t)row * DM + col);
            f32x4 o, q; o[0] = v[0] * fmaxf(bflo(b.x), 1e-30f); o[1] = v[1] * fmaxf(bfhi(b.x), 1e-30f); o[2] = v[2] * fmaxf(bflo(b.y), 1e-30f); o[3] = v[3] * fmaxf(bfhi(b.y), 1e-30f);
            q[0] = w[0] * fmaxf(bflo(b.z), 1e-30f); q[1] = w[1] * fmaxf(bfhi(b.z), 1e-30f); q[2] = w[2] * fmaxf(bflo(b.w), 1e-30f); q[3] = w[3] * fmaxf(bfhi(b.w), 1e-30f);
            return pk_bf16x8(o, q); });
    }
    __device__ __forceinline__ void apply2(int row, int col, f32x4 v1, f32x4 v2) const {
        const u32x2 a = *(const u32x2*)(GA + (size_t)row * DM + col), b = *(const u32x2*)(GB + (size_t)row * DM + col);
        f32x4 o; o[0] = v1[0] * bflo(a.x) + v2[0] * bflo(b.x); o[1] = v1[1] * bfhi(a.x) + v2[1] * bfhi(b.x); o[2] = v1[2] * bflo(a.y) + v2[2] * bflo(b.y); o[3] = v1[3] * bfhi(a.y) + v2[3] * bfhi(b.y);
        st_bf16x4(Y1 + (size_t)row * DM + col, o);
    }
};
struct EpiF32 {
    float* F; int ld;
    __device__ __forceinline__ void apply(int row, int col, f32x4 v) const { *(f32x4*)(F + (size_t)row * ld + col) = v; }
    __device__ __forceinline__ void operator()(const f32x4 (&acc)[2][2][4][2], int brow, int bcol, int wr, int wc, int fr, int fq) const {
        for_each_frag(acc, brow, bcol, wr, wc, fr, fq, [&](int row, int col, f32x4 v) { *(f32x4*)(F + (size_t)row * ld + col) = v; });
    }
};
struct EpiBf16 {
    bf16_t* O; int ld;
    __device__ __forceinline__ int lcol(int r) const { return lcol_a(r); }
    __device__ __forceinline__ void apply(int row, int col, f32x4 v) const { st_bf16x4(O + (size_t)row * ld + col, v); }
    __device__ __forceinline__ void operator()(const f32x4 (&acc)[2][2][4][2], int brow, int bcol, int wr, int wc, int fr, int fq) const {
        store_tile_lines(acc, brow, bcol, wr, wc, fr, fq, O, (size_t)ld, [&](int, int, f32x4 a, f32x4 b) { return pk_bf16x8(a, b); });
    }
};
struct EpiPart {
    bf16_t* PART;
    __device__ __forceinline__ void operator()(const f32x4 (&acc)[2][2][4][2], int brow, int bcol, int wr, int wc, int fr, int fq) const {
        const int z = bcol >> 20;
        store_tile_lines(acc, brow, 0, wr, wc, fr, fq, PART + (size_t)z * 256, (size_t)1024, [&](int, int, f32x4 a, f32x4 b) { return pk_bf16x8(a, b); });
    }
};
struct ZCmp { __device__ __forceinline__ size_t a(int z) const { return (size_t)z * 64; } __device__ __forceinline__ size_t b(int z) const { return (size_t)(z >> 1) * 256 * 1024; } };
struct EpiSwiGLU {
    bf16_t* ACT;
    __device__ __forceinline__ int lcol(int r) const { return lcol_s(r); }
    __device__ __forceinline__ void apply(int row, int col, f32x4 v) const { *(unsigned*)(ACT + (size_t)row * DFF + (col >> 1)) = cvt_pk_bf16(silu_fast(v[0]) * v[1], silu_fast(v[2]) * v[3]); }
    __device__ __forceinline__ void operator()(const f32x4 (&acc)[2][2][4][2], int brow, int bcol, int wr, int wc, int fr, int fq) const {
#pragma unroll
        for (int ai = 0; ai < 2; ++ai)
#pragma unroll
            for (int m = 0; m < 4; ++m) {
                const f32x4 &a = acc[ai][0][m][0], &b = acc[ai][0][m][1], &c = acc[ai][1][m][0], &d = acc[ai][1][m][1];
                u32x4 w;
                w.x = cvt_pk_bf16(silu_fast(a[0]) * a[1], silu_fast(a[2]) * a[3]); w.y = cvt_pk_bf16(silu_fast(b[0]) * b[1], silu_fast(b[2]) * b[3]);
                w.z = cvt_pk_bf16(silu_fast(c[0]) * c[1], silu_fast(c[2]) * c[3]); w.w = cvt_pk_bf16(silu_fast(d[0]) * d[1], silu_fast(d[2]) * d[3]);
                *(u32x4*)(ACT + (size_t)(brow + ai * HALF + wr * 64 + m * 16 + fr) * DFF + (bcol >> 1) + wc * 32 + fq * 8) = w;
            }
    }
};
struct EpiPleGate {
    const bf16_t* E; bf16_t* F;
    __device__ __forceinline__ void apply(int row, int col, f32x4 v) const {
        const u32x2 w = *(const u32x2*)(E + (size_t)row * DM + col);
        f32x4 o; o[0] = sigmoidf_(v[0]) * bflo(w.x); o[1] = sigmoidf_(v[1]) * bfhi(w.x); o[2] = sigmoidf_(v[2]) * bflo(w.y); o[3] = sigmoidf_(v[3]) * bfhi(w.y);
        st_bf16x4(F + (size_t)row * DM + col, o); }
    __device__ __forceinline__ int lcol(int r) const { return lcol_a(r); }
    __device__ __forceinline__ void operator()(const f32x4 (&acc)[2][2][4][2], int brow, int bcol, int wr, int wc, int fr, int fq) const {
        store_tile_lines(acc, brow, bcol, wr, wc, fr, fq, F, DM, [&](int row, int col, f32x4 a, f32x4 b) {
            const u32x4 w = *(const u32x4*)(E + (size_t)row * DM + col);
            f32x4 o, q; o[0] = sigmoidf_(a[0]) * bflo(w.x); o[1] = sigmoidf_(a[1]) * bfhi(w.x); o[2] = sigmoidf_(a[2]) * bflo(w.y); o[3] = sigmoidf_(a[3]) * bfhi(w.y);
            q[0] = sigmoidf_(b[0]) * bflo(w.z); q[1] = sigmoidf_(b[1]) * bfhi(w.z); q[2] = sigmoidf_(b[2]) * bflo(w.w); q[3] = sigmoidf_(b[3]) * bfhi(w.w);
            return pk_bf16x8(o, q); });
    }
};

template <class Epi>
__device__ __forceinline__ void gemm_skinny(const bf16_t* A  , int lda, const bf16_t* Bt, int K, int N, const Epi& E) {
    int tid = threadIdx.x; asm volatile("" : "+v"(tid));
    const int wid = __builtin_amdgcn_readfirstlane(tid >> 6), lane = tid & 63, c = lane & 15, G = lane >> 4;
    LAS f32x4* red = (LAS f32x4*)smem;
    const int nsteps = K / 32;
#pragma unroll 1
    for (int ct = blockIdx.x; ct < N / 16; ct += gridDim.x) {
        f32x4 acc0 = {0.f, 0.f, 0.f, 0.f}, acc1 = {0.f, 0.f, 0.f, 0.f};
        const bf16_t* bp = Bt + (size_t)(ct * 16 + c) * K + G * 8;
        const bf16_t* a0 = A + (size_t)c * lda + G * 8; const bf16_t* a1 = A + (size_t)(16 + c) * lda + G * 8;
#pragma unroll 4
        for (int kk = wid; kk < nsteps; kk += 8) {
            const bf16x8 bf = *(const bf16x8*)(bp + kk * 32), x0 = *(const bf16x8*)(a0 + kk * 32), x1 = *(const bf16x8*)(a1 + kk * 32);
            acc0 = mfma16(bf, x0, acc0); acc1 = mfma16(bf, x1, acc1);
        }
        __syncthreads();
        red[(wid * 2 + 0) * 64 + lane] = acc0; red[(wid * 2 + 1) * 64 + lane] = acc1;
        __syncthreads();
        if (tid < 128) {
            const int rt = tid >> 6;
            f32x4 v = red[rt * 64 + lane];
#pragma unroll
            for (int w = 1; w < 8; ++w) v = v + red[(w * 2 + rt) * 64 + lane];
            E.apply(MP + rt * 16 + c, E.lcol(ct * 16 + 4 * G), v);
        }
    }
    __syncthreads();
}

template <class Epi>
__device__ __forceinline__ void gemm_skinny2(const bf16_t* A  , int lda, const bf16_t* Bt, int K, int N, const Epi& E) {
    int tid = threadIdx.x; asm volatile("" : "+v"(tid));
    const int wid = __builtin_amdgcn_readfirstlane(tid >> 6), lane = tid & 63, c = lane & 15, G = lane >> 4;
    LAS f32x4* red = (LAS f32x4*)smem;
    const int hsteps = K / 64;
#pragma unroll 1
    for (int ct = blockIdx.x; ct < N / 16; ct += gridDim.x) {
        f32x4 acc[4] = {{0.f, 0.f, 0.f, 0.f}, {0.f, 0.f, 0.f, 0.f}, {0.f, 0.f, 0.f, 0.f}, {0.f, 0.f, 0.f, 0.f}};
        const bf16_t* bp = Bt + (size_t)(ct * 16 + c) * K + G * 8;
        const bf16_t* a0 = A + (size_t)c * lda + G * 8; const bf16_t* a1 = A + (size_t)(16 + c) * lda + G * 8;
#pragma unroll
        for (int h = 0; h < 2; ++h) {
#pragma unroll 2
            for (int kk = h * hsteps + wid; kk < (h + 1) * hsteps; kk += 8) {
                const bf16x8 bf = *(const bf16x8*)(bp + kk * 32), x0 = *(const bf16x8*)(a0 + kk * 32), x1 = *(const bf16x8*)(a1 + kk * 32);
                acc[h * 2] = mfma16(bf, x0, acc[h * 2]); acc[h * 2 + 1] = mfma16(bf, x1, acc[h * 2 + 1]);
            }
        }
        __syncthreads();
#pragma unroll
        for (int q = 0; q < 4; ++q) red[(wid * 4 + q) * 64 + lane] = acc[q];
        __syncthreads();
        if (tid < 128) {
            const int rt = tid >> 6;
            f32x4 v1 = red[rt * 64 + lane], v2 = red[(2 + rt) * 64 + lane];
#pragma unroll
            for (int w = 1; w < 8; ++w) { v1 = v1 + red[(w * 4 + rt) * 64 + lane]; v2 = v2 + red[(w * 4 + 2 + rt) * 64 + lane]; }
            E.apply2(MP + rt * 16 + c, E.lcol(ct * 16 + 4 * G), v1, v2);
        }
    }
    __syncthreads();
}

template <class Map>
__device__ __forceinline__ void transpose_tile(const float* W, int K, int N, bf16_t* Wt, int ldk, int kt, int ntile, Map map) {
    LAS float* tile = (LAS float*)smem;
    const int t = threadIdx.x;
    __syncthreads();
#pragma unroll
    for (int i = 0; i < 2; ++i) {
        const int k = (t >> 4) + 32 * i, n = (t & 15) * 4, gn = ntile * 64 + n;
        f32x4 v = (f32x4){0.f, 0.f, 0.f, 0.f};
        if (gn < N) v = *(const f32x4*)(W + (size_t)(kt * 64 + k) * N + gn);
        tile[k * 65 + n] = v[0]; tile[k * 65 + n + 1] = v[1]; tile[k * 65 + n + 2] = v[2]; tile[k * 65 + n + 3] = v[3];
    }
    __syncthreads();
    const int n = t >> 3, kc = (t & 7) * 8, gn = ntile * 64 + n;
    if (gn < N) {
        u32x4 w;
        w.x = cvt_pk_bf16(tile[(kc + 0) * 65 + n], tile[(kc + 1) * 65 + n]); w.y = cvt_pk_bf16(tile[(kc + 2) * 65 + n], tile[(kc + 3) * 65 + n]);
        w.z = cvt_pk_bf16(tile[(kc + 4) * 65 + n], tile[(kc + 5) * 65 + n]); w.w = cvt_pk_bf16(tile[(kc + 6) * 65 + n], tile[(kc + 7) * 65 + n]);
        *(u32x4*)(Wt + (size_t)map(gn) * ldk + kt * 64 + kc) = w;
    }
}
template <class Map>
__device__ __forceinline__ void transpose_all(const float* W, int K, int N, bf16_t* Wt, int ldk, Map map, int& base) {
    const int nkt = K / 64, nnt = (N + 63) / 64, ntl = nkt * nnt;
    for (int it = blockIdx.x; it < base + ntl; it += gridDim.x) {
        if (it < base) continue;
        const int l = it - base;
        transpose_tile(W, K, N, Wt, ldk, l / nnt, l % nnt, map);
    }
    base += ntl;
}
template <class Map>
__device__ __forceinline__ void transpose_all_sub(const float* W, int K, int N, bf16_t* Wt, int ldk, Map map, int& base) {
    const int nkt = K / 64, nnt = (N + 63) / 64, ntl = nkt * nnt, nb = gridDim.x - 32, me = blockIdx.x - 32;
    int first = base - (base % nb) + me; if (first < base) first += nb;
    for (int it = first; it < base + ntl; it += nb) { const int l = it - base; transpose_tile(W, K, N, Wt, ldk, l / nnt, l % nnt, map); }
    base += ntl;
}
__device__ __forceinline__ int map_win(int n) {
    if (n < 1280) return n;
    if (n < 1304) return 4352 + (n - 1280);
    if (n < 2328) return 1280 + (n - 1304);
    return 2304 + (n - 2328);
}

__device__ __forceinline__ float row_rstd(const f32x4 (&v)[4]) {
    float s = 0.f;
#pragma unroll
    for (int k = 0; k < 4; ++k) s += v[k][0] * v[k][0] + v[k][1] * v[k][1] + v[k][2] * v[k][2] + v[k][3] * v[k][3];
    s = wave_sum(s);
    return rsqrtf(s * (1.0f / DM) + EPS);
}
__device__ __forceinline__ const float* xrow_ptr(const Params& p, int row) {
    return row < MP ? p.x_prompt + (size_t)row * DM : p.x_sample + (size_t)(row - MP) * DM;
}

__device__ __forceinline__ void phase_prologue(const Params& p) {
    const int wid = threadIdx.x >> 6, lane = threadIdx.x & 63;
    const int gw = blockIdx.x * 8 + wid, nw = gridDim.x * 8;
    auto do_transposes = [&]() {
    int base = 0;
    transpose_all(p.w_in, DM, IND, p.WinT, DM, [](int n) { const int l = map_win(n); return win_tile_a(l >> 8) ? row_a(l) : l; }, base);
    for (int kv = 0; kv < 2; ++kv) for (int j = 0; j < 2; ++j)
        transpose_all((kv ? p.w1_v : p.w1_k) + (size_t)j * 1024 * 128, 1024, 128, p.W1T + (size_t)kv * 256 * 1024, 1024, [j](int n) { return inv_a(j * 128 + n); }, base);
    };
    do_transposes();
    __syncthreads();
    for (int i = blockIdx.x * 512 + threadIdx.x; i < (INP - IND) * DM / 8; i += gridDim.x * 512) ((u32x4*)(p.WinT + (size_t)IND * DM))[i] = (u32x4){0u, 0u, 0u, 0u};
    for (int row0 = gw * 2; row0 < MP + NS; row0 += nw * 2) {
        f32x4 v[2][4];
#pragma unroll
        for (int q = 0; q < 2; ++q) { const float* xr = xrow_ptr(p, row0 + q);
#pragma unroll
            for (int k = 0; k < 4; ++k) v[q][k] = *(const f32x4*)(xr + lane * 4 + k * 256); }
#pragma unroll
        for (int q = 0; q < 2; ++q) {
            const int row = row0 + q;
            u32x2* hd = (u32x2*)(p.H + (size_t)row * DM);
            const float r = row_rstd(v[q]);
#pragma unroll
            for (int k = 0; k < 4; ++k) { const f32x4 g = *(const f32x4*)(p.ln_mix_pre + lane * 4 + k * 256); const f32x4 o = v[q][k] * r * g; u32x2 w; w.x = cvt_pk_bf16(o[0], o[1]); w.y = cvt_pk_bf16(o[2], o[3]); hd[lane + k * 64] = w; }
            const float* pr = row < MP ? p.p_prompt + (size_t)row * PLE : p.p_sample + (size_t)(row - MP) * PLE;
            const f32x4 pv = *(const f32x4*)(pr + lane * 4);
            u32x2 w; w.x = cvt_pk_bf16(pv[0], pv[1]); w.y = cvt_pk_bf16(pv[2], pv[3]);
            ((u32x2*)(p.Pb + (size_t)row * PLE))[lane] = w;
        }
    }
    for (int i = blockIdx.x * 512 + threadIdx.x; i < 4 * 128 * 128; i += gridDim.x * 512) { const int t = (i >> 7) & 127, s = i & 127; p.GWb[i] = f2bf(s <= t ? p.gm_ws[i] : 0.f); }
    for (int i = blockIdx.x * 512 + threadIdx.x; i < 2 * 64 * 128; i += gridDim.x * 512) { const int kv = i >> 13, d = (i >> 7) & 63, h = i & 127; p.W2T[i] = f2bf((kv ? p.w2_v : p.w2_k)[h * 64 + d]); }
    if (gw < 256) {
        const int kv = gw >> 7, h = gw & 127;
        const float* pe = kv ? p.pe_v : p.pe_k; const float* w1 = kv ? p.w1_v : p.w1_k;
        float s = 0.f;
#pragma unroll 8
        for (int k = lane; k < 2048; k += 64) s += pe[k] * w1[(size_t)k * 128 + h];
        s = wave_sum(s);
        if (lane == 0) p.PEB[kv * 128 + h] = s;
    }
    const int cskip = gridDim.x > 64 ? 32 : 0;
    if ((int)blockIdx.x >= cskip)
    for (int i = (blockIdx.x - cskip) * 512 + threadIdx.x; i < NS * (WIN - 1) * 64; i += (gridDim.x - cskip) * 512) {
        const int b = i / ((WIN - 1) * 64), r = i % ((WIN - 1) * 64);
        __builtin_nontemporal_store(((const f32x4*)(p.state_win + (size_t)b * WIN * 256 + 256))[r], (f32x4*)(p.out + O_WINS + (size_t)b * WIN * 256) + r);
    }
}

__device__ __forceinline__ void phase_deferred_transposes(const Params& p) {
    if (blockIdx.x < 32) return;
    int base = 0;
    transpose_all_sub(p.w_br_nsa, QD, DM, p.WnT, DM, [](int n) { return row_a(n); }, base);
    transpose_all_sub(p.w_br_gm, GMD, DM, p.WnT + QD, DM, [](int n) { return row_a(n); }, base);
    transpose_all_sub(p.w_out, DM, DM, p.WoT, DM, [](int n) { return row_a(n); }, base);
    transpose_all_sub(p.w_gate, DM, DFF, p.WguT, DM, [](int n) { return row_s(n, 0); }, base);
    transpose_all_sub(p.w_up, DM, DFF, p.WguT, DM, [](int n) { return row_s(n, 1); }, base);
    transpose_all_sub(p.w_down, DFF, DM, p.WdT, DFF, [](int n) { return row_a(n); }, base);
    transpose_all_sub(p.w_ple_gate, DM, DM, p.WpgT, DM, [](int n) { return row_a(n); }, base);
    transpose_all_sub(p.w_ple, PLE, DM, p.WpT, PLE, [](int n) { return row_a(n); }, base);
    __syncthreads();
}
__device__ __forceinline__ void phase_gather(const Params& p) {
    int tid = threadIdx.x; asm volatile("" : "+v"(tid));
    const int wid = tid >> 6, lane = tid & 63;
    const int gw = (blockIdx.x >> 1) * 8 + wid, nw = (gridDim.x >> 1) * 8;
    const int cls = blockIdx.x & 1;
    auto ld8 = [&](int r8h, f32x4 (&a)[4], f32x4 (&cc)[4]) __attribute__((always_inline)) {
        const int r = (r8h * 2 + cls) * 8, b = r >> 14, pos = r & (PAST - 1), l5 = lane & 31, hrow = lane >> 5;
        const float* s = p.cache_cmp + ((size_t)p.page_table[b * NPG + (pos >> 7)] * PAGE + (pos & 127) + hrow) * 256 + l5 * 8;
#pragma unroll
        for (int k = 0; k < 4; ++k) { a[k] = *(const f32x4*)(s + (size_t)k * 512); cc[k] = *(const f32x4*)(s + (size_t)k * 512 + 4); }
    };
    auto st8 = [&](int r8h, const f32x4 (&a)[4], const f32x4 (&cc)[4]) __attribute__((always_inline)) {
        const int r = (r8h * 2 + cls) * 8, l5 = lane & 31, hrow = lane >> 5;
#pragma unroll
        for (int k = 0; k < 4; ++k) {
            u32x4 w; w.x = cvt_pk_bf16(a[k][0], a[k][1]); w.y = cvt_pk_bf16(a[k][2], a[k][3]); w.z = cvt_pk_bf16(cc[k][0], cc[k][1]); w.w = cvt_pk_bf16(cc[k][2], cc[k][3]);
            *(u32x4*)(p.CMPb + ((size_t)MP + r + 2 * k + hrow) * 256 + l5 * 8) = w;
        }
    };
#pragma unroll 1
    for (int r8h = gw; r8h < NS * PAST / 16; r8h += 2 * nw) {
        f32x4 a0[4], c0[4], a1[4], c1[4];
        const bool two = r8h + nw < NS * PAST / 16;
        ld8(r8h, a0, c0);
        if (two) ld8(r8h + nw, a1, c1);
        st8(r8h, a0, c0);
        if (two) st8(r8h + nw, a1, c1);
    }
}

__device__ __forceinline__ void phase_cmp_final(const Params& p) {
    const int wid = threadIdx.x >> 6, lane = threadIdx.x & 63;
    {
        const int c = lane & 15, G = lane >> 4;
        const int ngrp_p = NB * 4 * 32, ngrp_s = NS * 4 * 64;
#pragma unroll 1
        for (int it = blockIdx.x * 8 + wid; it < ngrp_p + ngrp_s; it += gridDim.x * 8) {
            const bool smp = it >= ngrp_p; const int l = smp ? it - ngrp_p : it;
            const int nch = smp ? 64 : 32, nc = smp ? NCS : NCP;
            const int ch = l % nch, z = (l / nch) & 3, seq = l / (nch * 4), kv = z >> 1, g = z & 1, n0 = ch * 16;
            const size_t r0 = smp ? (size_t)2048 + (size_t)seq * 1024 : (size_t)seq * 512;
            const int nr = n0 + c < nc ? n0 + c : nc - 1;
            const bf16_t* p0 = (const bf16_t*)p.PART + ((r0 + nr) * 4 + z) * 256;
            const bf16_t* p1 = (const bf16_t*)p.PART + ((r0 + nr + 1) * 4 + z) * 256 + 128;
            const float* pb = p.PEB + kv * 128;
            f32x4 acc[4] = {{0.f, 0.f, 0.f, 0.f}, {0.f, 0.f, 0.f, 0.f}, {0.f, 0.f, 0.f, 0.f}, {0.f, 0.f, 0.f, 0.f}};
#pragma unroll
            for (int ks = 0; ks < 4; ++ks) {
                const int h0 = 32 * ks + 8 * G;
                const u32x4 wa = *(const u32x4*)(p0 + h0), wb = *(const u32x4*)(p1 + h0);
                const f32x4 a0 = {bflo(wa.x), bfhi(wa.x), bflo(wa.y), bfhi(wa.y)}, a1 = {bflo(wa.z), bfhi(wa.z), bflo(wa.w), bfhi(wa.w)};
                const f32x4 b0 = {bflo(wb.x), bfhi(wb.x), bflo(wb.y), bfhi(wb.y)}, b1 = {bflo(wb.z), bfhi(wb.z), bflo(wb.w), bfhi(wb.w)};
                const f32x4 e0 = *(const f32x4*)(pb + h0), e1 = *(const f32x4*)(pb + h0 + 4);
                f32x4 x0 = a0 + b0 + e0, x1 = a1 + b1 + e1;
#pragma unroll
                for (int i = 0; i < 4; ++i) { x0[i] = siluf_(x0[i]); x1[i] = siluf_(x1[i]); }
                const bf16x8 A = pack_p(x0, x1);
#pragma unroll
                for (int nt = 0; nt < 4; ++nt) {
                    const bf16x8 B = *(const bf16x8*)(p.W2T + ((size_t)kv * 64 + nt * 16 + c) * 128 + h0);
                    acc[nt] = mfma16(A, B, acc[nt]);
                }
            }
#pragma unroll
            for (int nt = 0; nt < 4; ++nt) {
                const int d = nt * 16 + c;
#pragma unroll
                for (int i = 0; i < 4; ++i) {
                    const int n = n0 + 4 * G + i;
                    if (n < nc) {
                        if (smp) ((kv ? p.VCS : p.KCS) + (((size_t)seq * NG + g) * 1024 + n) * 64)[d] = acc[nt][i];
                        else if (kv == 0) p.KCb[((size_t)seq * NG + g) * 512 * 64 + kfrag_off(n, d)] = f2bf(acc[nt][i]);
                    }
                }
                if (!smp && kv == 1) {
                    f32x4 v = acc[nt];
#pragma unroll
                    for (int i = 0; i < 4; ++i) if (n0 + 4 * G + i >= nc) v[i] = 0.f;
                    st_bf16x4(p.VCT + ((size_t)seq * NG + g) * 512 * 64 + vfrag_off(n0 + 4 * G, d), v);
                }
            }
        }
    }
}

template <bool SAMPLE>
__device__ __forceinline__ void kv_row_ptr(const Params& p, int branch  , int b, int pos, int kv, int g, const bf16_t*& pb, const float*& pf) {
    const int off = kv * 128 + g * 64;
    if (!SAMPLE) { pf = nullptr; pb = (branch == 1 ? p.SLCb : p.WINb) + ((size_t)b * SEQ + pos) * 256 + off; }
    else if (pos >= PAST) { pf = nullptr; pb = (branch == 1 ? p.SLCb : p.WINb) + ((size_t)MP + b) * 256 + off; }
    else if (branch == 1) { pb = nullptr; pf = p.cache_slc + ((size_t)p.page_table[b * NPG + (pos >> 7)] * PAGE + (pos & 127)) * 256 + off; }
    else { pb = nullptr; pf = p.state_win + ((size_t)b * WIN + (pos - (PAST - WIN))) * 256 + off; }
}
__device__ __forceinline__ void dot4x64(const bf16_t* pb, const float* pf, const LAS float* qs_, float (&s)[4]) {
    s[0] = s[1] = s[2] = s[3] = 0.f;
    const LAS float* qs = qs_; asm volatile("" : "+v"(qs));
    if (pf) {
#pragma unroll 8
        for (int c = 0; c < 16; ++c) {
            const f32x4 kx = *(const f32x4*)(pf + c * 4);
#pragma unroll
            for (int h = 0; h < 4; ++h) { const f32x4 q = *(const LAS f32x4*)(qs + h * 64 + c * 4); s[h] += q[0] * kx[0] + q[1] * kx[1] + q[2] * kx[2] + q[3] * kx[3]; }
        }
    } else {
#pragma unroll 2
        for (int c = 0; c < 8; ++c) {
            const u32x4 w = *(const u32x4*)(pb + c * 8);
            const float k0 = bflo(w.x), k1 = bfhi(w.x), k2 = bflo(w.y), k3 = bfhi(w.y), k4 = bflo(w.z), k5 = bfhi(w.z), k6 = bflo(w.w), k7 = bfhi(w.w);
#pragma unroll
            for (int h = 0; h < 4; ++h) {
                const f32x4 qa = *(const LAS f32x4*)(qs + h * 64 + c * 8), qb = *(const LAS f32x4*)(qs + h * 64 + c * 8 + 4);
                s[h] += qa[0] * k0 + qa[1] * k1 + qa[2] * k2 + qa[3] * k3 + qb[0] * k4 + qb[1] * k5 + qb[2] * k6 + qb[3] * k7;
            }
        }
    }
}
template <bool SAMPLE>
__device__ __forceinline__ void attn_chunk(const Params& p, int branch, int b, int g, int t, int pos0, int lo, int hi,
                                           float (&m)[4], float (&l)[4], float (&o)[4], const LAS float* qs, LAS float* pbk, const LAS float* relb, int lane) {
    const int pos = pos0 + lane;
    const bool valid = pos >= lo && pos <= hi;
    float s[4] = {-1e30f, -1e30f, -1e30f, -1e30f};
    if (valid) {
        const bf16_t* pb; const float* pf; kv_row_ptr<SAMPLE>(p, branch, b, pos, 0, g, pb, pf);
        dot4x64(pb, pf, qs, s);
        const int bk = t5_bucket(t - pos);
#pragma unroll
        for (int h = 0; h < 4; ++h) s[h] += relb[bk * 8 + g * 4 + h];
    }
#pragma unroll
    for (int h = 0; h < 4; ++h) {
        const float mx = wave_max(s[h]);
        const float mn = fmaxf(m[h], mx);
        const float pr = valid ? ex2(s[h] - mn) : 0.f;
        const float sm = wave_sum(pr);
        const float al = ex2(m[h] - mn);
        l[h] = l[h] * al + sm; o[h] *= al; m[h] = mn;
        pbk[h * 64 + lane] = pr;
    }
    __builtin_amdgcn_wave_barrier();
    const int k0 = (lo > pos0 ? lo : pos0) - pos0, k1 = (hi < pos0 + 63 ? hi : pos0 + 63) - pos0;
    if (SAMPLE) {
        const int kend = (PAST - 1 - pos0) < k1 ? (PAST - 1 - pos0) : k1;
        if (kend >= k0) {
            const bf16_t* pb; const float* pf; kv_row_ptr<SAMPLE>(p, branch, b, pos0 + k0, 1, g, pb, pf);
            pf += lane;
#pragma unroll 16
            for (int k = k0; k <= kend; ++k) {
                const float v = pf[(size_t)(k - k0) * 256];
#pragma unroll
                for (int h = 0; h < 4; ++h) o[h] += pbk[h * 64 + k] * v;
            }
        }
        if (k1 > kend) {
            const bf16_t* pb; const float* pf; kv_row_ptr<SAMPLE>(p, branch, b, pos0 + k1, 1, g, pb, pf);
            const float v = bf2f(pb[lane]);
#pragma unroll
            for (int h = 0; h < 4; ++h) o[h] += pbk[h * 64 + k1] * v;
        }
    } else {
#pragma unroll 1
    for (int k = k0; k <= k1; ++k) {
        const bf16_t* pb; const float* pf; kv_row_ptr<SAMPLE>(p, branch, b, pos0 + k, 1, g, pb, pf);
        const float v = pf ? pf[lane] : bf2f(pb[lane]);
#pragma unroll
        for (int h = 0; h < 4; ++h) o[h] += pbk[h * 64 + k] * v;
    }
    }
    __builtin_amdgcn_wave_barrier();
}

constexpr int S_QS = 0, S_SC = 1024, S_PHS = S_SC + 4 * 1024 * 4, S_PBK = S_PHS + 1088 * 4, S_PART = S_PBK + 8 * 1024, S_RED = S_PART + 2 * 8 * 272 * 4, S_OCP = S_RED + 512,
              S_SEL = S_OCP + 2048, S_RELB = S_SEL + 64, ATTS_LDS = S_RELB + 1024;
__device__ __forceinline__ void attn_sample_item(const Params& p, int b, int g) {
    const int tid = threadIdx.x, wid = tid >> 6, lane = tid & 63;
    constexpr int t = PAST, NC = NCS, NSEL = 257, NJR = 5, qblk = PAST >> 6;
    const int row = MP + b;
    LAS unsigned char* L = (LAS unsigned char*)smem;
    LAS float* qs = (LAS float*)(L + S_QS); LAS float* sc = (LAS float*)(L + S_SC); LAS float* phs = (LAS float*)(L + S_PHS); LAS float* pbk = (LAS float*)(L + S_PBK) + wid * 256;
    LAS float* part = (LAS float*)(L + S_PART); LAS float* red = (LAS float*)(L + S_RED); LAS float* ocp = (LAS float*)(L + S_OCP); LAS int* sel = (LAS int*)(L + S_SEL);
    LAS float* relb = (LAS float*)(L + S_RELB);
    __syncthreads();
    if (tid < 256) { relb[tid] = p.rel_bias[tid] * LOG2E; qs[tid] = bf2f(p.Qb[(size_t)row * QD + g * 256 + tid]); }
    __syncthreads();
    const float* kc = p.KCS + ((size_t)b * NG + g) * 1024 * 64;
    const float* vc = p.VCS + ((size_t)b * NG + g) * 1024 * 64;
    {
        float mx[4] = {-1e30f, -1e30f, -1e30f, -1e30f};
#pragma unroll 1
        for (int r = wid; r < 16; r += 8) {
            const int n = r * 64 + lane;
            float s[4] = {-1e30f, -1e30f, -1e30f, -1e30f};
            if (n < NC) {
                dot4x64(nullptr, kc + (size_t)n * 64, qs, s);
                const int bk = t5_bucket(t - (16 * n + 31));
#pragma unroll
                for (int h = 0; h < 4; ++h) s[h] += relb[bk * 8 + g * 4 + h];
            }
#pragma unroll
            for (int h = 0; h < 4; ++h) { sc[h * 1024 + n] = s[h]; mx[h] = fmaxf(mx[h], s[h]); }
        }
#pragma unroll
        for (int h = 0; h < 4; ++h) { const float m = wave_max(mx[h]); if (lane == 0) red[wid * 4 + h] = m; }
    }
    __syncthreads();
    float gmx[4], inv[4];
#pragma unroll
    for (int h = 0; h < 4; ++h) { float m = red[h]; for (int w = 1; w < 8; ++w) m = fmaxf(m, red[w * 4 + h]); gmx[h] = m; }
    {
        float sum[4] = {0.f, 0.f, 0.f, 0.f};
#pragma unroll
        for (int k = 0; k < 2; ++k) { const int n = tid + 512 * k;
#pragma unroll
            for (int h = 0; h < 4; ++h) { const float e = n < NC ? ex2(sc[h * 1024 + n] - gmx[h]) : 0.f; sc[h * 1024 + n] = e; sum[h] += e; } }
#pragma unroll
        for (int h = 0; h < 4; ++h) { const float s = wave_sum(sum[h]); if (lane == 0) red[32 + wid * 4 + h] = s; }
    }
    __syncthreads();
#pragma unroll
    for (int h = 0; h < 4; ++h) { float s = 0.f; for (int w = 0; w < 8; ++w) s += red[32 + w * 4 + h]; inv[h] = s > 0.f ? 1.0f / s : 0.f; }
    for (int n = tid; n < 1088; n += 512) phs[n] = n < NC ? (sc[n] * inv[0] + sc[1024 + n] * inv[1]) + (sc[2048 + n] * inv[2] + sc[3072 + n] * inv[3]) : 0.f;
    {
        float a[4] = {0.f, 0.f, 0.f, 0.f};
#pragma unroll 16
        for (int n = wid; n < NC; n += 8) {
            const float v = vc[(size_t)n * 64 + lane];
#pragma unroll
            for (int h = 0; h < 4; ++h) a[h] += sc[h * 1024 + n] * v;
        }
#pragma unroll
        for (int h = 0; h < 4; ++h) part[(wid * 4 + h) * 68 + lane] = a[h] * inv[h];
    }
    __syncthreads();
    if (tid < 256) { float a = 0.f; for (int w = 0; w < 8; ++w) a += part[(w * 4 + (tid >> 6)) * 68 + (tid & 63)]; ocp[tid] = a; }
    __syncthreads();
    if (wid == 0) {
        unsigned long long key[NJR];
#pragma unroll
        for (int jr = 0; jr < NJR; ++jr) {
            const int j = jr * 64 + lane;
            key[jr] = 0ull;
            if (j >= 1 && j <= qblk - 2 && j < NSEL) {
                float im = 0.f;
#pragma unroll
                for (int n = 4 * j - 1; n <= 4 * j + 3; ++n) im += (n < NC) ? phs[n] : 0.f;
                key[jr] = ((unsigned long long)__float_as_uint(im) << 32) | (unsigned)(0xFFFF - j) | 0x10000ull;
            }
        }
        if (lane == 0) { sel[0] = 0; sel[1] = qblk - 1; sel[2] = qblk; }
#pragma unroll 1
        for (int it = 0; it < 13; ++it) {
            unsigned long long best = 0ull;
#pragma unroll
            for (int jr = 0; jr < NJR; ++jr) best = key[jr] > best ? key[jr] : best;
#pragma unroll
            for (int o = 32; o > 0; o >>= 1) { const unsigned long long ot = __shfl_xor(best, o); best = ot > best ? ot : best; }
            const int j = 0xFFFF - (int)(best & 0xFFFFull);
#pragma unroll
            for (int jr = 0; jr < NJR; ++jr) if (key[jr] == best) key[jr] = 0ull;
            if (lane == 0) sel[3 + it] = j;
        }
    }
    __syncthreads();
    {
        float ms[4] = {-1e30f, -1e30f, -1e30f, -1e30f}, ls[4] = {0.f, 0.f, 0.f, 0.f}, os[4] = {0.f, 0.f, 0.f, 0.f};
#pragma unroll 1
        for (int i = wid; i < 16; i += 8) attn_chunk<true>(p, 1, b, g, t, sel[i] * 64, 0, t, ms, ls, os, qs, pbk, relb, lane);
        float mw[4] = {-1e30f, -1e30f, -1e30f, -1e30f}, lw[4] = {0.f, 0.f, 0.f, 0.f}, ow[4] = {0.f, 0.f, 0.f, 0.f};
#pragma unroll 1
        for (int c = wid; c < 9; c += 8) attn_chunk<true>(p, 2, b, g, t, t - 63 - 64 * c, t - WIN, t, mw, lw, ow, qs, pbk, relb, lane);
#pragma unroll
        for (int h = 0; h < 4; ++h) {
            LAS float* ps = part + (wid * 4 + h) * 68; LAS float* pw = part + 8 * 272 + (wid * 4 + h) * 68;
            ps[lane] = os[h]; pw[lane] = ow[h];
            if (lane == 0) { ps[64] = ms[h]; ps[65] = ls[h]; pw[64] = mw[h]; pw[65] = lw[h]; }
        }
    }
    __syncthreads();
    if (tid < 256) {
        const int h = tid >> 6, d = tid & 63;
        float res[2];
#pragma unroll
        for (int br = 0; br < 2; ++br) {
            const LAS float* pp = part + br * 8 * 272 + h * 68;
            float m = -1e30f;
            for (int w = 0; w < 8; ++w) m = fmaxf(m, pp[w * 272 + 64]);
            float l = 0.f, o = 0.f;
            for (int w = 0; w < 8; ++w) { const float sc_ = ex2(pp[w * 272 + 64] - m); l += pp[w * 272 + 65] * sc_; o += pp[w * 272 + d] * sc_; }
            res[br] = o / l;
        }
        const float* gt = p.GATE + (size_t)row * 32 + (g * 4 + h) * 3;
        const float v = gt[0] * ocp[tid] + gt[1] * res[0] + gt[2] * res[1];
        p.OCAT[(size_t)row * DM + (g * 4 + h) * 64 + d] = f2bf(v);
    }
    __syncthreads();
}

constexpr int A_OST = 0, OST_LD = 68, A_LST = A_OST + 256 * OST_LD * 4, A_M0 = A_LST + 1024, A_MB = A_M0 + 1024, MB_LD = 132, A_MKN = A_MB + 64 * MB_LD,
              A_LIST = A_MKN + 256, A_CNT = A_LIST + 132 * 64, A_PK = A_CNT + 544, A_KN = A_PK + 400 * 4, A_T2 = A_KN + 512, A_NP = A_T2 + 132 * 8 * 4, A_QT = A_NP + 16, ATT2_LDS = A_QT + 64 * 512;
static_assert(ATT2_LDS <= GEMM_LDS && ATTS_LDS <= GEMM_LDS, "attention LDS");

__device__ __forceinline__ void qk64(const bf16_t* kb, int c, int G, const bf16x8 (&qB)[2], f32x4 (&s)[4]) {
#pragma unroll
    for (int kt = 0; kt < 4; ++kt) {
        const bf16_t* r = kb + (size_t)(16 * kt + c) * 256 + G * 8;
        const bf16x8 a0 = *(const bf16x8*)r, a1 = *(const bf16x8*)(r + 32);
        s[kt] = mfma16(a0, qB[0], (f32x4){0.f, 0.f, 0.f, 0.f}); s[kt] = mfma16(a1, qB[1], s[kt]);
    }
}
__device__ __forceinline__ void pv64(const bf16_t* vf, int key0, int lane, const f32x4 (&pr)[4], f32x4 (&o)[4]) {
#pragma unroll
    for (int ks = 0; ks < 2; ++ks) {
        const bf16x8 pB = pack_p(pr[2 * ks], pr[2 * ks + 1]);
#pragma unroll
        for (int dt = 0; dt < 4; ++dt) {
            const bf16x8 vA = *(const bf16x8*)(vf + ((size_t)(((key0 >> 5) + ks) * 4 + dt) * 64 + lane) * 8);
            o[dt] = mfma16(vA, pB, o[dt]);
        }
    }
}
__device__ __forceinline__ int qt_off(int qi, int hh, int k) { return (qi * 4 + hh) * 128 + ((k ^ (((qi & 3) << 1) | (hh >> 1))) << 4); }
__device__ __forceinline__ float grp_max(float v) {
    auto r = __builtin_amdgcn_permlane16_swap(__float_as_uint(v), __float_as_uint(v), false, false); v = fmaxf(__uint_as_float(r[0]), __uint_as_float(r[1]));
    r = __builtin_amdgcn_permlane32_swap(__float_as_uint(v), __float_as_uint(v), false, false); return fmaxf(__uint_as_float(r[0]), __uint_as_float(r[1]));
}
__device__ __forceinline__ float grp_sum(float v) {
    auto r = __builtin_amdgcn_permlane16_swap(__float_as_uint(v), __float_as_uint(v), false, false); v = __uint_as_float(r[0]) + __uint_as_float(r[1]);
    r = __builtin_amdgcn_permlane32_swap(__float_as_uint(v), __float_as_uint(v), false, false); return __uint_as_float(r[0]) + __uint_as_float(r[1]);
}
__device__ __forceinline__ int grp_min_i(int v) {
    auto r = __builtin_amdgcn_permlane16_swap((unsigned)v, (unsigned)v, false, false); v = (int)r[0] < (int)r[1] ? (int)r[0] : (int)r[1];
    r = __builtin_amdgcn_permlane32_swap((unsigned)v, (unsigned)v, false, false); return (int)r[0] < (int)r[1] ? (int)r[0] : (int)r[1];
}
__device__ __forceinline__ float dpp_x1(float v) { return __uint_as_float(__builtin_amdgcn_mov_dpp(__float_as_uint(v), 0xB1, 0xF, 0xF, true)); }
__device__ __forceinline__ float dpp_x2(float v) { return __uint_as_float(__builtin_amdgcn_mov_dpp(__float_as_uint(v), 0x4E, 0xF, 0xF, true)); }
__device__ __forceinline__ int dpp_x1i(int v) { return (int)__builtin_amdgcn_mov_dpp((unsigned)v, 0xB1, 0xF, 0xF, true); }
__device__ __forceinline__ int dpp_x2i(int v) { return (int)__builtin_amdgcn_mov_dpp((unsigned)v, 0x4E, 0xF, 0xF, true); }
__device__ __forceinline__ unsigned row_or_q(unsigned u) {
    u |= __builtin_amdgcn_mov_dpp(u, 0x124, 0xF, 0xF, true); u |= __builtin_amdgcn_mov_dpp(u, 0x128, 0xF, 0xF, true); return u;
}

__device__ __forceinline__ void attn_cmp(const Params& p, int b, int g, int t0, int lane_, LAS unsigned char* L, unsigned (&msk)[4]) {
    f32x4 oacc[4];
    int lane = lane_; asm volatile("" : "+v"(lane));
    const int c = lane & 15, G = lane >> 4, qs = c >> 2, hh = c & 3;
    const int qb = t0 >> 6, tc = t0 + qs;
    const size_t qrow = (size_t)b * SEQ + tc;
    const LAS float* T2 = (const LAS float*)(L + A_T2);
    const float b31 = T2[128 * 8 + g * 4 + hh];
    bf16x8 qB[2];
    qB[0] = *(const bf16x8*)(p.Qb + qrow * QD + (g * 4 + hh) * 64 + G * 8); qB[1] = *(const bf16x8*)(p.Qb + qrow * QD + (g * 4 + hh) * 64 + 32 + G * 8);
    const float* gate = p.GATE + qrow * 32 + (g * 4 + hh) * 3;
    msk[0] = msk[1] = msk[2] = msk[3] = 0u;
    {
        const int ncv_c = tc >= 31 ? ((tc - 31) >> 4) + 1 : 0;
        const int ncv_m = t0 + 3 >= 31 ? ((t0 + 3 - 31) >> 4) + 1 : 0;
        const int NT = (ncv_m + 15) >> 4;
        const int mt_far = t0 >= 399 ? (t0 - 399) / 256 + 1 : 0;
        const bf16_t* kcb = p.KCb + (size_t)(b * NG + g) * 512 * 64;
        f32x4 sc[32];
        float mxf = -1e30f, mxn = -1e30f;
        bf16x8 kbuf[2][4][2];
        auto ldkg = [&](int grp, bf16x8 (&kb)[4][2]) __attribute__((always_inline)) {
#pragma unroll
            for (int q = 0; q < 4; ++q) { const bf16_t* r = kcb + ((size_t)((grp * 4 + q) * 2) * 64 + lane) * 8; kb[q][0] = *(const bf16x8*)r; kb[q][1] = *(const bf16x8*)(r + 512); }
        };
        ldkg(0, kbuf[0]);
#pragma unroll
        for (int grp = 0; grp < 8; ++grp) {
            if (4 * grp < NT) {
                if (4 * (grp + 1) < NT) ldkg(grp + 1, kbuf[(grp + 1) & 1]);
                __builtin_amdgcn_sched_barrier(0);
#pragma unroll
                for (int q = 0; q < 4; ++q) {
                    const int mt = grp * 4 + q;
                    f32x4 s = mfma16(kbuf[grp & 1][q][0], qB[0], (f32x4){0.f, 0.f, 0.f, 0.f}); s = mfma16(kbuf[grp & 1][q][1], qB[1], s);
                    if (mt < mt_far) { mxf = fmaxf(mxf, fmaxf(fmaxf(s[0], s[1]), fmaxf(s[2], s[3]))); }
                    else {
#pragma unroll
                        for (int i = 0; i < 4; ++i) { const int n = 16 * mt + 4 * G + i; int dist = tc - (16 * n + 31); const bool ok = n < ncv_c; dist = dist < 0 ? 0 : (dist > 128 ? 128 : dist);
                            s[i] = ok ? s[i] + T2[dist * 8 + g * 4 + hh] : -1e30f; }
                        mxn = fmaxf(mxn, fmaxf(fmaxf(s[0], s[1]), fmaxf(s[2], s[3])));
                    }
                    sc[mt] = s;
                }
            } else {
#pragma unroll
                for (int q = 0; q < 4; ++q) sc[grp * 4 + q] = (f32x4){0.f, 0.f, 0.f, 0.f};
            }
        }
        const float mx = grp_max(fmaxf(mxf + b31, mxn));
        const float shf = mx - b31;
#pragma unroll
        for (int mt = 0; mt < 32; ++mt) if ((mt & ~3) < NT) {
            const float sh = mt < mt_far ? shf : mx;
#pragma unroll
            for (int i = 0; i < 4; ++i) sc[mt][i] = ex2(sc[mt][i] - sh);
        }
        const bf16_t* vct = p.VCT + (size_t)(b * NG + g) * 64 * 512;
        const bf16x8 ones = __builtin_bit_cast(bf16x8, (u32x4){0x3F803F80u, 0x3F803F80u, 0x3F803F80u, 0x3F803F80u});
        f32x4 oc[4] = {{0.f, 0.f, 0.f, 0.f}, {0.f, 0.f, 0.f, 0.f}, {0.f, 0.f, 0.f, 0.f}, {0.f, 0.f, 0.f, 0.f}};
        f32x4 rs = {0.f, 0.f, 0.f, 0.f};
        bf16x8 vbuf[2][2][4];
        auto ldvg = [&](int grp, bf16x8 (&vb)[2][4]) __attribute__((always_inline)) {
#pragma unroll
            for (int q = 0; q < 2; ++q)
#pragma unroll
                for (int dt = 0; dt < 4; ++dt) vb[q][dt] = *(const bf16x8*)(vct + ((size_t)((grp * 2 + q) * 4 + dt) * 64 + lane) * 8);
        };
        ldvg(0, vbuf[0]);
#pragma unroll
        for (int grp = 0; grp < 8; ++grp) if (4 * grp < NT) {
            if (4 * (grp + 1) < NT) ldvg(grp + 1, vbuf[(grp + 1) & 1]);
            __builtin_amdgcn_sched_barrier(0);
#pragma unroll
            for (int q = 0; q < 2; ++q) {
                const int k2 = grp * 2 + q;
                const bf16x8 pB = pack_p(sc[2 * k2], sc[2 * k2 + 1]);
                rs = mfma16(ones, pB, rs);
#pragma unroll
                for (int dt = 0; dt < 4; ++dt) oc[dt] = mfma16(vbuf[grp & 1][q][dt], pB, oc[dt]);
            }
        }
        const float inv = ncv_c > 0 ? __builtin_amdgcn_rcpf(rs[0]) : 0.f;
        if (qb <= 15) {
            msk[0] = (qb >= 31) ? 0xffffffffu : ((2u << qb) - 1u);
        } else {
            unsigned cand[8];
#pragma unroll
            for (int k = 0; k < 8; ++k) cand[k] = 0u;
            float prevB = 0.f;
#pragma unroll
            for (int mt = 0; mt < 32; ++mt) if (mt < NT) {
                const unsigned x3 = __float_as_uint(sc[mt][3]);
                const auto p16 = __builtin_amdgcn_permlane16_swap(x3, x3, false, false);
                const auto p32 = __builtin_amdgcn_permlane32_swap(p16[1], p16[1], false, false);
                const float r1 = G == 2 ? __uint_as_float(p32[0]) : __uint_as_float(p16[0]);
                float v = ((sc[mt][0] + sc[mt][1]) + (sc[mt][2] + sc[mt][3]) + (G == 0 ? prevB : r1)) * inv;
                prevB = __uint_as_float(p32[1]);
                v += dpp_x1(v); v += dpp_x2(v);
                const int j = 4 * mt + G;
                if ((mt & 3) == hh) cand[mt >> 2] = (j >= 1 && j <= qb - 2) ? ((__float_as_uint(v) & ~127u) | (unsigned)(127 - j)) : 0u;
            }
            auto setbit = [&](int j) { const unsigned bit = 1u << (j & 31); const int w = j >> 5; msk[0] |= w == 0 ? bit : 0u; msk[1] |= w == 1 ? bit : 0u; msk[2] |= w == 2 ? bit : 0u; msk[3] |= w == 3 ? bit : 0u; };
            setbit(0); setbit(qb); setbit(qb - 1);
#pragma unroll 1
            for (int it = 0; it < 13; ++it) {
                unsigned bv = cand[0];
#pragma unroll
                for (int k = 1; k < 8; ++k) bv = bv > cand[k] ? bv : cand[k];
                { unsigned o = __builtin_amdgcn_mov_dpp(bv, 0xB1, 0xF, 0xF, true); bv = o > bv ? o : bv; o = __builtin_amdgcn_mov_dpp(bv, 0x4E, 0xF, 0xF, true); bv = o > bv ? o : bv;
                  auto r = __builtin_amdgcn_permlane16_swap(bv, bv, false, false); bv = r[0] > r[1] ? r[0] : r[1]; r = __builtin_amdgcn_permlane32_swap(bv, bv, false, false); bv = r[0] > r[1] ? r[0] : r[1]; }
#pragma unroll
                for (int k = 0; k < 8; ++k) cand[k] = cand[k] == bv ? 0u : cand[k];
                setbit(127 - (int)(bv & 127u));
            }
        }
        const float g0 = gate[0] * inv;
#pragma unroll
        for (int dt = 0; dt < 4; ++dt) oacc[dt] = oc[dt] * g0;
    }
    bf16_t* orow = p.OCAT + qrow * DM + (g * 4 + hh) * 64 + 4 * G;
#pragma unroll
    for (int dt = 0; dt < 4; ++dt) st_bf16x4(orow + dt * 16, oacc[dt]);
}

struct PackSt { bf16x8 q0, q1; float m; f32x4 l4; f32x4 o[4]; };
__device__ __forceinline__ void attn_selwin_pair(const Params& p, int b, int g, int t0, int lane_, LAS unsigned char* L, const unsigned (&mskA)[4], const unsigned (&mskB)[4]) {
    int lane = lane_; asm volatile("" : "+v"(lane));
    const int c = lane & 15, G = lane >> 4, qs = c >> 2, hh = c & 3;
    const int qb = t0 >> 6;
    const LAS float* T2 = (const LAS float*)(L + A_T2);
    const float b31 = T2[128 * 8 + g * 4 + hh];
    const int tcA = t0 + qs, tcB = t0 + 4 + qs;
    const size_t qrowA = (size_t)b * SEQ + tcA;
    PackSt A, B;
    {
        const bf16_t* qa = p.Qb + qrowA * QD + (g * 4 + hh) * 64 + G * 8;
        A.q0 = *(const bf16x8*)qa; A.q1 = *(const bf16x8*)(qa + 32); B.q0 = *(const bf16x8*)(qa + 4 * QD); B.q1 = *(const bf16x8*)(qa + 4 * QD + 32);
    }
    auto reset = [&](PackSt& S) __attribute__((always_inline)) { S.m = -1e30f; S.l4 = (f32x4){0.f, 0.f, 0.f, 0.f};
#pragma unroll
        for (int dt = 0; dt < 4; ++dt) S.o[dt] = (f32x4){0.f, 0.f, 0.f, 0.f}; };
    const bf16x8 ones = __builtin_bit_cast(bf16x8, (u32x4){0x3F803F80u, 0x3F803F80u, 0x3F803F80u, 0x3F803F80u});
    auto finish = [&](PackSt& S, f32x4 (&s)[4], float cb, bool mine, const bf16x8 (&vf)[2][4]) __attribute__((always_inline)) {
        float cm = fmaxf(fmaxf(fmaxf(s[0][0], s[0][1]), fmaxf(s[0][2], s[0][3])), fmaxf(fmaxf(s[1][0], s[1][1]), fmaxf(s[1][2], s[1][3])));
        cm = fmaxf(cm, fmaxf(fmaxf(fmaxf(s[2][0], s[2][1]), fmaxf(s[2][2], s[2][3])), fmaxf(fmaxf(s[3][0], s[3][1]), fmaxf(s[3][2], s[3][3]))));
        cm = grp_max(mine ? cm + cb : -1e30f);
        const float mn = fmaxf(S.m, cm), al = ex2(S.m - mn);
        const float sh = (mine ? mn : 1e30f) - cb;
#pragma unroll
        for (int kt = 0; kt < 4; ++kt)
#pragma unroll
            for (int i = 0; i < 4; ++i) s[kt][i] = ex2(s[kt][i] - sh);
        S.m = mn;
        f32x4 rs = {0.f, 0.f, 0.f, 0.f};
#pragma unroll
        for (int dt = 0; dt < 4; ++dt) S.o[dt] = S.o[dt] * al;
#pragma unroll
        for (int ks = 0; ks < 2; ++ks) { const bf16x8 pB = pack_p(s[2 * ks], s[2 * ks + 1]);
            rs = mfma16(ones, pB, rs);
#pragma unroll
            for (int dt = 0; dt < 4; ++dt) S.o[dt] = mfma16(vf[ks][dt], pB, S.o[dt]); }
        S.l4[0] = S.l4[0] * al + rs[0];
    };
    auto addout = [&](PackSt& S, size_t qrow, int br) __attribute__((always_inline)) {
        const float gs = p.GATE[qrow * 32 + (g * 4 + hh) * 3 + br] * __builtin_amdgcn_rcpf(S.l4[0]);
        bf16_t* orow = p.OCAT + qrow * DM + (g * 4 + hh) * 64 + 4 * G;
#pragma unroll
        for (int dt = 0; dt < 4; ++dt) { const u32x2 w = *(const u32x2*)(orow + dt * 16); f32x4 pa; pa[0] = bflo(w.x); pa[1] = bfhi(w.x); pa[2] = bflo(w.y); pa[3] = bfhi(w.y);
            st_bf16x4(orow + dt * 16, pa + S.o[dt] * gs); }
    };
    {
        unsigned umA[4], umB[4], um[4];
#pragma unroll
        for (int w = 0; w < 4; ++w) {
            umA[w] = __builtin_amdgcn_readfirstlane(row_or_q(mskA[w]));
            umB[w] = __builtin_amdgcn_readfirstlane(row_or_q(mskB[w]));
            um[w] = umA[w] | umB[w];
        }
        reset(A); reset(B);
        const bf16_t* klane = p.SLCkF + (size_t)(b * NG + g) * SEQ * 64 + lane * 8;
        const bf16_t* vlane = p.SLCvT + (size_t)(b * NG + g) * SEQ * 64 + lane * 8;
        auto ldfr = [&](int j_, bf16x8 (&kf_)[4][2], bf16x8 (&vf_)[2][4]) __attribute__((always_inline)) {
            const bf16_t* kr = klane + (size_t)j_ * 4096; const bf16_t* vr = vlane + (size_t)j_ * 4096;
#pragma unroll
            for (int kt = 0; kt < 4; ++kt) { kf_[kt][0] = *(const bf16x8*)(kr + (kt * 2) * 512); kf_[kt][1] = *(const bf16x8*)(kr + (kt * 2 + 1) * 512); }
#pragma unroll
            for (int ks = 0; ks < 2; ++ks)
#pragma unroll
                for (int dt = 0; dt < 4; ++dt) vf_[ks][dt] = *(const bf16x8*)(vr + (ks * 4 + dt) * 512);
        };
        auto nextj = [&](int& j_) __attribute__((always_inline)) {
            int w = um[0] ? 0 : um[1] ? 1 : um[2] ? 2 : um[3] ? 3 : -1;
            if (w < 0) return false;
            const unsigned u = w == 0 ? um[0] : w == 1 ? um[1] : w == 2 ? um[2] : um[3];
            const int bpos = __builtin_ctz(u);
            j_ = w * 32 + bpos;
            const unsigned cl = ~(1u << bpos);
            if (w == 0) um[0] &= cl; else if (w == 1) um[1] &= cl; else if (w == 2) um[2] &= cl; else um[3] &= cl;
            return true;
        };
        auto packstep = [&](PackSt& S, const unsigned (&msk)[4], int tc, int j, const bf16x8 (&kf)[4][2], const bf16x8 (&vf)[2][4]) __attribute__((always_inline)) {
            const unsigned mw = (j >> 5) == 0 ? msk[0] : (j >> 5) == 1 ? msk[1] : (j >> 5) == 2 ? msk[2] : msk[3];
            const bool mine = (mw >> (j & 31)) & 1u;
            const bool farb = j <= qb - 3;
            f32x4 s[4];
#pragma unroll
            for (int kt = 0; kt < 4; ++kt) { s[kt] = mfma16(kf[kt][0], S.q0, (f32x4){0.f, 0.f, 0.f, 0.f}); s[kt] = mfma16(kf[kt][1], S.q1, s[kt]); }
            if (!farb) {
#pragma unroll
                for (int kt = 0; kt < 4; ++kt)
#pragma unroll
                    for (int i = 0; i < 4; ++i) { const int dist = tc - (j * 64 + 16 * kt + 4 * G + i); const int dd = dist < 0 ? 0 : (dist > 128 ? 128 : dist);
                        s[kt][i] = dist >= 0 ? s[kt][i] + T2[dd * 8 + g * 4 + hh] : -1e30f; }
            }
            finish(S, s, farb ? b31 : 0.f, mine, vf);
        };
        auto blockstep = [&](int j, const bf16x8 (&kf)[4][2], const bf16x8 (&vf)[2][4]) __attribute__((always_inline)) {
            const int w = j >> 5; const unsigned bit = 1u << (j & 31);
            const unsigned ua = w == 0 ? umA[0] : w == 1 ? umA[1] : w == 2 ? umA[2] : umA[3];
            const unsigned ub = w == 0 ? umB[0] : w == 1 ? umB[1] : w == 2 ? umB[2] : umB[3];
            if (ua & bit) packstep(A, mskA, tcA, j, kf, vf);
            if (ub & bit) packstep(B, mskB, tcB, j, kf, vf);
        };
        auto ldk = [&](int j_, bf16x8 (&kf_)[4][2]) __attribute__((always_inline)) {
            const bf16_t* kr = klane + (size_t)j_ * 4096;
#pragma unroll
            for (int kt = 0; kt < 4; ++kt) { kf_[kt][0] = *(const bf16x8*)(kr + (kt * 2) * 512); kf_[kt][1] = *(const bf16x8*)(kr + (kt * 2 + 1) * 512); }
        };
        auto ldv = [&](int j_, bf16x8 (&vf_)[2][4]) __attribute__((always_inline)) {
            const bf16_t* vr = vlane + (size_t)j_ * 4096;
#pragma unroll
            for (int ks = 0; ks < 2; ++ks)
#pragma unroll
                for (int dt = 0; dt < 4; ++dt) vf_[ks][dt] = *(const bf16x8*)(vr + (ks * 4 + dt) * 512);
        };
        bf16x8 kfA[4][2], kfB[4][2], vf[2][4];
        int j = 0; bool have = nextj(j);
        ldk(j, kfA);
#pragma unroll 1
        while (have) {
            int jn = j; bool haven = nextj(jn);
            ldv(j, vf); ldk(jn, kfB);
            __builtin_amdgcn_sched_barrier(0);
            blockstep(j, kfA, vf);
            if (!haven) break;
            j = jn; have = nextj(jn);
            ldv(j, vf); ldk(jn, kfA);
            __builtin_amdgcn_sched_barrier(0);
            blockstep(j, kfB, vf);
            j = jn;
        }
        addout(A, qrowA, 1); addout(B, qrowA + 4, 1);
    }
    {
        reset(A); reset(B);
        const int loA = t0 - WIN > 0 ? t0 - WIN : 0, hiA = t0 + 3, loB = t0 + 4 - WIN > 0 ? t0 + 4 - WIN : 0, hiB = t0 + 7;
        const bf16_t* klane = p.WINkF + (size_t)(b * NG + g) * SEQ * 64 + lane * 8;
        const bf16_t* vlane = p.WINvT + (size_t)(b * NG + g) * SEQ * 64 + lane * 8;
        auto ldfr = [&](int cb_, bf16x8 (&kf_)[4][2], bf16x8 (&vf_)[2][4]) __attribute__((always_inline)) {
            const bf16_t* kr = klane + (size_t)cb_ * 64; const bf16_t* vr = vlane + (size_t)cb_ * 64;
#pragma unroll
            for (int kt = 0; kt < 4; ++kt) { kf_[kt][0] = *(const bf16x8*)(kr + (kt * 2) * 512); kf_[kt][1] = *(const bf16x8*)(kr + (kt * 2 + 1) * 512); }
#pragma unroll
            for (int ks = 0; ks < 2; ++ks)
#pragma unroll
                for (int dt = 0; dt < 4; ++dt) vf_[ks][dt] = *(const bf16x8*)(vr + (ks * 4 + dt) * 512);
        };
        auto packstep = [&](PackSt& S, int tq0, int tc, int cb, const bf16x8 (&kf)[4][2], const bf16x8 (&vf)[2][4]) __attribute__((always_inline)) {
            const bool far = (cb + 63 <= tq0 - 128) && (cb >= tq0 + 3 - WIN);
            f32x4 s[4];
#pragma unroll
            for (int kt = 0; kt < 4; ++kt) { s[kt] = mfma16(kf[kt][0], S.q0, (f32x4){0.f, 0.f, 0.f, 0.f}); s[kt] = mfma16(kf[kt][1], S.q1, s[kt]); }
            if (!far) {
#pragma unroll
                for (int kt = 0; kt < 4; ++kt)
#pragma unroll
                    for (int i = 0; i < 4; ++i) { const int dist = tc - (cb + 16 * kt + 4 * G + i); const bool ok = dist >= 0 && dist <= WIN; const int dd = dist < 0 ? 0 : (dist > 128 ? 128 : dist);
                        s[kt][i] = ok ? s[kt][i] + T2[dd * 8 + g * 4 + hh] : -1e30f; }
            }
            finish(S, s, far ? b31 : 0.f, true, vf);
        };
        auto chunkstep = [&](int cb, const bf16x8 (&kf)[4][2], const bf16x8 (&vf)[2][4]) __attribute__((always_inline)) {
            if (cb <= hiA) packstep(A, t0, tcA, cb, kf, vf);
            if (cb + 63 >= loB) packstep(B, t0 + 4, tcB, cb, kf, vf);
        };
        auto ldk = [&](int cb_, bf16x8 (&kf_)[4][2]) __attribute__((always_inline)) {
            const bf16_t* kr = klane + (size_t)cb_ * 64;
#pragma unroll
            for (int kt = 0; kt < 4; ++kt) { kf_[kt][0] = *(const bf16x8*)(kr + (kt * 2) * 512); kf_[kt][1] = *(const bf16x8*)(kr + (kt * 2 + 1) * 512); }
        };
        auto ldv = [&](int cb_, bf16x8 (&vf_)[2][4]) __attribute__((always_inline)) {
            const bf16_t* vr = vlane + (size_t)cb_ * 64;
#pragma unroll
            for (int ks = 0; ks < 2; ++ks)
#pragma unroll
                for (int dt = 0; dt < 4; ++dt) vf_[ks][dt] = *(const bf16x8*)(vr + (ks * 4 + dt) * 512);
        };
        bf16x8 kfA[4][2], kfB[4][2], vf[2][4];
        int cb = loA & ~63;
        ldk(cb, kfA);
#pragma unroll 1
        for (;;) {
            ldv(cb, vf); ldk(cb + 64 <= hiB ? cb + 64 : cb, kfB);
            __builtin_amdgcn_sched_barrier(0);
            chunkstep(cb, kfA, vf);
            cb += 64; if (cb > hiB) break;
            ldv(cb, vf); ldk(cb + 64 <= hiB ? cb + 64 : cb, kfA);
            __builtin_amdgcn_sched_barrier(0);
            chunkstep(cb, kfB, vf);
            cb += 64; if (cb > hiB) break;
        }
        addout(A, qrowA, 2); addout(B, qrowA + 4, 2);
    }
}

__device__ __forceinline__ void phase_attn(const Params& p) {
    const int wid = threadIdx.x >> 6, lane = threadIdx.x & 63;
    { PROBE_BEGIN(3)
    if (blockIdx.x < NS * NG) attn_sample_item(p, blockIdx.x >> 1, blockIdx.x & 1);
    PROBE_END(3) }
    LAS unsigned char* L = (LAS unsigned char*)smem;
    for (int i = threadIdx.x; i < 129 * 8; i += 512) ((LAS float*)(L + A_T2))[i] = p.rel_bias[t5_bucket(i >> 3) * 8 + (i & 7)] * LOG2E;
    __syncthreads();
    {
        const int wid2 = __builtin_amdgcn_readfirstlane(threadIdx.x >> 6);
#pragma unroll 1
        for (;;) {
            __syncthreads();
            if (threadIdx.x == 0) ((LAS int*)(L + A_NP))[1] = (int)__hip_atomic_fetch_add(p.bar, 1u, __ATOMIC_RELAXED, __HIP_MEMORY_SCOPE_AGENT);
            __syncthreads();
            const int T = ((const LAS int*)(L + A_NP))[1];
            if (T >= NB * NG * (SEQ / 64)) break;
            const int bg = T & 7, qb = (SEQ / 64 - 1) - (T >> 3), t0 = qb * 64 + wid2 * 8;
            unsigned mA[4], mB[4];
            PROBE_BEGIN(6)
            attn_cmp(p, bg >> 1, bg & 1, t0, lane, L, mA);
            attn_cmp(p, bg >> 1, bg & 1, t0 + 4, lane, L, mB);
            PROBE_END(6)
            PROBE_BEGIN(7)
            attn_selwin_pair(p, bg >> 1, bg & 1, t0, lane, L, mA, mB);
            PROBE_END(7)
        }
    }
    __syncthreads();
}

constexpr int GM_LD = 136, GM_LDS = 128 * GM_LD * 2 + 1024;
__device__ __forceinline__ void phase_gmlp(const Params& p) {
    int tid = threadIdx.x; asm volatile("" : "+v"(tid));
    const int wid = __builtin_amdgcn_readfirstlane(tid >> 6), lane = tid & 63;
    LAS bf16_t* vnT = (LAS bf16_t*)smem;
    LAS float* mu = (LAS float*)(smem + 128 * GM_LD * 2);
    const int c = lane & 15, G = lane >> 4;
#pragma unroll 1
    for (int u = blockIdx.x; u < NB * 64; u += gridDim.x) {
        const int b = u >> 6, ch = u & 63; const size_t row0 = (size_t)b * SEQ + ch * 128;
        __syncthreads();
        for (int r = wid; r < 128; r += 8) {
            const u32x4 w = *(const u32x4*)(p.Vg + (row0 + r) * GMD + lane * 8);
            const float x[8] = {bflo(w.x), bfhi(w.x), bflo(w.y), bfhi(w.y), bflo(w.z), bfhi(w.z), bflo(w.w), bfhi(w.w)};
            float s = 0.f;
#pragma unroll
            for (int i = 0; i < 8; ++i) s += x[i];
            const float mean = wave_sum(s) * (1.0f / GMD);
            float q = 0.f;
#pragma unroll
            for (int i = 0; i < 8; ++i) q += (x[i] - mean) * (x[i] - mean);
            const float var = wave_sum(q) * (1.0f / GMD);
            if (lane == 0) { mu[r] = mean; mu[128 + r] = rsqrtf(var + EPS); }
        }
#pragma unroll 1
        for (int g = 0; g < 4; ++g) {
            __syncthreads();
#pragma unroll
            for (int k = 0; k < 4; ++k) {
                const int e = tid + 512 * k, s = e & 127, d0 = (e >> 7) * 8;
                const u32x4 w = *(const u32x4*)(p.Vg + (row0 + s) * GMD + g * 128 + d0);
                const float x[8] = {bflo(w.x), bfhi(w.x), bflo(w.y), bfhi(w.y), bflo(w.z), bfhi(w.z), bflo(w.w), bfhi(w.w)};
                const float m = mu[s], rs = mu[128 + s];
#pragma unroll
                for (int i = 0; i < 8; ++i) { const int cc = g * 128 + d0 + i; vnT[(d0 + i) * GM_LD + s] = f2bf((x[i] - m) * rs * p.gm_ln_g[cc] + p.gm_ln_b[cc]); }
            }
            __syncthreads();
            f32x4 acc[8];
#pragma unroll
            for (int dt = 0; dt < 8; ++dt) acc[dt] = (f32x4){0.f, 0.f, 0.f, 0.f};
            const bf16_t* wrow = p.GWb + ((size_t)g * 128 + 16 * wid + c) * 128 + 8 * G;
#pragma unroll 1
            for (int ks = 0; ks <= (wid >> 1); ++ks) {
                const bf16x8 B = *(const bf16x8*)(wrow + 32 * ks);
#pragma unroll
                for (int dt = 0; dt < 8; ++dt) {
                    const bf16x8 A = *(const LAS bf16x8*)(vnT + (dt * 16 + c) * GM_LD + 32 * ks + 8 * G);
                    acc[dt] = mfma16(A, B, acc[dt]);
                }
            }
            const int t = 16 * wid + c;
            const float bs = p.gm_bs[g * 128 + t];
#pragma unroll
            for (int dt = 0; dt < 8; ++dt) {
                const int d = dt * 16 + 4 * G;
                const u32x2 uw = *(const u32x2*)(p.U + (row0 + t) * GMD + g * 128 + d);
                f32x4 o; o[0] = bflo(uw.x) * (acc[dt][0] + bs); o[1] = bfhi(uw.x) * (acc[dt][1] + bs); o[2] = bflo(uw.y) * (acc[dt][2] + bs); o[3] = bfhi(uw.y) * (acc[dt][3] + bs);
                st_bf16x4(p.OCAT + (row0 + t) * DM + QD + g * 128 + d, o);
            }
        }
    }
    for (int it = blockIdx.x * 8 + wid; it < NS; it += gridDim.x * 8) {
        const size_t row = (size_t)MP + it;
        const u32x4 w = *(const u32x4*)(p.Vg + row * GMD + lane * 8);
        const float x[8] = {bflo(w.x), bfhi(w.x), bflo(w.y), bfhi(w.y), bflo(w.z), bfhi(w.z), bflo(w.w), bfhi(w.w)};
        float s = 0.f;
#pragma unroll
        for (int i = 0; i < 8; ++i) s += x[i];
        const float mean = wave_sum(s) * (1.0f / GMD);
        float q = 0.f;
#pragma unroll
        for (int i = 0; i < 8; ++i) q += (x[i] - mean) * (x[i] - mean);
        const float rs = rsqrtf(wave_sum(q) * (1.0f / GMD) + EPS);
#pragma unroll
        for (int i = 0; i < 8; ++i) {
            const int c = lane * 8 + i, g = c >> 7;
            const float v = (x[i] - mean) * rs * p.gm_ln_g[c] + p.gm_ln_b[c];
            p.out[O_GMV + (size_t)it * GMD + c] = v;
            const float a = p.gm_ws[(size_t)g * 128 * 128] * v + p.gm_bs[g * 128];
            p.OCAT[row * DM + QD + c] = f2bf(bf2f(p.U[row * GMD + c]) * a);
        }
    }
}

template <int MODE>
__device__ __forceinline__ void phase_norm(const Params& p) {
    int tid = threadIdx.x; asm volatile("" : "+v"(tid));
    const int wid = tid >> 6, lane = tid & 63;
    const float* gpost = MODE == 0 ? p.ln_mix_post : MODE == 1 ? p.ln_ffn_post : p.ln_ple_post;
    for (int row = blockIdx.x * 8 + wid; row < MP + NS; row += gridDim.x * 8) {
        const bf16_t* fr = (const bf16_t*)p.F + (size_t)row * DM;
        const bf16_t* xb = MODE == 1 ? (const bf16_t*)p.X1 + (size_t)row * DM : p.X2b + (size_t)row * DM;
        f32x4 f[4], x[4];
#pragma unroll
        for (int k = 0; k < 4; ++k) { const u32x2 w = __builtin_nontemporal_load((const u32x2*)(fr + lane * 4 + k * 256)); f[k][0] = bflo(w.x); f[k][1] = bfhi(w.x); f[k][2] = bflo(w.y); f[k][3] = bfhi(w.y);
            if (MODE == 0) x[k] = __builtin_nontemporal_load((const f32x4*)(xrow_ptr(p, row) + lane * 4 + k * 256));
            else { const u32x2 v = __builtin_nontemporal_load((const u32x2*)(xb + lane * 4 + k * 256)); x[k][0] = bflo(v.x); x[k][1] = bfhi(v.x); x[k][2] = bflo(v.y); x[k][3] = bfhi(v.y); } }
        const float r = row_rstd(f);
#pragma unroll
        for (int k = 0; k < 4; ++k) { const f32x4 g = *(const f32x4*)(gpost + lane * 4 + k * 256); x[k] = x[k] + f[k] * r * g; }
        if (MODE == 0) {
            const float r2 = row_rstd(x);
#pragma unroll
            for (int k = 0; k < 4; ++k) {
                st_bf16x4((bf16_t*)p.X1 + (size_t)row * DM + lane * 4 + k * 256, x[k]);
                const f32x4 g = *(const f32x4*)(p.ln_ffn_pre + lane * 4 + k * 256); const f32x4 o = x[k] * r2 * g;
                st_bf16x4(p.H2 + (size_t)row * DM + lane * 4 + k * 256, o);
            }
        } else if (MODE == 1) {
#pragma unroll
            for (int k = 0; k < 4; ++k) st_bf16x4(p.X2b + (size_t)row * DM + lane * 4 + k * 256, x[k]);
        } else {
            float* yr = row < MP ? p.out + O_YP + (size_t)row * DM : p.out + O_YS + (size_t)(row - MP) * DM;
#pragma unroll
            for (int k = 0; k < 4; ++k) __builtin_nontemporal_store(x[k], (f32x4*)(yr + lane * 4 + k * 256));
        }
    }
}


#define XB_TMO      128
#define XB_XCNT(j)  (256  + 64 * (j))
#define XB_XSUB(j)  (1280 + 64 * (j))
#define XB_XGEN(j)  (2304 + 64 * (j))
#define XB_TOP      3328
#define XB_TOPGEN   3392
#define XCD_BAR_WORDS 3456
#define XB_SPIN_CAP (1u << 22)

__device__ __forceinline__ unsigned xb_ld(unsigned* p)              { return __hip_atomic_load(p, __ATOMIC_RELAXED, __HIP_MEMORY_SCOPE_AGENT); }
__device__ __forceinline__ unsigned xb_add(unsigned* p, unsigned v) { return __hip_atomic_fetch_add(p, v, __ATOMIC_RELAXED, __HIP_MEMORY_SCOPE_AGENT); }
__device__ __forceinline__ unsigned xb_xcc_id() { return (unsigned)__builtin_amdgcn_s_getreg((3 << 11) | 20) & 0xFu; }
#define XB_SPIN(cond, bar) do { unsigned _sp = 0; while (cond) { __builtin_amdgcn_s_sleep(1); \
    if ((++_sp & 255u) == 0u) { if (xb_ld(&(bar)[XB_TMO])) break; if (_sp > XB_SPIN_CAP) { atomicAdd(&(bar)[XB_TMO], 1u); break; } } } } while (0)

struct XcdBarrier {
    unsigned* bar; unsigned x;
    volatile LAS unsigned* st;
};

__device__ __forceinline__ XcdBarrier xcd_barrier_post(unsigned* bar, volatile LAS unsigned* st) {
    XcdBarrier b; b.bar = bar; b.x = xb_xcc_id(); b.st = st;
    if (threadIdx.x == 0) (void)xb_add(&bar[XB_XCNT(b.x)], 1u);
    return b;
}
__device__ __forceinline__ void xcd_barrier_complete(unsigned* bar, unsigned x, unsigned& nloc, unsigned& nx) {
    const unsigned G = gridDim.x * gridDim.y * gridDim.z;
    unsigned sum, cnt, mine, sp = 0u;
    for (;;) {
        sum = 0u; cnt = 0u; mine = 0u;
#pragma unroll
        for (unsigned j = 0; j < 16; ++j) { const unsigned c = xb_ld(&bar[XB_XCNT(j)]); sum += c; cnt += (c > 0u) ? 1u : 0u; mine = (j == x) ? c : mine; }
        if (sum == G) break;
        __builtin_amdgcn_s_sleep(1);
        if ((++sp & 255u) == 0u) { if (xb_ld(&bar[XB_TMO])) break; if (sp > XB_SPIN_CAP) { atomicAdd(&bar[XB_TMO], 1u); break; } }
    }
    nloc = mine > 0u ? mine : 1u; nx = cnt > 0u ? cnt : 1u;
}

__device__ __forceinline__ void xcd_barrier(const XcdBarrier& b) {
    asm volatile("s_waitcnt vmcnt(0)" ::: "memory");
    __syncthreads();
    if (threadIdx.x == 0) {
        unsigned* bar = b.bar;
        __builtin_amdgcn_s_waitcnt(0);
        unsigned nloc = b.st[0], nx = b.st[1];
        if (nloc == 0u) { xcd_barrier_complete(bar, b.x, nloc, nx); b.st[0] = nloc; b.st[1] = nx; }
        const unsigned old = xb_add(&bar[XB_XSUB(b.x)], 1u);
        const unsigned gen = old / nloc;
        if (old + 1u == (gen + 1u) * nloc) {
            __builtin_amdgcn_fence(__ATOMIC_RELEASE, "agent");
            asm volatile("s_waitcnt vmcnt(0)" ::: "memory");
            const unsigned og = xb_add(&bar[XB_TOP], 1u);
            const unsigned tg = og / nx;
            if (og + 1u == (tg + 1u) * nx) xb_add(&bar[XB_TOPGEN], 1u);
            else XB_SPIN(xb_ld(&bar[XB_TOPGEN]) == tg, bar);
            __builtin_amdgcn_fence(__ATOMIC_ACQUIRE, "agent");
            xb_add(&bar[XB_XGEN(b.x)], 1u);
            asm volatile("s_waitcnt vmcnt(0)" ::: "memory");
        } else {
            XB_SPIN(xb_ld(&bar[XB_XGEN(b.x)]) == gen, bar);
            __builtin_amdgcn_fence(__ATOMIC_ACQUIRE, "agent");
            asm volatile("s_waitcnt vmcnt(0)" ::: "memory");
        }
    }
    __syncthreads();
}

constexpr int NPHASE = 16;
constexpr int LDS_BYTES = GEMM_LDS;
static_assert(GM_LDS <= LDS_BYTES, "lds");
constexpr int NMT = MALL / BM;

constexpr int NMP = MP / BM;
template <int PH>
__device__ __forceinline__ void run_phase(const Params& p) {
    if (PH == 0) phase_prologue(p);
    if (PH == 1) { EpiIn e{p}; if (blockIdx.x & 1) phase_gather(p); gemm_phase(p.H, DM, p.WinT, DM, NMP, INP / BM, e); gemm_skinny(p.H + (size_t)MP * DM, DM, p.WinT, DM, INP, e); if (!(blockIdx.x & 1)) phase_gather(p); }
    if (PH == 2) { EpiPart e{(bf16_t*)p.PART}; gemm_phase(p.CMPb, 4096, p.W1T, 1024, (2048 + NS * 1024) / BM, 1, e, 4, ZCmp(), 256); phase_deferred_transposes(p); }
    if (PH == 3) phase_cmp_final(p);
    if (PH == 4) phase_attn(p);
    if (PH == 5) phase_gmlp(p);
    if (PH == 6) { EpiBranch e{p.GA, p.GB, p.Y1}; gemm_phase<EpiBranch, ZNone, true>(p.OCAT, DM, p.WnT, DM, NMP, DM / BM, e); gemm_skinny2(p.OCAT + (size_t)MP * DM, DM, p.WnT, DM, DM, e); }
    if (PH == 8) { EpiBf16 e{(bf16_t*)p.F, DM}; gemm_phase(p.Y1, DM, p.WoT, DM, NMP, DM / BM, e); gemm_skinny(p.Y1 + (size_t)MP * DM, DM, p.WoT, DM, DM, e); }
    if (PH == 9) phase_norm<0>(p);
    if (PH == 10) { EpiSwiGLU e{p.ACT}; gemm_phase(p.H2, DM, p.WguT, DM, NMP, 2 * DFF / BM, e); gemm_skinny(p.H2 + (size_t)MP * DM, DM, p.WguT, DM, 2 * DFF, e); }
    if (PH == 11) { EpiBf16 e{(bf16_t*)p.F, DM}; gemm_phase(p.ACT, DFF, p.WdT, DFF, NMP, DM / BM, e); gemm_skinny(p.ACT + (size_t)MP * DFF, DFF, p.WdT, DFF, DM, e); }
    if (PH == 12) phase_norm<1>(p);
    if (PH == 13) { EpiBf16 e{(bf16_t*)p.T, DM}; gemm_phase(p.Pb, PLE, p.WpT, PLE, NMP, DM / BM, e); gemm_skinny(p.Pb + (size_t)MP * PLE, PLE, p.WpT, PLE, DM, e); }
    if (PH == 14) { EpiPleGate e{(const bf16_t*)p.T, (bf16_t*)p.F}; gemm_phase(p.X2b, DM, p.WpgT, DM, NMP, DM / BM, e); gemm_skinny(p.X2b + (size_t)MP * DM, DM, p.WpgT, DM, DM, e); }
    if (PH == 15) phase_norm<2>(p);
}

#ifndef MK_MULTI
#define MK_MULTI 0
#endif
template <int PH>
__global__ void __launch_bounds__(512, 2) k_phase(Params p) { run_phase<PH>(p); }

__global__ void __launch_bounds__(512, 2) k_all(Params p) {
    volatile LAS unsigned* st = (volatile LAS unsigned*)((LAS unsigned char*)smem + LDS_BYTES);
    if (threadIdx.x < 12) st[threadIdx.x] = 0u;
    __syncthreads();
    XcdBarrier bar = xcd_barrier_post(p.bar, st);
#if PROBE_DUP == 100
    run_phase<0>(p);  xcd_barrier(bar);
#endif
#if PROBE_SPIN >= 100
    if (threadIdx.x == 0) PROBE_TS[3] = probe_now();
#define PROBE_STAMP(k) if (threadIdx.x == 0 && PROBE_SEG == (k)) PROBE_TS[2] = probe_now() - PROBE_TS[3];
#else
#define PROBE_STAMP(k)
#endif
    run_phase<0>(p);  xcd_barrier(bar);
    PROBE_STAMP(20)
    run_phase<1>(p);  xcd_barrier(bar);
    PROBE_STAMP(21)
    run_phase<2>(p);  xcd_barrier(bar);
#if PROBE_DUP == 100
    run_phase<3>(p);  xcd_barrier(bar);
#endif
    run_phase<3>(p);  xcd_barrier(bar);
    PROBE_STAMP(23)
#if PROBE_DUP == 104
    run_phase<4>(p);  xcd_barrier(bar);
#endif
    run_phase<4>(p);
#if PROBE_DUP == 100
    run_phase<5>(p);  xcd_barrier(bar);
#endif
    run_phase<5>(p);  xcd_barrier(bar);
    PROBE_STAMP(25)
    run_phase<6>(p);  xcd_barrier(bar);
    run_phase<8>(p);  xcd_barrier(bar);
    PROBE_STAMP(28)
    run_phase<9>(p);  xcd_barrier(bar);
    PROBE_STAMP(29)
    run_phase<10>(p); xcd_barrier(bar);
    PROBE_STAMP(30)
    run_phase<11>(p); xcd_barrier(bar);
    PROBE_STAMP(31)
    run_phase<12>(p);
    run_phase<13>(p); xcd_barrier(bar);
    run_phase<14>(p); xcd_barrier(bar);
    PROBE_STAMP(34)
    run_phase<15>(p);
#if PROBE_SPIN
    if (blockIdx.x == 0 && threadIdx.x == 0) {
        const unsigned long long d = PROBE_TS[2] * (PROBE_SPIN >= 100 ? PROBE_SPIN - 100 : PROBE_SPIN), t0 = probe_now();
        while (probe_now() - t0 < d) __builtin_amdgcn_s_sleep(8);
    }
#endif
}

static inline size_t al256(size_t x) { return (x + 255) & ~(size_t)255; }
template <int PH> static void launch_phase(const Params& p, int grid, hipStream_t s) {
    static bool attr = false;
    if (!attr) { (void)hipFuncSetAttribute((const void*)k_phase<PH>, hipFuncAttributeMaxDynamicSharedMemorySize, LDS_BYTES); attr = true; }
    k_phase<PH><<<grid, 512, LDS_BYTES, s>>>(p);
}
template <int PH> static void launch_all(const Params& p, int grid, hipStream_t s) {
    launch_phase<PH>(p, grid, s);
    if constexpr (PH + 1 < NPHASE) launch_all<PH + 1>(p, grid, s);
}

extern "C" void kernel_launch(void* const* d_in, const int* in_sizes, int n_in, void* d_out, int out_size, void* d_ws, size_t ws_size, hipStream_t stream) {
    Params p{};
    p.x_prompt = (const float*)d_in[0]; p.x_sample = (const float*)d_in[1]; p.cache_cmp = (const float*)d_in[2]; p.cache_slc = (const float*)d_in[3];
    p.state_win = (const float*)d_in[4]; p.page_table = (const int*)d_in[5]; p.p_prompt = (const float*)d_in[6]; p.p_sample = (const float*)d_in[7];
    p.rel_bias = (const float*)d_in[8]; p.ln_mix_pre = (const float*)d_in[9]; p.w_in = (const float*)d_in[10];
    p.pe_k = (const float*)d_in[11]; p.w1_k = (const float*)d_in[12]; p.w2_k = (const float*)d_in[13];
    p.pe_v = (const float*)d_in[14]; p.w1_v = (const float*)d_in[15]; p.w2_v = (const float*)d_in[16];
    p.gm_ln_g = (const float*)d_in[17]; p.gm_ln_b = (const float*)d_in[18]; p.gm_ws = (const float*)d_in[19]; p.gm_bs = (const float*)d_in[20];
    p.w_br_nsa = (const float*)d_in[21]; p.w_br_gm = (const float*)d_in[22]; p.w_out = (const float*)d_in[23];
    p.ln_mix_post = (const float*)d_in[24]; p.ln_ffn_pre = (const float*)d_in[25]; p.w_gate = (const float*)d_in[26]; p.w_up = (const float*)d_in[27];
    p.w_down = (const float*)d_in[28]; p.ln_ffn_post = (const float*)d_in[29]; p.w_ple = (const float*)d_in[30]; p.w_ple_gate = (const float*)d_in[31];
    p.ln_ple_post = (const float*)d_in[32];
    p.out = (float*)d_out;
    unsigned char* w = (unsigned char*)d_ws; size_t off = 0;
    auto take = [&](size_t bytes) { void* r = w + off; off = al256(off + bytes); return r; };
    p.bar = (unsigned*)take(16384);
    p.WinT = (bf16_t*)take((size_t)INP * DM * 2); p.WnT = (bf16_t*)take((size_t)DM * DM * 2); p.WgT = nullptr;
    p.WoT = (bf16_t*)take((size_t)DM * DM * 2); p.WguT = (bf16_t*)take((size_t)2 * DFF * DM * 2); p.WdT = (bf16_t*)take((size_t)DM * DFF * 2);
    p.WpgT = (bf16_t*)take((size_t)DM * DM * 2); p.WpT = (bf16_t*)take((size_t)DM * PLE * 2); p.W1T = (bf16_t*)take((size_t)2 * 256 * 1024 * 2);
    p.H = (bf16_t*)take((size_t)MALL * DM * 2); p.Qb = (bf16_t*)take((size_t)MALL * QD * 2);
    p.CMPb = (bf16_t*)take(((size_t)MP + (size_t)NS * PAST) * 256 * 2); p.SLCb = (bf16_t*)take((size_t)MALL * 256 * 2); p.WINb = (bf16_t*)take((size_t)MALL * 256 * 2);
    p.U = (bf16_t*)take((size_t)MALL * GMD * 2); p.Vg = (bf16_t*)take((size_t)MALL * GMD * 2);
    p.GA = (bf16_t*)take((size_t)MALL * DM * 2); p.GB = (bf16_t*)take((size_t)MALL * DM * 2);
    p.GATE = (float*)take((size_t)MALL * 32 * 4);
    p.PART = (float*)take((size_t)(2048 + NS * 1024) * 4 * 256 * 4); p.PEB = (float*)take(256 * 4);
    p.KCP = (float*)take((size_t)NB * NG * 512 * 64 * 4); p.VCP = (float*)take((size_t)NB * NG * 512 * 64 * 4);
    p.KCS = (float*)take((size_t)NS * NG * 1024 * 64 * 4); p.VCS = (float*)take((size_t)NS * NG * 1024 * 64 * 4); p.KN = (float*)take(NB * NG * 128 * 4);
    p.KCb = (bf16_t*)take((size_t)NB * NG * 512 * 64 * 2); p.VCT = (bf16_t*)take((size_t)NB * NG * 64 * 512 * 2);
    p.SLCvT = (bf16_t*)take((size_t)NB * NG * 64 * SEQ * 2); p.WINvT = (bf16_t*)take((size_t)NB * NG * 64 * SEQ * 2);
    p.GWb = (bf16_t*)take(4 * 128 * 128 * 2); p.W2T = (bf16_t*)take(2 * 64 * 128 * 2);
    p.SLCkF = (bf16_t*)take((size_t)NB * NG * 64 * SEQ * 2); p.WINkF = (bf16_t*)take((size_t)NB * NG * 64 * SEQ * 2);
    p.OCAT = (bf16_t*)take((size_t)MALL * DM * 2); p.T = (float*)take((size_t)MALL * DM * 4); p.Y1 = (bf16_t*)take((size_t)MALL * DM * 2);
    p.F = (float*)take((size_t)MALL * DM * 4); p.X1 = (float*)take((size_t)MALL * DM * 4); p.H2 = (bf16_t*)take((size_t)MALL * DM * 2);
    p.ACT = (bf16_t*)take((size_t)MALL * DFF * 2); p.X2 = (float*)take((size_t)MALL * DM * 4); p.X2b = (bf16_t*)take((size_t)MALL * DM * 2);
    p.Pb = (bf16_t*)take((size_t)MALL * PLE * 2);
    if (off > ws_size) { fprintf(stderr, "workspace too small: need %zu have %zu\n", off, ws_size); return; }
#if MK_MULTI
    launch_all<0>(p, 256, stream);
#else
    constexpr size_t kDynLds = LDS_BYTES + 48;
    static int grid = 0;
    if (!grid) {
        int dev = 0, cus = 0, per_cu = 0;
        (void)hipGetDevice(&dev);
        (void)hipDeviceGetAttribute(&cus, hipDeviceAttributeMultiprocessorCount, dev);
        (void)hipFuncSetAttribute((const void*)k_all, hipFuncAttributeMaxDynamicSharedMemorySize, (int)kDynLds);
        (void)hipOccupancyMaxActiveBlocksPerMultiprocessor(&per_cu, (const void*)k_all, 512, kDynLds);
        grid = cus * (per_cu < 1 ? per_cu : 1);
        if (grid <= 0) { fprintf(stderr, "k_all: occupancy query says %d blocks per CU\n", per_cu); grid = 0; return; }
    }
    (void)hipMemsetAsync(p.bar, 0, XCD_BAR_WORDS * sizeof(unsigned), stream);
    k_all<<<grid, 512, kDynLds, stream>>>(p);
#endif
}
```
